# Optimizing an MI355X kernel written in HIP

```python
import math
import jax
import jax.numpy as jnp
from jax import lax
import numpy as np

D_MODEL = 1024
BATCH = 8
SEQ = 2048
DEPTH = 2

CTX_LEN = 256
GRID_W = 64

A_HEADS = 4
A_DK = 64
A_DV = 64
B_HEADS = 4
B_DQK = 32
B_DV = 64
C_HEADS = 4
C_DQK = 64
C_DV = 2 * C_DQK

A_WIDTH = A_HEADS * A_DV
B_WIDTH = B_HEADS * B_DV
C_WIDTH = C_HEADS * C_DV
D_MIX = A_WIDTH + B_WIDTH + C_WIDTH

PROJ_SIZES = (
    A_HEADS * A_DK,
    A_WIDTH,
    A_HEADS * A_DK,
    A_HEADS * A_DK,
    A_WIDTH,
    B_HEADS * B_DQK,
    B_HEADS * B_DQK,
    B_WIDTH,
    B_WIDTH,
    4 * B_HEADS,
    C_HEADS * 2 * C_DQK,
    C_HEADS * 2 * C_DQK,
    C_WIDTH,
)
D_PROJ = sum(PROJ_SIZES)

N_EXPERTS = 32
TOP_K = 4
D_FF = 1024
SWIGLU_ALPHA = 1.702
SWIGLU_LIMIT = 7.0

SCAN_CHUNK = 64
Q_BLOCK = 128
MOE_BLOCK = 128
ROPE_THETA = 10000.0
NORM_EPS = 1e-6
MLSTM_F_BIAS = 3.0
MASK_NEG = -1e30
F_MIN = 1e-12

kernel_name = 'hybrid_dit_hgrn2_mlstm_diffattn_moe'


def rmsnorm(x, gain):
    xf = x.astype(jnp.float32)
    y = xf * lax.rsqrt(jnp.mean(xf * xf, axis=-1, keepdims=True) + NORM_EPS)
    return (y * gain.astype(jnp.float32)).astype(x.dtype)


def modulated_norm(t, gain, shift, scale):
    return rmsnorm(t, gain) * (1.0 + scale) + shift


def split_heads(t, n_heads):
    b, l, w = t.shape
    return t.reshape(b, l, n_heads, w // n_heads).transpose(0, 2, 1, 3)


def merge_heads(t):
    b, h, l, d = t.shape
    return t.transpose(0, 2, 1, 3).reshape(b, l, h * d)


def flip_t(t):
    return jnp.flip(t, axis=2)


def split_projection(p):
    parts, start = [], 0
    for size in PROJ_SIZES:
        parts.append(p[..., start:start + size])
        start += size
    return parts


def to_chunks(t):
    b, h, l = t.shape[:3]
    t = t.reshape(b, h, l // SCAN_CHUNK, SCAN_CHUNK, *t.shape[3:])
    return jnp.moveaxis(t, 2, 0)


def from_chunks(t):
    t = jnp.moveaxis(t, 0, 2)
    b, h, n, c = t.shape[:4]
    return t.reshape(b, h, n * c, *t.shape[4:])


def axial_rope_tables(length):
    rows = length // GRID_W
    row = jnp.repeat(jnp.arange(rows, dtype=jnp.float32), GRID_W)
    col = jnp.tile(jnp.arange(GRID_W, dtype=jnp.float32), rows)
    n_freq = C_DQK // 4
    inv_freq = ROPE_THETA ** (-jnp.arange(n_freq, dtype=jnp.float32) / n_freq)
    ang_r = row[:, None] * inv_freq
    ang_c = col[:, None] * inv_freq
    return jnp.cos(ang_r), jnp.sin(ang_r), jnp.cos(ang_c), jnp.sin(ang_c)


def rotate_half(x, cos, sin):
    n = cos.shape[-1]
    x1, x2 = x[..., :n], x[..., n:]
    return jnp.concatenate([x1 * cos - x2 * sin, x1 * sin + x2 * cos], axis=-1)


def apply_axial_rope(x, tables):
    cr, sr, cc, sc = tables
    half = x.shape[-1] // 2
    xf = x.astype(jnp.float32)
    out = jnp.concatenate([rotate_half(xf[..., :half], cr, sr),
                           rotate_half(xf[..., half:], cc, sc)], axis=-1)
    return out.astype(x.dtype)


def hgrn_lower_bound(table, layer):
    p = jax.nn.softmax(table.astype(jnp.float32), axis=1)
    cum = jnp.cumsum(p, axis=1) - p[:, :1]
    return jnp.clip(cum[:, layer], 0.0, 1.0)


def hgrn2_gates(f_pre, lb):
    f_pre = f_pre.astype(jnp.float32)
    f = lb + (1.0 - lb) * jax.nn.sigmoid(f_pre)
    log_f = jnp.log(jnp.maximum(f, F_MIN))
    k = (1.0 - lb) * jax.nn.sigmoid(-f_pre)
    return split_heads(log_f, A_HEADS), split_heads(k, A_HEADS)


def hgrn2_scan(q, k, v, log_f, state):
    causal = jnp.tril(jnp.ones((SCAN_CHUNK, SCAN_CHUNK), dtype=bool))[:, :, None]

    def step(s, blk):
        qc, kc, vc, lfc = blk
        cum = jnp.cumsum(lfc, axis=-2)
        o_inter = jnp.einsum('bhtk,bhkv->bhtv', qc * jnp.exp(cum), s)
        rel = cum[:, :, :, None, :] - cum[:, :, None, :, :]
        decay = jnp.where(causal, jnp.exp(jnp.where(causal, rel, 0.0)), 0.0)
        scores = jnp.einsum('bhtk,bhsk,bhtsk->bhts', qc, kc, decay)
        o = o_inter + jnp.einsum('bhts,bhsv->bhtv', scores, vc)
        k_end = kc * jnp.exp(cum[:, :, -1:, :] - cum)
        s_new = jnp.exp(cum[:, :, -1, :])[..., None] * s + jnp.einsum('bhsk,bhsv->bhkv', k_end, vc)
        return s_new, o

    state, o = lax.scan(step, state, (to_chunks(q), to_chunks(k), to_chunks(v), to_chunks(log_f)))
    return from_chunks(o), state


def hgrn2_group(parts, lb, gain, s_fwd, s_bwd, readout):
    a_q, a_i, a_f_fwd, a_f_bwd, a_g = parts
    q = split_heads(jax.nn.silu(a_q.astype(jnp.float32)), A_HEADS)
    v = split_heads(a_i.astype(jnp.float32), A_HEADS)
    lf_f, k_f = hgrn2_gates(a_f_fwd, lb[0])
    lf_b, k_b = hgrn2_gates(a_f_bwd, lb[1])
    o_f, s_f = hgrn2_scan(q, k_f, v, lf_f, s_fwd)
    o_b, s_b = hgrn2_scan(flip_t(q), flip_t(k_b), flip_t(v), flip_t(lf_b), s_bwd)
    if not readout:
        return None, s_f, s_b
    o = rmsnorm(o_f + flip_t(o_b), gain)
    return merge_heads(o) * jax.nn.silu(a_g.astype(jnp.float32)), s_f, s_b


def mlstm_scan(q, k, v, log_i, log_f, state):
    causal = jnp.tril(jnp.ones((SCAN_CHUNK, SCAN_CHUNK), dtype=bool))

    def step(carry, blk):
        c_mat, n_vec, m = carry
        qc, kc, vc, ic, fc = blk
        cum = jnp.cumsum(fc, axis=-1)
        log_d = jnp.where(causal, cum[..., :, None] - cum[..., None, :] + ic[..., None, :], MASK_NEG)
        log_inter = cum + m[..., None]
        m_t = jnp.maximum(log_inter, jnp.max(log_d, axis=-1))
        w_intra = jnp.where(causal, jnp.exp(log_d - m_t[..., None]), 0.0)
        w_inter = jnp.exp(log_inter - m_t)
        scores = jnp.einsum('bhtk,bhsk->bhts', qc, kc) * w_intra
        num = (w_inter[..., None] * jnp.einsum('bhtk,bhkv->bhtv', qc, c_mat)
               + jnp.einsum('bhts,bhsv->bhtv', scores, vc))
        den = w_inter * jnp.einsum('bhtk,bhk->bht', qc, n_vec) + jnp.sum(scores, axis=-1)
        h = num / jnp.maximum(jnp.abs(den), jnp.exp(-m_t))[..., None]
        log_end = cum[..., -1:] - cum + ic
        m_end = jnp.maximum(cum[..., -1] + m, jnp.max(log_end, axis=-1))
        w_end = jnp.exp(log_end - m_end[..., None])
        w_carry = jnp.exp(cum[..., -1] + m - m_end)
        c_new = w_carry[..., None, None] * c_mat + jnp.einsum('bhs,bhsk,bhsv->bhkv', w_end, kc, vc)
        n_new = w_carry[..., None] * n_vec + jnp.einsum('bhs,bhsk->bhk', w_end, kc)
        return (c_new, n_new, m_end), h

    state, h = lax.scan(step, state, (to_chunks(q), to_chunks(k), to_chunks(v),
                                      to_chunks(log_i), to_chunks(log_f)))
    return from_chunks(h), state


def mlstm_group(parts, gate_bias, gain, st_fwd, st_bwd, readout):
    b_q, b_k, b_v, b_o, b_g = parts
    q = split_heads(b_q.astype(jnp.float32), B_HEADS) * (B_DQK ** -0.5)
    k = split_heads(b_k.astype(jnp.float32), B_HEADS)
    v = split_heads(b_v.astype(jnp.float32), B_HEADS)
    bsz, l, _ = b_g.shape
    g = (b_g.astype(jnp.float32) + gate_bias.astype(jnp.float32)).reshape(bsz, l, 4, B_HEADS)
    g = g.transpose(2, 0, 3, 1)
    h_f, st_f = mlstm_scan(q, k, v, g[0], jax.nn.log_sigmoid(g[1]), st_fwd)
    h_b, st_b = mlstm_scan(flip_t(q), flip_t(k), flip_t(v), flip_t(g[2]),
                           flip_t(jax.nn.log_sigmoid(g[3])), st_bwd)
    if not readout:
        return None, st_f, st_b
    gain_h = gain.astype(jnp.float32).reshape(B_HEADS, 1, B_DV)
    h = rmsnorm(h_f + flip_t(h_b), gain_h)
    return merge_heads(h) * jax.nn.sigmoid(b_o.astype(jnp.float32)), st_f, st_b


def diff_lambda(lam_params, lam_init):
    lq1, lk1, lq2, lk2 = lam_params.astype(jnp.float32)
    return jnp.exp(jnp.sum(lq1 * lk1)) - jnp.exp(jnp.sum(lq2 * lk2)) + lam_init


def diff_qkv(c_q, c_k, c_v):
    b, l, _ = c_q.shape
    q = c_q.reshape(b, l, C_HEADS, 2, C_DQK).transpose(0, 2, 3, 1, 4)
    k = c_k.reshape(b, l, C_HEADS, 2, C_DQK).transpose(0, 2, 3, 1, 4)
    v = split_heads(c_v, C_HEADS)
    return q, k, v


def diff_combine(s, v, lam):
    p = jax.nn.softmax(s.astype(jnp.float32) * (C_DQK ** -0.5), axis=-1)
    w = p[:, :, 0] - lam * p[:, :, 1]
    return jnp.einsum('bhqk,bhkv->bhqv', w, v.astype(jnp.float32))


def diff_readout(o, gain, lam_init):
    return merge_heads(rmsnorm(o, gain)) * (1.0 - lam_init)


def diff_group_context(parts, lam, lam_init, gain, readout):
    q, k, v = diff_qkv(*parts)
    if not readout:
        return None, k, v
    o = diff_combine(jnp.einsum('bhjqd,bhjkd->bhjqk', q, k), v, lam)
    return diff_readout(o, gain, lam_init), k, v


def diff_group_latent(parts, k_ctx, v_ctx, lam, lam_init, gain, tables):
    q, k, v = diff_qkv(*parts)
    b, h, _, l, d = q.shape
    q_rot = apply_axial_rope(q, tables)
    k_rot = apply_axial_rope(k, tables)
    v_all = jnp.concatenate([v, v_ctx], axis=2)
    n_blk = l // Q_BLOCK

    def blocks(t):
        return jnp.moveaxis(t.reshape(b, h, 2, n_blk, Q_BLOCK, d), 3, 0)

    def attend(args):
        qr, qp = args
        s = jnp.concatenate([jnp.einsum('bhjqd,bhjkd->bhjqk', qr, k_rot),
                             jnp.einsum('bhjqd,bhjkd->bhjqk', qp, k_ctx)],
                            axis=-1)
        return diff_combine(s, v_all, lam)

    o = lax.map(attend, (blocks(q_rot), blocks(q)))
    o = jnp.moveaxis(o, 0, 2).reshape(b, h, l, C_DV)
    return diff_readout(o, gain, lam_init)


def moe_ffn(h, router_w, router_b, w1, b1, w2, b2):
    shape = h.shape
    tokens = h.reshape(-1, MOE_BLOCK, shape[-1])

    def block(t):
        logits = (t @ router_w + router_b).astype(jnp.float32)
        top_val, top_idx = lax.top_k(logits, TOP_K)
        weights = jax.nn.softmax(top_val, axis=-1)
        gate = jnp.einsum('tk,tke->te', weights, jax.nn.one_hot(top_idx, N_EXPERTS, dtype=jnp.float32))
        hid = jnp.einsum('td,edf->tef', t, w1) + b1
        glu = jnp.minimum(hid[..., 0::2], SWIGLU_LIMIT)
        lin = jnp.clip(hid[..., 1::2], -SWIGLU_LIMIT, SWIGLU_LIMIT)
        act = glu * jax.nn.sigmoid(SWIGLU_ALPHA * glu) * (lin + 1.0)
        act = act * gate[..., None].astype(act.dtype)
        return jnp.einsum('tef,efd->td', act, w2) + gate.astype(t.dtype) @ b2

    return lax.map(block, tokens).reshape(shape)


def setup_inputs(seed: int = 0) -> dict:
    key = jax.random.key(seed)
    ks = jax.random.split(key, 21)
    f32 = jnp.float32

    def nrm(k, shape, scale):
        return jax.random.normal(k, shape, f32) * scale

    gate_offset = jnp.array([0.0, MLSTM_F_BIAS, 0.0, MLSTM_F_BIAS], f32)[None, :, None]
    return {
        'x': nrm(ks[0], (BATCH, SEQ, D_MODEL), 1.0),
        'c': nrm(ks[1], (BATCH, D_MODEL), 1.0),
        'ctx': nrm(ks[2], (BATCH, CTX_LEN, D_MODEL), 1.0),
        'c_ctx': nrm(ks[3], (D_MODEL,), 1.0),
        'ada_w': nrm(ks[4], (DEPTH, D_MODEL, 6 * D_MODEL), 0.5 * D_MODEL ** -0.5),
        'ada_b': nrm(ks[5], (DEPTH, 6 * D_MODEL), 0.02),
        'sandwich_norms': 1.0 + nrm(ks[6], (DEPTH, 4, D_MODEL), 0.05),
        'w_in': nrm(ks[7], (DEPTH, D_MODEL, D_PROJ), D_MODEL ** -0.5),
        'w_out': nrm(ks[8], (DEPTH, D_MIX, D_MODEL), D_MIX ** -0.5),
        'hgrn_lower_bounds': nrm(ks[9], (2, DEPTH, A_HEADS * A_DK), 0.5),
        'hgrn_norm': 1.0 + nrm(ks[10], (DEPTH, A_DV), 0.05),
        'mlstm_gate_bias': (nrm(ks[11], (DEPTH, 4, B_HEADS), 0.1) + gate_offset).reshape(DEPTH, 4 * B_HEADS),
        'mlstm_norm': 1.0 + nrm(ks[12], (DEPTH, B_WIDTH), 0.05),
        'diff_lambdas': nrm(ks[13], (DEPTH, 4, C_DQK), 0.1),
        'diff_norm': 1.0 + nrm(ks[14], (DEPTH, C_DV), 0.05),
        'router_w': nrm(ks[15], (DEPTH, D_MODEL, N_EXPERTS), D_MODEL ** -0.5),
        'router_b': nrm(ks[16], (DEPTH, N_EXPERTS), 0.01),
        'moe_w1': nrm(ks[17], (DEPTH, N_EXPERTS, D_MODEL, 2 * D_FF), D_MODEL ** -0.5),
        'moe_b1': nrm(ks[18], (DEPTH, N_EXPERTS, 2 * D_FF), 0.01),
        'moe_w2': nrm(ks[19], (DEPTH, N_EXPERTS, D_FF, D_MODEL), D_FF ** -0.5),
        'moe_b2': nrm(ks[20], (DEPTH, N_EXPERTS, D_MODEL), 0.01),
    }


def reference(x, c, ctx, c_ctx, ada_w, ada_b, sandwich_norms, w_in, w_out,
              hgrn_lower_bounds, hgrn_norm, mlstm_gate_bias, mlstm_norm,
              diff_lambdas, diff_norm, router_w, router_b, moe_w1, moe_b1, moe_w2, moe_b2):
    f32 = jnp.float32
    bsz, length, _ = x.shape
    tables = axial_rope_tables(length)
    y = ctx
    cond_lat = jax.nn.silu(c)
    cond_ctx = jax.nn.silu(c_ctx)[None]
    zero_a = jnp.zeros((bsz, A_HEADS, A_DK, A_DV), f32)
    zero_b = (jnp.zeros((bsz, B_HEADS, B_DQK, B_DV), f32),
              jnp.zeros((bsz, B_HEADS, B_DQK), f32),
              jnp.zeros((bsz, B_HEADS), f32))

    for layer in range(DEPTH):
        last = layer == DEPTH - 1
        norms = sandwich_norms[layer]
        mod_l = jnp.split((cond_lat @ ada_w[layer] + ada_b[layer])[:, None, :], 6, axis=-1)
        mod_c = jnp.split((cond_ctx @ ada_w[layer] + ada_b[layer])[:, None, :], 6, axis=-1)
        lb = hgrn_lower_bound(hgrn_lower_bounds, layer)
        lam_init = 0.8 - 0.6 * math.exp(-0.3 * layer)
        lam = diff_lambda(diff_lambdas[layer], lam_init)

        p_ctx = split_projection(modulated_norm(y, norms[0], mod_c[0], mod_c[1]) @ w_in[layer])
        p_lat = split_projection(modulated_norm(x, norms[0], mod_l[0], mod_l[1]) @ w_in[layer])

        oa_c, sa_f, sa_b = hgrn2_group(p_ctx[0:5], lb, hgrn_norm[layer], zero_a, zero_a, not last)
        ob_c, sb_f, sb_b = mlstm_group(p_ctx[5:10], mlstm_gate_bias[layer], mlstm_norm[layer],
                                       zero_b, zero_b, not last)
        oc_c, k_ctx, v_ctx = diff_group_context(p_ctx[10:13], lam, lam_init, diff_norm[layer], not last)

        oa_l, _, _ = hgrn2_group(p_lat[0:5], lb, hgrn_norm[layer], sa_f, sa_b, True)
        ob_l, _, _ = mlstm_group(p_lat[5:10], mlstm_gate_bias[layer], mlstm_norm[layer], sb_f, sb_b, True)
        oc_l = diff_group_latent(p_lat[10:13], k_ctx, v_ctx, lam, lam_init, diff_norm[layer], tables)

        mix_l = jnp.concatenate([oa_l, ob_l, oc_l], axis=-1).astype(x.dtype) @ w_out[layer]
        x = x + mod_l[2] * rmsnorm(mix_l, norms[1])
        ffn_l = moe_ffn(modulated_norm(x, norms[2], mod_l[3], mod_l[4]), router_w[layer], router_b[layer],
                        moe_w1[layer], moe_b1[layer], moe_w2[layer], moe_b2[layer])
        x = x + mod_l[5] * rmsnorm(ffn_l, norms[3])

        if not last:
            mix_c = jnp.concatenate([oa_c, ob_c, oc_c], axis=-1).astype(y.dtype) @ w_out[layer]
            y = y + mod_c[2] * rmsnorm(mix_c, norms[1])
            ffn_c = moe_ffn(modulated_norm(y, norms[2], mod_c[3], mod_c[4]), router_w[layer], router_b[layer],
                            moe_w1[layer], moe_b1[layer], moe_w2[layer], moe_b2[layer])
            y = y + mod_c[5] * rmsnorm(ffn_c, norms[3])
    return x
```

```cpp
#include <hip/hip_runtime.h>
#include <stdint.h>

namespace {
constexpr int D = 1024, NB = 8, SEQ = 2048, CTX = 256, SL = 2304, NT = NB * SL;
constexpr int DP = 3600, NE = 32, DFF = 1024, NPAIR = NT * 4;
constexpr int O_AQ = 0, O_AI = 256, O_AFF = 512, O_AFB = 768, O_AG = 1024, O_BQ = 1280, O_BK = 1408, O_BV = 1536, O_BO = 1792, O_BG = 2048, O_CQ = 2064, O_CK = 2576, O_CV = 3088;
constexpr int LISTCAP = NT;

struct Params {
    const float *x, *c, *ctx, *c_ctx, *ada_w, *ada_b, *norms, *w_in, *w_out, *hlb, *hnorm, *mgb, *mnorm, *dlam, *dnorm, *rw, *rb, *w1, *b1, *w2, *b2;
    float* out;
    float *MOD, *LB, *LAM, *X, *XN, *P, *OA, *HB, *QR, *KT, *OC, *MIX, *MIXO, *S, *H, *Y, *TOPW;
    int *TOPI, *LIST, *CNT;
};

#define DEV __device__ __forceinline__
DEV float wsum(float v) { for (int o = 32; o >= 1; o >>= 1) v += __shfl_xor(v, o); return v; }
DEV float wmaxf(float v) { for (int o = 32; o >= 1; o >>= 1) v = fmaxf(v, __shfl_xor(v, o)); return v; }
DEV float sigm(float x) { return 1.f / (1.f + expf(-x)); }
DEV float rdlane(float v, int l) { return __int_as_float(__builtin_amdgcn_readlane(__float_as_int(v), l)); }
DEV float lam_init_of(int layer) { return 0.8f - 0.6f * expf(-0.3f * (float)layer); }

template <class RowA, class LoadB, class Epi>
DEV void gemm128(int K, RowA rowA, LoadB loadB, Epi epi) {
    __shared__ __attribute__((aligned(16))) float As[16][132];
    __shared__ __attribute__((aligned(16))) float Bs[16][128];
    const int tid = threadIdx.x, ty = tid >> 5, tx = tid & 31;
    const int am = tid >> 2, akq = (tid & 3) * 4, bk = tid >> 5, bn = (tid & 31) * 4;
    const float* arow = rowA(am);
    float acc[8][4];
#pragma unroll
    for (int i = 0; i < 8; ++i)
#pragma unroll
        for (int j = 0; j < 4; ++j) acc[i][j] = 0.f;
    for (int k0 = 0; k0 < K; k0 += 16) {
        float4 a = arow ? *(const float4*)(arow + k0 + akq) : make_float4(0.f, 0.f, 0.f, 0.f);
        float4 b = loadB(k0 + bk, bn);
        __syncthreads();
        As[akq + 0][am] = a.x; As[akq + 1][am] = a.y; As[akq + 2][am] = a.z; As[akq + 3][am] = a.w;
        *(float4*)&Bs[bk][bn] = b;
        __syncthreads();
#pragma unroll
        for (int kk = 0; kk < 16; ++kk) {
            const float4 a0 = *(const float4*)&As[kk][ty * 8], a1 = *(const float4*)&As[kk][ty * 8 + 4], bb = *(const float4*)&Bs[kk][tx * 4];
            const float av[8] = {a0.x, a0.y, a0.z, a0.w, a1.x, a1.y, a1.z, a1.w};
#pragma unroll
            for (int i = 0; i < 8; ++i) { acc[i][0] += av[i] * bb.x; acc[i][1] += av[i] * bb.y; acc[i][2] += av[i] * bb.z; acc[i][3] += av[i] * bb.w; }
        }
    }
#pragma unroll
    for (int i = 0; i < 8; ++i) epi(ty * 8 + i, tx * 4, make_float4(acc[i][0], acc[i][1], acc[i][2], acc[i][3]));
}

DEV void row_load(const float* src, float4 (&v)[4], int lane) {
#pragma unroll
    for (int i = 0; i < 4; ++i) v[i] = *(const float4*)(src + i * 256 + lane * 4);
}
DEV void row_store(float* dst, const float4 (&v)[4], int lane) {
#pragma unroll
    for (int i = 0; i < 4; ++i) *(float4*)(dst + i * 256 + lane * 4) = v[i];
}
DEV float row_rinv(const float4 (&v)[4]) {
    float ss = 0.f;
#pragma unroll
    for (int i = 0; i < 4; ++i) ss += v[i].x * v[i].x + v[i].y * v[i].y + v[i].z * v[i].z + v[i].w * v[i].w;
    ss = wsum(ss);
    return rsqrtf(ss * (1.f / 1024.f) + 1e-6f);
}
DEV void row_modnorm(const float4 (&v)[4], const float* gain, const float* shift, const float* scale, float4 (&o)[4], int lane) {
    const float r = row_rinv(v);
#pragma unroll
    for (int i = 0; i < 4; ++i) {
        const int idx = i * 256 + lane * 4;
        const float4 g = *(const float4*)(gain + idx), sh = *(const float4*)(shift + idx), sc = *(const float4*)(scale + idx);
        o[i].x = v[i].x * r * g.x * (1.f + sc.x) + sh.x; o[i].y = v[i].y * r * g.y * (1.f + sc.y) + sh.y;
        o[i].z = v[i].z * r * g.z * (1.f + sc.z) + sh.z; o[i].w = v[i].w * r * g.w * (1.f + sc.w) + sh.w;
    }
}
DEV const float* modrow(const Params& p, int layer, int b, int s) { return p.MOD + ((size_t)layer * 9 + (s < CTX ? 8 : b)) * 6144; }

__global__ __launch_bounds__(512) void k_mods(Params p) {
    __shared__ float cond[9][1024];
    __shared__ float red[8][9][64];
    const int tid = threadIdx.x;
    for (int i = tid; i < 9 * 1024; i += 512) { const int r = i >> 10, k = i & 1023; const float c = r < 8 ? p.c[r * 1024 + k] : p.c_ctx[k]; cond[r][k] = c * sigm(c); }
    __syncthreads();
    for (int u = blockIdx.x; u < 192; u += gridDim.x) {
        const int layer = u / 96, cg = u % 96, jj = tid & 63, ks = tid >> 6, j = cg * 64 + jj;
        float acc[9];
#pragma unroll
        for (int r = 0; r < 9; ++r) acc[r] = 0.f;
        const float* w = p.ada_w + (size_t)layer * 1024 * 6144 + j;
        for (int k = ks * 128; k < ks * 128 + 128; ++k) { const float wv = w[(size_t)k * 6144];
#pragma unroll
            for (int r = 0; r < 9; ++r) acc[r] += cond[r][k] * wv; }
#pragma unroll
        for (int r = 0; r < 9; ++r) red[ks][r][jj] = acc[r];
        __syncthreads();
        for (int t = tid; t < 9 * 64; t += 512) { const int r = t >> 6, q = t & 63; float s = 0.f; for (int z = 0; z < 8; ++z) s += red[z][r][q];
            p.MOD[((size_t)layer * 9 + r) * 6144 + cg * 64 + q] = s + p.ada_b[layer * 6144 + cg * 64 + q]; }
        __syncthreads();
    }
    if (blockIdx.x == 0) {
        for (int t = tid; t < 1024; t += 512) { const int layer = t >> 9, dir = (t >> 8) & 1, w = t & 255;
            const float t0 = p.hlb[(dir * 2 + 0) * 256 + w], t1 = p.hlb[(dir * 2 + 1) * 256 + w];
            const float mx = fmaxf(t0, t1), e0 = expf(t0 - mx), e1 = expf(t1 - mx);
            float lb = layer == 0 ? 0.f : e1 / (e0 + e1); lb = fminf(fmaxf(lb, 0.f), 1.f);
            p.LB[(layer * 2 + dir) * 256 + w] = lb; }
        if (tid < 128) { const int layer = tid >> 6, lane = tid & 63; const float* L = p.dlam + layer * 256;
            const float s1 = wsum(L[lane] * L[64 + lane]), s2 = wsum(L[128 + lane] * L[192 + lane]);
            if (lane == 0) p.LAM[layer] = expf(s1) - expf(s2) + lam_init_of(layer); }
    }
}

__global__ __launch_bounds__(512) void k_init(Params p) {
    const int wid = threadIdx.x >> 6, lane = threadIdx.x & 63;
    for (int r = blockIdx.x * 8 + wid; r < NT; r += gridDim.x * 8) {
        const int b = r / SL, s = r % SL;
        const float* src = s < CTX ? p.ctx + ((size_t)b * CTX + s) * D : p.x + ((size_t)b * SEQ + (s - CTX)) * D;
        float4 v[4], o[4]; row_load(src, v, lane); row_store(p.X + (size_t)r * D, v, lane);
        const float* m = modrow(p, 0, b, s);
        row_modnorm(v, p.norms + 0, m + 0, m + 1024, o, lane);
        row_store(p.XN + (size_t)r * D, o, lane);
    }
}

__global__ __launch_bounds__(512) void k_inproj(Params p, int layer) {
    const float* W = p.w_in + (size_t)layer * D * DP;
    constexpr int ntn = (DP + 127) / 128, ntm = NT / 128;
    for (int u = blockIdx.x; u < ntm * ntn; u += gridDim.x) {
        const int tm = u / ntn, tn = u % ntn;
        gemm128(D,
            [&](int m) { return p.XN + (size_t)(tm * 128 + m) * D; },
            [&](int k, int n) { const int col = tn * 128 + n; return col < DP ? *(const float4*)(W + (size_t)k * DP + col) : make_float4(0.f, 0.f, 0.f, 0.f); },
            [&](int m, int n, float4 a) { const int col = tn * 128 + n; if (col < DP) *(float4*)(p.P + (size_t)(tm * 128 + m) * DP + col) = a; });
    }
}

__global__ __launch_bounds__(512) void k_scans(Params p, int layer) {
    const int gw = blockIdx.x * 8 + (threadIdx.x >> 6), lane = threadIdx.x & 63;
    if (gw >= 128) return;
    const int ch = gw & 63, b = ch >> 3, h = (ch >> 1) & 3, dir = ch & 1;
    if (gw < 64) {
        float S[64];
#pragma unroll
        for (int k = 0; k < 64; ++k) S[k] = 0.f;
        const float lbv = p.LB[(layer * 2 + dir) * 256 + h * 64 + lane];
        float* out = p.OA + (size_t)dir * NT * 256;
        for (int step = 0; step < SL; ++step) {
            const int s = dir == 0 ? step : (step < CTX ? CTX - 1 - step : SL + CTX - 1 - step);
            const float* row = p.P + (size_t)(b * SL + s) * DP;
            float q = row[O_AQ + h * 64 + lane]; q = q * sigm(q);
            const float fp = row[(dir ? O_AFB : O_AFF) + h * 64 + lane];
            const float f = fmaxf(lbv + (1.f - lbv) * sigm(fp), 1e-12f), kk = (1.f - lbv) * sigm(-fp);
            const float vv = row[O_AI + h * 64 + lane];
            float o = 0.f;
#pragma unroll
            for (int k = 0; k < 64; ++k) { S[k] = rdlane(f, k) * S[k] + rdlane(kk, k) * vv; o += S[k] * rdlane(q, k); }
            out[(size_t)(b * SL + s) * 256 + h * 64 + lane] = o;
        }
    } else {
        float C[32], n[32];
#pragma unroll
        for (int k = 0; k < 32; ++k) { C[k] = 0.f; n[k] = 0.f; }
        float m = 0.f;
        const float bi = p.mgb[layer * 16 + (dir * 2 + 0) * 4 + h], bf = p.mgb[layer * 16 + (dir * 2 + 1) * 4 + h];
        float* out = p.HB + (size_t)dir * NT * 256;
        for (int step = 0; step < SL; ++step) {
            const int s = dir == 0 ? step : (step < CTX ? CTX - 1 - step : SL + CTX - 1 - step);
            const float* row = p.P + (size_t)(b * SL + s) * DP;
            const float q = row[O_BQ + h * 32 + (lane & 31)] * 0.17677669529663687f;
            const float kx = row[O_BK + h * 32 + (lane & 31)];
            const float vv = row[O_BV + h * 64 + lane];
            const float li = row[O_BG + (dir * 2 + 0) * 4 + h] + bi;
            const float gf = row[O_BG + (dir * 2 + 1) * 4 + h] + bf;
            const float lf = fminf(gf, 0.f) - log1pf(expf(-fabsf(gf)));
            const float mn = fmaxf(lf + m, li);
            const float a = expf(lf + m - mn), bc = expf(li - mn);
            m = mn;
            float num = 0.f, den = 0.f;
#pragma unroll
            for (int k = 0; k < 32; ++k) { const float kk = rdlane(kx, k), qq = rdlane(q, k);
                C[k] = a * C[k] + bc * kk * vv; n[k] = a * n[k] + bc * kk; num += C[k] * qq; den += n[k] * qq; }
            out[(size_t)(b * SL + s) * 256 + h * 64 + lane] = num / fmaxf(fabsf(den), expf(-mn));
        }
    }
}

__global__ __launch_bounds__(512) void k_attn_prep(Params p) {
    const int t = threadIdx.x, rr = t >> 8, hj = (t >> 5) & 7, half = (t >> 4) & 1, i = t & 15;
    const float invf = expf(-(float)i * (1.f / 16.f) * 9.210340371976184f);
    for (int r = blockIdx.x * 2 + rr; r < NT; r += gridDim.x * 2) {
        const int b = r / SL, s = r % SL, g = b * 8 + hj;
        float cs = 1.f, sn = 0.f;
        if (s >= CTX) { const int tl = s - CTX; const float pos = half == 0 ? (float)(tl / 64) : (float)(tl % 64); sincosf(pos * invf, &sn, &cs); }
        const float* row = p.P + (size_t)r * DP;
        const int d1 = half * 32 + i, d2 = d1 + 16;
        const float q1 = row[O_CQ + hj * 64 + d1], q2 = row[O_CQ + hj * 64 + d2], k1 = row[O_CK + hj * 64 + d1], k2 = row[O_CK + hj * 64 + d2];
        float* qr = p.QR + ((size_t)g * SL + s) * 64;
        qr[d1] = q1 * cs - q2 * sn; qr[d2] = q1 * sn + q2 * cs;
        p.KT[((size_t)g * 64 + d1) * SL + s] = k1 * cs - k2 * sn;
        p.KT[((size_t)g * 64 + d2) * SL + s] = k1 * sn + k2 * cs;
    }
}
__global__ __launch_bounds__(512) void k_scores(Params p, int mode) {
    const int ntm = mode == 0 ? 16 : 18, ntn = mode == 0 ? 16 : 2, per = ntm * ntn;
    for (int u = blockIdx.x; u < 64 * per; u += gridDim.x) {
        const int g = u / per, tm = (u % per) / ntn, tn = u % ntn, b = g >> 3, hj = g & 7;
        const int r0 = mode == 0 ? CTX + tm * 128 : tm * 128, c0 = mode == 0 ? CTX + tn * 128 : tn * 128;
        gemm128(64,
            [&](int m) { return mode == 0 ? p.QR + ((size_t)g * SL + r0 + m) * 64 : p.P + (size_t)(b * SL + r0 + m) * DP + O_CQ + hj * 64; },
            [&](int k, int n) { return *(const float4*)(p.KT + ((size_t)g * 64 + k) * SL + c0 + n); },
            [&](int m, int n, float4 a) { *(float4*)(p.S + ((size_t)g * SL + r0 + m) * SL + c0 + n) = a; });
    }
}
__global__ __launch_bounds__(512) void k_softmax(Params p, int layer) {
    const int wid = threadIdx.x >> 6, lane = threadIdx.x & 63;
    const float lam = p.LAM[layer];
    for (int u = blockIdx.x * 8 + wid; u < 32 * SL; u += gridDim.x * 8) {
        const int bh = u / SL, s = u % SL;
        if (layer != 0 && s < CTX) continue;
        const int cnt = s < CTX ? 4 : 36;
        float* r1 = p.S + ((size_t)(bh * 2) * SL + s) * SL; const float* r2 = p.S + ((size_t)(bh * 2 + 1) * SL + s) * SL;
        float a[36], c[36]; float m1 = -3.0e38f, m2 = -3.0e38f;
#pragma unroll
        for (int i = 0; i < 36; ++i) if (i < cnt) { a[i] = r1[lane + 64 * i] * 0.125f; c[i] = r2[lane + 64 * i] * 0.125f; m1 = fmaxf(m1, a[i]); m2 = fmaxf(m2, c[i]); }
        m1 = wmaxf(m1); m2 = wmaxf(m2);
        float s1 = 0.f, s2 = 0.f;
#pragma unroll
        for (int i = 0; i < 36; ++i) if (i < cnt) { a[i] = expf(a[i] - m1); c[i] = expf(c[i] - m2); s1 += a[i]; s2 += c[i]; }
        s1 = wsum(s1); s2 = wsum(s2);
        const float i1 = 1.f / s1, i2 = lam / s2;
#pragma unroll
        for (int i = 0; i < 36; ++i) if (i < cnt) r1[lane + 64 * i] = a[i] * i1 - c[i] * i2;
    }
}
__global__ __launch_bounds__(512) void k_wv(Params p, int mode) {
    const int ntm = mode == 0 ? 16 : 2, K = mode == 0 ? SL : CTX;
    for (int u = blockIdx.x; u < 32 * ntm; u += gridDim.x) {
        const int bh = u / ntm, tm = u % ntm, b = bh >> 2, h = bh & 3, r0 = mode == 0 ? CTX + tm * 128 : tm * 128;
        gemm128(K,
            [&](int m) { return p.S + ((size_t)(bh * 2) * SL + r0 + m) * SL; },
            [&](int k, int n) { return *(const float4*)(p.P + (size_t)(b * SL + k) * DP + O_CV + h * 128 + n); },
            [&](int m, int n, float4 a) { *(float4*)(p.OC + ((size_t)bh * SL + r0 + m) * 128 + n) = a; });
    }
}
__global__ __launch_bounds__(512) void k_readout(Params p, int layer) {
    const int wid = threadIdx.x >> 6, lane = threadIdx.x & 63;
    const float omli = 1.f - lam_init_of(layer);
    for (int r = blockIdx.x * 8 + wid; r < NT; r += gridDim.x * 8) {
        const int b = r / SL, s = r % SL;
        if (layer != 0 && s < CTX) continue;
        const float* row = p.P + (size_t)r * DP; float* mix = p.MIX + (size_t)r * D;
#pragma unroll
        for (int h = 0; h < 4; ++h) {
            const int e = h * 64 + lane;
            const float oa = p.OA[(size_t)r * 256 + e] + p.OA[(size_t)NT * 256 + (size_t)r * 256 + e];
            const float ra = rsqrtf(wsum(oa * oa) * (1.f / 64.f) + 1e-6f);
            const float ga = row[O_AG + e];
            mix[e] = oa * ra * p.hnorm[layer * 64 + lane] * (ga * sigm(ga));
            const float ob = p.HB[(size_t)r * 256 + e] + p.HB[(size_t)NT * 256 + (size_t)r * 256 + e];
            const float rb = rsqrtf(wsum(ob * ob) * (1.f / 64.f) + 1e-6f);
            mix[256 + e] = ob * rb * p.mnorm[layer * 256 + e] * sigm(row[O_BO + e]);
            const float* oc = p.OC + ((size_t)(b * 4 + h) * SL + s) * 128;
            const float c0 = oc[lane], c1 = oc[64 + lane];
            const float rc = rsqrtf(wsum(c0 * c0 + c1 * c1) * (1.f / 128.f) + 1e-6f);
            mix[512 + h * 128 + lane] = c0 * rc * p.dnorm[layer * 128 + lane] * omli;
            mix[512 + h * 128 + 64 + lane] = c1 * rc * p.dnorm[layer * 128 + 64 + lane] * omli;
        }
    }
}
__global__ __launch_bounds__(512) void k_outproj(Params p, int layer) {
    const float* W = p.w_out + (size_t)layer * D * D;
    for (int u = blockIdx.x; u < (NT / 128) * 8; u += gridDim.x) {
        const int tm = u / 8, tn = u % 8;
        if (layer != 0 && (tm % 18) < 2) continue;
        gemm128(D,
            [&](int m) { return p.MIX + (size_t)(tm * 128 + m) * D; },
            [&](int k, int n) { return *(const float4*)(W + (size_t)k * D + tn * 128 + n); },
            [&](int m, int n, float4 a) { *(float4*)(p.MIXO + (size_t)(tm * 128 + m) * D + tn * 128 + n) = a; });
    }
}
__global__ __launch_bounds__(512) void k_norm2(Params p, int layer) {
    __shared__ float xs[8][1024];
    const int wid = threadIdx.x >> 6, lane = threadIdx.x & 63;
    const float* nr = p.norms + (size_t)layer * 4 * D;
    for (int r = blockIdx.x * 8 + wid; r < NT; r += gridDim.x * 8) {
        const int b = r / SL, s = r % SL;
        if (layer != 0 && s < CTX) continue;
        const float* m = modrow(p, layer, b, s);
        float4 mo[4], xv[4], o[4]; row_load(p.MIXO + (size_t)r * D, mo, lane); row_load(p.X + (size_t)r * D, xv, lane);
        const float ri = row_rinv(mo);
#pragma unroll
        for (int i = 0; i < 4; ++i) { const int idx = i * 256 + lane * 4; const float4 g = *(const float4*)(nr + D + idx), gt = *(const float4*)(m + 2048 + idx);
            xv[i].x += gt.x * (mo[i].x * ri * g.x); xv[i].y += gt.y * (mo[i].y * ri * g.y); xv[i].z += gt.z * (mo[i].z * ri * g.z); xv[i].w += gt.w * (mo[i].w * ri * g.w); }
        row_store(p.X + (size_t)r * D, xv, lane);
        row_modnorm(xv, nr + 2 * D, m + 3072, m + 4096, o, lane);
        row_store(p.XN + (size_t)r * D, o, lane);
        row_store(&xs[wid][0], o, lane);
        __builtin_amdgcn_wave_barrier();
        asm volatile("s_waitcnt lgkmcnt(0)" ::: "memory");
        const int e = lane & 31, part = lane >> 5;
        const float* rw = p.rw + (size_t)layer * D * NE + e;
        float acc = 0.f;
        for (int i = part * 512; i < part * 512 + 512; ++i) acc += xs[wid][i] * rw[(size_t)i * NE];
        acc += __shfl_xor(acc, 32);
        float logit = acc + p.rb[layer * NE + e];
        float tv[4]; int ti[4];
#pragma unroll
        for (int k = 0; k < 4; ++k) {
            float bv = logit; int bi = e;
            for (int o2 = 16; o2 >= 1; o2 >>= 1) { const float ov = __shfl_xor(bv, o2); const int oi = __shfl_xor(bi, o2); if (ov > bv || (ov == bv && oi < bi)) { bv = ov; bi = oi; } }
            tv[k] = bv; ti[k] = bi; if (e == bi) logit = -3.0e38f;
        }
        const float e0 = 1.f, e1 = expf(tv[1] - tv[0]), e2 = expf(tv[2] - tv[0]), e3 = expf(tv[3] - tv[0]), inv = 1.f / (e0 + e1 + e2 + e3);
        if (lane == 0) { *(float4*)(p.TOPW + (size_t)r * 4) = make_float4(e0 * inv, e1 * inv, e2 * inv, e3 * inv); *(int4*)(p.TOPI + (size_t)r * 4) = make_int4(ti[0], ti[1], ti[2], ti[3]); }
        __builtin_amdgcn_wave_barrier();
    }
}
__global__ __launch_bounds__(512) void k_route(Params p, int layer) {
    __shared__ int wc[8];
    const int tid = threadIdx.x, wid = tid >> 6, lane = tid & 63;
    for (int e = blockIdx.x; e < NE; e += gridDim.x) {
        int base = 0;
        for (int c0 = 0; c0 < NPAIR; c0 += 512) {
            const int pair = c0 + tid, r = pair >> 2, s = r % SL;
            const bool hit = (layer == 0 || s >= CTX) && p.TOPI[pair] == e;
            const unsigned long long bal = __ballot(hit);
            if (lane == 0) wc[wid] = __popcll(bal);
            __syncthreads();
            int off = base, tot = 0;
            for (int w = 0; w < 8; ++w) { const int c = wc[w]; if (w < wid) off += c; tot += c; }
            if (hit) p.LIST[(size_t)e * LISTCAP + off + __popcll(bal & ((1ull << lane) - 1ull))] = pair;
            base += tot;
            __syncthreads();
        }
        if (tid == 0) p.CNT[e] = base;
    }
}
DEV bool moe_unit(const int* cnt, int rt, int& e, int& t) {
    for (int i = 0; i < NE; ++i) { const int n = (cnt[i] + 127) >> 7; if (rt < n) { e = i; t = rt; return true; } rt -= n; }
    return false;
}
__global__ __launch_bounds__(512) void k_moe1(Params p, int layer) {
    for (int u = blockIdx.x;; u += gridDim.x) {
        int e, t; if (!moe_unit(p.CNT, u >> 4, e, t)) break;
        const int tn = u & 15, cnt = p.CNT[e];
        const float* W = p.w1 + ((size_t)layer * NE + e) * D * 2048; const float* B1 = p.b1 + ((size_t)layer * NE + e) * 2048;
        const int* list = p.LIST + (size_t)e * LISTCAP + t * 128;
        gemm128(D,
            [&](int m) -> const float* { return t * 128 + m < cnt ? p.XN + (size_t)(list[m] >> 2) * D : nullptr; },
            [&](int k, int n) { return *(const float4*)(W + (size_t)k * 2048 + tn * 128 + n); },
            [&](int m, int n, float4 a) { if (t * 128 + m >= cnt) return; const int pair = list[m], col = tn * 128 + n; const float4 bb = *(const float4*)(B1 + col);
                const float gate = p.TOPW[pair];
                const float g0 = fminf(a.x + bb.x, 7.f), l0 = fminf(fmaxf(a.y + bb.y, -7.f), 7.f), g1 = fminf(a.z + bb.z, 7.f), l1 = fminf(fmaxf(a.w + bb.w, -7.f), 7.f);
                float2 o; o.x = g0 * sigm(1.702f * g0) * (l0 + 1.f) * gate; o.y = g1 * sigm(1.702f * g1) * (l1 + 1.f) * gate;
                *(float2*)(p.H + (size_t)pair * DFF + (col >> 1)) = o; });
    }
}
__global__ __launch_bounds__(512) void k_moe2(Params p, int layer) {
    for (int u = blockIdx.x;; u += gridDim.x) {
        int e, t; if (!moe_unit(p.CNT, u >> 3, e, t)) break;
        const int tn = u & 7, cnt = p.CNT[e];
        const float* W = p.w2 + ((size_t)layer * NE + e) * DFF * D;
        const int* list = p.LIST + (size_t)e * LISTCAP + t * 128;
        gemm128(DFF,
            [&](int m) -> const float* { return t * 128 + m < cnt ? p.H + (size_t)list[m] * DFF : nullptr; },
            [&](int k, int n) { return *(const float4*)(W + (size_t)k * D + tn * 128 + n); },
            [&](int m, int n, float4 a) { if (t * 128 + m >= cnt) return; *(float4*)(p.Y + (size_t)list[m] * D + tn * 128 + n) = a; });
    }
}
__global__ __launch_bounds__(512) void k_combine(Params p, int layer) {
    const int wid = threadIdx.x >> 6, lane = threadIdx.x & 63;
    const float* nr = p.norms + (size_t)layer * 4 * D;
    for (int r = blockIdx.x * 8 + wid; r < NT; r += gridDim.x * 8) {
        const int b = r / SL, s = r % SL;
        if (layer != 0 && s < CTX) continue;
        const float* m = modrow(p, layer, b, s);
        const float4 tw = *(const float4*)(p.TOPW + (size_t)r * 4); const int4 ti = *(const int4*)(p.TOPI + (size_t)r * 4);
        const float w[4] = {tw.x, tw.y, tw.z, tw.w}; const int ei[4] = {ti.x, ti.y, ti.z, ti.w};
        float4 f[4], xv[4];
#pragma unroll
        for (int i = 0; i < 4; ++i) f[i] = make_float4(0.f, 0.f, 0.f, 0.f);
#pragma unroll
        for (int k = 0; k < 4; ++k) {
            const float* y = p.Y + ((size_t)r * 4 + k) * D; const float* bb = p.b2 + ((size_t)layer * NE + ei[k]) * D;
#pragma unroll
            for (int i = 0; i < 4; ++i) { const int idx = i * 256 + lane * 4; const float4 yv = *(const float4*)(y + idx), bv = *(const float4*)(bb + idx);
                f[i].x += yv.x + w[k] * bv.x; f[i].y += yv.y + w[k] * bv.y; f[i].z += yv.z + w[k] * bv.z; f[i].w += yv.w + w[k] * bv.w; }
        }
        row_load(p.X + (size_t)r * D, xv, lane);
        const float ri = row_rinv(f);
#pragma unroll
        for (int i = 0; i < 4; ++i) { const int idx = i * 256 + lane * 4; const float4 g = *(const float4*)(nr + 3 * D + idx), gt = *(const float4*)(m + 5120 + idx);
            xv[i].x += gt.x * (f[i].x * ri * g.x); xv[i].y += gt.y * (f[i].y * ri * g.y); xv[i].z += gt.z * (f[i].z * ri * g.z); xv[i].w += gt.w * (f[i].w * ri * g.w); }
        if (layer == 0) {
            row_store(p.X + (size_t)r * D, xv, lane);
            const float* m1 = modrow(p, 1, b, s); float4 o[4];
            row_modnorm(xv, p.norms + (size_t)4 * D, m1 + 0, m1 + 1024, o, lane);
            row_store(p.XN + (size_t)r * D, o, lane);
        } else {
            row_store(p.out + ((size_t)b * SEQ + (s - CTX)) * D, xv, lane);
        }
    }
}
}

extern "C" void kernel_launch(void* const* d_in, const int* in_sizes, int n_in, void* d_out, int out_size, void* d_ws, size_t ws_size, hipStream_t stream) {
    Params p{};
    const float** in = (const float**)&p;
    for (int i = 0; i < 21; ++i) in[i] = (const float*)d_in[i];
    p.out = (float*)d_out;
    char* w = (char*)d_ws; size_t off = 0;
    auto carve = [&](size_t bytes) { char* r = w + off; off += (bytes + 255) & ~(size_t)255; return r; };
    p.MOD = (float*)carve((size_t)2 * 9 * 6144 * 4);
    p.LB = (float*)carve(1024 * 4);
    p.LAM = (float*)carve(256);
    p.CNT = (int*)carve(256);
    p.TOPW = (float*)carve((size_t)NPAIR * 4);
    p.TOPI = (int*)carve((size_t)NPAIR * 4);
    p.LIST = (int*)carve((size_t)NE * LISTCAP * 4);
    p.X = (float*)carve((size_t)NT * D * 4);
    p.XN = (float*)carve((size_t)NT * D * 4);
    p.P = (float*)carve((size_t)NT * DP * 4);
    p.QR = (float*)carve((size_t)64 * SL * 64 * 4);
    p.KT = (float*)carve((size_t)64 * SL * 64 * 4);
    p.OC = (float*)carve((size_t)32 * SL * 128 * 4);
    p.MIX = (float*)carve((size_t)NT * D * 4);
    p.MIXO = (float*)carve((size_t)NT * D * 4);
    char* U = carve((size_t)64 * SL * SL * 4);
    p.S = (float*)U;
    p.OA = p.MIXO; p.HB = p.MIXO + (size_t)2 * NT * 256;
    p.H = (float*)U; p.Y = (float*)(U + (size_t)NPAIR * DFF * 4);
    if (off > ws_size) return;
    const dim3 blk(512);
    hipLaunchKernelGGL(k_mods, dim3(192), blk, 0, stream, p);
    hipLaunchKernelGGL(k_init, dim3(1024), blk, 0, stream, p);
    for (int layer = 0; layer < 2; ++layer) {
        hipLaunchKernelGGL(k_inproj, dim3(2048), blk, 0, stream, p, layer);
        hipLaunchKernelGGL(k_scans, dim3(16), blk, 0, stream, p, layer);
        hipLaunchKernelGGL(k_attn_prep, dim3(2048), blk, 0, stream, p);
        hipLaunchKernelGGL(k_scores, dim3(2048), blk, 0, stream, p, 0);
        hipLaunchKernelGGL(k_scores, dim3(2048), blk, 0, stream, p, 1);
        hipLaunchKernelGGL(k_softmax, dim3(2048), blk, 0, stream, p, layer);
        hipLaunchKernelGGL(k_wv, dim3(512), blk, 0, stream, p, 0);
        if (layer == 0) hipLaunchKernelGGL(k_wv, dim3(64), blk, 0, stream, p, 1);
        hipLaunchKernelGGL(k_readout, dim3(1024), blk, 0, stream, p, layer);
        hipLaunchKernelGGL(k_outproj, dim3(2048), blk, 0, stream, p, layer);
        hipLaunchKernelGGL(k_norm2, dim3(1024), blk, 0, stream, p, layer);
        hipLaunchKernelGGL(k_route, dim3(32), blk, 0, stream, p, layer);
        hipLaunchKernelGGL(k_moe1, dim3(2048), blk, 0, stream, p, layer);
        hipLaunchKernelGGL(k_moe2, dim3(2048), blk, 0, stream, p, layer);
        hipLaunchKernelGGL(k_combine, dim3(1024), blk, 0, stream, p, layer);
    }
}
```

```cpp
#include <hip/hip_runtime.h>
#include <stdint.h>

namespace {
constexpr int D = 1024, NB = 8, SEQ = 2048, CTX = 256, SL = 2304, NT = NB * SL;
constexpr int DP = 3600, NE = 32, DFF = 1024, NPAIR = NT * 4;
constexpr int O_AQ = 0, O_AI = 256, O_AFF = 512, O_AFB = 768, O_AG = 1024, O_BQ = 1280, O_BK = 1408, O_BV = 1536, O_BO = 1792, O_BG = 2048, O_CQ = 2064, O_CK = 2576, O_CV = 3088;
constexpr int LISTCAP = NT;

struct Params {
    const float *x, *c, *ctx, *c_ctx, *ada_w, *ada_b, *norms, *w_in, *w_out, *hlb, *hnorm, *mgb, *mnorm, *dlam, *dnorm, *rw, *rb, *w1, *b1, *w2, *b2;
    float* out;
    char* ws;
};
constexpr size_t al256(size_t x) { return (x + 255) & ~(size_t)255; }
constexpr size_t OFF_bar = 0;
constexpr size_t OFF_MOD = OFF_bar + al256(3456 * 4);
constexpr size_t OFF_LB = OFF_MOD + al256((size_t)2 * 9 * 6144 * 4);
constexpr size_t OFF_LAM = OFF_LB + al256(1024 * 4);
constexpr size_t OFF_CNT = OFF_LAM + 256;
constexpr size_t OFF_TOPW = OFF_CNT + 256;
constexpr size_t OFF_TOPI = OFF_TOPW + al256((size_t)NPAIR * 4);
constexpr size_t OFF_LIST = OFF_TOPI + al256((size_t)NPAIR * 4);
constexpr size_t OFF_X = OFF_LIST + al256((size_t)NE * LISTCAP * 4);
constexpr size_t OFF_XN = OFF_X + al256((size_t)NT * D * 4);
constexpr size_t OFF_P = OFF_XN + al256((size_t)NT * D * 4);
constexpr size_t OFF_QR = OFF_P + al256((size_t)NT * DP * 4);
constexpr size_t OFF_KT = OFF_QR + al256((size_t)64 * SL * 64 * 4);
constexpr size_t OFF_OC = OFF_KT + al256((size_t)64 * SL * 64 * 4);
constexpr size_t OFF_MIX = OFF_OC + al256((size_t)32 * SL * 128 * 4);
constexpr size_t OFF_MIXO = OFF_MIX + al256((size_t)NT * D * 4);
constexpr size_t OFF_U = OFF_MIXO + al256((size_t)NT * D * 4);
constexpr size_t WS_END = OFF_U + al256((size_t)64 * SL * SL * 4);
constexpr size_t OFF_S = OFF_U, OFF_H = OFF_U, OFF_Y = OFF_U + (size_t)NPAIR * DFF * 4;
constexpr size_t OFF_OA = OFF_MIXO, OFF_HB = OFF_MIXO + (size_t)2 * NT * 256 * 4;


#define DEV __device__ __forceinline__
DEV float wsum(float v) { for (int o = 32; o >= 1; o >>= 1) v += __shfl_xor(v, o); return v; }
DEV float wmaxf(float v) { for (int o = 32; o >= 1; o >>= 1) v = fmaxf(v, __shfl_xor(v, o)); return v; }
DEV float sigm(float x) { return 1.f / (1.f + expf(-x)); }
DEV float rdlane(float v, int l) { return __int_as_float(__builtin_amdgcn_readlane(__float_as_int(v), l)); }
DEV float lam_init_of(int layer) { return 0.8f - 0.6f * expf(-0.3f * (float)layer); }


#define XB_TMO      128
#define XB_XCNT(j)  (256  + 64 * (j))
#define XB_XSUB(j)  (1280 + 64 * (j))
#define XB_XGEN(j)  (2304 + 64 * (j))
#define XB_TOP      3328
#define XB_TOPGEN   3392
#define XCD_BAR_WORDS 3456
#define XB_SPIN_CAP (1u << 22)
#define LAS __attribute__((address_space(3)))
DEV unsigned xb_ld(unsigned* p)              { return __hip_atomic_load(p, __ATOMIC_RELAXED, __HIP_MEMORY_SCOPE_AGENT); }
DEV unsigned xb_add(unsigned* p, unsigned v) { return __hip_atomic_fetch_add(p, v, __ATOMIC_RELAXED, __HIP_MEMORY_SCOPE_AGENT); }
DEV unsigned xb_xcc_id() { return (unsigned)__builtin_amdgcn_s_getreg((3 << 11) | 20) & 0xFu; }
#define XB_SPIN(cond, bar) do { unsigned _sp = 0; while (cond) { __builtin_amdgcn_s_sleep(1); \
    if ((++_sp & 255u) == 0u) { if (xb_ld(&(bar)[XB_TMO])) break; if (_sp > XB_SPIN_CAP) { atomicAdd(&(bar)[XB_TMO], 1u); break; } } } } while (0)
struct XcdBarrier { unsigned* bar; unsigned x; volatile LAS unsigned* st; };
DEV XcdBarrier xcd_barrier_post(unsigned* bar, volatile LAS unsigned* st) {
    XcdBarrier b; b.bar = bar; b.x = xb_xcc_id(); b.st = st;
    if (threadIdx.x == 0) (void)xb_add(&bar[XB_XCNT(b.x)], 1u);
    return b;
}
DEV void xcd_barrier_complete(unsigned* bar, unsigned x, unsigned& nloc, unsigned& nx) {
    const unsigned G = gridDim.x * gridDim.y * gridDim.z;
    unsigned sum, cnt, mine, sp = 0u;
    for (;;) {
        sum = 0u; cnt = 0u; mine = 0u;
#pragma unroll
        for (unsigned j = 0; j < 16; ++j) { const unsigned c = xb_ld(&bar[XB_XCNT(j)]); sum += c; cnt += (c > 0u) ? 1u : 0u; mine = (j == x) ? c : mine; }
        if (sum == G) break;
        __builtin_amdgcn_s_sleep(1);
        if ((++sp & 255u) == 0u) { if (xb_ld(&bar[XB_TMO])) break; if (sp > XB_SPIN_CAP) { atomicAdd(&bar[XB_TMO], 1u); break; } }
    }
    nloc = mine > 0u ? mine : 1u; nx = cnt > 0u ? cnt : 1u;
}
DEV void xcd_barrier(const XcdBarrier& b) {
    asm volatile("s_waitcnt vmcnt(0)" ::: "memory");
    __syncthreads();
    if (threadIdx.x == 0) {
        unsigned* bar = b.bar;
        __builtin_amdgcn_s_waitcnt(0);
        unsigned nloc = b.st[0], nx = b.st[1];
        if (nloc == 0u) { xcd_barrier_complete(bar, b.x, nloc, nx); b.st[0] = nloc; b.st[1] = nx; }
        const unsigned old = xb_add(&bar[XB_XSUB(b.x)], 1u);
        const unsigned gen = old / nloc;
        if (old + 1u == (gen + 1u) * nloc) {
            __builtin_amdgcn_fence(__ATOMIC_RELEASE, "agent");
            asm volatile("s_waitcnt vmcnt(0)" ::: "memory");
            const unsigned og = xb_add(&bar[XB_TOP], 1u);
            const unsigned tg = og / nx;
            if (og + 1u == (tg + 1u) * nx) xb_add(&bar[XB_TOPGEN], 1u);
            else XB_SPIN(xb_ld(&bar[XB_TOPGEN]) == tg, bar);
            __builtin_amdgcn_fence(__ATOMIC_ACQUIRE, "agent");
            xb_add(&bar[XB_XGEN(b.x)], 1u);
            asm volatile("s_waitcnt vmcnt(0)" ::: "memory");
        } else {
            XB_SPIN(xb_ld(&bar[XB_XGEN(b.x)]) == gen, bar);
            __builtin_amdgcn_fence(__ATOMIC_ACQUIRE, "agent");
            asm volatile("s_waitcnt vmcnt(0)" ::: "memory");
        }
    }
    __syncthreads();
}

template <class RowA, class LoadB, class Epi>
DEV void gemm128(char* smem, int K, RowA rowA, LoadB loadB, Epi epi) {
    float (*As)[132] = (float (*)[132])smem;
    float (*Bs)[128] = (float (*)[128])(smem + 16 * 132 * 4);
    const int tid = threadIdx.x, ty = tid >> 5, tx = tid & 31;
    const int am = tid >> 2, akq = (tid & 3) * 4, bk = tid >> 5, bn = (tid & 31) * 4;
    const float* arow = rowA(am);
    float acc[8][4];
#pragma unroll
    for (int i = 0; i < 8; ++i)
#pragma unroll
        for (int j = 0; j < 4; ++j) acc[i][j] = 0.f;
#pragma unroll 1
    for (int k0 = 0; k0 < K; k0 += 16) {
        float4 a = arow ? *(const float4*)(arow + k0 + akq) : make_float4(0.f, 0.f, 0.f, 0.f);
        float4 b = loadB(k0 + bk, bn);
        __syncthreads();
        As[akq + 0][am] = a.x; As[akq + 1][am] = a.y; As[akq + 2][am] = a.z; As[akq + 3][am] = a.w;
        *(float4*)&Bs[bk][bn] = b;
        __syncthreads();
#pragma unroll 4
        for (int kk = 0; kk < 16; ++kk) {
            const float4 a0 = *(const float4*)&As[kk][ty * 8], a1 = *(const float4*)&As[kk][ty * 8 + 4], bb = *(const float4*)&Bs[kk][tx * 4];
            const float av[8] = {a0.x, a0.y, a0.z, a0.w, a1.x, a1.y, a1.z, a1.w};
#pragma unroll
            for (int i = 0; i < 8; ++i) { acc[i][0] += av[i] * bb.x; acc[i][1] += av[i] * bb.y; acc[i][2] += av[i] * bb.z; acc[i][3] += av[i] * bb.w; }
        }
    }
#pragma unroll
    for (int i = 0; i < 8; ++i) epi(ty * 8 + i, tx * 4, make_float4(acc[i][0], acc[i][1], acc[i][2], acc[i][3]));
}

DEV void row_load(const float* src, float4 (&v)[4], int lane) {
#pragma unroll
    for (int i = 0; i < 4; ++i) v[i] = *(const float4*)(src + i * 256 + lane * 4);
}
DEV void row_store(float* dst, const float4 (&v)[4], int lane) {
#pragma unroll
    for (int i = 0; i < 4; ++i) *(float4*)(dst + i * 256 + lane * 4) = v[i];
}
DEV float row_rinv(const float4 (&v)[4]) {
    float ss = 0.f;
#pragma unroll
    for (int i = 0; i < 4; ++i) ss += v[i].x * v[i].x + v[i].y * v[i].y + v[i].z * v[i].z + v[i].w * v[i].w;
    ss = wsum(ss);
    return rsqrtf(ss * (1.f / 1024.f) + 1e-6f);
}
DEV void row_modnorm(const float4 (&v)[4], const float* gain, const float* shift, const float* scale, float4 (&o)[4], int lane) {
    const float r = row_rinv(v);
#pragma unroll
    for (int i = 0; i < 4; ++i) {
        const int idx = i * 256 + lane * 4;
        const float4 g = *(const float4*)(gain + idx), sh = *(const float4*)(shift + idx), sc = *(const float4*)(scale + idx);
        o[i].x = v[i].x * r * g.x * (1.f + sc.x) + sh.x; o[i].y = v[i].y * r * g.y * (1.f + sc.y) + sh.y;
        o[i].z = v[i].z * r * g.z * (1.f + sc.z) + sh.z; o[i].w = v[i].w * r * g.w * (1.f + sc.w) + sh.w;
    }
}
DEV const float* modrow(const Params& p, int layer, int b, int s) { return ((float*)(p.ws + OFF_MOD)) + ((size_t)layer * 9 + (s < CTX ? 8 : b)) * 6144; }

DEV void ph_mods(const Params& p, char* smem) {
    float (*cond)[1024] = (float (*)[1024])smem;
    float (*red)[9][64] = (float (*)[9][64])(smem + 9 * 1024 * 4);
    const int tid = threadIdx.x;
    for (int i = tid; i < 9 * 1024; i += 512) { const int r = i >> 10, k = i & 1023; const float c = r < 8 ? p.c[r * 1024 + k] : p.c_ctx[k]; cond[r][k] = c * sigm(c); }
    __syncthreads();
    for (int u = blockIdx.x; u < 192; u += gridDim.x) {
        const int layer = u / 96, cg = u % 96, jj = tid & 63, ks = tid >> 6, j = cg * 64 + jj;
        float acc[9];
#pragma unroll
        for (int r = 0; r < 9; ++r) acc[r] = 0.f;
        const float* w = p.ada_w + (size_t)layer * 1024 * 6144 + j;
        for (int k = ks * 128; k < ks * 128 + 128; ++k) { const float wv = w[(size_t)k * 6144];
#pragma unroll
            for (int r = 0; r < 9; ++r) acc[r] += cond[r][k] * wv; }
#pragma unroll
        for (int r = 0; r < 9; ++r) red[ks][r][jj] = acc[r];
        __syncthreads();
        for (int t = tid; t < 9 * 64; t += 512) { const int r = t >> 6, q = t & 63; float s = 0.f; for (int z = 0; z < 8; ++z) s += red[z][r][q];
            ((float*)(p.ws + OFF_MOD))[((size_t)layer * 9 + r) * 6144 + cg * 64 + q] = s + p.ada_b[layer * 6144 + cg * 64 + q]; }
        __syncthreads();
    }
    if (blockIdx.x == 0) {
        for (int t = tid; t < 1024; t += 512) { const int layer = t >> 9, dir = (t >> 8) & 1, w = t & 255;
            const float t0 = p.hlb[(dir * 2 + 0) * 256 + w], t1 = p.hlb[(dir * 2 + 1) * 256 + w];
            const float mx = fmaxf(t0, t1), e0 = expf(t0 - mx), e1 = expf(t1 - mx);
            float lb = layer == 0 ? 0.f : e1 / (e0 + e1); lb = fminf(fmaxf(lb, 0.f), 1.f);
            ((float*)(p.ws + OFF_LB))[(layer * 2 + dir) * 256 + w] = lb; }
        if (tid < 128) { const int layer = tid >> 6, lane = tid & 63; const float* L = p.dlam + layer * 256;
            const float s1 = wsum(L[lane] * L[64 + lane]), s2 = wsum(L[128 + lane] * L[192 + lane]);
            if (lane == 0) ((float*)(p.ws + OFF_LAM))[layer] = expf(s1) - expf(s2) + lam_init_of(layer); }
    }
}

DEV void ph_init(const Params& p, char* smem) {
    const int wid = threadIdx.x >> 6, lane = threadIdx.x & 63;
    for (int r = blockIdx.x * 8 + wid; r < NT; r += gridDim.x * 8) {
        const int b = r / SL, s = r % SL;
        const float* src = s < CTX ? p.ctx + ((size_t)b * CTX + s) * D : p.x + ((size_t)b * SEQ + (s - CTX)) * D;
        float4 v[4], o[4]; row_load(src, v, lane); row_store(((float*)(p.ws + OFF_X)) + (size_t)r * D, v, lane);
        const float* m = modrow(p, 0, b, s);
        row_modnorm(v, p.norms + 0, m + 0, m + 1024, o, lane);
        row_store(((float*)(p.ws + OFF_XN)) + (size_t)r * D, o, lane);
    }
}

DEV void ph_inproj(const Params& p, int layer, char* smem) {
    const float* W = p.w_in + (size_t)layer * D * DP;
    constexpr int ntn = (DP + 127) / 128, ntm = NT / 128;
    for (int u = blockIdx.x; u < ntm * ntn; u += gridDim.x) {
        const int tm = u / ntn, tn = u % ntn;
        gemm128(smem, D,
            [&](int m) { return ((float*)(p.ws + OFF_XN)) + (size_t)(tm * 128 + m) * D; },
            [&](int k, int n) { const int col = tn * 128 + n; return col < DP ? *(const float4*)(W + (size_t)k * DP + col) : make_float4(0.f, 0.f, 0.f, 0.f); },
            [&](int m, int n, float4 a) { const int col = tn * 128 + n; if (col < DP) *(float4*)(((float*)(p.ws + OFF_P)) + (size_t)(tm * 128 + m) * DP + col) = a; });
    }
}

DEV void ph_scans(const Params& p, int layer, char* smem) {
    const int gw = (threadIdx.x < 64 && blockIdx.x < 128) ? (int)blockIdx.x : 128, lane = threadIdx.x & 63;
    const int ch = gw & 63, b = ch >> 3, h = (ch >> 1) & 3, dir = ch & 1;
    if (gw < 64) {
        float S[64];
#pragma unroll
        for (int k = 0; k < 64; ++k) S[k] = 0.f;
        const float lbv = ((float*)(p.ws + OFF_LB))[(layer * 2 + dir) * 256 + h * 64 + lane];
        float* out = ((float*)(p.ws + OFF_OA)) + (size_t)dir * NT * 256;
        for (int step = 0; step < SL; ++step) {
            const int s = dir == 0 ? step : (step < CTX ? CTX - 1 - step : SL + CTX - 1 - step);
            const float* row = ((float*)(p.ws + OFF_P)) + (size_t)(b * SL + s) * DP;
            float q = row[O_AQ + h * 64 + lane]; q = q * sigm(q);
            const float fp = row[(dir ? O_AFB : O_AFF) + h * 64 + lane];
            const float f = fmaxf(lbv + (1.f - lbv) * sigm(fp), 1e-12f), kk = (1.f - lbv) * sigm(-fp);
            const float vv = row[O_AI + h * 64 + lane];
            float o = 0.f;
#pragma unroll
            for (int k = 0; k < 64; ++k) { S[k] = rdlane(f, k) * S[k] + rdlane(kk, k) * vv; o += S[k] * rdlane(q, k); }
            out[(size_t)(b * SL + s) * 256 + h * 64 + lane] = o;
        }
    } else if (gw < 128) {
        float C[32], n[32];
#pragma unroll
        for (int k = 0; k < 32; ++k) { C[k] = 0.f; n[k] = 0.f; }
        float m = 0.f;
        const float bi = p.mgb[layer * 16 + (dir * 2 + 0) * 4 + h], bf = p.mgb[layer * 16 + (dir * 2 + 1) * 4 + h];
        float* out = ((float*)(p.ws + OFF_HB)) + (size_t)dir * NT * 256;
        for (int step = 0; step < SL; ++step) {
            const int s = dir == 0 ? step : (step < CTX ? CTX - 1 - step : SL + CTX - 1 - step);
            const float* row = ((float*)(p.ws + OFF_P)) + (size_t)(b * SL + s) * DP;
            const float q = row[O_BQ + h * 32 + (lane & 31)] * 0.17677669529663687f;
            const float kx = row[O_BK + h * 32 + (lane & 31)];
            const float vv = row[O_BV + h * 64 + lane];
            const float li = row[O_BG + (dir * 2 + 0) * 4 + h] + bi;
            const float gf = row[O_BG + (dir * 2 + 1) * 4 + h] + bf;
            const float lf = fminf(gf, 0.f) - log1pf(expf(-fabsf(gf)));
            const float mn = fmaxf(lf + m, li);
            const float a = expf(lf + m - mn), bc = expf(li - mn);
            m = mn;
            float num = 0.f, den = 0.f;
#pragma unroll
            for (int k = 0; k < 32; ++k) { const float kk = rdlane(kx, k), qq = rdlane(q, k);
                C[k] = a * C[k] + bc * kk * vv; n[k] = a * n[k] + bc * kk; num += C[k] * qq; den += n[k] * qq; }
            out[(size_t)(b * SL + s) * 256 + h * 64 + lane] = num / fmaxf(fabsf(den), expf(-mn));
        }
    }
}

DEV void ph_attn_prep(const Params& p, char* smem) {
    const int t = threadIdx.x, rr = t >> 8, hj = (t >> 5) & 7, half = (t >> 4) & 1, i = t & 15;
    const float invf = expf(-(float)i * (1.f / 16.f) * 9.210340371976184f);
    for (int r = blockIdx.x * 2 + rr; r < NT; r += gridDim.x * 2) {
        const int b = r / SL, s = r % SL, g = b * 8 + hj;
        float cs = 1.f, sn = 0.f;
        if (s >= CTX) { const int tl = s - CTX; const float pos = half == 0 ? (float)(tl / 64) : (float)(tl % 64); sincosf(pos * invf, &sn, &cs); }
        const float* row = ((float*)(p.ws + OFF_P)) + (size_t)r * DP;
        const int d1 = half * 32 + i, d2 = d1 + 16;
        const float q1 = row[O_CQ + hj * 64 + d1], q2 = row[O_CQ + hj * 64 + d2], k1 = row[O_CK + hj * 64 + d1], k2 = row[O_CK + hj * 64 + d2];
        float* qr = ((float*)(p.ws + OFF_QR)) + ((size_t)g * SL + s) * 64;
        qr[d1] = q1 * cs - q2 * sn; qr[d2] = q1 * sn + q2 * cs;
        ((float*)(p.ws + OFF_KT))[((size_t)g * 64 + d1) * SL + s] = k1 * cs - k2 * sn;
        ((float*)(p.ws + OFF_KT))[((size_t)g * 64 + d2) * SL + s] = k1 * sn + k2 * cs;
    }
}
DEV void ph_scores(const Params& p, int mode, char* smem) {
    const int ntm = mode == 0 ? 16 : 18, ntn = mode == 0 ? 16 : 2, per = ntm * ntn;
#pragma unroll 1
    for (int u = blockIdx.x; u < 64 * per; u += gridDim.x) {
        const int g = u / per, tm = (u % per) / ntn, tn = u % ntn, b = g >> 3, hj = g & 7;
        const int r0 = mode == 0 ? CTX + tm * 128 : tm * 128, c0 = mode == 0 ? CTX + tn * 128 : tn * 128;
        gemm128(smem, 64,
            [&](int m) { return mode == 0 ? ((float*)(p.ws + OFF_QR)) + ((size_t)g * SL + r0 + m) * 64 : ((float*)(p.ws + OFF_P)) + (size_t)(b * SL + r0 + m) * DP + O_CQ + hj * 64; },
            [&](int k, int n) { return *(const float4*)(((float*)(p.ws + OFF_KT)) + ((size_t)g * 64 + k) * SL + c0 + n); },
            [&](int m, int n, float4 a) { *(float4*)(((float*)(p.ws + OFF_S)) + ((size_t)g * SL + r0 + m) * SL + c0 + n) = a; });
    }
}
DEV void ph_softmax(const Params& p, int layer, char* smem) {
    const int wid = threadIdx.x >> 6, lane = threadIdx.x & 63;
    const float lam = ((float*)(p.ws + OFF_LAM))[layer];
    for (int u = blockIdx.x * 8 + wid; u < 32 * SL; u += gridDim.x * 8) {
        const int bh = u / SL, s = u % SL;
        if (layer != 0 && s < CTX) continue;
        const int cnt = s < CTX ? 4 : 36;
        float* r1 = ((float*)(p.ws + OFF_S)) + ((size_t)(bh * 2) * SL + s) * SL; const float* r2 = ((float*)(p.ws + OFF_S)) + ((size_t)(bh * 2 + 1) * SL + s) * SL;
        float a[36], c[36]; float m1 = -3.0e38f, m2 = -3.0e38f;
#pragma unroll
        for (int i = 0; i < 36; ++i) if (i < cnt) { a[i] = r1[lane + 64 * i] * 0.125f; c[i] = r2[lane + 64 * i] * 0.125f; m1 = fmaxf(m1, a[i]); m2 = fmaxf(m2, c[i]); }
        m1 = wmaxf(m1); m2 = wmaxf(m2);
        float s1 = 0.f, s2 = 0.f;
#pragma unroll
        for (int i = 0; i < 36; ++i) if (i < cnt) { a[i] = expf(a[i] - m1); c[i] = expf(c[i] - m2); s1 += a[i]; s2 += c[i]; }
        s1 = wsum(s1); s2 = wsum(s2);
        const float i1 = 1.f / s1, i2 = lam / s2;
#pragma unroll
        for (int i = 0; i < 36; ++i) if (i < cnt) r1[lane + 64 * i] = a[i] * i1 - c[i] * i2;
    }
}
DEV void ph_wv(const Params& p, int mode, char* smem) {
    const int ntm = mode == 0 ? 16 : 2, K = mode == 0 ? SL : CTX;
    for (int u = blockIdx.x; u < 32 * ntm; u += gridDim.x) {
        const int bh = u / ntm, tm = u % ntm, b = bh >> 2, h = bh & 3, r0 = mode == 0 ? CTX + tm * 128 : tm * 128;
        gemm128(smem, K,
            [&](int m) { return ((float*)(p.ws + OFF_S)) + ((size_t)(bh * 2) * SL + r0 + m) * SL; },
            [&](int k, int n) { return *(const float4*)(((float*)(p.ws + OFF_P)) + (size_t)(b * SL + k) * DP + O_CV + h * 128 + n); },
            [&](int m, int n, float4 a) { *(float4*)(((float*)(p.ws + OFF_OC)) + ((size_t)bh * SL + r0 + m) * 128 + n) = a; });
    }
}
DEV void ph_readout(const Params& p, int layer, char* smem) {
    const int wid = threadIdx.x >> 6, lane = threadIdx.x & 63;
    const float omli = 1.f - lam_init_of(layer);
    for (int r = blockIdx.x * 8 + wid; r < NT; r += gridDim.x * 8) {
        const int b = r / SL, s = r % SL;
        if (layer != 0 && s < CTX) continue;
        const float* row = ((float*)(p.ws + OFF_P)) + (size_t)r * DP; float* mix = ((float*)(p.ws + OFF_MIX)) + (size_t)r * D;
#pragma unroll
        for (int h = 0; h < 4; ++h) {
            const int e = h * 64 + lane;
            const float oa = ((float*)(p.ws + OFF_OA))[(size_t)r * 256 + e] + ((float*)(p.ws + OFF_OA))[(size_t)NT * 256 + (size_t)r * 256 + e];
            const float ra = rsqrtf(wsum(oa * oa) * (1.f / 64.f) + 1e-6f);
            const float ga = row[O_AG + e];
            mix[e] = oa * ra * p.hnorm[layer * 64 + lane] * (ga * sigm(ga));
            const float ob = ((float*)(p.ws + OFF_HB))[(size_t)r * 256 + e] + ((float*)(p.ws + OFF_HB))[(size_t)NT * 256 + (size_t)r * 256 + e];
            const float rb = rsqrtf(wsum(ob * ob) * (1.f / 64.f) + 1e-6f);
            mix[256 + e] = ob * rb * p.mnorm[layer * 256 + e] * sigm(row[O_BO + e]);
            const float* oc = ((float*)(p.ws + OFF_OC)) + ((size_t)(b * 4 + h) * SL + s) * 128;
            const float c0 = oc[lane], c1 = oc[64 + lane];
            const float rc = rsqrtf(wsum(c0 * c0 + c1 * c1) * (1.f / 128.f) + 1e-6f);
            mix[512 + h * 128 + lane] = c0 * rc * p.dnorm[layer * 128 + lane] * omli;
            mix[512 + h * 128 + 64 + lane] = c1 * rc * p.dnorm[layer * 128 + 64 + lane] * omli;
        }
    }
}
DEV void ph_outproj(const Params& p, int layer, char* smem) {
    const float* W = p.w_out + (size_t)layer * D * D;
    for (int u = blockIdx.x; u < (NT / 128) * 8; u += gridDim.x) {
        const int tm = u / 8, tn = u % 8;
        if (layer != 0 && (tm % 18) < 2) continue;
        gemm128(smem, D,
            [&](int m) { return ((float*)(p.ws + OFF_MIX)) + (size_t)(tm * 128 + m) * D; },
            [&](int k, int n) { return *(const float4*)(W + (size_t)k * D + tn * 128 + n); },
            [&](int m, int n, float4 a) { *(float4*)(((float*)(p.ws + OFF_MIXO)) + (size_t)(tm * 128 + m) * D + tn * 128 + n) = a; });
    }
}
DEV void ph_norm2(const Params& p, int layer, char* smem) {
    float (*xs)[1024] = (float (*)[1024])smem;
    const int wid = threadIdx.x >> 6, lane = threadIdx.x & 63;
    const float* nr = p.norms + (size_t)layer * 4 * D;
    for (int r = blockIdx.x * 8 + wid; r < NT; r += gridDim.x * 8) {
        const int b = r / SL, s = r % SL;
        if (layer != 0 && s < CTX) continue;
        const float* m = modrow(p, layer, b, s);
        float4 mo[4], xv[4], o[4]; row_load(((float*)(p.ws + OFF_MIXO)) + (size_t)r * D, mo, lane); row_load(((float*)(p.ws + OFF_X)) + (size_t)r * D, xv, lane);
        const float ri = row_rinv(mo);
#pragma unroll
        for (int i = 0; i < 4; ++i) { const int idx = i * 256 + lane * 4; const float4 g = *(const float4*)(nr + D + idx), gt = *(const float4*)(m + 2048 + idx);
            xv[i].x += gt.x * (mo[i].x * ri * g.x); xv[i].y += gt.y * (mo[i].y * ri * g.y); xv[i].z += gt.z * (mo[i].z * ri * g.z); xv[i].w += gt.w * (mo[i].w * ri * g.w); }
        row_store(((float*)(p.ws + OFF_X)) + (size_t)r * D, xv, lane);
        row_modnorm(xv, nr + 2 * D, m + 3072, m + 4096, o, lane);
        row_store(((float*)(p.ws + OFF_XN)) + (size_t)r * D, o, lane);
        row_store(&xs[wid][0], o, lane);
        __builtin_amdgcn_wave_barrier();
        asm volatile("s_waitcnt lgkmcnt(0)" ::: "memory");
        const int e = lane & 31, part = lane >> 5;
        const float* rw = p.rw + (size_t)layer * D * NE + e;
        float acc = 0.f;
        for (int i = part * 512; i < part * 512 + 512; ++i) acc += xs[wid][i] * rw[(size_t)i * NE];
        acc += __shfl_xor(acc, 32);
        float logit = acc + p.rb[layer * NE + e];
        float tv[4]; int ti[4];
#pragma unroll
        for (int k = 0; k < 4; ++k) {
            float bv = logit; int bi = e;
            for (int o2 = 16; o2 >= 1; o2 >>= 1) { const float ov = __shfl_xor(bv, o2); const int oi = __shfl_xor(bi, o2); if (ov > bv || (ov == bv && oi < bi)) { bv = ov; bi = oi; } }
            tv[k] = bv; ti[k] = bi; if (e == bi) logit = -3.0e38f;
        }
        const float e0 = 1.f, e1 = expf(tv[1] - tv[0]), e2 = expf(tv[2] - tv[0]), e3 = expf(tv[3] - tv[0]), inv = 1.f / (e0 + e1 + e2 + e3);
        if (lane == 0) { *(float4*)(((float*)(p.ws + OFF_TOPW)) + (size_t)r * 4) = make_float4(e0 * inv, e1 * inv, e2 * inv, e3 * inv); *(int4*)(((int*)(p.ws + OFF_TOPI)) + (size_t)r * 4) = make_int4(ti[0], ti[1], ti[2], ti[3]); }
        __builtin_amdgcn_wave_barrier();
    }
}
DEV void ph_route(const Params& p, int layer, char* smem) {
    int* wc = (int*)smem;
    const int tid = threadIdx.x, wid = tid >> 6, lane = tid & 63;
    for (int e = blockIdx.x; e < NE; e += gridDim.x) {
        int base = 0;
        for (int c0 = 0; c0 < NPAIR; c0 += 512) {
            const int pair = c0 + tid, r = pair >> 2, s = r % SL;
            const bool hit = (layer == 0 || s >= CTX) && ((int*)(p.ws + OFF_TOPI))[pair] == e;
            const unsigned long long bal = __ballot(hit);
            if (lane == 0) wc[wid] = __popcll(bal);
            __syncthreads();
            int off = base, tot = 0;
            for (int w = 0; w < 8; ++w) { const int c = wc[w]; if (w < wid) off += c; tot += c; }
            if (hit) ((int*)(p.ws + OFF_LIST))[(size_t)e * LISTCAP + off + __popcll(bal & ((1ull << lane) - 1ull))] = pair;
            base += tot;
            __syncthreads();
        }
        if (tid == 0) ((int*)(p.ws + OFF_CNT))[e] = base;
    }
}
DEV bool moe_unit(const int* cnt, int rt, int& e, int& t) {
    for (int i = 0; i < NE; ++i) { const int n = (cnt[i] + 127) >> 7; if (rt < n) { e = i; t = rt; return true; } rt -= n; }
    return false;
}
DEV void ph_moe1(const Params& p, int layer, char* smem) {
    for (int u = blockIdx.x;; u += gridDim.x) {
        int e, t; if (!moe_unit(((int*)(p.ws + OFF_CNT)), u >> 4, e, t)) break;
        const int tn = u & 15, cnt = ((int*)(p.ws + OFF_CNT))[e];
        const float* W = p.w1 + ((size_t)layer * NE + e) * D * 2048; const float* B1 = p.b1 + ((size_t)layer * NE + e) * 2048;
        const int* list = ((int*)(p.ws + OFF_LIST)) + (size_t)e * LISTCAP + t * 128;
        gemm128(smem, D,
            [&](int m) -> const float* { return t * 128 + m < cnt ? ((float*)(p.ws + OFF_XN)) + (size_t)(list[m] >> 2) * D : nullptr; },
            [&](int k, int n) { return *(const float4*)(W + (size_t)k * 2048 + tn * 128 + n); },
            [&](int m, int n, float4 a) { if (t * 128 + m >= cnt) return; const int pair = list[m], col = tn * 128 + n; const float4 bb = *(const float4*)(B1 + col);
                const float gate = ((float*)(p.ws + OFF_TOPW))[pair];
                const float g0 = fminf(a.x + bb.x, 7.f), l0 = fminf(fmaxf(a.y + bb.y, -7.f), 7.f), g1 = fminf(a.z + bb.z, 7.f), l1 = fminf(fmaxf(a.w + bb.w, -7.f), 7.f);
                float2 o; o.x = g0 * sigm(1.702f * g0) * (l0 + 1.f) * gate; o.y = g1 * sigm(1.702f * g1) * (l1 + 1.f) * gate;
                *(float2*)(((float*)(p.ws + OFF_H)) + (size_t)pair * DFF + (col >> 1)) = o; });
    }
}
DEV void ph_moe2(const Params& p, int layer, char* smem) {
    for (int u = blockIdx.x;; u += gridDim.x) {
        int e, t; if (!moe_unit(((int*)(p.ws + OFF_CNT)), u >> 3, e, t)) break;
        const int tn = u & 7, cnt = ((int*)(p.ws + OFF_CNT))[e];
        const float* W = p.w2 + ((size_t)layer * NE + e) * DFF * D;
        const int* list = ((int*)(p.ws + OFF_LIST)) + (size_t)e * LISTCAP + t * 128;
        gemm128(smem, DFF,
            [&](int m) -> const float* { return t * 128 + m < cnt ? ((float*)(p.ws + OFF_H)) + (size_t)list[m] * DFF : nullptr; },
            [&](int k, int n) { return *(const float4*)(W + (size_t)k * D + tn * 128 + n); },
            [&](int m, int n, float4 a) { if (t * 128 + m >= cnt) return; *(float4*)(((float*)(p.ws + OFF_Y)) + (size_t)list[m] * D + tn * 128 + n) = a; });
    }
}
DEV void ph_combine(const Params& p, int layer, char* smem) {
    const int wid = threadIdx.x >> 6, lane = threadIdx.x & 63;
    const float* nr = p.norms + (size_t)layer * 4 * D;
    for (int r = blockIdx.x * 8 + wid; r < NT; r += gridDim.x * 8) {
        const int b = r / SL, s = r % SL;
        if (layer != 0 && s < CTX) continue;
        const float* m = modrow(p, layer, b, s);
        const float4 tw = *(const float4*)(((float*)(p.ws + OFF_TOPW)) + (size_t)r * 4); const int4 ti = *(const int4*)(((int*)(p.ws + OFF_TOPI)) + (size_t)r * 4);
        const float w[4] = {tw.x, tw.y, tw.z, tw.w}; const int ei[4] = {ti.x, ti.y, ti.z, ti.w};
        float4 f[4], xv[4];
#pragma unroll
        for (int i = 0; i < 4; ++i) f[i] = make_float4(0.f, 0.f, 0.f, 0.f);
#pragma unroll
        for (int k = 0; k < 4; ++k) {
            const float* y = ((float*)(p.ws + OFF_Y)) + ((size_t)r * 4 + k) * D; const float* bb = p.b2 + ((size_t)layer * NE + ei[k]) * D;
#pragma unroll
            for (int i = 0; i < 4; ++i) { const int idx = i * 256 + lane * 4; const float4 yv = *(const float4*)(y + idx), bv = *(const float4*)(bb + idx);
                f[i].x += yv.x + w[k] * bv.x; f[i].y += yv.y + w[k] * bv.y; f[i].z += yv.z + w[k] * bv.z; f[i].w += yv.w + w[k] * bv.w; }
        }
        row_load(((float*)(p.ws + OFF_X)) + (size_t)r * D, xv, lane);
        const float ri = row_rinv(f);
#pragma unroll
        for (int i = 0; i < 4; ++i) { const int idx = i * 256 + lane * 4; const float4 g = *(const float4*)(nr + 3 * D + idx), gt = *(const float4*)(m + 5120 + idx);
            xv[i].x += gt.x * (f[i].x * ri * g.x); xv[i].y += gt.y * (f[i].y * ri * g.y); xv[i].z += gt.z * (f[i].z * ri * g.z); xv[i].w += gt.w * (f[i].w * ri * g.w); }
        if (layer == 0) {
            row_store(((float*)(p.ws + OFF_X)) + (size_t)r * D, xv, lane);
            const float* m1 = modrow(p, 1, b, s); float4 o[4];
            row_modnorm(xv, p.norms + (size_t)4 * D, m1 + 0, m1 + 1024, o, lane);
            row_store(((float*)(p.ws + OFF_XN)) + (size_t)r * D, o, lane);
        } else {
            row_store(p.out + ((size_t)b * SEQ + (s - CTX)) * D, xv, lane);
        }
    }
}

template <int layer> DEV void run_layer(const Params& p, char* smem, const XcdBarrier& bar) {
#define GB() xcd_barrier(bar)

        ph_inproj(p, layer, smem); GB();
        ph_scans(p, layer, smem); ph_attn_prep(p, smem); GB();
        ph_scores(p, 0, smem); ph_scores(p, 1, smem); GB();
        ph_softmax(p, layer, smem); GB();
        ph_wv(p, 0, smem); if (layer == 0) ph_wv(p, 1, smem); GB();
        ph_readout(p, layer, smem); GB();
        ph_outproj(p, layer, smem); GB();
        ph_norm2(p, layer, smem); GB();
        ph_route(p, layer, smem); GB();
        ph_moe1(p, layer, smem); GB();
        ph_moe2(p, layer, smem); GB();
        ph_combine(p, layer, smem); GB();
    #undef GB
}
constexpr int LDS_BYTES = 147456;
__global__ __launch_bounds__(512, 2) void k_mega(Params p) {
    extern __shared__ __attribute__((aligned(16))) char smem[];
    volatile LAS unsigned* st = (volatile LAS unsigned*)(smem + LDS_BYTES - 16);
    if (threadIdx.x == 0) { st[0] = 0u; st[1] = 0u; st[2] = 0u; st[3] = 0u; }
    __syncthreads();
    const XcdBarrier bar = xcd_barrier_post(((unsigned*)(p.ws + OFF_bar)), st);
#define GB() xcd_barrier(bar)
    ph_mods(p, smem); GB();
    ph_init(p, smem); GB();
    run_layer<0>(p, smem, bar);
    run_layer<1>(p, smem, bar);
#undef GB
}
}

extern "C" void kernel_launch(void* const* d_in, const int* in_sizes, int n_in, void* d_out, int out_size, void* d_ws, size_t ws_size, hipStream_t stream) {
    static int grid = 0;
    if (grid == 0) {
        int dev = 0, cus = 0, per_cu = 0;
        if (hipGetDevice(&dev) != hipSuccess || hipDeviceGetAttribute(&cus, hipDeviceAttributeMultiprocessorCount, dev) != hipSuccess) { grid = -1; return; }
        if (hipFuncSetAttribute((const void*)k_mega, hipFuncAttributeMaxDynamicSharedMemorySize, LDS_BYTES) != hipSuccess) { grid = -1; return; }
        (void)hipOccupancyMaxActiveBlocksPerMultiprocessor(&per_cu, (const void*)k_mega, 512, LDS_BYTES);
        (void)hipGetLastError();
        grid = cus;
    }
    if (grid < 0) return;
    Params p{};
    const float** in = (const float**)&p;
    for (int i = 0; i < 21; ++i) in[i] = (const float*)d_in[i];
    p.out = (float*)d_out;
    p.ws = (char*)d_ws;
    if (WS_END > ws_size) return;
    if (hipMemsetAsync(p.ws + OFF_bar, 0, (size_t)XCD_BAR_WORDS * 4, stream) != hipSuccess) return;
    hipLaunchKernelGGL(k_mega, dim3(grid), dim3(512), LDS_BYTES, stream, p);
}
```

```cpp
#include <hip/hip_runtime.h>
#include <stdint.h>

namespace {
constexpr int D = 1024, NB = 8, SEQ = 2048, CTX = 256, SL = 2304, NT = NB * SL;
constexpr int DP = 3840, DPW = 3600, NE = 32, DFF = 1024, NPAIR = NT * 4;
constexpr int O_AQ = 0, O_AI = 256, O_AFF = 512, O_AFB = 768, O_AG = 1024, O_BQ = 1280, O_BK = 1408, O_BV = 1536, O_BO = 1792, O_BG = 2048, O_CQ = 2064, O_CK = 2576, O_CV = 3088;
constexpr int LISTCAP = NT;

struct Params {
    const float *x, *c, *ctx, *c_ctx, *ada_w, *ada_b, *norms, *w_in, *w_out, *hlb, *hnorm, *mgb, *mnorm, *dlam, *dnorm, *rw, *rb, *w1, *b1, *w2, *b2;
    float* out;
    char* ws;
};
constexpr size_t al256(size_t x) { return (x + 255) & ~(size_t)255; }
constexpr size_t OFF_bar = 0;
constexpr size_t OFF_MOD = OFF_bar + al256(3456 * 4);
constexpr size_t OFF_LB = OFF_MOD + al256((size_t)2 * 9 * 6144 * 4);
constexpr size_t OFF_LAM = OFF_LB + al256(1024 * 4);
constexpr size_t OFF_CNT = OFF_LAM + 256;
constexpr size_t OFF_BC = OFF_CNT + 256;
constexpr size_t OFF_TOPW = OFF_BC + al256((size_t)1024 * NE * 4);
constexpr size_t OFF_TOPI = OFF_TOPW + al256((size_t)NPAIR * 4);
constexpr size_t OFF_LIST = OFF_TOPI + al256((size_t)NPAIR * 4);
constexpr size_t OFF_X = OFF_LIST + al256((size_t)NE * LISTCAP * 4);
constexpr size_t OFF_XN = OFF_X + al256((size_t)NT * D * 4);
constexpr size_t OFF_P = OFF_XN + al256((size_t)NT * D * 4);
constexpr size_t OFF_QR = OFF_P + al256((size_t)NT * DP * 4);
constexpr size_t OFF_KT = OFF_QR + al256((size_t)64 * SL * 64 * 4);
constexpr size_t OFF_OC = OFF_KT + al256((size_t)64 * SL * 64 * 4);
constexpr size_t OFF_MIX = OFF_OC + al256((size_t)32 * SL * 128 * 4);
constexpr size_t OFF_MIXO = OFF_MIX + al256((size_t)NT * D * 4);
constexpr size_t OFF_XNB = OFF_MIXO + al256((size_t)NT * D * 4);
constexpr size_t OFF_MIXB = OFF_XNB + al256((size_t)NT * D * 2);
constexpr size_t OFF_WIN = OFF_MIXB + al256((size_t)NT * D * 2);
constexpr size_t OFF_WOUT = OFF_WIN + al256((size_t)2 * DP * D * 2);
constexpr size_t OFF_W1T = OFF_WOUT + al256((size_t)2 * D * D * 2);
constexpr size_t OFF_W2T = OFF_W1T + al256((size_t)2 * NE * 2048 * D * 2);
constexpr size_t OFF_U = OFF_W2T + al256((size_t)2 * NE * D * DFF * 2);
constexpr size_t WS_END = OFF_U + al256((size_t)32 * SL * SL * 4);
constexpr size_t OFF_S = OFF_U, OFF_H = OFF_U, OFF_Y = OFF_U + al256((size_t)(NPAIR + 256) * DFF * 2);
constexpr size_t OFF_OA = OFF_MIXO, OFF_HB = OFF_MIXO + (size_t)2 * NT * 256 * 4;


#define DEV __device__ __forceinline__
DEV int tid_local() { int t = threadIdx.x; asm volatile("" : "+v"(t)); return t; }
DEV float wsum(float v) { for (int o = 32; o >= 1; o >>= 1) v += __shfl_xor(v, o); return v; }
DEV float wmaxf(float v) { for (int o = 32; o >= 1; o >>= 1) v = fmaxf(v, __shfl_xor(v, o)); return v; }
DEV float sigm(float x) { return 1.f / (1.f + expf(-x)); }
DEV float rdlane(float v, int l) { return __int_as_float(__builtin_amdgcn_readlane(__float_as_int(v), l)); }
DEV float lam_init_of(int layer) { return 0.8f - 0.6f * expf(-0.3f * (float)layer); }


#define XB_TMO      128
#define XB_XCNT(j)  (256  + 64 * (j))
#define XB_XSUB(j)  (1280 + 64 * (j))
#define XB_XGEN(j)  (2304 + 64 * (j))
#define XB_TOP      3328
#define XB_TOPGEN   3392
#define XCD_BAR_WORDS 3456
#define XB_SPIN_CAP (1u << 22)
#define LAS __attribute__((address_space(3)))
DEV unsigned xb_ld(unsigned* p)              { return __hip_atomic_load(p, __ATOMIC_RELAXED, __HIP_MEMORY_SCOPE_AGENT); }
DEV unsigned xb_add(unsigned* p, unsigned v) { return __hip_atomic_fetch_add(p, v, __ATOMIC_RELAXED, __HIP_MEMORY_SCOPE_AGENT); }
DEV unsigned xb_xcc_id() { return (unsigned)__builtin_amdgcn_s_getreg((3 << 11) | 20) & 0xFu; }
#define XB_SPIN(cond, bar) do { unsigned _sp = 0; while (cond) { __builtin_amdgcn_s_sleep(1); \
    if ((++_sp & 255u) == 0u) { if (xb_ld(&(bar)[XB_TMO])) break; if (_sp > XB_SPIN_CAP) { atomicAdd(&(bar)[XB_TMO], 1u); break; } } } } while (0)
struct XcdBarrier { unsigned* bar; unsigned x; volatile LAS unsigned* st; };
DEV XcdBarrier xcd_barrier_post(unsigned* bar, volatile LAS unsigned* st) {
    XcdBarrier b; b.bar = bar; b.x = xb_xcc_id(); b.st = st;
    if (threadIdx.x == 0) (void)xb_add(&bar[XB_XCNT(b.x)], 1u);
    return b;
}
DEV void xcd_barrier_complete(unsigned* bar, unsigned x, unsigned& nloc, unsigned& nx) {
    const unsigned G = gridDim.x * gridDim.y * gridDim.z;
    unsigned sum, cnt, mine, sp = 0u;
    for (;;) {
        sum = 0u; cnt = 0u; mine = 0u;
#pragma unroll
        for (unsigned j = 0; j < 16; ++j) { const unsigned c = xb_ld(&bar[XB_XCNT(j)]); sum += c; cnt += (c > 0u) ? 1u : 0u; mine = (j == x) ? c : mine; }
        if (sum == G) break;
        __builtin_amdgcn_s_sleep(1);
        if ((++sp & 255u) == 0u) { if (xb_ld(&bar[XB_TMO])) break; if (sp > XB_SPIN_CAP) { atomicAdd(&bar[XB_TMO], 1u); break; } }
    }
    nloc = mine > 0u ? mine : 1u; nx = cnt > 0u ? cnt : 1u;
}
DEV void xcd_barrier(const XcdBarrier& b) {
    asm volatile("s_waitcnt vmcnt(0)" ::: "memory");
    __syncthreads();
    if (threadIdx.x == 0) {
        unsigned* bar = b.bar;
        __builtin_amdgcn_s_waitcnt(0);
        unsigned nloc = b.st[0], nx = b.st[1];
        if (nloc == 0u) { xcd_barrier_complete(bar, b.x, nloc, nx); b.st[0] = nloc; b.st[1] = nx; }
        const unsigned old = xb_add(&bar[XB_XSUB(b.x)], 1u);
        const unsigned gen = old / nloc;
        if (old + 1u == (gen + 1u) * nloc) {
            __builtin_amdgcn_fence(__ATOMIC_RELEASE, "agent");
            asm volatile("s_waitcnt vmcnt(0)" ::: "memory");
            const unsigned og = xb_add(&bar[XB_TOP], 1u);
            const unsigned tg = og / nx;
            if (og + 1u == (tg + 1u) * nx) xb_add(&bar[XB_TOPGEN], 1u);
            else XB_SPIN(xb_ld(&bar[XB_TOPGEN]) == tg, bar);
            __builtin_amdgcn_fence(__ATOMIC_ACQUIRE, "agent");
            xb_add(&bar[XB_XGEN(b.x)], 1u);
            asm volatile("s_waitcnt vmcnt(0)" ::: "memory");
        } else {
            XB_SPIN(xb_ld(&bar[XB_XGEN(b.x)]) == gen, bar);
            __builtin_amdgcn_fence(__ATOMIC_ACQUIRE, "agent");
            asm volatile("s_waitcnt vmcnt(0)" ::: "memory");
        }
    }
    __syncthreads();
}

template <class RowA, class LoadB, class Epi>
DEV void gemm128(char* smem, int K, RowA rowA, LoadB loadB, Epi epi) {
    const int tidx = tid_local();
    float (*As)[132] = (float (*)[132])smem;
    float (*Bs)[128] = (float (*)[128])(smem + 16 * 132 * 4);
    const int tid = tidx, ty = tid >> 5, tx = tid & 31;
    const int am = tid >> 2, akq = (tid & 3) * 4, bk = tid >> 5, bn = (tid & 31) * 4;
    const float* arow = rowA(am);
    float acc[8][4];
#pragma unroll
    for (int i = 0; i < 8; ++i)
#pragma unroll
        for (int j = 0; j < 4; ++j) acc[i][j] = 0.f;
#pragma unroll 1
    for (int k0 = 0; k0 < K; k0 += 16) {
        float4 a = arow ? *(const float4*)(arow + k0 + akq) : make_float4(0.f, 0.f, 0.f, 0.f);
        float4 b = loadB(k0 + bk, bn);
        __syncthreads();
        As[akq + 0][am] = a.x; As[akq + 1][am] = a.y; As[akq + 2][am] = a.z; As[akq + 3][am] = a.w;
        *(float4*)&Bs[bk][bn] = b;
        __syncthreads();
#pragma unroll 4
        for (int kk = 0; kk < 16; ++kk) {
            const float4 a0 = *(const float4*)&As[kk][ty * 8], a1 = *(const float4*)&As[kk][ty * 8 + 4], bb = *(const float4*)&Bs[kk][tx * 4];
            const float av[8] = {a0.x, a0.y, a0.z, a0.w, a1.x, a1.y, a1.z, a1.w};
#pragma unroll
            for (int i = 0; i < 8; ++i) { acc[i][0] += av[i] * bb.x; acc[i][1] += av[i] * bb.y; acc[i][2] += av[i] * bb.z; acc[i][3] += av[i] * bb.w; }
        }
    }
#pragma unroll
    for (int i = 0; i < 8; ++i) epi(ty * 8 + i, tx * 4, make_float4(acc[i][0], acc[i][1], acc[i][2], acc[i][3]));
}


typedef unsigned short bf16_t;
DEV unsigned cvt_pk_bf16(float lo, float hi) { unsigned r; asm volatile("v_cvt_pk_bf16_f32 %0, %1, %2" : "=v"(r) : "v"(lo), "v"(hi)); return r; }

namespace pg8 {
typedef short bf16x8 __attribute__((ext_vector_type(8)));
typedef float f32x4 __attribute__((ext_vector_type(4)));
typedef unsigned u32x4 __attribute__((ext_vector_type(4)));
typedef unsigned u32x2 __attribute__((ext_vector_type(2)));
constexpr int BM = 256, BK = 64, HALF = 128, HTB = HALF * BK * 2, STAGE_BYTES = 8 * HTB, NXCD = 8, WGM = 8;
DEV int lds_byte(int r, int c) { const int st = (r >> 4) * 2 + (c >> 5), rr = r & 15, cc = c & 31, ob = rr * 64 + cc * 2; return st * 1024 + (ob ^ (((ob >> 9) & 1) << 5)); }
DEV void stage_rc(int b, int& R, int& C) { const int st = b / 1024, sb = b % 1024, swz = sb ^ (((sb >> 9) & 1) << 5); R = (st >> 1) * 16 + swz / 64; C = (st & 1) * 32 + (swz % 64) / 2; }
DEV int perm32(int rho) { const int n = rho >> 4, i = rho & 15; return 8 * (i >> 2) + 4 * n + (i & 3); }
struct Unit { int pm, pn, e, t; };
struct StaticOrder {
    int nM, nN, nwg, G, c, skipctx; const char* Bt; int K;
    DEV void init(int nM_, int nN_, int G_, int c_, int skipctx_, const void* Bt_, int K_) { nM = nM_; nN = nN_; nwg = nM * nN; G = G_; c = c_; skipctx = skipctx_; Bt = (const char*)Bt_; K = K_; }
    DEV bool next(int i, Unit& u) const {
        const long L = (long)i * G + c; if (L >= nwg) return false;
        int wgid = (int)L; { const int q = nwg / NXCD, r = nwg % NXCD, xcd = wgid % NXCD, off = wgid / NXCD; wgid = (xcd < r ? xcd * (q + 1) : r * (q + 1) + (xcd - r) * q) + off; }
        const int nig = WGM * nN, gid = wgid / nig, fm = gid * WGM, gsz = (nM - fm) < WGM ? (nM - fm) : WGM;
        int pm = fm + ((wgid % nig) % gsz); u.pn = (wgid % nig) / gsz;
        if (skipctx) pm = (pm >> 3) * 9 + 1 + (pm & 7);
        u.pm = pm; u.e = 0; u.t = 0; return true;
    }
    DEV int arow(const Unit& u, int rr) const { return u.pm * BM + rr; }
    DEV const char* bbase(const Unit& u) const { return Bt + (size_t)u.pn * BM * K * 2; }
};
struct EpiF32 {
    static constexpr bool PERM = false;
    float* C; int ldc;
    DEV void operator()(const f32x4 (&acc)[2][2][4][2], const Unit& u, int wr, int wc, int fr, int fq) const {
        const int row0 = u.pm * BM + wr * 64 + fr, col0 = u.pn * BM + wc * 32 + 4 * fq;
#pragma unroll
        for (int ai = 0; ai < 2; ++ai)
#pragma unroll
            for (int m = 0; m < 4; ++m) { float* rowp = C + (size_t)(row0 + ai * HALF + m * 16) * ldc + col0;
#pragma unroll
                for (int bj = 0; bj < 2; ++bj)
#pragma unroll
                    for (int n = 0; n < 2; ++n) *(f32x4*)(rowp + bj * HALF + n * 16) = acc[ai][bj][m][n]; }
    }
};

template <class Epi, class Sched>
DEV void gemm_phase(LAS unsigned char* lds, const char* Abase, const int K, const Sched& S, const Epi& E) {
    const int tid = tid_local(), wid = __builtin_amdgcn_readfirstlane(tid >> 6), lane = tid & 63, wr = wid >> 2, wc = wid & 3, fr = lane & 15, fq = lane >> 4;
    const int nt = K / BK;
    unsigned voffB[2];
#pragma unroll
    for (int i = 0; i < 2; ++i) { int R, C; stage_rc(tid * 16 + i * 8192, R, C); const int Rb = Epi::PERM ? ((R & ~31) + perm32(R & 31)) : R;
        voffB[i] = (unsigned)(Rb * K + C) * 2u; }
    const size_t kstep = (size_t)(BK * 2);
    const size_t hstep = (size_t)HALF * K * 2;
    const unsigned ldsw = (unsigned)wid * 1024u;
    const int aoff = lds_byte(wr * 64 + fr, fq * 8), boff = lds_byte(wc * 32 + fr, fq * 8);
#define PG8_SA(b, h) (((b) * 2 + (h)) * HTB)
#define PG8_SB(b, h) ((4 + (b) * 2 + (h)) * HTB)
#define PG8_STAGE_B(bufoff, gbase) do { _Pragma("unroll") for (int _i = 0; _i < 2; ++_i) \
        __builtin_amdgcn_global_load_lds((const unsigned*)((const char*)(gbase) + voffB[_i]), (LAS unsigned*)(lds + (bufoff) + ldsw + _i * 8192), 16, 0, 0); } while (0)
#define PG8_STAGE_A(bufoff, kb, V, h) do { _Pragma("unroll") for (int _i = 0; _i < 2; ++_i) \
        __builtin_amdgcn_global_load_lds((const unsigned*)(Abase + (kb) + (V)[h][_i]), (LAS unsigned*)(lds + (bufoff) + ldsw + _i * 8192), 16, 0, 0); } while (0)
#define PG8_VOFFA(V, u) do { _Pragma("unroll") for (int _i = 0; _i < 2; ++_i) { int _R, _C; stage_rc(tid * 16 + _i * 8192, _R, _C); _Pragma("unroll") for (int _h = 0; _h < 2; ++_h) \
        (V)[_h][_i] = ((unsigned)S.arow(u, _h * HALF + _R) * (unsigned)K + (unsigned)_C) * 2u; } } while (0)
#define PG8_LDA(dst, b, h) do { _Pragma("unroll") for (int m = 0; m < 4; ++m) _Pragma("unroll") for (int k = 0; k < 2; ++k) dst[m][k] = *(const LAS bf16x8*)(lds + PG8_SA(b, h) + aoff + m * 2048 + k * 1024); } while (0)
#define PG8_LDB(dst, b, h) do { _Pragma("unroll") for (int n = 0; n < 2; ++n) _Pragma("unroll") for (int k = 0; k < 2; ++k) dst[n][k] = *(const LAS bf16x8*)(lds + PG8_SB(b, h) + boff + n * 2048 + k * 1024); } while (0)
#define PG8_MMA(ai, bj, At, Bt) do { __builtin_amdgcn_s_setprio(1); _Pragma("unroll") for (int m = 0; m < 4; ++m) _Pragma("unroll") for (int n = 0; n < 2; ++n) _Pragma("unroll") for (int k = 0; k < 2; ++k) \
        acc[ai][bj][m][n] = __builtin_amdgcn_mfma_f32_16x16x32_bf16(Bt[n][k], At[m][k], acc[ai][bj][m][n], 0, 0, 0); __builtin_amdgcn_s_setprio(0); } while (0)
#define PG8_WAIT_V(n) asm volatile("s_waitcnt vmcnt(" #n ")" ::: "memory")
#define PG8_WAIT_L(n) asm volatile("s_waitcnt lgkmcnt(" #n ")" ::: "memory")
#define PG8_BAR __builtin_amdgcn_s_barrier()
#define PG8_SCHED __builtin_amdgcn_sched_barrier(0)
    Unit cur, nxt; int ui = 0;
    if (!S.next(0, cur)) return;
    f32x4 acc[2][2][4][2];
#pragma unroll
    for (int a = 0; a < 2; ++a)
#pragma unroll
        for (int b = 0; b < 2; ++b)
#pragma unroll
            for (int m = 0; m < 4; ++m)
#pragma unroll
                for (int n = 0; n < 2; ++n) acc[a][b][m][n] = (f32x4){0.f, 0.f, 0.f, 0.f};
    bf16x8 At[4][2], B0[2][2], B1[2][2];
    unsigned vc[2][2], v2[2][2];
    PG8_VOFFA(vc, cur);
    const char* cB = S.bbase(cur);
    PG8_STAGE_B(PG8_SB(0, 0), cB); PG8_STAGE_A(PG8_SA(0, 0), 0, vc, 0); PG8_STAGE_B(PG8_SB(0, 1), cB + hstep); PG8_STAGE_A(PG8_SA(0, 1), 0, vc, 1);
    if (wr == 1) PG8_BAR;
    PG8_WAIT_V(4); PG8_BAR;
    PG8_STAGE_B(PG8_SB(1, 0), cB + kstep); PG8_STAGE_A(PG8_SA(1, 0), kstep, vc, 0); PG8_STAGE_B(PG8_SB(1, 1), cB + hstep + kstep);
    PG8_WAIT_V(6); PG8_BAR;
    for (;;) {
        const bool has_next = S.next(ui + 1, nxt);
        const char* nB = has_next ? S.bbase(nxt) : cB;
        for (int t = 0; t < nt; t += 2) {
            const bool last = (t == nt - 2);
            const size_t k1 = (size_t)(t + 1) * kstep, k2 = last ? (size_t)0 : (size_t)(t + 2) * kstep, k3 = k2 + kstep;
            if (last && has_next) { PG8_VOFFA(v2, nxt); } else {
#pragma unroll
                for (int h = 0; h < 2; ++h)
#pragma unroll
                    for (int i = 0; i < 2; ++i) v2[h][i] = vc[h][i]; }
            const char* b2 = last ? nB : cB + (size_t)(t + 2) * kstep; const char* b3 = b2 + kstep;
            PG8_LDB(B0, 0, 0); PG8_SCHED; PG8_LDA(At, 0, 0); PG8_STAGE_A(PG8_SA(1, 1), k1, vc, 1);
            PG8_WAIT_L(8); PG8_BAR; PG8_WAIT_L(0); PG8_MMA(0, 0, At, B0); PG8_BAR; PG8_SCHED;
            PG8_LDB(B1, 0, 1); PG8_STAGE_B(PG8_SB(0, 0), b2);
            PG8_BAR; PG8_WAIT_L(0); PG8_MMA(0, 1, At, B1); PG8_BAR;
            PG8_LDA(At, 0, 1); PG8_STAGE_A(PG8_SA(0, 0), k2, v2, 0);
            PG8_BAR; PG8_WAIT_L(0); PG8_MMA(1, 0, At, B0); PG8_BAR; PG8_SCHED;
            PG8_STAGE_B(PG8_SB(0, 1), b2 + hstep);
            PG8_WAIT_V(6); PG8_BAR; PG8_MMA(1, 1, At, B1); PG8_BAR;
            PG8_LDB(B0, 1, 0); PG8_SCHED; PG8_LDA(At, 1, 0); PG8_STAGE_A(PG8_SA(0, 1), k2, v2, 1);
            PG8_WAIT_L(8); PG8_BAR; PG8_WAIT_L(0); PG8_MMA(0, 0, At, B0); PG8_BAR; PG8_SCHED;
            PG8_LDB(B1, 1, 1); PG8_STAGE_B(PG8_SB(1, 0), b3);
            PG8_BAR; PG8_WAIT_L(0); PG8_MMA(0, 1, At, B1); PG8_BAR;
            PG8_LDA(At, 1, 1); PG8_STAGE_A(PG8_SA(1, 0), k3, v2, 0);
            PG8_BAR; PG8_WAIT_L(0); PG8_MMA(1, 0, At, B0); PG8_BAR; PG8_SCHED;
            PG8_STAGE_B(PG8_SB(1, 1), b3 + hstep);
            PG8_WAIT_V(6); PG8_BAR; PG8_MMA(1, 1, At, B1); PG8_BAR;
        }
        E(acc, cur, wr, wc, fr, fq);
        if (!has_next) break;
#pragma unroll
        for (int a = 0; a < 2; ++a)
#pragma unroll
            for (int b = 0; b < 2; ++b)
#pragma unroll
                for (int m = 0; m < 4; ++m)
#pragma unroll
                    for (int n = 0; n < 2; ++n) acc[a][b][m][n] = (f32x4){0.f, 0.f, 0.f, 0.f};
        cur = nxt; cB = nB; ++ui;
#pragma unroll
        for (int h = 0; h < 2; ++h)
#pragma unroll
            for (int i = 0; i < 2; ++i) vc[h][i] = v2[h][i];
    }
    PG8_WAIT_V(0);
    if (wr == 0) PG8_BAR;
    PG8_BAR;
#undef PG8_SA
#undef PG8_SB
#undef PG8_STAGE_A
#undef PG8_STAGE_B
#undef PG8_VOFFA
#undef PG8_LDA
#undef PG8_LDB
#undef PG8_MMA
#undef PG8_WAIT_V
#undef PG8_WAIT_L
#undef PG8_BAR
#undef PG8_SCHED
}
}

DEV void cvt_tile(const float* src, int ld, int nvalid, bf16_t* dst, int K, int n0, int k0, float* T) {
    const int tidx = tid_local();
    const int t = tidx;
#pragma unroll
    for (int h = 0; h < 2; ++h) {
        const int kk = (t >> 4) + 32 * h, nq = (t & 15) * 4, n = n0 + nq;
        const float4 v = n < nvalid ? *(const float4*)(src + (size_t)(k0 + kk) * ld + n) : make_float4(0.f, 0.f, 0.f, 0.f);
        T[(nq + 0) * 65 + kk] = v.x; T[(nq + 1) * 65 + kk] = v.y; T[(nq + 2) * 65 + kk] = v.z; T[(nq + 3) * 65 + kk] = v.w;
    }
    __syncthreads();
    { const int n = t >> 3, kq = (t & 7) * 8; const float* r = T + n * 65 + kq;
      pg8::u32x4 w; w.x = cvt_pk_bf16(r[0], r[1]); w.y = cvt_pk_bf16(r[2], r[3]); w.z = cvt_pk_bf16(r[4], r[5]); w.w = cvt_pk_bf16(r[6], r[7]);
      *(pg8::u32x4*)(dst + (size_t)(n0 + n) * K + k0 + kq) = w; }
    __syncthreads();
}
DEV void ph_convert(const Params& p, char* smem) {
    const int tidx = tid_local();
    float* T = (float*)smem;
    constexpr int T_IN = 2 * 60 * 16, T_OUT = 2 * 16 * 16, T_W1 = 64 * 32 * 16, T_W2 = 64 * 16 * 16;
    for (int u = blockIdx.x; u < T_IN + T_OUT + T_W1 + T_W2; u += gridDim.x) {
        if (u < T_IN) { const int l = u / 960, r = u % 960, nt = r >> 4, kt = r & 15;
            cvt_tile(p.w_in + (size_t)l * D * DPW, DPW, DPW, (bf16_t*)(p.ws + OFF_WIN) + (size_t)l * DP * D, D, nt * 64, kt * 64, T); }
        else if (u < T_IN + T_OUT) { const int v = u - T_IN, l = v >> 8, r = v & 255, nt = r >> 4, kt = r & 15;
            cvt_tile(p.w_out + (size_t)l * D * D, D, D, (bf16_t*)(p.ws + OFF_WOUT) + (size_t)l * D * D, D, nt * 64, kt * 64, T); }
        else if (u < T_IN + T_OUT + T_W1) { const int v = u - T_IN - T_OUT, le = v >> 9, r = v & 511, nt = r >> 4, kt = r & 15;
            cvt_tile(p.w1 + (size_t)le * D * 2048, 2048, 2048, (bf16_t*)(p.ws + OFF_W1T) + (size_t)le * 2048 * D, D, nt * 64, kt * 64, T); }
        else { const int v = u - T_IN - T_OUT - T_W1, le = v >> 8, r = v & 255, nt = r >> 4, kt = r & 15;
            cvt_tile(p.w2 + (size_t)le * DFF * D, D, D, (bf16_t*)(p.ws + OFF_W2T) + (size_t)le * D * DFF, DFF, nt * 64, kt * 64, T); }
    }
}

DEV void row_load(const float* src, float4 (&v)[4], int lane) {
#pragma unroll
    for (int i = 0; i < 4; ++i) v[i] = *(const float4*)(src + i * 256 + lane * 4);
}
DEV void row_store(float* dst, const float4 (&v)[4], int lane) {
#pragma unroll
    for (int i = 0; i < 4; ++i) *(float4*)(dst + i * 256 + lane * 4) = v[i];
}
DEV void row_store_bf16(bf16_t* dst, const float4 (&v)[4], int lane) {
#pragma unroll
    for (int i = 0; i < 4; ++i) { pg8::u32x2 w; w.x = cvt_pk_bf16(v[i].x, v[i].y); w.y = cvt_pk_bf16(v[i].z, v[i].w); *(pg8::u32x2*)(dst + i * 256 + lane * 4) = w; }
}
DEV float row_rinv(const float4 (&v)[4]) {
    float ss = 0.f;
#pragma unroll
    for (int i = 0; i < 4; ++i) ss += v[i].x * v[i].x + v[i].y * v[i].y + v[i].z * v[i].z + v[i].w * v[i].w;
    ss = wsum(ss);
    return rsqrtf(ss * (1.f / 1024.f) + 1e-6f);
}
DEV void row_modnorm(const float4 (&v)[4], const float* gain, const float* shift, const float* scale, float4 (&o)[4], int lane) {
    const float r = row_rinv(v);
#pragma unroll
    for (int i = 0; i < 4; ++i) {
        const int idx = i * 256 + lane * 4;
        const float4 g = *(const float4*)(gain + idx), sh = *(const float4*)(shift + idx), sc = *(const float4*)(scale + idx);
        o[i].x = v[i].x * r * g.x * (1.f + sc.x) + sh.x; o[i].y = v[i].y * r * g.y * (1.f + sc.y) + sh.y;
        o[i].z = v[i].z * r * g.z * (1.f + sc.z) + sh.z; o[i].w = v[i].w * r * g.w * (1.f + sc.w) + sh.w;
    }
}
DEV const float* modrow(const Params& p, int layer, int b, int s) { return ((float*)(p.ws + OFF_MOD)) + ((size_t)layer * 9 + (s < CTX ? 8 : b)) * 6144; }

DEV void ph_mods(const Params& p, char* smem) {
    const int tidx = tid_local();
    float (*cond)[1024] = (float (*)[1024])smem;
    float (*red)[9][64] = (float (*)[9][64])(smem + 9 * 1024 * 4);
    const int tid = tidx;
    for (int i = tid; i < 9 * 1024; i += 512) { const int r = i >> 10, k = i & 1023; const float c = r < 8 ? p.c[r * 1024 + k] : p.c_ctx[k]; cond[r][k] = c * sigm(c); }
    __syncthreads();
    for (int u = blockIdx.x; u < 192; u += gridDim.x) {
        const int layer = u / 96, cg = u % 96, jj = tid & 63, ks = tid >> 6, j = cg * 64 + jj;
        float acc[9];
#pragma unroll
        for (int r = 0; r < 9; ++r) acc[r] = 0.f;
        const float* w = p.ada_w + (size_t)layer * 1024 * 6144 + j;
        for (int k = ks * 128; k < ks * 128 + 128; ++k) { const float wv = w[(size_t)k * 6144];
#pragma unroll
            for (int r = 0; r < 9; ++r) acc[r] += cond[r][k] * wv; }
#pragma unroll
        for (int r = 0; r < 9; ++r) red[ks][r][jj] = acc[r];
        __syncthreads();
        for (int t = tid; t < 9 * 64; t += 512) { const int r = t >> 6, q = t & 63; float s = 0.f; for (int z = 0; z < 8; ++z) s += red[z][r][q];
            ((float*)(p.ws + OFF_MOD))[((size_t)layer * 9 + r) * 6144 + cg * 64 + q] = s + p.ada_b[layer * 6144 + cg * 64 + q]; }
        __syncthreads();
    }
    if (blockIdx.x == 0) {
        for (int t = tid; t < 1024; t += 512) { const int layer = t >> 9, dir = (t >> 8) & 1, w = t & 255;
            const float t0 = p.hlb[(dir * 2 + 0) * 256 + w], t1 = p.hlb[(dir * 2 + 1) * 256 + w];
            const float mx = fmaxf(t0, t1), e0 = expf(t0 - mx), e1 = expf(t1 - mx);
            float lb = layer == 0 ? 0.f : e1 / (e0 + e1); lb = fminf(fmaxf(lb, 0.f), 1.f);
            ((float*)(p.ws + OFF_LB))[(layer * 2 + dir) * 256 + w] = lb; }
        if (tid < 128) { const int layer = tid >> 6, lane = tid & 63; const float* L = p.dlam + layer * 256;
            const float s1 = wsum(L[lane] * L[64 + lane]), s2 = wsum(L[128 + lane] * L[192 + lane]);
            if (lane == 0) ((float*)(p.ws + OFF_LAM))[layer] = expf(s1) - expf(s2) + lam_init_of(layer); }
    }
}

DEV void ph_init(const Params& p, char* smem) {
    const int tidx = tid_local();
    const int wid = tidx >> 6, lane = tidx & 63;
    for (int r = blockIdx.x * 8 + wid; r < NT; r += gridDim.x * 8) {
        const int b = r / SL, s = r % SL;
        const float* src = s < CTX ? p.ctx + ((size_t)b * CTX + s) * D : p.x + ((size_t)b * SEQ + (s - CTX)) * D;
        float4 v[4], o[4]; row_load(src, v, lane); row_store(((float*)(p.ws + OFF_X)) + (size_t)r * D, v, lane);
        const float* m = modrow(p, 0, b, s);
        row_modnorm(v, p.norms + 0, m + 0, m + 1024, o, lane);
        row_store_bf16((bf16_t*)(p.ws + OFF_XNB) + (size_t)r * D, o, lane);
    }
}

DEV void ph_inproj(const Params& p, int layer, char* smem) {
    const int tidx = tid_local();
    pg8::StaticOrder S; S.init(NT / 256, DP / 256, (int)gridDim.x, (int)blockIdx.x, 0, (const bf16_t*)(p.ws + OFF_WIN) + (size_t)layer * DP * D, D);
    pg8::EpiF32 E{(float*)(p.ws + OFF_P), DP};
    pg8::gemm_phase(( LAS unsigned char*)smem, (const char*)(p.ws + OFF_XNB), D, S, E);
}

DEV void ph_scans(const Params& p, int layer, char* smem) {
    const int tidx = tid_local();
    const int gw = (tidx < 64 && blockIdx.x < 128) ? (int)blockIdx.x : 128, lane = tidx & 63;
    const int ch = gw & 63, b = ch >> 3, h = (ch >> 1) & 3, dir = ch & 1;
    if (gw < 64) {
        float S[64];
#pragma unroll
        for (int k = 0; k < 64; ++k) S[k] = 0.f;
        const float lbv = ((float*)(p.ws + OFF_LB))[(layer * 2 + dir) * 256 + h * 64 + lane];
        float* out = ((float*)(p.ws + OFF_OA)) + (size_t)dir * NT * 256;
        for (int step = 0; step < SL; ++step) {
            const int s = dir == 0 ? step : (step < CTX ? CTX - 1 - step : SL + CTX - 1 - step);
            const float* row = ((float*)(p.ws + OFF_P)) + (size_t)(b * SL + s) * DP;
            float q = row[O_AQ + h * 64 + lane]; q = q * sigm(q);
            const float fp = row[(dir ? O_AFB : O_AFF) + h * 64 + lane];
            const float f = fmaxf(lbv + (1.f - lbv) * sigm(fp), 1e-12f), kk = (1.f - lbv) * sigm(-fp);
            const float vv = row[O_AI + h * 64 + lane];
            float o = 0.f;
#pragma unroll
            for (int k = 0; k < 64; ++k) { S[k] = rdlane(f, k) * S[k] + rdlane(kk, k) * vv; o += S[k] * rdlane(q, k); }
            out[(size_t)(b * SL + s) * 256 + h * 64 + lane] = o;
        }
    } else if (gw < 128) {
        float C[32], n[32];
#pragma unroll
        for (int k = 0; k < 32; ++k) { C[k] = 0.f; n[k] = 0.f; }
        float m = 0.f;
        const float bi = p.mgb[layer * 16 + (dir * 2 + 0) * 4 + h], bf = p.mgb[layer * 16 + (dir * 2 + 1) * 4 + h];
        float* out = ((float*)(p.ws + OFF_HB)) + (size_t)dir * NT * 256;
        for (int step = 0; step < SL; ++step) {
            const int s = dir == 0 ? step : (step < CTX ? CTX - 1 - step : SL + CTX - 1 - step);
            const float* row = ((float*)(p.ws + OFF_P)) + (size_t)(b * SL + s) * DP;
            const float q = row[O_BQ + h * 32 + (lane & 31)] * 0.17677669529663687f;
            const float kx = row[O_BK + h * 32 + (lane & 31)];
            const float vv = row[O_BV + h * 64 + lane];
            const float li = row[O_BG + (dir * 2 + 0) * 4 + h] + bi;
            const float gf = row[O_BG + (dir * 2 + 1) * 4 + h] + bf;
            const float lf = fminf(gf, 0.f) - log1pf(expf(-fabsf(gf)));
            const float mn = fmaxf(lf + m, li);
            const float a = expf(lf + m - mn), bc = expf(li - mn);
            m = mn;
            float num = 0.f, den = 0.f;
#pragma unroll
            for (int k = 0; k < 32; ++k) { const float kk = rdlane(kx, k), qq = rdlane(q, k);
                C[k] = a * C[k] + bc * kk * vv; n[k] = a * n[k] + bc * kk; num += C[k] * qq; den += n[k] * qq; }
            out[(size_t)(b * SL + s) * 256 + h * 64 + lane] = num / fmaxf(fabsf(den), expf(-mn));
        }
    }
}

DEV void ph_attn_prep(const Params& p, char* smem) {
    const int tidx = tid_local();
    const int t = tidx, rr = t >> 8, hj = (t >> 5) & 7, half = (t >> 4) & 1, i = t & 15;
    const float invf = expf(-(float)i * (1.f / 16.f) * 9.210340371976184f);
    for (int r = blockIdx.x * 2 + rr; r < NT; r += gridDim.x * 2) {
        const int b = r / SL, s = r % SL, g = b * 8 + hj;
        float cs = 1.f, sn = 0.f;
        if (s >= CTX) { const int tl = s - CTX; const float pos = half == 0 ? (float)(tl / 64) : (float)(tl % 64); sincosf(pos * invf, &sn, &cs); }
        const float* row = ((float*)(p.ws + OFF_P)) + (size_t)r * DP;
        const int d1 = half * 32 + i, d2 = d1 + 16;
        const float q1 = row[O_CQ + hj * 64 + d1], q2 = row[O_CQ + hj * 64 + d2], k1 = row[O_CK + hj * 64 + d1], k2 = row[O_CK + hj * 64 + d2];
        float* qr = ((float*)(p.ws + OFF_QR)) + ((size_t)g * SL + s) * 64;
        qr[d1] = q1 * cs - q2 * sn; qr[d2] = q1 * sn + q2 * cs;
        ((float*)(p.ws + OFF_KT))[((size_t)g * 64 + d1) * SL + s] = k1 * cs - k2 * sn;
        ((float*)(p.ws + OFF_KT))[((size_t)g * 64 + d2) * SL + s] = k1 * sn + k2 * cs;
    }
}
DEV void ph_scores(const Params& p, int mode, int half, char* smem) {
    const int tidx = tid_local();
    const int ntm = mode == 0 ? 16 : 18, ntn = mode == 0 ? 16 : 2, per = ntm * ntn;
#pragma unroll 1
    for (int u = blockIdx.x; u < 32 * per; u += gridDim.x) {
        const int gl = u / per, g = half * 32 + gl, tm = (u % per) / ntn, tn = u % ntn, b = g >> 3, hj = g & 7;
        const int r0 = mode == 0 ? CTX + tm * 128 : tm * 128, c0 = mode == 0 ? CTX + tn * 128 : tn * 128;
        gemm128(smem, 64,
            [&](int m) { return mode == 0 ? ((float*)(p.ws + OFF_QR)) + ((size_t)g * SL + r0 + m) * 64 : ((float*)(p.ws + OFF_P)) + (size_t)(b * SL + r0 + m) * DP + O_CQ + hj * 64; },
            [&](int k, int n) { return *(const float4*)(((float*)(p.ws + OFF_KT)) + ((size_t)g * 64 + k) * SL + c0 + n); },
            [&](int m, int n, float4 a) { *(float4*)(((float*)(p.ws + OFF_S)) + ((size_t)gl * SL + r0 + m) * SL + c0 + n) = a; });
    }
}
DEV void ph_softmax(const Params& p, int layer, int half, char* smem) {
    const int tidx = tid_local();
    const int wid = tidx >> 6, lane = tidx & 63;
    const float lam = ((float*)(p.ws + OFF_LAM))[layer];
    for (int u = blockIdx.x * 8 + wid; u < 16 * SL; u += gridDim.x * 8) {
        const int bh = u / SL, s = u % SL;
        if (layer != 0 && s < CTX) continue;
        const int cnt = s < CTX ? 4 : 36;
        float* r1 = ((float*)(p.ws + OFF_S)) + ((size_t)(bh * 2) * SL + s) * SL; const float* r2 = ((float*)(p.ws + OFF_S)) + ((size_t)(bh * 2 + 1) * SL + s) * SL;
        float a[36], c[36]; float m1 = -3.0e38f, m2 = -3.0e38f;
#pragma unroll
        for (int i = 0; i < 36; ++i) if (i < cnt) { a[i] = r1[lane + 64 * i] * 0.125f; c[i] = r2[lane + 64 * i] * 0.125f; m1 = fmaxf(m1, a[i]); m2 = fmaxf(m2, c[i]); }
        m1 = wmaxf(m1); m2 = wmaxf(m2);
        float s1 = 0.f, s2 = 0.f;
#pragma unroll
        for (int i = 0; i < 36; ++i) if (i < cnt) { a[i] = expf(a[i] - m1); c[i] = expf(c[i] - m2); s1 += a[i]; s2 += c[i]; }
        s1 = wsum(s1); s2 = wsum(s2);
        const float i1 = 1.f / s1, i2 = lam / s2;
#pragma unroll
        for (int i = 0; i < 36; ++i) if (i < cnt) r1[lane + 64 * i] = a[i] * i1 - c[i] * i2;
    }
}
DEV void ph_wv(const Params& p, int mode, int half, char* smem) {
    const int tidx = tid_local();
    const int ntm = mode == 0 ? 16 : 2, K = mode == 0 ? SL : CTX;
    for (int u = blockIdx.x; u < 16 * ntm; u += gridDim.x) {
        const int bhl = u / ntm, bh = half * 16 + bhl, tm = u % ntm, b = bh >> 2, h = bh & 3, r0 = mode == 0 ? CTX + tm * 128 : tm * 128;
        gemm128(smem, K,
            [&](int m) { return ((float*)(p.ws + OFF_S)) + ((size_t)(bhl * 2) * SL + r0 + m) * SL; },
            [&](int k, int n) { return *(const float4*)(((float*)(p.ws + OFF_P)) + (size_t)(b * SL + k) * DP + O_CV + h * 128 + n); },
            [&](int m, int n, float4 a) { *(float4*)(((float*)(p.ws + OFF_OC)) + ((size_t)bh * SL + r0 + m) * 128 + n) = a; });
    }
}
DEV void ph_readout(const Params& p, int layer, char* smem) {
    const int tidx = tid_local();
    const int wid = tidx >> 6, lane = tidx & 63;
    const float omli = 1.f - lam_init_of(layer);
    for (int r = blockIdx.x * 8 + wid; r < NT; r += gridDim.x * 8) {
        const int b = r / SL, s = r % SL;
        if (layer != 0 && s < CTX) continue;
        const float* row = ((float*)(p.ws + OFF_P)) + (size_t)r * DP; bf16_t* mix = (bf16_t*)(p.ws + OFF_MIXB) + (size_t)r * D;
#pragma unroll
        for (int h = 0; h < 4; ++h) {
            const int e = h * 64 + lane;
            const float oa = ((float*)(p.ws + OFF_OA))[(size_t)r * 256 + e] + ((float*)(p.ws + OFF_OA))[(size_t)NT * 256 + (size_t)r * 256 + e];
            const float ra = rsqrtf(wsum(oa * oa) * (1.f / 64.f) + 1e-6f);
            const float ga = row[O_AG + e];
            mix[e] = (bf16_t)(cvt_pk_bf16(oa * ra * p.hnorm[layer * 64 + lane] * (ga * sigm(ga)), 0.f) & 0xffffu);
            const float ob = ((float*)(p.ws + OFF_HB))[(size_t)r * 256 + e] + ((float*)(p.ws + OFF_HB))[(size_t)NT * 256 + (size_t)r * 256 + e];
            const float rb = rsqrtf(wsum(ob * ob) * (1.f / 64.f) + 1e-6f);
            mix[256 + e] = (bf16_t)(cvt_pk_bf16(ob * rb * p.mnorm[layer * 256 + e] * sigm(row[O_BO + e]), 0.f) & 0xffffu);
            const float* oc = ((float*)(p.ws + OFF_OC)) + ((size_t)(b * 4 + h) * SL + s) * 128;
            const float c0 = oc[lane], c1 = oc[64 + lane];
            const float rc = rsqrtf(wsum(c0 * c0 + c1 * c1) * (1.f / 128.f) + 1e-6f);
            mix[512 + h * 128 + lane] = (bf16_t)(cvt_pk_bf16(c0 * rc * p.dnorm[layer * 128 + lane] * omli, 0.f) & 0xffffu);
            mix[512 + h * 128 + 64 + lane] = (bf16_t)(cvt_pk_bf16(c1 * rc * p.dnorm[layer * 128 + 64 + lane] * omli, 0.f) & 0xffffu);
        }
    }
}
DEV void ph_outproj(const Params& p, int layer, char* smem) {
    const int tidx = tid_local();
    pg8::StaticOrder S; S.init(layer == 0 ? NT / 256 : NB * 8, D / 256, (int)gridDim.x, (int)blockIdx.x, layer == 0 ? 0 : 1, (const bf16_t*)(p.ws + OFF_WOUT) + (size_t)layer * D * D, D);
    pg8::EpiF32 E{(float*)(p.ws + OFF_MIXO), D};
    pg8::gemm_phase((LAS unsigned char*)smem, (const char*)(p.ws + OFF_MIXB), D, S, E);
}
DEV void ph_norm2(const Params& p, int layer, char* smem) {
    const int tidx = tid_local();
    float (*xs)[1024] = (float (*)[1024])smem;
    int* hist = (int*)(smem + 32768);
    const int wid = tidx >> 6, lane = tidx & 63;
    const float* nr = p.norms + (size_t)layer * 4 * D;
    if (tidx < NE) hist[tidx] = 0;
    __syncthreads();
    const int chunk = (NT + (int)gridDim.x - 1) / (int)gridDim.x, rbeg = (int)blockIdx.x * chunk, rend = min(NT, rbeg + chunk);
    for (int r = rbeg + wid; r < rend; r += 8) {
        const int b = r / SL, s = r % SL;
        if (layer != 0 && s < CTX) continue;
        const float* m = modrow(p, layer, b, s);
        float4 mo[4], xv[4], o[4]; row_load(((float*)(p.ws + OFF_MIXO)) + (size_t)r * D, mo, lane); row_load(((float*)(p.ws + OFF_X)) + (size_t)r * D, xv, lane);
        const float ri = row_rinv(mo);
#pragma unroll
        for (int i = 0; i < 4; ++i) { const int idx = i * 256 + lane * 4; const float4 g = *(const float4*)(nr + D + idx), gt = *(const float4*)(m + 2048 + idx);
            xv[i].x += gt.x * (mo[i].x * ri * g.x); xv[i].y += gt.y * (mo[i].y * ri * g.y); xv[i].z += gt.z * (mo[i].z * ri * g.z); xv[i].w += gt.w * (mo[i].w * ri * g.w); }
        row_store(((float*)(p.ws + OFF_X)) + (size_t)r * D, xv, lane);
        row_modnorm(xv, nr + 2 * D, m + 3072, m + 4096, o, lane);
        row_store_bf16((bf16_t*)(p.ws + OFF_XNB) + (size_t)r * D, o, lane);
        row_store(&xs[wid][0], o, lane);
        __builtin_amdgcn_wave_barrier();
        asm volatile("s_waitcnt lgkmcnt(0)" ::: "memory");
        const int e = lane & 31, part = lane >> 5;
        const float* rw = p.rw + (size_t)layer * D * NE + e;
        float acc = 0.f;
        for (int i = part * 512; i < part * 512 + 512; ++i) acc += xs[wid][i] * rw[(size_t)i * NE];
        acc += __shfl_xor(acc, 32);
        float logit = acc + p.rb[layer * NE + e];
        float tv[4]; int ti[4];
#pragma unroll
        for (int k = 0; k < 4; ++k) {
            float bv = logit; int bi = e;
            for (int o2 = 16; o2 >= 1; o2 >>= 1) { const float ov = __shfl_xor(bv, o2); const int oi = __shfl_xor(bi, o2); if (ov > bv || (ov == bv && oi < bi)) { bv = ov; bi = oi; } }
            tv[k] = bv; ti[k] = bi; if (e == bi) logit = -3.0e38f;
        }
        const float e0 = 1.f, e1 = expf(tv[1] - tv[0]), e2 = expf(tv[2] - tv[0]), e3 = expf(tv[3] - tv[0]), inv = 1.f / (e0 + e1 + e2 + e3);
        if (lane == 0) { *(float4*)(((float*)(p.ws + OFF_TOPW)) + (size_t)r * 4) = make_float4(e0 * inv, e1 * inv, e2 * inv, e3 * inv); *(int4*)(((int*)(p.ws + OFF_TOPI)) + (size_t)r * 4) = make_int4(ti[0], ti[1], ti[2], ti[3]); }
        if (lane < 4) atomicAdd(&hist[lane == 0 ? ti[0] : lane == 1 ? ti[1] : lane == 2 ? ti[2] : ti[3]], 1);
        __builtin_amdgcn_wave_barrier();
    }
    __syncthreads();
    if (tidx < NE) ((int*)(p.ws + OFF_BC))[(size_t)blockIdx.x * NE + tidx] = hist[tidx];
}
DEV void ph_route(const Params& p, int layer, char* smem) {
    const int tidx = tid_local();
    int* part = (int*)smem;
    int* off = part + 1024;
    const int G = (int)gridDim.x, bid = (int)blockIdx.x;
    const int* BC = (const int*)(p.ws + OFF_BC);
    { const int e = tidx & 31, sl = tidx >> 5; int before = 0, tot = 0;
      for (int bb = sl; bb < G; bb += 16) { const int c = BC[(size_t)bb * NE + e]; tot += c; if (bb < bid) before += c; }
      part[(sl * 2 + 0) * 32 + e] = before; part[(sl * 2 + 1) * 32 + e] = tot; }
    __syncthreads();
    if (tidx < NE) { int before = 0, tot = 0; for (int sl = 0; sl < 16; ++sl) { before += part[(sl * 2 + 0) * 32 + tidx]; tot += part[(sl * 2 + 1) * 32 + tidx]; }
        off[tidx] = before; if (bid == 0) ((int*)(p.ws + OFF_CNT))[tidx] = tot; }
    __syncthreads();
    if (tidx < 64) {
        const int lane = tidx;
        const int chunk = (NT + G - 1) / G, rbeg = bid * chunk, rend = min(NT, rbeg + chunk);
        for (int q0 = rbeg * 4; q0 < rend * 4; q0 += 64) {
            const int pair = q0 + lane, r = pair >> 2, s = r % SL;
            const bool act = pair < rend * 4 && (layer == 0 || s >= CTX);
            const int my = act ? ((const int*)(p.ws + OFF_TOPI))[pair] : -1;
            for (int e = 0; e < NE; ++e) {
                const unsigned long long bal = __ballot(my == e);
                if (bal) { const int base = off[e];
                    if (my == e) ((int*)(p.ws + OFF_LIST))[(size_t)e * LISTCAP + base + __popcll(bal & ((1ull << lane) - 1ull))] = pair;
                    __builtin_amdgcn_wave_barrier();
                    if (lane == 0) off[e] = base + __popcll(bal);
                    __builtin_amdgcn_wave_barrier(); }
            }
        }
    }
}
DEV int moe_rt(int i, int G, int c, int npn, int& pn) {
    if (G == 256) { const int xcd = c & 7, j = c >> 3, rpx = 32 / npn; pn = j % npn; return (i * 8 + xcd) * rpx + j / npn; }
    const int L = i * G + c; pn = L % npn; return L / npn;
}
constexpr int MOE_LDS = 131072, MOE_MAXU = 12;
DEV void moe_prepare(const Params& p, char* smem, int npn, int mode) {
    const int tidx = tid_local();
    LAS int* base = (LAS int*)(smem + MOE_LDS);
    LAS int *TE = base, *TT = base + 320, *NRT = base + 640, *UI = base + 704, *IDX = base + 768;
    const int* cnt = (const int*)(p.ws + OFF_CNT);
    if (tidx < 320) { int e = 0, acc = 0; for (; e < NE; ++e) { const int n = (cnt[e] + 255) >> 8; if (tidx < acc + n) break; acc += n; } TE[tidx] = e; TT[tidx] = tidx - acc; }
    if (tidx == 0) { int tot = 0; for (int e = 0; e < NE; ++e) tot += (cnt[e] + 255) >> 8; NRT[0] = tot; }
    __syncthreads();
    const int nrt = NRT[0];
    for (int i = 0; i < MOE_MAXU; ++i) {
        int pn; const int rt = moe_rt(i, (int)gridDim.x, (int)blockIdx.x, npn, pn);
        if (rt >= nrt) break;
        const int e = TE[rt], t = TT[rt], c = cnt[e];
        if (tidx < 256) { const int q = t * 256 + tidx; const int pair = ((const int*)(p.ws + OFF_LIST))[(size_t)e * LISTCAP + min(q, c - 1)];
            IDX[i * 256 + tidx] = mode == 1 ? (pair >> 2) : (q < c ? pair : -1); }
        if (tidx == 256) { int pre = 0; for (int z = 0; z < e; ++z) pre += cnt[z]; UI[i * 4 + 0] = min(256, c - t * 256); UI[i * 4 + 1] = pre + t * 256; }
    }
    __syncthreads();
}
struct MoeOrder {
    const LAS int *te, *ui, *idx; int nrt, npn, G, c, gather; const char* Bt; size_t bstride; int K;
    DEV bool next(int i, pg8::Unit& u) const { int pn; const int rt = moe_rt(i, G, c, npn, pn); if (rt >= nrt || i >= MOE_MAXU) return false;
        u.pm = rt; u.pn = pn; u.e = __builtin_amdgcn_readfirstlane(te[rt]); u.t = i; return true; }
    DEV int arow(const pg8::Unit& u, int rr) const { return gather ? idx[u.t * 256 + rr] : ui[u.t * 4 + 1] + rr; }
    DEV const char* bbase(const pg8::Unit& u) const { return Bt + (size_t)u.e * bstride + (size_t)u.pn * pg8::BM * K * 2; }
};
DEV float swiglu(float g, float l) { g = fminf(g, 7.f); l = fminf(fmaxf(l, -7.f), 7.f); return g * __builtin_amdgcn_rcpf(1.f + __expf(-1.702f * g)) * (l + 1.f); }
struct EpiSwiglu {
    static constexpr bool PERM = true;
    bf16_t* H; const float* b1; const LAS int* ui;
    DEV void operator()(const pg8::f32x4 (&acc)[2][2][4][2], const pg8::Unit& u, int wr, int wc, int fr, int fq) const {
        const int ucnt = ui[u.t * 4 + 0], hrow0 = ui[u.t * 4 + 1], col0 = u.pn * 256 + wc * 32 + 8 * fq;
        const float* bb = b1 + (size_t)u.e * 2048 + col0;
        pg8::f32x4 bv[2][2];
#pragma unroll
        for (int bj = 0; bj < 2; ++bj)
#pragma unroll
            for (int n = 0; n < 2; ++n) bv[bj][n] = *(const pg8::f32x4*)(bb + bj * 128 + 4 * n);
#pragma unroll
        for (int ai = 0; ai < 2; ++ai)
#pragma unroll
            for (int m = 0; m < 4; ++m) { const int rr = ai * 128 + wr * 64 + m * 16 + fr;
                if (rr < ucnt) { bf16_t* rowp = H + (size_t)(hrow0 + rr) * DFF + (col0 >> 1);
#pragma unroll
                    for (int bj = 0; bj < 2; ++bj) { const pg8::f32x4 v0 = acc[ai][bj][m][0] + bv[bj][0], v1 = acc[ai][bj][m][1] + bv[bj][1];
                        pg8::u32x2 w; w.x = cvt_pk_bf16(swiglu(v0[0], v0[1]), swiglu(v0[2], v0[3])); w.y = cvt_pk_bf16(swiglu(v1[0], v1[1]), swiglu(v1[2], v1[3]));
                        *(pg8::u32x2*)(rowp + bj * 64) = w; } } }
    }
};
struct EpiY {
    static constexpr bool PERM = true;
    bf16_t* Y; const LAS int* idx;
    DEV void operator()(const pg8::f32x4 (&acc)[2][2][4][2], const pg8::Unit& u, int wr, int wc, int fr, int fq) const {
        const int col0 = u.pn * 256 + wc * 32 + 8 * fq;
#pragma unroll
        for (int ai = 0; ai < 2; ++ai)
#pragma unroll
            for (int m = 0; m < 4; ++m) { const int rr = ai * 128 + wr * 64 + m * 16 + fr; const int pair = idx[u.t * 256 + rr];
                if (pair >= 0) { bf16_t* rowp = Y + (size_t)pair * D + col0;
#pragma unroll
                    for (int bj = 0; bj < 2; ++bj) { const pg8::f32x4 v0 = acc[ai][bj][m][0], v1 = acc[ai][bj][m][1];
                        pg8::u32x4 w; w.x = cvt_pk_bf16(v0[0], v0[1]); w.y = cvt_pk_bf16(v0[2], v0[3]); w.z = cvt_pk_bf16(v1[0], v1[1]); w.w = cvt_pk_bf16(v1[2], v1[3]);
                        *(pg8::u32x4*)(rowp + bj * 128) = w; } } }
    }
};
DEV void ph_moe1(const Params& p, int layer, char* smem) {
    moe_prepare(p, smem, 8, 1);
    LAS int* base = (LAS int*)(smem + MOE_LDS);
    MoeOrder S{base, base + 704, base + 768, base[640], 8, (int)gridDim.x, (int)blockIdx.x, 1, (const char*)(p.ws + OFF_W1T) + (size_t)layer * NE * 2048 * D * 2, (size_t)2048 * D * 2, D};
    EpiSwiglu E{(bf16_t*)(p.ws + OFF_H), p.b1 + (size_t)layer * NE * 2048, base + 704};
    pg8::gemm_phase((LAS unsigned char*)smem, (const char*)(p.ws + OFF_XNB), D, S, E);
}
DEV void ph_moe2(const Params& p, int layer, char* smem) {
    moe_prepare(p, smem, 4, 2);
    LAS int* base = (LAS int*)(smem + MOE_LDS);
    MoeOrder S{base, base + 704, base + 768, base[640], 4, (int)gridDim.x, (int)blockIdx.x, 0, (const char*)(p.ws + OFF_W2T) + (size_t)layer * NE * D * DFF * 2, (size_t)D * DFF * 2, DFF};
    EpiY E{(bf16_t*)(p.ws + OFF_Y), base + 768};
    pg8::gemm_phase((LAS unsigned char*)smem, (const char*)(p.ws + OFF_H), DFF, S, E);
}
DEV void ph_combine(const Params& p, int layer, char* smem) {
    const int tidx = tid_local();
    const int wid = tidx >> 6, lane = tidx & 63;
    const float* nr = p.norms + (size_t)layer * 4 * D;
    for (int r = blockIdx.x * 8 + wid; r < NT; r += gridDim.x * 8) {
        const int b = r / SL, s = r % SL;
        if (layer != 0 && s < CTX) continue;
        const float* m = modrow(p, layer, b, s);
        const float4 tw = *(const float4*)(((float*)(p.ws + OFF_TOPW)) + (size_t)r * 4); const int4 ti = *(const int4*)(((int*)(p.ws + OFF_TOPI)) + (size_t)r * 4);
        const float w[4] = {tw.x, tw.y, tw.z, tw.w}; const int ei[4] = {ti.x, ti.y, ti.z, ti.w};
        float4 f[4], xv[4];
#pragma unroll
        for (int i = 0; i < 4; ++i) f[i] = make_float4(0.f, 0.f, 0.f, 0.f);
#pragma unroll
        for (int k = 0; k < 4; ++k) {
            const bf16_t* y = (const bf16_t*)(p.ws + OFF_Y) + ((size_t)r * 4 + k) * D; const float* bb = p.b2 + ((size_t)layer * NE + ei[k]) * D;
#pragma unroll
            for (int i = 0; i < 4; ++i) { const int idx = i * 256 + lane * 4; const pg8::u32x2 yb = *(const pg8::u32x2*)(y + idx); const float4 bv = *(const float4*)(bb + idx);
                const float y0 = __uint_as_float(yb.x << 16), y1 = __uint_as_float(yb.x & 0xffff0000u), y2 = __uint_as_float(yb.y << 16), y3 = __uint_as_float(yb.y & 0xffff0000u);
                f[i].x += w[k] * (y0 + bv.x); f[i].y += w[k] * (y1 + bv.y); f[i].z += w[k] * (y2 + bv.z); f[i].w += w[k] * (y3 + bv.w); }
        }
        row_load(((float*)(p.ws + OFF_X)) + (size_t)r * D, xv, lane);
        const float ri = row_rinv(f);
#pragma unroll
        for (int i = 0; i < 4; ++i) { const int idx = i * 256 + lane * 4; const float4 g = *(const float4*)(nr + 3 * D + idx), gt = *(const float4*)(m + 5120 + idx);
            xv[i].x += gt.x * (f[i].x * ri * g.x); xv[i].y += gt.y * (f[i].y * ri * g.y); xv[i].z += gt.z * (f[i].z * ri * g.z); xv[i].w += gt.w * (f[i].w * ri * g.w); }
        if (layer == 0) {
            row_store(((float*)(p.ws + OFF_X)) + (size_t)r * D, xv, lane);
            const float* m1 = modrow(p, 1, b, s); float4 o[4];
            row_modnorm(xv, p.norms + (size_t)4 * D, m1 + 0, m1 + 1024, o, lane);
            row_store_bf16((bf16_t*)(p.ws + OFF_XNB) + (size_t)r * D, o, lane);
        } else {
            row_store(p.out + ((size_t)b * SEQ + (s - CTX)) * D, xv, lane);
        }
    }
}

template <int layer> DEV void run_layer(const Params& p, char* smem, const XcdBarrier& bar) {
#define GB() xcd_barrier(bar)

        ph_inproj(p, layer, smem); GB();
        ph_scans(p, layer, smem); ph_attn_prep(p, smem); GB();
#pragma unroll 1
        for (int half = 0; half < 2; ++half) {
            ph_scores(p, 0, half, smem); ph_scores(p, 1, half, smem); GB();
            ph_softmax(p, layer, half, smem); GB();
            ph_wv(p, 0, half, smem); if (layer == 0) ph_wv(p, 1, half, smem); GB();
        }
        ph_readout(p, layer, smem); GB();
        ph_outproj(p, layer, smem); GB();
        ph_norm2(p, layer, smem); GB();
        ph_route(p, layer, smem); GB();
        ph_moe1(p, layer, smem); GB();
        ph_moe2(p, layer, smem); GB();
        ph_combine(p, layer, smem); GB();
    #undef GB
}
constexpr int LDS_BYTES = 147456;
__global__ __launch_bounds__(512, 2) void k_mega(Params p) {
    extern __shared__ __attribute__((aligned(16))) char smem[];
    volatile LAS unsigned* st = (volatile LAS unsigned*)(smem + LDS_BYTES - 16);
    if (threadIdx.x == 0) { st[0] = 0u; st[1] = 0u; st[2] = 0u; st[3] = 0u; }
    __syncthreads();
    const XcdBarrier bar = xcd_barrier_post(((unsigned*)(p.ws + OFF_bar)), st);
#define GB() xcd_barrier(bar)
    ph_mods(p, smem); ph_convert(p, smem); GB();
    ph_init(p, smem); GB();
    run_layer<0>(p, smem, bar);
    run_layer<1>(p, smem, bar);
#undef GB
}
}

extern "C" void kernel_launch(void* const* d_in, const int* in_sizes, int n_in, void* d_out, int out_size, void* d_ws, size_t ws_size, hipStream_t stream) {
    static int grid = 0;
    if (grid == 0) {
        int dev = 0, cus = 0, per_cu = 0;
        if (hipGetDevice(&dev) != hipSuccess || hipDeviceGetAttribute(&cus, hipDeviceAttributeMultiprocessorCount, dev) != hipSuccess) { grid = -1; return; }
        if (hipFuncSetAttribute((const void*)k_mega, hipFuncAttributeMaxDynamicSharedMemorySize, LDS_BYTES) != hipSuccess) { grid = -1; return; }
        (void)hipOccupancyMaxActiveBlocksPerMultiprocessor(&per_cu, (const void*)k_mega, 512, LDS_BYTES);
        (void)hipGetLastError();
        grid = cus;
    }
    if (grid < 0) return;
    Params p{};
    const float** in = (const float**)&p;
    for (int i = 0; i < 21; ++i) in[i] = (const float*)d_in[i];
    p.out = (float*)d_out;
    p.ws = (char*)d_ws;
    if (WS_END > ws_size) return;
    if (hipMemsetAsync(p.ws + OFF_bar, 0, (size_t)XCD_BAR_WORDS * 4, stream) != hipSuccess) return;
    hipLaunchKernelGGL(k_mega, dim3(grid), dim3(512), LDS_BYTES, stream, p);
}
```

```cpp
#include <hip/hip_runtime.h>
#include <stdint.h>

namespace {
constexpr int D = 1024, NB = 8, SEQ = 2048, CTX = 256, SL = 2304, NT = NB * SL;
constexpr int DP = 3840, DPW = 3600, NE = 32, DFF = 1024, NPAIR = NT * 4;
constexpr int O_AQ = 0, O_AI = 256, O_AFF = 512, O_AFB = 768, O_AG = 1024, O_BQ = 1280, O_BK = 1408, O_BV = 1536, O_BO = 1792, O_BG = 2048, O_CQ = 2064, O_CK = 2576, O_CV = 3088;
constexpr int LISTCAP = NT;

struct Params {
    const float *x, *c, *ctx, *c_ctx, *ada_w, *ada_b, *norms, *w_in, *w_out, *hlb, *hnorm, *mgb, *mnorm, *dlam, *dnorm, *rw, *rb, *w1, *b1, *w2, *b2;
    float* out;
    char* ws;
    int wave_id, pad_;
};
constexpr size_t al256(size_t x) { return (x + 255) & ~(size_t)255; }
constexpr size_t OFF_bar = 0;
constexpr size_t OFF_MOD = OFF_bar + al256(3456 * 4);
constexpr size_t OFF_LB = OFF_MOD + al256((size_t)2 * 9 * 6144 * 4);
constexpr size_t OFF_LAM = OFF_LB + al256(1024 * 4);
constexpr size_t OFF_CNT = OFF_LAM + 256;
constexpr size_t OFF_BC = OFF_CNT + 256;
constexpr size_t OFF_TOPW = OFF_BC + al256((size_t)1024 * NE * 4);
constexpr size_t OFF_TOPI = OFF_TOPW + al256((size_t)NPAIR * 4);
constexpr size_t OFF_LIST = OFF_TOPI + al256((size_t)NPAIR * 4);
constexpr size_t OFF_X = OFF_LIST + al256((size_t)NE * LISTCAP * 4);
constexpr size_t OFF_XN = OFF_X + al256((size_t)NT * D * 4);
constexpr size_t OFF_P = OFF_XN + al256((size_t)NT * D * 4);
constexpr size_t OFF_QR = OFF_P + al256((size_t)NT * DP * 4);
constexpr size_t OFF_KT = OFF_QR + al256((size_t)64 * SL * 64 * 4);
constexpr size_t OFF_OC = OFF_KT + al256((size_t)64 * SL * 64 * 4);
constexpr size_t OFF_MIX = OFF_OC + al256((size_t)32 * SL * 128 * 4);
constexpr size_t OFF_MIXO = OFF_MIX + al256((size_t)NT * D * 4);
constexpr size_t OFF_XNB = OFF_MIXO + al256((size_t)NT * D * 4);
constexpr size_t OFF_MIXB = OFF_XNB + al256((size_t)NT * D * 2);
constexpr size_t OFF_WIN = OFF_MIXB + al256((size_t)NT * D * 2);
constexpr size_t OFF_WOUT = OFF_WIN + al256((size_t)2 * DP * D * 2);
constexpr size_t OFF_W1T = OFF_WOUT + al256((size_t)2 * D * D * 2);
constexpr size_t OFF_W2T = OFF_W1T + al256((size_t)2 * NE * 2048 * D * 2);
constexpr size_t OFF_U = OFF_W2T + al256((size_t)2 * NE * D * DFF * 2);
constexpr size_t WS_END = OFF_U + al256((size_t)32 * SL * SL * 4);
constexpr size_t OFF_UA = OFF_U, OFF_DECA = OFF_UA + (size_t)64 * 36 * 4096 * 4, OFF_UB = OFF_DECA + (size_t)64 * 36 * 64 * 4, OFF_NB = OFF_UB + (size_t)64 * 36 * 2048 * 4,
                 OFF_MB = OFF_NB + (size_t)64 * 36 * 32 * 4, OFF_SCB = OFF_MB + (size_t)64 * 36 * 4 * 4;
constexpr size_t OFF_QRB = OFF_QR, OFF_Q0B = OFF_QR + (size_t)32 * SL * 128 * 2, OFF_KB = OFF_KT, OFF_VB = OFF_KT + (size_t)32 * SL * 128 * 2;
constexpr size_t OFF_S = OFF_U, OFF_H = OFF_U, OFF_Y = OFF_U + al256((size_t)(NPAIR + 256) * DFF * 2);
constexpr size_t OFF_OA = OFF_MIXO, OFF_HB = OFF_MIXO + (size_t)2 * NT * 256 * 4;


#define DEV __device__ __forceinline__
DEV int lane_asm() { int l; asm volatile("v_mbcnt_lo_u32_b32 %0, -1, 0\n\tv_mbcnt_hi_u32_b32 %0, -1, %0" : "=v"(l)); return l; }
DEV int tid_of(int wave_id) { return (wave_id << 6) | lane_asm(); }
DEV float wsum(float v) { for (int o = 32; o >= 1; o >>= 1) v += __shfl_xor(v, o); return v; }
DEV float wmaxf(float v) { for (int o = 32; o >= 1; o >>= 1) v = fmaxf(v, __shfl_xor(v, o)); return v; }
DEV float sigm(float x) { return 1.f / (1.f + expf(-x)); }
DEV float rdlane(float v, int l) { return __int_as_float(__builtin_amdgcn_readlane(__float_as_int(v), l)); }
DEV float lam_init_of(int layer) { return 0.8f - 0.6f * expf(-0.3f * (float)layer); }


#define XB_TMO      128
#define XB_XCNT(j)  (256  + 64 * (j))
#define XB_XSUB(j)  (1280 + 64 * (j))
#define XB_XGEN(j)  (2304 + 64 * (j))
#define XB_TOP      3328
#define XB_TOPGEN   3392
#define XCD_BAR_WORDS 3456
#define XB_SPIN_CAP (1u << 22)
#define LAS __attribute__((address_space(3)))
DEV unsigned xb_ld(unsigned* p)              { return __hip_atomic_load(p, __ATOMIC_RELAXED, __HIP_MEMORY_SCOPE_AGENT); }
DEV unsigned xb_add(unsigned* p, unsigned v) { return __hip_atomic_fetch_add(p, v, __ATOMIC_RELAXED, __HIP_MEMORY_SCOPE_AGENT); }
DEV unsigned xb_xcc_id() { return (unsigned)__builtin_amdgcn_s_getreg((3 << 11) | 20) & 0xFu; }
#define XB_SPIN(cond, bar) do { unsigned _sp = 0; while (cond) { __builtin_amdgcn_s_sleep(1); \
    if ((++_sp & 255u) == 0u) { if (xb_ld(&(bar)[XB_TMO])) break; if (_sp > XB_SPIN_CAP) { atomicAdd(&(bar)[XB_TMO], 1u); break; } } } } while (0)
struct XcdBarrier { unsigned* bar; unsigned x; volatile LAS unsigned* st; int wave; };
DEV bool xb_thread0(int wave) { return wave == 0 && lane_asm() == 0; }
DEV XcdBarrier xcd_barrier_post(unsigned* bar, volatile LAS unsigned* st, int wave) {
    XcdBarrier b; b.bar = bar; b.x = xb_xcc_id(); b.st = st; b.wave = wave;
    if (xb_thread0(wave)) (void)xb_add(&bar[XB_XCNT(b.x)], 1u);
    return b;
}
DEV void xcd_barrier_complete(unsigned* bar, unsigned x, unsigned& nloc, unsigned& nx) {
    const unsigned G = gridDim.x * gridDim.y * gridDim.z;
    unsigned sum, cnt, mine, sp = 0u;
    for (;;) {
        sum = 0u; cnt = 0u; mine = 0u;
#pragma unroll
        for (unsigned j = 0; j < 16; ++j) { const unsigned c = xb_ld(&bar[XB_XCNT(j)]); sum += c; cnt += (c > 0u) ? 1u : 0u; mine = (j == x) ? c : mine; }
        if (sum == G) break;
        __builtin_amdgcn_s_sleep(1);
        if ((++sp & 255u) == 0u) { if (xb_ld(&bar[XB_TMO])) break; if (sp > XB_SPIN_CAP) { atomicAdd(&bar[XB_TMO], 1u); break; } }
    }
    nloc = mine > 0u ? mine : 1u; nx = cnt > 0u ? cnt : 1u;
}
DEV void xcd_barrier(const XcdBarrier& b) {
    asm volatile("s_waitcnt vmcnt(0)" ::: "memory");
    __syncthreads();
    if (xb_thread0(b.wave)) {
        unsigned* bar = b.bar;
        __builtin_amdgcn_s_waitcnt(0);
        unsigned nloc = b.st[0], nx = b.st[1];
        if (nloc == 0u) { xcd_barrier_complete(bar, b.x, nloc, nx); b.st[0] = nloc; b.st[1] = nx; }
        const unsigned old = xb_add(&bar[XB_XSUB(b.x)], 1u);
        const unsigned gen = old / nloc;
        if (old + 1u == (gen + 1u) * nloc) {
            __builtin_amdgcn_fence(__ATOMIC_RELEASE, "agent");
            asm volatile("s_waitcnt vmcnt(0)" ::: "memory");
            const unsigned og = xb_add(&bar[XB_TOP], 1u);
            const unsigned tg = og / nx;
            if (og + 1u == (tg + 1u) * nx) xb_add(&bar[XB_TOPGEN], 1u);
            else XB_SPIN(xb_ld(&bar[XB_TOPGEN]) == tg, bar);
            __builtin_amdgcn_fence(__ATOMIC_ACQUIRE, "agent");
            xb_add(&bar[XB_XGEN(b.x)], 1u);
            asm volatile("s_waitcnt vmcnt(0)" ::: "memory");
        } else {
            XB_SPIN(xb_ld(&bar[XB_XGEN(b.x)]) == gen, bar);
            __builtin_amdgcn_fence(__ATOMIC_ACQUIRE, "agent");
            asm volatile("s_waitcnt vmcnt(0)" ::: "memory");
        }
    }
    __syncthreads();
}

typedef unsigned short bf16_t;
DEV unsigned cvt_pk_bf16(float lo, float hi) { unsigned r; asm volatile("v_cvt_pk_bf16_f32 %0, %1, %2" : "=v"(r) : "v"(lo), "v"(hi)); return r; }

namespace pg8 {
typedef short bf16x8 __attribute__((ext_vector_type(8)));
typedef float f32x4 __attribute__((ext_vector_type(4)));
typedef unsigned u32x4 __attribute__((ext_vector_type(4)));
typedef unsigned u32x2 __attribute__((ext_vector_type(2)));
constexpr int BM = 256, BK = 64, HALF = 128, HTB = HALF * BK * 2, STAGE_BYTES = 8 * HTB, NXCD = 8, WGM = 8;
DEV int lds_byte(int r, int c) { const int st = (r >> 4) * 2 + (c >> 5), rr = r & 15, cc = c & 31, ob = rr * 64 + cc * 2; return st * 1024 + (ob ^ (((ob >> 9) & 1) << 5)); }
DEV void stage_rc(int b, int& R, int& C) { const int st = b / 1024, sb = b % 1024, swz = sb ^ (((sb >> 9) & 1) << 5); R = (st >> 1) * 16 + swz / 64; C = (st & 1) * 32 + (swz % 64) / 2; }
DEV int perm32(int rho) { const int n = rho >> 4, i = rho & 15; return 8 * (i >> 2) + 4 * n + (i & 3); }
struct Unit { int pm, pn, e, t; };
struct StaticOrder {
    int nM, nN, nwg, G, c, skipctx; const char* Bt; int K;
    DEV void init(int nM_, int nN_, int G_, int c_, int skipctx_, const void* Bt_, int K_) { nM = nM_; nN = nN_; nwg = nM * nN; G = G_; c = c_; skipctx = skipctx_; Bt = (const char*)Bt_; K = K_; }
    DEV bool next(int i, Unit& u) const {
        const long L = (long)i * G + c; if (L >= nwg) return false;
        int wgid = (int)L; { const int q = nwg / NXCD, r = nwg % NXCD, xcd = wgid % NXCD, off = wgid / NXCD; wgid = (xcd < r ? xcd * (q + 1) : r * (q + 1) + (xcd - r) * q) + off; }
        const int nig = WGM * nN, gid = wgid / nig, fm = gid * WGM, gsz = (nM - fm) < WGM ? (nM - fm) : WGM;
        int pm = fm + ((wgid % nig) % gsz); u.pn = (wgid % nig) / gsz;
        if (skipctx) pm = (pm >> 3) * 9 + 1 + (pm & 7);
        u.pm = pm; u.e = 0; u.t = 0; return true;
    }
    DEV int arow(const Unit& u, int rr) const { return u.pm * BM + rr; }
    DEV const char* bbase(const Unit& u) const { return Bt + (size_t)u.pn * BM * K * 2; }
};
struct EpiF32 {
    static constexpr bool PERM = false;
    float* C; int ldc;
    DEV void operator()(const f32x4 (&acc)[2][2][4][2], const Unit& u, int wr, int wc, int fr, int fq) const {
        const int row0 = u.pm * BM + wr * 64 + fr, col0 = u.pn * BM + wc * 32 + 4 * fq;
#pragma unroll
        for (int ai = 0; ai < 2; ++ai)
#pragma unroll
            for (int m = 0; m < 4; ++m) { float* rowp = C + (size_t)(row0 + ai * HALF + m * 16) * ldc + col0;
#pragma unroll
                for (int bj = 0; bj < 2; ++bj)
#pragma unroll
                    for (int n = 0; n < 2; ++n) *(f32x4*)(rowp + bj * HALF + n * 16) = acc[ai][bj][m][n]; }
    }
};

template <class Epi, class Sched>
DEV void gemm_phase(LAS unsigned char* lds, const char* Abase, const int K, const Sched& S, const Epi& E, const int tid) {
    const int wid = __builtin_amdgcn_readfirstlane(tid >> 6), lane = tid & 63, wr = wid >> 2, wc = wid & 3, fr = lane & 15, fq = lane >> 4;
    const int nt = K / BK;
    unsigned voffB[2];
#pragma unroll
    for (int i = 0; i < 2; ++i) { int R, C; stage_rc(tid * 16 + i * 8192, R, C); const int Rb = Epi::PERM ? ((R & ~31) + perm32(R & 31)) : R;
        voffB[i] = (unsigned)(Rb * K + C) * 2u; }
    const size_t kstep = (size_t)(BK * 2);
    const size_t hstep = (size_t)HALF * K * 2;
    const unsigned ldsw = (unsigned)wid * 1024u;
    const int aoff = lds_byte(wr * 64 + fr, fq * 8), boff = lds_byte(wc * 32 + fr, fq * 8);
#define PG8_SA(b, h) (((b) * 2 + (h)) * HTB)
#define PG8_SB(b, h) ((4 + (b) * 2 + (h)) * HTB)
#define PG8_STAGE_B(bufoff, gbase) do { _Pragma("unroll") for (int _i = 0; _i < 2; ++_i) \
        __builtin_amdgcn_global_load_lds((const unsigned*)((const char*)(gbase) + voffB[_i]), (LAS unsigned*)(lds + (bufoff) + ldsw + _i * 8192), 16, 0, 0); } while (0)
#define PG8_STAGE_A(bufoff, kb, V, h) do { _Pragma("unroll") for (int _i = 0; _i < 2; ++_i) \
        __builtin_amdgcn_global_load_lds((const unsigned*)(Abase + (kb) + (V)[h][_i]), (LAS unsigned*)(lds + (bufoff) + ldsw + _i * 8192), 16, 0, 0); } while (0)
#define PG8_VOFFA(V, u) do { _Pragma("unroll") for (int _i = 0; _i < 2; ++_i) { int _R, _C; stage_rc(tid * 16 + _i * 8192, _R, _C); _Pragma("unroll") for (int _h = 0; _h < 2; ++_h) \
        (V)[_h][_i] = ((unsigned)S.arow(u, _h * HALF + _R) * (unsigned)K + (unsigned)_C) * 2u; } } while (0)
#define PG8_LDA(dst, b, h) do { _Pragma("unroll") for (int m = 0; m < 4; ++m) _Pragma("unroll") for (int k = 0; k < 2; ++k) dst[m][k] = *(const LAS bf16x8*)(lds + PG8_SA(b, h) + aoff + m * 2048 + k * 1024); } while (0)
#define PG8_LDB(dst, b, h) do { _Pragma("unroll") for (int n = 0; n < 2; ++n) _Pragma("unroll") for (int k = 0; k < 2; ++k) dst[n][k] = *(const LAS bf16x8*)(lds + PG8_SB(b, h) + boff + n * 2048 + k * 1024); } while (0)
#define PG8_MMA(ai, bj, At, Bt) do { __builtin_amdgcn_s_setprio(1); _Pragma("unroll") for (int m = 0; m < 4; ++m) _Pragma("unroll") for (int n = 0; n < 2; ++n) _Pragma("unroll") for (int k = 0; k < 2; ++k) \
        acc[ai][bj][m][n] = __builtin_amdgcn_mfma_f32_16x16x32_bf16(Bt[n][k], At[m][k], acc[ai][bj][m][n], 0, 0, 0); __builtin_amdgcn_s_setprio(0); } while (0)
#define PG8_WAIT_V(n) asm volatile("s_waitcnt vmcnt(" #n ")" ::: "memory")
#define PG8_WAIT_L(n) asm volatile("s_waitcnt lgkmcnt(" #n ")" ::: "memory")
#define PG8_BAR __builtin_amdgcn_s_barrier()
#define PG8_SCHED __builtin_amdgcn_sched_barrier(0)
    Unit cur, nxt; int ui = 0;
    if (!S.next(0, cur)) return;
    f32x4 acc[2][2][4][2];
#pragma unroll
    for (int a = 0; a < 2; ++a)
#pragma unroll
        for (int b = 0; b < 2; ++b)
#pragma unroll
            for (int m = 0; m < 4; ++m)
#pragma unroll
                for (int n = 0; n < 2; ++n) acc[a][b][m][n] = (f32x4){0.f, 0.f, 0.f, 0.f};
    bf16x8 At[4][2], B0[2][2], B1[2][2];
    unsigned vc[2][2], v2[2][2];
    PG8_VOFFA(vc, cur);
    const char* cB = S.bbase(cur);
    PG8_STAGE_B(PG8_SB(0, 0), cB); PG8_STAGE_A(PG8_SA(0, 0), 0, vc, 0); PG8_STAGE_B(PG8_SB(0, 1), cB + hstep); PG8_STAGE_A(PG8_SA(0, 1), 0, vc, 1);
    if (wr == 1) PG8_BAR;
    PG8_WAIT_V(4); PG8_BAR;
    PG8_STAGE_B(PG8_SB(1, 0), cB + kstep); PG8_STAGE_A(PG8_SA(1, 0), kstep, vc, 0); PG8_STAGE_B(PG8_SB(1, 1), cB + hstep + kstep);
    PG8_WAIT_V(6); PG8_BAR;
    for (;;) {
        const bool has_next = S.next(ui + 1, nxt);
        const char* nB = has_next ? S.bbase(nxt) : cB;
        for (int t = 0; t < nt; t += 2) {
            const bool last = (t == nt - 2);
            const size_t k1 = (size_t)(t + 1) * kstep, k2 = last ? (size_t)0 : (size_t)(t + 2) * kstep, k3 = k2 + kstep;
            if (last && has_next) { PG8_VOFFA(v2, nxt); } else {
#pragma unroll
                for (int h = 0; h < 2; ++h)
#pragma unroll
                    for (int i = 0; i < 2; ++i) v2[h][i] = vc[h][i]; }
            const char* b2 = last ? nB : cB + (size_t)(t + 2) * kstep; const char* b3 = b2 + kstep;
            PG8_LDB(B0, 0, 0); PG8_SCHED; PG8_LDA(At, 0, 0); PG8_STAGE_A(PG8_SA(1, 1), k1, vc, 1);
            PG8_WAIT_L(8); PG8_BAR; PG8_WAIT_L(0); PG8_MMA(0, 0, At, B0); PG8_BAR; PG8_SCHED;
            PG8_LDB(B1, 0, 1); PG8_STAGE_B(PG8_SB(0, 0), b2);
            PG8_BAR; PG8_WAIT_L(0); PG8_MMA(0, 1, At, B1); PG8_BAR;
            PG8_LDA(At, 0, 1); PG8_STAGE_A(PG8_SA(0, 0), k2, v2, 0);
            PG8_BAR; PG8_WAIT_L(0); PG8_MMA(1, 0, At, B0); PG8_BAR; PG8_SCHED;
            PG8_STAGE_B(PG8_SB(0, 1), b2 + hstep);
            PG8_WAIT_V(6); PG8_BAR; PG8_MMA(1, 1, At, B1); PG8_BAR;
            PG8_LDB(B0, 1, 0); PG8_SCHED; PG8_LDA(At, 1, 0); PG8_STAGE_A(PG8_SA(0, 1), k2, v2, 1);
            PG8_WAIT_L(8); PG8_BAR; PG8_WAIT_L(0); PG8_MMA(0, 0, At, B0); PG8_BAR; PG8_SCHED;
            PG8_LDB(B1, 1, 1); PG8_STAGE_B(PG8_SB(1, 0), b3);
            PG8_BAR; PG8_WAIT_L(0); PG8_MMA(0, 1, At, B1); PG8_BAR;
            PG8_LDA(At, 1, 1); PG8_STAGE_A(PG8_SA(1, 0), k3, v2, 0);
            PG8_BAR; PG8_WAIT_L(0); PG8_MMA(1, 0, At, B0); PG8_BAR; PG8_SCHED;
            PG8_STAGE_B(PG8_SB(1, 1), b3 + hstep);
            PG8_WAIT_V(6); PG8_BAR; PG8_MMA(1, 1, At, B1); PG8_BAR;
        }
        E(acc, cur, wr, wc, fr, fq);
        if (!has_next) break;
#pragma unroll
        for (int a = 0; a < 2; ++a)
#pragma unroll
            for (int b = 0; b < 2; ++b)
#pragma unroll
                for (int m = 0; m < 4; ++m)
#pragma unroll
                    for (int n = 0; n < 2; ++n) acc[a][b][m][n] = (f32x4){0.f, 0.f, 0.f, 0.f};
        cur = nxt; cB = nB; ++ui;
#pragma unroll
        for (int h = 0; h < 2; ++h)
#pragma unroll
            for (int i = 0; i < 2; ++i) vc[h][i] = v2[h][i];
    }
    PG8_WAIT_V(0);
    if (wr == 0) PG8_BAR;
    PG8_BAR;
#undef PG8_SA
#undef PG8_SB
#undef PG8_STAGE_A
#undef PG8_STAGE_B
#undef PG8_VOFFA
#undef PG8_LDA
#undef PG8_LDB
#undef PG8_MMA
#undef PG8_WAIT_V
#undef PG8_WAIT_L
#undef PG8_BAR
#undef PG8_SCHED
}
}


namespace att {
using bf16x8 = __attribute__((ext_vector_type(8))) short;
using s16x4  = __attribute__((ext_vector_type(4))) short;
using f32x16 = __attribute__((ext_vector_type(16))) float;
using u32x4  = __attribute__((ext_vector_type(4))) unsigned;
constexpr int KVBLK = 64, LDK = 128;
constexpr int SHM_V = KVBLK * 128 * 2, SHM_K = KVBLK * 128 * 2, SHM_ATTN = 2 * SHM_V + 2 * SHM_K + 8 * 64 * 4;
constexpr float THR = 8.f;
#define KSWZ(row, colB) ((row) * 256 + ((colB) ^ (((row) & 7) << 4)))
#define SBAR() __builtin_amdgcn_sched_barrier(0)
DEV int crow(int r, int hi) { return (r & 3) + 8 * (r >> 2) + 4 * hi; }
DEV void partialSM(f32x16& p0, f32x16& p1, float& m_reg, float& mn, float& alpha) {
  float pmax = p0[0]; for (int r = 1; r < 16; ++r) pmax = fmaxf(pmax, p0[r]); for (int r = 0; r < 16; ++r) pmax = fmaxf(pmax, p1[r]);
  { auto rr = __builtin_amdgcn_permlane32_swap(__float_as_uint(pmax), __float_as_uint(pmax), false, false);
    pmax = fmaxf(__uint_as_float(rr[0]), __uint_as_float(rr[1])); }
  if (__builtin_expect(__all(pmax - m_reg <= THR), 1)) { mn = m_reg; alpha = 1.f; }
  else { mn = fmaxf(m_reg, pmax); alpha = __builtin_amdgcn_exp2f(m_reg - mn); m_reg = mn; }
  for (int r = 0; r < 16; ++r) p0[r] = p0[r] - mn; for (int r = 0; r < 16; ++r) p1[r] = p1[r] - mn;
  for (int r = 0; r < 16; ++r) p0[r] = __builtin_amdgcn_exp2f(p0[r]);
}
DEV void finishSM(f32x16& p0, f32x16& p1, float alpha, float& l_reg, bf16x8& pa0, bf16x8& pa1, bf16x8& pa2, bf16x8& pa3) {
  for (int r = 0; r < 16; ++r) p1[r] = __builtin_amdgcn_exp2f(p1[r]);
  float ps = 0; for (int r = 0; r < 16; ++r) ps += p0[r]; for (int r = 0; r < 16; ++r) ps += p1[r];
  { auto rr = __builtin_amdgcn_permlane32_swap(__float_as_uint(ps), __float_as_uint(ps), false, false);
    ps = __uint_as_float(rr[0]) + __uint_as_float(rr[1]); }
  l_reg = l_reg * alpha + ps;
#define PK4(P, BASE, OUT) do { unsigned a0 = cvt_pk_bf16(P[BASE + 0], P[BASE + 1]), a1 = cvt_pk_bf16(P[BASE + 2], P[BASE + 3]);   \
    unsigned b0 = cvt_pk_bf16(P[BASE + 4], P[BASE + 5]), b1 = cvt_pk_bf16(P[BASE + 6], P[BASE + 7]);                              \
    auto r0 = __builtin_amdgcn_permlane32_swap(a0, b0, false, false); auto r1 = __builtin_amdgcn_permlane32_swap(a1, b1, false, false); \
    u32x4 w = {r0[0], r1[0], r0[1], r1[1]}; OUT = *reinterpret_cast<bf16x8*>(&w); } while (0)
  PK4(p0, 0, pa0); PK4(p0, 8, pa1); PK4(p1, 0, pa2); PK4(p1, 8, pa3);
#undef PK4
}
DEV void qkt(f32x16& p0, f32x16& p1, const char* Ks, const bf16x8 (&qr)[4], int r32, int hi, int js) {
  p0 = f32x16{}; p1 = f32x16{};
#pragma unroll
  for (int d0 = 0; d0 < 4; ++d0) { const int cb = ((js * 4 + d0) * 16 + hi * 8) * 2;
    bf16x8 b0 = *reinterpret_cast<const bf16x8*>(Ks + KSWZ(r32, cb));
    bf16x8 b1 = *reinterpret_cast<const bf16x8*>(Ks + KSWZ(32 + r32, cb));
    p0 = __builtin_amdgcn_mfma_f32_32x32x16_bf16(b0, qr[d0], p0, 0, 0, 0);
    p1 = __builtin_amdgcn_mfma_f32_32x32x16_bf16(b1, qr[d0], p1, 0, 0, 0); }
}
DEV int v_st(int k, int c) { const int kk = (k & ~0xC) | ((k & 4) << 1) | ((k & 8) >> 1); return ((kk >> 3) * 4 + (c >> 5)) * 512 + ((kk & 7) * 32 + (c & 31)) * 2; }
DEV int v_rd_base(int lane) { return ((lane & 3) << 3) | (((lane >> 2) & 3) << 6) | (((lane >> 4) & 1) << 5) | (((lane >> 5) & 1) << 8); }
constexpr int v_rd_off(int d0, int ks, int half) { return d0 * 512 + ks * 4096 + half * 2048; }
template <int OFF> DEV s16x4 tr_read(int vb) {
  s16x4 r; asm volatile("ds_read_b64_tr_b16 %0, %1 offset:%2" : "=&v"(r) : "v"(vb), "i"(OFF) : "memory"); return r;
}
template <int D0> DEV void pv_one(f32x16& od, int vb, bf16x8 pa0, bf16x8 pa1, bf16x8 pa2, bf16x8 pa3) {
  const s16x4 l0 = tr_read<v_rd_off(D0, 0, 0)>(vb), h0 = tr_read<v_rd_off(D0, 0, 1)>(vb), l1 = tr_read<v_rd_off(D0, 1, 0)>(vb), h1 = tr_read<v_rd_off(D0, 1, 1)>(vb);
  const s16x4 l2 = tr_read<v_rd_off(D0, 2, 0)>(vb), h2 = tr_read<v_rd_off(D0, 2, 1)>(vb), l3 = tr_read<v_rd_off(D0, 3, 0)>(vb), h3 = tr_read<v_rd_off(D0, 3, 1)>(vb);
  asm volatile("s_waitcnt lgkmcnt(0)" ::: "memory"); SBAR();
#define PK(L, H) (bf16x8){L[0], L[1], L[2], L[3], H[0], H[1], H[2], H[3]}
  od = __builtin_amdgcn_mfma_f32_32x32x16_bf16(pa0, PK(l0, h0), od, 0, 0, 0);
  od = __builtin_amdgcn_mfma_f32_32x32x16_bf16(pa1, PK(l1, h1), od, 0, 0, 0);
  od = __builtin_amdgcn_mfma_f32_32x32x16_bf16(pa2, PK(l2, h2), od, 0, 0, 0);
  od = __builtin_amdgcn_mfma_f32_32x32x16_bf16(pa3, PK(l3, h3), od, 0, 0, 0);
#undef PK
}
DEV void pv_d0(f32x16* o, int vb, bf16x8 pa0, bf16x8 pa1, bf16x8 pa2, bf16x8 pa3) {
  pv_one<0>(o[0], vb, pa0, pa1, pa2, pa3); pv_one<1>(o[1], vb, pa0, pa1, pa2, pa3); pv_one<2>(o[2], vb, pa0, pa1, pa2, pa3); pv_one<3>(o[3], vb, pa0, pa1, pa2, pa3);
}
DEV void attn_tiles(const bf16x8 (&qr)[4], const bf16_t* __restrict__ Kh, const bf16_t* __restrict__ Vh, int seq, char* lds,
                    float& m_reg, float& l_reg, f32x16 (&o)[4], int tid, int js) {
  const int wid = tid >> 6, lane = tid & 63, r32 = lane & 31, hi = lane >> 5;
  char* V_lds = lds; char* K_lds = lds + 2 * SHM_V;
  float* ws = (float*)(lds + 2 * SHM_V + 2 * SHM_K) + wid * 64; float* al_l = ws + 32;
  const int sr = tid >> 4, sc = (tid & 15) * 8, vst0 = v_st(sr, sc), vst1 = v_st(32 + sr, sc);
  const int vb0 = (int)(uintptr_t)V_lds + v_rd_base(lane);
  struct { bf16x8 vs0, vs1, ks0, ks1; } sr_[2];
  const unsigned lo0 = (unsigned)((sr * LDK + sc) * 2), lo1 = lo0 + 32u * LDK * 2u;
#define SLOAD(i, k0) do { const char* vb_ = (const char*)Vh + (size_t)(k0) * (LDK * 2); const char* kb_ = (const char*)Kh + (size_t)(k0) * (LDK * 2); \
    sr_[i].vs0 = *(const bf16x8*)(vb_ + lo0); sr_[i].vs1 = *(const bf16x8*)(vb_ + lo1); sr_[i].ks0 = *(const bf16x8*)(kb_ + lo0); sr_[i].ks1 = *(const bf16x8*)(kb_ + lo1); } while (0)
#define SWRITE(b, i) do { *(bf16x8*)(V_lds + (b) * SHM_V + vst0) = sr_[i].vs0;          \
    *(bf16x8*)(V_lds + (b) * SHM_V + vst1) = sr_[i].vs1; int kc = sc * 2;               \
    *(bf16x8*)(K_lds + (b) * SHM_K + KSWZ(sr, kc)) = sr_[i].ks0;                       \
    *(bf16x8*)(K_lds + (b) * SHM_K + KSWZ(32 + sr, kc)) = sr_[i].ks1; } while (0)
#define SWAIT() asm volatile("s_waitcnt vmcnt(4)" ::: "memory")
#define RESC(a) do { if (__any((a) < 1.f)) { if (hi == 0) al_l[r32] = (a); asm volatile("s_waitcnt lgkmcnt(0)" ::: "memory"); \
    for (int d = 0; d < 4; ++d) for (int r = 0; r < 16; ++r) o[d][r] *= al_l[crow(r, hi)]; } } while (0)
  f32x16 pA0, pA1, pB0, pB1; float mnA, mnB, alA, alB; bf16x8 pa0, pa1, pa2, pa3; const int NTL = seq / KVBLK;
  constexpr int SE = 0, SO = 1;
  __syncthreads();
  SLOAD(SE, 0); asm volatile("s_waitcnt vmcnt(0)" ::: "memory"); SWRITE(0, SE); __syncthreads();
  qkt(pA0, pA1, K_lds, qr, r32, hi, js); partialSM(pA0, pA1, m_reg, mnA, alA);
  SLOAD(SO, KVBLK); if (2 < NTL) SLOAD(SE, 2 * KVBLK);
  SWAIT(); SWRITE(1, SO); __syncthreads();
  RESC(alA);
  for (int j = 1; j + 1 < NTL; j += 2) {
    SBAR(); qkt(pB0, pB1, K_lds + SHM_K, qr, r32, hi, js);
    finishSM(pA0, pA1, alA, l_reg, pa0, pa1, pa2, pa3); SBAR();
    SLOAD(SO, (j + 2) * KVBLK); SBAR();
    pv_d0(o, vb0, pa0, pa1, pa2, pa3); partialSM(pB0, pB1, m_reg, mnB, alB);
    __syncthreads(); SWAIT(); SWRITE(0, SE);
    RESC(alB); __syncthreads();
    SBAR(); qkt(pA0, pA1, K_lds, qr, r32, hi, js);
    finishSM(pB0, pB1, alB, l_reg, pa0, pa1, pa2, pa3); SBAR();
    if (j + 3 < NTL) SLOAD(SE, (j + 3) * KVBLK); SBAR();
    pv_d0(o, vb0 + SHM_V, pa0, pa1, pa2, pa3); partialSM(pA0, pA1, m_reg, mnA, alA);
    __syncthreads(); SWAIT(); SWRITE(1, SO);
    RESC(alA); __syncthreads();
  }
  SBAR(); qkt(pB0, pB1, K_lds + SHM_K, qr, r32, hi, js);
  finishSM(pA0, pA1, alA, l_reg, pa0, pa1, pa2, pa3); SBAR();
  pv_d0(o, vb0, pa0, pa1, pa2, pa3); partialSM(pB0, pB1, m_reg, mnB, alB);
  __syncthreads(); RESC(alB);
  finishSM(pB0, pB1, alB, l_reg, pa0, pa1, pa2, pa3); SBAR();
  pv_d0(o, vb0 + SHM_V, pa0, pa1, pa2, pa3);
#undef SLOAD
#undef SWRITE
#undef SWAIT
#undef RESC
}
}

DEV void cvt_tile(const float* src, int ld, int nvalid, bf16_t* dst, int K, int n0, int k0, float* T, const int t) {
#pragma unroll
    for (int h = 0; h < 2; ++h) {
        const int kk = (t >> 4) + 32 * h, nq = (t & 15) * 4, n = n0 + nq;
        const float4 v = n < nvalid ? *(const float4*)(src + (size_t)(k0 + kk) * ld + n) : make_float4(0.f, 0.f, 0.f, 0.f);
        T[(nq + 0) * 65 + kk] = v.x; T[(nq + 1) * 65 + kk] = v.y; T[(nq + 2) * 65 + kk] = v.z; T[(nq + 3) * 65 + kk] = v.w;
    }
    __syncthreads();
    { const int n = t >> 3, kq = (t & 7) * 8; const float* r = T + n * 65 + kq;
      pg8::u32x4 w; w.x = cvt_pk_bf16(r[0], r[1]); w.y = cvt_pk_bf16(r[2], r[3]); w.z = cvt_pk_bf16(r[4], r[5]); w.w = cvt_pk_bf16(r[6], r[7]);
      *(pg8::u32x4*)(dst + (size_t)(n0 + n) * K + k0 + kq) = w; }
    __syncthreads();
}
DEV void ph_convert(const Params& p, char* smem) {
    const int tidx = tid_of(p.wave_id);
    float* T = (float*)smem;
    constexpr int T_IN = 2 * 60 * 16, T_OUT = 2 * 16 * 16, T_W1 = 64 * 32 * 16, T_W2 = 64 * 16 * 16;
    for (int u = blockIdx.x; u < T_IN + T_OUT + T_W1 + T_W2; u += gridDim.x) {
        if (u < T_IN) { const int l = u / 960, r = u % 960, nt = r >> 4, kt = r & 15;
            cvt_tile(p.w_in + (size_t)l * D * DPW, DPW, DPW, (bf16_t*)(p.ws + OFF_WIN) + (size_t)l * DP * D, D, nt * 64, kt * 64, T, tidx); }
        else if (u < T_IN + T_OUT) { const int v = u - T_IN, l = v >> 8, r = v & 255, nt = r >> 4, kt = r & 15;
            cvt_tile(p.w_out + (size_t)l * D * D, D, D, (bf16_t*)(p.ws + OFF_WOUT) + (size_t)l * D * D, D, nt * 64, kt * 64, T, tidx); }
        else if (u < T_IN + T_OUT + T_W1) { const int v = u - T_IN - T_OUT, le = v >> 9, r = v & 511, nt = r >> 4, kt = r & 15;
            cvt_tile(p.w1 + (size_t)le * D * 2048, 2048, 2048, (bf16_t*)(p.ws + OFF_W1T) + (size_t)le * 2048 * D, D, nt * 64, kt * 64, T, tidx); }
        else { const int v = u - T_IN - T_OUT - T_W1, le = v >> 8, r = v & 255, nt = r >> 4, kt = r & 15;
            cvt_tile(p.w2 + (size_t)le * DFF * D, D, D, (bf16_t*)(p.ws + OFF_W2T) + (size_t)le * D * DFF, DFF, nt * 64, kt * 64, T, tidx); }
    }
}

DEV void row_load(const float* src, float4 (&v)[4], int lane) {
#pragma unroll
    for (int i = 0; i < 4; ++i) v[i] = *(const float4*)(src + i * 256 + lane * 4);
}
DEV void row_store(float* dst, const float4 (&v)[4], int lane) {
#pragma unroll
    for (int i = 0; i < 4; ++i) *(float4*)(dst + i * 256 + lane * 4) = v[i];
}
DEV void row_store_bf16(bf16_t* dst, const float4 (&v)[4], int lane) {
#pragma unroll
    for (int i = 0; i < 4; ++i) { pg8::u32x2 w; w.x = cvt_pk_bf16(v[i].x, v[i].y); w.y = cvt_pk_bf16(v[i].z, v[i].w); *(pg8::u32x2*)(dst + i * 256 + lane * 4) = w; }
}
DEV float row_rinv(const float4 (&v)[4]) {
    float ss = 0.f;
#pragma unroll
    for (int i = 0; i < 4; ++i) ss += v[i].x * v[i].x + v[i].y * v[i].y + v[i].z * v[i].z + v[i].w * v[i].w;
    ss = wsum(ss);
    return rsqrtf(ss * (1.f / 1024.f) + 1e-6f);
}
DEV void row_modnorm(const float4 (&v)[4], const float* gain, const float* shift, const float* scale, float4 (&o)[4], int lane) {
    const float r = row_rinv(v);
#pragma unroll
    for (int i = 0; i < 4; ++i) {
        const int idx = i * 256 + lane * 4;
        const float4 g = *(const float4*)(gain + idx), sh = *(const float4*)(shift + idx), sc = *(const float4*)(scale + idx);
        o[i].x = v[i].x * r * g.x * (1.f + sc.x) + sh.x; o[i].y = v[i].y * r * g.y * (1.f + sc.y) + sh.y;
        o[i].z = v[i].z * r * g.z * (1.f + sc.z) + sh.z; o[i].w = v[i].w * r * g.w * (1.f + sc.w) + sh.w;
    }
}
DEV const float* modrow(const Params& p, int layer, int b, int s) { return ((float*)(p.ws + OFF_MOD)) + ((size_t)layer * 9 + (s < CTX ? 8 : b)) * 6144; }

DEV void ph_mods(const Params& p, char* smem) {
    const int tidx = tid_of(p.wave_id);
    float (*cond)[1024] = (float (*)[1024])smem;
    float (*red)[9][64] = (float (*)[9][64])(smem + 9 * 1024 * 4);
    const int tid = tidx;
    for (int i = tid; i < 9 * 1024; i += 512) { const int r = i >> 10, k = i & 1023; const float c = r < 8 ? p.c[r * 1024 + k] : p.c_ctx[k]; cond[r][k] = c * sigm(c); }
    __syncthreads();
    for (int u = blockIdx.x; u < 192; u += gridDim.x) {
        const int layer = u / 96, cg = u % 96, jj = tid & 63, ks = tid >> 6, j = cg * 64 + jj;
        float acc[9];
#pragma unroll
        for (int r = 0; r < 9; ++r) acc[r] = 0.f;
        const float* w = p.ada_w + (size_t)layer * 1024 * 6144 + j;
        for (int k = ks * 128; k < ks * 128 + 128; ++k) { const float wv = w[(size_t)k * 6144];
#pragma unroll
            for (int r = 0; r < 9; ++r) acc[r] += cond[r][k] * wv; }
#pragma unroll
        for (int r = 0; r < 9; ++r) red[ks][r][jj] = acc[r];
        __syncthreads();
        for (int t = tid; t < 9 * 64; t += 512) { const int r = t >> 6, q = t & 63; float s = 0.f; for (int z = 0; z < 8; ++z) s += red[z][r][q];
            ((float*)(p.ws + OFF_MOD))[((size_t)layer * 9 + r) * 6144 + cg * 64 + q] = s + p.ada_b[layer * 6144 + cg * 64 + q]; }
        __syncthreads();
    }
    if (blockIdx.x == 0) {
        for (int t = tid; t < 1024; t += 512) { const int layer = t >> 9, dir = (t >> 8) & 1, w = t & 255;
            const float t0 = p.hlb[(dir * 2 + 0) * 256 + w], t1 = p.hlb[(dir * 2 + 1) * 256 + w];
            const float mx = fmaxf(t0, t1), e0 = expf(t0 - mx), e1 = expf(t1 - mx);
            float lb = layer == 0 ? 0.f : e1 / (e0 + e1); lb = fminf(fmaxf(lb, 0.f), 1.f);
            ((float*)(p.ws + OFF_LB))[(layer * 2 + dir) * 256 + w] = lb; }
        if (tid < 128) { const int layer = tid >> 6, lane = tid & 63; const float* L = p.dlam + layer * 256;
            const float s1 = wsum(L[lane] * L[64 + lane]), s2 = wsum(L[128 + lane] * L[192 + lane]);
            if (lane == 0) ((float*)(p.ws + OFF_LAM))[layer] = expf(s1) - expf(s2) + lam_init_of(layer); }
    }
}

DEV void ph_init(const Params& p, char* smem) {
    const int tidx = tid_of(p.wave_id);
    const int wid = tidx >> 6, lane = tidx & 63;
    for (int r = blockIdx.x * 8 + wid; r < NT; r += gridDim.x * 8) {
        const int b = r / SL, s = r % SL;
        const float* src = s < CTX ? p.ctx + ((size_t)b * CTX + s) * D : p.x + ((size_t)b * SEQ + (s - CTX)) * D;
        float4 v[4], o[4]; row_load(src, v, lane); row_store(((float*)(p.ws + OFF_X)) + (size_t)r * D, v, lane);
        const float* m = modrow(p, 0, b, s);
        row_modnorm(v, p.norms + 0, m + 0, m + 1024, o, lane);
        row_store_bf16((bf16_t*)(p.ws + OFF_XNB) + (size_t)r * D, o, lane);
    }
}

DEV void ph_inproj(const Params& p, int layer, char* smem) {
    const int tidx = tid_of(p.wave_id);
    pg8::StaticOrder S; S.init(NT / 256, DP / 256, (int)gridDim.x, (int)blockIdx.x, 0, (const bf16_t*)(p.ws + OFF_WIN) + (size_t)layer * DP * D, D);
    pg8::EpiF32 E{(float*)(p.ws + OFF_P), DP};
    pg8::gemm_phase(( LAS unsigned char*)smem, (const char*)(p.ws + OFF_XNB), D, S, E, tid_of(p.wave_id));
}

DEV int scan_token(int dir, int step) { return dir == 0 ? step : (step < CTX ? CTX - 1 - step : SL + CTX - 1 - step); }
DEV float logsig(float g) { return fminf(g, 0.f) - log1pf(expf(-fabsf(g))); }
DEV void ph_scan_local(const Params& p, int layer, char* smem) {
    const int tid = tid_of(p.wave_id), wid = tid >> 6, lane = tid & 63;
    float* L = (float*)(smem + wid * 16384);
    const float* P = (const float*)(p.ws + OFF_P);
    const int gw = (int)blockIdx.x * 8 + wid, nw = (int)gridDim.x * 8;
    for (int task = gw; task < 4608; task += nw) {
        const bool isB = task >= 2304; const int tt = isB ? task - 2304 : task, chain = tt / 36, c = tt % 36, b = chain >> 3, h = (chain >> 1) & 3, dir = chain & 1;
        if (!isB) {
            float S[64];
#pragma unroll
            for (int k = 0; k < 64; ++k) S[k] = 0.f;
            float decp = 1.f;
            const float lbv = ((const float*)(p.ws + OFF_LB))[(layer * 2 + dir) * 256 + h * 64 + lane];
            float* out = (float*)(p.ws + OFF_OA) + (size_t)dir * NT * 256 + h * 64 + lane;
#pragma unroll 1
            for (int sub = 0; sub < 4; ++sub) {
#pragma unroll
                for (int i = 0; i < 16; ++i) {
                    const int s = scan_token(dir, c * 64 + sub * 16 + i);
                    const float* row = P + (size_t)(b * SL + s) * DP;
                    float q = row[O_AQ + h * 64 + lane]; q = q * sigm(q);
                    const float fp = row[(dir ? O_AFB : O_AFF) + h * 64 + lane];
                    const float f = fmaxf(lbv + (1.f - lbv) * sigm(fp), 1e-12f), kk = (1.f - lbv) * sigm(-fp);
                    L[i * 64 + lane] = f; L[1024 + i * 64 + lane] = kk; L[2048 + i * 64 + lane] = q; L[3072 + i * 64 + lane] = row[O_AI + h * 64 + lane];
                    decp *= f;
                }
#pragma unroll 1
                for (int i = 0; i < 16; ++i) {
                    float o = 0.f; const float vv = L[3072 + i * 64 + lane];
#pragma unroll
                    for (int kq = 0; kq < 16; ++kq) {
                        const float4 f4 = *(const float4*)&L[i * 64 + 4 * kq], k4 = *(const float4*)&L[1024 + i * 64 + 4 * kq], q4 = *(const float4*)&L[2048 + i * 64 + 4 * kq];
                        S[4 * kq + 0] = f4.x * S[4 * kq + 0] + k4.x * vv; o += S[4 * kq + 0] * q4.x;
                        S[4 * kq + 1] = f4.y * S[4 * kq + 1] + k4.y * vv; o += S[4 * kq + 1] * q4.y;
                        S[4 * kq + 2] = f4.z * S[4 * kq + 2] + k4.z * vv; o += S[4 * kq + 2] * q4.z;
                        S[4 * kq + 3] = f4.w * S[4 * kq + 3] + k4.w * vv; o += S[4 * kq + 3] * q4.w;
                    }
                    const int s = scan_token(dir, c * 64 + sub * 16 + i);
                    out[(size_t)(b * SL + s) * 256] = o;
                }
            }
            float* U = (float*)(p.ws + OFF_UA) + ((size_t)chain * 36 + c) * 4096;
#pragma unroll
            for (int k = 0; k < 64; ++k) U[k * 64 + lane] = S[k];
            ((float*)(p.ws + OFF_DECA))[(chain * 36 + c) * 64 + lane] = decp;
        } else {
            float C[32], n[32];
#pragma unroll
            for (int k = 0; k < 32; ++k) { C[k] = 0.f; n[k] = 0.f; }
            float m = -1e30f, cumf = 0.f;
            const float bi = p.mgb[layer * 16 + (dir * 2 + 0) * 4 + h], bf = p.mgb[layer * 16 + (dir * 2 + 1) * 4 + h];
            float* out = (float*)(p.ws + OFF_HB) + (size_t)dir * NT * 256 + h * 64 + lane;
            float* sc = (float*)(p.ws + OFF_SCB) + (size_t)dir * NT * 16 + h * 4;
#pragma unroll 1
            for (int sub = 0; sub < 4; ++sub) {
#pragma unroll
                for (int i = 0; i < 16; ++i) {
                    const int s = scan_token(dir, c * 64 + sub * 16 + i);
                    const float* row = P + (size_t)(b * SL + s) * DP;
                    const float qk = lane < 32 ? row[O_BQ + h * 32 + lane] * 0.17677669529663687f : row[O_BK + h * 32 + lane - 32];
                    L[i * 64 + lane] = qk; L[1024 + i * 64 + lane] = row[O_BV + h * 64 + lane];
                    const float li = row[O_BG + (dir * 2 + 0) * 4 + h] + bi, lf = logsig(row[O_BG + (dir * 2 + 1) * 4 + h] + bf);
                    cumf += lf;
                    const float mn = fmaxf(lf + m, li), a = expf(lf + m - mn), bc = expf(li - mn);
                    m = mn;
                    if (lane == 0) *(float4*)&L[2048 + i * 4] = make_float4(a, bc, m, cumf);
                }
#pragma unroll 1
                for (int i = 0; i < 16; ++i) {
                    const float4 g4 = *(const float4*)&L[2048 + i * 4]; const float a = g4.x, bc = g4.y, vv = L[1024 + i * 64 + lane];
                    float num = 0.f, den = 0.f;
#pragma unroll
                    for (int kq = 0; kq < 8; ++kq) {
                        const float4 q4 = *(const float4*)&L[i * 64 + 4 * kq], k4 = *(const float4*)&L[i * 64 + 32 + 4 * kq];
                        const float kb0 = bc * k4.x, kb1 = bc * k4.y, kb2 = bc * k4.z, kb3 = bc * k4.w;
                        C[4 * kq + 0] = a * C[4 * kq + 0] + kb0 * vv; n[4 * kq + 0] = a * n[4 * kq + 0] + kb0; num += C[4 * kq + 0] * q4.x; den += n[4 * kq + 0] * q4.x;
                        C[4 * kq + 1] = a * C[4 * kq + 1] + kb1 * vv; n[4 * kq + 1] = a * n[4 * kq + 1] + kb1; num += C[4 * kq + 1] * q4.y; den += n[4 * kq + 1] * q4.y;
                        C[4 * kq + 2] = a * C[4 * kq + 2] + kb2 * vv; n[4 * kq + 2] = a * n[4 * kq + 2] + kb2; num += C[4 * kq + 2] * q4.z; den += n[4 * kq + 2] * q4.z;
                        C[4 * kq + 3] = a * C[4 * kq + 3] + kb3 * vv; n[4 * kq + 3] = a * n[4 * kq + 3] + kb3; num += C[4 * kq + 3] * q4.w; den += n[4 * kq + 3] * q4.w;
                    }
                    const int s = scan_token(dir, c * 64 + sub * 16 + i);
                    const size_t r = (size_t)(b * SL + s);
                    out[r * 256] = num;
                    if (lane == 0) *(float4*)(sc + r * 16) = make_float4(den, g4.z, g4.w, 0.f);
                }
            }
            float* U = (float*)(p.ws + OFF_UB) + ((size_t)chain * 36 + c) * 2048;
#pragma unroll
            for (int k = 0; k < 32; ++k) U[k * 64 + lane] = C[k];
            if (lane == 0) {
                float* N = (float*)(p.ws + OFF_NB) + (chain * 36 + c) * 32;
#pragma unroll
                for (int k = 0; k < 32; ++k) N[k] = n[k];
                float* M = (float*)(p.ws + OFF_MB) + (chain * 36 + c) * 4; M[0] = m; M[1] = cumf;
            }
        }
    }
}
DEV void ph_scan_carry(const Params& p, char* smem) {
    const int tid = tid_of(p.wave_id);
    const int gt = (int)blockIdx.x * 512 + tid, nth = (int)gridDim.x * 512;
    for (int e = gt; e < 64 * 4096; e += nth) {
        const int chain = e >> 12, kv = e & 4095, k = kv >> 6;
        float* U = (float*)(p.ws + OFF_UA) + (size_t)chain * 36 * 4096 + kv; const float* Dc = (const float*)(p.ws + OFF_DECA) + chain * 36 * 64 + k;
        float S = 0.f;
#pragma unroll 4
        for (int c = 0; c < 36; ++c) { const float u = U[(size_t)c * 4096], d = Dc[c * 64]; U[(size_t)c * 4096] = S; S = d * S + u; }
    }
    for (int e = gt; e < 64 * 2048; e += nth) {
        const int chain = e >> 11, kv = e & 2047;
        float* U = (float*)(p.ws + OFF_UB) + (size_t)chain * 36 * 2048 + kv; const float* M = (const float*)(p.ws + OFF_MB) + chain * 36 * 4;
        float Cc = 0.f, m = 0.f;
#pragma unroll 4
        for (int c = 0; c < 36; ++c) { const float mle = M[c * 4 + 0], ce = M[c * 4 + 1], u = U[(size_t)c * 2048]; U[(size_t)c * 2048] = Cc;
            const float mn = fmaxf(ce + m, mle); Cc = expf(ce + m - mn) * Cc + expf(mle - mn) * u; m = mn; }
    }
    for (int e = gt; e < 64 * 32; e += nth) {
        const int chain = e >> 5, k = e & 31;
        float* N = (float*)(p.ws + OFF_NB) + chain * 36 * 32 + k; float* M = (float*)(p.ws + OFF_MB) + chain * 36 * 4;
        float nn = 0.f, m = 0.f;
        for (int c = 0; c < 36; ++c) { const float mle = M[c * 4 + 0], ce = M[c * 4 + 1], u = N[c * 32]; N[c * 32] = nn; if (k == 0) M[c * 4 + 2] = m;
            const float mn = fmaxf(ce + m, mle); nn = expf(ce + m - mn) * nn + expf(mle - mn) * u; m = mn; }
    }
}
DEV void ph_scan_out(const Params& p, int layer, char* smem) {
    const int tid = tid_of(p.wave_id), wid = tid >> 6, lane = tid & 63;
    float* L = (float*)(smem + wid * 16384);
    const float* P = (const float*)(p.ws + OFF_P);
    const int gw = (int)blockIdx.x * 8 + wid, nw = (int)gridDim.x * 8;
    for (int task = gw; task < 2304; task += nw) {
        const bool isB = task >= 1152; const int tt = isB ? task - 1152 : task, bh = tt / 36, tc = tt % 36, b = bh >> 2, h = bh & 3;
        if (layer != 0 && tc < 4) continue;
        if (!isB) {
            float* oa0 = (float*)(p.ws + OFF_OA); float* oa1 = oa0 + (size_t)NT * 256;
#pragma unroll 1
            for (int dir = 1; dir >= 0; --dir) {
                const int chain = bh * 2 + dir, c = dir == 0 ? tc : (tc < 4 ? 3 - tc : 39 - tc);
                const float* U = (const float*)(p.ws + OFF_UA) + ((size_t)chain * 36 + c) * 4096;
                float S0[64];
#pragma unroll
                for (int k = 0; k < 64; ++k) S0[k] = U[k * 64 + lane];
                const float lbv = ((const float*)(p.ws + OFF_LB))[(layer * 2 + dir) * 256 + h * 64 + lane];
                float prod = 1.f;
#pragma unroll 1
                for (int sub = 0; sub < 4; ++sub) {
#pragma unroll
                    for (int i = 0; i < 16; ++i) {
                        const int s = scan_token(dir, c * 64 + sub * 16 + i);
                        const float* row = P + (size_t)(b * SL + s) * DP;
                        float q = row[O_AQ + h * 64 + lane]; q = q * sigm(q);
                        const float fp = row[(dir ? O_AFB : O_AFF) + h * 64 + lane];
                        prod *= fmaxf(lbv + (1.f - lbv) * sigm(fp), 1e-12f);
                        L[i * 64 + lane] = q * prod;
                    }
#pragma unroll
                    for (int i = 0; i < 16; ++i) {
                        float o = 0.f;
#pragma unroll
                        for (int kq = 0; kq < 16; ++kq) { const float4 q4 = *(const float4*)&L[i * 64 + 4 * kq];
                            o += q4.x * S0[4 * kq + 0]; o += q4.y * S0[4 * kq + 1]; o += q4.z * S0[4 * kq + 2]; o += q4.w * S0[4 * kq + 3]; }
                        const int s = scan_token(dir, c * 64 + sub * 16 + i);
                        const size_t r = (size_t)(b * SL + s);
                        if (dir == 1) { oa1[r * 256 + h * 64 + lane] += o; }
                        else { const float x = oa0[r * 256 + h * 64 + lane] + o + oa1[r * 256 + h * 64 + lane];
                            const float ri = rsqrtf(wsum(x * x) * (1.f / 64.f) + 1e-6f), ga = P[r * DP + O_AG + h * 64 + lane];
                            ((bf16_t*)(p.ws + OFF_MIXB))[r * D + h * 64 + lane] = (bf16_t)(cvt_pk_bf16(x * ri * p.hnorm[layer * 64 + lane] * (ga * sigm(ga)), 0.f) & 0xffffu); }
                    }
                }
                asm volatile("s_waitcnt vmcnt(0)" ::: "memory");
            }
        } else {
            float* hb0 = (float*)(p.ws + OFF_HB); float* hb1 = hb0 + (size_t)NT * 256;
#pragma unroll 1
            for (int dir = 1; dir >= 0; --dir) {
                const int chain = bh * 2 + dir, c = dir == 0 ? tc : (tc < 4 ? 3 - tc : 39 - tc);
                const float* U = (const float*)(p.ws + OFF_UB) + ((size_t)chain * 36 + c) * 2048;
                const float* N = (const float*)(p.ws + OFF_NB) + (chain * 36 + c) * 32;
                const float m0 = ((const float*)(p.ws + OFF_MB))[(chain * 36 + c) * 4 + 2];
                float C0[32], n0[32];
#pragma unroll
                for (int k = 0; k < 32; ++k) { C0[k] = U[k * 64 + lane]; n0[k] = N[k]; }
                const float* sc = (const float*)(p.ws + OFF_SCB) + (size_t)dir * NT * 16;
#pragma unroll 1
                for (int sub = 0; sub < 4; ++sub) {
#pragma unroll
                    for (int i = 0; i < 16; ++i) {
                        const int s = scan_token(dir, c * 64 + sub * 16 + i);
                        const float* row = P + (size_t)(b * SL + s) * DP;
                        L[i * 64 + lane] = row[O_BQ + h * 32 + (lane & 31)] * 0.17677669529663687f;
                    }
#pragma unroll
                    for (int i = 0; i < 16; ++i) {
                        float qc = 0.f, qn = 0.f;
#pragma unroll
                        for (int kq = 0; kq < 8; ++kq) { const float4 q4 = *(const float4*)&L[i * 64 + 4 * kq];
                            qc += q4.x * C0[4 * kq + 0]; qn += q4.x * n0[4 * kq + 0]; qc += q4.y * C0[4 * kq + 1]; qn += q4.y * n0[4 * kq + 1];
                            qc += q4.z * C0[4 * kq + 2]; qn += q4.z * n0[4 * kq + 2]; qc += q4.w * C0[4 * kq + 3]; qn += q4.w * n0[4 * kq + 3]; }
                        const int s = scan_token(dir, c * 64 + sub * 16 + i);
                        const size_t r = (size_t)(b * SL + s);
                        const float4 t4 = *(const float4*)(sc + r * 16 + h * 4);
                        const float mt = fmaxf(t4.z + m0, t4.y), wi = expf(t4.z + m0 - mt), wl = expf(t4.y - mt);
                        float* hb = dir == 1 ? hb1 : hb0;
                        const float num = wi * qc + wl * hb[r * 256 + h * 64 + lane], den = wi * qn + wl * t4.x;
                        const float hv = num / fmaxf(fabsf(den), expf(-mt));
                        if (dir == 1) { hb1[r * 256 + h * 64 + lane] = hv; }
                        else { const float x = hv + hb1[r * 256 + h * 64 + lane];
                            const float ri = rsqrtf(wsum(x * x) * (1.f / 64.f) + 1e-6f);
                            ((bf16_t*)(p.ws + OFF_MIXB))[r * D + 256 + h * 64 + lane] = (bf16_t)(cvt_pk_bf16(x * ri * p.mnorm[layer * 256 + h * 64 + lane] * sigm(P[r * DP + O_BO + h * 64 + lane]), 0.f) & 0xffffu); }
                    }
                }
                asm volatile("s_waitcnt vmcnt(0)" ::: "memory");
            }
        }
    }
}

DEV void ph_attn_prep(const Params& p, char* smem) {
    const int tidx = tid_of(p.wave_id);
    const int t = tidx, rr = t >> 8, hj = (t >> 5) & 7, half = (t >> 4) & 1, i = t & 15, h = hj >> 1, j = hj & 1;
    const float invf = expf(-(float)i * (1.f / 16.f) * 9.210340371976184f), QC = 0.125f * 1.4426950408889634f;
    bf16_t* KB = (bf16_t*)(p.ws + OFF_KB); bf16_t* VB = (bf16_t*)(p.ws + OFF_VB); bf16_t* QRB = (bf16_t*)(p.ws + OFF_QRB); bf16_t* Q0B = (bf16_t*)(p.ws + OFF_Q0B);
    for (int r = blockIdx.x * 2 + rr; r < NT; r += gridDim.x * 2) {
        const int b = r / SL, s = r % SL;
        float cs = 1.f, sn = 0.f;
        if (s >= CTX) { const int tl = s - CTX; const float pos = half == 0 ? (float)(tl / 64) : (float)(tl % 64); sincosf(pos * invf, &sn, &cs); }
        const float* row = ((float*)(p.ws + OFF_P)) + (size_t)r * DP;
        const int d1 = half * 32 + i, d2 = d1 + 16;
        const float q1 = row[O_CQ + hj * 64 + d1] * QC, q2 = row[O_CQ + hj * 64 + d2] * QC, k1 = row[O_CK + hj * 64 + d1], k2 = row[O_CK + hj * 64 + d2];
        const float v1 = row[O_CV + hj * 64 + d1], v2 = row[O_CV + hj * 64 + d2];
        const size_t o1 = ((size_t)(b * 4 + h) * SL + s) * 128 + j * 64 + d1, o2 = o1 + 16;
#define BF(x) ((bf16_t)(cvt_pk_bf16((x), 0.f) & 0xffffu))
        QRB[o1] = BF(q1 * cs - q2 * sn); QRB[o2] = BF(q1 * sn + q2 * cs);
        Q0B[o1] = BF(q1); Q0B[o2] = BF(q2);
        KB[o1] = BF(k1 * cs - k2 * sn); KB[o2] = BF(k1 * sn + k2 * cs);
        VB[o1] = BF(v1); VB[o2] = BF(v2);
#undef BF
    }
}
DEV void ph_attn(const Params& p, int layer, char* smem) {
    const int tid = tid_of(p.wave_id), wid = tid >> 6, lane = tid & 63, r32 = lane & 31, hi = lane >> 5, js = wid & 1, qb = wid >> 1;
    const float lam = ((const float*)(p.ws + OFF_LAM))[layer], omli = 1.f - lam_init_of(layer);
    const bf16_t* KB = (const bf16_t*)(p.ws + OFF_KB); const bf16_t* VB = (const bf16_t*)(p.ws + OFF_VB);
    const bf16_t* QRB = (const bf16_t*)(p.ws + OFF_QRB); const bf16_t* Q0B = (const bf16_t*)(p.ws + OFF_Q0B);
    const int G = (int)gridDim.x, c = (int)blockIdx.x;
    const int nlat = 512, ntot = nlat + (layer == 0 ? 64 : 0);
    for (int i = 0;; ++i) {
        int bh, s0; bool isctx;
        if (G == 256) {
            const int xcd = c & 7, j = c >> 3;
            if (i < 2) { bh = xcd + 8 * (i * 2 + (j >> 4)); s0 = CTX + (j & 15) * 128; isctx = false; }
            else if (i == 2 && layer == 0 && j < 8) { bh = xcd + 8 * (j >> 1); s0 = (j & 1) * 128; isctx = true; }
            else break;
        } else {
            const int u = i * G + c; if (u >= ntot) break;
            if (u < nlat) { bh = u >> 4; s0 = CTX + (u & 15) * 128; isctx = false; } else { const int v = u - nlat; bh = v >> 1; s0 = (v & 1) * 128; isctx = true; }
        }
        const bf16_t* Kh = KB + (size_t)bh * SL * 128; const bf16_t* Vh = VB + (size_t)bh * SL * 128;
        const size_t qoff = ((size_t)bh * SL + s0 + qb * 32 + r32) * 128 + js * 64 + hi * 8;
        att::bf16x8 qr[4];
#pragma unroll
        for (int d0 = 0; d0 < 4; ++d0) qr[d0] = *(const att::bf16x8*)(Q0B + qoff + d0 * 16);
        float m_reg = -1e30f, l_reg = 0.f; att::f32x16 o[4] = {};
        att::attn_tiles(qr, Kh, Vh, CTX, smem, m_reg, l_reg, o, tid, js);
        if (!isctx) {
#pragma unroll
            for (int d0 = 0; d0 < 4; ++d0) qr[d0] = *(const att::bf16x8*)(QRB + qoff + d0 * 16);
            att::attn_tiles(qr, Kh + (size_t)CTX * 128, Vh + (size_t)CTX * 128, SEQ, smem, m_reg, l_reg, o, tid, js);
        }
        float* wsw = (float*)(smem + 2 * att::SHM_V + 2 * att::SHM_K) + wid * 64;
        __syncthreads();
        if (hi == 0) wsw[r32] = l_reg;
        asm volatile("s_waitcnt lgkmcnt(0)" ::: "memory");
        float rli[16];
#pragma unroll
        for (int r = 0; r < 16; ++r) rli[r] = __builtin_amdgcn_rcpf(wsw[att::crow(r, hi)]);
        float* X = (float*)smem + qb * 4096;
        if (js == 1) {
#pragma unroll
            for (int d0 = 0; d0 < 4; ++d0)
#pragma unroll
                for (int r = 0; r < 16; ++r) X[(d0 * 16 + r) * 64 + lane] = o[d0][r] * rli[r];
        }
        __syncthreads();
        if (js == 0) {
            const int b = bh >> 2, h = bh & 3;
            float ss[16];
#pragma unroll
            for (int r = 0; r < 16; ++r) ss[r] = 0.f;
#pragma unroll
            for (int d0 = 0; d0 < 4; ++d0)
#pragma unroll
                for (int r = 0; r < 16; ++r) { const float v = o[d0][r] * rli[r] - lam * X[(d0 * 16 + r) * 64 + lane]; o[d0][r] = v; ss[r] += v * v; }
#pragma unroll
            for (int r = 0; r < 16; ++r) { float t = ss[r]; t += __shfl_xor(t, 1); t += __shfl_xor(t, 2); t += __shfl_xor(t, 4); t += __shfl_xor(t, 8); t += __shfl_xor(t, 16);
                ss[r] = rsqrtf(t * (1.f / 128.f) + 1e-6f) * omli; }
            bf16_t* mix = (bf16_t*)(p.ws + OFF_MIXB) + (size_t)(b * SL + s0 + qb * 32) * D + 512 + h * 128 + r32;
#pragma unroll
            for (int d0 = 0; d0 < 4; ++d0) { const float g = p.dnorm[layer * 128 + d0 * 32 + r32];
#pragma unroll
                for (int r = 0; r < 16; ++r) mix[(size_t)att::crow(r, hi) * D + d0 * 32] = (bf16_t)(cvt_pk_bf16(o[d0][r] * ss[r] * g, 0.f) & 0xffffu); }
        }
        __syncthreads();
    }
}
DEV void ph_outproj(const Params& p, int layer, char* smem) {
    const int tidx = tid_of(p.wave_id);
    pg8::StaticOrder S; S.init(layer == 0 ? NT / 256 : NB * 8, D / 256, (int)gridDim.x, (int)blockIdx.x, layer == 0 ? 0 : 1, (const bf16_t*)(p.ws + OFF_WOUT) + (size_t)layer * D * D, D);
    pg8::EpiF32 E{(float*)(p.ws + OFF_MIXO), D};
    pg8::gemm_phase((LAS unsigned char*)smem, (const char*)(p.ws + OFF_MIXB), D, S, E, tid_of(p.wave_id));
}
DEV void ph_norm2(const Params& p, int layer, char* smem) {
    const int tidx = tid_of(p.wave_id);
    float (*xs)[1024] = (float (*)[1024])smem;
    int* hist = (int*)(smem + 32768);
    const int wid = tidx >> 6, lane = tidx & 63;
    const float* nr = p.norms + (size_t)layer * 4 * D;
    if (tidx < NE) hist[tidx] = 0;
    __syncthreads();
    const int chunk = (NT + (int)gridDim.x - 1) / (int)gridDim.x, rbeg = (int)blockIdx.x * chunk, rend = min(NT, rbeg + chunk);
    for (int r = rbeg + wid; r < rend; r += 8) {
        const int b = r / SL, s = r % SL;
        if (layer != 0 && s < CTX) continue;
        const float* m = modrow(p, layer, b, s);
        float4 mo[4], xv[4], o[4]; row_load(((float*)(p.ws + OFF_MIXO)) + (size_t)r * D, mo, lane); row_load(((float*)(p.ws + OFF_X)) + (size_t)r * D, xv, lane);
        const float ri = row_rinv(mo);
#pragma unroll
        for (int i = 0; i < 4; ++i) { const int idx = i * 256 + lane * 4; const float4 g = *(const float4*)(nr + D + idx), gt = *(const float4*)(m + 2048 + idx);
            xv[i].x += gt.x * (mo[i].x * ri * g.x); xv[i].y += gt.y * (mo[i].y * ri * g.y); xv[i].z += gt.z * (mo[i].z * ri * g.z); xv[i].w += gt.w * (mo[i].w * ri * g.w); }
        row_store(((float*)(p.ws + OFF_X)) + (size_t)r * D, xv, lane);
        row_modnorm(xv, nr + 2 * D, m + 3072, m + 4096, o, lane);
        row_store_bf16((bf16_t*)(p.ws + OFF_XNB) + (size_t)r * D, o, lane);
        row_store(&xs[wid][0], o, lane);
        __builtin_amdgcn_wave_barrier();
        asm volatile("s_waitcnt lgkmcnt(0)" ::: "memory");
        const int e = lane & 31, part = lane >> 5;
        const float* rw = p.rw + (size_t)layer * D * NE + e;
        float acc = 0.f;
        for (int i = part * 512; i < part * 512 + 512; ++i) acc += xs[wid][i] * rw[(size_t)i * NE];
        acc += __shfl_xor(acc, 32);
        float logit = acc + p.rb[layer * NE + e];
        float tv[4]; int ti[4];
#pragma unroll
        for (int k = 0; k < 4; ++k) {
            float bv = logit; int bi = e;
            for (int o2 = 16; o2 >= 1; o2 >>= 1) { const float ov = __shfl_xor(bv, o2); const int oi = __shfl_xor(bi, o2); if (ov > bv || (ov == bv && oi < bi)) { bv = ov; bi = oi; } }
            tv[k] = bv; ti[k] = bi; if (e == bi) logit = -3.0e38f;
        }
        const float e0 = 1.f, e1 = expf(tv[1] - tv[0]), e2 = expf(tv[2] - tv[0]), e3 = expf(tv[3] - tv[0]), inv = 1.f / (e0 + e1 + e2 + e3);
        if (lane == 0) { *(float4*)(((float*)(p.ws + OFF_TOPW)) + (size_t)r * 4) = make_float4(e0 * inv, e1 * inv, e2 * inv, e3 * inv); *(int4*)(((int*)(p.ws + OFF_TOPI)) + (size_t)r * 4) = make_int4(ti[0], ti[1], ti[2], ti[3]); }
        if (lane < 4) atomicAdd(&hist[lane == 0 ? ti[0] : lane == 1 ? ti[1] : lane == 2 ? ti[2] : ti[3]], 1);
        __builtin_amdgcn_wave_barrier();
    }
    __syncthreads();
    if (tidx < NE) ((int*)(p.ws + OFF_BC))[(size_t)blockIdx.x * NE + tidx] = hist[tidx];
}
DEV void ph_route(const Params& p, int layer, char* smem) {
    const int tidx = tid_of(p.wave_id);
    int* part = (int*)smem;
    int* off = part + 1024;
    const int G = (int)gridDim.x, bid = (int)blockIdx.x;
    const int* BC = (const int*)(p.ws + OFF_BC);
    { const int e = tidx & 31, sl = tidx >> 5; int before = 0, tot = 0;
      for (int bb = sl; bb < G; bb += 16) { const int c = BC[(size_t)bb * NE + e]; tot += c; if (bb < bid) before += c; }
      part[(sl * 2 + 0) * 32 + e] = before; part[(sl * 2 + 1) * 32 + e] = tot; }
    __syncthreads();
    if (tidx < NE) { int before = 0, tot = 0; for (int sl = 0; sl < 16; ++sl) { before += part[(sl * 2 + 0) * 32 + tidx]; tot += part[(sl * 2 + 1) * 32 + tidx]; }
        off[tidx] = before; if (bid == 0) ((int*)(p.ws + OFF_CNT))[tidx] = tot; }
    __syncthreads();
    if (tidx < 64) {
        const int lane = tidx;
        const int chunk = (NT + G - 1) / G, rbeg = bid * chunk, rend = min(NT, rbeg + chunk);
        for (int q0 = rbeg * 4; q0 < rend * 4; q0 += 64) {
            const int pair = q0 + lane, r = pair >> 2, s = r % SL;
            const bool act = pair < rend * 4 && (layer == 0 || s >= CTX);
            const int my = act ? ((const int*)(p.ws + OFF_TOPI))[pair] : -1;
            for (int e = 0; e < NE; ++e) {
                const unsigned long long bal = __ballot(my == e);
                if (bal) { const int base = off[e];
                    if (my == e) ((int*)(p.ws + OFF_LIST))[(size_t)e * LISTCAP + base + __popcll(bal & ((1ull << lane) - 1ull))] = pair;
                    __builtin_amdgcn_wave_barrier();
                    if (lane == 0) off[e] = base + __popcll(bal);
                    __builtin_amdgcn_wave_barrier(); }
            }
        }
    }
}
DEV int moe_rt(int i, int G, int c, int npn, int& pn) {
    if (G == 256) { const int xcd = c & 7, j = c >> 3, rpx = 32 / npn; pn = j % npn; return (i * 8 + xcd) * rpx + j / npn; }
    const int L = i * G + c; pn = L % npn; return L / npn;
}
constexpr int MOE_LDS = 131072, MOE_MAXU = 12;
DEV void moe_prepare(const Params& p, char* smem, int npn, int mode) {
    const int tidx = tid_of(p.wave_id);
    LAS int* base = (LAS int*)(smem + MOE_LDS);
    LAS int *TE = base, *TT = base + 320, *NRT = base + 640, *UI = base + 704, *IDX = base + 768;
    const int* cnt = (const int*)(p.ws + OFF_CNT);
    if (tidx < 320) { int e = 0, acc = 0; for (; e < NE; ++e) { const int n = (cnt[e] + 255) >> 8; if (tidx < acc + n) break; acc += n; } TE[tidx] = e; TT[tidx] = tidx - acc; }
    if (tidx == 0) { int tot = 0; for (int e = 0; e < NE; ++e) tot += (cnt[e] + 255) >> 8; NRT[0] = tot; }
    __syncthreads();
    const int nrt = NRT[0];
    for (int i = 0; i < MOE_MAXU; ++i) {
        int pn; const int rt = moe_rt(i, (int)gridDim.x, (int)blockIdx.x, npn, pn);
        if (rt >= nrt) break;
        const int e = TE[rt], t = TT[rt], c = cnt[e];
        if (tidx < 256) { const int q = t * 256 + tidx; const int pair = ((const int*)(p.ws + OFF_LIST))[(size_t)e * LISTCAP + min(q, c - 1)];
            IDX[i * 256 + tidx] = mode == 1 ? (pair >> 2) : (q < c ? pair : -1); }
        if (tidx == 256) { int pre = 0; for (int z = 0; z < e; ++z) pre += cnt[z]; UI[i * 4 + 0] = min(256, c - t * 256); UI[i * 4 + 1] = pre + t * 256; }
    }
    __syncthreads();
}
struct MoeOrder {
    const LAS int *te, *ui, *idx; int nrt, npn, G, c, gather; const char* Bt; size_t bstride; int K;
    DEV bool next(int i, pg8::Unit& u) const { int pn; const int rt = moe_rt(i, G, c, npn, pn); if (rt >= nrt || i >= MOE_MAXU) return false;
        u.pm = rt; u.pn = pn; u.e = __builtin_amdgcn_readfirstlane(te[rt]); u.t = i; return true; }
    DEV int arow(const pg8::Unit& u, int rr) const { return gather ? idx[u.t * 256 + rr] : ui[u.t * 4 + 1] + rr; }
    DEV const char* bbase(const pg8::Unit& u) const { return Bt + (size_t)u.e * bstride + (size_t)u.pn * pg8::BM * K * 2; }
};
DEV float swiglu(float g, float l) { g = fminf(g, 7.f); l = fminf(fmaxf(l, -7.f), 7.f); return g * __builtin_amdgcn_rcpf(1.f + __expf(-1.702f * g)) * (l + 1.f); }
struct EpiSwiglu {
    static constexpr bool PERM = true;
    bf16_t* H; const float* b1; const LAS int* ui;
    DEV void operator()(const pg8::f32x4 (&acc)[2][2][4][2], const pg8::Unit& u, int wr, int wc, int fr, int fq) const {
        const int ucnt = ui[u.t * 4 + 0], hrow0 = ui[u.t * 4 + 1], col0 = u.pn * 256 + wc * 32 + 8 * fq;
        const float* bb = b1 + (size_t)u.e * 2048 + col0;
        pg8::f32x4 bv[2][2];
#pragma unroll
        for (int bj = 0; bj < 2; ++bj)
#pragma unroll
            for (int n = 0; n < 2; ++n) bv[bj][n] = *(const pg8::f32x4*)(bb + bj * 128 + 4 * n);
#pragma unroll
        for (int ai = 0; ai < 2; ++ai)
#pragma unroll
            for (int m = 0; m < 4; ++m) { const int rr = ai * 128 + wr * 64 + m * 16 + fr;
                if (rr < ucnt) { bf16_t* rowp = H + (size_t)(hrow0 + rr) * DFF + (col0 >> 1);
#pragma unroll
                    for (int bj = 0; bj < 2; ++bj) { const pg8::f32x4 v0 = acc[ai][bj][m][0] + bv[bj][0], v1 = acc[ai][bj][m][1] + bv[bj][1];
                        pg8::u32x2 w; w.x = cvt_pk_bf16(swiglu(v0[0], v0[1]), swiglu(v0[2], v0[3])); w.y = cvt_pk_bf16(swiglu(v1[0], v1[1]), swiglu(v1[2], v1[3]));
                        *(pg8::u32x2*)(rowp + bj * 64) = w; } } }
    }
};
struct EpiY {
    static constexpr bool PERM = true;
    bf16_t* Y; const LAS int* idx;
    DEV void operator()(const pg8::f32x4 (&acc)[2][2][4][2], const pg8::Unit& u, int wr, int wc, int fr, int fq) const {
        const int col0 = u.pn * 256 + wc * 32 + 8 * fq;
#pragma unroll
        for (int ai = 0; ai < 2; ++ai)
#pragma unroll
            for (int m = 0; m < 4; ++m) { const int rr = ai * 128 + wr * 64 + m * 16 + fr; const int pair = idx[u.t * 256 + rr];
                if (pair >= 0) { bf16_t* rowp = Y + (size_t)pair * D + col0;
#pragma unroll
                    for (int bj = 0; bj < 2; ++bj) { const pg8::f32x4 v0 = acc[ai][bj][m][0], v1 = acc[ai][bj][m][1];
                        pg8::u32x4 w; w.x = cvt_pk_bf16(v0[0], v0[1]); w.y = cvt_pk_bf16(v0[2], v0[3]); w.z = cvt_pk_bf16(v1[0], v1[1]); w.w = cvt_pk_bf16(v1[2], v1[3]);
                        *(pg8::u32x4*)(rowp + bj * 128) = w; } } }
    }
};
DEV void ph_moe1(const Params& p, int layer, char* smem) {
    moe_prepare(p, smem, 8, 1);
    LAS int* base = (LAS int*)(smem + MOE_LDS);
    MoeOrder S{base, base + 704, base + 768, base[640], 8, (int)gridDim.x, (int)blockIdx.x, 1, (const char*)(p.ws + OFF_W1T) + (size_t)layer * NE * 2048 * D * 2, (size_t)2048 * D * 2, D};
    EpiSwiglu E{(bf16_t*)(p.ws + OFF_H), p.b1 + (size_t)layer * NE * 2048, base + 704};
    pg8::gemm_phase((LAS unsigned char*)smem, (const char*)(p.ws + OFF_XNB), D, S, E, tid_of(p.wave_id));
}
DEV void ph_moe2(const Params& p, int layer, char* smem) {
    moe_prepare(p, smem, 4, 2);
    LAS int* base = (LAS int*)(smem + MOE_LDS);
    MoeOrder S{base, base + 704, base + 768, base[640], 4, (int)gridDim.x, (int)blockIdx.x, 0, (const char*)(p.ws + OFF_W2T) + (size_t)layer * NE * D * DFF * 2, (size_t)D * DFF * 2, DFF};
    EpiY E{(bf16_t*)(p.ws + OFF_Y), base + 768};
    pg8::gemm_phase((LAS unsigned char*)smem, (const char*)(p.ws + OFF_H), DFF, S, E, tid_of(p.wave_id));
}
DEV void ph_combine(const Params& p, int layer, char* smem) {
    const int tidx = tid_of(p.wave_id);
    const int wid = tidx >> 6, lane = tidx & 63;
    const float* nr = p.norms + (size_t)layer * 4 * D;
    for (int r = blockIdx.x * 8 + wid; r < NT; r += gridDim.x * 8) {
        const int b = r / SL, s = r % SL;
        if (layer != 0 && s < CTX) continue;
        const float* m = modrow(p, layer, b, s);
        const float4 tw = *(const float4*)(((float*)(p.ws + OFF_TOPW)) + (size_t)r * 4); const int4 ti = *(const int4*)(((int*)(p.ws + OFF_TOPI)) + (size_t)r * 4);
        const float w[4] = {tw.x, tw.y, tw.z, tw.w}; const int ei[4] = {ti.x, ti.y, ti.z, ti.w};
        float4 f[4], xv[4];
#pragma unroll
        for (int i = 0; i < 4; ++i) f[i] = make_float4(0.f, 0.f, 0.f, 0.f);
#pragma unroll
        for (int k = 0; k < 4; ++k) {
            const bf16_t* y = (const bf16_t*)(p.ws + OFF_Y) + ((size_t)r * 4 + k) * D; const float* bb = p.b2 + ((size_t)layer * NE + ei[k]) * D;
#pragma unroll
            for (int i = 0; i < 4; ++i) { const int idx = i * 256 + lane * 4; const pg8::u32x2 yb = *(const pg8::u32x2*)(y + idx); const float4 bv = *(const float4*)(bb + idx);
                const float y0 = __uint_as_float(yb.x << 16), y1 = __uint_as_float(yb.x & 0xffff0000u), y2 = __uint_as_float(yb.y << 16), y3 = __uint_as_float(yb.y & 0xffff0000u);
                f[i].x += w[k] * (y0 + bv.x); f[i].y += w[k] * (y1 + bv.y); f[i].z += w[k] * (y2 + bv.z); f[i].w += w[k] * (y3 + bv.w); }
        }
        row_load(((float*)(p.ws + OFF_X)) + (size_t)r * D, xv, lane);
        const float ri = row_rinv(f);
#pragma unroll
        for (int i = 0; i < 4; ++i) { const int idx = i * 256 + lane * 4; const float4 g = *(const float4*)(nr + 3 * D + idx), gt = *(const float4*)(m + 5120 + idx);
            xv[i].x += gt.x * (f[i].x * ri * g.x); xv[i].y += gt.y * (f[i].y * ri * g.y); xv[i].z += gt.z * (f[i].z * ri * g.z); xv[i].w += gt.w * (f[i].w * ri * g.w); }
        if (layer == 0) {
            row_store(((float*)(p.ws + OFF_X)) + (size_t)r * D, xv, lane);
            const float* m1 = modrow(p, 1, b, s); float4 o[4];
            row_modnorm(xv, p.norms + (size_t)4 * D, m1 + 0, m1 + 1024, o, lane);
            row_store_bf16((bf16_t*)(p.ws + OFF_XNB) + (size_t)r * D, o, lane);
        } else {
            row_store(p.out + ((size_t)b * SEQ + (s - CTX)) * D, xv, lane);
        }
    }
}

template <int layer> DEV void run_layer(const Params& p, char* smem, const XcdBarrier& bar) {
#define GB() xcd_barrier(bar)

        ph_inproj(p, layer, smem); GB();
        ph_scan_local(p, layer, smem); ph_attn_prep(p, smem); GB();
        ph_scan_carry(p, smem); ph_attn(p, layer, smem); GB();
        ph_scan_out(p, layer, smem); GB();
        ph_outproj(p, layer, smem); GB();
        ph_norm2(p, layer, smem); GB();
        ph_route(p, layer, smem); GB();
        ph_moe1(p, layer, smem); GB();
        ph_moe2(p, layer, smem); GB();
        ph_combine(p, layer, smem); GB();
    #undef GB
}
constexpr int LDS_BYTES = 147456;
__global__ __launch_bounds__(512, 2) void k_mega(Params p_in) {
    Params p = p_in; p.wave_id = __builtin_amdgcn_readfirstlane((int)(threadIdx.x >> 6));
    extern __shared__ __attribute__((aligned(16))) char smem[];
    volatile LAS unsigned* st = (volatile LAS unsigned*)(smem + LDS_BYTES - 16);
    if (threadIdx.x == 0) { st[0] = 0u; st[1] = 0u; st[2] = 0u; st[3] = 0u; }
    __syncthreads();
    const XcdBarrier bar = xcd_barrier_post(((unsigned*)(p.ws + OFF_bar)), st, p.wave_id);
#define GB() xcd_barrier(bar)
    ph_mods(p, smem); ph_convert(p, smem); GB();
    ph_init(p, smem); GB();
    run_layer<0>(p, smem, bar);
    run_layer<1>(p, smem, bar);
#undef GB
}
}

extern "C" void kernel_launch(void* const* d_in, const int* in_sizes, int n_in, void* d_out, int out_size, void* d_ws, size_t ws_size, hipStream_t stream) {
    static int grid = 0;
    if (grid == 0) {
        int dev = 0, cus = 0, per_cu = 0;
        if (hipGetDevice(&dev) != hipSuccess || hipDeviceGetAttribute(&cus, hipDeviceAttributeMultiprocessorCount, dev) != hipSuccess) { grid = -1; return; }
        if (hipFuncSetAttribute((const void*)k_mega, hipFuncAttributeMaxDynamicSharedMemorySize, LDS_BYTES) != hipSuccess) { grid = -1; return; }
        (void)hipOccupancyMaxActiveBlocksPerMultiprocessor(&per_cu, (const void*)k_mega, 512, LDS_BYTES);
        (void)hipGetLastError();
        grid = cus;
    }
    if (grid < 0) return;
    Params p{};
    const float** in = (const float**)&p;
    for (int i = 0; i < 21; ++i) in[i] = (const float*)d_in[i];
    p.out = (float*)d_out;
    p.ws = (char*)d_ws;
    if (WS_END > ws_size) return;
    if (hipMemsetAsync(p.ws + OFF_bar, 0, (size_t)XCD_BAR_WORDS * 4, stream) != hipSuccess) return;
    hipLaunchKernelGGL(k_mega, dim3(grid), dim3(512), LDS_BYTES, stream, p);
}
```

```cpp
#include <hip/hip_runtime.h>
#include <stdint.h>

namespace {
constexpr int D = 1024, NB = 8, SEQ = 2048, CTX = 256, SL = 2304, NT = NB * SL;
constexpr int DP = 3840, DPW = 3600, NE = 32, DFF = 1024, NPAIR = NT * 4;
constexpr int O_AQ = 0, O_AI = 256, O_AFF = 512, O_AFB = 768, O_AG = 1024, O_BQ = 1280, O_BK = 1408, O_BV = 1536, O_BO = 1792, O_BG = 2048, O_CQ = 2064, O_CK = 2576, O_CV = 3088;
constexpr int LISTCAP = NT;

struct Params {
    const float *x, *c, *ctx, *c_ctx, *ada_w, *ada_b, *norms, *w_in, *w_out, *hlb, *hnorm, *mgb, *mnorm, *dlam, *dnorm, *rw, *rb, *w1, *b1, *w2, *b2;
    float* out;
    char* ws;
    int wave_id, pad_;
};
constexpr size_t al256(size_t x) { return (x + 255) & ~(size_t)255; }
constexpr size_t OFF_bar = 0;
constexpr size_t OFF_MOD = OFF_bar + al256(3456 * 4);
constexpr size_t OFF_LB = OFF_MOD + al256((size_t)2 * 9 * 6144 * 4);
constexpr size_t OFF_LAM = OFF_LB + al256(1024 * 4);
constexpr size_t OFF_CNT = OFF_LAM + 256;
constexpr size_t OFF_BC = OFF_CNT + 256;
constexpr size_t OFF_TOPW = OFF_BC + al256((size_t)1024 * NE * 4);
constexpr size_t OFF_TOPI = OFF_TOPW + al256((size_t)NPAIR * 4);
constexpr size_t OFF_LIST = OFF_TOPI + al256((size_t)NPAIR * 4);
constexpr size_t OFF_X = OFF_LIST + al256((size_t)NE * LISTCAP * 4);
constexpr size_t OFF_XN = OFF_X + al256((size_t)NT * D * 4);
constexpr size_t OFF_P = OFF_XN + al256((size_t)NT * D * 4);
constexpr size_t OFF_QR = OFF_P + al256((size_t)NT * DP * 4);
constexpr size_t OFF_KT = OFF_QR + al256((size_t)64 * SL * 64 * 4);
constexpr size_t OFF_OC = OFF_KT + al256((size_t)64 * SL * 64 * 4);
constexpr size_t OFF_MIX = OFF_OC + al256((size_t)32 * SL * 128 * 4);
constexpr size_t OFF_MIXO = OFF_MIX + al256((size_t)NT * D * 4);
constexpr size_t OFF_XNB = OFF_MIXO + al256((size_t)NT * D * 4);
constexpr size_t OFF_MIXB = OFF_XNB + al256((size_t)NT * D * 2);
constexpr size_t OFF_WIN = OFF_MIXB + al256((size_t)NT * D * 2);
constexpr size_t OFF_WOUT = OFF_WIN + al256((size_t)2 * DP * D * 2);
constexpr size_t OFF_W1T = OFF_WOUT + al256((size_t)2 * D * D * 2);
constexpr size_t OFF_W2T = OFF_W1T + al256((size_t)2 * NE * 2048 * D * 2);
constexpr size_t OFF_U = OFF_W2T + al256((size_t)2 * NE * D * DFF * 2);
constexpr size_t WS_END = OFF_U + al256((size_t)32 * SL * SL * 4);
constexpr size_t OFF_UA = OFF_U, OFF_DECA = OFF_UA + (size_t)64 * 36 * 4096 * 4, OFF_UB = OFF_DECA + (size_t)64 * 36 * 64 * 4, OFF_NB = OFF_UB + (size_t)64 * 36 * 2048 * 4,
                 OFF_MB = OFF_NB + (size_t)64 * 36 * 32 * 4, OFF_SCB = OFF_MB + (size_t)64 * 36 * 4 * 4,
                 OFF_OA2 = OFF_SCB + (size_t)2 * NT * 16 * 4, OFF_HB2 = OFF_OA2 + (size_t)NT * 256 * 4, OFF_SA = OFF_HB2 + (size_t)NT * 256 * 4, OFF_SB = OFF_SA + (size_t)64 * 36 * 4096 * 4,
                 OFF_N0 = OFF_SB + (size_t)64 * 36 * 2048 * 4;
constexpr size_t OFF_QRB = OFF_QR, OFF_Q0B = OFF_QR + (size_t)32 * SL * 128 * 2, OFF_KB = OFF_KT, OFF_VB = OFF_KT + (size_t)32 * SL * 128 * 2;
constexpr size_t OFF_S = OFF_U, OFF_H = OFF_U, OFF_Y = OFF_U + al256((size_t)(NPAIR + 256) * DFF * 2);
constexpr size_t OFF_OA = OFF_MIXO, OFF_HB = OFF_MIXO + (size_t)2 * NT * 256 * 4;


#define DEV __device__ __forceinline__
DEV int lane_asm() { int l; asm volatile("v_mbcnt_lo_u32_b32 %0, -1, 0\n\tv_mbcnt_hi_u32_b32 %0, -1, %0" : "=v"(l)); return l; }
DEV int tid_of(int wave_id) { return (wave_id << 6) | lane_asm(); }
DEV float wsum(float v) { for (int o = 32; o >= 1; o >>= 1) v += __shfl_xor(v, o); return v; }
DEV float wmaxf(float v) { for (int o = 32; o >= 1; o >>= 1) v = fmaxf(v, __shfl_xor(v, o)); return v; }
DEV float sigm(float x) { return 1.f / (1.f + expf(-x)); }
DEV float rdlane(float v, int l) { return __int_as_float(__builtin_amdgcn_readlane(__float_as_int(v), l)); }
DEV float lam_init_of(int layer) { return 0.8f - 0.6f * expf(-0.3f * (float)layer); }


#define XB_TMO      128
#define XB_XCNT(j)  (256  + 64 * (j))
#define XB_XSUB(j)  (1280 + 64 * (j))
#define XB_XGEN(j)  (2304 + 64 * (j))
#define XB_TOP      3328
#define XB_TOPGEN   3392
#define XCD_BAR_WORDS 3456
#define XB_SPIN_CAP (1u << 22)
#define LAS __attribute__((address_space(3)))
DEV unsigned xb_ld(unsigned* p)              { return __hip_atomic_load(p, __ATOMIC_RELAXED, __HIP_MEMORY_SCOPE_AGENT); }
DEV unsigned xb_add(unsigned* p, unsigned v) { return __hip_atomic_fetch_add(p, v, __ATOMIC_RELAXED, __HIP_MEMORY_SCOPE_AGENT); }
DEV unsigned xb_xcc_id() { return (unsigned)__builtin_amdgcn_s_getreg((3 << 11) | 20) & 0xFu; }
#define XB_SPIN(cond, bar) do { unsigned _sp = 0; while (cond) { __builtin_amdgcn_s_sleep(1); \
    if ((++_sp & 255u) == 0u) { if (xb_ld(&(bar)[XB_TMO])) break; if (_sp > XB_SPIN_CAP) { atomicAdd(&(bar)[XB_TMO], 1u); break; } } } } while (0)
struct XcdBarrier { unsigned* bar; unsigned x; volatile LAS unsigned* st; int wave; };
DEV bool xb_thread0(int wave) { return wave == 0 && lane_asm() == 0; }
DEV XcdBarrier xcd_barrier_post(unsigned* bar, volatile LAS unsigned* st, int wave) {
    XcdBarrier b; b.bar = bar; b.x = xb_xcc_id(); b.st = st; b.wave = wave;
    if (xb_thread0(wave)) (void)xb_add(&bar[XB_XCNT(b.x)], 1u);
    return b;
}
DEV void xcd_barrier_complete(unsigned* bar, unsigned x, unsigned& nloc, unsigned& nx) {
    const unsigned G = gridDim.x * gridDim.y * gridDim.z;
    unsigned sum, cnt, mine, sp = 0u;
    for (;;) {
        sum = 0u; cnt = 0u; mine = 0u;
#pragma unroll
        for (unsigned j = 0; j < 16; ++j) { const unsigned c = xb_ld(&bar[XB_XCNT(j)]); sum += c; cnt += (c > 0u) ? 1u : 0u; mine = (j == x) ? c : mine; }
        if (sum == G) break;
        __builtin_amdgcn_s_sleep(1);
        if ((++sp & 255u) == 0u) { if (xb_ld(&bar[XB_TMO])) break; if (sp > XB_SPIN_CAP) { atomicAdd(&bar[XB_TMO], 1u); break; } }
    }
    nloc = mine > 0u ? mine : 1u; nx = cnt > 0u ? cnt : 1u;
}
DEV void xcd_barrier(const XcdBarrier& b) {
    asm volatile("s_waitcnt vmcnt(0)" ::: "memory");
    __syncthreads();
    if (xb_thread0(b.wave)) {
        unsigned* bar = b.bar;
        __builtin_amdgcn_s_waitcnt(0);
        unsigned nloc = b.st[0], nx = b.st[1];
        if (nloc == 0u) { xcd_barrier_complete(bar, b.x, nloc, nx); b.st[0] = nloc; b.st[1] = nx; }
        const unsigned old = xb_add(&bar[XB_XSUB(b.x)], 1u);
        const unsigned gen = old / nloc;
        if (old + 1u == (gen + 1u) * nloc) {
            __builtin_amdgcn_fence(__ATOMIC_RELEASE, "agent");
            asm volatile("s_waitcnt vmcnt(0)" ::: "memory");
            const unsigned og = xb_add(&bar[XB_TOP], 1u);
            const unsigned tg = og / nx;
            if (og + 1u == (tg + 1u) * nx) xb_add(&bar[XB_TOPGEN], 1u);
            else XB_SPIN(xb_ld(&bar[XB_TOPGEN]) == tg, bar);
            __builtin_amdgcn_fence(__ATOMIC_ACQUIRE, "agent");
            xb_add(&bar[XB_XGEN(b.x)], 1u);
            asm volatile("s_waitcnt vmcnt(0)" ::: "memory");
        } else {
            XB_SPIN(xb_ld(&bar[XB_XGEN(b.x)]) == gen, bar);
            __builtin_amdgcn_fence(__ATOMIC_ACQUIRE, "agent");
            asm volatile("s_waitcnt vmcnt(0)" ::: "memory");
        }
    }
    __syncthreads();
}

typedef unsigned short bf16_t;
DEV unsigned cvt_pk_bf16(float lo, float hi) { unsigned r; asm volatile("v_cvt_pk_bf16_f32 %0, %1, %2" : "=v"(r) : "v"(lo), "v"(hi)); return r; }

namespace pg8 {
typedef short bf16x8 __attribute__((ext_vector_type(8)));
typedef float f32x4 __attribute__((ext_vector_type(4)));
typedef unsigned u32x4 __attribute__((ext_vector_type(4)));
typedef unsigned u32x2 __attribute__((ext_vector_type(2)));
constexpr int BM = 256, BK = 64, HALF = 128, HTB = HALF * BK * 2, STAGE_BYTES = 8 * HTB, NXCD = 8, WGM = 8;
DEV int lds_byte(int r, int c) { const int st = (r >> 4) * 2 + (c >> 5), rr = r & 15, cc = c & 31, ob = rr * 64 + cc * 2; return st * 1024 + (ob ^ (((ob >> 9) & 1) << 5)); }
DEV void stage_rc(int b, int& R, int& C) { const int st = b / 1024, sb = b % 1024, swz = sb ^ (((sb >> 9) & 1) << 5); R = (st >> 1) * 16 + swz / 64; C = (st & 1) * 32 + (swz % 64) / 2; }
DEV int perm32(int rho) { const int n = rho >> 4, i = rho & 15; return 8 * (i >> 2) + 4 * n + (i & 3); }
struct Unit { int pm, pn, e, t; };
struct StaticOrder {
    int nM, nN, nwg, G, c, skipctx; const char* Bt; int K;
    DEV void init(int nM_, int nN_, int G_, int c_, int skipctx_, const void* Bt_, int K_) { nM = nM_; nN = nN_; nwg = nM * nN; G = G_; c = c_; skipctx = skipctx_; Bt = (const char*)Bt_; K = K_; }
    DEV bool next(int i, Unit& u) const {
        const long L = (long)i * G + c; if (L >= nwg) return false;
        int wgid = (int)L; { const int q = nwg / NXCD, r = nwg % NXCD, xcd = wgid % NXCD, off = wgid / NXCD; wgid = (xcd < r ? xcd * (q + 1) : r * (q + 1) + (xcd - r) * q) + off; }
        const int nig = WGM * nN, gid = wgid / nig, fm = gid * WGM, gsz = (nM - fm) < WGM ? (nM - fm) : WGM;
        int pm = fm + ((wgid % nig) % gsz); u.pn = (wgid % nig) / gsz;
        if (skipctx) pm = (pm >> 3) * 9 + 1 + (pm & 7);
        u.pm = pm; u.e = 0; u.t = 0; return true;
    }
    DEV int arow(const Unit& u, int rr) const { return u.pm * BM + rr; }
    DEV const char* bbase(const Unit& u) const { return Bt + (size_t)u.pn * BM * K * 2; }
};
struct EpiF32 {
    static constexpr bool PERM = false;
    float* C; int ldc;
    DEV void operator()(const f32x4 (&acc)[2][2][4][2], const Unit& u, int wr, int wc, int fr, int fq) const {
        const int row0 = u.pm * BM + wr * 64 + fr, col0 = u.pn * BM + wc * 32 + 4 * fq;
#pragma unroll
        for (int ai = 0; ai < 2; ++ai)
#pragma unroll
            for (int m = 0; m < 4; ++m) { float* rowp = C + (size_t)(row0 + ai * HALF + m * 16) * ldc + col0;
#pragma unroll
                for (int bj = 0; bj < 2; ++bj)
#pragma unroll
                    for (int n = 0; n < 2; ++n) *(f32x4*)(rowp + bj * HALF + n * 16) = acc[ai][bj][m][n]; }
    }
};

template <class Epi, class Sched>
DEV void gemm_phase(LAS unsigned char* lds, const char* Abase, const int K, const Sched& S, const Epi& E, const int tid) {
    const int wid = __builtin_amdgcn_readfirstlane(tid >> 6), lane = tid & 63, wr = wid >> 2, wc = wid & 3, fr = lane & 15, fq = lane >> 4;
    const int nt = K / BK;
    unsigned voffB[2];
#pragma unroll
    for (int i = 0; i < 2; ++i) { int R, C; stage_rc(tid * 16 + i * 8192, R, C); const int Rb = Epi::PERM ? ((R & ~31) + perm32(R & 31)) : R;
        voffB[i] = (unsigned)(Rb * K + C) * 2u; }
    const size_t kstep = (size_t)(BK * 2);
    const size_t hstep = (size_t)HALF * K * 2;
    const unsigned ldsw = (unsigned)wid * 1024u;
    const int aoff = lds_byte(wr * 64 + fr, fq * 8), boff = lds_byte(wc * 32 + fr, fq * 8);
#define PG8_SA(b, h) (((b) * 2 + (h)) * HTB)
#define PG8_SB(b, h) ((4 + (b) * 2 + (h)) * HTB)
#define PG8_STAGE_B(bufoff, gbase) do { _Pragma("unroll") for (int _i = 0; _i < 2; ++_i) \
        __builtin_amdgcn_global_load_lds((const unsigned*)((const char*)(gbase) + voffB[_i]), (LAS unsigned*)(lds + (bufoff) + ldsw + _i * 8192), 16, 0, 0); } while (0)
#define PG8_STAGE_A(bufoff, kb, V, h) do { _Pragma("unroll") for (int _i = 0; _i < 2; ++_i) \
        __builtin_amdgcn_global_load_lds((const unsigned*)(Abase + (kb) + (V)[h][_i]), (LAS unsigned*)(lds + (bufoff) + ldsw + _i * 8192), 16, 0, 0); } while (0)
#define PG8_VOFFA(V, u) do { _Pragma("unroll") for (int _i = 0; _i < 2; ++_i) { int _R, _C; stage_rc(tid * 16 + _i * 8192, _R, _C); _Pragma("unroll") for (int _h = 0; _h < 2; ++_h) \
        (V)[_h][_i] = ((unsigned)S.arow(u, _h * HALF + _R) * (unsigned)K + (unsigned)_C) * 2u; } } while (0)
#define PG8_LDA(dst, b, h) do { _Pragma("unroll") for (int m = 0; m < 4; ++m) _Pragma("unroll") for (int k = 0; k < 2; ++k) dst[m][k] = *(const LAS bf16x8*)(lds + PG8_SA(b, h) + aoff + m * 2048 + k * 1024); } while (0)
#define PG8_LDB(dst, b, h) do { _Pragma("unroll") for (int n = 0; n < 2; ++n) _Pragma("unroll") for (int k = 0; k < 2; ++k) dst[n][k] = *(const LAS bf16x8*)(lds + PG8_SB(b, h) + boff + n * 2048 + k * 1024); } while (0)
#define PG8_MMA(ai, bj, At, Bt) do { __builtin_amdgcn_s_setprio(1); _Pragma("unroll") for (int m = 0; m < 4; ++m) _Pragma("unroll") for (int n = 0; n < 2; ++n) _Pragma("unroll") for (int k = 0; k < 2; ++k) \
        acc[ai][bj][m][n] = __builtin_amdgcn_mfma_f32_16x16x32_bf16(Bt[n][k], At[m][k], acc[ai][bj][m][n], 0, 0, 0); __builtin_amdgcn_s_setprio(0); } while (0)
#define PG8_WAIT_V(n) asm volatile("s_waitcnt vmcnt(" #n ")" ::: "memory")
#define PG8_WAIT_L(n) asm volatile("s_waitcnt lgkmcnt(" #n ")" ::: "memory")
#define PG8_BAR __builtin_amdgcn_s_barrier()
#define PG8_SCHED __builtin_amdgcn_sched_barrier(0)
    Unit cur, nxt; int ui = 0;
    if (!S.next(0, cur)) return;
    f32x4 acc[2][2][4][2];
#pragma unroll
    for (int a = 0; a < 2; ++a)
#pragma unroll
        for (int b = 0; b < 2; ++b)
#pragma unroll
            for (int m = 0; m < 4; ++m)
#pragma unroll
                for (int n = 0; n < 2; ++n) acc[a][b][m][n] = (f32x4){0.f, 0.f, 0.f, 0.f};
    bf16x8 At[4][2], B0[2][2], B1[2][2];
    unsigned vc[2][2], v2[2][2];
    PG8_VOFFA(vc, cur);
    const char* cB = S.bbase(cur);
    PG8_STAGE_B(PG8_SB(0, 0), cB); PG8_STAGE_A(PG8_SA(0, 0), 0, vc, 0); PG8_STAGE_B(PG8_SB(0, 1), cB + hstep); PG8_STAGE_A(PG8_SA(0, 1), 0, vc, 1);
    if (wr == 1) PG8_BAR;
    PG8_WAIT_V(4); PG8_BAR;
    PG8_STAGE_B(PG8_SB(1, 0), cB + kstep); PG8_STAGE_A(PG8_SA(1, 0), kstep, vc, 0); PG8_STAGE_B(PG8_SB(1, 1), cB + hstep + kstep);
    PG8_WAIT_V(6); PG8_BAR;
    for (;;) {
        const bool has_next = S.next(ui + 1, nxt);
        const char* nB = has_next ? S.bbase(nxt) : cB;
        for (int t = 0; t < nt; t += 2) {
            const bool last = (t == nt - 2);
            const size_t k1 = (size_t)(t + 1) * kstep, k2 = last ? (size_t)0 : (size_t)(t + 2) * kstep, k3 = k2 + kstep;
            if (last && has_next) { PG8_VOFFA(v2, nxt); } else {
#pragma unroll
                for (int h = 0; h < 2; ++h)
#pragma unroll
                    for (int i = 0; i < 2; ++i) v2[h][i] = vc[h][i]; }
            const char* b2 = last ? nB : cB + (size_t)(t + 2) * kstep; const char* b3 = b2 + kstep;
            PG8_LDB(B0, 0, 0); PG8_SCHED; PG8_LDA(At, 0, 0); PG8_STAGE_A(PG8_SA(1, 1), k1, vc, 1);
            PG8_WAIT_L(8); PG8_BAR; PG8_WAIT_L(0); PG8_MMA(0, 0, At, B0); PG8_BAR; PG8_SCHED;
            PG8_LDB(B1, 0, 1); PG8_STAGE_B(PG8_SB(0, 0), b2);
            PG8_BAR; PG8_WAIT_L(0); PG8_MMA(0, 1, At, B1); PG8_BAR;
            PG8_LDA(At, 0, 1); PG8_STAGE_A(PG8_SA(0, 0), k2, v2, 0);
            PG8_BAR; PG8_WAIT_L(0); PG8_MMA(1, 0, At, B0); PG8_BAR; PG8_SCHED;
            PG8_STAGE_B(PG8_SB(0, 1), b2 + hstep);
            PG8_WAIT_V(6); PG8_BAR; PG8_MMA(1, 1, At, B1); PG8_BAR;
            PG8_LDB(B0, 1, 0); PG8_SCHED; PG8_LDA(At, 1, 0); PG8_STAGE_A(PG8_SA(0, 1), k2, v2, 1);
            PG8_WAIT_L(8); PG8_BAR; PG8_WAIT_L(0); PG8_MMA(0, 0, At, B0); PG8_BAR; PG8_SCHED;
            PG8_LDB(B1, 1, 1); PG8_STAGE_B(PG8_SB(1, 0), b3);
            PG8_BAR; PG8_WAIT_L(0); PG8_MMA(0, 1, At, B1); PG8_BAR;
            PG8_LDA(At, 1, 1); PG8_STAGE_A(PG8_SA(1, 0), k3, v2, 0);
            PG8_BAR; PG8_WAIT_L(0); PG8_MMA(1, 0, At, B0); PG8_BAR; PG8_SCHED;
            PG8_STAGE_B(PG8_SB(1, 1), b3 + hstep);
            PG8_WAIT_V(6); PG8_BAR; PG8_MMA(1, 1, At, B1); PG8_BAR;
        }
        E(acc, cur, wr, wc, fr, fq);
        if (!has_next) break;
#pragma unroll
        for (int a = 0; a < 2; ++a)
#pragma unroll
            for (int b = 0; b < 2; ++b)
#pragma unroll
                for (int m = 0; m < 4; ++m)
#pragma unroll
                    for (int n = 0; n < 2; ++n) acc[a][b][m][n] = (f32x4){0.f, 0.f, 0.f, 0.f};
        cur = nxt; cB = nB; ++ui;
#pragma unroll
        for (int h = 0; h < 2; ++h)
#pragma unroll
            for (int i = 0; i < 2; ++i) vc[h][i] = v2[h][i];
    }
    PG8_WAIT_V(0);
    if (wr == 0) PG8_BAR;
    PG8_BAR;
#undef PG8_SA
#undef PG8_SB
#undef PG8_STAGE_A
#undef PG8_STAGE_B
#undef PG8_VOFFA
#undef PG8_LDA
#undef PG8_LDB
#undef PG8_MMA
#undef PG8_WAIT_V
#undef PG8_WAIT_L
#undef PG8_BAR
#undef PG8_SCHED
}
}


namespace att {
using bf16x8 = __attribute__((ext_vector_type(8))) short;
using s16x4  = __attribute__((ext_vector_type(4))) short;
using f32x16 = __attribute__((ext_vector_type(16))) float;
using u32x4  = __attribute__((ext_vector_type(4))) unsigned;
constexpr int KVBLK = 64, LDK = 128;
constexpr int SHM_V = KVBLK * 128 * 2, SHM_K = KVBLK * 128 * 2, SHM_ATTN = 2 * SHM_V + 2 * SHM_K + 8 * 64 * 4;
constexpr float THR = 8.f;
#define KSWZ(row, colB) ((row) * 256 + ((colB) ^ (((row) & 7) << 4)))
#define SBAR() __builtin_amdgcn_sched_barrier(0)
DEV int crow(int r, int hi) { return (r & 3) + 8 * (r >> 2) + 4 * hi; }
DEV void partialSM(f32x16& p0, f32x16& p1, float& m_reg, float& mn, float& alpha) {
  float pmax = p0[0]; for (int r = 1; r < 16; ++r) pmax = fmaxf(pmax, p0[r]); for (int r = 0; r < 16; ++r) pmax = fmaxf(pmax, p1[r]);
  { auto rr = __builtin_amdgcn_permlane32_swap(__float_as_uint(pmax), __float_as_uint(pmax), false, false);
    pmax = fmaxf(__uint_as_float(rr[0]), __uint_as_float(rr[1])); }
  if (__builtin_expect(__all(pmax - m_reg <= THR), 1)) { mn = m_reg; alpha = 1.f; }
  else { mn = fmaxf(m_reg, pmax); alpha = __builtin_amdgcn_exp2f(m_reg - mn); m_reg = mn; }
  for (int r = 0; r < 16; ++r) p0[r] = p0[r] - mn; for (int r = 0; r < 16; ++r) p1[r] = p1[r] - mn;
  for (int r = 0; r < 16; ++r) p0[r] = __builtin_amdgcn_exp2f(p0[r]);
}
DEV void finishSM(f32x16& p0, f32x16& p1, float alpha, float& l_reg, bf16x8& pa0, bf16x8& pa1, bf16x8& pa2, bf16x8& pa3) {
  for (int r = 0; r < 16; ++r) p1[r] = __builtin_amdgcn_exp2f(p1[r]);
  float ps = 0; for (int r = 0; r < 16; ++r) ps += p0[r]; for (int r = 0; r < 16; ++r) ps += p1[r];
  { auto rr = __builtin_amdgcn_permlane32_swap(__float_as_uint(ps), __float_as_uint(ps), false, false);
    ps = __uint_as_float(rr[0]) + __uint_as_float(rr[1]); }
  l_reg = l_reg * alpha + ps;
#define PK4(P, BASE, OUT) do { unsigned a0 = cvt_pk_bf16(P[BASE + 0], P[BASE + 1]), a1 = cvt_pk_bf16(P[BASE + 2], P[BASE + 3]);   \
    unsigned b0 = cvt_pk_bf16(P[BASE + 4], P[BASE + 5]), b1 = cvt_pk_bf16(P[BASE + 6], P[BASE + 7]);                              \
    auto r0 = __builtin_amdgcn_permlane32_swap(a0, b0, false, false); auto r1 = __builtin_amdgcn_permlane32_swap(a1, b1, false, false); \
    u32x4 w = {r0[0], r1[0], r0[1], r1[1]}; OUT = *reinterpret_cast<bf16x8*>(&w); } while (0)
  PK4(p0, 0, pa0); PK4(p0, 8, pa1); PK4(p1, 0, pa2); PK4(p1, 8, pa3);
#undef PK4
}
DEV void qkt(f32x16& p0, f32x16& p1, const char* Ks, const bf16x8 (&qr)[4], int r32, int hi, int js) {
  p0 = f32x16{}; p1 = f32x16{};
#pragma unroll
  for (int d0 = 0; d0 < 4; ++d0) { const int cb = ((js * 4 + d0) * 16 + hi * 8) * 2;
    bf16x8 b0 = *reinterpret_cast<const bf16x8*>(Ks + KSWZ(r32, cb));
    bf16x8 b1 = *reinterpret_cast<const bf16x8*>(Ks + KSWZ(32 + r32, cb));
    p0 = __builtin_amdgcn_mfma_f32_32x32x16_bf16(b0, qr[d0], p0, 0, 0, 0);
    p1 = __builtin_amdgcn_mfma_f32_32x32x16_bf16(b1, qr[d0], p1, 0, 0, 0); }
}
DEV int v_st(int k, int c) { const int kk = (k & ~0xC) | ((k & 4) << 1) | ((k & 8) >> 1); return ((kk >> 3) * 4 + (c >> 5)) * 512 + ((kk & 7) * 32 + (c & 31)) * 2; }
DEV int v_rd_base(int lane) { return ((lane & 3) << 3) | (((lane >> 2) & 3) << 6) | (((lane >> 4) & 1) << 5) | (((lane >> 5) & 1) << 8); }
constexpr int v_rd_off(int d0, int ks, int half) { return d0 * 512 + ks * 4096 + half * 2048; }
template <int OFF> DEV s16x4 tr_read(int vb) {
  s16x4 r; asm volatile("ds_read_b64_tr_b16 %0, %1 offset:%2" : "=&v"(r) : "v"(vb), "i"(OFF) : "memory"); return r;
}
template <int D0> DEV void pv_one(f32x16& od, int vb, bf16x8 pa0, bf16x8 pa1, bf16x8 pa2, bf16x8 pa3) {
  const s16x4 l0 = tr_read<v_rd_off(D0, 0, 0)>(vb), h0 = tr_read<v_rd_off(D0, 0, 1)>(vb), l1 = tr_read<v_rd_off(D0, 1, 0)>(vb), h1 = tr_read<v_rd_off(D0, 1, 1)>(vb);
  const s16x4 l2 = tr_read<v_rd_off(D0, 2, 0)>(vb), h2 = tr_read<v_rd_off(D0, 2, 1)>(vb), l3 = tr_read<v_rd_off(D0, 3, 0)>(vb), h3 = tr_read<v_rd_off(D0, 3, 1)>(vb);
  asm volatile("s_waitcnt lgkmcnt(0)" ::: "memory"); SBAR();
#define PK(L, H) (bf16x8){L[0], L[1], L[2], L[3], H[0], H[1], H[2], H[3]}
  od = __builtin_amdgcn_mfma_f32_32x32x16_bf16(pa0, PK(l0, h0), od, 0, 0, 0);
  od = __builtin_amdgcn_mfma_f32_32x32x16_bf16(pa1, PK(l1, h1), od, 0, 0, 0);
  od = __builtin_amdgcn_mfma_f32_32x32x16_bf16(pa2, PK(l2, h2), od, 0, 0, 0);
  od = __builtin_amdgcn_mfma_f32_32x32x16_bf16(pa3, PK(l3, h3), od, 0, 0, 0);
#undef PK
}
DEV void pv_d0(f32x16* o, int vb, bf16x8 pa0, bf16x8 pa1, bf16x8 pa2, bf16x8 pa3) {
  pv_one<0>(o[0], vb, pa0, pa1, pa2, pa3); pv_one<1>(o[1], vb, pa0, pa1, pa2, pa3); pv_one<2>(o[2], vb, pa0, pa1, pa2, pa3); pv_one<3>(o[3], vb, pa0, pa1, pa2, pa3);
}
DEV void attn_tiles(const bf16x8 (&qr)[4], const bf16_t* __restrict__ Kh, const bf16_t* __restrict__ Vh, int seq, char* lds,
                    float& m_reg, float& l_reg, f32x16 (&o)[4], int tid, int js) {
  const int wid = tid >> 6, lane = tid & 63, r32 = lane & 31, hi = lane >> 5;
  char* V_lds = lds; char* K_lds = lds + 2 * SHM_V;
  float* ws = (float*)(lds + 2 * SHM_V + 2 * SHM_K) + wid * 64; float* al_l = ws + 32;
  const int sr = tid >> 4, sc = (tid & 15) * 8, vst0 = v_st(sr, sc), vst1 = v_st(32 + sr, sc);
  const int vb0 = (int)(uintptr_t)V_lds + v_rd_base(lane);
  struct { bf16x8 vs0, vs1, ks0, ks1; } sr_[2];
  const unsigned lo0 = (unsigned)((sr * LDK + sc) * 2), lo1 = lo0 + 32u * LDK * 2u;
#define SLOAD(i, k0) do { const char* vb_ = (const char*)Vh + (size_t)(k0) * (LDK * 2); const char* kb_ = (const char*)Kh + (size_t)(k0) * (LDK * 2); \
    sr_[i].vs0 = *(const bf16x8*)(vb_ + lo0); sr_[i].vs1 = *(const bf16x8*)(vb_ + lo1); sr_[i].ks0 = *(const bf16x8*)(kb_ + lo0); sr_[i].ks1 = *(const bf16x8*)(kb_ + lo1); } while (0)
#define SWRITE(b, i) do { *(bf16x8*)(V_lds + (b) * SHM_V + vst0) = sr_[i].vs0;          \
    *(bf16x8*)(V_lds + (b) * SHM_V + vst1) = sr_[i].vs1; int kc = sc * 2;               \
    *(bf16x8*)(K_lds + (b) * SHM_K + KSWZ(sr, kc)) = sr_[i].ks0;                       \
    *(bf16x8*)(K_lds + (b) * SHM_K + KSWZ(32 + sr, kc)) = sr_[i].ks1; } while (0)
#define SWAIT() asm volatile("s_waitcnt vmcnt(4)" ::: "memory")
#define RESC(a) do { if (__any((a) < 1.f)) { if (hi == 0) al_l[r32] = (a); asm volatile("s_waitcnt lgkmcnt(0)" ::: "memory"); \
    for (int d = 0; d < 4; ++d) for (int r = 0; r < 16; ++r) o[d][r] *= al_l[crow(r, hi)]; } } while (0)
  f32x16 pA0, pA1, pB0, pB1; float mnA, mnB, alA, alB; bf16x8 pa0, pa1, pa2, pa3; const int NTL = seq / KVBLK;
  constexpr int SE = 0, SO = 1;
  __syncthreads();
  SLOAD(SE, 0); asm volatile("s_waitcnt vmcnt(0)" ::: "memory"); SWRITE(0, SE); __syncthreads();
  qkt(pA0, pA1, K_lds, qr, r32, hi, js); partialSM(pA0, pA1, m_reg, mnA, alA);
  SLOAD(SO, KVBLK); if (2 < NTL) SLOAD(SE, 2 * KVBLK);
  SWAIT(); SWRITE(1, SO); __syncthreads();
  RESC(alA);
  for (int j = 1; j + 1 < NTL; j += 2) {
    SBAR(); qkt(pB0, pB1, K_lds + SHM_K, qr, r32, hi, js);
    finishSM(pA0, pA1, alA, l_reg, pa0, pa1, pa2, pa3); SBAR();
    SLOAD(SO, (j + 2) * KVBLK); SBAR();
    pv_d0(o, vb0, pa0, pa1, pa2, pa3); partialSM(pB0, pB1, m_reg, mnB, alB);
    __syncthreads(); SWAIT(); SWRITE(0, SE);
    RESC(alB); __syncthreads();
    SBAR(); qkt(pA0, pA1, K_lds, qr, r32, hi, js);
    finishSM(pB0, pB1, alB, l_reg, pa0, pa1, pa2, pa3); SBAR();
    if (j + 3 < NTL) SLOAD(SE, (j + 3) * KVBLK); SBAR();
    pv_d0(o, vb0 + SHM_V, pa0, pa1, pa2, pa3); partialSM(pA0, pA1, m_reg, mnA, alA);
    __syncthreads(); SWAIT(); SWRITE(1, SO);
    RESC(alA); __syncthreads();
  }
  SBAR(); qkt(pB0, pB1, K_lds + SHM_K, qr, r32, hi, js);
  finishSM(pA0, pA1, alA, l_reg, pa0, pa1, pa2, pa3); SBAR();
  pv_d0(o, vb0, pa0, pa1, pa2, pa3); partialSM(pB0, pB1, m_reg, mnB, alB);
  __syncthreads(); RESC(alB);
  finishSM(pB0, pB1, alB, l_reg, pa0, pa1, pa2, pa3); SBAR();
  pv_d0(o, vb0 + SHM_V, pa0, pa1, pa2, pa3);
#undef SLOAD
#undef SWRITE
#undef SWAIT
#undef RESC
}
}

DEV void cvt_tile(const float* src, int ld, int nvalid, bf16_t* dst, int K, int n0, int k0, float* T, const int t) {
#pragma unroll
    for (int h = 0; h < 2; ++h) {
        const int kk = (t >> 4) + 32 * h, nq = (t & 15) * 4, n = n0 + nq;
        const float4 v = n < nvalid ? *(const float4*)(src + (size_t)(k0 + kk) * ld + n) : make_float4(0.f, 0.f, 0.f, 0.f);
        T[(nq + 0) * 65 + kk] = v.x; T[(nq + 1) * 65 + kk] = v.y; T[(nq + 2) * 65 + kk] = v.z; T[(nq + 3) * 65 + kk] = v.w;
    }
    __syncthreads();
    { const int n = t >> 3, kq = (t & 7) * 8; const float* r = T + n * 65 + kq;
      pg8::u32x4 w; w.x = cvt_pk_bf16(r[0], r[1]); w.y = cvt_pk_bf16(r[2], r[3]); w.z = cvt_pk_bf16(r[4], r[5]); w.w = cvt_pk_bf16(r[6], r[7]);
      *(pg8::u32x4*)(dst + (size_t)(n0 + n) * K + k0 + kq) = w; }
    __syncthreads();
}
DEV void ph_convert(const Params& p, char* smem) {
    const int tidx = tid_of(p.wave_id);
    float* T = (float*)smem;
    constexpr int T_IN = 2 * 60 * 16, T_OUT = 2 * 16 * 16, T_W1 = 64 * 32 * 16, T_W2 = 64 * 16 * 16;
    for (int u = blockIdx.x; u < T_IN + T_OUT + T_W1 + T_W2; u += gridDim.x) {
        if (u < T_IN) { const int l = u / 960, r = u % 960, nt = r >> 4, kt = r & 15;
            cvt_tile(p.w_in + (size_t)l * D * DPW, DPW, DPW, (bf16_t*)(p.ws + OFF_WIN) + (size_t)l * DP * D, D, nt * 64, kt * 64, T, tidx); }
        else if (u < T_IN + T_OUT) { const int v = u - T_IN, l = v >> 8, r = v & 255, nt = r >> 4, kt = r & 15;
            cvt_tile(p.w_out + (size_t)l * D * D, D, D, (bf16_t*)(p.ws + OFF_WOUT) + (size_t)l * D * D, D, nt * 64, kt * 64, T, tidx); }
        else if (u < T_IN + T_OUT + T_W1) { const int v = u - T_IN - T_OUT, le = v >> 9, r = v & 511, nt = r >> 4, kt = r & 15;
            cvt_tile(p.w1 + (size_t)le * D * 2048, 2048, 2048, (bf16_t*)(p.ws + OFF_W1T) + (size_t)le * 2048 * D, D, nt * 64, kt * 64, T, tidx); }
        else { const int v = u - T_IN - T_OUT - T_W1, le = v >> 8, r = v & 255, nt = r >> 4, kt = r & 15;
            cvt_tile(p.w2 + (size_t)le * DFF * D, D, D, (bf16_t*)(p.ws + OFF_W2T) + (size_t)le * D * DFF, DFF, nt * 64, kt * 64, T, tidx); }
    }
}

DEV void row_load(const float* src, float4 (&v)[4], int lane) {
#pragma unroll
    for (int i = 0; i < 4; ++i) v[i] = *(const float4*)(src + i * 256 + lane * 4);
}
DEV void row_store(float* dst, const float4 (&v)[4], int lane) {
#pragma unroll
    for (int i = 0; i < 4; ++i) *(float4*)(dst + i * 256 + lane * 4) = v[i];
}
DEV void row_store_bf16(bf16_t* dst, const float4 (&v)[4], int lane) {
#pragma unroll
    for (int i = 0; i < 4; ++i) { pg8::u32x2 w; w.x = cvt_pk_bf16(v[i].x, v[i].y); w.y = cvt_pk_bf16(v[i].z, v[i].w); *(pg8::u32x2*)(dst + i * 256 + lane * 4) = w; }
}
DEV float row_rinv(const float4 (&v)[4]) {
    float ss = 0.f;
#pragma unroll
    for (int i = 0; i < 4; ++i) ss += v[i].x * v[i].x + v[i].y * v[i].y + v[i].z * v[i].z + v[i].w * v[i].w;
    ss = wsum(ss);
    return rsqrtf(ss * (1.f / 1024.f) + 1e-6f);
}
DEV void row_modnorm(const float4 (&v)[4], const float* gain, const float* shift, const float* scale, float4 (&o)[4], int lane) {
    const float r = row_rinv(v);
#pragma unroll
    for (int i = 0; i < 4; ++i) {
        const int idx = i * 256 + lane * 4;
        const float4 g = *(const float4*)(gain + idx), sh = *(const float4*)(shift + idx), sc = *(const float4*)(scale + idx);
        o[i].x = v[i].x * r * g.x * (1.f + sc.x) + sh.x; o[i].y = v[i].y * r * g.y * (1.f + sc.y) + sh.y;
        o[i].z = v[i].z * r * g.z * (1.f + sc.z) + sh.z; o[i].w = v[i].w * r * g.w * (1.f + sc.w) + sh.w;
    }
}
DEV const float* modrow(const Params& p, int layer, int b, int s) { return ((float*)(p.ws + OFF_MOD)) + ((size_t)layer * 9 + (s < CTX ? 8 : b)) * 6144; }

DEV void ph_mods(const Params& p, char* smem) {
    const int tidx = tid_of(p.wave_id);
    float (*cond)[1024] = (float (*)[1024])smem;
    float (*red)[9][64] = (float (*)[9][64])(smem + 9 * 1024 * 4);
    const int tid = tidx;
    for (int i = tid; i < 9 * 1024; i += 512) { const int r = i >> 10, k = i & 1023; const float c = r < 8 ? p.c[r * 1024 + k] : p.c_ctx[k]; cond[r][k] = c * sigm(c); }
    __syncthreads();
    for (int u = blockIdx.x; u < 192; u += gridDim.x) {
        const int layer = u / 96, cg = u % 96, jj = tid & 63, ks = tid >> 6, j = cg * 64 + jj;
        float acc[9];
#pragma unroll
        for (int r = 0; r < 9; ++r) acc[r] = 0.f;
        const float* w = p.ada_w + (size_t)layer * 1024 * 6144 + j;
        for (int k = ks * 128; k < ks * 128 + 128; ++k) { const float wv = w[(size_t)k * 6144];
#pragma unroll
            for (int r = 0; r < 9; ++r) acc[r] += cond[r][k] * wv; }
#pragma unroll
        for (int r = 0; r < 9; ++r) red[ks][r][jj] = acc[r];
        __syncthreads();
        for (int t = tid; t < 9 * 64; t += 512) { const int r = t >> 6, q = t & 63; float s = 0.f; for (int z = 0; z < 8; ++z) s += red[z][r][q];
            ((float*)(p.ws + OFF_MOD))[((size_t)layer * 9 + r) * 6144 + cg * 64 + q] = s + p.ada_b[layer * 6144 + cg * 64 + q]; }
        __syncthreads();
    }
    if (blockIdx.x == 0) {
        for (int t = tid; t < 1024; t += 512) { const int layer = t >> 9, dir = (t >> 8) & 1, w = t & 255;
            const float t0 = p.hlb[(dir * 2 + 0) * 256 + w], t1 = p.hlb[(dir * 2 + 1) * 256 + w];
            const float mx = fmaxf(t0, t1), e0 = expf(t0 - mx), e1 = expf(t1 - mx);
            float lb = layer == 0 ? 0.f : e1 / (e0 + e1); lb = fminf(fmaxf(lb, 0.f), 1.f);
            ((float*)(p.ws + OFF_LB))[(layer * 2 + dir) * 256 + w] = lb; }
        if (tid < 128) { const int layer = tid >> 6, lane = tid & 63; const float* L = p.dlam + layer * 256;
            const float s1 = wsum(L[lane] * L[64 + lane]), s2 = wsum(L[128 + lane] * L[192 + lane]);
            if (lane == 0) ((float*)(p.ws + OFF_LAM))[layer] = expf(s1) - expf(s2) + lam_init_of(layer); }
    }
}

DEV void ph_init(const Params& p, char* smem) {
    const int tidx = tid_of(p.wave_id);
    const int wid = tidx >> 6, lane = tidx & 63;
    for (int r = blockIdx.x * 8 + wid; r < NT; r += gridDim.x * 8) {
        const int b = r / SL, s = r % SL;
        const float* src = s < CTX ? p.ctx + ((size_t)b * CTX + s) * D : p.x + ((size_t)b * SEQ + (s - CTX)) * D;
        float4 v[4], o[4]; row_load(src, v, lane); row_store(((float*)(p.ws + OFF_X)) + (size_t)r * D, v, lane);
        const float* m = modrow(p, 0, b, s);
        row_modnorm(v, p.norms + 0, m + 0, m + 1024, o, lane);
        row_store_bf16((bf16_t*)(p.ws + OFF_XNB) + (size_t)r * D, o, lane);
    }
}

DEV void ph_inproj(const Params& p, int layer, char* smem) {
    const int tidx = tid_of(p.wave_id);
    pg8::StaticOrder S; S.init(NT / 256, DP / 256, (int)gridDim.x, (int)blockIdx.x, 0, (const bf16_t*)(p.ws + OFF_WIN) + (size_t)layer * DP * D, D);
    pg8::EpiF32 E{(float*)(p.ws + OFF_P), DP};
    pg8::gemm_phase(( LAS unsigned char*)smem, (const char*)(p.ws + OFF_XNB), D, S, E, tid_of(p.wave_id));
}


namespace scn {
using att::bf16x8; using att::s16x4; using att::f32x16; using att::u32x4; using att::crow;
DEV int v_st64(int k, int c) { const int kk = (k & ~0xC) | ((k & 4) << 1) | ((k & 8) >> 1); return ((kk >> 3) * 2 + (c >> 5)) * 512 + ((kk & 7) * 32 + (c & 31)) * 2; }
constexpr int v_rd_off64(int d0, int ks, int half) { return d0 * 512 + ks * 2048 + half * 1024; }
#define SCN_PK(L, H) (bf16x8){L[0], L[1], L[2], L[3], H[0], H[1], H[2], H[3]}
template <int D0> DEV void frags4(int vb, bf16x8& f0, bf16x8& f1, bf16x8& f2, bf16x8& f3) {
    const s16x4 l0 = att::tr_read<v_rd_off64(D0, 0, 0)>(vb), h0 = att::tr_read<v_rd_off64(D0, 0, 1)>(vb), l1 = att::tr_read<v_rd_off64(D0, 1, 0)>(vb), h1 = att::tr_read<v_rd_off64(D0, 1, 1)>(vb);
    const s16x4 l2 = att::tr_read<v_rd_off64(D0, 2, 0)>(vb), h2 = att::tr_read<v_rd_off64(D0, 2, 1)>(vb), l3 = att::tr_read<v_rd_off64(D0, 3, 0)>(vb), h3 = att::tr_read<v_rd_off64(D0, 3, 1)>(vb);
    asm volatile("s_waitcnt lgkmcnt(0)" ::: "memory"); SBAR();
    f0 = SCN_PK(l0, h0); f1 = SCN_PK(l1, h1); f2 = SCN_PK(l2, h2); f3 = SCN_PK(l3, h3);
}
DEV bf16x8 pack8(const float (&v)[8]) { u32x4 w = {cvt_pk_bf16(v[0], v[1]), cvt_pk_bf16(v[2], v[3]), cvt_pk_bf16(v[4], v[5]), cvt_pk_bf16(v[6], v[7])}; return *reinterpret_cast<bf16x8*>(&w); }
DEV void stage64(char* img, const float* src, size_t ld, int lane, float sc = 1.f) {
    const float* row = src + (size_t)lane * ld;
#pragma unroll
    for (int c8 = 0; c8 < 8; ++c8) { const float4 a = *(const float4*)(row + c8 * 8), b = *(const float4*)(row + c8 * 8 + 4);
        u32x4 w = {cvt_pk_bf16(a.x * sc, a.y * sc), cvt_pk_bf16(a.z * sc, a.w * sc), cvt_pk_bf16(b.x * sc, b.y * sc), cvt_pk_bf16(b.z * sc, b.w * sc)};
        *(u32x4*)(img + v_st64(lane, c8 * 8)) = w; }
}
template <int CTRL, int RM> DEV float dpp_f(float oldv, float v, bool bc) { return bc ? __builtin_bit_cast(float, __builtin_amdgcn_update_dpp(__builtin_bit_cast(int, oldv), __builtin_bit_cast(int, v), CTRL, RM, 0xf, true))
                                                                                   : __builtin_bit_cast(float, __builtin_amdgcn_update_dpp(__builtin_bit_cast(int, oldv), __builtin_bit_cast(int, v), CTRL, RM, 0xf, false)); }
DEV float bperm(float v, int src) { return __builtin_bit_cast(float, __builtin_amdgcn_ds_bpermute(src << 2, __builtin_bit_cast(int, v))); }
DEV float scan_inc32(float v) {
    v += dpp_f<0x111, 0xf>(0.f, v, true); v += dpp_f<0x112, 0xf>(0.f, v, true); v += dpp_f<0x114, 0xf>(0.f, v, true); v += dpp_f<0x118, 0xf>(0.f, v, true);
    v += dpp_f<0x142, 0xa>(0.f, v, false);
    return v;
}
DEV float scanmax_inc32(float v) {
    const float ni = -3.0e38f;
    v = fmaxf(v, dpp_f<0x111, 0xf>(ni, v, false)); v = fmaxf(v, dpp_f<0x112, 0xf>(ni, v, false)); v = fmaxf(v, dpp_f<0x114, 0xf>(ni, v, false)); v = fmaxf(v, dpp_f<0x118, 0xf>(ni, v, false));
    v = fmaxf(v, dpp_f<0x142, 0xa>(ni, v, false));
    return v;
}
DEV float scanmax_suf32(float v, int lane) {
    const float ni = -3.0e38f;
    v = fmaxf(v, dpp_f<0x101, 0xf>(ni, v, false)); v = fmaxf(v, dpp_f<0x102, 0xf>(ni, v, false)); v = fmaxf(v, dpp_f<0x104, 0xf>(ni, v, false)); v = fmaxf(v, dpp_f<0x108, 0xf>(ni, v, false));
    const float t = bperm(v, (lane & 32) | 16);
    return (lane & 16) ? v : fmaxf(v, t);
}
DEV float4 ldg4(const float* ub, unsigned boff) { return *(const float4*)((const char*)ub + boff); }
DEV float ldg1(const float* ub, unsigned boff) { return *(const float*)((const char*)ub + boff); }
DEV float fexp(float x) { return __expf(fminf(fmaxf(x, -80.f), 80.f)); }
DEV float fsig(float x) { return __builtin_amdgcn_rcpf(1.f + __expf(-x)); }
DEV void decay_ks(const float (&x)[2][8], const float (&lb)[8], int dir, int lane, float (&cum)[2][8], float (&kk)[2][8], float (&ref)[8]) {
#pragma unroll
    for (int tb = 0; tb < 2; ++tb)
#pragma unroll
        for (int j = 0; j < 8; ++j) { const float sg = fsig(x[tb][j]); kk[tb][j] = (1.f - lb[j]) * (1.f - sg); cum[tb][j] = __logf(fmaxf(lb[j] + (1.f - lb[j]) * sg, 1e-12f)); }
#pragma unroll
    for (int j = 0; j < 8; ++j) {
        const float i0 = scan_inc32(cum[0][j]), i1 = scan_inc32(cum[1][j]), t0 = bperm(i0, lane | 31), t1 = bperm(i1, lane | 31);
        if (dir == 0) { cum[0][j] = i0; cum[1][j] = i1 + t0; ref[j] = t0; }
        else { const float x0 = cum[0][j], x1 = cum[1][j]; cum[1][j] = t1 - i1 + x1; cum[0][j] = t0 - i0 + x0 + t1; ref[j] = t1; }
        if ((j & 3) == 3) SBAR();
    }
}
}

DEV void scanA_local(const Params& p, int layer, char* Lw, int bh, int tc, int lane) {
    using namespace scn;
    asm volatile("" : "+v"(lane));
    const int r32 = lane & 31, hi = lane >> 5, b = bh >> 2, h = bh & 3;
    const float* P = (const float*)(p.ws + OFF_P);
    const float* base = P + (size_t)(b * SL + 64 * tc) * DP;
    unsigned lo = (unsigned)(r32 * DP + 8 * hi) * 4u;
    asm volatile("" : "+v"(lo));
    char* imgV = Lw; char* imgK = Lw + 8192;
    const int vbV = (int)(uintptr_t)imgV + att::v_rd_base(lane), vbK = vbV + 8192;
    stage64(imgV, base + O_AI + h * 64, DP, lane);
#pragma unroll 1
    for (int dir = 0; dir < 2; ++dir) {
        const int chain = bh * 2 + dir, c = dir == 0 ? tc : (tc < 4 ? 3 - tc : 39 - tc);
#pragma unroll 1
        for (int ks = 0; ks < 4; ++ks) {
            const int ch = 16 * ks + 8 * hi;
            float x[2][8], cum[2][8], kk[2][8], ref[8], lb[8];
#pragma unroll
            for (int tb = 0; tb < 2; ++tb) { const float* ub = base + (dir ? O_AFB : O_AFF) + h * 64 + 16 * ks; const unsigned bo = lo + tb * (32u * DP * 4u);
                const float4 a = ldg4(ub, bo), bq = ldg4(ub, bo + 16u); x[tb][0] = a.x; x[tb][1] = a.y; x[tb][2] = a.z; x[tb][3] = a.w; x[tb][4] = bq.x; x[tb][5] = bq.y; x[tb][6] = bq.z; x[tb][7] = bq.w; }
            { const float* l = (const float*)(p.ws + OFF_LB) + (layer * 2 + dir) * 256 + h * 64 + ch;
#pragma unroll
              for (int j = 0; j < 8; ++j) lb[j] = l[j]; }
            decay_ks(x, lb, dir, lane, cum, kk, ref);
            float ke[8];
#pragma unroll
            for (int tb = 0; tb < 2; ++tb) {
#pragma unroll
                for (int j = 0; j < 8; ++j) { const float ce = dir == 0 ? bperm(cum[1][j], lane | 31) : bperm(cum[0][j], lane & 32);
                    ke[j] = kk[tb][j] * fexp(ce - cum[tb][j]);
                    if (tb == 1 && dir == 0 && r32 == 31) ((float*)(p.ws + OFF_DECA))[(chain * 36 + c) * 64 + ch + j] = __expf(ce);
                    if (tb == 0 && dir == 1 && r32 == 0) ((float*)(p.ws + OFF_DECA))[(chain * 36 + c) * 64 + ch + j] = __expf(ce); }
                *(bf16x8*)(imgK + v_st64(32 * tb + r32, ch)) = pack8(ke);
            }
            SBAR();
        }
        f32x16 u[2][2] = {};
        { bf16x8 k0, k1, k2, k3, v0, v1, v2, v3;
          frags4<0>(vbK, k0, k1, k2, k3); frags4<0>(vbV, v0, v1, v2, v3);
          u[0][0] = __builtin_amdgcn_mfma_f32_32x32x16_bf16(k0, v0, u[0][0], 0, 0, 0); u[0][0] = __builtin_amdgcn_mfma_f32_32x32x16_bf16(k1, v1, u[0][0], 0, 0, 0);
          u[0][0] = __builtin_amdgcn_mfma_f32_32x32x16_bf16(k2, v2, u[0][0], 0, 0, 0); u[0][0] = __builtin_amdgcn_mfma_f32_32x32x16_bf16(k3, v3, u[0][0], 0, 0, 0);
          bf16x8 w0, w1, w2, w3; frags4<1>(vbV, w0, w1, w2, w3);
          u[0][1] = __builtin_amdgcn_mfma_f32_32x32x16_bf16(k0, w0, u[0][1], 0, 0, 0); u[0][1] = __builtin_amdgcn_mfma_f32_32x32x16_bf16(k1, w1, u[0][1], 0, 0, 0);
          u[0][1] = __builtin_amdgcn_mfma_f32_32x32x16_bf16(k2, w2, u[0][1], 0, 0, 0); u[0][1] = __builtin_amdgcn_mfma_f32_32x32x16_bf16(k3, w3, u[0][1], 0, 0, 0);
          frags4<1>(vbK, k0, k1, k2, k3);
          u[1][0] = __builtin_amdgcn_mfma_f32_32x32x16_bf16(k0, v0, u[1][0], 0, 0, 0); u[1][0] = __builtin_amdgcn_mfma_f32_32x32x16_bf16(k1, v1, u[1][0], 0, 0, 0);
          u[1][0] = __builtin_amdgcn_mfma_f32_32x32x16_bf16(k2, v2, u[1][0], 0, 0, 0); u[1][0] = __builtin_amdgcn_mfma_f32_32x32x16_bf16(k3, v3, u[1][0], 0, 0, 0);
          u[1][1] = __builtin_amdgcn_mfma_f32_32x32x16_bf16(k0, w0, u[1][1], 0, 0, 0); u[1][1] = __builtin_amdgcn_mfma_f32_32x32x16_bf16(k1, w1, u[1][1], 0, 0, 0);
          u[1][1] = __builtin_amdgcn_mfma_f32_32x32x16_bf16(k2, w2, u[1][1], 0, 0, 0); u[1][1] = __builtin_amdgcn_mfma_f32_32x32x16_bf16(k3, w3, u[1][1], 0, 0, 0); }
        float* U = (float*)(p.ws + OFF_UA) + ((size_t)chain * 36 + c) * 4096;
#pragma unroll
        for (int kb = 0; kb < 2; ++kb)
#pragma unroll
            for (int d0 = 0; d0 < 2; ++d0)
#pragma unroll
                for (int r = 0; r < 16; ++r) U[(32 * kb + crow(r, hi)) * 64 + 32 * d0 + r32] = u[kb][d0][r];
    }
}
DEV void scanA_out(const Params& p, int layer, char* Lw, int bh, int tc, int lane) {
    using namespace scn;
    asm volatile("" : "+v"(lane));
    const int r32 = lane & 31, hi = lane >> 5, b = bh >> 2, h = bh & 3;
    const float* P = (const float*)(p.ws + OFF_P);
    const float* base = P + (size_t)(b * SL + 64 * tc) * DP;
    unsigned lo = (unsigned)(r32 * DP + 8 * hi) * 4u;
    asm volatile("" : "+v"(lo));
    char* imgV = Lw; char* imgS = Lw + 8192;
    const int vbV = (int)(uintptr_t)imgV + att::v_rd_base(lane), vbS = vbV + 8192;
    stage64(imgV, base + O_AI + h * 64, DP, lane);
    f32x16 o[2][2] = {};
#pragma unroll 1
    for (int dir = 0; dir < 2; ++dir) {
        const int chain = bh * 2 + dir, c = dir == 0 ? tc : (tc < 4 ? 3 - tc : 39 - tc);
        const float* S0g = (const float*)(p.ws + OFF_SA) + ((size_t)chain * 36 + c) * 4096;
        f32x16 pd0 = {}, pd1 = {}, px = {};
#define MM(acc, A, B) acc = __builtin_amdgcn_mfma_f32_32x32x16_bf16(A, B, acc, 0, 0, 0)
#define KSTEP(ks) do { \
            const int ch = 16 * (ks) + 8 * hi; \
            float x[2][8], cum[2][8], kk[2][8], ref[8], lb[8]; \
            _Pragma("unroll") for (int tb = 0; tb < 2; ++tb) { const float* ub = base + (dir ? O_AFB : O_AFF) + h * 64 + 16 * (ks); const unsigned bo = lo + tb * (32u * DP * 4u); \
                const float4 a = ldg4(ub, bo), bq = ldg4(ub, bo + 16u); x[tb][0] = a.x; x[tb][1] = a.y; x[tb][2] = a.z; x[tb][3] = a.w; x[tb][4] = bq.x; x[tb][5] = bq.y; x[tb][6] = bq.z; x[tb][7] = bq.w; } \
            { const float* l = (const float*)(p.ws + OFF_LB) + (layer * 2 + dir) * 256 + h * 64 + ch; _Pragma("unroll") for (int j = 0; j < 8; ++j) lb[j] = l[j]; } \
            decay_ks(x, lb, dir, lane, cum, kk, ref); \
              \
            { const int ci = lane >> 2, sj = ci & 7, sl = (ci >> 3) * 32; float rv = 0.f; \
              _Pragma("unroll") for (int j = 0; j < 8; ++j) { const float t = bperm(ref[j], sl); rv = (sj == j) ? t : rv; } \
              const float er = __expf(fmaxf(rv, -80.f)); const int row = 16 * (ks) + ci, c16 = (lane & 3) * 16; const float* sp = S0g + row * 64 + c16; \
              const float4 a = *(const float4*)sp, bq = *(const float4*)(sp + 4), cq = *(const float4*)(sp + 8), dq = *(const float4*)(sp + 12); \
              u32x4 w0 = {cvt_pk_bf16(a.x * er, a.y * er), cvt_pk_bf16(a.z * er, a.w * er), cvt_pk_bf16(bq.x * er, bq.y * er), cvt_pk_bf16(bq.z * er, bq.w * er)}; \
              u32x4 w1 = {cvt_pk_bf16(cq.x * er, cq.y * er), cvt_pk_bf16(cq.z * er, cq.w * er), cvt_pk_bf16(dq.x * er, dq.y * er), cvt_pk_bf16(dq.z * er, dq.w * er)}; \
              *(u32x4*)(imgS + v_st64(row, c16)) = w0; *(u32x4*)(imgS + v_st64(row, c16 + 8)) = w1; } \
            bf16x8 qt0, qt1, kt0, kt1; \
            _Pragma("unroll") for (int tb = 0; tb < 2; ++tb) { const float* ub = base + O_AQ + h * 64 + 16 * (ks); const unsigned bo = lo + tb * (32u * DP * 4u); \
                const float4 a = ldg4(ub, bo), bq = ldg4(ub, bo + 16u); const float qv[8] = {a.x, a.y, a.z, a.w, bq.x, bq.y, bq.z, bq.w}; \
                float t1[8], t2[8]; \
                _Pragma("unroll") for (int j = 0; j < 8; ++j) { const float q = qv[j] * fsig(qv[j]); t1[j] = q * fexp(cum[tb][j] - ref[j]); t2[j] = kk[tb][j] * fexp(ref[j] - cum[tb][j]); } \
                if (tb == 0) { qt0 = pack8(t1); kt0 = pack8(t2); } else { qt1 = pack8(t1); kt1 = pack8(t2); } } \
            MM(pd0, kt0, qt0); MM(pd1, kt1, qt1); if (dir == 0) MM(px, kt0, qt1); else MM(px, kt1, qt0); \
            { const s16x4 l0 = att::tr_read<v_rd_off64(0, ks, 0)>(vbS), h0 = att::tr_read<v_rd_off64(0, ks, 1)>(vbS), l1 = att::tr_read<v_rd_off64(1, ks, 0)>(vbS), h1 = att::tr_read<v_rd_off64(1, ks, 1)>(vbS); \
              asm volatile("s_waitcnt lgkmcnt(0)" ::: "memory"); SBAR(); \
              const bf16x8 s0 = SCN_PK(l0, h0), s1 = SCN_PK(l1, h1); \
              MM(o[0][0], qt0, s0); MM(o[1][0], qt1, s0); MM(o[0][1], qt0, s1); MM(o[1][1], qt1, s1); } \
            SBAR(); } while (0)
        KSTEP(0); KSTEP(1); KSTEP(2); KSTEP(3);
#undef KSTEP
#pragma unroll
        for (int r = 0; r < 16; ++r) { const int sl = crow(r, hi); const bool keep = dir == 0 ? (sl <= r32) : (sl >= r32); pd0[r] = keep ? pd0[r] : 0.f; pd1[r] = keep ? pd1[r] : 0.f; }
        bf16x8 a0, a1, b0, b1, c0, c1;
#define PK4(P, BASE, OUT) do { unsigned a0_ = cvt_pk_bf16(P[BASE + 0], P[BASE + 1]), a1_ = cvt_pk_bf16(P[BASE + 2], P[BASE + 3]);   \
    unsigned b0_ = cvt_pk_bf16(P[BASE + 4], P[BASE + 5]), b1_ = cvt_pk_bf16(P[BASE + 6], P[BASE + 7]);                              \
    auto r0_ = __builtin_amdgcn_permlane32_swap(a0_, b0_, false, false); auto r1_ = __builtin_amdgcn_permlane32_swap(a1_, b1_, false, false); \
    u32x4 w_ = {r0_[0], r1_[0], r0_[1], r1_[1]}; OUT = *reinterpret_cast<bf16x8*>(&w_); } while (0)
        PK4(pd0, 0, a0); PK4(pd0, 8, a1); PK4(pd1, 0, b0); PK4(pd1, 8, b1); PK4(px, 0, c0); PK4(px, 8, c1);
#undef PK4
        {   bf16x8 v0, v1, v2, v3;
#define BLOCK(D0) do { frags4<D0>(vbV, v0, v1, v2, v3); \
            if (dir == 0) { MM(o[0][D0], a0, v0); MM(o[0][D0], a1, v1); MM(o[1][D0], c0, v0); MM(o[1][D0], c1, v1); MM(o[1][D0], b0, v2); MM(o[1][D0], b1, v3); } \
            else          { MM(o[0][D0], a0, v0); MM(o[0][D0], a1, v1); MM(o[0][D0], c0, v2); MM(o[0][D0], c1, v3); MM(o[1][D0], b0, v2); MM(o[1][D0], b1, v3); } } while (0)
            BLOCK(0); BLOCK(1);
#undef BLOCK
        }
#undef MM
    }
    unsigned rob = (unsigned)(4 * hi * DP + r32) * 4u, mob = (unsigned)(4 * hi * D + r32) * 2u;
    asm volatile("" : "+v"(rob), "+v"(mob));
#pragma unroll
    for (int tb = 0; tb < 2; ++tb)
#pragma unroll
        for (int r = 0; r < 16; ++r) {
            const float x0 = o[tb][0][r], x1 = o[tb][1][r];
            float t = x0 * x0 + x1 * x1; t += bperm(t, lane ^ 1); t += bperm(t, lane ^ 2); t += bperm(t, lane ^ 4); t += bperm(t, lane ^ 8); t += bperm(t, lane ^ 16);
            const float ri = rsqrtf(t * (1.f / 64.f) + 1e-6f);
            const unsigned tcst = (unsigned)(32 * tb + (r & 3) + 8 * (r >> 2));
            const float* gb = base + O_AG + h * 64; const unsigned go = rob + tcst * (DP * 4u);
            const float g0 = ldg1(gb, go), g1 = ldg1(gb, go + 128u);
            char* mb = (char*)((bf16_t*)(p.ws + OFF_MIXB) + (size_t)(b * SL + 64 * tc) * D + h * 64); const unsigned mo = mob + tcst * (D * 2u);
            *(bf16_t*)(mb + mo) = (bf16_t)(cvt_pk_bf16(x0 * ri * p.hnorm[layer * 64 + r32] * (g0 * fsig(g0)), 0.f) & 0xffffu);
            *(bf16_t*)(mb + mo + 64u) = (bf16_t)(cvt_pk_bf16(x1 * ri * p.hnorm[layer * 64 + 32 + r32] * (g1 * fsig(g1)), 0.f) & 0xffffu);
            if ((r & 3) == 3) SBAR();
        }
}


namespace scn {
DEV float logsig_f(float g) { return fminf(g, 0.f) - __logf(1.f + __expf(-fabsf(g))); }
DEV void gates_B(const float* gb  , unsigned rowoff, int dir, float bi, float bf, int lane, float (&cumf)[2], float (&g)[2], float (&G)[2], float& cend, float& gmax) {
    float lf[2], li[2];
#pragma unroll
    for (int tb = 0; tb < 2; ++tb) { const unsigned bo = rowoff + tb * (32u * DP * 4u); li[tb] = ldg1(gb + (dir * 2 + 0) * 4, bo) + bi; lf[tb] = logsig_f(ldg1(gb + (dir * 2 + 1) * 4, bo) + bf); }
    { const float i0 = scan_inc32(lf[0]), i1 = scan_inc32(lf[1]), t0 = bperm(i0, lane | 31), t1 = bperm(i1, lane | 31);
      if (dir == 0) { cumf[0] = i0; cumf[1] = i1 + t0; } else { cumf[1] = t1 - i1 + lf[1]; cumf[0] = t0 - i0 + lf[0] + t1; }
      cend = t0 + t1; }
    g[0] = li[0] - cumf[0]; g[1] = li[1] - cumf[1];
    if (dir == 0) { const float a0 = scanmax_inc32(g[0]), m0 = bperm(a0, lane | 31), a1 = fmaxf(scanmax_inc32(g[1]), m0); G[0] = a0; G[1] = a1; gmax = bperm(a1, lane | 31); }
    else { const float a1 = scanmax_suf32(g[1], lane), m1 = bperm(a1, lane & 32), a0 = fmaxf(scanmax_suf32(g[0], lane), m1); G[0] = a0; G[1] = a1; gmax = bperm(a0, lane & 32); }
}
}
DEV void scanB_local(const Params& p, int layer, char* Lw, int bh, int tc, int lane) {
    using namespace scn;
    asm volatile("" : "+v"(lane));
    const int r32 = lane & 31, hi = lane >> 5, b = bh >> 2, h = bh & 3;
    const float* base = (const float*)(p.ws + OFF_P) + (size_t)(b * SL + 64 * tc) * DP;
    unsigned ro = (unsigned)(r32 * DP) * 4u; asm volatile("" : "+v"(ro));
    char* imgV = Lw; char* imgK = Lw + 8192;
    const int vbV = (int)(uintptr_t)imgV + att::v_rd_base(lane), vbK = vbV + 8192;
    stage64(imgV, base + O_BV + h * 64, DP, lane);
#pragma unroll 1
    for (int dir = 0; dir < 2; ++dir) {
        const int chain = bh * 2 + dir, c = dir == 0 ? tc : (tc < 4 ? 3 - tc : 39 - tc);
        const float bi = p.mgb[layer * 16 + (dir * 2 + 0) * 4 + h], bf = p.mgb[layer * 16 + (dir * 2 + 1) * 4 + h];
        float cumf[2], g[2], G[2], cend, gmax;
        gates_B(base + O_BG + h, ro, dir, bi, bf, lane, cumf, g, G, cend, gmax);
        const float w[2] = {__expf(g[0] - gmax), __expf(g[1] - gmax)};
#pragma unroll
        for (int ks = 0; ks < 2; ++ks) {
            float un[8];
#pragma unroll
            for (int j = 0; j < 8; ++j) un[j] = 0.f;
#pragma unroll
            for (int tb = 0; tb < 2; ++tb) { const float* ub = base + O_BK + h * 32 + 16 * ks; const unsigned bo = ro + 32u * hi + tb * (32u * DP * 4u);
                const float4 a = ldg4(ub, bo), bq = ldg4(ub, bo + 16u); float wk[8] = {a.x, a.y, a.z, a.w, bq.x, bq.y, bq.z, bq.w};
#pragma unroll
                for (int j = 0; j < 8; ++j) { wk[j] *= w[tb]; un[j] += wk[j]; }
                *(bf16x8*)(imgK + v_st64(32 * tb + r32, 16 * ks + 8 * hi)) = pack8(wk); }
#pragma unroll
            for (int j = 0; j < 8; ++j) { float t = un[j]; t += bperm(t, lane ^ 1); t += bperm(t, lane ^ 2); t += bperm(t, lane ^ 4); t += bperm(t, lane ^ 8); t += bperm(t, lane ^ 16);
                if (r32 == 0) ((float*)(p.ws + OFF_NB))[(chain * 36 + c) * 32 + 16 * ks + 8 * hi + j] = t; }
        }
        f32x16 u0 = {}, u1 = {};
        { bf16x8 k0, k1, k2, k3, v0, v1, v2, v3;
#define MM(acc, A, B) acc = __builtin_amdgcn_mfma_f32_32x32x16_bf16(A, B, acc, 0, 0, 0)
          frags4<0>(vbK, k0, k1, k2, k3); frags4<0>(vbV, v0, v1, v2, v3);
          MM(u0, k0, v0); MM(u0, k1, v1); MM(u0, k2, v2); MM(u0, k3, v3);
          frags4<1>(vbV, v0, v1, v2, v3);
          MM(u1, k0, v0); MM(u1, k1, v1); MM(u1, k2, v2); MM(u1, k3, v3);
#undef MM
        }
        float* U = (float*)(p.ws + OFF_UB) + ((size_t)chain * 36 + c) * 2048;
#pragma unroll
        for (int r = 0; r < 16; ++r) { U[crow(r, hi) * 64 + r32] = u0[r]; U[crow(r, hi) * 64 + 32 + r32] = u1[r]; }
        if (lane == 0) { float* M = (float*)(p.ws + OFF_MB) + (chain * 36 + c) * 4; M[0] = cend + gmax; M[1] = cend; }
    }
}
DEV void scanB_out(const Params& p, int layer, char* Lw, int bh, int tc, int lane) {
    using namespace scn;
    asm volatile("" : "+v"(lane));
    const int r32 = lane & 31, hi = lane >> 5, b = bh >> 2, h = bh & 3;
    const float* base = (const float*)(p.ws + OFF_P) + (size_t)(b * SL + 64 * tc) * DP;
    unsigned ro = (unsigned)(r32 * DP) * 4u; asm volatile("" : "+v"(ro));
    char* imgV = Lw; char* imgC = Lw + 8192; float* gA = (float*)(Lw + 12288); float* dA = gA + 64;
    const int vbV = (int)(uintptr_t)imgV + att::v_rd_base(lane), vbC = vbV + 8192;
    stage64(imgV, base + O_BV + h * 64, DP, lane);
#pragma unroll 1
    for (int dir = 0; dir < 2; ++dir) {
        const int chain = bh * 2 + dir, c = dir == 0 ? tc : (tc < 4 ? 3 - tc : 39 - tc);
        const float bi = p.mgb[layer * 16 + (dir * 2 + 0) * 4 + h], bf = p.mgb[layer * 16 + (dir * 2 + 1) * 4 + h];
        { const float* cg = (const float*)(p.ws + OFF_SB) + ((size_t)chain * 36 + c) * 2048 + (lane >> 1) * 64 + (lane & 1) * 32;
#pragma unroll
          for (int i = 0; i < 4; ++i) { const float4 a = *(const float4*)(cg + 8 * i), bq = *(const float4*)(cg + 8 * i + 4);
              u32x4 w = {cvt_pk_bf16(a.x, a.y), cvt_pk_bf16(a.z, a.w), cvt_pk_bf16(bq.x, bq.y), cvt_pk_bf16(bq.z, bq.w)};
              *(u32x4*)(imgC + v_st64(lane >> 1, (lane & 1) * 32 + 8 * i)) = w; } }
        const float m0 = ((const float*)(p.ws + OFF_MB))[(chain * 36 + c) * 4 + 2];
        float cumf[2], g[2], G[2], cend, gmax;
        gates_B(base + O_BG + h, ro, dir, bi, bf, lane, cumf, g, G, cend, gmax);
        float wi[2], wl[2], emt[2];
#pragma unroll
        for (int tb = 0; tb < 2; ++tb) { const float ml = cumf[tb] + G[tb], mt = fmaxf(cumf[tb] + m0, ml); wi[tb] = __expf(cumf[tb] + m0 - mt); wl[tb] = __expf(ml - mt); emt[tb] = __expf(-mt); }
        if (hi == 0) { gA[r32] = g[0]; gA[32 + r32] = g[1]; }
        f32x16 pd0 = {}, pd1 = {}, px = {};
        float qn[2] = {0.f, 0.f};
        bf16x8 qw[2][2];
#define MM(acc, A, B) acc = __builtin_amdgcn_mfma_f32_32x32x16_bf16(A, B, acc, 0, 0, 0)
#define KSTEP(ks) do { \
            bf16x8 qs0, qs1, kt0, kt1; \
            const float* nn = (const float*)(p.ws + OFF_N0) + (chain * 36 + c) * 32 + 16 * (ks) + 8 * hi; \
            _Pragma("unroll") for (int tb = 0; tb < 2; ++tb) { const unsigned bo = ro + 32u * hi + tb * (32u * DP * 4u); \
                const float* uq = base + O_BQ + h * 32 + 16 * (ks); const float* uk = base + O_BK + h * 32 + 16 * (ks); \
                const float4 a = ldg4(uq, bo), bq = ldg4(uq, bo + 16u), ck = ldg4(uk, bo), dk = ldg4(uk, bo + 16u); \
                float q8[8] = {a.x, a.y, a.z, a.w, bq.x, bq.y, bq.z, bq.w}; const float k8[8] = {ck.x, ck.y, ck.z, ck.w, dk.x, dk.y, dk.z, dk.w}; float qv[8]; \
                _Pragma("unroll") for (int j = 0; j < 8; ++j) { q8[j] *= 0.17677669529663687f; qn[tb] += q8[j] * nn[j]; qv[j] = q8[j] * wi[tb]; } \
                qw[tb][ks] = pack8(qv); \
                if (tb == 0) { qs0 = pack8(q8); kt0 = pack8(k8); } else { qs1 = pack8(q8); kt1 = pack8(k8); } } \
            MM(pd0, kt0, qs0); MM(pd1, kt1, qs1); if (dir == 0) MM(px, kt0, qs1); else MM(px, kt1, qs0); \
            SBAR(); } while (0)
        KSTEP(0); KSTEP(1);
#undef KSTEP
        qn[0] += bperm(qn[0], lane ^ 32); qn[1] += bperm(qn[1], lane ^ 32);
        float ds[2] = {0.f, 0.f};
#pragma unroll
        for (int r = 0; r < 16; ++r) {
            const int sl = crow(r, hi); const bool keep = dir == 0 ? (sl <= r32) : (sl >= r32);
            const float g0 = gA[sl], g1 = gA[32 + sl];
            const float e00 = keep ? __expf(g0 - G[0]) * wl[0] : 0.f, e11 = keep ? __expf(g1 - G[1]) * wl[1] : 0.f;
            const float ex = dir == 0 ? __expf(g0 - G[1]) * wl[1] : __expf(g1 - G[0]) * wl[0];
            pd0[r] *= e00; pd1[r] *= e11; px[r] *= ex;
            if (dir == 0) { ds[0] += pd0[r]; ds[1] += pd1[r] + px[r]; } else { ds[0] += pd0[r] + px[r]; ds[1] += pd1[r]; }
        }
        ds[0] += bperm(ds[0], lane ^ 32); ds[1] += bperm(ds[1], lane ^ 32);
#pragma unroll
        for (int tb = 0; tb < 2; ++tb) { const float den = wi[tb] * qn[tb] + ds[tb]; const float di = __builtin_amdgcn_rcpf(fmaxf(fabsf(den), emt[tb])); if (hi == 0) dA[32 * tb + r32] = di; }
        bf16x8 a0, a1, b0, b1, c0, c1;
#define PK4(P, BASE, OUT) do { unsigned a0_ = cvt_pk_bf16(P[BASE + 0], P[BASE + 1]), a1_ = cvt_pk_bf16(P[BASE + 2], P[BASE + 3]);   \
    unsigned b0_ = cvt_pk_bf16(P[BASE + 4], P[BASE + 5]), b1_ = cvt_pk_bf16(P[BASE + 6], P[BASE + 7]);                              \
    auto r0_ = __builtin_amdgcn_permlane32_swap(a0_, b0_, false, false); auto r1_ = __builtin_amdgcn_permlane32_swap(a1_, b1_, false, false); \
    u32x4 w_ = {r0_[0], r1_[0], r0_[1], r1_[1]}; OUT = *reinterpret_cast<bf16x8*>(&w_); } while (0)
        PK4(pd0, 0, a0); PK4(pd0, 8, a1); PK4(pd1, 0, b0); PK4(pd1, 8, b1); PK4(px, 0, c0); PK4(px, 8, c1);
#undef PK4
        SBAR();
        f32x16 o[2][2] = {};
        {   bf16x8 v0, v1, v2, v3;
#define BLOCK(D0) do { frags4<D0>(vbV, v0, v1, v2, v3); \
            if (dir == 0) { MM(o[0][D0], a0, v0); MM(o[0][D0], a1, v1); MM(o[1][D0], c0, v0); MM(o[1][D0], c1, v1); MM(o[1][D0], b0, v2); MM(o[1][D0], b1, v3); } \
            else          { MM(o[0][D0], a0, v0); MM(o[0][D0], a1, v1); MM(o[0][D0], c0, v2); MM(o[0][D0], c1, v3); MM(o[1][D0], b0, v2); MM(o[1][D0], b1, v3); } \
            { const s16x4 l0 = att::tr_read<v_rd_off64(D0, 0, 0)>(vbC), h0 = att::tr_read<v_rd_off64(D0, 0, 1)>(vbC), l1 = att::tr_read<v_rd_off64(D0, 1, 0)>(vbC), h1 = att::tr_read<v_rd_off64(D0, 1, 1)>(vbC); \
              asm volatile("s_waitcnt lgkmcnt(0)" ::: "memory"); SBAR(); \
              const bf16x8 s0 = SCN_PK(l0, h0), s1 = SCN_PK(l1, h1); \
              MM(o[0][D0], qw[0][0], s0); MM(o[0][D0], qw[0][1], s1); MM(o[1][D0], qw[1][0], s0); MM(o[1][D0], qw[1][1], s1); } } while (0)
            BLOCK(0); BLOCK(1);
#undef BLOCK
        }
#undef MM
        asm volatile("s_waitcnt lgkmcnt(0)" ::: "memory");
        unsigned rob = (unsigned)(4 * hi * DP + r32) * 4u, mob = (unsigned)(4 * hi * D + r32) * 2u, hob = (unsigned)(4 * hi * 256 + r32) * 4u;
        asm volatile("" : "+v"(rob), "+v"(mob), "+v"(hob));
        float* hpk = (float*)(p.ws + OFF_HB2) + (size_t)(b * SL + 64 * tc) * 256 + h * 64;
        if (dir == 0) {
#pragma unroll
            for (int tb = 0; tb < 2; ++tb)
#pragma unroll
                for (int r = 0; r < 16; ++r) { const float di = dA[32 * tb + crow(r, hi)]; const unsigned ho = hob + (unsigned)(32 * tb + (r & 3) + 8 * (r >> 2)) * 1024u;
                    *(float*)((char*)hpk + ho) = o[tb][0][r] * di; *(float*)((char*)hpk + ho + 128u) = o[tb][1][r] * di; }
            asm volatile("s_waitcnt vmcnt(0)" ::: "memory");
        } else {
#pragma unroll
            for (int tb = 0; tb < 2; ++tb)
#pragma unroll
                for (int r = 0; r < 16; ++r) {
                    const unsigned tcst = (unsigned)(32 * tb + (r & 3) + 8 * (r >> 2)); const unsigned ho = hob + tcst * 1024u;
                    const float di = dA[32 * tb + crow(r, hi)];
                    const float x0 = o[tb][0][r] * di + ldg1(hpk, ho), x1 = o[tb][1][r] * di + ldg1(hpk, ho + 128u);
                    float t = x0 * x0 + x1 * x1; t += bperm(t, lane ^ 1); t += bperm(t, lane ^ 2); t += bperm(t, lane ^ 4); t += bperm(t, lane ^ 8); t += bperm(t, lane ^ 16);
                    const float ri = rsqrtf(t * (1.f / 64.f) + 1e-6f);
                    const float* gb = base + O_BO + h * 64; const unsigned go = rob + tcst * (DP * 4u);
                    const float g0 = ldg1(gb, go), g1 = ldg1(gb, go + 128u);
                    char* mb = (char*)((bf16_t*)(p.ws + OFF_MIXB) + (size_t)(b * SL + 64 * tc) * D + 256 + h * 64); const unsigned mo = mob + tcst * (D * 2u);
                    *(bf16_t*)(mb + mo) = (bf16_t)(cvt_pk_bf16(x0 * ri * p.mnorm[layer * 256 + h * 64 + r32] * fsig(g0), 0.f) & 0xffffu);
                    *(bf16_t*)(mb + mo + 64u) = (bf16_t)(cvt_pk_bf16(x1 * ri * p.mnorm[layer * 256 + h * 64 + 32 + r32] * fsig(g1), 0.f) & 0xffffu);
                    if ((r & 3) == 3) SBAR();
                }
        }
    }
}

DEV int scan_token(int dir, int step) { return dir == 0 ? step : (step < CTX ? CTX - 1 - step : SL + CTX - 1 - step); }
DEV float logsig(float g) { return fminf(g, 0.f) - log1pf(expf(-fabsf(g))); }
DEV void ph_scan_local(const Params& p, int layer, char* smem) {
    const int wid = p.wave_id, lane = lane_asm();
    const int gw = (int)blockIdx.x * 8 + wid, nw = (int)gridDim.x * 8;
    for (int task = gw; task < 2304; task += nw) {
        if (task < 1152) scanA_local(p, layer, smem + wid * 16384, task / 36, task % 36, lane);
        else scanB_local(p, layer, smem + wid * 16384, (task - 1152) / 36, (task - 1152) % 36, lane);
    }
}
DEV void ph_scan_carry(const Params& p, char* smem) {
    const int tid = tid_of(p.wave_id);
    const int gt = (int)blockIdx.x * 512 + tid, nth = (int)gridDim.x * 512;
    for (int e = gt; e < 64 * 4096; e += nth) {
        const int chain = e >> 12, kv = e & 4095, k = kv >> 6;
        const float* U = (const float*)(p.ws + OFF_UA) + (size_t)chain * 36 * 4096 + kv; float* SO = (float*)(p.ws + OFF_SA) + (size_t)chain * 36 * 4096 + kv; const float* Dc = (const float*)(p.ws + OFF_DECA) + chain * 36 * 64 + k;
        float S = 0.f;
#pragma unroll 4
        for (int c = 0; c < 36; ++c) { const float u = U[(size_t)c * 4096], d = Dc[c * 64]; SO[(size_t)c * 4096] = S; S = d * S + u; }
    }
    for (int e = gt; e < 64 * 2048; e += nth) {
        const int chain = e >> 11, kv = e & 2047;
        const float* U = (const float*)(p.ws + OFF_UB) + (size_t)chain * 36 * 2048 + kv; float* SO = (float*)(p.ws + OFF_SB) + (size_t)chain * 36 * 2048 + kv; const float* M = (const float*)(p.ws + OFF_MB) + chain * 36 * 4;
        float Cc = 0.f, m = 0.f;
#pragma unroll 4
        for (int c = 0; c < 36; ++c) { const float mle = M[c * 4 + 0], ce = M[c * 4 + 1], u = U[(size_t)c * 2048]; SO[(size_t)c * 2048] = Cc;
            const float mn = fmaxf(ce + m, mle); Cc = expf(ce + m - mn) * Cc + expf(mle - mn) * u; m = mn; }
    }
    for (int e = gt; e < 64 * 32; e += nth) {
        const int chain = e >> 5, k = e & 31;
        const float* N = (const float*)(p.ws + OFF_NB) + chain * 36 * 32 + k; float* NO = (float*)(p.ws + OFF_N0) + chain * 36 * 32 + k; float* M = (float*)(p.ws + OFF_MB) + chain * 36 * 4;
        float nn = 0.f, m = 0.f;
        for (int c = 0; c < 36; ++c) { const float mle = M[c * 4 + 0], ce = M[c * 4 + 1], u = N[c * 32]; NO[c * 32] = nn; if (k == 0) M[c * 4 + 2] = m;
            const float mn = fmaxf(ce + m, mle); nn = expf(ce + m - mn) * nn + expf(mle - mn) * u; m = mn; }
    }
}
DEV void ph_scan_out(const Params& p, int layer, char* smem) {
    const int wid = p.wave_id, lane = lane_asm();
    const int gw = (int)blockIdx.x * 8 + wid, nw = (int)gridDim.x * 8;
    for (int task = gw; task < 2304; task += nw) {
        const bool isB = task >= 1152; const int tt = isB ? task - 1152 : task, bh = tt / 36, tc = tt % 36;
        if (layer != 0 && tc < 4) continue;
        if (!isB) scanA_out(p, layer, smem + wid * 16384, bh, tc, lane);
        else scanB_out(p, layer, smem + wid * 16384, bh, tc, lane);
    }
}

DEV void ph_attn_prep(const Params& p, char* smem) {
    const int tidx = tid_of(p.wave_id);
    const int t = tidx, rr = t >> 8, hj = (t >> 5) & 7, half = (t >> 4) & 1, i = t & 15, h = hj >> 1, j = hj & 1;
    const float invf = expf(-(float)i * (1.f / 16.f) * 9.210340371976184f), QC = 0.125f * 1.4426950408889634f;
    bf16_t* KB = (bf16_t*)(p.ws + OFF_KB); bf16_t* VB = (bf16_t*)(p.ws + OFF_VB); bf16_t* QRB = (bf16_t*)(p.ws + OFF_QRB); bf16_t* Q0B = (bf16_t*)(p.ws + OFF_Q0B);
    for (int r = blockIdx.x * 2 + rr; r < NT; r += gridDim.x * 2) {
        const int b = r / SL, s = r % SL;
        float cs = 1.f, sn = 0.f;
        if (s >= CTX) { const int tl = s - CTX; const float pos = half == 0 ? (float)(tl / 64) : (float)(tl % 64); sincosf(pos * invf, &sn, &cs); }
        const float* row = ((float*)(p.ws + OFF_P)) + (size_t)r * DP;
        const int d1 = half * 32 + i, d2 = d1 + 16;
        const float q1 = row[O_CQ + hj * 64 + d1] * QC, q2 = row[O_CQ + hj * 64 + d2] * QC, k1 = row[O_CK + hj * 64 + d1], k2 = row[O_CK + hj * 64 + d2];
        const float v1 = row[O_CV + hj * 64 + d1], v2 = row[O_CV + hj * 64 + d2];
        const size_t o1 = ((size_t)(b * 4 + h) * SL + s) * 128 + j * 64 + d1, o2 = o1 + 16;
#define BF(x) ((bf16_t)(cvt_pk_bf16((x), 0.f) & 0xffffu))
        QRB[o1] = BF(q1 * cs - q2 * sn); QRB[o2] = BF(q1 * sn + q2 * cs);
        Q0B[o1] = BF(q1); Q0B[o2] = BF(q2);
        KB[o1] = BF(k1 * cs - k2 * sn); KB[o2] = BF(k1 * sn + k2 * cs);
        VB[o1] = BF(v1); VB[o2] = BF(v2);
#undef BF
    }
}
DEV void ph_attn(const Params& p, int layer, char* smem) {
    const int wid = p.wave_id, js = wid & 1, qb = wid >> 1;
    const float lam = ((const float*)(p.ws + OFF_LAM))[layer], omli = 1.f - lam_init_of(layer);
    const bf16_t* KB = (const bf16_t*)(p.ws + OFF_KB); const bf16_t* VB = (const bf16_t*)(p.ws + OFF_VB);
    const bf16_t* QRB = (const bf16_t*)(p.ws + OFF_QRB); const bf16_t* Q0B = (const bf16_t*)(p.ws + OFF_Q0B);
    const int G = (int)gridDim.x, c = (int)blockIdx.x;
    const int nlat = 512, ntot = nlat + (layer == 0 ? 64 : 0);
    for (int i = 0;; ++i) {
        int bh, s0; bool isctx;
        if (G == 256) {
            const int xcd = c & 7, j = c >> 3;
            if (i < 2) { bh = xcd + 8 * (i * 2 + (j >> 4)); s0 = CTX + (j & 15) * 128; isctx = false; }
            else if (i == 2 && layer == 0 && j < 8) { bh = xcd + 8 * (j >> 1); s0 = (j & 1) * 128; isctx = true; }
            else break;
        } else {
            const int u = i * G + c; if (u >= ntot) break;
            if (u < nlat) { bh = u >> 4; s0 = CTX + (u & 15) * 128; isctx = false; } else { const int v = u - nlat; bh = v >> 1; s0 = (v & 1) * 128; isctx = true; }
        }
        const int lane = lane_asm(), tid = (wid << 6) | lane, r32 = lane & 31, hi = lane >> 5;
        const bf16_t* Kh = KB + (size_t)bh * SL * 128; const bf16_t* Vh = VB + (size_t)bh * SL * 128;
        const size_t qoff = ((size_t)bh * SL + s0 + qb * 32 + r32) * 128 + js * 64 + hi * 8;
        att::bf16x8 qr[4];
#pragma unroll
        for (int d0 = 0; d0 < 4; ++d0) qr[d0] = *(const att::bf16x8*)(Q0B + qoff + d0 * 16);
        float m_reg = -1e30f, l_reg = 0.f; att::f32x16 o[4] = {};
        att::attn_tiles(qr, Kh, Vh, CTX, smem, m_reg, l_reg, o, tid, js);
        if (!isctx) {
#pragma unroll
            for (int d0 = 0; d0 < 4; ++d0) qr[d0] = *(const att::bf16x8*)(QRB + qoff + d0 * 16);
            att::attn_tiles(qr, Kh + (size_t)CTX * 128, Vh + (size_t)CTX * 128, SEQ, smem, m_reg, l_reg, o, tid, js);
        }
        float* wsw = (float*)(smem + 2 * att::SHM_V + 2 * att::SHM_K) + wid * 64;
        __syncthreads();
        if (hi == 0) wsw[r32] = l_reg;
        asm volatile("s_waitcnt lgkmcnt(0)" ::: "memory");
        float rli[16];
#pragma unroll
        for (int r = 0; r < 16; ++r) rli[r] = __builtin_amdgcn_rcpf(wsw[att::crow(r, hi)]);
        float* X = (float*)smem + qb * 4096;
        if (js == 1) {
#pragma unroll
            for (int d0 = 0; d0 < 4; ++d0)
#pragma unroll
                for (int r = 0; r < 16; ++r) X[(d0 * 16 + r) * 64 + lane] = o[d0][r] * rli[r];
        }
        __syncthreads();
        if (js == 0) {
            const int b = bh >> 2, h = bh & 3;
            float ss[16];
#pragma unroll
            for (int r = 0; r < 16; ++r) ss[r] = 0.f;
#pragma unroll
            for (int d0 = 0; d0 < 4; ++d0)
#pragma unroll
                for (int r = 0; r < 16; ++r) { const float v = o[d0][r] * rli[r] - lam * X[(d0 * 16 + r) * 64 + lane]; o[d0][r] = v; ss[r] += v * v; }
#pragma unroll
            for (int r = 0; r < 16; ++r) { float t = ss[r]; t += __shfl_xor(t, 1); t += __shfl_xor(t, 2); t += __shfl_xor(t, 4); t += __shfl_xor(t, 8); t += __shfl_xor(t, 16);
                ss[r] = rsqrtf(t * (1.f / 128.f) + 1e-6f) * omli; }
            bf16_t* mix = (bf16_t*)(p.ws + OFF_MIXB) + (size_t)(b * SL + s0 + qb * 32) * D + 512 + h * 128 + r32;
#pragma unroll
            for (int d0 = 0; d0 < 4; ++d0) { const float g = p.dnorm[layer * 128 + d0 * 32 + r32];
#pragma unroll
                for (int r = 0; r < 16; ++r) mix[(size_t)att::crow(r, hi) * D + d0 * 32] = (bf16_t)(cvt_pk_bf16(o[d0][r] * ss[r] * g, 0.f) & 0xffffu); }
        }
        __syncthreads();
    }
}
DEV void ph_outproj(const Params& p, int layer, char* smem) {
    const int tidx = tid_of(p.wave_id);
    pg8::StaticOrder S; S.init(layer == 0 ? NT / 256 : NB * 8, D / 256, (int)gridDim.x, (int)blockIdx.x, layer == 0 ? 0 : 1, (const bf16_t*)(p.ws + OFF_WOUT) + (size_t)layer * D * D, D);
    pg8::EpiF32 E{(float*)(p.ws + OFF_MIXO), D};
    pg8::gemm_phase((LAS unsigned char*)smem, (const char*)(p.ws + OFF_MIXB), D, S, E, tid_of(p.wave_id));
}
DEV void ph_norm2(const Params& p, int layer, char* smem) {
    typedef float f32x16 __attribute__((ext_vector_type(16)));
    const int tidx = tid_of(p.wave_id), wid = tidx >> 6, lane = tidx & 63;
    constexpr int XP = 1028;
    float* xs = (float*)smem;
    float* red = (float*)smem;
    int* hist = (int*)(smem + 32 * XP * 4);
    const float* nr = p.norms + (size_t)layer * 4 * D;
    if (tidx < NE) hist[tidx] = 0;
    const int chunk = (NT + (int)gridDim.x - 1) / (int)gridDim.x, rbeg = (int)blockIdx.x * chunk, rend = min(NT, rbeg + chunk);
    const float* rw = p.rw + (size_t)layer * D * NE;
    for (int r0 = rbeg; r0 < rend; r0 += 32) {
        __syncthreads();
#pragma unroll 1
        for (int j = 0; j < 4; ++j) {
            const int lr = wid * 4 + j, r = r0 + lr;
            if (r >= rend) continue;
            const int b = r / SL, s = r % SL;
            if (layer != 0 && s < CTX) continue;
            const float* m = modrow(p, layer, b, s);
            float4 mo[4], xv[4], o[4]; row_load(((float*)(p.ws + OFF_MIXO)) + (size_t)r * D, mo, lane); row_load(((float*)(p.ws + OFF_X)) + (size_t)r * D, xv, lane);
            const float ri = row_rinv(mo);
#pragma unroll
            for (int i = 0; i < 4; ++i) { const int idx = i * 256 + lane * 4; const float4 g = *(const float4*)(nr + D + idx), gt = *(const float4*)(m + 2048 + idx);
                xv[i].x += gt.x * (mo[i].x * ri * g.x); xv[i].y += gt.y * (mo[i].y * ri * g.y); xv[i].z += gt.z * (mo[i].z * ri * g.z); xv[i].w += gt.w * (mo[i].w * ri * g.w); }
            row_store(((float*)(p.ws + OFF_XN)) + (size_t)r * D, xv, lane);
            row_modnorm(xv, nr + 2 * D, m + 3072, m + 4096, o, lane);
            row_store_bf16((bf16_t*)(p.ws + OFF_XNB) + (size_t)r * D, o, lane);
            row_store(xs + lr * XP, o, lane);
        }
        __syncthreads();
        f32x16 acc = {};
        { const int row = lane & 31, kh = lane >> 5, k0 = wid * 128;
          const float* xa = xs + row * XP + k0 + kh; const float* wb = rw + (size_t)(k0 + kh) * NE + row;
#pragma unroll 8
          for (int ks = 0; ks < 64; ++ks) acc = __builtin_amdgcn_mfma_f32_32x32x2f32(xa[2 * ks], wb[(size_t)2 * ks * NE], acc, 0, 0, 0); }
        __syncthreads();
#pragma unroll
        for (int rg = 0; rg < 16; ++rg) red[(wid * 32 + (rg & 3) + 8 * (rg >> 2) + 4 * (lane >> 5)) * 32 + (lane & 31)] = acc[rg];
        __syncthreads();
#pragma unroll 1
        for (int j = 0; j < 4; ++j) {
            const int lr = wid * 4 + j, r = r0 + lr;
            if (r >= rend) continue;
            const int s = r % SL;
            if (layer != 0 && s < CTX) continue;
            const int e = lane & 31;
            float logit = p.rb[layer * NE + e];
#pragma unroll
            for (int w = 0; w < 8; ++w) logit += red[(w * 32 + lr) * 32 + e];
            float tv[4]; int ti[4];
#pragma unroll
            for (int k = 0; k < 4; ++k) {
                float bv = logit; int bi = e;
                for (int o2 = 16; o2 >= 1; o2 >>= 1) { const float ov = __shfl_xor(bv, o2); const int oi = __shfl_xor(bi, o2); if (ov > bv || (ov == bv && oi < bi)) { bv = ov; bi = oi; } }
                tv[k] = bv; ti[k] = bi; if (e == bi) logit = -3.0e38f;
            }
            const float e0 = 1.f, e1 = expf(tv[1] - tv[0]), e2 = expf(tv[2] - tv[0]), e3 = expf(tv[3] - tv[0]), inv = 1.f / (e0 + e1 + e2 + e3);
            if (lane == 0) { *(float4*)(((float*)(p.ws + OFF_TOPW)) + (size_t)r * 4) = make_float4(e0 * inv, e1 * inv, e2 * inv, e3 * inv); *(int4*)(((int*)(p.ws + OFF_TOPI)) + (size_t)r * 4) = make_int4(ti[0], ti[1], ti[2], ti[3]); }
            if (lane < 4) atomicAdd(&hist[lane == 0 ? ti[0] : lane == 1 ? ti[1] : lane == 2 ? ti[2] : ti[3]], 1);
        }
    }
    __syncthreads();
    if (tidx < NE) ((int*)(p.ws + OFF_BC))[(size_t)blockIdx.x * NE + tidx] = hist[tidx];
}
DEV void ph_route(const Params& p, int layer, char* smem) {
    const int tidx = tid_of(p.wave_id);
    int* part = (int*)smem;
    int* off = part + 1024;
    const int G = (int)gridDim.x, bid = (int)blockIdx.x;
    const int* BC = (const int*)(p.ws + OFF_BC);
    { const int e = tidx & 31, sl = tidx >> 5; int before = 0, tot = 0;
      for (int bb = sl; bb < G; bb += 16) { const int c = BC[(size_t)bb * NE + e]; tot += c; if (bb < bid) before += c; }
      part[(sl * 2 + 0) * 32 + e] = before; part[(sl * 2 + 1) * 32 + e] = tot; }
    __syncthreads();
    if (tidx < NE) { int before = 0, tot = 0; for (int sl = 0; sl < 16; ++sl) { before += part[(sl * 2 + 0) * 32 + tidx]; tot += part[(sl * 2 + 1) * 32 + tidx]; }
        off[tidx] = before; if (bid == 0) ((int*)(p.ws + OFF_CNT))[tidx] = tot; }
    __syncthreads();
    if (tidx < 64) {
        const int lane = tidx;
        const int chunk = (NT + G - 1) / G, rbeg = bid * chunk, rend = min(NT, rbeg + chunk);
        for (int q0 = rbeg * 4; q0 < rend * 4; q0 += 64) {
            const int pair = q0 + lane, r = pair >> 2, s = r % SL;
            const bool act = pair < rend * 4 && (layer == 0 || s >= CTX);
            const int my = act ? ((const int*)(p.ws + OFF_TOPI))[pair] : -1;
            for (int e = 0; e < NE; ++e) {
                const unsigned long long bal = __ballot(my == e);
                if (bal) { const int base = off[e];
                    if (my == e) ((int*)(p.ws + OFF_LIST))[(size_t)e * LISTCAP + base + __popcll(bal & ((1ull << lane) - 1ull))] = pair;
                    __builtin_amdgcn_wave_barrier();
                    if (lane == 0) off[e] = base + __popcll(bal);
                    __builtin_amdgcn_wave_barrier(); }
            }
        }
    }
}
DEV int moe_rt(int i, int G, int c, int npn, int& pn) {
    if (G == 256) { const int xcd = c & 7, j = c >> 3, rpx = 32 / npn; pn = j % npn; return (i * 8 + xcd) * rpx + j / npn; }
    const int L = i * G + c; pn = L % npn; return L / npn;
}
constexpr int MOE_LDS = 131072, MOE_MAXU = 12;
DEV void moe_prepare(const Params& p, char* smem, int npn, int mode) {
    const int tidx = tid_of(p.wave_id);
    LAS int* base = (LAS int*)(smem + MOE_LDS);
    LAS int *TE = base, *TT = base + 320, *NRT = base + 640, *UI = base + 704, *IDX = base + 768;
    const int* cnt = (const int*)(p.ws + OFF_CNT);
    if (tidx < 320) { int e = 0, acc = 0; for (; e < NE; ++e) { const int n = (cnt[e] + 255) >> 8; if (tidx < acc + n) break; acc += n; } TE[tidx] = e; TT[tidx] = tidx - acc; }
    if (tidx == 0) { int tot = 0; for (int e = 0; e < NE; ++e) tot += (cnt[e] + 255) >> 8; NRT[0] = tot; }
    __syncthreads();
    const int nrt = NRT[0];
    for (int i = 0; i < MOE_MAXU; ++i) {
        int pn; const int rt = moe_rt(i, (int)gridDim.x, (int)blockIdx.x, npn, pn);
        if (rt >= nrt) break;
        const int e = TE[rt], t = TT[rt], c = cnt[e];
        if (tidx < 256) { const int q = t * 256 + tidx; const int pair = ((const int*)(p.ws + OFF_LIST))[(size_t)e * LISTCAP + min(q, c - 1)];
            IDX[i * 256 + tidx] = mode == 1 ? (pair >> 2) : (q < c ? pair : -1); }
        if (tidx == 256) { int pre = 0; for (int z = 0; z < e; ++z) pre += cnt[z]; UI[i * 4 + 0] = min(256, c - t * 256); UI[i * 4 + 1] = pre + t * 256; }
    }
    __syncthreads();
}
struct MoeOrder {
    const LAS int *te, *ui, *idx; int nrt, npn, G, c, gather; const char* Bt; size_t bstride; int K;
    DEV bool next(int i, pg8::Unit& u) const { int pn; const int rt = moe_rt(i, G, c, npn, pn); if (rt >= nrt || i >= MOE_MAXU) return false;
        u.pm = rt; u.pn = pn; u.e = __builtin_amdgcn_readfirstlane(te[rt]); u.t = i; return true; }
    DEV int arow(const pg8::Unit& u, int rr) const { return gather ? idx[u.t * 256 + rr] : ui[u.t * 4 + 1] + rr; }
    DEV const char* bbase(const pg8::Unit& u) const { return Bt + (size_t)u.e * bstride + (size_t)u.pn * pg8::BM * K * 2; }
};
DEV float swiglu(float g, float l) { g = fminf(g, 7.f); l = fminf(fmaxf(l, -7.f), 7.f); return g * __builtin_amdgcn_rcpf(1.f + __expf(-1.702f * g)) * (l + 1.f); }
struct EpiSwiglu {
    static constexpr bool PERM = true;
    bf16_t* H; const float* b1; const LAS int* ui;
    DEV void operator()(const pg8::f32x4 (&acc)[2][2][4][2], const pg8::Unit& u, int wr, int wc, int fr, int fq) const {
        const int ucnt = ui[u.t * 4 + 0], hrow0 = ui[u.t * 4 + 1], col0 = u.pn * 256 + wc * 32 + 8 * fq;
        const float* bb = b1 + (size_t)u.e * 2048 + col0;
        pg8::f32x4 bv[2][2];
#pragma unroll
        for (int bj = 0; bj < 2; ++bj)
#pragma unroll
            for (int n = 0; n < 2; ++n) bv[bj][n] = *(const pg8::f32x4*)(bb + bj * 128 + 4 * n);
#pragma unroll
        for (int ai = 0; ai < 2; ++ai)
#pragma unroll
            for (int m = 0; m < 4; ++m) { const int rr = ai * 128 + wr * 64 + m * 16 + fr;
                if (rr < ucnt) { bf16_t* rowp = H + (size_t)(hrow0 + rr) * DFF + (col0 >> 1);
#pragma unroll
                    for (int bj = 0; bj < 2; ++bj) { const pg8::f32x4 v0 = acc[ai][bj][m][0] + bv[bj][0], v1 = acc[ai][bj][m][1] + bv[bj][1];
                        pg8::u32x2 w; w.x = cvt_pk_bf16(swiglu(v0[0], v0[1]), swiglu(v0[2], v0[3])); w.y = cvt_pk_bf16(swiglu(v1[0], v1[1]), swiglu(v1[2], v1[3]));
                        *(pg8::u32x2*)(rowp + bj * 64) = w; } } }
    }
};
struct EpiY {
    static constexpr bool PERM = true;
    bf16_t* Y; const LAS int* idx;
    DEV void operator()(const pg8::f32x4 (&acc)[2][2][4][2], const pg8::Unit& u, int wr, int wc, int fr, int fq) const {
        const int col0 = u.pn * 256 + wc * 32 + 8 * fq;
#pragma unroll
        for (int ai = 0; ai < 2; ++ai)
#pragma unroll
            for (int m = 0; m < 4; ++m) { const int rr = ai * 128 + wr * 64 + m * 16 + fr; const int pair = idx[u.t * 256 + rr];
                if (pair >= 0) { bf16_t* rowp = Y + (size_t)pair * D + col0;
#pragma unroll
                    for (int bj = 0; bj < 2; ++bj) { const pg8::f32x4 v0 = acc[ai][bj][m][0], v1 = acc[ai][bj][m][1];
                        pg8::u32x4 w; w.x = cvt_pk_bf16(v0[0], v0[1]); w.y = cvt_pk_bf16(v0[2], v0[3]); w.z = cvt_pk_bf16(v1[0], v1[1]); w.w = cvt_pk_bf16(v1[2], v1[3]);
                        *(pg8::u32x4*)(rowp + bj * 128) = w; } } }
    }
};
DEV void ph_moe1(const Params& p, int layer, char* smem) {
    moe_prepare(p, smem, 8, 1);
    LAS int* base = (LAS int*)(smem + MOE_LDS);
    MoeOrder S{base, base + 704, base + 768, base[640], 8, (int)gridDim.x, (int)blockIdx.x, 1, (const char*)(p.ws + OFF_W1T) + (size_t)layer * NE * 2048 * D * 2, (size_t)2048 * D * 2, D};
    EpiSwiglu E{(bf16_t*)(p.ws + OFF_H), p.b1 + (size_t)layer * NE * 2048, base + 704};
    pg8::gemm_phase((LAS unsigned char*)smem, (const char*)(p.ws + OFF_XNB), D, S, E, tid_of(p.wave_id));
}
DEV void ph_moe2(const Params& p, int layer, char* smem) {
    moe_prepare(p, smem, 4, 2);
    LAS int* base = (LAS int*)(smem + MOE_LDS);
    MoeOrder S{base, base + 704, base + 768, base[640], 4, (int)gridDim.x, (int)blockIdx.x, 0, (const char*)(p.ws + OFF_W2T) + (size_t)layer * NE * D * DFF * 2, (size_t)D * DFF * 2, DFF};
    EpiY E{(bf16_t*)(p.ws + OFF_Y), base + 768};
    pg8::gemm_phase((LAS unsigned char*)smem, (const char*)(p.ws + OFF_H), DFF, S, E, tid_of(p.wave_id));
}
DEV void ph_combine(const Params& p, int layer, char* smem) {
    const int tidx = tid_of(p.wave_id);
    const int wid = tidx >> 6, lane = tidx & 63;
    const float* nr = p.norms + (size_t)layer * 4 * D;
    for (int r = blockIdx.x * 8 + wid; r < NT; r += gridDim.x * 8) {
        const int b = r / SL, s = r % SL;
        if (layer != 0 && s < CTX) continue;
        const float* m = modrow(p, layer, b, s);
        const float4 tw = *(const float4*)(((float*)(p.ws + OFF_TOPW)) + (size_t)r * 4); const int4 ti = *(const int4*)(((int*)(p.ws + OFF_TOPI)) + (size_t)r * 4);
        const float w[4] = {tw.x, tw.y, tw.z, tw.w}; const int ei[4] = {ti.x, ti.y, ti.z, ti.w};
        float4 f[4], xv[4];
#pragma unroll
        for (int i = 0; i < 4; ++i) f[i] = make_float4(0.f, 0.f, 0.f, 0.f);
#pragma unroll
        for (int k = 0; k < 4; ++k) {
            const bf16_t* y = (const bf16_t*)(p.ws + OFF_Y) + ((size_t)r * 4 + k) * D; const float* bb = p.b2 + ((size_t)layer * NE + ei[k]) * D;
#pragma unroll
            for (int i = 0; i < 4; ++i) { const int idx = i * 256 + lane * 4; const pg8::u32x2 yb = *(const pg8::u32x2*)(y + idx); const float4 bv = *(const float4*)(bb + idx);
                const float y0 = __uint_as_float(yb.x << 16), y1 = __uint_as_float(yb.x & 0xffff0000u), y2 = __uint_as_float(yb.y << 16), y3 = __uint_as_float(yb.y & 0xffff0000u);
                f[i].x += w[k] * (y0 + bv.x); f[i].y += w[k] * (y1 + bv.y); f[i].z += w[k] * (y2 + bv.z); f[i].w += w[k] * (y3 + bv.w); }
        }
        row_load(((float*)(p.ws + OFF_XN)) + (size_t)r * D, xv, lane);
        const float ri = row_rinv(f);
#pragma unroll
        for (int i = 0; i < 4; ++i) { const int idx = i * 256 + lane * 4; const float4 g = *(const float4*)(nr + 3 * D + idx), gt = *(const float4*)(m + 5120 + idx);
            xv[i].x += gt.x * (f[i].x * ri * g.x); xv[i].y += gt.y * (f[i].y * ri * g.y); xv[i].z += gt.z * (f[i].z * ri * g.z); xv[i].w += gt.w * (f[i].w * ri * g.w); }
        if (layer == 0) {
            row_store(((float*)(p.ws + OFF_X)) + (size_t)r * D, xv, lane);
            const float* m1 = modrow(p, 1, b, s); float4 o[4];
            row_modnorm(xv, p.norms + (size_t)4 * D, m1 + 0, m1 + 1024, o, lane);
            row_store_bf16((bf16_t*)(p.ws + OFF_XNB) + (size_t)r * D, o, lane);
        } else {
            row_store(p.out + ((size_t)b * SEQ + (s - CTX)) * D, xv, lane);
        }
    }
}

template <int layer> DEV void run_layer(const Params& p, char* smem, const XcdBarrier& bar) {
#define GB() xcd_barrier(bar)

        ph_inproj(p, layer, smem); GB();
        ph_scan_local(p, layer, smem); ph_attn_prep(p, smem); GB();
        ph_scan_carry(p, smem); ph_attn(p, layer, smem); GB();
        ph_scan_out(p, layer, smem); GB();
        ph_outproj(p, layer, smem); GB();
        ph_norm2(p, layer, smem); GB();
        ph_route(p, layer, smem); GB();
        ph_moe1(p, layer, smem); GB();
        ph_moe2(p, layer, smem); GB();
        ph_combine(p, layer, smem); GB();
    #undef GB
}
constexpr int LDS_BYTES = 147456;
__global__ __launch_bounds__(512, 2) void k_mega(Params p_in) {
    Params p = p_in; p.wave_id = __builtin_amdgcn_readfirstlane((int)(threadIdx.x >> 6));
    extern __shared__ __attribute__((aligned(16))) char smem[];
    volatile LAS unsigned* st = (volatile LAS unsigned*)(smem + LDS_BYTES - 16);
    if (threadIdx.x == 0) { st[0] = 0u; st[1] = 0u; st[2] = 0u; st[3] = 0u; }
    __syncthreads();
    const XcdBarrier bar = xcd_barrier_post(((unsigned*)(p.ws + OFF_bar)), st, p.wave_id);
#define GB() xcd_barrier(bar)
    ph_mods(p, smem); ph_convert(p, smem); GB();
    ph_init(p, smem); GB();
    run_layer<0>(p, smem, bar);
    run_layer<1>(p, smem, bar);
#undef GB
}
}

extern "C" void kernel_launch(void* const* d_in, const int* in_sizes, int n_in, void* d_out, int out_size, void* d_ws, size_t ws_size, hipStream_t stream) {
    static int grid = 0;
    if (grid == 0) {
        int dev = 0, cus = 0, per_cu = 0;
        if (hipGetDevice(&dev) != hipSuccess || hipDeviceGetAttribute(&cus, hipDeviceAttributeMultiprocessorCount, dev) != hipSuccess) { grid = -1; return; }
        if (hipFuncSetAttribute((const void*)k_mega, hipFuncAttributeMaxDynamicSharedMemorySize, LDS_BYTES) != hipSuccess) { grid = -1; return; }
        (void)hipOccupancyMaxActiveBlocksPerMultiprocessor(&per_cu, (const void*)k_mega, 512, LDS_BYTES);
        (void)hipGetLastError();
        grid = cus;
    }
    if (grid < 0) return;
    Params p{};
    const float** in = (const float**)&p;
    for (int i = 0; i < 21; ++i) in[i] = (const float*)d_in[i];
    p.out = (float*)d_out;
    p.ws = (char*)d_ws;
    if (WS_END > ws_size) return;
    if (hipMemsetAsync(p.ws + OFF_bar, 0, (size_t)XCD_BAR_WORDS * 4, stream) != hipSuccess) return;
    hipLaunchKernelGGL(k_mega, dim3(grid), dim3(512), LDS_BYTES, stream, p);
}
```

```cpp
#include <hip/hip_runtime.h>
#include <stdint.h>

namespace {
constexpr int D = 1024, NB = 8, SEQ = 2048, CTX = 256, SL = 2304, NT = NB * SL;
constexpr int DP = 3840, DPW = 3600, NE = 32, DFF = 1024, NPAIR = NT * 4;
constexpr int O_AQ = 0, O_AI = 256, O_AFF = 512, O_AFB = 768, O_AG = 1024, O_BQ = 1280, O_BK = 1408, O_BV = 1536, O_BO = 1792, O_BG = 3584;
constexpr int LISTCAP = NT;

struct Params {
    const float *x, *c, *ctx, *c_ctx, *ada_w, *ada_b, *norms, *w_in, *w_out, *hlb, *hnorm, *mgb, *mnorm, *dlam, *dnorm, *rw, *rb, *w1, *b1, *w2, *b2;
    float* out;
    char* ws;
    int wave_id, pad_;
};
constexpr size_t al256(size_t x) { return (x + 255) & ~(size_t)255; }
constexpr size_t OFF_bar = 0;
constexpr size_t OFF_MOD = OFF_bar + al256(3456 * 4);
constexpr size_t OFF_LB = OFF_MOD + al256((size_t)2 * 9 * 6144 * 4);
constexpr size_t OFF_LAM = OFF_LB + al256(1024 * 4);
constexpr size_t OFF_CNT = OFF_LAM + 256;
constexpr size_t OFF_BC = OFF_CNT + 256;
constexpr size_t OFF_TOPW = OFF_BC + al256((size_t)1024 * NE * 4);
constexpr size_t OFF_TOPI = OFF_TOPW + al256((size_t)NPAIR * 4);
constexpr size_t OFF_LIST = OFF_TOPI + al256((size_t)NPAIR * 4);
constexpr size_t OFF_X = OFF_LIST + al256((size_t)NE * LISTCAP * 4);
constexpr size_t OFF_XN = OFF_X + al256((size_t)NT * D * 4);
constexpr size_t OFF_P = OFF_XN + al256((size_t)NT * D * 4);
constexpr size_t OFF_QR = OFF_P + al256((size_t)NT * DP * 4);
constexpr size_t OFF_KT = OFF_QR + al256((size_t)64 * SL * 64 * 4);
constexpr size_t OFF_OC = OFF_KT + al256((size_t)64 * SL * 64 * 4);
constexpr size_t OFF_MIX = OFF_OC + al256((size_t)32 * SL * 128 * 4);
constexpr size_t OFF_MIXO = OFF_MIX + al256((size_t)NT * D * 4);
constexpr size_t OFF_XNB = OFF_MIXO + al256((size_t)NT * D * 4);
constexpr size_t OFF_MIXB = OFF_XNB + al256((size_t)NT * D * 2);
constexpr size_t OFF_WIN = OFF_MIXB + al256((size_t)NT * D * 2);
constexpr size_t OFF_WOUT = OFF_WIN + al256((size_t)2 * DP * D * 2);
constexpr size_t OFF_W1T = OFF_WOUT + al256((size_t)2 * D * D * 2);
constexpr size_t OFF_W2T = OFF_W1T + al256((size_t)2 * NE * 2048 * D * 2);
constexpr size_t OFF_U = OFF_W2T + al256((size_t)2 * NE * D * DFF * 2);
constexpr size_t WS_END = OFF_U + al256((size_t)32 * SL * SL * 4);
constexpr size_t OFF_UA = OFF_U, OFF_DECA = OFF_UA + (size_t)64 * 36 * 4096 * 4, OFF_UB = OFF_DECA + (size_t)64 * 36 * 64 * 4, OFF_NB = OFF_UB + (size_t)64 * 36 * 2048 * 4,
                 OFF_MB = OFF_NB + (size_t)64 * 36 * 32 * 4, OFF_SCB = OFF_MB + (size_t)64 * 36 * 4 * 4,
                 OFF_OA2 = OFF_SCB + (size_t)2 * NT * 16 * 4, OFF_HB2 = OFF_OA2 + (size_t)NT * 256 * 4, OFF_SA = OFF_HB2 + (size_t)NT * 256 * 4, OFF_SB = OFF_SA + (size_t)64 * 36 * 4096 * 4,
                 OFF_N0 = OFF_SB + (size_t)64 * 36 * 2048 * 4;
constexpr size_t OFF_PB = OFF_P;
constexpr size_t OFF_ROPE = OFF_P + al256((size_t)NT * DP * 2);
constexpr size_t OFF_QRB = OFF_QR, OFF_Q0B = OFF_QR + (size_t)32 * SL * 128 * 2, OFF_KB = OFF_KT, OFF_VB = OFF_KT + (size_t)32 * SL * 128 * 2;
constexpr size_t OFF_S = OFF_U, OFF_H = OFF_U, OFF_Y = OFF_U + al256((size_t)(NPAIR + 256) * DFF * 2);
constexpr size_t OFF_OA = OFF_MIXO, OFF_HB = OFF_MIXO + (size_t)2 * NT * 256 * 4;


#define DEV __device__ __forceinline__
DEV int lane_asm() { int l; asm volatile("v_mbcnt_lo_u32_b32 %0, -1, 0\n\tv_mbcnt_hi_u32_b32 %0, -1, %0" : "=v"(l)); return l; }
DEV int tid_of(int wave_id) { return (wave_id << 6) | lane_asm(); }
DEV float wsum(float v) { for (int o = 32; o >= 1; o >>= 1) v += __shfl_xor(v, o); return v; }
DEV float wmaxf(float v) { for (int o = 32; o >= 1; o >>= 1) v = fmaxf(v, __shfl_xor(v, o)); return v; }
DEV float sigm(float x) { return 1.f / (1.f + expf(-x)); }
DEV float rdlane(float v, int l) { return __int_as_float(__builtin_amdgcn_readlane(__float_as_int(v), l)); }
DEV float lam_init_of(int layer) { return 0.8f - 0.6f * expf(-0.3f * (float)layer); }


#define XB_TMO      128
#define XB_XCNT(j)  (256  + 64 * (j))
#define XB_XSUB(j)  (1280 + 64 * (j))
#define XB_XGEN(j)  (2304 + 64 * (j))
#define XB_TOP      3328
#define XB_TOPGEN   3392
#define XCD_BAR_WORDS 3456
#define XB_SPIN_CAP (1u << 22)
#define LAS __attribute__((address_space(3)))
DEV unsigned xb_ld(unsigned* p)              { return __hip_atomic_load(p, __ATOMIC_RELAXED, __HIP_MEMORY_SCOPE_AGENT); }
DEV unsigned xb_add(unsigned* p, unsigned v) { return __hip_atomic_fetch_add(p, v, __ATOMIC_RELAXED, __HIP_MEMORY_SCOPE_AGENT); }
DEV unsigned xb_xcc_id() { return (unsigned)__builtin_amdgcn_s_getreg((3 << 11) | 20) & 0xFu; }
#define XB_SPIN(cond, bar) do { unsigned _sp = 0; while (cond) { __builtin_amdgcn_s_sleep(1); \
    if ((++_sp & 255u) == 0u) { if (xb_ld(&(bar)[XB_TMO])) break; if (_sp > XB_SPIN_CAP) { atomicAdd(&(bar)[XB_TMO], 1u); break; } } } } while (0)
struct XcdBarrier { unsigned* bar; unsigned x; volatile LAS unsigned* st; int wave; };
DEV bool xb_thread0(int wave) { return wave == 0 && lane_asm() == 0; }
DEV XcdBarrier xcd_barrier_post(unsigned* bar, volatile LAS unsigned* st, int wave) {
    XcdBarrier b; b.bar = bar; b.x = xb_xcc_id(); b.st = st; b.wave = wave;
    if (xb_thread0(wave)) (void)xb_add(&bar[XB_XCNT(b.x)], 1u);
    return b;
}
DEV void xcd_barrier_complete(unsigned* bar, unsigned x, unsigned& nloc, unsigned& nx) {
    const unsigned G = gridDim.x * gridDim.y * gridDim.z;
    unsigned sum, cnt, mine, sp = 0u;
    for (;;) {
        sum = 0u; cnt = 0u; mine = 0u;
#pragma unroll
        for (unsigned j = 0; j < 16; ++j) { const unsigned c = xb_ld(&bar[XB_XCNT(j)]); sum += c; cnt += (c > 0u) ? 1u : 0u; mine = (j == x) ? c : mine; }
        if (sum == G) break;
        __builtin_amdgcn_s_sleep(1);
        if ((++sp & 255u) == 0u) { if (xb_ld(&bar[XB_TMO])) break; if (sp > XB_SPIN_CAP) { atomicAdd(&bar[XB_TMO], 1u); break; } }
    }
    nloc = mine > 0u ? mine : 1u; nx = cnt > 0u ? cnt : 1u;
}
DEV void xcd_barrier(const XcdBarrier& b) {
    asm volatile("s_waitcnt vmcnt(0)" ::: "memory");
    __syncthreads();
    if (xb_thread0(b.wave)) {
        unsigned* bar = b.bar;
        __builtin_amdgcn_s_waitcnt(0);
        unsigned nloc = b.st[0], nx = b.st[1];
        if (nloc == 0u) { xcd_barrier_complete(bar, b.x, nloc, nx); b.st[0] = nloc; b.st[1] = nx; }
        const unsigned old = xb_add(&bar[XB_XSUB(b.x)], 1u);
        const unsigned gen = old / nloc;
        if (old + 1u == (gen + 1u) * nloc) {
            __builtin_amdgcn_fence(__ATOMIC_RELEASE, "agent");
            asm volatile("s_waitcnt vmcnt(0)" ::: "memory");
            const unsigned og = xb_add(&bar[XB_TOP], 1u);
            const unsigned tg = og / nx;
            if (og + 1u == (tg + 1u) * nx) xb_add(&bar[XB_TOPGEN], 1u);
            else XB_SPIN(xb_ld(&bar[XB_TOPGEN]) == tg, bar);
            __builtin_amdgcn_fence(__ATOMIC_ACQUIRE, "agent");
            xb_add(&bar[XB_XGEN(b.x)], 1u);
            asm volatile("s_waitcnt vmcnt(0)" ::: "memory");
        } else {
            XB_SPIN(xb_ld(&bar[XB_XGEN(b.x)]) == gen, bar);
            __builtin_amdgcn_fence(__ATOMIC_ACQUIRE, "agent");
            asm volatile("s_waitcnt vmcnt(0)" ::: "memory");
        }
    }
    __syncthreads();
}

typedef unsigned short bf16_t;
DEV unsigned cvt_pk_bf16(float lo, float hi) { unsigned r; asm volatile("v_cvt_pk_bf16_f32 %0, %1, %2" : "=v"(r) : "v"(lo), "v"(hi)); return r; }

namespace pg8 {
typedef short bf16x8 __attribute__((ext_vector_type(8)));
typedef float f32x4 __attribute__((ext_vector_type(4)));
typedef unsigned u32x4 __attribute__((ext_vector_type(4)));
typedef unsigned u32x2 __attribute__((ext_vector_type(2)));
constexpr int BM = 256, BK = 64, HALF = 128, HTB = HALF * BK * 2, STAGE_BYTES = 8 * HTB, NXCD = 8, WGM = 8;
DEV int lds_byte(int r, int c) { const int st = (r >> 4) * 2 + (c >> 5), rr = r & 15, cc = c & 31, ob = rr * 64 + cc * 2; return st * 1024 + (ob ^ (((ob >> 9) & 1) << 5)); }
DEV void stage_rc(int b, int& R, int& C) { const int st = b / 1024, sb = b % 1024, swz = sb ^ (((sb >> 9) & 1) << 5); R = (st >> 1) * 16 + swz / 64; C = (st & 1) * 32 + (swz % 64) / 2; }
DEV int perm32(int rho) { const int n = rho >> 4, i = rho & 15; return 8 * (i >> 2) + 4 * n + (i & 3); }
struct Unit { int pm, pn, e, t; };
struct StaticOrder {
    int nM, nN, nwg, G, c, skipctx; const char* Bt; int K;
    DEV void init(int nM_, int nN_, int G_, int c_, int skipctx_, const void* Bt_, int K_) { nM = nM_; nN = nN_; nwg = nM * nN; G = G_; c = c_; skipctx = skipctx_; Bt = (const char*)Bt_; K = K_; }
    DEV bool next(int i, Unit& u) const {
        const long L = (long)i * G + c; if (L >= nwg) return false;
        int wgid = (int)L; { const int q = nwg / NXCD, r = nwg % NXCD, xcd = wgid % NXCD, off = wgid / NXCD; wgid = (xcd < r ? xcd * (q + 1) : r * (q + 1) + (xcd - r) * q) + off; }
        const int nig = WGM * nN, gid = wgid / nig, fm = gid * WGM, gsz = (nM - fm) < WGM ? (nM - fm) : WGM;
        int pm = fm + ((wgid % nig) % gsz); u.pn = (wgid % nig) / gsz;
        if (skipctx) pm = (pm >> 3) * 9 + 1 + (pm & 7);
        u.pm = pm; u.e = 0; u.t = 0; return true;
    }
    DEV int arow(const Unit& u, int rr) const { return u.pm * BM + rr; }
    DEV const char* bbase(const Unit& u) const { return Bt + (size_t)u.pn * BM * K * 2; }
};
struct EpiF32 {
    static constexpr bool PERM = false;
    float* C; int ldc;
    DEV void operator()(const f32x4 (&acc)[2][2][4][2], const Unit& u, int wr, int wc, int fr, int fq) const {
        const int row0 = u.pm * BM + wr * 64 + fr, col0 = u.pn * BM + wc * 32 + 4 * fq;
#pragma unroll
        for (int ai = 0; ai < 2; ++ai)
#pragma unroll
            for (int m = 0; m < 4; ++m) { float* rowp = C + (size_t)(row0 + ai * HALF + m * 16) * ldc + col0;
#pragma unroll
                for (int bj = 0; bj < 2; ++bj)
#pragma unroll
                    for (int n = 0; n < 2; ++n) *(f32x4*)(rowp + bj * HALF + n * 16) = acc[ai][bj][m][n]; }
    }
};

template <class Epi, class Sched>
DEV void gemm_phase(LAS unsigned char* lds, const char* Abase, const int K, const Sched& S, const Epi& E, const int tid) {
    const int wid = __builtin_amdgcn_readfirstlane(tid >> 6), lane = tid & 63, wr = wid >> 2, wc = wid & 3, fr = lane & 15, fq = lane >> 4;
    const int nt = K / BK;
    unsigned voffB[2];
#pragma unroll
    for (int i = 0; i < 2; ++i) { int R, C; stage_rc(tid * 16 + i * 8192, R, C); const int Rb = Epi::PERM ? ((R & ~31) + perm32(R & 31)) : R;
        voffB[i] = (unsigned)(Rb * K + C) * 2u; }
    const size_t kstep = (size_t)(BK * 2);
    const size_t hstep = (size_t)HALF * K * 2;
    const unsigned ldsw = (unsigned)wid * 1024u;
    const int aoff = lds_byte(wr * 64 + fr, fq * 8), boff = lds_byte(wc * 32 + fr, fq * 8);
#define PG8_SA(b, h) (((b) * 2 + (h)) * HTB)
#define PG8_SB(b, h) ((4 + (b) * 2 + (h)) * HTB)
#define PG8_STAGE_B(bufoff, gbase) do { _Pragma("unroll") for (int _i = 0; _i < 2; ++_i) \
        __builtin_amdgcn_global_load_lds((const unsigned*)((const char*)(gbase) + voffB[_i]), (LAS unsigned*)(lds + (bufoff) + ldsw + _i * 8192), 16, 0, 0); } while (0)
#define PG8_STAGE_A(bufoff, kb, V, h) do { _Pragma("unroll") for (int _i = 0; _i < 2; ++_i) \
        __builtin_amdgcn_global_load_lds((const unsigned*)(Abase + (kb) + (V)[h][_i]), (LAS unsigned*)(lds + (bufoff) + ldsw + _i * 8192), 16, 0, 0); } while (0)
#define PG8_VOFFA(V, u) do { _Pragma("unroll") for (int _i = 0; _i < 2; ++_i) { int _R, _C; stage_rc(tid * 16 + _i * 8192, _R, _C); _Pragma("unroll") for (int _h = 0; _h < 2; ++_h) \
        (V)[_h][_i] = ((unsigned)S.arow(u, _h * HALF + _R) * (unsigned)K + (unsigned)_C) * 2u; } } while (0)
#define PG8_LDA(dst, b, h) do { _Pragma("unroll") for (int m = 0; m < 4; ++m) _Pragma("unroll") for (int k = 0; k < 2; ++k) dst[m][k] = *(const LAS bf16x8*)(lds + PG8_SA(b, h) + aoff + m * 2048 + k * 1024); } while (0)
#define PG8_LDB(dst, b, h) do { _Pragma("unroll") for (int n = 0; n < 2; ++n) _Pragma("unroll") for (int k = 0; k < 2; ++k) dst[n][k] = *(const LAS bf16x8*)(lds + PG8_SB(b, h) + boff + n * 2048 + k * 1024); } while (0)
#define PG8_MMA(ai, bj, At, Bt) do { __builtin_amdgcn_s_setprio(1); _Pragma("unroll") for (int m = 0; m < 4; ++m) _Pragma("unroll") for (int n = 0; n < 2; ++n) _Pragma("unroll") for (int k = 0; k < 2; ++k) \
        acc[ai][bj][m][n] = __builtin_amdgcn_mfma_f32_16x16x32_bf16(Bt[n][k], At[m][k], acc[ai][bj][m][n], 0, 0, 0); __builtin_amdgcn_s_setprio(0); } while (0)
#define PG8_WAIT_V(n) asm volatile("s_waitcnt vmcnt(" #n ")" ::: "memory")
#define PG8_WAIT_L(n) asm volatile("s_waitcnt lgkmcnt(" #n ")" ::: "memory")
#define PG8_BAR __builtin_amdgcn_s_barrier()
#define PG8_SCHED __builtin_amdgcn_sched_barrier(0)
    Unit cur, nxt; int ui = 0;
    if (!S.next(0, cur)) return;
    f32x4 acc[2][2][4][2];
#pragma unroll
    for (int a = 0; a < 2; ++a)
#pragma unroll
        for (int b = 0; b < 2; ++b)
#pragma unroll
            for (int m = 0; m < 4; ++m)
#pragma unroll
                for (int n = 0; n < 2; ++n) acc[a][b][m][n] = (f32x4){0.f, 0.f, 0.f, 0.f};
    bf16x8 At[4][2], B0[2][2], B1[2][2];
    unsigned vc[2][2], v2[2][2];
    PG8_VOFFA(vc, cur);
    const char* cB = S.bbase(cur);
    PG8_STAGE_B(PG8_SB(0, 0), cB); PG8_STAGE_A(PG8_SA(0, 0), 0, vc, 0); PG8_STAGE_B(PG8_SB(0, 1), cB + hstep); PG8_STAGE_A(PG8_SA(0, 1), 0, vc, 1);
    if (wr == 1) PG8_BAR;
    PG8_WAIT_V(4); PG8_BAR;
    PG8_STAGE_B(PG8_SB(1, 0), cB + kstep); PG8_STAGE_A(PG8_SA(1, 0), kstep, vc, 0); PG8_STAGE_B(PG8_SB(1, 1), cB + hstep + kstep);
    PG8_WAIT_V(6); PG8_BAR;
    for (;;) {
        const bool has_next = S.next(ui + 1, nxt);
        const char* nB = has_next ? S.bbase(nxt) : cB;
        for (int t = 0; t < nt; t += 2) {
            const bool last = (t == nt - 2);
            const size_t k1 = (size_t)(t + 1) * kstep, k2 = last ? (size_t)0 : (size_t)(t + 2) * kstep, k3 = k2 + kstep;
            if (last && has_next) { PG8_VOFFA(v2, nxt); } else {
#pragma unroll
                for (int h = 0; h < 2; ++h)
#pragma unroll
                    for (int i = 0; i < 2; ++i) v2[h][i] = vc[h][i]; }
            const char* b2 = last ? nB : cB + (size_t)(t + 2) * kstep; const char* b3 = b2 + kstep;
            PG8_LDB(B0, 0, 0); PG8_SCHED; PG8_LDA(At, 0, 0); PG8_STAGE_A(PG8_SA(1, 1), k1, vc, 1);
            PG8_WAIT_L(8); PG8_BAR; PG8_WAIT_L(0); PG8_MMA(0, 0, At, B0); PG8_BAR; PG8_SCHED;
            PG8_LDB(B1, 0, 1); PG8_STAGE_B(PG8_SB(0, 0), b2);
            PG8_BAR; PG8_WAIT_L(0); PG8_MMA(0, 1, At, B1); PG8_BAR;
            PG8_LDA(At, 0, 1); PG8_STAGE_A(PG8_SA(0, 0), k2, v2, 0);
            PG8_BAR; PG8_WAIT_L(0); PG8_MMA(1, 0, At, B0); PG8_BAR; PG8_SCHED;
            PG8_STAGE_B(PG8_SB(0, 1), b2 + hstep);
            PG8_WAIT_V(6); PG8_BAR; PG8_MMA(1, 1, At, B1); PG8_BAR;
            PG8_LDB(B0, 1, 0); PG8_SCHED; PG8_LDA(At, 1, 0); PG8_STAGE_A(PG8_SA(0, 1), k2, v2, 1);
            PG8_WAIT_L(8); PG8_BAR; PG8_WAIT_L(0); PG8_MMA(0, 0, At, B0); PG8_BAR; PG8_SCHED;
            PG8_LDB(B1, 1, 1); PG8_STAGE_B(PG8_SB(1, 0), b3);
            PG8_BAR; PG8_WAIT_L(0); PG8_MMA(0, 1, At, B1); PG8_BAR;
            PG8_LDA(At, 1, 1); PG8_STAGE_A(PG8_SA(1, 0), k3, v2, 0);
            PG8_BAR; PG8_WAIT_L(0); PG8_MMA(1, 0, At, B0); PG8_BAR; PG8_SCHED;
            PG8_STAGE_B(PG8_SB(1, 1), b3 + hstep);
            PG8_WAIT_V(6); PG8_BAR; PG8_MMA(1, 1, At, B1); PG8_BAR;
        }
        E(acc, cur, wr, wc, fr, fq);
        if (!has_next) break;
#pragma unroll
        for (int a = 0; a < 2; ++a)
#pragma unroll
            for (int b = 0; b < 2; ++b)
#pragma unroll
                for (int m = 0; m < 4; ++m)
#pragma unroll
                    for (int n = 0; n < 2; ++n) acc[a][b][m][n] = (f32x4){0.f, 0.f, 0.f, 0.f};
        cur = nxt; cB = nB; ++ui;
#pragma unroll
        for (int h = 0; h < 2; ++h)
#pragma unroll
            for (int i = 0; i < 2; ++i) vc[h][i] = v2[h][i];
    }
    PG8_WAIT_V(0);
    if (wr == 0) PG8_BAR;
    PG8_BAR;
#undef PG8_SA
#undef PG8_SB
#undef PG8_STAGE_A
#undef PG8_STAGE_B
#undef PG8_VOFFA
#undef PG8_LDA
#undef PG8_LDB
#undef PG8_MMA
#undef PG8_WAIT_V
#undef PG8_WAIT_L
#undef PG8_BAR
#undef PG8_SCHED
}
}


namespace att {
using bf16x8 = __attribute__((ext_vector_type(8))) short;
using s16x4  = __attribute__((ext_vector_type(4))) short;
using f32x16 = __attribute__((ext_vector_type(16))) float;
using u32x4  = __attribute__((ext_vector_type(4))) unsigned;
constexpr int KVBLK = 64, LDK = 128;
constexpr int SHM_V = KVBLK * 128 * 2, SHM_K = KVBLK * 128 * 2, SHM_ATTN = 2 * SHM_V + 2 * SHM_K + 8 * 64 * 4;
constexpr float THR = 8.f;
#define KSWZ(row, colB) ((row) * 256 + ((colB) ^ (((row) & 7) << 4)))
#define SBAR() __builtin_amdgcn_sched_barrier(0)
DEV int crow(int r, int hi) { return (r & 3) + 8 * (r >> 2) + 4 * hi; }
DEV void partialSM(f32x16& p0, f32x16& p1, float& m_reg, float& mn, float& alpha) {
  float pmax = p0[0]; for (int r = 1; r < 16; ++r) pmax = fmaxf(pmax, p0[r]); for (int r = 0; r < 16; ++r) pmax = fmaxf(pmax, p1[r]);
  { auto rr = __builtin_amdgcn_permlane32_swap(__float_as_uint(pmax), __float_as_uint(pmax), false, false);
    pmax = fmaxf(__uint_as_float(rr[0]), __uint_as_float(rr[1])); }
  if (__builtin_expect(__all(pmax - m_reg <= THR), 1)) { mn = m_reg; alpha = 1.f; }
  else { mn = fmaxf(m_reg, pmax); alpha = __builtin_amdgcn_exp2f(m_reg - mn); m_reg = mn; }
  for (int r = 0; r < 16; ++r) p0[r] = p0[r] - mn; for (int r = 0; r < 16; ++r) p1[r] = p1[r] - mn;
  for (int r = 0; r < 16; ++r) p0[r] = __builtin_amdgcn_exp2f(p0[r]);
}
DEV void finishSM(f32x16& p0, f32x16& p1, float alpha, float& l_reg, bf16x8& pa0, bf16x8& pa1, bf16x8& pa2, bf16x8& pa3) {
  for (int r = 0; r < 16; ++r) p1[r] = __builtin_amdgcn_exp2f(p1[r]);
  float ps = 0; for (int r = 0; r < 16; ++r) ps += p0[r]; for (int r = 0; r < 16; ++r) ps += p1[r];
  { auto rr = __builtin_amdgcn_permlane32_swap(__float_as_uint(ps), __float_as_uint(ps), false, false);
    ps = __uint_as_float(rr[0]) + __uint_as_float(rr[1]); }
  l_reg = l_reg * alpha + ps;
#define PK4(P, BASE, OUT) do { unsigned a0 = cvt_pk_bf16(P[BASE + 0], P[BASE + 1]), a1 = cvt_pk_bf16(P[BASE + 2], P[BASE + 3]);   \
    unsigned b0 = cvt_pk_bf16(P[BASE + 4], P[BASE + 5]), b1 = cvt_pk_bf16(P[BASE + 6], P[BASE + 7]);                              \
    auto r0 = __builtin_amdgcn_permlane32_swap(a0, b0, false, false); auto r1 = __builtin_amdgcn_permlane32_swap(a1, b1, false, false); \
    u32x4 w = {r0[0], r1[0], r0[1], r1[1]}; OUT = *reinterpret_cast<bf16x8*>(&w); } while (0)
  PK4(p0, 0, pa0); PK4(p0, 8, pa1); PK4(p1, 0, pa2); PK4(p1, 8, pa3);
#undef PK4
}
DEV void qkt(f32x16& p0, f32x16& p1, const char* Ks, const bf16x8 (&qr)[4], int r32, int hi, int js) {
  p0 = f32x16{}; p1 = f32x16{};
#pragma unroll
  for (int d0 = 0; d0 < 4; ++d0) { const int cb = ((js * 4 + d0) * 16 + hi * 8) * 2;
    bf16x8 b0 = *reinterpret_cast<const bf16x8*>(Ks + KSWZ(r32, cb));
    bf16x8 b1 = *reinterpret_cast<const bf16x8*>(Ks + KSWZ(32 + r32, cb));
    p0 = __builtin_amdgcn_mfma_f32_32x32x16_bf16(b0, qr[d0], p0, 0, 0, 0);
    p1 = __builtin_amdgcn_mfma_f32_32x32x16_bf16(b1, qr[d0], p1, 0, 0, 0); }
}
DEV int v_st(int k, int c) { const int kk = (k & ~0xC) | ((k & 4) << 1) | ((k & 8) >> 1); return ((kk >> 3) * 4 + (c >> 5)) * 512 + ((kk & 7) * 32 + (c & 31)) * 2; }
DEV int v_rd_base(int lane) { return ((lane & 3) << 3) | (((lane >> 2) & 3) << 6) | (((lane >> 4) & 1) << 5) | (((lane >> 5) & 1) << 8); }
constexpr int v_rd_off(int d0, int ks, int half) { return d0 * 512 + ks * 4096 + half * 2048; }
template <int OFF> DEV s16x4 tr_read(int vb) {
  s16x4 r; asm volatile("ds_read_b64_tr_b16 %0, %1 offset:%2" : "=&v"(r) : "v"(vb), "i"(OFF) : "memory"); return r;
}
template <int D0> DEV void pv_one(f32x16& od, int vb, bf16x8 pa0, bf16x8 pa1, bf16x8 pa2, bf16x8 pa3) {
  const s16x4 l0 = tr_read<v_rd_off(D0, 0, 0)>(vb), h0 = tr_read<v_rd_off(D0, 0, 1)>(vb), l1 = tr_read<v_rd_off(D0, 1, 0)>(vb), h1 = tr_read<v_rd_off(D0, 1, 1)>(vb);
  const s16x4 l2 = tr_read<v_rd_off(D0, 2, 0)>(vb), h2 = tr_read<v_rd_off(D0, 2, 1)>(vb), l3 = tr_read<v_rd_off(D0, 3, 0)>(vb), h3 = tr_read<v_rd_off(D0, 3, 1)>(vb);
  asm volatile("s_waitcnt lgkmcnt(0)" ::: "memory"); SBAR();
#define PK(L, H) (bf16x8){L[0], L[1], L[2], L[3], H[0], H[1], H[2], H[3]}
  od = __builtin_amdgcn_mfma_f32_32x32x16_bf16(pa0, PK(l0, h0), od, 0, 0, 0);
  od = __builtin_amdgcn_mfma_f32_32x32x16_bf16(pa1, PK(l1, h1), od, 0, 0, 0);
  od = __builtin_amdgcn_mfma_f32_32x32x16_bf16(pa2, PK(l2, h2), od, 0, 0, 0);
  od = __builtin_amdgcn_mfma_f32_32x32x16_bf16(pa3, PK(l3, h3), od, 0, 0, 0);
#undef PK
}
DEV void pv_d0(f32x16* o, int vb, bf16x8 pa0, bf16x8 pa1, bf16x8 pa2, bf16x8 pa3) {
  pv_one<0>(o[0], vb, pa0, pa1, pa2, pa3); pv_one<1>(o[1], vb, pa0, pa1, pa2, pa3); pv_one<2>(o[2], vb, pa0, pa1, pa2, pa3); pv_one<3>(o[3], vb, pa0, pa1, pa2, pa3);
}
DEV void attn_tiles(const bf16x8 (&qr)[4], const bf16_t* __restrict__ Kh, const bf16_t* __restrict__ Vh, int seq, char* lds,
                    float& m_reg, float& l_reg, f32x16 (&o)[4], int tid, int js) {
  const int wid = tid >> 6, lane = tid & 63, r32 = lane & 31, hi = lane >> 5;
  char* V_lds = lds; char* K_lds = lds + 2 * SHM_V;
  float* ws = (float*)(lds + 2 * SHM_V + 2 * SHM_K) + wid * 64; float* al_l = ws + 32;
  const int sr = tid >> 4, sc = (tid & 15) * 8, vst0 = v_st(sr, sc), vst1 = v_st(32 + sr, sc);
  const int vb0 = (int)(uintptr_t)V_lds + v_rd_base(lane);
  struct { bf16x8 vs0, vs1, ks0, ks1; } sr_[2];
  const unsigned lo0 = (unsigned)((sr * LDK + sc) * 2), lo1 = lo0 + 32u * LDK * 2u;
#define SLOAD(i, k0) do { const char* vb_ = (const char*)Vh + (size_t)(k0) * (LDK * 2); const char* kb_ = (const char*)Kh + (size_t)(k0) * (LDK * 2); \
    sr_[i].vs0 = *(const bf16x8*)(vb_ + lo0); sr_[i].vs1 = *(const bf16x8*)(vb_ + lo1); sr_[i].ks0 = *(const bf16x8*)(kb_ + lo0); sr_[i].ks1 = *(const bf16x8*)(kb_ + lo1); } while (0)
#define SWRITE(b, i) do { *(bf16x8*)(V_lds + (b) * SHM_V + vst0) = sr_[i].vs0;          \
    *(bf16x8*)(V_lds + (b) * SHM_V + vst1) = sr_[i].vs1; int kc = sc * 2;               \
    *(bf16x8*)(K_lds + (b) * SHM_K + KSWZ(sr, kc)) = sr_[i].ks0;                       \
    *(bf16x8*)(K_lds + (b) * SHM_K + KSWZ(32 + sr, kc)) = sr_[i].ks1; } while (0)
#define SWAIT() asm volatile("s_waitcnt vmcnt(4)" ::: "memory")
#define RESC(a) do { if (__any((a) < 1.f)) { if (hi == 0) al_l[r32] = (a); asm volatile("s_waitcnt lgkmcnt(0)" ::: "memory"); \
    for (int d = 0; d < 4; ++d) for (int r = 0; r < 16; ++r) o[d][r] *= al_l[crow(r, hi)]; } } while (0)
  f32x16 pA0, pA1, pB0, pB1; float mnA, mnB, alA, alB; bf16x8 pa0, pa1, pa2, pa3; const int NTL = seq / KVBLK;
  constexpr int SE = 0, SO = 1;
  __syncthreads();
  SLOAD(SE, 0); asm volatile("s_waitcnt vmcnt(0)" ::: "memory"); SWRITE(0, SE); __syncthreads();
  qkt(pA0, pA1, K_lds, qr, r32, hi, js); partialSM(pA0, pA1, m_reg, mnA, alA);
  SLOAD(SO, KVBLK); if (2 < NTL) SLOAD(SE, 2 * KVBLK);
  SWAIT(); SWRITE(1, SO); __syncthreads();
  RESC(alA);
  for (int j = 1; j + 1 < NTL; j += 2) {
    SBAR(); qkt(pB0, pB1, K_lds + SHM_K, qr, r32, hi, js);
    finishSM(pA0, pA1, alA, l_reg, pa0, pa1, pa2, pa3); SBAR();
    SLOAD(SO, (j + 2) * KVBLK); SBAR();
    pv_d0(o, vb0, pa0, pa1, pa2, pa3); partialSM(pB0, pB1, m_reg, mnB, alB);
    __syncthreads(); SWAIT(); SWRITE(0, SE);
    RESC(alB); __syncthreads();
    SBAR(); qkt(pA0, pA1, K_lds, qr, r32, hi, js);
    finishSM(pB0, pB1, alB, l_reg, pa0, pa1, pa2, pa3); SBAR();
    if (j + 3 < NTL) SLOAD(SE, (j + 3) * KVBLK); SBAR();
    pv_d0(o, vb0 + SHM_V, pa0, pa1, pa2, pa3); partialSM(pA0, pA1, m_reg, mnA, alA);
    __syncthreads(); SWAIT(); SWRITE(1, SO);
    RESC(alA); __syncthreads();
  }
  SBAR(); qkt(pB0, pB1, K_lds + SHM_K, qr, r32, hi, js);
  finishSM(pA0, pA1, alA, l_reg, pa0, pa1, pa2, pa3); SBAR();
  pv_d0(o, vb0, pa0, pa1, pa2, pa3); partialSM(pB0, pB1, m_reg, mnB, alB);
  __syncthreads(); RESC(alB);
  finishSM(pB0, pB1, alB, l_reg, pa0, pa1, pa2, pa3); SBAR();
  pv_d0(o, vb0 + SHM_V, pa0, pa1, pa2, pa3);
#undef SLOAD
#undef SWRITE
#undef SWAIT
#undef RESC
}
}

DEV void cvt_tile(const float* src, int ld, int nvalid, bf16_t* dst, int K, int n0, int k0, float* T, const int t, int ns0 = -1) {
    if (ns0 < 0) ns0 = n0;
#pragma unroll
    for (int h = 0; h < 2; ++h) {
        const int kk = (t >> 4) + 32 * h, nq = (t & 15) * 4, n = ns0 + nq;
        const float4 v = n < nvalid ? *(const float4*)(src + (size_t)(k0 + kk) * ld + n) : make_float4(0.f, 0.f, 0.f, 0.f);
        T[(nq + 0) * 65 + kk] = v.x; T[(nq + 1) * 65 + kk] = v.y; T[(nq + 2) * 65 + kk] = v.z; T[(nq + 3) * 65 + kk] = v.w;
    }
    __syncthreads();
    { const int n = t >> 3, kq = (t & 7) * 8; const float* r = T + n * 65 + kq;
      pg8::u32x4 w; w.x = cvt_pk_bf16(r[0], r[1]); w.y = cvt_pk_bf16(r[2], r[3]); w.z = cvt_pk_bf16(r[4], r[5]); w.w = cvt_pk_bf16(r[6], r[7]);
      *(pg8::u32x4*)(dst + (size_t)(n0 + n) * K + k0 + kq) = w; }
    __syncthreads();
}
DEV void ph_convert(const Params& p, char* smem) {
    const int tidx = tid_of(p.wave_id);
    float* T = (float*)smem;
    constexpr int T_IN = 2 * 60 * 16, T_OUT = 2 * 16 * 16, T_W1 = 64 * 32 * 16, T_W2 = 64 * 16 * 16;
    for (int u = blockIdx.x; u < T_IN + T_OUT + T_W1 + T_W2; u += gridDim.x) {
        if (u < T_IN) { const int l = u / 960, r = u % 960, nt = r >> 4, kt = r & 15;
            const int n0 = nt * 64; int ns0, nv;
            if (n0 < 2048) { ns0 = n0; nv = DPW; } else if (n0 < 3584) { ns0 = n0 + 16; nv = DPW; } else if (n0 == 3584) { ns0 = 2048; nv = 2064; } else { ns0 = 0; nv = 0; }
            cvt_tile(p.w_in + (size_t)l * D * DPW, DPW, nv, (bf16_t*)(p.ws + OFF_WIN) + (size_t)l * DP * D, D, n0, kt * 64, T, tidx, ns0); }
        else if (u < T_IN + T_OUT) { const int v = u - T_IN, l = v >> 8, r = v & 255, nt = r >> 4, kt = r & 15;
            cvt_tile(p.w_out + (size_t)l * D * D, D, D, (bf16_t*)(p.ws + OFF_WOUT) + (size_t)l * D * D, D, nt * 64, kt * 64, T, tidx); }
        else if (u < T_IN + T_OUT + T_W1) { const int v = u - T_IN - T_OUT, le = v >> 9, r = v & 511, nt = r >> 4, kt = r & 15;
            cvt_tile(p.w1 + (size_t)le * D * 2048, 2048, 2048, (bf16_t*)(p.ws + OFF_W1T) + (size_t)le * 2048 * D, D, nt * 64, kt * 64, T, tidx); }
        else { const int v = u - T_IN - T_OUT - T_W1, le = v >> 8, r = v & 255, nt = r >> 4, kt = r & 15;
            cvt_tile(p.w2 + (size_t)le * DFF * D, D, D, (bf16_t*)(p.ws + OFF_W2T) + (size_t)le * D * DFF, DFF, nt * 64, kt * 64, T, tidx); }
    }
}

DEV void row_load(const float* src, float4 (&v)[4], int lane) {
#pragma unroll
    for (int i = 0; i < 4; ++i) v[i] = *(const float4*)(src + i * 256 + lane * 4);
}
DEV void row_store(float* dst, const float4 (&v)[4], int lane) {
#pragma unroll
    for (int i = 0; i < 4; ++i) *(float4*)(dst + i * 256 + lane * 4) = v[i];
}
DEV void row_store_bf16(bf16_t* dst, const float4 (&v)[4], int lane) {
#pragma unroll
    for (int i = 0; i < 4; ++i) { pg8::u32x2 w; w.x = cvt_pk_bf16(v[i].x, v[i].y); w.y = cvt_pk_bf16(v[i].z, v[i].w); *(pg8::u32x2*)(dst + i * 256 + lane * 4) = w; }
}
DEV float row_rinv(const float4 (&v)[4]) {
    float ss = 0.f;
#pragma unroll
    for (int i = 0; i < 4; ++i) ss += v[i].x * v[i].x + v[i].y * v[i].y + v[i].z * v[i].z + v[i].w * v[i].w;
    ss = wsum(ss);
    return rsqrtf(ss * (1.f / 1024.f) + 1e-6f);
}
DEV void row_modnorm(const float4 (&v)[4], const float* gain, const float* shift, const float* scale, float4 (&o)[4], int lane) {
    const float r = row_rinv(v);
#pragma unroll
    for (int i = 0; i < 4; ++i) {
        const int idx = i * 256 + lane * 4;
        const float4 g = *(const float4*)(gain + idx), sh = *(const float4*)(shift + idx), sc = *(const float4*)(scale + idx);
        o[i].x = v[i].x * r * g.x * (1.f + sc.x) + sh.x; o[i].y = v[i].y * r * g.y * (1.f + sc.y) + sh.y;
        o[i].z = v[i].z * r * g.z * (1.f + sc.z) + sh.z; o[i].w = v[i].w * r * g.w * (1.f + sc.w) + sh.w;
    }
}
DEV const float* modrow(const Params& p, int layer, int b, int s) { return ((float*)(p.ws + OFF_MOD)) + ((size_t)layer * 9 + (s < CTX ? 8 : b)) * 6144; }

DEV void ph_mods(const Params& p, char* smem) {
    const int tidx = tid_of(p.wave_id);
    float (*cond)[1024] = (float (*)[1024])smem;
    float (*red)[9][64] = (float (*)[9][64])(smem + 9 * 1024 * 4);
    const int tid = tidx;
    for (int i = tid; i < 9 * 1024; i += 512) { const int r = i >> 10, k = i & 1023; const float c = r < 8 ? p.c[r * 1024 + k] : p.c_ctx[k]; cond[r][k] = c * sigm(c); }
    __syncthreads();
    for (int u = blockIdx.x; u < 192; u += gridDim.x) {
        const int layer = u / 96, cg = u % 96, jj = tid & 63, ks = tid >> 6, j = cg * 64 + jj;
        float acc[9];
#pragma unroll
        for (int r = 0; r < 9; ++r) acc[r] = 0.f;
        const float* w = p.ada_w + (size_t)layer * 1024 * 6144 + j;
        for (int k = ks * 128; k < ks * 128 + 128; ++k) { const float wv = w[(size_t)k * 6144];
#pragma unroll
            for (int r = 0; r < 9; ++r) acc[r] += cond[r][k] * wv; }
#pragma unroll
        for (int r = 0; r < 9; ++r) red[ks][r][jj] = acc[r];
        __syncthreads();
        for (int t = tid; t < 9 * 64; t += 512) { const int r = t >> 6, q = t & 63; float s = 0.f; for (int z = 0; z < 8; ++z) s += red[z][r][q];
            ((float*)(p.ws + OFF_MOD))[((size_t)layer * 9 + r) * 6144 + cg * 64 + q] = s + p.ada_b[layer * 6144 + cg * 64 + q]; }
        __syncthreads();
    }
    if (blockIdx.x == (gridDim.x > 1 ? 1u : 0u)) {
        for (int t = tid; t < 1024; t += 512) { const int pos = t >> 4, i = t & 15; float sn, cs; sincosf((float)pos * expf(-(float)i * (1.f / 16.f) * 9.210340371976184f), &sn, &cs);
            ((float2*)(p.ws + OFF_ROPE))[t] = make_float2(cs, sn); }
    }
    if (blockIdx.x == 0) {
        for (int t = tid; t < 1024; t += 512) { const int layer = t >> 9, dir = (t >> 8) & 1, w = t & 255;
            const float t0 = p.hlb[(dir * 2 + 0) * 256 + w], t1 = p.hlb[(dir * 2 + 1) * 256 + w];
            const float mx = fmaxf(t0, t1), e0 = expf(t0 - mx), e1 = expf(t1 - mx);
            float lb = layer == 0 ? 0.f : e1 / (e0 + e1); lb = fminf(fmaxf(lb, 0.f), 1.f);
            ((float*)(p.ws + OFF_LB))[(layer * 2 + dir) * 256 + w] = lb; }
        if (tid < 128) { const int layer = tid >> 6, lane = tid & 63; const float* L = p.dlam + layer * 256;
            const float s1 = wsum(L[lane] * L[64 + lane]), s2 = wsum(L[128 + lane] * L[192 + lane]);
            if (lane == 0) ((float*)(p.ws + OFF_LAM))[layer] = expf(s1) - expf(s2) + lam_init_of(layer); }
    }
}

DEV void ph_init(const Params& p, char* smem) {
    const int tidx = tid_of(p.wave_id);
    const int wid = tidx >> 6, lane = tidx & 63;
    for (int r = blockIdx.x * 8 + wid; r < NT; r += gridDim.x * 8) {
        const int b = r / SL, s = r % SL;
        const float* src = s < CTX ? p.ctx + ((size_t)b * CTX + s) * D : p.x + ((size_t)b * SEQ + (s - CTX)) * D;
        float4 v[4], o[4]; row_load(src, v, lane); row_store(((float*)(p.ws + OFF_X)) + (size_t)r * D, v, lane);
        const float* m = modrow(p, 0, b, s);
        row_modnorm(v, p.norms + 0, m + 0, m + 1024, o, lane);
        row_store_bf16((bf16_t*)(p.ws + OFF_XNB) + (size_t)r * D, o, lane);
    }
}


struct EpiIn {
    static constexpr bool PERM = false;
    bf16_t *PB, *QRB, *Q0B, *KB, *VB; const float* CS;
    DEV void operator()(const pg8::f32x4 (&acc)[2][2][4][2], const pg8::Unit& u, int wr, int wc, int fr, int fq) const {
        using pg8::f32x4; using pg8::u32x2;
        const int pn = u.pn;
        if (pn < 8 || pn == 14) {
#pragma unroll
            for (int ai = 0; ai < 2; ++ai)
#pragma unroll
                for (int m = 0; m < 4; ++m) { bf16_t* rowp = PB + (size_t)(u.pm * 256 + ai * 128 + wr * 64 + m * 16 + fr) * DP + pn * 256 + wc * 32 + 4 * fq;
#pragma unroll
                    for (int bj = 0; bj < 2; ++bj)
#pragma unroll
                        for (int n = 0; n < 2; ++n) { const f32x4 v = acc[ai][bj][m][n]; u32x2 w; w.x = cvt_pk_bf16(v[0], v[1]); w.y = cvt_pk_bf16(v[2], v[3]); *(u32x2*)(rowp + bj * 128 + n * 16) = w; } }
        } else {
            const int kind = (pn - 8) >> 1, hb = ((pn - 8) & 1) * 2, b = u.pm / 9, tq = u.pm % 9, half = wc & 1, jsub = wc >> 1;
            const bool isctx = tq == 0;
            const float QC = 0.125f * 1.4426950408889634f;
#pragma unroll
            for (int ai = 0; ai < 2; ++ai)
#pragma unroll
                for (int m = 0; m < 4; ++m) {
                    const int s = tq * 256 + ai * 128 + wr * 64 + m * 16 + fr;
                    f32x4 c4 = {1.f, 1.f, 1.f, 1.f}, s4 = {0.f, 0.f, 0.f, 0.f};
                    if (kind != 2 && !isctx) { const int pos = half == 0 ? (tq - 1) * 4 + ai * 2 + wr : m * 16 + fr;
                        const f32x4 t0 = *(const f32x4*)(CS + (pos * 16 + 4 * fq) * 2), t1 = *(const f32x4*)(CS + (pos * 16 + 4 * fq) * 2 + 4);
                        c4 = (f32x4){t0[0], t0[2], t1[0], t1[2]}; s4 = (f32x4){t0[1], t0[3], t1[1], t1[3]}; }
#pragma unroll
                    for (int bj = 0; bj < 2; ++bj) {
                        const size_t dst = ((size_t)(b * 4 + hb + bj) * SL + s) * 128 + jsub * 64 + half * 32 + 4 * fq;
                        const f32x4 x1 = acc[ai][bj][m][0], x2 = acc[ai][bj][m][1];
#define ST4(ptr, v) do { u32x2 w_; w_.x = cvt_pk_bf16((v)[0], (v)[1]); w_.y = cvt_pk_bf16((v)[2], (v)[3]); *(u32x2*)(ptr) = w_; } while (0)
                        if (kind == 2) { ST4(VB + dst, x1); ST4(VB + dst + 16, x2); }
                        else {
                            const f32x4 o1 = x1 * c4 - x2 * s4, o2 = x1 * s4 + x2 * c4;
                            if (kind == 1) { ST4(KB + dst, o1); ST4(KB + dst + 16, o2); }
                            else { const f32x4 a1 = o1 * QC, a2 = o2 * QC, p1 = x1 * QC, p2 = x2 * QC; ST4(QRB + dst, a1); ST4(QRB + dst + 16, a2); ST4(Q0B + dst, p1); ST4(Q0B + dst + 16, p2); }
                        }
#undef ST4
                    }
                }
        }
    }
};
DEV void ph_inproj(const Params& p, int layer, char* smem) {
    const int tidx = tid_of(p.wave_id);
    pg8::StaticOrder S; S.init(NT / 256, DP / 256, (int)gridDim.x, (int)blockIdx.x, 0, (const bf16_t*)(p.ws + OFF_WIN) + (size_t)layer * DP * D, D);
    EpiIn E{(bf16_t*)(p.ws + OFF_PB), (bf16_t*)(p.ws + OFF_QRB), (bf16_t*)(p.ws + OFF_Q0B), (bf16_t*)(p.ws + OFF_KB), (bf16_t*)(p.ws + OFF_VB), (const float*)(p.ws + OFF_ROPE)};
    pg8::gemm_phase(( LAS unsigned char*)smem, (const char*)(p.ws + OFF_XNB), D, S, E, tid_of(p.wave_id));
}


namespace scn {
using att::bf16x8; using att::s16x4; using att::f32x16; using att::u32x4; using att::crow;
DEV int v_st64(int k, int c) { const int kk = (k & ~0xC) | ((k & 4) << 1) | ((k & 8) >> 1); return ((kk >> 3) * 2 + (c >> 5)) * 512 + ((kk & 7) * 32 + (c & 31)) * 2; }
constexpr int v_rd_off64(int d0, int ks, int half) { return d0 * 512 + ks * 2048 + half * 1024; }
#define SCN_PK(L, H) (bf16x8){L[0], L[1], L[2], L[3], H[0], H[1], H[2], H[3]}
template <int D0> DEV void frags4(int vb, bf16x8& f0, bf16x8& f1, bf16x8& f2, bf16x8& f3) {
    const s16x4 l0 = att::tr_read<v_rd_off64(D0, 0, 0)>(vb), h0 = att::tr_read<v_rd_off64(D0, 0, 1)>(vb), l1 = att::tr_read<v_rd_off64(D0, 1, 0)>(vb), h1 = att::tr_read<v_rd_off64(D0, 1, 1)>(vb);
    const s16x4 l2 = att::tr_read<v_rd_off64(D0, 2, 0)>(vb), h2 = att::tr_read<v_rd_off64(D0, 2, 1)>(vb), l3 = att::tr_read<v_rd_off64(D0, 3, 0)>(vb), h3 = att::tr_read<v_rd_off64(D0, 3, 1)>(vb);
    asm volatile("s_waitcnt lgkmcnt(0)" ::: "memory"); SBAR();
    f0 = SCN_PK(l0, h0); f1 = SCN_PK(l1, h1); f2 = SCN_PK(l2, h2); f3 = SCN_PK(l3, h3);
}
DEV bf16x8 pack8(const float (&v)[8]) { u32x4 w = {cvt_pk_bf16(v[0], v[1]), cvt_pk_bf16(v[2], v[3]), cvt_pk_bf16(v[4], v[5]), cvt_pk_bf16(v[6], v[7])}; return *reinterpret_cast<bf16x8*>(&w); }
DEV void stage64(char* img, const float* src, size_t ld, int lane, float sc = 1.f) {
    const float* row = src + (size_t)lane * ld;
#pragma unroll
    for (int c8 = 0; c8 < 8; ++c8) { const float4 a = *(const float4*)(row + c8 * 8), b = *(const float4*)(row + c8 * 8 + 4);
        u32x4 w = {cvt_pk_bf16(a.x * sc, a.y * sc), cvt_pk_bf16(a.z * sc, a.w * sc), cvt_pk_bf16(b.x * sc, b.y * sc), cvt_pk_bf16(b.z * sc, b.w * sc)};
        *(u32x4*)(img + v_st64(lane, c8 * 8)) = w; }
}
template <int CTRL, int RM> DEV float dpp_f(float oldv, float v, bool bc) { return bc ? __builtin_bit_cast(float, __builtin_amdgcn_update_dpp(__builtin_bit_cast(int, oldv), __builtin_bit_cast(int, v), CTRL, RM, 0xf, true))
                                                                                   : __builtin_bit_cast(float, __builtin_amdgcn_update_dpp(__builtin_bit_cast(int, oldv), __builtin_bit_cast(int, v), CTRL, RM, 0xf, false)); }
DEV float bperm(float v, int src) { return __builtin_bit_cast(float, __builtin_amdgcn_ds_bpermute(src << 2, __builtin_bit_cast(int, v))); }
DEV float scan_inc32(float v) {
    v += dpp_f<0x111, 0xf>(0.f, v, true); v += dpp_f<0x112, 0xf>(0.f, v, true); v += dpp_f<0x114, 0xf>(0.f, v, true); v += dpp_f<0x118, 0xf>(0.f, v, true);
    v += dpp_f<0x142, 0xa>(0.f, v, false);
    return v;
}
DEV float scanmax_inc32(float v) {
    const float ni = -3.0e38f;
    v = fmaxf(v, dpp_f<0x111, 0xf>(ni, v, false)); v = fmaxf(v, dpp_f<0x112, 0xf>(ni, v, false)); v = fmaxf(v, dpp_f<0x114, 0xf>(ni, v, false)); v = fmaxf(v, dpp_f<0x118, 0xf>(ni, v, false));
    v = fmaxf(v, dpp_f<0x142, 0xa>(ni, v, false));
    return v;
}
DEV float scanmax_suf32(float v, int lane) {
    const float ni = -3.0e38f;
    v = fmaxf(v, dpp_f<0x101, 0xf>(ni, v, false)); v = fmaxf(v, dpp_f<0x102, 0xf>(ni, v, false)); v = fmaxf(v, dpp_f<0x104, 0xf>(ni, v, false)); v = fmaxf(v, dpp_f<0x108, 0xf>(ni, v, false));
    const float t = bperm(v, (lane & 32) | 16);
    return (lane & 16) ? v : fmaxf(v, t);
}
DEV void ld8(const bf16_t* ub, unsigned boff, float (&v)[8]) { const u32x4 w = *(const u32x4*)((const char*)ub + boff);
    v[0] = __uint_as_float(w.x << 16); v[1] = __uint_as_float(w.x & 0xffff0000u); v[2] = __uint_as_float(w.y << 16); v[3] = __uint_as_float(w.y & 0xffff0000u);
    v[4] = __uint_as_float(w.z << 16); v[5] = __uint_as_float(w.z & 0xffff0000u); v[6] = __uint_as_float(w.w << 16); v[7] = __uint_as_float(w.w & 0xffff0000u); }
DEV float ld1(const bf16_t* ub, unsigned boff) { return __uint_as_float((unsigned)(*(const unsigned short*)((const char*)ub + boff)) << 16); }
DEV void stage64b(char* img, const bf16_t* src, size_t ld, int lane) {
    const bf16_t* row = src + (size_t)lane * ld;
#pragma unroll
    for (int c8 = 0; c8 < 8; ++c8) *(u32x4*)(img + v_st64(lane, c8 * 8)) = *(const u32x4*)(row + c8 * 8);
}
DEV float4 ldg4(const float* ub, unsigned boff) { return *(const float4*)((const char*)ub + boff); }
DEV float ldg1(const float* ub, unsigned boff) { return *(const float*)((const char*)ub + boff); }
DEV float fexp(float x) { return __expf(fminf(fmaxf(x, -80.f), 80.f)); }
DEV float fsig(float x) { return __builtin_amdgcn_rcpf(1.f + __expf(-x)); }
DEV void decay_ks(const float (&x)[2][8], const float (&lb)[8], int dir, int lane, float (&cum)[2][8], float (&kk)[2][8], float (&ref)[8]) {
#pragma unroll
    for (int tb = 0; tb < 2; ++tb)
#pragma unroll
        for (int j = 0; j < 8; ++j) { const float sg = fsig(x[tb][j]); kk[tb][j] = (1.f - lb[j]) * (1.f - sg); cum[tb][j] = __logf(fmaxf(lb[j] + (1.f - lb[j]) * sg, 1e-12f)); }
#pragma unroll
    for (int j = 0; j < 8; ++j) {
        const float i0 = scan_inc32(cum[0][j]), i1 = scan_inc32(cum[1][j]), t0 = bperm(i0, lane | 31), t1 = bperm(i1, lane | 31);
        if (dir == 0) { cum[0][j] = i0; cum[1][j] = i1 + t0; ref[j] = t0; }
        else { const float x0 = cum[0][j], x1 = cum[1][j]; cum[1][j] = t1 - i1 + x1; cum[0][j] = t0 - i0 + x0 + t1; ref[j] = t1; }
        if ((j & 3) == 3) SBAR();
    }
}
}

DEV void scanA_local(const Params& p, int layer, char* Lw, int bh, int tc, int lane) {
    using namespace scn;
    asm volatile("" : "+v"(lane));
    const int r32 = lane & 31, hi = lane >> 5, b = bh >> 2, h = bh & 3;
    const bf16_t* base = (const bf16_t*)(p.ws + OFF_PB) + (size_t)(b * SL + 64 * tc) * DP;
    unsigned lo = (unsigned)(r32 * DP + 8 * hi) * 2u;
    asm volatile("" : "+v"(lo));
    char* imgV = Lw; char* imgK = Lw + 8192;
    const int vbV = (int)(uintptr_t)imgV + att::v_rd_base(lane), vbK = vbV + 8192;
    stage64b(imgV, base + O_AI + h * 64, DP, lane);
#pragma unroll 1
    for (int dir = 0; dir < 2; ++dir) {
        const int chain = bh * 2 + dir, c = dir == 0 ? tc : (tc < 4 ? 3 - tc : 39 - tc);
#pragma unroll 1
        for (int ks = 0; ks < 4; ++ks) {
            const int ch = 16 * ks + 8 * hi;
            float x[2][8], cum[2][8], kk[2][8], ref[8], lb[8];
#pragma unroll
            for (int tb = 0; tb < 2; ++tb) ld8(base + (dir ? O_AFB : O_AFF) + h * 64 + 16 * ks, lo + tb * (32u * DP * 2u), x[tb]);
            { const float* l = (const float*)(p.ws + OFF_LB) + (layer * 2 + dir) * 256 + h * 64 + ch;
#pragma unroll
              for (int j = 0; j < 8; ++j) lb[j] = l[j]; }
            decay_ks(x, lb, dir, lane, cum, kk, ref);
            float ke[8];
#pragma unroll
            for (int tb = 0; tb < 2; ++tb) {
#pragma unroll
                for (int j = 0; j < 8; ++j) { const float ce = dir == 0 ? bperm(cum[1][j], lane | 31) : bperm(cum[0][j], lane & 32);
                    ke[j] = kk[tb][j] * fexp(ce - cum[tb][j]);
                    if (tb == 1 && dir == 0 && r32 == 31) ((float*)(p.ws + OFF_DECA))[(chain * 36 + c) * 64 + ch + j] = __expf(ce);
                    if (tb == 0 && dir == 1 && r32 == 0) ((float*)(p.ws + OFF_DECA))[(chain * 36 + c) * 64 + ch + j] = __expf(ce); }
                *(bf16x8*)(imgK + v_st64(32 * tb + r32, ch)) = pack8(ke);
            }
            SBAR();
        }
        f32x16 u[2][2] = {};
        { bf16x8 k0, k1, k2, k3, v0, v1, v2, v3;
          frags4<0>(vbK, k0, k1, k2, k3); frags4<0>(vbV, v0, v1, v2, v3);
          u[0][0] = __builtin_amdgcn_mfma_f32_32x32x16_bf16(k0, v0, u[0][0], 0, 0, 0); u[0][0] = __builtin_amdgcn_mfma_f32_32x32x16_bf16(k1, v1, u[0][0], 0, 0, 0);
          u[0][0] = __builtin_amdgcn_mfma_f32_32x32x16_bf16(k2, v2, u[0][0], 0, 0, 0); u[0][0] = __builtin_amdgcn_mfma_f32_32x32x16_bf16(k3, v3, u[0][0], 0, 0, 0);
          bf16x8 w0, w1, w2, w3; frags4<1>(vbV, w0, w1, w2, w3);
          u[0][1] = __builtin_amdgcn_mfma_f32_32x32x16_bf16(k0, w0, u[0][1], 0, 0, 0); u[0][1] = __builtin_amdgcn_mfma_f32_32x32x16_bf16(k1, w1, u[0][1], 0, 0, 0);
          u[0][1] = __builtin_amdgcn_mfma_f32_32x32x16_bf16(k2, w2, u[0][1], 0, 0, 0); u[0][1] = __builtin_amdgcn_mfma_f32_32x32x16_bf16(k3, w3, u[0][1], 0, 0, 0);
          frags4<1>(vbK, k0, k1, k2, k3);
          u[1][0] = __builtin_amdgcn_mfma_f32_32x32x16_bf16(k0, v0, u[1][0], 0, 0, 0); u[1][0] = __builtin_amdgcn_mfma_f32_32x32x16_bf16(k1, v1, u[1][0], 0, 0, 0);
          u[1][0] = __builtin_amdgcn_mfma_f32_32x32x16_bf16(k2, v2, u[1][0], 0, 0, 0); u[1][0] = __builtin_amdgcn_mfma_f32_32x32x16_bf16(k3, v3, u[1][0], 0, 0, 0);
          u[1][1] = __builtin_amdgcn_mfma_f32_32x32x16_bf16(k0, w0, u[1][1], 0, 0, 0); u[1][1] = __builtin_amdgcn_mfma_f32_32x32x16_bf16(k1, w1, u[1][1], 0, 0, 0);
          u[1][1] = __builtin_amdgcn_mfma_f32_32x32x16_bf16(k2, w2, u[1][1], 0, 0, 0); u[1][1] = __builtin_amdgcn_mfma_f32_32x32x16_bf16(k3, w3, u[1][1], 0, 0, 0); }
        float* U = (float*)(p.ws + OFF_UA) + ((size_t)chain * 36 + c) * 4096;
#pragma unroll
        for (int kb = 0; kb < 2; ++kb)
#pragma unroll
            for (int d0 = 0; d0 < 2; ++d0)
#pragma unroll
                for (int r = 0; r < 16; ++r) U[(32 * kb + crow(r, hi)) * 64 + 32 * d0 + r32] = u[kb][d0][r];
    }
}
DEV void scanA_out(const Params& p, int layer, char* Lw, int bh, int tc, int lane) {
    using namespace scn;
    asm volatile("" : "+v"(lane));
    const int r32 = lane & 31, hi = lane >> 5, b = bh >> 2, h = bh & 3;
    const bf16_t* base = (const bf16_t*)(p.ws + OFF_PB) + (size_t)(b * SL + 64 * tc) * DP;
    unsigned lo = (unsigned)(r32 * DP + 8 * hi) * 2u;
    asm volatile("" : "+v"(lo));
    char* imgV = Lw; char* imgS = Lw + 8192;
    const int vbV = (int)(uintptr_t)imgV + att::v_rd_base(lane), vbS = vbV + 8192;
    stage64b(imgV, base + O_AI + h * 64, DP, lane);
    f32x16 o[2][2] = {};
#pragma unroll 1
    for (int dir = 0; dir < 2; ++dir) {
        const int chain = bh * 2 + dir, c = dir == 0 ? tc : (tc < 4 ? 3 - tc : 39 - tc);
        const float* S0g = (const float*)(p.ws + OFF_SA) + ((size_t)chain * 36 + c) * 4096;
        f32x16 pd0 = {}, pd1 = {}, px = {};
#define MM(acc, A, B) acc = __builtin_amdgcn_mfma_f32_32x32x16_bf16(A, B, acc, 0, 0, 0)
#define LOADX(ks) do { _Pragma("unroll") for (int tb = 0; tb < 2; ++tb) ld8(base + (dir ? O_AFB : O_AFF) + h * 64 + 16 * (ks), lo + tb * (32u * DP * 2u), xr[tb]); } while (0)
#define LOADQ(ks) do { _Pragma("unroll") for (int tb = 0; tb < 2; ++tb) ld8(base + O_AQ + h * 64 + 16 * (ks), lo + tb * (32u * DP * 2u), qr[tb]); } while (0)
        float xr[2][8], qr[2][8];
#define KSTEP(ks) do { \
            const int ch = 16 * (ks) + 8 * hi; \
            float cum[2][8], kk[2][8], ref[8], lb[8]; \
            { const float* l = (const float*)(p.ws + OFF_LB) + (layer * 2 + dir) * 256 + h * 64 + ch; _Pragma("unroll") for (int j = 0; j < 8; ++j) lb[j] = l[j]; } \
            const int ci = lane >> 2; const int row = 16 * (ks) + ci, c16 = (lane & 3) * 16; const float* sp = S0g + row * 64 + c16; \
            LOADX(ks); LOADQ(ks); decay_ks(xr, lb, dir, lane, cum, kk, ref); \
            const float4 sa = *(const float4*)sp, sb4 = *(const float4*)(sp + 4), sc4 = *(const float4*)(sp + 8), sd4 = *(const float4*)(sp + 12); \
              \
            { const int sj = ci & 7, sl = (ci >> 3) * 32; float rv = 0.f; \
              _Pragma("unroll") for (int j = 0; j < 8; ++j) { const float t = bperm(ref[j], sl); rv = (sj == j) ? t : rv; } \
              const float er = __expf(fmaxf(rv, -80.f)); \
              u32x4 w0 = {cvt_pk_bf16(sa.x * er, sa.y * er), cvt_pk_bf16(sa.z * er, sa.w * er), cvt_pk_bf16(sb4.x * er, sb4.y * er), cvt_pk_bf16(sb4.z * er, sb4.w * er)}; \
              u32x4 w1 = {cvt_pk_bf16(sc4.x * er, sc4.y * er), cvt_pk_bf16(sc4.z * er, sc4.w * er), cvt_pk_bf16(sd4.x * er, sd4.y * er), cvt_pk_bf16(sd4.z * er, sd4.w * er)}; \
              *(u32x4*)(imgS + v_st64(row, c16)) = w0; *(u32x4*)(imgS + v_st64(row, c16 + 8)) = w1; } \
            bf16x8 qt0, qt1, kt0, kt1; \
            _Pragma("unroll") for (int tb = 0; tb < 2; ++tb) { \
                float t1[8], t2[8]; \
                _Pragma("unroll") for (int j = 0; j < 8; ++j) { const float q = qr[tb][j] * fsig(qr[tb][j]); t1[j] = q * fexp(cum[tb][j] - ref[j]); t2[j] = kk[tb][j] * fexp(ref[j] - cum[tb][j]); } \
                if (tb == 0) { qt0 = pack8(t1); kt0 = pack8(t2); } else { qt1 = pack8(t1); kt1 = pack8(t2); } } \
            MM(pd0, kt0, qt0); MM(pd1, kt1, qt1); if (dir == 0) MM(px, kt0, qt1); else MM(px, kt1, qt0); \
            { const s16x4 l0 = att::tr_read<v_rd_off64(0, ks, 0)>(vbS), h0 = att::tr_read<v_rd_off64(0, ks, 1)>(vbS), l1 = att::tr_read<v_rd_off64(1, ks, 0)>(vbS), h1 = att::tr_read<v_rd_off64(1, ks, 1)>(vbS); \
              asm volatile("s_waitcnt lgkmcnt(0)" ::: "memory"); SBAR(); \
              const bf16x8 s0 = SCN_PK(l0, h0), s1 = SCN_PK(l1, h1); \
              MM(o[0][0], qt0, s0); MM(o[1][0], qt1, s0); MM(o[0][1], qt0, s1); MM(o[1][1], qt1, s1); } \
            SBAR(); } while (0)
        KSTEP(0); KSTEP(1); KSTEP(2); KSTEP(3);
#undef KSTEP
#undef LOADX
#undef LOADQ
        const int r32m = r32;
#pragma unroll
        for (int r = 0; r < 16; ++r) { const int sl = crow(r, hi); const bool keep = dir == 0 ? (sl <= r32m) : (sl >= r32m); pd0[r] = keep ? pd0[r] : 0.f; pd1[r] = keep ? pd1[r] : 0.f; }
        bf16x8 a0, a1, b0, b1, c0, c1;
#define PK4(P, BASE, OUT) do { unsigned a0_ = cvt_pk_bf16(P[BASE + 0], P[BASE + 1]), a1_ = cvt_pk_bf16(P[BASE + 2], P[BASE + 3]);   \
    unsigned b0_ = cvt_pk_bf16(P[BASE + 4], P[BASE + 5]), b1_ = cvt_pk_bf16(P[BASE + 6], P[BASE + 7]);                              \
    auto r0_ = __builtin_amdgcn_permlane32_swap(a0_, b0_, false, false); auto r1_ = __builtin_amdgcn_permlane32_swap(a1_, b1_, false, false); \
    u32x4 w_ = {r0_[0], r1_[0], r0_[1], r1_[1]}; OUT = *reinterpret_cast<bf16x8*>(&w_); } while (0)
        PK4(pd0, 0, a0); PK4(pd0, 8, a1); PK4(pd1, 0, b0); PK4(pd1, 8, b1); PK4(px, 0, c0); PK4(px, 8, c1);
#undef PK4
        {   bf16x8 v0, v1, v2, v3;
#define BLOCK(D0) do { frags4<D0>(vbV, v0, v1, v2, v3); \
            if (dir == 0) { MM(o[0][D0], a0, v0); MM(o[0][D0], a1, v1); MM(o[1][D0], c0, v0); MM(o[1][D0], c1, v1); MM(o[1][D0], b0, v2); MM(o[1][D0], b1, v3); } \
            else          { MM(o[0][D0], a0, v0); MM(o[0][D0], a1, v1); MM(o[0][D0], c0, v2); MM(o[0][D0], c1, v3); MM(o[1][D0], b0, v2); MM(o[1][D0], b1, v3); } } while (0)
            BLOCK(0); BLOCK(1);
#undef BLOCK
        }
#undef MM
    }
    unsigned rob = (unsigned)(4 * hi * DP + r32) * 2u, mob = (unsigned)(4 * hi * D + r32) * 2u;
    asm volatile("" : "+v"(rob), "+v"(mob));
    float gv[2][16][2];
#pragma unroll
    for (int tb = 0; tb < 2; ++tb)
#pragma unroll
        for (int r = 0; r < 16; ++r) { const unsigned go = rob + (unsigned)(32 * tb + (r & 3) + 8 * (r >> 2)) * (DP * 2u); const bf16_t* gb = base + O_AG + h * 64;
            gv[tb][r][0] = ld1(gb, go); gv[tb][r][1] = ld1(gb, go + 64u); }
#pragma unroll
    for (int tb = 0; tb < 2; ++tb)
#pragma unroll
        for (int r = 0; r < 16; ++r) {
            const float x0 = o[tb][0][r], x1 = o[tb][1][r];
            float t = x0 * x0 + x1 * x1; t += bperm(t, lane ^ 1); t += bperm(t, lane ^ 2); t += bperm(t, lane ^ 4); t += bperm(t, lane ^ 8); t += bperm(t, lane ^ 16);
            const float ri = rsqrtf(t * (1.f / 64.f) + 1e-6f);
            const unsigned tcst = (unsigned)(32 * tb + (r & 3) + 8 * (r >> 2));
            const float g0 = gv[tb][r][0], g1 = gv[tb][r][1];
            char* mb = (char*)((bf16_t*)(p.ws + OFF_MIXB) + (size_t)(b * SL + 64 * tc) * D + h * 64); const unsigned mo = mob + tcst * (D * 2u);
            *(bf16_t*)(mb + mo) = (bf16_t)(cvt_pk_bf16(x0 * ri * p.hnorm[layer * 64 + r32] * (g0 * fsig(g0)), 0.f) & 0xffffu);
            *(bf16_t*)(mb + mo + 64u) = (bf16_t)(cvt_pk_bf16(x1 * ri * p.hnorm[layer * 64 + 32 + r32] * (g1 * fsig(g1)), 0.f) & 0xffffu);
        }
}

namespace scn {
DEV float logsig_f(float g) { return fminf(g, 0.f) - __logf(1.f + __expf(-fabsf(g))); }
DEV void gates_B(const bf16_t* gb  , unsigned rowoff, int dir, float bi, float bf, int lane, float (&cumf)[2], float (&g)[2], float (&G)[2], float& cend, float& gmax) {
    float lf[2], li[2];
#pragma unroll
    for (int tb = 0; tb < 2; ++tb) { const unsigned bo = rowoff + tb * (32u * DP * 2u); li[tb] = ld1(gb + (dir * 2 + 0) * 4, bo) + bi; lf[tb] = logsig_f(ld1(gb + (dir * 2 + 1) * 4, bo) + bf); }
    { const float i0 = scan_inc32(lf[0]), i1 = scan_inc32(lf[1]), t0 = bperm(i0, lane | 31), t1 = bperm(i1, lane | 31);
      if (dir == 0) { cumf[0] = i0; cumf[1] = i1 + t0; } else { cumf[1] = t1 - i1 + lf[1]; cumf[0] = t0 - i0 + lf[0] + t1; }
      cend = t0 + t1; }
    g[0] = li[0] - cumf[0]; g[1] = li[1] - cumf[1];
    if (dir == 0) { const float a0 = scanmax_inc32(g[0]), m0 = bperm(a0, lane | 31), a1 = fmaxf(scanmax_inc32(g[1]), m0); G[0] = a0; G[1] = a1; gmax = bperm(a1, lane | 31); }
    else { const float a1 = scanmax_suf32(g[1], lane), m1 = bperm(a1, lane & 32), a0 = fmaxf(scanmax_suf32(g[0], lane), m1); G[0] = a0; G[1] = a1; gmax = bperm(a0, lane & 32); }
}
}
DEV void scanB_local(const Params& p, int layer, char* Lw, int bh, int tc, int lane) {
    using namespace scn;
    asm volatile("" : "+v"(lane));
    const int r32 = lane & 31, hi = lane >> 5, b = bh >> 2, h = bh & 3;
    const bf16_t* base = (const bf16_t*)(p.ws + OFF_PB) + (size_t)(b * SL + 64 * tc) * DP;
    unsigned ro = (unsigned)(r32 * DP) * 2u; asm volatile("" : "+v"(ro));
    char* imgV = Lw; char* imgK = Lw + 8192;
    const int vbV = (int)(uintptr_t)imgV + att::v_rd_base(lane), vbK = vbV + 8192;
    stage64b(imgV, base + O_BV + h * 64, DP, lane);
#pragma unroll 1
    for (int dir = 0; dir < 2; ++dir) {
        const int chain = bh * 2 + dir, c = dir == 0 ? tc : (tc < 4 ? 3 - tc : 39 - tc);
        const float bi = p.mgb[layer * 16 + (dir * 2 + 0) * 4 + h], bf = p.mgb[layer * 16 + (dir * 2 + 1) * 4 + h];
        float cumf[2], g[2], G[2], cend, gmax;
        gates_B(base + O_BG + h, ro, dir, bi, bf, lane, cumf, g, G, cend, gmax);
        const float w[2] = {__expf(g[0] - gmax), __expf(g[1] - gmax)};
#pragma unroll
        for (int ks = 0; ks < 2; ++ks) {
            float un[8];
#pragma unroll
            for (int j = 0; j < 8; ++j) un[j] = 0.f;
#pragma unroll
            for (int tb = 0; tb < 2; ++tb) { float wk[8]; ld8(base + O_BK + h * 32 + 16 * ks, ro + 16u * hi + tb * (32u * DP * 2u), wk);
#pragma unroll
                for (int j = 0; j < 8; ++j) { wk[j] *= w[tb]; un[j] += wk[j]; }
                *(bf16x8*)(imgK + v_st64(32 * tb + r32, 16 * ks + 8 * hi)) = pack8(wk); }
#pragma unroll
            for (int j = 0; j < 8; ++j) { float t = un[j]; t += bperm(t, lane ^ 1); t += bperm(t, lane ^ 2); t += bperm(t, lane ^ 4); t += bperm(t, lane ^ 8); t += bperm(t, lane ^ 16);
                if (r32 == 0) ((float*)(p.ws + OFF_NB))[(chain * 36 + c) * 32 + 16 * ks + 8 * hi + j] = t; }
        }
        f32x16 u0 = {}, u1 = {};
        { bf16x8 k0, k1, k2, k3, v0, v1, v2, v3;
#define MM(acc, A, B) acc = __builtin_amdgcn_mfma_f32_32x32x16_bf16(A, B, acc, 0, 0, 0)
          frags4<0>(vbK, k0, k1, k2, k3); frags4<0>(vbV, v0, v1, v2, v3);
          MM(u0, k0, v0); MM(u0, k1, v1); MM(u0, k2, v2); MM(u0, k3, v3);
          frags4<1>(vbV, v0, v1, v2, v3);
          MM(u1, k0, v0); MM(u1, k1, v1); MM(u1, k2, v2); MM(u1, k3, v3);
#undef MM
        }
        float* U = (float*)(p.ws + OFF_UB) + ((size_t)chain * 36 + c) * 2048;
#pragma unroll
        for (int r = 0; r < 16; ++r) { U[crow(r, hi) * 64 + r32] = u0[r]; U[crow(r, hi) * 64 + 32 + r32] = u1[r]; }
        if (lane == 0) { float* M = (float*)(p.ws + OFF_MB) + (chain * 36 + c) * 4; M[0] = cend + gmax; M[1] = cend; }
    }
}
DEV void scanB_out(const Params& p, int layer, char* Lw, int bh, int tc, int lane) {
    using namespace scn;
    asm volatile("" : "+v"(lane));
    const int r32 = lane & 31, hi = lane >> 5, b = bh >> 2, h = bh & 3;
    const bf16_t* base = (const bf16_t*)(p.ws + OFF_PB) + (size_t)(b * SL + 64 * tc) * DP;
    unsigned ro = (unsigned)(r32 * DP) * 2u; asm volatile("" : "+v"(ro));
    char* imgV = Lw; char* imgC = Lw + 8192; float* gA = (float*)(Lw + 12288); float* dA = gA + 64;
    const int vbV = (int)(uintptr_t)imgV + att::v_rd_base(lane), vbC = vbV + 8192;
    stage64b(imgV, base + O_BV + h * 64, DP, lane);
#pragma unroll 1
    for (int dir = 0; dir < 2; ++dir) {
        const int chain = bh * 2 + dir, c = dir == 0 ? tc : (tc < 4 ? 3 - tc : 39 - tc);
        const float bi = p.mgb[layer * 16 + (dir * 2 + 0) * 4 + h], bf = p.mgb[layer * 16 + (dir * 2 + 1) * 4 + h];
        { const float* cg = (const float*)(p.ws + OFF_SB) + ((size_t)chain * 36 + c) * 2048 + (lane >> 1) * 64 + (lane & 1) * 32;
#pragma unroll
          for (int i = 0; i < 4; ++i) { const float4 a = *(const float4*)(cg + 8 * i), bq = *(const float4*)(cg + 8 * i + 4);
              u32x4 w = {cvt_pk_bf16(a.x, a.y), cvt_pk_bf16(a.z, a.w), cvt_pk_bf16(bq.x, bq.y), cvt_pk_bf16(bq.z, bq.w)};
              *(u32x4*)(imgC + v_st64(lane >> 1, (lane & 1) * 32 + 8 * i)) = w; } }
        const float m0 = ((const float*)(p.ws + OFF_MB))[(chain * 36 + c) * 4 + 2];
        float rq[2][2][8], rk[2][2][8];
#pragma unroll
        for (int ks = 0; ks < 2; ++ks)
#pragma unroll
            for (int tb = 0; tb < 2; ++tb) { const unsigned bo = ro + 16u * hi + tb * (32u * DP * 2u);
                ld8(base + O_BQ + h * 32 + 16 * ks, bo, rq[ks][tb]); ld8(base + O_BK + h * 32 + 16 * ks, bo, rk[ks][tb]); }
        float cumf[2], g[2], G[2], cend, gmax;
        gates_B(base + O_BG + h, ro, dir, bi, bf, lane, cumf, g, G, cend, gmax);
        float wi[2], wl[2], emt[2];
#pragma unroll
        for (int tb = 0; tb < 2; ++tb) { const float ml = cumf[tb] + G[tb], mt = fmaxf(cumf[tb] + m0, ml); wi[tb] = __expf(cumf[tb] + m0 - mt); wl[tb] = __expf(ml - mt); emt[tb] = __expf(-mt); }
        if (hi == 0) { gA[r32] = g[0]; gA[32 + r32] = g[1]; }
        f32x16 pd0 = {}, pd1 = {}, px = {};
        float qn[2] = {0.f, 0.f};
        bf16x8 qw[2][2];
#define MM(acc, A, B) acc = __builtin_amdgcn_mfma_f32_32x32x16_bf16(A, B, acc, 0, 0, 0)
#define KSTEP(ks) do { \
            bf16x8 qs0, qs1, kt0, kt1; \
            const float* nn = (const float*)(p.ws + OFF_N0) + (chain * 36 + c) * 32 + 16 * (ks) + 8 * hi; \
            _Pragma("unroll") for (int tb = 0; tb < 2; ++tb) { \
                float q8[8], k8[8], qv[8]; \
                _Pragma("unroll") for (int j = 0; j < 8; ++j) { q8[j] = rq[ks][tb][j] * 0.17677669529663687f; k8[j] = rk[ks][tb][j]; qn[tb] += q8[j] * nn[j]; qv[j] = q8[j] * wi[tb]; } \
                qw[tb][ks] = pack8(qv); \
                if (tb == 0) { qs0 = pack8(q8); kt0 = pack8(k8); } else { qs1 = pack8(q8); kt1 = pack8(k8); } } \
            MM(pd0, kt0, qs0); MM(pd1, kt1, qs1); if (dir == 0) MM(px, kt0, qs1); else MM(px, kt1, qs0); \
            SBAR(); } while (0)
        KSTEP(0); KSTEP(1);
#undef KSTEP
        qn[0] += bperm(qn[0], lane ^ 32); qn[1] += bperm(qn[1], lane ^ 32);
        float ds[2] = {0.f, 0.f};
#pragma unroll
        for (int r = 0; r < 16; ++r) {
            const int sl = crow(r, hi); const bool keep = dir == 0 ? (sl <= r32) : (sl >= r32);
            const float g0 = gA[sl], g1 = gA[32 + sl];
            const float e00 = keep ? __expf(g0 - G[0]) * wl[0] : 0.f, e11 = keep ? __expf(g1 - G[1]) * wl[1] : 0.f;
            const float ex = dir == 0 ? __expf(g0 - G[1]) * wl[1] : __expf(g1 - G[0]) * wl[0];
            pd0[r] *= e00; pd1[r] *= e11; px[r] *= ex;
            if (dir == 0) { ds[0] += pd0[r]; ds[1] += pd1[r] + px[r]; } else { ds[0] += pd0[r] + px[r]; ds[1] += pd1[r]; }
        }
        ds[0] += bperm(ds[0], lane ^ 32); ds[1] += bperm(ds[1], lane ^ 32);
#pragma unroll
        for (int tb = 0; tb < 2; ++tb) { const float den = wi[tb] * qn[tb] + ds[tb]; const float di = __builtin_amdgcn_rcpf(fmaxf(fabsf(den), emt[tb])); if (hi == 0) dA[32 * tb + r32] = di; }
        bf16x8 a0, a1, b0, b1, c0, c1;
#define PK4(P, BASE, OUT) do { unsigned a0_ = cvt_pk_bf16(P[BASE + 0], P[BASE + 1]), a1_ = cvt_pk_bf16(P[BASE + 2], P[BASE + 3]);   \
    unsigned b0_ = cvt_pk_bf16(P[BASE + 4], P[BASE + 5]), b1_ = cvt_pk_bf16(P[BASE + 6], P[BASE + 7]);                              \
    auto r0_ = __builtin_amdgcn_permlane32_swap(a0_, b0_, false, false); auto r1_ = __builtin_amdgcn_permlane32_swap(a1_, b1_, false, false); \
    u32x4 w_ = {r0_[0], r1_[0], r0_[1], r1_[1]}; OUT = *reinterpret_cast<bf16x8*>(&w_); } while (0)
        PK4(pd0, 0, a0); PK4(pd0, 8, a1); PK4(pd1, 0, b0); PK4(pd1, 8, b1); PK4(px, 0, c0); PK4(px, 8, c1);
#undef PK4
        SBAR();
        f32x16 o[2][2] = {};
        {   bf16x8 v0, v1, v2, v3;
#define BLOCK(D0) do { frags4<D0>(vbV, v0, v1, v2, v3); \
            if (dir == 0) { MM(o[0][D0], a0, v0); MM(o[0][D0], a1, v1); MM(o[1][D0], c0, v0); MM(o[1][D0], c1, v1); MM(o[1][D0], b0, v2); MM(o[1][D0], b1, v3); } \
            else          { MM(o[0][D0], a0, v0); MM(o[0][D0], a1, v1); MM(o[0][D0], c0, v2); MM(o[0][D0], c1, v3); MM(o[1][D0], b0, v2); MM(o[1][D0], b1, v3); } \
            { const s16x4 l0 = att::tr_read<v_rd_off64(D0, 0, 0)>(vbC), h0 = att::tr_read<v_rd_off64(D0, 0, 1)>(vbC), l1 = att::tr_read<v_rd_off64(D0, 1, 0)>(vbC), h1 = att::tr_read<v_rd_off64(D0, 1, 1)>(vbC); \
              asm volatile("s_waitcnt lgkmcnt(0)" ::: "memory"); SBAR(); \
              const bf16x8 s0 = SCN_PK(l0, h0), s1 = SCN_PK(l1, h1); \
              MM(o[0][D0], qw[0][0], s0); MM(o[0][D0], qw[0][1], s1); MM(o[1][D0], qw[1][0], s0); MM(o[1][D0], qw[1][1], s1); } } while (0)
            BLOCK(0); BLOCK(1);
#undef BLOCK
        }
#undef MM
        asm volatile("s_waitcnt lgkmcnt(0)" ::: "memory");
        unsigned rob = (unsigned)(4 * hi * DP + r32) * 2u, mob = (unsigned)(4 * hi * D + r32) * 2u, hob = (unsigned)(4 * hi * 256 + r32) * 4u;
        asm volatile("" : "+v"(rob), "+v"(mob), "+v"(hob));
        float* hpk = (float*)(p.ws + OFF_HB2) + (size_t)(b * SL + 64 * tc) * 256 + h * 64;
        if (dir == 0) {
#pragma unroll
            for (int tb = 0; tb < 2; ++tb)
#pragma unroll
                for (int r = 0; r < 16; ++r) { const float di = dA[32 * tb + crow(r, hi)]; const unsigned ho = hob + (unsigned)(32 * tb + (r & 3) + 8 * (r >> 2)) * 1024u;
                    *(float*)((char*)hpk + ho) = o[tb][0][r] * di; *(float*)((char*)hpk + ho + 128u) = o[tb][1][r] * di; }
            asm volatile("s_waitcnt vmcnt(0)" ::: "memory");
        } else {
#pragma unroll
            for (int tb = 0; tb < 2; ++tb)
#pragma unroll
                for (int r = 0; r < 16; ++r) {
                    const unsigned tcst = (unsigned)(32 * tb + (r & 3) + 8 * (r >> 2)); const unsigned ho = hob + tcst * 1024u;
                    const float di = dA[32 * tb + crow(r, hi)];
                    const float x0 = o[tb][0][r] * di + ldg1(hpk, ho), x1 = o[tb][1][r] * di + ldg1(hpk, ho + 128u);
                    float t = x0 * x0 + x1 * x1; t += bperm(t, lane ^ 1); t += bperm(t, lane ^ 2); t += bperm(t, lane ^ 4); t += bperm(t, lane ^ 8); t += bperm(t, lane ^ 16);
                    const float ri = rsqrtf(t * (1.f / 64.f) + 1e-6f);
                    const bf16_t* gb = base + O_BO + h * 64; const unsigned go = rob + tcst * (DP * 2u);
                    const float g0 = ld1(gb, go), g1 = ld1(gb, go + 64u);
                    char* mb = (char*)((bf16_t*)(p.ws + OFF_MIXB) + (size_t)(b * SL + 64 * tc) * D + 256 + h * 64); const unsigned mo = mob + tcst * (D * 2u);
                    *(bf16_t*)(mb + mo) = (bf16_t)(cvt_pk_bf16(x0 * ri * p.mnorm[layer * 256 + h * 64 + r32] * fsig(g0), 0.f) & 0xffffu);
                    *(bf16_t*)(mb + mo + 64u) = (bf16_t)(cvt_pk_bf16(x1 * ri * p.mnorm[layer * 256 + h * 64 + 32 + r32] * fsig(g1), 0.f) & 0xffffu);
                    if ((r & 3) == 3) SBAR();
                }
        }
    }
}

DEV int scan_token(int dir, int step) { return dir == 0 ? step : (step < CTX ? CTX - 1 - step : SL + CTX - 1 - step); }
DEV float logsig(float g) { return fminf(g, 0.f) - log1pf(expf(-fabsf(g))); }
DEV void ph_scan_local(const Params& p, int layer, char* smem) {
    const int wid = p.wave_id;
    const int gw = (int)blockIdx.x * 8 + wid, nw = (int)gridDim.x * 8;
    for (int task = gw; task < 2304; task += nw) {
        const int lane = lane_asm();
        if (task < 1152) scanA_local(p, layer, smem + wid * 16384, task / 36, task % 36, lane);
        else scanB_local(p, layer, smem + wid * 16384, (task - 1152) / 36, (task - 1152) % 36, lane);
    }
}
DEV void ph_scan_carry(const Params& p, char* smem) {
    const int tid = tid_of(p.wave_id);
    const int gt = (int)blockIdx.x * 512 + tid, nth = (int)gridDim.x * 512;
    for (int e = gt; e < 64 * 4096; e += nth) {
        const int chain = e >> 12, kv = e & 4095, k = kv >> 6;
        const float* U = (const float*)(p.ws + OFF_UA) + (size_t)chain * 36 * 4096 + kv; float* SO = (float*)(p.ws + OFF_SA) + (size_t)chain * 36 * 4096 + kv; const float* Dc = (const float*)(p.ws + OFF_DECA) + chain * 36 * 64 + k;
        float S = 0.f;
#pragma unroll 4
        for (int c = 0; c < 36; ++c) { const float u = U[(size_t)c * 4096], d = Dc[c * 64]; SO[(size_t)c * 4096] = S; S = d * S + u; }
    }
    for (int e = gt; e < 64 * 2048; e += nth) {
        const int chain = e >> 11, kv = e & 2047;
        const float* U = (const float*)(p.ws + OFF_UB) + (size_t)chain * 36 * 2048 + kv; float* SO = (float*)(p.ws + OFF_SB) + (size_t)chain * 36 * 2048 + kv; const float* M = (const float*)(p.ws + OFF_MB) + chain * 36 * 4;
        float Cc = 0.f, m = 0.f;
#pragma unroll 4
        for (int c = 0; c < 36; ++c) { const float mle = M[c * 4 + 0], ce = M[c * 4 + 1], u = U[(size_t)c * 2048]; SO[(size_t)c * 2048] = Cc;
            const float mn = fmaxf(ce + m, mle); Cc = expf(ce + m - mn) * Cc + expf(mle - mn) * u; m = mn; }
    }
    for (int e = gt; e < 64 * 32; e += nth) {
        const int chain = e >> 5, k = e & 31;
        const float* N = (const float*)(p.ws + OFF_NB) + chain * 36 * 32 + k; float* NO = (float*)(p.ws + OFF_N0) + chain * 36 * 32 + k; float* M = (float*)(p.ws + OFF_MB) + chain * 36 * 4;
        float nn = 0.f, m = 0.f;
        for (int c = 0; c < 36; ++c) { const float mle = M[c * 4 + 0], ce = M[c * 4 + 1], u = N[c * 32]; NO[c * 32] = nn; if (k == 0) M[c * 4 + 2] = m;
            const float mn = fmaxf(ce + m, mle); nn = expf(ce + m - mn) * nn + expf(mle - mn) * u; m = mn; }
    }
}
DEV void ph_scan_out(const Params& p, int layer, char* smem) {
    const int wid = p.wave_id;
    const int gw = (int)blockIdx.x * 8 + wid, nw = (int)gridDim.x * 8;
    for (int task = gw; task < 2304; task += nw) {
        const int lane = lane_asm();
        const bool isB = task >= 1152; const int tt = isB ? task - 1152 : task, bh = tt / 36, tc = tt % 36;
        if (layer != 0 && tc < 4) continue;
        if (!isB) scanA_out(p, layer, smem + wid * 16384, bh, tc, lane);
        else scanB_out(p, layer, smem + wid * 16384, bh, tc, lane);
    }
}

DEV void ph_attn(const Params& p, int layer, char* smem) {
    const int wid = p.wave_id, js = wid & 1, qb = wid >> 1;
    const float lam = ((const float*)(p.ws + OFF_LAM))[layer], omli = 1.f - lam_init_of(layer);
    const bf16_t* KB = (const bf16_t*)(p.ws + OFF_KB); const bf16_t* VB = (const bf16_t*)(p.ws + OFF_VB);
    const bf16_t* QRB = (const bf16_t*)(p.ws + OFF_QRB); const bf16_t* Q0B = (const bf16_t*)(p.ws + OFF_Q0B);
    const int G = (int)gridDim.x, c = (int)blockIdx.x;
    const int nlat = 512, ntot = nlat + (layer == 0 ? 64 : 0);
    for (int i = 0;; ++i) {
        int bh, s0; bool isctx;
        if (G == 256) {
            const int xcd = c & 7, j = c >> 3;
            if (i < 2) { bh = xcd + 8 * (i * 2 + (j >> 4)); s0 = CTX + (j & 15) * 128; isctx = false; }
            else if (i == 2 && layer == 0 && j < 8) { bh = xcd + 8 * (j >> 1); s0 = (j & 1) * 128; isctx = true; }
            else break;
        } else {
            const int u = i * G + c; if (u >= ntot) break;
            if (u < nlat) { bh = u >> 4; s0 = CTX + (u & 15) * 128; isctx = false; } else { const int v = u - nlat; bh = v >> 1; s0 = (v & 1) * 128; isctx = true; }
        }
        const int lane = lane_asm(), tid = (wid << 6) | lane, r32 = lane & 31, hi = lane >> 5;
        const bf16_t* Kh = KB + (size_t)bh * SL * 128; const bf16_t* Vh = VB + (size_t)bh * SL * 128;
        const size_t qoff = ((size_t)bh * SL + s0 + qb * 32 + r32) * 128 + js * 64 + hi * 8;
        att::bf16x8 qr[4];
#pragma unroll
        for (int d0 = 0; d0 < 4; ++d0) qr[d0] = *(const att::bf16x8*)(Q0B + qoff + d0 * 16);
        float m_reg = -1e30f, l_reg = 0.f; att::f32x16 o[4] = {};
        att::attn_tiles(qr, Kh, Vh, CTX, smem, m_reg, l_reg, o, tid, js);
        if (!isctx) {
#pragma unroll
            for (int d0 = 0; d0 < 4; ++d0) qr[d0] = *(const att::bf16x8*)(QRB + qoff + d0 * 16);
            att::attn_tiles(qr, Kh + (size_t)CTX * 128, Vh + (size_t)CTX * 128, SEQ, smem, m_reg, l_reg, o, tid, js);
        }
        float* wsw = (float*)(smem + 2 * att::SHM_V + 2 * att::SHM_K) + wid * 64;
        __syncthreads();
        if (hi == 0) wsw[r32] = l_reg;
        asm volatile("s_waitcnt lgkmcnt(0)" ::: "memory");
        float rli[16];
#pragma unroll
        for (int r = 0; r < 16; ++r) rli[r] = __builtin_amdgcn_rcpf(wsw[att::crow(r, hi)]);
        float* X = (float*)smem + qb * 4096;
        if (js == 1) {
#pragma unroll
            for (int d0 = 0; d0 < 4; ++d0)
#pragma unroll
                for (int r = 0; r < 16; ++r) X[(d0 * 16 + r) * 64 + lane] = o[d0][r] * rli[r];
        }
        __syncthreads();
        if (js == 0) {
            const int b = bh >> 2, h = bh & 3;
            float ss[16];
#pragma unroll
            for (int r = 0; r < 16; ++r) ss[r] = 0.f;
#pragma unroll
            for (int d0 = 0; d0 < 4; ++d0)
#pragma unroll
                for (int r = 0; r < 16; ++r) { const float v = o[d0][r] * rli[r] - lam * X[(d0 * 16 + r) * 64 + lane]; o[d0][r] = v; ss[r] += v * v; }
#pragma unroll
            for (int r = 0; r < 16; ++r) { float t = ss[r]; t += __shfl_xor(t, 1); t += __shfl_xor(t, 2); t += __shfl_xor(t, 4); t += __shfl_xor(t, 8); t += __shfl_xor(t, 16);
                ss[r] = rsqrtf(t * (1.f / 128.f) + 1e-6f) * omli; }
            bf16_t* mix = (bf16_t*)(p.ws + OFF_MIXB) + (size_t)(b * SL + s0 + qb * 32) * D + 512 + h * 128 + r32;
#pragma unroll
            for (int d0 = 0; d0 < 4; ++d0) { const float g = p.dnorm[layer * 128 + d0 * 32 + r32];
#pragma unroll
                for (int r = 0; r < 16; ++r) mix[(size_t)att::crow(r, hi) * D + d0 * 32] = (bf16_t)(cvt_pk_bf16(o[d0][r] * ss[r] * g, 0.f) & 0xffffu); }
        }
        __syncthreads();
    }
}
DEV void ph_outproj(const Params& p, int layer, char* smem) {
    const int tidx = tid_of(p.wave_id);
    pg8::StaticOrder S; S.init(layer == 0 ? NT / 256 : NB * 8, D / 256, (int)gridDim.x, (int)blockIdx.x, layer == 0 ? 0 : 1, (const bf16_t*)(p.ws + OFF_WOUT) + (size_t)layer * D * D, D);
    pg8::EpiF32 E{(float*)(p.ws + OFF_MIXO), D};
    pg8::gemm_phase((LAS unsigned char*)smem, (const char*)(p.ws + OFF_MIXB), D, S, E, tid_of(p.wave_id));
}
DEV void ph_norm2(const Params& p, int layer, char* smem) {
    typedef float f32x16 __attribute__((ext_vector_type(16)));
    const int wid = p.wave_id, lane = lane_asm(), tidx = (wid << 6) | lane;
    constexpr int XP = 1028, RP = 24;
    float* xs = (float*)smem;
    float* red = (float*)smem;
    int* hist = (int*)(smem + 32 * XP * 4);
    const float* nr = p.norms + (size_t)layer * 4 * D;
    if (tidx < NE) hist[tidx] = 0;
    const int chunk = (NT + (int)gridDim.x - 1) / (int)gridDim.x, rbeg = (int)blockIdx.x * chunk, rend = min(NT, rbeg + chunk);
    float wreg[64];
    { const float* wb = p.rw + (size_t)layer * D * NE + (size_t)(wid * 128 + (lane >> 5)) * NE + (lane & 31);
#pragma unroll
      for (int ks = 0; ks < 64; ++ks) wreg[ks] = wb[(size_t)2 * ks * NE]; }
    for (int r0 = rbeg; r0 < rend; r0 += RP) {
        __syncthreads();
#pragma unroll 1
        for (int j = 0; j < 3; ++j) {
            const int lr = wid * 3 + j, r = r0 + lr;
            if (r >= rend) continue;
            const int b = r / SL, s = r % SL;
            if (layer != 0 && s < CTX) continue;
            const float* m = modrow(p, layer, b, s);
            float4 mo[4], xv[4], o[4]; row_load(((float*)(p.ws + OFF_MIXO)) + (size_t)r * D, mo, lane); row_load(((float*)(p.ws + OFF_X)) + (size_t)r * D, xv, lane);
            const float ri = row_rinv(mo);
#pragma unroll
            for (int i = 0; i < 4; ++i) { const int idx = i * 256 + lane * 4; const float4 g = *(const float4*)(nr + D + idx), gt = *(const float4*)(m + 2048 + idx);
                xv[i].x += gt.x * (mo[i].x * ri * g.x); xv[i].y += gt.y * (mo[i].y * ri * g.y); xv[i].z += gt.z * (mo[i].z * ri * g.z); xv[i].w += gt.w * (mo[i].w * ri * g.w); }
            row_store(((float*)(p.ws + OFF_XN)) + (size_t)r * D, xv, lane);
            row_modnorm(xv, nr + 2 * D, m + 3072, m + 4096, o, lane);
            row_store_bf16((bf16_t*)(p.ws + OFF_XNB) + (size_t)r * D, o, lane);
            row_store(xs + lr * XP, o, lane);
        }
        __syncthreads();
        f32x16 acc = {};
        { const float* xa = xs + (lane & 31) * XP + wid * 128 + (lane >> 5);
#pragma unroll
          for (int ks = 0; ks < 64; ++ks) acc = __builtin_amdgcn_mfma_f32_32x32x2f32(xa[2 * ks], wreg[ks], acc, 0, 0, 0); }
        __syncthreads();
#pragma unroll
        for (int rg = 0; rg < 16; ++rg) red[(wid * 32 + (rg & 3) + 8 * (rg >> 2) + 4 * (lane >> 5)) * 32 + (lane & 31)] = acc[rg];
        __syncthreads();
#pragma unroll 1
        for (int j = 0; j < 3; ++j) {
            const int lr = wid * 3 + j, r = r0 + lr;
            if (r >= rend) continue;
            const int s = r % SL;
            if (layer != 0 && s < CTX) continue;
            const int e = lane & 31;
            float logit = p.rb[layer * NE + e];
#pragma unroll
            for (int w = 0; w < 8; ++w) logit += red[(w * 32 + lr) * 32 + e];
            float tv[4]; int ti[4];
#pragma unroll
            for (int k = 0; k < 4; ++k) {
                float bv = logit; int bi = e;
                for (int o2 = 16; o2 >= 1; o2 >>= 1) { const float ov = __shfl_xor(bv, o2); const int oi = __shfl_xor(bi, o2); if (ov > bv || (ov == bv && oi < bi)) { bv = ov; bi = oi; } }
                tv[k] = bv; ti[k] = bi; if (e == bi) logit = -3.0e38f;
            }
            const float e0 = 1.f, e1 = expf(tv[1] - tv[0]), e2 = expf(tv[2] - tv[0]), e3 = expf(tv[3] - tv[0]), inv = 1.f / (e0 + e1 + e2 + e3);
            if (lane == 0) { *(float4*)(((float*)(p.ws + OFF_TOPW)) + (size_t)r * 4) = make_float4(e0 * inv, e1 * inv, e2 * inv, e3 * inv); *(int4*)(((int*)(p.ws + OFF_TOPI)) + (size_t)r * 4) = make_int4(ti[0], ti[1], ti[2], ti[3]); }
            if (lane < 4) atomicAdd(&hist[lane == 0 ? ti[0] : lane == 1 ? ti[1] : lane == 2 ? ti[2] : ti[3]], 1);
        }
    }
    __syncthreads();
    if (tidx < NE) ((int*)(p.ws + OFF_BC))[(size_t)blockIdx.x * NE + tidx] = hist[tidx];
}
DEV void ph_route(const Params& p, int layer, char* smem) {
    const int tidx = tid_of(p.wave_id);
    int* part = (int*)smem;
    int* off = part + 1024;
    const int G = (int)gridDim.x, bid = (int)blockIdx.x;
    const int* BC = (const int*)(p.ws + OFF_BC);
    { const int e = tidx & 31, sl = tidx >> 5; int before = 0, tot = 0;
      for (int bb = sl; bb < G; bb += 16) { const int c = BC[(size_t)bb * NE + e]; tot += c; if (bb < bid) before += c; }
      part[(sl * 2 + 0) * 32 + e] = before; part[(sl * 2 + 1) * 32 + e] = tot; }
    __syncthreads();
    if (tidx < NE) { int before = 0, tot = 0; for (int sl = 0; sl < 16; ++sl) { before += part[(sl * 2 + 0) * 32 + tidx]; tot += part[(sl * 2 + 1) * 32 + tidx]; }
        off[tidx] = before; if (bid == 0) ((int*)(p.ws + OFF_CNT))[tidx] = tot; }
    __syncthreads();
    if (tidx < 64) {
        const int lane = tidx;
        const int chunk = (NT + G - 1) / G, rbeg = bid * chunk, rend = min(NT, rbeg + chunk);
        for (int q0 = rbeg * 4; q0 < rend * 4; q0 += 64) {
            const int pair = q0 + lane, r = pair >> 2, s = r % SL;
            const bool act = pair < rend * 4 && (layer == 0 || s >= CTX);
            const int my = act ? ((const int*)(p.ws + OFF_TOPI))[pair] : -1;
            for (int e = 0; e < NE; ++e) {
                const unsigned long long bal = __ballot(my == e);
                if (bal) { const int base = off[e];
                    if (my == e) ((int*)(p.ws + OFF_LIST))[(size_t)e * LISTCAP + base + __popcll(bal & ((1ull << lane) - 1ull))] = pair;
                    __builtin_amdgcn_wave_barrier();
                    if (lane == 0) off[e] = base + __popcll(bal);
                    __builtin_amdgcn_wave_barrier(); }
            }
        }
    }
}
DEV int moe_rt(int i, int G, int c, int npn, int& pn) {
    if (G == 256) { const int xcd = c & 7, j = c >> 3, rpx = 32 / npn; pn = j % npn; return (i * 8 + xcd) * rpx + j / npn; }
    const int L = i * G + c; pn = L % npn; return L / npn;
}
constexpr int MOE_LDS = 131072, MOE_MAXU = 12;
DEV void moe_prepare(const Params& p, char* smem, int npn, int mode) {
    const int tidx = tid_of(p.wave_id);
    LAS int* base = (LAS int*)(smem + MOE_LDS);
    LAS int *TE = base, *TT = base + 320, *NRT = base + 640, *UI = base + 704, *IDX = base + 768;
    const int* cnt = (const int*)(p.ws + OFF_CNT);
    if (tidx < 320) { int e = 0, acc = 0; for (; e < NE; ++e) { const int n = (cnt[e] + 255) >> 8; if (tidx < acc + n) break; acc += n; } TE[tidx] = e; TT[tidx] = tidx - acc; }
    if (tidx == 0) { int tot = 0; for (int e = 0; e < NE; ++e) tot += (cnt[e] + 255) >> 8; NRT[0] = tot; }
    __syncthreads();
    const int nrt = NRT[0];
    for (int i = 0; i < MOE_MAXU; ++i) {
        int pn; const int rt = moe_rt(i, (int)gridDim.x, (int)blockIdx.x, npn, pn);
        if (rt >= nrt) break;
        const int e = TE[rt], t = TT[rt], c = cnt[e];
        if (tidx < 256) { const int q = t * 256 + tidx; const int pair = ((const int*)(p.ws + OFF_LIST))[(size_t)e * LISTCAP + min(q, c - 1)];
            IDX[i * 256 + tidx] = mode == 1 ? (pair >> 2) : (q < c ? pair : -1); }
        if (tidx == 256) { int pre = 0; for (int z = 0; z < e; ++z) pre += cnt[z]; UI[i * 4 + 0] = min(256, c - t * 256); UI[i * 4 + 1] = pre + t * 256; }
    }
    __syncthreads();
}
struct MoeOrder {
    const LAS int *te, *ui, *idx; int nrt, npn, G, c, gather; const char* Bt; size_t bstride; int K;
    DEV bool next(int i, pg8::Unit& u) const { int pn; const int rt = moe_rt(i, G, c, npn, pn); if (rt >= nrt || i >= MOE_MAXU) return false;
        u.pm = rt; u.pn = pn; u.e = __builtin_amdgcn_readfirstlane(te[rt]); u.t = i; return true; }
    DEV int arow(const pg8::Unit& u, int rr) const { return gather ? idx[u.t * 256 + rr] : ui[u.t * 4 + 1] + rr; }
    DEV const char* bbase(const pg8::Unit& u) const { return Bt + (size_t)u.e * bstride + (size_t)u.pn * pg8::BM * K * 2; }
};
DEV float swiglu(float g, float l) { g = fminf(g, 7.f); l = fminf(fmaxf(l, -7.f), 7.f); return g * __builtin_amdgcn_rcpf(1.f + __expf(-1.702f * g)) * (l + 1.f); }
struct EpiSwiglu {
    static constexpr bool PERM = true;
    bf16_t* H; const float* b1; const LAS int* ui;
    DEV void operator()(const pg8::f32x4 (&acc)[2][2][4][2], const pg8::Unit& u, int wr, int wc, int fr, int fq) const {
        const int ucnt = ui[u.t * 4 + 0], hrow0 = ui[u.t * 4 + 1], col0 = u.pn * 256 + wc * 32 + 8 * fq;
        const float* bb = b1 + (size_t)u.e * 2048 + col0;
        pg8::f32x4 bv[2][2];
#pragma unroll
        for (int bj = 0; bj < 2; ++bj)
#pragma unroll
            for (int n = 0; n < 2; ++n) bv[bj][n] = *(const pg8::f32x4*)(bb + bj * 128 + 4 * n);
#pragma unroll
        for (int ai = 0; ai < 2; ++ai)
#pragma unroll
            for (int m = 0; m < 4; ++m) { const int rr = ai * 128 + wr * 64 + m * 16 + fr;
                if (rr < ucnt) { bf16_t* rowp = H + (size_t)(hrow0 + rr) * DFF + (col0 >> 1);
#pragma unroll
                    for (int bj = 0; bj < 2; ++bj) { const pg8::f32x4 v0 = acc[ai][bj][m][0] + bv[bj][0], v1 = acc[ai][bj][m][1] + bv[bj][1];
                        pg8::u32x2 w; w.x = cvt_pk_bf16(swiglu(v0[0], v0[1]), swiglu(v0[2], v0[3])); w.y = cvt_pk_bf16(swiglu(v1[0], v1[1]), swiglu(v1[2], v1[3]));
                        *(pg8::u32x2*)(rowp + bj * 64) = w; } } }
    }
};
struct EpiY {
    static constexpr bool PERM = true;
    bf16_t* Y; const LAS int* idx;
    DEV void operator()(const pg8::f32x4 (&acc)[2][2][4][2], const pg8::Unit& u, int wr, int wc, int fr, int fq) const {
        const int col0 = u.pn * 256 + wc * 32 + 8 * fq;
#pragma unroll
        for (int ai = 0; ai < 2; ++ai)
#pragma unroll
            for (int m = 0; m < 4; ++m) { const int rr = ai * 128 + wr * 64 + m * 16 + fr; const int pair = idx[u.t * 256 + rr];
                if (pair >= 0) { bf16_t* rowp = Y + (size_t)pair * D + col0;
#pragma unroll
                    for (int bj = 0; bj < 2; ++bj) { const pg8::f32x4 v0 = acc[ai][bj][m][0], v1 = acc[ai][bj][m][1];
                        pg8::u32x4 w; w.x = cvt_pk_bf16(v0[0], v0[1]); w.y = cvt_pk_bf16(v0[2], v0[3]); w.z = cvt_pk_bf16(v1[0], v1[1]); w.w = cvt_pk_bf16(v1[2], v1[3]);
                        *(pg8::u32x4*)(rowp + bj * 128) = w; } } }
    }
};
DEV void ph_moe1(const Params& p, int layer, char* smem) {
    moe_prepare(p, smem, 8, 1);
    LAS int* base = (LAS int*)(smem + MOE_LDS);
    MoeOrder S{base, base + 704, base + 768, base[640], 8, (int)gridDim.x, (int)blockIdx.x, 1, (const char*)(p.ws + OFF_W1T) + (size_t)layer * NE * 2048 * D * 2, (size_t)2048 * D * 2, D};
    EpiSwiglu E{(bf16_t*)(p.ws + OFF_H), p.b1 + (size_t)layer * NE * 2048, base + 704};
    pg8::gemm_phase((LAS unsigned char*)smem, (const char*)(p.ws + OFF_XNB), D, S, E, tid_of(p.wave_id));
}
DEV void ph_moe2(const Params& p, int layer, char* smem) {
    moe_prepare(p, smem, 4, 2);
    LAS int* base = (LAS int*)(smem + MOE_LDS);
    MoeOrder S{base, base + 704, base + 768, base[640], 4, (int)gridDim.x, (int)blockIdx.x, 0, (const char*)(p.ws + OFF_W2T) + (size_t)layer * NE * D * DFF * 2, (size_t)D * DFF * 2, DFF};
    EpiY E{(bf16_t*)(p.ws + OFF_Y), base + 768};
    pg8::gemm_phase((LAS unsigned char*)smem, (const char*)(p.ws + OFF_H), DFF, S, E, tid_of(p.wave_id));
}
DEV void ph_combine(const Params& p, int layer, char* smem) {
    const int wid = p.wave_id, lane = lane_asm();
    const float* nr = p.norms + (size_t)layer * 4 * D;
    const int total = layer == 0 ? NT : NB * SEQ, stride = (int)gridDim.x * 8;
    for (int q0 = (int)blockIdx.x * 8 + wid; q0 < total; q0 += 2 * stride) {
        int rr[2]; bool ok[2]; float4 tw[2]; int4 ti[2];
#pragma unroll
        for (int u = 0; u < 2; ++u) { const int q = q0 + u * stride; ok[u] = q < total; const int qq = ok[u] ? q : q0;
            rr[u] = layer == 0 ? qq : (qq / SEQ) * SL + CTX + qq % SEQ;
            tw[u] = *(const float4*)(((float*)(p.ws + OFF_TOPW)) + (size_t)rr[u] * 4); ti[u] = *(const int4*)(((int*)(p.ws + OFF_TOPI)) + (size_t)rr[u] * 4); }
        float4 f[2][4], xv[2][4];
#pragma unroll
        for (int u = 0; u < 2; ++u) {
            const int r = rr[u];
            const float w[4] = {tw[u].x, tw[u].y, tw[u].z, tw[u].w}; const int ei[4] = {ti[u].x, ti[u].y, ti[u].z, ti[u].w};
#pragma unroll
            for (int i = 0; i < 4; ++i) f[u][i] = make_float4(0.f, 0.f, 0.f, 0.f);
#pragma unroll
            for (int k = 0; k < 4; ++k) {
                const bf16_t* y = (const bf16_t*)(p.ws + OFF_Y) + ((size_t)r * 4 + k) * D; const float* bb = p.b2 + ((size_t)layer * NE + ei[k]) * D;
#pragma unroll
                for (int i = 0; i < 4; ++i) { const int idx = i * 256 + lane * 4; const pg8::u32x2 yb = *(const pg8::u32x2*)(y + idx); const float4 bv = *(const float4*)(bb + idx);
                    const float y0 = __uint_as_float(yb.x << 16), y1 = __uint_as_float(yb.x & 0xffff0000u), y2 = __uint_as_float(yb.y << 16), y3 = __uint_as_float(yb.y & 0xffff0000u);
                    f[u][i].x += w[k] * (y0 + bv.x); f[u][i].y += w[k] * (y1 + bv.y); f[u][i].z += w[k] * (y2 + bv.z); f[u][i].w += w[k] * (y3 + bv.w); }
            }
            row_load(((float*)(p.ws + OFF_XN)) + (size_t)r * D, xv[u], lane);
        }
#pragma unroll
        for (int u = 0; u < 2; ++u) {
            const int r = rr[u], b = r / SL, s = r % SL;
            const float* m = modrow(p, layer, b, s);
            const float ri = row_rinv(f[u]);
#pragma unroll
            for (int i = 0; i < 4; ++i) { const int idx = i * 256 + lane * 4; const float4 g = *(const float4*)(nr + 3 * D + idx), gt = *(const float4*)(m + 5120 + idx);
                xv[u][i].x += gt.x * (f[u][i].x * ri * g.x); xv[u][i].y += gt.y * (f[u][i].y * ri * g.y); xv[u][i].z += gt.z * (f[u][i].z * ri * g.z); xv[u][i].w += gt.w * (f[u][i].w * ri * g.w); }
            if (ok[u]) {
                if (layer == 0) {
                    row_store(((float*)(p.ws + OFF_X)) + (size_t)r * D, xv[u], lane);
                    const float* m1 = modrow(p, 1, b, s); float4 o[4];
                    row_modnorm(xv[u], p.norms + (size_t)4 * D, m1 + 0, m1 + 1024, o, lane);
                    row_store_bf16((bf16_t*)(p.ws + OFF_XNB) + (size_t)r * D, o, lane);
                } else {
                    row_store(p.out + ((size_t)b * SEQ + (s - CTX)) * D, xv[u], lane);
                }
            }
        }
    }
}

template <int layer> DEV void run_layer(const Params& p, char* smem, const XcdBarrier& bar) {
#define GB() xcd_barrier(bar)

        ph_inproj(p, layer, smem); GB();
        ph_scan_local(p, layer, smem); GB();
        ph_scan_carry(p, smem); ph_attn(p, layer, smem); GB();
        ph_scan_out(p, layer, smem); GB();
        ph_outproj(p, layer, smem); GB();
        ph_norm2(p, layer, smem); GB();
        ph_route(p, layer, smem); GB();
        ph_moe1(p, layer, smem); GB();
        ph_moe2(p, layer, smem); GB();
        ph_combine(p, layer, smem); GB();
    #undef GB
}
constexpr int LDS_BYTES = 147456;
__global__ __launch_bounds__(512, 2) void k_mega(Params p_in) {
    Params p = p_in; p.wave_id = __builtin_amdgcn_readfirstlane((int)(threadIdx.x >> 6));
    extern __shared__ __attribute__((aligned(16))) char smem[];
    volatile LAS unsigned* st = (volatile LAS unsigned*)(smem + LDS_BYTES - 16);
    if (threadIdx.x == 0) { st[0] = 0u; st[1] = 0u; st[2] = 0u; st[3] = 0u; }
    __syncthreads();
    const XcdBarrier bar = xcd_barrier_post(((unsigned*)(p.ws + OFF_bar)), st, p.wave_id);
#define GB() xcd_barrier(bar)
    ph_mods(p, smem); ph_convert(p, smem); GB();
    ph_init(p, smem); GB();
    run_layer<0>(p, smem, bar);
    run_layer<1>(p, smem, bar);
#undef GB
}
}

extern "C" void kernel_launch(void* const* d_in, const int* in_sizes, int n_in, void* d_out, int out_size, void* d_ws, size_t ws_size, hipStream_t stream) {
    static int grid = 0;
    if (grid == 0) {
        int dev = 0, cus = 0, per_cu = 0;
        if (hipGetDevice(&dev) != hipSuccess || hipDeviceGetAttribute(&cus, hipDeviceAttributeMultiprocessorCount, dev) != hipSuccess) { grid = -1; return; }
        if (hipFuncSetAttribute((const void*)k_mega, hipFuncAttributeMaxDynamicSharedMemorySize, LDS_BYTES) != hipSuccess) { grid = -1; return; }
        (void)hipOccupancyMaxActiveBlocksPerMultiprocessor(&per_cu, (const void*)k_mega, 512, LDS_BYTES);
        (void)hipGetLastError();
        grid = cus;
    }
    if (grid < 0) return;
    Params p{};
    const float** in = (const float**)&p;
    for (int i = 0; i < 21; ++i) in[i] = (const float*)d_in[i];
    p.out = (float*)d_out;
    p.ws = (char*)d_ws;
    if (WS_END > ws_size) return;
    if (hipMemsetAsync(p.ws + OFF_bar, 0, (size_t)XCD_BAR_WORDS * 4, stream) != hipSuccess) return;
    hipLaunchKernelGGL(k_mega, dim3(grid), dim3(512), LDS_BYTES, stream, p);
}
```

```cpp
#include <hip/hip_runtime.h>
#include <stdint.h>

namespace {
constexpr int D = 1024, NB = 8, SEQ = 2048, CTX = 256, SL = 2304, NT = NB * SL;
constexpr int DP = 3840, DPW = 3600, NE = 32, DFF = 1024, NPAIR = NT * 4;
constexpr int O_AQ = 0, O_AI = 256, O_AFF = 512, O_AFB = 768, O_AG = 1024, O_BQ = 1280, O_BK = 1408, O_BV = 1536, O_BO = 1792, O_BG = 3584;
constexpr int LISTCAP = NT;

struct Params {
    const float *x, *c, *ctx, *c_ctx, *ada_w, *ada_b, *norms, *w_in, *w_out, *hlb, *hnorm, *mgb, *mnorm, *dlam, *dnorm, *rw, *rb, *w1, *b1, *w2, *b2;
    float* out;
    char* ws;
    int wave_id, pad_;
};
constexpr size_t al256(size_t x) { return (x + 255) & ~(size_t)255; }
constexpr size_t OFF_bar = 0;
constexpr size_t OFF_MOD = OFF_bar + al256(3456 * 4);
constexpr size_t OFF_LB = OFF_MOD + al256((size_t)2 * 9 * 6144 * 4);
constexpr size_t OFF_LAM = OFF_LB + al256(1024 * 4);
constexpr size_t OFF_CNT = OFF_LAM + 256;
constexpr size_t OFF_BC = OFF_CNT + 256;
constexpr size_t OFF_TOPW = OFF_BC + al256((size_t)1024 * NE * 4);
constexpr size_t OFF_TOPI = OFF_TOPW + al256((size_t)NPAIR * 4);
constexpr size_t OFF_LIST = OFF_TOPI + al256((size_t)NPAIR * 4);
constexpr size_t OFF_X = OFF_LIST + al256((size_t)NE * LISTCAP * 4);
constexpr size_t OFF_XN = OFF_X + al256((size_t)NT * D * 4);
constexpr size_t OFF_P = OFF_XN + al256((size_t)NT * D * 4);
constexpr size_t OFF_QR = OFF_P + al256((size_t)NT * DP * 4);
constexpr size_t OFF_KT = OFF_QR + al256((size_t)64 * SL * 64 * 4);
constexpr size_t OFF_OC = OFF_KT + al256((size_t)64 * SL * 64 * 4);
constexpr size_t OFF_MIX = OFF_OC + al256((size_t)32 * SL * 128 * 4);
constexpr size_t OFF_MIXO = OFF_MIX + al256((size_t)NT * D * 4);
constexpr size_t OFF_XNB = OFF_MIXO + al256((size_t)NT * D * 4);
constexpr size_t OFF_MIXB = OFF_XNB + al256((size_t)NT * D * 2);
constexpr size_t OFF_WIN = OFF_MIXB + al256((size_t)NT * D * 2);
constexpr size_t OFF_WOUT = OFF_WIN + al256((size_t)2 * DP * D * 2);
constexpr size_t OFF_W1T = OFF_WOUT + al256((size_t)2 * D * D * 2);
constexpr size_t OFF_W2T = OFF_W1T + al256((size_t)2 * NE * 2048 * D * 2);
constexpr size_t OFF_U = OFF_W2T + al256((size_t)2 * NE * D * DFF * 2);
constexpr size_t WS_END = OFF_U + al256((size_t)32 * SL * SL * 4);
constexpr size_t OFF_UA = OFF_U, OFF_DECA = OFF_UA + (size_t)64 * 36 * 4096 * 4, OFF_UB = OFF_DECA + (size_t)64 * 36 * 64 * 4, OFF_NB = OFF_UB + (size_t)64 * 36 * 2048 * 4,
                 OFF_MB = OFF_NB + (size_t)64 * 36 * 32 * 4, OFF_SCB = OFF_MB + (size_t)64 * 36 * 4 * 4,
                 OFF_OA2 = OFF_SCB + (size_t)2 * NT * 16 * 4, OFF_HB2 = OFF_OA2 + (size_t)NT * 256 * 4, OFF_SA = OFF_HB2 + (size_t)NT * 256 * 4, OFF_SB = OFF_SA + (size_t)64 * 36 * 4096 * 4,
                 OFF_N0 = OFF_SB + (size_t)64 * 36 * 2048 * 4;
constexpr size_t OFF_PB = OFF_P;
constexpr size_t OFF_ROPE = OFF_P + al256((size_t)NT * DP * 2);
constexpr size_t OFF_QRB = OFF_QR, OFF_Q0B = OFF_QR + (size_t)32 * SL * 128 * 2, OFF_KB = OFF_KT, OFF_VB = OFF_KT + (size_t)32 * SL * 128 * 2;
constexpr size_t OFF_S = OFF_U, OFF_H = OFF_U, OFF_Y = OFF_U + al256((size_t)(NPAIR + 256) * DFF * 2);
constexpr size_t OFF_OA = OFF_MIXO, OFF_HB = OFF_MIXO + (size_t)2 * NT * 256 * 4;


#define DEV __device__ __forceinline__
DEV int lane_asm() { int l; asm volatile("v_mbcnt_lo_u32_b32 %0, -1, 0\n\tv_mbcnt_hi_u32_b32 %0, -1, %0" : "=v"(l)); return l; }
DEV int tid_of(int wave_id) { return (wave_id << 6) | lane_asm(); }
DEV float wsum(float v) { for (int o = 32; o >= 1; o >>= 1) v += __shfl_xor(v, o); return v; }
DEV float wmaxf(float v) { for (int o = 32; o >= 1; o >>= 1) v = fmaxf(v, __shfl_xor(v, o)); return v; }
DEV float sigm(float x) { return 1.f / (1.f + expf(-x)); }
DEV float rdlane(float v, int l) { return __int_as_float(__builtin_amdgcn_readlane(__float_as_int(v), l)); }
DEV float lam_init_of(int layer) { return 0.8f - 0.6f * expf(-0.3f * (float)layer); }


#define XB_TMO      128
#define XB_XCNT(j)  (256  + 64 * (j))
#define XB_XSUB(j)  (1280 + 64 * (j))
#define XB_XGEN(j)  (2304 + 64 * (j))
#define XB_TOP      3328
#define XB_TOPGEN   3392
#define XCD_BAR_WORDS 3456
#define XB_SPIN_CAP (1u << 22)
#define LAS __attribute__((address_space(3)))
DEV unsigned xb_ld(unsigned* p)              { return __hip_atomic_load(p, __ATOMIC_RELAXED, __HIP_MEMORY_SCOPE_AGENT); }
DEV unsigned xb_add(unsigned* p, unsigned v) { return __hip_atomic_fetch_add(p, v, __ATOMIC_RELAXED, __HIP_MEMORY_SCOPE_AGENT); }
DEV unsigned xb_xcc_id() { return (unsigned)__builtin_amdgcn_s_getreg((3 << 11) | 20) & 0xFu; }
#define XB_SPIN(cond, bar) do { unsigned _sp = 0; while (cond) { __builtin_amdgcn_s_sleep(1); \
    if ((++_sp & 255u) == 0u) { if (xb_ld(&(bar)[XB_TMO])) break; if (_sp > XB_SPIN_CAP) { atomicAdd(&(bar)[XB_TMO], 1u); break; } } } } while (0)
struct XcdBarrier { unsigned* bar; unsigned x; volatile LAS unsigned* st; int wave; };
DEV bool xb_thread0(int wave) { return wave == 0 && lane_asm() == 0; }
DEV XcdBarrier xcd_barrier_post(unsigned* bar, volatile LAS unsigned* st, int wave) {
    XcdBarrier b; b.bar = bar; b.x = xb_xcc_id(); b.st = st; b.wave = wave;
    if (xb_thread0(wave)) (void)xb_add(&bar[XB_XCNT(b.x)], 1u);
    return b;
}
DEV void xcd_barrier_complete(unsigned* bar, unsigned x, unsigned& nloc, unsigned& nx) {
    const unsigned G = gridDim.x * gridDim.y * gridDim.z;
    unsigned sum, cnt, mine, sp = 0u;
    for (;;) {
        sum = 0u; cnt = 0u; mine = 0u;
#pragma unroll
        for (unsigned j = 0; j < 16; ++j) { const unsigned c = xb_ld(&bar[XB_XCNT(j)]); sum += c; cnt += (c > 0u) ? 1u : 0u; mine = (j == x) ? c : mine; }
        if (sum == G) break;
        __builtin_amdgcn_s_sleep(1);
        if ((++sp & 255u) == 0u) { if (xb_ld(&bar[XB_TMO])) break; if (sp > XB_SPIN_CAP) { atomicAdd(&bar[XB_TMO], 1u); break; } }
    }
    nloc = mine > 0u ? mine : 1u; nx = cnt > 0u ? cnt : 1u;
}
DEV void xcd_barrier(const XcdBarrier& b) {
    asm volatile("s_waitcnt vmcnt(0)" ::: "memory");
    __syncthreads();
    if (xb_thread0(b.wave)) {
        unsigned* bar = b.bar;
        __builtin_amdgcn_s_waitcnt(0);
        unsigned nloc = b.st[0], nx = b.st[1];
        if (nloc == 0u) { xcd_barrier_complete(bar, b.x, nloc, nx); b.st[0] = nloc; b.st[1] = nx; }
        const unsigned old = xb_add(&bar[XB_XSUB(b.x)], 1u);
        const unsigned gen = old / nloc;
        if (old + 1u == (gen + 1u) * nloc) {
            __builtin_amdgcn_fence(__ATOMIC_RELEASE, "agent");
            asm volatile("s_waitcnt vmcnt(0)" ::: "memory");
            const unsigned og = xb_add(&bar[XB_TOP], 1u);
            const unsigned tg = og / nx;
            if (og + 1u == (tg + 1u) * nx) xb_add(&bar[XB_TOPGEN], 1u);
            else XB_SPIN(xb_ld(&bar[XB_TOPGEN]) == tg, bar);
            __builtin_amdgcn_fence(__ATOMIC_ACQUIRE, "agent");
            xb_add(&bar[XB_XGEN(b.x)], 1u);
            asm volatile("s_waitcnt vmcnt(0)" ::: "memory");
        } else {
            XB_SPIN(xb_ld(&bar[XB_XGEN(b.x)]) == gen, bar);
            __builtin_amdgcn_fence(__ATOMIC_ACQUIRE, "agent");
            asm volatile("s_waitcnt vmcnt(0)" ::: "memory");
        }
    }
    __syncthreads();
}

typedef unsigned short bf16_t;
DEV unsigned cvt_pk_bf16(float lo, float hi) { unsigned r; asm volatile("v_cvt_pk_bf16_f32 %0, %1, %2" : "=v"(r) : "v"(lo), "v"(hi)); return r; }

namespace pg8 {
typedef short bf16x8 __attribute__((ext_vector_type(8)));
typedef float f32x4 __attribute__((ext_vector_type(4)));
typedef unsigned u32x4 __attribute__((ext_vector_type(4)));
typedef unsigned u32x2 __attribute__((ext_vector_type(2)));
constexpr int BM = 256, BK = 64, HALF = 128, HTB = HALF * BK * 2, STAGE_BYTES = 8 * HTB, NXCD = 8, WGM = 8;
DEV int lds_byte(int r, int c) { const int st = (r >> 4) * 2 + (c >> 5), rr = r & 15, cc = c & 31, ob = rr * 64 + cc * 2; return st * 1024 + (ob ^ (((ob >> 9) & 1) << 5)); }
DEV void stage_rc(int b, int& R, int& C) { const int st = b / 1024, sb = b % 1024, swz = sb ^ (((sb >> 9) & 1) << 5); R = (st >> 1) * 16 + swz / 64; C = (st & 1) * 32 + (swz % 64) / 2; }
DEV int perm32(int rho) { const int n = rho >> 4, i = rho & 15; return 8 * (i >> 2) + 4 * n + (i & 3); }
struct Unit { int pm, pn, e, t; };
struct StaticOrder {
    int nM, nN, nwg, G, c, skipctx; const char* Bt; int K;
    DEV void init(int nM_, int nN_, int G_, int c_, int skipctx_, const void* Bt_, int K_) { nM = nM_; nN = nN_; nwg = nM * nN; G = G_; c = c_; skipctx = skipctx_; Bt = (const char*)Bt_; K = K_; }
    DEV bool next(int i, Unit& u) const {
        const long L = (long)i * G + c; if (L >= nwg) return false;
        int wgid = (int)L; { const int q = nwg / NXCD, r = nwg % NXCD, xcd = wgid % NXCD, off = wgid / NXCD; wgid = (xcd < r ? xcd * (q + 1) : r * (q + 1) + (xcd - r) * q) + off; }
        const int nig = WGM * nN, gid = wgid / nig, fm = gid * WGM, gsz = (nM - fm) < WGM ? (nM - fm) : WGM;
        int pm = fm + ((wgid % nig) % gsz); u.pn = (wgid % nig) / gsz;
        if (skipctx) pm = (pm >> 3) * 9 + 1 + (pm & 7);
        u.pm = pm; u.e = 0; u.t = 0; return true;
    }
    DEV int arow(const Unit& u, int rr) const { return u.pm * BM + rr; }
    DEV const char* bbase(const Unit& u) const { return Bt + (size_t)u.pn * BM * K * 2; }
};
struct EpiF32 {
    static constexpr bool PERM = false;
    float* C; int ldc;
    DEV void operator()(const f32x4 (&acc)[2][2][4][2], const Unit& u, int wr, int wc, int fr, int fq) const {
        const int row0 = u.pm * BM + wr * 64 + fr, col0 = u.pn * BM + wc * 32 + 4 * fq;
#pragma unroll
        for (int ai = 0; ai < 2; ++ai)
#pragma unroll
            for (int m = 0; m < 4; ++m) { float* rowp = C + (size_t)(row0 + ai * HALF + m * 16) * ldc + col0;
#pragma unroll
                for (int bj = 0; bj < 2; ++bj)
#pragma unroll
                    for (int n = 0; n < 2; ++n) *(f32x4*)(rowp + bj * HALF + n * 16) = acc[ai][bj][m][n]; }
    }
};

template <class Epi, class Sched>
DEV void gemm_phase(LAS unsigned char* lds, const char* Abase, const int K, const Sched& S, const Epi& E, const int tid) {
    const int wid = __builtin_amdgcn_readfirstlane(tid >> 6), lane = tid & 63, wr = wid >> 2, wc = wid & 3, fr = lane & 15, fq = lane >> 4;
    const int nt = K / BK;
    unsigned voffB[2];
#pragma unroll
    for (int i = 0; i < 2; ++i) { int R, C; stage_rc(tid * 16 + i * 8192, R, C); const int Rb = Epi::PERM ? ((R & ~31) + perm32(R & 31)) : R;
        voffB[i] = (unsigned)(Rb * K + C) * 2u; }
    const size_t kstep = (size_t)(BK * 2);
    const size_t hstep = (size_t)HALF * K * 2;
    const unsigned ldsw = (unsigned)wid * 1024u;
    const int aoff = lds_byte(wr * 64 + fr, fq * 8), boff = lds_byte(wc * 32 + fr, fq * 8);
#define PG8_SA(b, h) (((b) * 2 + (h)) * HTB)
#define PG8_SB(b, h) ((4 + (b) * 2 + (h)) * HTB)
#define PG8_STAGE_B(bufoff, gbase) do { _Pragma("unroll") for (int _i = 0; _i < 2; ++_i) \
        __builtin_amdgcn_global_load_lds((const unsigned*)((const char*)(gbase) + voffB[_i]), (LAS unsigned*)(lds + (bufoff) + ldsw + _i * 8192), 16, 0, 0); } while (0)
#define PG8_STAGE_A(bufoff, kb, V, h) do { _Pragma("unroll") for (int _i = 0; _i < 2; ++_i) \
        __builtin_amdgcn_global_load_lds((const unsigned*)(Abase + (kb) + (V)[h][_i]), (LAS unsigned*)(lds + (bufoff) + ldsw + _i * 8192), 16, 0, 0); } while (0)
#define PG8_VOFFA(V, u) do { _Pragma("unroll") for (int _i = 0; _i < 2; ++_i) { int _R, _C; stage_rc(tid * 16 + _i * 8192, _R, _C); _Pragma("unroll") for (int _h = 0; _h < 2; ++_h) \
        (V)[_h][_i] = ((unsigned)S.arow(u, _h * HALF + _R) * (unsigned)K + (unsigned)_C) * 2u; } } while (0)
#define PG8_LDA(dst, b, h) do { _Pragma("unroll") for (int m = 0; m < 4; ++m) _Pragma("unroll") for (int k = 0; k < 2; ++k) dst[m][k] = *(const LAS bf16x8*)(lds + PG8_SA(b, h) + aoff + m * 2048 + k * 1024); } while (0)
#define PG8_LDB(dst, b, h) do { _Pragma("unroll") for (int n = 0; n < 2; ++n) _Pragma("unroll") for (int k = 0; k < 2; ++k) dst[n][k] = *(const LAS bf16x8*)(lds + PG8_SB(b, h) + boff + n * 2048 + k * 1024); } while (0)
#define PG8_MMA(ai, bj, At, Bt) do { __builtin_amdgcn_s_setprio(1); _Pragma("unroll") for (int m = 0; m < 4; ++m) _Pragma("unroll") for (int n = 0; n < 2; ++n) _Pragma("unroll") for (int k = 0; k < 2; ++k) \
        acc[ai][bj][m][n] = __builtin_amdgcn_mfma_f32_16x16x32_bf16(Bt[n][k], At[m][k], acc[ai][bj][m][n], 0, 0, 0); __builtin_amdgcn_s_setprio(0); } while (0)
#define PG8_WAIT_V(n) asm volatile("s_waitcnt vmcnt(" #n ")" ::: "memory")
#define PG8_WAIT_L(n) asm volatile("s_waitcnt lgkmcnt(" #n ")" ::: "memory")
#define PG8_BAR __builtin_amdgcn_s_barrier()
#define PG8_SCHED __builtin_amdgcn_sched_barrier(0)
    Unit cur, nxt; int ui = 0;
    if (!S.next(0, cur)) return;
    f32x4 acc[2][2][4][2];
#pragma unroll
    for (int a = 0; a < 2; ++a)
#pragma unroll
        for (int b = 0; b < 2; ++b)
#pragma unroll
            for (int m = 0; m < 4; ++m)
#pragma unroll
                for (int n = 0; n < 2; ++n) acc[a][b][m][n] = (f32x4){0.f, 0.f, 0.f, 0.f};
    bf16x8 At[4][2], B0[2][2], B1[2][2];
    unsigned vc[2][2], v2[2][2];
    PG8_VOFFA(vc, cur);
    const char* cB = S.bbase(cur);
    PG8_STAGE_B(PG8_SB(0, 0), cB); PG8_STAGE_A(PG8_SA(0, 0), 0, vc, 0); PG8_STAGE_B(PG8_SB(0, 1), cB + hstep); PG8_STAGE_A(PG8_SA(0, 1), 0, vc, 1);
    if (wr == 1) PG8_BAR;
    PG8_WAIT_V(4); PG8_BAR;
    PG8_STAGE_B(PG8_SB(1, 0), cB + kstep); PG8_STAGE_A(PG8_SA(1, 0), kstep, vc, 0); PG8_STAGE_B(PG8_SB(1, 1), cB + hstep + kstep);
    PG8_WAIT_V(6); PG8_BAR;
    for (;;) {
        const bool has_next = S.next(ui + 1, nxt);
        const char* nB = has_next ? S.bbase(nxt) : cB;
        for (int t = 0; t < nt; t += 2) {
            const bool last = (t == nt - 2);
            const size_t k1 = (size_t)(t + 1) * kstep, k2 = last ? (size_t)0 : (size_t)(t + 2) * kstep, k3 = k2 + kstep;
            if (last && has_next) { PG8_VOFFA(v2, nxt); } else {
#pragma unroll
                for (int h = 0; h < 2; ++h)
#pragma unroll
                    for (int i = 0; i < 2; ++i) v2[h][i] = vc[h][i]; }
            const char* b2 = last ? nB : cB + (size_t)(t + 2) * kstep; const char* b3 = b2 + kstep;
            PG8_LDB(B0, 0, 0); PG8_SCHED; PG8_LDA(At, 0, 0); PG8_STAGE_A(PG8_SA(1, 1), k1, vc, 1);
            PG8_WAIT_L(8); PG8_BAR; PG8_WAIT_L(0); PG8_MMA(0, 0, At, B0); PG8_BAR; PG8_SCHED;
            PG8_LDB(B1, 0, 1); PG8_STAGE_B(PG8_SB(0, 0), b2);
            PG8_BAR; PG8_WAIT_L(0); PG8_MMA(0, 1, At, B1); PG8_BAR;
            PG8_LDA(At, 0, 1); PG8_STAGE_A(PG8_SA(0, 0), k2, v2, 0);
            PG8_BAR; PG8_WAIT_L(0); PG8_MMA(1, 0, At, B0); PG8_BAR; PG8_SCHED;
            PG8_STAGE_B(PG8_SB(0, 1), b2 + hstep);
            PG8_WAIT_V(6); PG8_BAR; PG8_MMA(1, 1, At, B1); PG8_BAR;
            PG8_LDB(B0, 1, 0); PG8_SCHED; PG8_LDA(At, 1, 0); PG8_STAGE_A(PG8_SA(0, 1), k2, v2, 1);
            PG8_WAIT_L(8); PG8_BAR; PG8_WAIT_L(0); PG8_MMA(0, 0, At, B0); PG8_BAR; PG8_SCHED;
            PG8_LDB(B1, 1, 1); PG8_STAGE_B(PG8_SB(1, 0), b3);
            PG8_BAR; PG8_WAIT_L(0); PG8_MMA(0, 1, At, B1); PG8_BAR;
            PG8_LDA(At, 1, 1); PG8_STAGE_A(PG8_SA(1, 0), k3, v2, 0);
            PG8_BAR; PG8_WAIT_L(0); PG8_MMA(1, 0, At, B0); PG8_BAR; PG8_SCHED;
            PG8_STAGE_B(PG8_SB(1, 1), b3 + hstep);
            PG8_WAIT_V(6); PG8_BAR; PG8_MMA(1, 1, At, B1); PG8_BAR;
        }
        E(acc, cur, wr, wc, fr, fq);
        if (!has_next) break;
#pragma unroll
        for (int a = 0; a < 2; ++a)
#pragma unroll
            for (int b = 0; b < 2; ++b)
#pragma unroll
                for (int m = 0; m < 4; ++m)
#pragma unroll
                    for (int n = 0; n < 2; ++n) acc[a][b][m][n] = (f32x4){0.f, 0.f, 0.f, 0.f};
        cur = nxt; cB = nB; ++ui;
#pragma unroll
        for (int h = 0; h < 2; ++h)
#pragma unroll
            for (int i = 0; i < 2; ++i) vc[h][i] = v2[h][i];
    }
    PG8_WAIT_V(0);
    if (wr == 0) PG8_BAR;
    PG8_BAR;
#undef PG8_SA
#undef PG8_SB
#undef PG8_STAGE_A
#undef PG8_STAGE_B
#undef PG8_VOFFA
#undef PG8_LDA
#undef PG8_LDB
#undef PG8_MMA
#undef PG8_WAIT_V
#undef PG8_WAIT_L
#undef PG8_BAR
#undef PG8_SCHED
}
}


namespace att {
using bf16x8 = __attribute__((ext_vector_type(8))) short;
using s16x4  = __attribute__((ext_vector_type(4))) short;
using f32x16 = __attribute__((ext_vector_type(16))) float;
using u32x4  = __attribute__((ext_vector_type(4))) unsigned;
constexpr int KVBLK = 64, LDK = 128;
constexpr int SHM_V = KVBLK * 128 * 2, SHM_K = KVBLK * 128 * 2, SHM_ATTN = 2 * SHM_V + 2 * SHM_K + 8 * 64 * 4;
constexpr float THR = 8.f;
#define KSWZ(row, colB) ((row) * 256 + ((colB) ^ (((row) & 7) << 4)))
#define SBAR() __builtin_amdgcn_sched_barrier(0)
DEV int crow(int r, int hi) { return (r & 3) + 8 * (r >> 2) + 4 * hi; }
DEV void partialSM(f32x16& p0, f32x16& p1, float& m_reg, float& mn, float& alpha) {
  float pmax = p0[0]; for (int r = 1; r < 16; ++r) pmax = fmaxf(pmax, p0[r]); for (int r = 0; r < 16; ++r) pmax = fmaxf(pmax, p1[r]);
  { auto rr = __builtin_amdgcn_permlane32_swap(__float_as_uint(pmax), __float_as_uint(pmax), false, false);
    pmax = fmaxf(__uint_as_float(rr[0]), __uint_as_float(rr[1])); }
  if (__builtin_expect(__all(pmax - m_reg <= THR), 1)) { mn = m_reg; alpha = 1.f; }
  else { mn = fmaxf(m_reg, pmax); alpha = __builtin_amdgcn_exp2f(m_reg - mn); m_reg = mn; }
  for (int r = 0; r < 16; ++r) p0[r] = p0[r] - mn; for (int r = 0; r < 16; ++r) p1[r] = p1[r] - mn;
  for (int r = 0; r < 16; ++r) p0[r] = __builtin_amdgcn_exp2f(p0[r]);
}
DEV void finishSM(f32x16& p0, f32x16& p1, float alpha, float& l_reg, bf16x8& pa0, bf16x8& pa1, bf16x8& pa2, bf16x8& pa3) {
  for (int r = 0; r < 16; ++r) p1[r] = __builtin_amdgcn_exp2f(p1[r]);
  float ps = 0; for (int r = 0; r < 16; ++r) ps += p0[r]; for (int r = 0; r < 16; ++r) ps += p1[r];
  { auto rr = __builtin_amdgcn_permlane32_swap(__float_as_uint(ps), __float_as_uint(ps), false, false);
    ps = __uint_as_float(rr[0]) + __uint_as_float(rr[1]); }
  l_reg = l_reg * alpha + ps;
#define PK4(P, BASE, OUT) do { unsigned a0 = cvt_pk_bf16(P[BASE + 0], P[BASE + 1]), a1 = cvt_pk_bf16(P[BASE + 2], P[BASE + 3]);   \
    unsigned b0 = cvt_pk_bf16(P[BASE + 4], P[BASE + 5]), b1 = cvt_pk_bf16(P[BASE + 6], P[BASE + 7]);                              \
    auto r0 = __builtin_amdgcn_permlane32_swap(a0, b0, false, false); auto r1 = __builtin_amdgcn_permlane32_swap(a1, b1, false, false); \
    u32x4 w = {r0[0], r1[0], r0[1], r1[1]}; OUT = *reinterpret_cast<bf16x8*>(&w); } while (0)
  PK4(p0, 0, pa0); PK4(p0, 8, pa1); PK4(p1, 0, pa2); PK4(p1, 8, pa3);
#undef PK4
}
DEV void qkt(f32x16& p0, f32x16& p1, const char* Ks, const bf16x8 (&qr)[4], int r32, int hi, int js) {
  p0 = f32x16{}; p1 = f32x16{};
#pragma unroll
  for (int d0 = 0; d0 < 4; ++d0) { const int cb = ((js * 4 + d0) * 16 + hi * 8) * 2;
    bf16x8 b0 = *reinterpret_cast<const bf16x8*>(Ks + KSWZ(r32, cb));
    bf16x8 b1 = *reinterpret_cast<const bf16x8*>(Ks + KSWZ(32 + r32, cb));
    p0 = __builtin_amdgcn_mfma_f32_32x32x16_bf16(b0, qr[d0], p0, 0, 0, 0);
    p1 = __builtin_amdgcn_mfma_f32_32x32x16_bf16(b1, qr[d0], p1, 0, 0, 0); }
}
DEV int v_st(int k, int c) { const int kk = (k & ~0xC) | ((k & 4) << 1) | ((k & 8) >> 1); return ((kk >> 3) * 4 + (c >> 5)) * 512 + ((kk & 7) * 32 + (c & 31)) * 2; }
DEV int v_rd_base(int lane) { return ((lane & 3) << 3) | (((lane >> 2) & 3) << 6) | (((lane >> 4) & 1) << 5) | (((lane >> 5) & 1) << 8); }
constexpr int v_rd_off(int d0, int ks, int half) { return d0 * 512 + ks * 4096 + half * 2048; }
template <int OFF> DEV s16x4 tr_read(int vb) {
  s16x4 r; asm volatile("ds_read_b64_tr_b16 %0, %1 offset:%2" : "=&v"(r) : "v"(vb), "i"(OFF) : "memory"); return r;
}
template <int D0> DEV void pv_one(f32x16& od, int vb, bf16x8 pa0, bf16x8 pa1, bf16x8 pa2, bf16x8 pa3) {
  const s16x4 l0 = tr_read<v_rd_off(D0, 0, 0)>(vb), h0 = tr_read<v_rd_off(D0, 0, 1)>(vb), l1 = tr_read<v_rd_off(D0, 1, 0)>(vb), h1 = tr_read<v_rd_off(D0, 1, 1)>(vb);
  const s16x4 l2 = tr_read<v_rd_off(D0, 2, 0)>(vb), h2 = tr_read<v_rd_off(D0, 2, 1)>(vb), l3 = tr_read<v_rd_off(D0, 3, 0)>(vb), h3 = tr_read<v_rd_off(D0, 3, 1)>(vb);
  asm volatile("s_waitcnt lgkmcnt(0)" ::: "memory"); SBAR();
#define PK(L, H) (bf16x8){L[0], L[1], L[2], L[3], H[0], H[1], H[2], H[3]}
  od = __builtin_amdgcn_mfma_f32_32x32x16_bf16(pa0, PK(l0, h0), od, 0, 0, 0);
  od = __builtin_amdgcn_mfma_f32_32x32x16_bf16(pa1, PK(l1, h1), od, 0, 0, 0);
  od = __builtin_amdgcn_mfma_f32_32x32x16_bf16(pa2, PK(l2, h2), od, 0, 0, 0);
  od = __builtin_amdgcn_mfma_f32_32x32x16_bf16(pa3, PK(l3, h3), od, 0, 0, 0);
#undef PK
}
DEV void pv_d0(f32x16* o, int vb, bf16x8 pa0, bf16x8 pa1, bf16x8 pa2, bf16x8 pa3) {
  pv_one<0>(o[0], vb, pa0, pa1, pa2, pa3); pv_one<1>(o[1], vb, pa0, pa1, pa2, pa3); pv_one<2>(o[2], vb, pa0, pa1, pa2, pa3); pv_one<3>(o[3], vb, pa0, pa1, pa2, pa3);
}
DEV void attn_tiles(const bf16x8 (&qr)[4], const bf16_t* __restrict__ Kh, const bf16_t* __restrict__ Vh, int seq, char* lds,
                    float& m_reg, float& l_reg, f32x16 (&o)[4], int tid, int js) {
  const int wid = tid >> 6, lane = tid & 63, r32 = lane & 31, hi = lane >> 5;
  char* V_lds = lds; char* K_lds = lds + 2 * SHM_V;
  float* ws = (float*)(lds + 2 * SHM_V + 2 * SHM_K) + wid * 64; float* al_l = ws + 32;
  const int sr = tid >> 4, sc = (tid & 15) * 8, vst0 = v_st(sr, sc), vst1 = v_st(32 + sr, sc);
  const int vb0 = (int)(uintptr_t)V_lds + v_rd_base(lane);
  struct { bf16x8 vs0, vs1, ks0, ks1; } sr_[2];
  const unsigned lo0 = (unsigned)((sr * LDK + sc) * 2), lo1 = lo0 + 32u * LDK * 2u;
#define SLOAD(i, k0) do { const char* vb_ = (const char*)Vh + (size_t)(k0) * (LDK * 2); const char* kb_ = (const char*)Kh + (size_t)(k0) * (LDK * 2); \
    sr_[i].vs0 = *(const bf16x8*)(vb_ + lo0); sr_[i].vs1 = *(const bf16x8*)(vb_ + lo1); sr_[i].ks0 = *(const bf16x8*)(kb_ + lo0); sr_[i].ks1 = *(const bf16x8*)(kb_ + lo1); } while (0)
#define SWRITE(b, i) do { *(bf16x8*)(V_lds + (b) * SHM_V + vst0) = sr_[i].vs0;          \
    *(bf16x8*)(V_lds + (b) * SHM_V + vst1) = sr_[i].vs1; int kc = sc * 2;               \
    *(bf16x8*)(K_lds + (b) * SHM_K + KSWZ(sr, kc)) = sr_[i].ks0;                       \
    *(bf16x8*)(K_lds + (b) * SHM_K + KSWZ(32 + sr, kc)) = sr_[i].ks1; } while (0)
#define SWAIT() asm volatile("s_waitcnt vmcnt(4)" ::: "memory")
#define RESC(a) do { if (__any((a) < 1.f)) { if (hi == 0) al_l[r32] = (a); asm volatile("s_waitcnt lgkmcnt(0)" ::: "memory"); \
    for (int d = 0; d < 4; ++d) for (int r = 0; r < 16; ++r) o[d][r] *= al_l[crow(r, hi)]; } } while (0)
  f32x16 pA0, pA1, pB0, pB1; float mnA, mnB, alA, alB; bf16x8 pa0, pa1, pa2, pa3; const int NTL = seq / KVBLK;
  constexpr int SE = 0, SO = 1;
  __syncthreads();
  SLOAD(SE, 0); asm volatile("s_waitcnt vmcnt(0)" ::: "memory"); SWRITE(0, SE); __syncthreads();
  qkt(pA0, pA1, K_lds, qr, r32, hi, js); partialSM(pA0, pA1, m_reg, mnA, alA);
  SLOAD(SO, KVBLK); if (2 < NTL) SLOAD(SE, 2 * KVBLK);
  SWAIT(); SWRITE(1, SO); __syncthreads();
  RESC(alA);
  for (int j = 1; j + 1 < NTL; j += 2) {
    SBAR(); qkt(pB0, pB1, K_lds + SHM_K, qr, r32, hi, js);
    finishSM(pA0, pA1, alA, l_reg, pa0, pa1, pa2, pa3); SBAR();
    SLOAD(SO, (j + 2) * KVBLK); SBAR();
    pv_d0(o, vb0, pa0, pa1, pa2, pa3); partialSM(pB0, pB1, m_reg, mnB, alB);
    __syncthreads(); SWAIT(); SWRITE(0, SE);
    RESC(alB); __syncthreads();
    SBAR(); qkt(pA0, pA1, K_lds, qr, r32, hi, js);
    finishSM(pB0, pB1, alB, l_reg, pa0, pa1, pa2, pa3); SBAR();
    if (j + 3 < NTL) SLOAD(SE, (j + 3) * KVBLK); SBAR();
    pv_d0(o, vb0 + SHM_V, pa0, pa1, pa2, pa3); partialSM(pA0, pA1, m_reg, mnA, alA);
    __syncthreads(); SWAIT(); SWRITE(1, SO);
    RESC(alA); __syncthreads();
  }
  SBAR(); qkt(pB0, pB1, K_lds + SHM_K, qr, r32, hi, js);
  finishSM(pA0, pA1, alA, l_reg, pa0, pa1, pa2, pa3); SBAR();
  pv_d0(o, vb0, pa0, pa1, pa2, pa3); partialSM(pB0, pB1, m_reg, mnB, alB);
  __syncthreads(); RESC(alB);
  finishSM(pB0, pB1, alB, l_reg, pa0, pa1, pa2, pa3); SBAR();
  pv_d0(o, vb0 + SHM_V, pa0, pa1, pa2, pa3);
#undef SLOAD
#undef SWRITE
#undef SWAIT
#undef RESC
}
}

DEV void cvt_tile(const float* src, int ld, int nvalid, bf16_t* dst, int K, int n0, int k0, float* T, const int t, int ns0 = -1) {
    if (ns0 < 0) ns0 = n0;
#pragma unroll
    for (int h = 0; h < 2; ++h) {
        const int kk = (t >> 4) + 32 * h, nq = (t & 15) * 4, n = ns0 + nq;
        const float4 v = n < nvalid ? *(const float4*)(src + (size_t)(k0 + kk) * ld + n) : make_float4(0.f, 0.f, 0.f, 0.f);
        T[(nq + 0) * 65 + kk] = v.x; T[(nq + 1) * 65 + kk] = v.y; T[(nq + 2) * 65 + kk] = v.z; T[(nq + 3) * 65 + kk] = v.w;
    }
    __syncthreads();
    { const int n = t >> 3, kq = (t & 7) * 8; const float* r = T + n * 65 + kq;
      pg8::u32x4 w; w.x = cvt_pk_bf16(r[0], r[1]); w.y = cvt_pk_bf16(r[2], r[3]); w.z = cvt_pk_bf16(r[4], r[5]); w.w = cvt_pk_bf16(r[6], r[7]);
      *(pg8::u32x4*)(dst + (size_t)(n0 + n) * K + k0 + kq) = w; }
    __syncthreads();
}
DEV void ph_convert(const Params& p, char* smem) {
    const int tidx = tid_of(p.wave_id);
    float* T = (float*)smem;
    constexpr int T_IN = 2 * 60 * 16, T_OUT = 2 * 16 * 16, T_W1 = 64 * 32 * 16, T_W2 = 64 * 16 * 16;
    for (int u = blockIdx.x; u < T_IN + T_OUT + T_W1 + T_W2; u += gridDim.x) {
        if (u < T_IN) { const int l = u / 960, r = u % 960, nt = r >> 4, kt = r & 15;
            const int n0 = nt * 64; int ns0, nv;
            if (n0 < 2048) { ns0 = n0; nv = DPW; } else if (n0 < 3584) { ns0 = n0 + 16; nv = DPW; } else if (n0 == 3584) { ns0 = 2048; nv = 2064; } else { ns0 = 0; nv = 0; }
            cvt_tile(p.w_in + (size_t)l * D * DPW, DPW, nv, (bf16_t*)(p.ws + OFF_WIN) + (size_t)l * DP * D, D, n0, kt * 64, T, tidx, ns0); }
        else if (u < T_IN + T_OUT) { const int v = u - T_IN, l = v >> 8, r = v & 255, nt = r >> 4, kt = r & 15;
            cvt_tile(p.w_out + (size_t)l * D * D, D, D, (bf16_t*)(p.ws + OFF_WOUT) + (size_t)l * D * D, D, nt * 64, kt * 64, T, tidx); }
        else if (u < T_IN + T_OUT + T_W1) { const int v = u - T_IN - T_OUT, le = v >> 9, r = v & 511, nt = r >> 4, kt = r & 15;
            cvt_tile(p.w1 + (size_t)le * D * 2048, 2048, 2048, (bf16_t*)(p.ws + OFF_W1T) + (size_t)le * 2048 * D, D, nt * 64, kt * 64, T, tidx); }
        else { const int v = u - T_IN - T_OUT - T_W1, le = v >> 8, r = v & 255, nt = r >> 4, kt = r & 15;
            cvt_tile(p.w2 + (size_t)le * DFF * D, D, D, (bf16_t*)(p.ws + OFF_W2T) + (size_t)le * D * DFF, DFF, nt * 64, kt * 64, T, tidx); }
    }
}

DEV void row_load(const float* src, float4 (&v)[4], int lane) {
#pragma unroll
    for (int i = 0; i < 4; ++i) v[i] = *(const float4*)(src + i * 256 + lane * 4);
}
DEV void row_store(float* dst, const float4 (&v)[4], int lane) {
#pragma unroll
    for (int i = 0; i < 4; ++i) *(float4*)(dst + i * 256 + lane * 4) = v[i];
}
DEV void row_store_bf16(bf16_t* dst, const float4 (&v)[4], int lane) {
#pragma unroll
    for (int i = 0; i < 4; ++i) { pg8::u32x2 w; w.x = cvt_pk_bf16(v[i].x, v[i].y); w.y = cvt_pk_bf16(v[i].z, v[i].w); *(pg8::u32x2*)(dst + i * 256 + lane * 4) = w; }
}
DEV float row_rinv(const float4 (&v)[4]) {
    float ss = 0.f;
#pragma unroll
    for (int i = 0; i < 4; ++i) ss += v[i].x * v[i].x + v[i].y * v[i].y + v[i].z * v[i].z + v[i].w * v[i].w;
    ss = wsum(ss);
    return rsqrtf(ss * (1.f / 1024.f) + 1e-6f);
}
DEV void row_modnorm(const float4 (&v)[4], const float* gain, const float* shift, const float* scale, float4 (&o)[4], int lane) {
    const float r = row_rinv(v);
#pragma unroll
    for (int i = 0; i < 4; ++i) {
        const int idx = i * 256 + lane * 4;
        const float4 g = *(const float4*)(gain + idx), sh = *(const float4*)(shift + idx), sc = *(const float4*)(scale + idx);
        o[i].x = v[i].x * r * g.x * (1.f + sc.x) + sh.x; o[i].y = v[i].y * r * g.y * (1.f + sc.y) + sh.y;
        o[i].z = v[i].z * r * g.z * (1.f + sc.z) + sh.z; o[i].w = v[i].w * r * g.w * (1.f + sc.w) + sh.w;
    }
}
DEV const float* modrow(const Params& p, int layer, int b, int s) { return ((float*)(p.ws + OFF_MOD)) + ((size_t)layer * 9 + (s < CTX ? 8 : b)) * 6144; }

DEV void ph_mods(const Params& p, char* smem) {
    const int tidx = tid_of(p.wave_id);
    float (*cond)[1024] = (float (*)[1024])smem;
    float (*red)[9][64] = (float (*)[9][64])(smem + 9 * 1024 * 4);
    const int tid = tidx;
    for (int i = tid; i < 9 * 1024; i += 512) { const int r = i >> 10, k = i & 1023; const float c = r < 8 ? p.c[r * 1024 + k] : p.c_ctx[k]; cond[r][k] = c * sigm(c); }
    __syncthreads();
    for (int u = blockIdx.x; u < 192; u += gridDim.x) {
        const int layer = u / 96, cg = u % 96, jj = tid & 63, ks = tid >> 6, j = cg * 64 + jj;
        float acc[9];
#pragma unroll
        for (int r = 0; r < 9; ++r) acc[r] = 0.f;
        const float* w = p.ada_w + (size_t)layer * 1024 * 6144 + j;
        for (int k = ks * 128; k < ks * 128 + 128; ++k) { const float wv = w[(size_t)k * 6144];
#pragma unroll
            for (int r = 0; r < 9; ++r) acc[r] += cond[r][k] * wv; }
#pragma unroll
        for (int r = 0; r < 9; ++r) red[ks][r][jj] = acc[r];
        __syncthreads();
        for (int t = tid; t < 9 * 64; t += 512) { const int r = t >> 6, q = t & 63; float s = 0.f; for (int z = 0; z < 8; ++z) s += red[z][r][q];
            ((float*)(p.ws + OFF_MOD))[((size_t)layer * 9 + r) * 6144 + cg * 64 + q] = s + p.ada_b[layer * 6144 + cg * 64 + q]; }
        __syncthreads();
    }
    if (blockIdx.x == (gridDim.x > 1 ? 1u : 0u)) {
        for (int t = tid; t < 1024; t += 512) { const int pos = t >> 4, i = t & 15; float sn, cs; sincosf((float)pos * expf(-(float)i * (1.f / 16.f) * 9.210340371976184f), &sn, &cs);
            ((float2*)(p.ws + OFF_ROPE))[t] = make_float2(cs, sn); }
    }
    if (blockIdx.x == 0) {
        for (int t = tid; t < 1024; t += 512) { const int layer = t >> 9, dir = (t >> 8) & 1, w = t & 255;
            const float t0 = p.hlb[(dir * 2 + 0) * 256 + w], t1 = p.hlb[(dir * 2 + 1) * 256 + w];
            const float mx = fmaxf(t0, t1), e0 = expf(t0 - mx), e1 = expf(t1 - mx);
            float lb = layer == 0 ? 0.f : e1 / (e0 + e1); lb = fminf(fmaxf(lb, 0.f), 1.f);
            ((float*)(p.ws + OFF_LB))[(layer * 2 + dir) * 256 + w] = lb; }
        if (tid < 128) { const int layer = tid >> 6, lane = tid & 63; const float* L = p.dlam + layer * 256;
            const float s1 = wsum(L[lane] * L[64 + lane]), s2 = wsum(L[128 + lane] * L[192 + lane]);
            if (lane == 0) ((float*)(p.ws + OFF_LAM))[layer] = expf(s1) - expf(s2) + lam_init_of(layer); }
    }
}

DEV void ph_init(const Params& p, char* smem) {
    const int tidx = tid_of(p.wave_id);
    const int wid = tidx >> 6, lane = tidx & 63;
    for (int r = blockIdx.x * 8 + wid; r < NT; r += gridDim.x * 8) {
        const int b = r / SL, s = r % SL;
        const float* src = s < CTX ? p.ctx + ((size_t)b * CTX + s) * D : p.x + ((size_t)b * SEQ + (s - CTX)) * D;
        float4 v[4], o[4]; row_load(src, v, lane); row_store(((float*)(p.ws + OFF_X)) + (size_t)r * D, v, lane);
        const float* m = modrow(p, 0, b, s);
        row_modnorm(v, p.norms + 0, m + 0, m + 1024, o, lane);
        row_store_bf16((bf16_t*)(p.ws + OFF_XNB) + (size_t)r * D, o, lane);
    }
}


struct EpiIn {
    static constexpr bool PERM = false;
    bf16_t *PB, *QRB, *Q0B, *KB, *VB; const float* CS;
    DEV void operator()(const pg8::f32x4 (&acc)[2][2][4][2], const pg8::Unit& u, int wr, int wc, int fr, int fq) const {
        using pg8::f32x4; using pg8::u32x2;
        const int pn = u.pn;
        if (pn < 8 || pn == 14) {
#pragma unroll
            for (int ai = 0; ai < 2; ++ai)
#pragma unroll
                for (int m = 0; m < 4; ++m) { bf16_t* rowp = PB + (size_t)(u.pm * 256 + ai * 128 + wr * 64 + m * 16 + fr) * DP + pn * 256 + wc * 32 + 4 * fq;
#pragma unroll
                    for (int bj = 0; bj < 2; ++bj)
#pragma unroll
                        for (int n = 0; n < 2; ++n) { const f32x4 v = acc[ai][bj][m][n]; u32x2 w; w.x = cvt_pk_bf16(v[0], v[1]); w.y = cvt_pk_bf16(v[2], v[3]); *(u32x2*)(rowp + bj * 128 + n * 16) = w; } }
        } else {
            const int kind = (pn - 8) >> 1, hb = ((pn - 8) & 1) * 2, b = u.pm / 9, tq = u.pm % 9, half = wc & 1, jsub = wc >> 1;
            const bool isctx = tq == 0;
            const float QC = 0.125f * 1.4426950408889634f;
#pragma unroll
            for (int ai = 0; ai < 2; ++ai)
#pragma unroll
                for (int m = 0; m < 4; ++m) {
                    const int s = tq * 256 + ai * 128 + wr * 64 + m * 16 + fr;
                    f32x4 c4 = {1.f, 1.f, 1.f, 1.f}, s4 = {0.f, 0.f, 0.f, 0.f};
                    if (kind != 2 && !isctx) { const int pos = half == 0 ? (tq - 1) * 4 + ai * 2 + wr : m * 16 + fr;
                        const f32x4 t0 = *(const f32x4*)(CS + (pos * 16 + 4 * fq) * 2), t1 = *(const f32x4*)(CS + (pos * 16 + 4 * fq) * 2 + 4);
                        c4 = (f32x4){t0[0], t0[2], t1[0], t1[2]}; s4 = (f32x4){t0[1], t0[3], t1[1], t1[3]}; }
#pragma unroll
                    for (int bj = 0; bj < 2; ++bj) {
                        const size_t dst = ((size_t)(b * 4 + hb + bj) * SL + s) * 128 + jsub * 64 + half * 32 + 4 * fq;
                        const f32x4 x1 = acc[ai][bj][m][0], x2 = acc[ai][bj][m][1];
#define ST4(ptr, v) do { u32x2 w_; w_.x = cvt_pk_bf16((v)[0], (v)[1]); w_.y = cvt_pk_bf16((v)[2], (v)[3]); *(u32x2*)(ptr) = w_; } while (0)
                        if (kind == 2) { ST4(VB + dst, x1); ST4(VB + dst + 16, x2); }
                        else {
                            const f32x4 o1 = x1 * c4 - x2 * s4, o2 = x1 * s4 + x2 * c4;
                            if (kind == 1) { ST4(KB + dst, o1); ST4(KB + dst + 16, o2); }
                            else { const f32x4 a1 = o1 * QC, a2 = o2 * QC, p1 = x1 * QC, p2 = x2 * QC; ST4(QRB + dst, a1); ST4(QRB + dst + 16, a2); ST4(Q0B + dst, p1); ST4(Q0B + dst + 16, p2); }
                        }
#undef ST4
                    }
                }
        }
    }
};

struct InOrder {
    int G, c, Lbeg, Lend; const char* Bt; int K;
    DEV bool next(int i, pg8::Unit& u) const {
        const int L = Lbeg + i * G + c; if (L >= Lend) return false;
        const int nN = L < 648 ? 9 : 6, l = L < 648 ? L : L - 648, nM = NT / 256, nwg = nM * nN;
        int wgid = l; { const int q = nwg / 8, r = nwg % 8, xcd = wgid % 8, off = wgid / 8; wgid = (xcd < r ? xcd * (q + 1) : r * (q + 1) + (xcd - r) * q) + off; }
        const int nig = 8 * nN, gid = wgid / nig, fm = gid * 8, gsz = (nM - fm) < 8 ? (nM - fm) : 8;
        const int pnl = (wgid % nig) / gsz;
        u.pm = fm + ((wgid % nig) % gsz); u.pn = L < 648 ? (pnl < 8 ? pnl : 14) : 8 + pnl; u.e = 0; u.t = 0; return true;
    }
    DEV int arow(const pg8::Unit& u, int rr) const { return u.pm * 256 + rr; }
    DEV const char* bbase(const pg8::Unit& u) const { return Bt + (size_t)u.pn * 256 * K * 2; }
};
DEV void ph_inproj(const Params& p, int layer, char* smem, int part) {
    const int tidx = tid_of(p.wave_id);
    const int G = (int)gridDim.x, nun = (NT / 256) * (DP / 256), cut = 4 * G < nun ? 4 * G : nun;
    const int nleft = nun - cut, cid = part == 0 ? (int)blockIdx.x : (int)blockIdx.x - (G - nleft);
    if (part == 1 && (nleft <= 0 || cid < 0)) return;
    InOrder S{G, cid, part == 0 ? 0 : cut, part == 0 ? cut : nun, (const char*)((const bf16_t*)(p.ws + OFF_WIN) + (size_t)layer * DP * D), D};
    EpiIn E{(bf16_t*)(p.ws + OFF_PB), (bf16_t*)(p.ws + OFF_QRB), (bf16_t*)(p.ws + OFF_Q0B), (bf16_t*)(p.ws + OFF_KB), (bf16_t*)(p.ws + OFF_VB), (const float*)(p.ws + OFF_ROPE)};
    pg8::gemm_phase(( LAS unsigned char*)smem, (const char*)(p.ws + OFF_XNB), D, S, E, tid_of(p.wave_id));
}


namespace scn {
using att::bf16x8; using att::s16x4; using att::f32x16; using att::u32x4; using att::crow;
DEV int v_st64(int k, int c) { const int kk = (k & ~0xC) | ((k & 4) << 1) | ((k & 8) >> 1); return ((kk >> 3) * 2 + (c >> 5)) * 512 + ((kk & 7) * 32 + (c & 31)) * 2; }
constexpr int v_rd_off64(int d0, int ks, int half) { return d0 * 512 + ks * 2048 + half * 1024; }
#define SCN_PK(L, H) (bf16x8){L[0], L[1], L[2], L[3], H[0], H[1], H[2], H[3]}
template <int D0> DEV void frags4(int vb, bf16x8& f0, bf16x8& f1, bf16x8& f2, bf16x8& f3) {
    const s16x4 l0 = att::tr_read<v_rd_off64(D0, 0, 0)>(vb), h0 = att::tr_read<v_rd_off64(D0, 0, 1)>(vb), l1 = att::tr_read<v_rd_off64(D0, 1, 0)>(vb), h1 = att::tr_read<v_rd_off64(D0, 1, 1)>(vb);
    const s16x4 l2 = att::tr_read<v_rd_off64(D0, 2, 0)>(vb), h2 = att::tr_read<v_rd_off64(D0, 2, 1)>(vb), l3 = att::tr_read<v_rd_off64(D0, 3, 0)>(vb), h3 = att::tr_read<v_rd_off64(D0, 3, 1)>(vb);
    asm volatile("s_waitcnt lgkmcnt(0)" ::: "memory"); SBAR();
    f0 = SCN_PK(l0, h0); f1 = SCN_PK(l1, h1); f2 = SCN_PK(l2, h2); f3 = SCN_PK(l3, h3);
}
DEV bf16x8 pack8(const float (&v)[8]) { u32x4 w = {cvt_pk_bf16(v[0], v[1]), cvt_pk_bf16(v[2], v[3]), cvt_pk_bf16(v[4], v[5]), cvt_pk_bf16(v[6], v[7])}; return *reinterpret_cast<bf16x8*>(&w); }
DEV void stage64(char* img, const float* src, size_t ld, int lane, float sc = 1.f) {
    const float* row = src + (size_t)lane * ld;
#pragma unroll
    for (int c8 = 0; c8 < 8; ++c8) { const float4 a = *(const float4*)(row + c8 * 8), b = *(const float4*)(row + c8 * 8 + 4);
        u32x4 w = {cvt_pk_bf16(a.x * sc, a.y * sc), cvt_pk_bf16(a.z * sc, a.w * sc), cvt_pk_bf16(b.x * sc, b.y * sc), cvt_pk_bf16(b.z * sc, b.w * sc)};
        *(u32x4*)(img + v_st64(lane, c8 * 8)) = w; }
}
template <int CTRL, int RM> DEV float dpp_f(float oldv, float v, bool bc) { return bc ? __builtin_bit_cast(float, __builtin_amdgcn_update_dpp(__builtin_bit_cast(int, oldv), __builtin_bit_cast(int, v), CTRL, RM, 0xf, true))
                                                                                   : __builtin_bit_cast(float, __builtin_amdgcn_update_dpp(__builtin_bit_cast(int, oldv), __builtin_bit_cast(int, v), CTRL, RM, 0xf, false)); }
DEV float bperm(float v, int src) { return __builtin_bit_cast(float, __builtin_amdgcn_ds_bpermute(src << 2, __builtin_bit_cast(int, v))); }
DEV float scan_inc32(float v) {
    v += dpp_f<0x111, 0xf>(0.f, v, true); v += dpp_f<0x112, 0xf>(0.f, v, true); v += dpp_f<0x114, 0xf>(0.f, v, true); v += dpp_f<0x118, 0xf>(0.f, v, true);
    v += dpp_f<0x142, 0xa>(0.f, v, false);
    return v;
}
DEV float scanmax_inc32(float v) {
    const float ni = -3.0e38f;
    v = fmaxf(v, dpp_f<0x111, 0xf>(ni, v, false)); v = fmaxf(v, dpp_f<0x112, 0xf>(ni, v, false)); v = fmaxf(v, dpp_f<0x114, 0xf>(ni, v, false)); v = fmaxf(v, dpp_f<0x118, 0xf>(ni, v, false));
    v = fmaxf(v, dpp_f<0x142, 0xa>(ni, v, false));
    return v;
}
DEV float scanmax_suf32(float v, int lane) {
    const float ni = -3.0e38f;
    v = fmaxf(v, dpp_f<0x101, 0xf>(ni, v, false)); v = fmaxf(v, dpp_f<0x102, 0xf>(ni, v, false)); v = fmaxf(v, dpp_f<0x104, 0xf>(ni, v, false)); v = fmaxf(v, dpp_f<0x108, 0xf>(ni, v, false));
    const float t = bperm(v, (lane & 32) | 16);
    return (lane & 16) ? v : fmaxf(v, t);
}
DEV void ld8(const bf16_t* ub, unsigned boff, float (&v)[8]) { const u32x4 w = *(const u32x4*)((const char*)ub + boff);
    v[0] = __uint_as_float(w.x << 16); v[1] = __uint_as_float(w.x & 0xffff0000u); v[2] = __uint_as_float(w.y << 16); v[3] = __uint_as_float(w.y & 0xffff0000u);
    v[4] = __uint_as_float(w.z << 16); v[5] = __uint_as_float(w.z & 0xffff0000u); v[6] = __uint_as_float(w.w << 16); v[7] = __uint_as_float(w.w & 0xffff0000u); }
DEV float ld1(const bf16_t* ub, unsigned boff) { return __uint_as_float((unsigned)(*(const unsigned short*)((const char*)ub + boff)) << 16); }
DEV void stage64b(char* img, const bf16_t* src, size_t ld, int lane) {
    const bf16_t* row = src + (size_t)lane * ld;
#pragma unroll
    for (int c8 = 0; c8 < 8; ++c8) *(u32x4*)(img + v_st64(lane, c8 * 8)) = *(const u32x4*)(row + c8 * 8);
}
DEV float4 ldg4(const float* ub, unsigned boff) { return *(const float4*)((const char*)ub + boff); }
DEV float ldg1(const float* ub, unsigned boff) { return *(const float*)((const char*)ub + boff); }
DEV float fexp(float x) { return __expf(fminf(fmaxf(x, -80.f), 80.f)); }
DEV float fsig(float x) { return __builtin_amdgcn_rcpf(1.f + __expf(-x)); }
DEV void decay_ks(const float (&x)[2][8], const float (&lb)[8], int dir, int lane, float (&cum)[2][8], float (&kk)[2][8], float (&ref)[8]) {
#pragma unroll
    for (int tb = 0; tb < 2; ++tb)
#pragma unroll
        for (int j = 0; j < 8; ++j) { const float sg = fsig(x[tb][j]); kk[tb][j] = (1.f - lb[j]) * (1.f - sg); cum[tb][j] = __logf(fmaxf(lb[j] + (1.f - lb[j]) * sg, 1e-12f)); }
#pragma unroll
    for (int j = 0; j < 8; ++j) {
        const float i0 = scan_inc32(cum[0][j]), i1 = scan_inc32(cum[1][j]), t0 = bperm(i0, lane | 31), t1 = bperm(i1, lane | 31);
        if (dir == 0) { cum[0][j] = i0; cum[1][j] = i1 + t0; ref[j] = t0; }
        else { const float x0 = cum[0][j], x1 = cum[1][j]; cum[1][j] = t1 - i1 + x1; cum[0][j] = t0 - i0 + x0 + t1; ref[j] = t1; }
        if ((j & 3) == 3) SBAR();
    }
}
}

DEV void scanA_local(const Params& p, int layer, char* Lw, int bh, int tc, int lane) {
    using namespace scn;
    asm volatile("" : "+v"(lane));
    const int r32 = lane & 31, hi = lane >> 5, b = bh >> 2, h = bh & 3;
    const bf16_t* base = (const bf16_t*)(p.ws + OFF_PB) + (size_t)(b * SL + 64 * tc) * DP;
    unsigned lo = (unsigned)(r32 * DP + 8 * hi) * 2u;
    asm volatile("" : "+v"(lo));
    char* imgV = Lw; char* imgK = Lw + 8192;
    const int vbV = (int)(uintptr_t)imgV + att::v_rd_base(lane), vbK = vbV + 8192;
    stage64b(imgV, base + O_AI + h * 64, DP, lane);
#pragma unroll 1
    for (int dir = 0; dir < 2; ++dir) {
        const int chain = bh * 2 + dir, c = dir == 0 ? tc : (tc < 4 ? 3 - tc : 39 - tc);
#pragma unroll 1
        for (int ks = 0; ks < 4; ++ks) {
            const int ch = 16 * ks + 8 * hi;
            float x[2][8], cum[2][8], kk[2][8], ref[8], lb[8];
#pragma unroll
            for (int tb = 0; tb < 2; ++tb) ld8(base + (dir ? O_AFB : O_AFF) + h * 64 + 16 * ks, lo + tb * (32u * DP * 2u), x[tb]);
            { const float* l = (const float*)(p.ws + OFF_LB) + (layer * 2 + dir) * 256 + h * 64 + ch;
#pragma unroll
              for (int j = 0; j < 8; ++j) lb[j] = l[j]; }
            decay_ks(x, lb, dir, lane, cum, kk, ref);
            float ke[8];
#pragma unroll
            for (int tb = 0; tb < 2; ++tb) {
#pragma unroll
                for (int j = 0; j < 8; ++j) { const float ce = dir == 0 ? bperm(cum[1][j], lane | 31) : bperm(cum[0][j], lane & 32);
                    ke[j] = kk[tb][j] * fexp(ce - cum[tb][j]);
                    if (tb == 1 && dir == 0 && r32 == 31) ((float*)(p.ws + OFF_DECA))[(chain * 36 + c) * 64 + ch + j] = __expf(ce);
                    if (tb == 0 && dir == 1 && r32 == 0) ((float*)(p.ws + OFF_DECA))[(chain * 36 + c) * 64 + ch + j] = __expf(ce); }
                *(bf16x8*)(imgK + v_st64(32 * tb + r32, ch)) = pack8(ke);
            }
            SBAR();
        }
        f32x16 u[2][2] = {};
        { bf16x8 k0, k1, k2, k3, v0, v1, v2, v3;
          frags4<0>(vbK, k0, k1, k2, k3); frags4<0>(vbV, v0, v1, v2, v3);
          u[0][0] = __builtin_amdgcn_mfma_f32_32x32x16_bf16(k0, v0, u[0][0], 0, 0, 0); u[0][0] = __builtin_amdgcn_mfma_f32_32x32x16_bf16(k1, v1, u[0][0], 0, 0, 0);
          u[0][0] = __builtin_amdgcn_mfma_f32_32x32x16_bf16(k2, v2, u[0][0], 0, 0, 0); u[0][0] = __builtin_amdgcn_mfma_f32_32x32x16_bf16(k3, v3, u[0][0], 0, 0, 0);
          bf16x8 w0, w1, w2, w3; frags4<1>(vbV, w0, w1, w2, w3);
          u[0][1] = __builtin_amdgcn_mfma_f32_32x32x16_bf16(k0, w0, u[0][1], 0, 0, 0); u[0][1] = __builtin_amdgcn_mfma_f32_32x32x16_bf16(k1, w1, u[0][1], 0, 0, 0);
          u[0][1] = __builtin_amdgcn_mfma_f32_32x32x16_bf16(k2, w2, u[0][1], 0, 0, 0); u[0][1] = __builtin_amdgcn_mfma_f32_32x32x16_bf16(k3, w3, u[0][1], 0, 0, 0);
          frags4<1>(vbK, k0, k1, k2, k3);
          u[1][0] = __builtin_amdgcn_mfma_f32_32x32x16_bf16(k0, v0, u[1][0], 0, 0, 0); u[1][0] = __builtin_amdgcn_mfma_f32_32x32x16_bf16(k1, v1, u[1][0], 0, 0, 0);
          u[1][0] = __builtin_amdgcn_mfma_f32_32x32x16_bf16(k2, v2, u[1][0], 0, 0, 0); u[1][0] = __builtin_amdgcn_mfma_f32_32x32x16_bf16(k3, v3, u[1][0], 0, 0, 0);
          u[1][1] = __builtin_amdgcn_mfma_f32_32x32x16_bf16(k0, w0, u[1][1], 0, 0, 0); u[1][1] = __builtin_amdgcn_mfma_f32_32x32x16_bf16(k1, w1, u[1][1], 0, 0, 0);
          u[1][1] = __builtin_amdgcn_mfma_f32_32x32x16_bf16(k2, w2, u[1][1], 0, 0, 0); u[1][1] = __builtin_amdgcn_mfma_f32_32x32x16_bf16(k3, w3, u[1][1], 0, 0, 0); }
        float* U = (float*)(p.ws + OFF_UA) + ((size_t)chain * 36 + c) * 4096;
#pragma unroll
        for (int kb = 0; kb < 2; ++kb)
#pragma unroll
            for (int d0 = 0; d0 < 2; ++d0)
#pragma unroll
                for (int r = 0; r < 16; ++r) U[(32 * kb + crow(r, hi)) * 64 + 32 * d0 + r32] = u[kb][d0][r];
    }
}
DEV void scanA_out(const Params& p, int layer, char* Lw, int bh, int tc, int lane) {
    using namespace scn;
    asm volatile("" : "+v"(lane));
    const int r32 = lane & 31, hi = lane >> 5, b = bh >> 2, h = bh & 3;
    const bf16_t* base = (const bf16_t*)(p.ws + OFF_PB) + (size_t)(b * SL + 64 * tc) * DP;
    unsigned lo = (unsigned)(r32 * DP + 8 * hi) * 2u;
    asm volatile("" : "+v"(lo));
    char* imgV = Lw; char* imgS = Lw + 8192;
    const int vbV = (int)(uintptr_t)imgV + att::v_rd_base(lane), vbS = vbV + 8192;
    stage64b(imgV, base + O_AI + h * 64, DP, lane);
    f32x16 o[2][2] = {};
#pragma unroll 1
    for (int dir = 0; dir < 2; ++dir) {
        const int chain = bh * 2 + dir, c = dir == 0 ? tc : (tc < 4 ? 3 - tc : 39 - tc);
        const float* S0g = (const float*)(p.ws + OFF_SA) + ((size_t)chain * 36 + c) * 4096;
        f32x16 pd0 = {}, pd1 = {}, px = {};
#define MM(acc, A, B) acc = __builtin_amdgcn_mfma_f32_32x32x16_bf16(A, B, acc, 0, 0, 0)
#define LOADX(ks) do { _Pragma("unroll") for (int tb = 0; tb < 2; ++tb) ld8(base + (dir ? O_AFB : O_AFF) + h * 64 + 16 * (ks), lo + tb * (32u * DP * 2u), xr[tb]); } while (0)
#define LOADQ(ks) do { _Pragma("unroll") for (int tb = 0; tb < 2; ++tb) ld8(base + O_AQ + h * 64 + 16 * (ks), lo + tb * (32u * DP * 2u), qr[tb]); } while (0)
        float xr[2][8], qr[2][8];
#define KSTEP(ks) do { \
            const int ch = 16 * (ks) + 8 * hi; \
            float cum[2][8], kk[2][8], ref[8], lb[8]; \
            { const float* l = (const float*)(p.ws + OFF_LB) + (layer * 2 + dir) * 256 + h * 64 + ch; _Pragma("unroll") for (int j = 0; j < 8; ++j) lb[j] = l[j]; } \
            const int ci = lane >> 2; const int row = 16 * (ks) + ci, c16 = (lane & 3) * 16; const float* sp = S0g + row * 64 + c16; \
            LOADX(ks); LOADQ(ks); decay_ks(xr, lb, dir, lane, cum, kk, ref); \
            const float4 sa = *(const float4*)sp, sb4 = *(const float4*)(sp + 4), sc4 = *(const float4*)(sp + 8), sd4 = *(const float4*)(sp + 12); \
              \
            { const int sj = ci & 7, sl = (ci >> 3) * 32; float rv = 0.f; \
              _Pragma("unroll") for (int j = 0; j < 8; ++j) { const float t = bperm(ref[j], sl); rv = (sj == j) ? t : rv; } \
              const float er = __expf(fmaxf(rv, -80.f)); \
              u32x4 w0 = {cvt_pk_bf16(sa.x * er, sa.y * er), cvt_pk_bf16(sa.z * er, sa.w * er), cvt_pk_bf16(sb4.x * er, sb4.y * er), cvt_pk_bf16(sb4.z * er, sb4.w * er)}; \
              u32x4 w1 = {cvt_pk_bf16(sc4.x * er, sc4.y * er), cvt_pk_bf16(sc4.z * er, sc4.w * er), cvt_pk_bf16(sd4.x * er, sd4.y * er), cvt_pk_bf16(sd4.z * er, sd4.w * er)}; \
              *(u32x4*)(imgS + v_st64(row, c16)) = w0; *(u32x4*)(imgS + v_st64(row, c16 + 8)) = w1; } \
            bf16x8 qt0, qt1, kt0, kt1; \
            _Pragma("unroll") for (int tb = 0; tb < 2; ++tb) { \
                float t1[8], t2[8]; \
                _Pragma("unroll") for (int j = 0; j < 8; ++j) { const float q = qr[tb][j] * fsig(qr[tb][j]); t1[j] = q * fexp(cum[tb][j] - ref[j]); t2[j] = kk[tb][j] * fexp(ref[j] - cum[tb][j]); } \
                if (tb == 0) { qt0 = pack8(t1); kt0 = pack8(t2); } else { qt1 = pack8(t1); kt1 = pack8(t2); } } \
            MM(pd0, kt0, qt0); MM(pd1, kt1, qt1); if (dir == 0) MM(px, kt0, qt1); else MM(px, kt1, qt0); \
            { const s16x4 l0 = att::tr_read<v_rd_off64(0, ks, 0)>(vbS), h0 = att::tr_read<v_rd_off64(0, ks, 1)>(vbS), l1 = att::tr_read<v_rd_off64(1, ks, 0)>(vbS), h1 = att::tr_read<v_rd_off64(1, ks, 1)>(vbS); \
              asm volatile("s_waitcnt lgkmcnt(0)" ::: "memory"); SBAR(); \
              const bf16x8 s0 = SCN_PK(l0, h0), s1 = SCN_PK(l1, h1); \
              MM(o[0][0], qt0, s0); MM(o[1][0], qt1, s0); MM(o[0][1], qt0, s1); MM(o[1][1], qt1, s1); } \
            SBAR(); } while (0)
        KSTEP(0); KSTEP(1); KSTEP(2); KSTEP(3);
#undef KSTEP
#undef LOADX
#undef LOADQ
        const int r32m = r32;
#pragma unroll
        for (int r = 0; r < 16; ++r) { const int sl = crow(r, hi); const bool keep = dir == 0 ? (sl <= r32m) : (sl >= r32m); pd0[r] = keep ? pd0[r] : 0.f; pd1[r] = keep ? pd1[r] : 0.f; }
        bf16x8 a0, a1, b0, b1, c0, c1;
#define PK4(P, BASE, OUT) do { unsigned a0_ = cvt_pk_bf16(P[BASE + 0], P[BASE + 1]), a1_ = cvt_pk_bf16(P[BASE + 2], P[BASE + 3]);   \
    unsigned b0_ = cvt_pk_bf16(P[BASE + 4], P[BASE + 5]), b1_ = cvt_pk_bf16(P[BASE + 6], P[BASE + 7]);                              \
    auto r0_ = __builtin_amdgcn_permlane32_swap(a0_, b0_, false, false); auto r1_ = __builtin_amdgcn_permlane32_swap(a1_, b1_, false, false); \
    u32x4 w_ = {r0_[0], r1_[0], r0_[1], r1_[1]}; OUT = *reinterpret_cast<bf16x8*>(&w_); } while (0)
        PK4(pd0, 0, a0); PK4(pd0, 8, a1); PK4(pd1, 0, b0); PK4(pd1, 8, b1); PK4(px, 0, c0); PK4(px, 8, c1);
#undef PK4
        {   bf16x8 v0, v1, v2, v3;
#define BLOCK(D0) do { frags4<D0>(vbV, v0, v1, v2, v3); \
            if (dir == 0) { MM(o[0][D0], a0, v0); MM(o[0][D0], a1, v1); MM(o[1][D0], c0, v0); MM(o[1][D0], c1, v1); MM(o[1][D0], b0, v2); MM(o[1][D0], b1, v3); } \
            else          { MM(o[0][D0], a0, v0); MM(o[0][D0], a1, v1); MM(o[0][D0], c0, v2); MM(o[0][D0], c1, v3); MM(o[1][D0], b0, v2); MM(o[1][D0], b1, v3); } } while (0)
            BLOCK(0); BLOCK(1);
#undef BLOCK
        }
#undef MM
    }
    unsigned rob = (unsigned)(4 * hi * DP + r32) * 2u, mob = (unsigned)(4 * hi * D + r32) * 2u;
    asm volatile("" : "+v"(rob), "+v"(mob));
    float gv[2][16][2];
#pragma unroll
    for (int tb = 0; tb < 2; ++tb)
#pragma unroll
        for (int r = 0; r < 16; ++r) { const unsigned go = rob + (unsigned)(32 * tb + (r & 3) + 8 * (r >> 2)) * (DP * 2u); const bf16_t* gb = base + O_AG + h * 64;
            gv[tb][r][0] = ld1(gb, go); gv[tb][r][1] = ld1(gb, go + 64u); }
#pragma unroll
    for (int tb = 0; tb < 2; ++tb)
#pragma unroll
        for (int r = 0; r < 16; ++r) {
            const float x0 = o[tb][0][r], x1 = o[tb][1][r];
            float t = x0 * x0 + x1 * x1; t += bperm(t, lane ^ 1); t += bperm(t, lane ^ 2); t += bperm(t, lane ^ 4); t += bperm(t, lane ^ 8); t += bperm(t, lane ^ 16);
            const float ri = rsqrtf(t * (1.f / 64.f) + 1e-6f);
            const unsigned tcst = (unsigned)(32 * tb + (r & 3) + 8 * (r >> 2));
            const float g0 = gv[tb][r][0], g1 = gv[tb][r][1];
            char* mb = (char*)((bf16_t*)(p.ws + OFF_MIXB) + (size_t)(b * SL + 64 * tc) * D + h * 64); const unsigned mo = mob + tcst * (D * 2u);
            *(bf16_t*)(mb + mo) = (bf16_t)(cvt_pk_bf16(x0 * ri * p.hnorm[layer * 64 + r32] * (g0 * fsig(g0)), 0.f) & 0xffffu);
            *(bf16_t*)(mb + mo + 64u) = (bf16_t)(cvt_pk_bf16(x1 * ri * p.hnorm[layer * 64 + 32 + r32] * (g1 * fsig(g1)), 0.f) & 0xffffu);
        }
}

namespace scn {
DEV float logsig_f(float g) { return fminf(g, 0.f) - __logf(1.f + __expf(-fabsf(g))); }
DEV void gates_B(const bf16_t* gb  , unsigned rowoff, int dir, float bi, float bf, int lane, float (&cumf)[2], float (&g)[2], float (&G)[2], float& cend, float& gmax) {
    float lf[2], li[2];
#pragma unroll
    for (int tb = 0; tb < 2; ++tb) { const unsigned bo = rowoff + tb * (32u * DP * 2u); li[tb] = ld1(gb + (dir * 2 + 0) * 4, bo) + bi; lf[tb] = logsig_f(ld1(gb + (dir * 2 + 1) * 4, bo) + bf); }
    { const float i0 = scan_inc32(lf[0]), i1 = scan_inc32(lf[1]), t0 = bperm(i0, lane | 31), t1 = bperm(i1, lane | 31);
      if (dir == 0) { cumf[0] = i0; cumf[1] = i1 + t0; } else { cumf[1] = t1 - i1 + lf[1]; cumf[0] = t0 - i0 + lf[0] + t1; }
      cend = t0 + t1; }
    g[0] = li[0] - cumf[0]; g[1] = li[1] - cumf[1];
    if (dir == 0) { const float a0 = scanmax_inc32(g[0]), m0 = bperm(a0, lane | 31), a1 = fmaxf(scanmax_inc32(g[1]), m0); G[0] = a0; G[1] = a1; gmax = bperm(a1, lane | 31); }
    else { const float a1 = scanmax_suf32(g[1], lane), m1 = bperm(a1, lane & 32), a0 = fmaxf(scanmax_suf32(g[0], lane), m1); G[0] = a0; G[1] = a1; gmax = bperm(a0, lane & 32); }
}
}
DEV void scanB_local(const Params& p, int layer, char* Lw, int bh, int tc, int lane) {
    using namespace scn;
    asm volatile("" : "+v"(lane));
    const int r32 = lane & 31, hi = lane >> 5, b = bh >> 2, h = bh & 3;
    const bf16_t* base = (const bf16_t*)(p.ws + OFF_PB) + (size_t)(b * SL + 64 * tc) * DP;
    unsigned ro = (unsigned)(r32 * DP) * 2u; asm volatile("" : "+v"(ro));
    char* imgV = Lw; char* imgK = Lw + 8192;
    const int vbV = (int)(uintptr_t)imgV + att::v_rd_base(lane), vbK = vbV + 8192;
    stage64b(imgV, base + O_BV + h * 64, DP, lane);
#pragma unroll 1
    for (int dir = 0; dir < 2; ++dir) {
        const int chain = bh * 2 + dir, c = dir == 0 ? tc : (tc < 4 ? 3 - tc : 39 - tc);
        const float bi = p.mgb[layer * 16 + (dir * 2 + 0) * 4 + h], bf = p.mgb[layer * 16 + (dir * 2 + 1) * 4 + h];
        float cumf[2], g[2], G[2], cend, gmax;
        gates_B(base + O_BG + h, ro, dir, bi, bf, lane, cumf, g, G, cend, gmax);
        const float w[2] = {__expf(g[0] - gmax), __expf(g[1] - gmax)};
#pragma unroll
        for (int ks = 0; ks < 2; ++ks) {
            float un[8];
#pragma unroll
            for (int j = 0; j < 8; ++j) un[j] = 0.f;
#pragma unroll
            for (int tb = 0; tb < 2; ++tb) { float wk[8]; ld8(base + O_BK + h * 32 + 16 * ks, ro + 16u * hi + tb * (32u * DP * 2u), wk);
#pragma unroll
                for (int j = 0; j < 8; ++j) { wk[j] *= w[tb]; un[j] += wk[j]; }
                *(bf16x8*)(imgK + v_st64(32 * tb + r32, 16 * ks + 8 * hi)) = pack8(wk); }
#pragma unroll
            for (int j = 0; j < 8; ++j) { float t = un[j]; t += bperm(t, lane ^ 1); t += bperm(t, lane ^ 2); t += bperm(t, lane ^ 4); t += bperm(t, lane ^ 8); t += bperm(t, lane ^ 16);
                if (r32 == 0) ((float*)(p.ws + OFF_NB))[(chain * 36 + c) * 32 + 16 * ks + 8 * hi + j] = t; }
        }
        f32x16 u0 = {}, u1 = {};
        { bf16x8 k0, k1, k2, k3, v0, v1, v2, v3;
#define MM(acc, A, B) acc = __builtin_amdgcn_mfma_f32_32x32x16_bf16(A, B, acc, 0, 0, 0)
          frags4<0>(vbK, k0, k1, k2, k3); frags4<0>(vbV, v0, v1, v2, v3);
          MM(u0, k0, v0); MM(u0, k1, v1); MM(u0, k2, v2); MM(u0, k3, v3);
          frags4<1>(vbV, v0, v1, v2, v3);
          MM(u1, k0, v0); MM(u1, k1, v1); MM(u1, k2, v2); MM(u1, k3, v3);
#undef MM
        }
        float* U = (float*)(p.ws + OFF_UB) + ((size_t)chain * 36 + c) * 2048;
#pragma unroll
        for (int r = 0; r < 16; ++r) { U[crow(r, hi) * 64 + r32] = u0[r]; U[crow(r, hi) * 64 + 32 + r32] = u1[r]; }
        if (lane == 0) { float* M = (float*)(p.ws + OFF_MB) + (chain * 36 + c) * 4; M[0] = cend + gmax; M[1] = cend; }
    }
}
DEV void scanB_out(const Params& p, int layer, char* Lw, int bh, int tc, int lane) {
    using namespace scn;
    asm volatile("" : "+v"(lane));
    const int r32 = lane & 31, hi = lane >> 5, b = bh >> 2, h = bh & 3;
    const bf16_t* base = (const bf16_t*)(p.ws + OFF_PB) + (size_t)(b * SL + 64 * tc) * DP;
    unsigned ro = (unsigned)(r32 * DP) * 2u; asm volatile("" : "+v"(ro));
    char* imgV = Lw; char* imgC = Lw + 8192; float* gA = (float*)(Lw + 12288); float* dA = gA + 64;
    const int vbV = (int)(uintptr_t)imgV + att::v_rd_base(lane), vbC = vbV + 8192;
    stage64b(imgV, base + O_BV + h * 64, DP, lane);
#pragma unroll 1
    for (int dir = 0; dir < 2; ++dir) {
        const int chain = bh * 2 + dir, c = dir == 0 ? tc : (tc < 4 ? 3 - tc : 39 - tc);
        const float bi = p.mgb[layer * 16 + (dir * 2 + 0) * 4 + h], bf = p.mgb[layer * 16 + (dir * 2 + 1) * 4 + h];
        { const float* cg = (const float*)(p.ws + OFF_SB) + ((size_t)chain * 36 + c) * 2048 + (lane >> 1) * 64 + (lane & 1) * 32;
#pragma unroll
          for (int i = 0; i < 4; ++i) { const float4 a = *(const float4*)(cg + 8 * i), bq = *(const float4*)(cg + 8 * i + 4);
              u32x4 w = {cvt_pk_bf16(a.x, a.y), cvt_pk_bf16(a.z, a.w), cvt_pk_bf16(bq.x, bq.y), cvt_pk_bf16(bq.z, bq.w)};
              *(u32x4*)(imgC + v_st64(lane >> 1, (lane & 1) * 32 + 8 * i)) = w; } }
        const float m0 = ((const float*)(p.ws + OFF_MB))[(chain * 36 + c) * 4 + 2];
        float rq[2][2][8], rk[2][2][8];
#pragma unroll
        for (int ks = 0; ks < 2; ++ks)
#pragma unroll
            for (int tb = 0; tb < 2; ++tb) { const unsigned bo = ro + 16u * hi + tb * (32u * DP * 2u);
                ld8(base + O_BQ + h * 32 + 16 * ks, bo, rq[ks][tb]); ld8(base + O_BK + h * 32 + 16 * ks, bo, rk[ks][tb]); }
        float cumf[2], g[2], G[2], cend, gmax;
        gates_B(base + O_BG + h, ro, dir, bi, bf, lane, cumf, g, G, cend, gmax);
        float wi[2], wl[2], emt[2];
#pragma unroll
        for (int tb = 0; tb < 2; ++tb) { const float ml = cumf[tb] + G[tb], mt = fmaxf(cumf[tb] + m0, ml); wi[tb] = __expf(cumf[tb] + m0 - mt); wl[tb] = __expf(ml - mt); emt[tb] = __expf(-mt); }
        if (hi == 0) { gA[r32] = g[0]; gA[32 + r32] = g[1]; }
        f32x16 pd0 = {}, pd1 = {}, px = {};
        float qn[2] = {0.f, 0.f};
        bf16x8 qw[2][2];
#define MM(acc, A, B) acc = __builtin_amdgcn_mfma_f32_32x32x16_bf16(A, B, acc, 0, 0, 0)
#define KSTEP(ks) do { \
            bf16x8 qs0, qs1, kt0, kt1; \
            const float* nn = (const float*)(p.ws + OFF_N0) + (chain * 36 + c) * 32 + 16 * (ks) + 8 * hi; \
            _Pragma("unroll") for (int tb = 0; tb < 2; ++tb) { \
                float q8[8], k8[8], qv[8]; \
                _Pragma("unroll") for (int j = 0; j < 8; ++j) { q8[j] = rq[ks][tb][j] * 0.17677669529663687f; k8[j] = rk[ks][tb][j]; qn[tb] += q8[j] * nn[j]; qv[j] = q8[j] * wi[tb]; } \
                qw[tb][ks] = pack8(qv); \
                if (tb == 0) { qs0 = pack8(q8); kt0 = pack8(k8); } else { qs1 = pack8(q8); kt1 = pack8(k8); } } \
            MM(pd0, kt0, qs0); MM(pd1, kt1, qs1); if (dir == 0) MM(px, kt0, qs1); else MM(px, kt1, qs0); \
            SBAR(); } while (0)
        KSTEP(0); KSTEP(1);
#undef KSTEP
        qn[0] += bperm(qn[0], lane ^ 32); qn[1] += bperm(qn[1], lane ^ 32);
        float ds[2] = {0.f, 0.f};
#pragma unroll
        for (int r = 0; r < 16; ++r) {
            const int sl = crow(r, hi); const bool keep = dir == 0 ? (sl <= r32) : (sl >= r32);
            const float g0 = gA[sl], g1 = gA[32 + sl];
            const float e00 = keep ? __expf(g0 - G[0]) * wl[0] : 0.f, e11 = keep ? __expf(g1 - G[1]) * wl[1] : 0.f;
            const float ex = dir == 0 ? __expf(g0 - G[1]) * wl[1] : __expf(g1 - G[0]) * wl[0];
            pd0[r] *= e00; pd1[r] *= e11; px[r] *= ex;
            if (dir == 0) { ds[0] += pd0[r]; ds[1] += pd1[r] + px[r]; } else { ds[0] += pd0[r] + px[r]; ds[1] += pd1[r]; }
        }
        ds[0] += bperm(ds[0], lane ^ 32); ds[1] += bperm(ds[1], lane ^ 32);
#pragma unroll
        for (int tb = 0; tb < 2; ++tb) { const float den = wi[tb] * qn[tb] + ds[tb]; const float di = __builtin_amdgcn_rcpf(fmaxf(fabsf(den), emt[tb])); if (hi == 0) dA[32 * tb + r32] = di; }
        bf16x8 a0, a1, b0, b1, c0, c1;
#define PK4(P, BASE, OUT) do { unsigned a0_ = cvt_pk_bf16(P[BASE + 0], P[BASE + 1]), a1_ = cvt_pk_bf16(P[BASE + 2], P[BASE + 3]);   \
    unsigned b0_ = cvt_pk_bf16(P[BASE + 4], P[BASE + 5]), b1_ = cvt_pk_bf16(P[BASE + 6], P[BASE + 7]);                              \
    auto r0_ = __builtin_amdgcn_permlane32_swap(a0_, b0_, false, false); auto r1_ = __builtin_amdgcn_permlane32_swap(a1_, b1_, false, false); \
    u32x4 w_ = {r0_[0], r1_[0], r0_[1], r1_[1]}; OUT = *reinterpret_cast<bf16x8*>(&w_); } while (0)
        PK4(pd0, 0, a0); PK4(pd0, 8, a1); PK4(pd1, 0, b0); PK4(pd1, 8, b1); PK4(px, 0, c0); PK4(px, 8, c1);
#undef PK4
        SBAR();
        f32x16 o[2][2] = {};
        {   bf16x8 v0, v1, v2, v3;
#define BLOCK(D0) do { frags4<D0>(vbV, v0, v1, v2, v3); \
            if (dir == 0) { MM(o[0][D0], a0, v0); MM(o[0][D0], a1, v1); MM(o[1][D0], c0, v0); MM(o[1][D0], c1, v1); MM(o[1][D0], b0, v2); MM(o[1][D0], b1, v3); } \
            else          { MM(o[0][D0], a0, v0); MM(o[0][D0], a1, v1); MM(o[0][D0], c0, v2); MM(o[0][D0], c1, v3); MM(o[1][D0], b0, v2); MM(o[1][D0], b1, v3); } \
            { const s16x4 l0 = att::tr_read<v_rd_off64(D0, 0, 0)>(vbC), h0 = att::tr_read<v_rd_off64(D0, 0, 1)>(vbC), l1 = att::tr_read<v_rd_off64(D0, 1, 0)>(vbC), h1 = att::tr_read<v_rd_off64(D0, 1, 1)>(vbC); \
              asm volatile("s_waitcnt lgkmcnt(0)" ::: "memory"); SBAR(); \
              const bf16x8 s0 = SCN_PK(l0, h0), s1 = SCN_PK(l1, h1); \
              MM(o[0][D0], qw[0][0], s0); MM(o[0][D0], qw[0][1], s1); MM(o[1][D0], qw[1][0], s0); MM(o[1][D0], qw[1][1], s1); } } while (0)
            BLOCK(0); BLOCK(1);
#undef BLOCK
        }
#undef MM
        asm volatile("s_waitcnt lgkmcnt(0)" ::: "memory");
        unsigned rob = (unsigned)(4 * hi * DP + r32) * 2u, mob = (unsigned)(4 * hi * D + r32) * 2u, hob = (unsigned)(4 * hi * 256 + r32) * 4u;
        asm volatile("" : "+v"(rob), "+v"(mob), "+v"(hob));
        float* hpk = (float*)(p.ws + OFF_HB2) + (size_t)(b * SL + 64 * tc) * 256 + h * 64;
        if (dir == 0) {
#pragma unroll
            for (int tb = 0; tb < 2; ++tb)
#pragma unroll
                for (int r = 0; r < 16; ++r) { const float di = dA[32 * tb + crow(r, hi)]; const unsigned ho = hob + (unsigned)(32 * tb + (r & 3) + 8 * (r >> 2)) * 1024u;
                    *(float*)((char*)hpk + ho) = o[tb][0][r] * di; *(float*)((char*)hpk + ho + 128u) = o[tb][1][r] * di; }
            asm volatile("s_waitcnt vmcnt(0)" ::: "memory");
        } else {
#pragma unroll
            for (int tb = 0; tb < 2; ++tb)
#pragma unroll
                for (int r = 0; r < 16; ++r) {
                    const unsigned tcst = (unsigned)(32 * tb + (r & 3) + 8 * (r >> 2)); const unsigned ho = hob + tcst * 1024u;
                    const float di = dA[32 * tb + crow(r, hi)];
                    const float x0 = o[tb][0][r] * di + ldg1(hpk, ho), x1 = o[tb][1][r] * di + ldg1(hpk, ho + 128u);
                    float t = x0 * x0 + x1 * x1; t += bperm(t, lane ^ 1); t += bperm(t, lane ^ 2); t += bperm(t, lane ^ 4); t += bperm(t, lane ^ 8); t += bperm(t, lane ^ 16);
                    const float ri = rsqrtf(t * (1.f / 64.f) + 1e-6f);
                    const bf16_t* gb = base + O_BO + h * 64; const unsigned go = rob + tcst * (DP * 2u);
                    const float g0 = ld1(gb, go), g1 = ld1(gb, go + 64u);
                    char* mb = (char*)((bf16_t*)(p.ws + OFF_MIXB) + (size_t)(b * SL + 64 * tc) * D + 256 + h * 64); const unsigned mo = mob + tcst * (D * 2u);
                    *(bf16_t*)(mb + mo) = (bf16_t)(cvt_pk_bf16(x0 * ri * p.mnorm[layer * 256 + h * 64 + r32] * fsig(g0), 0.f) & 0xffffu);
                    *(bf16_t*)(mb + mo + 64u) = (bf16_t)(cvt_pk_bf16(x1 * ri * p.mnorm[layer * 256 + h * 64 + 32 + r32] * fsig(g1), 0.f) & 0xffffu);
                    if ((r & 3) == 3) SBAR();
                }
        }
    }
}

DEV int scan_token(int dir, int step) { return dir == 0 ? step : (step < CTX ? CTX - 1 - step : SL + CTX - 1 - step); }
DEV float logsig(float g) { return fminf(g, 0.f) - log1pf(expf(-fabsf(g))); }
DEV void ph_scan_local(const Params& p, int layer, char* smem) {
    const int wid = p.wave_id;
    const int gw = (int)blockIdx.x * 8 + wid, nw = (int)gridDim.x * 8;
    for (int task = gw; task < 2304; task += nw) {
        const int lane = lane_asm();
        if (task < 1152) scanA_local(p, layer, smem + wid * 16384, task / 36, task % 36, lane);
        else scanB_local(p, layer, smem + wid * 16384, (task - 1152) / 36, (task - 1152) % 36, lane);
    }
}
DEV void ph_scan_carry(const Params& p, char* smem) {
    const int tid = tid_of(p.wave_id);
    const int gt = (int)blockIdx.x * 512 + tid, nth = (int)gridDim.x * 512;
    for (int e = gt; e < 64 * 4096; e += nth) {
        const int chain = e >> 12, kv = e & 4095, k = kv >> 6;
        const float* U = (const float*)(p.ws + OFF_UA) + (size_t)chain * 36 * 4096 + kv; float* SO = (float*)(p.ws + OFF_SA) + (size_t)chain * 36 * 4096 + kv; const float* Dc = (const float*)(p.ws + OFF_DECA) + chain * 36 * 64 + k;
        float S = 0.f;
#pragma unroll 4
        for (int c = 0; c < 36; ++c) { const float u = U[(size_t)c * 4096], d = Dc[c * 64]; SO[(size_t)c * 4096] = S; S = d * S + u; }
    }
    for (int e = gt; e < 64 * 2048; e += nth) {
        const int chain = e >> 11, kv = e & 2047;
        const float* U = (const float*)(p.ws + OFF_UB) + (size_t)chain * 36 * 2048 + kv; float* SO = (float*)(p.ws + OFF_SB) + (size_t)chain * 36 * 2048 + kv; const float* M = (const float*)(p.ws + OFF_MB) + chain * 36 * 4;
        float Cc = 0.f, m = 0.f;
#pragma unroll 4
        for (int c = 0; c < 36; ++c) { const float mle = M[c * 4 + 0], ce = M[c * 4 + 1], u = U[(size_t)c * 2048]; SO[(size_t)c * 2048] = Cc;
            const float mn = fmaxf(ce + m, mle); Cc = expf(ce + m - mn) * Cc + expf(mle - mn) * u; m = mn; }
    }
    for (int e = gt; e < 64 * 32; e += nth) {
        const int chain = e >> 5, k = e & 31;
        const float* N = (const float*)(p.ws + OFF_NB) + chain * 36 * 32 + k; float* NO = (float*)(p.ws + OFF_N0) + chain * 36 * 32 + k; float* M = (float*)(p.ws + OFF_MB) + chain * 36 * 4;
        float nn = 0.f, m = 0.f;
        for (int c = 0; c < 36; ++c) { const float mle = M[c * 4 + 0], ce = M[c * 4 + 1], u = N[c * 32]; NO[c * 32] = nn; if (k == 0) M[c * 4 + 2] = m;
            const float mn = fmaxf(ce + m, mle); nn = expf(ce + m - mn) * nn + expf(mle - mn) * u; m = mn; }
    }
}
DEV void ph_scan_out(const Params& p, int layer, char* smem) {
    const int wid = p.wave_id;
    const int gw = (int)blockIdx.x * 8 + wid, nw = (int)gridDim.x * 8;
    for (int task = gw; task < 2304; task += nw) {
        const int lane = lane_asm();
        const bool isB = task >= 1152; const int tt = isB ? task - 1152 : task, bh = tt / 36, tc = tt % 36;
        if (layer != 0 && tc < 4) continue;
        if (!isB) scanA_out(p, layer, smem + wid * 16384, bh, tc, lane);
        else scanB_out(p, layer, smem + wid * 16384, bh, tc, lane);
    }
}

DEV void ph_attn(const Params& p, int layer, char* smem) {
    const int wid = p.wave_id, js = wid & 1, qb = wid >> 1;
    const float lam = ((const float*)(p.ws + OFF_LAM))[layer], omli = 1.f - lam_init_of(layer);
    const bf16_t* KB = (const bf16_t*)(p.ws + OFF_KB); const bf16_t* VB = (const bf16_t*)(p.ws + OFF_VB);
    const bf16_t* QRB = (const bf16_t*)(p.ws + OFF_QRB); const bf16_t* Q0B = (const bf16_t*)(p.ws + OFF_Q0B);
    const int G = (int)gridDim.x, c = (int)blockIdx.x;
    const int nlat = 512, ntot = nlat + (layer == 0 ? 64 : 0);
    for (int i = 0;; ++i) {
        int bh, s0; bool isctx;
        if (G == 256) {
            const int xcd = c & 7, j = c >> 3;
            if (i < 2) { bh = xcd + 8 * (i * 2 + (j >> 4)); s0 = CTX + (j & 15) * 128; isctx = false; }
            else if (i == 2 && layer == 0 && j < 8) { bh = xcd + 8 * (j >> 1); s0 = (j & 1) * 128; isctx = true; }
            else break;
        } else {
            const int u = i * G + c; if (u >= ntot) break;
            if (u < nlat) { bh = u >> 4; s0 = CTX + (u & 15) * 128; isctx = false; } else { const int v = u - nlat; bh = v >> 1; s0 = (v & 1) * 128; isctx = true; }
        }
        const int lane = lane_asm(), tid = (wid << 6) | lane, r32 = lane & 31, hi = lane >> 5;
        const bf16_t* Kh = KB + (size_t)bh * SL * 128; const bf16_t* Vh = VB + (size_t)bh * SL * 128;
        const size_t qoff = ((size_t)bh * SL + s0 + qb * 32 + r32) * 128 + js * 64 + hi * 8;
        att::bf16x8 qr[4];
#pragma unroll
        for (int d0 = 0; d0 < 4; ++d0) qr[d0] = *(const att::bf16x8*)(Q0B + qoff + d0 * 16);
        float m_reg = -1e30f, l_reg = 0.f; att::f32x16 o[4] = {};
        att::attn_tiles(qr, Kh, Vh, CTX, smem, m_reg, l_reg, o, tid, js);
        if (!isctx) {
#pragma unroll
            for (int d0 = 0; d0 < 4; ++d0) qr[d0] = *(const att::bf16x8*)(QRB + qoff + d0 * 16);
            att::attn_tiles(qr, Kh + (size_t)CTX * 128, Vh + (size_t)CTX * 128, SEQ, smem, m_reg, l_reg, o, tid, js);
        }
        float* wsw = (float*)(smem + 2 * att::SHM_V + 2 * att::SHM_K) + wid * 64;
        __syncthreads();
        if (hi == 0) wsw[r32] = l_reg;
        asm volatile("s_waitcnt lgkmcnt(0)" ::: "memory");
        float rli[16];
#pragma unroll
        for (int r = 0; r < 16; ++r) rli[r] = __builtin_amdgcn_rcpf(wsw[att::crow(r, hi)]);
        float* X = (float*)smem + qb * 4096;
        if (js == 1) {
#pragma unroll
            for (int d0 = 0; d0 < 4; ++d0)
#pragma unroll
                for (int r = 0; r < 16; ++r) X[(d0 * 16 + r) * 64 + lane] = o[d0][r] * rli[r];
        }
        __syncthreads();
        if (js == 0) {
            const int b = bh >> 2, h = bh & 3;
            float ss[16];
#pragma unroll
            for (int r = 0; r < 16; ++r) ss[r] = 0.f;
#pragma unroll
            for (int d0 = 0; d0 < 4; ++d0)
#pragma unroll
                for (int r = 0; r < 16; ++r) { const float v = o[d0][r] * rli[r] - lam * X[(d0 * 16 + r) * 64 + lane]; o[d0][r] = v; ss[r] += v * v; }
#pragma unroll
            for (int r = 0; r < 16; ++r) { float t = ss[r]; t += __shfl_xor(t, 1); t += __shfl_xor(t, 2); t += __shfl_xor(t, 4); t += __shfl_xor(t, 8); t += __shfl_xor(t, 16);
                ss[r] = rsqrtf(t * (1.f / 128.f) + 1e-6f) * omli; }
            bf16_t* mix = (bf16_t*)(p.ws + OFF_MIXB) + (size_t)(b * SL + s0 + qb * 32) * D + 512 + h * 128 + r32;
#pragma unroll
            for (int d0 = 0; d0 < 4; ++d0) { const float g = p.dnorm[layer * 128 + d0 * 32 + r32];
#pragma unroll
                for (int r = 0; r < 16; ++r) mix[(size_t)att::crow(r, hi) * D + d0 * 32] = (bf16_t)(cvt_pk_bf16(o[d0][r] * ss[r] * g, 0.f) & 0xffffu); }
        }
        __syncthreads();
    }
}
DEV void ph_outproj(const Params& p, int layer, char* smem) {
    const int tidx = tid_of(p.wave_id);
    pg8::StaticOrder S; S.init(layer == 0 ? NT / 256 : NB * 8, D / 256, (int)gridDim.x, (int)blockIdx.x, layer == 0 ? 0 : 1, (const bf16_t*)(p.ws + OFF_WOUT) + (size_t)layer * D * D, D);
    pg8::EpiF32 E{(float*)(p.ws + OFF_MIXO), D};
    pg8::gemm_phase((LAS unsigned char*)smem, (const char*)(p.ws + OFF_MIXB), D, S, E, tid_of(p.wave_id));
}
DEV void ph_norm2(const Params& p, int layer, char* smem) {
    typedef float f32x16 __attribute__((ext_vector_type(16)));
    const int wid = p.wave_id, lane = lane_asm(), tidx = (wid << 6) | lane;
    constexpr int XP = 1028, RP = 24;
    float* xs = (float*)smem;
    float* red = (float*)smem;
    int* hist = (int*)(smem + 32 * XP * 4);
    const float* nr = p.norms + (size_t)layer * 4 * D;
    if (tidx < NE) hist[tidx] = 0;
    const int chunk = (NT + (int)gridDim.x - 1) / (int)gridDim.x, rbeg = (int)blockIdx.x * chunk, rend = min(NT, rbeg + chunk);
    float wreg[64];
    { const float* wb = p.rw + (size_t)layer * D * NE + (size_t)(wid * 128 + (lane >> 5)) * NE + (lane & 31);
#pragma unroll
      for (int ks = 0; ks < 64; ++ks) wreg[ks] = wb[(size_t)2 * ks * NE]; }
    for (int r0 = rbeg; r0 < rend; r0 += RP) {
        __syncthreads();
#pragma unroll 1
        for (int j = 0; j < 3; ++j) {
            const int lr = wid * 3 + j, r = r0 + lr;
            if (r >= rend) continue;
            const int b = r / SL, s = r % SL;
            if (layer != 0 && s < CTX) continue;
            const float* m = modrow(p, layer, b, s);
            float4 mo[4], xv[4], o[4]; row_load(((float*)(p.ws + OFF_MIXO)) + (size_t)r * D, mo, lane); row_load(((float*)(p.ws + OFF_X)) + (size_t)r * D, xv, lane);
            const float ri = row_rinv(mo);
#pragma unroll
            for (int i = 0; i < 4; ++i) { const int idx = i * 256 + lane * 4; const float4 g = *(const float4*)(nr + D + idx), gt = *(const float4*)(m + 2048 + idx);
                xv[i].x += gt.x * (mo[i].x * ri * g.x); xv[i].y += gt.y * (mo[i].y * ri * g.y); xv[i].z += gt.z * (mo[i].z * ri * g.z); xv[i].w += gt.w * (mo[i].w * ri * g.w); }
            row_store(((float*)(p.ws + OFF_XN)) + (size_t)r * D, xv, lane);
            row_modnorm(xv, nr + 2 * D, m + 3072, m + 4096, o, lane);
            row_store_bf16((bf16_t*)(p.ws + OFF_XNB) + (size_t)r * D, o, lane);
            row_store(xs + lr * XP, o, lane);
        }
        __syncthreads();
        f32x16 acc = {};
        { const float* xa = xs + (lane & 31) * XP + wid * 128 + (lane >> 5);
#pragma unroll
          for (int ks = 0; ks < 64; ++ks) acc = __builtin_amdgcn_mfma_f32_32x32x2f32(xa[2 * ks], wreg[ks], acc, 0, 0, 0); }
        __syncthreads();
#pragma unroll
        for (int rg = 0; rg < 16; ++rg) red[(wid * 32 + (rg & 3) + 8 * (rg >> 2) + 4 * (lane >> 5)) * 32 + (lane & 31)] = acc[rg];
        __syncthreads();
#pragma unroll 1
        for (int j = 0; j < 3; ++j) {
            const int lr = wid * 3 + j, r = r0 + lr;
            if (r >= rend) continue;
            const int s = r % SL;
            if (layer != 0 && s < CTX) continue;
            const int e = lane & 31;
            float logit = p.rb[layer * NE + e];
#pragma unroll
            for (int w = 0; w < 8; ++w) logit += red[(w * 32 + lr) * 32 + e];
            float tv[4]; int ti[4];
#pragma unroll
            for (int k = 0; k < 4; ++k) {
                float bv = logit; int bi = e;
                for (int o2 = 16; o2 >= 1; o2 >>= 1) { const float ov = __shfl_xor(bv, o2); const int oi = __shfl_xor(bi, o2); if (ov > bv || (ov == bv && oi < bi)) { bv = ov; bi = oi; } }
                tv[k] = bv; ti[k] = bi; if (e == bi) logit = -3.0e38f;
            }
            const float e0 = 1.f, e1 = expf(tv[1] - tv[0]), e2 = expf(tv[2] - tv[0]), e3 = expf(tv[3] - tv[0]), inv = 1.f / (e0 + e1 + e2 + e3);
            if (lane == 0) { *(float4*)(((float*)(p.ws + OFF_TOPW)) + (size_t)r * 4) = make_float4(e0 * inv, e1 * inv, e2 * inv, e3 * inv); *(int4*)(((int*)(p.ws + OFF_TOPI)) + (size_t)r * 4) = make_int4(ti[0], ti[1], ti[2], ti[3]); }
            if (lane < 4) atomicAdd(&hist[lane == 0 ? ti[0] : lane == 1 ? ti[1] : lane == 2 ? ti[2] : ti[3]], 1);
        }
    }
    __syncthreads();
    if (tidx < NE) ((int*)(p.ws + OFF_BC))[(size_t)blockIdx.x * NE + tidx] = hist[tidx];
}
DEV void ph_route(const Params& p, int layer, char* smem) {
    const int tidx = tid_of(p.wave_id);
    int* part = (int*)smem;
    int* off = part + 1024;
    const int G = (int)gridDim.x, bid = (int)blockIdx.x;
    const int* BC = (const int*)(p.ws + OFF_BC);
    { const int e = tidx & 31, sl = tidx >> 5; int before = 0, tot = 0;
      for (int bb = sl; bb < G; bb += 16) { const int c = BC[(size_t)bb * NE + e]; tot += c; if (bb < bid) before += c; }
      part[(sl * 2 + 0) * 32 + e] = before; part[(sl * 2 + 1) * 32 + e] = tot; }
    __syncthreads();
    if (tidx < NE) { int before = 0, tot = 0; for (int sl = 0; sl < 16; ++sl) { before += part[(sl * 2 + 0) * 32 + tidx]; tot += part[(sl * 2 + 1) * 32 + tidx]; }
        off[tidx] = before; if (bid == 0) ((int*)(p.ws + OFF_CNT))[tidx] = tot; }
    __syncthreads();
    if (tidx < 64) {
        const int lane = tidx;
        const int chunk = (NT + G - 1) / G, rbeg = bid * chunk, rend = min(NT, rbeg + chunk);
        for (int q0 = rbeg * 4; q0 < rend * 4; q0 += 64) {
            const int pair = q0 + lane, r = pair >> 2, s = r % SL;
            const bool act = pair < rend * 4 && (layer == 0 || s >= CTX);
            const int my = act ? ((const int*)(p.ws + OFF_TOPI))[pair] : -1;
            for (int e = 0; e < NE; ++e) {
                const unsigned long long bal = __ballot(my == e);
                if (bal) { const int base = off[e];
                    if (my == e) ((int*)(p.ws + OFF_LIST))[(size_t)e * LISTCAP + base + __popcll(bal & ((1ull << lane) - 1ull))] = pair;
                    __builtin_amdgcn_wave_barrier();
                    if (lane == 0) off[e] = base + __popcll(bal);
                    __builtin_amdgcn_wave_barrier(); }
            }
        }
    }
}
DEV int moe_rt(int i, int G, int c, int npn, int& pn) {
    if (G == 256) { const int xcd = c & 7, j = c >> 3, rpx = 32 / npn; pn = j % npn; return (i * 8 + xcd) * rpx + j / npn; }
    const int L = i * G + c; pn = L % npn; return L / npn;
}
constexpr int MOE_LDS = 131072, MOE_MAXU = 12;
DEV void moe_prepare(const Params& p, char* smem, int npn, int mode) {
    const int tidx = tid_of(p.wave_id);
    LAS int* base = (LAS int*)(smem + MOE_LDS);
    LAS int *TE = base, *TT = base + 320, *NRT = base + 640, *CN = base + 656  , *UI = base + 704, *IDX = base + 768;
    if (tidx < NE) CN[tidx] = ((const int*)(p.ws + OFF_CNT))[tidx];
    __syncthreads();
    if (tidx < 320) { int e = 0, acc = 0; for (; e < NE; ++e) { const int n = (CN[e] + 255) >> 8; if (tidx < acc + n) break; acc += n; } TE[tidx] = e; TT[tidx] = tidx - acc; }
    if (tidx == 0) { int tot = 0; for (int e = 0; e < NE; ++e) tot += (CN[e] + 255) >> 8; NRT[0] = tot; }
    __syncthreads();
    const int nrt = NRT[0];
    for (int i = 0; i < MOE_MAXU; ++i) {
        int pn; const int rt = moe_rt(i, (int)gridDim.x, (int)blockIdx.x, npn, pn);
        if (rt >= nrt) break;
        const int e = TE[rt], t = TT[rt], c = CN[e];
        if (tidx < 256) { const int q = t * 256 + tidx; const int pair = ((const int*)(p.ws + OFF_LIST))[(size_t)e * LISTCAP + min(q, c - 1)];
            IDX[i * 256 + tidx] = mode == 1 ? (pair >> 2) : (q < c ? pair : -1); }
        if (tidx == 256) { int pre = 0; for (int z = 0; z < e; ++z) pre += CN[z]; UI[i * 4 + 0] = min(256, c - t * 256); UI[i * 4 + 1] = pre + t * 256; }
    }
    __syncthreads();
}
struct MoeOrder {
    const LAS int *te, *ui, *idx; int nrt, npn, G, c, gather; const char* Bt; size_t bstride; int K;
    DEV bool next(int i, pg8::Unit& u) const { int pn; const int rt = moe_rt(i, G, c, npn, pn); if (rt >= nrt || i >= MOE_MAXU) return false;
        u.pm = rt; u.pn = pn; u.e = __builtin_amdgcn_readfirstlane(te[rt]); u.t = i; return true; }
    DEV int arow(const pg8::Unit& u, int rr) const { return gather ? idx[u.t * 256 + rr] : ui[u.t * 4 + 1] + rr; }
    DEV const char* bbase(const pg8::Unit& u) const { return Bt + (size_t)u.e * bstride + (size_t)u.pn * pg8::BM * K * 2; }
};
DEV float swiglu(float g, float l) { g = fminf(g, 7.f); l = fminf(fmaxf(l, -7.f), 7.f); return g * __builtin_amdgcn_rcpf(1.f + __builtin_amdgcn_exp2f(-1.702f * 1.4426950408889634f * g)) * (l + 1.f); }
struct EpiSwiglu {
    static constexpr bool PERM = true;
    bf16_t* H; const float* b1; const LAS int* ui;
    DEV void operator()(const pg8::f32x4 (&acc)[2][2][4][2], const pg8::Unit& u, int wr, int wc, int fr, int fq) const {
        const int ucnt = ui[u.t * 4 + 0], hrow0 = ui[u.t * 4 + 1], col0 = u.pn * 256 + wc * 32 + 8 * fq;
        const float* bb = b1 + (size_t)u.e * 2048 + col0;
        pg8::f32x4 bv[2][2];
#pragma unroll
        for (int bj = 0; bj < 2; ++bj)
#pragma unroll
            for (int n = 0; n < 2; ++n) bv[bj][n] = *(const pg8::f32x4*)(bb + bj * 128 + 4 * n);
#pragma unroll
        for (int ai = 0; ai < 2; ++ai)
#pragma unroll
            for (int m = 0; m < 4; ++m) { const int rr = ai * 128 + wr * 64 + m * 16 + fr;
                if (rr < ucnt) { bf16_t* rowp = H + (size_t)(hrow0 + rr) * DFF + (col0 >> 1);
#pragma unroll
                    for (int bj = 0; bj < 2; ++bj) { const pg8::f32x4 v0 = acc[ai][bj][m][0] + bv[bj][0], v1 = acc[ai][bj][m][1] + bv[bj][1];
                        pg8::u32x2 w; w.x = cvt_pk_bf16(swiglu(v0[0], v0[1]), swiglu(v0[2], v0[3])); w.y = cvt_pk_bf16(swiglu(v1[0], v1[1]), swiglu(v1[2], v1[3]));
                        *(pg8::u32x2*)(rowp + bj * 64) = w; } } }
    }
};
struct EpiY {
    static constexpr bool PERM = true;
    bf16_t* Y; const LAS int* idx;
    DEV void operator()(const pg8::f32x4 (&acc)[2][2][4][2], const pg8::Unit& u, int wr, int wc, int fr, int fq) const {
        const int col0 = u.pn * 256 + wc * 32 + 8 * fq;
#pragma unroll
        for (int ai = 0; ai < 2; ++ai)
#pragma unroll
            for (int m = 0; m < 4; ++m) { const int rr = ai * 128 + wr * 64 + m * 16 + fr; const int pair = idx[u.t * 256 + rr];
                if (pair >= 0) { bf16_t* rowp = Y + (size_t)pair * D + col0;
#pragma unroll
                    for (int bj = 0; bj < 2; ++bj) { const pg8::f32x4 v0 = acc[ai][bj][m][0], v1 = acc[ai][bj][m][1];
                        pg8::u32x4 w; w.x = cvt_pk_bf16(v0[0], v0[1]); w.y = cvt_pk_bf16(v0[2], v0[3]); w.z = cvt_pk_bf16(v1[0], v1[1]); w.w = cvt_pk_bf16(v1[2], v1[3]);
                        *(pg8::u32x4*)(rowp + bj * 128) = w; } } }
    }
};
DEV void ph_moe1(const Params& p, int layer, char* smem) {
    moe_prepare(p, smem, 8, 1);
    LAS int* base = (LAS int*)(smem + MOE_LDS);
    MoeOrder S{base, base + 704, base + 768, base[640], 8, (int)gridDim.x, (int)blockIdx.x, 1, (const char*)(p.ws + OFF_W1T) + (size_t)layer * NE * 2048 * D * 2, (size_t)2048 * D * 2, D};
    EpiSwiglu E{(bf16_t*)(p.ws + OFF_H), p.b1 + (size_t)layer * NE * 2048, base + 704};
    pg8::gemm_phase((LAS unsigned char*)smem, (const char*)(p.ws + OFF_XNB), D, S, E, tid_of(p.wave_id));
}
DEV void ph_moe2(const Params& p, int layer, char* smem) {
    moe_prepare(p, smem, 4, 2);
    LAS int* base = (LAS int*)(smem + MOE_LDS);
    MoeOrder S{base, base + 704, base + 768, base[640], 4, (int)gridDim.x, (int)blockIdx.x, 0, (const char*)(p.ws + OFF_W2T) + (size_t)layer * NE * D * DFF * 2, (size_t)D * DFF * 2, DFF};
    EpiY E{(bf16_t*)(p.ws + OFF_Y), base + 768};
    pg8::gemm_phase((LAS unsigned char*)smem, (const char*)(p.ws + OFF_H), DFF, S, E, tid_of(p.wave_id));
}
DEV void ph_combine(const Params& p, int layer, char* smem) {
    const int wid = p.wave_id, lane = lane_asm();
    const float* nr = p.norms + (size_t)layer * 4 * D;
    const int total = layer == 0 ? NT : NB * SEQ, stride = (int)gridDim.x * 8;
    for (int q0 = (int)blockIdx.x * 8 + wid; q0 < total; q0 += 2 * stride) {
        int rr[2]; bool ok[2]; float4 tw[2]; int4 ti[2];
#pragma unroll
        for (int u = 0; u < 2; ++u) { const int q = q0 + u * stride; ok[u] = q < total; const int qq = ok[u] ? q : q0;
            rr[u] = layer == 0 ? qq : (qq / SEQ) * SL + CTX + qq % SEQ;
            tw[u] = *(const float4*)(((float*)(p.ws + OFF_TOPW)) + (size_t)rr[u] * 4); ti[u] = *(const int4*)(((int*)(p.ws + OFF_TOPI)) + (size_t)rr[u] * 4); }
        float4 f[2][4], xv[2][4];
#pragma unroll
        for (int u = 0; u < 2; ++u) {
            const int r = rr[u];
            const float w[4] = {tw[u].x, tw[u].y, tw[u].z, tw[u].w}; const int ei[4] = {ti[u].x, ti[u].y, ti[u].z, ti[u].w};
#pragma unroll
            for (int i = 0; i < 4; ++i) f[u][i] = make_float4(0.f, 0.f, 0.f, 0.f);
#pragma unroll
            for (int k = 0; k < 4; ++k) {
                const bf16_t* y = (const bf16_t*)(p.ws + OFF_Y) + ((size_t)r * 4 + k) * D; const float* bb = p.b2 + ((size_t)layer * NE + ei[k]) * D;
#pragma unroll
                for (int i = 0; i < 4; ++i) { const int idx = i * 256 + lane * 4; const pg8::u32x2 yb = *(const pg8::u32x2*)(y + idx); const float4 bv = *(const float4*)(bb + idx);
                    const float y0 = __uint_as_float(yb.x << 16), y1 = __uint_as_float(yb.x & 0xffff0000u), y2 = __uint_as_float(yb.y << 16), y3 = __uint_as_float(yb.y & 0xffff0000u);
                    f[u][i].x += w[k] * (y0 + bv.x); f[u][i].y += w[k] * (y1 + bv.y); f[u][i].z += w[k] * (y2 + bv.z); f[u][i].w += w[k] * (y3 + bv.w); }
            }
            row_load(((float*)(p.ws + OFF_XN)) + (size_t)r * D, xv[u], lane);
        }
#pragma unroll
        for (int u = 0; u < 2; ++u) {
            const int r = rr[u], b = r / SL, s = r % SL;
            const float* m = modrow(p, layer, b, s);
            const float ri = row_rinv(f[u]);
#pragma unroll
            for (int i = 0; i < 4; ++i) { const int idx = i * 256 + lane * 4; const float4 g = *(const float4*)(nr + 3 * D + idx), gt = *(const float4*)(m + 5120 + idx);
                xv[u][i].x += gt.x * (f[u][i].x * ri * g.x); xv[u][i].y += gt.y * (f[u][i].y * ri * g.y); xv[u][i].z += gt.z * (f[u][i].z * ri * g.z); xv[u][i].w += gt.w * (f[u][i].w * ri * g.w); }
            if (ok[u]) {
                if (layer == 0) {
                    row_store(((float*)(p.ws + OFF_X)) + (size_t)r * D, xv[u], lane);
                    const float* m1 = modrow(p, 1, b, s); float4 o[4];
                    row_modnorm(xv[u], p.norms + (size_t)4 * D, m1 + 0, m1 + 1024, o, lane);
                    row_store_bf16((bf16_t*)(p.ws + OFF_XNB) + (size_t)r * D, o, lane);
                } else {
                    row_store(p.out + ((size_t)b * SEQ + (s - CTX)) * D, xv[u], lane);
                }
            }
        }
    }
}

template <int layer> DEV void run_layer(const Params& p, char* smem, const XcdBarrier& bar) {
#define GB() xcd_barrier(bar)

        ph_inproj(p, layer, smem, 0); GB();
        ph_inproj(p, layer, smem, 1); ph_scan_local(p, layer, smem); GB();
        ph_scan_carry(p, smem); ph_attn(p, layer, smem); GB();
        ph_scan_out(p, layer, smem); GB();
        ph_outproj(p, layer, smem); GB();
        ph_norm2(p, layer, smem); GB();
        ph_route(p, layer, smem); GB();
        ph_moe1(p, layer, smem); GB();
        ph_moe2(p, layer, smem); GB();
        ph_combine(p, layer, smem); GB();
    #undef GB
}
constexpr int LDS_BYTES = 147456;
__global__ __launch_bounds__(512, 2) void k_mega(Params p_in) {
    Params p = p_in; p.wave_id = __builtin_amdgcn_readfirstlane((int)(threadIdx.x >> 6));
    extern __shared__ __attribute__((aligned(16))) char smem[];
    volatile LAS unsigned* st = (volatile LAS unsigned*)(smem + LDS_BYTES - 16);
    if (threadIdx.x == 0) { st[0] = 0u; st[1] = 0u; st[2] = 0u; st[3] = 0u; }
    __syncthreads();
    const XcdBarrier bar = xcd_barrier_post(((unsigned*)(p.ws + OFF_bar)), st, p.wave_id);
#define GB() xcd_barrier(bar)
    ph_mods(p, smem); ph_convert(p, smem); GB();
    ph_init(p, smem); GB();
    run_layer<0>(p, smem, bar);
    run_layer<1>(p, smem, bar);
#undef GB
}
}

extern "C" void kernel_launch(void* const* d_in, const int* in_sizes, int n_in, void* d_out, int out_size, void* d_ws, size_t ws_size, hipStream_t stream) {
    static int grid = 0;
    if (grid == 0) {
        int dev = 0, cus = 0, per_cu = 0;
        if (hipGetDevice(&dev) != hipSuccess || hipDeviceGetAttribute(&cus, hipDeviceAttributeMultiprocessorCount, dev) != hipSuccess) { grid = -1; return; }
        if (hipFuncSetAttribute((const void*)k_mega, hipFuncAttributeMaxDynamicSharedMemorySize, LDS_BYTES) != hipSuccess) { grid = -1; return; }
        (void)hipOccupancyMaxActiveBlocksPerMultiprocessor(&per_cu, (const void*)k_mega, 512, LDS_BYTES);
        (void)hipGetLastError();
        grid = cus;
    }
    if (grid < 0) return;
    Params p{};
    const float** in = (const float**)&p;
    for (int i = 0; i < 21; ++i) in[i] = (const float*)d_in[i];
    p.out = (float*)d_out;
    p.ws = (char*)d_ws;
    if (WS_END > ws_size) return;
    if (hipMemsetAsync(p.ws + OFF_bar, 0, (size_t)XCD_BAR_WORDS * 4, stream) != hipSuccess) return;
    hipLaunchKernelGGL(k_mega, dim3(grid), dim3(512), LDS_BYTES, stream, p);
}
```

```cpp
#include <hip/hip_runtime.h>
#include <stdint.h>

namespace {
constexpr int D = 1024, NB = 8, SEQ = 2048, CTX = 256, SL = 2304, NT = NB * SL;
constexpr int DP = 3840, DPW = 3600, NE = 32, DFF = 1024, NPAIR = NT * 4;
constexpr int O_AQ = 0, O_AI = 256, O_AFF = 512, O_AFB = 768, O_AG = 1024, O_BQ = 1280, O_BK = 1408, O_BV = 1536, O_BO = 1792, O_BG = 3584;
constexpr int LISTCAP = NT;

struct Params {
    const float *x, *c, *ctx, *c_ctx, *ada_w, *ada_b, *norms, *w_in, *w_out, *hlb, *hnorm, *mgb, *mnorm, *dlam, *dnorm, *rw, *rb, *w1, *b1, *w2, *b2;
    float* out;
    char* ws;
    int wave_id, pad_;
};
constexpr size_t al256(size_t x) { return (x + 255) & ~(size_t)255; }
constexpr size_t OFF_bar = 0;
constexpr size_t OFF_MOD = OFF_bar + 16384;
constexpr int CW_QHEAD = 3520, CTL_BYTES = 16384;
constexpr size_t OFF_LB = OFF_MOD + al256((size_t)2 * 9 * 6144 * 4);
constexpr size_t OFF_LAM = OFF_LB + al256(1024 * 4);
constexpr size_t OFF_CNT = OFF_LAM + 256;
constexpr size_t OFF_BC = OFF_CNT + 256;
constexpr size_t OFF_TOPW = OFF_BC + al256((size_t)1024 * NE * 4);
constexpr size_t OFF_TOPI = OFF_TOPW + al256((size_t)NPAIR * 4);
constexpr size_t OFF_LIST = OFF_TOPI + al256((size_t)NPAIR * 4);
constexpr size_t OFF_X = OFF_LIST + al256((size_t)NE * LISTCAP * 4);
constexpr size_t OFF_XN = OFF_X + al256((size_t)NT * D * 4);
constexpr size_t OFF_P = OFF_XN + al256((size_t)NT * D * 4);
constexpr size_t OFF_QR = OFF_P + al256((size_t)NT * DP * 4);
constexpr size_t OFF_KT = OFF_QR + al256((size_t)64 * SL * 64 * 4);
constexpr size_t OFF_OC = OFF_KT + al256((size_t)64 * SL * 64 * 4);
constexpr size_t OFF_MIX = OFF_OC + al256((size_t)32 * SL * 128 * 4);
constexpr size_t OFF_MIXO = OFF_MIX + al256((size_t)NT * D * 4);
constexpr size_t OFF_XNB = OFF_MIXO + al256((size_t)NT * D * 4);
constexpr size_t OFF_MIXB = OFF_XNB + al256((size_t)NT * D * 2);
constexpr size_t OFF_WIN = OFF_MIXB + al256((size_t)NT * D * 2);
constexpr size_t OFF_WOUT = OFF_WIN + al256((size_t)2 * DP * D * 2);
constexpr size_t OFF_W1T = OFF_WOUT + al256((size_t)2 * D * D * 2);
constexpr size_t OFF_W2T = OFF_W1T + al256((size_t)2 * NE * 2048 * D * 2);
constexpr size_t OFF_U = OFF_W2T + al256((size_t)2 * NE * D * DFF * 2);
constexpr size_t WS_END = OFF_U + al256((size_t)32 * SL * SL * 4);
constexpr size_t OFF_UA = OFF_U, OFF_DECA = OFF_UA + (size_t)64 * 36 * 4096 * 4, OFF_UB = OFF_DECA + (size_t)64 * 36 * 64 * 4, OFF_NB = OFF_UB + (size_t)64 * 36 * 2048 * 4,
                 OFF_MB = OFF_NB + (size_t)64 * 36 * 32 * 4, OFF_SCB = OFF_MB + (size_t)64 * 36 * 4 * 4,
                 OFF_OA2 = OFF_SCB + (size_t)2 * NT * 16 * 4, OFF_HB2 = OFF_OA2 + (size_t)NT * 256 * 4, OFF_SA = OFF_HB2 + (size_t)NT * 256 * 4, OFF_SB = OFF_SA + (size_t)64 * 36 * 4096 * 4,
                 OFF_N0 = OFF_SB + (size_t)64 * 36 * 2048 * 4;
constexpr size_t OFF_PB = OFF_P;
constexpr size_t OFF_ROPE = OFF_P + al256((size_t)NT * DP * 2);
constexpr size_t OFF_QRB = OFF_QR, OFF_Q0B = OFF_QR + (size_t)32 * SL * 128 * 2, OFF_KB = OFF_KT, OFF_VB = OFF_KT + (size_t)32 * SL * 128 * 2;
constexpr size_t OFF_S = OFF_U, OFF_H = OFF_U, OFF_Y = OFF_U + al256((size_t)(NPAIR + 256) * DFF * 2);
constexpr size_t OFF_OA = OFF_MIXO, OFF_HB = OFF_MIXO + (size_t)2 * NT * 256 * 4;


#define DEV __device__ __forceinline__
DEV int lane_asm() { int l; asm volatile("v_mbcnt_lo_u32_b32 %0, -1, 0\n\tv_mbcnt_hi_u32_b32 %0, -1, %0" : "=v"(l)); return l; }
DEV int tid_of(int wave_id) { return (wave_id << 6) | lane_asm(); }
DEV float wsum(float v) { for (int o = 32; o >= 1; o >>= 1) v += __shfl_xor(v, o); return v; }
DEV float wmaxf(float v) { for (int o = 32; o >= 1; o >>= 1) v = fmaxf(v, __shfl_xor(v, o)); return v; }
DEV float sigm(float x) { return 1.f / (1.f + expf(-x)); }
DEV float rdlane(float v, int l) { return __int_as_float(__builtin_amdgcn_readlane(__float_as_int(v), l)); }
DEV float lam_init_of(int layer) { return 0.8f - 0.6f * expf(-0.3f * (float)layer); }


#define XB_TMO      128
#define XB_XCNT(j)  (256  + 64 * (j))
#define XB_XSUB(j)  (1280 + 64 * (j))
#define XB_XGEN(j)  (2304 + 64 * (j))
#define XB_TOP      3328
#define XB_TOPGEN   3392
#define XCD_BAR_WORDS 3456
#define XB_SPIN_CAP (1u << 22)
#define LAS __attribute__((address_space(3)))
DEV unsigned xb_ld(unsigned* p)              { return __hip_atomic_load(p, __ATOMIC_RELAXED, __HIP_MEMORY_SCOPE_AGENT); }
DEV unsigned xb_add(unsigned* p, unsigned v) { return __hip_atomic_fetch_add(p, v, __ATOMIC_RELAXED, __HIP_MEMORY_SCOPE_AGENT); }
DEV unsigned xb_xcc_id() { return (unsigned)__builtin_amdgcn_s_getreg((3 << 11) | 20) & 0xFu; }
#define XB_SPIN(cond, bar) do { unsigned _sp = 0; while (cond) { __builtin_amdgcn_s_sleep(1); \
    if ((++_sp & 255u) == 0u) { if (xb_ld(&(bar)[XB_TMO])) break; if (_sp > XB_SPIN_CAP) { atomicAdd(&(bar)[XB_TMO], 1u); break; } } } } while (0)
struct XcdBarrier { unsigned* bar; unsigned x; volatile LAS unsigned* st; int wave; };
DEV bool xb_thread0(int wave) { return wave == 0 && lane_asm() == 0; }
DEV XcdBarrier xcd_barrier_post(unsigned* bar, volatile LAS unsigned* st, int wave) {
    XcdBarrier b; b.bar = bar; b.x = xb_xcc_id(); b.st = st; b.wave = wave;
    if (xb_thread0(wave)) (void)xb_add(&bar[XB_XCNT(b.x)], 1u);
    return b;
}
DEV void xcd_barrier_complete(unsigned* bar, unsigned x, unsigned& nloc, unsigned& nx) {
    const unsigned G = gridDim.x * gridDim.y * gridDim.z;
    unsigned sum, cnt, mine, sp = 0u;
    for (;;) {
        sum = 0u; cnt = 0u; mine = 0u;
#pragma unroll
        for (unsigned j = 0; j < 16; ++j) { const unsigned c = xb_ld(&bar[XB_XCNT(j)]); sum += c; cnt += (c > 0u) ? 1u : 0u; mine = (j == x) ? c : mine; }
        if (sum == G) break;
        __builtin_amdgcn_s_sleep(1);
        if ((++sp & 255u) == 0u) { if (xb_ld(&bar[XB_TMO])) break; if (sp > XB_SPIN_CAP) { atomicAdd(&bar[XB_TMO], 1u); break; } }
    }
    nloc = mine > 0u ? mine : 1u; nx = cnt > 0u ? cnt : 1u;
}
DEV void xcd_barrier(const XcdBarrier& b) {
    asm volatile("s_waitcnt vmcnt(0)" ::: "memory");
    __syncthreads();
    if (xb_thread0(b.wave)) {
        unsigned* bar = b.bar;
        __builtin_amdgcn_s_waitcnt(0);
        unsigned nloc = b.st[0], nx = b.st[1];
        if (nloc == 0u) { xcd_barrier_complete(bar, b.x, nloc, nx); b.st[0] = nloc; b.st[1] = nx; }
        const unsigned old = xb_add(&bar[XB_XSUB(b.x)], 1u);
        const unsigned gen = old / nloc;
        if (old + 1u == (gen + 1u) * nloc) {
            __builtin_amdgcn_fence(__ATOMIC_RELEASE, "agent");
            asm volatile("s_waitcnt vmcnt(0)" ::: "memory");
            const unsigned og = xb_add(&bar[XB_TOP], 1u);
            const unsigned tg = og / nx;
            if (og + 1u == (tg + 1u) * nx) xb_add(&bar[XB_TOPGEN], 1u);
            else XB_SPIN(xb_ld(&bar[XB_TOPGEN]) == tg, bar);
            __builtin_amdgcn_fence(__ATOMIC_ACQUIRE, "agent");
            xb_add(&bar[XB_XGEN(b.x)], 1u);
            asm volatile("s_waitcnt vmcnt(0)" ::: "memory");
        } else {
            XB_SPIN(xb_ld(&bar[XB_XGEN(b.x)]) == gen, bar);
            __builtin_amdgcn_fence(__ATOMIC_ACQUIRE, "agent");
            asm volatile("s_waitcnt vmcnt(0)" ::: "memory");
        }
    }
    __syncthreads();
}

typedef unsigned short bf16_t;
DEV unsigned cvt_pk_bf16(float lo, float hi) { unsigned r; asm volatile("v_cvt_pk_bf16_f32 %0, %1, %2" : "=v"(r) : "v"(lo), "v"(hi)); return r; }

namespace pg8 {
typedef short bf16x8 __attribute__((ext_vector_type(8)));
typedef float f32x4 __attribute__((ext_vector_type(4)));
typedef unsigned u32x4 __attribute__((ext_vector_type(4)));
typedef unsigned u32x2 __attribute__((ext_vector_type(2)));
constexpr int BM = 256, BK = 64, HALF = 128, HTB = HALF * BK * 2, STAGE_BYTES = 8 * HTB, NXCD = 8, WGM = 8;
DEV int lds_byte(int r, int c) { const int st = (r >> 4) * 2 + (c >> 5), rr = r & 15, cc = c & 31, ob = rr * 64 + cc * 2; return st * 1024 + (ob ^ (((ob >> 9) & 1) << 5)); }
DEV void stage_rc(int b, int& R, int& C) { const int st = b / 1024, sb = b % 1024, swz = sb ^ (((sb >> 9) & 1) << 5); R = (st >> 1) * 16 + swz / 64; C = (st & 1) * 32 + (swz % 64) / 2; }
DEV int perm32(int rho) { const int n = rho >> 4, i = rho & 15; return 8 * (i >> 2) + 4 * n + (i & 3); }
struct Unit { int pm, pn, e, t; };
struct StaticOrder {
    int nM, nN, nwg, G, c, skipctx; const char* Bt; int K;
    DEV void init(int nM_, int nN_, int G_, int c_, int skipctx_, const void* Bt_, int K_) { nM = nM_; nN = nN_; nwg = nM * nN; G = G_; c = c_; skipctx = skipctx_; Bt = (const char*)Bt_; K = K_; }
    DEV bool next(int i, Unit& u) const {
        const long L = (long)i * G + c; if (L >= nwg) return false;
        int wgid = (int)L; { const int q = nwg / NXCD, r = nwg % NXCD, xcd = wgid % NXCD, off = wgid / NXCD; wgid = (xcd < r ? xcd * (q + 1) : r * (q + 1) + (xcd - r) * q) + off; }
        const int nig = WGM * nN, gid = wgid / nig, fm = gid * WGM, gsz = (nM - fm) < WGM ? (nM - fm) : WGM;
        int pm = fm + ((wgid % nig) % gsz); u.pn = (wgid % nig) / gsz;
        if (skipctx) pm = (pm >> 3) * 9 + 1 + (pm & 7);
        u.pm = pm; u.e = 0; u.t = 0; return true;
    }
    DEV int arow(const Unit& u, int rr) const { return u.pm * BM + rr; }
    DEV const char* bbase(const Unit& u) const { return Bt + (size_t)u.pn * BM * K * 2; }
};
struct EpiF32 {
    static constexpr bool PERM = false;
    float* C; int ldc;
    DEV void operator()(const f32x4 (&acc)[2][2][4][2], const Unit& u, int wr, int wc, int fr, int fq) const {
        const int row0 = u.pm * BM + wr * 64 + fr, col0 = u.pn * BM + wc * 32 + 4 * fq;
#pragma unroll
        for (int ai = 0; ai < 2; ++ai)
#pragma unroll
            for (int m = 0; m < 4; ++m) { float* rowp = C + (size_t)(row0 + ai * HALF + m * 16) * ldc + col0;
#pragma unroll
                for (int bj = 0; bj < 2; ++bj)
#pragma unroll
                    for (int n = 0; n < 2; ++n) *(f32x4*)(rowp + bj * HALF + n * 16) = acc[ai][bj][m][n]; }
    }
};

template <class Epi, class Sched>
DEV void gemm_phase(LAS unsigned char* lds, const char* Abase, const int K, const Sched& S, const Epi& E, const int tid) {
    const int wid = __builtin_amdgcn_readfirstlane(tid >> 6), lane = tid & 63, wr = wid >> 2, wc = wid & 3, fr = lane & 15, fq = lane >> 4;
    const int nt = K / BK;
    unsigned voffB[2];
#pragma unroll
    for (int i = 0; i < 2; ++i) { int R, C; stage_rc(tid * 16 + i * 8192, R, C); const int Rb = Epi::PERM ? ((R & ~31) + perm32(R & 31)) : R;
        voffB[i] = (unsigned)(Rb * K + C) * 2u; }
    const size_t kstep = (size_t)(BK * 2);
    const size_t hstep = (size_t)HALF * K * 2;
    const unsigned ldsw = (unsigned)wid * 1024u;
    const int aoff = lds_byte(wr * 64 + fr, fq * 8), boff = lds_byte(wc * 32 + fr, fq * 8);
#define PG8_SA(b, h) (((b) * 2 + (h)) * HTB)
#define PG8_SB(b, h) ((4 + (b) * 2 + (h)) * HTB)
#define PG8_STAGE_B(bufoff, gbase) do { _Pragma("unroll") for (int _i = 0; _i < 2; ++_i) \
        __builtin_amdgcn_global_load_lds((const unsigned*)((const char*)(gbase) + voffB[_i]), (LAS unsigned*)(lds + (bufoff) + ldsw + _i * 8192), 16, 0, 0); } while (0)
#define PG8_STAGE_A(bufoff, kb, V, h) do { _Pragma("unroll") for (int _i = 0; _i < 2; ++_i) \
        __builtin_amdgcn_global_load_lds((const unsigned*)(Abase + (kb) + (V)[h][_i]), (LAS unsigned*)(lds + (bufoff) + ldsw + _i * 8192), 16, 0, 0); } while (0)
#define PG8_VOFFA(V, u) do { _Pragma("unroll") for (int _i = 0; _i < 2; ++_i) { int _R, _C; stage_rc(tid * 16 + _i * 8192, _R, _C); _Pragma("unroll") for (int _h = 0; _h < 2; ++_h) \
        (V)[_h][_i] = ((unsigned)S.arow(u, _h * HALF + _R) * (unsigned)K + (unsigned)_C) * 2u; } } while (0)
#define PG8_LDA(dst, b, h) do { _Pragma("unroll") for (int m = 0; m < 4; ++m) _Pragma("unroll") for (int k = 0; k < 2; ++k) dst[m][k] = *(const LAS bf16x8*)(lds + PG8_SA(b, h) + aoff + m * 2048 + k * 1024); } while (0)
#define PG8_LDB(dst, b, h) do { _Pragma("unroll") for (int n = 0; n < 2; ++n) _Pragma("unroll") for (int k = 0; k < 2; ++k) dst[n][k] = *(const LAS bf16x8*)(lds + PG8_SB(b, h) + boff + n * 2048 + k * 1024); } while (0)
#define PG8_MMA(ai, bj, At, Bt) do { __builtin_amdgcn_s_setprio(1); _Pragma("unroll") for (int m = 0; m < 4; ++m) _Pragma("unroll") for (int n = 0; n < 2; ++n) _Pragma("unroll") for (int k = 0; k < 2; ++k) \
        acc[ai][bj][m][n] = __builtin_amdgcn_mfma_f32_16x16x32_bf16(Bt[n][k], At[m][k], acc[ai][bj][m][n], 0, 0, 0); __builtin_amdgcn_s_setprio(0); } while (0)
#define PG8_WAIT_V(n) asm volatile("s_waitcnt vmcnt(" #n ")" ::: "memory")
#define PG8_WAIT_L(n) asm volatile("s_waitcnt lgkmcnt(" #n ")" ::: "memory")
#define PG8_BAR __builtin_amdgcn_s_barrier()
#define PG8_SCHED __builtin_amdgcn_sched_barrier(0)
    Unit cur, nxt; int ui = 0;
    if (!S.next(0, cur)) return;
    f32x4 acc[2][2][4][2];
#pragma unroll
    for (int a = 0; a < 2; ++a)
#pragma unroll
        for (int b = 0; b < 2; ++b)
#pragma unroll
            for (int m = 0; m < 4; ++m)
#pragma unroll
                for (int n = 0; n < 2; ++n) acc[a][b][m][n] = (f32x4){0.f, 0.f, 0.f, 0.f};
    bf16x8 At[4][2], B0[2][2], B1[2][2];
    unsigned vc[2][2], v2[2][2];
    PG8_VOFFA(vc, cur);
    const char* cB = S.bbase(cur);
    PG8_STAGE_B(PG8_SB(0, 0), cB); PG8_STAGE_A(PG8_SA(0, 0), 0, vc, 0); PG8_STAGE_B(PG8_SB(0, 1), cB + hstep); PG8_STAGE_A(PG8_SA(0, 1), 0, vc, 1);
    if (wr == 1) PG8_BAR;
    PG8_WAIT_V(4); PG8_BAR;
    PG8_STAGE_B(PG8_SB(1, 0), cB + kstep); PG8_STAGE_A(PG8_SA(1, 0), kstep, vc, 0); PG8_STAGE_B(PG8_SB(1, 1), cB + hstep + kstep);
    PG8_WAIT_V(6); PG8_BAR;
    for (;;) {
        const bool has_next = S.next(ui + 1, nxt);
        const char* nB = has_next ? S.bbase(nxt) : cB;
        for (int t = 0; t < nt; t += 2) {
            const bool last = (t == nt - 2);
            const size_t k1 = (size_t)(t + 1) * kstep, k2 = last ? (size_t)0 : (size_t)(t + 2) * kstep, k3 = k2 + kstep;
            if (last && has_next) { PG8_VOFFA(v2, nxt); } else {
#pragma unroll
                for (int h = 0; h < 2; ++h)
#pragma unroll
                    for (int i = 0; i < 2; ++i) v2[h][i] = vc[h][i]; }
            const char* b2 = last ? nB : cB + (size_t)(t + 2) * kstep; const char* b3 = b2 + kstep;
            PG8_LDB(B0, 0, 0); PG8_SCHED; PG8_LDA(At, 0, 0); PG8_STAGE_A(PG8_SA(1, 1), k1, vc, 1);
            PG8_WAIT_L(8); PG8_BAR; PG8_WAIT_L(0); PG8_MMA(0, 0, At, B0); PG8_BAR; PG8_SCHED;
            PG8_LDB(B1, 0, 1); PG8_STAGE_B(PG8_SB(0, 0), b2);
            PG8_BAR; PG8_WAIT_L(0); PG8_MMA(0, 1, At, B1); PG8_BAR;
            PG8_LDA(At, 0, 1); PG8_STAGE_A(PG8_SA(0, 0), k2, v2, 0);
            PG8_BAR; PG8_WAIT_L(0); PG8_MMA(1, 0, At, B0); PG8_BAR; PG8_SCHED;
            PG8_STAGE_B(PG8_SB(0, 1), b2 + hstep);
            PG8_WAIT_V(6); PG8_BAR; PG8_MMA(1, 1, At, B1); PG8_BAR;
            PG8_LDB(B0, 1, 0); PG8_SCHED; PG8_LDA(At, 1, 0); PG8_STAGE_A(PG8_SA(0, 1), k2, v2, 1);
            PG8_WAIT_L(8); PG8_BAR; PG8_WAIT_L(0); PG8_MMA(0, 0, At, B0); PG8_BAR; PG8_SCHED;
            PG8_LDB(B1, 1, 1); PG8_STAGE_B(PG8_SB(1, 0), b3);
            PG8_BAR; PG8_WAIT_L(0); PG8_MMA(0, 1, At, B1); PG8_BAR;
            PG8_LDA(At, 1, 1); PG8_STAGE_A(PG8_SA(1, 0), k3, v2, 0);
            PG8_BAR; PG8_WAIT_L(0); PG8_MMA(1, 0, At, B0); PG8_BAR; PG8_SCHED;
            PG8_STAGE_B(PG8_SB(1, 1), b3 + hstep);
            PG8_WAIT_V(6); PG8_BAR; PG8_MMA(1, 1, At, B1); PG8_BAR;
        }
        E(acc, cur, wr, wc, fr, fq);
        if (!has_next) break;
#pragma unroll
        for (int a = 0; a < 2; ++a)
#pragma unroll
            for (int b = 0; b < 2; ++b)
#pragma unroll
                for (int m = 0; m < 4; ++m)
#pragma unroll
                    for (int n = 0; n < 2; ++n) acc[a][b][m][n] = (f32x4){0.f, 0.f, 0.f, 0.f};
        cur = nxt; cB = nB; ++ui;
#pragma unroll
        for (int h = 0; h < 2; ++h)
#pragma unroll
            for (int i = 0; i < 2; ++i) vc[h][i] = v2[h][i];
    }
    PG8_WAIT_V(0);
    if (wr == 0) PG8_BAR;
    PG8_BAR;
#undef PG8_SA
#undef PG8_SB
#undef PG8_STAGE_A
#undef PG8_STAGE_B
#undef PG8_VOFFA
#undef PG8_LDA
#undef PG8_LDB
#undef PG8_MMA
#undef PG8_WAIT_V
#undef PG8_WAIT_L
#undef PG8_BAR
#undef PG8_SCHED
}
}


namespace att {
using bf16x8 = __attribute__((ext_vector_type(8))) short;
using s16x4  = __attribute__((ext_vector_type(4))) short;
using f32x16 = __attribute__((ext_vector_type(16))) float;
using u32x4  = __attribute__((ext_vector_type(4))) unsigned;
constexpr int KVBLK = 64, LDK = 128;
constexpr int SHM_V = KVBLK * 128 * 2, SHM_K = KVBLK * 128 * 2, SHM_ATTN = 2 * SHM_V + 2 * SHM_K + 8 * 64 * 4;
constexpr float THR = 8.f;
#define KSWZ(row, colB) ((row) * 256 + ((colB) ^ (((row) & 7) << 4)))
#define SBAR() __builtin_amdgcn_sched_barrier(0)
DEV int crow(int r, int hi) { return (r & 3) + 8 * (r >> 2) + 4 * hi; }
DEV void partialSM(f32x16& p0, f32x16& p1, float& m_reg, float& mn, float& alpha) {
  float pmax = p0[0]; for (int r = 1; r < 16; ++r) pmax = fmaxf(pmax, p0[r]); for (int r = 0; r < 16; ++r) pmax = fmaxf(pmax, p1[r]);
  { auto rr = __builtin_amdgcn_permlane32_swap(__float_as_uint(pmax), __float_as_uint(pmax), false, false);
    pmax = fmaxf(__uint_as_float(rr[0]), __uint_as_float(rr[1])); }
  if (__builtin_expect(__all(pmax - m_reg <= THR), 1)) { mn = m_reg; alpha = 1.f; }
  else { mn = fmaxf(m_reg, pmax); alpha = __builtin_amdgcn_exp2f(m_reg - mn); m_reg = mn; }
  for (int r = 0; r < 16; ++r) p0[r] = p0[r] - mn; for (int r = 0; r < 16; ++r) p1[r] = p1[r] - mn;
  for (int r = 0; r < 16; ++r) p0[r] = __builtin_amdgcn_exp2f(p0[r]);
}
DEV void finishSM(f32x16& p0, f32x16& p1, float alpha, float& l_reg, bf16x8& pa0, bf16x8& pa1, bf16x8& pa2, bf16x8& pa3) {
  for (int r = 0; r < 16; ++r) p1[r] = __builtin_amdgcn_exp2f(p1[r]);
  float ps = 0; for (int r = 0; r < 16; ++r) ps += p0[r]; for (int r = 0; r < 16; ++r) ps += p1[r];
  { auto rr = __builtin_amdgcn_permlane32_swap(__float_as_uint(ps), __float_as_uint(ps), false, false);
    ps = __uint_as_float(rr[0]) + __uint_as_float(rr[1]); }
  l_reg = l_reg * alpha + ps;
#define PK4(P, BASE, OUT) do { unsigned a0 = cvt_pk_bf16(P[BASE + 0], P[BASE + 1]), a1 = cvt_pk_bf16(P[BASE + 2], P[BASE + 3]);   \
    unsigned b0 = cvt_pk_bf16(P[BASE + 4], P[BASE + 5]), b1 = cvt_pk_bf16(P[BASE + 6], P[BASE + 7]);                              \
    auto r0 = __builtin_amdgcn_permlane32_swap(a0, b0, false, false); auto r1 = __builtin_amdgcn_permlane32_swap(a1, b1, false, false); \
    u32x4 w = {r0[0], r1[0], r0[1], r1[1]}; OUT = *reinterpret_cast<bf16x8*>(&w); } while (0)
  PK4(p0, 0, pa0); PK4(p0, 8, pa1); PK4(p1, 0, pa2); PK4(p1, 8, pa3);
#undef PK4
}
DEV void qkt(f32x16& p0, f32x16& p1, const char* Ks, const bf16x8 (&qr)[4], int r32, int hi, int js) {
  p0 = f32x16{}; p1 = f32x16{};
#pragma unroll
  for (int d0 = 0; d0 < 4; ++d0) { const int cb = ((js * 4 + d0) * 16 + hi * 8) * 2;
    bf16x8 b0 = *reinterpret_cast<const bf16x8*>(Ks + KSWZ(r32, cb));
    bf16x8 b1 = *reinterpret_cast<const bf16x8*>(Ks + KSWZ(32 + r32, cb));
    p0 = __builtin_amdgcn_mfma_f32_32x32x16_bf16(b0, qr[d0], p0, 0, 0, 0);
    p1 = __builtin_amdgcn_mfma_f32_32x32x16_bf16(b1, qr[d0], p1, 0, 0, 0); }
}
DEV int v_st(int k, int c) { const int kk = (k & ~0xC) | ((k & 4) << 1) | ((k & 8) >> 1); return ((kk >> 3) * 4 + (c >> 5)) * 512 + ((kk & 7) * 32 + (c & 31)) * 2; }
DEV int v_rd_base(int lane) { return ((lane & 3) << 3) | (((lane >> 2) & 3) << 6) | (((lane >> 4) & 1) << 5) | (((lane >> 5) & 1) << 8); }
constexpr int v_rd_off(int d0, int ks, int half) { return d0 * 512 + ks * 4096 + half * 2048; }
template <int OFF> DEV s16x4 tr_read(int vb) {
  s16x4 r; asm volatile("ds_read_b64_tr_b16 %0, %1 offset:%2" : "=&v"(r) : "v"(vb), "i"(OFF) : "memory"); return r;
}
template <int D0> DEV void pv_one(f32x16& od, int vb, bf16x8 pa0, bf16x8 pa1, bf16x8 pa2, bf16x8 pa3) {
  const s16x4 l0 = tr_read<v_rd_off(D0, 0, 0)>(vb), h0 = tr_read<v_rd_off(D0, 0, 1)>(vb), l1 = tr_read<v_rd_off(D0, 1, 0)>(vb), h1 = tr_read<v_rd_off(D0, 1, 1)>(vb);
  const s16x4 l2 = tr_read<v_rd_off(D0, 2, 0)>(vb), h2 = tr_read<v_rd_off(D0, 2, 1)>(vb), l3 = tr_read<v_rd_off(D0, 3, 0)>(vb), h3 = tr_read<v_rd_off(D0, 3, 1)>(vb);
  asm volatile("s_waitcnt lgkmcnt(0)" ::: "memory"); SBAR();
#define PK(L, H) (bf16x8){L[0], L[1], L[2], L[3], H[0], H[1], H[2], H[3]}
  od = __builtin_amdgcn_mfma_f32_32x32x16_bf16(pa0, PK(l0, h0), od, 0, 0, 0);
  od = __builtin_amdgcn_mfma_f32_32x32x16_bf16(pa1, PK(l1, h1), od, 0, 0, 0);
  od = __builtin_amdgcn_mfma_f32_32x32x16_bf16(pa2, PK(l2, h2), od, 0, 0, 0);
  od = __builtin_amdgcn_mfma_f32_32x32x16_bf16(pa3, PK(l3, h3), od, 0, 0, 0);
#undef PK
}
DEV void pv_d0(f32x16* o, int vb, bf16x8 pa0, bf16x8 pa1, bf16x8 pa2, bf16x8 pa3) {
  pv_one<0>(o[0], vb, pa0, pa1, pa2, pa3); pv_one<1>(o[1], vb, pa0, pa1, pa2, pa3); pv_one<2>(o[2], vb, pa0, pa1, pa2, pa3); pv_one<3>(o[3], vb, pa0, pa1, pa2, pa3);
}
DEV void attn_tiles(const bf16x8 (&qr)[4], const bf16_t* __restrict__ Kh, const bf16_t* __restrict__ Vh, int seq, char* lds,
                    float& m_reg, float& l_reg, f32x16 (&o)[4], int tid, int js) {
  const int wid = tid >> 6, lane = tid & 63, r32 = lane & 31, hi = lane >> 5;
  char* V_lds = lds; char* K_lds = lds + 2 * SHM_V;
  float* ws = (float*)(lds + 2 * SHM_V + 2 * SHM_K) + wid * 64; float* al_l = ws + 32;
  const int sr = tid >> 4, sc = (tid & 15) * 8, vst0 = v_st(sr, sc), vst1 = v_st(32 + sr, sc);
  const int vb0 = (int)(uintptr_t)V_lds + v_rd_base(lane);
  struct { bf16x8 vs0, vs1, ks0, ks1; } sr_[2];
  const unsigned lo0 = (unsigned)((sr * LDK + sc) * 2), lo1 = lo0 + 32u * LDK * 2u;
#define SLOAD(i, k0) do { const char* vb_ = (const char*)Vh + (size_t)(k0) * (LDK * 2); const char* kb_ = (const char*)Kh + (size_t)(k0) * (LDK * 2); \
    sr_[i].vs0 = *(const bf16x8*)(vb_ + lo0); sr_[i].vs1 = *(const bf16x8*)(vb_ + lo1); sr_[i].ks0 = *(const bf16x8*)(kb_ + lo0); sr_[i].ks1 = *(const bf16x8*)(kb_ + lo1); } while (0)
#define SWRITE(b, i) do { *(bf16x8*)(V_lds + (b) * SHM_V + vst0) = sr_[i].vs0;          \
    *(bf16x8*)(V_lds + (b) * SHM_V + vst1) = sr_[i].vs1; int kc = sc * 2;               \
    *(bf16x8*)(K_lds + (b) * SHM_K + KSWZ(sr, kc)) = sr_[i].ks0;                       \
    *(bf16x8*)(K_lds + (b) * SHM_K + KSWZ(32 + sr, kc)) = sr_[i].ks1; } while (0)
#define SWAIT() asm volatile("s_waitcnt vmcnt(4)" ::: "memory")
#define RESC(a) do { if (__any((a) < 1.f)) { if (hi == 0) al_l[r32] = (a); asm volatile("s_waitcnt lgkmcnt(0)" ::: "memory"); \
    for (int d = 0; d < 4; ++d) for (int r = 0; r < 16; ++r) o[d][r] *= al_l[crow(r, hi)]; } } while (0)
  f32x16 pA0, pA1, pB0, pB1; float mnA, mnB, alA, alB; bf16x8 pa0, pa1, pa2, pa3; const int NTL = seq / KVBLK;
  constexpr int SE = 0, SO = 1;
  __syncthreads();
  SLOAD(SE, 0); asm volatile("s_waitcnt vmcnt(0)" ::: "memory"); SWRITE(0, SE); __syncthreads();
  qkt(pA0, pA1, K_lds, qr, r32, hi, js); partialSM(pA0, pA1, m_reg, mnA, alA);
  SLOAD(SO, KVBLK); if (2 < NTL) SLOAD(SE, 2 * KVBLK);
  SWAIT(); SWRITE(1, SO); __syncthreads();
  RESC(alA);
  for (int j = 1; j + 1 < NTL; j += 2) {
    SBAR(); qkt(pB0, pB1, K_lds + SHM_K, qr, r32, hi, js);
    finishSM(pA0, pA1, alA, l_reg, pa0, pa1, pa2, pa3); SBAR();
    SLOAD(SO, (j + 2) * KVBLK); SBAR();
    pv_d0(o, vb0, pa0, pa1, pa2, pa3); partialSM(pB0, pB1, m_reg, mnB, alB);
    __syncthreads(); SWAIT(); SWRITE(0, SE);
    RESC(alB); __syncthreads();
    SBAR(); qkt(pA0, pA1, K_lds, qr, r32, hi, js);
    finishSM(pB0, pB1, alB, l_reg, pa0, pa1, pa2, pa3); SBAR();
    if (j + 3 < NTL) SLOAD(SE, (j + 3) * KVBLK); SBAR();
    pv_d0(o, vb0 + SHM_V, pa0, pa1, pa2, pa3); partialSM(pA0, pA1, m_reg, mnA, alA);
    __syncthreads(); SWAIT(); SWRITE(1, SO);
    RESC(alA); __syncthreads();
  }
  SBAR(); qkt(pB0, pB1, K_lds + SHM_K, qr, r32, hi, js);
  finishSM(pA0, pA1, alA, l_reg, pa0, pa1, pa2, pa3); SBAR();
  pv_d0(o, vb0, pa0, pa1, pa2, pa3); partialSM(pB0, pB1, m_reg, mnB, alB);
  __syncthreads(); RESC(alB);
  finishSM(pB0, pB1, alB, l_reg, pa0, pa1, pa2, pa3); SBAR();
  pv_d0(o, vb0 + SHM_V, pa0, pa1, pa2, pa3);
#undef SLOAD
#undef SWRITE
#undef SWAIT
#undef RESC
}
}

DEV void cvt_tile(const float* src, int ld, int nvalid, bf16_t* dst, int K, int n0, int k0, float* T, const int t, int ns0 = -1) {
    if (ns0 < 0) ns0 = n0;
#pragma unroll
    for (int h = 0; h < 2; ++h) {
        const int kk = (t >> 4) + 32 * h, nq = (t & 15) * 4, n = ns0 + nq;
        const float4 v = n < nvalid ? *(const float4*)(src + (size_t)(k0 + kk) * ld + n) : make_float4(0.f, 0.f, 0.f, 0.f);
        T[(nq + 0) * 65 + kk] = v.x; T[(nq + 1) * 65 + kk] = v.y; T[(nq + 2) * 65 + kk] = v.z; T[(nq + 3) * 65 + kk] = v.w;
    }
    __syncthreads();
    { const int n = t >> 3, kq = (t & 7) * 8; const float* r = T + n * 65 + kq;
      pg8::u32x4 w; w.x = cvt_pk_bf16(r[0], r[1]); w.y = cvt_pk_bf16(r[2], r[3]); w.z = cvt_pk_bf16(r[4], r[5]); w.w = cvt_pk_bf16(r[6], r[7]);
      *(pg8::u32x4*)(dst + (size_t)(n0 + n) * K + k0 + kq) = w; }
    __syncthreads();
}
DEV void cvt_tile4(const float* src, int ld, int nvalid, bf16_t* dst, int K, int n0, int k0, float* T, const int t, int ns0 = -1) {
    if (ns0 < 0) ns0 = n0;
    float4 v[4][2];
#pragma unroll
    for (int q = 0; q < 4; ++q)
#pragma unroll
        for (int h = 0; h < 2; ++h) { const int kk = (t >> 4) + 32 * h, n = ns0 + (t & 15) * 4;
            v[q][h] = n < nvalid ? *(const float4*)(src + (size_t)(k0 + q * 64 + kk) * ld + n) : make_float4(0.f, 0.f, 0.f, 0.f); }
#pragma unroll
    for (int q = 0; q < 4; ++q)
#pragma unroll
        for (int h = 0; h < 2; ++h) { const int kk = (t >> 4) + 32 * h, nq = (t & 15) * 4; float* Tq = T + q * (64 * 65);
            Tq[(nq + 0) * 65 + kk] = v[q][h].x; Tq[(nq + 1) * 65 + kk] = v[q][h].y; Tq[(nq + 2) * 65 + kk] = v[q][h].z; Tq[(nq + 3) * 65 + kk] = v[q][h].w; }
    __syncthreads();
#pragma unroll
    for (int q = 0; q < 4; ++q) { const int n = t >> 3, kq = (t & 7) * 8; const float* r = T + q * (64 * 65) + n * 65 + kq;
      pg8::u32x4 w; w.x = cvt_pk_bf16(r[0], r[1]); w.y = cvt_pk_bf16(r[2], r[3]); w.z = cvt_pk_bf16(r[4], r[5]); w.w = cvt_pk_bf16(r[6], r[7]);
      *(pg8::u32x4*)(dst + (size_t)(n0 + n) * K + k0 + q * 64 + kq) = w; }
    __syncthreads();
}
DEV void ph_convert(const Params& p, char* smem) {
    const int tidx = tid_of(p.wave_id);
    float* T = (float*)(smem + 256);
    volatile int* msg = (volatile int*)smem;
    unsigned* qh = (unsigned*)(p.ws + OFF_bar) + CW_QHEAD;
    constexpr int T_IN = 2 * 60 * 4, T_OUT = 2 * 16 * 4, T_W1 = 64 * 32 * 4, T_W2 = 64 * 16 * 4;
    unsigned nxt = 0u;
    if (tidx == 0) nxt = xb_add(qh, 1u);
    for (;;) {
        __syncthreads();
        if (tidx == 0) msg[0] = (int)nxt;
        __syncthreads();
        const int u = msg[0];
        if (u >= T_IN + T_OUT + T_W1 + T_W2) break;
        if (tidx == 0) nxt = xb_add(qh, 1u);
        if (u < T_IN) { const int l = u / 240, r = u % 240, nt = r >> 2, kq = r & 3;
            const int n0 = nt * 64; int ns0, nv;
            if (n0 < 2048) { ns0 = n0; nv = DPW; } else if (n0 < 3584) { ns0 = n0 + 16; nv = DPW; } else if (n0 == 3584) { ns0 = 2048; nv = 2064; } else { ns0 = 0; nv = 0; }
            cvt_tile4(p.w_in + (size_t)l * D * DPW, DPW, nv, (bf16_t*)(p.ws + OFF_WIN) + (size_t)l * DP * D, D, n0, kq * 256, T, tidx, ns0); }
        else if (u < T_IN + T_OUT) { const int v = u - T_IN, l = v >> 6, r = v & 63, nt = r >> 2, kq = r & 3;
            cvt_tile4(p.w_out + (size_t)l * D * D, D, D, (bf16_t*)(p.ws + OFF_WOUT) + (size_t)l * D * D, D, nt * 64, kq * 256, T, tidx); }
        else if (u < T_IN + T_OUT + T_W1) { const int v = u - T_IN - T_OUT, le = v >> 7, r = v & 127, nt = r >> 2, kq = r & 3;
            cvt_tile4(p.w1 + (size_t)le * D * 2048, 2048, 2048, (bf16_t*)(p.ws + OFF_W1T) + (size_t)le * 2048 * D, D, nt * 64, kq * 256, T, tidx); }
        else { const int v = u - T_IN - T_OUT - T_W1, le = v >> 6, r = v & 63, nt = r >> 2, kq = r & 3;
            cvt_tile4(p.w2 + (size_t)le * DFF * D, D, D, (bf16_t*)(p.ws + OFF_W2T) + (size_t)le * D * DFF, DFF, nt * 64, kq * 256, T, tidx); }
    }
}

DEV void row_load(const float* src, float4 (&v)[4], int lane) {
#pragma unroll
    for (int i = 0; i < 4; ++i) v[i] = *(const float4*)(src + i * 256 + lane * 4);
}
DEV void row_store(float* dst, const float4 (&v)[4], int lane) {
#pragma unroll
    for (int i = 0; i < 4; ++i) *(float4*)(dst + i * 256 + lane * 4) = v[i];
}
DEV void row_store_bf16(bf16_t* dst, const float4 (&v)[4], int lane) {
#pragma unroll
    for (int i = 0; i < 4; ++i) { pg8::u32x2 w; w.x = cvt_pk_bf16(v[i].x, v[i].y); w.y = cvt_pk_bf16(v[i].z, v[i].w); *(pg8::u32x2*)(dst + i * 256 + lane * 4) = w; }
}
DEV float row_rinv(const float4 (&v)[4]) {
    float ss = 0.f;
#pragma unroll
    for (int i = 0; i < 4; ++i) ss += v[i].x * v[i].x + v[i].y * v[i].y + v[i].z * v[i].z + v[i].w * v[i].w;
    ss = wsum(ss);
    return rsqrtf(ss * (1.f / 1024.f) + 1e-6f);
}
DEV void row_modnorm(const float4 (&v)[4], const float* gain, const float* shift, const float* scale, float4 (&o)[4], int lane) {
    const float r = row_rinv(v);
#pragma unroll
    for (int i = 0; i < 4; ++i) {
        const int idx = i * 256 + lane * 4;
        const float4 g = *(const float4*)(gain + idx), sh = *(const float4*)(shift + idx), sc = *(const float4*)(scale + idx);
        o[i].x = v[i].x * r * g.x * (1.f + sc.x) + sh.x; o[i].y = v[i].y * r * g.y * (1.f + sc.y) + sh.y;
        o[i].z = v[i].z * r * g.z * (1.f + sc.z) + sh.z; o[i].w = v[i].w * r * g.w * (1.f + sc.w) + sh.w;
    }
}
DEV const float* modrow(const Params& p, int layer, int b, int s) { return ((float*)(p.ws + OFF_MOD)) + ((size_t)layer * 9 + (s < CTX ? 8 : b)) * 6144; }

DEV void ph_mods(const Params& p, char* smem) {
    const int tidx = tid_of(p.wave_id);
    float (*cond)[1024] = (float (*)[1024])smem;
    float (*red)[9][64] = (float (*)[9][64])(smem + 9 * 1024 * 4);
    const int tid = tidx;
    for (int i = tid; i < 9 * 1024; i += 512) { const int r = i >> 10, k = i & 1023; const float c = r < 8 ? p.c[r * 1024 + k] : p.c_ctx[k]; cond[r][k] = c * sigm(c); }
    __syncthreads();
    for (int u = blockIdx.x; u < 192; u += gridDim.x) {
        const int layer = u / 96, cg = u % 96, jj = tid & 63, ks = tid >> 6, j = cg * 64 + jj;
        float acc[9];
#pragma unroll
        for (int r = 0; r < 9; ++r) acc[r] = 0.f;
        const float* w = p.ada_w + (size_t)layer * 1024 * 6144 + j;
        for (int k = ks * 128; k < ks * 128 + 128; ++k) { const float wv = w[(size_t)k * 6144];
#pragma unroll
            for (int r = 0; r < 9; ++r) acc[r] += cond[r][k] * wv; }
#pragma unroll
        for (int r = 0; r < 9; ++r) red[ks][r][jj] = acc[r];
        __syncthreads();
        for (int t = tid; t < 9 * 64; t += 512) { const int r = t >> 6, q = t & 63; float s = 0.f; for (int z = 0; z < 8; ++z) s += red[z][r][q];
            ((float*)(p.ws + OFF_MOD))[((size_t)layer * 9 + r) * 6144 + cg * 64 + q] = s + p.ada_b[layer * 6144 + cg * 64 + q]; }
        __syncthreads();
    }
    if (blockIdx.x == (gridDim.x > 1 ? 1u : 0u)) {
        for (int t = tid; t < 1024; t += 512) { const int pos = t >> 4, i = t & 15; float sn, cs; sincosf((float)pos * expf(-(float)i * (1.f / 16.f) * 9.210340371976184f), &sn, &cs);
            ((float2*)(p.ws + OFF_ROPE))[t] = make_float2(cs, sn); }
    }
    if (blockIdx.x == 0) {
        for (int t = tid; t < 1024; t += 512) { const int layer = t >> 9, dir = (t >> 8) & 1, w = t & 255;
            const float t0 = p.hlb[(dir * 2 + 0) * 256 + w], t1 = p.hlb[(dir * 2 + 1) * 256 + w];
            const float mx = fmaxf(t0, t1), e0 = expf(t0 - mx), e1 = expf(t1 - mx);
            float lb = layer == 0 ? 0.f : e1 / (e0 + e1); lb = fminf(fmaxf(lb, 0.f), 1.f);
            ((float*)(p.ws + OFF_LB))[(layer * 2 + dir) * 256 + w] = lb; }
        if (tid < 128) { const int layer = tid >> 6, lane = tid & 63; const float* L = p.dlam + layer * 256;
            const float s1 = wsum(L[lane] * L[64 + lane]), s2 = wsum(L[128 + lane] * L[192 + lane]);
            if (lane == 0) ((float*)(p.ws + OFF_LAM))[layer] = expf(s1) - expf(s2) + lam_init_of(layer); }
    }
}

DEV void ph_init(const Params& p, char* smem) {
    const int tidx = tid_of(p.wave_id);
    const int wid = tidx >> 6, lane = tidx & 63;
    for (int r = blockIdx.x * 8 + wid; r < NT; r += gridDim.x * 8) {
        const int b = r / SL, s = r % SL;
        const float* src = s < CTX ? p.ctx + ((size_t)b * CTX + s) * D : p.x + ((size_t)b * SEQ + (s - CTX)) * D;
        float4 v[4], o[4]; row_load(src, v, lane); row_store(((float*)(p.ws + OFF_X)) + (size_t)r * D, v, lane);
        const float* m = modrow(p, 0, b, s);
        row_modnorm(v, p.norms + 0, m + 0, m + 1024, o, lane);
        row_store_bf16((bf16_t*)(p.ws + OFF_XNB) + (size_t)r * D, o, lane);
    }
}


struct EpiIn {
    static constexpr bool PERM = false;
    bf16_t *PB, *QRB, *Q0B, *KB, *VB; const float* CS;
    DEV void operator()(const pg8::f32x4 (&acc)[2][2][4][2], const pg8::Unit& u, int wr, int wc, int fr, int fq) const {
        using pg8::f32x4; using pg8::u32x2;
        const int pn = u.pn;
        if (pn < 8 || pn == 14) {
#pragma unroll
            for (int ai = 0; ai < 2; ++ai)
#pragma unroll
                for (int m = 0; m < 4; ++m) { bf16_t* rowp = PB + (size_t)(u.pm * 256 + ai * 128 + wr * 64 + m * 16 + fr) * DP + pn * 256 + wc * 32 + 4 * fq;
#pragma unroll
                    for (int bj = 0; bj < 2; ++bj)
#pragma unroll
                        for (int n = 0; n < 2; ++n) { const f32x4 v = acc[ai][bj][m][n]; u32x2 w; w.x = cvt_pk_bf16(v[0], v[1]); w.y = cvt_pk_bf16(v[2], v[3]); *(u32x2*)(rowp + bj * 128 + n * 16) = w; } }
        } else {
            const int kind = (pn - 8) >> 1, hb = ((pn - 8) & 1) * 2, b = u.pm / 9, tq = u.pm % 9, half = wc & 1, jsub = wc >> 1;
            const bool isctx = tq == 0;
            const float QC = 0.125f * 1.4426950408889634f;
#pragma unroll
            for (int ai = 0; ai < 2; ++ai)
#pragma unroll
                for (int m = 0; m < 4; ++m) {
                    const int s = tq * 256 + ai * 128 + wr * 64 + m * 16 + fr;
                    f32x4 c4 = {1.f, 1.f, 1.f, 1.f}, s4 = {0.f, 0.f, 0.f, 0.f};
                    if (kind != 2 && !isctx) { const int pos = half == 0 ? (tq - 1) * 4 + ai * 2 + wr : m * 16 + fr;
                        const f32x4 t0 = *(const f32x4*)(CS + (pos * 16 + 4 * fq) * 2), t1 = *(const f32x4*)(CS + (pos * 16 + 4 * fq) * 2 + 4);
                        c4 = (f32x4){t0[0], t0[2], t1[0], t1[2]}; s4 = (f32x4){t0[1], t0[3], t1[1], t1[3]}; }
#pragma unroll
                    for (int bj = 0; bj < 2; ++bj) {
                        const size_t dst = ((size_t)(b * 4 + hb + bj) * SL + s) * 128 + jsub * 64 + half * 32 + 4 * fq;
                        const f32x4 x1 = acc[ai][bj][m][0], x2 = acc[ai][bj][m][1];
#define ST4(ptr, v) do { u32x2 w_; w_.x = cvt_pk_bf16((v)[0], (v)[1]); w_.y = cvt_pk_bf16((v)[2], (v)[3]); *(u32x2*)(ptr) = w_; } while (0)
                        if (kind == 2) { ST4(VB + dst, x1); ST4(VB + dst + 16, x2); }
                        else {
                            const f32x4 o1 = x1 * c4 - x2 * s4, o2 = x1 * s4 + x2 * c4;
                            if (kind == 1) { ST4(KB + dst, o1); ST4(KB + dst + 16, o2); }
                            else { const f32x4 a1 = o1 * QC, a2 = o2 * QC, p1 = x1 * QC, p2 = x2 * QC; ST4(QRB + dst, a1); ST4(QRB + dst + 16, a2); ST4(Q0B + dst, p1); ST4(Q0B + dst + 16, p2); }
                        }
#undef ST4
                    }
                }
        }
    }
};

struct InOrder {
    int G, c, Lbeg, Lend; const char* Bt; int K;
    DEV bool next(int i, pg8::Unit& u) const {
        const int L = Lbeg + i * G + c; if (L >= Lend) return false;
        const int nN = L < 648 ? 9 : 6, l = L < 648 ? L : L - 648, nM = NT / 256, nwg = nM * nN;
        int wgid = l; { const int q = nwg / 8, r = nwg % 8, xcd = wgid % 8, off = wgid / 8; wgid = (xcd < r ? xcd * (q + 1) : r * (q + 1) + (xcd - r) * q) + off; }
        const int nig = 8 * nN, gid = wgid / nig, fm = gid * 8, gsz = (nM - fm) < 8 ? (nM - fm) : 8;
        const int pnl = (wgid % nig) / gsz;
        u.pm = fm + ((wgid % nig) % gsz); u.pn = L < 648 ? (pnl < 8 ? pnl : 14) : 8 + pnl; u.e = 0; u.t = 0; return true;
    }
    DEV int arow(const pg8::Unit& u, int rr) const { return u.pm * 256 + rr; }
    DEV const char* bbase(const pg8::Unit& u) const { return Bt + (size_t)u.pn * 256 * K * 2; }
};
DEV void ph_inproj(const Params& p, int layer, char* smem, int part) {
    const int tidx = tid_of(p.wave_id);
    const int G = (int)gridDim.x, nun = (NT / 256) * (DP / 256), cut = 4 * G < nun ? 4 * G : nun;
    const int nleft = nun - cut, cid = part == 0 ? (int)blockIdx.x : (int)blockIdx.x - (G - nleft);
    if (part == 1 && (nleft <= 0 || cid < 0)) return;
    InOrder S{G, cid, part == 0 ? 0 : cut, part == 0 ? cut : nun, (const char*)((const bf16_t*)(p.ws + OFF_WIN) + (size_t)layer * DP * D), D};
    EpiIn E{(bf16_t*)(p.ws + OFF_PB), (bf16_t*)(p.ws + OFF_QRB), (bf16_t*)(p.ws + OFF_Q0B), (bf16_t*)(p.ws + OFF_KB), (bf16_t*)(p.ws + OFF_VB), (const float*)(p.ws + OFF_ROPE)};
    pg8::gemm_phase(( LAS unsigned char*)smem, (const char*)(p.ws + OFF_XNB), D, S, E, tid_of(p.wave_id));
}


namespace scn {
using att::bf16x8; using att::s16x4; using att::f32x16; using att::u32x4; using att::crow;
DEV int v_st64(int k, int c) { const int kk = (k & ~0xC) | ((k & 4) << 1) | ((k & 8) >> 1); return ((kk >> 3) * 2 + (c >> 5)) * 512 + ((kk & 7) * 32 + (c & 31)) * 2; }
constexpr int v_rd_off64(int d0, int ks, int half) { return d0 * 512 + ks * 2048 + half * 1024; }
#define SCN_PK(L, H) (bf16x8){L[0], L[1], L[2], L[3], H[0], H[1], H[2], H[3]}
template <int D0> DEV void frags4(int vb, bf16x8& f0, bf16x8& f1, bf16x8& f2, bf16x8& f3) {
    const s16x4 l0 = att::tr_read<v_rd_off64(D0, 0, 0)>(vb), h0 = att::tr_read<v_rd_off64(D0, 0, 1)>(vb), l1 = att::tr_read<v_rd_off64(D0, 1, 0)>(vb), h1 = att::tr_read<v_rd_off64(D0, 1, 1)>(vb);
    const s16x4 l2 = att::tr_read<v_rd_off64(D0, 2, 0)>(vb), h2 = att::tr_read<v_rd_off64(D0, 2, 1)>(vb), l3 = att::tr_read<v_rd_off64(D0, 3, 0)>(vb), h3 = att::tr_read<v_rd_off64(D0, 3, 1)>(vb);
    asm volatile("s_waitcnt lgkmcnt(0)" ::: "memory"); SBAR();
    f0 = SCN_PK(l0, h0); f1 = SCN_PK(l1, h1); f2 = SCN_PK(l2, h2); f3 = SCN_PK(l3, h3);
}
DEV bf16x8 pack8(const float (&v)[8]) { u32x4 w = {cvt_pk_bf16(v[0], v[1]), cvt_pk_bf16(v[2], v[3]), cvt_pk_bf16(v[4], v[5]), cvt_pk_bf16(v[6], v[7])}; return *reinterpret_cast<bf16x8*>(&w); }
DEV void stage64(char* img, const float* src, size_t ld, int lane, float sc = 1.f) {
    const float* row = src + (size_t)lane * ld;
#pragma unroll
    for (int c8 = 0; c8 < 8; ++c8) { const float4 a = *(const float4*)(row + c8 * 8), b = *(const float4*)(row + c8 * 8 + 4);
        u32x4 w = {cvt_pk_bf16(a.x * sc, a.y * sc), cvt_pk_bf16(a.z * sc, a.w * sc), cvt_pk_bf16(b.x * sc, b.y * sc), cvt_pk_bf16(b.z * sc, b.w * sc)};
        *(u32x4*)(img + v_st64(lane, c8 * 8)) = w; }
}
template <int CTRL, int RM> DEV float dpp_f(float oldv, float v, bool bc) { return bc ? __builtin_bit_cast(float, __builtin_amdgcn_update_dpp(__builtin_bit_cast(int, oldv), __builtin_bit_cast(int, v), CTRL, RM, 0xf, true))
                                                                                   : __builtin_bit_cast(float, __builtin_amdgcn_update_dpp(__builtin_bit_cast(int, oldv), __builtin_bit_cast(int, v), CTRL, RM, 0xf, false)); }
DEV float bperm(float v, int src) { return __builtin_bit_cast(float, __builtin_amdgcn_ds_bpermute(src << 2, __builtin_bit_cast(int, v))); }
DEV float scan_inc32(float v) {
    v += dpp_f<0x111, 0xf>(0.f, v, true); v += dpp_f<0x112, 0xf>(0.f, v, true); v += dpp_f<0x114, 0xf>(0.f, v, true); v += dpp_f<0x118, 0xf>(0.f, v, true);
    v += dpp_f<0x142, 0xa>(0.f, v, false);
    return v;
}
DEV float scanmax_inc32(float v) {
    const float ni = -3.0e38f;
    v = fmaxf(v, dpp_f<0x111, 0xf>(ni, v, false)); v = fmaxf(v, dpp_f<0x112, 0xf>(ni, v, false)); v = fmaxf(v, dpp_f<0x114, 0xf>(ni, v, false)); v = fmaxf(v, dpp_f<0x118, 0xf>(ni, v, false));
    v = fmaxf(v, dpp_f<0x142, 0xa>(ni, v, false));
    return v;
}
DEV float scanmax_suf32(float v, int lane) {
    const float ni = -3.0e38f;
    v = fmaxf(v, dpp_f<0x101, 0xf>(ni, v, false)); v = fmaxf(v, dpp_f<0x102, 0xf>(ni, v, false)); v = fmaxf(v, dpp_f<0x104, 0xf>(ni, v, false)); v = fmaxf(v, dpp_f<0x108, 0xf>(ni, v, false));
    const float t = bperm(v, (lane & 32) | 16);
    return (lane & 16) ? v : fmaxf(v, t);
}
DEV void ld8(const bf16_t* ub, unsigned boff, float (&v)[8]) { const u32x4 w = *(const u32x4*)((const char*)ub + boff);
    v[0] = __uint_as_float(w.x << 16); v[1] = __uint_as_float(w.x & 0xffff0000u); v[2] = __uint_as_float(w.y << 16); v[3] = __uint_as_float(w.y & 0xffff0000u);
    v[4] = __uint_as_float(w.z << 16); v[5] = __uint_as_float(w.z & 0xffff0000u); v[6] = __uint_as_float(w.w << 16); v[7] = __uint_as_float(w.w & 0xffff0000u); }
DEV float ld1(const bf16_t* ub, unsigned boff) { return __uint_as_float((unsigned)(*(const unsigned short*)((const char*)ub + boff)) << 16); }
DEV void stage64b(char* img, const bf16_t* src, size_t ld, int lane) {
    const bf16_t* row = src + (size_t)lane * ld;
#pragma unroll
    for (int c8 = 0; c8 < 8; ++c8) *(u32x4*)(img + v_st64(lane, c8 * 8)) = *(const u32x4*)(row + c8 * 8);
}
DEV float4 ldg4(const float* ub, unsigned boff) { return *(const float4*)((const char*)ub + boff); }
DEV float ldg1(const float* ub, unsigned boff) { return *(const float*)((const char*)ub + boff); }
DEV float fexp(float x) { return __expf(fminf(fmaxf(x, -80.f), 80.f)); }
DEV float fsig(float x) { return __builtin_amdgcn_rcpf(1.f + __expf(-x)); }
DEV void decay_ks(const float (&x)[2][8], const float (&lb)[8], int dir, int lane, float (&cum)[2][8], float (&kk)[2][8], float (&ref)[8]) {
#pragma unroll
    for (int tb = 0; tb < 2; ++tb)
#pragma unroll
        for (int j = 0; j < 8; ++j) { const float sg = fsig(x[tb][j]); kk[tb][j] = (1.f - lb[j]) * (1.f - sg); cum[tb][j] = __logf(fmaxf(lb[j] + (1.f - lb[j]) * sg, 1e-12f)); }
#pragma unroll
    for (int j = 0; j < 8; ++j) {
        const float i0 = scan_inc32(cum[0][j]), i1 = scan_inc32(cum[1][j]), t0 = bperm(i0, lane | 31), t1 = bperm(i1, lane | 31);
        if (dir == 0) { cum[0][j] = i0; cum[1][j] = i1 + t0; ref[j] = t0; }
        else { const float x0 = cum[0][j], x1 = cum[1][j]; cum[1][j] = t1 - i1 + x1; cum[0][j] = t0 - i0 + x0 + t1; ref[j] = t1; }
        if ((j & 3) == 3) SBAR();
    }
}
}

DEV void scanA_local(const Params& p, int layer, char* Lw, int bh, int tc, int lane) {
    using namespace scn;
    asm volatile("" : "+v"(lane));
    const int r32 = lane & 31, hi = lane >> 5, b = bh >> 2, h = bh & 3;
    const bf16_t* base = (const bf16_t*)(p.ws + OFF_PB) + (size_t)(b * SL + 64 * tc) * DP;
    unsigned lo = (unsigned)(r32 * DP + 8 * hi) * 2u;
    asm volatile("" : "+v"(lo));
    char* imgV = Lw; char* imgK = Lw + 8192;
    const int vbV = (int)(uintptr_t)imgV + att::v_rd_base(lane), vbK = vbV + 8192;
    stage64b(imgV, base + O_AI + h * 64, DP, lane);
#pragma unroll 1
    for (int dir = 0; dir < 2; ++dir) {
        const int chain = bh * 2 + dir, c = dir == 0 ? tc : (tc < 4 ? 3 - tc : 39 - tc);
#pragma unroll 1
        for (int ks = 0; ks < 4; ++ks) {
            const int ch = 16 * ks + 8 * hi;
            float x[2][8], cum[2][8], kk[2][8], ref[8], lb[8];
#pragma unroll
            for (int tb = 0; tb < 2; ++tb) ld8(base + (dir ? O_AFB : O_AFF) + h * 64 + 16 * ks, lo + tb * (32u * DP * 2u), x[tb]);
            { const float* l = (const float*)(p.ws + OFF_LB) + (layer * 2 + dir) * 256 + h * 64 + ch;
#pragma unroll
              for (int j = 0; j < 8; ++j) lb[j] = l[j]; }
            decay_ks(x, lb, dir, lane, cum, kk, ref);
            float ke[8];
#pragma unroll
            for (int tb = 0; tb < 2; ++tb) {
#pragma unroll
                for (int j = 0; j < 8; ++j) { const float ce = dir == 0 ? bperm(cum[1][j], lane | 31) : bperm(cum[0][j], lane & 32);
                    ke[j] = kk[tb][j] * fexp(ce - cum[tb][j]);
                    if (tb == 1 && dir == 0 && r32 == 31) ((float*)(p.ws + OFF_DECA))[(chain * 36 + c) * 64 + ch + j] = __expf(ce);
                    if (tb == 0 && dir == 1 && r32 == 0) ((float*)(p.ws + OFF_DECA))[(chain * 36 + c) * 64 + ch + j] = __expf(ce); }
                *(bf16x8*)(imgK + v_st64(32 * tb + r32, ch)) = pack8(ke);
            }
            SBAR();
        }
        f32x16 u[2][2] = {};
        { bf16x8 k0, k1, k2, k3, v0, v1, v2, v3;
          frags4<0>(vbK, k0, k1, k2, k3); frags4<0>(vbV, v0, v1, v2, v3);
          u[0][0] = __builtin_amdgcn_mfma_f32_32x32x16_bf16(k0, v0, u[0][0], 0, 0, 0); u[0][0] = __builtin_amdgcn_mfma_f32_32x32x16_bf16(k1, v1, u[0][0], 0, 0, 0);
          u[0][0] = __builtin_amdgcn_mfma_f32_32x32x16_bf16(k2, v2, u[0][0], 0, 0, 0); u[0][0] = __builtin_amdgcn_mfma_f32_32x32x16_bf16(k3, v3, u[0][0], 0, 0, 0);
          bf16x8 w0, w1, w2, w3; frags4<1>(vbV, w0, w1, w2, w3);
          u[0][1] = __builtin_amdgcn_mfma_f32_32x32x16_bf16(k0, w0, u[0][1], 0, 0, 0); u[0][1] = __builtin_amdgcn_mfma_f32_32x32x16_bf16(k1, w1, u[0][1], 0, 0, 0);
          u[0][1] = __builtin_amdgcn_mfma_f32_32x32x16_bf16(k2, w2, u[0][1], 0, 0, 0); u[0][1] = __builtin_amdgcn_mfma_f32_32x32x16_bf16(k3, w3, u[0][1], 0, 0, 0);
          frags4<1>(vbK, k0, k1, k2, k3);
          u[1][0] = __builtin_amdgcn_mfma_f32_32x32x16_bf16(k0, v0, u[1][0], 0, 0, 0); u[1][0] = __builtin_amdgcn_mfma_f32_32x32x16_bf16(k1, v1, u[1][0], 0, 0, 0);
          u[1][0] = __builtin_amdgcn_mfma_f32_32x32x16_bf16(k2, v2, u[1][0], 0, 0, 0); u[1][0] = __builtin_amdgcn_mfma_f32_32x32x16_bf16(k3, v3, u[1][0], 0, 0, 0);
          u[1][1] = __builtin_amdgcn_mfma_f32_32x32x16_bf16(k0, w0, u[1][1], 0, 0, 0); u[1][1] = __builtin_amdgcn_mfma_f32_32x32x16_bf16(k1, w1, u[1][1], 0, 0, 0);
          u[1][1] = __builtin_amdgcn_mfma_f32_32x32x16_bf16(k2, w2, u[1][1], 0, 0, 0); u[1][1] = __builtin_amdgcn_mfma_f32_32x32x16_bf16(k3, w3, u[1][1], 0, 0, 0); }
        float* U = (float*)(p.ws + OFF_UA) + ((size_t)chain * 36 + c) * 4096;
#pragma unroll
        for (int kb = 0; kb < 2; ++kb)
#pragma unroll
            for (int d0 = 0; d0 < 2; ++d0)
#pragma unroll
                for (int r = 0; r < 16; ++r) U[(32 * kb + crow(r, hi)) * 64 + 32 * d0 + r32] = u[kb][d0][r];
    }
}
DEV void scanA_out(const Params& p, int layer, char* Lw, int bh, int tc, int lane) {
    using namespace scn;
    asm volatile("" : "+v"(lane));
    const int r32 = lane & 31, hi = lane >> 5, b = bh >> 2, h = bh & 3;
    const bf16_t* base = (const bf16_t*)(p.ws + OFF_PB) + (size_t)(b * SL + 64 * tc) * DP;
    unsigned lo = (unsigned)(r32 * DP + 8 * hi) * 2u;
    asm volatile("" : "+v"(lo));
    char* imgV = Lw; char* imgS = Lw + 8192;
    const int vbV = (int)(uintptr_t)imgV + att::v_rd_base(lane), vbS = vbV + 8192;
    stage64b(imgV, base + O_AI + h * 64, DP, lane);
    f32x16 o[2][2] = {};
#pragma unroll 1
    for (int dir = 0; dir < 2; ++dir) {
        const int chain = bh * 2 + dir, c = dir == 0 ? tc : (tc < 4 ? 3 - tc : 39 - tc);
        const float* S0g = (const float*)(p.ws + OFF_SA) + ((size_t)chain * 36 + c) * 4096;
        f32x16 pd0 = {}, pd1 = {}, px = {};
#define MM(acc, A, B) acc = __builtin_amdgcn_mfma_f32_32x32x16_bf16(A, B, acc, 0, 0, 0)
#define LOADX(ks) do { _Pragma("unroll") for (int tb = 0; tb < 2; ++tb) ld8(base + (dir ? O_AFB : O_AFF) + h * 64 + 16 * (ks), lo + tb * (32u * DP * 2u), xr[tb]); } while (0)
#define LOADQ(ks) do { _Pragma("unroll") for (int tb = 0; tb < 2; ++tb) ld8(base + O_AQ + h * 64 + 16 * (ks), lo + tb * (32u * DP * 2u), qr[tb]); } while (0)
        float xr[2][8], qr[2][8];
#define KSTEP(ks) do { \
            const int ch = 16 * (ks) + 8 * hi; \
            float cum[2][8], kk[2][8], ref[8], lb[8]; \
            { const float* l = (const float*)(p.ws + OFF_LB) + (layer * 2 + dir) * 256 + h * 64 + ch; _Pragma("unroll") for (int j = 0; j < 8; ++j) lb[j] = l[j]; } \
            const int ci = lane >> 2; const int row = 16 * (ks) + ci, c16 = (lane & 3) * 16; const float* sp = S0g + row * 64 + c16; \
            LOADX(ks); LOADQ(ks); decay_ks(xr, lb, dir, lane, cum, kk, ref); \
            const float4 sa = *(const float4*)sp, sb4 = *(const float4*)(sp + 4), sc4 = *(const float4*)(sp + 8), sd4 = *(const float4*)(sp + 12); \
              \
            { const int sj = ci & 7, sl = (ci >> 3) * 32; float rv = 0.f; \
              _Pragma("unroll") for (int j = 0; j < 8; ++j) { const float t = bperm(ref[j], sl); rv = (sj == j) ? t : rv; } \
              const float er = __expf(fmaxf(rv, -80.f)); \
              u32x4 w0 = {cvt_pk_bf16(sa.x * er, sa.y * er), cvt_pk_bf16(sa.z * er, sa.w * er), cvt_pk_bf16(sb4.x * er, sb4.y * er), cvt_pk_bf16(sb4.z * er, sb4.w * er)}; \
              u32x4 w1 = {cvt_pk_bf16(sc4.x * er, sc4.y * er), cvt_pk_bf16(sc4.z * er, sc4.w * er), cvt_pk_bf16(sd4.x * er, sd4.y * er), cvt_pk_bf16(sd4.z * er, sd4.w * er)}; \
              *(u32x4*)(imgS + v_st64(row, c16)) = w0; *(u32x4*)(imgS + v_st64(row, c16 + 8)) = w1; } \
            bf16x8 qt0, qt1, kt0, kt1; \
            _Pragma("unroll") for (int tb = 0; tb < 2; ++tb) { \
                float t1[8], t2[8]; \
                _Pragma("unroll") for (int j = 0; j < 8; ++j) { const float q = qr[tb][j] * fsig(qr[tb][j]); t1[j] = q * fexp(cum[tb][j] - ref[j]); t2[j] = kk[tb][j] * fexp(ref[j] - cum[tb][j]); } \
                if (tb == 0) { qt0 = pack8(t1); kt0 = pack8(t2); } else { qt1 = pack8(t1); kt1 = pack8(t2); } } \
            MM(pd0, kt0, qt0); MM(pd1, kt1, qt1); if (dir == 0) MM(px, kt0, qt1); else MM(px, kt1, qt0); \
            { const s16x4 l0 = att::tr_read<v_rd_off64(0, ks, 0)>(vbS), h0 = att::tr_read<v_rd_off64(0, ks, 1)>(vbS), l1 = att::tr_read<v_rd_off64(1, ks, 0)>(vbS), h1 = att::tr_read<v_rd_off64(1, ks, 1)>(vbS); \
              asm volatile("s_waitcnt lgkmcnt(0)" ::: "memory"); SBAR(); \
              const bf16x8 s0 = SCN_PK(l0, h0), s1 = SCN_PK(l1, h1); \
              MM(o[0][0], qt0, s0); MM(o[1][0], qt1, s0); MM(o[0][1], qt0, s1); MM(o[1][1], qt1, s1); } \
            SBAR(); } while (0)
        KSTEP(0); KSTEP(1); KSTEP(2); KSTEP(3);
#undef KSTEP
#undef LOADX
#undef LOADQ
        const int r32m = r32;
#pragma unroll
        for (int r = 0; r < 16; ++r) { const int sl = crow(r, hi); const bool keep = dir == 0 ? (sl <= r32m) : (sl >= r32m); pd0[r] = keep ? pd0[r] : 0.f; pd1[r] = keep ? pd1[r] : 0.f; }
        bf16x8 a0, a1, b0, b1, c0, c1;
#define PK4(P, BASE, OUT) do { unsigned a0_ = cvt_pk_bf16(P[BASE + 0], P[BASE + 1]), a1_ = cvt_pk_bf16(P[BASE + 2], P[BASE + 3]);   \
    unsigned b0_ = cvt_pk_bf16(P[BASE + 4], P[BASE + 5]), b1_ = cvt_pk_bf16(P[BASE + 6], P[BASE + 7]);                              \
    auto r0_ = __builtin_amdgcn_permlane32_swap(a0_, b0_, false, false); auto r1_ = __builtin_amdgcn_permlane32_swap(a1_, b1_, false, false); \
    u32x4 w_ = {r0_[0], r1_[0], r0_[1], r1_[1]}; OUT = *reinterpret_cast<bf16x8*>(&w_); } while (0)
        PK4(pd0, 0, a0); PK4(pd0, 8, a1); PK4(pd1, 0, b0); PK4(pd1, 8, b1); PK4(px, 0, c0); PK4(px, 8, c1);
#undef PK4
        {   bf16x8 v0, v1, v2, v3;
#define BLOCK(D0) do { frags4<D0>(vbV, v0, v1, v2, v3); \
            if (dir == 0) { MM(o[0][D0], a0, v0); MM(o[0][D0], a1, v1); MM(o[1][D0], c0, v0); MM(o[1][D0], c1, v1); MM(o[1][D0], b0, v2); MM(o[1][D0], b1, v3); } \
            else          { MM(o[0][D0], a0, v0); MM(o[0][D0], a1, v1); MM(o[0][D0], c0, v2); MM(o[0][D0], c1, v3); MM(o[1][D0], b0, v2); MM(o[1][D0], b1, v3); } } while (0)
            BLOCK(0); BLOCK(1);
#undef BLOCK
        }
#undef MM
    }
    unsigned rob = (unsigned)(4 * hi * DP + r32) * 2u, mob = (unsigned)(4 * hi * D + r32) * 2u;
    asm volatile("" : "+v"(rob), "+v"(mob));
    float gv[2][16][2];
#pragma unroll
    for (int tb = 0; tb < 2; ++tb)
#pragma unroll
        for (int r = 0; r < 16; ++r) { const unsigned go = rob + (unsigned)(32 * tb + (r & 3) + 8 * (r >> 2)) * (DP * 2u); const bf16_t* gb = base + O_AG + h * 64;
            gv[tb][r][0] = ld1(gb, go); gv[tb][r][1] = ld1(gb, go + 64u); }
#pragma unroll
    for (int tb = 0; tb < 2; ++tb)
#pragma unroll
        for (int r = 0; r < 16; ++r) {
            const float x0 = o[tb][0][r], x1 = o[tb][1][r];
            float t = x0 * x0 + x1 * x1; t += bperm(t, lane ^ 1); t += bperm(t, lane ^ 2); t += bperm(t, lane ^ 4); t += bperm(t, lane ^ 8); t += bperm(t, lane ^ 16);
            const float ri = rsqrtf(t * (1.f / 64.f) + 1e-6f);
            const unsigned tcst = (unsigned)(32 * tb + (r & 3) + 8 * (r >> 2));
            const float g0 = gv[tb][r][0], g1 = gv[tb][r][1];
            char* mb = (char*)((bf16_t*)(p.ws + OFF_MIXB) + (size_t)(b * SL + 64 * tc) * D + h * 64); const unsigned mo = mob + tcst * (D * 2u);
            *(bf16_t*)(mb + mo) = (bf16_t)(cvt_pk_bf16(x0 * ri * p.hnorm[layer * 64 + r32] * (g0 * fsig(g0)), 0.f) & 0xffffu);
            *(bf16_t*)(mb + mo + 64u) = (bf16_t)(cvt_pk_bf16(x1 * ri * p.hnorm[layer * 64 + 32 + r32] * (g1 * fsig(g1)), 0.f) & 0xffffu);
        }
}

namespace scn {
DEV float logsig_f(float g) { return fminf(g, 0.f) - __logf(1.f + __expf(-fabsf(g))); }
DEV void gates_B(const bf16_t* gb  , unsigned rowoff, int dir, float bi, float bf, int lane, float (&cumf)[2], float (&g)[2], float (&G)[2], float& cend, float& gmax) {
    float lf[2], li[2];
#pragma unroll
    for (int tb = 0; tb < 2; ++tb) { const unsigned bo = rowoff + tb * (32u * DP * 2u); li[tb] = ld1(gb + (dir * 2 + 0) * 4, bo) + bi; lf[tb] = logsig_f(ld1(gb + (dir * 2 + 1) * 4, bo) + bf); }
    { const float i0 = scan_inc32(lf[0]), i1 = scan_inc32(lf[1]), t0 = bperm(i0, lane | 31), t1 = bperm(i1, lane | 31);
      if (dir == 0) { cumf[0] = i0; cumf[1] = i1 + t0; } else { cumf[1] = t1 - i1 + lf[1]; cumf[0] = t0 - i0 + lf[0] + t1; }
      cend = t0 + t1; }
    g[0] = li[0] - cumf[0]; g[1] = li[1] - cumf[1];
    if (dir == 0) { const float a0 = scanmax_inc32(g[0]), m0 = bperm(a0, lane | 31), a1 = fmaxf(scanmax_inc32(g[1]), m0); G[0] = a0; G[1] = a1; gmax = bperm(a1, lane | 31); }
    else { const float a1 = scanmax_suf32(g[1], lane), m1 = bperm(a1, lane & 32), a0 = fmaxf(scanmax_suf32(g[0], lane), m1); G[0] = a0; G[1] = a1; gmax = bperm(a0, lane & 32); }
}
}
DEV void scanB_local(const Params& p, int layer, char* Lw, int bh, int tc, int lane) {
    using namespace scn;
    asm volatile("" : "+v"(lane));
    const int r32 = lane & 31, hi = lane >> 5, b = bh >> 2, h = bh & 3;
    const bf16_t* base = (const bf16_t*)(p.ws + OFF_PB) + (size_t)(b * SL + 64 * tc) * DP;
    unsigned ro = (unsigned)(r32 * DP) * 2u; asm volatile("" : "+v"(ro));
    char* imgV = Lw; char* imgK = Lw + 8192;
    const int vbV = (int)(uintptr_t)imgV + att::v_rd_base(lane), vbK = vbV + 8192;
    stage64b(imgV, base + O_BV + h * 64, DP, lane);
#pragma unroll 1
    for (int dir = 0; dir < 2; ++dir) {
        const int chain = bh * 2 + dir, c = dir == 0 ? tc : (tc < 4 ? 3 - tc : 39 - tc);
        const float bi = p.mgb[layer * 16 + (dir * 2 + 0) * 4 + h], bf = p.mgb[layer * 16 + (dir * 2 + 1) * 4 + h];
        float cumf[2], g[2], G[2], cend, gmax;
        gates_B(base + O_BG + h, ro, dir, bi, bf, lane, cumf, g, G, cend, gmax);
        const float w[2] = {__expf(g[0] - gmax), __expf(g[1] - gmax)};
#pragma unroll
        for (int ks = 0; ks < 2; ++ks) {
            float un[8];
#pragma unroll
            for (int j = 0; j < 8; ++j) un[j] = 0.f;
#pragma unroll
            for (int tb = 0; tb < 2; ++tb) { float wk[8]; ld8(base + O_BK + h * 32 + 16 * ks, ro + 16u * hi + tb * (32u * DP * 2u), wk);
#pragma unroll
                for (int j = 0; j < 8; ++j) { wk[j] *= w[tb]; un[j] += wk[j]; }
                *(bf16x8*)(imgK + v_st64(32 * tb + r32, 16 * ks + 8 * hi)) = pack8(wk); }
#pragma unroll
            for (int j = 0; j < 8; ++j) { float t = un[j]; t += bperm(t, lane ^ 1); t += bperm(t, lane ^ 2); t += bperm(t, lane ^ 4); t += bperm(t, lane ^ 8); t += bperm(t, lane ^ 16);
                if (r32 == 0) ((float*)(p.ws + OFF_NB))[(chain * 36 + c) * 32 + 16 * ks + 8 * hi + j] = t; }
        }
        f32x16 u0 = {}, u1 = {};
        { bf16x8 k0, k1, k2, k3, v0, v1, v2, v3;
#define MM(acc, A, B) acc = __builtin_amdgcn_mfma_f32_32x32x16_bf16(A, B, acc, 0, 0, 0)
          frags4<0>(vbK, k0, k1, k2, k3); frags4<0>(vbV, v0, v1, v2, v3);
          MM(u0, k0, v0); MM(u0, k1, v1); MM(u0, k2, v2); MM(u0, k3, v3);
          frags4<1>(vbV, v0, v1, v2, v3);
          MM(u1, k0, v0); MM(u1, k1, v1); MM(u1, k2, v2); MM(u1, k3, v3);
#undef MM
        }
        float* U = (float*)(p.ws + OFF_UB) + ((size_t)chain * 36 + c) * 2048;
#pragma unroll
        for (int r = 0; r < 16; ++r) { U[crow(r, hi) * 64 + r32] = u0[r]; U[crow(r, hi) * 64 + 32 + r32] = u1[r]; }
        if (lane == 0) { float* M = (float*)(p.ws + OFF_MB) + (chain * 36 + c) * 4; M[0] = cend + gmax; M[1] = cend; }
    }
}
DEV void scanB_out(const Params& p, int layer, char* Lw, int bh, int tc, int lane) {
    using namespace scn;
    asm volatile("" : "+v"(lane));
    const int r32 = lane & 31, hi = lane >> 5, b = bh >> 2, h = bh & 3;
    const bf16_t* base = (const bf16_t*)(p.ws + OFF_PB) + (size_t)(b * SL + 64 * tc) * DP;
    unsigned ro = (unsigned)(r32 * DP) * 2u; asm volatile("" : "+v"(ro));
    char* imgV = Lw; char* imgC = Lw + 8192; float* gA = (float*)(Lw + 12288); float* dA = gA + 64;
    const int vbV = (int)(uintptr_t)imgV + att::v_rd_base(lane), vbC = vbV + 8192;
    stage64b(imgV, base + O_BV + h * 64, DP, lane);
#pragma unroll 1
    for (int dir = 0; dir < 2; ++dir) {
        const int chain = bh * 2 + dir, c = dir == 0 ? tc : (tc < 4 ? 3 - tc : 39 - tc);
        const float bi = p.mgb[layer * 16 + (dir * 2 + 0) * 4 + h], bf = p.mgb[layer * 16 + (dir * 2 + 1) * 4 + h];
        { const float* cg = (const float*)(p.ws + OFF_SB) + ((size_t)chain * 36 + c) * 2048 + (lane >> 1) * 64 + (lane & 1) * 32;
#pragma unroll
          for (int i = 0; i < 4; ++i) { const float4 a = *(const float4*)(cg + 8 * i), bq = *(const float4*)(cg + 8 * i + 4);
              u32x4 w = {cvt_pk_bf16(a.x, a.y), cvt_pk_bf16(a.z, a.w), cvt_pk_bf16(bq.x, bq.y), cvt_pk_bf16(bq.z, bq.w)};
              *(u32x4*)(imgC + v_st64(lane >> 1, (lane & 1) * 32 + 8 * i)) = w; } }
        const float m0 = ((const float*)(p.ws + OFF_MB))[(chain * 36 + c) * 4 + 2];
        float rq[2][2][8], rk[2][2][8];
#pragma unroll
        for (int ks = 0; ks < 2; ++ks)
#pragma unroll
            for (int tb = 0; tb < 2; ++tb) { const unsigned bo = ro + 16u * hi + tb * (32u * DP * 2u);
                ld8(base + O_BQ + h * 32 + 16 * ks, bo, rq[ks][tb]); ld8(base + O_BK + h * 32 + 16 * ks, bo, rk[ks][tb]); }
        float cumf[2], g[2], G[2], cend, gmax;
        gates_B(base + O_BG + h, ro, dir, bi, bf, lane, cumf, g, G, cend, gmax);
        float wi[2], wl[2], emt[2];
#pragma unroll
        for (int tb = 0; tb < 2; ++tb) { const float ml = cumf[tb] + G[tb], mt = fmaxf(cumf[tb] + m0, ml); wi[tb] = __expf(cumf[tb] + m0 - mt); wl[tb] = __expf(ml - mt); emt[tb] = __expf(-mt); }
        if (hi == 0) { gA[r32] = g[0]; gA[32 + r32] = g[1]; }
        f32x16 pd0 = {}, pd1 = {}, px = {};
        float qn[2] = {0.f, 0.f};
        bf16x8 qw[2][2];
#define MM(acc, A, B) acc = __builtin_amdgcn_mfma_f32_32x32x16_bf16(A, B, acc, 0, 0, 0)
#define KSTEP(ks) do { \
            bf16x8 qs0, qs1, kt0, kt1; \
            const float* nn = (const float*)(p.ws + OFF_N0) + (chain * 36 + c) * 32 + 16 * (ks) + 8 * hi; \
            _Pragma("unroll") for (int tb = 0; tb < 2; ++tb) { \
                float q8[8], k8[8], qv[8]; \
                _Pragma("unroll") for (int j = 0; j < 8; ++j) { q8[j] = rq[ks][tb][j] * 0.17677669529663687f; k8[j] = rk[ks][tb][j]; qn[tb] += q8[j] * nn[j]; qv[j] = q8[j] * wi[tb]; } \
                qw[tb][ks] = pack8(qv); \
                if (tb == 0) { qs0 = pack8(q8); kt0 = pack8(k8); } else { qs1 = pack8(q8); kt1 = pack8(k8); } } \
            MM(pd0, kt0, qs0); MM(pd1, kt1, qs1); if (dir == 0) MM(px, kt0, qs1); else MM(px, kt1, qs0); \
            SBAR(); } while (0)
        KSTEP(0); KSTEP(1);
#undef KSTEP
        qn[0] += bperm(qn[0], lane ^ 32); qn[1] += bperm(qn[1], lane ^ 32);
        float ds[2] = {0.f, 0.f};
#pragma unroll
        for (int r = 0; r < 16; ++r) {
            const int sl = crow(r, hi); const bool keep = dir == 0 ? (sl <= r32) : (sl >= r32);
            const float g0 = gA[sl], g1 = gA[32 + sl];
            const float e00 = keep ? __expf(g0 - G[0]) * wl[0] : 0.f, e11 = keep ? __expf(g1 - G[1]) * wl[1] : 0.f;
            const float ex = dir == 0 ? __expf(g0 - G[1]) * wl[1] : __expf(g1 - G[0]) * wl[0];
            pd0[r] *= e00; pd1[r] *= e11; px[r] *= ex;
            if (dir == 0) { ds[0] += pd0[r]; ds[1] += pd1[r] + px[r]; } else { ds[0] += pd0[r] + px[r]; ds[1] += pd1[r]; }
        }
        ds[0] += bperm(ds[0], lane ^ 32); ds[1] += bperm(ds[1], lane ^ 32);
#pragma unroll
        for (int tb = 0; tb < 2; ++tb) { const float den = wi[tb] * qn[tb] + ds[tb]; const float di = __builtin_amdgcn_rcpf(fmaxf(fabsf(den), emt[tb])); if (hi == 0) dA[32 * tb + r32] = di; }
        bf16x8 a0, a1, b0, b1, c0, c1;
#define PK4(P, BASE, OUT) do { unsigned a0_ = cvt_pk_bf16(P[BASE + 0], P[BASE + 1]), a1_ = cvt_pk_bf16(P[BASE + 2], P[BASE + 3]);   \
    unsigned b0_ = cvt_pk_bf16(P[BASE + 4], P[BASE + 5]), b1_ = cvt_pk_bf16(P[BASE + 6], P[BASE + 7]);                              \
    auto r0_ = __builtin_amdgcn_permlane32_swap(a0_, b0_, false, false); auto r1_ = __builtin_amdgcn_permlane32_swap(a1_, b1_, false, false); \
    u32x4 w_ = {r0_[0], r1_[0], r0_[1], r1_[1]}; OUT = *reinterpret_cast<bf16x8*>(&w_); } while (0)
        PK4(pd0, 0, a0); PK4(pd0, 8, a1); PK4(pd1, 0, b0); PK4(pd1, 8, b1); PK4(px, 0, c0); PK4(px, 8, c1);
#undef PK4
        SBAR();
        f32x16 o[2][2] = {};
        {   bf16x8 v0, v1, v2, v3;
#define BLOCK(D0) do { frags4<D0>(vbV, v0, v1, v2, v3); \
            if (dir == 0) { MM(o[0][D0], a0, v0); MM(o[0][D0], a1, v1); MM(o[1][D0], c0, v0); MM(o[1][D0], c1, v1); MM(o[1][D0], b0, v2); MM(o[1][D0], b1, v3); } \
            else          { MM(o[0][D0], a0, v0); MM(o[0][D0], a1, v1); MM(o[0][D0], c0, v2); MM(o[0][D0], c1, v3); MM(o[1][D0], b0, v2); MM(o[1][D0], b1, v3); } \
            { const s16x4 l0 = att::tr_read<v_rd_off64(D0, 0, 0)>(vbC), h0 = att::tr_read<v_rd_off64(D0, 0, 1)>(vbC), l1 = att::tr_read<v_rd_off64(D0, 1, 0)>(vbC), h1 = att::tr_read<v_rd_off64(D0, 1, 1)>(vbC); \
              asm volatile("s_waitcnt lgkmcnt(0)" ::: "memory"); SBAR(); \
              const bf16x8 s0 = SCN_PK(l0, h0), s1 = SCN_PK(l1, h1); \
              MM(o[0][D0], qw[0][0], s0); MM(o[0][D0], qw[0][1], s1); MM(o[1][D0], qw[1][0], s0); MM(o[1][D0], qw[1][1], s1); } } while (0)
            BLOCK(0); BLOCK(1);
#undef BLOCK
        }
#undef MM
        asm volatile("s_waitcnt lgkmcnt(0)" ::: "memory");
        unsigned rob = (unsigned)(4 * hi * DP + r32) * 2u, mob = (unsigned)(4 * hi * D + r32) * 2u, hob = (unsigned)(4 * hi * 256 + r32) * 4u;
        asm volatile("" : "+v"(rob), "+v"(mob), "+v"(hob));
        float* hpk = (float*)(p.ws + OFF_HB2) + (size_t)(b * SL + 64 * tc) * 256 + h * 64;
        if (dir == 0) {
#pragma unroll
            for (int tb = 0; tb < 2; ++tb)
#pragma unroll
                for (int r = 0; r < 16; ++r) { const float di = dA[32 * tb + crow(r, hi)]; const unsigned ho = hob + (unsigned)(32 * tb + (r & 3) + 8 * (r >> 2)) * 1024u;
                    *(float*)((char*)hpk + ho) = o[tb][0][r] * di; *(float*)((char*)hpk + ho + 128u) = o[tb][1][r] * di; }
            asm volatile("s_waitcnt vmcnt(0)" ::: "memory");
        } else {
#pragma unroll
            for (int tb = 0; tb < 2; ++tb)
#pragma unroll
                for (int r = 0; r < 16; ++r) {
                    const unsigned tcst = (unsigned)(32 * tb + (r & 3) + 8 * (r >> 2)); const unsigned ho = hob + tcst * 1024u;
                    const float di = dA[32 * tb + crow(r, hi)];
                    const float x0 = o[tb][0][r] * di + ldg1(hpk, ho), x1 = o[tb][1][r] * di + ldg1(hpk, ho + 128u);
                    float t = x0 * x0 + x1 * x1; t += bperm(t, lane ^ 1); t += bperm(t, lane ^ 2); t += bperm(t, lane ^ 4); t += bperm(t, lane ^ 8); t += bperm(t, lane ^ 16);
                    const float ri = rsqrtf(t * (1.f / 64.f) + 1e-6f);
                    const bf16_t* gb = base + O_BO + h * 64; const unsigned go = rob + tcst * (DP * 2u);
                    const float g0 = ld1(gb, go), g1 = ld1(gb, go + 64u);
                    char* mb = (char*)((bf16_t*)(p.ws + OFF_MIXB) + (size_t)(b * SL + 64 * tc) * D + 256 + h * 64); const unsigned mo = mob + tcst * (D * 2u);
                    *(bf16_t*)(mb + mo) = (bf16_t)(cvt_pk_bf16(x0 * ri * p.mnorm[layer * 256 + h * 64 + r32] * fsig(g0), 0.f) & 0xffffu);
                    *(bf16_t*)(mb + mo + 64u) = (bf16_t)(cvt_pk_bf16(x1 * ri * p.mnorm[layer * 256 + h * 64 + 32 + r32] * fsig(g1), 0.f) & 0xffffu);
                    if ((r & 3) == 3) SBAR();
                }
        }
    }
}

DEV int scan_token(int dir, int step) { return dir == 0 ? step : (step < CTX ? CTX - 1 - step : SL + CTX - 1 - step); }
DEV float logsig(float g) { return fminf(g, 0.f) - log1pf(expf(-fabsf(g))); }
DEV void ph_scan_local(const Params& p, int layer, char* smem) {
    const int wid = p.wave_id;
    const int G = (int)gridDim.x, nw = G * 8, nun = (NT / 256) * (DP / 256), nleft = 4 * G < nun ? nun - 4 * G : 0, nfree = G - nleft > 0 ? G - nleft : G;
    for (int it = 0; it < 2; ++it) {
        int task;
        if (it == 0) task = (int)blockIdx.x * 8 + wid;
        else { if ((int)blockIdx.x >= nfree) break; task = nw + wid * nfree + (int)blockIdx.x; }
        if (task >= 2304) break;
        const int lane = lane_asm();
        if (task < 1152) scanA_local(p, layer, smem + wid * 16384, task / 36, task % 36, lane);
        else scanB_local(p, layer, smem + wid * 16384, (task - 1152) / 36, (task - 1152) % 36, lane);
    }
}
DEV void ph_scan_carry(const Params& p, char* smem) {
    const int tid = tid_of(p.wave_id);
    const int gt = (int)blockIdx.x * 512 + tid, nth = (int)gridDim.x * 512;
    for (int e = gt; e < 64 * 4096; e += nth) {
        const int chain = e >> 12, kv = e & 4095, k = kv >> 6;
        const float* U = (const float*)(p.ws + OFF_UA) + (size_t)chain * 36 * 4096 + kv; float* SO = (float*)(p.ws + OFF_SA) + (size_t)chain * 36 * 4096 + kv; const float* Dc = (const float*)(p.ws + OFF_DECA) + chain * 36 * 64 + k;
        float S = 0.f;
#pragma unroll 4
        for (int c = 0; c < 36; ++c) { const float u = U[(size_t)c * 4096], d = Dc[c * 64]; SO[(size_t)c * 4096] = S; S = d * S + u; }
    }
    for (int e = gt; e < 64 * 2048; e += nth) {
        const int chain = e >> 11, kv = e & 2047;
        const float* U = (const float*)(p.ws + OFF_UB) + (size_t)chain * 36 * 2048 + kv; float* SO = (float*)(p.ws + OFF_SB) + (size_t)chain * 36 * 2048 + kv; const float* M = (const float*)(p.ws + OFF_MB) + chain * 36 * 4;
        float Cc = 0.f, m = 0.f;
#pragma unroll 4
        for (int c = 0; c < 36; ++c) { const float mle = M[c * 4 + 0], ce = M[c * 4 + 1], u = U[(size_t)c * 2048]; SO[(size_t)c * 2048] = Cc;
            const float mn = fmaxf(ce + m, mle); Cc = expf(ce + m - mn) * Cc + expf(mle - mn) * u; m = mn; }
    }
    for (int e = gt; e < 64 * 32; e += nth) {
        const int chain = e >> 5, k = e & 31;
        const float* N = (const float*)(p.ws + OFF_NB) + chain * 36 * 32 + k; float* NO = (float*)(p.ws + OFF_N0) + chain * 36 * 32 + k; float* M = (float*)(p.ws + OFF_MB) + chain * 36 * 4;
        float nn = 0.f, m = 0.f;
        for (int c = 0; c < 36; ++c) { const float mle = M[c * 4 + 0], ce = M[c * 4 + 1], u = N[c * 32]; NO[c * 32] = nn; if (k == 0) M[c * 4 + 2] = m;
            const float mn = fmaxf(ce + m, mle); nn = expf(ce + m - mn) * nn + expf(mle - mn) * u; m = mn; }
    }
}
DEV void ph_scan_out(const Params& p, int layer, char* smem) {
    const int wid = p.wave_id;
    const int nw = (int)gridDim.x * 8, ntc = layer == 0 ? 36 : 32, tc0 = layer == 0 ? 0 : 4, half = 32 * ntc, total = 2 * half;
    for (int it = 0; it < 2 + (total - nw > 0 ? (total - nw) / (int)gridDim.x : 0); ++it) {
        int task;
        if (it == 0) task = (int)blockIdx.x * 8 + wid;
        else { if (wid != 0) break; task = nw + (it - 1) * (int)gridDim.x + (int)blockIdx.x; }
        if (task >= total) break;
        const int lane = lane_asm();
        const bool isB = task >= half; const int tt = isB ? task - half : task, bh = tt / ntc, tc = tc0 + tt % ntc;
        if (!isB) scanA_out(p, layer, smem + wid * 16384, bh, tc, lane);
        else scanB_out(p, layer, smem + wid * 16384, bh, tc, lane);
    }
}

DEV void ph_attn(const Params& p, int layer, char* smem) {
    const int wid = p.wave_id, js = wid & 1, qb = wid >> 1;
    const float lam = ((const float*)(p.ws + OFF_LAM))[layer], omli = 1.f - lam_init_of(layer);
    const bf16_t* KB = (const bf16_t*)(p.ws + OFF_KB); const bf16_t* VB = (const bf16_t*)(p.ws + OFF_VB);
    const bf16_t* QRB = (const bf16_t*)(p.ws + OFF_QRB); const bf16_t* Q0B = (const bf16_t*)(p.ws + OFF_Q0B);
    const int G = (int)gridDim.x, c = (int)blockIdx.x;
    const int nlat = 512, ntot = nlat + (layer == 0 ? 64 : 0);
    for (int i = 0;; ++i) {
        int bh, s0; bool isctx;
        if (G == 256) {
            const int xcd = c & 7, j = c >> 3;
            if (i < 2) { bh = xcd + 8 * (i * 2 + (j >> 4)); s0 = CTX + (j & 15) * 128; isctx = false; }
            else if (i == 2 && layer == 0 && j < 8) { bh = xcd + 8 * (j >> 1); s0 = (j & 1) * 128; isctx = true; }
            else break;
        } else {
            const int u = i * G + c; if (u >= ntot) break;
            if (u < nlat) { bh = u >> 4; s0 = CTX + (u & 15) * 128; isctx = false; } else { const int v = u - nlat; bh = v >> 1; s0 = (v & 1) * 128; isctx = true; }
        }
        const int lane = lane_asm(), tid = (wid << 6) | lane, r32 = lane & 31, hi = lane >> 5;
        const bf16_t* Kh = KB + (size_t)bh * SL * 128; const bf16_t* Vh = VB + (size_t)bh * SL * 128;
        const size_t qoff = ((size_t)bh * SL + s0 + qb * 32 + r32) * 128 + js * 64 + hi * 8;
        att::bf16x8 qr[4];
#pragma unroll
        for (int d0 = 0; d0 < 4; ++d0) qr[d0] = *(const att::bf16x8*)(Q0B + qoff + d0 * 16);
        float m_reg = -1e30f, l_reg = 0.f; att::f32x16 o[4] = {};
        att::attn_tiles(qr, Kh, Vh, CTX, smem, m_reg, l_reg, o, tid, js);
        if (!isctx) {
#pragma unroll
            for (int d0 = 0; d0 < 4; ++d0) qr[d0] = *(const att::bf16x8*)(QRB + qoff + d0 * 16);
            att::attn_tiles(qr, Kh + (size_t)CTX * 128, Vh + (size_t)CTX * 128, SEQ, smem, m_reg, l_reg, o, tid, js);
        }
        float* wsw = (float*)(smem + 2 * att::SHM_V + 2 * att::SHM_K) + wid * 64;
        __syncthreads();
        if (hi == 0) wsw[r32] = l_reg;
        asm volatile("s_waitcnt lgkmcnt(0)" ::: "memory");
        float rli[16];
#pragma unroll
        for (int r = 0; r < 16; ++r) rli[r] = __builtin_amdgcn_rcpf(wsw[att::crow(r, hi)]);
        float* X = (float*)smem + qb * 4096;
        if (js == 1) {
#pragma unroll
            for (int d0 = 0; d0 < 4; ++d0)
#pragma unroll
                for (int r = 0; r < 16; ++r) X[(d0 * 16 + r) * 64 + lane] = o[d0][r] * rli[r];
        }
        __syncthreads();
        if (js == 0) {
            const int b = bh >> 2, h = bh & 3;
            float ss[16];
#pragma unroll
            for (int r = 0; r < 16; ++r) ss[r] = 0.f;
#pragma unroll
            for (int d0 = 0; d0 < 4; ++d0)
#pragma unroll
                for (int r = 0; r < 16; ++r) { const float v = o[d0][r] * rli[r] - lam * X[(d0 * 16 + r) * 64 + lane]; o[d0][r] = v; ss[r] += v * v; }
#pragma unroll
            for (int r = 0; r < 16; ++r) { float t = ss[r]; t += __shfl_xor(t, 1); t += __shfl_xor(t, 2); t += __shfl_xor(t, 4); t += __shfl_xor(t, 8); t += __shfl_xor(t, 16);
                ss[r] = rsqrtf(t * (1.f / 128.f) + 1e-6f) * omli; }
            bf16_t* mix = (bf16_t*)(p.ws + OFF_MIXB) + (size_t)(b * SL + s0 + qb * 32) * D + 512 + h * 128 + r32;
#pragma unroll
            for (int d0 = 0; d0 < 4; ++d0) { const float g = p.dnorm[layer * 128 + d0 * 32 + r32];
#pragma unroll
                for (int r = 0; r < 16; ++r) mix[(size_t)att::crow(r, hi) * D + d0 * 32] = (bf16_t)(cvt_pk_bf16(o[d0][r] * ss[r] * g, 0.f) & 0xffffu); }
        }
        __syncthreads();
    }
}
DEV void ph_outproj(const Params& p, int layer, char* smem) {
    const int tidx = tid_of(p.wave_id);
    pg8::StaticOrder S; S.init(layer == 0 ? NT / 256 : NB * 8, D / 256, (int)gridDim.x, (int)blockIdx.x, layer == 0 ? 0 : 1, (const bf16_t*)(p.ws + OFF_WOUT) + (size_t)layer * D * D, D);
    pg8::EpiF32 E{(float*)(p.ws + OFF_MIXO), D};
    pg8::gemm_phase((LAS unsigned char*)smem, (const char*)(p.ws + OFF_MIXB), D, S, E, tid_of(p.wave_id));
}
DEV void ph_norm2(const Params& p, int layer, char* smem) {
    typedef float f32x16 __attribute__((ext_vector_type(16)));
    const int wid = p.wave_id, lane = lane_asm(), tidx = (wid << 6) | lane;
    constexpr int XP = 1028, RP = 24;
    float* xs = (float*)smem;
    float* red = (float*)smem;
    int* hist = (int*)(smem + 32 * XP * 4);
    const float* nr = p.norms + (size_t)layer * 4 * D;
    if (tidx < NE) hist[tidx] = 0;
    const int chunk = (NT + (int)gridDim.x - 1) / (int)gridDim.x, rbeg = (int)blockIdx.x * chunk, rend = min(NT, rbeg + chunk);
    float wreg[64];
    { const float* wb = p.rw + (size_t)layer * D * NE + (size_t)(wid * 128 + (lane >> 5)) * NE + (lane & 31);
#pragma unroll
      for (int ks = 0; ks < 64; ++ks) wreg[ks] = wb[(size_t)2 * ks * NE]; }
    for (int r0 = rbeg; r0 < rend; r0 += RP) {
        __syncthreads();
#pragma unroll 1
        for (int j = 0; j < 3; ++j) {
            const int lr = wid * 3 + j, r = r0 + lr;
            if (r >= rend) continue;
            const int b = r / SL, s = r % SL;
            if (layer != 0 && s < CTX) continue;
            const float* m = modrow(p, layer, b, s);
            float4 mo[4], xv[4], o[4]; row_load(((float*)(p.ws + OFF_MIXO)) + (size_t)r * D, mo, lane); row_load(((float*)(p.ws + OFF_X)) + (size_t)r * D, xv, lane);
            const float ri = row_rinv(mo);
#pragma unroll
            for (int i = 0; i < 4; ++i) { const int idx = i * 256 + lane * 4; const float4 g = *(const float4*)(nr + D + idx), gt = *(const float4*)(m + 2048 + idx);
                xv[i].x += gt.x * (mo[i].x * ri * g.x); xv[i].y += gt.y * (mo[i].y * ri * g.y); xv[i].z += gt.z * (mo[i].z * ri * g.z); xv[i].w += gt.w * (mo[i].w * ri * g.w); }
            row_store(((float*)(p.ws + OFF_XN)) + (size_t)r * D, xv, lane);
            row_modnorm(xv, nr + 2 * D, m + 3072, m + 4096, o, lane);
            row_store_bf16((bf16_t*)(p.ws + OFF_XNB) + (size_t)r * D, o, lane);
            row_store(xs + lr * XP, o, lane);
        }
        __syncthreads();
        f32x16 acc = {};
        { const float* xa = xs + (lane & 31) * XP + wid * 128 + (lane >> 5);
#pragma unroll
          for (int ks = 0; ks < 64; ++ks) acc = __builtin_amdgcn_mfma_f32_32x32x2f32(xa[2 * ks], wreg[ks], acc, 0, 0, 0); }
        __syncthreads();
#pragma unroll
        for (int rg = 0; rg < 16; ++rg) red[(wid * 32 + (rg & 3) + 8 * (rg >> 2) + 4 * (lane >> 5)) * 32 + (lane & 31)] = acc[rg];
        __syncthreads();
#pragma unroll 1
        for (int j = 0; j < 3; ++j) {
            const int lr = wid * 3 + j, r = r0 + lr;
            if (r >= rend) continue;
            const int s = r % SL;
            if (layer != 0 && s < CTX) continue;
            const int e = lane & 31;
            float logit = p.rb[layer * NE + e];
#pragma unroll
            for (int w = 0; w < 8; ++w) logit += red[(w * 32 + lr) * 32 + e];
            float tv[4]; int ti[4];
#pragma unroll
            for (int k = 0; k < 4; ++k) {
                float bv = logit; int bi = e;
                for (int o2 = 16; o2 >= 1; o2 >>= 1) { const float ov = __shfl_xor(bv, o2); const int oi = __shfl_xor(bi, o2); if (ov > bv || (ov == bv && oi < bi)) { bv = ov; bi = oi; } }
                tv[k] = bv; ti[k] = bi; if (e == bi) logit = -3.0e38f;
            }
            const float e0 = 1.f, e1 = expf(tv[1] - tv[0]), e2 = expf(tv[2] - tv[0]), e3 = expf(tv[3] - tv[0]), inv = 1.f / (e0 + e1 + e2 + e3);
            if (lane == 0) { *(float4*)(((float*)(p.ws + OFF_TOPW)) + (size_t)r * 4) = make_float4(e0 * inv, e1 * inv, e2 * inv, e3 * inv); *(int4*)(((int*)(p.ws + OFF_TOPI)) + (size_t)r * 4) = make_int4(ti[0], ti[1], ti[2], ti[3]); }
            if (lane < 4) atomicAdd(&hist[lane == 0 ? ti[0] : lane == 1 ? ti[1] : lane == 2 ? ti[2] : ti[3]], 1);
        }
    }
    __syncthreads();
    if (tidx < NE) ((int*)(p.ws + OFF_BC))[(size_t)blockIdx.x * NE + tidx] = hist[tidx];
}
DEV void ph_route(const Params& p, int layer, char* smem) {
    const int tidx = tid_of(p.wave_id);
    int* part = (int*)smem;
    int* off = part + 1024;
    const int G = (int)gridDim.x, bid = (int)blockIdx.x;
    const int* BC = (const int*)(p.ws + OFF_BC);
    { const int e = tidx & 31, sl = tidx >> 5; int before = 0, tot = 0;
      for (int bb = sl; bb < G; bb += 16) { const int c = BC[(size_t)bb * NE + e]; tot += c; if (bb < bid) before += c; }
      part[(sl * 2 + 0) * 32 + e] = before; part[(sl * 2 + 1) * 32 + e] = tot; }
    __syncthreads();
    if (tidx < NE) { int before = 0, tot = 0; for (int sl = 0; sl < 16; ++sl) { before += part[(sl * 2 + 0) * 32 + tidx]; tot += part[(sl * 2 + 1) * 32 + tidx]; }
        off[tidx] = before; if (bid == 0) ((int*)(p.ws + OFF_CNT))[tidx] = tot; }
    __syncthreads();
    if (tidx < 64) {
        const int lane = tidx;
        const int chunk = (NT + G - 1) / G, rbeg = bid * chunk, rend = min(NT, rbeg + chunk);
        for (int q0 = rbeg * 4; q0 < rend * 4; q0 += 64) {
            const int pair = q0 + lane, r = pair >> 2, s = r % SL;
            const bool act = pair < rend * 4 && (layer == 0 || s >= CTX);
            const int my = act ? ((const int*)(p.ws + OFF_TOPI))[pair] : -1;
            for (int e = 0; e < NE; ++e) {
                const unsigned long long bal = __ballot(my == e);
                if (bal) { const int base = off[e];
                    if (my == e) ((int*)(p.ws + OFF_LIST))[(size_t)e * LISTCAP + base + __popcll(bal & ((1ull << lane) - 1ull))] = pair;
                    __builtin_amdgcn_wave_barrier();
                    if (lane == 0) off[e] = base + __popcll(bal);
                    __builtin_amdgcn_wave_barrier(); }
            }
        }
    }
}
DEV int moe_rt(int i, int G, int c, int npn, int& pn) {
    if (G == 256) { const int xcd = c & 7, j = c >> 3, rpx = 32 / npn; pn = j % npn; return (i * 8 + xcd) * rpx + j / npn; }
    const int L = i * G + c; pn = L % npn; return L / npn;
}
constexpr int MOE_LDS = 131072, MOE_MAXU = 12;
DEV void moe_prepare(const Params& p, char* smem, int npn, int mode) {
    const int tidx = tid_of(p.wave_id);
    LAS int* base = (LAS int*)(smem + MOE_LDS);
    LAS int *TE = base, *TT = base + 320, *NRT = base + 640, *CN = base + 656  , *UI = base + 704, *IDX = base + 768;
    if (tidx < NE) CN[tidx] = ((const int*)(p.ws + OFF_CNT))[tidx];
    __syncthreads();
    if (tidx < 320) { int e = 0, acc = 0; for (; e < NE; ++e) { const int n = (CN[e] + 255) >> 8; if (tidx < acc + n) break; acc += n; } TE[tidx] = e; TT[tidx] = tidx - acc; }
    if (tidx == 0) { int tot = 0; for (int e = 0; e < NE; ++e) tot += (CN[e] + 255) >> 8; NRT[0] = tot; }
    __syncthreads();
    const int nrt = NRT[0];
#pragma unroll
    for (int k = 0; k < (MOE_MAXU * 256) / 512; ++k) {
        const int idx = tidx + 512 * k, i = idx >> 8, row = idx & 255;
        int pn; const int rt = moe_rt(i, (int)gridDim.x, (int)blockIdx.x, npn, pn);
        if (rt < nrt) { const int e = TE[rt], t = TT[rt], c = CN[e], q = t * 256 + row;
            const int pair = ((const int*)(p.ws + OFF_LIST))[(size_t)e * LISTCAP + min(q, c - 1)];
            IDX[idx] = mode == 1 ? (pair >> 2) : (q < c ? pair : -1); }
    }
    if (tidx < MOE_MAXU) { int pn; const int rt = moe_rt(tidx, (int)gridDim.x, (int)blockIdx.x, npn, pn);
        if (rt < nrt) { const int e = TE[rt], t = TT[rt], c = CN[e]; int pre = 0; for (int z = 0; z < e; ++z) pre += CN[z]; UI[tidx * 4 + 0] = min(256, c - t * 256); UI[tidx * 4 + 1] = pre + t * 256; } }
    __syncthreads();
}
struct MoeOrder {
    const LAS int *te, *ui, *idx; int nrt, npn, G, c, gather; const char* Bt; size_t bstride; int K;
    DEV bool next(int i, pg8::Unit& u) const { int pn; const int rt = moe_rt(i, G, c, npn, pn); if (rt >= nrt || i >= MOE_MAXU) return false;
        u.pm = rt; u.pn = pn; u.e = __builtin_amdgcn_readfirstlane(te[rt]); u.t = i; return true; }
    DEV int arow(const pg8::Unit& u, int rr) const { return gather ? idx[u.t * 256 + rr] : ui[u.t * 4 + 1] + rr; }
    DEV const char* bbase(const pg8::Unit& u) const { return Bt + (size_t)u.e * bstride + (size_t)u.pn * pg8::BM * K * 2; }
};
DEV float swiglu(float g, float l) { g = fminf(g, 7.f); l = fminf(fmaxf(l, -7.f), 7.f); return g * __builtin_amdgcn_rcpf(1.f + __builtin_amdgcn_exp2f(-1.702f * 1.4426950408889634f * g)) * (l + 1.f); }
struct EpiSwiglu {
    static constexpr bool PERM = true;
    bf16_t* H; const float* b1; const LAS int* ui;
    DEV void operator()(const pg8::f32x4 (&acc)[2][2][4][2], const pg8::Unit& u, int wr, int wc, int fr, int fq) const {
        const int ucnt = ui[u.t * 4 + 0], hrow0 = ui[u.t * 4 + 1], col0 = u.pn * 256 + wc * 32 + 8 * fq;
        const float* bb = b1 + (size_t)u.e * 2048 + col0;
        pg8::f32x4 bv[2][2];
#pragma unroll
        for (int bj = 0; bj < 2; ++bj)
#pragma unroll
            for (int n = 0; n < 2; ++n) bv[bj][n] = *(const pg8::f32x4*)(bb + bj * 128 + 4 * n);
#pragma unroll
        for (int ai = 0; ai < 2; ++ai)
#pragma unroll
            for (int m = 0; m < 4; ++m) { const int rr = ai * 128 + wr * 64 + m * 16 + fr;
                if (rr < ucnt) { bf16_t* rowp = H + (size_t)(hrow0 + rr) * DFF + (col0 >> 1);
#pragma unroll
                    for (int bj = 0; bj < 2; ++bj) { const pg8::f32x4 v0 = acc[ai][bj][m][0] + bv[bj][0], v1 = acc[ai][bj][m][1] + bv[bj][1];
                        pg8::u32x2 w; w.x = cvt_pk_bf16(swiglu(v0[0], v0[1]), swiglu(v0[2], v0[3])); w.y = cvt_pk_bf16(swiglu(v1[0], v1[1]), swiglu(v1[2], v1[3]));
                        *(pg8::u32x2*)(rowp + bj * 64) = w; } } }
    }
};
struct EpiY {
    static constexpr bool PERM = true;
    bf16_t* Y; const LAS int* idx;
    DEV void operator()(const pg8::f32x4 (&acc)[2][2][4][2], const pg8::Unit& u, int wr, int wc, int fr, int fq) const {
        const int col0 = u.pn * 256 + wc * 32 + 8 * fq;
#pragma unroll
        for (int ai = 0; ai < 2; ++ai)
#pragma unroll
            for (int m = 0; m < 4; ++m) { const int rr = ai * 128 + wr * 64 + m * 16 + fr; const int pair = idx[u.t * 256 + rr];
                if (pair >= 0) { bf16_t* rowp = Y + (size_t)pair * D + col0;
#pragma unroll
                    for (int bj = 0; bj < 2; ++bj) { const pg8::f32x4 v0 = acc[ai][bj][m][0], v1 = acc[ai][bj][m][1];
                        pg8::u32x4 w; w.x = cvt_pk_bf16(v0[0], v0[1]); w.y = cvt_pk_bf16(v0[2], v0[3]); w.z = cvt_pk_bf16(v1[0], v1[1]); w.w = cvt_pk_bf16(v1[2], v1[3]);
                        *(pg8::u32x4*)(rowp + bj * 128) = w; } } }
    }
};
DEV void ph_moe1(const Params& p, int layer, char* smem) {
    moe_prepare(p, smem, 8, 1);
    LAS int* base = (LAS int*)(smem + MOE_LDS);
    MoeOrder S{base, base + 704, base + 768, base[640], 8, (int)gridDim.x, (int)blockIdx.x, 1, (const char*)(p.ws + OFF_W1T) + (size_t)layer * NE * 2048 * D * 2, (size_t)2048 * D * 2, D};
    EpiSwiglu E{(bf16_t*)(p.ws + OFF_H), p.b1 + (size_t)layer * NE * 2048, base + 704};
    pg8::gemm_phase((LAS unsigned char*)smem, (const char*)(p.ws + OFF_XNB), D, S, E, tid_of(p.wave_id));
}
DEV void ph_moe2(const Params& p, int layer, char* smem) {
    moe_prepare(p, smem, 4, 2);
    LAS int* base = (LAS int*)(smem + MOE_LDS);
    MoeOrder S{base, base + 704, base + 768, base[640], 4, (int)gridDim.x, (int)blockIdx.x, 0, (const char*)(p.ws + OFF_W2T) + (size_t)layer * NE * D * DFF * 2, (size_t)D * DFF * 2, DFF};
    EpiY E{(bf16_t*)(p.ws + OFF_Y), base + 768};
    pg8::gemm_phase((LAS unsigned char*)smem, (const char*)(p.ws + OFF_H), DFF, S, E, tid_of(p.wave_id));
}
DEV void ph_combine(const Params& p, int layer, char* smem) {
    const int wid = p.wave_id, lane = lane_asm();
    const float* nr = p.norms + (size_t)layer * 4 * D;
    const int total = layer == 0 ? NT : NB * SEQ, stride = (int)gridDim.x * 8;
    for (int q0 = (int)blockIdx.x * 8 + wid; q0 < total; q0 += 2 * stride) {
        int rr[2]; bool ok[2]; float4 tw[2]; int4 ti[2];
#pragma unroll
        for (int u = 0; u < 2; ++u) { const int q = q0 + u * stride; ok[u] = q < total; const int qq = ok[u] ? q : q0;
            rr[u] = layer == 0 ? qq : (qq / SEQ) * SL + CTX + qq % SEQ;
            tw[u] = *(const float4*)(((float*)(p.ws + OFF_TOPW)) + (size_t)rr[u] * 4); ti[u] = *(const int4*)(((int*)(p.ws + OFF_TOPI)) + (size_t)rr[u] * 4); }
        float4 f[2][4], xv[2][4];
#pragma unroll
        for (int u = 0; u < 2; ++u) {
            const int r = rr[u];
            const float w[4] = {tw[u].x, tw[u].y, tw[u].z, tw[u].w}; const int ei[4] = {ti[u].x, ti[u].y, ti[u].z, ti[u].w};
#pragma unroll
            for (int i = 0; i < 4; ++i) f[u][i] = make_float4(0.f, 0.f, 0.f, 0.f);
#pragma unroll
            for (int k = 0; k < 4; ++k) {
                const bf16_t* y = (const bf16_t*)(p.ws + OFF_Y) + ((size_t)r * 4 + k) * D; const float* bb = p.b2 + ((size_t)layer * NE + ei[k]) * D;
#pragma unroll
                for (int i = 0; i < 4; ++i) { const int idx = i * 256 + lane * 4; const pg8::u32x2 yb = *(const pg8::u32x2*)(y + idx); const float4 bv = *(const float4*)(bb + idx);
                    const float y0 = __uint_as_float(yb.x << 16), y1 = __uint_as_float(yb.x & 0xffff0000u), y2 = __uint_as_float(yb.y << 16), y3 = __uint_as_float(yb.y & 0xffff0000u);
                    f[u][i].x += w[k] * (y0 + bv.x); f[u][i].y += w[k] * (y1 + bv.y); f[u][i].z += w[k] * (y2 + bv.z); f[u][i].w += w[k] * (y3 + bv.w); }
            }
            row_load(((float*)(p.ws + OFF_XN)) + (size_t)r * D, xv[u], lane);
        }
#pragma unroll
        for (int u = 0; u < 2; ++u) {
            const int r = rr[u], b = r / SL, s = r % SL;
            const float* m = modrow(p, layer, b, s);
            const float ri = row_rinv(f[u]);
#pragma unroll
            for (int i = 0; i < 4; ++i) { const int idx = i * 256 + lane * 4; const float4 g = *(const float4*)(nr + 3 * D + idx), gt = *(const float4*)(m + 5120 + idx);
                xv[u][i].x += gt.x * (f[u][i].x * ri * g.x); xv[u][i].y += gt.y * (f[u][i].y * ri * g.y); xv[u][i].z += gt.z * (f[u][i].z * ri * g.z); xv[u][i].w += gt.w * (f[u][i].w * ri * g.w); }
            if (ok[u]) {
                if (layer == 0) {
                    row_store(((float*)(p.ws + OFF_X)) + (size_t)r * D, xv[u], lane);
                    const float* m1 = modrow(p, 1, b, s); float4 o[4];
                    row_modnorm(xv[u], p.norms + (size_t)4 * D, m1 + 0, m1 + 1024, o, lane);
                    row_store_bf16((bf16_t*)(p.ws + OFF_XNB) + (size_t)r * D, o, lane);
                } else {
                    row_store(p.out + ((size_t)b * SEQ + (s - CTX)) * D, xv[u], lane);
                }
            }
        }
    }
}

template <int layer> DEV void run_layer(const Params& p, char* smem, const XcdBarrier& bar) {
#define GB() xcd_barrier(bar)

        ph_inproj(p, layer, smem, 0); GB();
        ph_inproj(p, layer, smem, 1); ph_scan_local(p, layer, smem); GB();
        ph_scan_carry(p, smem); ph_attn(p, layer, smem); GB();
        ph_scan_out(p, layer, smem); GB();
        ph_outproj(p, layer, smem); GB();
        ph_norm2(p, layer, smem); GB();
        ph_route(p, layer, smem); GB();
        ph_moe1(p, layer, smem); GB();
        ph_moe2(p, layer, smem); GB();
        ph_combine(p, layer, smem); GB();
    #undef GB
}
constexpr int LDS_BYTES = 147456;
__global__ __launch_bounds__(512, 2) void k_mega(Params p_in) {
    Params p = p_in; p.wave_id = __builtin_amdgcn_readfirstlane((int)(threadIdx.x >> 6));
    extern __shared__ __attribute__((aligned(16))) char smem[];
    volatile LAS unsigned* st = (volatile LAS unsigned*)(smem + LDS_BYTES - 16);
    if (threadIdx.x == 0) { st[0] = 0u; st[1] = 0u; st[2] = 0u; st[3] = 0u; }
    __syncthreads();
    const XcdBarrier bar = xcd_barrier_post(((unsigned*)(p.ws + OFF_bar)), st, p.wave_id);
#define GB() xcd_barrier(bar)
    ph_mods(p, smem); ph_convert(p, smem); GB();
    ph_init(p, smem); GB();
    run_layer<0>(p, smem, bar);
    run_layer<1>(p, smem, bar);
#undef GB
}
}

extern "C" void kernel_launch(void* const* d_in, const int* in_sizes, int n_in, void* d_out, int out_size, void* d_ws, size_t ws_size, hipStream_t stream) {
    static int grid = 0;
    if (grid == 0) {
        int dev = 0, cus = 0, per_cu = 0;
        if (hipGetDevice(&dev) != hipSuccess || hipDeviceGetAttribute(&cus, hipDeviceAttributeMultiprocessorCount, dev) != hipSuccess) { grid = -1; return; }
        if (hipFuncSetAttribute((const void*)k_mega, hipFuncAttributeMaxDynamicSharedMemorySize, LDS_BYTES) != hipSuccess) { grid = -1; return; }
        (void)hipOccupancyMaxActiveBlocksPerMultiprocessor(&per_cu, (const void*)k_mega, 512, LDS_BYTES);
        (void)hipGetLastError();
        grid = cus;
    }
    if (grid < 0) return;
    Params p{};
    const float** in = (const float**)&p;
    for (int i = 0; i < 21; ++i) in[i] = (const float*)d_in[i];
    p.out = (float*)d_out;
    p.ws = (char*)d_ws;
    if (WS_END > ws_size) return;
    if (hipMemsetAsync(p.ws + OFF_bar, 0, (size_t)CTL_BYTES, stream) != hipSuccess) return;
    hipLaunchKernelGGL(k_mega, dim3(grid), dim3(512), LDS_BYTES, stream, p);
}
```

```cpp
#include <hip/hip_runtime.h>
#include <stdint.h>

namespace {
constexpr int D = 1024, NB = 8, SEQ = 2048, CTX = 256, SL = 2304, NT = NB * SL;
constexpr int DP = 3840, DPW = 3600, NE = 32, DFF = 1024, NPAIR = NT * 4;
constexpr int O_AQ = 0, O_AI = 256, O_AFF = 512, O_AFB = 768, O_AG = 1024, O_BQ = 1280, O_BK = 1408, O_BV = 1536, O_BO = 1792, O_BG = 3584;
constexpr int LISTCAP = NT;

struct Params {
    const float *x, *c, *ctx, *c_ctx, *ada_w, *ada_b, *norms, *w_in, *w_out, *hlb, *hnorm, *mgb, *mnorm, *dlam, *dnorm, *rw, *rb, *w1, *b1, *w2, *b2;
    float* out;
    char* ws;
    int wave_id, pad_;
};
constexpr size_t al256(size_t x) { return (x + 255) & ~(size_t)255; }
constexpr size_t OFF_bar = 0;
constexpr size_t OFF_MOD = OFF_bar + 16384;
constexpr int CW_QHEAD = 3520, CTL_BYTES = 16384;
constexpr size_t OFF_LB = OFF_MOD + al256((size_t)2 * 9 * 6144 * 4);
constexpr size_t OFF_LAM = OFF_LB + al256(1024 * 4);
constexpr size_t OFF_CNT = OFF_LAM + 256;
constexpr size_t OFF_BC = OFF_CNT + 256;
constexpr size_t OFF_TOPW = OFF_BC + al256((size_t)1024 * NE * 4);
constexpr size_t OFF_TOPI = OFF_TOPW + al256((size_t)NPAIR * 4);
constexpr size_t OFF_LIST = OFF_TOPI + al256((size_t)NPAIR * 4);
constexpr size_t OFF_X = OFF_LIST + al256((size_t)NE * LISTCAP * 4);
constexpr size_t OFF_XN = OFF_X + al256((size_t)NT * D * 4);
constexpr size_t OFF_P = OFF_XN + al256((size_t)NT * D * 4);
constexpr size_t OFF_QR = OFF_P + al256((size_t)NT * DP * 4);
constexpr size_t OFF_KT = OFF_QR + al256((size_t)64 * SL * 64 * 4);
constexpr size_t OFF_OC = OFF_KT + al256((size_t)64 * SL * 64 * 4);
constexpr size_t OFF_MIX = OFF_OC + al256((size_t)32 * SL * 128 * 4);
constexpr size_t OFF_MIXO = OFF_MIX + al256((size_t)NT * D * 4);
constexpr size_t OFF_XNB = OFF_MIXO + al256((size_t)NT * D * 4);
constexpr size_t OFF_MIXB = OFF_XNB + al256((size_t)NT * D * 2);
constexpr size_t OFF_WIN = OFF_MIXB + al256((size_t)NT * D * 2);
constexpr size_t OFF_WOUT = OFF_WIN + al256((size_t)2 * DP * D * 2);
constexpr size_t OFF_W1T = OFF_WOUT + al256((size_t)2 * D * D * 2);
constexpr size_t OFF_W2T = OFF_W1T + al256((size_t)2 * NE * 2048 * D * 2);
constexpr size_t OFF_U = OFF_W2T + al256((size_t)2 * NE * D * DFF * 2);
constexpr size_t WS_END = OFF_U + al256((size_t)32 * SL * SL * 4);
constexpr size_t OFF_UA = OFF_U, OFF_DECA = OFF_UA + (size_t)64 * 36 * 4096 * 4, OFF_UB = OFF_DECA + (size_t)64 * 36 * 64 * 4, OFF_NB = OFF_UB + (size_t)64 * 36 * 2048 * 4,
                 OFF_MB = OFF_NB + (size_t)64 * 36 * 32 * 4, OFF_SCB = OFF_MB + (size_t)64 * 36 * 4 * 4,
                 OFF_OA2 = OFF_SCB + (size_t)2 * NT * 16 * 4, OFF_HB2 = OFF_OA2 + (size_t)NT * 256 * 4, OFF_SA = OFF_HB2 + (size_t)NT * 256 * 4, OFF_SB = OFF_SA + (size_t)64 * 36 * 4096 * 4,
                 OFF_N0 = OFF_SB + (size_t)64 * 36 * 2048 * 4;
constexpr size_t OFF_PB = OFF_P;
constexpr size_t OFF_ROPE = OFF_P + al256((size_t)NT * DP * 2);
constexpr size_t OFF_QRB = OFF_QR, OFF_Q0B = OFF_QR + (size_t)32 * SL * 128 * 2, OFF_KB = OFF_KT, OFF_VB = OFF_KT + (size_t)32 * SL * 128 * 2;
constexpr size_t OFF_S = OFF_U, OFF_H = OFF_U, OFF_Y = OFF_U + al256((size_t)(NPAIR + 256) * DFF * 2);
constexpr size_t OFF_OA = OFF_MIXO, OFF_HB = OFF_MIXO + (size_t)2 * NT * 256 * 4;


#define DEV __device__ __forceinline__
DEV int lane_asm() { int l; asm volatile("v_mbcnt_lo_u32_b32 %0, -1, 0\n\tv_mbcnt_hi_u32_b32 %0, -1, %0" : "=v"(l)); return l; }
DEV int tid_of(int wave_id) { return (wave_id << 6) | lane_asm(); }
DEV float wsum(float v) { for (int o = 32; o >= 1; o >>= 1) v += __shfl_xor(v, o); return v; }
DEV float wmaxf(float v) { for (int o = 32; o >= 1; o >>= 1) v = fmaxf(v, __shfl_xor(v, o)); return v; }
DEV float sigm(float x) { return 1.f / (1.f + expf(-x)); }
DEV float rdlane(float v, int l) { return __int_as_float(__builtin_amdgcn_readlane(__float_as_int(v), l)); }
DEV float lam_init_of(int layer) { return 0.8f - 0.6f * expf(-0.3f * (float)layer); }


#define XB_TMO      128
#define XB_XCNT(j)  (256  + 64 * (j))
#define XB_XSUB(j)  (1280 + 64 * (j))
#define XB_XGEN(j)  (2304 + 64 * (j))
#define XB_TOP      3328
#define XB_TOPGEN   3392
#define XCD_BAR_WORDS 3456
#define XB_SPIN_CAP (1u << 22)
#define LAS __attribute__((address_space(3)))
DEV unsigned xb_ld(unsigned* p)              { return __hip_atomic_load(p, __ATOMIC_RELAXED, __HIP_MEMORY_SCOPE_AGENT); }
DEV unsigned xb_add(unsigned* p, unsigned v) { return __hip_atomic_fetch_add(p, v, __ATOMIC_RELAXED, __HIP_MEMORY_SCOPE_AGENT); }
DEV unsigned xb_xcc_id() { return (unsigned)__builtin_amdgcn_s_getreg((3 << 11) | 20) & 0xFu; }
#define XB_SPIN(cond, bar) do { unsigned _sp = 0; while (cond) { __builtin_amdgcn_s_sleep(1); \
    if ((++_sp & 255u) == 0u) { if (xb_ld(&(bar)[XB_TMO])) break; if (_sp > XB_SPIN_CAP) { atomicAdd(&(bar)[XB_TMO], 1u); break; } } } } while (0)
struct XcdBarrier { unsigned* bar; unsigned x; volatile LAS unsigned* st; int wave; };
DEV bool xb_thread0(int wave) { return wave == 0 && lane_asm() == 0; }
DEV XcdBarrier xcd_barrier_post(unsigned* bar, volatile LAS unsigned* st, int wave) {
    XcdBarrier b; b.bar = bar; b.x = xb_xcc_id(); b.st = st; b.wave = wave;
    if (xb_thread0(wave)) (void)xb_add(&bar[XB_XCNT(b.x)], 1u);
    return b;
}
DEV void xcd_barrier_complete(unsigned* bar, unsigned x, unsigned& nloc, unsigned& nx) {
    const unsigned G = gridDim.x * gridDim.y * gridDim.z;
    unsigned sum, cnt, mine, sp = 0u;
    for (;;) {
        sum = 0u; cnt = 0u; mine = 0u;
#pragma unroll
        for (unsigned j = 0; j < 16; ++j) { const unsigned c = xb_ld(&bar[XB_XCNT(j)]); sum += c; cnt += (c > 0u) ? 1u : 0u; mine = (j == x) ? c : mine; }
        if (sum == G) break;
        __builtin_amdgcn_s_sleep(1);
        if ((++sp & 255u) == 0u) { if (xb_ld(&bar[XB_TMO])) break; if (sp > XB_SPIN_CAP) { atomicAdd(&bar[XB_TMO], 1u); break; } }
    }
    nloc = mine > 0u ? mine : 1u; nx = cnt > 0u ? cnt : 1u;
}
DEV void xcd_barrier(const XcdBarrier& b) {
    asm volatile("s_waitcnt vmcnt(0)" ::: "memory");
    __syncthreads();
    if (xb_thread0(b.wave)) {
        unsigned* bar = b.bar;
        __builtin_amdgcn_s_waitcnt(0);
        unsigned nloc = b.st[0], nx = b.st[1];
        if (nloc == 0u) { xcd_barrier_complete(bar, b.x, nloc, nx); b.st[0] = nloc; b.st[1] = nx; }
        const unsigned old = xb_add(&bar[XB_XSUB(b.x)], 1u);
        const unsigned gen = old / nloc;
        if (old + 1u == (gen + 1u) * nloc) {
            __builtin_amdgcn_fence(__ATOMIC_RELEASE, "agent");
            asm volatile("s_waitcnt vmcnt(0)" ::: "memory");
            const unsigned og = xb_add(&bar[XB_TOP], 1u);
            const unsigned tg = og / nx;
            if (og + 1u == (tg + 1u) * nx) xb_add(&bar[XB_TOPGEN], 1u);
            else XB_SPIN(xb_ld(&bar[XB_TOPGEN]) == tg, bar);
            __builtin_amdgcn_fence(__ATOMIC_ACQUIRE, "agent");
            xb_add(&bar[XB_XGEN(b.x)], 1u);
            asm volatile("s_waitcnt vmcnt(0)" ::: "memory");
        } else {
            XB_SPIN(xb_ld(&bar[XB_XGEN(b.x)]) == gen, bar);
            __builtin_amdgcn_fence(__ATOMIC_ACQUIRE, "agent");
            asm volatile("s_waitcnt vmcnt(0)" ::: "memory");
        }
    }
    __syncthreads();
}

typedef unsigned short bf16_t;
DEV unsigned cvt_pk_bf16(float lo, float hi) { unsigned r; asm volatile("v_cvt_pk_bf16_f32 %0, %1, %2" : "=v"(r) : "v"(lo), "v"(hi)); return r; }

namespace pg8 {
typedef short bf16x8 __attribute__((ext_vector_type(8)));
typedef float f32x4 __attribute__((ext_vector_type(4)));
typedef unsigned u32x4 __attribute__((ext_vector_type(4)));
typedef unsigned u32x2 __attribute__((ext_vector_type(2)));
constexpr int BM = 256, BK = 64, HALF = 128, HTB = HALF * BK * 2, STAGE_BYTES = 8 * HTB, NXCD = 8, WGM = 8;
DEV int lds_byte(int r, int c) { const int st = (r >> 4) * 2 + (c >> 5), rr = r & 15, cc = c & 31, ob = rr * 64 + cc * 2; return st * 1024 + (ob ^ (((ob >> 9) & 1) << 5)); }
DEV void stage_rc(int b, int& R, int& C) { const int st = b / 1024, sb = b % 1024, swz = sb ^ (((sb >> 9) & 1) << 5); R = (st >> 1) * 16 + swz / 64; C = (st & 1) * 32 + (swz % 64) / 2; }
DEV int perm32(int rho) { const int n = rho >> 4, i = rho & 15; return 8 * (i >> 2) + 4 * n + (i & 3); }
struct Unit { int pm, pn, e, t; };
struct StaticOrder {
    int nM, nN, nwg, G, c, skipctx; const char* Bt; int K;
    DEV void init(int nM_, int nN_, int G_, int c_, int skipctx_, const void* Bt_, int K_) { nM = nM_; nN = nN_; nwg = nM * nN; G = G_; c = c_; skipctx = skipctx_; Bt = (const char*)Bt_; K = K_; }
    DEV bool next(int i, Unit& u) const {
        const long L = (long)i * G + c; if (L >= nwg) return false;
        int wgid = (int)L; { const int q = nwg / NXCD, r = nwg % NXCD, xcd = wgid % NXCD, off = wgid / NXCD; wgid = (xcd < r ? xcd * (q + 1) : r * (q + 1) + (xcd - r) * q) + off; }
        const int nig = WGM * nN, gid = wgid / nig, fm = gid * WGM, gsz = (nM - fm) < WGM ? (nM - fm) : WGM;
        int pm = fm + ((wgid % nig) % gsz); u.pn = (wgid % nig) / gsz;
        if (skipctx) pm = (pm >> 3) * 9 + 1 + (pm & 7);
        u.pm = pm; u.e = 0; u.t = 0; return true;
    }
    DEV int arow(const Unit& u, int rr) const { return u.pm * BM + rr; }
    DEV const char* bbase(const Unit& u) const { return Bt + (size_t)u.pn * BM * K * 2; }
};
struct EpiF32 {
    static constexpr bool PERM = false;
    float* C; int ldc;
    DEV void operator()(const f32x4 (&acc)[2][2][4][2], const Unit& u, int wr, int wc, int fr, int fq) const {
        const int row0 = u.pm * BM + wr * 64 + fr, col0 = u.pn * BM + wc * 32 + 4 * fq;
#pragma unroll
        for (int ai = 0; ai < 2; ++ai)
#pragma unroll
            for (int m = 0; m < 4; ++m) { float* rowp = C + (size_t)(row0 + ai * HALF + m * 16) * ldc + col0;
#pragma unroll
                for (int bj = 0; bj < 2; ++bj)
#pragma unroll
                    for (int n = 0; n < 2; ++n) *(f32x4*)(rowp + bj * HALF + n * 16) = acc[ai][bj][m][n]; }
    }
};

template <class Epi, class Sched>
DEV void gemm_phase(LAS unsigned char* lds, const char* Abase, const int K, const Sched& S, const Epi& E, const int tid) {
    const int wid = __builtin_amdgcn_readfirstlane(tid >> 6), lane = tid & 63, wr = wid >> 2, wc = wid & 3, fr = lane & 15, fq = lane >> 4;
    const int nt = K / BK;
    unsigned voffB[2];
#pragma unroll
    for (int i = 0; i < 2; ++i) { int R, C; stage_rc(tid * 16 + i * 8192, R, C); const int Rb = Epi::PERM ? ((R & ~31) + perm32(R & 31)) : R;
        voffB[i] = (unsigned)(Rb * K + C) * 2u; }
    const size_t kstep = (size_t)(BK * 2);
    const size_t hstep = (size_t)HALF * K * 2;
    const unsigned ldsw = (unsigned)wid * 1024u;
    const int aoff = lds_byte(wr * 64 + fr, fq * 8), boff = lds_byte(wc * 32 + fr, fq * 8);
#define PG8_SA(b, h) (((b) * 2 + (h)) * HTB)
#define PG8_SB(b, h) ((4 + (b) * 2 + (h)) * HTB)
#define PG8_STAGE_B(bufoff, gbase) do { _Pragma("unroll") for (int _i = 0; _i < 2; ++_i) \
        __builtin_amdgcn_global_load_lds((const unsigned*)((const char*)(gbase) + voffB[_i]), (LAS unsigned*)(lds + (bufoff) + ldsw + _i * 8192), 16, 0, 0); } while (0)
#define PG8_STAGE_A(bufoff, kb, V, h) do { _Pragma("unroll") for (int _i = 0; _i < 2; ++_i) \
        __builtin_amdgcn_global_load_lds((const unsigned*)(Abase + (kb) + (V)[h][_i]), (LAS unsigned*)(lds + (bufoff) + ldsw + _i * 8192), 16, 0, 0); } while (0)
#define PG8_VOFFA(V, u) do { _Pragma("unroll") for (int _i = 0; _i < 2; ++_i) { int _R, _C; stage_rc(tid * 16 + _i * 8192, _R, _C); _Pragma("unroll") for (int _h = 0; _h < 2; ++_h) \
        (V)[_h][_i] = ((unsigned)S.arow(u, _h * HALF + _R) * (unsigned)K + (unsigned)_C) * 2u; } } while (0)
#define PG8_LDA(dst, b, h) do { _Pragma("unroll") for (int m = 0; m < 4; ++m) _Pragma("unroll") for (int k = 0; k < 2; ++k) dst[m][k] = *(const LAS bf16x8*)(lds + PG8_SA(b, h) + aoff + m * 2048 + k * 1024); } while (0)
#define PG8_LDB(dst, b, h) do { _Pragma("unroll") for (int n = 0; n < 2; ++n) _Pragma("unroll") for (int k = 0; k < 2; ++k) dst[n][k] = *(const LAS bf16x8*)(lds + PG8_SB(b, h) + boff + n * 2048 + k * 1024); } while (0)
#define PG8_MMA(ai, bj, At, Bt) do { __builtin_amdgcn_s_setprio(1); _Pragma("unroll") for (int m = 0; m < 4; ++m) _Pragma("unroll") for (int n = 0; n < 2; ++n) _Pragma("unroll") for (int k = 0; k < 2; ++k) \
        acc[ai][bj][m][n] = __builtin_amdgcn_mfma_f32_16x16x32_bf16(Bt[n][k], At[m][k], acc[ai][bj][m][n], 0, 0, 0); __builtin_amdgcn_s_setprio(0); } while (0)
#define PG8_WAIT_V(n) asm volatile("s_waitcnt vmcnt(" #n ")" ::: "memory")
#define PG8_WAIT_L(n) asm volatile("s_waitcnt lgkmcnt(" #n ")" ::: "memory")
#define PG8_BAR __builtin_amdgcn_s_barrier()
#define PG8_SCHED __builtin_amdgcn_sched_barrier(0)
    Unit cur, nxt; int ui = 0;
    if (!S.next(0, cur)) return;
    f32x4 acc[2][2][4][2];
#pragma unroll
    for (int a = 0; a < 2; ++a)
#pragma unroll
        for (int b = 0; b < 2; ++b)
#pragma unroll
            for (int m = 0; m < 4; ++m)
#pragma unroll
                for (int n = 0; n < 2; ++n) acc[a][b][m][n] = (f32x4){0.f, 0.f, 0.f, 0.f};
    bf16x8 At[4][2], B0[2][2], B1[2][2];
    unsigned vc[2][2], v2[2][2];
    PG8_VOFFA(vc, cur);
    const char* cB = S.bbase(cur);
    PG8_STAGE_B(PG8_SB(0, 0), cB); PG8_STAGE_A(PG8_SA(0, 0), 0, vc, 0); PG8_STAGE_B(PG8_SB(0, 1), cB + hstep); PG8_STAGE_A(PG8_SA(0, 1), 0, vc, 1);
    if (wr == 1) PG8_BAR;
    PG8_WAIT_V(4); PG8_BAR;
    PG8_STAGE_B(PG8_SB(1, 0), cB + kstep); PG8_STAGE_A(PG8_SA(1, 0), kstep, vc, 0); PG8_STAGE_B(PG8_SB(1, 1), cB + hstep + kstep);
    PG8_WAIT_V(6); PG8_BAR;
    for (;;) {
        const bool has_next = S.next(ui + 1, nxt);
        const char* nB = has_next ? S.bbase(nxt) : cB;
        for (int t = 0; t < nt; t += 2) {
            const bool last = (t == nt - 2);
            const size_t k1 = (size_t)(t + 1) * kstep, k2 = last ? (size_t)0 : (size_t)(t + 2) * kstep, k3 = k2 + kstep;
            if (last && has_next) { PG8_VOFFA(v2, nxt); } else {
#pragma unroll
                for (int h = 0; h < 2; ++h)
#pragma unroll
                    for (int i = 0; i < 2; ++i) v2[h][i] = vc[h][i]; }
            const char* b2 = last ? nB : cB + (size_t)(t + 2) * kstep; const char* b3 = b2 + kstep;
            PG8_LDB(B0, 0, 0); PG8_SCHED; PG8_LDA(At, 0, 0); PG8_STAGE_A(PG8_SA(1, 1), k1, vc, 1);
            PG8_WAIT_L(8); PG8_BAR; PG8_WAIT_L(0); PG8_MMA(0, 0, At, B0); PG8_BAR; PG8_SCHED;
            PG8_LDB(B1, 0, 1); PG8_STAGE_B(PG8_SB(0, 0), b2);
            PG8_BAR; PG8_WAIT_L(0); PG8_MMA(0, 1, At, B1); PG8_BAR;
            PG8_LDA(At, 0, 1); PG8_STAGE_A(PG8_SA(0, 0), k2, v2, 0);
            PG8_BAR; PG8_WAIT_L(0); PG8_MMA(1, 0, At, B0); PG8_BAR; PG8_SCHED;
            PG8_STAGE_B(PG8_SB(0, 1), b2 + hstep);
            PG8_WAIT_V(6); PG8_BAR; PG8_MMA(1, 1, At, B1); PG8_BAR;
            PG8_LDB(B0, 1, 0); PG8_SCHED; PG8_LDA(At, 1, 0); PG8_STAGE_A(PG8_SA(0, 1), k2, v2, 1);
            PG8_WAIT_L(8); PG8_BAR; PG8_WAIT_L(0); PG8_MMA(0, 0, At, B0); PG8_BAR; PG8_SCHED;
            PG8_LDB(B1, 1, 1); PG8_STAGE_B(PG8_SB(1, 0), b3);
            PG8_BAR; PG8_WAIT_L(0); PG8_MMA(0, 1, At, B1); PG8_BAR;
            PG8_LDA(At, 1, 1); PG8_STAGE_A(PG8_SA(1, 0), k3, v2, 0);
            PG8_BAR; PG8_WAIT_L(0); PG8_MMA(1, 0, At, B0); PG8_BAR; PG8_SCHED;
            PG8_STAGE_B(PG8_SB(1, 1), b3 + hstep);
            PG8_WAIT_V(6); PG8_BAR; PG8_MMA(1, 1, At, B1); PG8_BAR;
        }
        E(acc, cur, wr, wc, fr, fq);
        if (!has_next) break;
#pragma unroll
        for (int a = 0; a < 2; ++a)
#pragma unroll
            for (int b = 0; b < 2; ++b)
#pragma unroll
                for (int m = 0; m < 4; ++m)
#pragma unroll
                    for (int n = 0; n < 2; ++n) acc[a][b][m][n] = (f32x4){0.f, 0.f, 0.f, 0.f};
        cur = nxt; cB = nB; ++ui;
#pragma unroll
        for (int h = 0; h < 2; ++h)
#pragma unroll
            for (int i = 0; i < 2; ++i) vc[h][i] = v2[h][i];
    }
    PG8_WAIT_V(0);
    if (wr == 0) PG8_BAR;
    PG8_BAR;
#undef PG8_SA
#undef PG8_SB
#undef PG8_STAGE_A
#undef PG8_STAGE_B
#undef PG8_VOFFA
#undef PG8_LDA
#undef PG8_LDB
#undef PG8_MMA
#undef PG8_WAIT_V
#undef PG8_WAIT_L
#undef PG8_BAR
#undef PG8_SCHED
}
}


namespace att {
using bf16x8 = __attribute__((ext_vector_type(8))) short;
using s16x4  = __attribute__((ext_vector_type(4))) short;
using f32x16 = __attribute__((ext_vector_type(16))) float;
using u32x4  = __attribute__((ext_vector_type(4))) unsigned;
constexpr int KVBLK = 64, LDK = 128;
constexpr int SHM_V = KVBLK * 128 * 2, SHM_K = KVBLK * 128 * 2, SHM_ATTN = 2 * SHM_V + 2 * SHM_K + 8 * 64 * 4;
constexpr float THR = 8.f;
#define KSWZ(row, colB) ((row) * 256 + ((colB) ^ (((row) & 7) << 4)))
#define SBAR() __builtin_amdgcn_sched_barrier(0)
DEV int crow(int r, int hi) { return (r & 3) + 8 * (r >> 2) + 4 * hi; }
DEV void partialSM(f32x16& p0, f32x16& p1, float& m_reg, float& mn, float& alpha) {
  float pmax = p0[0]; for (int r = 1; r < 16; ++r) pmax = fmaxf(pmax, p0[r]); for (int r = 0; r < 16; ++r) pmax = fmaxf(pmax, p1[r]);
  { auto rr = __builtin_amdgcn_permlane32_swap(__float_as_uint(pmax), __float_as_uint(pmax), false, false);
    pmax = fmaxf(__uint_as_float(rr[0]), __uint_as_float(rr[1])); }
  if (__builtin_expect(__all(pmax - m_reg <= THR), 1)) { mn = m_reg; alpha = 1.f; }
  else { mn = fmaxf(m_reg, pmax); alpha = __builtin_amdgcn_exp2f(m_reg - mn); m_reg = mn; }
  for (int r = 0; r < 16; ++r) p0[r] = p0[r] - mn; for (int r = 0; r < 16; ++r) p1[r] = p1[r] - mn;
  for (int r = 0; r < 16; ++r) p0[r] = __builtin_amdgcn_exp2f(p0[r]);
}
DEV void finishSM(f32x16& p0, f32x16& p1, float alpha, float& l_reg, bf16x8& pa0, bf16x8& pa1, bf16x8& pa2, bf16x8& pa3) {
  for (int r = 0; r < 16; ++r) p1[r] = __builtin_amdgcn_exp2f(p1[r]);
  float ps = 0; for (int r = 0; r < 16; ++r) ps += p0[r]; for (int r = 0; r < 16; ++r) ps += p1[r];
  { auto rr = __builtin_amdgcn_permlane32_swap(__float_as_uint(ps), __float_as_uint(ps), false, false);
    ps = __uint_as_float(rr[0]) + __uint_as_float(rr[1]); }
  l_reg = l_reg * alpha + ps;
#define PK4(P, BASE, OUT) do { unsigned a0 = cvt_pk_bf16(P[BASE + 0], P[BASE + 1]), a1 = cvt_pk_bf16(P[BASE + 2], P[BASE + 3]);   \
    unsigned b0 = cvt_pk_bf16(P[BASE + 4], P[BASE + 5]), b1 = cvt_pk_bf16(P[BASE + 6], P[BASE + 7]);                              \
    auto r0 = __builtin_amdgcn_permlane32_swap(a0, b0, false, false); auto r1 = __builtin_amdgcn_permlane32_swap(a1, b1, false, false); \
    u32x4 w = {r0[0], r1[0], r0[1], r1[1]}; OUT = *reinterpret_cast<bf16x8*>(&w); } while (0)
  PK4(p0, 0, pa0); PK4(p0, 8, pa1); PK4(p1, 0, pa2); PK4(p1, 8, pa3);
#undef PK4
}
DEV void qkt(f32x16& p0, f32x16& p1, const char* Ks, const bf16x8 (&qr)[4], int r32, int hi, int js) {
  p0 = f32x16{}; p1 = f32x16{};
#pragma unroll
  for (int d0 = 0; d0 < 4; ++d0) { const int cb = ((js * 4 + d0) * 16 + hi * 8) * 2;
    bf16x8 b0 = *reinterpret_cast<const bf16x8*>(Ks + KSWZ(r32, cb));
    bf16x8 b1 = *reinterpret_cast<const bf16x8*>(Ks + KSWZ(32 + r32, cb));
    p0 = __builtin_amdgcn_mfma_f32_32x32x16_bf16(b0, qr[d0], p0, 0, 0, 0);
    p1 = __builtin_amdgcn_mfma_f32_32x32x16_bf16(b1, qr[d0], p1, 0, 0, 0); }
}
DEV int v_st(int k, int c) { const int kk = (k & ~0xC) | ((k & 4) << 1) | ((k & 8) >> 1); return ((kk >> 3) * 4 + (c >> 5)) * 512 + ((kk & 7) * 32 + (c & 31)) * 2; }
DEV int v_rd_base(int lane) { return ((lane & 3) << 3) | (((lane >> 2) & 3) << 6) | (((lane >> 4) & 1) << 5) | (((lane >> 5) & 1) << 8); }
constexpr int v_rd_off(int d0, int ks, int half) { return d0 * 512 + ks * 4096 + half * 2048; }
template <int OFF> DEV s16x4 tr_read(int vb) {
  s16x4 r; asm volatile("ds_read_b64_tr_b16 %0, %1 offset:%2" : "=&v"(r) : "v"(vb), "i"(OFF) : "memory"); return r;
}
template <int D0> DEV void pv_one(f32x16& od, int vb, bf16x8 pa0, bf16x8 pa1, bf16x8 pa2, bf16x8 pa3) {
  const s16x4 l0 = tr_read<v_rd_off(D0, 0, 0)>(vb), h0 = tr_read<v_rd_off(D0, 0, 1)>(vb), l1 = tr_read<v_rd_off(D0, 1, 0)>(vb), h1 = tr_read<v_rd_off(D0, 1, 1)>(vb);
  const s16x4 l2 = tr_read<v_rd_off(D0, 2, 0)>(vb), h2 = tr_read<v_rd_off(D0, 2, 1)>(vb), l3 = tr_read<v_rd_off(D0, 3, 0)>(vb), h3 = tr_read<v_rd_off(D0, 3, 1)>(vb);
  asm volatile("s_waitcnt lgkmcnt(0)" ::: "memory"); SBAR();
#define PK(L, H) (bf16x8){L[0], L[1], L[2], L[3], H[0], H[1], H[2], H[3]}
  od = __builtin_amdgcn_mfma_f32_32x32x16_bf16(pa0, PK(l0, h0), od, 0, 0, 0);
  od = __builtin_amdgcn_mfma_f32_32x32x16_bf16(pa1, PK(l1, h1), od, 0, 0, 0);
  od = __builtin_amdgcn_mfma_f32_32x32x16_bf16(pa2, PK(l2, h2), od, 0, 0, 0);
  od = __builtin_amdgcn_mfma_f32_32x32x16_bf16(pa3, PK(l3, h3), od, 0, 0, 0);
#undef PK
}
DEV void pv_d0(f32x16* o, int vb, bf16x8 pa0, bf16x8 pa1, bf16x8 pa2, bf16x8 pa3) {
  pv_one<0>(o[0], vb, pa0, pa1, pa2, pa3); pv_one<1>(o[1], vb, pa0, pa1, pa2, pa3); pv_one<2>(o[2], vb, pa0, pa1, pa2, pa3); pv_one<3>(o[3], vb, pa0, pa1, pa2, pa3);
}
DEV void attn_tiles(const bf16x8 (&qr)[4], const bf16_t* __restrict__ Kh, const bf16_t* __restrict__ Vh, int seq, char* lds,
                    float& m_reg, float& l_reg, f32x16 (&o)[4], int tid, int js) {
  const int wid = tid >> 6, lane = tid & 63, r32 = lane & 31, hi = lane >> 5;
  char* V_lds = lds; char* K_lds = lds + 2 * SHM_V;
  float* ws = (float*)(lds + 2 * SHM_V + 2 * SHM_K) + wid * 64; float* al_l = ws + 32;
  const int sr = tid >> 4, sc = (tid & 15) * 8, vst0 = v_st(sr, sc), vst1 = v_st(32 + sr, sc);
  const int vb0 = (int)(uintptr_t)V_lds + v_rd_base(lane);
  struct { bf16x8 vs0, vs1, ks0, ks1; } sr_[2];
  const unsigned lo0 = (unsigned)((sr * LDK + sc) * 2), lo1 = lo0 + 32u * LDK * 2u;
#define SLOAD(i, k0) do { const char* vb_ = (const char*)Vh + (size_t)(k0) * (LDK * 2); const char* kb_ = (const char*)Kh + (size_t)(k0) * (LDK * 2); \
    sr_[i].vs0 = *(const bf16x8*)(vb_ + lo0); sr_[i].vs1 = *(const bf16x8*)(vb_ + lo1); sr_[i].ks0 = *(const bf16x8*)(kb_ + lo0); sr_[i].ks1 = *(const bf16x8*)(kb_ + lo1); } while (0)
#define SWRITE(b, i) do { *(bf16x8*)(V_lds + (b) * SHM_V + vst0) = sr_[i].vs0;          \
    *(bf16x8*)(V_lds + (b) * SHM_V + vst1) = sr_[i].vs1; int kc = sc * 2;               \
    *(bf16x8*)(K_lds + (b) * SHM_K + KSWZ(sr, kc)) = sr_[i].ks0;                       \
    *(bf16x8*)(K_lds + (b) * SHM_K + KSWZ(32 + sr, kc)) = sr_[i].ks1; } while (0)
#define SWAIT() asm volatile("s_waitcnt vmcnt(4)" ::: "memory")
#define RESC(a) do { if (__any((a) < 1.f)) { if (hi == 0) al_l[r32] = (a); asm volatile("s_waitcnt lgkmcnt(0)" ::: "memory"); \
    for (int d = 0; d < 4; ++d) for (int r = 0; r < 16; ++r) o[d][r] *= al_l[crow(r, hi)]; } } while (0)
  f32x16 pA0, pA1, pB0, pB1; float mnA, mnB, alA, alB; bf16x8 pa0, pa1, pa2, pa3; const int NTL = seq / KVBLK;
  constexpr int SE = 0, SO = 1;
  __syncthreads();
  SLOAD(SE, 0); asm volatile("s_waitcnt vmcnt(0)" ::: "memory"); SWRITE(0, SE); __syncthreads();
  qkt(pA0, pA1, K_lds, qr, r32, hi, js); partialSM(pA0, pA1, m_reg, mnA, alA);
  SLOAD(SO, KVBLK); if (2 < NTL) SLOAD(SE, 2 * KVBLK);
  SWAIT(); SWRITE(1, SO); __syncthreads();
  RESC(alA);
  for (int j = 1; j + 1 < NTL; j += 2) {
    SBAR(); qkt(pB0, pB1, K_lds + SHM_K, qr, r32, hi, js);
    finishSM(pA0, pA1, alA, l_reg, pa0, pa1, pa2, pa3); SBAR();
    SLOAD(SO, (j + 2) * KVBLK); SBAR();
    pv_d0(o, vb0, pa0, pa1, pa2, pa3); partialSM(pB0, pB1, m_reg, mnB, alB);
    __syncthreads(); SWAIT(); SWRITE(0, SE);
    RESC(alB); __syncthreads();
    SBAR(); qkt(pA0, pA1, K_lds, qr, r32, hi, js);
    finishSM(pB0, pB1, alB, l_reg, pa0, pa1, pa2, pa3); SBAR();
    if (j + 3 < NTL) SLOAD(SE, (j + 3) * KVBLK); SBAR();
    pv_d0(o, vb0 + SHM_V, pa0, pa1, pa2, pa3); partialSM(pA0, pA1, m_reg, mnA, alA);
    __syncthreads(); SWAIT(); SWRITE(1, SO);
    RESC(alA); __syncthreads();
  }
  SBAR(); qkt(pB0, pB1, K_lds + SHM_K, qr, r32, hi, js);
  finishSM(pA0, pA1, alA, l_reg, pa0, pa1, pa2, pa3); SBAR();
  pv_d0(o, vb0, pa0, pa1, pa2, pa3); partialSM(pB0, pB1, m_reg, mnB, alB);
  __syncthreads(); RESC(alB);
  finishSM(pB0, pB1, alB, l_reg, pa0, pa1, pa2, pa3); SBAR();
  pv_d0(o, vb0 + SHM_V, pa0, pa1, pa2, pa3);
#undef SLOAD
#undef SWRITE
#undef SWAIT
#undef RESC
}
}

DEV void cvt_tile(const float* src, int ld, int nvalid, bf16_t* dst, int K, int n0, int k0, float* T, const int t, int ns0 = -1) {
    if (ns0 < 0) ns0 = n0;
#pragma unroll
    for (int h = 0; h < 2; ++h) {
        const int kk = (t >> 4) + 32 * h, nq = (t & 15) * 4, n = ns0 + nq;
        const float4 v = n < nvalid ? *(const float4*)(src + (size_t)(k0 + kk) * ld + n) : make_float4(0.f, 0.f, 0.f, 0.f);
        T[(nq + 0) * 65 + kk] = v.x; T[(nq + 1) * 65 + kk] = v.y; T[(nq + 2) * 65 + kk] = v.z; T[(nq + 3) * 65 + kk] = v.w;
    }
    __syncthreads();
    { const int n = t >> 3, kq = (t & 7) * 8; const float* r = T + n * 65 + kq;
      pg8::u32x4 w; w.x = cvt_pk_bf16(r[0], r[1]); w.y = cvt_pk_bf16(r[2], r[3]); w.z = cvt_pk_bf16(r[4], r[5]); w.w = cvt_pk_bf16(r[6], r[7]);
      *(pg8::u32x4*)(dst + (size_t)(n0 + n) * K + k0 + kq) = w; }
    __syncthreads();
}
DEV void cvt_tile4(const float* src, int ld, int nvalid, bf16_t* dst, int K, int n0, int k0, float* T, const int t, int ns0 = -1) {
    if (ns0 < 0) ns0 = n0;
    float4 v[4][2];
#pragma unroll
    for (int q = 0; q < 4; ++q)
#pragma unroll
        for (int h = 0; h < 2; ++h) { const int kk = (t >> 4) + 32 * h, n = ns0 + (t & 15) * 4;
            v[q][h] = n < nvalid ? *(const float4*)(src + (size_t)(k0 + q * 64 + kk) * ld + n) : make_float4(0.f, 0.f, 0.f, 0.f); }
#pragma unroll
    for (int q = 0; q < 4; ++q)
#pragma unroll
        for (int h = 0; h < 2; ++h) { const int kk = (t >> 4) + 32 * h, nq = (t & 15) * 4; float* Tq = T + q * (64 * 65);
            Tq[(nq + 0) * 65 + kk] = v[q][h].x; Tq[(nq + 1) * 65 + kk] = v[q][h].y; Tq[(nq + 2) * 65 + kk] = v[q][h].z; Tq[(nq + 3) * 65 + kk] = v[q][h].w; }
    __syncthreads();
#pragma unroll
    for (int q = 0; q < 4; ++q) { const int n = t >> 3, kq = (t & 7) * 8; const float* r = T + q * (64 * 65) + n * 65 + kq;
      pg8::u32x4 w; w.x = cvt_pk_bf16(r[0], r[1]); w.y = cvt_pk_bf16(r[2], r[3]); w.z = cvt_pk_bf16(r[4], r[5]); w.w = cvt_pk_bf16(r[6], r[7]);
      *(pg8::u32x4*)(dst + (size_t)(n0 + n) * K + k0 + q * 64 + kq) = w; }
    __syncthreads();
}
DEV void ph_convert(const Params& p, char* smem) {
    const int tidx = tid_of(p.wave_id);
    float* T = (float*)(smem + 256);
    volatile int* msg = (volatile int*)smem;
    unsigned* qh = (unsigned*)(p.ws + OFF_bar) + CW_QHEAD;
    constexpr int T_IN = 2 * 60 * 4, T_OUT = 2 * 16 * 4, T_W1 = 64 * 32 * 4, T_W2 = 64 * 16 * 4;
    unsigned nxt = 0u;
    if (tidx == 0) nxt = xb_add(qh, 1u);
    for (;;) {
        __syncthreads();
        if (tidx == 0) msg[0] = (int)nxt;
        __syncthreads();
        const int u = msg[0];
        if (u >= T_IN + T_OUT + T_W1 + T_W2) break;
        if (tidx == 0) nxt = xb_add(qh, 1u);
        if (u < T_IN) { const int l = u / 240, r = u % 240, nt = r >> 2, kq = r & 3;
            const int n0 = nt * 64; int ns0, nv;
            if (n0 < 2048) { ns0 = n0; nv = DPW; } else if (n0 < 3584) { ns0 = n0 + 16; nv = DPW; } else if (n0 == 3584) { ns0 = 2048; nv = 2064; } else { ns0 = 0; nv = 0; }
            cvt_tile4(p.w_in + (size_t)l * D * DPW, DPW, nv, (bf16_t*)(p.ws + OFF_WIN) + (size_t)l * DP * D, D, n0, kq * 256, T, tidx, ns0); }
        else if (u < T_IN + T_OUT) { const int v = u - T_IN, l = v >> 6, r = v & 63, nt = r >> 2, kq = r & 3;
            cvt_tile4(p.w_out + (size_t)l * D * D, D, D, (bf16_t*)(p.ws + OFF_WOUT) + (size_t)l * D * D, D, nt * 64, kq * 256, T, tidx); }
        else if (u < T_IN + T_OUT + T_W1) { const int v = u - T_IN - T_OUT, le = v >> 7, r = v & 127, nt = r >> 2, kq = r & 3;
            cvt_tile4(p.w1 + (size_t)le * D * 2048, 2048, 2048, (bf16_t*)(p.ws + OFF_W1T) + (size_t)le * 2048 * D, D, nt * 64, kq * 256, T, tidx); }
        else { const int v = u - T_IN - T_OUT - T_W1, le = v >> 6, r = v & 63, nt = r >> 2, kq = r & 3;
            cvt_tile4(p.w2 + (size_t)le * DFF * D, D, D, (bf16_t*)(p.ws + OFF_W2T) + (size_t)le * D * DFF, DFF, nt * 64, kq * 256, T, tidx); }
    }
}

DEV void row_load(const float* src, float4 (&v)[4], int lane) {
#pragma unroll
    for (int i = 0; i < 4; ++i) v[i] = *(const float4*)(src + i * 256 + lane * 4);
}
DEV void row_store(float* dst, const float4 (&v)[4], int lane) {
#pragma unroll
    for (int i = 0; i < 4; ++i) *(float4*)(dst + i * 256 + lane * 4) = v[i];
}
DEV void row_store_bf16(bf16_t* dst, const float4 (&v)[4], int lane) {
#pragma unroll
    for (int i = 0; i < 4; ++i) { pg8::u32x2 w; w.x = cvt_pk_bf16(v[i].x, v[i].y); w.y = cvt_pk_bf16(v[i].z, v[i].w); *(pg8::u32x2*)(dst + i * 256 + lane * 4) = w; }
}
DEV void row_load_bf(const bf16_t* src, float4 (&v)[4], int lane) {
#pragma unroll
    for (int i = 0; i < 4; ++i) { const pg8::u32x2 w = *(const pg8::u32x2*)(src + i * 256 + lane * 4);
        v[i] = make_float4(__uint_as_float(w.x << 16), __uint_as_float(w.x & 0xffff0000u), __uint_as_float(w.y << 16), __uint_as_float(w.y & 0xffff0000u)); }
}
DEV float row_rinv(const float4 (&v)[4]) {
    float ss = 0.f;
#pragma unroll
    for (int i = 0; i < 4; ++i) ss += v[i].x * v[i].x + v[i].y * v[i].y + v[i].z * v[i].z + v[i].w * v[i].w;
    ss = wsum(ss);
    return rsqrtf(ss * (1.f / 1024.f) + 1e-6f);
}
DEV void row_modnorm(const float4 (&v)[4], const float* gain, const float* shift, const float* scale, float4 (&o)[4], int lane) {
    const float r = row_rinv(v);
#pragma unroll
    for (int i = 0; i < 4; ++i) {
        const int idx = i * 256 + lane * 4;
        const float4 g = *(const float4*)(gain + idx), sh = *(const float4*)(shift + idx), sc = *(const float4*)(scale + idx);
        o[i].x = v[i].x * r * g.x * (1.f + sc.x) + sh.x; o[i].y = v[i].y * r * g.y * (1.f + sc.y) + sh.y;
        o[i].z = v[i].z * r * g.z * (1.f + sc.z) + sh.z; o[i].w = v[i].w * r * g.w * (1.f + sc.w) + sh.w;
    }
}
DEV const float* modrow(const Params& p, int layer, int b, int s) { return ((float*)(p.ws + OFF_MOD)) + ((size_t)layer * 9 + (s < CTX ? 8 : b)) * 6144; }

DEV void ph_mods(const Params& p, char* smem) {
    const int tidx = tid_of(p.wave_id);
    float (*cond)[1024] = (float (*)[1024])smem;
    float (*red)[9][64] = (float (*)[9][64])(smem + 9 * 1024 * 4);
    const int tid = tidx;
    for (int i = tid; i < 9 * 1024; i += 512) { const int r = i >> 10, k = i & 1023; const float c = r < 8 ? p.c[r * 1024 + k] : p.c_ctx[k]; cond[r][k] = c * sigm(c); }
    __syncthreads();
    for (int u = blockIdx.x; u < 192; u += gridDim.x) {
        const int layer = u / 96, cg = u % 96, jj = tid & 63, ks = tid >> 6, j = cg * 64 + jj;
        float acc[9];
#pragma unroll
        for (int r = 0; r < 9; ++r) acc[r] = 0.f;
        const float* w = p.ada_w + (size_t)layer * 1024 * 6144 + j;
        for (int k = ks * 128; k < ks * 128 + 128; ++k) { const float wv = w[(size_t)k * 6144];
#pragma unroll
            for (int r = 0; r < 9; ++r) acc[r] += cond[r][k] * wv; }
#pragma unroll
        for (int r = 0; r < 9; ++r) red[ks][r][jj] = acc[r];
        __syncthreads();
        for (int t = tid; t < 9 * 64; t += 512) { const int r = t >> 6, q = t & 63; float s = 0.f; for (int z = 0; z < 8; ++z) s += red[z][r][q];
            ((float*)(p.ws + OFF_MOD))[((size_t)layer * 9 + r) * 6144 + cg * 64 + q] = s + p.ada_b[layer * 6144 + cg * 64 + q]; }
        __syncthreads();
    }
    if (blockIdx.x == (gridDim.x > 1 ? 1u : 0u)) {
        for (int t = tid; t < 1024; t += 512) { const int pos = t >> 4, i = t & 15; float sn, cs; sincosf((float)pos * expf(-(float)i * (1.f / 16.f) * 9.210340371976184f), &sn, &cs);
            ((float2*)(p.ws + OFF_ROPE))[t] = make_float2(cs, sn); }
    }
    if (blockIdx.x == 0) {
        for (int t = tid; t < 1024; t += 512) { const int layer = t >> 9, dir = (t >> 8) & 1, w = t & 255;
            const float t0 = p.hlb[(dir * 2 + 0) * 256 + w], t1 = p.hlb[(dir * 2 + 1) * 256 + w];
            const float mx = fmaxf(t0, t1), e0 = expf(t0 - mx), e1 = expf(t1 - mx);
            float lb = layer == 0 ? 0.f : e1 / (e0 + e1); lb = fminf(fmaxf(lb, 0.f), 1.f);
            ((float*)(p.ws + OFF_LB))[(layer * 2 + dir) * 256 + w] = lb; }
        if (tid < 128) { const int layer = tid >> 6, lane = tid & 63; const float* L = p.dlam + layer * 256;
            const float s1 = wsum(L[lane] * L[64 + lane]), s2 = wsum(L[128 + lane] * L[192 + lane]);
            if (lane == 0) ((float*)(p.ws + OFF_LAM))[layer] = expf(s1) - expf(s2) + lam_init_of(layer); }
    }
}

DEV void ph_init(const Params& p, char* smem) {
    const int tidx = tid_of(p.wave_id);
    const int wid = tidx >> 6, lane = tidx & 63;
    for (int r = blockIdx.x * 8 + wid; r < NT; r += gridDim.x * 8) {
        const int b = r / SL, s = r % SL;
        const float* src = s < CTX ? p.ctx + ((size_t)b * CTX + s) * D : p.x + ((size_t)b * SEQ + (s - CTX)) * D;
        float4 v[4], o[4]; row_load(src, v, lane); row_store_bf16((bf16_t*)(p.ws + OFF_X) + (size_t)r * D, v, lane);
        const float* m = modrow(p, 0, b, s);
        row_modnorm(v, p.norms + 0, m + 0, m + 1024, o, lane);
        row_store_bf16((bf16_t*)(p.ws + OFF_XNB) + (size_t)r * D, o, lane);
    }
}


struct EpiIn {
    static constexpr bool PERM = false;
    bf16_t *PB, *QRB, *Q0B, *KB, *VB; const float* CS;
    DEV void operator()(const pg8::f32x4 (&acc)[2][2][4][2], const pg8::Unit& u, int wr, int wc, int fr, int fq) const {
        using pg8::f32x4; using pg8::u32x2;
        const int pn = u.pn;
        if (pn < 8 || pn == 14) {
#pragma unroll
            for (int ai = 0; ai < 2; ++ai)
#pragma unroll
                for (int m = 0; m < 4; ++m) { bf16_t* rowp = PB + (size_t)(u.pm * 256 + ai * 128 + wr * 64 + m * 16 + fr) * DP + pn * 256 + wc * 32 + 4 * fq;
#pragma unroll
                    for (int bj = 0; bj < 2; ++bj)
#pragma unroll
                        for (int n = 0; n < 2; ++n) { const f32x4 v = acc[ai][bj][m][n]; u32x2 w; w.x = cvt_pk_bf16(v[0], v[1]); w.y = cvt_pk_bf16(v[2], v[3]); *(u32x2*)(rowp + bj * 128 + n * 16) = w; } }
        } else {
            const int kind = (pn - 8) >> 1, hb = ((pn - 8) & 1) * 2, b = u.pm / 9, tq = u.pm % 9, half = wc & 1, jsub = wc >> 1;
            const bool isctx = tq == 0;
            const float QC = 0.125f * 1.4426950408889634f;
#pragma unroll
            for (int ai = 0; ai < 2; ++ai)
#pragma unroll
                for (int m = 0; m < 4; ++m) {
                    const int s = tq * 256 + ai * 128 + wr * 64 + m * 16 + fr;
                    f32x4 c4 = {1.f, 1.f, 1.f, 1.f}, s4 = {0.f, 0.f, 0.f, 0.f};
                    if (kind != 2 && !isctx) { const int pos = half == 0 ? (tq - 1) * 4 + ai * 2 + wr : m * 16 + fr;
                        const f32x4 t0 = *(const f32x4*)(CS + (pos * 16 + 4 * fq) * 2), t1 = *(const f32x4*)(CS + (pos * 16 + 4 * fq) * 2 + 4);
                        c4 = (f32x4){t0[0], t0[2], t1[0], t1[2]}; s4 = (f32x4){t0[1], t0[3], t1[1], t1[3]}; }
#pragma unroll
                    for (int bj = 0; bj < 2; ++bj) {
                        const size_t dst = ((size_t)(b * 4 + hb + bj) * SL + s) * 128 + jsub * 64 + half * 32 + 4 * fq;
                        const f32x4 x1 = acc[ai][bj][m][0], x2 = acc[ai][bj][m][1];
#define ST4(ptr, v) do { u32x2 w_; w_.x = cvt_pk_bf16((v)[0], (v)[1]); w_.y = cvt_pk_bf16((v)[2], (v)[3]); *(u32x2*)(ptr) = w_; } while (0)
                        if (kind == 2) { ST4(VB + dst, x1); ST4(VB + dst + 16, x2); }
                        else {
                            const f32x4 o1 = x1 * c4 - x2 * s4, o2 = x1 * s4 + x2 * c4;
                            if (kind == 1) { ST4(KB + dst, o1); ST4(KB + dst + 16, o2); }
                            else { const f32x4 a1 = o1 * QC, a2 = o2 * QC, p1 = x1 * QC, p2 = x2 * QC; ST4(QRB + dst, a1); ST4(QRB + dst + 16, a2); ST4(Q0B + dst, p1); ST4(Q0B + dst + 16, p2); }
                        }
#undef ST4
                    }
                }
        }
    }
};

struct InOrder {
    int G, c, Lbeg, Lend; const char* Bt; int K;
    DEV bool next(int i, pg8::Unit& u) const {
        const int L = Lbeg + i * G + c; if (L >= Lend) return false;
        const int nN = L < 648 ? 9 : 6, l = L < 648 ? L : L - 648, nM = NT / 256, nwg = nM * nN;
        int wgid = l; { const int q = nwg / 8, r = nwg % 8, xcd = wgid % 8, off = wgid / 8; wgid = (xcd < r ? xcd * (q + 1) : r * (q + 1) + (xcd - r) * q) + off; }
        const int nig = 8 * nN, gid = wgid / nig, fm = gid * 8, gsz = (nM - fm) < 8 ? (nM - fm) : 8;
        const int pnl = (wgid % nig) / gsz;
        u.pm = fm + ((wgid % nig) % gsz); u.pn = L < 648 ? (pnl < 8 ? pnl : 14) : 8 + pnl; u.e = 0; u.t = 0; return true;
    }
    DEV int arow(const pg8::Unit& u, int rr) const { return u.pm * 256 + rr; }
    DEV const char* bbase(const pg8::Unit& u) const { return Bt + (size_t)u.pn * 256 * K * 2; }
};
DEV void ph_inproj(const Params& p, int layer, char* smem, int part) {
    const int tidx = tid_of(p.wave_id);
    const int G = (int)gridDim.x, nun = (NT / 256) * (DP / 256), cut = 4 * G < nun ? 4 * G : nun;
    const int nleft = nun - cut, cid = part == 0 ? (int)blockIdx.x : (int)blockIdx.x - (G - nleft);
    if (part == 1 && (nleft <= 0 || cid < 0)) return;
    InOrder S{G, cid, part == 0 ? 0 : cut, part == 0 ? cut : nun, (const char*)((const bf16_t*)(p.ws + OFF_WIN) + (size_t)layer * DP * D), D};
    EpiIn E{(bf16_t*)(p.ws + OFF_PB), (bf16_t*)(p.ws + OFF_QRB), (bf16_t*)(p.ws + OFF_Q0B), (bf16_t*)(p.ws + OFF_KB), (bf16_t*)(p.ws + OFF_VB), (const float*)(p.ws + OFF_ROPE)};
    pg8::gemm_phase(( LAS unsigned char*)smem, (const char*)(p.ws + OFF_XNB), D, S, E, tid_of(p.wave_id));
}


namespace scn {
using att::bf16x8; using att::s16x4; using att::f32x16; using att::u32x4; using att::crow;
DEV int v_st64(int k, int c) { const int kk = (k & ~0xC) | ((k & 4) << 1) | ((k & 8) >> 1); return ((kk >> 3) * 2 + (c >> 5)) * 512 + ((kk & 7) * 32 + (c & 31)) * 2; }
constexpr int v_rd_off64(int d0, int ks, int half) { return d0 * 512 + ks * 2048 + half * 1024; }
#define SCN_PK(L, H) (bf16x8){L[0], L[1], L[2], L[3], H[0], H[1], H[2], H[3]}
template <int D0> DEV void frags4(int vb, bf16x8& f0, bf16x8& f1, bf16x8& f2, bf16x8& f3) {
    const s16x4 l0 = att::tr_read<v_rd_off64(D0, 0, 0)>(vb), h0 = att::tr_read<v_rd_off64(D0, 0, 1)>(vb), l1 = att::tr_read<v_rd_off64(D0, 1, 0)>(vb), h1 = att::tr_read<v_rd_off64(D0, 1, 1)>(vb);
    const s16x4 l2 = att::tr_read<v_rd_off64(D0, 2, 0)>(vb), h2 = att::tr_read<v_rd_off64(D0, 2, 1)>(vb), l3 = att::tr_read<v_rd_off64(D0, 3, 0)>(vb), h3 = att::tr_read<v_rd_off64(D0, 3, 1)>(vb);
    asm volatile("s_waitcnt lgkmcnt(0)" ::: "memory"); SBAR();
    f0 = SCN_PK(l0, h0); f1 = SCN_PK(l1, h1); f2 = SCN_PK(l2, h2); f3 = SCN_PK(l3, h3);
}
DEV bf16x8 pack8(const float (&v)[8]) { u32x4 w = {cvt_pk_bf16(v[0], v[1]), cvt_pk_bf16(v[2], v[3]), cvt_pk_bf16(v[4], v[5]), cvt_pk_bf16(v[6], v[7])}; return *reinterpret_cast<bf16x8*>(&w); }
DEV void stage64(char* img, const float* src, size_t ld, int lane, float sc = 1.f) {
    const float* row = src + (size_t)lane * ld;
#pragma unroll
    for (int c8 = 0; c8 < 8; ++c8) { const float4 a = *(const float4*)(row + c8 * 8), b = *(const float4*)(row + c8 * 8 + 4);
        u32x4 w = {cvt_pk_bf16(a.x * sc, a.y * sc), cvt_pk_bf16(a.z * sc, a.w * sc), cvt_pk_bf16(b.x * sc, b.y * sc), cvt_pk_bf16(b.z * sc, b.w * sc)};
        *(u32x4*)(img + v_st64(lane, c8 * 8)) = w; }
}
template <int CTRL, int RM> DEV float dpp_f(float oldv, float v, bool bc) { return bc ? __builtin_bit_cast(float, __builtin_amdgcn_update_dpp(__builtin_bit_cast(int, oldv), __builtin_bit_cast(int, v), CTRL, RM, 0xf, true))
                                                                                   : __builtin_bit_cast(float, __builtin_amdgcn_update_dpp(__builtin_bit_cast(int, oldv), __builtin_bit_cast(int, v), CTRL, RM, 0xf, false)); }
DEV float bperm(float v, int src) { return __builtin_bit_cast(float, __builtin_amdgcn_ds_bpermute(src << 2, __builtin_bit_cast(int, v))); }
DEV float scan_inc32(float v) {
    v += dpp_f<0x111, 0xf>(0.f, v, true); v += dpp_f<0x112, 0xf>(0.f, v, true); v += dpp_f<0x114, 0xf>(0.f, v, true); v += dpp_f<0x118, 0xf>(0.f, v, true);
    v += dpp_f<0x142, 0xa>(0.f, v, false);
    return v;
}
DEV float scanmax_inc32(float v) {
    const float ni = -3.0e38f;
    v = fmaxf(v, dpp_f<0x111, 0xf>(ni, v, false)); v = fmaxf(v, dpp_f<0x112, 0xf>(ni, v, false)); v = fmaxf(v, dpp_f<0x114, 0xf>(ni, v, false)); v = fmaxf(v, dpp_f<0x118, 0xf>(ni, v, false));
    v = fmaxf(v, dpp_f<0x142, 0xa>(ni, v, false));
    return v;
}
DEV float scanmax_suf32(float v, int lane) {
    const float ni = -3.0e38f;
    v = fmaxf(v, dpp_f<0x101, 0xf>(ni, v, false)); v = fmaxf(v, dpp_f<0x102, 0xf>(ni, v, false)); v = fmaxf(v, dpp_f<0x104, 0xf>(ni, v, false)); v = fmaxf(v, dpp_f<0x108, 0xf>(ni, v, false));
    const float t = bperm(v, (lane & 32) | 16);
    return (lane & 16) ? v : fmaxf(v, t);
}
DEV void ld8(const bf16_t* ub, unsigned boff, float (&v)[8]) { const u32x4 w = *(const u32x4*)((const char*)ub + boff);
    v[0] = __uint_as_float(w.x << 16); v[1] = __uint_as_float(w.x & 0xffff0000u); v[2] = __uint_as_float(w.y << 16); v[3] = __uint_as_float(w.y & 0xffff0000u);
    v[4] = __uint_as_float(w.z << 16); v[5] = __uint_as_float(w.z & 0xffff0000u); v[6] = __uint_as_float(w.w << 16); v[7] = __uint_as_float(w.w & 0xffff0000u); }
DEV float ld1(const bf16_t* ub, unsigned boff) { return __uint_as_float((unsigned)(*(const unsigned short*)((const char*)ub + boff)) << 16); }
DEV void stage64b(char* img, const bf16_t* src, size_t ld, int lane) {
    const bf16_t* row = src + (size_t)lane * ld;
#pragma unroll
    for (int c8 = 0; c8 < 8; ++c8) *(u32x4*)(img + v_st64(lane, c8 * 8)) = *(const u32x4*)(row + c8 * 8);
}
DEV float4 ldg4(const float* ub, unsigned boff) { return *(const float4*)((const char*)ub + boff); }
DEV float ldg1(const float* ub, unsigned boff) { return *(const float*)((const char*)ub + boff); }
DEV float fexp(float x) { return __expf(fminf(fmaxf(x, -80.f), 80.f)); }
DEV float fsig(float x) { return __builtin_amdgcn_rcpf(1.f + __expf(-x)); }
DEV void decay_ks(const float (&x)[2][8], const float (&lb)[8], int dir, int lane, float (&cum)[2][8], float (&kk)[2][8], float (&ref)[8]) {
#pragma unroll
    for (int tb = 0; tb < 2; ++tb)
#pragma unroll
        for (int j = 0; j < 8; ++j) { const float sg = fsig(x[tb][j]); kk[tb][j] = (1.f - lb[j]) * (1.f - sg); cum[tb][j] = __logf(fmaxf(lb[j] + (1.f - lb[j]) * sg, 1e-12f)); }
#pragma unroll
    for (int j = 0; j < 8; ++j) {
        const float i0 = scan_inc32(cum[0][j]), i1 = scan_inc32(cum[1][j]), t0 = bperm(i0, lane | 31), t1 = bperm(i1, lane | 31);
        if (dir == 0) { cum[0][j] = i0; cum[1][j] = i1 + t0; ref[j] = t0; }
        else { const float x0 = cum[0][j], x1 = cum[1][j]; cum[1][j] = t1 - i1 + x1; cum[0][j] = t0 - i0 + x0 + t1; ref[j] = t1; }
        if ((j & 3) == 3) SBAR();
    }
}
}

DEV void scanA_local(const Params& p, int layer, char* Lw, int bh, int tc, int lane) {
    using namespace scn;
    asm volatile("" : "+v"(lane));
    const int r32 = lane & 31, hi = lane >> 5, b = bh >> 2, h = bh & 3;
    const bf16_t* base = (const bf16_t*)(p.ws + OFF_PB) + (size_t)(b * SL + 64 * tc) * DP;
    unsigned lo = (unsigned)(r32 * DP + 8 * hi) * 2u;
    asm volatile("" : "+v"(lo));
    char* imgV = Lw; char* imgK = Lw + 8192;
    const int vbV = (int)(uintptr_t)imgV + att::v_rd_base(lane), vbK = vbV + 8192;
    stage64b(imgV, base + O_AI + h * 64, DP, lane);
#pragma unroll 1
    for (int dir = 0; dir < 2; ++dir) {
        const int chain = bh * 2 + dir, c = dir == 0 ? tc : (tc < 4 ? 3 - tc : 39 - tc);
#pragma unroll 1
        for (int ks = 0; ks < 4; ++ks) {
            const int ch = 16 * ks + 8 * hi;
            float x[2][8], cum[2][8], kk[2][8], ref[8], lb[8];
#pragma unroll
            for (int tb = 0; tb < 2; ++tb) ld8(base + (dir ? O_AFB : O_AFF) + h * 64 + 16 * ks, lo + tb * (32u * DP * 2u), x[tb]);
            { const float* l = (const float*)(p.ws + OFF_LB) + (layer * 2 + dir) * 256 + h * 64 + ch;
#pragma unroll
              for (int j = 0; j < 8; ++j) lb[j] = l[j]; }
            decay_ks(x, lb, dir, lane, cum, kk, ref);
            float ke[8];
#pragma unroll
            for (int tb = 0; tb < 2; ++tb) {
#pragma unroll
                for (int j = 0; j < 8; ++j) { const float ce = dir == 0 ? bperm(cum[1][j], lane | 31) : bperm(cum[0][j], lane & 32);
                    ke[j] = kk[tb][j] * fexp(ce - cum[tb][j]);
                    if (tb == 1 && dir == 0 && r32 == 31) ((float*)(p.ws + OFF_DECA))[(chain * 36 + c) * 64 + ch + j] = __expf(ce);
                    if (tb == 0 && dir == 1 && r32 == 0) ((float*)(p.ws + OFF_DECA))[(chain * 36 + c) * 64 + ch + j] = __expf(ce); }
                *(bf16x8*)(imgK + v_st64(32 * tb + r32, ch)) = pack8(ke);
            }
            SBAR();
        }
        f32x16 u[2][2] = {};
        { bf16x8 k0, k1, k2, k3, v0, v1, v2, v3;
          frags4<0>(vbK, k0, k1, k2, k3); frags4<0>(vbV, v0, v1, v2, v3);
          u[0][0] = __builtin_amdgcn_mfma_f32_32x32x16_bf16(k0, v0, u[0][0], 0, 0, 0); u[0][0] = __builtin_amdgcn_mfma_f32_32x32x16_bf16(k1, v1, u[0][0], 0, 0, 0);
          u[0][0] = __builtin_amdgcn_mfma_f32_32x32x16_bf16(k2, v2, u[0][0], 0, 0, 0); u[0][0] = __builtin_amdgcn_mfma_f32_32x32x16_bf16(k3, v3, u[0][0], 0, 0, 0);
          bf16x8 w0, w1, w2, w3; frags4<1>(vbV, w0, w1, w2, w3);
          u[0][1] = __builtin_amdgcn_mfma_f32_32x32x16_bf16(k0, w0, u[0][1], 0, 0, 0); u[0][1] = __builtin_amdgcn_mfma_f32_32x32x16_bf16(k1, w1, u[0][1], 0, 0, 0);
          u[0][1] = __builtin_amdgcn_mfma_f32_32x32x16_bf16(k2, w2, u[0][1], 0, 0, 0); u[0][1] = __builtin_amdgcn_mfma_f32_32x32x16_bf16(k3, w3, u[0][1], 0, 0, 0);
          frags4<1>(vbK, k0, k1, k2, k3);
          u[1][0] = __builtin_amdgcn_mfma_f32_32x32x16_bf16(k0, v0, u[1][0], 0, 0, 0); u[1][0] = __builtin_amdgcn_mfma_f32_32x32x16_bf16(k1, v1, u[1][0], 0, 0, 0);
          u[1][0] = __builtin_amdgcn_mfma_f32_32x32x16_bf16(k2, v2, u[1][0], 0, 0, 0); u[1][0] = __builtin_amdgcn_mfma_f32_32x32x16_bf16(k3, v3, u[1][0], 0, 0, 0);
          u[1][1] = __builtin_amdgcn_mfma_f32_32x32x16_bf16(k0, w0, u[1][1], 0, 0, 0); u[1][1] = __builtin_amdgcn_mfma_f32_32x32x16_bf16(k1, w1, u[1][1], 0, 0, 0);
          u[1][1] = __builtin_amdgcn_mfma_f32_32x32x16_bf16(k2, w2, u[1][1], 0, 0, 0); u[1][1] = __builtin_amdgcn_mfma_f32_32x32x16_bf16(k3, w3, u[1][1], 0, 0, 0); }
        float* U = (float*)(p.ws + OFF_UA) + ((size_t)chain * 36 + c) * 4096;
#pragma unroll
        for (int kb = 0; kb < 2; ++kb)
#pragma unroll
            for (int d0 = 0; d0 < 2; ++d0)
#pragma unroll
                for (int r = 0; r < 16; ++r) U[(32 * kb + crow(r, hi)) * 64 + 32 * d0 + r32] = u[kb][d0][r];
    }
}
DEV void scanA_out(const Params& p, int layer, char* Lw, int bh, int tc, int lane) {
    using namespace scn;
    asm volatile("" : "+v"(lane));
    const int r32 = lane & 31, hi = lane >> 5, b = bh >> 2, h = bh & 3;
    const bf16_t* base = (const bf16_t*)(p.ws + OFF_PB) + (size_t)(b * SL + 64 * tc) * DP;
    unsigned lo = (unsigned)(r32 * DP + 8 * hi) * 2u;
    asm volatile("" : "+v"(lo));
    char* imgV = Lw; char* imgS = Lw + 8192;
    const int vbV = (int)(uintptr_t)imgV + att::v_rd_base(lane), vbS = vbV + 8192;
    stage64b(imgV, base + O_AI + h * 64, DP, lane);
    f32x16 o[2][2] = {};
#pragma unroll 1
    for (int dir = 0; dir < 2; ++dir) {
        const int chain = bh * 2 + dir, c = dir == 0 ? tc : (tc < 4 ? 3 - tc : 39 - tc);
        const float* S0g = (const float*)(p.ws + OFF_SA) + ((size_t)chain * 36 + c) * 4096;
        f32x16 pd0 = {}, pd1 = {}, px = {};
#define MM(acc, A, B) acc = __builtin_amdgcn_mfma_f32_32x32x16_bf16(A, B, acc, 0, 0, 0)
#define LOADX(ks) do { _Pragma("unroll") for (int tb = 0; tb < 2; ++tb) ld8(base + (dir ? O_AFB : O_AFF) + h * 64 + 16 * (ks), lo + tb * (32u * DP * 2u), xr[tb]); } while (0)
#define LOADQ(ks) do { _Pragma("unroll") for (int tb = 0; tb < 2; ++tb) ld8(base + O_AQ + h * 64 + 16 * (ks), lo + tb * (32u * DP * 2u), qr[tb]); } while (0)
        float xr[2][8], qr[2][8];
#define KSTEP(ks) do { \
            const int ch = 16 * (ks) + 8 * hi; \
            float cum[2][8], kk[2][8], ref[8], lb[8]; \
            { const float* l = (const float*)(p.ws + OFF_LB) + (layer * 2 + dir) * 256 + h * 64 + ch; _Pragma("unroll") for (int j = 0; j < 8; ++j) lb[j] = l[j]; } \
            const int ci = lane >> 2; const int row = 16 * (ks) + ci, c16 = (lane & 3) * 16; const float* sp = S0g + row * 64 + c16; \
            LOADX(ks); LOADQ(ks); decay_ks(xr, lb, dir, lane, cum, kk, ref); \
            const float4 sa = *(const float4*)sp, sb4 = *(const float4*)(sp + 4), sc4 = *(const float4*)(sp + 8), sd4 = *(const float4*)(sp + 12); \
              \
            { const int sj = ci & 7, sl = (ci >> 3) * 32; float rv = 0.f; \
              _Pragma("unroll") for (int j = 0; j < 8; ++j) { const float t = bperm(ref[j], sl); rv = (sj == j) ? t : rv; } \
              const float er = __expf(fmaxf(rv, -80.f)); \
              u32x4 w0 = {cvt_pk_bf16(sa.x * er, sa.y * er), cvt_pk_bf16(sa.z * er, sa.w * er), cvt_pk_bf16(sb4.x * er, sb4.y * er), cvt_pk_bf16(sb4.z * er, sb4.w * er)}; \
              u32x4 w1 = {cvt_pk_bf16(sc4.x * er, sc4.y * er), cvt_pk_bf16(sc4.z * er, sc4.w * er), cvt_pk_bf16(sd4.x * er, sd4.y * er), cvt_pk_bf16(sd4.z * er, sd4.w * er)}; \
              *(u32x4*)(imgS + v_st64(row, c16)) = w0; *(u32x4*)(imgS + v_st64(row, c16 + 8)) = w1; } \
            bf16x8 qt0, qt1, kt0, kt1; \
            _Pragma("unroll") for (int tb = 0; tb < 2; ++tb) { \
                float t1[8], t2[8]; \
                _Pragma("unroll") for (int j = 0; j < 8; ++j) { const float q = qr[tb][j] * fsig(qr[tb][j]); t1[j] = q * fexp(cum[tb][j] - ref[j]); t2[j] = kk[tb][j] * fexp(ref[j] - cum[tb][j]); } \
                if (tb == 0) { qt0 = pack8(t1); kt0 = pack8(t2); } else { qt1 = pack8(t1); kt1 = pack8(t2); } } \
            MM(pd0, kt0, qt0); MM(pd1, kt1, qt1); if (dir == 0) MM(px, kt0, qt1); else MM(px, kt1, qt0); \
            { const s16x4 l0 = att::tr_read<v_rd_off64(0, ks, 0)>(vbS), h0 = att::tr_read<v_rd_off64(0, ks, 1)>(vbS), l1 = att::tr_read<v_rd_off64(1, ks, 0)>(vbS), h1 = att::tr_read<v_rd_off64(1, ks, 1)>(vbS); \
              asm volatile("s_waitcnt lgkmcnt(0)" ::: "memory"); SBAR(); \
              const bf16x8 s0 = SCN_PK(l0, h0), s1 = SCN_PK(l1, h1); \
              MM(o[0][0], qt0, s0); MM(o[1][0], qt1, s0); MM(o[0][1], qt0, s1); MM(o[1][1], qt1, s1); } \
            SBAR(); } while (0)
        KSTEP(0); KSTEP(1); KSTEP(2); KSTEP(3);
#undef KSTEP
#undef LOADX
#undef LOADQ
        const int r32m = r32;
#pragma unroll
        for (int r = 0; r < 16; ++r) { const int sl = crow(r, hi); const bool keep = dir == 0 ? (sl <= r32m) : (sl >= r32m); pd0[r] = keep ? pd0[r] : 0.f; pd1[r] = keep ? pd1[r] : 0.f; }
        bf16x8 a0, a1, b0, b1, c0, c1;
#define PK4(P, BASE, OUT) do { unsigned a0_ = cvt_pk_bf16(P[BASE + 0], P[BASE + 1]), a1_ = cvt_pk_bf16(P[BASE + 2], P[BASE + 3]);   \
    unsigned b0_ = cvt_pk_bf16(P[BASE + 4], P[BASE + 5]), b1_ = cvt_pk_bf16(P[BASE + 6], P[BASE + 7]);                              \
    auto r0_ = __builtin_amdgcn_permlane32_swap(a0_, b0_, false, false); auto r1_ = __builtin_amdgcn_permlane32_swap(a1_, b1_, false, false); \
    u32x4 w_ = {r0_[0], r1_[0], r0_[1], r1_[1]}; OUT = *reinterpret_cast<bf16x8*>(&w_); } while (0)
        PK4(pd0, 0, a0); PK4(pd0, 8, a1); PK4(pd1, 0, b0); PK4(pd1, 8, b1); PK4(px, 0, c0); PK4(px, 8, c1);
#undef PK4
        {   bf16x8 v0, v1, v2, v3;
#define BLOCK(D0) do { frags4<D0>(vbV, v0, v1, v2, v3); \
            if (dir == 0) { MM(o[0][D0], a0, v0); MM(o[0][D0], a1, v1); MM(o[1][D0], c0, v0); MM(o[1][D0], c1, v1); MM(o[1][D0], b0, v2); MM(o[1][D0], b1, v3); } \
            else          { MM(o[0][D0], a0, v0); MM(o[0][D0], a1, v1); MM(o[0][D0], c0, v2); MM(o[0][D0], c1, v3); MM(o[1][D0], b0, v2); MM(o[1][D0], b1, v3); } } while (0)
            BLOCK(0); BLOCK(1);
#undef BLOCK
        }
#undef MM
    }
    unsigned rob = (unsigned)(4 * hi * DP + r32) * 2u, mob = (unsigned)(4 * hi * D + r32) * 2u;
    asm volatile("" : "+v"(rob), "+v"(mob));
    float gv[2][16][2];
#pragma unroll
    for (int tb = 0; tb < 2; ++tb)
#pragma unroll
        for (int r = 0; r < 16; ++r) { const unsigned go = rob + (unsigned)(32 * tb + (r & 3) + 8 * (r >> 2)) * (DP * 2u); const bf16_t* gb = base + O_AG + h * 64;
            gv[tb][r][0] = ld1(gb, go); gv[tb][r][1] = ld1(gb, go + 64u); }
#pragma unroll
    for (int tb = 0; tb < 2; ++tb)
#pragma unroll
        for (int r = 0; r < 16; ++r) {
            const float x0 = o[tb][0][r], x1 = o[tb][1][r];
            float t = x0 * x0 + x1 * x1; t += bperm(t, lane ^ 1); t += bperm(t, lane ^ 2); t += bperm(t, lane ^ 4); t += bperm(t, lane ^ 8); t += bperm(t, lane ^ 16);
            const float ri = rsqrtf(t * (1.f / 64.f) + 1e-6f);
            const unsigned tcst = (unsigned)(32 * tb + (r & 3) + 8 * (r >> 2));
            const float g0 = gv[tb][r][0], g1 = gv[tb][r][1];
            char* mb = (char*)((bf16_t*)(p.ws + OFF_MIXB) + (size_t)(b * SL + 64 * tc) * D + h * 64); const unsigned mo = mob + tcst * (D * 2u);
            *(bf16_t*)(mb + mo) = (bf16_t)(cvt_pk_bf16(x0 * ri * p.hnorm[layer * 64 + r32] * (g0 * fsig(g0)), 0.f) & 0xffffu);
            *(bf16_t*)(mb + mo + 64u) = (bf16_t)(cvt_pk_bf16(x1 * ri * p.hnorm[layer * 64 + 32 + r32] * (g1 * fsig(g1)), 0.f) & 0xffffu);
        }
}

namespace scn {
DEV float logsig_f(float g) { return fminf(g, 0.f) - __logf(1.f + __expf(-fabsf(g))); }
DEV void gates_B(const bf16_t* gb  , unsigned rowoff, int dir, float bi, float bf, int lane, float (&cumf)[2], float (&g)[2], float (&G)[2], float& cend, float& gmax) {
    float lf[2], li[2];
#pragma unroll
    for (int tb = 0; tb < 2; ++tb) { const unsigned bo = rowoff + tb * (32u * DP * 2u); li[tb] = ld1(gb + (dir * 2 + 0) * 4, bo) + bi; lf[tb] = logsig_f(ld1(gb + (dir * 2 + 1) * 4, bo) + bf); }
    { const float i0 = scan_inc32(lf[0]), i1 = scan_inc32(lf[1]), t0 = bperm(i0, lane | 31), t1 = bperm(i1, lane | 31);
      if (dir == 0) { cumf[0] = i0; cumf[1] = i1 + t0; } else { cumf[1] = t1 - i1 + lf[1]; cumf[0] = t0 - i0 + lf[0] + t1; }
      cend = t0 + t1; }
    g[0] = li[0] - cumf[0]; g[1] = li[1] - cumf[1];
    if (dir == 0) { const float a0 = scanmax_inc32(g[0]), m0 = bperm(a0, lane | 31), a1 = fmaxf(scanmax_inc32(g[1]), m0); G[0] = a0; G[1] = a1; gmax = bperm(a1, lane | 31); }
    else { const float a1 = scanmax_suf32(g[1], lane), m1 = bperm(a1, lane & 32), a0 = fmaxf(scanmax_suf32(g[0], lane), m1); G[0] = a0; G[1] = a1; gmax = bperm(a0, lane & 32); }
}
}
DEV void scanB_local(const Params& p, int layer, char* Lw, int bh, int tc, int lane) {
    using namespace scn;
    asm volatile("" : "+v"(lane));
    const int r32 = lane & 31, hi = lane >> 5, b = bh >> 2, h = bh & 3;
    const bf16_t* base = (const bf16_t*)(p.ws + OFF_PB) + (size_t)(b * SL + 64 * tc) * DP;
    unsigned ro = (unsigned)(r32 * DP) * 2u; asm volatile("" : "+v"(ro));
    char* imgV = Lw; char* imgK = Lw + 8192;
    const int vbV = (int)(uintptr_t)imgV + att::v_rd_base(lane), vbK = vbV + 8192;
    stage64b(imgV, base + O_BV + h * 64, DP, lane);
#pragma unroll 1
    for (int dir = 0; dir < 2; ++dir) {
        const int chain = bh * 2 + dir, c = dir == 0 ? tc : (tc < 4 ? 3 - tc : 39 - tc);
        const float bi = p.mgb[layer * 16 + (dir * 2 + 0) * 4 + h], bf = p.mgb[layer * 16 + (dir * 2 + 1) * 4 + h];
        float cumf[2], g[2], G[2], cend, gmax;
        gates_B(base + O_BG + h, ro, dir, bi, bf, lane, cumf, g, G, cend, gmax);
        const float w[2] = {__expf(g[0] - gmax), __expf(g[1] - gmax)};
#pragma unroll
        for (int ks = 0; ks < 2; ++ks) {
            float un[8];
#pragma unroll
            for (int j = 0; j < 8; ++j) un[j] = 0.f;
#pragma unroll
            for (int tb = 0; tb < 2; ++tb) { float wk[8]; ld8(base + O_BK + h * 32 + 16 * ks, ro + 16u * hi + tb * (32u * DP * 2u), wk);
#pragma unroll
                for (int j = 0; j < 8; ++j) { wk[j] *= w[tb]; un[j] += wk[j]; }
                *(bf16x8*)(imgK + v_st64(32 * tb + r32, 16 * ks + 8 * hi)) = pack8(wk); }
#pragma unroll
            for (int j = 0; j < 8; ++j) { float t = un[j]; t += bperm(t, lane ^ 1); t += bperm(t, lane ^ 2); t += bperm(t, lane ^ 4); t += bperm(t, lane ^ 8); t += bperm(t, lane ^ 16);
                if (r32 == 0) ((float*)(p.ws + OFF_NB))[(chain * 36 + c) * 32 + 16 * ks + 8 * hi + j] = t; }
        }
        f32x16 u0 = {}, u1 = {};
        { bf16x8 k0, k1, k2, k3, v0, v1, v2, v3;
#define MM(acc, A, B) acc = __builtin_amdgcn_mfma_f32_32x32x16_bf16(A, B, acc, 0, 0, 0)
          frags4<0>(vbK, k0, k1, k2, k3); frags4<0>(vbV, v0, v1, v2, v3);
          MM(u0, k0, v0); MM(u0, k1, v1); MM(u0, k2, v2); MM(u0, k3, v3);
          frags4<1>(vbV, v0, v1, v2, v3);
          MM(u1, k0, v0); MM(u1, k1, v1); MM(u1, k2, v2); MM(u1, k3, v3);
#undef MM
        }
        float* U = (float*)(p.ws + OFF_UB) + ((size_t)chain * 36 + c) * 2048;
#pragma unroll
        for (int r = 0; r < 16; ++r) { U[crow(r, hi) * 64 + r32] = u0[r]; U[crow(r, hi) * 64 + 32 + r32] = u1[r]; }
        if (lane == 0) { float* M = (float*)(p.ws + OFF_MB) + (chain * 36 + c) * 4; M[0] = cend + gmax; M[1] = cend; }
    }
}
DEV void scanB_out(const Params& p, int layer, char* Lw, int bh, int tc, int lane) {
    using namespace scn;
    asm volatile("" : "+v"(lane));
    const int r32 = lane & 31, hi = lane >> 5, b = bh >> 2, h = bh & 3;
    const bf16_t* base = (const bf16_t*)(p.ws + OFF_PB) + (size_t)(b * SL + 64 * tc) * DP;
    unsigned ro = (unsigned)(r32 * DP) * 2u; asm volatile("" : "+v"(ro));
    char* imgV = Lw; char* imgC = Lw + 8192; float* gA = (float*)(Lw + 12288); float* dA = gA + 64;
    const int vbV = (int)(uintptr_t)imgV + att::v_rd_base(lane), vbC = vbV + 8192;
    stage64b(imgV, base + O_BV + h * 64, DP, lane);
#pragma unroll 1
    for (int dir = 0; dir < 2; ++dir) {
        const int chain = bh * 2 + dir, c = dir == 0 ? tc : (tc < 4 ? 3 - tc : 39 - tc);
        const float bi = p.mgb[layer * 16 + (dir * 2 + 0) * 4 + h], bf = p.mgb[layer * 16 + (dir * 2 + 1) * 4 + h];
        { const float* cg = (const float*)(p.ws + OFF_SB) + ((size_t)chain * 36 + c) * 2048 + (lane >> 1) * 64 + (lane & 1) * 32;
#pragma unroll
          for (int i = 0; i < 4; ++i) { const float4 a = *(const float4*)(cg + 8 * i), bq = *(const float4*)(cg + 8 * i + 4);
              u32x4 w = {cvt_pk_bf16(a.x, a.y), cvt_pk_bf16(a.z, a.w), cvt_pk_bf16(bq.x, bq.y), cvt_pk_bf16(bq.z, bq.w)};
              *(u32x4*)(imgC + v_st64(lane >> 1, (lane & 1) * 32 + 8 * i)) = w; } }
        const float m0 = ((const float*)(p.ws + OFF_MB))[(chain * 36 + c) * 4 + 2];
        float rq[2][2][8], rk[2][2][8];
#pragma unroll
        for (int ks = 0; ks < 2; ++ks)
#pragma unroll
            for (int tb = 0; tb < 2; ++tb) { const unsigned bo = ro + 16u * hi + tb * (32u * DP * 2u);
                ld8(base + O_BQ + h * 32 + 16 * ks, bo, rq[ks][tb]); ld8(base + O_BK + h * 32 + 16 * ks, bo, rk[ks][tb]); }
        float cumf[2], g[2], G[2], cend, gmax;
        gates_B(base + O_BG + h, ro, dir, bi, bf, lane, cumf, g, G, cend, gmax);
        float wi[2], wl[2], emt[2];
#pragma unroll
        for (int tb = 0; tb < 2; ++tb) { const float ml = cumf[tb] + G[tb], mt = fmaxf(cumf[tb] + m0, ml); wi[tb] = __expf(cumf[tb] + m0 - mt); wl[tb] = __expf(ml - mt); emt[tb] = __expf(-mt); }
        if (hi == 0) { gA[r32] = g[0]; gA[32 + r32] = g[1]; }
        f32x16 pd0 = {}, pd1 = {}, px = {};
        float qn[2] = {0.f, 0.f};
        bf16x8 qw[2][2];
#define MM(acc, A, B) acc = __builtin_amdgcn_mfma_f32_32x32x16_bf16(A, B, acc, 0, 0, 0)
#define KSTEP(ks) do { \
            bf16x8 qs0, qs1, kt0, kt1; \
            const float* nn = (const float*)(p.ws + OFF_N0) + (chain * 36 + c) * 32 + 16 * (ks) + 8 * hi; \
            _Pragma("unroll") for (int tb = 0; tb < 2; ++tb) { \
                float q8[8], k8[8], qv[8]; \
                _Pragma("unroll") for (int j = 0; j < 8; ++j) { q8[j] = rq[ks][tb][j] * 0.17677669529663687f; k8[j] = rk[ks][tb][j]; qn[tb] += q8[j] * nn[j]; qv[j] = q8[j] * wi[tb]; } \
                qw[tb][ks] = pack8(qv); \
                if (tb == 0) { qs0 = pack8(q8); kt0 = pack8(k8); } else { qs1 = pack8(q8); kt1 = pack8(k8); } } \
            MM(pd0, kt0, qs0); MM(pd1, kt1, qs1); if (dir == 0) MM(px, kt0, qs1); else MM(px, kt1, qs0); \
            SBAR(); } while (0)
        KSTEP(0); KSTEP(1);
#undef KSTEP
        qn[0] += bperm(qn[0], lane ^ 32); qn[1] += bperm(qn[1], lane ^ 32);
        float ds[2] = {0.f, 0.f};
#pragma unroll
        for (int r = 0; r < 16; ++r) {
            const int sl = crow(r, hi); const bool keep = dir == 0 ? (sl <= r32) : (sl >= r32);
            const float g0 = gA[sl], g1 = gA[32 + sl];
            const float e00 = keep ? __expf(g0 - G[0]) * wl[0] : 0.f, e11 = keep ? __expf(g1 - G[1]) * wl[1] : 0.f;
            const float ex = dir == 0 ? __expf(g0 - G[1]) * wl[1] : __expf(g1 - G[0]) * wl[0];
            pd0[r] *= e00; pd1[r] *= e11; px[r] *= ex;
            if (dir == 0) { ds[0] += pd0[r]; ds[1] += pd1[r] + px[r]; } else { ds[0] += pd0[r] + px[r]; ds[1] += pd1[r]; }
        }
        ds[0] += bperm(ds[0], lane ^ 32); ds[1] += bperm(ds[1], lane ^ 32);
#pragma unroll
        for (int tb = 0; tb < 2; ++tb) { const float den = wi[tb] * qn[tb] + ds[tb]; const float di = __builtin_amdgcn_rcpf(fmaxf(fabsf(den), emt[tb])); if (hi == 0) dA[32 * tb + r32] = di; }
        bf16x8 a0, a1, b0, b1, c0, c1;
#define PK4(P, BASE, OUT) do { unsigned a0_ = cvt_pk_bf16(P[BASE + 0], P[BASE + 1]), a1_ = cvt_pk_bf16(P[BASE + 2], P[BASE + 3]);   \
    unsigned b0_ = cvt_pk_bf16(P[BASE + 4], P[BASE + 5]), b1_ = cvt_pk_bf16(P[BASE + 6], P[BASE + 7]);                              \
    auto r0_ = __builtin_amdgcn_permlane32_swap(a0_, b0_, false, false); auto r1_ = __builtin_amdgcn_permlane32_swap(a1_, b1_, false, false); \
    u32x4 w_ = {r0_[0], r1_[0], r0_[1], r1_[1]}; OUT = *reinterpret_cast<bf16x8*>(&w_); } while (0)
        PK4(pd0, 0, a0); PK4(pd0, 8, a1); PK4(pd1, 0, b0); PK4(pd1, 8, b1); PK4(px, 0, c0); PK4(px, 8, c1);
#undef PK4
        SBAR();
        f32x16 o[2][2] = {};
        {   bf16x8 v0, v1, v2, v3;
#define BLOCK(D0) do { frags4<D0>(vbV, v0, v1, v2, v3); \
            if (dir == 0) { MM(o[0][D0], a0, v0); MM(o[0][D0], a1, v1); MM(o[1][D0], c0, v0); MM(o[1][D0], c1, v1); MM(o[1][D0], b0, v2); MM(o[1][D0], b1, v3); } \
            else          { MM(o[0][D0], a0, v0); MM(o[0][D0], a1, v1); MM(o[0][D0], c0, v2); MM(o[0][D0], c1, v3); MM(o[1][D0], b0, v2); MM(o[1][D0], b1, v3); } \
            { const s16x4 l0 = att::tr_read<v_rd_off64(D0, 0, 0)>(vbC), h0 = att::tr_read<v_rd_off64(D0, 0, 1)>(vbC), l1 = att::tr_read<v_rd_off64(D0, 1, 0)>(vbC), h1 = att::tr_read<v_rd_off64(D0, 1, 1)>(vbC); \
              asm volatile("s_waitcnt lgkmcnt(0)" ::: "memory"); SBAR(); \
              const bf16x8 s0 = SCN_PK(l0, h0), s1 = SCN_PK(l1, h1); \
              MM(o[0][D0], qw[0][0], s0); MM(o[0][D0], qw[0][1], s1); MM(o[1][D0], qw[1][0], s0); MM(o[1][D0], qw[1][1], s1); } } while (0)
            BLOCK(0); BLOCK(1);
#undef BLOCK
        }
#undef MM
        asm volatile("s_waitcnt lgkmcnt(0)" ::: "memory");
        unsigned rob = (unsigned)(4 * hi * DP + r32) * 2u, mob = (unsigned)(4 * hi * D + r32) * 2u, hob = (unsigned)(4 * hi * 256 + r32) * 4u;
        asm volatile("" : "+v"(rob), "+v"(mob), "+v"(hob));
        float* hpk = (float*)(p.ws + OFF_HB2) + (size_t)(b * SL + 64 * tc) * 256 + h * 64;
        if (dir == 0) {
#pragma unroll
            for (int tb = 0; tb < 2; ++tb)
#pragma unroll
                for (int r = 0; r < 16; ++r) { const float di = dA[32 * tb + crow(r, hi)]; const unsigned ho = hob + (unsigned)(32 * tb + (r & 3) + 8 * (r >> 2)) * 1024u;
                    *(float*)((char*)hpk + ho) = o[tb][0][r] * di; *(float*)((char*)hpk + ho + 128u) = o[tb][1][r] * di; }
            asm volatile("s_waitcnt vmcnt(0)" ::: "memory");
        } else {
#pragma unroll
            for (int tb = 0; tb < 2; ++tb)
#pragma unroll
                for (int r = 0; r < 16; ++r) {
                    const unsigned tcst = (unsigned)(32 * tb + (r & 3) + 8 * (r >> 2)); const unsigned ho = hob + tcst * 1024u;
                    const float di = dA[32 * tb + crow(r, hi)];
                    const float x0 = o[tb][0][r] * di + ldg1(hpk, ho), x1 = o[tb][1][r] * di + ldg1(hpk, ho + 128u);
                    float t = x0 * x0 + x1 * x1; t += bperm(t, lane ^ 1); t += bperm(t, lane ^ 2); t += bperm(t, lane ^ 4); t += bperm(t, lane ^ 8); t += bperm(t, lane ^ 16);
                    const float ri = rsqrtf(t * (1.f / 64.f) + 1e-6f);
                    const bf16_t* gb = base + O_BO + h * 64; const unsigned go = rob + tcst * (DP * 2u);
                    const float g0 = ld1(gb, go), g1 = ld1(gb, go + 64u);
                    char* mb = (char*)((bf16_t*)(p.ws + OFF_MIXB) + (size_t)(b * SL + 64 * tc) * D + 256 + h * 64); const unsigned mo = mob + tcst * (D * 2u);
                    *(bf16_t*)(mb + mo) = (bf16_t)(cvt_pk_bf16(x0 * ri * p.mnorm[layer * 256 + h * 64 + r32] * fsig(g0), 0.f) & 0xffffu);
                    *(bf16_t*)(mb + mo + 64u) = (bf16_t)(cvt_pk_bf16(x1 * ri * p.mnorm[layer * 256 + h * 64 + 32 + r32] * fsig(g1), 0.f) & 0xffffu);
                    if ((r & 3) == 3) SBAR();
                }
        }
    }
}

DEV int scan_token(int dir, int step) { return dir == 0 ? step : (step < CTX ? CTX - 1 - step : SL + CTX - 1 - step); }
DEV float logsig(float g) { return fminf(g, 0.f) - log1pf(expf(-fabsf(g))); }
DEV void ph_scan_local(const Params& p, int layer, char* smem) {
    const int wid = p.wave_id;
    const int G = (int)gridDim.x, nw = G * 8, nun = (NT / 256) * (DP / 256), nleft = 4 * G < nun ? nun - 4 * G : 0, nfree = G - nleft > 0 ? G - nleft : G;
    for (int it = 0; it < 2; ++it) {
        int task;
        if (it == 0) task = (int)blockIdx.x * 8 + wid;
        else { if ((int)blockIdx.x >= nfree) break; task = nw + wid * nfree + (int)blockIdx.x; }
        if (task >= 2304) break;
        const int lane = lane_asm();
        if (task < 1152) scanA_local(p, layer, smem + wid * 16384, task / 36, task % 36, lane);
        else scanB_local(p, layer, smem + wid * 16384, (task - 1152) / 36, (task - 1152) % 36, lane);
    }
}
DEV void ph_scan_carry(const Params& p, char* smem) {
    const int tid = tid_of(p.wave_id);
    const int gt = (int)blockIdx.x * 512 + tid, nth = (int)gridDim.x * 512;
    for (int e = gt; e < 64 * 4096; e += nth) {
        const int chain = e >> 12, kv = e & 4095, k = kv >> 6;
        const float* U = (const float*)(p.ws + OFF_UA) + (size_t)chain * 36 * 4096 + kv; float* SO = (float*)(p.ws + OFF_SA) + (size_t)chain * 36 * 4096 + kv; const float* Dc = (const float*)(p.ws + OFF_DECA) + chain * 36 * 64 + k;
        float S = 0.f;
#pragma unroll 4
        for (int c = 0; c < 36; ++c) { const float u = U[(size_t)c * 4096], d = Dc[c * 64]; SO[(size_t)c * 4096] = S; S = d * S + u; }
    }
    for (int e = gt; e < 64 * 2048; e += nth) {
        const int chain = e >> 11, kv = e & 2047;
        const float* U = (const float*)(p.ws + OFF_UB) + (size_t)chain * 36 * 2048 + kv; float* SO = (float*)(p.ws + OFF_SB) + (size_t)chain * 36 * 2048 + kv; const float* M = (const float*)(p.ws + OFF_MB) + chain * 36 * 4;
        float Cc = 0.f, m = 0.f;
#pragma unroll 4
        for (int c = 0; c < 36; ++c) { const float mle = M[c * 4 + 0], ce = M[c * 4 + 1], u = U[(size_t)c * 2048]; SO[(size_t)c * 2048] = Cc;
            const float mn = fmaxf(ce + m, mle); Cc = expf(ce + m - mn) * Cc + expf(mle - mn) * u; m = mn; }
    }
    for (int e = gt; e < 64 * 32; e += nth) {
        const int chain = e >> 5, k = e & 31;
        const float* N = (const float*)(p.ws + OFF_NB) + chain * 36 * 32 + k; float* NO = (float*)(p.ws + OFF_N0) + chain * 36 * 32 + k; float* M = (float*)(p.ws + OFF_MB) + chain * 36 * 4;
        float nn = 0.f, m = 0.f;
        for (int c = 0; c < 36; ++c) { const float mle = M[c * 4 + 0], ce = M[c * 4 + 1], u = N[c * 32]; NO[c * 32] = nn; if (k == 0) M[c * 4 + 2] = m;
            const float mn = fmaxf(ce + m, mle); nn = expf(ce + m - mn) * nn + expf(mle - mn) * u; m = mn; }
    }
}
DEV void ph_scan_out(const Params& p, int layer, char* smem) {
    const int wid = p.wave_id;
    const int nw = (int)gridDim.x * 8, ntc = layer == 0 ? 36 : 32, tc0 = layer == 0 ? 0 : 4, half = 32 * ntc, total = 2 * half;
    for (int it = 0; it < 2 + (total - nw > 0 ? (total - nw) / (int)gridDim.x : 0); ++it) {
        int task;
        if (it == 0) task = (int)blockIdx.x * 8 + wid;
        else { if (wid != 0) break; task = nw + (it - 1) * (int)gridDim.x + (int)blockIdx.x; }
        if (task >= total) break;
        const int lane = lane_asm();
        const bool isB = task >= half; const int tt = isB ? task - half : task, bh = tt / ntc, tc = tc0 + tt % ntc;
        if (!isB) scanA_out(p, layer, smem + wid * 16384, bh, tc, lane);
        else scanB_out(p, layer, smem + wid * 16384, bh, tc, lane);
    }
}

DEV void ph_attn(const Params& p, int layer, char* smem) {
    const int wid = p.wave_id, js = wid & 1, qb = wid >> 1;
    const float lam = ((const float*)(p.ws + OFF_LAM))[layer], omli = 1.f - lam_init_of(layer);
    const bf16_t* KB = (const bf16_t*)(p.ws + OFF_KB); const bf16_t* VB = (const bf16_t*)(p.ws + OFF_VB);
    const bf16_t* QRB = (const bf16_t*)(p.ws + OFF_QRB); const bf16_t* Q0B = (const bf16_t*)(p.ws + OFF_Q0B);
    const int G = (int)gridDim.x, c = (int)blockIdx.x;
    const int nlat = 512, ntot = nlat + (layer == 0 ? 64 : 0);
    for (int i = 0;; ++i) {
        int bh, s0; bool isctx;
        if (G == 256) {
            const int xcd = c & 7, j = c >> 3;
            if (i < 2) { bh = xcd + 8 * (i * 2 + (j >> 4)); s0 = CTX + (j & 15) * 128; isctx = false; }
            else if (i == 2 && layer == 0 && j < 8) { bh = xcd + 8 * (j >> 1); s0 = (j & 1) * 128; isctx = true; }
            else break;
        } else {
            const int u = i * G + c; if (u >= ntot) break;
            if (u < nlat) { bh = u >> 4; s0 = CTX + (u & 15) * 128; isctx = false; } else { const int v = u - nlat; bh = v >> 1; s0 = (v & 1) * 128; isctx = true; }
        }
        const int lane = lane_asm(), tid = (wid << 6) | lane, r32 = lane & 31, hi = lane >> 5;
        const bf16_t* Kh = KB + (size_t)bh * SL * 128; const bf16_t* Vh = VB + (size_t)bh * SL * 128;
        const size_t qoff = ((size_t)bh * SL + s0 + qb * 32 + r32) * 128 + js * 64 + hi * 8;
        att::bf16x8 qr[4];
#pragma unroll
        for (int d0 = 0; d0 < 4; ++d0) qr[d0] = *(const att::bf16x8*)(Q0B + qoff + d0 * 16);
        float m_reg = -1e30f, l_reg = 0.f; att::f32x16 o[4] = {};
        att::attn_tiles(qr, Kh, Vh, CTX, smem, m_reg, l_reg, o, tid, js);
        if (!isctx) {
#pragma unroll
            for (int d0 = 0; d0 < 4; ++d0) qr[d0] = *(const att::bf16x8*)(QRB + qoff + d0 * 16);
            att::attn_tiles(qr, Kh + (size_t)CTX * 128, Vh + (size_t)CTX * 128, SEQ, smem, m_reg, l_reg, o, tid, js);
        }
        float* wsw = (float*)(smem + 2 * att::SHM_V + 2 * att::SHM_K) + wid * 64;
        __syncthreads();
        if (hi == 0) wsw[r32] = l_reg;
        asm volatile("s_waitcnt lgkmcnt(0)" ::: "memory");
        float rli[16];
#pragma unroll
        for (int r = 0; r < 16; ++r) rli[r] = __builtin_amdgcn_rcpf(wsw[att::crow(r, hi)]);
        float* X = (float*)smem + qb * 4096;
        if (js == 1) {
#pragma unroll
            for (int d0 = 0; d0 < 4; ++d0)
#pragma unroll
                for (int r = 0; r < 16; ++r) X[(d0 * 16 + r) * 64 + lane] = o[d0][r] * rli[r];
        }
        __syncthreads();
        if (js == 0) {
            const int b = bh >> 2, h = bh & 3;
            float ss[16];
#pragma unroll
            for (int r = 0; r < 16; ++r) ss[r] = 0.f;
#pragma unroll
            for (int d0 = 0; d0 < 4; ++d0)
#pragma unroll
                for (int r = 0; r < 16; ++r) { const float v = o[d0][r] * rli[r] - lam * X[(d0 * 16 + r) * 64 + lane]; o[d0][r] = v; ss[r] += v * v; }
#pragma unroll
            for (int r = 0; r < 16; ++r) { float t = ss[r]; t += __shfl_xor(t, 1); t += __shfl_xor(t, 2); t += __shfl_xor(t, 4); t += __shfl_xor(t, 8); t += __shfl_xor(t, 16);
                ss[r] = rsqrtf(t * (1.f / 128.f) + 1e-6f) * omli; }
            bf16_t* mix = (bf16_t*)(p.ws + OFF_MIXB) + (size_t)(b * SL + s0 + qb * 32) * D + 512 + h * 128 + r32;
#pragma unroll
            for (int d0 = 0; d0 < 4; ++d0) { const float g = p.dnorm[layer * 128 + d0 * 32 + r32];
#pragma unroll
                for (int r = 0; r < 16; ++r) mix[(size_t)att::crow(r, hi) * D + d0 * 32] = (bf16_t)(cvt_pk_bf16(o[d0][r] * ss[r] * g, 0.f) & 0xffffu); }
        }
        __syncthreads();
    }
}

struct EpiRowsBf16 {
    static constexpr bool PERM = true;
    bf16_t* O; int ldc;
    DEV void operator()(const pg8::f32x4 (&acc)[2][2][4][2], const pg8::Unit& u, int wr, int wc, int fr, int fq) const {
        const int row0 = u.pm * 256 + wr * 64 + fr, col0 = u.pn * 256 + wc * 32 + 8 * fq;
#pragma unroll
        for (int ai = 0; ai < 2; ++ai)
#pragma unroll
            for (int m = 0; m < 4; ++m) { bf16_t* rowp = O + (size_t)(row0 + ai * 128 + m * 16) * ldc + col0;
#pragma unroll
                for (int bj = 0; bj < 2; ++bj) { const pg8::f32x4 v0 = acc[ai][bj][m][0], v1 = acc[ai][bj][m][1];
                    pg8::u32x4 w; w.x = cvt_pk_bf16(v0[0], v0[1]); w.y = cvt_pk_bf16(v0[2], v0[3]); w.z = cvt_pk_bf16(v1[0], v1[1]); w.w = cvt_pk_bf16(v1[2], v1[3]);
                    *(pg8::u32x4*)(rowp + bj * 128) = w; } }
    }
};
DEV void ph_outproj(const Params& p, int layer, char* smem) {
    const int tidx = tid_of(p.wave_id);
    pg8::StaticOrder S; S.init(layer == 0 ? NT / 256 : NB * 8, D / 256, (int)gridDim.x, (int)blockIdx.x, layer == 0 ? 0 : 1, (const bf16_t*)(p.ws + OFF_WOUT) + (size_t)layer * D * D, D);
    EpiRowsBf16 E{(bf16_t*)(p.ws + OFF_MIXO), D};
    pg8::gemm_phase((LAS unsigned char*)smem, (const char*)(p.ws + OFF_MIXB), D, S, E, tid_of(p.wave_id));
}
DEV void ph_norm2(const Params& p, int layer, char* smem) {
    typedef float f32x16 __attribute__((ext_vector_type(16)));
    const int wid = p.wave_id, lane = lane_asm(), tidx = (wid << 6) | lane;
    constexpr int XP = 1028, RP = 24;
    float* xs = (float*)smem;
    float* red = (float*)smem;
    int* hist = (int*)(smem + 32 * XP * 4);
    const float* nr = p.norms + (size_t)layer * 4 * D;
    if (tidx < NE) hist[tidx] = 0;
    const int chunk = (NT + (int)gridDim.x - 1) / (int)gridDim.x, rbeg = (int)blockIdx.x * chunk, rend = min(NT, rbeg + chunk);
    float wreg[64];
    { const float* wb = p.rw + (size_t)layer * D * NE + (size_t)(wid * 128 + (lane >> 5)) * NE + (lane & 31);
#pragma unroll
      for (int ks = 0; ks < 64; ++ks) wreg[ks] = wb[(size_t)2 * ks * NE]; }
    for (int r0 = rbeg; r0 < rend; r0 += RP) {
        __syncthreads();
#pragma unroll 1
        for (int j = 0; j < 3; ++j) {
            const int lr = wid * 3 + j, r = r0 + lr;
            if (r >= rend) continue;
            const int b = r / SL, s = r % SL;
            if (layer != 0 && s < CTX) continue;
            const float* m = modrow(p, layer, b, s);
            float4 mo[4], xv[4], o[4]; row_load_bf((const bf16_t*)(p.ws + OFF_MIXO) + (size_t)r * D, mo, lane); row_load_bf((const bf16_t*)(p.ws + OFF_X) + (size_t)r * D, xv, lane);
            const float ri = row_rinv(mo);
#pragma unroll
            for (int i = 0; i < 4; ++i) { const int idx = i * 256 + lane * 4; const float4 g = *(const float4*)(nr + D + idx), gt = *(const float4*)(m + 2048 + idx);
                xv[i].x += gt.x * (mo[i].x * ri * g.x); xv[i].y += gt.y * (mo[i].y * ri * g.y); xv[i].z += gt.z * (mo[i].z * ri * g.z); xv[i].w += gt.w * (mo[i].w * ri * g.w); }
            row_store_bf16((bf16_t*)(p.ws + OFF_XN) + (size_t)r * D, xv, lane);
            row_modnorm(xv, nr + 2 * D, m + 3072, m + 4096, o, lane);
            row_store_bf16((bf16_t*)(p.ws + OFF_XNB) + (size_t)r * D, o, lane);
            row_store(xs + lr * XP, o, lane);
        }
        __syncthreads();
        f32x16 acc = {};
        { const float* xa = xs + (lane & 31) * XP + wid * 128 + (lane >> 5);
#pragma unroll
          for (int ks = 0; ks < 64; ++ks) acc = __builtin_amdgcn_mfma_f32_32x32x2f32(xa[2 * ks], wreg[ks], acc, 0, 0, 0); }
        __syncthreads();
#pragma unroll
        for (int rg = 0; rg < 16; ++rg) red[(wid * 32 + (rg & 3) + 8 * (rg >> 2) + 4 * (lane >> 5)) * 32 + (lane & 31)] = acc[rg];
        __syncthreads();
#pragma unroll 1
        for (int j = 0; j < 3; ++j) {
            const int lr = wid * 3 + j, r = r0 + lr;
            if (r >= rend) continue;
            const int s = r % SL;
            if (layer != 0 && s < CTX) continue;
            const int e = lane & 31;
            float logit = p.rb[layer * NE + e];
#pragma unroll
            for (int w = 0; w < 8; ++w) logit += red[(w * 32 + lr) * 32 + e];
            float tv[4]; int ti[4];
#pragma unroll
            for (int k = 0; k < 4; ++k) {
                float bv = logit; int bi = e;
                for (int o2 = 16; o2 >= 1; o2 >>= 1) { const float ov = __shfl_xor(bv, o2); const int oi = __shfl_xor(bi, o2); if (ov > bv || (ov == bv && oi < bi)) { bv = ov; bi = oi; } }
                tv[k] = bv; ti[k] = bi; if (e == bi) logit = -3.0e38f;
            }
            const float e0 = 1.f, e1 = expf(tv[1] - tv[0]), e2 = expf(tv[2] - tv[0]), e3 = expf(tv[3] - tv[0]), inv = 1.f / (e0 + e1 + e2 + e3);
            if (lane == 0) { *(float4*)(((float*)(p.ws + OFF_TOPW)) + (size_t)r * 4) = make_float4(e0 * inv, e1 * inv, e2 * inv, e3 * inv); *(int4*)(((int*)(p.ws + OFF_TOPI)) + (size_t)r * 4) = make_int4(ti[0], ti[1], ti[2], ti[3]); }
            if (lane < 4) atomicAdd(&hist[lane == 0 ? ti[0] : lane == 1 ? ti[1] : lane == 2 ? ti[2] : ti[3]], 1);
        }
    }
    __syncthreads();
    if (tidx < NE) ((int*)(p.ws + OFF_BC))[(size_t)blockIdx.x * NE + tidx] = hist[tidx];
}
DEV void ph_route(const Params& p, int layer, char* smem) {
    const int tidx = tid_of(p.wave_id);
    int* part = (int*)smem;
    int* off = part + 1024;
    const int G = (int)gridDim.x, bid = (int)blockIdx.x;
    const int* BC = (const int*)(p.ws + OFF_BC);
    { const int e = tidx & 31, sl = tidx >> 5; int before = 0, tot = 0;
      for (int bb = sl; bb < G; bb += 16) { const int c = BC[(size_t)bb * NE + e]; tot += c; if (bb < bid) before += c; }
      part[(sl * 2 + 0) * 32 + e] = before; part[(sl * 2 + 1) * 32 + e] = tot; }
    __syncthreads();
    if (tidx < NE) { int before = 0, tot = 0; for (int sl = 0; sl < 16; ++sl) { before += part[(sl * 2 + 0) * 32 + tidx]; tot += part[(sl * 2 + 1) * 32 + tidx]; }
        off[tidx] = before; if (bid == 0) ((int*)(p.ws + OFF_CNT))[tidx] = tot; }
    __syncthreads();
    if (tidx < 64) {
        const int lane = tidx;
        const int chunk = (NT + G - 1) / G, rbeg = bid * chunk, rend = min(NT, rbeg + chunk);
        for (int q0 = rbeg * 4; q0 < rend * 4; q0 += 64) {
            const int pair = q0 + lane, r = pair >> 2, s = r % SL;
            const bool act = pair < rend * 4 && (layer == 0 || s >= CTX);
            const int my = act ? ((const int*)(p.ws + OFF_TOPI))[pair] : -1;
            for (int e = 0; e < NE; ++e) {
                const unsigned long long bal = __ballot(my == e);
                if (bal) { const int base = off[e];
                    if (my == e) ((int*)(p.ws + OFF_LIST))[(size_t)e * LISTCAP + base + __popcll(bal & ((1ull << lane) - 1ull))] = pair;
                    __builtin_amdgcn_wave_barrier();
                    if (lane == 0) off[e] = base + __popcll(bal);
                    __builtin_amdgcn_wave_barrier(); }
            }
        }
    }
}
DEV int moe_rt(int i, int G, int c, int npn, int& pn) {
    if (G == 256) { const int xcd = c & 7, j = c >> 3, rpx = 32 / npn; pn = j % npn; return (i * 8 + xcd) * rpx + j / npn; }
    const int L = i * G + c; pn = L % npn; return L / npn;
}
constexpr int MOE_LDS = 131072, MOE_MAXU = 12;
DEV void moe_prepare(const Params& p, char* smem, int npn, int mode) {
    const int tidx = tid_of(p.wave_id);
    LAS int* base = (LAS int*)(smem + MOE_LDS);
    LAS int *TE = base, *TT = base + 320, *NRT = base + 640, *CN = base + 656  , *UI = base + 704, *IDX = base + 768;
    if (tidx < NE) CN[tidx] = ((const int*)(p.ws + OFF_CNT))[tidx];
    __syncthreads();
    if (tidx < 320) { int e = 0, acc = 0; for (; e < NE; ++e) { const int n = (CN[e] + 255) >> 8; if (tidx < acc + n) break; acc += n; } TE[tidx] = e; TT[tidx] = tidx - acc; }
    if (tidx == 0) { int tot = 0; for (int e = 0; e < NE; ++e) tot += (CN[e] + 255) >> 8; NRT[0] = tot; }
    __syncthreads();
    const int nrt = NRT[0];
#pragma unroll
    for (int k = 0; k < (MOE_MAXU * 256) / 512; ++k) {
        const int idx = tidx + 512 * k, i = idx >> 8, row = idx & 255;
        int pn; const int rt = moe_rt(i, (int)gridDim.x, (int)blockIdx.x, npn, pn);
        if (rt < nrt) { const int e = TE[rt], t = TT[rt], c = CN[e], q = t * 256 + row;
            const int pair = ((const int*)(p.ws + OFF_LIST))[(size_t)e * LISTCAP + min(q, c - 1)];
            IDX[idx] = mode == 1 ? (pair >> 2) : (q < c ? pair : -1); }
    }
    if (tidx < MOE_MAXU) { int pn; const int rt = moe_rt(tidx, (int)gridDim.x, (int)blockIdx.x, npn, pn);
        if (rt < nrt) { const int e = TE[rt], t = TT[rt], c = CN[e]; int pre = 0; for (int z = 0; z < e; ++z) pre += CN[z]; UI[tidx * 4 + 0] = min(256, c - t * 256); UI[tidx * 4 + 1] = pre + t * 256; } }
    __syncthreads();
}
struct MoeOrder {
    const LAS int *te, *ui, *idx; int nrt, npn, G, c, gather; const char* Bt; size_t bstride; int K;
    DEV bool next(int i, pg8::Unit& u) const { int pn; const int rt = moe_rt(i, G, c, npn, pn); if (rt >= nrt || i >= MOE_MAXU) return false;
        u.pm = rt; u.pn = pn; u.e = __builtin_amdgcn_readfirstlane(te[rt]); u.t = i; return true; }
    DEV int arow(const pg8::Unit& u, int rr) const { return gather ? idx[u.t * 256 + rr] : ui[u.t * 4 + 1] + rr; }
    DEV const char* bbase(const pg8::Unit& u) const { return Bt + (size_t)u.e * bstride + (size_t)u.pn * pg8::BM * K * 2; }
};
DEV float swiglu(float g, float l) { g = fminf(g, 7.f); l = fminf(fmaxf(l, -7.f), 7.f); return g * __builtin_amdgcn_rcpf(1.f + __builtin_amdgcn_exp2f(-1.702f * 1.4426950408889634f * g)) * (l + 1.f); }
struct EpiSwiglu {
    static constexpr bool PERM = true;
    bf16_t* H; const float* b1; const LAS int* ui;
    DEV void operator()(const pg8::f32x4 (&acc)[2][2][4][2], const pg8::Unit& u, int wr, int wc, int fr, int fq) const {
        const int ucnt = ui[u.t * 4 + 0], hrow0 = ui[u.t * 4 + 1], col0 = u.pn * 256 + wc * 32 + 8 * fq;
        const float* bb = b1 + (size_t)u.e * 2048 + col0;
        pg8::f32x4 bv[2][2];
#pragma unroll
        for (int bj = 0; bj < 2; ++bj)
#pragma unroll
            for (int n = 0; n < 2; ++n) bv[bj][n] = *(const pg8::f32x4*)(bb + bj * 128 + 4 * n);
#pragma unroll
        for (int ai = 0; ai < 2; ++ai)
#pragma unroll
            for (int m = 0; m < 4; ++m) { const int rr = ai * 128 + wr * 64 + m * 16 + fr;
                if (rr < ucnt) { bf16_t* rowp = H + (size_t)(hrow0 + rr) * DFF + (col0 >> 1);
#pragma unroll
                    for (int bj = 0; bj < 2; ++bj) { const pg8::f32x4 v0 = acc[ai][bj][m][0] + bv[bj][0], v1 = acc[ai][bj][m][1] + bv[bj][1];
                        pg8::u32x2 w; w.x = cvt_pk_bf16(swiglu(v0[0], v0[1]), swiglu(v0[2], v0[3])); w.y = cvt_pk_bf16(swiglu(v1[0], v1[1]), swiglu(v1[2], v1[3]));
                        *(pg8::u32x2*)(rowp + bj * 64) = w; } } }
    }
};
struct EpiY {
    static constexpr bool PERM = true;
    bf16_t* Y; const LAS int* idx;
    DEV void operator()(const pg8::f32x4 (&acc)[2][2][4][2], const pg8::Unit& u, int wr, int wc, int fr, int fq) const {
        const int col0 = u.pn * 256 + wc * 32 + 8 * fq;
#pragma unroll
        for (int ai = 0; ai < 2; ++ai)
#pragma unroll
            for (int m = 0; m < 4; ++m) { const int rr = ai * 128 + wr * 64 + m * 16 + fr; const int pair = idx[u.t * 256 + rr];
                if (pair >= 0) { bf16_t* rowp = Y + (size_t)pair * D + col0;
#pragma unroll
                    for (int bj = 0; bj < 2; ++bj) { const pg8::f32x4 v0 = acc[ai][bj][m][0], v1 = acc[ai][bj][m][1];
                        pg8::u32x4 w; w.x = cvt_pk_bf16(v0[0], v0[1]); w.y = cvt_pk_bf16(v0[2], v0[3]); w.z = cvt_pk_bf16(v1[0], v1[1]); w.w = cvt_pk_bf16(v1[2], v1[3]);
                        *(pg8::u32x4*)(rowp + bj * 128) = w; } } }
    }
};
DEV void ph_moe1(const Params& p, int layer, char* smem) {
    moe_prepare(p, smem, 8, 1);
    LAS int* base = (LAS int*)(smem + MOE_LDS);
    MoeOrder S{base, base + 704, base + 768, base[640], 8, (int)gridDim.x, (int)blockIdx.x, 1, (const char*)(p.ws + OFF_W1T) + (size_t)layer * NE * 2048 * D * 2, (size_t)2048 * D * 2, D};
    EpiSwiglu E{(bf16_t*)(p.ws + OFF_H), p.b1 + (size_t)layer * NE * 2048, base + 704};
    pg8::gemm_phase((LAS unsigned char*)smem, (const char*)(p.ws + OFF_XNB), D, S, E, tid_of(p.wave_id));
}
DEV void ph_moe2(const Params& p, int layer, char* smem) {
    moe_prepare(p, smem, 4, 2);
    LAS int* base = (LAS int*)(smem + MOE_LDS);
    MoeOrder S{base, base + 704, base + 768, base[640], 4, (int)gridDim.x, (int)blockIdx.x, 0, (const char*)(p.ws + OFF_W2T) + (size_t)layer * NE * D * DFF * 2, (size_t)D * DFF * 2, DFF};
    EpiY E{(bf16_t*)(p.ws + OFF_Y), base + 768};
    pg8::gemm_phase((LAS unsigned char*)smem, (const char*)(p.ws + OFF_H), DFF, S, E, tid_of(p.wave_id));
}
DEV void ph_combine(const Params& p, int layer, char* smem) {
    const int wid = p.wave_id, lane = lane_asm();
    const float* nr = p.norms + (size_t)layer * 4 * D;
    const int total = layer == 0 ? NT : NB * SEQ, stride = (int)gridDim.x * 8;
    for (int q0 = (int)blockIdx.x * 8 + wid; q0 < total; q0 += 2 * stride) {
        int rr[2]; bool ok[2]; float4 tw[2]; int4 ti[2];
#pragma unroll
        for (int u = 0; u < 2; ++u) { const int q = q0 + u * stride; ok[u] = q < total; const int qq = ok[u] ? q : q0;
            rr[u] = layer == 0 ? qq : (qq / SEQ) * SL + CTX + qq % SEQ;
            tw[u] = *(const float4*)(((float*)(p.ws + OFF_TOPW)) + (size_t)rr[u] * 4); ti[u] = *(const int4*)(((int*)(p.ws + OFF_TOPI)) + (size_t)rr[u] * 4); }
        float4 f[2][4], xv[2][4];
#pragma unroll
        for (int u = 0; u < 2; ++u) {
            const int r = rr[u];
            const float w[4] = {tw[u].x, tw[u].y, tw[u].z, tw[u].w}; const int ei[4] = {ti[u].x, ti[u].y, ti[u].z, ti[u].w};
#pragma unroll
            for (int i = 0; i < 4; ++i) f[u][i] = make_float4(0.f, 0.f, 0.f, 0.f);
#pragma unroll
            for (int k = 0; k < 4; ++k) {
                const bf16_t* y = (const bf16_t*)(p.ws + OFF_Y) + ((size_t)r * 4 + k) * D; const float* bb = p.b2 + ((size_t)layer * NE + ei[k]) * D;
#pragma unroll
                for (int i = 0; i < 4; ++i) { const int idx = i * 256 + lane * 4; const pg8::u32x2 yb = *(const pg8::u32x2*)(y + idx); const float4 bv = *(const float4*)(bb + idx);
                    const float y0 = __uint_as_float(yb.x << 16), y1 = __uint_as_float(yb.x & 0xffff0000u), y2 = __uint_as_float(yb.y << 16), y3 = __uint_as_float(yb.y & 0xffff0000u);
                    f[u][i].x += w[k] * (y0 + bv.x); f[u][i].y += w[k] * (y1 + bv.y); f[u][i].z += w[k] * (y2 + bv.z); f[u][i].w += w[k] * (y3 + bv.w); }
            }
            row_load_bf((const bf16_t*)(p.ws + OFF_XN) + (size_t)r * D, xv[u], lane);
        }
#pragma unroll
        for (int u = 0; u < 2; ++u) {
            const int r = rr[u], b = r / SL, s = r % SL;
            const float* m = modrow(p, layer, b, s);
            const float ri = row_rinv(f[u]);
#pragma unroll
            for (int i = 0; i < 4; ++i) { const int idx = i * 256 + lane * 4; const float4 g = *(const float4*)(nr + 3 * D + idx), gt = *(const float4*)(m + 5120 + idx);
                xv[u][i].x += gt.x * (f[u][i].x * ri * g.x); xv[u][i].y += gt.y * (f[u][i].y * ri * g.y); xv[u][i].z += gt.z * (f[u][i].z * ri * g.z); xv[u][i].w += gt.w * (f[u][i].w * ri * g.w); }
            if (ok[u]) {
                if (layer == 0) {
                    row_store_bf16((bf16_t*)(p.ws + OFF_X) + (size_t)r * D, xv[u], lane);
                    const float* m1 = modrow(p, 1, b, s); float4 o[4];
                    row_modnorm(xv[u], p.norms + (size_t)4 * D, m1 + 0, m1 + 1024, o, lane);
                    row_store_bf16((bf16_t*)(p.ws + OFF_XNB) + (size_t)r * D, o, lane);
                } else {
                    row_store(p.out + ((size_t)b * SEQ + (s - CTX)) * D, xv[u], lane);
                }
            }
        }
    }
}

template <int layer> DEV void run_layer(const Params& p, char* smem, const XcdBarrier& bar) {
#define GB() xcd_barrier(bar)

        ph_inproj(p, layer, smem, 0); GB();
        ph_inproj(p, layer, smem, 1); ph_scan_local(p, layer, smem); GB();
        ph_scan_carry(p, smem); ph_attn(p, layer, smem); GB();
        ph_scan_out(p, layer, smem); GB();
        ph_outproj(p, layer, smem); GB();
        ph_norm2(p, layer, smem); GB();
        ph_route(p, layer, smem); GB();
        ph_moe1(p, layer, smem); GB();
        ph_moe2(p, layer, smem); GB();
        ph_combine(p, layer, smem); GB();
    #undef GB
}
constexpr int LDS_BYTES = 147456;
__global__ __launch_bounds__(512, 2) void k_mega(Params p_in) {
    Params p = p_in; p.wave_id = __builtin_amdgcn_readfirstlane((int)(threadIdx.x >> 6));
    extern __shared__ __attribute__((aligned(16))) char smem[];
    volatile LAS unsigned* st = (volatile LAS unsigned*)(smem + LDS_BYTES - 16);
    if (threadIdx.x == 0) { st[0] = 0u; st[1] = 0u; st[2] = 0u; st[3] = 0u; }
    __syncthreads();
    const XcdBarrier bar = xcd_barrier_post(((unsigned*)(p.ws + OFF_bar)), st, p.wave_id);
#define GB() xcd_barrier(bar)
    ph_mods(p, smem); ph_convert(p, smem); GB();
    ph_init(p, smem); GB();
    run_layer<0>(p, smem, bar);
    run_layer<1>(p, smem, bar);
#undef GB
}
}

extern "C" void kernel_launch(void* const* d_in, const int* in_sizes, int n_in, void* d_out, int out_size, void* d_ws, size_t ws_size, hipStream_t stream) {
    static int grid = 0;
    if (grid == 0) {
        int dev = 0, cus = 0, per_cu = 0;
        if (hipGetDevice(&dev) != hipSuccess || hipDeviceGetAttribute(&cus, hipDeviceAttributeMultiprocessorCount, dev) != hipSuccess) { grid = -1; return; }
        if (hipFuncSetAttribute((const void*)k_mega, hipFuncAttributeMaxDynamicSharedMemorySize, LDS_BYTES) != hipSuccess) { grid = -1; return; }
        (void)hipOccupancyMaxActiveBlocksPerMultiprocessor(&per_cu, (const void*)k_mega, 512, LDS_BYTES);
        (void)hipGetLastError();
        grid = cus;
    }
    if (grid < 0) return;
    Params p{};
    const float** in = (const float**)&p;
    for (int i = 0; i < 21; ++i) in[i] = (const float*)d_in[i];
    p.out = (float*)d_out;
    p.ws = (char*)d_ws;
    if (WS_END > ws_size) return;
    if (hipMemsetAsync(p.ws + OFF_bar, 0, (size_t)CTL_BYTES, stream) != hipSuccess) return;
    hipLaunchKernelGGL(k_mega, dim3(grid), dim3(512), LDS_BYTES, stream, p);
}
```

```cpp
#include <hip/hip_runtime.h>
#include <stdint.h>

namespace {
constexpr int D = 1024, NB = 8, SEQ = 2048, CTX = 256, SL = 2304, NT = NB * SL;
constexpr int DP = 3840, DPW = 3600, NE = 32, DFF = 1024, NPAIR = NT * 4;
constexpr int O_AQ = 0, O_AI = 256, O_AFF = 512, O_AFB = 768, O_AG = 1024, O_BQ = 1280, O_BK = 1408, O_BV = 1536, O_BO = 1792, O_BG = 3584;
constexpr int LISTCAP = NT;

struct Params {
    const float *x, *c, *ctx, *c_ctx, *ada_w, *ada_b, *norms, *w_in, *w_out, *hlb, *hnorm, *mgb, *mnorm, *dlam, *dnorm, *rw, *rb, *w1, *b1, *w2, *b2;
    float* out;
    char* ws;
    int wave_id, pad_;
};
constexpr size_t al256(size_t x) { return (x + 255) & ~(size_t)255; }
constexpr size_t OFF_bar = 0;
constexpr size_t OFF_MOD = OFF_bar + 16384;
constexpr int CW_QHEAD = 3520, CTL_BYTES = 16384;
constexpr size_t OFF_LB = OFF_MOD + al256((size_t)2 * 9 * 6144 * 4);
constexpr size_t OFF_LAM = OFF_LB + al256(1024 * 4);
constexpr size_t OFF_CNT = OFF_LAM + 256;
constexpr size_t OFF_BC = OFF_CNT + 256;
constexpr size_t OFF_TOPW = OFF_BC + al256((size_t)1024 * NE * 4);
constexpr size_t OFF_TOPI = OFF_TOPW + al256((size_t)NPAIR * 4);
constexpr size_t OFF_LIST = OFF_TOPI + al256((size_t)NPAIR * 4);
constexpr size_t OFF_X = OFF_LIST + al256((size_t)NE * LISTCAP * 4);
constexpr size_t OFF_XN = OFF_X + al256((size_t)NT * D * 4);
constexpr size_t OFF_P = OFF_XN + al256((size_t)NT * D * 4);
constexpr size_t OFF_QR = OFF_P + al256((size_t)NT * DP * 4);
constexpr size_t OFF_KT = OFF_QR + al256((size_t)64 * SL * 64 * 4);
constexpr size_t OFF_OC = OFF_KT + al256((size_t)64 * SL * 64 * 4);
constexpr size_t OFF_MIX = OFF_OC + al256((size_t)32 * SL * 128 * 4);
constexpr size_t OFF_MIXO = OFF_MIX + al256((size_t)NT * D * 4);
constexpr size_t OFF_XNB = OFF_MIXO + al256((size_t)NT * D * 4);
constexpr size_t OFF_MIXB = OFF_XNB + al256((size_t)NT * D * 2);
constexpr size_t OFF_WIN = OFF_MIXB + al256((size_t)NT * D * 2);
constexpr size_t OFF_WOUT = OFF_WIN + al256((size_t)2 * DP * D * 2);
constexpr size_t OFF_W1T = OFF_WOUT + al256((size_t)2 * D * D * 2);
constexpr size_t OFF_W2T = OFF_W1T + al256((size_t)2 * NE * 2048 * D * 2);
constexpr size_t OFF_U = OFF_W2T + al256((size_t)2 * NE * D * DFF * 2);
constexpr size_t WS_END = OFF_U + al256((size_t)32 * SL * SL * 4);
constexpr size_t OFF_UA = OFF_U, OFF_DECA = OFF_UA + (size_t)64 * 36 * 4096 * 4, OFF_UB = OFF_DECA + (size_t)64 * 36 * 64 * 4, OFF_NB = OFF_UB + (size_t)64 * 36 * 2048 * 4,
                 OFF_MB = OFF_NB + (size_t)64 * 36 * 32 * 4, OFF_SCB = OFF_MB + (size_t)64 * 36 * 4 * 4,
                 OFF_OA2 = OFF_SCB + (size_t)2 * NT * 16 * 4, OFF_HB2 = OFF_OA2 + (size_t)NT * 256 * 4, OFF_SA = OFF_HB2 + (size_t)NT * 256 * 4, OFF_SB = OFF_SA + (size_t)64 * 36 * 4096 * 4,
                 OFF_N0 = OFF_SB + (size_t)64 * 36 * 2048 * 4;
constexpr size_t OFF_PB = OFF_P;
constexpr size_t OFF_ROPE = OFF_P + al256((size_t)NT * DP * 2);
constexpr size_t OFF_QRB = OFF_QR, OFF_Q0B = OFF_QR + (size_t)32 * SL * 128 * 2, OFF_KB = OFF_KT, OFF_VB = OFF_KT + (size_t)32 * SL * 128 * 2;
constexpr size_t OFF_S = OFF_U, OFF_H = OFF_U, OFF_Y = OFF_U + al256((size_t)(NPAIR + 256) * DFF * 2);
constexpr size_t OFF_OA = OFF_MIXO, OFF_HB = OFF_MIXO + (size_t)2 * NT * 256 * 4;


#define DEV __device__ __forceinline__
DEV int lane_asm() { int l; asm volatile("v_mbcnt_lo_u32_b32 %0, -1, 0\n\tv_mbcnt_hi_u32_b32 %0, -1, %0" : "=v"(l)); return l; }
DEV int tid_of(int wave_id) { return (wave_id << 6) | lane_asm(); }
DEV float wsum(float v) { for (int o = 32; o >= 1; o >>= 1) v += __shfl_xor(v, o); return v; }
DEV float wmaxf(float v) { for (int o = 32; o >= 1; o >>= 1) v = fmaxf(v, __shfl_xor(v, o)); return v; }
DEV float sigm(float x) { return 1.f / (1.f + expf(-x)); }
DEV float rdlane(float v, int l) { return __int_as_float(__builtin_amdgcn_readlane(__float_as_int(v), l)); }
DEV float lam_init_of(int layer) { return 0.8f - 0.6f * expf(-0.3f * (float)layer); }


#define XB_TMO      128
#define XB_XCNT(j)  (256  + 64 * (j))
#define XB_XSUB(j)  (1280 + 64 * (j))
#define XB_XGEN(j)  (2304 + 64 * (j))
#define XB_TOP      3328
#define XB_TOPGEN   3392
#define XCD_BAR_WORDS 3456
#define XB_SPIN_CAP (1u << 22)
#define LAS __attribute__((address_space(3)))
DEV unsigned xb_ld(unsigned* p)              { return __hip_atomic_load(p, __ATOMIC_RELAXED, __HIP_MEMORY_SCOPE_AGENT); }
DEV unsigned xb_add(unsigned* p, unsigned v) { return __hip_atomic_fetch_add(p, v, __ATOMIC_RELAXED, __HIP_MEMORY_SCOPE_AGENT); }
DEV unsigned xb_xcc_id() { return (unsigned)__builtin_amdgcn_s_getreg((3 << 11) | 20) & 0xFu; }
#define XB_SPIN(cond, bar) do { unsigned _sp = 0; while (cond) { __builtin_amdgcn_s_sleep(1); \
    if ((++_sp & 255u) == 0u) { if (xb_ld(&(bar)[XB_TMO])) break; if (_sp > XB_SPIN_CAP) { atomicAdd(&(bar)[XB_TMO], 1u); break; } } } } while (0)
struct XcdBarrier { unsigned* bar; unsigned x; volatile LAS unsigned* st; int wave; };
DEV bool xb_thread0(int wave) { return wave == 0 && lane_asm() == 0; }
DEV XcdBarrier xcd_barrier_post(unsigned* bar, volatile LAS unsigned* st, int wave) {
    XcdBarrier b; b.bar = bar; b.x = xb_xcc_id(); b.st = st; b.wave = wave;
    if (xb_thread0(wave)) (void)xb_add(&bar[XB_XCNT(b.x)], 1u);
    return b;
}
DEV void xcd_barrier_complete(unsigned* bar, unsigned x, unsigned& nloc, unsigned& nx) {
    const unsigned G = gridDim.x * gridDim.y * gridDim.z;
    unsigned sum, cnt, mine, sp = 0u;
    for (;;) {
        sum = 0u; cnt = 0u; mine = 0u;
#pragma unroll
        for (unsigned j = 0; j < 16; ++j) { const unsigned c = xb_ld(&bar[XB_XCNT(j)]); sum += c; cnt += (c > 0u) ? 1u : 0u; mine = (j == x) ? c : mine; }
        if (sum == G) break;
        __builtin_amdgcn_s_sleep(1);
        if ((++sp & 255u) == 0u) { if (xb_ld(&bar[XB_TMO])) break; if (sp > XB_SPIN_CAP) { atomicAdd(&bar[XB_TMO], 1u); break; } }
    }
    nloc = mine > 0u ? mine : 1u; nx = cnt > 0u ? cnt : 1u;
}
DEV void xcd_barrier(const XcdBarrier& b) {
    asm volatile("s_waitcnt vmcnt(0)" ::: "memory");
    __syncthreads();
    if (xb_thread0(b.wave)) {
        unsigned* bar = b.bar;
        __builtin_amdgcn_s_waitcnt(0);
        unsigned nloc = b.st[0], nx = b.st[1];
        if (nloc == 0u) { xcd_barrier_complete(bar, b.x, nloc, nx); b.st[0] = nloc; b.st[1] = nx; }
        const unsigned old = xb_add(&bar[XB_XSUB(b.x)], 1u);
        const unsigned gen = old / nloc;
        if (old + 1u == (gen + 1u) * nloc) {
            __builtin_amdgcn_fence(__ATOMIC_RELEASE, "agent");
            asm volatile("s_waitcnt vmcnt(0)" ::: "memory");
            const unsigned og = xb_add(&bar[XB_TOP], 1u);
            const unsigned tg = og / nx;
            if (og + 1u == (tg + 1u) * nx) xb_add(&bar[XB_TOPGEN], 1u);
            else XB_SPIN(xb_ld(&bar[XB_TOPGEN]) == tg, bar);
            __builtin_amdgcn_fence(__ATOMIC_ACQUIRE, "agent");
            xb_add(&bar[XB_XGEN(b.x)], 1u);
            asm volatile("s_waitcnt vmcnt(0)" ::: "memory");
        } else {
            XB_SPIN(xb_ld(&bar[XB_XGEN(b.x)]) == gen, bar);
            __builtin_amdgcn_fence(__ATOMIC_ACQUIRE, "agent");
            asm volatile("s_waitcnt vmcnt(0)" ::: "memory");
        }
    }
    __syncthreads();
}

typedef unsigned short bf16_t;
DEV unsigned cvt_pk_bf16(float lo, float hi) { unsigned r; asm volatile("v_cvt_pk_bf16_f32 %0, %1, %2" : "=v"(r) : "v"(lo), "v"(hi)); return r; }

namespace pg8 {
typedef short bf16x8 __attribute__((ext_vector_type(8)));
typedef float f32x4 __attribute__((ext_vector_type(4)));
typedef unsigned u32x4 __attribute__((ext_vector_type(4)));
typedef unsigned u32x2 __attribute__((ext_vector_type(2)));
constexpr int BM = 256, BK = 64, HALF = 128, HTB = HALF * BK * 2, STAGE_BYTES = 8 * HTB, NXCD = 8, WGM = 8;
DEV int lds_byte(int r, int c) { const int st = (r >> 4) * 2 + (c >> 5), rr = r & 15, cc = c & 31, ob = rr * 64 + cc * 2; return st * 1024 + (ob ^ (((ob >> 9) & 1) << 5)); }
DEV void stage_rc(int b, int& R, int& C) { const int st = b / 1024, sb = b % 1024, swz = sb ^ (((sb >> 9) & 1) << 5); R = (st >> 1) * 16 + swz / 64; C = (st & 1) * 32 + (swz % 64) / 2; }
DEV int perm32(int rho) { const int n = rho >> 4, i = rho & 15; return 8 * (i >> 2) + 4 * n + (i & 3); }
struct Unit { int pm, pn, e, t; };
struct StaticOrder {
    int nM, nN, nwg, G, c, skipctx; const char* Bt; int K;
    DEV void init(int nM_, int nN_, int G_, int c_, int skipctx_, const void* Bt_, int K_) { nM = nM_; nN = nN_; nwg = nM * nN; G = G_; c = c_; skipctx = skipctx_; Bt = (const char*)Bt_; K = K_; }
    DEV bool next(int i, Unit& u) const {
        const long L = (long)i * G + c; if (L >= nwg) return false;
        int wgid = (int)L; { const int q = nwg / NXCD, r = nwg % NXCD, xcd = wgid % NXCD, off = wgid / NXCD; wgid = (xcd < r ? xcd * (q + 1) : r * (q + 1) + (xcd - r) * q) + off; }
        const int nig = WGM * nN, gid = wgid / nig, fm = gid * WGM, gsz = (nM - fm) < WGM ? (nM - fm) : WGM;
        int pm = fm + ((wgid % nig) % gsz); u.pn = (wgid % nig) / gsz;
        if (skipctx) pm = (pm >> 3) * 9 + 1 + (pm & 7);
        u.pm = pm; u.e = 0; u.t = 0; return true;
    }
    DEV int arow(const Unit& u, int rr) const { return u.pm * BM + rr; }
    DEV const char* bbase(const Unit& u) const { return Bt + (size_t)u.pn * BM * K * 2; }
};
struct EpiF32 {
    static constexpr bool PERM = false;
    float* C; int ldc;
    DEV void operator()(const f32x4 (&acc)[2][2][4][2], const Unit& u, int wr, int wc, int fr, int fq) const {
        const int row0 = u.pm * BM + wr * 64 + fr, col0 = u.pn * BM + wc * 32 + 4 * fq;
#pragma unroll
        for (int ai = 0; ai < 2; ++ai)
#pragma unroll
            for (int m = 0; m < 4; ++m) { float* rowp = C + (size_t)(row0 + ai * HALF + m * 16) * ldc + col0;
#pragma unroll
                for (int bj = 0; bj < 2; ++bj)
#pragma unroll
                    for (int n = 0; n < 2; ++n) *(f32x4*)(rowp + bj * HALF + n * 16) = acc[ai][bj][m][n]; }
    }
};

typedef int i32x4 __attribute__((ext_vector_type(4)));
typedef int i32x8 __attribute__((ext_vector_type(8)));
DEV i32x8 cat8(bf16x8 a, bf16x8 b) { const i32x4 x = __builtin_bit_cast(i32x4, a), y = __builtin_bit_cast(i32x4, b); return __builtin_shufflevector(x, y, 0, 1, 2, 3, 4, 5, 6, 7); }
template <class Epi, class Sched, bool F8 = false>
DEV void gemm_phase(LAS unsigned char* lds, const char* Abase, const int K, const Sched& S, const Epi& E, const int tid) {
    const int wid = __builtin_amdgcn_readfirstlane(tid >> 6), lane = tid & 63, wr = wid >> 2, wc = wid & 3, fr = lane & 15, fq = lane >> 4;
    const int nt = K / BK;
    unsigned voffB[2];
#pragma unroll
    for (int i = 0; i < 2; ++i) { int R, C; stage_rc(tid * 16 + i * 8192, R, C); const int Rb = Epi::PERM ? ((R & ~31) + perm32(R & 31)) : R;
        voffB[i] = (unsigned)(Rb * K + C) * 2u; }
    const size_t kstep = (size_t)(BK * 2);
    const size_t hstep = (size_t)HALF * K * 2;
    const unsigned ldsw = (unsigned)wid * 1024u;
    const int aoff = lds_byte(wr * 64 + fr, fq * 8), boff = lds_byte(wc * 32 + fr, fq * 8);
#define PG8_SA(b, h) (((b) * 2 + (h)) * HTB)
#define PG8_SB(b, h) ((4 + (b) * 2 + (h)) * HTB)
#define PG8_STAGE_B(bufoff, gbase) do { _Pragma("unroll") for (int _i = 0; _i < 2; ++_i) \
        __builtin_amdgcn_global_load_lds((const unsigned*)((const char*)(gbase) + voffB[_i]), (LAS unsigned*)(lds + (bufoff) + ldsw + _i * 8192), 16, 0, 0); } while (0)
#define PG8_STAGE_A(bufoff, kb, V, h) do { _Pragma("unroll") for (int _i = 0; _i < 2; ++_i) \
        __builtin_amdgcn_global_load_lds((const unsigned*)(Abase + (kb) + (V)[h][_i]), (LAS unsigned*)(lds + (bufoff) + ldsw + _i * 8192), 16, 0, 0); } while (0)
#define PG8_VOFFA(V, u) do { _Pragma("unroll") for (int _i = 0; _i < 2; ++_i) { int _R, _C; stage_rc(tid * 16 + _i * 8192, _R, _C); _Pragma("unroll") for (int _h = 0; _h < 2; ++_h) \
        (V)[_h][_i] = ((unsigned)S.arow(u, _h * HALF + _R) * (unsigned)K + (unsigned)_C) * 2u; } } while (0)
#define PG8_LDA(dst, b, h) do { _Pragma("unroll") for (int m = 0; m < 4; ++m) _Pragma("unroll") for (int k = 0; k < 2; ++k) dst[m][k] = *(const LAS bf16x8*)(lds + PG8_SA(b, h) + aoff + m * 2048 + k * 1024); } while (0)
#define PG8_LDB(dst, b, h) do { _Pragma("unroll") for (int n = 0; n < 2; ++n) _Pragma("unroll") for (int k = 0; k < 2; ++k) dst[n][k] = *(const LAS bf16x8*)(lds + PG8_SB(b, h) + boff + n * 2048 + k * 1024); } while (0)
#define PG8_MMA(ai, bj, At, Bt) do { __builtin_amdgcn_s_setprio(1); _Pragma("unroll") for (int m = 0; m < 4; ++m) _Pragma("unroll") for (int n = 0; n < 2; ++n) { \
        if constexpr (F8) asm volatile("v_mfma_f32_16x16x128_f8f6f4 %0, %1, %2, %0" : "+v"(acc[ai][bj][m][n]) : "v"(cat8(Bt[n][0], Bt[n][1])), "v"(cat8(At[m][0], At[m][1]))); \
        else { _Pragma("unroll") for (int k = 0; k < 2; ++k) acc[ai][bj][m][n] = __builtin_amdgcn_mfma_f32_16x16x32_bf16(Bt[n][k], At[m][k], acc[ai][bj][m][n], 0, 0, 0); } } __builtin_amdgcn_s_setprio(0); } while (0)
#define PG8_WAIT_V(n) asm volatile("s_waitcnt vmcnt(" #n ")" ::: "memory")
#define PG8_WAIT_L(n) asm volatile("s_waitcnt lgkmcnt(" #n ")" ::: "memory")
#define PG8_BAR __builtin_amdgcn_s_barrier()
#define PG8_SCHED __builtin_amdgcn_sched_barrier(0)
    Unit cur, nxt; int ui = 0;
    if (!S.next(0, cur)) return;
    f32x4 acc[2][2][4][2];
#pragma unroll
    for (int a = 0; a < 2; ++a)
#pragma unroll
        for (int b = 0; b < 2; ++b)
#pragma unroll
            for (int m = 0; m < 4; ++m)
#pragma unroll
                for (int n = 0; n < 2; ++n) acc[a][b][m][n] = (f32x4){0.f, 0.f, 0.f, 0.f};
    bf16x8 At[4][2], B0[2][2], B1[2][2];
    unsigned vc[2][2], v2[2][2];
    PG8_VOFFA(vc, cur);
    const char* cB = S.bbase(cur);
    PG8_STAGE_B(PG8_SB(0, 0), cB); PG8_STAGE_A(PG8_SA(0, 0), 0, vc, 0); PG8_STAGE_B(PG8_SB(0, 1), cB + hstep); PG8_STAGE_A(PG8_SA(0, 1), 0, vc, 1);
    if (wr == 1) PG8_BAR;
    PG8_WAIT_V(4); PG8_BAR;
    PG8_STAGE_B(PG8_SB(1, 0), cB + kstep); PG8_STAGE_A(PG8_SA(1, 0), kstep, vc, 0); PG8_STAGE_B(PG8_SB(1, 1), cB + hstep + kstep);
    PG8_WAIT_V(6); PG8_BAR;
    for (;;) {
        const bool has_next = S.next(ui + 1, nxt);
        const char* nB = has_next ? S.bbase(nxt) : cB;
        for (int t = 0; t < nt; t += 2) {
            const bool last = (t == nt - 2);
            const size_t k1 = (size_t)(t + 1) * kstep, k2 = last ? (size_t)0 : (size_t)(t + 2) * kstep, k3 = k2 + kstep;
            if (last && has_next) { PG8_VOFFA(v2, nxt); } else {
#pragma unroll
                for (int h = 0; h < 2; ++h)
#pragma unroll
                    for (int i = 0; i < 2; ++i) v2[h][i] = vc[h][i]; }
            const char* b2 = last ? nB : cB + (size_t)(t + 2) * kstep; const char* b3 = b2 + kstep;
            PG8_LDB(B0, 0, 0); PG8_SCHED; PG8_LDA(At, 0, 0); PG8_STAGE_A(PG8_SA(1, 1), k1, vc, 1);
            PG8_WAIT_L(8); PG8_BAR; PG8_WAIT_L(0); PG8_MMA(0, 0, At, B0); PG8_BAR; PG8_SCHED;
            PG8_LDB(B1, 0, 1); PG8_STAGE_B(PG8_SB(0, 0), b2);
            PG8_BAR; PG8_WAIT_L(0); PG8_MMA(0, 1, At, B1); PG8_BAR;
            PG8_LDA(At, 0, 1); PG8_STAGE_A(PG8_SA(0, 0), k2, v2, 0);
            PG8_BAR; PG8_WAIT_L(0); PG8_MMA(1, 0, At, B0); PG8_BAR; PG8_SCHED;
            PG8_STAGE_B(PG8_SB(0, 1), b2 + hstep);
            PG8_WAIT_V(6); PG8_BAR; PG8_MMA(1, 1, At, B1); PG8_BAR;
            PG8_LDB(B0, 1, 0); PG8_SCHED; PG8_LDA(At, 1, 0); PG8_STAGE_A(PG8_SA(0, 1), k2, v2, 1);
            PG8_WAIT_L(8); PG8_BAR; PG8_WAIT_L(0); PG8_MMA(0, 0, At, B0); PG8_BAR; PG8_SCHED;
            PG8_LDB(B1, 1, 1); PG8_STAGE_B(PG8_SB(1, 0), b3);
            PG8_BAR; PG8_WAIT_L(0); PG8_MMA(0, 1, At, B1); PG8_BAR;
            PG8_LDA(At, 1, 1); PG8_STAGE_A(PG8_SA(1, 0), k3, v2, 0);
            PG8_BAR; PG8_WAIT_L(0); PG8_MMA(1, 0, At, B0); PG8_BAR; PG8_SCHED;
            PG8_STAGE_B(PG8_SB(1, 1), b3 + hstep);
            PG8_WAIT_V(6); PG8_BAR; PG8_MMA(1, 1, At, B1); PG8_BAR;
        }
        if constexpr (F8) asm volatile("s_nop 15\n\ts_nop 15" ::: "memory");
        E(acc, cur, wr, wc, fr, fq);
        if (!has_next) break;
#pragma unroll
        for (int a = 0; a < 2; ++a)
#pragma unroll
            for (int b = 0; b < 2; ++b)
#pragma unroll
                for (int m = 0; m < 4; ++m)
#pragma unroll
                    for (int n = 0; n < 2; ++n) acc[a][b][m][n] = (f32x4){0.f, 0.f, 0.f, 0.f};
        cur = nxt; cB = nB; ++ui;
#pragma unroll
        for (int h = 0; h < 2; ++h)
#pragma unroll
            for (int i = 0; i < 2; ++i) vc[h][i] = v2[h][i];
    }
    PG8_WAIT_V(0);
    if (wr == 0) PG8_BAR;
    PG8_BAR;
#undef PG8_SA
#undef PG8_SB
#undef PG8_STAGE_A
#undef PG8_STAGE_B
#undef PG8_VOFFA
#undef PG8_LDA
#undef PG8_LDB
#undef PG8_MMA
#undef PG8_WAIT_V
#undef PG8_WAIT_L
#undef PG8_BAR
#undef PG8_SCHED
}
}


namespace att {
using bf16x8 = __attribute__((ext_vector_type(8))) short;
using s16x4  = __attribute__((ext_vector_type(4))) short;
using f32x16 = __attribute__((ext_vector_type(16))) float;
using u32x4  = __attribute__((ext_vector_type(4))) unsigned;
constexpr int KVBLK = 64, LDK = 128;
constexpr int SHM_V = KVBLK * 128 * 2, SHM_K = KVBLK * 128 * 2, SHM_ATTN = 2 * SHM_V + 2 * SHM_K + 8 * 64 * 4;
constexpr float THR = 8.f;
#define KSWZ(row, colB) ((row) * 256 + ((colB) ^ (((row) & 7) << 4)))
#define SBAR() __builtin_amdgcn_sched_barrier(0)
DEV int crow(int r, int hi) { return (r & 3) + 8 * (r >> 2) + 4 * hi; }
DEV void partialSM(f32x16& p0, f32x16& p1, float& m_reg, float& mn, float& alpha) {
  float pmax = p0[0]; for (int r = 1; r < 16; ++r) pmax = fmaxf(pmax, p0[r]); for (int r = 0; r < 16; ++r) pmax = fmaxf(pmax, p1[r]);
  { auto rr = __builtin_amdgcn_permlane32_swap(__float_as_uint(pmax), __float_as_uint(pmax), false, false);
    pmax = fmaxf(__uint_as_float(rr[0]), __uint_as_float(rr[1])); }
  if (__builtin_expect(__all(pmax - m_reg <= THR), 1)) { mn = m_reg; alpha = 1.f; }
  else { mn = fmaxf(m_reg, pmax); alpha = __builtin_amdgcn_exp2f(m_reg - mn); m_reg = mn; }
  for (int r = 0; r < 16; ++r) p0[r] = p0[r] - mn; for (int r = 0; r < 16; ++r) p1[r] = p1[r] - mn;
  for (int r = 0; r < 16; ++r) p0[r] = __builtin_amdgcn_exp2f(p0[r]);
}
DEV void finishSM(f32x16& p0, f32x16& p1, float alpha, float& l_reg, bf16x8& pa0, bf16x8& pa1, bf16x8& pa2, bf16x8& pa3) {
  for (int r = 0; r < 16; ++r) p1[r] = __builtin_amdgcn_exp2f(p1[r]);
  float ps = 0; for (int r = 0; r < 16; ++r) ps += p0[r]; for (int r = 0; r < 16; ++r) ps += p1[r];
  { auto rr = __builtin_amdgcn_permlane32_swap(__float_as_uint(ps), __float_as_uint(ps), false, false);
    ps = __uint_as_float(rr[0]) + __uint_as_float(rr[1]); }
  l_reg = l_reg * alpha + ps;
#define PK4(P, BASE, OUT) do { unsigned a0 = cvt_pk_bf16(P[BASE + 0], P[BASE + 1]), a1 = cvt_pk_bf16(P[BASE + 2], P[BASE + 3]);   \
    unsigned b0 = cvt_pk_bf16(P[BASE + 4], P[BASE + 5]), b1 = cvt_pk_bf16(P[BASE + 6], P[BASE + 7]);                              \
    auto r0 = __builtin_amdgcn_permlane32_swap(a0, b0, false, false); auto r1 = __builtin_amdgcn_permlane32_swap(a1, b1, false, false); \
    u32x4 w = {r0[0], r1[0], r0[1], r1[1]}; OUT = *reinterpret_cast<bf16x8*>(&w); } while (0)
  PK4(p0, 0, pa0); PK4(p0, 8, pa1); PK4(p1, 0, pa2); PK4(p1, 8, pa3);
#undef PK4
}
DEV void qkt(f32x16& p0, f32x16& p1, const char* Ks, const bf16x8 (&qr)[4], int r32, int hi, int js) {
  p0 = f32x16{}; p1 = f32x16{};
#pragma unroll
  for (int d0 = 0; d0 < 4; ++d0) { const int cb = ((js * 4 + d0) * 16 + hi * 8) * 2;
    bf16x8 b0 = *reinterpret_cast<const bf16x8*>(Ks + KSWZ(r32, cb));
    bf16x8 b1 = *reinterpret_cast<const bf16x8*>(Ks + KSWZ(32 + r32, cb));
    p0 = __builtin_amdgcn_mfma_f32_32x32x16_bf16(b0, qr[d0], p0, 0, 0, 0);
    p1 = __builtin_amdgcn_mfma_f32_32x32x16_bf16(b1, qr[d0], p1, 0, 0, 0); }
}
DEV int v_st(int k, int c) { const int kk = (k & ~0xC) | ((k & 4) << 1) | ((k & 8) >> 1); return ((kk >> 3) * 4 + (c >> 5)) * 512 + ((kk & 7) * 32 + (c & 31)) * 2; }
DEV int v_rd_base(int lane) { return ((lane & 3) << 3) | (((lane >> 2) & 3) << 6) | (((lane >> 4) & 1) << 5) | (((lane >> 5) & 1) << 8); }
constexpr int v_rd_off(int d0, int ks, int half) { return d0 * 512 + ks * 4096 + half * 2048; }
template <int OFF> DEV s16x4 tr_read(int vb) {
  s16x4 r; asm volatile("ds_read_b64_tr_b16 %0, %1 offset:%2" : "=&v"(r) : "v"(vb), "i"(OFF) : "memory"); return r;
}
template <int D0> DEV void pv_one(f32x16& od, int vb, bf16x8 pa0, bf16x8 pa1, bf16x8 pa2, bf16x8 pa3) {
  const s16x4 l0 = tr_read<v_rd_off(D0, 0, 0)>(vb), h0 = tr_read<v_rd_off(D0, 0, 1)>(vb), l1 = tr_read<v_rd_off(D0, 1, 0)>(vb), h1 = tr_read<v_rd_off(D0, 1, 1)>(vb);
  const s16x4 l2 = tr_read<v_rd_off(D0, 2, 0)>(vb), h2 = tr_read<v_rd_off(D0, 2, 1)>(vb), l3 = tr_read<v_rd_off(D0, 3, 0)>(vb), h3 = tr_read<v_rd_off(D0, 3, 1)>(vb);
  asm volatile("s_waitcnt lgkmcnt(0)" ::: "memory"); SBAR();
#define PK(L, H) (bf16x8){L[0], L[1], L[2], L[3], H[0], H[1], H[2], H[3]}
  od = __builtin_amdgcn_mfma_f32_32x32x16_bf16(pa0, PK(l0, h0), od, 0, 0, 0);
  od = __builtin_amdgcn_mfma_f32_32x32x16_bf16(pa1, PK(l1, h1), od, 0, 0, 0);
  od = __builtin_amdgcn_mfma_f32_32x32x16_bf16(pa2, PK(l2, h2), od, 0, 0, 0);
  od = __builtin_amdgcn_mfma_f32_32x32x16_bf16(pa3, PK(l3, h3), od, 0, 0, 0);
#undef PK
}
DEV void pv_d0(f32x16* o, int vb, bf16x8 pa0, bf16x8 pa1, bf16x8 pa2, bf16x8 pa3) {
  pv_one<0>(o[0], vb, pa0, pa1, pa2, pa3); pv_one<1>(o[1], vb, pa0, pa1, pa2, pa3); pv_one<2>(o[2], vb, pa0, pa1, pa2, pa3); pv_one<3>(o[3], vb, pa0, pa1, pa2, pa3);
}
DEV void attn_tiles(const bf16x8 (&qr)[4], const bf16_t* __restrict__ Kh, const bf16_t* __restrict__ Vh, int seq, char* lds,
                    float& m_reg, float& l_reg, f32x16 (&o)[4], int tid, int js) {
  const int wid = tid >> 6, lane = tid & 63, r32 = lane & 31, hi = lane >> 5;
  char* V_lds = lds; char* K_lds = lds + 2 * SHM_V;
  float* ws = (float*)(lds + 2 * SHM_V + 2 * SHM_K) + wid * 64; float* al_l = ws + 32;
  const int sr = tid >> 4, sc = (tid & 15) * 8, vst0 = v_st(sr, sc), vst1 = v_st(32 + sr, sc);
  const int vb0 = (int)(uintptr_t)V_lds + v_rd_base(lane);
  struct { bf16x8 vs0, vs1, ks0, ks1; } sr_[2];
  const unsigned lo0 = (unsigned)((sr * LDK + sc) * 2), lo1 = lo0 + 32u * LDK * 2u;
#define SLOAD(i, k0) do { const char* vb_ = (const char*)Vh + (size_t)(k0) * (LDK * 2); const char* kb_ = (const char*)Kh + (size_t)(k0) * (LDK * 2); \
    sr_[i].vs0 = *(const bf16x8*)(vb_ + lo0); sr_[i].vs1 = *(const bf16x8*)(vb_ + lo1); sr_[i].ks0 = *(const bf16x8*)(kb_ + lo0); sr_[i].ks1 = *(const bf16x8*)(kb_ + lo1); } while (0)
#define SWRITE(b, i) do { *(bf16x8*)(V_lds + (b) * SHM_V + vst0) = sr_[i].vs0;          \
    *(bf16x8*)(V_lds + (b) * SHM_V + vst1) = sr_[i].vs1; int kc = sc * 2;               \
    *(bf16x8*)(K_lds + (b) * SHM_K + KSWZ(sr, kc)) = sr_[i].ks0;                       \
    *(bf16x8*)(K_lds + (b) * SHM_K + KSWZ(32 + sr, kc)) = sr_[i].ks1; } while (0)
#define SWAIT() asm volatile("s_waitcnt vmcnt(4)" ::: "memory")
#define RESC(a) do { if (__any((a) < 1.f)) { if (hi == 0) al_l[r32] = (a); asm volatile("s_waitcnt lgkmcnt(0)" ::: "memory"); \
    for (int d = 0; d < 4; ++d) for (int r = 0; r < 16; ++r) o[d][r] *= al_l[crow(r, hi)]; } } while (0)
  f32x16 pA0, pA1, pB0, pB1; float mnA, mnB, alA, alB; bf16x8 pa0, pa1, pa2, pa3; const int NTL = seq / KVBLK;
  constexpr int SE = 0, SO = 1;
  __syncthreads();
  SLOAD(SE, 0); asm volatile("s_waitcnt vmcnt(0)" ::: "memory"); SWRITE(0, SE); __syncthreads();
  qkt(pA0, pA1, K_lds, qr, r32, hi, js); partialSM(pA0, pA1, m_reg, mnA, alA);
  SLOAD(SO, KVBLK); if (2 < NTL) SLOAD(SE, 2 * KVBLK);
  SWAIT(); SWRITE(1, SO); __syncthreads();
  RESC(alA);
  for (int j = 1; j + 1 < NTL; j += 2) {
    SBAR(); qkt(pB0, pB1, K_lds + SHM_K, qr, r32, hi, js);
    finishSM(pA0, pA1, alA, l_reg, pa0, pa1, pa2, pa3); SBAR();
    SLOAD(SO, (j + 2) * KVBLK); SBAR();
    pv_d0(o, vb0, pa0, pa1, pa2, pa3); partialSM(pB0, pB1, m_reg, mnB, alB);
    __syncthreads(); SWAIT(); SWRITE(0, SE);
    RESC(alB); __syncthreads();
    SBAR(); qkt(pA0, pA1, K_lds, qr, r32, hi, js);
    finishSM(pB0, pB1, alB, l_reg, pa0, pa1, pa2, pa3); SBAR();
    if (j + 3 < NTL) SLOAD(SE, (j + 3) * KVBLK); SBAR();
    pv_d0(o, vb0 + SHM_V, pa0, pa1, pa2, pa3); partialSM(pA0, pA1, m_reg, mnA, alA);
    __syncthreads(); SWAIT(); SWRITE(1, SO);
    RESC(alA); __syncthreads();
  }
  SBAR(); qkt(pB0, pB1, K_lds + SHM_K, qr, r32, hi, js);
  finishSM(pA0, pA1, alA, l_reg, pa0, pa1, pa2, pa3); SBAR();
  pv_d0(o, vb0, pa0, pa1, pa2, pa3); partialSM(pB0, pB1, m_reg, mnB, alB);
  __syncthreads(); RESC(alB);
  finishSM(pB0, pB1, alB, l_reg, pa0, pa1, pa2, pa3); SBAR();
  pv_d0(o, vb0 + SHM_V, pa0, pa1, pa2, pa3);
#undef SLOAD
#undef SWRITE
#undef SWAIT
#undef RESC
}
}

DEV void cvt_tile(const float* src, int ld, int nvalid, bf16_t* dst, int K, int n0, int k0, float* T, const int t, int ns0 = -1) {
    if (ns0 < 0) ns0 = n0;
#pragma unroll
    for (int h = 0; h < 2; ++h) {
        const int kk = (t >> 4) + 32 * h, nq = (t & 15) * 4, n = ns0 + nq;
        const float4 v = n < nvalid ? *(const float4*)(src + (size_t)(k0 + kk) * ld + n) : make_float4(0.f, 0.f, 0.f, 0.f);
        T[(nq + 0) * 65 + kk] = v.x; T[(nq + 1) * 65 + kk] = v.y; T[(nq + 2) * 65 + kk] = v.z; T[(nq + 3) * 65 + kk] = v.w;
    }
    __syncthreads();
    { const int n = t >> 3, kq = (t & 7) * 8; const float* r = T + n * 65 + kq;
      pg8::u32x4 w; w.x = cvt_pk_bf16(r[0], r[1]); w.y = cvt_pk_bf16(r[2], r[3]); w.z = cvt_pk_bf16(r[4], r[5]); w.w = cvt_pk_bf16(r[6], r[7]);
      *(pg8::u32x4*)(dst + (size_t)(n0 + n) * K + k0 + kq) = w; }
    __syncthreads();
}
DEV unsigned pk4_fp8(float a, float b, float c, float d) {
    a = __builtin_amdgcn_fmed3f(a, -448.f, 448.f); b = __builtin_amdgcn_fmed3f(b, -448.f, 448.f); c = __builtin_amdgcn_fmed3f(c, -448.f, 448.f); d = __builtin_amdgcn_fmed3f(d, -448.f, 448.f);
    int w = 0; w = __builtin_amdgcn_cvt_pk_fp8_f32(a, b, w, false); w = __builtin_amdgcn_cvt_pk_fp8_f32(c, d, w, true); return (unsigned)w;
}
constexpr float F8_SW = 1024.f  , F8_SX = 16.f  , F8_SH = 8.f  ;
DEV void cvt_tile4(const float* src, int ld, int nvalid, bf16_t* dst, int K, int n0, int k0, float* T, const int t, int ns0 = -1, bool f8 = false) {
    if (ns0 < 0) ns0 = n0;
    float4 v[4][2];
#pragma unroll
    for (int q = 0; q < 4; ++q)
#pragma unroll
        for (int h = 0; h < 2; ++h) { const int kk = (t >> 4) + 32 * h, n = ns0 + (t & 15) * 4;
            v[q][h] = n < nvalid ? *(const float4*)(src + (size_t)(k0 + q * 64 + kk) * ld + n) : make_float4(0.f, 0.f, 0.f, 0.f); }
#pragma unroll
    for (int q = 0; q < 4; ++q)
#pragma unroll
        for (int h = 0; h < 2; ++h) { const int kk = (t >> 4) + 32 * h, nq = (t & 15) * 4; float* Tq = T + q * (64 * 65);
            Tq[(nq + 0) * 65 + kk] = v[q][h].x; Tq[(nq + 1) * 65 + kk] = v[q][h].y; Tq[(nq + 2) * 65 + kk] = v[q][h].z; Tq[(nq + 3) * 65 + kk] = v[q][h].w; }
    __syncthreads();
#pragma unroll
    for (int q = 0; q < 4; ++q) { const int n = t >> 3, kq = (t & 7) * 8; const float* r = T + q * (64 * 65) + n * 65 + kq;
      if (f8) { pg8::u32x2 w; w.x = pk4_fp8(r[0] * F8_SW, r[1] * F8_SW, r[2] * F8_SW, r[3] * F8_SW); w.y = pk4_fp8(r[4] * F8_SW, r[5] * F8_SW, r[6] * F8_SW, r[7] * F8_SW);
          *(pg8::u32x2*)((unsigned char*)dst + (size_t)(n0 + n) * K + k0 + q * 64 + kq) = w; }
      else { pg8::u32x4 w; w.x = cvt_pk_bf16(r[0], r[1]); w.y = cvt_pk_bf16(r[2], r[3]); w.z = cvt_pk_bf16(r[4], r[5]); w.w = cvt_pk_bf16(r[6], r[7]);
          *(pg8::u32x4*)(dst + (size_t)(n0 + n) * K + k0 + q * 64 + kq) = w; } }
    __syncthreads();
}
DEV void ph_convert(const Params& p, char* smem) {
    const int tidx = tid_of(p.wave_id);
    float* T = (float*)(smem + 256);
    volatile int* msg = (volatile int*)smem;
    unsigned* qh = (unsigned*)(p.ws + OFF_bar) + CW_QHEAD;
    constexpr int T_IN = 2 * 60 * 4, T_OUT = 2 * 16 * 4, T_W1 = 64 * 32 * 4, T_W2 = 64 * 16 * 4;
    unsigned nxt = 0u;
    if (tidx == 0) nxt = xb_add(qh, 1u);
    for (;;) {
        __syncthreads();
        if (tidx == 0) msg[0] = (int)nxt;
        __syncthreads();
        const int u = msg[0];
        if (u >= T_IN + T_OUT + T_W1 + T_W2) break;
        if (tidx == 0) nxt = xb_add(qh, 1u);
        if (u < T_IN) { const int l = u / 240, r = u % 240, nt = r >> 2, kq = r & 3;
            const int n0 = nt * 64; int ns0, nv;
            if (n0 < 2048) { ns0 = n0; nv = DPW; } else if (n0 < 3584) { ns0 = n0 + 16; nv = DPW; } else if (n0 == 3584) { ns0 = 2048; nv = 2064; } else { ns0 = 0; nv = 0; }
            cvt_tile4(p.w_in + (size_t)l * D * DPW, DPW, nv, (bf16_t*)(p.ws + OFF_WIN) + (size_t)l * DP * D, D, n0, kq * 256, T, tidx, ns0); }
        else if (u < T_IN + T_OUT) { const int v = u - T_IN, l = v >> 6, r = v & 63, nt = r >> 2, kq = r & 3;
            cvt_tile4(p.w_out + (size_t)l * D * D, D, D, (bf16_t*)(p.ws + OFF_WOUT) + (size_t)l * D * D, D, nt * 64, kq * 256, T, tidx); }
        else if (u < T_IN + T_OUT + T_W1) { const int v = u - T_IN - T_OUT, le = v >> 7, r = v & 127, nt = r >> 2, kq = r & 3;
            cvt_tile4(p.w1 + (size_t)le * D * 2048, 2048, 2048, (bf16_t*)(p.ws + OFF_W1T + (size_t)le * 2048 * D), D, nt * 64, kq * 256, T, tidx, -1, true); }
        else { const int v = u - T_IN - T_OUT - T_W1, le = v >> 6, r = v & 63, nt = r >> 2, kq = r & 3;
            cvt_tile4(p.w2 + (size_t)le * DFF * D, D, D, (bf16_t*)(p.ws + OFF_W2T + (size_t)le * D * DFF), DFF, nt * 64, kq * 256, T, tidx, -1, true); }
    }
}

DEV void row_load(const float* src, float4 (&v)[4], int lane) {
#pragma unroll
    for (int i = 0; i < 4; ++i) v[i] = *(const float4*)(src + i * 256 + lane * 4);
}
DEV void row_store(float* dst, const float4 (&v)[4], int lane) {
#pragma unroll
    for (int i = 0; i < 4; ++i) *(float4*)(dst + i * 256 + lane * 4) = v[i];
}
DEV void row_store_bf16(bf16_t* dst, const float4 (&v)[4], int lane) {
#pragma unroll
    for (int i = 0; i < 4; ++i) { pg8::u32x2 w; w.x = cvt_pk_bf16(v[i].x, v[i].y); w.y = cvt_pk_bf16(v[i].z, v[i].w); *(pg8::u32x2*)(dst + i * 256 + lane * 4) = w; }
}
DEV void row_store_fp8(unsigned char* dst, const float4 (&v)[4], int lane, float sc) {
#pragma unroll
    for (int i = 0; i < 4; ++i) *(unsigned*)(dst + i * 256 + lane * 4) = pk4_fp8(v[i].x * sc, v[i].y * sc, v[i].z * sc, v[i].w * sc);
}
DEV void row_load_bf(const bf16_t* src, float4 (&v)[4], int lane) {
#pragma unroll
    for (int i = 0; i < 4; ++i) { const pg8::u32x2 w = *(const pg8::u32x2*)(src + i * 256 + lane * 4);
        v[i] = make_float4(__uint_as_float(w.x << 16), __uint_as_float(w.x & 0xffff0000u), __uint_as_float(w.y << 16), __uint_as_float(w.y & 0xffff0000u)); }
}
DEV float row_rinv(const float4 (&v)[4]) {
    float ss = 0.f;
#pragma unroll
    for (int i = 0; i < 4; ++i) ss += v[i].x * v[i].x + v[i].y * v[i].y + v[i].z * v[i].z + v[i].w * v[i].w;
    ss = wsum(ss);
    return rsqrtf(ss * (1.f / 1024.f) + 1e-6f);
}
DEV void row_modnorm(const float4 (&v)[4], const float* gain, const float* shift, const float* scale, float4 (&o)[4], int lane) {
    const float r = row_rinv(v);
#pragma unroll
    for (int i = 0; i < 4; ++i) {
        const int idx = i * 256 + lane * 4;
        const float4 g = *(const float4*)(gain + idx), sh = *(const float4*)(shift + idx), sc = *(const float4*)(scale + idx);
        o[i].x = v[i].x * r * g.x * (1.f + sc.x) + sh.x; o[i].y = v[i].y * r * g.y * (1.f + sc.y) + sh.y;
        o[i].z = v[i].z * r * g.z * (1.f + sc.z) + sh.z; o[i].w = v[i].w * r * g.w * (1.f + sc.w) + sh.w;
    }
}
DEV const float* modrow(const Params& p, int layer, int b, int s) { return ((float*)(p.ws + OFF_MOD)) + ((size_t)layer * 9 + (s < CTX ? 8 : b)) * 6144; }

DEV void ph_mods(const Params& p, char* smem) {
    const int tidx = tid_of(p.wave_id);
    float (*cond)[1024] = (float (*)[1024])smem;
    float (*red)[9][64] = (float (*)[9][64])(smem + 9 * 1024 * 4);
    const int tid = tidx;
    for (int i = tid; i < 9 * 1024; i += 512) { const int r = i >> 10, k = i & 1023; const float c = r < 8 ? p.c[r * 1024 + k] : p.c_ctx[k]; cond[r][k] = c * sigm(c); }
    __syncthreads();
    for (int u = blockIdx.x; u < 192; u += gridDim.x) {
        const int layer = u / 96, cg = u % 96, jj = tid & 63, ks = tid >> 6, j = cg * 64 + jj;
        float acc[9];
#pragma unroll
        for (int r = 0; r < 9; ++r) acc[r] = 0.f;
        const float* w = p.ada_w + (size_t)layer * 1024 * 6144 + j;
        for (int k = ks * 128; k < ks * 128 + 128; ++k) { const float wv = w[(size_t)k * 6144];
#pragma unroll
            for (int r = 0; r < 9; ++r) acc[r] += cond[r][k] * wv; }
#pragma unroll
        for (int r = 0; r < 9; ++r) red[ks][r][jj] = acc[r];
        __syncthreads();
        for (int t = tid; t < 9 * 64; t += 512) { const int r = t >> 6, q = t & 63; float s = 0.f; for (int z = 0; z < 8; ++z) s += red[z][r][q];
            ((float*)(p.ws + OFF_MOD))[((size_t)layer * 9 + r) * 6144 + cg * 64 + q] = s + p.ada_b[layer * 6144 + cg * 64 + q]; }
        __syncthreads();
    }
    if (blockIdx.x == (gridDim.x > 1 ? 1u : 0u)) {
        for (int t = tid; t < 1024; t += 512) { const int pos = t >> 4, i = t & 15; float sn, cs; sincosf((float)pos * expf(-(float)i * (1.f / 16.f) * 9.210340371976184f), &sn, &cs);
            ((float2*)(p.ws + OFF_ROPE))[t] = make_float2(cs, sn); }
    }
    if (blockIdx.x == 0) {
        for (int t = tid; t < 1024; t += 512) { const int layer = t >> 9, dir = (t >> 8) & 1, w = t & 255;
            const float t0 = p.hlb[(dir * 2 + 0) * 256 + w], t1 = p.hlb[(dir * 2 + 1) * 256 + w];
            const float mx = fmaxf(t0, t1), e0 = expf(t0 - mx), e1 = expf(t1 - mx);
            float lb = layer == 0 ? 0.f : e1 / (e0 + e1); lb = fminf(fmaxf(lb, 0.f), 1.f);
            ((float*)(p.ws + OFF_LB))[(layer * 2 + dir) * 256 + w] = lb; }
        if (tid < 128) { const int layer = tid >> 6, lane = tid & 63; const float* L = p.dlam + layer * 256;
            const float s1 = wsum(L[lane] * L[64 + lane]), s2 = wsum(L[128 + lane] * L[192 + lane]);
            if (lane == 0) ((float*)(p.ws + OFF_LAM))[layer] = expf(s1) - expf(s2) + lam_init_of(layer); }
    }
}

DEV void ph_init(const Params& p, char* smem) {
    const int tidx = tid_of(p.wave_id);
    const int wid = tidx >> 6, lane = tidx & 63;
    for (int r = blockIdx.x * 8 + wid; r < NT; r += gridDim.x * 8) {
        const int b = r / SL, s = r % SL;
        const float* src = s < CTX ? p.ctx + ((size_t)b * CTX + s) * D : p.x + ((size_t)b * SEQ + (s - CTX)) * D;
        float4 v[4], o[4]; row_load(src, v, lane); row_store_bf16((bf16_t*)(p.ws + OFF_X) + (size_t)r * D, v, lane);
        const float* m = modrow(p, 0, b, s);
        row_modnorm(v, p.norms + 0, m + 0, m + 1024, o, lane);
        row_store_bf16((bf16_t*)(p.ws + OFF_XNB) + (size_t)r * D, o, lane);
    }
}


struct EpiIn {
    static constexpr bool PERM = false;
    bf16_t *PB, *QRB, *Q0B, *KB, *VB; const float* CS;
    DEV void operator()(const pg8::f32x4 (&acc)[2][2][4][2], const pg8::Unit& u, int wr, int wc, int fr, int fq) const {
        using pg8::f32x4; using pg8::u32x2;
        const int pn = u.pn;
        if (pn < 8 || pn == 14) {
#pragma unroll
            for (int ai = 0; ai < 2; ++ai)
#pragma unroll
                for (int m = 0; m < 4; ++m) { bf16_t* rowp = PB + (size_t)(u.pm * 256 + ai * 128 + wr * 64 + m * 16 + fr) * DP + pn * 256 + wc * 32 + 4 * fq;
#pragma unroll
                    for (int bj = 0; bj < 2; ++bj)
#pragma unroll
                        for (int n = 0; n < 2; ++n) { const f32x4 v = acc[ai][bj][m][n]; u32x2 w; w.x = cvt_pk_bf16(v[0], v[1]); w.y = cvt_pk_bf16(v[2], v[3]); *(u32x2*)(rowp + bj * 128 + n * 16) = w; } }
        } else {
            const int kind = (pn - 8) >> 1, hb = ((pn - 8) & 1) * 2, b = u.pm / 9, tq = u.pm % 9, half = wc & 1, jsub = wc >> 1;
            const bool isctx = tq == 0;
            const float QC = 0.125f * 1.4426950408889634f;
#pragma unroll
            for (int ai = 0; ai < 2; ++ai)
#pragma unroll
                for (int m = 0; m < 4; ++m) {
                    const int s = tq * 256 + ai * 128 + wr * 64 + m * 16 + fr;
                    f32x4 c4 = {1.f, 1.f, 1.f, 1.f}, s4 = {0.f, 0.f, 0.f, 0.f};
                    if (kind != 2 && !isctx) { const int pos = half == 0 ? (tq - 1) * 4 + ai * 2 + wr : m * 16 + fr;
                        const f32x4 t0 = *(const f32x4*)(CS + (pos * 16 + 4 * fq) * 2), t1 = *(const f32x4*)(CS + (pos * 16 + 4 * fq) * 2 + 4);
                        c4 = (f32x4){t0[0], t0[2], t1[0], t1[2]}; s4 = (f32x4){t0[1], t0[3], t1[1], t1[3]}; }
#pragma unroll
                    for (int bj = 0; bj < 2; ++bj) {
                        const size_t dst = ((size_t)(b * 4 + hb + bj) * SL + s) * 128 + jsub * 64 + half * 32 + 4 * fq;
                        const f32x4 x1 = acc[ai][bj][m][0], x2 = acc[ai][bj][m][1];
#define ST4(ptr, v) do { u32x2 w_; w_.x = cvt_pk_bf16((v)[0], (v)[1]); w_.y = cvt_pk_bf16((v)[2], (v)[3]); *(u32x2*)(ptr) = w_; } while (0)
                        if (kind == 2) { ST4(VB + dst, x1); ST4(VB + dst + 16, x2); }
                        else {
                            const f32x4 o1 = x1 * c4 - x2 * s4, o2 = x1 * s4 + x2 * c4;
                            if (kind == 1) { ST4(KB + dst, o1); ST4(KB + dst + 16, o2); }
                            else { const f32x4 a1 = o1 * QC, a2 = o2 * QC, p1 = x1 * QC, p2 = x2 * QC; ST4(QRB + dst, a1); ST4(QRB + dst + 16, a2); ST4(Q0B + dst, p1); ST4(Q0B + dst + 16, p2); }
                        }
#undef ST4
                    }
                }
        }
    }
};

struct InOrder {
    int G, c, Lbeg, Lend; const char* Bt; int K;
    DEV bool next(int i, pg8::Unit& u) const {
        const int L = Lbeg + i * G + c; if (L >= Lend) return false;
        const int nN = L < 648 ? 9 : 6, l = L < 648 ? L : L - 648, nM = NT / 256, nwg = nM * nN;
        int wgid = l; { const int q = nwg / 8, r = nwg % 8, xcd = wgid % 8, off = wgid / 8; wgid = (xcd < r ? xcd * (q + 1) : r * (q + 1) + (xcd - r) * q) + off; }
        const int nig = 8 * nN, gid = wgid / nig, fm = gid * 8, gsz = (nM - fm) < 8 ? (nM - fm) : 8;
        const int pnl = (wgid % nig) / gsz;
        u.pm = fm + ((wgid % nig) % gsz); u.pn = L < 648 ? (pnl < 8 ? pnl : 14) : 8 + pnl; u.e = 0; u.t = 0; return true;
    }
    DEV int arow(const pg8::Unit& u, int rr) const { return u.pm * 256 + rr; }
    DEV const char* bbase(const pg8::Unit& u) const { return Bt + (size_t)u.pn * 256 * K * 2; }
};
DEV void ph_inproj(const Params& p, int layer, char* smem, int part) {
    const int tidx = tid_of(p.wave_id);
    const int G = (int)gridDim.x, nun = (NT / 256) * (DP / 256), cut = 4 * G < nun ? 4 * G : nun;
    const int nleft = nun - cut, cid = part == 0 ? (int)blockIdx.x : (int)blockIdx.x - (G - nleft);
    if (part == 1 && (nleft <= 0 || cid < 0)) return;
    InOrder S{G, cid, part == 0 ? 0 : cut, part == 0 ? cut : nun, (const char*)((const bf16_t*)(p.ws + OFF_WIN) + (size_t)layer * DP * D), D};
    EpiIn E{(bf16_t*)(p.ws + OFF_PB), (bf16_t*)(p.ws + OFF_QRB), (bf16_t*)(p.ws + OFF_Q0B), (bf16_t*)(p.ws + OFF_KB), (bf16_t*)(p.ws + OFF_VB), (const float*)(p.ws + OFF_ROPE)};
    pg8::gemm_phase(( LAS unsigned char*)smem, (const char*)(p.ws + OFF_XNB), D, S, E, tid_of(p.wave_id));
}


namespace scn {
using att::bf16x8; using att::s16x4; using att::f32x16; using att::u32x4; using att::crow;
DEV int v_st64(int k, int c) { const int kk = (k & ~0xC) | ((k & 4) << 1) | ((k & 8) >> 1); return ((kk >> 3) * 2 + (c >> 5)) * 512 + ((kk & 7) * 32 + (c & 31)) * 2; }
constexpr int v_rd_off64(int d0, int ks, int half) { return d0 * 512 + ks * 2048 + half * 1024; }
#define SCN_PK(L, H) (bf16x8){L[0], L[1], L[2], L[3], H[0], H[1], H[2], H[3]}
template <int D0> DEV void frags4(int vb, bf16x8& f0, bf16x8& f1, bf16x8& f2, bf16x8& f3) {
    const s16x4 l0 = att::tr_read<v_rd_off64(D0, 0, 0)>(vb), h0 = att::tr_read<v_rd_off64(D0, 0, 1)>(vb), l1 = att::tr_read<v_rd_off64(D0, 1, 0)>(vb), h1 = att::tr_read<v_rd_off64(D0, 1, 1)>(vb);
    const s16x4 l2 = att::tr_read<v_rd_off64(D0, 2, 0)>(vb), h2 = att::tr_read<v_rd_off64(D0, 2, 1)>(vb), l3 = att::tr_read<v_rd_off64(D0, 3, 0)>(vb), h3 = att::tr_read<v_rd_off64(D0, 3, 1)>(vb);
    asm volatile("s_waitcnt lgkmcnt(0)" ::: "memory"); SBAR();
    f0 = SCN_PK(l0, h0); f1 = SCN_PK(l1, h1); f2 = SCN_PK(l2, h2); f3 = SCN_PK(l3, h3);
}
DEV bf16x8 pack8(const float (&v)[8]) { u32x4 w = {cvt_pk_bf16(v[0], v[1]), cvt_pk_bf16(v[2], v[3]), cvt_pk_bf16(v[4], v[5]), cvt_pk_bf16(v[6], v[7])}; return *reinterpret_cast<bf16x8*>(&w); }
DEV void stage64(char* img, const float* src, size_t ld, int lane, float sc = 1.f) {
    const float* row = src + (size_t)lane * ld;
#pragma unroll
    for (int c8 = 0; c8 < 8; ++c8) { const float4 a = *(const float4*)(row + c8 * 8), b = *(const float4*)(row + c8 * 8 + 4);
        u32x4 w = {cvt_pk_bf16(a.x * sc, a.y * sc), cvt_pk_bf16(a.z * sc, a.w * sc), cvt_pk_bf16(b.x * sc, b.y * sc), cvt_pk_bf16(b.z * sc, b.w * sc)};
        *(u32x4*)(img + v_st64(lane, c8 * 8)) = w; }
}
template <int CTRL, int RM> DEV float dpp_f(float oldv, float v, bool bc) { return bc ? __builtin_bit_cast(float, __builtin_amdgcn_update_dpp(__builtin_bit_cast(int, oldv), __builtin_bit_cast(int, v), CTRL, RM, 0xf, true))
                                                                                   : __builtin_bit_cast(float, __builtin_amdgcn_update_dpp(__builtin_bit_cast(int, oldv), __builtin_bit_cast(int, v), CTRL, RM, 0xf, false)); }
DEV float bperm(float v, int src) { return __builtin_bit_cast(float, __builtin_amdgcn_ds_bpermute(src << 2, __builtin_bit_cast(int, v))); }
DEV float scan_inc32(float v) {
    v += dpp_f<0x111, 0xf>(0.f, v, true); v += dpp_f<0x112, 0xf>(0.f, v, true); v += dpp_f<0x114, 0xf>(0.f, v, true); v += dpp_f<0x118, 0xf>(0.f, v, true);
    v += dpp_f<0x142, 0xa>(0.f, v, false);
    return v;
}
DEV float scanmax_inc32(float v) {
    const float ni = -3.0e38f;
    v = fmaxf(v, dpp_f<0x111, 0xf>(ni, v, false)); v = fmaxf(v, dpp_f<0x112, 0xf>(ni, v, false)); v = fmaxf(v, dpp_f<0x114, 0xf>(ni, v, false)); v = fmaxf(v, dpp_f<0x118, 0xf>(ni, v, false));
    v = fmaxf(v, dpp_f<0x142, 0xa>(ni, v, false));
    return v;
}
DEV float scanmax_suf32(float v, int lane) {
    const float ni = -3.0e38f;
    v = fmaxf(v, dpp_f<0x101, 0xf>(ni, v, false)); v = fmaxf(v, dpp_f<0x102, 0xf>(ni, v, false)); v = fmaxf(v, dpp_f<0x104, 0xf>(ni, v, false)); v = fmaxf(v, dpp_f<0x108, 0xf>(ni, v, false));
    const float t = bperm(v, (lane & 32) | 16);
    return (lane & 16) ? v : fmaxf(v, t);
}
DEV void ld8(const bf16_t* ub, unsigned boff, float (&v)[8]) { const u32x4 w = *(const u32x4*)((const char*)ub + boff);
    v[0] = __uint_as_float(w.x << 16); v[1] = __uint_as_float(w.x & 0xffff0000u); v[2] = __uint_as_float(w.y << 16); v[3] = __uint_as_float(w.y & 0xffff0000u);
    v[4] = __uint_as_float(w.z << 16); v[5] = __uint_as_float(w.z & 0xffff0000u); v[6] = __uint_as_float(w.w << 16); v[7] = __uint_as_float(w.w & 0xffff0000u); }
DEV float ld1(const bf16_t* ub, unsigned boff) { return __uint_as_float((unsigned)(*(const unsigned short*)((const char*)ub + boff)) << 16); }
DEV void stage64b(char* img, const bf16_t* src, size_t ld, int lane) {
    const bf16_t* row = src + (size_t)lane * ld;
#pragma unroll
    for (int c8 = 0; c8 < 8; ++c8) *(u32x4*)(img + v_st64(lane, c8 * 8)) = *(const u32x4*)(row + c8 * 8);
}
DEV float4 ldg4(const float* ub, unsigned boff) { return *(const float4*)((const char*)ub + boff); }
DEV float ldg1(const float* ub, unsigned boff) { return *(const float*)((const char*)ub + boff); }
DEV float fexp(float x) { return __expf(fminf(fmaxf(x, -80.f), 80.f)); }
DEV float fsig(float x) { return __builtin_amdgcn_rcpf(1.f + __expf(-x)); }
DEV void decay_ks(const float (&x)[2][8], const float (&lb)[8], int dir, int lane, float (&cum)[2][8], float (&kk)[2][8], float (&ref)[8]) {
#pragma unroll
    for (int tb = 0; tb < 2; ++tb)
#pragma unroll
        for (int j = 0; j < 8; ++j) { const float sg = fsig(x[tb][j]); kk[tb][j] = (1.f - lb[j]) * (1.f - sg); cum[tb][j] = __logf(fmaxf(lb[j] + (1.f - lb[j]) * sg, 1e-12f)); }
#pragma unroll
    for (int j = 0; j < 8; ++j) {
        const float i0 = scan_inc32(cum[0][j]), i1 = scan_inc32(cum[1][j]), t0 = bperm(i0, lane | 31), t1 = bperm(i1, lane | 31);
        if (dir == 0) { cum[0][j] = i0; cum[1][j] = i1 + t0; ref[j] = t0; }
        else { const float x0 = cum[0][j], x1 = cum[1][j]; cum[1][j] = t1 - i1 + x1; cum[0][j] = t0 - i0 + x0 + t1; ref[j] = t1; }
        if ((j & 3) == 3) SBAR();
    }
}
}

DEV void scanA_local(const Params& p, int layer, char* Lw, int bh, int tc, int lane) {
    using namespace scn;
    asm volatile("" : "+v"(lane));
    const int r32 = lane & 31, hi = lane >> 5, b = bh >> 2, h = bh & 3;
    const bf16_t* base = (const bf16_t*)(p.ws + OFF_PB) + (size_t)(b * SL + 64 * tc) * DP;
    unsigned lo = (unsigned)(r32 * DP + 8 * hi) * 2u;
    asm volatile("" : "+v"(lo));
    char* imgV = Lw; char* imgK = Lw + 8192;
    const int vbV = (int)(uintptr_t)imgV + att::v_rd_base(lane), vbK = vbV + 8192;
    stage64b(imgV, base + O_AI + h * 64, DP, lane);
#pragma unroll 1
    for (int dir = 0; dir < 2; ++dir) {
        const int chain = bh * 2 + dir, c = dir == 0 ? tc : (tc < 4 ? 3 - tc : 39 - tc);
#pragma unroll 1
        for (int ks = 0; ks < 4; ++ks) {
            const int ch = 16 * ks + 8 * hi;
            float x[2][8], cum[2][8], kk[2][8], ref[8], lb[8];
#pragma unroll
            for (int tb = 0; tb < 2; ++tb) ld8(base + (dir ? O_AFB : O_AFF) + h * 64 + 16 * ks, lo + tb * (32u * DP * 2u), x[tb]);
            { const float* l = (const float*)(p.ws + OFF_LB) + (layer * 2 + dir) * 256 + h * 64 + ch;
#pragma unroll
              for (int j = 0; j < 8; ++j) lb[j] = l[j]; }
            decay_ks(x, lb, dir, lane, cum, kk, ref);
            float ke[8];
#pragma unroll
            for (int tb = 0; tb < 2; ++tb) {
#pragma unroll
                for (int j = 0; j < 8; ++j) { const float ce = dir == 0 ? bperm(cum[1][j], lane | 31) : bperm(cum[0][j], lane & 32);
                    ke[j] = kk[tb][j] * fexp(ce - cum[tb][j]);
                    if (tb == 1 && dir == 0 && r32 == 31) ((float*)(p.ws + OFF_DECA))[(chain * 36 + c) * 64 + ch + j] = __expf(ce);
                    if (tb == 0 && dir == 1 && r32 == 0) ((float*)(p.ws + OFF_DECA))[(chain * 36 + c) * 64 + ch + j] = __expf(ce); }
                *(bf16x8*)(imgK + v_st64(32 * tb + r32, ch)) = pack8(ke);
            }
            SBAR();
        }
        f32x16 u[2][2] = {};
        { bf16x8 k0, k1, k2, k3, v0, v1, v2, v3;
          frags4<0>(vbK, k0, k1, k2, k3); frags4<0>(vbV, v0, v1, v2, v3);
          u[0][0] = __builtin_amdgcn_mfma_f32_32x32x16_bf16(k0, v0, u[0][0], 0, 0, 0); u[0][0] = __builtin_amdgcn_mfma_f32_32x32x16_bf16(k1, v1, u[0][0], 0, 0, 0);
          u[0][0] = __builtin_amdgcn_mfma_f32_32x32x16_bf16(k2, v2, u[0][0], 0, 0, 0); u[0][0] = __builtin_amdgcn_mfma_f32_32x32x16_bf16(k3, v3, u[0][0], 0, 0, 0);
          bf16x8 w0, w1, w2, w3; frags4<1>(vbV, w0, w1, w2, w3);
          u[0][1] = __builtin_amdgcn_mfma_f32_32x32x16_bf16(k0, w0, u[0][1], 0, 0, 0); u[0][1] = __builtin_amdgcn_mfma_f32_32x32x16_bf16(k1, w1, u[0][1], 0, 0, 0);
          u[0][1] = __builtin_amdgcn_mfma_f32_32x32x16_bf16(k2, w2, u[0][1], 0, 0, 0); u[0][1] = __builtin_amdgcn_mfma_f32_32x32x16_bf16(k3, w3, u[0][1], 0, 0, 0);
          frags4<1>(vbK, k0, k1, k2, k3);
          u[1][0] = __builtin_amdgcn_mfma_f32_32x32x16_bf16(k0, v0, u[1][0], 0, 0, 0); u[1][0] = __builtin_amdgcn_mfma_f32_32x32x16_bf16(k1, v1, u[1][0], 0, 0, 0);
          u[1][0] = __builtin_amdgcn_mfma_f32_32x32x16_bf16(k2, v2, u[1][0], 0, 0, 0); u[1][0] = __builtin_amdgcn_mfma_f32_32x32x16_bf16(k3, v3, u[1][0], 0, 0, 0);
          u[1][1] = __builtin_amdgcn_mfma_f32_32x32x16_bf16(k0, w0, u[1][1], 0, 0, 0); u[1][1] = __builtin_amdgcn_mfma_f32_32x32x16_bf16(k1, w1, u[1][1], 0, 0, 0);
          u[1][1] = __builtin_amdgcn_mfma_f32_32x32x16_bf16(k2, w2, u[1][1], 0, 0, 0); u[1][1] = __builtin_amdgcn_mfma_f32_32x32x16_bf16(k3, w3, u[1][1], 0, 0, 0); }
        float* U = (float*)(p.ws + OFF_UA) + ((size_t)chain * 36 + c) * 4096;
#pragma unroll
        for (int kb = 0; kb < 2; ++kb)
#pragma unroll
            for (int d0 = 0; d0 < 2; ++d0)
#pragma unroll
                for (int r = 0; r < 16; ++r) U[(32 * kb + crow(r, hi)) * 64 + 32 * d0 + r32] = u[kb][d0][r];
    }
}
DEV void scanA_out(const Params& p, int layer, char* Lw, int bh, int tc, int lane) {
    using namespace scn;
    asm volatile("" : "+v"(lane));
    const int r32 = lane & 31, hi = lane >> 5, b = bh >> 2, h = bh & 3;
    const bf16_t* base = (const bf16_t*)(p.ws + OFF_PB) + (size_t)(b * SL + 64 * tc) * DP;
    unsigned lo = (unsigned)(r32 * DP + 8 * hi) * 2u;
    asm volatile("" : "+v"(lo));
    char* imgV = Lw; char* imgS = Lw + 8192;
    const int vbV = (int)(uintptr_t)imgV + att::v_rd_base(lane), vbS = vbV + 8192;
    stage64b(imgV, base + O_AI + h * 64, DP, lane);
    f32x16 o[2][2] = {};
#pragma unroll 1
    for (int dir = 0; dir < 2; ++dir) {
        const int chain = bh * 2 + dir, c = dir == 0 ? tc : (tc < 4 ? 3 - tc : 39 - tc);
        const float* S0g = (const float*)(p.ws + OFF_SA) + ((size_t)chain * 36 + c) * 4096;
        f32x16 pd0 = {}, pd1 = {}, px = {};
#define MM(acc, A, B) acc = __builtin_amdgcn_mfma_f32_32x32x16_bf16(A, B, acc, 0, 0, 0)
#define LOADX(ks) do { _Pragma("unroll") for (int tb = 0; tb < 2; ++tb) ld8(base + (dir ? O_AFB : O_AFF) + h * 64 + 16 * (ks), lo + tb * (32u * DP * 2u), xr[tb]); } while (0)
#define LOADQ(ks) do { _Pragma("unroll") for (int tb = 0; tb < 2; ++tb) ld8(base + O_AQ + h * 64 + 16 * (ks), lo + tb * (32u * DP * 2u), qr[tb]); } while (0)
        float xr[2][8], qr[2][8];
#define KSTEP(ks) do { \
            const int ch = 16 * (ks) + 8 * hi; \
            float cum[2][8], kk[2][8], ref[8], lb[8]; \
            { const float* l = (const float*)(p.ws + OFF_LB) + (layer * 2 + dir) * 256 + h * 64 + ch; _Pragma("unroll") for (int j = 0; j < 8; ++j) lb[j] = l[j]; } \
            const int ci = lane >> 2; const int row = 16 * (ks) + ci, c16 = (lane & 3) * 16; const float* sp = S0g + row * 64 + c16; \
            LOADX(ks); LOADQ(ks); decay_ks(xr, lb, dir, lane, cum, kk, ref); \
            const float4 sa = *(const float4*)sp, sb4 = *(const float4*)(sp + 4), sc4 = *(const float4*)(sp + 8), sd4 = *(const float4*)(sp + 12); \
              \
            { const int sj = ci & 7, sl = (ci >> 3) * 32; float rv = 0.f; \
              _Pragma("unroll") for (int j = 0; j < 8; ++j) { const float t = bperm(ref[j], sl); rv = (sj == j) ? t : rv; } \
              const float er = __expf(fmaxf(rv, -80.f)); \
              u32x4 w0 = {cvt_pk_bf16(sa.x * er, sa.y * er), cvt_pk_bf16(sa.z * er, sa.w * er), cvt_pk_bf16(sb4.x * er, sb4.y * er), cvt_pk_bf16(sb4.z * er, sb4.w * er)}; \
              u32x4 w1 = {cvt_pk_bf16(sc4.x * er, sc4.y * er), cvt_pk_bf16(sc4.z * er, sc4.w * er), cvt_pk_bf16(sd4.x * er, sd4.y * er), cvt_pk_bf16(sd4.z * er, sd4.w * er)}; \
              *(u32x4*)(imgS + v_st64(row, c16)) = w0; *(u32x4*)(imgS + v_st64(row, c16 + 8)) = w1; } \
            bf16x8 qt0, qt1, kt0, kt1; \
            _Pragma("unroll") for (int tb = 0; tb < 2; ++tb) { \
                float t1[8], t2[8]; \
                _Pragma("unroll") for (int j = 0; j < 8; ++j) { const float q = qr[tb][j] * fsig(qr[tb][j]); t1[j] = q * fexp(cum[tb][j] - ref[j]); t2[j] = kk[tb][j] * fexp(ref[j] - cum[tb][j]); } \
                if (tb == 0) { qt0 = pack8(t1); kt0 = pack8(t2); } else { qt1 = pack8(t1); kt1 = pack8(t2); } } \
            MM(pd0, kt0, qt0); MM(pd1, kt1, qt1); if (dir == 0) MM(px, kt0, qt1); else MM(px, kt1, qt0); \
            { const s16x4 l0 = att::tr_read<v_rd_off64(0, ks, 0)>(vbS), h0 = att::tr_read<v_rd_off64(0, ks, 1)>(vbS), l1 = att::tr_read<v_rd_off64(1, ks, 0)>(vbS), h1 = att::tr_read<v_rd_off64(1, ks, 1)>(vbS); \
              asm volatile("s_waitcnt lgkmcnt(0)" ::: "memory"); SBAR(); \
              const bf16x8 s0 = SCN_PK(l0, h0), s1 = SCN_PK(l1, h1); \
              MM(o[0][0], qt0, s0); MM(o[1][0], qt1, s0); MM(o[0][1], qt0, s1); MM(o[1][1], qt1, s1); } \
            SBAR(); } while (0)
        KSTEP(0); KSTEP(1); KSTEP(2); KSTEP(3);
#undef KSTEP
#undef LOADX
#undef LOADQ
        const int r32m = r32;
#pragma unroll
        for (int r = 0; r < 16; ++r) { const int sl = crow(r, hi); const bool keep = dir == 0 ? (sl <= r32m) : (sl >= r32m); pd0[r] = keep ? pd0[r] : 0.f; pd1[r] = keep ? pd1[r] : 0.f; }
        bf16x8 a0, a1, b0, b1, c0, c1;
#define PK4(P, BASE, OUT) do { unsigned a0_ = cvt_pk_bf16(P[BASE + 0], P[BASE + 1]), a1_ = cvt_pk_bf16(P[BASE + 2], P[BASE + 3]);   \
    unsigned b0_ = cvt_pk_bf16(P[BASE + 4], P[BASE + 5]), b1_ = cvt_pk_bf16(P[BASE + 6], P[BASE + 7]);                              \
    auto r0_ = __builtin_amdgcn_permlane32_swap(a0_, b0_, false, false); auto r1_ = __builtin_amdgcn_permlane32_swap(a1_, b1_, false, false); \
    u32x4 w_ = {r0_[0], r1_[0], r0_[1], r1_[1]}; OUT = *reinterpret_cast<bf16x8*>(&w_); } while (0)
        PK4(pd0, 0, a0); PK4(pd0, 8, a1); PK4(pd1, 0, b0); PK4(pd1, 8, b1); PK4(px, 0, c0); PK4(px, 8, c1);
#undef PK4
        {   bf16x8 v0, v1, v2, v3;
#define BLOCK(D0) do { frags4<D0>(vbV, v0, v1, v2, v3); \
            if (dir == 0) { MM(o[0][D0], a0, v0); MM(o[0][D0], a1, v1); MM(o[1][D0], c0, v0); MM(o[1][D0], c1, v1); MM(o[1][D0], b0, v2); MM(o[1][D0], b1, v3); } \
            else          { MM(o[0][D0], a0, v0); MM(o[0][D0], a1, v1); MM(o[0][D0], c0, v2); MM(o[0][D0], c1, v3); MM(o[1][D0], b0, v2); MM(o[1][D0], b1, v3); } } while (0)
            BLOCK(0); BLOCK(1);
#undef BLOCK
        }
#undef MM
    }
    unsigned rob = (unsigned)(4 * hi * DP + r32) * 2u, mob = (unsigned)(4 * hi * D + r32) * 2u;
    asm volatile("" : "+v"(rob), "+v"(mob));
    float gv[2][16][2];
#pragma unroll
    for (int tb = 0; tb < 2; ++tb)
#pragma unroll
        for (int r = 0; r < 16; ++r) { const unsigned go = rob + (unsigned)(32 * tb + (r & 3) + 8 * (r >> 2)) * (DP * 2u); const bf16_t* gb = base + O_AG + h * 64;
            gv[tb][r][0] = ld1(gb, go); gv[tb][r][1] = ld1(gb, go + 64u); }
#pragma unroll
    for (int tb = 0; tb < 2; ++tb)
#pragma unroll
        for (int r = 0; r < 16; ++r) {
            const float x0 = o[tb][0][r], x1 = o[tb][1][r];
            float t = x0 * x0 + x1 * x1; t += bperm(t, lane ^ 1); t += bperm(t, lane ^ 2); t += bperm(t, lane ^ 4); t += bperm(t, lane ^ 8); t += bperm(t, lane ^ 16);
            const float ri = rsqrtf(t * (1.f / 64.f) + 1e-6f);
            const unsigned tcst = (unsigned)(32 * tb + (r & 3) + 8 * (r >> 2));
            const float g0 = gv[tb][r][0], g1 = gv[tb][r][1];
            char* mb = (char*)((bf16_t*)(p.ws + OFF_MIXB) + (size_t)(b * SL + 64 * tc) * D + h * 64); const unsigned mo = mob + tcst * (D * 2u);
            *(bf16_t*)(mb + mo) = (bf16_t)(cvt_pk_bf16(x0 * ri * p.hnorm[layer * 64 + r32] * (g0 * fsig(g0)), 0.f) & 0xffffu);
            *(bf16_t*)(mb + mo + 64u) = (bf16_t)(cvt_pk_bf16(x1 * ri * p.hnorm[layer * 64 + 32 + r32] * (g1 * fsig(g1)), 0.f) & 0xffffu);
        }
}

namespace scn {
DEV float logsig_f(float g) { return fminf(g, 0.f) - __logf(1.f + __expf(-fabsf(g))); }
DEV void gates_B(const bf16_t* gb  , unsigned rowoff, int dir, float bi, float bf, int lane, float (&cumf)[2], float (&g)[2], float (&G)[2], float& cend, float& gmax) {
    float lf[2], li[2];
#pragma unroll
    for (int tb = 0; tb < 2; ++tb) { const unsigned bo = rowoff + tb * (32u * DP * 2u); li[tb] = ld1(gb + (dir * 2 + 0) * 4, bo) + bi; lf[tb] = logsig_f(ld1(gb + (dir * 2 + 1) * 4, bo) + bf); }
    { const float i0 = scan_inc32(lf[0]), i1 = scan_inc32(lf[1]), t0 = bperm(i0, lane | 31), t1 = bperm(i1, lane | 31);
      if (dir == 0) { cumf[0] = i0; cumf[1] = i1 + t0; } else { cumf[1] = t1 - i1 + lf[1]; cumf[0] = t0 - i0 + lf[0] + t1; }
      cend = t0 + t1; }
    g[0] = li[0] - cumf[0]; g[1] = li[1] - cumf[1];
    if (dir == 0) { const float a0 = scanmax_inc32(g[0]), m0 = bperm(a0, lane | 31), a1 = fmaxf(scanmax_inc32(g[1]), m0); G[0] = a0; G[1] = a1; gmax = bperm(a1, lane | 31); }
    else { const float a1 = scanmax_suf32(g[1], lane), m1 = bperm(a1, lane & 32), a0 = fmaxf(scanmax_suf32(g[0], lane), m1); G[0] = a0; G[1] = a1; gmax = bperm(a0, lane & 32); }
}
}
DEV void scanB_local(const Params& p, int layer, char* Lw, int bh, int tc, int lane) {
    using namespace scn;
    asm volatile("" : "+v"(lane));
    const int r32 = lane & 31, hi = lane >> 5, b = bh >> 2, h = bh & 3;
    const bf16_t* base = (const bf16_t*)(p.ws + OFF_PB) + (size_t)(b * SL + 64 * tc) * DP;
    unsigned ro = (unsigned)(r32 * DP) * 2u; asm volatile("" : "+v"(ro));
    char* imgV = Lw; char* imgK = Lw + 8192;
    const int vbV = (int)(uintptr_t)imgV + att::v_rd_base(lane), vbK = vbV + 8192;
    stage64b(imgV, base + O_BV + h * 64, DP, lane);
#pragma unroll 1
    for (int dir = 0; dir < 2; ++dir) {
        const int chain = bh * 2 + dir, c = dir == 0 ? tc : (tc < 4 ? 3 - tc : 39 - tc);
        const float bi = p.mgb[layer * 16 + (dir * 2 + 0) * 4 + h], bf = p.mgb[layer * 16 + (dir * 2 + 1) * 4 + h];
        float cumf[2], g[2], G[2], cend, gmax;
        gates_B(base + O_BG + h, ro, dir, bi, bf, lane, cumf, g, G, cend, gmax);
        const float w[2] = {__expf(g[0] - gmax), __expf(g[1] - gmax)};
#pragma unroll
        for (int ks = 0; ks < 2; ++ks) {
            float un[8];
#pragma unroll
            for (int j = 0; j < 8; ++j) un[j] = 0.f;
#pragma unroll
            for (int tb = 0; tb < 2; ++tb) { float wk[8]; ld8(base + O_BK + h * 32 + 16 * ks, ro + 16u * hi + tb * (32u * DP * 2u), wk);
#pragma unroll
                for (int j = 0; j < 8; ++j) { wk[j] *= w[tb]; un[j] += wk[j]; }
                *(bf16x8*)(imgK + v_st64(32 * tb + r32, 16 * ks + 8 * hi)) = pack8(wk); }
#pragma unroll
            for (int j = 0; j < 8; ++j) { float t = un[j]; t += bperm(t, lane ^ 1); t += bperm(t, lane ^ 2); t += bperm(t, lane ^ 4); t += bperm(t, lane ^ 8); t += bperm(t, lane ^ 16);
                if (r32 == 0) ((float*)(p.ws + OFF_NB))[(chain * 36 + c) * 32 + 16 * ks + 8 * hi + j] = t; }
        }
        f32x16 u0 = {}, u1 = {};
        { bf16x8 k0, k1, k2, k3, v0, v1, v2, v3;
#define MM(acc, A, B) acc = __builtin_amdgcn_mfma_f32_32x32x16_bf16(A, B, acc, 0, 0, 0)
          frags4<0>(vbK, k0, k1, k2, k3); frags4<0>(vbV, v0, v1, v2, v3);
          MM(u0, k0, v0); MM(u0, k1, v1); MM(u0, k2, v2); MM(u0, k3, v3);
          frags4<1>(vbV, v0, v1, v2, v3);
          MM(u1, k0, v0); MM(u1, k1, v1); MM(u1, k2, v2); MM(u1, k3, v3);
#undef MM
        }
        float* U = (float*)(p.ws + OFF_UB) + ((size_t)chain * 36 + c) * 2048;
#pragma unroll
        for (int r = 0; r < 16; ++r) { U[crow(r, hi) * 64 + r32] = u0[r]; U[crow(r, hi) * 64 + 32 + r32] = u1[r]; }
        if (lane == 0) { float* M = (float*)(p.ws + OFF_MB) + (chain * 36 + c) * 4; M[0] = cend + gmax; M[1] = cend; }
    }
}
DEV void scanB_out(const Params& p, int layer, char* Lw, int bh, int tc, int lane) {
    using namespace scn;
    asm volatile("" : "+v"(lane));
    const int r32 = lane & 31, hi = lane >> 5, b = bh >> 2, h = bh & 3;
    const bf16_t* base = (const bf16_t*)(p.ws + OFF_PB) + (size_t)(b * SL + 64 * tc) * DP;
    unsigned ro = (unsigned)(r32 * DP) * 2u; asm volatile("" : "+v"(ro));
    char* imgV = Lw; char* imgC = Lw + 8192; float* gA = (float*)(Lw + 12288); float* dA = gA + 64;
    const int vbV = (int)(uintptr_t)imgV + att::v_rd_base(lane), vbC = vbV + 8192;
    stage64b(imgV, base + O_BV + h * 64, DP, lane);
#pragma unroll 1
    for (int dir = 0; dir < 2; ++dir) {
        const int chain = bh * 2 + dir, c = dir == 0 ? tc : (tc < 4 ? 3 - tc : 39 - tc);
        const float bi = p.mgb[layer * 16 + (dir * 2 + 0) * 4 + h], bf = p.mgb[layer * 16 + (dir * 2 + 1) * 4 + h];
        { const float* cg = (const float*)(p.ws + OFF_SB) + ((size_t)chain * 36 + c) * 2048 + (lane >> 1) * 64 + (lane & 1) * 32;
#pragma unroll
          for (int i = 0; i < 4; ++i) { const float4 a = *(const float4*)(cg + 8 * i), bq = *(const float4*)(cg + 8 * i + 4);
              u32x4 w = {cvt_pk_bf16(a.x, a.y), cvt_pk_bf16(a.z, a.w), cvt_pk_bf16(bq.x, bq.y), cvt_pk_bf16(bq.z, bq.w)};
              *(u32x4*)(imgC + v_st64(lane >> 1, (lane & 1) * 32 + 8 * i)) = w; } }
        const float m0 = ((const float*)(p.ws + OFF_MB))[(chain * 36 + c) * 4 + 2];
        float rq[2][2][8], rk[2][2][8];
#pragma unroll
        for (int ks = 0; ks < 2; ++ks)
#pragma unroll
            for (int tb = 0; tb < 2; ++tb) { const unsigned bo = ro + 16u * hi + tb * (32u * DP * 2u);
                ld8(base + O_BQ + h * 32 + 16 * ks, bo, rq[ks][tb]); ld8(base + O_BK + h * 32 + 16 * ks, bo, rk[ks][tb]); }
        float cumf[2], g[2], G[2], cend, gmax;
        gates_B(base + O_BG + h, ro, dir, bi, bf, lane, cumf, g, G, cend, gmax);
        float wi[2], wl[2], emt[2];
#pragma unroll
        for (int tb = 0; tb < 2; ++tb) { const float ml = cumf[tb] + G[tb], mt = fmaxf(cumf[tb] + m0, ml); wi[tb] = __expf(cumf[tb] + m0 - mt); wl[tb] = __expf(ml - mt); emt[tb] = __expf(-mt); }
        if (hi == 0) { gA[r32] = g[0]; gA[32 + r32] = g[1]; }
        f32x16 pd0 = {}, pd1 = {}, px = {};
        float qn[2] = {0.f, 0.f};
        bf16x8 qw[2][2];
#define MM(acc, A, B) acc = __builtin_amdgcn_mfma_f32_32x32x16_bf16(A, B, acc, 0, 0, 0)
#define KSTEP(ks) do { \
            bf16x8 qs0, qs1, kt0, kt1; \
            const float* nn = (const float*)(p.ws + OFF_N0) + (chain * 36 + c) * 32 + 16 * (ks) + 8 * hi; \
            _Pragma("unroll") for (int tb = 0; tb < 2; ++tb) { \
                float q8[8], k8[8], qv[8]; \
                _Pragma("unroll") for (int j = 0; j < 8; ++j) { q8[j] = rq[ks][tb][j] * 0.17677669529663687f; k8[j] = rk[ks][tb][j]; qn[tb] += q8[j] * nn[j]; qv[j] = q8[j] * wi[tb]; } \
                qw[tb][ks] = pack8(qv); \
                if (tb == 0) { qs0 = pack8(q8); kt0 = pack8(k8); } else { qs1 = pack8(q8); kt1 = pack8(k8); } } \
            MM(pd0, kt0, qs0); MM(pd1, kt1, qs1); if (dir == 0) MM(px, kt0, qs1); else MM(px, kt1, qs0); \
            SBAR(); } while (0)
        KSTEP(0); KSTEP(1);
#undef KSTEP
        qn[0] += bperm(qn[0], lane ^ 32); qn[1] += bperm(qn[1], lane ^ 32);
        float ds[2] = {0.f, 0.f};
#pragma unroll
        for (int r = 0; r < 16; ++r) {
            const int sl = crow(r, hi); const bool keep = dir == 0 ? (sl <= r32) : (sl >= r32);
            const float g0 = gA[sl], g1 = gA[32 + sl];
            const float e00 = keep ? __expf(g0 - G[0]) * wl[0] : 0.f, e11 = keep ? __expf(g1 - G[1]) * wl[1] : 0.f;
            const float ex = dir == 0 ? __expf(g0 - G[1]) * wl[1] : __expf(g1 - G[0]) * wl[0];
            pd0[r] *= e00; pd1[r] *= e11; px[r] *= ex;
            if (dir == 0) { ds[0] += pd0[r]; ds[1] += pd1[r] + px[r]; } else { ds[0] += pd0[r] + px[r]; ds[1] += pd1[r]; }
        }
        ds[0] += bperm(ds[0], lane ^ 32); ds[1] += bperm(ds[1], lane ^ 32);
#pragma unroll
        for (int tb = 0; tb < 2; ++tb) { const float den = wi[tb] * qn[tb] + ds[tb]; const float di = __builtin_amdgcn_rcpf(fmaxf(fabsf(den), emt[tb])); if (hi == 0) dA[32 * tb + r32] = di; }
        bf16x8 a0, a1, b0, b1, c0, c1;
#define PK4(P, BASE, OUT) do { unsigned a0_ = cvt_pk_bf16(P[BASE + 0], P[BASE + 1]), a1_ = cvt_pk_bf16(P[BASE + 2], P[BASE + 3]);   \
    unsigned b0_ = cvt_pk_bf16(P[BASE + 4], P[BASE + 5]), b1_ = cvt_pk_bf16(P[BASE + 6], P[BASE + 7]);                              \
    auto r0_ = __builtin_amdgcn_permlane32_swap(a0_, b0_, false, false); auto r1_ = __builtin_amdgcn_permlane32_swap(a1_, b1_, false, false); \
    u32x4 w_ = {r0_[0], r1_[0], r0_[1], r1_[1]}; OUT = *reinterpret_cast<bf16x8*>(&w_); } while (0)
        PK4(pd0, 0, a0); PK4(pd0, 8, a1); PK4(pd1, 0, b0); PK4(pd1, 8, b1); PK4(px, 0, c0); PK4(px, 8, c1);
#undef PK4
        SBAR();
        f32x16 o[2][2] = {};
        {   bf16x8 v0, v1, v2, v3;
#define BLOCK(D0) do { frags4<D0>(vbV, v0, v1, v2, v3); \
            if (dir == 0) { MM(o[0][D0], a0, v0); MM(o[0][D0], a1, v1); MM(o[1][D0], c0, v0); MM(o[1][D0], c1, v1); MM(o[1][D0], b0, v2); MM(o[1][D0], b1, v3); } \
            else          { MM(o[0][D0], a0, v0); MM(o[0][D0], a1, v1); MM(o[0][D0], c0, v2); MM(o[0][D0], c1, v3); MM(o[1][D0], b0, v2); MM(o[1][D0], b1, v3); } \
            { const s16x4 l0 = att::tr_read<v_rd_off64(D0, 0, 0)>(vbC), h0 = att::tr_read<v_rd_off64(D0, 0, 1)>(vbC), l1 = att::tr_read<v_rd_off64(D0, 1, 0)>(vbC), h1 = att::tr_read<v_rd_off64(D0, 1, 1)>(vbC); \
              asm volatile("s_waitcnt lgkmcnt(0)" ::: "memory"); SBAR(); \
              const bf16x8 s0 = SCN_PK(l0, h0), s1 = SCN_PK(l1, h1); \
              MM(o[0][D0], qw[0][0], s0); MM(o[0][D0], qw[0][1], s1); MM(o[1][D0], qw[1][0], s0); MM(o[1][D0], qw[1][1], s1); } } while (0)
            BLOCK(0); BLOCK(1);
#undef BLOCK
        }
#undef MM
        asm volatile("s_waitcnt lgkmcnt(0)" ::: "memory");
        unsigned rob = (unsigned)(4 * hi * DP + r32) * 2u, mob = (unsigned)(4 * hi * D + r32) * 2u, hob = (unsigned)(4 * hi * 256 + r32) * 4u;
        asm volatile("" : "+v"(rob), "+v"(mob), "+v"(hob));
        float* hpk = (float*)(p.ws + OFF_HB2) + (size_t)(b * SL + 64 * tc) * 256 + h * 64;
        if (dir == 0) {
#pragma unroll
            for (int tb = 0; tb < 2; ++tb)
#pragma unroll
                for (int r = 0; r < 16; ++r) { const float di = dA[32 * tb + crow(r, hi)]; const unsigned ho = hob + (unsigned)(32 * tb + (r & 3) + 8 * (r >> 2)) * 1024u;
                    *(float*)((char*)hpk + ho) = o[tb][0][r] * di; *(float*)((char*)hpk + ho + 128u) = o[tb][1][r] * di; }
            asm volatile("s_waitcnt vmcnt(0)" ::: "memory");
        } else {
#pragma unroll
            for (int tb = 0; tb < 2; ++tb)
#pragma unroll
                for (int r = 0; r < 16; ++r) {
                    const unsigned tcst = (unsigned)(32 * tb + (r & 3) + 8 * (r >> 2)); const unsigned ho = hob + tcst * 1024u;
                    const float di = dA[32 * tb + crow(r, hi)];
                    const float x0 = o[tb][0][r] * di + ldg1(hpk, ho), x1 = o[tb][1][r] * di + ldg1(hpk, ho + 128u);
                    float t = x0 * x0 + x1 * x1; t += bperm(t, lane ^ 1); t += bperm(t, lane ^ 2); t += bperm(t, lane ^ 4); t += bperm(t, lane ^ 8); t += bperm(t, lane ^ 16);
                    const float ri = rsqrtf(t * (1.f / 64.f) + 1e-6f);
                    const bf16_t* gb = base + O_BO + h * 64; const unsigned go = rob + tcst * (DP * 2u);
                    const float g0 = ld1(gb, go), g1 = ld1(gb, go + 64u);
                    char* mb = (char*)((bf16_t*)(p.ws + OFF_MIXB) + (size_t)(b * SL + 64 * tc) * D + 256 + h * 64); const unsigned mo = mob + tcst * (D * 2u);
                    *(bf16_t*)(mb + mo) = (bf16_t)(cvt_pk_bf16(x0 * ri * p.mnorm[layer * 256 + h * 64 + r32] * fsig(g0), 0.f) & 0xffffu);
                    *(bf16_t*)(mb + mo + 64u) = (bf16_t)(cvt_pk_bf16(x1 * ri * p.mnorm[layer * 256 + h * 64 + 32 + r32] * fsig(g1), 0.f) & 0xffffu);
                    if ((r & 3) == 3) SBAR();
                }
        }
    }
}

DEV int scan_token(int dir, int step) { return dir == 0 ? step : (step < CTX ? CTX - 1 - step : SL + CTX - 1 - step); }
DEV float logsig(float g) { return fminf(g, 0.f) - log1pf(expf(-fabsf(g))); }
DEV void ph_scan_local(const Params& p, int layer, char* smem) {
    const int wid = p.wave_id;
    const int G = (int)gridDim.x, nw = G * 8, nun = (NT / 256) * (DP / 256), nleft = 4 * G < nun ? nun - 4 * G : 0, nfree = G - nleft > 0 ? G - nleft : G;
    for (int it = 0; it < 2; ++it) {
        int task;
        if (it == 0) task = (int)blockIdx.x * 8 + wid;
        else { if ((int)blockIdx.x >= nfree) break; task = nw + wid * nfree + (int)blockIdx.x; }
        if (task >= 2304) break;
        const int lane = lane_asm();
        if (task < 1152) scanA_local(p, layer, smem + wid * 16384, task / 36, task % 36, lane);
        else scanB_local(p, layer, smem + wid * 16384, (task - 1152) / 36, (task - 1152) % 36, lane);
    }
}
DEV void ph_scan_carry(const Params& p, char* smem) {
    const int tid = tid_of(p.wave_id);
    const int gt = (int)blockIdx.x * 512 + tid, nth = (int)gridDim.x * 512;
    for (int e = gt; e < 64 * 4096; e += nth) {
        const int chain = e >> 12, kv = e & 4095, k = kv >> 6;
        const float* U = (const float*)(p.ws + OFF_UA) + (size_t)chain * 36 * 4096 + kv; float* SO = (float*)(p.ws + OFF_SA) + (size_t)chain * 36 * 4096 + kv; const float* Dc = (const float*)(p.ws + OFF_DECA) + chain * 36 * 64 + k;
        float S = 0.f;
#pragma unroll 4
        for (int c = 0; c < 36; ++c) { const float u = U[(size_t)c * 4096], d = Dc[c * 64]; SO[(size_t)c * 4096] = S; S = d * S + u; }
    }
    for (int e = gt; e < 64 * 2048; e += nth) {
        const int chain = e >> 11, kv = e & 2047;
        const float* U = (const float*)(p.ws + OFF_UB) + (size_t)chain * 36 * 2048 + kv; float* SO = (float*)(p.ws + OFF_SB) + (size_t)chain * 36 * 2048 + kv; const float* M = (const float*)(p.ws + OFF_MB) + chain * 36 * 4;
        float Cc = 0.f, m = 0.f;
#pragma unroll 4
        for (int c = 0; c < 36; ++c) { const float mle = M[c * 4 + 0], ce = M[c * 4 + 1], u = U[(size_t)c * 2048]; SO[(size_t)c * 2048] = Cc;
            const float mn = fmaxf(ce + m, mle); Cc = expf(ce + m - mn) * Cc + expf(mle - mn) * u; m = mn; }
    }
    for (int e = gt; e < 64 * 32; e += nth) {
        const int chain = e >> 5, k = e & 31;
        const float* N = (const float*)(p.ws + OFF_NB) + chain * 36 * 32 + k; float* NO = (float*)(p.ws + OFF_N0) + chain * 36 * 32 + k; float* M = (float*)(p.ws + OFF_MB) + chain * 36 * 4;
        float nn = 0.f, m = 0.f;
        for (int c = 0; c < 36; ++c) { const float mle = M[c * 4 + 0], ce = M[c * 4 + 1], u = N[c * 32]; NO[c * 32] = nn; if (k == 0) M[c * 4 + 2] = m;
            const float mn = fmaxf(ce + m, mle); nn = expf(ce + m - mn) * nn + expf(mle - mn) * u; m = mn; }
    }
}
DEV void ph_scan_out(const Params& p, int layer, char* smem) {
    const int wid = p.wave_id;
    const int nw = (int)gridDim.x * 8, ntc = layer == 0 ? 36 : 32, tc0 = layer == 0 ? 0 : 4, half = 32 * ntc, total = 2 * half;
    for (int it = 0; it < 2 + (total - nw > 0 ? (total - nw) / (int)gridDim.x : 0); ++it) {
        int task;
        if (it == 0) task = (int)blockIdx.x * 8 + wid;
        else { if (wid != 0) break; task = nw + (it - 1) * (int)gridDim.x + (int)blockIdx.x; }
        if (task >= total) break;
        const int lane = lane_asm();
        const bool isB = task >= half; const int tt = isB ? task - half : task, bh = tt / ntc, tc = tc0 + tt % ntc;
        if (!isB) scanA_out(p, layer, smem + wid * 16384, bh, tc, lane);
        else scanB_out(p, layer, smem + wid * 16384, bh, tc, lane);
    }
}

DEV void ph_attn(const Params& p, int layer, char* smem) {
    const int wid = p.wave_id, js = wid & 1, qb = wid >> 1;
    const float lam = ((const float*)(p.ws + OFF_LAM))[layer], omli = 1.f - lam_init_of(layer);
    const bf16_t* KB = (const bf16_t*)(p.ws + OFF_KB); const bf16_t* VB = (const bf16_t*)(p.ws + OFF_VB);
    const bf16_t* QRB = (const bf16_t*)(p.ws + OFF_QRB); const bf16_t* Q0B = (const bf16_t*)(p.ws + OFF_Q0B);
    const int G = (int)gridDim.x, c = (int)blockIdx.x;
    const int nlat = 512, ntot = nlat + (layer == 0 ? 64 : 0);
    for (int i = 0;; ++i) {
        int bh, s0; bool isctx;
        if (G == 256) {
            const int xcd = c & 7, j = c >> 3;
            if (i < 2) { bh = xcd + 8 * (i * 2 + (j >> 4)); s0 = CTX + (j & 15) * 128; isctx = false; }
            else if (i == 2 && layer == 0 && j < 8) { bh = xcd + 8 * (j >> 1); s0 = (j & 1) * 128; isctx = true; }
            else break;
        } else {
            const int u = i * G + c; if (u >= ntot) break;
            if (u < nlat) { bh = u >> 4; s0 = CTX + (u & 15) * 128; isctx = false; } else { const int v = u - nlat; bh = v >> 1; s0 = (v & 1) * 128; isctx = true; }
        }
        const int lane = lane_asm(), tid = (wid << 6) | lane, r32 = lane & 31, hi = lane >> 5;
        const bf16_t* Kh = KB + (size_t)bh * SL * 128; const bf16_t* Vh = VB + (size_t)bh * SL * 128;
        const size_t qoff = ((size_t)bh * SL + s0 + qb * 32 + r32) * 128 + js * 64 + hi * 8;
        att::bf16x8 qr[4];
#pragma unroll
        for (int d0 = 0; d0 < 4; ++d0) qr[d0] = *(const att::bf16x8*)(Q0B + qoff + d0 * 16);
        float m_reg = -1e30f, l_reg = 0.f; att::f32x16 o[4] = {};
        att::attn_tiles(qr, Kh, Vh, CTX, smem, m_reg, l_reg, o, tid, js);
        if (!isctx) {
#pragma unroll
            for (int d0 = 0; d0 < 4; ++d0) qr[d0] = *(const att::bf16x8*)(QRB + qoff + d0 * 16);
            att::attn_tiles(qr, Kh + (size_t)CTX * 128, Vh + (size_t)CTX * 128, SEQ, smem, m_reg, l_reg, o, tid, js);
        }
        float* wsw = (float*)(smem + 2 * att::SHM_V + 2 * att::SHM_K) + wid * 64;
        __syncthreads();
        if (hi == 0) wsw[r32] = l_reg;
        asm volatile("s_waitcnt lgkmcnt(0)" ::: "memory");
        float rli[16];
#pragma unroll
        for (int r = 0; r < 16; ++r) rli[r] = __builtin_amdgcn_rcpf(wsw[att::crow(r, hi)]);
        float* X = (float*)smem + qb * 4096;
        if (js == 1) {
#pragma unroll
            for (int d0 = 0; d0 < 4; ++d0)
#pragma unroll
                for (int r = 0; r < 16; ++r) X[(d0 * 16 + r) * 64 + lane] = o[d0][r] * rli[r];
        }
        __syncthreads();
        if (js == 0) {
            const int b = bh >> 2, h = bh & 3;
            float ss[16];
#pragma unroll
            for (int r = 0; r < 16; ++r) ss[r] = 0.f;
#pragma unroll
            for (int d0 = 0; d0 < 4; ++d0)
#pragma unroll
                for (int r = 0; r < 16; ++r) { const float v = o[d0][r] * rli[r] - lam * X[(d0 * 16 + r) * 64 + lane]; o[d0][r] = v; ss[r] += v * v; }
#pragma unroll
            for (int r = 0; r < 16; ++r) { float t = ss[r]; t += __shfl_xor(t, 1); t += __shfl_xor(t, 2); t += __shfl_xor(t, 4); t += __shfl_xor(t, 8); t += __shfl_xor(t, 16);
                ss[r] = rsqrtf(t * (1.f / 128.f) + 1e-6f) * omli; }
            bf16_t* Tq = (bf16_t*)X;
#pragma unroll
            for (int d0 = 0; d0 < 4; ++d0) { const float g = p.dnorm[layer * 128 + d0 * 32 + r32];
#pragma unroll
                for (int r = 0; r < 16; ++r) Tq[att::crow(r, hi) * 128 + d0 * 32 + r32] = (bf16_t)(cvt_pk_bf16(o[d0][r] * ss[r] * g, 0.f) & 0xffffu); }
            char* mixb = (char*)((bf16_t*)(p.ws + OFF_MIXB) + (size_t)(b * SL + s0 + qb * 32) * D + 512 + h * 128);
#pragma unroll
            for (int k = 0; k < 8; ++k) { const int idx = lane + 64 * k, row = idx >> 4, ch = idx & 15;
                *(pg8::u32x4*)(mixb + (size_t)row * (D * 2) + ch * 16) = *(const pg8::u32x4*)((const char*)Tq + row * 256 + ch * 16); }
        }
        __syncthreads();
    }
}

struct EpiRowsBf16 {
    static constexpr bool PERM = true;
    bf16_t* O; int ldc;
    DEV void operator()(const pg8::f32x4 (&acc)[2][2][4][2], const pg8::Unit& u, int wr, int wc, int fr, int fq) const {
        const int row0 = u.pm * 256 + wr * 64 + fr, col0 = u.pn * 256 + wc * 32 + 8 * fq;
#pragma unroll
        for (int ai = 0; ai < 2; ++ai)
#pragma unroll
            for (int m = 0; m < 4; ++m) { bf16_t* rowp = O + (size_t)(row0 + ai * 128 + m * 16) * ldc + col0;
#pragma unroll
                for (int bj = 0; bj < 2; ++bj) { const pg8::f32x4 v0 = acc[ai][bj][m][0], v1 = acc[ai][bj][m][1];
                    pg8::u32x4 w; w.x = cvt_pk_bf16(v0[0], v0[1]); w.y = cvt_pk_bf16(v0[2], v0[3]); w.z = cvt_pk_bf16(v1[0], v1[1]); w.w = cvt_pk_bf16(v1[2], v1[3]);
                    *(pg8::u32x4*)(rowp + bj * 128) = w; } }
    }
};
DEV void ph_outproj(const Params& p, int layer, char* smem) {
    const int tidx = tid_of(p.wave_id);
    pg8::StaticOrder S; S.init(layer == 0 ? NT / 256 : NB * 8, D / 256, (int)gridDim.x, (int)blockIdx.x, layer == 0 ? 0 : 1, (const bf16_t*)(p.ws + OFF_WOUT) + (size_t)layer * D * D, D);
    EpiRowsBf16 E{(bf16_t*)(p.ws + OFF_MIXO), D};
    pg8::gemm_phase((LAS unsigned char*)smem, (const char*)(p.ws + OFF_MIXB), D, S, E, tid_of(p.wave_id));
}
DEV void ph_norm2(const Params& p, int layer, char* smem) {
    typedef float f32x16 __attribute__((ext_vector_type(16)));
    const int wid = p.wave_id, lane = lane_asm(), tidx = (wid << 6) | lane;
    constexpr int XP = 1028, RP = 24;
    float* xs = (float*)smem;
    float* red = (float*)smem;
    int* hist = (int*)(smem + 32 * XP * 4);
    const float* nr = p.norms + (size_t)layer * 4 * D;
    if (tidx < NE) hist[tidx] = 0;
    const int chunk = (NT + (int)gridDim.x - 1) / (int)gridDim.x, rbeg = (int)blockIdx.x * chunk, rend = min(NT, rbeg + chunk);
    float wreg[64];
    { const float* wb = p.rw + (size_t)layer * D * NE + (size_t)(wid * 128 + (lane >> 5)) * NE + (lane & 31);
#pragma unroll
      for (int ks = 0; ks < 64; ++ks) wreg[ks] = wb[(size_t)2 * ks * NE]; }
    for (int r0 = rbeg; r0 < rend; r0 += RP) {
        __syncthreads();
#pragma unroll 1
        for (int j = 0; j < 3; ++j) {
            const int lr = wid * 3 + j, r = r0 + lr;
            if (r >= rend) continue;
            const int b = r / SL, s = r % SL;
            if (layer != 0 && s < CTX) continue;
            const float* m = modrow(p, layer, b, s);
            float4 mo[4], xv[4], o[4]; row_load_bf((const bf16_t*)(p.ws + OFF_MIXO) + (size_t)r * D, mo, lane); row_load_bf((const bf16_t*)(p.ws + OFF_X) + (size_t)r * D, xv, lane);
            const float ri = row_rinv(mo);
#pragma unroll
            for (int i = 0; i < 4; ++i) { const int idx = i * 256 + lane * 4; const float4 g = *(const float4*)(nr + D + idx), gt = *(const float4*)(m + 2048 + idx);
                xv[i].x += gt.x * (mo[i].x * ri * g.x); xv[i].y += gt.y * (mo[i].y * ri * g.y); xv[i].z += gt.z * (mo[i].z * ri * g.z); xv[i].w += gt.w * (mo[i].w * ri * g.w); }
            row_store_bf16((bf16_t*)(p.ws + OFF_XN) + (size_t)r * D, xv, lane);
            row_modnorm(xv, nr + 2 * D, m + 3072, m + 4096, o, lane);
            row_store_fp8((unsigned char*)(p.ws + OFF_XNB) + (size_t)r * D, o, lane, F8_SX);
            row_store(xs + lr * XP, o, lane);
        }
        __syncthreads();
        f32x16 acc = {};
        { const float* xa = xs + (lane & 31) * XP + wid * 128 + (lane >> 5);
#pragma unroll
          for (int ks = 0; ks < 64; ++ks) acc = __builtin_amdgcn_mfma_f32_32x32x2f32(xa[2 * ks], wreg[ks], acc, 0, 0, 0); }
        __syncthreads();
#pragma unroll
        for (int rg = 0; rg < 16; ++rg) red[(wid * 32 + (rg & 3) + 8 * (rg >> 2) + 4 * (lane >> 5)) * 32 + (lane & 31)] = acc[rg];
        __syncthreads();
#pragma unroll 1
        for (int j = 0; j < 3; ++j) {
            const int lr = wid * 3 + j, r = r0 + lr;
            if (r >= rend) continue;
            const int s = r % SL;
            if (layer != 0 && s < CTX) continue;
            const int e = lane & 31;
            float logit = p.rb[layer * NE + e];
#pragma unroll
            for (int w = 0; w < 8; ++w) logit += red[(w * 32 + lr) * 32 + e];
            float tv[4]; int ti[4];
#pragma unroll
            for (int k = 0; k < 4; ++k) {
                float bv = logit; int bi = e;
                for (int o2 = 16; o2 >= 1; o2 >>= 1) { const float ov = __shfl_xor(bv, o2); const int oi = __shfl_xor(bi, o2); if (ov > bv || (ov == bv && oi < bi)) { bv = ov; bi = oi; } }
                tv[k] = bv; ti[k] = bi; if (e == bi) logit = -3.0e38f;
            }
            const float e0 = 1.f, e1 = expf(tv[1] - tv[0]), e2 = expf(tv[2] - tv[0]), e3 = expf(tv[3] - tv[0]), inv = 1.f / (e0 + e1 + e2 + e3);
            if (lane == 0) { *(float4*)(((float*)(p.ws + OFF_TOPW)) + (size_t)r * 4) = make_float4(e0 * inv, e1 * inv, e2 * inv, e3 * inv); *(int4*)(((int*)(p.ws + OFF_TOPI)) + (size_t)r * 4) = make_int4(ti[0], ti[1], ti[2], ti[3]); }
            if (lane < 4) atomicAdd(&hist[lane == 0 ? ti[0] : lane == 1 ? ti[1] : lane == 2 ? ti[2] : ti[3]], 1);
        }
    }
    __syncthreads();
    if (tidx < NE) ((int*)(p.ws + OFF_BC))[(size_t)blockIdx.x * NE + tidx] = hist[tidx];
}
DEV void ph_route(const Params& p, int layer, char* smem) {
    const int tidx = tid_of(p.wave_id);
    int* part = (int*)smem;
    int* off = part + 1024;
    const int G = (int)gridDim.x, bid = (int)blockIdx.x;
    const int* BC = (const int*)(p.ws + OFF_BC);
    { const int e = tidx & 31, sl = tidx >> 5; int before = 0, tot = 0;
      for (int bb = sl; bb < G; bb += 16) { const int c = BC[(size_t)bb * NE + e]; tot += c; if (bb < bid) before += c; }
      part[(sl * 2 + 0) * 32 + e] = before; part[(sl * 2 + 1) * 32 + e] = tot; }
    __syncthreads();
    if (tidx < NE) { int before = 0, tot = 0; for (int sl = 0; sl < 16; ++sl) { before += part[(sl * 2 + 0) * 32 + tidx]; tot += part[(sl * 2 + 1) * 32 + tidx]; }
        off[tidx] = before; if (bid == 0) ((int*)(p.ws + OFF_CNT))[tidx] = tot; }
    __syncthreads();
    if (tidx < 64) {
        const int lane = tidx;
        const int chunk = (NT + G - 1) / G, rbeg = bid * chunk, rend = min(NT, rbeg + chunk);
        for (int q0 = rbeg * 4; q0 < rend * 4; q0 += 64) {
            const int pair = q0 + lane, r = pair >> 2, s = r % SL;
            const bool act = pair < rend * 4 && (layer == 0 || s >= CTX);
            const int my = act ? ((const int*)(p.ws + OFF_TOPI))[pair] : -1;
            for (int e = 0; e < NE; ++e) {
                const unsigned long long bal = __ballot(my == e);
                if (bal) { const int base = off[e];
                    if (my == e) ((int*)(p.ws + OFF_LIST))[(size_t)e * LISTCAP + base + __popcll(bal & ((1ull << lane) - 1ull))] = pair;
                    __builtin_amdgcn_wave_barrier();
                    if (lane == 0) off[e] = base + __popcll(bal);
                    __builtin_amdgcn_wave_barrier(); }
            }
        }
    }
}
DEV int moe_rt(int i, int G, int c, int npn, int& pn) {
    if (G == 256) { const int xcd = c & 7, j = c >> 3, rpx = 32 / npn; pn = j % npn; return (i * 8 + xcd) * rpx + j / npn; }
    const int L = i * G + c; pn = L % npn; return L / npn;
}
constexpr int MOE_LDS = 131072, MOE_MAXU = 12;
DEV void moe_prepare(const Params& p, char* smem, int npn, int mode) {
    const int tidx = tid_of(p.wave_id);
    LAS int* base = (LAS int*)(smem + MOE_LDS);
    LAS int *TE = base, *TT = base + 320, *NRT = base + 640, *CN = base + 656  , *UI = base + 704, *IDX = base + 768;
    if (tidx < NE) CN[tidx] = ((const int*)(p.ws + OFF_CNT))[tidx];
    __syncthreads();
    if (tidx < 320) { int e = 0, acc = 0; for (; e < NE; ++e) { const int n = (CN[e] + 255) >> 8; if (tidx < acc + n) break; acc += n; } TE[tidx] = e; TT[tidx] = tidx - acc; }
    if (tidx == 0) { int tot = 0; for (int e = 0; e < NE; ++e) tot += (CN[e] + 255) >> 8; NRT[0] = tot; }
    __syncthreads();
    const int nrt = NRT[0];
#pragma unroll
    for (int k = 0; k < (MOE_MAXU * 256) / 512; ++k) {
        const int idx = tidx + 512 * k, i = idx >> 8, row = idx & 255;
        int pn; const int rt = moe_rt(i, (int)gridDim.x, (int)blockIdx.x, npn, pn);
        if (rt < nrt) { const int e = TE[rt], t = TT[rt], c = CN[e], q = t * 256 + row;
            const int pair = ((const int*)(p.ws + OFF_LIST))[(size_t)e * LISTCAP + min(q, c - 1)];
            IDX[idx] = mode == 1 ? (pair >> 2) : (q < c ? pair : -1); }
    }
    if (tidx < MOE_MAXU) { int pn; const int rt = moe_rt(tidx, (int)gridDim.x, (int)blockIdx.x, npn, pn);
        if (rt < nrt) { const int e = TE[rt], t = TT[rt], c = CN[e]; int pre = 0; for (int z = 0; z < e; ++z) pre += CN[z]; UI[tidx * 4 + 0] = min(256, c - t * 256); UI[tidx * 4 + 1] = pre + t * 256; } }
    __syncthreads();
}
struct MoeOrder {
    const LAS int *te, *ui, *idx; int nrt, npn, G, c, gather; const char* Bt; size_t bstride; int K;
    DEV bool next(int i, pg8::Unit& u) const { int pn; const int rt = moe_rt(i, G, c, npn, pn); if (rt >= nrt || i >= MOE_MAXU) return false;
        u.pm = rt; u.pn = pn; u.e = __builtin_amdgcn_readfirstlane(te[rt]); u.t = i; return true; }
    DEV int arow(const pg8::Unit& u, int rr) const { return gather ? idx[u.t * 256 + rr] : ui[u.t * 4 + 1] + rr; }
    DEV const char* bbase(const pg8::Unit& u) const { return Bt + (size_t)u.e * bstride + (size_t)u.pn * pg8::BM * K * 2; }
};
DEV float swiglu(float g, float l) { g = fminf(g, 7.f); l = fminf(fmaxf(l, -7.f), 7.f); return g * __builtin_amdgcn_rcpf(1.f + __builtin_amdgcn_exp2f(-1.702f * 1.4426950408889634f * g)) * (l + 1.f); }
struct EpiSwiglu {
    static constexpr bool PERM = true;
    unsigned char* H; const float* b1; const LAS int* ui;
    DEV void operator()(const pg8::f32x4 (&acc)[2][2][4][2], const pg8::Unit& u, int wr, int wc, int fr, int fq) const {
        const int ucnt = ui[u.t * 4 + 0], hrow0 = ui[u.t * 4 + 1], col0 = u.pn * 256 + wc * 32 + 8 * fq;
        const float* bb = b1 + (size_t)u.e * 2048 + col0;
        pg8::f32x4 bv[2][2];
#pragma unroll
        for (int bj = 0; bj < 2; ++bj)
#pragma unroll
            for (int n = 0; n < 2; ++n) bv[bj][n] = *(const pg8::f32x4*)(bb + bj * 128 + 4 * n);
        __builtin_amdgcn_s_waitcnt(0x0F70);
#pragma unroll
        for (int ai = 0; ai < 2; ++ai)
#pragma unroll
            for (int m = 0; m < 4; ++m) { const int rr = ai * 128 + wr * 64 + m * 16 + fr;
                if (rr < ucnt) { unsigned char* rowp = H + (size_t)(hrow0 + rr) * DFF + (col0 >> 1);
#pragma unroll
                    for (int bj = 0; bj < 2; ++bj) { constexpr float DS = 1.f / (F8_SX * F8_SW); const pg8::f32x4 v0 = acc[ai][bj][m][0] * DS + bv[bj][0], v1 = acc[ai][bj][m][1] * DS + bv[bj][1];
                        *(unsigned*)(rowp + bj * 64) = pk4_fp8(F8_SH * swiglu(v0[0], v0[1]), F8_SH * swiglu(v0[2], v0[3]), F8_SH * swiglu(v1[0], v1[1]), F8_SH * swiglu(v1[2], v1[3])); } } }
    }
};
struct EpiY {
    static constexpr bool PERM = true;
    bf16_t* Y; const LAS int* idx;
    DEV void operator()(const pg8::f32x4 (&acc)[2][2][4][2], const pg8::Unit& u, int wr, int wc, int fr, int fq) const {
        const int col0 = u.pn * 256 + wc * 32 + 8 * fq;
#pragma unroll
        for (int ai = 0; ai < 2; ++ai)
#pragma unroll
            for (int m = 0; m < 4; ++m) { const int rr = ai * 128 + wr * 64 + m * 16 + fr; const int pair = idx[u.t * 256 + rr];
                if (pair >= 0) { bf16_t* rowp = Y + (size_t)pair * D + col0;
#pragma unroll
                    for (int bj = 0; bj < 2; ++bj) { constexpr float DS = 1.f / (F8_SH * F8_SW); const pg8::f32x4 v0 = acc[ai][bj][m][0] * DS, v1 = acc[ai][bj][m][1] * DS;
                        pg8::u32x4 w; w.x = cvt_pk_bf16(v0[0], v0[1]); w.y = cvt_pk_bf16(v0[2], v0[3]); w.z = cvt_pk_bf16(v1[0], v1[1]); w.w = cvt_pk_bf16(v1[2], v1[3]);
                        *(pg8::u32x4*)(rowp + bj * 128) = w; } } }
    }
};
DEV void ph_moe1(const Params& p, int layer, char* smem) {
    moe_prepare(p, smem, 8, 1);
    LAS int* base = (LAS int*)(smem + MOE_LDS);
    MoeOrder S{base, base + 704, base + 768, base[640], 8, (int)gridDim.x, (int)blockIdx.x, 1, (const char*)(p.ws + OFF_W1T) + (size_t)layer * NE * 2048 * D, (size_t)2048 * D, D / 2};
    EpiSwiglu E{(unsigned char*)(p.ws + OFF_H), p.b1 + (size_t)layer * NE * 2048, base + 704};
    pg8::gemm_phase<EpiSwiglu, MoeOrder, true>((LAS unsigned char*)smem, (const char*)(p.ws + OFF_XNB), D / 2, S, E, tid_of(p.wave_id));
}
DEV void ph_moe2(const Params& p, int layer, char* smem) {
    moe_prepare(p, smem, 4, 2);
    LAS int* base = (LAS int*)(smem + MOE_LDS);
    MoeOrder S{base, base + 704, base + 768, base[640], 4, (int)gridDim.x, (int)blockIdx.x, 0, (const char*)(p.ws + OFF_W2T) + (size_t)layer * NE * D * DFF, (size_t)D * DFF, DFF / 2};
    EpiY E{(bf16_t*)(p.ws + OFF_Y), base + 768};
    pg8::gemm_phase<EpiY, MoeOrder, true>((LAS unsigned char*)smem, (const char*)(p.ws + OFF_H), DFF / 2, S, E, tid_of(p.wave_id));
}
DEV void ph_combine(const Params& p, int layer, char* smem) {
    const int wid = p.wave_id, lane = lane_asm();
    const float* nr = p.norms + (size_t)layer * 4 * D;
    const int total = layer == 0 ? NT : NB * SEQ, stride = (int)gridDim.x * 8;
    for (int q0 = (int)blockIdx.x * 8 + wid; q0 < total; q0 += 2 * stride) {
        int rr[2]; bool ok[2]; float4 tw[2]; int4 ti[2];
#pragma unroll
        for (int u = 0; u < 2; ++u) { const int q = q0 + u * stride; ok[u] = q < total; const int qq = ok[u] ? q : q0;
            rr[u] = layer == 0 ? qq : (qq / SEQ) * SL + CTX + qq % SEQ;
            tw[u] = *(const float4*)(((float*)(p.ws + OFF_TOPW)) + (size_t)rr[u] * 4); ti[u] = *(const int4*)(((int*)(p.ws + OFF_TOPI)) + (size_t)rr[u] * 4); }
        float4 f[2][4], xv[2][4];
#pragma unroll
        for (int u = 0; u < 2; ++u) {
            const int r = rr[u];
            const float w[4] = {tw[u].x, tw[u].y, tw[u].z, tw[u].w}; const int ei[4] = {ti[u].x, ti[u].y, ti[u].z, ti[u].w};
#pragma unroll
            for (int i = 0; i < 4; ++i) f[u][i] = make_float4(0.f, 0.f, 0.f, 0.f);
#pragma unroll
            for (int k = 0; k < 4; ++k) {
                const bf16_t* y = (const bf16_t*)(p.ws + OFF_Y) + ((size_t)r * 4 + k) * D; const float* bb = p.b2 + ((size_t)layer * NE + ei[k]) * D;
#pragma unroll
                for (int i = 0; i < 4; ++i) { const int idx = i * 256 + lane * 4; const pg8::u32x2 yb = *(const pg8::u32x2*)(y + idx); const float4 bv = *(const float4*)(bb + idx);
                    const float y0 = __uint_as_float(yb.x << 16), y1 = __uint_as_float(yb.x & 0xffff0000u), y2 = __uint_as_float(yb.y << 16), y3 = __uint_as_float(yb.y & 0xffff0000u);
                    f[u][i].x += w[k] * (y0 + bv.x); f[u][i].y += w[k] * (y1 + bv.y); f[u][i].z += w[k] * (y2 + bv.z); f[u][i].w += w[k] * (y3 + bv.w); }
            }
            row_load_bf((const bf16_t*)(p.ws + OFF_XN) + (size_t)r * D, xv[u], lane);
        }
#pragma unroll
        for (int u = 0; u < 2; ++u) {
            const int r = rr[u], b = r / SL, s = r % SL;
            const float* m = modrow(p, layer, b, s);
            const float ri = row_rinv(f[u]);
#pragma unroll
            for (int i = 0; i < 4; ++i) { const int idx = i * 256 + lane * 4; const float4 g = *(const float4*)(nr + 3 * D + idx), gt = *(const float4*)(m + 5120 + idx);
                xv[u][i].x += gt.x * (f[u][i].x * ri * g.x); xv[u][i].y += gt.y * (f[u][i].y * ri * g.y); xv[u][i].z += gt.z * (f[u][i].z * ri * g.z); xv[u][i].w += gt.w * (f[u][i].w * ri * g.w); }
            if (ok[u]) {
                if (layer == 0) {
                    row_store_bf16((bf16_t*)(p.ws + OFF_X) + (size_t)r * D, xv[u], lane);
                    const float* m1 = modrow(p, 1, b, s); float4 o[4];
                    row_modnorm(xv[u], p.norms + (size_t)4 * D, m1 + 0, m1 + 1024, o, lane);
                    row_store_bf16((bf16_t*)(p.ws + OFF_XNB) + (size_t)r * D, o, lane);
                } else {
                    row_store(p.out + ((size_t)b * SEQ + (s - CTX)) * D, xv[u], lane);
                }
            }
        }
    }
}

template <int layer> DEV void run_layer(const Params& p, char* smem, const XcdBarrier& bar) {
#define GB() xcd_barrier(bar)

        ph_inproj(p, layer, smem, 0); GB();
        ph_inproj(p, layer, smem, 1); ph_scan_local(p, layer, smem); GB();
        ph_scan_carry(p, smem); ph_attn(p, layer, smem); GB();
        ph_scan_out(p, layer, smem); GB();
        ph_outproj(p, layer, smem); GB();
        ph_norm2(p, layer, smem); GB();
        ph_route(p, layer, smem); GB();
        ph_moe1(p, layer, smem); GB();
        ph_moe2(p, layer, smem); GB();
        ph_combine(p, layer, smem); GB();
    #undef GB
}
constexpr int LDS_BYTES = 147456;
__global__ __launch_bounds__(512, 2) void k_mega(Params p_in) {
    Params p = p_in; p.wave_id = __builtin_amdgcn_readfirstlane((int)(threadIdx.x >> 6));
    extern __shared__ __attribute__((aligned(16))) char smem[];
    volatile LAS unsigned* st = (volatile LAS unsigned*)(smem + LDS_BYTES - 16);
    if (threadIdx.x == 0) { st[0] = 0u; st[1] = 0u; st[2] = 0u; st[3] = 0u; }
    __syncthreads();
    const XcdBarrier bar = xcd_barrier_post(((unsigned*)(p.ws + OFF_bar)), st, p.wave_id);
#define GB() xcd_barrier(bar)
    ph_mods(p, smem); ph_convert(p, smem); GB();
    ph_init(p, smem); GB();
    run_layer<0>(p, smem, bar);
    run_layer<1>(p, smem, bar);
#undef GB
}
}

extern "C" void kernel_launch(void* const* d_in, const int* in_sizes, int n_in, void* d_out, int out_size, void* d_ws, size_t ws_size, hipStream_t stream) {
    static int grid = 0;
    if (grid == 0) {
        int dev = 0, cus = 0, per_cu = 0;
        if (hipGetDevice(&dev) != hipSuccess || hipDeviceGetAttribute(&cus, hipDeviceAttributeMultiprocessorCount, dev) != hipSuccess) { grid = -1; return; }
        if (hipFuncSetAttribute((const void*)k_mega, hipFuncAttributeMaxDynamicSharedMemorySize, LDS_BYTES) != hipSuccess) { grid = -1; return; }
        (void)hipOccupancyMaxActiveBlocksPerMultiprocessor(&per_cu, (const void*)k_mega, 512, LDS_BYTES);
        (void)hipGetLastError();
        grid = cus;
    }
    if (grid < 0) return;
    Params p{};
    const float** in = (const float**)&p;
    for (int i = 0; i < 21; ++i) in[i] = (const float*)d_in[i];
    p.out = (float*)d_out;
    p.ws = (char*)d_ws;
    if (WS_END > ws_size) return;
    if (hipMemsetAsync(p.ws + OFF_bar, 0, (size_t)CTL_BYTES, stream) != hipSuccess) return;
    hipLaunchKernelGGL(k_mega, dim3(grid), dim3(512), LDS_BYTES, stream, p);
}
```

```cpp
#include <hip/hip_runtime.h>
#include <stdint.h>

namespace {
constexpr int D = 1024, NB = 8, SEQ = 2048, CTX = 256, SL = 2304, NT = NB * SL;
constexpr int DP = 3840, DPW = 3600, NE = 32, DFF = 1024, NPAIR = NT * 4;
constexpr int O_AQ = 0, O_AI = 256, O_AFF = 512, O_AFB = 768, O_AG = 1024, O_BQ = 1280, O_BK = 1408, O_BV = 1536, O_BO = 1792, O_BG = 3584;
constexpr int LISTCAP = NT;

struct Params {
    const float *x, *c, *ctx, *c_ctx, *ada_w, *ada_b, *norms, *w_in, *w_out, *hlb, *hnorm, *mgb, *mnorm, *dlam, *dnorm, *rw, *rb, *w1, *b1, *w2, *b2;
    float* out;
    char* ws;
    int wave_id, pad_;
};
constexpr size_t al256(size_t x) { return (x + 255) & ~(size_t)255; }
constexpr size_t OFF_bar = 0;
constexpr size_t OFF_MOD = OFF_bar + 16384;
constexpr int CW_QHEAD = 3520, CW_CNT = 3584  , CTL_BYTES = 16384;
constexpr size_t OFF_LB = OFF_MOD + al256((size_t)2 * 9 * 6144 * 4);
constexpr size_t OFF_LAM = OFF_LB + al256(1024 * 4);
constexpr size_t OFF_CNT = OFF_LAM + 256;
constexpr size_t OFF_BC = OFF_CNT + 256;
constexpr size_t OFF_TOPW = OFF_BC + al256((size_t)1024 * NE * 4);
constexpr size_t OFF_TOPI = OFF_TOPW + al256((size_t)NPAIR * 4);
constexpr size_t OFF_LIST = OFF_TOPI + al256((size_t)NPAIR * 4);
constexpr size_t OFF_X = OFF_LIST + al256((size_t)NE * LISTCAP * 4);
constexpr size_t OFF_XN = OFF_X + al256((size_t)NT * D * 4);
constexpr size_t OFF_P = OFF_XN + al256((size_t)NT * D * 4);
constexpr size_t OFF_QR = OFF_P + al256((size_t)NT * DP * 4);
constexpr size_t OFF_KT = OFF_QR + al256((size_t)64 * SL * 64 * 4);
constexpr size_t OFF_OC = OFF_KT + al256((size_t)64 * SL * 64 * 4);
constexpr size_t OFF_MIX = OFF_OC + al256((size_t)32 * SL * 128 * 4);
constexpr size_t OFF_MIXO = OFF_MIX + al256((size_t)NT * D * 4);
constexpr size_t OFF_XNB = OFF_MIXO + al256((size_t)NT * D * 4);
constexpr size_t OFF_MIXB = OFF_XNB + al256((size_t)NT * D * 2);
constexpr size_t OFF_WIN = OFF_MIXB + al256((size_t)NT * D * 2);
constexpr size_t OFF_WOUT = OFF_WIN + al256((size_t)2 * DP * D * 2);
constexpr size_t OFF_W1T = OFF_WOUT + al256((size_t)2 * D * D * 2);
constexpr size_t OFF_W2T = OFF_W1T + al256((size_t)2 * NE * 2048 * D * 2);
constexpr size_t OFF_U = OFF_W2T + al256((size_t)2 * NE * D * DFF * 2);
constexpr size_t WS_END = OFF_U + al256((size_t)32 * SL * SL * 4);
constexpr size_t OFF_UA = OFF_U, OFF_DECA = OFF_UA + (size_t)64 * 36 * 4096 * 4, OFF_UB = OFF_DECA + (size_t)64 * 36 * 64 * 4, OFF_NB = OFF_UB + (size_t)64 * 36 * 2048 * 4,
                 OFF_MB = OFF_NB + (size_t)64 * 36 * 32 * 4, OFF_SCB = OFF_MB + (size_t)64 * 36 * 4 * 4,
                 OFF_OA2 = OFF_SCB + (size_t)2 * NT * 16 * 4, OFF_HB2 = OFF_OA2 + (size_t)NT * 256 * 4, OFF_SA = OFF_HB2 + (size_t)NT * 256 * 4, OFF_SB = OFF_SA + (size_t)64 * 36 * 4096 * 4,
                 OFF_N0 = OFF_SB + (size_t)64 * 36 * 2048 * 4;
constexpr size_t OFF_PB = OFF_P;
constexpr size_t OFF_ROPE = OFF_P + al256((size_t)NT * DP * 2);
constexpr size_t OFF_QRB = OFF_QR, OFF_Q0B = OFF_QR + (size_t)32 * SL * 128 * 2, OFF_KB = OFF_KT, OFF_VB = OFF_KT + (size_t)32 * SL * 128 * 2;
constexpr size_t OFF_S = OFF_U, OFF_H = OFF_U, OFF_Y = OFF_U + al256((size_t)(NPAIR + 256) * DFF * 2);
constexpr size_t OFF_OA = OFF_MIXO, OFF_HB = OFF_MIXO + (size_t)2 * NT * 256 * 4;


#define DEV __device__ __forceinline__
DEV int lane_asm() { int l; asm volatile("v_mbcnt_lo_u32_b32 %0, -1, 0\n\tv_mbcnt_hi_u32_b32 %0, -1, %0" : "=v"(l)); return l; }
DEV int tid_of(int wave_id) { return (wave_id << 6) | lane_asm(); }
DEV float wsum(float v) { for (int o = 32; o >= 1; o >>= 1) v += __shfl_xor(v, o); return v; }
DEV float wmaxf(float v) { for (int o = 32; o >= 1; o >>= 1) v = fmaxf(v, __shfl_xor(v, o)); return v; }
DEV float sigm(float x) { return 1.f / (1.f + expf(-x)); }
DEV float rdlane(float v, int l) { return __int_as_float(__builtin_amdgcn_readlane(__float_as_int(v), l)); }
DEV float lam_init_of(int layer) { return 0.8f - 0.6f * expf(-0.3f * (float)layer); }


#define XB_TMO      128
#define XB_XCNT(j)  (256  + 64 * (j))
#define XB_XSUB(j)  (1280 + 64 * (j))
#define XB_XGEN(j)  (2304 + 64 * (j))
#define XB_TOP      3328
#define XB_TOPGEN   3392
#define XCD_BAR_WORDS 3456
#define XB_SPIN_CAP (1u << 22)
#define LAS __attribute__((address_space(3)))
DEV unsigned xb_ld(unsigned* p)              { return __hip_atomic_load(p, __ATOMIC_RELAXED, __HIP_MEMORY_SCOPE_AGENT); }
DEV unsigned xb_add(unsigned* p, unsigned v) { return __hip_atomic_fetch_add(p, v, __ATOMIC_RELAXED, __HIP_MEMORY_SCOPE_AGENT); }
DEV unsigned xb_xcc_id() { return (unsigned)__builtin_amdgcn_s_getreg((3 << 11) | 20) & 0xFu; }
#define XB_SPIN(cond, bar) do { unsigned _sp = 0; while (cond) { __builtin_amdgcn_s_sleep(1); \
    if ((++_sp & 255u) == 0u) { if (xb_ld(&(bar)[XB_TMO])) break; if (_sp > XB_SPIN_CAP) { atomicAdd(&(bar)[XB_TMO], 1u); break; } } } } while (0)
struct XcdBarrier { unsigned* bar; unsigned x; volatile LAS unsigned* st; int wave; };
DEV bool xb_thread0(int wave) { return wave == 0 && lane_asm() == 0; }
DEV XcdBarrier xcd_barrier_post(unsigned* bar, volatile LAS unsigned* st, int wave) {
    XcdBarrier b; b.bar = bar; b.x = xb_xcc_id(); b.st = st; b.wave = wave;
    if (xb_thread0(wave)) (void)xb_add(&bar[XB_XCNT(b.x)], 1u);
    return b;
}
DEV void xcd_barrier_complete(unsigned* bar, unsigned x, unsigned& nloc, unsigned& nx) {
    const unsigned G = gridDim.x * gridDim.y * gridDim.z;
    unsigned sum, cnt, mine, sp = 0u;
    for (;;) {
        sum = 0u; cnt = 0u; mine = 0u;
#pragma unroll
        for (unsigned j = 0; j < 16; ++j) { const unsigned c = xb_ld(&bar[XB_XCNT(j)]); sum += c; cnt += (c > 0u) ? 1u : 0u; mine = (j == x) ? c : mine; }
        if (sum == G) break;
        __builtin_amdgcn_s_sleep(1);
        if ((++sp & 255u) == 0u) { if (xb_ld(&bar[XB_TMO])) break; if (sp > XB_SPIN_CAP) { atomicAdd(&bar[XB_TMO], 1u); break; } }
    }
    nloc = mine > 0u ? mine : 1u; nx = cnt > 0u ? cnt : 1u;
}
DEV void xcd_barrier(const XcdBarrier& b) {
    asm volatile("s_waitcnt vmcnt(0)" ::: "memory");
    __syncthreads();
    if (xb_thread0(b.wave)) {
        unsigned* bar = b.bar;
        __builtin_amdgcn_s_waitcnt(0);
        unsigned nloc = b.st[0], nx = b.st[1];
        if (nloc == 0u) { xcd_barrier_complete(bar, b.x, nloc, nx); b.st[0] = nloc; b.st[1] = nx; }
        const unsigned old = xb_add(&bar[XB_XSUB(b.x)], 1u);
        const unsigned gen = old / nloc;
        if (old + 1u == (gen + 1u) * nloc) {
            __builtin_amdgcn_fence(__ATOMIC_RELEASE, "agent");
            asm volatile("s_waitcnt vmcnt(0)" ::: "memory");
            const unsigned og = xb_add(&bar[XB_TOP], 1u);
            const unsigned tg = og / nx;
            if (og + 1u == (tg + 1u) * nx) xb_add(&bar[XB_TOPGEN], 1u);
            else XB_SPIN(xb_ld(&bar[XB_TOPGEN]) == tg, bar);
            __builtin_amdgcn_fence(__ATOMIC_ACQUIRE, "agent");
            xb_add(&bar[XB_XGEN(b.x)], 1u);
            asm volatile("s_waitcnt vmcnt(0)" ::: "memory");
        } else {
            XB_SPIN(xb_ld(&bar[XB_XGEN(b.x)]) == gen, bar);
            __builtin_amdgcn_fence(__ATOMIC_ACQUIRE, "agent");
            asm volatile("s_waitcnt vmcnt(0)" ::: "memory");
        }
    }
    __syncthreads();
}

typedef unsigned short bf16_t;
DEV unsigned cvt_pk_bf16(float lo, float hi) { unsigned r; asm volatile("v_cvt_pk_bf16_f32 %0, %1, %2" : "=v"(r) : "v"(lo), "v"(hi)); return r; }

namespace pg8 {
typedef short bf16x8 __attribute__((ext_vector_type(8)));
typedef float f32x4 __attribute__((ext_vector_type(4)));
typedef unsigned u32x4 __attribute__((ext_vector_type(4)));
typedef unsigned u32x2 __attribute__((ext_vector_type(2)));
constexpr int BM = 256, BK = 64, HALF = 128, HTB = HALF * BK * 2, STAGE_BYTES = 8 * HTB, NXCD = 8, WGM = 8;
DEV int lds_byte(int r, int c) { const int st = (r >> 4) * 2 + (c >> 5), rr = r & 15, cc = c & 31, ob = rr * 64 + cc * 2; return st * 1024 + (ob ^ (((ob >> 9) & 1) << 5)); }
DEV void stage_rc(int b, int& R, int& C) { const int st = b / 1024, sb = b % 1024, swz = sb ^ (((sb >> 9) & 1) << 5); R = (st >> 1) * 16 + swz / 64; C = (st & 1) * 32 + (swz % 64) / 2; }
DEV int perm32(int rho) { const int n = rho >> 4, i = rho & 15; return 8 * (i >> 2) + 4 * n + (i & 3); }
struct Unit { int pm, pn, e, t; };
struct StaticOrder {
    int nM, nN, nwg, G, c, skipctx; const char* Bt; int K;
    DEV void init(int nM_, int nN_, int G_, int c_, int skipctx_, const void* Bt_, int K_) { nM = nM_; nN = nN_; nwg = nM * nN; G = G_; c = c_; skipctx = skipctx_; Bt = (const char*)Bt_; K = K_; }
    DEV bool next(int i, Unit& u) const {
        const long L = (long)i * G + c; if (L >= nwg) return false;
        int wgid = (int)L; { const int q = nwg / NXCD, r = nwg % NXCD, xcd = wgid % NXCD, off = wgid / NXCD; wgid = (xcd < r ? xcd * (q + 1) : r * (q + 1) + (xcd - r) * q) + off; }
        const int nig = WGM * nN, gid = wgid / nig, fm = gid * WGM, gsz = (nM - fm) < WGM ? (nM - fm) : WGM;
        int pm = fm + ((wgid % nig) % gsz); u.pn = (wgid % nig) / gsz;
        if (skipctx) pm = (pm >> 3) * 9 + 1 + (pm & 7);
        u.pm = pm; u.e = 0; u.t = 0; return true;
    }
    DEV int arow(const Unit& u, int rr) const { return u.pm * BM + rr; }
    DEV const char* bbase(const Unit& u) const { return Bt + (size_t)u.pn * BM * K * 2; }
};
struct EpiF32 {
    static constexpr bool PERM = false;
    float* C; int ldc;
    DEV void operator()(const f32x4 (&acc)[2][2][4][2], const Unit& u, int wr, int wc, int fr, int fq) const {
        const int row0 = u.pm * BM + wr * 64 + fr, col0 = u.pn * BM + wc * 32 + 4 * fq;
#pragma unroll
        for (int ai = 0; ai < 2; ++ai)
#pragma unroll
            for (int m = 0; m < 4; ++m) { float* rowp = C + (size_t)(row0 + ai * HALF + m * 16) * ldc + col0;
#pragma unroll
                for (int bj = 0; bj < 2; ++bj)
#pragma unroll
                    for (int n = 0; n < 2; ++n) *(f32x4*)(rowp + bj * HALF + n * 16) = acc[ai][bj][m][n]; }
    }
};

typedef int i32x4 __attribute__((ext_vector_type(4)));
typedef int i32x8 __attribute__((ext_vector_type(8)));
DEV i32x8 cat8(bf16x8 a, bf16x8 b) { const i32x4 x = __builtin_bit_cast(i32x4, a), y = __builtin_bit_cast(i32x4, b); return __builtin_shufflevector(x, y, 0, 1, 2, 3, 4, 5, 6, 7); }
template <class Epi, class Sched, bool F8 = false>
DEV void gemm_phase(LAS unsigned char* lds, const char* Abase, const int K, const Sched& S, const Epi& E, const int tid) {
    const int wid = __builtin_amdgcn_readfirstlane(tid >> 6), lane = tid & 63, wr = wid >> 2, wc = wid & 3, fr = lane & 15, fq = lane >> 4;
    const int nt = K / BK;
    unsigned voffB[2];
#pragma unroll
    for (int i = 0; i < 2; ++i) { int R, C; stage_rc(tid * 16 + i * 8192, R, C); const int Rb = Epi::PERM ? ((R & ~31) + perm32(R & 31)) : R;
        voffB[i] = (unsigned)(Rb * BK + C) * 2u; }
    const size_t kstep = (size_t)(BK * 2);
    const size_t hstep = (size_t)HALF * K * 2;
    constexpr size_t kstepB = (size_t)BM * BK * 2, hstepB = (size_t)HALF * BK * 2;
    const unsigned ldsw = (unsigned)wid * 1024u;
    const int aoff = lds_byte(wr * 64 + fr, fq * 8), boff = lds_byte(wc * 32 + fr, fq * 8);
#define PG8_SA(b, h) (((b) * 2 + (h)) * HTB)
#define PG8_SB(b, h) ((4 + (b) * 2 + (h)) * HTB)
#define PG8_STAGE_B(bufoff, gbase) do { _Pragma("unroll") for (int _i = 0; _i < 2; ++_i) \
        __builtin_amdgcn_global_load_lds((const unsigned*)((const char*)(gbase) + voffB[_i]), (LAS unsigned*)(lds + (bufoff) + ldsw + _i * 8192), 16, 0, 0); } while (0)
#define PG8_STAGE_A(bufoff, kb, V, h) do { _Pragma("unroll") for (int _i = 0; _i < 2; ++_i) \
        __builtin_amdgcn_global_load_lds((const unsigned*)(Abase + (kb) + (V)[h][_i]), (LAS unsigned*)(lds + (bufoff) + ldsw + _i * 8192), 16, 0, 0); } while (0)
#define PG8_VOFFA(V, u) do { _Pragma("unroll") for (int _i = 0; _i < 2; ++_i) { int _R, _C; stage_rc(tid * 16 + _i * 8192, _R, _C); _Pragma("unroll") for (int _h = 0; _h < 2; ++_h) \
        (V)[_h][_i] = ((unsigned)S.arow(u, _h * HALF + _R) * (unsigned)K + (unsigned)_C) * 2u; } } while (0)
#define PG8_LDA(dst, b, h) do { _Pragma("unroll") for (int m = 0; m < 4; ++m) _Pragma("unroll") for (int k = 0; k < 2; ++k) dst[m][k] = *(const LAS bf16x8*)(lds + PG8_SA(b, h) + aoff + m * 2048 + k * 1024); } while (0)
#define PG8_LDB(dst, b, h) do { _Pragma("unroll") for (int n = 0; n < 2; ++n) _Pragma("unroll") for (int k = 0; k < 2; ++k) dst[n][k] = *(const LAS bf16x8*)(lds + PG8_SB(b, h) + boff + n * 2048 + k * 1024); } while (0)
#define PG8_MMA(ai, bj, At, Bt) do { __builtin_amdgcn_s_setprio(1); _Pragma("unroll") for (int m = 0; m < 4; ++m) _Pragma("unroll") for (int n = 0; n < 2; ++n) { \
        if constexpr (F8) asm volatile("v_mfma_f32_16x16x128_f8f6f4 %0, %1, %2, %0" : "+v"(acc[ai][bj][m][n]) : "v"(cat8(Bt[n][0], Bt[n][1])), "v"(cat8(At[m][0], At[m][1]))); \
        else { _Pragma("unroll") for (int k = 0; k < 2; ++k) acc[ai][bj][m][n] = __builtin_amdgcn_mfma_f32_16x16x32_bf16(Bt[n][k], At[m][k], acc[ai][bj][m][n], 0, 0, 0); } } __builtin_amdgcn_s_setprio(0); } while (0)
#define PG8_WAIT_V(n) asm volatile("s_waitcnt vmcnt(" #n ")" ::: "memory")
#define PG8_WAIT_L(n) asm volatile("s_waitcnt lgkmcnt(" #n ")" ::: "memory")
#define PG8_BAR __builtin_amdgcn_s_barrier()
#define PG8_SCHED __builtin_amdgcn_sched_barrier(0)
    Unit cur, nxt; int ui = 0;
    if (!S.next(0, cur)) return;
    f32x4 acc[2][2][4][2];
#pragma unroll
    for (int a = 0; a < 2; ++a)
#pragma unroll
        for (int b = 0; b < 2; ++b)
#pragma unroll
            for (int m = 0; m < 4; ++m)
#pragma unroll
                for (int n = 0; n < 2; ++n) acc[a][b][m][n] = (f32x4){0.f, 0.f, 0.f, 0.f};
    bf16x8 At[4][2], B0[2][2], B1[2][2];
    unsigned vc[2][2], v2[2][2];
    PG8_VOFFA(vc, cur);
    const char* cB = S.bbase(cur);
    PG8_STAGE_B(PG8_SB(0, 0), cB); PG8_STAGE_A(PG8_SA(0, 0), 0, vc, 0); PG8_STAGE_B(PG8_SB(0, 1), cB + hstepB); PG8_STAGE_A(PG8_SA(0, 1), 0, vc, 1);
    if (wr == 1) PG8_BAR;
    PG8_WAIT_V(4); PG8_BAR;
    PG8_STAGE_B(PG8_SB(1, 0), cB + kstepB); PG8_STAGE_A(PG8_SA(1, 0), kstep, vc, 0); PG8_STAGE_B(PG8_SB(1, 1), cB + hstepB + kstepB);
    PG8_WAIT_V(6); PG8_BAR;
    for (;;) {
        const bool has_next = S.next(ui + 1, nxt);
        const char* nB = has_next ? S.bbase(nxt) : cB;
        for (int t = 0; t < nt; t += 2) {
            const bool last = (t == nt - 2);
            const size_t k1 = (size_t)(t + 1) * kstep, k2 = last ? (size_t)0 : (size_t)(t + 2) * kstep, k3 = k2 + kstep;
            if (last && has_next) { PG8_VOFFA(v2, nxt); } else {
#pragma unroll
                for (int h = 0; h < 2; ++h)
#pragma unroll
                    for (int i = 0; i < 2; ++i) v2[h][i] = vc[h][i]; }
            const char* b2 = last ? nB : cB + (size_t)(t + 2) * kstepB; const char* b3 = b2 + kstepB;
            PG8_LDB(B0, 0, 0); PG8_SCHED; PG8_LDA(At, 0, 0); PG8_STAGE_A(PG8_SA(1, 1), k1, vc, 1);
            PG8_WAIT_L(8); PG8_BAR; PG8_WAIT_L(0); PG8_MMA(0, 0, At, B0); PG8_BAR; PG8_SCHED;
            PG8_LDB(B1, 0, 1); PG8_STAGE_B(PG8_SB(0, 0), b2);
            PG8_BAR; PG8_WAIT_L(0); PG8_MMA(0, 1, At, B1); PG8_BAR;
            PG8_LDA(At, 0, 1); PG8_STAGE_A(PG8_SA(0, 0), k2, v2, 0);
            PG8_BAR; PG8_WAIT_L(0); PG8_MMA(1, 0, At, B0); PG8_BAR; PG8_SCHED;
            PG8_STAGE_B(PG8_SB(0, 1), b2 + hstepB);
            PG8_WAIT_V(6); PG8_BAR; PG8_MMA(1, 1, At, B1); PG8_BAR;
            PG8_LDB(B0, 1, 0); PG8_SCHED; PG8_LDA(At, 1, 0); PG8_STAGE_A(PG8_SA(0, 1), k2, v2, 1);
            PG8_WAIT_L(8); PG8_BAR; PG8_WAIT_L(0); PG8_MMA(0, 0, At, B0); PG8_BAR; PG8_SCHED;
            PG8_LDB(B1, 1, 1); PG8_STAGE_B(PG8_SB(1, 0), b3);
            PG8_BAR; PG8_WAIT_L(0); PG8_MMA(0, 1, At, B1); PG8_BAR;
            PG8_LDA(At, 1, 1); PG8_STAGE_A(PG8_SA(1, 0), k3, v2, 0);
            PG8_BAR; PG8_WAIT_L(0); PG8_MMA(1, 0, At, B0); PG8_BAR; PG8_SCHED;
            PG8_STAGE_B(PG8_SB(1, 1), b3 + hstepB);
            PG8_WAIT_V(6); PG8_BAR; PG8_MMA(1, 1, At, B1); PG8_BAR;
        }
        if constexpr (F8) asm volatile("s_nop 15\n\ts_nop 15" ::: "memory");
        E(acc, cur, wr, wc, fr, fq);
        if (!has_next) break;
#pragma unroll
        for (int a = 0; a < 2; ++a)
#pragma unroll
            for (int b = 0; b < 2; ++b)
#pragma unroll
                for (int m = 0; m < 4; ++m)
#pragma unroll
                    for (int n = 0; n < 2; ++n) acc[a][b][m][n] = (f32x4){0.f, 0.f, 0.f, 0.f};
        cur = nxt; cB = nB; ++ui;
#pragma unroll
        for (int h = 0; h < 2; ++h)
#pragma unroll
            for (int i = 0; i < 2; ++i) vc[h][i] = v2[h][i];
    }
    PG8_WAIT_V(0);
    if (wr == 0) PG8_BAR;
    PG8_BAR;
#undef PG8_SA
#undef PG8_SB
#undef PG8_STAGE_A
#undef PG8_STAGE_B
#undef PG8_VOFFA
#undef PG8_LDA
#undef PG8_LDB
#undef PG8_MMA
#undef PG8_WAIT_V
#undef PG8_WAIT_L
#undef PG8_BAR
#undef PG8_SCHED
}
}


namespace att {
using bf16x8 = __attribute__((ext_vector_type(8))) short;
using s16x4  = __attribute__((ext_vector_type(4))) short;
using f32x16 = __attribute__((ext_vector_type(16))) float;
using u32x4  = __attribute__((ext_vector_type(4))) unsigned;
constexpr int KVBLK = 64, LDK = 128;
constexpr int SHM_V = KVBLK * 128 * 2, SHM_K = KVBLK * 128 * 2, SHM_ATTN = 2 * SHM_V + 2 * SHM_K + 8 * 64 * 4;
constexpr float THR = 8.f;
#define KSWZ(row, colB) ((row) * 256 + ((colB) ^ (((row) & 7) << 4)))
#define SBAR() __builtin_amdgcn_sched_barrier(0)
DEV int crow(int r, int hi) { return (r & 3) + 8 * (r >> 2) + 4 * hi; }
DEV void partialSM(f32x16& p0, f32x16& p1, float& m_reg, float& mn, float& alpha) {
  float pmax = p0[0]; for (int r = 1; r < 16; ++r) pmax = fmaxf(pmax, p0[r]); for (int r = 0; r < 16; ++r) pmax = fmaxf(pmax, p1[r]);
  { auto rr = __builtin_amdgcn_permlane32_swap(__float_as_uint(pmax), __float_as_uint(pmax), false, false);
    pmax = fmaxf(__uint_as_float(rr[0]), __uint_as_float(rr[1])); }
  if (__builtin_expect(__all(pmax - m_reg <= THR), 1)) { mn = m_reg; alpha = 1.f; }
  else { mn = fmaxf(m_reg, pmax); alpha = __builtin_amdgcn_exp2f(m_reg - mn); m_reg = mn; }
  for (int r = 0; r < 16; ++r) p0[r] = p0[r] - mn; for (int r = 0; r < 16; ++r) p1[r] = p1[r] - mn;
  for (int r = 0; r < 16; ++r) p0[r] = __builtin_amdgcn_exp2f(p0[r]);
}
DEV void finishSM(f32x16& p0, f32x16& p1, float alpha, float& l_reg, bf16x8& pa0, bf16x8& pa1, bf16x8& pa2, bf16x8& pa3) {
  for (int r = 0; r < 16; ++r) p1[r] = __builtin_amdgcn_exp2f(p1[r]);
  float ps = 0; for (int r = 0; r < 16; ++r) ps += p0[r]; for (int r = 0; r < 16; ++r) ps += p1[r];
  { auto rr = __builtin_amdgcn_permlane32_swap(__float_as_uint(ps), __float_as_uint(ps), false, false);
    ps = __uint_as_float(rr[0]) + __uint_as_float(rr[1]); }
  l_reg = l_reg * alpha + ps;
#define PK4(P, BASE, OUT) do { unsigned a0 = cvt_pk_bf16(P[BASE + 0], P[BASE + 1]), a1 = cvt_pk_bf16(P[BASE + 2], P[BASE + 3]);   \
    unsigned b0 = cvt_pk_bf16(P[BASE + 4], P[BASE + 5]), b1 = cvt_pk_bf16(P[BASE + 6], P[BASE + 7]);                              \
    auto r0 = __builtin_amdgcn_permlane32_swap(a0, b0, false, false); auto r1 = __builtin_amdgcn_permlane32_swap(a1, b1, false, false); \
    u32x4 w = {r0[0], r1[0], r0[1], r1[1]}; OUT = *reinterpret_cast<bf16x8*>(&w); } while (0)
  PK4(p0, 0, pa0); PK4(p0, 8, pa1); PK4(p1, 0, pa2); PK4(p1, 8, pa3);
#undef PK4
}
DEV void qkt(f32x16& p0, f32x16& p1, const char* Ks, const bf16x8 (&qr)[4], int r32, int hi, int js) {
  p0 = f32x16{}; p1 = f32x16{};
#pragma unroll
  for (int d0 = 0; d0 < 4; ++d0) { const int cb = ((js * 4 + d0) * 16 + hi * 8) * 2;
    bf16x8 b0 = *reinterpret_cast<const bf16x8*>(Ks + KSWZ(r32, cb));
    bf16x8 b1 = *reinterpret_cast<const bf16x8*>(Ks + KSWZ(32 + r32, cb));
    p0 = __builtin_amdgcn_mfma_f32_32x32x16_bf16(b0, qr[d0], p0, 0, 0, 0);
    p1 = __builtin_amdgcn_mfma_f32_32x32x16_bf16(b1, qr[d0], p1, 0, 0, 0); }
}
DEV int v_st(int k, int c) { const int kk = (k & ~0xC) | ((k & 4) << 1) | ((k & 8) >> 1); return ((kk >> 3) * 4 + (c >> 5)) * 512 + ((kk & 7) * 32 + (c & 31)) * 2; }
DEV int v_rd_base(int lane) { return ((lane & 3) << 3) | (((lane >> 2) & 3) << 6) | (((lane >> 4) & 1) << 5) | (((lane >> 5) & 1) << 8); }
constexpr int v_rd_off(int d0, int ks, int half) { return d0 * 512 + ks * 4096 + half * 2048; }
template <int OFF> DEV s16x4 tr_read(int vb) {
  s16x4 r; asm volatile("ds_read_b64_tr_b16 %0, %1 offset:%2" : "=&v"(r) : "v"(vb), "i"(OFF) : "memory"); return r;
}
template <int D0> DEV void pv_one(f32x16& od, int vb, bf16x8 pa0, bf16x8 pa1, bf16x8 pa2, bf16x8 pa3) {
  const s16x4 l0 = tr_read<v_rd_off(D0, 0, 0)>(vb), h0 = tr_read<v_rd_off(D0, 0, 1)>(vb), l1 = tr_read<v_rd_off(D0, 1, 0)>(vb), h1 = tr_read<v_rd_off(D0, 1, 1)>(vb);
  const s16x4 l2 = tr_read<v_rd_off(D0, 2, 0)>(vb), h2 = tr_read<v_rd_off(D0, 2, 1)>(vb), l3 = tr_read<v_rd_off(D0, 3, 0)>(vb), h3 = tr_read<v_rd_off(D0, 3, 1)>(vb);
  asm volatile("s_waitcnt lgkmcnt(0)" ::: "memory"); SBAR();
#define PK(L, H) (bf16x8){L[0], L[1], L[2], L[3], H[0], H[1], H[2], H[3]}
  od = __builtin_amdgcn_mfma_f32_32x32x16_bf16(pa0, PK(l0, h0), od, 0, 0, 0);
  od = __builtin_amdgcn_mfma_f32_32x32x16_bf16(pa1, PK(l1, h1), od, 0, 0, 0);
  od = __builtin_amdgcn_mfma_f32_32x32x16_bf16(pa2, PK(l2, h2), od, 0, 0, 0);
  od = __builtin_amdgcn_mfma_f32_32x32x16_bf16(pa3, PK(l3, h3), od, 0, 0, 0);
#undef PK
}
DEV void pv_d0(f32x16* o, int vb, bf16x8 pa0, bf16x8 pa1, bf16x8 pa2, bf16x8 pa3) {
  pv_one<0>(o[0], vb, pa0, pa1, pa2, pa3); pv_one<1>(o[1], vb, pa0, pa1, pa2, pa3); pv_one<2>(o[2], vb, pa0, pa1, pa2, pa3); pv_one<3>(o[3], vb, pa0, pa1, pa2, pa3);
}
DEV void attn_tiles(const bf16x8 (&qr)[4], const bf16_t* __restrict__ Kh, const bf16_t* __restrict__ Vh, int seq, char* lds,
                    float& m_reg, float& l_reg, f32x16 (&o)[4], int tid, int js) {
  const int wid = tid >> 6, lane = tid & 63, r32 = lane & 31, hi = lane >> 5;
  char* V_lds = lds; char* K_lds = lds + 2 * SHM_V;
  float* ws = (float*)(lds + 2 * SHM_V + 2 * SHM_K) + wid * 64; float* al_l = ws + 32;
  const int sr = tid >> 4, sc = (tid & 15) * 8, vst0 = v_st(sr, sc), vst1 = v_st(32 + sr, sc);
  const int vb0 = (int)(uintptr_t)V_lds + v_rd_base(lane);
  struct { bf16x8 vs0, vs1, ks0, ks1; } sr_[2];
  const unsigned lo0 = (unsigned)((sr * LDK + sc) * 2), lo1 = lo0 + 32u * LDK * 2u;
#define SLOAD(i, k0) do { const char* vb_ = (const char*)Vh + (size_t)(k0) * (LDK * 2); const char* kb_ = (const char*)Kh + (size_t)(k0) * (LDK * 2); \
    sr_[i].vs0 = *(const bf16x8*)(vb_ + lo0); sr_[i].vs1 = *(const bf16x8*)(vb_ + lo1); sr_[i].ks0 = *(const bf16x8*)(kb_ + lo0); sr_[i].ks1 = *(const bf16x8*)(kb_ + lo1); } while (0)
#define SWRITE(b, i) do { *(bf16x8*)(V_lds + (b) * SHM_V + vst0) = sr_[i].vs0;          \
    *(bf16x8*)(V_lds + (b) * SHM_V + vst1) = sr_[i].vs1; int kc = sc * 2;               \
    *(bf16x8*)(K_lds + (b) * SHM_K + KSWZ(sr, kc)) = sr_[i].ks0;                       \
    *(bf16x8*)(K_lds + (b) * SHM_K + KSWZ(32 + sr, kc)) = sr_[i].ks1; } while (0)
#define SWAIT() asm volatile("s_waitcnt vmcnt(4)" ::: "memory")
#define RESC(a) do { if (__any((a) < 1.f)) { if (hi == 0) al_l[r32] = (a); asm volatile("s_waitcnt lgkmcnt(0)" ::: "memory"); \
    for (int d = 0; d < 4; ++d) for (int r = 0; r < 16; ++r) o[d][r] *= al_l[crow(r, hi)]; } } while (0)
  f32x16 pA0, pA1, pB0, pB1; float mnA, mnB, alA, alB; bf16x8 pa0, pa1, pa2, pa3; const int NTL = seq / KVBLK;
  constexpr int SE = 0, SO = 1;
  __syncthreads();
  SLOAD(SE, 0); asm volatile("s_waitcnt vmcnt(0)" ::: "memory"); SWRITE(0, SE); __syncthreads();
  qkt(pA0, pA1, K_lds, qr, r32, hi, js); partialSM(pA0, pA1, m_reg, mnA, alA);
  SLOAD(SO, KVBLK); if (2 < NTL) SLOAD(SE, 2 * KVBLK);
  SWAIT(); SWRITE(1, SO); __syncthreads();
  RESC(alA);
  for (int j = 1; j + 1 < NTL; j += 2) {
    SBAR(); qkt(pB0, pB1, K_lds + SHM_K, qr, r32, hi, js);
    finishSM(pA0, pA1, alA, l_reg, pa0, pa1, pa2, pa3); SBAR();
    SLOAD(SO, (j + 2) * KVBLK); SBAR();
    pv_d0(o, vb0, pa0, pa1, pa2, pa3); partialSM(pB0, pB1, m_reg, mnB, alB);
    __syncthreads(); SWAIT(); SWRITE(0, SE);
    RESC(alB); __syncthreads();
    SBAR(); qkt(pA0, pA1, K_lds, qr, r32, hi, js);
    finishSM(pB0, pB1, alB, l_reg, pa0, pa1, pa2, pa3); SBAR();
    if (j + 3 < NTL) SLOAD(SE, (j + 3) * KVBLK); SBAR();
    pv_d0(o, vb0 + SHM_V, pa0, pa1, pa2, pa3); partialSM(pA0, pA1, m_reg, mnA, alA);
    __syncthreads(); SWAIT(); SWRITE(1, SO);
    RESC(alA); __syncthreads();
  }
  SBAR(); qkt(pB0, pB1, K_lds + SHM_K, qr, r32, hi, js);
  finishSM(pA0, pA1, alA, l_reg, pa0, pa1, pa2, pa3); SBAR();
  pv_d0(o, vb0, pa0, pa1, pa2, pa3); partialSM(pB0, pB1, m_reg, mnB, alB);
  __syncthreads(); RESC(alB);
  finishSM(pB0, pB1, alB, l_reg, pa0, pa1, pa2, pa3); SBAR();
  pv_d0(o, vb0 + SHM_V, pa0, pa1, pa2, pa3);
#undef SLOAD
#undef SWRITE
#undef SWAIT
#undef RESC
}
}

DEV void cvt_tile(const float* src, int ld, int nvalid, bf16_t* dst, int K, int n0, int k0, float* T, const int t, int ns0 = -1) {
    if (ns0 < 0) ns0 = n0;
#pragma unroll
    for (int h = 0; h < 2; ++h) {
        const int kk = (t >> 4) + 32 * h, nq = (t & 15) * 4, n = ns0 + nq;
        const float4 v = n < nvalid ? *(const float4*)(src + (size_t)(k0 + kk) * ld + n) : make_float4(0.f, 0.f, 0.f, 0.f);
        T[(nq + 0) * 65 + kk] = v.x; T[(nq + 1) * 65 + kk] = v.y; T[(nq + 2) * 65 + kk] = v.z; T[(nq + 3) * 65 + kk] = v.w;
    }
    __syncthreads();
    { const int n = t >> 3, kq = (t & 7) * 8; const float* r = T + n * 65 + kq;
      pg8::u32x4 w; w.x = cvt_pk_bf16(r[0], r[1]); w.y = cvt_pk_bf16(r[2], r[3]); w.z = cvt_pk_bf16(r[4], r[5]); w.w = cvt_pk_bf16(r[6], r[7]);
      *(pg8::u32x4*)(dst + (size_t)(n0 + n) * K + k0 + kq) = w; }
    __syncthreads();
}
DEV unsigned pk4_fp8(float a, float b, float c, float d) {
    a = __builtin_amdgcn_fmed3f(a, -448.f, 448.f); b = __builtin_amdgcn_fmed3f(b, -448.f, 448.f); c = __builtin_amdgcn_fmed3f(c, -448.f, 448.f); d = __builtin_amdgcn_fmed3f(d, -448.f, 448.f);
    int w = 0; w = __builtin_amdgcn_cvt_pk_fp8_f32(a, b, w, false); w = __builtin_amdgcn_cvt_pk_fp8_f32(c, d, w, true); return (unsigned)w;
}
constexpr float F8_SW = 1024.f  , F8_SX = 16.f  , F8_SH = 8.f  ;
DEV void cvt_tile4(const float* src, int ld, int nvalid, bf16_t* dst, int K, int n0, int k0, float* T, const int t, int ns0 = -1, bool f8 = false) {
    if (ns0 < 0) ns0 = n0;
    float4 v[4][2];
#pragma unroll
    for (int q = 0; q < 4; ++q)
#pragma unroll
        for (int h = 0; h < 2; ++h) { const int kk = (t >> 4) + 32 * h, n = ns0 + (t & 15) * 4;
            v[q][h] = n < nvalid ? *(const float4*)(src + (size_t)(k0 + q * 64 + kk) * ld + n) : make_float4(0.f, 0.f, 0.f, 0.f); }
#pragma unroll
    for (int q = 0; q < 4; ++q)
#pragma unroll
        for (int h = 0; h < 2; ++h) { const int kk = (t >> 4) + 32 * h, nq = (t & 15) * 4; float* Tq = T + q * (64 * 65);
            Tq[(nq + 0) * 65 + kk] = v[q][h].x; Tq[(nq + 1) * 65 + kk] = v[q][h].y; Tq[(nq + 2) * 65 + kk] = v[q][h].z; Tq[(nq + 3) * 65 + kk] = v[q][h].w; }
    __syncthreads();
#pragma unroll
    for (int q = 0; q < 4; ++q) { const int n = t >> 3, kq = (t & 7) * 8; const float* r = T + q * (64 * 65) + n * 65 + kq;
      if (f8) { pg8::u32x2 w; w.x = pk4_fp8(r[0] * F8_SW, r[1] * F8_SW, r[2] * F8_SW, r[3] * F8_SW); w.y = pk4_fp8(r[4] * F8_SW, r[5] * F8_SW, r[6] * F8_SW, r[7] * F8_SW);
          const int nn = n0 + n, kk = k0 + q * 64 + kq;
          *(pg8::u32x2*)((unsigned char*)dst + (size_t)(nn >> 8) * 256 * K + (size_t)(kk >> 7) * (256 * 128) + (nn & 255) * 128 + (kk & 127)) = w; }
      else { pg8::u32x4 w; w.x = cvt_pk_bf16(r[0], r[1]); w.y = cvt_pk_bf16(r[2], r[3]); w.z = cvt_pk_bf16(r[4], r[5]); w.w = cvt_pk_bf16(r[6], r[7]);
          const int nn = n0 + n, kk = k0 + q * 64 + kq;
          *(pg8::u32x4*)(dst + (size_t)(nn >> 8) * 256 * K + (size_t)(kk >> 6) * (256 * 64) + (nn & 255) * 64 + (kk & 63)) = w; } }
    __syncthreads();
}
DEV void ph_convert(const Params& p, char* smem) {
    const int tidx = tid_of(p.wave_id);
    float* T = (float*)(smem + 256);
    volatile int* msg = (volatile int*)smem;
    unsigned* qh = (unsigned*)(p.ws + OFF_bar) + CW_QHEAD;
    constexpr int T_IN = 2 * 60 * 4, T_OUT = 2 * 16 * 4, T_W1 = 64 * 32 * 4, T_W2 = 64 * 16 * 4;
    unsigned nxt = 0u;
    if (tidx == 0) nxt = xb_add(qh, 1u);
    for (;;) {
        __syncthreads();
        if (tidx == 0) msg[0] = (int)nxt;
        __syncthreads();
        const int u = msg[0];
        if (u >= T_IN + T_OUT + T_W1 + T_W2) break;
        if (tidx == 0) nxt = xb_add(qh, 1u);
        if (u < T_IN) { const int l = u / 240, r = u % 240, nt = r >> 2, kq = r & 3;
            const int n0 = nt * 64; int ns0, nv;
            if (n0 < 2048) { ns0 = n0; nv = DPW; } else if (n0 < 3584) { ns0 = n0 + 16; nv = DPW; } else if (n0 == 3584) { ns0 = 2048; nv = 2064; } else { ns0 = 0; nv = 0; }
            cvt_tile4(p.w_in + (size_t)l * D * DPW, DPW, nv, (bf16_t*)(p.ws + OFF_WIN) + (size_t)l * DP * D, D, n0, kq * 256, T, tidx, ns0); }
        else if (u < T_IN + T_OUT) { const int v = u - T_IN, l = v >> 6, r = v & 63, nt = r >> 2, kq = r & 3;
            cvt_tile4(p.w_out + (size_t)l * D * D, D, D, (bf16_t*)(p.ws + OFF_WOUT) + (size_t)l * D * D, D, nt * 64, kq * 256, T, tidx); }
        else if (u < T_IN + T_OUT + T_W1) { const int v = u - T_IN - T_OUT, le = v >> 7, r = v & 127, nt = r >> 2, kq = r & 3;
            cvt_tile4(p.w1 + (size_t)le * D * 2048, 2048, 2048, (bf16_t*)(p.ws + OFF_W1T + (size_t)le * 2048 * D), D, nt * 64, kq * 256, T, tidx, -1, true); }
        else { const int v = u - T_IN - T_OUT - T_W1, le = v >> 6, r = v & 63, nt = r >> 2, kq = r & 3;
            cvt_tile4(p.w2 + (size_t)le * DFF * D, D, D, (bf16_t*)(p.ws + OFF_W2T + (size_t)le * D * DFF), DFF, nt * 64, kq * 256, T, tidx, -1, true); }
    }
}

DEV void row_load(const float* src, float4 (&v)[4], int lane) {
#pragma unroll
    for (int i = 0; i < 4; ++i) v[i] = *(const float4*)(src + i * 256 + lane * 4);
}
DEV void row_store(float* dst, const float4 (&v)[4], int lane) {
#pragma unroll
    for (int i = 0; i < 4; ++i) *(float4*)(dst + i * 256 + lane * 4) = v[i];
}
DEV void row_store_bf16(bf16_t* dst, const float4 (&v)[4], int lane) {
#pragma unroll
    for (int i = 0; i < 4; ++i) { pg8::u32x2 w; w.x = cvt_pk_bf16(v[i].x, v[i].y); w.y = cvt_pk_bf16(v[i].z, v[i].w); *(pg8::u32x2*)(dst + i * 256 + lane * 4) = w; }
}
DEV void row_store_fp8(unsigned char* dst, const float4 (&v)[4], int lane, float sc) {
#pragma unroll
    for (int i = 0; i < 4; ++i) *(unsigned*)(dst + i * 256 + lane * 4) = pk4_fp8(v[i].x * sc, v[i].y * sc, v[i].z * sc, v[i].w * sc);
}
DEV void row_load_bf(const bf16_t* src, float4 (&v)[4], int lane) {
#pragma unroll
    for (int i = 0; i < 4; ++i) { const pg8::u32x2 w = *(const pg8::u32x2*)(src + i * 256 + lane * 4);
        v[i] = make_float4(__uint_as_float(w.x << 16), __uint_as_float(w.x & 0xffff0000u), __uint_as_float(w.y << 16), __uint_as_float(w.y & 0xffff0000u)); }
}
DEV float row_rinv(const float4 (&v)[4]) {
    float ss = 0.f;
#pragma unroll
    for (int i = 0; i < 4; ++i) ss += v[i].x * v[i].x + v[i].y * v[i].y + v[i].z * v[i].z + v[i].w * v[i].w;
    ss = wsum(ss);
    return rsqrtf(ss * (1.f / 1024.f) + 1e-6f);
}
DEV void row_modnorm(const float4 (&v)[4], const float* gain, const float* shift, const float* scale, float4 (&o)[4], int lane) {
    const float r = row_rinv(v);
#pragma unroll
    for (int i = 0; i < 4; ++i) {
        const int idx = i * 256 + lane * 4;
        const float4 g = *(const float4*)(gain + idx), sh = *(const float4*)(shift + idx), sc = *(const float4*)(scale + idx);
        o[i].x = v[i].x * r * g.x * (1.f + sc.x) + sh.x; o[i].y = v[i].y * r * g.y * (1.f + sc.y) + sh.y;
        o[i].z = v[i].z * r * g.z * (1.f + sc.z) + sh.z; o[i].w = v[i].w * r * g.w * (1.f + sc.w) + sh.w;
    }
}
DEV const float* modrow(const Params& p, int layer, int b, int s) { return ((float*)(p.ws + OFF_MOD)) + ((size_t)layer * 9 + (s < CTX ? 8 : b)) * 6144; }

DEV void ph_mods(const Params& p, char* smem) {
    const int tidx = tid_of(p.wave_id);
    float (*cond)[1024] = (float (*)[1024])smem;
    float (*red)[9][64] = (float (*)[9][64])(smem + 9 * 1024 * 4);
    const int tid = tidx;
    for (int i = tid; i < 9 * 1024; i += 512) { const int r = i >> 10, k = i & 1023; const float c = r < 8 ? p.c[r * 1024 + k] : p.c_ctx[k]; cond[r][k] = c * sigm(c); }
    __syncthreads();
    for (int u = blockIdx.x; u < 192; u += gridDim.x) {
        const int layer = u / 96, cg = u % 96, jj = tid & 63, ks = tid >> 6, j = cg * 64 + jj;
        float acc[9];
#pragma unroll
        for (int r = 0; r < 9; ++r) acc[r] = 0.f;
        const float* w = p.ada_w + (size_t)layer * 1024 * 6144 + j;
        for (int k = ks * 128; k < ks * 128 + 128; ++k) { const float wv = w[(size_t)k * 6144];
#pragma unroll
            for (int r = 0; r < 9; ++r) acc[r] += cond[r][k] * wv; }
#pragma unroll
        for (int r = 0; r < 9; ++r) red[ks][r][jj] = acc[r];
        __syncthreads();
        for (int t = tid; t < 9 * 64; t += 512) { const int r = t >> 6, q = t & 63; float s = 0.f; for (int z = 0; z < 8; ++z) s += red[z][r][q];
            ((float*)(p.ws + OFF_MOD))[((size_t)layer * 9 + r) * 6144 + cg * 64 + q] = s + p.ada_b[layer * 6144 + cg * 64 + q]; }
        __syncthreads();
    }
    if (blockIdx.x == (gridDim.x > 1 ? 1u : 0u)) {
        for (int t = tid; t < 1024; t += 512) { const int pos = t >> 4, i = t & 15; float sn, cs; sincosf((float)pos * expf(-(float)i * (1.f / 16.f) * 9.210340371976184f), &sn, &cs);
            ((float2*)(p.ws + OFF_ROPE))[t] = make_float2(cs, sn); }
    }
    if (blockIdx.x == 0) {
        for (int t = tid; t < 1024; t += 512) { const int layer = t >> 9, dir = (t >> 8) & 1, w = t & 255;
            const float t0 = p.hlb[(dir * 2 + 0) * 256 + w], t1 = p.hlb[(dir * 2 + 1) * 256 + w];
            const float mx = fmaxf(t0, t1), e0 = expf(t0 - mx), e1 = expf(t1 - mx);
            float lb = layer == 0 ? 0.f : e1 / (e0 + e1); lb = fminf(fmaxf(lb, 0.f), 1.f);
            ((float*)(p.ws + OFF_LB))[(layer * 2 + dir) * 256 + w] = lb; }
        if (tid < 128) { const int layer = tid >> 6, lane = tid & 63; const float* L = p.dlam + layer * 256;
            const float s1 = wsum(L[lane] * L[64 + lane]), s2 = wsum(L[128 + lane] * L[192 + lane]);
            if (lane == 0) ((float*)(p.ws + OFF_LAM))[layer] = expf(s1) - expf(s2) + lam_init_of(layer); }
    }
}

DEV void ph_init(const Params& p, char* smem) {
    const int tidx = tid_of(p.wave_id);
    const int wid = tidx >> 6, lane = tidx & 63;
    for (int r = blockIdx.x * 8 + wid; r < NT; r += gridDim.x * 8) {
        const int b = r / SL, s = r % SL;
        const float* src = s < CTX ? p.ctx + ((size_t)b * CTX + s) * D : p.x + ((size_t)b * SEQ + (s - CTX)) * D;
        float4 v[4], o[4]; row_load(src, v, lane); row_store_bf16((bf16_t*)(p.ws + OFF_X) + (size_t)r * D, v, lane);
        const float* m = modrow(p, 0, b, s);
        row_modnorm(v, p.norms + 0, m + 0, m + 1024, o, lane);
        row_store_bf16((bf16_t*)(p.ws + OFF_XNB) + (size_t)r * D, o, lane);
    }
}


struct EpiIn {
    static constexpr bool PERM = false;
    bf16_t *PB, *QRB, *Q0B, *KB, *VB; const float* CS;
    DEV void operator()(const pg8::f32x4 (&acc)[2][2][4][2], const pg8::Unit& u, int wr, int wc, int fr, int fq) const {
        using pg8::f32x4; using pg8::u32x2;
        const int pn = u.pn;
        if (pn < 8 || pn == 14) {
#pragma unroll
            for (int ai = 0; ai < 2; ++ai)
#pragma unroll
                for (int m = 0; m < 4; ++m) { bf16_t* rowp = PB + (size_t)(u.pm * 256 + ai * 128 + wr * 64 + m * 16 + fr) * DP + pn * 256 + wc * 32 + 4 * fq;
#pragma unroll
                    for (int bj = 0; bj < 2; ++bj)
#pragma unroll
                        for (int n = 0; n < 2; ++n) { const f32x4 v = acc[ai][bj][m][n]; u32x2 w; w.x = cvt_pk_bf16(v[0], v[1]); w.y = cvt_pk_bf16(v[2], v[3]); *(u32x2*)(rowp + bj * 128 + n * 16) = w; } }
        } else {
            const int kind = (pn - 8) >> 1, hb = ((pn - 8) & 1) * 2, b = u.pm / 9, tq = u.pm % 9, half = wc & 1, jsub = wc >> 1;
            const bool isctx = tq == 0;
            const float QC = 0.125f * 1.4426950408889634f;
#pragma unroll
            for (int ai = 0; ai < 2; ++ai)
#pragma unroll
                for (int m = 0; m < 4; ++m) {
                    const int s = tq * 256 + ai * 128 + wr * 64 + m * 16 + fr;
                    f32x4 c4 = {1.f, 1.f, 1.f, 1.f}, s4 = {0.f, 0.f, 0.f, 0.f};
                    if (kind != 2 && !isctx) { const int pos = half == 0 ? (tq - 1) * 4 + ai * 2 + wr : m * 16 + fr;
                        const f32x4 t0 = *(const f32x4*)(CS + (pos * 16 + 4 * fq) * 2), t1 = *(const f32x4*)(CS + (pos * 16 + 4 * fq) * 2 + 4);
                        c4 = (f32x4){t0[0], t0[2], t1[0], t1[2]}; s4 = (f32x4){t0[1], t0[3], t1[1], t1[3]}; }
#pragma unroll
                    for (int bj = 0; bj < 2; ++bj) {
                        const size_t dst = ((size_t)(b * 4 + hb + bj) * SL + s) * 128 + jsub * 64 + half * 32 + 4 * fq;
                        const f32x4 x1 = acc[ai][bj][m][0], x2 = acc[ai][bj][m][1];
#define ST4(ptr, v) do { u32x2 w_; w_.x = cvt_pk_bf16((v)[0], (v)[1]); w_.y = cvt_pk_bf16((v)[2], (v)[3]); *(u32x2*)(ptr) = w_; } while (0)
                        if (kind == 2) { ST4(VB + dst, x1); ST4(VB + dst + 16, x2); }
                        else {
                            const f32x4 o1 = x1 * c4 - x2 * s4, o2 = x1 * s4 + x2 * c4;
                            if (kind == 1) { ST4(KB + dst, o1); ST4(KB + dst + 16, o2); }
                            else { const f32x4 a1 = o1 * QC, a2 = o2 * QC, p1 = x1 * QC, p2 = x2 * QC; ST4(QRB + dst, a1); ST4(QRB + dst + 16, a2); ST4(Q0B + dst, p1); ST4(Q0B + dst + 16, p2); }
                        }
#undef ST4
                    }
                }
        }
    }
};

struct InOrder {
    int G, c, Lbeg, Lend; const char* Bt; int K;
    DEV bool next(int i, pg8::Unit& u) const {
        const int L = Lbeg + i * G + c; if (L >= Lend) return false;
        const int nN = L < 648 ? 9 : 6, l = L < 648 ? L : L - 648, nM = NT / 256, nwg = nM * nN;
        int wgid = l; { const int q = nwg / 8, r = nwg % 8, xcd = wgid % 8, off = wgid / 8; wgid = (xcd < r ? xcd * (q + 1) : r * (q + 1) + (xcd - r) * q) + off; }
        const int nig = 8 * nN, gid = wgid / nig, fm = gid * 8, gsz = (nM - fm) < 8 ? (nM - fm) : 8;
        const int pnl = (wgid % nig) / gsz;
        u.pm = fm + ((wgid % nig) % gsz); u.pn = L < 648 ? (pnl < 8 ? pnl : 14) : 8 + pnl; u.e = 0; u.t = 0; return true;
    }
    DEV int arow(const pg8::Unit& u, int rr) const { return u.pm * 256 + rr; }
    DEV const char* bbase(const pg8::Unit& u) const { return Bt + (size_t)u.pn * 256 * K * 2; }
};
DEV void ph_inproj(const Params& p, int layer, char* smem, int part) {
    const int tidx = tid_of(p.wave_id);
    const int G = (int)gridDim.x, nun = (NT / 256) * (DP / 256), cut = 4 * G < nun ? 4 * G : nun;
    const int nleft = nun - cut, cid = part == 0 ? (int)blockIdx.x : (int)blockIdx.x - (G - nleft);
    if (part == 1 && (nleft <= 0 || cid < 0)) return;
    InOrder S{G, cid, part == 0 ? 0 : cut, part == 0 ? cut : nun, (const char*)((const bf16_t*)(p.ws + OFF_WIN) + (size_t)layer * DP * D), D};
    EpiIn E{(bf16_t*)(p.ws + OFF_PB), (bf16_t*)(p.ws + OFF_QRB), (bf16_t*)(p.ws + OFF_Q0B), (bf16_t*)(p.ws + OFF_KB), (bf16_t*)(p.ws + OFF_VB), (const float*)(p.ws + OFF_ROPE)};
    pg8::gemm_phase(( LAS unsigned char*)smem, (const char*)(p.ws + OFF_XNB), D, S, E, tid_of(p.wave_id));
}


namespace scn {
using att::bf16x8; using att::s16x4; using att::f32x16; using att::u32x4; using att::crow;
DEV int v_st64(int k, int c) { const int kk = (k & ~0xC) | ((k & 4) << 1) | ((k & 8) >> 1); return ((kk >> 3) * 2 + (c >> 5)) * 512 + ((kk & 7) * 32 + (c & 31)) * 2; }
constexpr int v_rd_off64(int d0, int ks, int half) { return d0 * 512 + ks * 2048 + half * 1024; }
#define SCN_PK(L, H) (bf16x8){L[0], L[1], L[2], L[3], H[0], H[1], H[2], H[3]}
template <int D0> DEV void frags4(int vb, bf16x8& f0, bf16x8& f1, bf16x8& f2, bf16x8& f3) {
    const s16x4 l0 = att::tr_read<v_rd_off64(D0, 0, 0)>(vb), h0 = att::tr_read<v_rd_off64(D0, 0, 1)>(vb), l1 = att::tr_read<v_rd_off64(D0, 1, 0)>(vb), h1 = att::tr_read<v_rd_off64(D0, 1, 1)>(vb);
    const s16x4 l2 = att::tr_read<v_rd_off64(D0, 2, 0)>(vb), h2 = att::tr_read<v_rd_off64(D0, 2, 1)>(vb), l3 = att::tr_read<v_rd_off64(D0, 3, 0)>(vb), h3 = att::tr_read<v_rd_off64(D0, 3, 1)>(vb);
    asm volatile("s_waitcnt lgkmcnt(0)" ::: "memory"); SBAR();
    f0 = SCN_PK(l0, h0); f1 = SCN_PK(l1, h1); f2 = SCN_PK(l2, h2); f3 = SCN_PK(l3, h3);
}
DEV bf16x8 pack8(const float (&v)[8]) { u32x4 w = {cvt_pk_bf16(v[0], v[1]), cvt_pk_bf16(v[2], v[3]), cvt_pk_bf16(v[4], v[5]), cvt_pk_bf16(v[6], v[7])}; return *reinterpret_cast<bf16x8*>(&w); }
DEV void stage64(char* img, const float* src, size_t ld, int lane, float sc = 1.f) {
    const float* row = src + (size_t)lane * ld;
#pragma unroll
    for (int c8 = 0; c8 < 8; ++c8) { const float4 a = *(const float4*)(row + c8 * 8), b = *(const float4*)(row + c8 * 8 + 4);
        u32x4 w = {cvt_pk_bf16(a.x * sc, a.y * sc), cvt_pk_bf16(a.z * sc, a.w * sc), cvt_pk_bf16(b.x * sc, b.y * sc), cvt_pk_bf16(b.z * sc, b.w * sc)};
        *(u32x4*)(img + v_st64(lane, c8 * 8)) = w; }
}
template <int CTRL, int RM> DEV float dpp_f(float oldv, float v, bool bc) { return bc ? __builtin_bit_cast(float, __builtin_amdgcn_update_dpp(__builtin_bit_cast(int, oldv), __builtin_bit_cast(int, v), CTRL, RM, 0xf, true))
                                                                                   : __builtin_bit_cast(float, __builtin_amdgcn_update_dpp(__builtin_bit_cast(int, oldv), __builtin_bit_cast(int, v), CTRL, RM, 0xf, false)); }
DEV float bperm(float v, int src) { return __builtin_bit_cast(float, __builtin_amdgcn_ds_bpermute(src << 2, __builtin_bit_cast(int, v))); }
DEV float scan_inc32(float v) {
    v += dpp_f<0x111, 0xf>(0.f, v, true); v += dpp_f<0x112, 0xf>(0.f, v, true); v += dpp_f<0x114, 0xf>(0.f, v, true); v += dpp_f<0x118, 0xf>(0.f, v, true);
    v += dpp_f<0x142, 0xa>(0.f, v, false);
    return v;
}
DEV float scanmax_inc32(float v) {
    const float ni = -3.0e38f;
    v = fmaxf(v, dpp_f<0x111, 0xf>(ni, v, false)); v = fmaxf(v, dpp_f<0x112, 0xf>(ni, v, false)); v = fmaxf(v, dpp_f<0x114, 0xf>(ni, v, false)); v = fmaxf(v, dpp_f<0x118, 0xf>(ni, v, false));
    v = fmaxf(v, dpp_f<0x142, 0xa>(ni, v, false));
    return v;
}
DEV float scanmax_suf32(float v, int lane) {
    const float ni = -3.0e38f;
    v = fmaxf(v, dpp_f<0x101, 0xf>(ni, v, false)); v = fmaxf(v, dpp_f<0x102, 0xf>(ni, v, false)); v = fmaxf(v, dpp_f<0x104, 0xf>(ni, v, false)); v = fmaxf(v, dpp_f<0x108, 0xf>(ni, v, false));
    const float t = bperm(v, (lane & 32) | 16);
    return (lane & 16) ? v : fmaxf(v, t);
}
DEV void ld8(const bf16_t* ub, unsigned boff, float (&v)[8]) { const u32x4 w = *(const u32x4*)((const char*)ub + boff);
    v[0] = __uint_as_float(w.x << 16); v[1] = __uint_as_float(w.x & 0xffff0000u); v[2] = __uint_as_float(w.y << 16); v[3] = __uint_as_float(w.y & 0xffff0000u);
    v[4] = __uint_as_float(w.z << 16); v[5] = __uint_as_float(w.z & 0xffff0000u); v[6] = __uint_as_float(w.w << 16); v[7] = __uint_as_float(w.w & 0xffff0000u); }
DEV float ld1(const bf16_t* ub, unsigned boff) { return __uint_as_float((unsigned)(*(const unsigned short*)((const char*)ub + boff)) << 16); }
DEV void stage64b(char* img, const bf16_t* src, size_t ld, int lane) {
    const bf16_t* row = src + (size_t)lane * ld;
#pragma unroll
    for (int c8 = 0; c8 < 8; ++c8) *(u32x4*)(img + v_st64(lane, c8 * 8)) = *(const u32x4*)(row + c8 * 8);
}
DEV float4 ldg4(const float* ub, unsigned boff) { return *(const float4*)((const char*)ub + boff); }
DEV float ldg1(const float* ub, unsigned boff) { return *(const float*)((const char*)ub + boff); }
DEV float fexp(float x) { return __expf(fminf(fmaxf(x, -80.f), 80.f)); }
DEV float fsig(float x) { return __builtin_amdgcn_rcpf(1.f + __expf(-x)); }
DEV void decay_ks(const float (&x)[2][8], const float (&lb)[8], int dir, int lane, float (&cum)[2][8], float (&kk)[2][8], float (&ref)[8]) {
#pragma unroll
    for (int tb = 0; tb < 2; ++tb)
#pragma unroll
        for (int j = 0; j < 8; ++j) { const float sg = fsig(x[tb][j]); kk[tb][j] = (1.f - lb[j]) * (1.f - sg); cum[tb][j] = __logf(fmaxf(lb[j] + (1.f - lb[j]) * sg, 1e-12f)); }
#pragma unroll
    for (int j = 0; j < 8; ++j) {
        const float i0 = scan_inc32(cum[0][j]), i1 = scan_inc32(cum[1][j]), t0 = bperm(i0, lane | 31), t1 = bperm(i1, lane | 31);
        if (dir == 0) { cum[0][j] = i0; cum[1][j] = i1 + t0; ref[j] = t0; }
        else { const float x0 = cum[0][j], x1 = cum[1][j]; cum[1][j] = t1 - i1 + x1; cum[0][j] = t0 - i0 + x0 + t1; ref[j] = t1; }
        if ((j & 3) == 3) SBAR();
    }
}
}

DEV void scanA_local(const Params& p, int layer, char* Lw, int bh, int tc, int lane) {
    using namespace scn;
    asm volatile("" : "+v"(lane));
    const int r32 = lane & 31, hi = lane >> 5, b = bh >> 2, h = bh & 3;
    const bf16_t* base = (const bf16_t*)(p.ws + OFF_PB) + (size_t)(b * SL + 64 * tc) * DP;
    unsigned lo = (unsigned)(r32 * DP + 8 * hi) * 2u;
    asm volatile("" : "+v"(lo));
    char* imgV = Lw; char* imgK = Lw + 8192;
    const int vbV = (int)(uintptr_t)imgV + att::v_rd_base(lane), vbK = vbV + 8192;
    stage64b(imgV, base + O_AI + h * 64, DP, lane);
#pragma unroll 1
    for (int dir = 0; dir < 2; ++dir) {
        const int chain = bh * 2 + dir, c = dir == 0 ? tc : (tc < 4 ? 3 - tc : 39 - tc);
#pragma unroll 1
        for (int ks = 0; ks < 4; ++ks) {
            const int ch = 16 * ks + 8 * hi;
            float x[2][8], cum[2][8], kk[2][8], ref[8], lb[8];
#pragma unroll
            for (int tb = 0; tb < 2; ++tb) ld8(base + (dir ? O_AFB : O_AFF) + h * 64 + 16 * ks, lo + tb * (32u * DP * 2u), x[tb]);
            { const float* l = (const float*)(p.ws + OFF_LB) + (layer * 2 + dir) * 256 + h * 64 + ch;
#pragma unroll
              for (int j = 0; j < 8; ++j) lb[j] = l[j]; }
            decay_ks(x, lb, dir, lane, cum, kk, ref);
            float ke[8];
#pragma unroll
            for (int tb = 0; tb < 2; ++tb) {
#pragma unroll
                for (int j = 0; j < 8; ++j) { const float ce = dir == 0 ? bperm(cum[1][j], lane | 31) : bperm(cum[0][j], lane & 32);
                    ke[j] = kk[tb][j] * fexp(ce - cum[tb][j]);
                    if (tb == 1 && dir == 0 && r32 == 31) ((float*)(p.ws + OFF_DECA))[(chain * 36 + c) * 64 + ch + j] = __expf(ce);
                    if (tb == 0 && dir == 1 && r32 == 0) ((float*)(p.ws + OFF_DECA))[(chain * 36 + c) * 64 + ch + j] = __expf(ce); }
                *(bf16x8*)(imgK + v_st64(32 * tb + r32, ch)) = pack8(ke);
            }
            SBAR();
        }
        f32x16 u[2][2] = {};
        { bf16x8 k0, k1, k2, k3, v0, v1, v2, v3;
          frags4<0>(vbK, k0, k1, k2, k3); frags4<0>(vbV, v0, v1, v2, v3);
          u[0][0] = __builtin_amdgcn_mfma_f32_32x32x16_bf16(k0, v0, u[0][0], 0, 0, 0); u[0][0] = __builtin_amdgcn_mfma_f32_32x32x16_bf16(k1, v1, u[0][0], 0, 0, 0);
          u[0][0] = __builtin_amdgcn_mfma_f32_32x32x16_bf16(k2, v2, u[0][0], 0, 0, 0); u[0][0] = __builtin_amdgcn_mfma_f32_32x32x16_bf16(k3, v3, u[0][0], 0, 0, 0);
          bf16x8 w0, w1, w2, w3; frags4<1>(vbV, w0, w1, w2, w3);
          u[0][1] = __builtin_amdgcn_mfma_f32_32x32x16_bf16(k0, w0, u[0][1], 0, 0, 0); u[0][1] = __builtin_amdgcn_mfma_f32_32x32x16_bf16(k1, w1, u[0][1], 0, 0, 0);
          u[0][1] = __builtin_amdgcn_mfma_f32_32x32x16_bf16(k2, w2, u[0][1], 0, 0, 0); u[0][1] = __builtin_amdgcn_mfma_f32_32x32x16_bf16(k3, w3, u[0][1], 0, 0, 0);
          frags4<1>(vbK, k0, k1, k2, k3);
          u[1][0] = __builtin_amdgcn_mfma_f32_32x32x16_bf16(k0, v0, u[1][0], 0, 0, 0); u[1][0] = __builtin_amdgcn_mfma_f32_32x32x16_bf16(k1, v1, u[1][0], 0, 0, 0);
          u[1][0] = __builtin_amdgcn_mfma_f32_32x32x16_bf16(k2, v2, u[1][0], 0, 0, 0); u[1][0] = __builtin_amdgcn_mfma_f32_32x32x16_bf16(k3, v3, u[1][0], 0, 0, 0);
          u[1][1] = __builtin_amdgcn_mfma_f32_32x32x16_bf16(k0, w0, u[1][1], 0, 0, 0); u[1][1] = __builtin_amdgcn_mfma_f32_32x32x16_bf16(k1, w1, u[1][1], 0, 0, 0);
          u[1][1] = __builtin_amdgcn_mfma_f32_32x32x16_bf16(k2, w2, u[1][1], 0, 0, 0); u[1][1] = __builtin_amdgcn_mfma_f32_32x32x16_bf16(k3, w3, u[1][1], 0, 0, 0); }
        float* U = (float*)(p.ws + OFF_UA) + ((size_t)chain * 36 + c) * 4096;
#pragma unroll
        for (int kb = 0; kb < 2; ++kb)
#pragma unroll
            for (int d0 = 0; d0 < 2; ++d0)
#pragma unroll
                for (int r = 0; r < 16; ++r) U[(32 * kb + crow(r, hi)) * 64 + 32 * d0 + r32] = u[kb][d0][r];
    }
}
DEV void scanA_out(const Params& p, int layer, char* Lw, int bh, int tc, int lane) {
    using namespace scn;
    asm volatile("" : "+v"(lane));
    const int r32 = lane & 31, hi = lane >> 5, b = bh >> 2, h = bh & 3;
    const bf16_t* base = (const bf16_t*)(p.ws + OFF_PB) + (size_t)(b * SL + 64 * tc) * DP;
    unsigned lo = (unsigned)(r32 * DP + 8 * hi) * 2u;
    asm volatile("" : "+v"(lo));
    char* imgV = Lw; char* imgS = Lw + 8192;
    const int vbV = (int)(uintptr_t)imgV + att::v_rd_base(lane), vbS = vbV + 8192;
    stage64b(imgV, base + O_AI + h * 64, DP, lane);
    f32x16 o[2][2] = {};
#pragma unroll 1
    for (int dir = 0; dir < 2; ++dir) {
        const int chain = bh * 2 + dir, c = dir == 0 ? tc : (tc < 4 ? 3 - tc : 39 - tc);
        const float* S0g = (const float*)(p.ws + OFF_SA) + ((size_t)chain * 36 + c) * 4096;
        f32x16 pd0 = {}, pd1 = {}, px = {};
#define MM(acc, A, B) acc = __builtin_amdgcn_mfma_f32_32x32x16_bf16(A, B, acc, 0, 0, 0)
#define LOADX(ks) do { _Pragma("unroll") for (int tb = 0; tb < 2; ++tb) ld8(base + (dir ? O_AFB : O_AFF) + h * 64 + 16 * (ks), lo + tb * (32u * DP * 2u), xr[tb]); } while (0)
#define LOADQ(ks) do { _Pragma("unroll") for (int tb = 0; tb < 2; ++tb) ld8(base + O_AQ + h * 64 + 16 * (ks), lo + tb * (32u * DP * 2u), qr[tb]); } while (0)
        float xr[2][8], qr[2][8];
#define KSTEP(ks) do { \
            const int ch = 16 * (ks) + 8 * hi; \
            float cum[2][8], kk[2][8], ref[8], lb[8]; \
            { const float* l = (const float*)(p.ws + OFF_LB) + (layer * 2 + dir) * 256 + h * 64 + ch; _Pragma("unroll") for (int j = 0; j < 8; ++j) lb[j] = l[j]; } \
            const int ci = lane >> 2; const int row = 16 * (ks) + ci, c16 = (lane & 3) * 16; const float* sp = S0g + row * 64 + c16; \
            LOADX(ks); LOADQ(ks); decay_ks(xr, lb, dir, lane, cum, kk, ref); \
            const float4 sa = *(const float4*)sp, sb4 = *(const float4*)(sp + 4), sc4 = *(const float4*)(sp + 8), sd4 = *(const float4*)(sp + 12); \
              \
            { const int sj = ci & 7, sl = (ci >> 3) * 32; float rv = 0.f; \
              _Pragma("unroll") for (int j = 0; j < 8; ++j) { const float t = bperm(ref[j], sl); rv = (sj == j) ? t : rv; } \
              const float er = __expf(fmaxf(rv, -80.f)); \
              u32x4 w0 = {cvt_pk_bf16(sa.x * er, sa.y * er), cvt_pk_bf16(sa.z * er, sa.w * er), cvt_pk_bf16(sb4.x * er, sb4.y * er), cvt_pk_bf16(sb4.z * er, sb4.w * er)}; \
              u32x4 w1 = {cvt_pk_bf16(sc4.x * er, sc4.y * er), cvt_pk_bf16(sc4.z * er, sc4.w * er), cvt_pk_bf16(sd4.x * er, sd4.y * er), cvt_pk_bf16(sd4.z * er, sd4.w * er)}; \
              *(u32x4*)(imgS + v_st64(row, c16)) = w0; *(u32x4*)(imgS + v_st64(row, c16 + 8)) = w1; } \
            bf16x8 qt0, qt1, kt0, kt1; \
            _Pragma("unroll") for (int tb = 0; tb < 2; ++tb) { \
                float t1[8], t2[8]; \
                _Pragma("unroll") for (int j = 0; j < 8; ++j) { const float q = qr[tb][j] * fsig(qr[tb][j]); t1[j] = q * fexp(cum[tb][j] - ref[j]); t2[j] = kk[tb][j] * fexp(ref[j] - cum[tb][j]); } \
                if (tb == 0) { qt0 = pack8(t1); kt0 = pack8(t2); } else { qt1 = pack8(t1); kt1 = pack8(t2); } } \
            MM(pd0, kt0, qt0); MM(pd1, kt1, qt1); if (dir == 0) MM(px, kt0, qt1); else MM(px, kt1, qt0); \
            { const s16x4 l0 = att::tr_read<v_rd_off64(0, ks, 0)>(vbS), h0 = att::tr_read<v_rd_off64(0, ks, 1)>(vbS), l1 = att::tr_read<v_rd_off64(1, ks, 0)>(vbS), h1 = att::tr_read<v_rd_off64(1, ks, 1)>(vbS); \
              asm volatile("s_waitcnt lgkmcnt(0)" ::: "memory"); SBAR(); \
              const bf16x8 s0 = SCN_PK(l0, h0), s1 = SCN_PK(l1, h1); \
              MM(o[0][0], qt0, s0); MM(o[1][0], qt1, s0); MM(o[0][1], qt0, s1); MM(o[1][1], qt1, s1); } \
            SBAR(); } while (0)
        KSTEP(0); KSTEP(1); KSTEP(2); KSTEP(3);
#undef KSTEP
#undef LOADX
#undef LOADQ
        const int r32m = r32;
#pragma unroll
        for (int r = 0; r < 16; ++r) { const int sl = crow(r, hi); const bool keep = dir == 0 ? (sl <= r32m) : (sl >= r32m); pd0[r] = keep ? pd0[r] : 0.f; pd1[r] = keep ? pd1[r] : 0.f; }
        bf16x8 a0, a1, b0, b1, c0, c1;
#define PK4(P, BASE, OUT) do { unsigned a0_ = cvt_pk_bf16(P[BASE + 0], P[BASE + 1]), a1_ = cvt_pk_bf16(P[BASE + 2], P[BASE + 3]);   \
    unsigned b0_ = cvt_pk_bf16(P[BASE + 4], P[BASE + 5]), b1_ = cvt_pk_bf16(P[BASE + 6], P[BASE + 7]);                              \
    auto r0_ = __builtin_amdgcn_permlane32_swap(a0_, b0_, false, false); auto r1_ = __builtin_amdgcn_permlane32_swap(a1_, b1_, false, false); \
    u32x4 w_ = {r0_[0], r1_[0], r0_[1], r1_[1]}; OUT = *reinterpret_cast<bf16x8*>(&w_); } while (0)
        PK4(pd0, 0, a0); PK4(pd0, 8, a1); PK4(pd1, 0, b0); PK4(pd1, 8, b1); PK4(px, 0, c0); PK4(px, 8, c1);
#undef PK4
        {   bf16x8 v0, v1, v2, v3;
#define BLOCK(D0) do { frags4<D0>(vbV, v0, v1, v2, v3); \
            if (dir == 0) { MM(o[0][D0], a0, v0); MM(o[0][D0], a1, v1); MM(o[1][D0], c0, v0); MM(o[1][D0], c1, v1); MM(o[1][D0], b0, v2); MM(o[1][D0], b1, v3); } \
            else          { MM(o[0][D0], a0, v0); MM(o[0][D0], a1, v1); MM(o[0][D0], c0, v2); MM(o[0][D0], c1, v3); MM(o[1][D0], b0, v2); MM(o[1][D0], b1, v3); } } while (0)
            BLOCK(0); BLOCK(1);
#undef BLOCK
        }
#undef MM
    }
    unsigned rob = (unsigned)(4 * hi * DP + r32) * 2u, mob = (unsigned)(4 * hi * D + r32) * 2u;
    asm volatile("" : "+v"(rob), "+v"(mob));
    float gv[2][16][2];
#pragma unroll
    for (int tb = 0; tb < 2; ++tb)
#pragma unroll
        for (int r = 0; r < 16; ++r) { const unsigned go = rob + (unsigned)(32 * tb + (r & 3) + 8 * (r >> 2)) * (DP * 2u); const bf16_t* gb = base + O_AG + h * 64;
            gv[tb][r][0] = ld1(gb, go); gv[tb][r][1] = ld1(gb, go + 64u); }
#pragma unroll
    for (int tb = 0; tb < 2; ++tb)
#pragma unroll
        for (int r = 0; r < 16; ++r) {
            const float x0 = o[tb][0][r], x1 = o[tb][1][r];
            float t = x0 * x0 + x1 * x1; t += bperm(t, lane ^ 1); t += bperm(t, lane ^ 2); t += bperm(t, lane ^ 4); t += bperm(t, lane ^ 8); t += bperm(t, lane ^ 16);
            const float ri = rsqrtf(t * (1.f / 64.f) + 1e-6f);
            const unsigned tcst = (unsigned)(32 * tb + (r & 3) + 8 * (r >> 2));
            const float g0 = gv[tb][r][0], g1 = gv[tb][r][1];
            char* mb = (char*)((bf16_t*)(p.ws + OFF_MIXB) + (size_t)(b * SL + 64 * tc) * D + h * 64); const unsigned mo = mob + tcst * (D * 2u);
            *(bf16_t*)(mb + mo) = (bf16_t)(cvt_pk_bf16(x0 * ri * p.hnorm[layer * 64 + r32] * (g0 * fsig(g0)), 0.f) & 0xffffu);
            *(bf16_t*)(mb + mo + 64u) = (bf16_t)(cvt_pk_bf16(x1 * ri * p.hnorm[layer * 64 + 32 + r32] * (g1 * fsig(g1)), 0.f) & 0xffffu);
        }
}

namespace scn {
DEV float logsig_f(float g) { return fminf(g, 0.f) - __logf(1.f + __expf(-fabsf(g))); }
DEV void gates_B(const bf16_t* gb  , unsigned rowoff, int dir, float bi, float bf, int lane, float (&cumf)[2], float (&g)[2], float (&G)[2], float& cend, float& gmax) {
    float lf[2], li[2];
#pragma unroll
    for (int tb = 0; tb < 2; ++tb) { const unsigned bo = rowoff + tb * (32u * DP * 2u); li[tb] = ld1(gb + (dir * 2 + 0) * 4, bo) + bi; lf[tb] = logsig_f(ld1(gb + (dir * 2 + 1) * 4, bo) + bf); }
    { const float i0 = scan_inc32(lf[0]), i1 = scan_inc32(lf[1]), t0 = bperm(i0, lane | 31), t1 = bperm(i1, lane | 31);
      if (dir == 0) { cumf[0] = i0; cumf[1] = i1 + t0; } else { cumf[1] = t1 - i1 + lf[1]; cumf[0] = t0 - i0 + lf[0] + t1; }
      cend = t0 + t1; }
    g[0] = li[0] - cumf[0]; g[1] = li[1] - cumf[1];
    if (dir == 0) { const float a0 = scanmax_inc32(g[0]), m0 = bperm(a0, lane | 31), a1 = fmaxf(scanmax_inc32(g[1]), m0); G[0] = a0; G[1] = a1; gmax = bperm(a1, lane | 31); }
    else { const float a1 = scanmax_suf32(g[1], lane), m1 = bperm(a1, lane & 32), a0 = fmaxf(scanmax_suf32(g[0], lane), m1); G[0] = a0; G[1] = a1; gmax = bperm(a0, lane & 32); }
}
}
DEV void scanB_local(const Params& p, int layer, char* Lw, int bh, int tc, int lane) {
    using namespace scn;
    asm volatile("" : "+v"(lane));
    const int r32 = lane & 31, hi = lane >> 5, b = bh >> 2, h = bh & 3;
    const bf16_t* base = (const bf16_t*)(p.ws + OFF_PB) + (size_t)(b * SL + 64 * tc) * DP;
    unsigned ro = (unsigned)(r32 * DP) * 2u; asm volatile("" : "+v"(ro));
    char* imgV = Lw; char* imgK = Lw + 8192;
    const int vbV = (int)(uintptr_t)imgV + att::v_rd_base(lane), vbK = vbV + 8192;
    stage64b(imgV, base + O_BV + h * 64, DP, lane);
#pragma unroll 1
    for (int dir = 0; dir < 2; ++dir) {
        const int chain = bh * 2 + dir, c = dir == 0 ? tc : (tc < 4 ? 3 - tc : 39 - tc);
        const float bi = p.mgb[layer * 16 + (dir * 2 + 0) * 4 + h], bf = p.mgb[layer * 16 + (dir * 2 + 1) * 4 + h];
        float cumf[2], g[2], G[2], cend, gmax;
        gates_B(base + O_BG + h, ro, dir, bi, bf, lane, cumf, g, G, cend, gmax);
        const float w[2] = {__expf(g[0] - gmax), __expf(g[1] - gmax)};
#pragma unroll
        for (int ks = 0; ks < 2; ++ks) {
            float un[8];
#pragma unroll
            for (int j = 0; j < 8; ++j) un[j] = 0.f;
#pragma unroll
            for (int tb = 0; tb < 2; ++tb) { float wk[8]; ld8(base + O_BK + h * 32 + 16 * ks, ro + 16u * hi + tb * (32u * DP * 2u), wk);
#pragma unroll
                for (int j = 0; j < 8; ++j) { wk[j] *= w[tb]; un[j] += wk[j]; }
                *(bf16x8*)(imgK + v_st64(32 * tb + r32, 16 * ks + 8 * hi)) = pack8(wk); }
#pragma unroll
            for (int j = 0; j < 8; ++j) { float t = un[j]; t += bperm(t, lane ^ 1); t += bperm(t, lane ^ 2); t += bperm(t, lane ^ 4); t += bperm(t, lane ^ 8); t += bperm(t, lane ^ 16);
                if (r32 == 0) ((float*)(p.ws + OFF_NB))[(chain * 36 + c) * 32 + 16 * ks + 8 * hi + j] = t; }
        }
        f32x16 u0 = {}, u1 = {};
        { bf16x8 k0, k1, k2, k3, v0, v1, v2, v3;
#define MM(acc, A, B) acc = __builtin_amdgcn_mfma_f32_32x32x16_bf16(A, B, acc, 0, 0, 0)
          frags4<0>(vbK, k0, k1, k2, k3); frags4<0>(vbV, v0, v1, v2, v3);
          MM(u0, k0, v0); MM(u0, k1, v1); MM(u0, k2, v2); MM(u0, k3, v3);
          frags4<1>(vbV, v0, v1, v2, v3);
          MM(u1, k0, v0); MM(u1, k1, v1); MM(u1, k2, v2); MM(u1, k3, v3);
#undef MM
        }
        float* U = (float*)(p.ws + OFF_UB) + ((size_t)chain * 36 + c) * 2048;
#pragma unroll
        for (int r = 0; r < 16; ++r) { U[crow(r, hi) * 64 + r32] = u0[r]; U[crow(r, hi) * 64 + 32 + r32] = u1[r]; }
        if (lane == 0) { float* M = (float*)(p.ws + OFF_MB) + (chain * 36 + c) * 4; M[0] = cend + gmax; M[1] = cend; }
    }
}
DEV void scanB_out(const Params& p, int layer, char* Lw, int bh, int tc, int lane) {
    using namespace scn;
    asm volatile("" : "+v"(lane));
    const int r32 = lane & 31, hi = lane >> 5, b = bh >> 2, h = bh & 3;
    const bf16_t* base = (const bf16_t*)(p.ws + OFF_PB) + (size_t)(b * SL + 64 * tc) * DP;
    unsigned ro = (unsigned)(r32 * DP) * 2u; asm volatile("" : "+v"(ro));
    char* imgV = Lw; char* imgC = Lw + 8192; float* gA = (float*)(Lw + 12288); float* dA = gA + 64;
    const int vbV = (int)(uintptr_t)imgV + att::v_rd_base(lane), vbC = vbV + 8192;
    stage64b(imgV, base + O_BV + h * 64, DP, lane);
#pragma unroll 1
    for (int dir = 0; dir < 2; ++dir) {
        const int chain = bh * 2 + dir, c = dir == 0 ? tc : (tc < 4 ? 3 - tc : 39 - tc);
        const float bi = p.mgb[layer * 16 + (dir * 2 + 0) * 4 + h], bf = p.mgb[layer * 16 + (dir * 2 + 1) * 4 + h];
        { const float* cg = (const float*)(p.ws + OFF_SB) + ((size_t)chain * 36 + c) * 2048 + (lane >> 1) * 64 + (lane & 1) * 32;
#pragma unroll
          for (int i = 0; i < 4; ++i) { const float4 a = *(const float4*)(cg + 8 * i), bq = *(const float4*)(cg + 8 * i + 4);
              u32x4 w = {cvt_pk_bf16(a.x, a.y), cvt_pk_bf16(a.z, a.w), cvt_pk_bf16(bq.x, bq.y), cvt_pk_bf16(bq.z, bq.w)};
              *(u32x4*)(imgC + v_st64(lane >> 1, (lane & 1) * 32 + 8 * i)) = w; } }
        const float m0 = ((const float*)(p.ws + OFF_MB))[(chain * 36 + c) * 4 + 2];
        float rq[2][2][8], rk[2][2][8];
#pragma unroll
        for (int ks = 0; ks < 2; ++ks)
#pragma unroll
            for (int tb = 0; tb < 2; ++tb) { const unsigned bo = ro + 16u * hi + tb * (32u * DP * 2u);
                ld8(base + O_BQ + h * 32 + 16 * ks, bo, rq[ks][tb]); ld8(base + O_BK + h * 32 + 16 * ks, bo, rk[ks][tb]); }
        float cumf[2], g[2], G[2], cend, gmax;
        gates_B(base + O_BG + h, ro, dir, bi, bf, lane, cumf, g, G, cend, gmax);
        float wi[2], wl[2], emt[2];
#pragma unroll
        for (int tb = 0; tb < 2; ++tb) { const float ml = cumf[tb] + G[tb], mt = fmaxf(cumf[tb] + m0, ml); wi[tb] = __expf(cumf[tb] + m0 - mt); wl[tb] = __expf(ml - mt); emt[tb] = __expf(-mt); }
        if (hi == 0) { gA[r32] = g[0]; gA[32 + r32] = g[1]; }
        f32x16 pd0 = {}, pd1 = {}, px = {};
        float qn[2] = {0.f, 0.f};
        bf16x8 qw[2][2];
#define MM(acc, A, B) acc = __builtin_amdgcn_mfma_f32_32x32x16_bf16(A, B, acc, 0, 0, 0)
#define KSTEP(ks) do { \
            bf16x8 qs0, qs1, kt0, kt1; \
            const float* nn = (const float*)(p.ws + OFF_N0) + (chain * 36 + c) * 32 + 16 * (ks) + 8 * hi; \
            _Pragma("unroll") for (int tb = 0; tb < 2; ++tb) { \
                float q8[8], k8[8], qv[8]; \
                _Pragma("unroll") for (int j = 0; j < 8; ++j) { q8[j] = rq[ks][tb][j] * 0.17677669529663687f; k8[j] = rk[ks][tb][j]; qn[tb] += q8[j] * nn[j]; qv[j] = q8[j] * wi[tb]; } \
                qw[tb][ks] = pack8(qv); \
                if (tb == 0) { qs0 = pack8(q8); kt0 = pack8(k8); } else { qs1 = pack8(q8); kt1 = pack8(k8); } } \
            MM(pd0, kt0, qs0); MM(pd1, kt1, qs1); if (dir == 0) MM(px, kt0, qs1); else MM(px, kt1, qs0); \
            SBAR(); } while (0)
        KSTEP(0); KSTEP(1);
#undef KSTEP
        qn[0] += bperm(qn[0], lane ^ 32); qn[1] += bperm(qn[1], lane ^ 32);
        float ds[2] = {0.f, 0.f};
#pragma unroll
        for (int r = 0; r < 16; ++r) {
            const int sl = crow(r, hi); const bool keep = dir == 0 ? (sl <= r32) : (sl >= r32);
            const float g0 = gA[sl], g1 = gA[32 + sl];
            const float e00 = keep ? __expf(g0 - G[0]) * wl[0] : 0.f, e11 = keep ? __expf(g1 - G[1]) * wl[1] : 0.f;
            const float ex = dir == 0 ? __expf(g0 - G[1]) * wl[1] : __expf(g1 - G[0]) * wl[0];
            pd0[r] *= e00; pd1[r] *= e11; px[r] *= ex;
            if (dir == 0) { ds[0] += pd0[r]; ds[1] += pd1[r] + px[r]; } else { ds[0] += pd0[r] + px[r]; ds[1] += pd1[r]; }
        }
        ds[0] += bperm(ds[0], lane ^ 32); ds[1] += bperm(ds[1], lane ^ 32);
#pragma unroll
        for (int tb = 0; tb < 2; ++tb) { const float den = wi[tb] * qn[tb] + ds[tb]; const float di = __builtin_amdgcn_rcpf(fmaxf(fabsf(den), emt[tb])); if (hi == 0) dA[32 * tb + r32] = di; }
        bf16x8 a0, a1, b0, b1, c0, c1;
#define PK4(P, BASE, OUT) do { unsigned a0_ = cvt_pk_bf16(P[BASE + 0], P[BASE + 1]), a1_ = cvt_pk_bf16(P[BASE + 2], P[BASE + 3]);   \
    unsigned b0_ = cvt_pk_bf16(P[BASE + 4], P[BASE + 5]), b1_ = cvt_pk_bf16(P[BASE + 6], P[BASE + 7]);                              \
    auto r0_ = __builtin_amdgcn_permlane32_swap(a0_, b0_, false, false); auto r1_ = __builtin_amdgcn_permlane32_swap(a1_, b1_, false, false); \
    u32x4 w_ = {r0_[0], r1_[0], r0_[1], r1_[1]}; OUT = *reinterpret_cast<bf16x8*>(&w_); } while (0)
        PK4(pd0, 0, a0); PK4(pd0, 8, a1); PK4(pd1, 0, b0); PK4(pd1, 8, b1); PK4(px, 0, c0); PK4(px, 8, c1);
#undef PK4
        SBAR();
        f32x16 o[2][2] = {};
        {   bf16x8 v0, v1, v2, v3;
#define BLOCK(D0) do { frags4<D0>(vbV, v0, v1, v2, v3); \
            if (dir == 0) { MM(o[0][D0], a0, v0); MM(o[0][D0], a1, v1); MM(o[1][D0], c0, v0); MM(o[1][D0], c1, v1); MM(o[1][D0], b0, v2); MM(o[1][D0], b1, v3); } \
            else          { MM(o[0][D0], a0, v0); MM(o[0][D0], a1, v1); MM(o[0][D0], c0, v2); MM(o[0][D0], c1, v3); MM(o[1][D0], b0, v2); MM(o[1][D0], b1, v3); } \
            { const s16x4 l0 = att::tr_read<v_rd_off64(D0, 0, 0)>(vbC), h0 = att::tr_read<v_rd_off64(D0, 0, 1)>(vbC), l1 = att::tr_read<v_rd_off64(D0, 1, 0)>(vbC), h1 = att::tr_read<v_rd_off64(D0, 1, 1)>(vbC); \
              asm volatile("s_waitcnt lgkmcnt(0)" ::: "memory"); SBAR(); \
              const bf16x8 s0 = SCN_PK(l0, h0), s1 = SCN_PK(l1, h1); \
              MM(o[0][D0], qw[0][0], s0); MM(o[0][D0], qw[0][1], s1); MM(o[1][D0], qw[1][0], s0); MM(o[1][D0], qw[1][1], s1); } } while (0)
            BLOCK(0); BLOCK(1);
#undef BLOCK
        }
#undef MM
        asm volatile("s_waitcnt lgkmcnt(0)" ::: "memory");
        unsigned rob = (unsigned)(4 * hi * DP + r32) * 2u, mob = (unsigned)(4 * hi * D + r32) * 2u, hob = (unsigned)(4 * hi * 256 + r32) * 4u;
        asm volatile("" : "+v"(rob), "+v"(mob), "+v"(hob));
        float* hpk = (float*)(p.ws + OFF_HB2) + (size_t)(b * SL + 64 * tc) * 256 + h * 64;
        if (dir == 0) {
#pragma unroll
            for (int tb = 0; tb < 2; ++tb)
#pragma unroll
                for (int r = 0; r < 16; ++r) { const float di = dA[32 * tb + crow(r, hi)]; const unsigned ho = hob + (unsigned)(32 * tb + (r & 3) + 8 * (r >> 2)) * 1024u;
                    *(float*)((char*)hpk + ho) = o[tb][0][r] * di; *(float*)((char*)hpk + ho + 128u) = o[tb][1][r] * di; }
            asm volatile("s_waitcnt vmcnt(0)" ::: "memory");
        } else {
#pragma unroll
            for (int tb = 0; tb < 2; ++tb)
#pragma unroll
                for (int r = 0; r < 16; ++r) {
                    const unsigned tcst = (unsigned)(32 * tb + (r & 3) + 8 * (r >> 2)); const unsigned ho = hob + tcst * 1024u;
                    const float di = dA[32 * tb + crow(r, hi)];
                    const float x0 = o[tb][0][r] * di + ldg1(hpk, ho), x1 = o[tb][1][r] * di + ldg1(hpk, ho + 128u);
                    float t = x0 * x0 + x1 * x1; t += bperm(t, lane ^ 1); t += bperm(t, lane ^ 2); t += bperm(t, lane ^ 4); t += bperm(t, lane ^ 8); t += bperm(t, lane ^ 16);
                    const float ri = rsqrtf(t * (1.f / 64.f) + 1e-6f);
                    const bf16_t* gb = base + O_BO + h * 64; const unsigned go = rob + tcst * (DP * 2u);
                    const float g0 = ld1(gb, go), g1 = ld1(gb, go + 64u);
                    char* mb = (char*)((bf16_t*)(p.ws + OFF_MIXB) + (size_t)(b * SL + 64 * tc) * D + 256 + h * 64); const unsigned mo = mob + tcst * (D * 2u);
                    *(bf16_t*)(mb + mo) = (bf16_t)(cvt_pk_bf16(x0 * ri * p.mnorm[layer * 256 + h * 64 + r32] * fsig(g0), 0.f) & 0xffffu);
                    *(bf16_t*)(mb + mo + 64u) = (bf16_t)(cvt_pk_bf16(x1 * ri * p.mnorm[layer * 256 + h * 64 + 32 + r32] * fsig(g1), 0.f) & 0xffffu);
                    if ((r & 3) == 3) SBAR();
                }
        }
    }
}

DEV int scan_token(int dir, int step) { return dir == 0 ? step : (step < CTX ? CTX - 1 - step : SL + CTX - 1 - step); }
DEV float logsig(float g) { return fminf(g, 0.f) - log1pf(expf(-fabsf(g))); }
DEV void ph_scan_local(const Params& p, int layer, char* smem) {
    const int wid = p.wave_id;
    const int G = (int)gridDim.x, nw = G * 8, nun = (NT / 256) * (DP / 256), nleft = 4 * G < nun ? nun - 4 * G : 0, nfree = G - nleft > 0 ? G - nleft : G;
    for (int it = 0; it < 2; ++it) {
        int task;
        if (it == 0) task = (int)blockIdx.x * 8 + wid;
        else { if ((int)blockIdx.x >= nfree) break; task = nw + wid * nfree + (int)blockIdx.x; }
        if (task >= 2304) break;
        const int lane = lane_asm();
        if (task < 1152) scanA_local(p, layer, smem + wid * 16384, task / 36, task % 36, lane);
        else scanB_local(p, layer, smem + wid * 16384, (task - 1152) / 36, (task - 1152) % 36, lane);
    }
}
DEV void ph_scan_carry(const Params& p, char* smem) {
    const int tid = tid_of(p.wave_id);
    const int gt = (int)blockIdx.x * 512 + tid, nth = (int)gridDim.x * 512;
    for (int e = gt; e < 64 * 4096; e += nth) {
        const int chain = e >> 12, kv = e & 4095, k = kv >> 6;
        const float* U = (const float*)(p.ws + OFF_UA) + (size_t)chain * 36 * 4096 + kv; float* SO = (float*)(p.ws + OFF_SA) + (size_t)chain * 36 * 4096 + kv; const float* Dc = (const float*)(p.ws + OFF_DECA) + chain * 36 * 64 + k;
        float S = 0.f;
#pragma unroll 4
        for (int c = 0; c < 36; ++c) { const float u = U[(size_t)c * 4096], d = Dc[c * 64]; SO[(size_t)c * 4096] = S; S = d * S + u; }
    }
    for (int e = gt; e < 64 * 2048; e += nth) {
        const int chain = e >> 11, kv = e & 2047;
        const float* U = (const float*)(p.ws + OFF_UB) + (size_t)chain * 36 * 2048 + kv; float* SO = (float*)(p.ws + OFF_SB) + (size_t)chain * 36 * 2048 + kv; const float* M = (const float*)(p.ws + OFF_MB) + chain * 36 * 4;
        float Cc = 0.f, m = 0.f;
#pragma unroll 4
        for (int c = 0; c < 36; ++c) { const float mle = M[c * 4 + 0], ce = M[c * 4 + 1], u = U[(size_t)c * 2048]; SO[(size_t)c * 2048] = Cc;
            const float mn = fmaxf(ce + m, mle); Cc = expf(ce + m - mn) * Cc + expf(mle - mn) * u; m = mn; }
    }
    for (int e = gt; e < 64 * 32; e += nth) {
        const int chain = e >> 5, k = e & 31;
        const float* N = (const float*)(p.ws + OFF_NB) + chain * 36 * 32 + k; float* NO = (float*)(p.ws + OFF_N0) + chain * 36 * 32 + k; float* M = (float*)(p.ws + OFF_MB) + chain * 36 * 4;
        float nn = 0.f, m = 0.f;
        for (int c = 0; c < 36; ++c) { const float mle = M[c * 4 + 0], ce = M[c * 4 + 1], u = N[c * 32]; NO[c * 32] = nn; if (k == 0) M[c * 4 + 2] = m;
            const float mn = fmaxf(ce + m, mle); nn = expf(ce + m - mn) * nn + expf(mle - mn) * u; m = mn; }
    }
}
DEV void ph_scan_out(const Params& p, int layer, char* smem) {
    const int wid = p.wave_id;
    const int nw = (int)gridDim.x * 8, ntc = layer == 0 ? 36 : 32, tc0 = layer == 0 ? 0 : 4, half = 32 * ntc, total = 2 * half;
    for (int it = 0; it < 2 + (total - nw > 0 ? (total - nw) / (int)gridDim.x : 0); ++it) {
        int task;
        if (it == 0) task = (int)blockIdx.x * 8 + wid;
        else { if (wid != 0) break; task = nw + (it - 1) * (int)gridDim.x + (int)blockIdx.x; }
        if (task >= total) break;
        const int lane = lane_asm();
        const bool isB = task >= half; const int tt = isB ? task - half : task, bh = tt / ntc, tc = tc0 + tt % ntc;
        if (!isB) scanA_out(p, layer, smem + wid * 16384, bh, tc, lane);
        else scanB_out(p, layer, smem + wid * 16384, bh, tc, lane);
    }
}

DEV void ph_attn(const Params& p, int layer, char* smem) {
    const int wid = p.wave_id, js = wid & 1, qb = wid >> 1;
    const float lam = ((const float*)(p.ws + OFF_LAM))[layer], omli = 1.f - lam_init_of(layer);
    const bf16_t* KB = (const bf16_t*)(p.ws + OFF_KB); const bf16_t* VB = (const bf16_t*)(p.ws + OFF_VB);
    const bf16_t* QRB = (const bf16_t*)(p.ws + OFF_QRB); const bf16_t* Q0B = (const bf16_t*)(p.ws + OFF_Q0B);
    const int G = (int)gridDim.x, c = (int)blockIdx.x;
    const int nlat = 512, ntot = nlat + (layer == 0 ? 64 : 0);
    for (int i = 0;; ++i) {
        int bh, s0; bool isctx;
        if (G == 256) {
            const int xcd = c & 7, j = c >> 3;
            if (i < 2) { bh = xcd + 8 * (i * 2 + (j >> 4)); s0 = CTX + (j & 15) * 128; isctx = false; }
            else if (i == 2 && layer == 0 && j < 8) { bh = xcd + 8 * (j >> 1); s0 = (j & 1) * 128; isctx = true; }
            else break;
        } else {
            const int u = i * G + c; if (u >= ntot) break;
            if (u < nlat) { bh = u >> 4; s0 = CTX + (u & 15) * 128; isctx = false; } else { const int v = u - nlat; bh = v >> 1; s0 = (v & 1) * 128; isctx = true; }
        }
        const int lane = lane_asm(), tid = (wid << 6) | lane, r32 = lane & 31, hi = lane >> 5;
        const bf16_t* Kh = KB + (size_t)bh * SL * 128; const bf16_t* Vh = VB + (size_t)bh * SL * 128;
        const size_t qoff = ((size_t)bh * SL + s0 + qb * 32 + r32) * 128 + js * 64 + hi * 8;
        att::bf16x8 qr[4];
#pragma unroll
        for (int d0 = 0; d0 < 4; ++d0) qr[d0] = *(const att::bf16x8*)(Q0B + qoff + d0 * 16);
        float m_reg = -1e30f, l_reg = 0.f; att::f32x16 o[4] = {};
        att::attn_tiles(qr, Kh, Vh, CTX, smem, m_reg, l_reg, o, tid, js);
        if (!isctx) {
#pragma unroll
            for (int d0 = 0; d0 < 4; ++d0) qr[d0] = *(const att::bf16x8*)(QRB + qoff + d0 * 16);
            att::attn_tiles(qr, Kh + (size_t)CTX * 128, Vh + (size_t)CTX * 128, SEQ, smem, m_reg, l_reg, o, tid, js);
        }
        float* wsw = (float*)(smem + 2 * att::SHM_V + 2 * att::SHM_K) + wid * 64;
        __syncthreads();
        if (hi == 0) wsw[r32] = l_reg;
        asm volatile("s_waitcnt lgkmcnt(0)" ::: "memory");
        float rli[16];
#pragma unroll
        for (int r = 0; r < 16; ++r) rli[r] = __builtin_amdgcn_rcpf(wsw[att::crow(r, hi)]);
        float* X = (float*)smem + qb * 4096;
        if (js == 1) {
#pragma unroll
            for (int d0 = 0; d0 < 4; ++d0)
#pragma unroll
                for (int r = 0; r < 16; ++r) X[(d0 * 16 + r) * 64 + lane] = o[d0][r] * rli[r];
        }
        __syncthreads();
        if (js == 0) {
            const int b = bh >> 2, h = bh & 3;
            float ss[16];
#pragma unroll
            for (int r = 0; r < 16; ++r) ss[r] = 0.f;
#pragma unroll
            for (int d0 = 0; d0 < 4; ++d0)
#pragma unroll
                for (int r = 0; r < 16; ++r) { const float v = o[d0][r] * rli[r] - lam * X[(d0 * 16 + r) * 64 + lane]; o[d0][r] = v; ss[r] += v * v; }
#pragma unroll
            for (int r = 0; r < 16; ++r) { float t = ss[r]; t += __shfl_xor(t, 1); t += __shfl_xor(t, 2); t += __shfl_xor(t, 4); t += __shfl_xor(t, 8); t += __shfl_xor(t, 16);
                ss[r] = rsqrtf(t * (1.f / 128.f) + 1e-6f) * omli; }
            bf16_t* Tq = (bf16_t*)X;
#pragma unroll
            for (int d0 = 0; d0 < 4; ++d0) { const float g = p.dnorm[layer * 128 + d0 * 32 + r32];
#pragma unroll
                for (int r = 0; r < 16; ++r) Tq[att::crow(r, hi) * 128 + d0 * 32 + r32] = (bf16_t)(cvt_pk_bf16(o[d0][r] * ss[r] * g, 0.f) & 0xffffu); }
            char* mixb = (char*)((bf16_t*)(p.ws + OFF_MIXB) + (size_t)(b * SL + s0 + qb * 32) * D + 512 + h * 128);
#pragma unroll
            for (int k = 0; k < 8; ++k) { const int idx = lane + 64 * k, row = idx >> 4, ch = idx & 15;
                *(pg8::u32x4*)(mixb + (size_t)row * (D * 2) + ch * 16) = *(const pg8::u32x4*)((const char*)Tq + row * 256 + ch * 16); }
        }
        __syncthreads();
    }
}

struct EpiRowsBf16 {
    static constexpr bool PERM = true;
    bf16_t* O; int ldc;
    DEV void operator()(const pg8::f32x4 (&acc)[2][2][4][2], const pg8::Unit& u, int wr, int wc, int fr, int fq) const {
        const int row0 = u.pm * 256 + wr * 64 + fr, col0 = u.pn * 256 + wc * 32 + 8 * fq;
#pragma unroll
        for (int ai = 0; ai < 2; ++ai)
#pragma unroll
            for (int m = 0; m < 4; ++m) { bf16_t* rowp = O + (size_t)(row0 + ai * 128 + m * 16) * ldc + col0;
#pragma unroll
                for (int bj = 0; bj < 2; ++bj) { const pg8::f32x4 v0 = acc[ai][bj][m][0], v1 = acc[ai][bj][m][1];
                    pg8::u32x4 w; w.x = cvt_pk_bf16(v0[0], v0[1]); w.y = cvt_pk_bf16(v0[2], v0[3]); w.z = cvt_pk_bf16(v1[0], v1[1]); w.w = cvt_pk_bf16(v1[2], v1[3]);
                    *(pg8::u32x4*)(rowp + bj * 128) = w; } }
    }
};
DEV void ph_outproj(const Params& p, int layer, char* smem) {
    const int tidx = tid_of(p.wave_id);
    pg8::StaticOrder S; S.init(layer == 0 ? NT / 256 : NB * 8, D / 256, (int)gridDim.x, (int)blockIdx.x, layer == 0 ? 0 : 1, (const bf16_t*)(p.ws + OFF_WOUT) + (size_t)layer * D * D, D);
    EpiRowsBf16 E{(bf16_t*)(p.ws + OFF_MIXO), D};
    pg8::gemm_phase((LAS unsigned char*)smem, (const char*)(p.ws + OFF_MIXB), D, S, E, tid_of(p.wave_id));
}
DEV void ph_norm2(const Params& p, int layer, char* smem) {
    typedef float f32x16 __attribute__((ext_vector_type(16)));
    const int wid = p.wave_id, lane = lane_asm(), tidx = (wid << 6) | lane;
    constexpr int XP = 1028, RP = 24;
    float* xs = (float*)smem;
    float* red = (float*)smem;
    int* hist = (int*)(smem + 32 * XP * 4);
    int* offl = hist + 32;
    int* sel = hist + 64;
    const float* nr = p.norms + (size_t)layer * 4 * D;
    if (tidx < NE) hist[tidx] = 0;
    const int chunk = (NT + (int)gridDim.x - 1) / (int)gridDim.x, rbeg = (int)blockIdx.x * chunk, rend = min(NT, rbeg + chunk);
    for (int i = tidx; i < chunk * 4; i += 512) sel[i] = -1;
    float wreg[64];
    { const float* wb = p.rw + (size_t)layer * D * NE + (size_t)(wid * 128 + (lane >> 5)) * NE + (lane & 31);
#pragma unroll
      for (int ks = 0; ks < 64; ++ks) wreg[ks] = wb[(size_t)2 * ks * NE]; }
    for (int r0 = rbeg; r0 < rend; r0 += RP) {
        __syncthreads();
#pragma unroll 1
        for (int j = 0; j < 3; ++j) {
            const int lr = wid * 3 + j, r = r0 + lr;
            if (r >= rend) continue;
            const int b = r / SL, s = r % SL;
            if (layer != 0 && s < CTX) continue;
            const float* m = modrow(p, layer, b, s);
            float4 mo[4], xv[4], o[4]; row_load_bf((const bf16_t*)(p.ws + OFF_MIXO) + (size_t)r * D, mo, lane); row_load_bf((const bf16_t*)(p.ws + OFF_X) + (size_t)r * D, xv, lane);
            const float ri = row_rinv(mo);
#pragma unroll
            for (int i = 0; i < 4; ++i) { const int idx = i * 256 + lane * 4; const float4 g = *(const float4*)(nr + D + idx), gt = *(const float4*)(m + 2048 + idx);
                xv[i].x += gt.x * (mo[i].x * ri * g.x); xv[i].y += gt.y * (mo[i].y * ri * g.y); xv[i].z += gt.z * (mo[i].z * ri * g.z); xv[i].w += gt.w * (mo[i].w * ri * g.w); }
            row_store_bf16((bf16_t*)(p.ws + OFF_XN) + (size_t)r * D, xv, lane);
            row_modnorm(xv, nr + 2 * D, m + 3072, m + 4096, o, lane);
            row_store_fp8((unsigned char*)(p.ws + OFF_XNB) + (size_t)r * D, o, lane, F8_SX);
            row_store(xs + lr * XP, o, lane);
        }
        __syncthreads();
        f32x16 acc = {};
        { const float* xa = xs + (lane & 31) * XP + wid * 128 + (lane >> 5);
#pragma unroll
          for (int ks = 0; ks < 64; ++ks) acc = __builtin_amdgcn_mfma_f32_32x32x2f32(xa[2 * ks], wreg[ks], acc, 0, 0, 0); }
        __syncthreads();
#pragma unroll
        for (int rg = 0; rg < 16; ++rg) red[(wid * 32 + (rg & 3) + 8 * (rg >> 2) + 4 * (lane >> 5)) * 32 + (lane & 31)] = acc[rg];
        __syncthreads();
#pragma unroll 1
        for (int j = 0; j < 3; ++j) {
            const int lr = wid * 3 + j, r = r0 + lr;
            if (r >= rend) continue;
            const int s = r % SL;
            if (layer != 0 && s < CTX) continue;
            const int e = lane & 31;
            float logit = p.rb[layer * NE + e];
#pragma unroll
            for (int w = 0; w < 8; ++w) logit += red[(w * 32 + lr) * 32 + e];
            float tv[4]; int ti[4];
#pragma unroll
            for (int k = 0; k < 4; ++k) {
                float bv = logit; int bi = e;
                for (int o2 = 16; o2 >= 1; o2 >>= 1) { const float ov = __shfl_xor(bv, o2); const int oi = __shfl_xor(bi, o2); if (ov > bv || (ov == bv && oi < bi)) { bv = ov; bi = oi; } }
                tv[k] = bv; ti[k] = bi; if (e == bi) logit = -3.0e38f;
            }
            const float e0 = 1.f, e1 = expf(tv[1] - tv[0]), e2 = expf(tv[2] - tv[0]), e3 = expf(tv[3] - tv[0]), inv = 1.f / (e0 + e1 + e2 + e3);
            if (lane == 0) { *(float4*)(((float*)(p.ws + OFF_TOPW)) + (size_t)r * 4) = make_float4(e0 * inv, e1 * inv, e2 * inv, e3 * inv); *(int4*)(((int*)(p.ws + OFF_TOPI)) + (size_t)r * 4) = make_int4(ti[0], ti[1], ti[2], ti[3]); }
            if (lane < 4) { const int es = lane == 0 ? ti[0] : lane == 1 ? ti[1] : lane == 2 ? ti[2] : ti[3]; atomicAdd(&hist[es], 1); sel[(r - rbeg) * 4 + lane] = es; }
        }
    }
    __syncthreads();
    if (tidx < NE) { const int h = hist[tidx]; offl[tidx] = h ? (int)__hip_atomic_fetch_add((unsigned*)(p.ws + OFF_bar) + CW_CNT + layer * NE + tidx, (unsigned)h, __ATOMIC_RELAXED, __HIP_MEMORY_SCOPE_AGENT) : 0; }
    __syncthreads();
    for (int i = tidx; i < (rend - rbeg) * 4; i += 512) { const int e = sel[i];
        if (e >= 0) { const int pos = atomicAdd(&offl[e], 1); ((int*)(p.ws + OFF_LIST))[(size_t)e * LISTCAP + pos] = rbeg * 4 + i; } }
}
DEV int moe_rt(int i, int G, int c, int npn, int& pn) {
    if (G == 256) { const int xcd = c & 7, j = c >> 3, rpx = 32 / npn; pn = j % npn; return (i * 8 + xcd) * rpx + j / npn; }
    const int L = i * G + c; pn = L % npn; return L / npn;
}
constexpr int MOE_LDS = 131072, MOE_MAXU = 12;
DEV void moe_prepare(const Params& p, int layer, char* smem, int npn, int mode) {
    const int tidx = tid_of(p.wave_id);
    LAS int* base = (LAS int*)(smem + MOE_LDS);
    LAS int *TE = base, *TT = base + 320, *NRT = base + 640, *CN = base + 656  , *UI = base + 704, *IDX = base + 768;
    if (tidx < NE) CN[tidx] = ((const int*)(p.ws + OFF_bar))[CW_CNT + layer * NE + tidx];
    __syncthreads();
    if (tidx < 320) { int e = 0, acc = 0; for (; e < NE; ++e) { const int n = (CN[e] + 255) >> 8; if (tidx < acc + n) break; acc += n; } TE[tidx] = e; TT[tidx] = tidx - acc; }
    if (tidx == 0) { int tot = 0; for (int e = 0; e < NE; ++e) tot += (CN[e] + 255) >> 8; NRT[0] = tot; }
    __syncthreads();
    const int nrt = NRT[0];
#pragma unroll
    for (int k = 0; k < (MOE_MAXU * 256) / 512; ++k) {
        const int idx = tidx + 512 * k, i = idx >> 8, row = idx & 255;
        int pn; const int rt = moe_rt(i, (int)gridDim.x, (int)blockIdx.x, npn, pn);
        if (rt < nrt) { const int e = TE[rt], t = TT[rt], c = CN[e], q = t * 256 + row;
            const int pair = ((const int*)(p.ws + OFF_LIST))[(size_t)e * LISTCAP + min(q, c - 1)];
            IDX[idx] = mode == 1 ? (pair >> 2) : (q < c ? pair : -1); }
    }
    if (tidx < MOE_MAXU) { int pn; const int rt = moe_rt(tidx, (int)gridDim.x, (int)blockIdx.x, npn, pn);
        if (rt < nrt) { const int e = TE[rt], t = TT[rt], c = CN[e]; int pre = 0; for (int z = 0; z < e; ++z) pre += CN[z]; UI[tidx * 4 + 0] = min(256, c - t * 256); UI[tidx * 4 + 1] = pre + t * 256; } }
    __syncthreads();
}
struct MoeOrder {
    const LAS int *te, *ui, *idx; int nrt, npn, G, c, gather; const char* Bt; size_t bstride; int K;
    DEV bool next(int i, pg8::Unit& u) const { int pn; const int rt = moe_rt(i, G, c, npn, pn); if (rt >= nrt || i >= MOE_MAXU) return false;
        u.pm = rt; u.pn = pn; u.e = __builtin_amdgcn_readfirstlane(te[rt]); u.t = i; return true; }
    DEV int arow(const pg8::Unit& u, int rr) const { return gather ? idx[u.t * 256 + rr] : ui[u.t * 4 + 1] + rr; }
    DEV const char* bbase(const pg8::Unit& u) const { return Bt + (size_t)u.e * bstride + (size_t)u.pn * pg8::BM * K * 2; }
};
DEV float swiglu(float g, float l) { g = fminf(g, 7.f); l = fminf(fmaxf(l, -7.f), 7.f); return g * __builtin_amdgcn_rcpf(1.f + __builtin_amdgcn_exp2f(-1.702f * 1.4426950408889634f * g)) * (l + 1.f); }
struct EpiSwiglu {
    static constexpr bool PERM = true;
    unsigned char* H; const float* b1; const LAS int* ui;
    DEV void operator()(const pg8::f32x4 (&acc)[2][2][4][2], const pg8::Unit& u, int wr, int wc, int fr, int fq) const {
        const int ucnt = ui[u.t * 4 + 0], hrow0 = ui[u.t * 4 + 1], col0 = u.pn * 256 + wc * 32 + 8 * fq;
        const float* bb = b1 + (size_t)u.e * 2048 + col0;
        pg8::f32x4 bv[2][2];
#pragma unroll
        for (int bj = 0; bj < 2; ++bj)
#pragma unroll
            for (int n = 0; n < 2; ++n) bv[bj][n] = *(const pg8::f32x4*)(bb + bj * 128 + 4 * n);
        __builtin_amdgcn_s_waitcnt(0x0F70);
#pragma unroll
        for (int ai = 0; ai < 2; ++ai)
#pragma unroll
            for (int m = 0; m < 4; ++m) { const int rr = ai * 128 + wr * 64 + m * 16 + fr;
                if (rr < ucnt) { unsigned char* rowp = H + (size_t)(hrow0 + rr) * DFF + (col0 >> 1);
#pragma unroll
                    for (int bj = 0; bj < 2; ++bj) { constexpr float DS = 1.f / (F8_SX * F8_SW); const pg8::f32x4 v0 = acc[ai][bj][m][0] * DS + bv[bj][0], v1 = acc[ai][bj][m][1] * DS + bv[bj][1];
                        *(unsigned*)(rowp + bj * 64) = pk4_fp8(F8_SH * swiglu(v0[0], v0[1]), F8_SH * swiglu(v0[2], v0[3]), F8_SH * swiglu(v1[0], v1[1]), F8_SH * swiglu(v1[2], v1[3])); } } }
    }
};
struct EpiY {
    static constexpr bool PERM = true;
    bf16_t* Y; const LAS int* idx;
    DEV void operator()(const pg8::f32x4 (&acc)[2][2][4][2], const pg8::Unit& u, int wr, int wc, int fr, int fq) const {
        const int col0 = u.pn * 256 + wc * 32 + 8 * fq;
#pragma unroll
        for (int ai = 0; ai < 2; ++ai)
#pragma unroll
            for (int m = 0; m < 4; ++m) { const int rr = ai * 128 + wr * 64 + m * 16 + fr; const int pair = idx[u.t * 256 + rr];
                if (pair >= 0) { bf16_t* rowp = Y + (size_t)pair * D + col0;
#pragma unroll
                    for (int bj = 0; bj < 2; ++bj) { constexpr float DS = 1.f / (F8_SH * F8_SW); const pg8::f32x4 v0 = acc[ai][bj][m][0] * DS, v1 = acc[ai][bj][m][1] * DS;
                        pg8::u32x4 w; w.x = cvt_pk_bf16(v0[0], v0[1]); w.y = cvt_pk_bf16(v0[2], v0[3]); w.z = cvt_pk_bf16(v1[0], v1[1]); w.w = cvt_pk_bf16(v1[2], v1[3]);
                        *(pg8::u32x4*)(rowp + bj * 128) = w; } } }
    }
};
DEV void ph_moe1(const Params& p, int layer, char* smem) {
    moe_prepare(p, layer, smem, 8, 1);
    LAS int* base = (LAS int*)(smem + MOE_LDS);
    MoeOrder S{base, base + 704, base + 768, base[640], 8, (int)gridDim.x, (int)blockIdx.x, 1, (const char*)(p.ws + OFF_W1T) + (size_t)layer * NE * 2048 * D, (size_t)2048 * D, D / 2};
    EpiSwiglu E{(unsigned char*)(p.ws + OFF_H), p.b1 + (size_t)layer * NE * 2048, base + 704};
    pg8::gemm_phase<EpiSwiglu, MoeOrder, true>((LAS unsigned char*)smem, (const char*)(p.ws + OFF_XNB), D / 2, S, E, tid_of(p.wave_id));
}
DEV void ph_moe2(const Params& p, int layer, char* smem) {
    moe_prepare(p, layer, smem, 4, 2);
    LAS int* base = (LAS int*)(smem + MOE_LDS);
    MoeOrder S{base, base + 704, base + 768, base[640], 4, (int)gridDim.x, (int)blockIdx.x, 0, (const char*)(p.ws + OFF_W2T) + (size_t)layer * NE * D * DFF, (size_t)D * DFF, DFF / 2};
    EpiY E{(bf16_t*)(p.ws + OFF_Y), base + 768};
    pg8::gemm_phase<EpiY, MoeOrder, true>((LAS unsigned char*)smem, (const char*)(p.ws + OFF_H), DFF / 2, S, E, tid_of(p.wave_id));
}
DEV void ph_combine(const Params& p, int layer, char* smem) {
    const int wid = p.wave_id, lane = lane_asm();
    const float* nr = p.norms + (size_t)layer * 4 * D;
    const int total = layer == 0 ? NT : NB * SEQ, stride = (int)gridDim.x * 8;
    for (int q0 = (int)blockIdx.x * 8 + wid; q0 < total; q0 += 2 * stride) {
        int rr[2]; bool ok[2]; float4 tw[2]; int4 ti[2];
#pragma unroll
        for (int u = 0; u < 2; ++u) { const int q = q0 + u * stride; ok[u] = q < total; const int qq = ok[u] ? q : q0;
            rr[u] = layer == 0 ? qq : (qq / SEQ) * SL + CTX + qq % SEQ;
            tw[u] = *(const float4*)(((float*)(p.ws + OFF_TOPW)) + (size_t)rr[u] * 4); ti[u] = *(const int4*)(((int*)(p.ws + OFF_TOPI)) + (size_t)rr[u] * 4); }
        float4 f[2][4], xv[2][4];
#pragma unroll
        for (int u = 0; u < 2; ++u) {
            const int r = rr[u];
            const float w[4] = {tw[u].x, tw[u].y, tw[u].z, tw[u].w}; const int ei[4] = {ti[u].x, ti[u].y, ti[u].z, ti[u].w};
#pragma unroll
            for (int i = 0; i < 4; ++i) f[u][i] = make_float4(0.f, 0.f, 0.f, 0.f);
#pragma unroll
            for (int k = 0; k < 4; ++k) {
                const bf16_t* y = (const bf16_t*)(p.ws + OFF_Y) + ((size_t)r * 4 + k) * D; const float* bb = p.b2 + ((size_t)layer * NE + ei[k]) * D;
#pragma unroll
                for (int i = 0; i < 4; ++i) { const int idx = i * 256 + lane * 4; const pg8::u32x2 yb = *(const pg8::u32x2*)(y + idx); const float4 bv = *(const float4*)(bb + idx);
                    const float y0 = __uint_as_float(yb.x << 16), y1 = __uint_as_float(yb.x & 0xffff0000u), y2 = __uint_as_float(yb.y << 16), y3 = __uint_as_float(yb.y & 0xffff0000u);
                    f[u][i].x += w[k] * (y0 + bv.x); f[u][i].y += w[k] * (y1 + bv.y); f[u][i].z += w[k] * (y2 + bv.z); f[u][i].w += w[k] * (y3 + bv.w); }
            }
            row_load_bf((const bf16_t*)(p.ws + OFF_XN) + (size_t)r * D, xv[u], lane);
        }
#pragma unroll
        for (int u = 0; u < 2; ++u) {
            const int r = rr[u], b = r / SL, s = r % SL;
            const float* m = modrow(p, layer, b, s);
            const float ri = row_rinv(f[u]);
#pragma unroll
            for (int i = 0; i < 4; ++i) { const int idx = i * 256 + lane * 4; const float4 g = *(const float4*)(nr + 3 * D + idx), gt = *(const float4*)(m + 5120 + idx);
                xv[u][i].x += gt.x * (f[u][i].x * ri * g.x); xv[u][i].y += gt.y * (f[u][i].y * ri * g.y); xv[u][i].z += gt.z * (f[u][i].z * ri * g.z); xv[u][i].w += gt.w * (f[u][i].w * ri * g.w); }
            if (ok[u]) {
                if (layer == 0) {
                    row_store_bf16((bf16_t*)(p.ws + OFF_X) + (size_t)r * D, xv[u], lane);
                    const float* m1 = modrow(p, 1, b, s); float4 o[4];
                    row_modnorm(xv[u], p.norms + (size_t)4 * D, m1 + 0, m1 + 1024, o, lane);
                    row_store_bf16((bf16_t*)(p.ws + OFF_XNB) + (size_t)r * D, o, lane);
                } else {
                    row_store(p.out + ((size_t)b * SEQ + (s - CTX)) * D, xv[u], lane);
                }
            }
        }
    }
}

template <int layer> DEV void run_layer(const Params& p, char* smem, const XcdBarrier& bar) {
#define GB() xcd_barrier(bar)

        ph_inproj(p, layer, smem, 0); GB();
        ph_inproj(p, layer, smem, 1); ph_scan_local(p, layer, smem); GB();
        ph_scan_carry(p, smem); ph_attn(p, layer, smem); GB();
        ph_scan_out(p, layer, smem); GB();
        ph_outproj(p, layer, smem); GB();
        ph_norm2(p, layer, smem); GB();
        ph_moe1(p, layer, smem); GB();
        ph_moe2(p, layer, smem); GB();
        ph_combine(p, layer, smem); GB();
    #undef GB
}
constexpr int LDS_BYTES = 147456;
__global__ __launch_bounds__(512, 2) void k_mega(Params p_in) {
    Params p = p_in; p.wave_id = __builtin_amdgcn_readfirstlane((int)(threadIdx.x >> 6));
    extern __shared__ __attribute__((aligned(16))) char smem[];
    volatile LAS unsigned* st = (volatile LAS unsigned*)(smem + LDS_BYTES - 16);
    if (threadIdx.x == 0) { st[0] = 0u; st[1] = 0u; st[2] = 0u; st[3] = 0u; }
    __syncthreads();
    const XcdBarrier bar = xcd_barrier_post(((unsigned*)(p.ws + OFF_bar)), st, p.wave_id);
#define GB() xcd_barrier(bar)
    ph_mods(p, smem); ph_convert(p, smem); GB();
    ph_init(p, smem); GB();
    run_layer<0>(p, smem, bar);
    run_layer<1>(p, smem, bar);
#undef GB
}
}

extern "C" void kernel_launch(void* const* d_in, const int* in_sizes, int n_in, void* d_out, int out_size, void* d_ws, size_t ws_size, hipStream_t stream) {
    static int grid = 0;
    if (grid == 0) {
        int dev = 0, cus = 0, per_cu = 0;
        if (hipGetDevice(&dev) != hipSuccess || hipDeviceGetAttribute(&cus, hipDeviceAttributeMultiprocessorCount, dev) != hipSuccess) { grid = -1; return; }
        if (hipFuncSetAttribute((const void*)k_mega, hipFuncAttributeMaxDynamicSharedMemorySize, LDS_BYTES) != hipSuccess) { grid = -1; return; }
        (void)hipOccupancyMaxActiveBlocksPerMultiprocessor(&per_cu, (const void*)k_mega, 512, LDS_BYTES);
        (void)hipGetLastError();
        grid = cus;
    }
    if (grid < 0) return;
    Params p{};
    const float** in = (const float**)&p;
    for (int i = 0; i < 21; ++i) in[i] = (const float*)d_in[i];
    p.out = (float*)d_out;
    p.ws = (char*)d_ws;
    if (WS_END > ws_size) return;
    if (hipMemsetAsync(p.ws + OFF_bar, 0, (size_t)CTL_BYTES, stream) != hipSuccess) return;
    hipLaunchKernelGGL(k_mega, dim3(grid), dim3(512), LDS_BYTES, stream, p);
}
```

```cpp
#include <hip/hip_runtime.h>
#include <stdint.h>

namespace {
constexpr int D = 1024, NB = 8, SEQ = 2048, CTX = 256, SL = 2304, NT = NB * SL;
constexpr int DP = 3840, DPW = 3600, NE = 32, DFF = 1024, NPAIR = NT * 4;
constexpr int O_AQ = 0, O_AI = 256, O_AFF = 512, O_AFB = 768, O_AG = 1024, O_BQ = 1280, O_BK = 1408, O_BV = 1536, O_BO = 1792, O_BG = 3584;
constexpr int LISTCAP = NT;

struct Params {
    const float *x, *c, *ctx, *c_ctx, *ada_w, *ada_b, *norms, *w_in, *w_out, *hlb, *hnorm, *mgb, *mnorm, *dlam, *dnorm, *rw, *rb, *w1, *b1, *w2, *b2;
    float* out;
    char* ws;
    int wave_id, pad_;
};
constexpr size_t al256(size_t x) { return (x + 255) & ~(size_t)255; }
constexpr size_t OFF_bar = 0;
constexpr size_t OFF_MOD = OFF_bar + 16384;
constexpr int CW_QHEAD = 3520, CW_CNT = 3584  , CTL_BYTES = 16384;
constexpr size_t OFF_LB = OFF_MOD + al256((size_t)2 * 9 * 6144 * 4);
constexpr size_t OFF_LAM = OFF_LB + al256(1024 * 4);
constexpr size_t OFF_CNT = OFF_LAM + 256;
constexpr size_t OFF_BC = OFF_CNT + 256;
constexpr size_t OFF_TOPW = OFF_BC + al256((size_t)1024 * NE * 4);
constexpr size_t OFF_TOPI = OFF_TOPW + al256((size_t)NPAIR * 4);
constexpr size_t OFF_LIST = OFF_TOPI + al256((size_t)NPAIR * 4);
constexpr size_t OFF_X = OFF_LIST + al256((size_t)NE * LISTCAP * 4);
constexpr size_t OFF_XN = OFF_X + al256((size_t)NT * D * 4);
constexpr size_t OFF_P = OFF_XN + al256((size_t)NT * D * 4);
constexpr size_t OFF_QR = OFF_P + al256((size_t)NT * DP * 4);
constexpr size_t OFF_KT = OFF_QR + al256((size_t)64 * SL * 64 * 4);
constexpr size_t OFF_OC = OFF_KT + al256((size_t)64 * SL * 64 * 4);
constexpr size_t OFF_MIX = OFF_OC + al256((size_t)32 * SL * 128 * 4);
constexpr size_t OFF_MIXO = OFF_MIX + al256((size_t)NT * D * 4);
constexpr size_t OFF_XNB = OFF_MIXO + al256((size_t)NT * D * 4);
constexpr size_t OFF_MIXB = OFF_XNB + al256((size_t)NT * D * 2);
constexpr size_t OFF_WIN = OFF_MIXB + al256((size_t)NT * D * 2);
constexpr size_t OFF_WOUT = OFF_WIN + al256((size_t)2 * DP * D * 2);
constexpr size_t OFF_W1T = OFF_WOUT + al256((size_t)2 * D * D * 2);
constexpr size_t OFF_W2T = OFF_W1T + al256((size_t)2 * NE * 2048 * D * 2);
constexpr size_t OFF_U = OFF_W2T + al256((size_t)2 * NE * D * DFF * 2);
constexpr size_t WS_END = OFF_U + al256((size_t)32 * SL * SL * 4);
constexpr size_t OFF_UA = OFF_U, OFF_DECA = OFF_UA + (size_t)64 * 36 * 4096 * 4, OFF_UB = OFF_DECA + (size_t)64 * 36 * 64 * 4, OFF_NB = OFF_UB + (size_t)64 * 36 * 2048 * 4,
                 OFF_MB = OFF_NB + (size_t)64 * 36 * 32 * 4, OFF_SCB = OFF_MB + (size_t)64 * 36 * 4 * 4,
                 OFF_OA2 = OFF_SCB + (size_t)2 * NT * 16 * 4, OFF_HB2 = OFF_OA2 + (size_t)NT * 256 * 4, OFF_SA = OFF_HB2 + (size_t)NT * 256 * 4, OFF_SB = OFF_SA + (size_t)64 * 36 * 4096 * 4,
                 OFF_N0 = OFF_SB + (size_t)64 * 36 * 2048 * 4;
constexpr size_t OFF_PB = OFF_P;
constexpr size_t OFF_ROPE = OFF_P + al256((size_t)NT * DP * 2);
constexpr size_t OFF_QRB = OFF_QR, OFF_Q0B = OFF_QR + (size_t)32 * SL * 128 * 2, OFF_KB = OFF_KT, OFF_VB = OFF_KT + (size_t)32 * SL * 128 * 2;
constexpr size_t OFF_S = OFF_U, OFF_H = OFF_U, OFF_Y = OFF_U + al256((size_t)(NPAIR + 256) * DFF * 2);
constexpr size_t OFF_OA = OFF_MIXO, OFF_HB = OFF_MIXO + (size_t)2 * NT * 256 * 4;


#define DEV __device__ __forceinline__
DEV int lane_asm() { int l; asm volatile("v_mbcnt_lo_u32_b32 %0, -1, 0\n\tv_mbcnt_hi_u32_b32 %0, -1, %0" : "=v"(l)); return l; }
DEV int tid_of(int wave_id) { return (wave_id << 6) | lane_asm(); }
DEV float wsum(float v) { for (int o = 32; o >= 1; o >>= 1) v += __shfl_xor(v, o); return v; }
DEV float wmaxf(float v) { for (int o = 32; o >= 1; o >>= 1) v = fmaxf(v, __shfl_xor(v, o)); return v; }
DEV float sigm(float x) { return 1.f / (1.f + expf(-x)); }
DEV float rdlane(float v, int l) { return __int_as_float(__builtin_amdgcn_readlane(__float_as_int(v), l)); }
DEV float lam_init_of(int layer) { return 0.8f - 0.6f * expf(-0.3f * (float)layer); }


#define XB_TMO      128
#define XB_XCNT(j)  (256  + 64 * (j))
#define XB_XSUB(j)  (1280 + 64 * (j))
#define XB_XGEN(j)  (2304 + 64 * (j))
#define XB_TOP      3328
#define XB_TOPGEN   3392
#define XCD_BAR_WORDS 3456
#define XB_SPIN_CAP (1u << 22)
#define LAS __attribute__((address_space(3)))
DEV unsigned xb_ld(unsigned* p)              { return __hip_atomic_load(p, __ATOMIC_RELAXED, __HIP_MEMORY_SCOPE_AGENT); }
DEV unsigned xb_add(unsigned* p, unsigned v) { return __hip_atomic_fetch_add(p, v, __ATOMIC_RELAXED, __HIP_MEMORY_SCOPE_AGENT); }
DEV unsigned xb_xcc_id() { return (unsigned)__builtin_amdgcn_s_getreg((3 << 11) | 20) & 0xFu; }
#define XB_SPIN(cond, bar) do { unsigned _sp = 0; while (cond) { __builtin_amdgcn_s_sleep(1); \
    if ((++_sp & 255u) == 0u) { if (xb_ld(&(bar)[XB_TMO])) break; if (_sp > XB_SPIN_CAP) { atomicAdd(&(bar)[XB_TMO], 1u); break; } } } } while (0)
struct XcdBarrier { unsigned* bar; unsigned x; volatile LAS unsigned* st; int wave; };
DEV bool xb_thread0(int wave) { return wave == 0 && lane_asm() == 0; }
DEV XcdBarrier xcd_barrier_post(unsigned* bar, volatile LAS unsigned* st, int wave) {
    XcdBarrier b; b.bar = bar; b.x = xb_xcc_id(); b.st = st; b.wave = wave;
    if (xb_thread0(wave)) (void)xb_add(&bar[XB_XCNT(b.x)], 1u);
    return b;
}
DEV void xcd_barrier_complete(unsigned* bar, unsigned x, unsigned& nloc, unsigned& nx) {
    const unsigned G = gridDim.x * gridDim.y * gridDim.z;
    unsigned sum, cnt, mine, sp = 0u;
    for (;;) {
        sum = 0u; cnt = 0u; mine = 0u;
#pragma unroll
        for (unsigned j = 0; j < 16; ++j) { const unsigned c = xb_ld(&bar[XB_XCNT(j)]); sum += c; cnt += (c > 0u) ? 1u : 0u; mine = (j == x) ? c : mine; }
        if (sum == G) break;
        __builtin_amdgcn_s_sleep(1);
        if ((++sp & 255u) == 0u) { if (xb_ld(&bar[XB_TMO])) break; if (sp > XB_SPIN_CAP) { atomicAdd(&bar[XB_TMO], 1u); break; } }
    }
    nloc = mine > 0u ? mine : 1u; nx = cnt > 0u ? cnt : 1u;
}
DEV void xcd_barrier(const XcdBarrier& b) {
    asm volatile("s_waitcnt vmcnt(0)" ::: "memory");
    __syncthreads();
    if (xb_thread0(b.wave)) {
        unsigned* bar = b.bar;
        __builtin_amdgcn_s_waitcnt(0);
        unsigned nloc = b.st[0], nx = b.st[1];
        if (nloc == 0u) { xcd_barrier_complete(bar, b.x, nloc, nx); b.st[0] = nloc; b.st[1] = nx; }
        const unsigned old = xb_add(&bar[XB_XSUB(b.x)], 1u);
        const unsigned gen = old / nloc;
        if (old + 1u == (gen + 1u) * nloc) {
            __builtin_amdgcn_fence(__ATOMIC_RELEASE, "agent");
            asm volatile("s_waitcnt vmcnt(0)" ::: "memory");
            const unsigned og = xb_add(&bar[XB_TOP], 1u);
            const unsigned tg = og / nx;
            if (og + 1u == (tg + 1u) * nx) xb_add(&bar[XB_TOPGEN], 1u);
            else XB_SPIN(xb_ld(&bar[XB_TOPGEN]) == tg, bar);
            __builtin_amdgcn_fence(__ATOMIC_ACQUIRE, "agent");
            xb_add(&bar[XB_XGEN(b.x)], 1u);
            asm volatile("s_waitcnt vmcnt(0)" ::: "memory");
        } else {
            XB_SPIN(xb_ld(&bar[XB_XGEN(b.x)]) == gen, bar);
            __builtin_amdgcn_fence(__ATOMIC_ACQUIRE, "agent");
            asm volatile("s_waitcnt vmcnt(0)" ::: "memory");
        }
    }
    __syncthreads();
}

typedef unsigned short bf16_t;
DEV unsigned cvt_pk_bf16(float lo, float hi) { unsigned r; asm volatile("v_cvt_pk_bf16_f32 %0, %1, %2" : "=v"(r) : "v"(lo), "v"(hi)); return r; }

namespace pg8 {
typedef short bf16x8 __attribute__((ext_vector_type(8)));
typedef float f32x4 __attribute__((ext_vector_type(4)));
typedef unsigned u32x4 __attribute__((ext_vector_type(4)));
typedef unsigned u32x2 __attribute__((ext_vector_type(2)));
constexpr int BM = 256, BK = 64, HALF = 128, HTB = HALF * BK * 2, STAGE_BYTES = 8 * HTB, NXCD = 8, WGM = 8;
DEV int lds_byte(int r, int c) { const int st = (r >> 4) * 2 + (c >> 5), rr = r & 15, cc = c & 31, ob = rr * 64 + cc * 2; return st * 1024 + (ob ^ (((ob >> 9) & 1) << 5)); }
DEV void stage_rc(int b, int& R, int& C) { const int st = b / 1024, sb = b % 1024, swz = sb ^ (((sb >> 9) & 1) << 5); R = (st >> 1) * 16 + swz / 64; C = (st & 1) * 32 + (swz % 64) / 2; }
DEV int perm32(int rho) { const int n = rho >> 4, i = rho & 15; return 8 * (i >> 2) + 4 * n + (i & 3); }
struct Unit { int pm, pn, e, t; };
struct StaticOrder {
    int nM, nN, nwg, G, c, skipctx; const char* Bt; int K;
    DEV void init(int nM_, int nN_, int G_, int c_, int skipctx_, const void* Bt_, int K_) { nM = nM_; nN = nN_; nwg = nM * nN; G = G_; c = c_; skipctx = skipctx_; Bt = (const char*)Bt_; K = K_; }
    DEV bool next(int i, Unit& u) const {
        const long L = (long)i * G + c; if (L >= nwg) return false;
        int wgid = (int)L; { const int q = nwg / NXCD, r = nwg % NXCD, xcd = wgid % NXCD, off = wgid / NXCD; wgid = (xcd < r ? xcd * (q + 1) : r * (q + 1) + (xcd - r) * q) + off; }
        const int nig = WGM * nN, gid = wgid / nig, fm = gid * WGM, gsz = (nM - fm) < WGM ? (nM - fm) : WGM;
        int pm = fm + ((wgid % nig) % gsz); u.pn = (wgid % nig) / gsz;
        if (skipctx) pm = (pm >> 3) * 9 + 1 + (pm & 7);
        u.pm = pm; u.e = 0; u.t = 0; return true;
    }
    DEV int arow(const Unit& u, int rr) const { return u.pm * BM + rr; }
    DEV const char* bbase(const Unit& u) const { return Bt + (size_t)u.pn * BM * K * 2; }
};
struct EpiF32 {
    static constexpr bool PERM = false;
    float* C; int ldc;
    DEV void operator()(const f32x4 (&acc)[2][2][4][2], const Unit& u, int wr, int wc, int fr, int fq) const {
        const int row0 = u.pm * BM + wr * 64 + fr, col0 = u.pn * BM + wc * 32 + 4 * fq;
#pragma unroll
        for (int ai = 0; ai < 2; ++ai)
#pragma unroll
            for (int m = 0; m < 4; ++m) { float* rowp = C + (size_t)(row0 + ai * HALF + m * 16) * ldc + col0;
#pragma unroll
                for (int bj = 0; bj < 2; ++bj)
#pragma unroll
                    for (int n = 0; n < 2; ++n) *(f32x4*)(rowp + bj * HALF + n * 16) = acc[ai][bj][m][n]; }
    }
};

typedef int i32x4 __attribute__((ext_vector_type(4)));
typedef int i32x8 __attribute__((ext_vector_type(8)));
DEV i32x8 cat8(bf16x8 a, bf16x8 b) { const i32x4 x = __builtin_bit_cast(i32x4, a), y = __builtin_bit_cast(i32x4, b); return __builtin_shufflevector(x, y, 0, 1, 2, 3, 4, 5, 6, 7); }
template <class Epi, class Sched, bool F8 = false>
DEV void gemm_phase(LAS unsigned char* lds, const char* Abase, const int K, const Sched& S, const Epi& E, const int tid) {
    const int wid = __builtin_amdgcn_readfirstlane(tid >> 6), lane = tid & 63, wr = wid >> 2, wc = wid & 3, fr = lane & 15, fq = lane >> 4;
    const int nt = K / BK;
    unsigned voffB[2];
#pragma unroll
    for (int i = 0; i < 2; ++i) { int R, C; stage_rc(tid * 16 + i * 8192, R, C); const int Rb = Epi::PERM ? ((R & ~31) + perm32(R & 31)) : R;
        voffB[i] = (unsigned)(Rb * BK + C) * 2u; }
    const size_t kstep = (size_t)(BK * 2);
    const size_t hstep = (size_t)HALF * K * 2;
    constexpr size_t kstepB = (size_t)BM * BK * 2, hstepB = (size_t)HALF * BK * 2;
    const unsigned ldsw = (unsigned)wid * 1024u;
    const int aoff = lds_byte(wr * 64 + fr, fq * 8), boff = lds_byte(wc * 32 + fr, fq * 8);
#define PG8_SA(b, h) (((b) * 2 + (h)) * HTB)
#define PG8_SB(b, h) ((4 + (b) * 2 + (h)) * HTB)
#define PG8_STAGE_B(bufoff, gbase) do { _Pragma("unroll") for (int _i = 0; _i < 2; ++_i) \
        __builtin_amdgcn_global_load_lds((const unsigned*)((const char*)(gbase) + voffB[_i]), (LAS unsigned*)(lds + (bufoff) + ldsw + _i * 8192), 16, 0, 0); } while (0)
#define PG8_STAGE_A(bufoff, kb, V, h) do { _Pragma("unroll") for (int _i = 0; _i < 2; ++_i) \
        __builtin_amdgcn_global_load_lds((const unsigned*)(Abase + (kb) + (V)[h][_i]), (LAS unsigned*)(lds + (bufoff) + ldsw + _i * 8192), 16, 0, 0); } while (0)
#define PG8_VOFFA(V, u) do { _Pragma("unroll") for (int _i = 0; _i < 2; ++_i) { int _R, _C; stage_rc(tid * 16 + _i * 8192, _R, _C); _Pragma("unroll") for (int _h = 0; _h < 2; ++_h) \
        (V)[_h][_i] = ((unsigned)S.arow(u, _h * HALF + _R) * (unsigned)K + (unsigned)_C) * 2u; } } while (0)
#define PG8_LDA(dst, b, h) do { _Pragma("unroll") for (int m = 0; m < 4; ++m) _Pragma("unroll") for (int k = 0; k < 2; ++k) dst[m][k] = *(const LAS bf16x8*)(lds + PG8_SA(b, h) + aoff + m * 2048 + k * 1024); } while (0)
#define PG8_LDB(dst, b, h) do { _Pragma("unroll") for (int n = 0; n < 2; ++n) _Pragma("unroll") for (int k = 0; k < 2; ++k) dst[n][k] = *(const LAS bf16x8*)(lds + PG8_SB(b, h) + boff + n * 2048 + k * 1024); } while (0)
#define PG8_MMA(ai, bj, At, Bt) do { __builtin_amdgcn_s_setprio(1); _Pragma("unroll") for (int m = 0; m < 4; ++m) _Pragma("unroll") for (int n = 0; n < 2; ++n) { \
        if constexpr (F8) asm volatile("v_mfma_f32_16x16x128_f8f6f4 %0, %1, %2, %0" : "+v"(acc[ai][bj][m][n]) : "v"(cat8(Bt[n][0], Bt[n][1])), "v"(cat8(At[m][0], At[m][1]))); \
        else { _Pragma("unroll") for (int k = 0; k < 2; ++k) acc[ai][bj][m][n] = __builtin_amdgcn_mfma_f32_16x16x32_bf16(Bt[n][k], At[m][k], acc[ai][bj][m][n], 0, 0, 0); } } __builtin_amdgcn_s_setprio(0); } while (0)
#define PG8_WAIT_V(n) asm volatile("s_waitcnt vmcnt(" #n ")" ::: "memory")
#define PG8_WAIT_L(n) asm volatile("s_waitcnt lgkmcnt(" #n ")" ::: "memory")
#define PG8_BAR __builtin_amdgcn_s_barrier()
#define PG8_SCHED __builtin_amdgcn_sched_barrier(0)
    Unit cur, nxt; int ui = 0;
    if (!S.next(0, cur)) return;
    f32x4 acc[2][2][4][2];
#pragma unroll
    for (int a = 0; a < 2; ++a)
#pragma unroll
        for (int b = 0; b < 2; ++b)
#pragma unroll
            for (int m = 0; m < 4; ++m)
#pragma unroll
                for (int n = 0; n < 2; ++n) acc[a][b][m][n] = (f32x4){0.f, 0.f, 0.f, 0.f};
    bf16x8 At[4][2], B0[2][2], B1[2][2];
    unsigned vc[2][2], v2[2][2];
    PG8_VOFFA(vc, cur);
    const char* cB = S.bbase(cur);
    PG8_STAGE_B(PG8_SB(0, 0), cB); PG8_STAGE_A(PG8_SA(0, 0), 0, vc, 0); PG8_STAGE_B(PG8_SB(0, 1), cB + hstepB); PG8_STAGE_A(PG8_SA(0, 1), 0, vc, 1);
    if (wr == 1) PG8_BAR;
    PG8_WAIT_V(4); PG8_BAR;
    PG8_STAGE_B(PG8_SB(1, 0), cB + kstepB); PG8_STAGE_A(PG8_SA(1, 0), kstep, vc, 0); PG8_STAGE_B(PG8_SB(1, 1), cB + hstepB + kstepB);
    PG8_WAIT_V(6); PG8_BAR;
    for (;;) {
        const bool has_next = S.next(ui + 1, nxt);
        const char* nB = has_next ? S.bbase(nxt) : cB;
        for (int t = 0; t < nt; t += 2) {
            const bool last = (t == nt - 2);
            const size_t k1 = (size_t)(t + 1) * kstep, k2 = last ? (size_t)0 : (size_t)(t + 2) * kstep, k3 = k2 + kstep;
            if (last && has_next) { PG8_VOFFA(v2, nxt); } else {
#pragma unroll
                for (int h = 0; h < 2; ++h)
#pragma unroll
                    for (int i = 0; i < 2; ++i) v2[h][i] = vc[h][i]; }
            const char* b2 = last ? nB : cB + (size_t)(t + 2) * kstepB; const char* b3 = b2 + kstepB;
            PG8_LDB(B0, 0, 0); PG8_SCHED; PG8_LDA(At, 0, 0); PG8_STAGE_A(PG8_SA(1, 1), k1, vc, 1);
            PG8_WAIT_L(8); PG8_BAR; PG8_WAIT_L(0); PG8_MMA(0, 0, At, B0); PG8_BAR; PG8_SCHED;
            PG8_LDB(B1, 0, 1); PG8_STAGE_B(PG8_SB(0, 0), b2);
            PG8_BAR; PG8_WAIT_L(0); PG8_MMA(0, 1, At, B1); PG8_BAR;
            PG8_LDA(At, 0, 1); PG8_STAGE_A(PG8_SA(0, 0), k2, v2, 0);
            PG8_BAR; PG8_WAIT_L(0); PG8_MMA(1, 0, At, B0); PG8_BAR; PG8_SCHED;
            PG8_STAGE_B(PG8_SB(0, 1), b2 + hstepB);
            PG8_WAIT_V(6); PG8_BAR; PG8_MMA(1, 1, At, B1); PG8_BAR;
            PG8_LDB(B0, 1, 0); PG8_SCHED; PG8_LDA(At, 1, 0); PG8_STAGE_A(PG8_SA(0, 1), k2, v2, 1);
            PG8_WAIT_L(8); PG8_BAR; PG8_WAIT_L(0); PG8_MMA(0, 0, At, B0); PG8_BAR; PG8_SCHED;
            PG8_LDB(B1, 1, 1); PG8_STAGE_B(PG8_SB(1, 0), b3);
            PG8_BAR; PG8_WAIT_L(0); PG8_MMA(0, 1, At, B1); PG8_BAR;
            PG8_LDA(At, 1, 1); PG8_STAGE_A(PG8_SA(1, 0), k3, v2, 0);
            PG8_BAR; PG8_WAIT_L(0); PG8_MMA(1, 0, At, B0); PG8_BAR; PG8_SCHED;
            PG8_STAGE_B(PG8_SB(1, 1), b3 + hstepB);
            PG8_WAIT_V(6); PG8_BAR; PG8_MMA(1, 1, At, B1); PG8_BAR;
        }
        if constexpr (F8) asm volatile("s_nop 15\n\ts_nop 15" ::: "memory");
        E(acc, cur, wr, wc, fr, fq);
        if (!has_next) break;
#pragma unroll
        for (int a = 0; a < 2; ++a)
#pragma unroll
            for (int b = 0; b < 2; ++b)
#pragma unroll
                for (int m = 0; m < 4; ++m)
#pragma unroll
                    for (int n = 0; n < 2; ++n) acc[a][b][m][n] = (f32x4){0.f, 0.f, 0.f, 0.f};
        cur = nxt; cB = nB; ++ui;
#pragma unroll
        for (int h = 0; h < 2; ++h)
#pragma unroll
            for (int i = 0; i < 2; ++i) vc[h][i] = v2[h][i];
    }
    PG8_WAIT_V(0);
    if (wr == 0) PG8_BAR;
    PG8_BAR;
#undef PG8_SA
#undef PG8_SB
#undef PG8_STAGE_A
#undef PG8_STAGE_B
#undef PG8_VOFFA
#undef PG8_LDA
#undef PG8_LDB
#undef PG8_MMA
#undef PG8_WAIT_V
#undef PG8_WAIT_L
#undef PG8_BAR
#undef PG8_SCHED
}
}


namespace att {
using bf16x8 = __attribute__((ext_vector_type(8))) short;
using s16x4  = __attribute__((ext_vector_type(4))) short;
using f32x16 = __attribute__((ext_vector_type(16))) float;
using u32x4  = __attribute__((ext_vector_type(4))) unsigned;
constexpr int KVBLK = 64, LDK = 128;
constexpr int SHM_V = KVBLK * 128 * 2, SHM_K = KVBLK * 128 * 2, SHM_ATTN = 2 * SHM_V + 2 * SHM_K + 8 * 64 * 4;
constexpr float THR = 8.f;
#define KSWZ(row, colB) ((row) * 256 + ((colB) ^ (((row) & 7) << 4)))
#define SBAR() __builtin_amdgcn_sched_barrier(0)
DEV int crow(int r, int hi) { return (r & 3) + 8 * (r >> 2) + 4 * hi; }
DEV void partialSM(f32x16& p0, f32x16& p1, float& m_reg, float& mn, float& alpha) {
  float pmax = p0[0]; for (int r = 1; r < 16; ++r) pmax = fmaxf(pmax, p0[r]); for (int r = 0; r < 16; ++r) pmax = fmaxf(pmax, p1[r]);
  { auto rr = __builtin_amdgcn_permlane32_swap(__float_as_uint(pmax), __float_as_uint(pmax), false, false);
    pmax = fmaxf(__uint_as_float(rr[0]), __uint_as_float(rr[1])); }
  if (__builtin_expect(__all(pmax - m_reg <= THR), 1)) { mn = m_reg; alpha = 1.f; }
  else { mn = fmaxf(m_reg, pmax); alpha = __builtin_amdgcn_exp2f(m_reg - mn); m_reg = mn; }
  for (int r = 0; r < 16; ++r) p0[r] = p0[r] - mn; for (int r = 0; r < 16; ++r) p1[r] = p1[r] - mn;
  for (int r = 0; r < 16; ++r) p0[r] = __builtin_amdgcn_exp2f(p0[r]);
}
DEV void finishSM(f32x16& p0, f32x16& p1, float alpha, float& l_reg, bf16x8& pa0, bf16x8& pa1, bf16x8& pa2, bf16x8& pa3) {
  for (int r = 0; r < 16; ++r) p1[r] = __builtin_amdgcn_exp2f(p1[r]);
  float ps = 0; for (int r = 0; r < 16; ++r) ps += p0[r]; for (int r = 0; r < 16; ++r) ps += p1[r];
  { auto rr = __builtin_amdgcn_permlane32_swap(__float_as_uint(ps), __float_as_uint(ps), false, false);
    ps = __uint_as_float(rr[0]) + __uint_as_float(rr[1]); }
  l_reg = l_reg * alpha + ps;
#define PK4(P, BASE, OUT) do { unsigned a0 = cvt_pk_bf16(P[BASE + 0], P[BASE + 1]), a1 = cvt_pk_bf16(P[BASE + 2], P[BASE + 3]);   \
    unsigned b0 = cvt_pk_bf16(P[BASE + 4], P[BASE + 5]), b1 = cvt_pk_bf16(P[BASE + 6], P[BASE + 7]);                              \
    auto r0 = __builtin_amdgcn_permlane32_swap(a0, b0, false, false); auto r1 = __builtin_amdgcn_permlane32_swap(a1, b1, false, false); \
    u32x4 w = {r0[0], r1[0], r0[1], r1[1]}; OUT = *reinterpret_cast<bf16x8*>(&w); } while (0)
  PK4(p0, 0, pa0); PK4(p0, 8, pa1); PK4(p1, 0, pa2); PK4(p1, 8, pa3);
#undef PK4
}
DEV void qkt(f32x16& p0, f32x16& p1, const char* Ks, const bf16x8 (&qr)[4], int r32, int hi, int js) {
  p0 = f32x16{}; p1 = f32x16{};
#pragma unroll
  for (int d0 = 0; d0 < 4; ++d0) { const int cb = ((js * 4 + d0) * 16 + hi * 8) * 2;
    bf16x8 b0 = *reinterpret_cast<const bf16x8*>(Ks + KSWZ(r32, cb));
    bf16x8 b1 = *reinterpret_cast<const bf16x8*>(Ks + KSWZ(32 + r32, cb));
    p0 = __builtin_amdgcn_mfma_f32_32x32x16_bf16(b0, qr[d0], p0, 0, 0, 0);
    p1 = __builtin_amdgcn_mfma_f32_32x32x16_bf16(b1, qr[d0], p1, 0, 0, 0); }
}
DEV int v_st(int k, int c) { const int kk = (k & ~0xC) | ((k & 4) << 1) | ((k & 8) >> 1); return ((kk >> 3) * 4 + (c >> 5)) * 512 + ((kk & 7) * 32 + (c & 31)) * 2; }
DEV int v_rd_base(int lane) { return ((lane & 3) << 3) | (((lane >> 2) & 3) << 6) | (((lane >> 4) & 1) << 5) | (((lane >> 5) & 1) << 8); }
constexpr int v_rd_off(int d0, int ks, int half) { return d0 * 512 + ks * 4096 + half * 2048; }
template <int OFF> DEV s16x4 tr_read(int vb) {
  s16x4 r; asm volatile("ds_read_b64_tr_b16 %0, %1 offset:%2" : "=&v"(r) : "v"(vb), "i"(OFF) : "memory"); return r;
}
template <int D0> DEV void pv_one(f32x16& od, int vb, bf16x8 pa0, bf16x8 pa1, bf16x8 pa2, bf16x8 pa3) {
  const s16x4 l0 = tr_read<v_rd_off(D0, 0, 0)>(vb), h0 = tr_read<v_rd_off(D0, 0, 1)>(vb), l1 = tr_read<v_rd_off(D0, 1, 0)>(vb), h1 = tr_read<v_rd_off(D0, 1, 1)>(vb);
  const s16x4 l2 = tr_read<v_rd_off(D0, 2, 0)>(vb), h2 = tr_read<v_rd_off(D0, 2, 1)>(vb), l3 = tr_read<v_rd_off(D0, 3, 0)>(vb), h3 = tr_read<v_rd_off(D0, 3, 1)>(vb);
  asm volatile("s_waitcnt lgkmcnt(0)" ::: "memory"); SBAR();
#define PK(L, H) (bf16x8){L[0], L[1], L[2], L[3], H[0], H[1], H[2], H[3]}
  od = __builtin_amdgcn_mfma_f32_32x32x16_bf16(pa0, PK(l0, h0), od, 0, 0, 0);
  od = __builtin_amdgcn_mfma_f32_32x32x16_bf16(pa1, PK(l1, h1), od, 0, 0, 0);
  od = __builtin_amdgcn_mfma_f32_32x32x16_bf16(pa2, PK(l2, h2), od, 0, 0, 0);
  od = __builtin_amdgcn_mfma_f32_32x32x16_bf16(pa3, PK(l3, h3), od, 0, 0, 0);
#undef PK
}
DEV void pv_d0(f32x16* o, int vb, bf16x8 pa0, bf16x8 pa1, bf16x8 pa2, bf16x8 pa3) {
  pv_one<0>(o[0], vb, pa0, pa1, pa2, pa3); pv_one<1>(o[1], vb, pa0, pa1, pa2, pa3); pv_one<2>(o[2], vb, pa0, pa1, pa2, pa3); pv_one<3>(o[3], vb, pa0, pa1, pa2, pa3);
}
DEV void attn_tiles(const bf16x8 (&qr)[4], const bf16_t* __restrict__ Kh, const bf16_t* __restrict__ Vh, int seq, char* lds,
                    float& m_reg, float& l_reg, f32x16 (&o)[4], int tid, int js) {
  const int wid = tid >> 6, lane = tid & 63, r32 = lane & 31, hi = lane >> 5;
  char* V_lds = lds; char* K_lds = lds + 2 * SHM_V;
  float* ws = (float*)(lds + 2 * SHM_V + 2 * SHM_K) + wid * 64; float* al_l = ws + 32;
  const int sr = tid >> 4, sc = (tid & 15) * 8, vst0 = v_st(sr, sc), vst1 = v_st(32 + sr, sc);
  const int vb0 = (int)(uintptr_t)V_lds + v_rd_base(lane);
  struct { bf16x8 vs0, vs1, ks0, ks1; } sr_[2];
  const unsigned lo0 = (unsigned)((sr * LDK + sc) * 2), lo1 = lo0 + 32u * LDK * 2u;
#define SLOAD(i, k0) do { const char* vb_ = (const char*)Vh + (size_t)(k0) * (LDK * 2); const char* kb_ = (const char*)Kh + (size_t)(k0) * (LDK * 2); \
    sr_[i].vs0 = *(const bf16x8*)(vb_ + lo0); sr_[i].vs1 = *(const bf16x8*)(vb_ + lo1); sr_[i].ks0 = *(const bf16x8*)(kb_ + lo0); sr_[i].ks1 = *(const bf16x8*)(kb_ + lo1); } while (0)
#define SWRITE(b, i) do { *(bf16x8*)(V_lds + (b) * SHM_V + vst0) = sr_[i].vs0;          \
    *(bf16x8*)(V_lds + (b) * SHM_V + vst1) = sr_[i].vs1; int kc = sc * 2;               \
    *(bf16x8*)(K_lds + (b) * SHM_K + KSWZ(sr, kc)) = sr_[i].ks0;                       \
    *(bf16x8*)(K_lds + (b) * SHM_K + KSWZ(32 + sr, kc)) = sr_[i].ks1; } while (0)
#define SWAIT() asm volatile("s_waitcnt vmcnt(4)" ::: "memory")
#define RESC(a) do { if (__any((a) < 1.f)) { if (hi == 0) al_l[r32] = (a); asm volatile("s_waitcnt lgkmcnt(0)" ::: "memory"); \
    for (int d = 0; d < 4; ++d) for (int r = 0; r < 16; ++r) o[d][r] *= al_l[crow(r, hi)]; } } while (0)
  f32x16 pA0, pA1, pB0, pB1; float mnA, mnB, alA, alB; bf16x8 pa0, pa1, pa2, pa3; const int NTL = seq / KVBLK;
  constexpr int SE = 0, SO = 1;
  __syncthreads();
  SLOAD(SE, 0); asm volatile("s_waitcnt vmcnt(0)" ::: "memory"); SWRITE(0, SE); __syncthreads();
  qkt(pA0, pA1, K_lds, qr, r32, hi, js); partialSM(pA0, pA1, m_reg, mnA, alA);
  SLOAD(SO, KVBLK); if (2 < NTL) SLOAD(SE, 2 * KVBLK);
  SWAIT(); SWRITE(1, SO); __syncthreads();
  RESC(alA);
  for (int j = 1; j + 1 < NTL; j += 2) {
    SBAR(); qkt(pB0, pB1, K_lds + SHM_K, qr, r32, hi, js);
    finishSM(pA0, pA1, alA, l_reg, pa0, pa1, pa2, pa3); SBAR();
    SLOAD(SO, (j + 2) * KVBLK); SBAR();
    pv_d0(o, vb0, pa0, pa1, pa2, pa3); partialSM(pB0, pB1, m_reg, mnB, alB);
    __syncthreads(); SWAIT(); SWRITE(0, SE);
    RESC(alB); __syncthreads();
    SBAR(); qkt(pA0, pA1, K_lds, qr, r32, hi, js);
    finishSM(pB0, pB1, alB, l_reg, pa0, pa1, pa2, pa3); SBAR();
    if (j + 3 < NTL) SLOAD(SE, (j + 3) * KVBLK); SBAR();
    pv_d0(o, vb0 + SHM_V, pa0, pa1, pa2, pa3); partialSM(pA0, pA1, m_reg, mnA, alA);
    __syncthreads(); SWAIT(); SWRITE(1, SO);
    RESC(alA); __syncthreads();
  }
  SBAR(); qkt(pB0, pB1, K_lds + SHM_K, qr, r32, hi, js);
  finishSM(pA0, pA1, alA, l_reg, pa0, pa1, pa2, pa3); SBAR();
  pv_d0(o, vb0, pa0, pa1, pa2, pa3); partialSM(pB0, pB1, m_reg, mnB, alB);
  __syncthreads(); RESC(alB);
  finishSM(pB0, pB1, alB, l_reg, pa0, pa1, pa2, pa3); SBAR();
  pv_d0(o, vb0 + SHM_V, pa0, pa1, pa2, pa3);
#undef SLOAD
#undef SWRITE
#undef SWAIT
#undef RESC
}
}

DEV void cvt_tile(const float* src, int ld, int nvalid, bf16_t* dst, int K, int n0, int k0, float* T, const int t, int ns0 = -1) {
    if (ns0 < 0) ns0 = n0;
#pragma unroll
    for (int h = 0; h < 2; ++h) {
        const int kk = (t >> 4) + 32 * h, nq = (t & 15) * 4, n = ns0 + nq;
        const float4 v = n < nvalid ? *(const float4*)(src + (size_t)(k0 + kk) * ld + n) : make_float4(0.f, 0.f, 0.f, 0.f);
        T[(nq + 0) * 65 + kk] = v.x; T[(nq + 1) * 65 + kk] = v.y; T[(nq + 2) * 65 + kk] = v.z; T[(nq + 3) * 65 + kk] = v.w;
    }
    __syncthreads();
    { const int n = t >> 3, kq = (t & 7) * 8; const float* r = T + n * 65 + kq;
      pg8::u32x4 w; w.x = cvt_pk_bf16(r[0], r[1]); w.y = cvt_pk_bf16(r[2], r[3]); w.z = cvt_pk_bf16(r[4], r[5]); w.w = cvt_pk_bf16(r[6], r[7]);
      *(pg8::u32x4*)(dst + (size_t)(n0 + n) * K + k0 + kq) = w; }
    __syncthreads();
}
DEV unsigned pk4_fp8(float a, float b, float c, float d) {
    a = __builtin_amdgcn_fmed3f(a, -448.f, 448.f); b = __builtin_amdgcn_fmed3f(b, -448.f, 448.f); c = __builtin_amdgcn_fmed3f(c, -448.f, 448.f); d = __builtin_amdgcn_fmed3f(d, -448.f, 448.f);
    int w = 0; w = __builtin_amdgcn_cvt_pk_fp8_f32(a, b, w, false); w = __builtin_amdgcn_cvt_pk_fp8_f32(c, d, w, true); return (unsigned)w;
}
constexpr float F8_SW = 1024.f  , F8_SX = 16.f  , F8_SH = 8.f  ;
DEV void cvt_tile4(const float* src, int ld, int nvalid, bf16_t* dst, int K, int n0, int k0, float* T, const int t, int ns0 = -1, bool f8 = false) {
    if (ns0 < 0) ns0 = n0;
    float4 v[4][2];
#pragma unroll
    for (int q = 0; q < 4; ++q)
#pragma unroll
        for (int h = 0; h < 2; ++h) { const int kk = (t >> 4) + 32 * h, n = ns0 + (t & 15) * 4;
            v[q][h] = n < nvalid ? *(const float4*)(src + (size_t)(k0 + q * 64 + kk) * ld + n) : make_float4(0.f, 0.f, 0.f, 0.f); }
#pragma unroll
    for (int q = 0; q < 4; ++q)
#pragma unroll
        for (int h = 0; h < 2; ++h) { const int kk = (t >> 4) + 32 * h, nq = (t & 15) * 4; float* Tq = T + q * (64 * 65);
            Tq[(nq + 0) * 65 + kk] = v[q][h].x; Tq[(nq + 1) * 65 + kk] = v[q][h].y; Tq[(nq + 2) * 65 + kk] = v[q][h].z; Tq[(nq + 3) * 65 + kk] = v[q][h].w; }
    __syncthreads();
#pragma unroll
    for (int q = 0; q < 4; ++q) { const int n = t >> 3, kq = (t & 7) * 8; const float* r = T + q * (64 * 65) + n * 65 + kq;
      if (f8) { pg8::u32x2 w; w.x = pk4_fp8(r[0] * F8_SW, r[1] * F8_SW, r[2] * F8_SW, r[3] * F8_SW); w.y = pk4_fp8(r[4] * F8_SW, r[5] * F8_SW, r[6] * F8_SW, r[7] * F8_SW);
          const int nn = n0 + n, kk = k0 + q * 64 + kq;
          *(pg8::u32x2*)((unsigned char*)dst + (size_t)(nn >> 8) * 256 * K + (size_t)(kk >> 7) * (256 * 128) + (nn & 255) * 128 + (kk & 127)) = w; }
      else { pg8::u32x4 w; w.x = cvt_pk_bf16(r[0], r[1]); w.y = cvt_pk_bf16(r[2], r[3]); w.z = cvt_pk_bf16(r[4], r[5]); w.w = cvt_pk_bf16(r[6], r[7]);
          const int nn = n0 + n, kk = k0 + q * 64 + kq;
          *(pg8::u32x4*)(dst + (size_t)(nn >> 8) * 256 * K + (size_t)(kk >> 6) * (256 * 64) + (nn & 255) * 64 + (kk & 63)) = w; } }
    __syncthreads();
}
DEV void ph_convert(const Params& p, char* smem) {
    const int tidx = tid_of(p.wave_id);
    float* T = (float*)(smem + 256);
    volatile int* msg = (volatile int*)smem;
    unsigned* qh = (unsigned*)(p.ws + OFF_bar) + CW_QHEAD;
    constexpr int T_IN = 2 * 60 * 4, T_OUT = 2 * 16 * 4, T_W1 = 64 * 32 * 4, T_W2 = 64 * 16 * 4;
    unsigned nxt = 0u;
    if (tidx == 0) nxt = xb_add(qh, 1u);
    for (;;) {
        __syncthreads();
        if (tidx == 0) msg[0] = (int)nxt;
        __syncthreads();
        const int u = msg[0];
        if (u >= T_IN + T_OUT + T_W1 + T_W2) break;
        if (tidx == 0) nxt = xb_add(qh, 1u);
        if (u < T_IN) { const int l = u / 240, r = u % 240, nt = r >> 2, kq = r & 3;
            const int n0 = nt * 64; int ns0, nv;
            if (n0 < 2048) { ns0 = n0; nv = DPW; } else if (n0 < 3584) { ns0 = n0 + 16; nv = DPW; } else if (n0 == 3584) { ns0 = 2048; nv = 2064; } else { ns0 = 0; nv = 0; }
            cvt_tile4(p.w_in + (size_t)l * D * DPW, DPW, nv, (bf16_t*)(p.ws + OFF_WIN) + (size_t)l * DP * D, D, n0, kq * 256, T, tidx, ns0); }
        else if (u < T_IN + T_OUT) { const int v = u - T_IN, l = v >> 6, r = v & 63, nt = r >> 2, kq = r & 3;
            cvt_tile4(p.w_out + (size_t)l * D * D, D, D, (bf16_t*)(p.ws + OFF_WOUT) + (size_t)l * D * D, D, nt * 64, kq * 256, T, tidx); }
        else if (u < T_IN + T_OUT + T_W1) { const int v = u - T_IN - T_OUT, le = v >> 7, r = v & 127, nt = r >> 2, kq = r & 3;
            cvt_tile4(p.w1 + (size_t)le * D * 2048, 2048, 2048, (bf16_t*)(p.ws + OFF_W1T + (size_t)le * 2048 * D), D, nt * 64, kq * 256, T, tidx, -1, true); }
        else { const int v = u - T_IN - T_OUT - T_W1, le = v >> 6, r = v & 63, nt = r >> 2, kq = r & 3;
            cvt_tile4(p.w2 + (size_t)le * DFF * D, D, D, (bf16_t*)(p.ws + OFF_W2T + (size_t)le * D * DFF), DFF, nt * 64, kq * 256, T, tidx, -1, true); }
    }
}

DEV void row_load(const float* src, float4 (&v)[4], int lane) {
#pragma unroll
    for (int i = 0; i < 4; ++i) v[i] = *(const float4*)(src + i * 256 + lane * 4);
}
DEV void row_store(float* dst, const float4 (&v)[4], int lane) {
#pragma unroll
    for (int i = 0; i < 4; ++i) *(float4*)(dst + i * 256 + lane * 4) = v[i];
}
DEV void row_store_bf16(bf16_t* dst, const float4 (&v)[4], int lane) {
#pragma unroll
    for (int i = 0; i < 4; ++i) { pg8::u32x2 w; w.x = cvt_pk_bf16(v[i].x, v[i].y); w.y = cvt_pk_bf16(v[i].z, v[i].w); *(pg8::u32x2*)(dst + i * 256 + lane * 4) = w; }
}
DEV void row_store_fp8(unsigned char* dst, const float4 (&v)[4], int lane, float sc) {
#pragma unroll
    for (int i = 0; i < 4; ++i) *(unsigned*)(dst + i * 256 + lane * 4) = pk4_fp8(v[i].x * sc, v[i].y * sc, v[i].z * sc, v[i].w * sc);
}
DEV void row_load_bf(const bf16_t* src, float4 (&v)[4], int lane) {
#pragma unroll
    for (int i = 0; i < 4; ++i) { const pg8::u32x2 w = *(const pg8::u32x2*)(src + i * 256 + lane * 4);
        v[i] = make_float4(__uint_as_float(w.x << 16), __uint_as_float(w.x & 0xffff0000u), __uint_as_float(w.y << 16), __uint_as_float(w.y & 0xffff0000u)); }
}
DEV float row_rinv(const float4 (&v)[4]) {
    float ss = 0.f;
#pragma unroll
    for (int i = 0; i < 4; ++i) ss += v[i].x * v[i].x + v[i].y * v[i].y + v[i].z * v[i].z + v[i].w * v[i].w;
    ss = wsum(ss);
    return rsqrtf(ss * (1.f / 1024.f) + 1e-6f);
}
DEV void row_modnorm(const float4 (&v)[4], const float* gain, const float* shift, const float* scale, float4 (&o)[4], int lane) {
    const float r = row_rinv(v);
#pragma unroll
    for (int i = 0; i < 4; ++i) {
        const int idx = i * 256 + lane * 4;
        const float4 g = *(const float4*)(gain + idx), sh = *(const float4*)(shift + idx), sc = *(const float4*)(scale + idx);
        o[i].x = v[i].x * r * g.x * (1.f + sc.x) + sh.x; o[i].y = v[i].y * r * g.y * (1.f + sc.y) + sh.y;
        o[i].z = v[i].z * r * g.z * (1.f + sc.z) + sh.z; o[i].w = v[i].w * r * g.w * (1.f + sc.w) + sh.w;
    }
}
DEV const float* modrow(const Params& p, int layer, int b, int s) { return ((float*)(p.ws + OFF_MOD)) + ((size_t)layer * 9 + (s < CTX ? 8 : b)) * 6144; }

DEV void ph_mods(const Params& p, char* smem) {
    const int tidx = tid_of(p.wave_id);
    float (*cond)[1024] = (float (*)[1024])smem;
    float (*red)[9][64] = (float (*)[9][64])(smem + 9 * 1024 * 4);
    const int tid = tidx;
    for (int i = tid; i < 9 * 1024; i += 512) { const int r = i >> 10, k = i & 1023; const float c = r < 8 ? p.c[r * 1024 + k] : p.c_ctx[k]; cond[r][k] = c * sigm(c); }
    __syncthreads();
    for (int u = blockIdx.x; u < 192; u += gridDim.x) {
        const int layer = u / 96, cg = u % 96, jj = tid & 63, ks = tid >> 6, j = cg * 64 + jj;
        float acc[9];
#pragma unroll
        for (int r = 0; r < 9; ++r) acc[r] = 0.f;
        const float* w = p.ada_w + (size_t)layer * 1024 * 6144 + j;
        for (int k = ks * 128; k < ks * 128 + 128; ++k) { const float wv = w[(size_t)k * 6144];
#pragma unroll
            for (int r = 0; r < 9; ++r) acc[r] += cond[r][k] * wv; }
#pragma unroll
        for (int r = 0; r < 9; ++r) red[ks][r][jj] = acc[r];
        __syncthreads();
        for (int t = tid; t < 9 * 64; t += 512) { const int r = t >> 6, q = t & 63; float s = 0.f; for (int z = 0; z < 8; ++z) s += red[z][r][q];
            ((float*)(p.ws + OFF_MOD))[((size_t)layer * 9 + r) * 6144 + cg * 64 + q] = s + p.ada_b[layer * 6144 + cg * 64 + q]; }
        __syncthreads();
    }
    if (blockIdx.x == (gridDim.x > 1 ? 1u : 0u)) {
        for (int t = tid; t < 1024; t += 512) { const int pos = t >> 4, i = t & 15; float sn, cs; sincosf((float)pos * expf(-(float)i * (1.f / 16.f) * 9.210340371976184f), &sn, &cs);
            ((float2*)(p.ws + OFF_ROPE))[t] = make_float2(cs, sn); }
    }
    if (blockIdx.x == 0) {
        for (int t = tid; t < 1024; t += 512) { const int layer = t >> 9, dir = (t >> 8) & 1, w = t & 255;
            const float t0 = p.hlb[(dir * 2 + 0) * 256 + w], t1 = p.hlb[(dir * 2 + 1) * 256 + w];
            const float mx = fmaxf(t0, t1), e0 = expf(t0 - mx), e1 = expf(t1 - mx);
            float lb = layer == 0 ? 0.f : e1 / (e0 + e1); lb = fminf(fmaxf(lb, 0.f), 1.f);
            ((float*)(p.ws + OFF_LB))[(layer * 2 + dir) * 256 + w] = lb; }
        if (tid < 128) { const int layer = tid >> 6, lane = tid & 63; const float* L = p.dlam + layer * 256;
            const float s1 = wsum(L[lane] * L[64 + lane]), s2 = wsum(L[128 + lane] * L[192 + lane]);
            if (lane == 0) ((float*)(p.ws + OFF_LAM))[layer] = expf(s1) - expf(s2) + lam_init_of(layer); }
    }
}

DEV void ph_init(const Params& p, char* smem) {
    const int tidx = tid_of(p.wave_id);
    const int wid = tidx >> 6, lane = tidx & 63;
    for (int r = blockIdx.x * 8 + wid; r < NT; r += gridDim.x * 8) {
        const int b = r / SL, s = r % SL;
        const float* src = s < CTX ? p.ctx + ((size_t)b * CTX + s) * D : p.x + ((size_t)b * SEQ + (s - CTX)) * D;
        float4 v[4], o[4]; row_load(src, v, lane); row_store_bf16((bf16_t*)(p.ws + OFF_X) + (size_t)r * D, v, lane);
        const float* m = modrow(p, 0, b, s);
        row_modnorm(v, p.norms + 0, m + 0, m + 1024, o, lane);
        row_store_bf16((bf16_t*)(p.ws + OFF_XNB) + (size_t)r * D, o, lane);
    }
}


struct EpiIn {
    static constexpr bool PERM = false;
    bf16_t *PB, *QRB, *Q0B, *KB, *VB; const float* CS;
    DEV void operator()(const pg8::f32x4 (&acc)[2][2][4][2], const pg8::Unit& u, int wr, int wc, int fr, int fq) const {
        using pg8::f32x4; using pg8::u32x2;
        const int pn = u.pn;
        if (pn < 8 || pn == 14) {
#pragma unroll
            for (int ai = 0; ai < 2; ++ai)
#pragma unroll
                for (int m = 0; m < 4; ++m) { bf16_t* rowp = PB + (size_t)(u.pm * 256 + ai * 128 + wr * 64 + m * 16 + fr) * DP + pn * 256 + wc * 32 + 4 * fq;
#pragma unroll
                    for (int bj = 0; bj < 2; ++bj)
#pragma unroll
                        for (int n = 0; n < 2; ++n) { const f32x4 v = acc[ai][bj][m][n]; u32x2 w; w.x = cvt_pk_bf16(v[0], v[1]); w.y = cvt_pk_bf16(v[2], v[3]); *(u32x2*)(rowp + bj * 128 + n * 16) = w; } }
        } else {
            const int kind = (pn - 8) >> 1, hb = ((pn - 8) & 1) * 2, b = u.pm / 9, tq = u.pm % 9, half = wc & 1, jsub = wc >> 1;
            const bool isctx = tq == 0;
            const float QC = 0.125f * 1.4426950408889634f;
#pragma unroll
            for (int ai = 0; ai < 2; ++ai)
#pragma unroll
                for (int m = 0; m < 4; ++m) {
                    const int s = tq * 256 + ai * 128 + wr * 64 + m * 16 + fr;
                    f32x4 c4 = {1.f, 1.f, 1.f, 1.f}, s4 = {0.f, 0.f, 0.f, 0.f};
                    if (kind != 2 && !isctx) { const int pos = half == 0 ? (tq - 1) * 4 + ai * 2 + wr : m * 16 + fr;
                        const f32x4 t0 = *(const f32x4*)(CS + (pos * 16 + 4 * fq) * 2), t1 = *(const f32x4*)(CS + (pos * 16 + 4 * fq) * 2 + 4);
                        c4 = (f32x4){t0[0], t0[2], t1[0], t1[2]}; s4 = (f32x4){t0[1], t0[3], t1[1], t1[3]}; }
#pragma unroll
                    for (int bj = 0; bj < 2; ++bj) {
                        const size_t dst = ((size_t)(b * 4 + hb + bj) * SL + s) * 128 + jsub * 64 + half * 32 + 4 * fq;
                        const f32x4 x1 = acc[ai][bj][m][0], x2 = acc[ai][bj][m][1];
#define ST4(ptr, v) do { u32x2 w_; w_.x = cvt_pk_bf16((v)[0], (v)[1]); w_.y = cvt_pk_bf16((v)[2], (v)[3]); *(u32x2*)(ptr) = w_; } while (0)
                        if (kind == 2) { ST4(VB + dst, x1); ST4(VB + dst + 16, x2); }
                        else {
                            const f32x4 o1 = x1 * c4 - x2 * s4, o2 = x1 * s4 + x2 * c4;
                            if (kind == 1) { ST4(KB + dst, o1); ST4(KB + dst + 16, o2); }
                            else { const f32x4 a1 = o1 * QC, a2 = o2 * QC, p1 = x1 * QC, p2 = x2 * QC; ST4(QRB + dst, a1); ST4(QRB + dst + 16, a2); ST4(Q0B + dst, p1); ST4(Q0B + dst + 16, p2); }
                        }
#undef ST4
                    }
                }
        }
    }
};

struct InOrder {
    int G, c, Lbeg, Lend; const char* Bt; int K;
    DEV bool next(int i, pg8::Unit& u) const {
        const int L = Lbeg + i * G + c; if (L >= Lend) return false;
        const int nN = L < 648 ? 9 : 6, l = L < 648 ? L : L - 648, nM = NT / 256, nwg = nM * nN;
        int wgid = l; { const int q = nwg / 8, r = nwg % 8, xcd = wgid % 8, off = wgid / 8; wgid = (xcd < r ? xcd * (q + 1) : r * (q + 1) + (xcd - r) * q) + off; }
        const int nig = 8 * nN, gid = wgid / nig, fm = gid * 8, gsz = (nM - fm) < 8 ? (nM - fm) : 8;
        const int pnl = (wgid % nig) / gsz;
        u.pm = fm + ((wgid % nig) % gsz); u.pn = L < 648 ? (pnl < 8 ? pnl : 14) : 8 + pnl; u.e = 0; u.t = 0; return true;
    }
    DEV int arow(const pg8::Unit& u, int rr) const { return u.pm * 256 + rr; }
    DEV const char* bbase(const pg8::Unit& u) const { return Bt + (size_t)u.pn * 256 * K * 2; }
};
DEV void ph_inproj(const Params& p, int layer, char* smem, int part) {
    const int tidx = tid_of(p.wave_id);
    const int G = (int)gridDim.x, nun = (NT / 256) * (DP / 256), cut = 4 * G < nun ? 4 * G : nun;
    const int nleft = nun - cut, cid = part == 0 ? (int)blockIdx.x : (int)blockIdx.x - (G - nleft);
    if (part == 1 && (nleft <= 0 || cid < 0)) return;
    InOrder S{G, cid, part == 0 ? 0 : cut, part == 0 ? cut : nun, (const char*)((const bf16_t*)(p.ws + OFF_WIN) + (size_t)layer * DP * D), D};
    EpiIn E{(bf16_t*)(p.ws + OFF_PB), (bf16_t*)(p.ws + OFF_QRB), (bf16_t*)(p.ws + OFF_Q0B), (bf16_t*)(p.ws + OFF_KB), (bf16_t*)(p.ws + OFF_VB), (const float*)(p.ws + OFF_ROPE)};
    pg8::gemm_phase(( LAS unsigned char*)smem, (const char*)(p.ws + OFF_XNB), D, S, E, tid_of(p.wave_id));
}


namespace scn {
using att::bf16x8; using att::s16x4; using att::f32x16; using att::u32x4; using att::crow;
DEV int v_st64(int k, int c) { const int kk = (k & ~0xC) | ((k & 4) << 1) | ((k & 8) >> 1); return ((kk >> 3) * 2 + (c >> 5)) * 512 + ((kk & 7) * 32 + (c & 31)) * 2; }
constexpr int v_rd_off64(int d0, int ks, int half) { return d0 * 512 + ks * 2048 + half * 1024; }
#define SCN_PK(L, H) (bf16x8){L[0], L[1], L[2], L[3], H[0], H[1], H[2], H[3]}
template <int D0> DEV void frags4(int vb, bf16x8& f0, bf16x8& f1, bf16x8& f2, bf16x8& f3) {
    const s16x4 l0 = att::tr_read<v_rd_off64(D0, 0, 0)>(vb), h0 = att::tr_read<v_rd_off64(D0, 0, 1)>(vb), l1 = att::tr_read<v_rd_off64(D0, 1, 0)>(vb), h1 = att::tr_read<v_rd_off64(D0, 1, 1)>(vb);
    const s16x4 l2 = att::tr_read<v_rd_off64(D0, 2, 0)>(vb), h2 = att::tr_read<v_rd_off64(D0, 2, 1)>(vb), l3 = att::tr_read<v_rd_off64(D0, 3, 0)>(vb), h3 = att::tr_read<v_rd_off64(D0, 3, 1)>(vb);
    asm volatile("s_waitcnt lgkmcnt(0)" ::: "memory"); SBAR();
    f0 = SCN_PK(l0, h0); f1 = SCN_PK(l1, h1); f2 = SCN_PK(l2, h2); f3 = SCN_PK(l3, h3);
}
DEV bf16x8 pack8(const float (&v)[8]) { u32x4 w = {cvt_pk_bf16(v[0], v[1]), cvt_pk_bf16(v[2], v[3]), cvt_pk_bf16(v[4], v[5]), cvt_pk_bf16(v[6], v[7])}; return *reinterpret_cast<bf16x8*>(&w); }
DEV void stage64(char* img, const float* src, size_t ld, int lane, float sc = 1.f) {
    const float* row = src + (size_t)lane * ld;
#pragma unroll
    for (int c8 = 0; c8 < 8; ++c8) { const float4 a = *(const float4*)(row + c8 * 8), b = *(const float4*)(row + c8 * 8 + 4);
        u32x4 w = {cvt_pk_bf16(a.x * sc, a.y * sc), cvt_pk_bf16(a.z * sc, a.w * sc), cvt_pk_bf16(b.x * sc, b.y * sc), cvt_pk_bf16(b.z * sc, b.w * sc)};
        *(u32x4*)(img + v_st64(lane, c8 * 8)) = w; }
}
template <int CTRL, int RM> DEV float dpp_f(float oldv, float v, bool bc) { return bc ? __builtin_bit_cast(float, __builtin_amdgcn_update_dpp(__builtin_bit_cast(int, oldv), __builtin_bit_cast(int, v), CTRL, RM, 0xf, true))
                                                                                   : __builtin_bit_cast(float, __builtin_amdgcn_update_dpp(__builtin_bit_cast(int, oldv), __builtin_bit_cast(int, v), CTRL, RM, 0xf, false)); }
DEV float bperm(float v, int src) { return __builtin_bit_cast(float, __builtin_amdgcn_ds_bpermute(src << 2, __builtin_bit_cast(int, v))); }
DEV float scan_inc32(float v) {
    v += dpp_f<0x111, 0xf>(0.f, v, true); v += dpp_f<0x112, 0xf>(0.f, v, true); v += dpp_f<0x114, 0xf>(0.f, v, true); v += dpp_f<0x118, 0xf>(0.f, v, true);
    v += dpp_f<0x142, 0xa>(0.f, v, false);
    return v;
}
DEV float scanmax_inc32(float v) {
    const float ni = -3.0e38f;
    v = fmaxf(v, dpp_f<0x111, 0xf>(ni, v, false)); v = fmaxf(v, dpp_f<0x112, 0xf>(ni, v, false)); v = fmaxf(v, dpp_f<0x114, 0xf>(ni, v, false)); v = fmaxf(v, dpp_f<0x118, 0xf>(ni, v, false));
    v = fmaxf(v, dpp_f<0x142, 0xa>(ni, v, false));
    return v;
}
DEV float scanmax_suf32(float v, int lane) {
    const float ni = -3.0e38f;
    v = fmaxf(v, dpp_f<0x101, 0xf>(ni, v, false)); v = fmaxf(v, dpp_f<0x102, 0xf>(ni, v, false)); v = fmaxf(v, dpp_f<0x104, 0xf>(ni, v, false)); v = fmaxf(v, dpp_f<0x108, 0xf>(ni, v, false));
    const float t = bperm(v, (lane & 32) | 16);
    return (lane & 16) ? v : fmaxf(v, t);
}
DEV void ld8(const bf16_t* ub, unsigned boff, float (&v)[8]) { const u32x4 w = *(const u32x4*)((const char*)ub + boff);
    v[0] = __uint_as_float(w.x << 16); v[1] = __uint_as_float(w.x & 0xffff0000u); v[2] = __uint_as_float(w.y << 16); v[3] = __uint_as_float(w.y & 0xffff0000u);
    v[4] = __uint_as_float(w.z << 16); v[5] = __uint_as_float(w.z & 0xffff0000u); v[6] = __uint_as_float(w.w << 16); v[7] = __uint_as_float(w.w & 0xffff0000u); }
DEV float ld1(const bf16_t* ub, unsigned boff) { return __uint_as_float((unsigned)(*(const unsigned short*)((const char*)ub + boff)) << 16); }
DEV void stage64b(char* img, const bf16_t* src, size_t ld, int lane) {
    const bf16_t* row = src + (size_t)lane * ld;
#pragma unroll
    for (int c8 = 0; c8 < 8; ++c8) *(u32x4*)(img + v_st64(lane, c8 * 8)) = *(const u32x4*)(row + c8 * 8);
}
DEV float4 ldg4(const float* ub, unsigned boff) { return *(const float4*)((const char*)ub + boff); }
DEV float ldg1(const float* ub, unsigned boff) { return *(const float*)((const char*)ub + boff); }
DEV float fexp(float x) { return __expf(fminf(fmaxf(x, -80.f), 80.f)); }
DEV float fsig(float x) { return __builtin_amdgcn_rcpf(1.f + __expf(-x)); }
DEV void decay_ks(const float (&x)[2][8], const float (&lb)[8], int dir, int lane, float (&cum)[2][8], float (&kk)[2][8], float (&ref)[8]) {
#pragma unroll
    for (int tb = 0; tb < 2; ++tb)
#pragma unroll
        for (int j = 0; j < 8; ++j) { const float sg = fsig(x[tb][j]); kk[tb][j] = (1.f - lb[j]) * (1.f - sg); cum[tb][j] = __logf(fmaxf(lb[j] + (1.f - lb[j]) * sg, 1e-12f)); }
#pragma unroll
    for (int j = 0; j < 8; ++j) {
        const float i0 = scan_inc32(cum[0][j]), i1 = scan_inc32(cum[1][j]), t0 = bperm(i0, lane | 31), t1 = bperm(i1, lane | 31);
        if (dir == 0) { cum[0][j] = i0; cum[1][j] = i1 + t0; ref[j] = t0; }
        else { const float x0 = cum[0][j], x1 = cum[1][j]; cum[1][j] = t1 - i1 + x1; cum[0][j] = t0 - i0 + x0 + t1; ref[j] = t1; }
        if ((j & 3) == 3) SBAR();
    }
}
}

DEV void scanA_local(const Params& p, int layer, char* Lw, int bh, int tc, int lane) {
    using namespace scn;
    asm volatile("" : "+v"(lane));
    const int r32 = lane & 31, hi = lane >> 5, b = bh >> 2, h = bh & 3;
    const bf16_t* base = (const bf16_t*)(p.ws + OFF_PB) + (size_t)(b * SL + 64 * tc) * DP;
    unsigned lo = (unsigned)(r32 * DP + 8 * hi) * 2u;
    asm volatile("" : "+v"(lo));
    char* imgV = Lw; char* imgK = Lw + 8192;
    const int vbV = (int)(uintptr_t)imgV + att::v_rd_base(lane), vbK = vbV + 8192;
    stage64b(imgV, base + O_AI + h * 64, DP, lane);
#pragma unroll 1
    for (int dir = 0; dir < 2; ++dir) {
        const int chain = bh * 2 + dir, c = dir == 0 ? tc : (tc < 4 ? 3 - tc : 39 - tc);
#pragma unroll 1
        for (int ks = 0; ks < 4; ++ks) {
            const int ch = 16 * ks + 8 * hi;
            float x[2][8], cum[2][8], kk[2][8], ref[8], lb[8];
#pragma unroll
            for (int tb = 0; tb < 2; ++tb) ld8(base + (dir ? O_AFB : O_AFF) + h * 64 + 16 * ks, lo + tb * (32u * DP * 2u), x[tb]);
            { const float* l = (const float*)(p.ws + OFF_LB) + (layer * 2 + dir) * 256 + h * 64 + ch;
#pragma unroll
              for (int j = 0; j < 8; ++j) lb[j] = l[j]; }
            decay_ks(x, lb, dir, lane, cum, kk, ref);
            float ke[8];
#pragma unroll
            for (int tb = 0; tb < 2; ++tb) {
#pragma unroll
                for (int j = 0; j < 8; ++j) { const float ce = dir == 0 ? bperm(cum[1][j], lane | 31) : bperm(cum[0][j], lane & 32);
                    ke[j] = kk[tb][j] * fexp(ce - cum[tb][j]);
                    if (tb == 1 && dir == 0 && r32 == 31) ((float*)(p.ws + OFF_DECA))[(chain * 36 + c) * 64 + ch + j] = __expf(ce);
                    if (tb == 0 && dir == 1 && r32 == 0) ((float*)(p.ws + OFF_DECA))[(chain * 36 + c) * 64 + ch + j] = __expf(ce); }
                *(bf16x8*)(imgK + v_st64(32 * tb + r32, ch)) = pack8(ke);
            }
            SBAR();
        }
        f32x16 u[2][2] = {};
        { bf16x8 k0, k1, k2, k3, v0, v1, v2, v3;
          frags4<0>(vbK, k0, k1, k2, k3); frags4<0>(vbV, v0, v1, v2, v3);
          u[0][0] = __builtin_amdgcn_mfma_f32_32x32x16_bf16(k0, v0, u[0][0], 0, 0, 0); u[0][0] = __builtin_amdgcn_mfma_f32_32x32x16_bf16(k1, v1, u[0][0], 0, 0, 0);
          u[0][0] = __builtin_amdgcn_mfma_f32_32x32x16_bf16(k2, v2, u[0][0], 0, 0, 0); u[0][0] = __builtin_amdgcn_mfma_f32_32x32x16_bf16(k3, v3, u[0][0], 0, 0, 0);
          bf16x8 w0, w1, w2, w3; frags4<1>(vbV, w0, w1, w2, w3);
          u[0][1] = __builtin_amdgcn_mfma_f32_32x32x16_bf16(k0, w0, u[0][1], 0, 0, 0); u[0][1] = __builtin_amdgcn_mfma_f32_32x32x16_bf16(k1, w1, u[0][1], 0, 0, 0);
          u[0][1] = __builtin_amdgcn_mfma_f32_32x32x16_bf16(k2, w2, u[0][1], 0, 0, 0); u[0][1] = __builtin_amdgcn_mfma_f32_32x32x16_bf16(k3, w3, u[0][1], 0, 0, 0);
          frags4<1>(vbK, k0, k1, k2, k3);
          u[1][0] = __builtin_amdgcn_mfma_f32_32x32x16_bf16(k0, v0, u[1][0], 0, 0, 0); u[1][0] = __builtin_amdgcn_mfma_f32_32x32x16_bf16(k1, v1, u[1][0], 0, 0, 0);
          u[1][0] = __builtin_amdgcn_mfma_f32_32x32x16_bf16(k2, v2, u[1][0], 0, 0, 0); u[1][0] = __builtin_amdgcn_mfma_f32_32x32x16_bf16(k3, v3, u[1][0], 0, 0, 0);
          u[1][1] = __builtin_amdgcn_mfma_f32_32x32x16_bf16(k0, w0, u[1][1], 0, 0, 0); u[1][1] = __builtin_amdgcn_mfma_f32_32x32x16_bf16(k1, w1, u[1][1], 0, 0, 0);
          u[1][1] = __builtin_amdgcn_mfma_f32_32x32x16_bf16(k2, w2, u[1][1], 0, 0, 0); u[1][1] = __builtin_amdgcn_mfma_f32_32x32x16_bf16(k3, w3, u[1][1], 0, 0, 0); }
        float* U = (float*)(p.ws + OFF_UA) + ((size_t)chain * 36 + c) * 4096;
#pragma unroll
        for (int kb = 0; kb < 2; ++kb)
#pragma unroll
            for (int d0 = 0; d0 < 2; ++d0)
#pragma unroll
                for (int r = 0; r < 16; ++r) U[(32 * kb + crow(r, hi)) * 64 + 32 * d0 + r32] = u[kb][d0][r];
    }
}
DEV void scanA_out(const Params& p, int layer, char* Lw, int bh, int tc, int lane) {
    using namespace scn;
    asm volatile("" : "+v"(lane));
    const int r32 = lane & 31, hi = lane >> 5, b = bh >> 2, h = bh & 3;
    const bf16_t* base = (const bf16_t*)(p.ws + OFF_PB) + (size_t)(b * SL + 64 * tc) * DP;
    unsigned lo = (unsigned)(r32 * DP + 8 * hi) * 2u;
    asm volatile("" : "+v"(lo));
    char* imgV = Lw; char* imgS = Lw + 8192;
    const int vbV = (int)(uintptr_t)imgV + att::v_rd_base(lane), vbS = vbV + 8192;
    stage64b(imgV, base + O_AI + h * 64, DP, lane);
    f32x16 o[2][2] = {};
#pragma unroll 1
    for (int dir = 0; dir < 2; ++dir) {
        const int chain = bh * 2 + dir, c = dir == 0 ? tc : (tc < 4 ? 3 - tc : 39 - tc);
        const float* S0g = (const float*)(p.ws + OFF_SA) + ((size_t)chain * 36 + c) * 4096;
        f32x16 pd0 = {}, pd1 = {}, px = {};
#define MM(acc, A, B) acc = __builtin_amdgcn_mfma_f32_32x32x16_bf16(A, B, acc, 0, 0, 0)
#define LOADX(ks) do { _Pragma("unroll") for (int tb = 0; tb < 2; ++tb) ld8(base + (dir ? O_AFB : O_AFF) + h * 64 + 16 * (ks), lo + tb * (32u * DP * 2u), xr[tb]); } while (0)
#define LOADQ(ks) do { _Pragma("unroll") for (int tb = 0; tb < 2; ++tb) ld8(base + O_AQ + h * 64 + 16 * (ks), lo + tb * (32u * DP * 2u), qr[tb]); } while (0)
        float xr[2][8], qr[2][8];
#define KSTEP(ks) do { \
            const int ch = 16 * (ks) + 8 * hi; \
            float cum[2][8], kk[2][8], ref[8], lb[8]; \
            { const float* l = (const float*)(p.ws + OFF_LB) + (layer * 2 + dir) * 256 + h * 64 + ch; _Pragma("unroll") for (int j = 0; j < 8; ++j) lb[j] = l[j]; } \
            const int ci = lane >> 2; const int row = 16 * (ks) + ci, c16 = (lane & 3) * 16; const float* sp = S0g + row * 64 + c16; \
            LOADX(ks); LOADQ(ks); decay_ks(xr, lb, dir, lane, cum, kk, ref); \
            const float4 sa = *(const float4*)sp, sb4 = *(const float4*)(sp + 4), sc4 = *(const float4*)(sp + 8), sd4 = *(const float4*)(sp + 12); \
              \
            { const int sj = ci & 7, sl = (ci >> 3) * 32; float rv = 0.f; \
              _Pragma("unroll") for (int j = 0; j < 8; ++j) { const float t = bperm(ref[j], sl); rv = (sj == j) ? t : rv; } \
              const float er = __expf(fmaxf(rv, -80.f)); \
              u32x4 w0 = {cvt_pk_bf16(sa.x * er, sa.y * er), cvt_pk_bf16(sa.z * er, sa.w * er), cvt_pk_bf16(sb4.x * er, sb4.y * er), cvt_pk_bf16(sb4.z * er, sb4.w * er)}; \
              u32x4 w1 = {cvt_pk_bf16(sc4.x * er, sc4.y * er), cvt_pk_bf16(sc4.z * er, sc4.w * er), cvt_pk_bf16(sd4.x * er, sd4.y * er), cvt_pk_bf16(sd4.z * er, sd4.w * er)}; \
              *(u32x4*)(imgS + v_st64(row, c16)) = w0; *(u32x4*)(imgS + v_st64(row, c16 + 8)) = w1; } \
            bf16x8 qt0, qt1, kt0, kt1; \
            _Pragma("unroll") for (int tb = 0; tb < 2; ++tb) { \
                float t1[8], t2[8]; \
                _Pragma("unroll") for (int j = 0; j < 8; ++j) { const float q = qr[tb][j] * fsig(qr[tb][j]); t1[j] = q * fexp(cum[tb][j] - ref[j]); t2[j] = kk[tb][j] * fexp(ref[j] - cum[tb][j]); } \
                if (tb == 0) { qt0 = pack8(t1); kt0 = pack8(t2); } else { qt1 = pack8(t1); kt1 = pack8(t2); } } \
            MM(pd0, kt0, qt0); MM(pd1, kt1, qt1); if (dir == 0) MM(px, kt0, qt1); else MM(px, kt1, qt0); \
            { const s16x4 l0 = att::tr_read<v_rd_off64(0, ks, 0)>(vbS), h0 = att::tr_read<v_rd_off64(0, ks, 1)>(vbS), l1 = att::tr_read<v_rd_off64(1, ks, 0)>(vbS), h1 = att::tr_read<v_rd_off64(1, ks, 1)>(vbS); \
              asm volatile("s_waitcnt lgkmcnt(0)" ::: "memory"); SBAR(); \
              const bf16x8 s0 = SCN_PK(l0, h0), s1 = SCN_PK(l1, h1); \
              MM(o[0][0], qt0, s0); MM(o[1][0], qt1, s0); MM(o[0][1], qt0, s1); MM(o[1][1], qt1, s1); } \
            SBAR(); } while (0)
        KSTEP(0); KSTEP(1); KSTEP(2); KSTEP(3);
#undef KSTEP
#undef LOADX
#undef LOADQ
        const int r32m = r32;
#pragma unroll
        for (int r = 0; r < 16; ++r) { const int sl = crow(r, hi); const bool keep = dir == 0 ? (sl <= r32m) : (sl >= r32m); pd0[r] = keep ? pd0[r] : 0.f; pd1[r] = keep ? pd1[r] : 0.f; }
        bf16x8 a0, a1, b0, b1, c0, c1;
#define PK4(P, BASE, OUT) do { unsigned a0_ = cvt_pk_bf16(P[BASE + 0], P[BASE + 1]), a1_ = cvt_pk_bf16(P[BASE + 2], P[BASE + 3]);   \
    unsigned b0_ = cvt_pk_bf16(P[BASE + 4], P[BASE + 5]), b1_ = cvt_pk_bf16(P[BASE + 6], P[BASE + 7]);                              \
    auto r0_ = __builtin_amdgcn_permlane32_swap(a0_, b0_, false, false); auto r1_ = __builtin_amdgcn_permlane32_swap(a1_, b1_, false, false); \
    u32x4 w_ = {r0_[0], r1_[0], r0_[1], r1_[1]}; OUT = *reinterpret_cast<bf16x8*>(&w_); } while (0)
        PK4(pd0, 0, a0); PK4(pd0, 8, a1); PK4(pd1, 0, b0); PK4(pd1, 8, b1); PK4(px, 0, c0); PK4(px, 8, c1);
#undef PK4
        {   bf16x8 v0, v1, v2, v3;
#define BLOCK(D0) do { frags4<D0>(vbV, v0, v1, v2, v3); \
            if (dir == 0) { MM(o[0][D0], a0, v0); MM(o[0][D0], a1, v1); MM(o[1][D0], c0, v0); MM(o[1][D0], c1, v1); MM(o[1][D0], b0, v2); MM(o[1][D0], b1, v3); } \
            else          { MM(o[0][D0], a0, v0); MM(o[0][D0], a1, v1); MM(o[0][D0], c0, v2); MM(o[0][D0], c1, v3); MM(o[1][D0], b0, v2); MM(o[1][D0], b1, v3); } } while (0)
            BLOCK(0); BLOCK(1);
#undef BLOCK
        }
#undef MM
    }
    unsigned rob = (unsigned)(4 * hi * DP + r32) * 2u, mob = (unsigned)(4 * hi * D + r32) * 2u;
    asm volatile("" : "+v"(rob), "+v"(mob));
    float gv[2][16][2];
#pragma unroll
    for (int tb = 0; tb < 2; ++tb)
#pragma unroll
        for (int r = 0; r < 16; ++r) { const unsigned go = rob + (unsigned)(32 * tb + (r & 3) + 8 * (r >> 2)) * (DP * 2u); const bf16_t* gb = base + O_AG + h * 64;
            gv[tb][r][0] = ld1(gb, go); gv[tb][r][1] = ld1(gb, go + 64u); }
#pragma unroll
    for (int tb = 0; tb < 2; ++tb)
#pragma unroll
        for (int r = 0; r < 16; ++r) {
            const float x0 = o[tb][0][r], x1 = o[tb][1][r];
            float t = x0 * x0 + x1 * x1; t += bperm(t, lane ^ 1); t += bperm(t, lane ^ 2); t += bperm(t, lane ^ 4); t += bperm(t, lane ^ 8); t += bperm(t, lane ^ 16);
            const float ri = rsqrtf(t * (1.f / 64.f) + 1e-6f);
            const unsigned tcst = (unsigned)(32 * tb + (r & 3) + 8 * (r >> 2));
            const float g0 = gv[tb][r][0], g1 = gv[tb][r][1];
            char* mb = (char*)((bf16_t*)(p.ws + OFF_MIXB) + (size_t)(b * SL + 64 * tc) * D + h * 64); const unsigned mo = mob + tcst * (D * 2u);
            *(bf16_t*)(mb + mo) = (bf16_t)(cvt_pk_bf16(x0 * ri * p.hnorm[layer * 64 + r32] * (g0 * fsig(g0)), 0.f) & 0xffffu);
            *(bf16_t*)(mb + mo + 64u) = (bf16_t)(cvt_pk_bf16(x1 * ri * p.hnorm[layer * 64 + 32 + r32] * (g1 * fsig(g1)), 0.f) & 0xffffu);
        }
}

namespace scn {
DEV float logsig_f(float g) { return fminf(g, 0.f) - __logf(1.f + __expf(-fabsf(g))); }
DEV void gates_B(const bf16_t* gb  , unsigned rowoff, int dir, float bi, float bf, int lane, float (&cumf)[2], float (&g)[2], float (&G)[2], float& cend, float& gmax) {
    float lf[2], li[2];
#pragma unroll
    for (int tb = 0; tb < 2; ++tb) { const unsigned bo = rowoff + tb * (32u * DP * 2u); li[tb] = ld1(gb + (dir * 2 + 0) * 4, bo) + bi; lf[tb] = logsig_f(ld1(gb + (dir * 2 + 1) * 4, bo) + bf); }
    { const float i0 = scan_inc32(lf[0]), i1 = scan_inc32(lf[1]), t0 = bperm(i0, lane | 31), t1 = bperm(i1, lane | 31);
      if (dir == 0) { cumf[0] = i0; cumf[1] = i1 + t0; } else { cumf[1] = t1 - i1 + lf[1]; cumf[0] = t0 - i0 + lf[0] + t1; }
      cend = t0 + t1; }
    g[0] = li[0] - cumf[0]; g[1] = li[1] - cumf[1];
    if (dir == 0) { const float a0 = scanmax_inc32(g[0]), m0 = bperm(a0, lane | 31), a1 = fmaxf(scanmax_inc32(g[1]), m0); G[0] = a0; G[1] = a1; gmax = bperm(a1, lane | 31); }
    else { const float a1 = scanmax_suf32(g[1], lane), m1 = bperm(a1, lane & 32), a0 = fmaxf(scanmax_suf32(g[0], lane), m1); G[0] = a0; G[1] = a1; gmax = bperm(a0, lane & 32); }
}
}
DEV void scanB_local(const Params& p, int layer, char* Lw, int bh, int tc, int lane) {
    using namespace scn;
    asm volatile("" : "+v"(lane));
    const int r32 = lane & 31, hi = lane >> 5, b = bh >> 2, h = bh & 3;
    const bf16_t* base = (const bf16_t*)(p.ws + OFF_PB) + (size_t)(b * SL + 64 * tc) * DP;
    unsigned ro = (unsigned)(r32 * DP) * 2u; asm volatile("" : "+v"(ro));
    char* imgV = Lw; char* imgK = Lw + 8192;
    const int vbV = (int)(uintptr_t)imgV + att::v_rd_base(lane), vbK = vbV + 8192;
    stage64b(imgV, base + O_BV + h * 64, DP, lane);
#pragma unroll 1
    for (int dir = 0; dir < 2; ++dir) {
        const int chain = bh * 2 + dir, c = dir == 0 ? tc : (tc < 4 ? 3 - tc : 39 - tc);
        const float bi = p.mgb[layer * 16 + (dir * 2 + 0) * 4 + h], bf = p.mgb[layer * 16 + (dir * 2 + 1) * 4 + h];
        float cumf[2], g[2], G[2], cend, gmax;
        gates_B(base + O_BG + h, ro, dir, bi, bf, lane, cumf, g, G, cend, gmax);
        const float w[2] = {__expf(g[0] - gmax), __expf(g[1] - gmax)};
#pragma unroll
        for (int ks = 0; ks < 2; ++ks) {
            float un[8];
#pragma unroll
            for (int j = 0; j < 8; ++j) un[j] = 0.f;
#pragma unroll
            for (int tb = 0; tb < 2; ++tb) { float wk[8]; ld8(base + O_BK + h * 32 + 16 * ks, ro + 16u * hi + tb * (32u * DP * 2u), wk);
#pragma unroll
                for (int j = 0; j < 8; ++j) { wk[j] *= w[tb]; un[j] += wk[j]; }
                *(bf16x8*)(imgK + v_st64(32 * tb + r32, 16 * ks + 8 * hi)) = pack8(wk); }
#pragma unroll
            for (int j = 0; j < 8; ++j) { float t = un[j]; t += bperm(t, lane ^ 1); t += bperm(t, lane ^ 2); t += bperm(t, lane ^ 4); t += bperm(t, lane ^ 8); t += bperm(t, lane ^ 16);
                if (r32 == 0) ((float*)(p.ws + OFF_NB))[(chain * 36 + c) * 32 + 16 * ks + 8 * hi + j] = t; }
        }
        f32x16 u0 = {}, u1 = {};
        { bf16x8 k0, k1, k2, k3, v0, v1, v2, v3;
#define MM(acc, A, B) acc = __builtin_amdgcn_mfma_f32_32x32x16_bf16(A, B, acc, 0, 0, 0)
          frags4<0>(vbK, k0, k1, k2, k3); frags4<0>(vbV, v0, v1, v2, v3);
          MM(u0, k0, v0); MM(u0, k1, v1); MM(u0, k2, v2); MM(u0, k3, v3);
          frags4<1>(vbV, v0, v1, v2, v3);
          MM(u1, k0, v0); MM(u1, k1, v1); MM(u1, k2, v2); MM(u1, k3, v3);
#undef MM
        }
        float* U = (float*)(p.ws + OFF_UB) + ((size_t)chain * 36 + c) * 2048;
#pragma unroll
        for (int r = 0; r < 16; ++r) { U[crow(r, hi) * 64 + r32] = u0[r]; U[crow(r, hi) * 64 + 32 + r32] = u1[r]; }
        if (lane == 0) { float* M = (float*)(p.ws + OFF_MB) + (chain * 36 + c) * 4; M[0] = cend + gmax; M[1] = cend; }
    }
}
DEV void scanB_out(const Params& p, int layer, char* Lw, int bh, int tc, int lane) {
    using namespace scn;
    asm volatile("" : "+v"(lane));
    const int r32 = lane & 31, hi = lane >> 5, b = bh >> 2, h = bh & 3;
    const bf16_t* base = (const bf16_t*)(p.ws + OFF_PB) + (size_t)(b * SL + 64 * tc) * DP;
    unsigned ro = (unsigned)(r32 * DP) * 2u; asm volatile("" : "+v"(ro));
    char* imgV = Lw; char* imgC = Lw + 8192; float* gA = (float*)(Lw + 12288); float* dA = gA + 64;
    const int vbV = (int)(uintptr_t)imgV + att::v_rd_base(lane), vbC = vbV + 8192;
    stage64b(imgV, base + O_BV + h * 64, DP, lane);
#pragma unroll 1
    for (int dir = 0; dir < 2; ++dir) {
        const int chain = bh * 2 + dir, c = dir == 0 ? tc : (tc < 4 ? 3 - tc : 39 - tc);
        const float bi = p.mgb[layer * 16 + (dir * 2 + 0) * 4 + h], bf = p.mgb[layer * 16 + (dir * 2 + 1) * 4 + h];
        { const float* cg = (const float*)(p.ws + OFF_SB) + ((size_t)chain * 36 + c) * 2048 + (lane >> 1) * 64 + (lane & 1) * 32;
#pragma unroll
          for (int i = 0; i < 4; ++i) { const float4 a = *(const float4*)(cg + 8 * i), bq = *(const float4*)(cg + 8 * i + 4);
              u32x4 w = {cvt_pk_bf16(a.x, a.y), cvt_pk_bf16(a.z, a.w), cvt_pk_bf16(bq.x, bq.y), cvt_pk_bf16(bq.z, bq.w)};
              *(u32x4*)(imgC + v_st64(lane >> 1, (lane & 1) * 32 + 8 * i)) = w; } }
        const float m0 = ((const float*)(p.ws + OFF_MB))[(chain * 36 + c) * 4 + 2];
        float rq[2][2][8], rk[2][2][8];
#pragma unroll
        for (int ks = 0; ks < 2; ++ks)
#pragma unroll
            for (int tb = 0; tb < 2; ++tb) { const unsigned bo = ro + 16u * hi + tb * (32u * DP * 2u);
                ld8(base + O_BQ + h * 32 + 16 * ks, bo, rq[ks][tb]); ld8(base + O_BK + h * 32 + 16 * ks, bo, rk[ks][tb]); }
        float cumf[2], g[2], G[2], cend, gmax;
        gates_B(base + O_BG + h, ro, dir, bi, bf, lane, cumf, g, G, cend, gmax);
        float wi[2], wl[2], emt[2];
#pragma unroll
        for (int tb = 0; tb < 2; ++tb) { const float ml = cumf[tb] + G[tb], mt = fmaxf(cumf[tb] + m0, ml); wi[tb] = __expf(cumf[tb] + m0 - mt); wl[tb] = __expf(ml - mt); emt[tb] = __expf(-mt); }
        if (hi == 0) { gA[r32] = g[0]; gA[32 + r32] = g[1]; }
        f32x16 pd0 = {}, pd1 = {}, px = {};
        float qn[2] = {0.f, 0.f};
        bf16x8 qw[2][2];
#define MM(acc, A, B) acc = __builtin_amdgcn_mfma_f32_32x32x16_bf16(A, B, acc, 0, 0, 0)
#define KSTEP(ks) do { \
            bf16x8 qs0, qs1, kt0, kt1; \
            const float* nn = (const float*)(p.ws + OFF_N0) + (chain * 36 + c) * 32 + 16 * (ks) + 8 * hi; \
            _Pragma("unroll") for (int tb = 0; tb < 2; ++tb) { \
                float q8[8], k8[8], qv[8]; \
                _Pragma("unroll") for (int j = 0; j < 8; ++j) { q8[j] = rq[ks][tb][j] * 0.17677669529663687f; k8[j] = rk[ks][tb][j]; qn[tb] += q8[j] * nn[j]; qv[j] = q8[j] * wi[tb]; } \
                qw[tb][ks] = pack8(qv); \
                if (tb == 0) { qs0 = pack8(q8); kt0 = pack8(k8); } else { qs1 = pack8(q8); kt1 = pack8(k8); } } \
            MM(pd0, kt0, qs0); MM(pd1, kt1, qs1); if (dir == 0) MM(px, kt0, qs1); else MM(px, kt1, qs0); \
            SBAR(); } while (0)
        KSTEP(0); KSTEP(1);
#undef KSTEP
        qn[0] += bperm(qn[0], lane ^ 32); qn[1] += bperm(qn[1], lane ^ 32);
        float ds[2] = {0.f, 0.f};
#pragma unroll
        for (int r = 0; r < 16; ++r) {
            const int sl = crow(r, hi); const bool keep = dir == 0 ? (sl <= r32) : (sl >= r32);
            const float g0 = gA[sl], g1 = gA[32 + sl];
            const float e00 = keep ? __expf(g0 - G[0]) * wl[0] : 0.f, e11 = keep ? __expf(g1 - G[1]) * wl[1] : 0.f;
            const float ex = dir == 0 ? __expf(g0 - G[1]) * wl[1] : __expf(g1 - G[0]) * wl[0];
            pd0[r] *= e00; pd1[r] *= e11; px[r] *= ex;
            if (dir == 0) { ds[0] += pd0[r]; ds[1] += pd1[r] + px[r]; } else { ds[0] += pd0[r] + px[r]; ds[1] += pd1[r]; }
        }
        ds[0] += bperm(ds[0], lane ^ 32); ds[1] += bperm(ds[1], lane ^ 32);
#pragma unroll
        for (int tb = 0; tb < 2; ++tb) { const float den = wi[tb] * qn[tb] + ds[tb]; const float di = __builtin_amdgcn_rcpf(fmaxf(fabsf(den), emt[tb])); if (hi == 0) dA[32 * tb + r32] = di; }
        bf16x8 a0, a1, b0, b1, c0, c1;
#define PK4(P, BASE, OUT) do { unsigned a0_ = cvt_pk_bf16(P[BASE + 0], P[BASE + 1]), a1_ = cvt_pk_bf16(P[BASE + 2], P[BASE + 3]);   \
    unsigned b0_ = cvt_pk_bf16(P[BASE + 4], P[BASE + 5]), b1_ = cvt_pk_bf16(P[BASE + 6], P[BASE + 7]);                              \
    auto r0_ = __builtin_amdgcn_permlane32_swap(a0_, b0_, false, false); auto r1_ = __builtin_amdgcn_permlane32_swap(a1_, b1_, false, false); \
    u32x4 w_ = {r0_[0], r1_[0], r0_[1], r1_[1]}; OUT = *reinterpret_cast<bf16x8*>(&w_); } while (0)
        PK4(pd0, 0, a0); PK4(pd0, 8, a1); PK4(pd1, 0, b0); PK4(pd1, 8, b1); PK4(px, 0, c0); PK4(px, 8, c1);
#undef PK4
        SBAR();
        f32x16 o[2][2] = {};
        {   bf16x8 v0, v1, v2, v3;
#define BLOCK(D0) do { frags4<D0>(vbV, v0, v1, v2, v3); \
            if (dir == 0) { MM(o[0][D0], a0, v0); MM(o[0][D0], a1, v1); MM(o[1][D0], c0, v0); MM(o[1][D0], c1, v1); MM(o[1][D0], b0, v2); MM(o[1][D0], b1, v3); } \
            else          { MM(o[0][D0], a0, v0); MM(o[0][D0], a1, v1); MM(o[0][D0], c0, v2); MM(o[0][D0], c1, v3); MM(o[1][D0], b0, v2); MM(o[1][D0], b1, v3); } \
            { const s16x4 l0 = att::tr_read<v_rd_off64(D0, 0, 0)>(vbC), h0 = att::tr_read<v_rd_off64(D0, 0, 1)>(vbC), l1 = att::tr_read<v_rd_off64(D0, 1, 0)>(vbC), h1 = att::tr_read<v_rd_off64(D0, 1, 1)>(vbC); \
              asm volatile("s_waitcnt lgkmcnt(0)" ::: "memory"); SBAR(); \
              const bf16x8 s0 = SCN_PK(l0, h0), s1 = SCN_PK(l1, h1); \
              MM(o[0][D0], qw[0][0], s0); MM(o[0][D0], qw[0][1], s1); MM(o[1][D0], qw[1][0], s0); MM(o[1][D0], qw[1][1], s1); } } while (0)
            BLOCK(0); BLOCK(1);
#undef BLOCK
        }
#undef MM
        asm volatile("s_waitcnt lgkmcnt(0)" ::: "memory");
        unsigned rob = (unsigned)(4 * hi * DP + r32) * 2u, mob = (unsigned)(4 * hi * D + r32) * 2u, hob = (unsigned)(4 * hi * 256 + r32) * 4u;
        asm volatile("" : "+v"(rob), "+v"(mob), "+v"(hob));
        float* hpk = (float*)(p.ws + OFF_HB2) + (size_t)(b * SL + 64 * tc) * 256 + h * 64;
        if (dir == 0) {
#pragma unroll
            for (int tb = 0; tb < 2; ++tb)
#pragma unroll
                for (int r = 0; r < 16; ++r) { const float di = dA[32 * tb + crow(r, hi)]; const unsigned ho = hob + (unsigned)(32 * tb + (r & 3) + 8 * (r >> 2)) * 1024u;
                    *(float*)((char*)hpk + ho) = o[tb][0][r] * di; *(float*)((char*)hpk + ho + 128u) = o[tb][1][r] * di; }
            asm volatile("s_waitcnt vmcnt(0)" ::: "memory");
        } else {
#pragma unroll
            for (int tb = 0; tb < 2; ++tb)
#pragma unroll
                for (int r = 0; r < 16; ++r) {
                    const unsigned tcst = (unsigned)(32 * tb + (r & 3) + 8 * (r >> 2)); const unsigned ho = hob + tcst * 1024u;
                    const float di = dA[32 * tb + crow(r, hi)];
                    const float x0 = o[tb][0][r] * di + ldg1(hpk, ho), x1 = o[tb][1][r] * di + ldg1(hpk, ho + 128u);
                    float t = x0 * x0 + x1 * x1; t += bperm(t, lane ^ 1); t += bperm(t, lane ^ 2); t += bperm(t, lane ^ 4); t += bperm(t, lane ^ 8); t += bperm(t, lane ^ 16);
                    const float ri = rsqrtf(t * (1.f / 64.f) + 1e-6f);
                    const bf16_t* gb = base + O_BO + h * 64; const unsigned go = rob + tcst * (DP * 2u);
                    const float g0 = ld1(gb, go), g1 = ld1(gb, go + 64u);
                    char* mb = (char*)((bf16_t*)(p.ws + OFF_MIXB) + (size_t)(b * SL + 64 * tc) * D + 256 + h * 64); const unsigned mo = mob + tcst * (D * 2u);
                    *(bf16_t*)(mb + mo) = (bf16_t)(cvt_pk_bf16(x0 * ri * p.mnorm[layer * 256 + h * 64 + r32] * fsig(g0), 0.f) & 0xffffu);
                    *(bf16_t*)(mb + mo + 64u) = (bf16_t)(cvt_pk_bf16(x1 * ri * p.mnorm[layer * 256 + h * 64 + 32 + r32] * fsig(g1), 0.f) & 0xffffu);
                    if ((r & 3) == 3) SBAR();
                }
        }
    }
}

DEV int scan_token(int dir, int step) { return dir == 0 ? step : (step < CTX ? CTX - 1 - step : SL + CTX - 1 - step); }
DEV float logsig(float g) { return fminf(g, 0.f) - log1pf(expf(-fabsf(g))); }
DEV void ph_scan_local(const Params& p, int layer, char* smem) {
    const int wid = p.wave_id;
    const int G = (int)gridDim.x, nw = G * 8, nun = (NT / 256) * (DP / 256), nleft = 4 * G < nun ? nun - 4 * G : 0, nfree = G - nleft > 0 ? G - nleft : G;
    for (int it = 0; it < 2; ++it) {
        int task;
        if (it == 0) task = (int)blockIdx.x * 8 + wid;
        else { if ((int)blockIdx.x >= nfree) break; task = nw + wid * nfree + (int)blockIdx.x; }
        if (task >= 2304) break;
        const int lane = lane_asm();
        if (task < 1152) scanA_local(p, layer, smem + wid * 16384, task / 36, task % 36, lane);
        else scanB_local(p, layer, smem + wid * 16384, (task - 1152) / 36, (task - 1152) % 36, lane);
    }
}
DEV void ph_scan_carry(const Params& p, char* smem) {
    const int tid = tid_of(p.wave_id);
    const int gt = (int)blockIdx.x * 512 + tid, nth = (int)gridDim.x * 512;
    for (int e = gt; e < 64 * 4096; e += nth) {
        const int chain = e >> 12, kv = e & 4095, k = kv >> 6;
        const float* U = (const float*)(p.ws + OFF_UA) + (size_t)chain * 36 * 4096 + kv; float* SO = (float*)(p.ws + OFF_SA) + (size_t)chain * 36 * 4096 + kv; const float* Dc = (const float*)(p.ws + OFF_DECA) + chain * 36 * 64 + k;
        float S = 0.f;
#pragma unroll 4
        for (int c = 0; c < 36; ++c) { const float u = U[(size_t)c * 4096], d = Dc[c * 64]; SO[(size_t)c * 4096] = S; S = d * S + u; }
    }
    for (int e = gt; e < 64 * 2048; e += nth) {
        const int chain = e >> 11, kv = e & 2047;
        const float* U = (const float*)(p.ws + OFF_UB) + (size_t)chain * 36 * 2048 + kv; float* SO = (float*)(p.ws + OFF_SB) + (size_t)chain * 36 * 2048 + kv; const float* M = (const float*)(p.ws + OFF_MB) + chain * 36 * 4;
        float Cc = 0.f, m = 0.f;
#pragma unroll 4
        for (int c = 0; c < 36; ++c) { const float mle = M[c * 4 + 0], ce = M[c * 4 + 1], u = U[(size_t)c * 2048]; SO[(size_t)c * 2048] = Cc;
            const float mn = fmaxf(ce + m, mle); Cc = expf(ce + m - mn) * Cc + expf(mle - mn) * u; m = mn; }
    }
    for (int e = gt; e < 64 * 32; e += nth) {
        const int chain = e >> 5, k = e & 31;
        const float* N = (const float*)(p.ws + OFF_NB) + chain * 36 * 32 + k; float* NO = (float*)(p.ws + OFF_N0) + chain * 36 * 32 + k; float* M = (float*)(p.ws + OFF_MB) + chain * 36 * 4;
        float nn = 0.f, m = 0.f;
        for (int c = 0; c < 36; ++c) { const float mle = M[c * 4 + 0], ce = M[c * 4 + 1], u = N[c * 32]; NO[c * 32] = nn; if (k == 0) M[c * 4 + 2] = m;
            const float mn = fmaxf(ce + m, mle); nn = expf(ce + m - mn) * nn + expf(mle - mn) * u; m = mn; }
    }
}
DEV void ph_scan_out(const Params& p, int layer, char* smem) {
    const int wid = p.wave_id;
    const int nw = (int)gridDim.x * 8, ntc = layer == 0 ? 36 : 32, tc0 = layer == 0 ? 0 : 4, half = 32 * ntc, total = 2 * half;
    for (int it = 0; it < 2 + (total - nw > 0 ? (total - nw) / (int)gridDim.x : 0); ++it) {
        int task;
        if (it == 0) task = (int)blockIdx.x * 8 + wid;
        else { if (wid != 0) break; task = nw + (it - 1) * (int)gridDim.x + (int)blockIdx.x; }
        if (task >= total) break;
        const int lane = lane_asm();
        const bool isB = task >= half; const int tt = isB ? task - half : task, bh = tt / ntc, tc = tc0 + tt % ntc;
        if (!isB) scanA_out(p, layer, smem + wid * 16384, bh, tc, lane);
        else scanB_out(p, layer, smem + wid * 16384, bh, tc, lane);
    }
}

DEV void ph_attn(const Params& p, int layer, char* smem) {
    const int wid = p.wave_id, js = wid & 1, qb = wid >> 1;
    const float lam = ((const float*)(p.ws + OFF_LAM))[layer], omli = 1.f - lam_init_of(layer);
    const bf16_t* KB = (const bf16_t*)(p.ws + OFF_KB); const bf16_t* VB = (const bf16_t*)(p.ws + OFF_VB);
    const bf16_t* QRB = (const bf16_t*)(p.ws + OFF_QRB); const bf16_t* Q0B = (const bf16_t*)(p.ws + OFF_Q0B);
    const int G = (int)gridDim.x, c = (int)blockIdx.x;
    const int nlat = 512, ntot = nlat + (layer == 0 ? 64 : 0);
    for (int i = 0;; ++i) {
        int bh, s0; bool isctx;
        if (G == 256) {
            const int xcd = c & 7, j = c >> 3;
            if (i < 2) { bh = xcd + 8 * (i * 2 + (j >> 4)); s0 = CTX + (j & 15) * 128; isctx = false; }
            else if (i == 2 && layer == 0 && j < 8) { bh = xcd + 8 * (j >> 1); s0 = (j & 1) * 128; isctx = true; }
            else break;
        } else {
            const int u = i * G + c; if (u >= ntot) break;
            if (u < nlat) { bh = u >> 4; s0 = CTX + (u & 15) * 128; isctx = false; } else { const int v = u - nlat; bh = v >> 1; s0 = (v & 1) * 128; isctx = true; }
        }
        const int lane = lane_asm(), tid = (wid << 6) | lane, r32 = lane & 31, hi = lane >> 5;
        const bf16_t* Kh = KB + (size_t)bh * SL * 128; const bf16_t* Vh = VB + (size_t)bh * SL * 128;
        const size_t qoff = ((size_t)bh * SL + s0 + qb * 32 + r32) * 128 + js * 64 + hi * 8;
        att::bf16x8 qr[4];
#pragma unroll
        for (int d0 = 0; d0 < 4; ++d0) qr[d0] = *(const att::bf16x8*)(Q0B + qoff + d0 * 16);
        float m_reg = -1e30f, l_reg = 0.f; att::f32x16 o[4] = {};
        att::attn_tiles(qr, Kh, Vh, CTX, smem, m_reg, l_reg, o, tid, js);
        if (!isctx) {
#pragma unroll
            for (int d0 = 0; d0 < 4; ++d0) qr[d0] = *(const att::bf16x8*)(QRB + qoff + d0 * 16);
            att::attn_tiles(qr, Kh + (size_t)CTX * 128, Vh + (size_t)CTX * 128, SEQ, smem, m_reg, l_reg, o, tid, js);
        }
        float* wsw = (float*)(smem + 2 * att::SHM_V + 2 * att::SHM_K) + wid * 64;
        __syncthreads();
        if (hi == 0) wsw[r32] = l_reg;
        asm volatile("s_waitcnt lgkmcnt(0)" ::: "memory");
        float rli[16];
#pragma unroll
        for (int r = 0; r < 16; ++r) rli[r] = __builtin_amdgcn_rcpf(wsw[att::crow(r, hi)]);
        float* X = (float*)smem + qb * 4096;
        if (js == 1) {
#pragma unroll
            for (int d0 = 0; d0 < 4; ++d0)
#pragma unroll
                for (int r = 0; r < 16; ++r) X[(d0 * 16 + r) * 64 + lane] = o[d0][r] * rli[r];
        }
        __syncthreads();
        if (js == 0) {
            const int b = bh >> 2, h = bh & 3;
            float ss[16];
#pragma unroll
            for (int r = 0; r < 16; ++r) ss[r] = 0.f;
#pragma unroll
            for (int d0 = 0; d0 < 4; ++d0)
#pragma unroll
                for (int r = 0; r < 16; ++r) { const float v = o[d0][r] * rli[r] - lam * X[(d0 * 16 + r) * 64 + lane]; o[d0][r] = v; ss[r] += v * v; }
#pragma unroll
            for (int r = 0; r < 16; ++r) { float t = ss[r]; t += __shfl_xor(t, 1); t += __shfl_xor(t, 2); t += __shfl_xor(t, 4); t += __shfl_xor(t, 8); t += __shfl_xor(t, 16);
                ss[r] = rsqrtf(t * (1.f / 128.f) + 1e-6f) * omli; }
            bf16_t* Tq = (bf16_t*)X;
#pragma unroll
            for (int d0 = 0; d0 < 4; ++d0) { const float g = p.dnorm[layer * 128 + d0 * 32 + r32];
#pragma unroll
                for (int r = 0; r < 16; ++r) Tq[att::crow(r, hi) * 128 + d0 * 32 + r32] = (bf16_t)(cvt_pk_bf16(o[d0][r] * ss[r] * g, 0.f) & 0xffffu); }
            char* mixb = (char*)((bf16_t*)(p.ws + OFF_MIXB) + (size_t)(b * SL + s0 + qb * 32) * D + 512 + h * 128);
#pragma unroll
            for (int k = 0; k < 8; ++k) { const int idx = lane + 64 * k, row = idx >> 4, ch = idx & 15;
                *(pg8::u32x4*)(mixb + (size_t)row * (D * 2) + ch * 16) = *(const pg8::u32x4*)((const char*)Tq + row * 256 + ch * 16); }
        }
        __syncthreads();
    }
}

struct EpiRowsBf16 {
    static constexpr bool PERM = true;
    bf16_t* O; int ldc;
    DEV void operator()(const pg8::f32x4 (&acc)[2][2][4][2], const pg8::Unit& u, int wr, int wc, int fr, int fq) const {
        const int row0 = u.pm * 256 + wr * 64 + fr, col0 = u.pn * 256 + wc * 32 + 8 * fq;
#pragma unroll
        for (int ai = 0; ai < 2; ++ai)
#pragma unroll
            for (int m = 0; m < 4; ++m) { bf16_t* rowp = O + (size_t)(row0 + ai * 128 + m * 16) * ldc + col0;
#pragma unroll
                for (int bj = 0; bj < 2; ++bj) { const pg8::f32x4 v0 = acc[ai][bj][m][0], v1 = acc[ai][bj][m][1];
                    pg8::u32x4 w; w.x = cvt_pk_bf16(v0[0], v0[1]); w.y = cvt_pk_bf16(v0[2], v0[3]); w.z = cvt_pk_bf16(v1[0], v1[1]); w.w = cvt_pk_bf16(v1[2], v1[3]);
                    *(pg8::u32x4*)(rowp + bj * 128) = w; } }
    }
};
DEV void ph_outproj(const Params& p, int layer, char* smem) {
    const int tidx = tid_of(p.wave_id);
    pg8::StaticOrder S; S.init(layer == 0 ? NT / 256 : NB * 8, D / 256, (int)gridDim.x, (int)blockIdx.x, layer == 0 ? 0 : 1, (const bf16_t*)(p.ws + OFF_WOUT) + (size_t)layer * D * D, D);
    EpiRowsBf16 E{(bf16_t*)(p.ws + OFF_MIXO), D};
    pg8::gemm_phase((LAS unsigned char*)smem, (const char*)(p.ws + OFF_MIXB), D, S, E, tid_of(p.wave_id));
}
DEV void ph_norm2(const Params& p, int layer, char* smem) {
    typedef float f32x16 __attribute__((ext_vector_type(16)));
    const int wid = p.wave_id, lane = lane_asm(), tidx = (wid << 6) | lane;
    constexpr int XP = 1028, RP = 24;
    float* xs = (float*)smem;
    float* red = (float*)smem;
    int* hist = (int*)(smem + 32 * XP * 4);
    int* offl = hist + 32;
    int* sel = hist + 64;
    const float* nr = p.norms + (size_t)layer * 4 * D;
    if (tidx < NE) hist[tidx] = 0;
    const int chunk = (NT + (int)gridDim.x - 1) / (int)gridDim.x, rbeg = (int)blockIdx.x * chunk, rend = min(NT, rbeg + chunk);
    for (int i = tidx; i < chunk * 4; i += 512) sel[i] = -1;
    float4 cA[4], cB[4], cC[4]; int ckey = -1;
    float wreg[64];
    { const float* wb = p.rw + (size_t)layer * D * NE + (size_t)(wid * 128 + (lane >> 5)) * NE + (lane & 31);
#pragma unroll
      for (int ks = 0; ks < 64; ++ks) wreg[ks] = wb[(size_t)2 * ks * NE]; }
    for (int r0 = rbeg; r0 < rend; r0 += RP) {
        __syncthreads();
#pragma unroll 1
        for (int j = 0; j < 3; ++j) {
            const int lr = wid * 3 + j, r = r0 + lr;
            if (r >= rend) continue;
            const int b = r / SL, s = r % SL;
            if (layer != 0 && s < CTX) continue;
            float4 mo[4], xv[4], o[4]; row_load_bf((const bf16_t*)(p.ws + OFF_MIXO) + (size_t)r * D, mo, lane); row_load_bf((const bf16_t*)(p.ws + OFF_X) + (size_t)r * D, xv, lane);
            { const int key = s < CTX ? 8 : b;
              if (key != ckey) { ckey = key; const float* m = modrow(p, layer, b, s);
#pragma unroll
                  for (int i = 0; i < 4; ++i) { const int idx = i * 256 + lane * 4; const float4 g = *(const float4*)(nr + D + idx), gt = *(const float4*)(m + 2048 + idx), gn = *(const float4*)(nr + 2 * D + idx), sh = *(const float4*)(m + 3072 + idx), sc = *(const float4*)(m + 4096 + idx);
                      cA[i] = make_float4(g.x * gt.x, g.y * gt.y, g.z * gt.z, g.w * gt.w); cB[i] = make_float4(gn.x * (1.f + sc.x), gn.y * (1.f + sc.y), gn.z * (1.f + sc.z), gn.w * (1.f + sc.w)); cC[i] = sh; } } }
            const float ri = row_rinv(mo);
#pragma unroll
            for (int i = 0; i < 4; ++i) { xv[i].x += cA[i].x * (mo[i].x * ri); xv[i].y += cA[i].y * (mo[i].y * ri); xv[i].z += cA[i].z * (mo[i].z * ri); xv[i].w += cA[i].w * (mo[i].w * ri); }
            row_store_bf16((bf16_t*)(p.ws + OFF_XN) + (size_t)r * D, xv, lane);
            { const float rn = row_rinv(xv);
#pragma unroll
              for (int i = 0; i < 4; ++i) o[i] = make_float4(xv[i].x * rn * cB[i].x + cC[i].x, xv[i].y * rn * cB[i].y + cC[i].y, xv[i].z * rn * cB[i].z + cC[i].z, xv[i].w * rn * cB[i].w + cC[i].w); }
            row_store_fp8((unsigned char*)(p.ws + OFF_XNB) + (size_t)r * D, o, lane, F8_SX);
            row_store(xs + lr * XP, o, lane);
        }
        __syncthreads();
        f32x16 acc = {};
        { const float* xa = xs + (lane & 31) * XP + wid * 128 + (lane >> 5);
#pragma unroll
          for (int ks = 0; ks < 64; ++ks) acc = __builtin_amdgcn_mfma_f32_32x32x2f32(xa[2 * ks], wreg[ks], acc, 0, 0, 0); }
        __syncthreads();
#pragma unroll
        for (int rg = 0; rg < 16; ++rg) red[(wid * 32 + (rg & 3) + 8 * (rg >> 2) + 4 * (lane >> 5)) * 32 + (lane & 31)] = acc[rg];
        __syncthreads();
#pragma unroll 1
        for (int j = 0; j < 3; ++j) {
            const int lr = wid * 3 + j, r = r0 + lr;
            if (r >= rend) continue;
            const int s = r % SL;
            if (layer != 0 && s < CTX) continue;
            const int e = lane & 31;
            float logit = p.rb[layer * NE + e];
#pragma unroll
            for (int w = 0; w < 8; ++w) logit += red[(w * 32 + lr) * 32 + e];
            float tv[4]; int ti[4];
#pragma unroll
            for (int k = 0; k < 4; ++k) {
                float bv = logit; int bi = e;
                for (int o2 = 16; o2 >= 1; o2 >>= 1) { const float ov = __shfl_xor(bv, o2); const int oi = __shfl_xor(bi, o2); if (ov > bv || (ov == bv && oi < bi)) { bv = ov; bi = oi; } }
                tv[k] = bv; ti[k] = bi; if (e == bi) logit = -3.0e38f;
            }
            const float e0 = 1.f, e1 = expf(tv[1] - tv[0]), e2 = expf(tv[2] - tv[0]), e3 = expf(tv[3] - tv[0]), inv = 1.f / (e0 + e1 + e2 + e3);
            if (lane == 0) { *(float4*)(((float*)(p.ws + OFF_TOPW)) + (size_t)r * 4) = make_float4(e0 * inv, e1 * inv, e2 * inv, e3 * inv); *(int4*)(((int*)(p.ws + OFF_TOPI)) + (size_t)r * 4) = make_int4(ti[0], ti[1], ti[2], ti[3]); }
            if (lane < 4) { const int es = lane == 0 ? ti[0] : lane == 1 ? ti[1] : lane == 2 ? ti[2] : ti[3]; atomicAdd(&hist[es], 1); sel[(r - rbeg) * 4 + lane] = es; }
        }
    }
    __syncthreads();
    if (tidx < NE) { const int h = hist[tidx]; offl[tidx] = h ? (int)__hip_atomic_fetch_add((unsigned*)(p.ws + OFF_bar) + CW_CNT + layer * NE + tidx, (unsigned)h, __ATOMIC_RELAXED, __HIP_MEMORY_SCOPE_AGENT) : 0; }
    __syncthreads();
    for (int i = tidx; i < (rend - rbeg) * 4; i += 512) { const int e = sel[i];
        if (e >= 0) { const int pos = atomicAdd(&offl[e], 1); ((int*)(p.ws + OFF_LIST))[(size_t)e * LISTCAP + pos] = rbeg * 4 + i; } }
}
DEV int moe_rt(int i, int G, int c, int npn, int& pn) {
    if (G == 256) { const int xcd = c & 7, j = c >> 3, rpx = 32 / npn; pn = j % npn; return (i * 8 + xcd) * rpx + j / npn; }
    const int L = i * G + c; pn = L % npn; return L / npn;
}
constexpr int MOE_LDS = 131072, MOE_MAXU = 12;
DEV void moe_prepare(const Params& p, int layer, char* smem, int npn, int mode) {
    const int tidx = tid_of(p.wave_id);
    LAS int* base = (LAS int*)(smem + MOE_LDS);
    LAS int *TE = base, *TT = base + 320, *NRT = base + 640, *CN = base + 656  , *UI = base + 704, *IDX = base + 768;
    if (tidx < NE) CN[tidx] = ((const int*)(p.ws + OFF_bar))[CW_CNT + layer * NE + tidx];
    __syncthreads();
    if (tidx < 320) { int e = 0, acc = 0; for (; e < NE; ++e) { const int n = (CN[e] + 255) >> 8; if (tidx < acc + n) break; acc += n; } TE[tidx] = e; TT[tidx] = tidx - acc; }
    if (tidx == 0) { int tot = 0; for (int e = 0; e < NE; ++e) tot += (CN[e] + 255) >> 8; NRT[0] = tot; }
    __syncthreads();
    const int nrt = NRT[0];
#pragma unroll
    for (int k = 0; k < (MOE_MAXU * 256) / 512; ++k) {
        const int idx = tidx + 512 * k, i = idx >> 8, row = idx & 255;
        int pn; const int rt = moe_rt(i, (int)gridDim.x, (int)blockIdx.x, npn, pn);
        if (rt < nrt) { const int e = TE[rt], t = TT[rt], c = CN[e], q = t * 256 + row;
            const int pair = ((const int*)(p.ws + OFF_LIST))[(size_t)e * LISTCAP + min(q, c - 1)];
            IDX[idx] = mode == 1 ? (pair >> 2) : (q < c ? pair : -1); }
    }
    if (tidx < MOE_MAXU) { int pn; const int rt = moe_rt(tidx, (int)gridDim.x, (int)blockIdx.x, npn, pn);
        if (rt < nrt) { const int e = TE[rt], t = TT[rt], c = CN[e]; int pre = 0; for (int z = 0; z < e; ++z) pre += CN[z]; UI[tidx * 4 + 0] = min(256, c - t * 256); UI[tidx * 4 + 1] = pre + t * 256; } }
    __syncthreads();
}
struct MoeOrder {
    const LAS int *te, *ui, *idx; int nrt, npn, G, c, gather; const char* Bt; size_t bstride; int K;
    DEV bool next(int i, pg8::Unit& u) const { int pn; const int rt = moe_rt(i, G, c, npn, pn); if (rt >= nrt || i >= MOE_MAXU) return false;
        u.pm = rt; u.pn = pn; u.e = __builtin_amdgcn_readfirstlane(te[rt]); u.t = i; return true; }
    DEV int arow(const pg8::Unit& u, int rr) const { return gather ? idx[u.t * 256 + rr] : ui[u.t * 4 + 1] + rr; }
    DEV const char* bbase(const pg8::Unit& u) const { return Bt + (size_t)u.e * bstride + (size_t)u.pn * pg8::BM * K * 2; }
};
DEV float swiglu(float g, float l) { g = fminf(g, 7.f); l = fminf(fmaxf(l, -7.f), 7.f); return g * __builtin_amdgcn_rcpf(1.f + __builtin_amdgcn_exp2f(-1.702f * 1.4426950408889634f * g)) * (l + 1.f); }
struct EpiSwiglu {
    static constexpr bool PERM = true;
    unsigned char* H; const float* b1; const LAS int* ui;
    DEV void operator()(const pg8::f32x4 (&acc)[2][2][4][2], const pg8::Unit& u, int wr, int wc, int fr, int fq) const {
        const int ucnt = ui[u.t * 4 + 0], hrow0 = ui[u.t * 4 + 1], col0 = u.pn * 256 + wc * 32 + 8 * fq;
        const float* bb = b1 + (size_t)u.e * 2048 + col0;
        pg8::f32x4 bv[2][2];
#pragma unroll
        for (int bj = 0; bj < 2; ++bj)
#pragma unroll
            for (int n = 0; n < 2; ++n) bv[bj][n] = *(const pg8::f32x4*)(bb + bj * 128 + 4 * n);
        __builtin_amdgcn_s_waitcnt(0x0F70);
#pragma unroll
        for (int ai = 0; ai < 2; ++ai)
#pragma unroll
            for (int m = 0; m < 4; ++m) { const int rr = ai * 128 + wr * 64 + m * 16 + fr;
                if (rr < ucnt) { unsigned char* rowp = H + (size_t)(hrow0 + rr) * DFF + (col0 >> 1);
#pragma unroll
                    for (int bj = 0; bj < 2; ++bj) { constexpr float DS = 1.f / (F8_SX * F8_SW); const pg8::f32x4 v0 = acc[ai][bj][m][0] * DS + bv[bj][0], v1 = acc[ai][bj][m][1] * DS + bv[bj][1];
                        *(unsigned*)(rowp + bj * 64) = pk4_fp8(F8_SH * swiglu(v0[0], v0[1]), F8_SH * swiglu(v0[2], v0[3]), F8_SH * swiglu(v1[0], v1[1]), F8_SH * swiglu(v1[2], v1[3])); } } }
    }
};
struct EpiY {
    static constexpr bool PERM = true;
    bf16_t* Y; const LAS int* idx; const float* b2;
    DEV void operator()(const pg8::f32x4 (&acc)[2][2][4][2], const pg8::Unit& u, int wr, int wc, int fr, int fq) const {
        const int col0 = u.pn * 256 + wc * 32 + 8 * fq;
        const float* bb = b2 + (size_t)u.e * D + col0;
        pg8::f32x4 bv[2][2];
#pragma unroll
        for (int bj = 0; bj < 2; ++bj)
#pragma unroll
            for (int n = 0; n < 2; ++n) bv[bj][n] = *(const pg8::f32x4*)(bb + bj * 128 + 4 * n);
        __builtin_amdgcn_s_waitcnt(0x0F70);
#pragma unroll
        for (int ai = 0; ai < 2; ++ai)
#pragma unroll
            for (int m = 0; m < 4; ++m) { const int rr = ai * 128 + wr * 64 + m * 16 + fr; const int pair = idx[u.t * 256 + rr];
                if (pair >= 0) { bf16_t* rowp = Y + (size_t)pair * D + col0;
#pragma unroll
                    for (int bj = 0; bj < 2; ++bj) { constexpr float DS = 1.f / (F8_SH * F8_SW); const pg8::f32x4 v0 = acc[ai][bj][m][0] * DS + bv[bj][0], v1 = acc[ai][bj][m][1] * DS + bv[bj][1];
                        pg8::u32x4 w; w.x = cvt_pk_bf16(v0[0], v0[1]); w.y = cvt_pk_bf16(v0[2], v0[3]); w.z = cvt_pk_bf16(v1[0], v1[1]); w.w = cvt_pk_bf16(v1[2], v1[3]);
                        *(pg8::u32x4*)(rowp + bj * 128) = w; } } }
    }
};
DEV void ph_moe1(const Params& p, int layer, char* smem) {
    moe_prepare(p, layer, smem, 8, 1);
    LAS int* base = (LAS int*)(smem + MOE_LDS);
    MoeOrder S{base, base + 704, base + 768, base[640], 8, (int)gridDim.x, (int)blockIdx.x, 1, (const char*)(p.ws + OFF_W1T) + (size_t)layer * NE * 2048 * D, (size_t)2048 * D, D / 2};
    EpiSwiglu E{(unsigned char*)(p.ws + OFF_H), p.b1 + (size_t)layer * NE * 2048, base + 704};
    pg8::gemm_phase<EpiSwiglu, MoeOrder, true>((LAS unsigned char*)smem, (const char*)(p.ws + OFF_XNB), D / 2, S, E, tid_of(p.wave_id));
}
DEV void ph_moe2(const Params& p, int layer, char* smem) {
    moe_prepare(p, layer, smem, 4, 2);
    LAS int* base = (LAS int*)(smem + MOE_LDS);
    MoeOrder S{base, base + 704, base + 768, base[640], 4, (int)gridDim.x, (int)blockIdx.x, 0, (const char*)(p.ws + OFF_W2T) + (size_t)layer * NE * D * DFF, (size_t)D * DFF, DFF / 2};
    EpiY E{(bf16_t*)(p.ws + OFF_Y), base + 768, p.b2 + (size_t)layer * NE * D};
    pg8::gemm_phase<EpiY, MoeOrder, true>((LAS unsigned char*)smem, (const char*)(p.ws + OFF_H), DFF / 2, S, E, tid_of(p.wave_id));
}
DEV void ph_combine(const Params& p, int layer, char* smem) {
    const int wid = p.wave_id, lane = lane_asm();
    const float* nr = p.norms + (size_t)layer * 4 * D;
    const int total = layer == 0 ? NT : NB * SEQ, G = (int)gridDim.x, chunk = (total + G - 1) / G, qbeg = (int)blockIdx.x * chunk, qend = min(total, qbeg + chunk);
    float4 cA[4], cB[4], cC[4]; int ckey = -1;
    for (int q0 = qbeg + wid; q0 < qend; q0 += 16) {
        int rr[2]; bool ok[2]; float4 tw[2];
#pragma unroll
        for (int u = 0; u < 2; ++u) { const int q = q0 + u * 8; ok[u] = q < qend; const int qq = ok[u] ? q : q0;
            rr[u] = layer == 0 ? qq : (qq / SEQ) * SL + CTX + qq % SEQ;
            tw[u] = *(const float4*)(((float*)(p.ws + OFF_TOPW)) + (size_t)rr[u] * 4); }
        float4 f[2][4], xv[2][4];
#pragma unroll
        for (int u = 0; u < 2; ++u) {
            const int r = rr[u];
            const float w[4] = {tw[u].x, tw[u].y, tw[u].z, tw[u].w};
#pragma unroll
            for (int i = 0; i < 4; ++i) f[u][i] = make_float4(0.f, 0.f, 0.f, 0.f);
#pragma unroll
            for (int k = 0; k < 4; ++k) {
                const bf16_t* y = (const bf16_t*)(p.ws + OFF_Y) + ((size_t)r * 4 + k) * D;
#pragma unroll
                for (int i = 0; i < 4; ++i) { const int idx = i * 256 + lane * 4; const pg8::u32x2 yb = *(const pg8::u32x2*)(y + idx);
                    const float y0 = __uint_as_float(yb.x << 16), y1 = __uint_as_float(yb.x & 0xffff0000u), y2 = __uint_as_float(yb.y << 16), y3 = __uint_as_float(yb.y & 0xffff0000u);
                    f[u][i].x += w[k] * y0; f[u][i].y += w[k] * y1; f[u][i].z += w[k] * y2; f[u][i].w += w[k] * y3; }
            }
            row_load_bf((const bf16_t*)(p.ws + OFF_XN) + (size_t)r * D, xv[u], lane);
        }
#pragma unroll
        for (int u = 0; u < 2; ++u) {
            const int r = rr[u], b = r / SL, s = r % SL;
            { const int key = s < CTX ? 8 : b;
              if (key != ckey) { ckey = key; const float* m = modrow(p, layer, b, s); const float* m1 = modrow(p, 1, b, s);
#pragma unroll
                  for (int i = 0; i < 4; ++i) { const int idx = i * 256 + lane * 4; const float4 g = *(const float4*)(nr + 3 * D + idx), gt = *(const float4*)(m + 5120 + idx);
                      cA[i] = make_float4(g.x * gt.x, g.y * gt.y, g.z * gt.z, g.w * gt.w);
                      if (layer == 0) { const float4 gn = *(const float4*)(p.norms + (size_t)4 * D + idx), sh = *(const float4*)(m1 + idx), sc = *(const float4*)(m1 + 1024 + idx);
                          cB[i] = make_float4(gn.x * (1.f + sc.x), gn.y * (1.f + sc.y), gn.z * (1.f + sc.z), gn.w * (1.f + sc.w)); cC[i] = sh; } } } }
            const float ri = row_rinv(f[u]);
#pragma unroll
            for (int i = 0; i < 4; ++i) { xv[u][i].x += cA[i].x * (f[u][i].x * ri); xv[u][i].y += cA[i].y * (f[u][i].y * ri); xv[u][i].z += cA[i].z * (f[u][i].z * ri); xv[u][i].w += cA[i].w * (f[u][i].w * ri); }
            if (ok[u]) {
                if (layer == 0) {
                    row_store_bf16((bf16_t*)(p.ws + OFF_X) + (size_t)r * D, xv[u], lane);
                    float4 o[4]; const float rn = row_rinv(xv[u]);
#pragma unroll
                    for (int i = 0; i < 4; ++i) o[i] = make_float4(xv[u][i].x * rn * cB[i].x + cC[i].x, xv[u][i].y * rn * cB[i].y + cC[i].y, xv[u][i].z * rn * cB[i].z + cC[i].z, xv[u][i].w * rn * cB[i].w + cC[i].w);
                    row_store_bf16((bf16_t*)(p.ws + OFF_XNB) + (size_t)r * D, o, lane);
                } else {
                    row_store(p.out + ((size_t)b * SEQ + (s - CTX)) * D, xv[u], lane);
                }
            }
        }
    }
}

template <int layer> DEV void run_layer(const Params& p, char* smem, const XcdBarrier& bar) {
#define GB() xcd_barrier(bar)

        ph_inproj(p, layer, smem, 0); GB();
        ph_inproj(p, layer, smem, 1); ph_scan_local(p, layer, smem); GB();
        ph_scan_carry(p, smem); ph_attn(p, layer, smem); GB();
        ph_scan_out(p, layer, smem); GB();
        ph_outproj(p, layer, smem); GB();
        ph_norm2(p, layer, smem); GB();
        ph_moe1(p, layer, smem); GB();
        ph_moe2(p, layer, smem); GB();
        ph_combine(p, layer, smem); GB();
    #undef GB
}
constexpr int LDS_BYTES = 147456;
__global__ __launch_bounds__(512, 2) void k_mega(Params p_in) {
    Params p = p_in; p.wave_id = __builtin_amdgcn_readfirstlane((int)(threadIdx.x >> 6));
    extern __shared__ __attribute__((aligned(16))) char smem[];
    volatile LAS unsigned* st = (volatile LAS unsigned*)(smem + LDS_BYTES - 16);
    if (threadIdx.x == 0) { st[0] = 0u; st[1] = 0u; st[2] = 0u; st[3] = 0u; }
    __syncthreads();
    const XcdBarrier bar = xcd_barrier_post(((unsigned*)(p.ws + OFF_bar)), st, p.wave_id);
#define GB() xcd_barrier(bar)
    ph_mods(p, smem); ph_convert(p, smem); GB();
    ph_init(p, smem); GB();
    run_layer<0>(p, smem, bar);
    run_layer<1>(p, smem, bar);
#undef GB
}
}

extern "C" void kernel_launch(void* const* d_in, const int* in_sizes, int n_in, void* d_out, int out_size, void* d_ws, size_t ws_size, hipStream_t stream) {
    static int grid = 0;
    if (grid == 0) {
        int dev = 0, cus = 0, per_cu = 0;
        if (hipGetDevice(&dev) != hipSuccess || hipDeviceGetAttribute(&cus, hipDeviceAttributeMultiprocessorCount, dev) != hipSuccess) { grid = -1; return; }
        if (hipFuncSetAttribute((const void*)k_mega, hipFuncAttributeMaxDynamicSharedMemorySize, LDS_BYTES) != hipSuccess) { grid = -1; return; }
        (void)hipOccupancyMaxActiveBlocksPerMultiprocessor(&per_cu, (const void*)k_mega, 512, LDS_BYTES);
        (void)hipGetLastError();
        grid = cus;
    }
    if (grid < 0) return;
    Params p{};
    const float** in = (const float**)&p;
    for (int i = 0; i < 21; ++i) in[i] = (const float*)d_in[i];
    p.out = (float*)d_out;
    p.ws = (char*)d_ws;
    if (WS_END > ws_size) return;
    if (hipMemsetAsync(p.ws + OFF_bar, 0, (size_t)CTL_BYTES, stream) != hipSuccess) return;
    hipLaunchKernelGGL(k_mega, dim3(grid), dim3(512), LDS_BYTES, stream, p);
}
```

```cpp
#include <hip/hip_runtime.h>
#include <stdint.h>

namespace {
constexpr int D = 1024, NB = 8, SEQ = 2048, CTX = 256, SL = 2304, NT = NB * SL;
constexpr int DP = 3840, DPW = 3600, NE = 32, DFF = 1024, NPAIR = NT * 4;
constexpr int O_AQ = 0, O_AI = 256, O_AFF = 512, O_AFB = 768, O_AG = 1024, O_BQ = 1280, O_BK = 1408, O_BV = 1536, O_BO = 1792, O_BG = 3584;
constexpr int LISTCAP = NT;

struct Params {
    const float *x, *c, *ctx, *c_ctx, *ada_w, *ada_b, *norms, *w_in, *w_out, *hlb, *hnorm, *mgb, *mnorm, *dlam, *dnorm, *rw, *rb, *w1, *b1, *w2, *b2;
    float* out;
    char* ws;
    int wave_id, pad_;
};
constexpr size_t al256(size_t x) { return (x + 255) & ~(size_t)255; }
constexpr size_t OFF_bar = 0;
constexpr size_t OFF_MOD = OFF_bar + 16384;
constexpr int CW_QHEAD = 3520, CW_CNT = 3584  , CTL_BYTES = 16384;
constexpr size_t OFF_LB = OFF_MOD + al256((size_t)2 * 9 * 6144 * 4);
constexpr size_t OFF_LAM = OFF_LB + al256(1024 * 4);
constexpr size_t OFF_CNT = OFF_LAM + 256;
constexpr size_t OFF_BC = OFF_CNT + 256;
constexpr size_t OFF_TOPW = OFF_BC + al256((size_t)1024 * NE * 4);
constexpr size_t OFF_TOPI = OFF_TOPW + al256((size_t)NPAIR * 4);
constexpr size_t OFF_LIST = OFF_TOPI + al256((size_t)NPAIR * 4);
constexpr size_t OFF_X = OFF_LIST + al256((size_t)NE * LISTCAP * 4);
constexpr size_t OFF_XN = OFF_X + al256((size_t)NT * D * 4);
constexpr size_t OFF_P = OFF_XN + al256((size_t)NT * D * 4);
constexpr size_t OFF_QR = OFF_P + al256((size_t)NT * DP * 4);
constexpr size_t OFF_KT = OFF_QR + al256((size_t)64 * SL * 64 * 4);
constexpr size_t OFF_OC = OFF_KT + al256((size_t)64 * SL * 64 * 4);
constexpr size_t OFF_MIX = OFF_OC + al256((size_t)32 * SL * 128 * 4);
constexpr size_t OFF_MIXO = OFF_MIX + al256((size_t)NT * D * 4);
constexpr size_t OFF_XNB = OFF_MIXO + al256((size_t)NT * D * 4);
constexpr size_t OFF_MIXB = OFF_XNB + al256((size_t)NT * D * 2);
constexpr size_t OFF_WIN = OFF_MIXB + al256((size_t)NT * D * 2);
constexpr size_t OFF_WOUT = OFF_WIN + al256((size_t)2 * DP * D * 2);
constexpr size_t OFF_W1T = OFF_WOUT + al256((size_t)2 * D * D * 2);
constexpr size_t OFF_W2T = OFF_W1T + al256((size_t)2 * NE * 2048 * D * 2);
constexpr size_t OFF_U = OFF_W2T + al256((size_t)2 * NE * D * DFF * 2);
constexpr size_t WS_END = OFF_U + al256((size_t)32 * SL * SL * 4);
constexpr size_t OFF_UA = OFF_U, OFF_DECA = OFF_UA + (size_t)64 * 36 * 4096 * 4, OFF_UB = OFF_DECA + (size_t)64 * 36 * 64 * 4, OFF_NB = OFF_UB + (size_t)64 * 36 * 2048 * 4,
                 OFF_MB = OFF_NB + (size_t)64 * 36 * 32 * 4, OFF_SCB = OFF_MB + (size_t)64 * 36 * 4 * 4,
                 OFF_OA2 = OFF_SCB + (size_t)2 * NT * 16 * 4, OFF_HB2 = OFF_OA2 + (size_t)NT * 256 * 4, OFF_SA = OFF_HB2 + (size_t)NT * 256 * 4, OFF_SB = OFF_SA + (size_t)64 * 36 * 4096 * 4,
                 OFF_N0 = OFF_SB + (size_t)64 * 36 * 2048 * 4;
constexpr size_t OFF_PB = OFF_P;
constexpr size_t OFF_ROPE = OFF_P + al256((size_t)NT * DP * 2);
constexpr size_t OFF_QRB = OFF_QR, OFF_Q0B = OFF_QR + (size_t)32 * SL * 128 * 2, OFF_KB = OFF_KT, OFF_VB = OFF_KT + (size_t)32 * SL * 128 * 2;
constexpr size_t OFF_S = OFF_U, OFF_H = OFF_U, OFF_Y = OFF_U + al256((size_t)(NPAIR + 256) * DFF * 2);
constexpr size_t OFF_OA = OFF_MIXO, OFF_HB = OFF_MIXO + (size_t)2 * NT * 256 * 4;


#define DEV __device__ __forceinline__
DEV int lane_asm() { int l; asm volatile("v_mbcnt_lo_u32_b32 %0, -1, 0\n\tv_mbcnt_hi_u32_b32 %0, -1, %0" : "=v"(l)); return l; }
DEV int tid_of(int wave_id) { return (wave_id << 6) | lane_asm(); }
DEV float wsum(float v) { for (int o = 32; o >= 1; o >>= 1) v += __shfl_xor(v, o); return v; }
DEV float wmaxf(float v) { for (int o = 32; o >= 1; o >>= 1) v = fmaxf(v, __shfl_xor(v, o)); return v; }
DEV float sigm(float x) { return 1.f / (1.f + expf(-x)); }
DEV float rdlane(float v, int l) { return __int_as_float(__builtin_amdgcn_readlane(__float_as_int(v), l)); }
DEV float lam_init_of(int layer) { return 0.8f - 0.6f * expf(-0.3f * (float)layer); }


#define XB_TMO      128
#define XB_XCNT(j)  (256  + 64 * (j))
#define XB_XSUB(j)  (1280 + 64 * (j))
#define XB_XGEN(j)  (2304 + 64 * (j))
#define XB_TOP      3328
#define XB_TOPGEN   3392
#define XCD_BAR_WORDS 3456
#define XB_SPIN_CAP (1u << 22)
#define LAS __attribute__((address_space(3)))
DEV unsigned xb_ld(unsigned* p)              { return __hip_atomic_load(p, __ATOMIC_RELAXED, __HIP_MEMORY_SCOPE_AGENT); }
DEV unsigned xb_add(unsigned* p, unsigned v) { return __hip_atomic_fetch_add(p, v, __ATOMIC_RELAXED, __HIP_MEMORY_SCOPE_AGENT); }
DEV unsigned xb_xcc_id() { return (unsigned)__builtin_amdgcn_s_getreg((3 << 11) | 20) & 0xFu; }
#define XB_SPIN(cond, bar) do { unsigned _sp = 0; while (cond) { __builtin_amdgcn_s_sleep(1); \
    if ((++_sp & 255u) == 0u) { if (xb_ld(&(bar)[XB_TMO])) break; if (_sp > XB_SPIN_CAP) { atomicAdd(&(bar)[XB_TMO], 1u); break; } } } } while (0)
struct XcdBarrier { unsigned* bar; unsigned x; volatile LAS unsigned* st; int wave; };
DEV bool xb_thread0(int wave) { return wave == 0 && lane_asm() == 0; }
DEV XcdBarrier xcd_barrier_post(unsigned* bar, volatile LAS unsigned* st, int wave) {
    XcdBarrier b; b.bar = bar; b.x = xb_xcc_id(); b.st = st; b.wave = wave;
    if (xb_thread0(wave)) (void)xb_add(&bar[XB_XCNT(b.x)], 1u);
    return b;
}
DEV void xcd_barrier_complete(unsigned* bar, unsigned x, unsigned& nloc, unsigned& nx) {
    const unsigned G = gridDim.x * gridDim.y * gridDim.z;
    unsigned sum, cnt, mine, sp = 0u;
    for (;;) {
        sum = 0u; cnt = 0u; mine = 0u;
#pragma unroll
        for (unsigned j = 0; j < 16; ++j) { const unsigned c = xb_ld(&bar[XB_XCNT(j)]); sum += c; cnt += (c > 0u) ? 1u : 0u; mine = (j == x) ? c : mine; }
        if (sum == G) break;
        __builtin_amdgcn_s_sleep(1);
        if ((++sp & 255u) == 0u) { if (xb_ld(&bar[XB_TMO])) break; if (sp > XB_SPIN_CAP) { atomicAdd(&bar[XB_TMO], 1u); break; } }
    }
    nloc = mine > 0u ? mine : 1u; nx = cnt > 0u ? cnt : 1u;
}
DEV void xcd_barrier(const XcdBarrier& b) {
    asm volatile("s_waitcnt vmcnt(0)" ::: "memory");
    __syncthreads();
    if (xb_thread0(b.wave)) {
        unsigned* bar = b.bar;
        __builtin_amdgcn_s_waitcnt(0);
        unsigned nloc = b.st[0], nx = b.st[1];
        if (nloc == 0u) { xcd_barrier_complete(bar, b.x, nloc, nx); b.st[0] = nloc; b.st[1] = nx; }
        const unsigned old = xb_add(&bar[XB_XSUB(b.x)], 1u);
        const unsigned gen = old / nloc;
        if (old + 1u == (gen + 1u) * nloc) {
            __builtin_amdgcn_fence(__ATOMIC_RELEASE, "agent");
            asm volatile("s_waitcnt vmcnt(0)" ::: "memory");
            const unsigned og = xb_add(&bar[XB_TOP], 1u);
            const unsigned tg = og / nx;
            if (og + 1u == (tg + 1u) * nx) xb_add(&bar[XB_TOPGEN], 1u);
            else XB_SPIN(xb_ld(&bar[XB_TOPGEN]) == tg, bar);
            __builtin_amdgcn_fence(__ATOMIC_ACQUIRE, "agent");
            xb_add(&bar[XB_XGEN(b.x)], 1u);
            asm volatile("s_waitcnt vmcnt(0)" ::: "memory");
        } else {
            XB_SPIN(xb_ld(&bar[XB_XGEN(b.x)]) == gen, bar);
            __builtin_amdgcn_fence(__ATOMIC_ACQUIRE, "agent");
            asm volatile("s_waitcnt vmcnt(0)" ::: "memory");
        }
    }
    __syncthreads();
}

typedef unsigned short bf16_t;
DEV unsigned cvt_pk_bf16(float lo, float hi) { unsigned r; asm volatile("v_cvt_pk_bf16_f32 %0, %1, %2" : "=v"(r) : "v"(lo), "v"(hi)); return r; }

namespace pg8 {
typedef short bf16x8 __attribute__((ext_vector_type(8)));
typedef float f32x4 __attribute__((ext_vector_type(4)));
typedef unsigned u32x4 __attribute__((ext_vector_type(4)));
typedef unsigned u32x2 __attribute__((ext_vector_type(2)));
constexpr int BM = 256, BK = 64, HALF = 128, HTB = HALF * BK * 2, STAGE_BYTES = 8 * HTB, NXCD = 8, WGM = 8;
DEV int lds_byte(int r, int c) { const int st = (r >> 4) * 2 + (c >> 5), rr = r & 15, cc = c & 31, ob = rr * 64 + cc * 2; return st * 1024 + (ob ^ (((ob >> 9) & 1) << 5)); }
DEV void stage_rc(int b, int& R, int& C) { const int st = b / 1024, sb = b % 1024, swz = sb ^ (((sb >> 9) & 1) << 5); R = (st >> 1) * 16 + swz / 64; C = (st & 1) * 32 + (swz % 64) / 2; }
DEV int perm32(int rho) { const int n = rho >> 4, i = rho & 15; return 8 * (i >> 2) + 4 * n + (i & 3); }
struct Unit { int pm, pn, e, t; };
struct StaticOrder {
    int nM, nN, nwg, G, c, skipctx; const char* Bt; int K;
    DEV void init(int nM_, int nN_, int G_, int c_, int skipctx_, const void* Bt_, int K_) { nM = nM_; nN = nN_; nwg = nM * nN; G = G_; c = c_; skipctx = skipctx_; Bt = (const char*)Bt_; K = K_; }
    DEV bool next(int i, Unit& u) const {
        const long L = (long)i * G + c; if (L >= nwg) return false;
        int wgid = (int)L; { const int q = nwg / NXCD, r = nwg % NXCD, xcd = wgid % NXCD, off = wgid / NXCD; wgid = (xcd < r ? xcd * (q + 1) : r * (q + 1) + (xcd - r) * q) + off; }
        const int nig = WGM * nN, gid = wgid / nig, fm = gid * WGM, gsz = (nM - fm) < WGM ? (nM - fm) : WGM;
        int pm = fm + ((wgid % nig) % gsz); u.pn = (wgid % nig) / gsz;
        if (skipctx) pm = (pm >> 3) * 9 + 1 + (pm & 7);
        u.pm = pm; u.e = 0; u.t = 0; return true;
    }
    DEV int arow(const Unit& u, int rr) const { return u.pm * BM + rr; }
    DEV const char* bbase(const Unit& u) const { return Bt + (size_t)u.pn * BM * K * 2; }
};
struct EpiF32 {
    static constexpr bool PERM = false;
    float* C; int ldc;
    DEV void operator()(const f32x4 (&acc)[2][2][4][2], const Unit& u, int wr, int wc, int fr, int fq) const {
        const int row0 = u.pm * BM + wr * 64 + fr, col0 = u.pn * BM + wc * 32 + 4 * fq;
#pragma unroll
        for (int ai = 0; ai < 2; ++ai)
#pragma unroll
            for (int m = 0; m < 4; ++m) { float* rowp = C + (size_t)(row0 + ai * HALF + m * 16) * ldc + col0;
#pragma unroll
                for (int bj = 0; bj < 2; ++bj)
#pragma unroll
                    for (int n = 0; n < 2; ++n) *(f32x4*)(rowp + bj * HALF + n * 16) = acc[ai][bj][m][n]; }
    }
};

typedef int i32x4 __attribute__((ext_vector_type(4)));
typedef int i32x8 __attribute__((ext_vector_type(8)));
DEV i32x8 cat8(bf16x8 a, bf16x8 b) { const i32x4 x = __builtin_bit_cast(i32x4, a), y = __builtin_bit_cast(i32x4, b); return __builtin_shufflevector(x, y, 0, 1, 2, 3, 4, 5, 6, 7); }
template <class Epi, class Sched, bool F8 = false>
DEV void gemm_phase(LAS unsigned char* lds, const char* Abase, const int K, const Sched& S, const Epi& E, const int tid) {
    const int wid = __builtin_amdgcn_readfirstlane(tid >> 6), lane = tid & 63, wr = wid >> 2, wc = wid & 3, fr = lane & 15, fq = lane >> 4;
    const int nt = K / BK;
    unsigned voffB[2];
#pragma unroll
    for (int i = 0; i < 2; ++i) { int R, C; stage_rc(tid * 16 + i * 8192, R, C); const int Rb = Epi::PERM ? ((R & ~31) + perm32(R & 31)) : R;
        voffB[i] = (unsigned)(Rb * BK + C) * 2u; }
    const size_t kstep = (size_t)(BK * 2);
    const size_t hstep = (size_t)HALF * K * 2;
    constexpr size_t kstepB = (size_t)BM * BK * 2, hstepB = (size_t)HALF * BK * 2;
    const unsigned ldsw = (unsigned)wid * 1024u;
    const int aoff = lds_byte(wr * 64 + fr, fq * 8), boff = lds_byte(wc * 32 + fr, fq * 8);
#define PG8_SA(b, h) (((b) * 2 + (h)) * HTB)
#define PG8_SB(b, h) ((4 + (b) * 2 + (h)) * HTB)
#define PG8_STAGE_B(bufoff, gbase) do { _Pragma("unroll") for (int _i = 0; _i < 2; ++_i) \
        __builtin_amdgcn_global_load_lds((const unsigned*)((const char*)(gbase) + voffB[_i]), (LAS unsigned*)(lds + (bufoff) + ldsw + _i * 8192), 16, 0, 0); } while (0)
#define PG8_STAGE_A(bufoff, kb, V, h) do { _Pragma("unroll") for (int _i = 0; _i < 2; ++_i) \
        __builtin_amdgcn_global_load_lds((const unsigned*)(Abase + (kb) + (V)[h][_i]), (LAS unsigned*)(lds + (bufoff) + ldsw + _i * 8192), 16, 0, 0); } while (0)
#define PG8_VOFFA(V, u) do { _Pragma("unroll") for (int _i = 0; _i < 2; ++_i) { int _R, _C; stage_rc(tid * 16 + _i * 8192, _R, _C); _Pragma("unroll") for (int _h = 0; _h < 2; ++_h) \
        (V)[_h][_i] = ((unsigned)S.arow(u, _h * HALF + _R) * (unsigned)K + (unsigned)_C) * 2u; } } while (0)
#define PG8_LDA(dst, b, h) do { _Pragma("unroll") for (int m = 0; m < 4; ++m) _Pragma("unroll") for (int k = 0; k < 2; ++k) dst[m][k] = *(const LAS bf16x8*)(lds + PG8_SA(b, h) + aoff + m * 2048 + k * 1024); } while (0)
#define PG8_LDB(dst, b, h) do { _Pragma("unroll") for (int n = 0; n < 2; ++n) _Pragma("unroll") for (int k = 0; k < 2; ++k) dst[n][k] = *(const LAS bf16x8*)(lds + PG8_SB(b, h) + boff + n * 2048 + k * 1024); } while (0)
#define PG8_MMA(ai, bj, At, Bt) do { __builtin_amdgcn_s_setprio(1); _Pragma("unroll") for (int m = 0; m < 4; ++m) _Pragma("unroll") for (int n = 0; n < 2; ++n) { \
        if constexpr (F8) asm volatile("v_mfma_f32_16x16x128_f8f6f4 %0, %1, %2, %0" : "+v"(acc[ai][bj][m][n]) : "v"(cat8(Bt[n][0], Bt[n][1])), "v"(cat8(At[m][0], At[m][1]))); \
        else { _Pragma("unroll") for (int k = 0; k < 2; ++k) acc[ai][bj][m][n] = __builtin_amdgcn_mfma_f32_16x16x32_bf16(Bt[n][k], At[m][k], acc[ai][bj][m][n], 0, 0, 0); } } __builtin_amdgcn_s_setprio(0); } while (0)
#define PG8_WAIT_V(n) asm volatile("s_waitcnt vmcnt(" #n ")" ::: "memory")
#define PG8_WAIT_L(n) asm volatile("s_waitcnt lgkmcnt(" #n ")" ::: "memory")
#define PG8_BAR __builtin_amdgcn_s_barrier()
#define PG8_SCHED __builtin_amdgcn_sched_barrier(0)
    Unit cur, nxt; int ui = 0;
    if (!S.next(0, cur)) return;
    f32x4 acc[2][2][4][2];
#pragma unroll
    for (int a = 0; a < 2; ++a)
#pragma unroll
        for (int b = 0; b < 2; ++b)
#pragma unroll
            for (int m = 0; m < 4; ++m)
#pragma unroll
                for (int n = 0; n < 2; ++n) acc[a][b][m][n] = (f32x4){0.f, 0.f, 0.f, 0.f};
    bf16x8 At[4][2], B0[2][2], B1[2][2];
    unsigned vc[2][2], v2[2][2];
    PG8_VOFFA(vc, cur);
    const char* cB = S.bbase(cur);
    PG8_STAGE_B(PG8_SB(0, 0), cB); PG8_STAGE_A(PG8_SA(0, 0), 0, vc, 0); PG8_STAGE_B(PG8_SB(0, 1), cB + hstepB); PG8_STAGE_A(PG8_SA(0, 1), 0, vc, 1);
    if (wr == 1) PG8_BAR;
    PG8_WAIT_V(4); PG8_BAR;
    PG8_STAGE_B(PG8_SB(1, 0), cB + kstepB); PG8_STAGE_A(PG8_SA(1, 0), kstep, vc, 0); PG8_STAGE_B(PG8_SB(1, 1), cB + hstepB + kstepB);
    PG8_WAIT_V(6); PG8_BAR;
    for (;;) {
        const bool has_next = S.next(ui + 1, nxt);
        const char* nB = has_next ? S.bbase(nxt) : cB;
        for (int t = 0; t < nt; t += 2) {
            const bool last = (t == nt - 2);
            const size_t k1 = (size_t)(t + 1) * kstep, k2 = last ? (size_t)0 : (size_t)(t + 2) * kstep, k3 = k2 + kstep;
            if (last && has_next) { PG8_VOFFA(v2, nxt); } else {
#pragma unroll
                for (int h = 0; h < 2; ++h)
#pragma unroll
                    for (int i = 0; i < 2; ++i) v2[h][i] = vc[h][i]; }
            const char* b2 = last ? nB : cB + (size_t)(t + 2) * kstepB; const char* b3 = b2 + kstepB;
            PG8_LDB(B0, 0, 0); PG8_SCHED; PG8_LDA(At, 0, 0); PG8_STAGE_A(PG8_SA(1, 1), k1, vc, 1);
            PG8_WAIT_L(8); PG8_BAR; PG8_WAIT_L(0); PG8_MMA(0, 0, At, B0); PG8_BAR; PG8_SCHED;
            PG8_LDB(B1, 0, 1); PG8_STAGE_B(PG8_SB(0, 0), b2);
            PG8_BAR; PG8_WAIT_L(0); PG8_MMA(0, 1, At, B1); PG8_BAR;
            PG8_LDA(At, 0, 1); PG8_STAGE_A(PG8_SA(0, 0), k2, v2, 0);
            PG8_BAR; PG8_WAIT_L(0); PG8_MMA(1, 0, At, B0); PG8_BAR; PG8_SCHED;
            PG8_STAGE_B(PG8_SB(0, 1), b2 + hstepB);
            PG8_WAIT_V(6); PG8_BAR; PG8_MMA(1, 1, At, B1); PG8_BAR;
            PG8_LDB(B0, 1, 0); PG8_SCHED; PG8_LDA(At, 1, 0); PG8_STAGE_A(PG8_SA(0, 1), k2, v2, 1);
            PG8_WAIT_L(8); PG8_BAR; PG8_WAIT_L(0); PG8_MMA(0, 0, At, B0); PG8_BAR; PG8_SCHED;
            PG8_LDB(B1, 1, 1); PG8_STAGE_B(PG8_SB(1, 0), b3);
            PG8_BAR; PG8_WAIT_L(0); PG8_MMA(0, 1, At, B1); PG8_BAR;
            PG8_LDA(At, 1, 1); PG8_STAGE_A(PG8_SA(1, 0), k3, v2, 0);
            PG8_BAR; PG8_WAIT_L(0); PG8_MMA(1, 0, At, B0); PG8_BAR; PG8_SCHED;
            PG8_STAGE_B(PG8_SB(1, 1), b3 + hstepB);
            PG8_WAIT_V(6); PG8_BAR; PG8_MMA(1, 1, At, B1); PG8_BAR;
        }
        if constexpr (F8) asm volatile("s_nop 15\n\ts_nop 15" ::: "memory");
        E(acc, cur, wr, wc, fr, fq);
        if (!has_next) break;
#pragma unroll
        for (int a = 0; a < 2; ++a)
#pragma unroll
            for (int b = 0; b < 2; ++b)
#pragma unroll
                for (int m = 0; m < 4; ++m)
#pragma unroll
                    for (int n = 0; n < 2; ++n) acc[a][b][m][n] = (f32x4){0.f, 0.f, 0.f, 0.f};
        cur = nxt; cB = nB; ++ui;
#pragma unroll
        for (int h = 0; h < 2; ++h)
#pragma unroll
            for (int i = 0; i < 2; ++i) vc[h][i] = v2[h][i];
    }
    PG8_WAIT_V(0);
    if (wr == 0) PG8_BAR;
    PG8_BAR;
#undef PG8_SA
#undef PG8_SB
#undef PG8_STAGE_A
#undef PG8_STAGE_B
#undef PG8_VOFFA
#undef PG8_LDA
#undef PG8_LDB
#undef PG8_MMA
#undef PG8_WAIT_V
#undef PG8_WAIT_L
#undef PG8_BAR
#undef PG8_SCHED
}
}


namespace att {
using bf16x8 = __attribute__((ext_vector_type(8))) short;
using s16x4  = __attribute__((ext_vector_type(4))) short;
using f32x16 = __attribute__((ext_vector_type(16))) float;
using u32x4  = __attribute__((ext_vector_type(4))) unsigned;
constexpr int KVBLK = 64, LDK = 128;
constexpr int SHM_V = KVBLK * 128 * 2, SHM_K = KVBLK * 128 * 2, SHM_ATTN = 2 * SHM_V + 2 * SHM_K + 8 * 64 * 4;
constexpr float THR = 8.f;
#define KSWZ(row, colB) ((row) * 256 + ((colB) ^ (((row) & 7) << 4)))
#define SBAR() __builtin_amdgcn_sched_barrier(0)
DEV int crow(int r, int hi) { return (r & 3) + 8 * (r >> 2) + 4 * hi; }
DEV void partialSM(f32x16& p0, f32x16& p1, float& m_reg, float& mn, float& alpha) {
  float pmax = p0[0]; for (int r = 1; r < 16; ++r) pmax = fmaxf(pmax, p0[r]); for (int r = 0; r < 16; ++r) pmax = fmaxf(pmax, p1[r]);
  { auto rr = __builtin_amdgcn_permlane32_swap(__float_as_uint(pmax), __float_as_uint(pmax), false, false);
    pmax = fmaxf(__uint_as_float(rr[0]), __uint_as_float(rr[1])); }
  if (__builtin_expect(__all(pmax - m_reg <= THR), 1)) { mn = m_reg; alpha = 1.f; }
  else { mn = fmaxf(m_reg, pmax); alpha = __builtin_amdgcn_exp2f(m_reg - mn); m_reg = mn; }
  for (int r = 0; r < 16; ++r) p0[r] = p0[r] - mn; for (int r = 0; r < 16; ++r) p1[r] = p1[r] - mn;
  for (int r = 0; r < 16; ++r) p0[r] = __builtin_amdgcn_exp2f(p0[r]);
}
DEV void finishSM(f32x16& p0, f32x16& p1, float alpha, float& l_reg, bf16x8& pa0, bf16x8& pa1, bf16x8& pa2, bf16x8& pa3) {
  for (int r = 0; r < 16; ++r) p1[r] = __builtin_amdgcn_exp2f(p1[r]);
  float ps = 0; for (int r = 0; r < 16; ++r) ps += p0[r]; for (int r = 0; r < 16; ++r) ps += p1[r];
  { auto rr = __builtin_amdgcn_permlane32_swap(__float_as_uint(ps), __float_as_uint(ps), false, false);
    ps = __uint_as_float(rr[0]) + __uint_as_float(rr[1]); }
  l_reg = l_reg * alpha + ps;
#define PK4(P, BASE, OUT) do { unsigned a0 = cvt_pk_bf16(P[BASE + 0], P[BASE + 1]), a1 = cvt_pk_bf16(P[BASE + 2], P[BASE + 3]);   \
    unsigned b0 = cvt_pk_bf16(P[BASE + 4], P[BASE + 5]), b1 = cvt_pk_bf16(P[BASE + 6], P[BASE + 7]);                              \
    auto r0 = __builtin_amdgcn_permlane32_swap(a0, b0, false, false); auto r1 = __builtin_amdgcn_permlane32_swap(a1, b1, false, false); \
    u32x4 w = {r0[0], r1[0], r0[1], r1[1]}; OUT = *reinterpret_cast<bf16x8*>(&w); } while (0)
  PK4(p0, 0, pa0); PK4(p0, 8, pa1); PK4(p1, 0, pa2); PK4(p1, 8, pa3);
#undef PK4
}
DEV void qkt(f32x16& p0, f32x16& p1, const char* Ks, const bf16x8 (&qr)[4], int r32, int hi, int js) {
  p0 = f32x16{}; p1 = f32x16{};
#pragma unroll
  for (int d0 = 0; d0 < 4; ++d0) { const int cb = ((js * 4 + d0) * 16 + hi * 8) * 2;
    bf16x8 b0 = *reinterpret_cast<const bf16x8*>(Ks + KSWZ(r32, cb));
    bf16x8 b1 = *reinterpret_cast<const bf16x8*>(Ks + KSWZ(32 + r32, cb));
    p0 = __builtin_amdgcn_mfma_f32_32x32x16_bf16(b0, qr[d0], p0, 0, 0, 0);
    p1 = __builtin_amdgcn_mfma_f32_32x32x16_bf16(b1, qr[d0], p1, 0, 0, 0); }
}
DEV int v_st(int k, int c) { const int kk = (k & ~0xC) | ((k & 4) << 1) | ((k & 8) >> 1); return ((kk >> 3) * 4 + (c >> 5)) * 512 + ((kk & 7) * 32 + (c & 31)) * 2; }
DEV int v_rd_base(int lane) { return ((lane & 3) << 3) | (((lane >> 2) & 3) << 6) | (((lane >> 4) & 1) << 5) | (((lane >> 5) & 1) << 8); }
constexpr int v_rd_off(int d0, int ks, int half) { return d0 * 512 + ks * 4096 + half * 2048; }
template <int OFF> DEV s16x4 tr_read(int vb) {
  s16x4 r; asm volatile("ds_read_b64_tr_b16 %0, %1 offset:%2" : "=&v"(r) : "v"(vb), "i"(OFF) : "memory"); return r;
}
template <int D0> DEV void pv_one(f32x16& od, int vb, bf16x8 pa0, bf16x8 pa1, bf16x8 pa2, bf16x8 pa3) {
  const s16x4 l0 = tr_read<v_rd_off(D0, 0, 0)>(vb), h0 = tr_read<v_rd_off(D0, 0, 1)>(vb), l1 = tr_read<v_rd_off(D0, 1, 0)>(vb), h1 = tr_read<v_rd_off(D0, 1, 1)>(vb);
  const s16x4 l2 = tr_read<v_rd_off(D0, 2, 0)>(vb), h2 = tr_read<v_rd_off(D0, 2, 1)>(vb), l3 = tr_read<v_rd_off(D0, 3, 0)>(vb), h3 = tr_read<v_rd_off(D0, 3, 1)>(vb);
  asm volatile("s_waitcnt lgkmcnt(0)" ::: "memory"); SBAR();
#define PK(L, H) (bf16x8){L[0], L[1], L[2], L[3], H[0], H[1], H[2], H[3]}
  od = __builtin_amdgcn_mfma_f32_32x32x16_bf16(pa0, PK(l0, h0), od, 0, 0, 0);
  od = __builtin_amdgcn_mfma_f32_32x32x16_bf16(pa1, PK(l1, h1), od, 0, 0, 0);
  od = __builtin_amdgcn_mfma_f32_32x32x16_bf16(pa2, PK(l2, h2), od, 0, 0, 0);
  od = __builtin_amdgcn_mfma_f32_32x32x16_bf16(pa3, PK(l3, h3), od, 0, 0, 0);
#undef PK
}
DEV void pv_d0(f32x16* o, int vb, bf16x8 pa0, bf16x8 pa1, bf16x8 pa2, bf16x8 pa3) {
  pv_one<0>(o[0], vb, pa0, pa1, pa2, pa3); pv_one<1>(o[1], vb, pa0, pa1, pa2, pa3); pv_one<2>(o[2], vb, pa0, pa1, pa2, pa3); pv_one<3>(o[3], vb, pa0, pa1, pa2, pa3);
}
DEV void attn_tiles(const bf16x8 (&qr)[4], const bf16_t* __restrict__ Kh, const bf16_t* __restrict__ Vh, int seq, char* lds,
                    float& m_reg, float& l_reg, f32x16 (&o)[4], int tid, int js) {
  const int wid = tid >> 6, lane = tid & 63, r32 = lane & 31, hi = lane >> 5;
  char* V_lds = lds; char* K_lds = lds + 2 * SHM_V;
  float* ws = (float*)(lds + 2 * SHM_V + 2 * SHM_K) + wid * 64; float* al_l = ws + 32;
  const int sr = tid >> 4, sc = (tid & 15) * 8, vst0 = v_st(sr, sc), vst1 = v_st(32 + sr, sc);
  const int vb0 = (int)(uintptr_t)V_lds + v_rd_base(lane);
  struct { bf16x8 vs0, vs1, ks0, ks1; } sr_[2];
  const unsigned lo0 = (unsigned)((sr * LDK + sc) * 2), lo1 = lo0 + 32u * LDK * 2u;
#define SLOAD(i, k0) do { const char* vb_ = (const char*)Vh + (size_t)(k0) * (LDK * 2); const char* kb_ = (const char*)Kh + (size_t)(k0) * (LDK * 2); \
    sr_[i].vs0 = *(const bf16x8*)(vb_ + lo0); sr_[i].vs1 = *(const bf16x8*)(vb_ + lo1); sr_[i].ks0 = *(const bf16x8*)(kb_ + lo0); sr_[i].ks1 = *(const bf16x8*)(kb_ + lo1); } while (0)
#define SWRITE(b, i) do { *(bf16x8*)(V_lds + (b) * SHM_V + vst0) = sr_[i].vs0;          \
    *(bf16x8*)(V_lds + (b) * SHM_V + vst1) = sr_[i].vs1; int kc = sc * 2;               \
    *(bf16x8*)(K_lds + (b) * SHM_K + KSWZ(sr, kc)) = sr_[i].ks0;                       \
    *(bf16x8*)(K_lds + (b) * SHM_K + KSWZ(32 + sr, kc)) = sr_[i].ks1; } while (0)
#define SWAIT() asm volatile("s_waitcnt vmcnt(4)" ::: "memory")
#define RESC(a) do { if (__any((a) < 1.f)) { if (hi == 0) al_l[r32] = (a); asm volatile("s_waitcnt lgkmcnt(0)" ::: "memory"); \
    for (int d = 0; d < 4; ++d) for (int r = 0; r < 16; ++r) o[d][r] *= al_l[crow(r, hi)]; } } while (0)
  f32x16 pA0, pA1, pB0, pB1; float mnA, mnB, alA, alB; bf16x8 pa0, pa1, pa2, pa3; const int NTL = seq / KVBLK;
  constexpr int SE = 0, SO = 1;
  __syncthreads();
  SLOAD(SE, 0); asm volatile("s_waitcnt vmcnt(0)" ::: "memory"); SWRITE(0, SE); __syncthreads();
  qkt(pA0, pA1, K_lds, qr, r32, hi, js); partialSM(pA0, pA1, m_reg, mnA, alA);
  SLOAD(SO, KVBLK); if (2 < NTL) SLOAD(SE, 2 * KVBLK);
  SWAIT(); SWRITE(1, SO); __syncthreads();
  RESC(alA);
  for (int j = 1; j + 1 < NTL; j += 2) {
    SBAR(); qkt(pB0, pB1, K_lds + SHM_K, qr, r32, hi, js);
    finishSM(pA0, pA1, alA, l_reg, pa0, pa1, pa2, pa3); SBAR();
    SLOAD(SO, (j + 2) * KVBLK); SBAR();
    pv_d0(o, vb0, pa0, pa1, pa2, pa3); partialSM(pB0, pB1, m_reg, mnB, alB);
    __syncthreads(); SWAIT(); SWRITE(0, SE);
    RESC(alB); __syncthreads();
    SBAR(); qkt(pA0, pA1, K_lds, qr, r32, hi, js);
    finishSM(pB0, pB1, alB, l_reg, pa0, pa1, pa2, pa3); SBAR();
    if (j + 3 < NTL) SLOAD(SE, (j + 3) * KVBLK); SBAR();
    pv_d0(o, vb0 + SHM_V, pa0, pa1, pa2, pa3); partialSM(pA0, pA1, m_reg, mnA, alA);
    __syncthreads(); SWAIT(); SWRITE(1, SO);
    RESC(alA); __syncthreads();
  }
  SBAR(); qkt(pB0, pB1, K_lds + SHM_K, qr, r32, hi, js);
  finishSM(pA0, pA1, alA, l_reg, pa0, pa1, pa2, pa3); SBAR();
  pv_d0(o, vb0, pa0, pa1, pa2, pa3); partialSM(pB0, pB1, m_reg, mnB, alB);
  __syncthreads(); RESC(alB);
  finishSM(pB0, pB1, alB, l_reg, pa0, pa1, pa2, pa3); SBAR();
  pv_d0(o, vb0 + SHM_V, pa0, pa1, pa2, pa3);
#undef SLOAD
#undef SWRITE
#undef SWAIT
#undef RESC
}
}

DEV void cvt_tile(const float* src, int ld, int nvalid, bf16_t* dst, int K, int n0, int k0, float* T, const int t, int ns0 = -1) {
    if (ns0 < 0) ns0 = n0;
#pragma unroll
    for (int h = 0; h < 2; ++h) {
        const int kk = (t >> 4) + 32 * h, nq = (t & 15) * 4, n = ns0 + nq;
        const float4 v = n < nvalid ? *(const float4*)(src + (size_t)(k0 + kk) * ld + n) : make_float4(0.f, 0.f, 0.f, 0.f);
        T[(nq + 0) * 65 + kk] = v.x; T[(nq + 1) * 65 + kk] = v.y; T[(nq + 2) * 65 + kk] = v.z; T[(nq + 3) * 65 + kk] = v.w;
    }
    __syncthreads();
    { const int n = t >> 3, kq = (t & 7) * 8; const float* r = T + n * 65 + kq;
      pg8::u32x4 w; w.x = cvt_pk_bf16(r[0], r[1]); w.y = cvt_pk_bf16(r[2], r[3]); w.z = cvt_pk_bf16(r[4], r[5]); w.w = cvt_pk_bf16(r[6], r[7]);
      *(pg8::u32x4*)(dst + (size_t)(n0 + n) * K + k0 + kq) = w; }
    __syncthreads();
}
DEV unsigned pk4_fp8(float a, float b, float c, float d) {
    a = __builtin_amdgcn_fmed3f(a, -448.f, 448.f); b = __builtin_amdgcn_fmed3f(b, -448.f, 448.f); c = __builtin_amdgcn_fmed3f(c, -448.f, 448.f); d = __builtin_amdgcn_fmed3f(d, -448.f, 448.f);
    int w = 0; w = __builtin_amdgcn_cvt_pk_fp8_f32(a, b, w, false); w = __builtin_amdgcn_cvt_pk_fp8_f32(c, d, w, true); return (unsigned)w;
}
constexpr float F8_SW = 1024.f  , F8_SX = 16.f  , F8_SH = 8.f  , F8_SY = 32.f  ;
DEV void cvt_tile4(const float* src, int ld, int nvalid, bf16_t* dst, int K, int n0, int k0, float* T, const int t, int ns0 = -1, bool f8 = false) {
    if (ns0 < 0) ns0 = n0;
    float4 v[4][2];
#pragma unroll
    for (int q = 0; q < 4; ++q)
#pragma unroll
        for (int h = 0; h < 2; ++h) { const int kk = (t >> 4) + 32 * h, n = ns0 + (t & 15) * 4;
            v[q][h] = n < nvalid ? *(const float4*)(src + (size_t)(k0 + q * 64 + kk) * ld + n) : make_float4(0.f, 0.f, 0.f, 0.f); }
#pragma unroll
    for (int q = 0; q < 4; ++q)
#pragma unroll
        for (int h = 0; h < 2; ++h) { const int kk = (t >> 4) + 32 * h, nq = (t & 15) * 4; float* Tq = T + q * (64 * 65);
            Tq[(nq + 0) * 65 + kk] = v[q][h].x; Tq[(nq + 1) * 65 + kk] = v[q][h].y; Tq[(nq + 2) * 65 + kk] = v[q][h].z; Tq[(nq + 3) * 65 + kk] = v[q][h].w; }
    __syncthreads();
#pragma unroll
    for (int q = 0; q < 4; ++q) { const int n = t >> 3, kq = (t & 7) * 8; const float* r = T + q * (64 * 65) + n * 65 + kq;
      if (f8) { pg8::u32x2 w; w.x = pk4_fp8(r[0] * F8_SW, r[1] * F8_SW, r[2] * F8_SW, r[3] * F8_SW); w.y = pk4_fp8(r[4] * F8_SW, r[5] * F8_SW, r[6] * F8_SW, r[7] * F8_SW);
          const int nn = n0 + n, kk = k0 + q * 64 + kq;
          *(pg8::u32x2*)((unsigned char*)dst + (size_t)(nn >> 8) * 256 * K + (size_t)(kk >> 7) * (256 * 128) + (nn & 255) * 128 + (kk & 127)) = w; }
      else { pg8::u32x4 w; w.x = cvt_pk_bf16(r[0], r[1]); w.y = cvt_pk_bf16(r[2], r[3]); w.z = cvt_pk_bf16(r[4], r[5]); w.w = cvt_pk_bf16(r[6], r[7]);
          const int nn = n0 + n, kk = k0 + q * 64 + kq;
          *(pg8::u32x4*)(dst + (size_t)(nn >> 8) * 256 * K + (size_t)(kk >> 6) * (256 * 64) + (nn & 255) * 64 + (kk & 63)) = w; } }
    __syncthreads();
}
DEV void ph_convert(const Params& p, char* smem) {
    const int tidx = tid_of(p.wave_id);
    float* T = (float*)(smem + 256);
    volatile int* msg = (volatile int*)smem;
    unsigned* qh = (unsigned*)(p.ws + OFF_bar) + CW_QHEAD;
    constexpr int T_IN = 2 * 60 * 4, T_OUT = 2 * 16 * 4, T_W1 = 64 * 32 * 4, T_W2 = 64 * 16 * 4;
    unsigned nxt = 0u;
    if (tidx == 0) nxt = xb_add(qh, 1u);
    for (;;) {
        __syncthreads();
        if (tidx == 0) msg[0] = (int)nxt;
        __syncthreads();
        const int u = msg[0];
        if (u >= T_IN + T_OUT + T_W1 + T_W2) break;
        if (tidx == 0) nxt = xb_add(qh, 1u);
        if (u < T_IN) { const int l = u / 240, r = u % 240, nt = r >> 2, kq = r & 3;
            const int n0 = nt * 64; int ns0, nv;
            if (n0 < 2048) { ns0 = n0; nv = DPW; } else if (n0 < 3584) { ns0 = n0 + 16; nv = DPW; } else if (n0 == 3584) { ns0 = 2048; nv = 2064; } else { ns0 = 0; nv = 0; }
            cvt_tile4(p.w_in + (size_t)l * D * DPW, DPW, nv, (bf16_t*)(p.ws + OFF_WIN) + (size_t)l * DP * D, D, n0, kq * 256, T, tidx, ns0); }
        else if (u < T_IN + T_OUT) { const int v = u - T_IN, l = v >> 6, r = v & 63, nt = r >> 2, kq = r & 3;
            cvt_tile4(p.w_out + (size_t)l * D * D, D, D, (bf16_t*)(p.ws + OFF_WOUT) + (size_t)l * D * D, D, nt * 64, kq * 256, T, tidx); }
        else if (u < T_IN + T_OUT + T_W1) { const int v = u - T_IN - T_OUT, le = v >> 7, r = v & 127, nt = r >> 2, kq = r & 3;
            cvt_tile4(p.w1 + (size_t)le * D * 2048, 2048, 2048, (bf16_t*)(p.ws + OFF_W1T + (size_t)le * 2048 * D), D, nt * 64, kq * 256, T, tidx, -1, true); }
        else { const int v = u - T_IN - T_OUT - T_W1, le = v >> 6, r = v & 63, nt = r >> 2, kq = r & 3;
            cvt_tile4(p.w2 + (size_t)le * DFF * D, D, D, (bf16_t*)(p.ws + OFF_W2T + (size_t)le * D * DFF), DFF, nt * 64, kq * 256, T, tidx, -1, true); }
    }
}

DEV void row_load(const float* src, float4 (&v)[4], int lane) {
#pragma unroll
    for (int i = 0; i < 4; ++i) v[i] = *(const float4*)(src + i * 256 + lane * 4);
}
DEV void row_store(float* dst, const float4 (&v)[4], int lane) {
#pragma unroll
    for (int i = 0; i < 4; ++i) *(float4*)(dst + i * 256 + lane * 4) = v[i];
}
DEV void row_store_bf16(bf16_t* dst, const float4 (&v)[4], int lane) {
#pragma unroll
    for (int i = 0; i < 4; ++i) { pg8::u32x2 w; w.x = cvt_pk_bf16(v[i].x, v[i].y); w.y = cvt_pk_bf16(v[i].z, v[i].w); *(pg8::u32x2*)(dst + i * 256 + lane * 4) = w; }
}
DEV void row_store_fp8(unsigned char* dst, const float4 (&v)[4], int lane, float sc) {
#pragma unroll
    for (int i = 0; i < 4; ++i) *(unsigned*)(dst + i * 256 + lane * 4) = pk4_fp8(v[i].x * sc, v[i].y * sc, v[i].z * sc, v[i].w * sc);
}
DEV void row_load_bf(const bf16_t* src, float4 (&v)[4], int lane) {
#pragma unroll
    for (int i = 0; i < 4; ++i) { const pg8::u32x2 w = *(const pg8::u32x2*)(src + i * 256 + lane * 4);
        v[i] = make_float4(__uint_as_float(w.x << 16), __uint_as_float(w.x & 0xffff0000u), __uint_as_float(w.y << 16), __uint_as_float(w.y & 0xffff0000u)); }
}
DEV float row_rinv(const float4 (&v)[4]) {
    float ss = 0.f;
#pragma unroll
    for (int i = 0; i < 4; ++i) ss += v[i].x * v[i].x + v[i].y * v[i].y + v[i].z * v[i].z + v[i].w * v[i].w;
    ss = wsum(ss);
    return rsqrtf(ss * (1.f / 1024.f) + 1e-6f);
}
DEV void row_modnorm(const float4 (&v)[4], const float* gain, const float* shift, const float* scale, float4 (&o)[4], int lane) {
    const float r = row_rinv(v);
#pragma unroll
    for (int i = 0; i < 4; ++i) {
        const int idx = i * 256 + lane * 4;
        const float4 g = *(const float4*)(gain + idx), sh = *(const float4*)(shift + idx), sc = *(const float4*)(scale + idx);
        o[i].x = v[i].x * r * g.x * (1.f + sc.x) + sh.x; o[i].y = v[i].y * r * g.y * (1.f + sc.y) + sh.y;
        o[i].z = v[i].z * r * g.z * (1.f + sc.z) + sh.z; o[i].w = v[i].w * r * g.w * (1.f + sc.w) + sh.w;
    }
}
DEV const float* modrow(const Params& p, int layer, int b, int s) { return ((float*)(p.ws + OFF_MOD)) + ((size_t)layer * 9 + (s < CTX ? 8 : b)) * 6144; }

DEV void ph_mods(const Params& p, char* smem) {
    const int tidx = tid_of(p.wave_id);
    float (*cond)[1024] = (float (*)[1024])smem;
    float (*red)[9][64] = (float (*)[9][64])(smem + 9 * 1024 * 4);
    const int tid = tidx;
    for (int i = tid; i < 9 * 1024; i += 512) { const int r = i >> 10, k = i & 1023; const float c = r < 8 ? p.c[r * 1024 + k] : p.c_ctx[k]; cond[r][k] = c * sigm(c); }
    __syncthreads();
    for (int u = blockIdx.x; u < 192; u += gridDim.x) {
        const int layer = u / 96, cg = u % 96, jj = tid & 63, ks = tid >> 6, j = cg * 64 + jj;
        float acc[9];
#pragma unroll
        for (int r = 0; r < 9; ++r) acc[r] = 0.f;
        const float* w = p.ada_w + (size_t)layer * 1024 * 6144 + j;
        for (int k = ks * 128; k < ks * 128 + 128; ++k) { const float wv = w[(size_t)k * 6144];
#pragma unroll
            for (int r = 0; r < 9; ++r) acc[r] += cond[r][k] * wv; }
#pragma unroll
        for (int r = 0; r < 9; ++r) red[ks][r][jj] = acc[r];
        __syncthreads();
        for (int t = tid; t < 9 * 64; t += 512) { const int r = t >> 6, q = t & 63; float s = 0.f; for (int z = 0; z < 8; ++z) s += red[z][r][q];
            ((float*)(p.ws + OFF_MOD))[((size_t)layer * 9 + r) * 6144 + cg * 64 + q] = s + p.ada_b[layer * 6144 + cg * 64 + q]; }
        __syncthreads();
    }
    if (blockIdx.x == (gridDim.x > 1 ? 1u : 0u)) {
        for (int t = tid; t < 1024; t += 512) { const int pos = t >> 4, i = t & 15; float sn, cs; sincosf((float)pos * expf(-(float)i * (1.f / 16.f) * 9.210340371976184f), &sn, &cs);
            ((float2*)(p.ws + OFF_ROPE))[t] = make_float2(cs, sn); }
    }
    if (blockIdx.x == 0) {
        for (int t = tid; t < 1024; t += 512) { const int layer = t >> 9, dir = (t >> 8) & 1, w = t & 255;
            const float t0 = p.hlb[(dir * 2 + 0) * 256 + w], t1 = p.hlb[(dir * 2 + 1) * 256 + w];
            const float mx = fmaxf(t0, t1), e0 = expf(t0 - mx), e1 = expf(t1 - mx);
            float lb = layer == 0 ? 0.f : e1 / (e0 + e1); lb = fminf(fmaxf(lb, 0.f), 1.f);
            ((float*)(p.ws + OFF_LB))[(layer * 2 + dir) * 256 + w] = lb; }
        if (tid < 128) { const int layer = tid >> 6, lane = tid & 63; const float* L = p.dlam + layer * 256;
            const float s1 = wsum(L[lane] * L[64 + lane]), s2 = wsum(L[128 + lane] * L[192 + lane]);
            if (lane == 0) ((float*)(p.ws + OFF_LAM))[layer] = expf(s1) - expf(s2) + lam_init_of(layer); }
    }
}

DEV void ph_init(const Params& p, char* smem) {
    const int tidx = tid_of(p.wave_id);
    const int wid = tidx >> 6, lane = tidx & 63;
    for (int r = blockIdx.x * 8 + wid; r < NT; r += gridDim.x * 8) {
        const int b = r / SL, s = r % SL;
        const float* src = s < CTX ? p.ctx + ((size_t)b * CTX + s) * D : p.x + ((size_t)b * SEQ + (s - CTX)) * D;
        float4 v[4], o[4]; row_load(src, v, lane); row_store_bf16((bf16_t*)(p.ws + OFF_X) + (size_t)r * D, v, lane);
        const float* m = modrow(p, 0, b, s);
        row_modnorm(v, p.norms + 0, m + 0, m + 1024, o, lane);
        row_store_bf16((bf16_t*)(p.ws + OFF_XNB) + (size_t)r * D, o, lane);
    }
}


struct EpiIn {
    static constexpr bool PERM = false;
    bf16_t *PB, *QRB, *Q0B, *KB, *VB; const float* CS;
    DEV void operator()(const pg8::f32x4 (&acc)[2][2][4][2], const pg8::Unit& u, int wr, int wc, int fr, int fq) const {
        using pg8::f32x4; using pg8::u32x2;
        const int pn = u.pn;
        if (pn < 8 || pn == 14) {
#pragma unroll
            for (int ai = 0; ai < 2; ++ai)
#pragma unroll
                for (int m = 0; m < 4; ++m) { bf16_t* rowp = PB + (size_t)(u.pm * 256 + ai * 128 + wr * 64 + m * 16 + fr) * DP + pn * 256 + wc * 32 + 4 * fq;
#pragma unroll
                    for (int bj = 0; bj < 2; ++bj)
#pragma unroll
                        for (int n = 0; n < 2; ++n) { const f32x4 v = acc[ai][bj][m][n]; u32x2 w; w.x = cvt_pk_bf16(v[0], v[1]); w.y = cvt_pk_bf16(v[2], v[3]); *(u32x2*)(rowp + bj * 128 + n * 16) = w; } }
        } else {
            const int kind = (pn - 8) >> 1, hb = ((pn - 8) & 1) * 2, b = u.pm / 9, tq = u.pm % 9, half = wc & 1, jsub = wc >> 1;
            const bool isctx = tq == 0;
            const float QC = 0.125f * 1.4426950408889634f;
#pragma unroll
            for (int ai = 0; ai < 2; ++ai)
#pragma unroll
                for (int m = 0; m < 4; ++m) {
                    const int s = tq * 256 + ai * 128 + wr * 64 + m * 16 + fr;
                    f32x4 c4 = {1.f, 1.f, 1.f, 1.f}, s4 = {0.f, 0.f, 0.f, 0.f};
                    if (kind != 2 && !isctx) { const int pos = half == 0 ? (tq - 1) * 4 + ai * 2 + wr : m * 16 + fr;
                        const f32x4 t0 = *(const f32x4*)(CS + (pos * 16 + 4 * fq) * 2), t1 = *(const f32x4*)(CS + (pos * 16 + 4 * fq) * 2 + 4);
                        c4 = (f32x4){t0[0], t0[2], t1[0], t1[2]}; s4 = (f32x4){t0[1], t0[3], t1[1], t1[3]}; }
#pragma unroll
                    for (int bj = 0; bj < 2; ++bj) {
                        const size_t dst = ((size_t)(b * 4 + hb + bj) * SL + s) * 128 + jsub * 64 + half * 32 + 4 * fq;
                        const f32x4 x1 = acc[ai][bj][m][0], x2 = acc[ai][bj][m][1];
#define ST4(ptr, v) do { u32x2 w_; w_.x = cvt_pk_bf16((v)[0], (v)[1]); w_.y = cvt_pk_bf16((v)[2], (v)[3]); *(u32x2*)(ptr) = w_; } while (0)
                        if (kind == 2) { ST4(VB + dst, x1); ST4(VB + dst + 16, x2); }
                        else {
                            const f32x4 o1 = x1 * c4 - x2 * s4, o2 = x1 * s4 + x2 * c4;
                            if (kind == 1) { ST4(KB + dst, o1); ST4(KB + dst + 16, o2); }
                            else { const f32x4 a1 = o1 * QC, a2 = o2 * QC, p1 = x1 * QC, p2 = x2 * QC; ST4(QRB + dst, a1); ST4(QRB + dst + 16, a2); ST4(Q0B + dst, p1); ST4(Q0B + dst + 16, p2); }
                        }
#undef ST4
                    }
                }
        }
    }
};

struct InOrder {
    int G, c, Lbeg, Lend; const char* Bt; int K;
    DEV bool next(int i, pg8::Unit& u) const {
        const int L = Lbeg + i * G + c; if (L >= Lend) return false;
        const int nN = L < 648 ? 9 : 6, l = L < 648 ? L : L - 648, nM = NT / 256, nwg = nM * nN;
        int wgid = l; { const int q = nwg / 8, r = nwg % 8, xcd = wgid % 8, off = wgid / 8; wgid = (xcd < r ? xcd * (q + 1) : r * (q + 1) + (xcd - r) * q) + off; }
        const int nig = 8 * nN, gid = wgid / nig, fm = gid * 8, gsz = (nM - fm) < 8 ? (nM - fm) : 8;
        const int pnl = (wgid % nig) / gsz;
        u.pm = fm + ((wgid % nig) % gsz); u.pn = L < 648 ? (pnl < 8 ? pnl : 14) : 8 + pnl; u.e = 0; u.t = 0; return true;
    }
    DEV int arow(const pg8::Unit& u, int rr) const { return u.pm * 256 + rr; }
    DEV const char* bbase(const pg8::Unit& u) const { return Bt + (size_t)u.pn * 256 * K * 2; }
};
DEV void ph_inproj(const Params& p, int layer, char* smem, int part) {
    const int tidx = tid_of(p.wave_id);
    const int G = (int)gridDim.x, nun = (NT / 256) * (DP / 256), cut = 4 * G < nun ? 4 * G : nun;
    const int nleft = nun - cut, cid = part == 0 ? (int)blockIdx.x : (int)blockIdx.x - (G - nleft);
    if (part == 1 && (nleft <= 0 || cid < 0)) return;
    InOrder S{G, cid, part == 0 ? 0 : cut, part == 0 ? cut : nun, (const char*)((const bf16_t*)(p.ws + OFF_WIN) + (size_t)layer * DP * D), D};
    EpiIn E{(bf16_t*)(p.ws + OFF_PB), (bf16_t*)(p.ws + OFF_QRB), (bf16_t*)(p.ws + OFF_Q0B), (bf16_t*)(p.ws + OFF_KB), (bf16_t*)(p.ws + OFF_VB), (const float*)(p.ws + OFF_ROPE)};
    pg8::gemm_phase(( LAS unsigned char*)smem, (const char*)(p.ws + OFF_XNB), D, S, E, tid_of(p.wave_id));
}


namespace scn {
using att::bf16x8; using att::s16x4; using att::f32x16; using att::u32x4; using att::crow;
DEV int v_st64(int k, int c) { const int kk = (k & ~0xC) | ((k & 4) << 1) | ((k & 8) >> 1); return ((kk >> 3) * 2 + (c >> 5)) * 512 + ((kk & 7) * 32 + (c & 31)) * 2; }
constexpr int v_rd_off64(int d0, int ks, int half) { return d0 * 512 + ks * 2048 + half * 1024; }
#define SCN_PK(L, H) (bf16x8){L[0], L[1], L[2], L[3], H[0], H[1], H[2], H[3]}
template <int D0> DEV void frags4(int vb, bf16x8& f0, bf16x8& f1, bf16x8& f2, bf16x8& f3) {
    const s16x4 l0 = att::tr_read<v_rd_off64(D0, 0, 0)>(vb), h0 = att::tr_read<v_rd_off64(D0, 0, 1)>(vb), l1 = att::tr_read<v_rd_off64(D0, 1, 0)>(vb), h1 = att::tr_read<v_rd_off64(D0, 1, 1)>(vb);
    const s16x4 l2 = att::tr_read<v_rd_off64(D0, 2, 0)>(vb), h2 = att::tr_read<v_rd_off64(D0, 2, 1)>(vb), l3 = att::tr_read<v_rd_off64(D0, 3, 0)>(vb), h3 = att::tr_read<v_rd_off64(D0, 3, 1)>(vb);
    asm volatile("s_waitcnt lgkmcnt(0)" ::: "memory"); SBAR();
    f0 = SCN_PK(l0, h0); f1 = SCN_PK(l1, h1); f2 = SCN_PK(l2, h2); f3 = SCN_PK(l3, h3);
}
DEV bf16x8 pack8(const float (&v)[8]) { u32x4 w = {cvt_pk_bf16(v[0], v[1]), cvt_pk_bf16(v[2], v[3]), cvt_pk_bf16(v[4], v[5]), cvt_pk_bf16(v[6], v[7])}; return *reinterpret_cast<bf16x8*>(&w); }
DEV void stage64(char* img, const float* src, size_t ld, int lane, float sc = 1.f) {
    const float* row = src + (size_t)lane * ld;
#pragma unroll
    for (int c8 = 0; c8 < 8; ++c8) { const float4 a = *(const float4*)(row + c8 * 8), b = *(const float4*)(row + c8 * 8 + 4);
        u32x4 w = {cvt_pk_bf16(a.x * sc, a.y * sc), cvt_pk_bf16(a.z * sc, a.w * sc), cvt_pk_bf16(b.x * sc, b.y * sc), cvt_pk_bf16(b.z * sc, b.w * sc)};
        *(u32x4*)(img + v_st64(lane, c8 * 8)) = w; }
}
template <int CTRL, int RM> DEV float dpp_f(float oldv, float v, bool bc) { return bc ? __builtin_bit_cast(float, __builtin_amdgcn_update_dpp(__builtin_bit_cast(int, oldv), __builtin_bit_cast(int, v), CTRL, RM, 0xf, true))
                                                                                   : __builtin_bit_cast(float, __builtin_amdgcn_update_dpp(__builtin_bit_cast(int, oldv), __builtin_bit_cast(int, v), CTRL, RM, 0xf, false)); }
DEV float bperm(float v, int src) { return __builtin_bit_cast(float, __builtin_amdgcn_ds_bpermute(src << 2, __builtin_bit_cast(int, v))); }
DEV float scan_inc32(float v) {
    v += dpp_f<0x111, 0xf>(0.f, v, true); v += dpp_f<0x112, 0xf>(0.f, v, true); v += dpp_f<0x114, 0xf>(0.f, v, true); v += dpp_f<0x118, 0xf>(0.f, v, true);
    v += dpp_f<0x142, 0xa>(0.f, v, false);
    return v;
}
DEV float scanmax_inc32(float v) {
    const float ni = -3.0e38f;
    v = fmaxf(v, dpp_f<0x111, 0xf>(ni, v, false)); v = fmaxf(v, dpp_f<0x112, 0xf>(ni, v, false)); v = fmaxf(v, dpp_f<0x114, 0xf>(ni, v, false)); v = fmaxf(v, dpp_f<0x118, 0xf>(ni, v, false));
    v = fmaxf(v, dpp_f<0x142, 0xa>(ni, v, false));
    return v;
}
DEV float scanmax_suf32(float v, int lane) {
    const float ni = -3.0e38f;
    v = fmaxf(v, dpp_f<0x101, 0xf>(ni, v, false)); v = fmaxf(v, dpp_f<0x102, 0xf>(ni, v, false)); v = fmaxf(v, dpp_f<0x104, 0xf>(ni, v, false)); v = fmaxf(v, dpp_f<0x108, 0xf>(ni, v, false));
    const float t = bperm(v, (lane & 32) | 16);
    return (lane & 16) ? v : fmaxf(v, t);
}
DEV void ld8(const bf16_t* ub, unsigned boff, float (&v)[8]) { const u32x4 w = *(const u32x4*)((const char*)ub + boff);
    v[0] = __uint_as_float(w.x << 16); v[1] = __uint_as_float(w.x & 0xffff0000u); v[2] = __uint_as_float(w.y << 16); v[3] = __uint_as_float(w.y & 0xffff0000u);
    v[4] = __uint_as_float(w.z << 16); v[5] = __uint_as_float(w.z & 0xffff0000u); v[6] = __uint_as_float(w.w << 16); v[7] = __uint_as_float(w.w & 0xffff0000u); }
DEV float ld1(const bf16_t* ub, unsigned boff) { return __uint_as_float((unsigned)(*(const unsigned short*)((const char*)ub + boff)) << 16); }
DEV void stage64b(char* img, const bf16_t* src, size_t ld, int lane) {
    const bf16_t* row = src + (size_t)lane * ld;
#pragma unroll
    for (int c8 = 0; c8 < 8; ++c8) *(u32x4*)(img + v_st64(lane, c8 * 8)) = *(const u32x4*)(row + c8 * 8);
}
DEV float4 ldg4(const float* ub, unsigned boff) { return *(const float4*)((const char*)ub + boff); }
DEV float ldg1(const float* ub, unsigned boff) { return *(const float*)((const char*)ub + boff); }
DEV float fexp(float x) { return __expf(fminf(fmaxf(x, -80.f), 80.f)); }
DEV float fsig(float x) { return __builtin_amdgcn_rcpf(1.f + __expf(-x)); }
DEV void decay_ks(const float (&x)[2][8], const float (&lb)[8], int dir, int lane, float (&cum)[2][8], float (&kk)[2][8], float (&ref)[8]) {
#pragma unroll
    for (int tb = 0; tb < 2; ++tb)
#pragma unroll
        for (int j = 0; j < 8; ++j) { const float sg = fsig(x[tb][j]); kk[tb][j] = (1.f - lb[j]) * (1.f - sg); cum[tb][j] = __logf(fmaxf(lb[j] + (1.f - lb[j]) * sg, 1e-12f)); }
#pragma unroll
    for (int j = 0; j < 8; ++j) {
        const float i0 = scan_inc32(cum[0][j]), i1 = scan_inc32(cum[1][j]), t0 = bperm(i0, lane | 31), t1 = bperm(i1, lane | 31);
        if (dir == 0) { cum[0][j] = i0; cum[1][j] = i1 + t0; ref[j] = t0; }
        else { const float x0 = cum[0][j], x1 = cum[1][j]; cum[1][j] = t1 - i1 + x1; cum[0][j] = t0 - i0 + x0 + t1; ref[j] = t1; }
        if ((j & 3) == 3) SBAR();
    }
}
}

DEV void scanA_local(const Params& p, int layer, char* Lw, int bh, int tc, int lane) {
    using namespace scn;
    asm volatile("" : "+v"(lane));
    const int r32 = lane & 31, hi = lane >> 5, b = bh >> 2, h = bh & 3;
    const bf16_t* base = (const bf16_t*)(p.ws + OFF_PB) + (size_t)(b * SL + 64 * tc) * DP;
    unsigned lo = (unsigned)(r32 * DP + 8 * hi) * 2u;
    asm volatile("" : "+v"(lo));
    char* imgV = Lw; char* imgK = Lw + 8192;
    const int vbV = (int)(uintptr_t)imgV + att::v_rd_base(lane), vbK = vbV + 8192;
    stage64b(imgV, base + O_AI + h * 64, DP, lane);
#pragma unroll 1
    for (int dir = 0; dir < 2; ++dir) {
        const int chain = bh * 2 + dir, c = dir == 0 ? tc : (tc < 4 ? 3 - tc : 39 - tc);
#pragma unroll 1
        for (int ks = 0; ks < 4; ++ks) {
            const int ch = 16 * ks + 8 * hi;
            float x[2][8], cum[2][8], kk[2][8], ref[8], lb[8];
#pragma unroll
            for (int tb = 0; tb < 2; ++tb) ld8(base + (dir ? O_AFB : O_AFF) + h * 64 + 16 * ks, lo + tb * (32u * DP * 2u), x[tb]);
            { const float* l = (const float*)(p.ws + OFF_LB) + (layer * 2 + dir) * 256 + h * 64 + ch;
#pragma unroll
              for (int j = 0; j < 8; ++j) lb[j] = l[j]; }
            decay_ks(x, lb, dir, lane, cum, kk, ref);
            float ke[8];
#pragma unroll
            for (int tb = 0; tb < 2; ++tb) {
#pragma unroll
                for (int j = 0; j < 8; ++j) { const float ce = dir == 0 ? bperm(cum[1][j], lane | 31) : bperm(cum[0][j], lane & 32);
                    ke[j] = kk[tb][j] * fexp(ce - cum[tb][j]);
                    if (tb == 1 && dir == 0 && r32 == 31) ((float*)(p.ws + OFF_DECA))[(chain * 36 + c) * 64 + ch + j] = __expf(ce);
                    if (tb == 0 && dir == 1 && r32 == 0) ((float*)(p.ws + OFF_DECA))[(chain * 36 + c) * 64 + ch + j] = __expf(ce); }
                *(bf16x8*)(imgK + v_st64(32 * tb + r32, ch)) = pack8(ke);
            }
            SBAR();
        }
        f32x16 u[2][2] = {};
        { bf16x8 k0, k1, k2, k3, v0, v1, v2, v3;
          frags4<0>(vbK, k0, k1, k2, k3); frags4<0>(vbV, v0, v1, v2, v3);
          u[0][0] = __builtin_amdgcn_mfma_f32_32x32x16_bf16(k0, v0, u[0][0], 0, 0, 0); u[0][0] = __builtin_amdgcn_mfma_f32_32x32x16_bf16(k1, v1, u[0][0], 0, 0, 0);
          u[0][0] = __builtin_amdgcn_mfma_f32_32x32x16_bf16(k2, v2, u[0][0], 0, 0, 0); u[0][0] = __builtin_amdgcn_mfma_f32_32x32x16_bf16(k3, v3, u[0][0], 0, 0, 0);
          bf16x8 w0, w1, w2, w3; frags4<1>(vbV, w0, w1, w2, w3);
          u[0][1] = __builtin_amdgcn_mfma_f32_32x32x16_bf16(k0, w0, u[0][1], 0, 0, 0); u[0][1] = __builtin_amdgcn_mfma_f32_32x32x16_bf16(k1, w1, u[0][1], 0, 0, 0);
          u[0][1] = __builtin_amdgcn_mfma_f32_32x32x16_bf16(k2, w2, u[0][1], 0, 0, 0); u[0][1] = __builtin_amdgcn_mfma_f32_32x32x16_bf16(k3, w3, u[0][1], 0, 0, 0);
          frags4<1>(vbK, k0, k1, k2, k3);
          u[1][0] = __builtin_amdgcn_mfma_f32_32x32x16_bf16(k0, v0, u[1][0], 0, 0, 0); u[1][0] = __builtin_amdgcn_mfma_f32_32x32x16_bf16(k1, v1, u[1][0], 0, 0, 0);
          u[1][0] = __builtin_amdgcn_mfma_f32_32x32x16_bf16(k2, v2, u[1][0], 0, 0, 0); u[1][0] = __builtin_amdgcn_mfma_f32_32x32x16_bf16(k3, v3, u[1][0], 0, 0, 0);
          u[1][1] = __builtin_amdgcn_mfma_f32_32x32x16_bf16(k0, w0, u[1][1], 0, 0, 0); u[1][1] = __builtin_amdgcn_mfma_f32_32x32x16_bf16(k1, w1, u[1][1], 0, 0, 0);
          u[1][1] = __builtin_amdgcn_mfma_f32_32x32x16_bf16(k2, w2, u[1][1], 0, 0, 0); u[1][1] = __builtin_amdgcn_mfma_f32_32x32x16_bf16(k3, w3, u[1][1], 0, 0, 0); }
        float* U = (float*)(p.ws + OFF_UA) + ((size_t)chain * 36 + c) * 4096;
#pragma unroll
        for (int kb = 0; kb < 2; ++kb)
#pragma unroll
            for (int d0 = 0; d0 < 2; ++d0)
#pragma unroll
                for (int r = 0; r < 16; ++r) U[(32 * kb + crow(r, hi)) * 64 + 32 * d0 + r32] = u[kb][d0][r];
    }
}
DEV void scanA_out(const Params& p, int layer, char* Lw, int bh, int tc, int lane) {
    using namespace scn;
    asm volatile("" : "+v"(lane));
    const int r32 = lane & 31, hi = lane >> 5, b = bh >> 2, h = bh & 3;
    const bf16_t* base = (const bf16_t*)(p.ws + OFF_PB) + (size_t)(b * SL + 64 * tc) * DP;
    unsigned lo = (unsigned)(r32 * DP + 8 * hi) * 2u;
    asm volatile("" : "+v"(lo));
    char* imgV = Lw; char* imgS = Lw + 8192;
    const int vbV = (int)(uintptr_t)imgV + att::v_rd_base(lane), vbS = vbV + 8192;
    stage64b(imgV, base + O_AI + h * 64, DP, lane);
    f32x16 o[2][2] = {};
#pragma unroll 1
    for (int dir = 0; dir < 2; ++dir) {
        const int chain = bh * 2 + dir, c = dir == 0 ? tc : (tc < 4 ? 3 - tc : 39 - tc);
        const float* S0g = (const float*)(p.ws + OFF_SA) + ((size_t)chain * 36 + c) * 4096;
        f32x16 pd0 = {}, pd1 = {}, px = {};
#define MM(acc, A, B) acc = __builtin_amdgcn_mfma_f32_32x32x16_bf16(A, B, acc, 0, 0, 0)
#define LOADX(ks) do { _Pragma("unroll") for (int tb = 0; tb < 2; ++tb) ld8(base + (dir ? O_AFB : O_AFF) + h * 64 + 16 * (ks), lo + tb * (32u * DP * 2u), xr[tb]); } while (0)
#define LOADQ(ks) do { _Pragma("unroll") for (int tb = 0; tb < 2; ++tb) ld8(base + O_AQ + h * 64 + 16 * (ks), lo + tb * (32u * DP * 2u), qr[tb]); } while (0)
        float xr[2][8], qr[2][8];
#define KSTEP(ks) do { \
            const int ch = 16 * (ks) + 8 * hi; \
            float cum[2][8], kk[2][8], ref[8], lb[8]; \
            { const float* l = (const float*)(p.ws + OFF_LB) + (layer * 2 + dir) * 256 + h * 64 + ch; _Pragma("unroll") for (int j = 0; j < 8; ++j) lb[j] = l[j]; } \
            const int ci = lane >> 2; const int row = 16 * (ks) + ci, c16 = (lane & 3) * 16; const float* sp = S0g + row * 64 + c16; \
            LOADX(ks); LOADQ(ks); decay_ks(xr, lb, dir, lane, cum, kk, ref); \
            const float4 sa = *(const float4*)sp, sb4 = *(const float4*)(sp + 4), sc4 = *(const float4*)(sp + 8), sd4 = *(const float4*)(sp + 12); \
              \
            { const int sj = ci & 7, sl = (ci >> 3) * 32; float rv = 0.f; \
              _Pragma("unroll") for (int j = 0; j < 8; ++j) { const float t = bperm(ref[j], sl); rv = (sj == j) ? t : rv; } \
              const float er = __expf(fmaxf(rv, -80.f)); \
              u32x4 w0 = {cvt_pk_bf16(sa.x * er, sa.y * er), cvt_pk_bf16(sa.z * er, sa.w * er), cvt_pk_bf16(sb4.x * er, sb4.y * er), cvt_pk_bf16(sb4.z * er, sb4.w * er)}; \
              u32x4 w1 = {cvt_pk_bf16(sc4.x * er, sc4.y * er), cvt_pk_bf16(sc4.z * er, sc4.w * er), cvt_pk_bf16(sd4.x * er, sd4.y * er), cvt_pk_bf16(sd4.z * er, sd4.w * er)}; \
              *(u32x4*)(imgS + v_st64(row, c16)) = w0; *(u32x4*)(imgS + v_st64(row, c16 + 8)) = w1; } \
            bf16x8 qt0, qt1, kt0, kt1; \
            _Pragma("unroll") for (int tb = 0; tb < 2; ++tb) { \
                float t1[8], t2[8]; \
                _Pragma("unroll") for (int j = 0; j < 8; ++j) { const float q = qr[tb][j] * fsig(qr[tb][j]); t1[j] = q * fexp(cum[tb][j] - ref[j]); t2[j] = kk[tb][j] * fexp(ref[j] - cum[tb][j]); } \
                if (tb == 0) { qt0 = pack8(t1); kt0 = pack8(t2); } else { qt1 = pack8(t1); kt1 = pack8(t2); } } \
            MM(pd0, kt0, qt0); MM(pd1, kt1, qt1); if (dir == 0) MM(px, kt0, qt1); else MM(px, kt1, qt0); \
            { const s16x4 l0 = att::tr_read<v_rd_off64(0, ks, 0)>(vbS), h0 = att::tr_read<v_rd_off64(0, ks, 1)>(vbS), l1 = att::tr_read<v_rd_off64(1, ks, 0)>(vbS), h1 = att::tr_read<v_rd_off64(1, ks, 1)>(vbS); \
              asm volatile("s_waitcnt lgkmcnt(0)" ::: "memory"); SBAR(); \
              const bf16x8 s0 = SCN_PK(l0, h0), s1 = SCN_PK(l1, h1); \
              MM(o[0][0], qt0, s0); MM(o[1][0], qt1, s0); MM(o[0][1], qt0, s1); MM(o[1][1], qt1, s1); } \
            SBAR(); } while (0)
        KSTEP(0); KSTEP(1); KSTEP(2); KSTEP(3);
#undef KSTEP
#undef LOADX
#undef LOADQ
        const int r32m = r32;
#pragma unroll
        for (int r = 0; r < 16; ++r) { const int sl = crow(r, hi); const bool keep = dir == 0 ? (sl <= r32m) : (sl >= r32m); pd0[r] = keep ? pd0[r] : 0.f; pd1[r] = keep ? pd1[r] : 0.f; }
        bf16x8 a0, a1, b0, b1, c0, c1;
#define PK4(P, BASE, OUT) do { unsigned a0_ = cvt_pk_bf16(P[BASE + 0], P[BASE + 1]), a1_ = cvt_pk_bf16(P[BASE + 2], P[BASE + 3]);   \
    unsigned b0_ = cvt_pk_bf16(P[BASE + 4], P[BASE + 5]), b1_ = cvt_pk_bf16(P[BASE + 6], P[BASE + 7]);                              \
    auto r0_ = __builtin_amdgcn_permlane32_swap(a0_, b0_, false, false); auto r1_ = __builtin_amdgcn_permlane32_swap(a1_, b1_, false, false); \
    u32x4 w_ = {r0_[0], r1_[0], r0_[1], r1_[1]}; OUT = *reinterpret_cast<bf16x8*>(&w_); } while (0)
        PK4(pd0, 0, a0); PK4(pd0, 8, a1); PK4(pd1, 0, b0); PK4(pd1, 8, b1); PK4(px, 0, c0); PK4(px, 8, c1);
#undef PK4
        {   bf16x8 v0, v1, v2, v3;
#define BLOCK(D0) do { frags4<D0>(vbV, v0, v1, v2, v3); \
            if (dir == 0) { MM(o[0][D0], a0, v0); MM(o[0][D0], a1, v1); MM(o[1][D0], c0, v0); MM(o[1][D0], c1, v1); MM(o[1][D0], b0, v2); MM(o[1][D0], b1, v3); } \
            else          { MM(o[0][D0], a0, v0); MM(o[0][D0], a1, v1); MM(o[0][D0], c0, v2); MM(o[0][D0], c1, v3); MM(o[1][D0], b0, v2); MM(o[1][D0], b1, v3); } } while (0)
            BLOCK(0); BLOCK(1);
#undef BLOCK
        }
#undef MM
    }
    unsigned rob = (unsigned)(4 * hi * DP + r32) * 2u, mob = (unsigned)(4 * hi * D + r32) * 2u;
    asm volatile("" : "+v"(rob), "+v"(mob));
    float gv[2][16][2];
#pragma unroll
    for (int tb = 0; tb < 2; ++tb)
#pragma unroll
        for (int r = 0; r < 16; ++r) { const unsigned go = rob + (unsigned)(32 * tb + (r & 3) + 8 * (r >> 2)) * (DP * 2u); const bf16_t* gb = base + O_AG + h * 64;
            gv[tb][r][0] = ld1(gb, go); gv[tb][r][1] = ld1(gb, go + 64u); }
#pragma unroll
    for (int tb = 0; tb < 2; ++tb)
#pragma unroll
        for (int r = 0; r < 16; ++r) {
            const float x0 = o[tb][0][r], x1 = o[tb][1][r];
            float t = x0 * x0 + x1 * x1; t += bperm(t, lane ^ 1); t += bperm(t, lane ^ 2); t += bperm(t, lane ^ 4); t += bperm(t, lane ^ 8); t += bperm(t, lane ^ 16);
            const float ri = rsqrtf(t * (1.f / 64.f) + 1e-6f);
            const unsigned tcst = (unsigned)(32 * tb + (r & 3) + 8 * (r >> 2));
            const float g0 = gv[tb][r][0], g1 = gv[tb][r][1];
            char* mb = (char*)((bf16_t*)(p.ws + OFF_MIXB) + (size_t)(b * SL + 64 * tc) * D + h * 64); const unsigned mo = mob + tcst * (D * 2u);
            *(bf16_t*)(mb + mo) = (bf16_t)(cvt_pk_bf16(x0 * ri * p.hnorm[layer * 64 + r32] * (g0 * fsig(g0)), 0.f) & 0xffffu);
            *(bf16_t*)(mb + mo + 64u) = (bf16_t)(cvt_pk_bf16(x1 * ri * p.hnorm[layer * 64 + 32 + r32] * (g1 * fsig(g1)), 0.f) & 0xffffu);
        }
}

namespace scn {
DEV float logsig_f(float g) { return fminf(g, 0.f) - __logf(1.f + __expf(-fabsf(g))); }
DEV void gates_B(const bf16_t* gb  , unsigned rowoff, int dir, float bi, float bf, int lane, float (&cumf)[2], float (&g)[2], float (&G)[2], float& cend, float& gmax) {
    float lf[2], li[2];
#pragma unroll
    for (int tb = 0; tb < 2; ++tb) { const unsigned bo = rowoff + tb * (32u * DP * 2u); li[tb] = ld1(gb + (dir * 2 + 0) * 4, bo) + bi; lf[tb] = logsig_f(ld1(gb + (dir * 2 + 1) * 4, bo) + bf); }
    { const float i0 = scan_inc32(lf[0]), i1 = scan_inc32(lf[1]), t0 = bperm(i0, lane | 31), t1 = bperm(i1, lane | 31);
      if (dir == 0) { cumf[0] = i0; cumf[1] = i1 + t0; } else { cumf[1] = t1 - i1 + lf[1]; cumf[0] = t0 - i0 + lf[0] + t1; }
      cend = t0 + t1; }
    g[0] = li[0] - cumf[0]; g[1] = li[1] - cumf[1];
    if (dir == 0) { const float a0 = scanmax_inc32(g[0]), m0 = bperm(a0, lane | 31), a1 = fmaxf(scanmax_inc32(g[1]), m0); G[0] = a0; G[1] = a1; gmax = bperm(a1, lane | 31); }
    else { const float a1 = scanmax_suf32(g[1], lane), m1 = bperm(a1, lane & 32), a0 = fmaxf(scanmax_suf32(g[0], lane), m1); G[0] = a0; G[1] = a1; gmax = bperm(a0, lane & 32); }
}
}
DEV void scanB_local(const Params& p, int layer, char* Lw, int bh, int tc, int lane) {
    using namespace scn;
    asm volatile("" : "+v"(lane));
    const int r32 = lane & 31, hi = lane >> 5, b = bh >> 2, h = bh & 3;
    const bf16_t* base = (const bf16_t*)(p.ws + OFF_PB) + (size_t)(b * SL + 64 * tc) * DP;
    unsigned ro = (unsigned)(r32 * DP) * 2u; asm volatile("" : "+v"(ro));
    char* imgV = Lw; char* imgK = Lw + 8192;
    const int vbV = (int)(uintptr_t)imgV + att::v_rd_base(lane), vbK = vbV + 8192;
    stage64b(imgV, base + O_BV + h * 64, DP, lane);
#pragma unroll 1
    for (int dir = 0; dir < 2; ++dir) {
        const int chain = bh * 2 + dir, c = dir == 0 ? tc : (tc < 4 ? 3 - tc : 39 - tc);
        const float bi = p.mgb[layer * 16 + (dir * 2 + 0) * 4 + h], bf = p.mgb[layer * 16 + (dir * 2 + 1) * 4 + h];
        float cumf[2], g[2], G[2], cend, gmax;
        gates_B(base + O_BG + h, ro, dir, bi, bf, lane, cumf, g, G, cend, gmax);
        const float w[2] = {__expf(g[0] - gmax), __expf(g[1] - gmax)};
#pragma unroll
        for (int ks = 0; ks < 2; ++ks) {
            float un[8];
#pragma unroll
            for (int j = 0; j < 8; ++j) un[j] = 0.f;
#pragma unroll
            for (int tb = 0; tb < 2; ++tb) { float wk[8]; ld8(base + O_BK + h * 32 + 16 * ks, ro + 16u * hi + tb * (32u * DP * 2u), wk);
#pragma unroll
                for (int j = 0; j < 8; ++j) { wk[j] *= w[tb]; un[j] += wk[j]; }
                *(bf16x8*)(imgK + v_st64(32 * tb + r32, 16 * ks + 8 * hi)) = pack8(wk); }
#pragma unroll
            for (int j = 0; j < 8; ++j) { float t = un[j]; t += bperm(t, lane ^ 1); t += bperm(t, lane ^ 2); t += bperm(t, lane ^ 4); t += bperm(t, lane ^ 8); t += bperm(t, lane ^ 16);
                if (r32 == 0) ((float*)(p.ws + OFF_NB))[(chain * 36 + c) * 32 + 16 * ks + 8 * hi + j] = t; }
        }
        f32x16 u0 = {}, u1 = {};
        { bf16x8 k0, k1, k2, k3, v0, v1, v2, v3;
#define MM(acc, A, B) acc = __builtin_amdgcn_mfma_f32_32x32x16_bf16(A, B, acc, 0, 0, 0)
          frags4<0>(vbK, k0, k1, k2, k3); frags4<0>(vbV, v0, v1, v2, v3);
          MM(u0, k0, v0); MM(u0, k1, v1); MM(u0, k2, v2); MM(u0, k3, v3);
          frags4<1>(vbV, v0, v1, v2, v3);
          MM(u1, k0, v0); MM(u1, k1, v1); MM(u1, k2, v2); MM(u1, k3, v3);
#undef MM
        }
        float* U = (float*)(p.ws + OFF_UB) + ((size_t)chain * 36 + c) * 2048;
#pragma unroll
        for (int r = 0; r < 16; ++r) { U[crow(r, hi) * 64 + r32] = u0[r]; U[crow(r, hi) * 64 + 32 + r32] = u1[r]; }
        if (lane == 0) { float* M = (float*)(p.ws + OFF_MB) + (chain * 36 + c) * 4; M[0] = cend + gmax; M[1] = cend; }
    }
}
DEV void scanB_out(const Params& p, int layer, char* Lw, int bh, int tc, int lane) {
    using namespace scn;
    asm volatile("" : "+v"(lane));
    const int r32 = lane & 31, hi = lane >> 5, b = bh >> 2, h = bh & 3;
    const bf16_t* base = (const bf16_t*)(p.ws + OFF_PB) + (size_t)(b * SL + 64 * tc) * DP;
    unsigned ro = (unsigned)(r32 * DP) * 2u; asm volatile("" : "+v"(ro));
    char* imgV = Lw; char* imgC = Lw + 8192; float* gA = (float*)(Lw + 12288); float* dA = gA + 64;
    const int vbV = (int)(uintptr_t)imgV + att::v_rd_base(lane), vbC = vbV + 8192;
    stage64b(imgV, base + O_BV + h * 64, DP, lane);
#pragma unroll 1
    for (int dir = 0; dir < 2; ++dir) {
        const int chain = bh * 2 + dir, c = dir == 0 ? tc : (tc < 4 ? 3 - tc : 39 - tc);
        const float bi = p.mgb[layer * 16 + (dir * 2 + 0) * 4 + h], bf = p.mgb[layer * 16 + (dir * 2 + 1) * 4 + h];
        { const float* cg = (const float*)(p.ws + OFF_SB) + ((size_t)chain * 36 + c) * 2048 + (lane >> 1) * 64 + (lane & 1) * 32;
#pragma unroll
          for (int i = 0; i < 4; ++i) { const float4 a = *(const float4*)(cg + 8 * i), bq = *(const float4*)(cg + 8 * i + 4);
              u32x4 w = {cvt_pk_bf16(a.x, a.y), cvt_pk_bf16(a.z, a.w), cvt_pk_bf16(bq.x, bq.y), cvt_pk_bf16(bq.z, bq.w)};
              *(u32x4*)(imgC + v_st64(lane >> 1, (lane & 1) * 32 + 8 * i)) = w; } }
        const float m0 = ((const float*)(p.ws + OFF_MB))[(chain * 36 + c) * 4 + 2];
        float rq[2][2][8], rk[2][2][8];
#pragma unroll
        for (int ks = 0; ks < 2; ++ks)
#pragma unroll
            for (int tb = 0; tb < 2; ++tb) { const unsigned bo = ro + 16u * hi + tb * (32u * DP * 2u);
                ld8(base + O_BQ + h * 32 + 16 * ks, bo, rq[ks][tb]); ld8(base + O_BK + h * 32 + 16 * ks, bo, rk[ks][tb]); }
        float cumf[2], g[2], G[2], cend, gmax;
        gates_B(base + O_BG + h, ro, dir, bi, bf, lane, cumf, g, G, cend, gmax);
        float wi[2], wl[2], emt[2];
#pragma unroll
        for (int tb = 0; tb < 2; ++tb) { const float ml = cumf[tb] + G[tb], mt = fmaxf(cumf[tb] + m0, ml); wi[tb] = __expf(cumf[tb] + m0 - mt); wl[tb] = __expf(ml - mt); emt[tb] = __expf(-mt); }
        if (hi == 0) { gA[r32] = g[0]; gA[32 + r32] = g[1]; }
        f32x16 pd0 = {}, pd1 = {}, px = {};
        float qn[2] = {0.f, 0.f};
        bf16x8 qw[2][2];
#define MM(acc, A, B) acc = __builtin_amdgcn_mfma_f32_32x32x16_bf16(A, B, acc, 0, 0, 0)
#define KSTEP(ks) do { \
            bf16x8 qs0, qs1, kt0, kt1; \
            const float* nn = (const float*)(p.ws + OFF_N0) + (chain * 36 + c) * 32 + 16 * (ks) + 8 * hi; \
            _Pragma("unroll") for (int tb = 0; tb < 2; ++tb) { \
                float q8[8], k8[8], qv[8]; \
                _Pragma("unroll") for (int j = 0; j < 8; ++j) { q8[j] = rq[ks][tb][j] * 0.17677669529663687f; k8[j] = rk[ks][tb][j]; qn[tb] += q8[j] * nn[j]; qv[j] = q8[j] * wi[tb]; } \
                qw[tb][ks] = pack8(qv); \
                if (tb == 0) { qs0 = pack8(q8); kt0 = pack8(k8); } else { qs1 = pack8(q8); kt1 = pack8(k8); } } \
            MM(pd0, kt0, qs0); MM(pd1, kt1, qs1); if (dir == 0) MM(px, kt0, qs1); else MM(px, kt1, qs0); \
            SBAR(); } while (0)
        KSTEP(0); KSTEP(1);
#undef KSTEP
        qn[0] += bperm(qn[0], lane ^ 32); qn[1] += bperm(qn[1], lane ^ 32);
        float ds[2] = {0.f, 0.f};
#pragma unroll
        for (int r = 0; r < 16; ++r) {
            const int sl = crow(r, hi); const bool keep = dir == 0 ? (sl <= r32) : (sl >= r32);
            const float g0 = gA[sl], g1 = gA[32 + sl];
            const float e00 = keep ? __expf(g0 - G[0]) * wl[0] : 0.f, e11 = keep ? __expf(g1 - G[1]) * wl[1] : 0.f;
            const float ex = dir == 0 ? __expf(g0 - G[1]) * wl[1] : __expf(g1 - G[0]) * wl[0];
            pd0[r] *= e00; pd1[r] *= e11; px[r] *= ex;
            if (dir == 0) { ds[0] += pd0[r]; ds[1] += pd1[r] + px[r]; } else { ds[0] += pd0[r] + px[r]; ds[1] += pd1[r]; }
        }
        ds[0] += bperm(ds[0], lane ^ 32); ds[1] += bperm(ds[1], lane ^ 32);
#pragma unroll
        for (int tb = 0; tb < 2; ++tb) { const float den = wi[tb] * qn[tb] + ds[tb]; const float di = __builtin_amdgcn_rcpf(fmaxf(fabsf(den), emt[tb])); if (hi == 0) dA[32 * tb + r32] = di; }
        bf16x8 a0, a1, b0, b1, c0, c1;
#define PK4(P, BASE, OUT) do { unsigned a0_ = cvt_pk_bf16(P[BASE + 0], P[BASE + 1]), a1_ = cvt_pk_bf16(P[BASE + 2], P[BASE + 3]);   \
    unsigned b0_ = cvt_pk_bf16(P[BASE + 4], P[BASE + 5]), b1_ = cvt_pk_bf16(P[BASE + 6], P[BASE + 7]);                              \
    auto r0_ = __builtin_amdgcn_permlane32_swap(a0_, b0_, false, false); auto r1_ = __builtin_amdgcn_permlane32_swap(a1_, b1_, false, false); \
    u32x4 w_ = {r0_[0], r1_[0], r0_[1], r1_[1]}; OUT = *reinterpret_cast<bf16x8*>(&w_); } while (0)
        PK4(pd0, 0, a0); PK4(pd0, 8, a1); PK4(pd1, 0, b0); PK4(pd1, 8, b1); PK4(px, 0, c0); PK4(px, 8, c1);
#undef PK4
        SBAR();
        f32x16 o[2][2] = {};
        {   bf16x8 v0, v1, v2, v3;
#define BLOCK(D0) do { frags4<D0>(vbV, v0, v1, v2, v3); \
            if (dir == 0) { MM(o[0][D0], a0, v0); MM(o[0][D0], a1, v1); MM(o[1][D0], c0, v0); MM(o[1][D0], c1, v1); MM(o[1][D0], b0, v2); MM(o[1][D0], b1, v3); } \
            else          { MM(o[0][D0], a0, v0); MM(o[0][D0], a1, v1); MM(o[0][D0], c0, v2); MM(o[0][D0], c1, v3); MM(o[1][D0], b0, v2); MM(o[1][D0], b1, v3); } \
            { const s16x4 l0 = att::tr_read<v_rd_off64(D0, 0, 0)>(vbC), h0 = att::tr_read<v_rd_off64(D0, 0, 1)>(vbC), l1 = att::tr_read<v_rd_off64(D0, 1, 0)>(vbC), h1 = att::tr_read<v_rd_off64(D0, 1, 1)>(vbC); \
              asm volatile("s_waitcnt lgkmcnt(0)" ::: "memory"); SBAR(); \
              const bf16x8 s0 = SCN_PK(l0, h0), s1 = SCN_PK(l1, h1); \
              MM(o[0][D0], qw[0][0], s0); MM(o[0][D0], qw[0][1], s1); MM(o[1][D0], qw[1][0], s0); MM(o[1][D0], qw[1][1], s1); } } while (0)
            BLOCK(0); BLOCK(1);
#undef BLOCK
        }
#undef MM
        asm volatile("s_waitcnt lgkmcnt(0)" ::: "memory");
        unsigned rob = (unsigned)(4 * hi * DP + r32) * 2u, mob = (unsigned)(4 * hi * D + r32) * 2u, hob = (unsigned)(4 * hi * 256 + r32) * 4u;
        asm volatile("" : "+v"(rob), "+v"(mob), "+v"(hob));
        float* hpk = (float*)(p.ws + OFF_HB2) + (size_t)(b * SL + 64 * tc) * 256 + h * 64;
        if (dir == 0) {
#pragma unroll
            for (int tb = 0; tb < 2; ++tb)
#pragma unroll
                for (int r = 0; r < 16; ++r) { const float di = dA[32 * tb + crow(r, hi)]; const unsigned ho = hob + (unsigned)(32 * tb + (r & 3) + 8 * (r >> 2)) * 1024u;
                    *(float*)((char*)hpk + ho) = o[tb][0][r] * di; *(float*)((char*)hpk + ho + 128u) = o[tb][1][r] * di; }
            asm volatile("s_waitcnt vmcnt(0)" ::: "memory");
        } else {
#pragma unroll
            for (int tb = 0; tb < 2; ++tb)
#pragma unroll
                for (int r = 0; r < 16; ++r) {
                    const unsigned tcst = (unsigned)(32 * tb + (r & 3) + 8 * (r >> 2)); const unsigned ho = hob + tcst * 1024u;
                    const float di = dA[32 * tb + crow(r, hi)];
                    const float x0 = o[tb][0][r] * di + ldg1(hpk, ho), x1 = o[tb][1][r] * di + ldg1(hpk, ho + 128u);
                    float t = x0 * x0 + x1 * x1; t += bperm(t, lane ^ 1); t += bperm(t, lane ^ 2); t += bperm(t, lane ^ 4); t += bperm(t, lane ^ 8); t += bperm(t, lane ^ 16);
                    const float ri = rsqrtf(t * (1.f / 64.f) + 1e-6f);
                    const bf16_t* gb = base + O_BO + h * 64; const unsigned go = rob + tcst * (DP * 2u);
                    const float g0 = ld1(gb, go), g1 = ld1(gb, go + 64u);
                    char* mb = (char*)((bf16_t*)(p.ws + OFF_MIXB) + (size_t)(b * SL + 64 * tc) * D + 256 + h * 64); const unsigned mo = mob + tcst * (D * 2u);
                    *(bf16_t*)(mb + mo) = (bf16_t)(cvt_pk_bf16(x0 * ri * p.mnorm[layer * 256 + h * 64 + r32] * fsig(g0), 0.f) & 0xffffu);
                    *(bf16_t*)(mb + mo + 64u) = (bf16_t)(cvt_pk_bf16(x1 * ri * p.mnorm[layer * 256 + h * 64 + 32 + r32] * fsig(g1), 0.f) & 0xffffu);
                    if ((r & 3) == 3) SBAR();
                }
        }
    }
}

DEV int scan_token(int dir, int step) { return dir == 0 ? step : (step < CTX ? CTX - 1 - step : SL + CTX - 1 - step); }
DEV float logsig(float g) { return fminf(g, 0.f) - log1pf(expf(-fabsf(g))); }
DEV void ph_scan_local(const Params& p, int layer, char* smem) {
    const int wid = p.wave_id;
    const int G = (int)gridDim.x, nw = G * 8, nun = (NT / 256) * (DP / 256), nleft = 4 * G < nun ? nun - 4 * G : 0, nfree = G - nleft > 0 ? G - nleft : G;
    for (int it = 0; it < 2; ++it) {
        int task;
        if (it == 0) task = (int)blockIdx.x * 8 + wid;
        else { if ((int)blockIdx.x >= nfree) break; task = nw + wid * nfree + (int)blockIdx.x; }
        if (task >= 2304) break;
        const int lane = lane_asm();
        if (task < 1152) scanA_local(p, layer, smem + wid * 16384, task / 36, task % 36, lane);
        else scanB_local(p, layer, smem + wid * 16384, (task - 1152) / 36, (task - 1152) % 36, lane);
    }
}
DEV void ph_scan_carry(const Params& p, char* smem) {
    const int tid = tid_of(p.wave_id);
    const int gt = (int)blockIdx.x * 512 + tid, nth = (int)gridDim.x * 512;
    for (int e = gt; e < 64 * 4096; e += nth) {
        const int chain = e >> 12, kv = e & 4095, k = kv >> 6;
        const float* U = (const float*)(p.ws + OFF_UA) + (size_t)chain * 36 * 4096 + kv; float* SO = (float*)(p.ws + OFF_SA) + (size_t)chain * 36 * 4096 + kv; const float* Dc = (const float*)(p.ws + OFF_DECA) + chain * 36 * 64 + k;
        float S = 0.f;
#pragma unroll 4
        for (int c = 0; c < 36; ++c) { const float u = U[(size_t)c * 4096], d = Dc[c * 64]; SO[(size_t)c * 4096] = S; S = d * S + u; }
    }
    for (int e = gt; e < 64 * 2048; e += nth) {
        const int chain = e >> 11, kv = e & 2047;
        const float* U = (const float*)(p.ws + OFF_UB) + (size_t)chain * 36 * 2048 + kv; float* SO = (float*)(p.ws + OFF_SB) + (size_t)chain * 36 * 2048 + kv; const float* M = (const float*)(p.ws + OFF_MB) + chain * 36 * 4;
        float Cc = 0.f, m = 0.f;
#pragma unroll 4
        for (int c = 0; c < 36; ++c) { const float mle = M[c * 4 + 0], ce = M[c * 4 + 1], u = U[(size_t)c * 2048]; SO[(size_t)c * 2048] = Cc;
            const float mn = fmaxf(ce + m, mle); Cc = expf(ce + m - mn) * Cc + expf(mle - mn) * u; m = mn; }
    }
    for (int e = gt; e < 64 * 32; e += nth) {
        const int chain = e >> 5, k = e & 31;
        const float* N = (const float*)(p.ws + OFF_NB) + chain * 36 * 32 + k; float* NO = (float*)(p.ws + OFF_N0) + chain * 36 * 32 + k; float* M = (float*)(p.ws + OFF_MB) + chain * 36 * 4;
        float nn = 0.f, m = 0.f;
        for (int c = 0; c < 36; ++c) { const float mle = M[c * 4 + 0], ce = M[c * 4 + 1], u = N[c * 32]; NO[c * 32] = nn; if (k == 0) M[c * 4 + 2] = m;
            const float mn = fmaxf(ce + m, mle); nn = expf(ce + m - mn) * nn + expf(mle - mn) * u; m = mn; }
    }
}
DEV void ph_scan_out(const Params& p, int layer, char* smem) {
    const int wid = p.wave_id;
    const int nw = (int)gridDim.x * 8, ntc = layer == 0 ? 36 : 32, tc0 = layer == 0 ? 0 : 4, half = 32 * ntc, total = 2 * half;
    for (int it = 0; it < 2 + (total - nw > 0 ? (total - nw) / (int)gridDim.x : 0); ++it) {
        int task;
        if (it == 0) task = (int)blockIdx.x * 8 + wid;
        else { if (wid != 0) break; task = nw + (it - 1) * (int)gridDim.x + (int)blockIdx.x; }
        if (task >= total) break;
        const int lane = lane_asm();
        const bool isB = task >= half; const int tt = isB ? task - half : task, bh = tt / ntc, tc = tc0 + tt % ntc;
        if (!isB) scanA_out(p, layer, smem + wid * 16384, bh, tc, lane);
        else scanB_out(p, layer, smem + wid * 16384, bh, tc, lane);
    }
}

DEV void ph_attn(const Params& p, int layer, char* smem) {
    const int wid = p.wave_id, js = wid & 1, qb = wid >> 1;
    const float lam = ((const float*)(p.ws + OFF_LAM))[layer], omli = 1.f - lam_init_of(layer);
    const bf16_t* KB = (const bf16_t*)(p.ws + OFF_KB); const bf16_t* VB = (const bf16_t*)(p.ws + OFF_VB);
    const bf16_t* QRB = (const bf16_t*)(p.ws + OFF_QRB); const bf16_t* Q0B = (const bf16_t*)(p.ws + OFF_Q0B);
    const int G = (int)gridDim.x, c = (int)blockIdx.x;
    const int nlat = 512, ntot = nlat + (layer == 0 ? 64 : 0);
    for (int i = 0;; ++i) {
        int bh, s0; bool isctx;
        if (G == 256) {
            const int xcd = c & 7, j = c >> 3;
            if (i < 2) { bh = xcd + 8 * (i * 2 + (j >> 4)); s0 = CTX + (j & 15) * 128; isctx = false; }
            else if (i == 2 && layer == 0 && j < 8) { bh = xcd + 8 * (j >> 1); s0 = (j & 1) * 128; isctx = true; }
            else break;
        } else {
            const int u = i * G + c; if (u >= ntot) break;
            if (u < nlat) { bh = u >> 4; s0 = CTX + (u & 15) * 128; isctx = false; } else { const int v = u - nlat; bh = v >> 1; s0 = (v & 1) * 128; isctx = true; }
        }
        const int lane = lane_asm(), tid = (wid << 6) | lane, r32 = lane & 31, hi = lane >> 5;
        const bf16_t* Kh = KB + (size_t)bh * SL * 128; const bf16_t* Vh = VB + (size_t)bh * SL * 128;
        const size_t qoff = ((size_t)bh * SL + s0 + qb * 32 + r32) * 128 + js * 64 + hi * 8;
        att::bf16x8 qr[4];
#pragma unroll
        for (int d0 = 0; d0 < 4; ++d0) qr[d0] = *(const att::bf16x8*)(Q0B + qoff + d0 * 16);
        float m_reg = -1e30f, l_reg = 0.f; att::f32x16 o[4] = {};
        att::attn_tiles(qr, Kh, Vh, CTX, smem, m_reg, l_reg, o, tid, js);
        if (!isctx) {
#pragma unroll
            for (int d0 = 0; d0 < 4; ++d0) qr[d0] = *(const att::bf16x8*)(QRB + qoff + d0 * 16);
            att::attn_tiles(qr, Kh + (size_t)CTX * 128, Vh + (size_t)CTX * 128, SEQ, smem, m_reg, l_reg, o, tid, js);
        }
        float* wsw = (float*)(smem + 2 * att::SHM_V + 2 * att::SHM_K) + wid * 64;
        __syncthreads();
        if (hi == 0) wsw[r32] = l_reg;
        asm volatile("s_waitcnt lgkmcnt(0)" ::: "memory");
        float rli[16];
#pragma unroll
        for (int r = 0; r < 16; ++r) rli[r] = __builtin_amdgcn_rcpf(wsw[att::crow(r, hi)]);
        float* X = (float*)smem + qb * 4096;
        if (js == 1) {
#pragma unroll
            for (int d0 = 0; d0 < 4; ++d0)
#pragma unroll
                for (int r = 0; r < 16; ++r) X[(d0 * 16 + r) * 64 + lane] = o[d0][r] * rli[r];
        }
        __syncthreads();
        if (js == 0) {
            const int b = bh >> 2, h = bh & 3;
            float ss[16];
#pragma unroll
            for (int r = 0; r < 16; ++r) ss[r] = 0.f;
#pragma unroll
            for (int d0 = 0; d0 < 4; ++d0)
#pragma unroll
                for (int r = 0; r < 16; ++r) { const float v = o[d0][r] * rli[r] - lam * X[(d0 * 16 + r) * 64 + lane]; o[d0][r] = v; ss[r] += v * v; }
#pragma unroll
            for (int r = 0; r < 16; ++r) { float t = ss[r]; t += __shfl_xor(t, 1); t += __shfl_xor(t, 2); t += __shfl_xor(t, 4); t += __shfl_xor(t, 8); t += __shfl_xor(t, 16);
                ss[r] = rsqrtf(t * (1.f / 128.f) + 1e-6f) * omli; }
            bf16_t* Tq = (bf16_t*)X;
#pragma unroll
            for (int d0 = 0; d0 < 4; ++d0) { const float g = p.dnorm[layer * 128 + d0 * 32 + r32];
#pragma unroll
                for (int r = 0; r < 16; ++r) Tq[att::crow(r, hi) * 128 + d0 * 32 + r32] = (bf16_t)(cvt_pk_bf16(o[d0][r] * ss[r] * g, 0.f) & 0xffffu); }
            char* mixb = (char*)((bf16_t*)(p.ws + OFF_MIXB) + (size_t)(b * SL + s0 + qb * 32) * D + 512 + h * 128);
#pragma unroll
            for (int k = 0; k < 8; ++k) { const int idx = lane + 64 * k, row = idx >> 4, ch = idx & 15;
                *(pg8::u32x4*)(mixb + (size_t)row * (D * 2) + ch * 16) = *(const pg8::u32x4*)((const char*)Tq + row * 256 + ch * 16); }
        }
        __syncthreads();
    }
}

struct EpiRowsBf16 {
    static constexpr bool PERM = true;
    bf16_t* O; int ldc;
    DEV void operator()(const pg8::f32x4 (&acc)[2][2][4][2], const pg8::Unit& u, int wr, int wc, int fr, int fq) const {
        const int row0 = u.pm * 256 + wr * 64 + fr, col0 = u.pn * 256 + wc * 32 + 8 * fq;
#pragma unroll
        for (int ai = 0; ai < 2; ++ai)
#pragma unroll
            for (int m = 0; m < 4; ++m) { bf16_t* rowp = O + (size_t)(row0 + ai * 128 + m * 16) * ldc + col0;
#pragma unroll
                for (int bj = 0; bj < 2; ++bj) { const pg8::f32x4 v0 = acc[ai][bj][m][0], v1 = acc[ai][bj][m][1];
                    pg8::u32x4 w; w.x = cvt_pk_bf16(v0[0], v0[1]); w.y = cvt_pk_bf16(v0[2], v0[3]); w.z = cvt_pk_bf16(v1[0], v1[1]); w.w = cvt_pk_bf16(v1[2], v1[3]);
                    *(pg8::u32x4*)(rowp + bj * 128) = w; } }
    }
};
DEV void ph_outproj(const Params& p, int layer, char* smem) {
    const int tidx = tid_of(p.wave_id);
    pg8::StaticOrder S; S.init(layer == 0 ? NT / 256 : NB * 8, D / 256, (int)gridDim.x, (int)blockIdx.x, layer == 0 ? 0 : 1, (const bf16_t*)(p.ws + OFF_WOUT) + (size_t)layer * D * D, D);
    EpiRowsBf16 E{(bf16_t*)(p.ws + OFF_MIXO), D};
    pg8::gemm_phase((LAS unsigned char*)smem, (const char*)(p.ws + OFF_MIXB), D, S, E, tid_of(p.wave_id));
}
DEV void ph_norm2(const Params& p, int layer, char* smem) {
    typedef float f32x16 __attribute__((ext_vector_type(16)));
    const int wid = p.wave_id, lane = lane_asm(), tidx = (wid << 6) | lane;
    constexpr int XP = 1028, RP = 24;
    float* xs = (float*)smem;
    float* red = (float*)smem;
    int* hist = (int*)(smem + 32 * XP * 4);
    int* offl = hist + 32;
    int* sel = hist + 64;
    const float* nr = p.norms + (size_t)layer * 4 * D;
    if (tidx < NE) hist[tidx] = 0;
    const int chunk = (NT + (int)gridDim.x - 1) / (int)gridDim.x, rbeg = (int)blockIdx.x * chunk, rend = min(NT, rbeg + chunk);
    for (int i = tidx; i < chunk * 4; i += 512) sel[i] = -1;
    float4 cA[4], cB[4], cC[4]; int ckey = -1;
    float wreg[64];
    { const float* wb = p.rw + (size_t)layer * D * NE + (size_t)(wid * 128 + (lane >> 5)) * NE + (lane & 31);
#pragma unroll
      for (int ks = 0; ks < 64; ++ks) wreg[ks] = wb[(size_t)2 * ks * NE]; }
    for (int r0 = rbeg; r0 < rend; r0 += RP) {
        __syncthreads();
#pragma unroll 1
        for (int j = 0; j < 3; ++j) {
            const int lr = wid * 3 + j, r = r0 + lr;
            if (r >= rend) continue;
            const int b = r / SL, s = r % SL;
            if (layer != 0 && s < CTX) continue;
            float4 mo[4], xv[4], o[4]; row_load_bf((const bf16_t*)(p.ws + OFF_MIXO) + (size_t)r * D, mo, lane); row_load_bf((const bf16_t*)(p.ws + OFF_X) + (size_t)r * D, xv, lane);
            { const int key = s < CTX ? 8 : b;
              if (key != ckey) { ckey = key; const float* m = modrow(p, layer, b, s);
#pragma unroll
                  for (int i = 0; i < 4; ++i) { const int idx = i * 256 + lane * 4; const float4 g = *(const float4*)(nr + D + idx), gt = *(const float4*)(m + 2048 + idx), gn = *(const float4*)(nr + 2 * D + idx), sh = *(const float4*)(m + 3072 + idx), sc = *(const float4*)(m + 4096 + idx);
                      cA[i] = make_float4(g.x * gt.x, g.y * gt.y, g.z * gt.z, g.w * gt.w); cB[i] = make_float4(gn.x * (1.f + sc.x), gn.y * (1.f + sc.y), gn.z * (1.f + sc.z), gn.w * (1.f + sc.w)); cC[i] = sh; } } }
            const float ri = row_rinv(mo);
#pragma unroll
            for (int i = 0; i < 4; ++i) { xv[i].x += cA[i].x * (mo[i].x * ri); xv[i].y += cA[i].y * (mo[i].y * ri); xv[i].z += cA[i].z * (mo[i].z * ri); xv[i].w += cA[i].w * (mo[i].w * ri); }
            row_store_bf16((bf16_t*)(p.ws + OFF_XN) + (size_t)r * D, xv, lane);
            { const float rn = row_rinv(xv);
#pragma unroll
              for (int i = 0; i < 4; ++i) o[i] = make_float4(xv[i].x * rn * cB[i].x + cC[i].x, xv[i].y * rn * cB[i].y + cC[i].y, xv[i].z * rn * cB[i].z + cC[i].z, xv[i].w * rn * cB[i].w + cC[i].w); }
            row_store_fp8((unsigned char*)(p.ws + OFF_XNB) + (size_t)r * D, o, lane, F8_SX);
            row_store(xs + lr * XP, o, lane);
        }
        __syncthreads();
        f32x16 acc = {};
        { const float* xa = xs + (lane & 31) * XP + wid * 128 + (lane >> 5);
#pragma unroll
          for (int ks = 0; ks < 64; ++ks) acc = __builtin_amdgcn_mfma_f32_32x32x2f32(xa[2 * ks], wreg[ks], acc, 0, 0, 0); }
        __syncthreads();
#pragma unroll
        for (int rg = 0; rg < 16; ++rg) red[(wid * 32 + (rg & 3) + 8 * (rg >> 2) + 4 * (lane >> 5)) * 32 + (lane & 31)] = acc[rg];
        __syncthreads();
#pragma unroll 1
        for (int j = 0; j < 3; ++j) {
            const int lr = wid * 3 + j, r = r0 + lr;
            if (r >= rend) continue;
            const int s = r % SL;
            if (layer != 0 && s < CTX) continue;
            const int e = lane & 31;
            float logit = p.rb[layer * NE + e];
#pragma unroll
            for (int w = 0; w < 8; ++w) logit += red[(w * 32 + lr) * 32 + e];
            float tv[4]; int ti[4];
#pragma unroll
            for (int k = 0; k < 4; ++k) {
                float bv = logit; int bi = e;
                for (int o2 = 16; o2 >= 1; o2 >>= 1) { const float ov = __shfl_xor(bv, o2); const int oi = __shfl_xor(bi, o2); if (ov > bv || (ov == bv && oi < bi)) { bv = ov; bi = oi; } }
                tv[k] = bv; ti[k] = bi; if (e == bi) logit = -3.0e38f;
            }
            const float e0 = 1.f, e1 = expf(tv[1] - tv[0]), e2 = expf(tv[2] - tv[0]), e3 = expf(tv[3] - tv[0]), inv = 1.f / (e0 + e1 + e2 + e3);
            if (lane == 0) { *(float4*)(((float*)(p.ws + OFF_TOPW)) + (size_t)r * 4) = make_float4(e0 * inv, e1 * inv, e2 * inv, e3 * inv); *(int4*)(((int*)(p.ws + OFF_TOPI)) + (size_t)r * 4) = make_int4(ti[0], ti[1], ti[2], ti[3]); }
            if (lane < 4) { const int es = lane == 0 ? ti[0] : lane == 1 ? ti[1] : lane == 2 ? ti[2] : ti[3]; atomicAdd(&hist[es], 1); sel[(r - rbeg) * 4 + lane] = es; }
        }
    }
    __syncthreads();
    if (tidx < NE) { const int h = hist[tidx]; offl[tidx] = h ? (int)__hip_atomic_fetch_add((unsigned*)(p.ws + OFF_bar) + CW_CNT + layer * NE + tidx, (unsigned)h, __ATOMIC_RELAXED, __HIP_MEMORY_SCOPE_AGENT) : 0; }
    __syncthreads();
    for (int i = tidx; i < (rend - rbeg) * 4; i += 512) { const int e = sel[i];
        if (e >= 0) { const int pos = atomicAdd(&offl[e], 1); ((int*)(p.ws + OFF_LIST))[(size_t)e * LISTCAP + pos] = rbeg * 4 + i; } }
}
DEV int moe_rt(int i, int G, int c, int npn, int& pn) {
    if (G == 256) { const int xcd = c & 7, j = c >> 3, rpx = 32 / npn; pn = j % npn; return (i * 8 + xcd) * rpx + j / npn; }
    const int L = i * G + c; pn = L % npn; return L / npn;
}
constexpr int MOE_LDS = 131072, MOE_MAXU = 12;
DEV void moe_prepare(const Params& p, int layer, char* smem, int npn, int mode) {
    const int tidx = tid_of(p.wave_id);
    LAS int* base = (LAS int*)(smem + MOE_LDS);
    LAS int *TE = base, *TT = base + 320, *NRT = base + 640, *CN = base + 656  , *UI = base + 704, *IDX = base + 768;
    if (tidx < NE) CN[tidx] = ((const int*)(p.ws + OFF_bar))[CW_CNT + layer * NE + tidx];
    __syncthreads();
    if (tidx < 320) { int e = 0, acc = 0; for (; e < NE; ++e) { const int n = (CN[e] + 255) >> 8; if (tidx < acc + n) break; acc += n; } TE[tidx] = e; TT[tidx] = tidx - acc; }
    if (tidx == 0) { int tot = 0; for (int e = 0; e < NE; ++e) tot += (CN[e] + 255) >> 8; NRT[0] = tot; }
    __syncthreads();
    const int nrt = NRT[0];
#pragma unroll
    for (int k = 0; k < (MOE_MAXU * 256) / 512; ++k) {
        const int idx = tidx + 512 * k, i = idx >> 8, row = idx & 255;
        int pn; const int rt = moe_rt(i, (int)gridDim.x, (int)blockIdx.x, npn, pn);
        if (rt < nrt) { const int e = TE[rt], t = TT[rt], c = CN[e], q = t * 256 + row;
            const int pair = ((const int*)(p.ws + OFF_LIST))[(size_t)e * LISTCAP + min(q, c - 1)];
            IDX[idx] = mode == 1 ? (pair >> 2) : (q < c ? pair : -1); }
    }
    if (tidx < MOE_MAXU) { int pn; const int rt = moe_rt(tidx, (int)gridDim.x, (int)blockIdx.x, npn, pn);
        if (rt < nrt) { const int e = TE[rt], t = TT[rt], c = CN[e]; int pre = 0; for (int z = 0; z < e; ++z) pre += CN[z]; UI[tidx * 4 + 0] = min(256, c - t * 256); UI[tidx * 4 + 1] = pre + t * 256; } }
    __syncthreads();
}
struct MoeOrder {
    const LAS int *te, *ui, *idx; int nrt, npn, G, c, gather; const char* Bt; size_t bstride; int K;
    DEV bool next(int i, pg8::Unit& u) const { int pn; const int rt = moe_rt(i, G, c, npn, pn); if (rt >= nrt || i >= MOE_MAXU) return false;
        u.pm = rt; u.pn = pn; u.e = __builtin_amdgcn_readfirstlane(te[rt]); u.t = i; return true; }
    DEV int arow(const pg8::Unit& u, int rr) const { return gather ? idx[u.t * 256 + rr] : ui[u.t * 4 + 1] + rr; }
    DEV const char* bbase(const pg8::Unit& u) const { return Bt + (size_t)u.e * bstride + (size_t)u.pn * pg8::BM * K * 2; }
};
DEV float swiglu(float g, float l) { g = fminf(g, 7.f); l = fminf(fmaxf(l, -7.f), 7.f); return g * __builtin_amdgcn_rcpf(1.f + __builtin_amdgcn_exp2f(-1.702f * 1.4426950408889634f * g)) * (l + 1.f); }
struct EpiSwiglu {
    static constexpr bool PERM = true;
    unsigned char* H; const float* b1; const LAS int* ui;
    DEV void operator()(const pg8::f32x4 (&acc)[2][2][4][2], const pg8::Unit& u, int wr, int wc, int fr, int fq) const {
        const int ucnt = ui[u.t * 4 + 0], hrow0 = ui[u.t * 4 + 1], col0 = u.pn * 256 + wc * 32 + 8 * fq;
        const float* bb = b1 + (size_t)u.e * 2048 + col0;
        pg8::f32x4 bv[2][2];
#pragma unroll
        for (int bj = 0; bj < 2; ++bj)
#pragma unroll
            for (int n = 0; n < 2; ++n) bv[bj][n] = *(const pg8::f32x4*)(bb + bj * 128 + 4 * n);
        __builtin_amdgcn_s_waitcnt(0x0F70);
#pragma unroll
        for (int ai = 0; ai < 2; ++ai)
#pragma unroll
            for (int m = 0; m < 4; ++m) { const int rr = ai * 128 + wr * 64 + m * 16 + fr;
                if (rr < ucnt) { unsigned char* rowp = H + (size_t)(hrow0 + rr) * DFF + (col0 >> 1);
#pragma unroll
                    for (int bj = 0; bj < 2; ++bj) { constexpr float DS = 1.f / (F8_SX * F8_SW); const pg8::f32x4 v0 = acc[ai][bj][m][0] * DS + bv[bj][0], v1 = acc[ai][bj][m][1] * DS + bv[bj][1];
                        *(unsigned*)(rowp + bj * 64) = pk4_fp8(F8_SH * swiglu(v0[0], v0[1]), F8_SH * swiglu(v0[2], v0[3]), F8_SH * swiglu(v1[0], v1[1]), F8_SH * swiglu(v1[2], v1[3])); } } }
    }
};
struct EpiY {
    static constexpr bool PERM = true;
    unsigned char* Y; const LAS int* idx; const float* b2;
    DEV void operator()(const pg8::f32x4 (&acc)[2][2][4][2], const pg8::Unit& u, int wr, int wc, int fr, int fq) const {
        const int col0 = u.pn * 256 + wc * 32 + 8 * fq;
        const float* bb = b2 + (size_t)u.e * D + col0;
        pg8::f32x4 bv[2][2];
#pragma unroll
        for (int bj = 0; bj < 2; ++bj)
#pragma unroll
            for (int n = 0; n < 2; ++n) bv[bj][n] = *(const pg8::f32x4*)(bb + bj * 128 + 4 * n);
        __builtin_amdgcn_s_waitcnt(0x0F70);
#pragma unroll
        for (int ai = 0; ai < 2; ++ai)
#pragma unroll
            for (int m = 0; m < 4; ++m) { const int rr = ai * 128 + wr * 64 + m * 16 + fr; const int pair = idx[u.t * 256 + rr];
                if (pair >= 0) { unsigned char* rowp = Y + (size_t)pair * D + col0;
#pragma unroll
                    for (int bj = 0; bj < 2; ++bj) { constexpr float DS = 1.f / (F8_SH * F8_SW); const pg8::f32x4 v0 = acc[ai][bj][m][0] * DS + bv[bj][0], v1 = acc[ai][bj][m][1] * DS + bv[bj][1];
                        pg8::u32x2 w; w.x = pk4_fp8(v0[0] * F8_SY, v0[1] * F8_SY, v0[2] * F8_SY, v0[3] * F8_SY); w.y = pk4_fp8(v1[0] * F8_SY, v1[1] * F8_SY, v1[2] * F8_SY, v1[3] * F8_SY);
                        *(pg8::u32x2*)(rowp + bj * 128) = w; } } }
    }
};
DEV void ph_moe1(const Params& p, int layer, char* smem) {
    moe_prepare(p, layer, smem, 8, 1);
    LAS int* base = (LAS int*)(smem + MOE_LDS);
    MoeOrder S{base, base + 704, base + 768, base[640], 8, (int)gridDim.x, (int)blockIdx.x, 1, (const char*)(p.ws + OFF_W1T) + (size_t)layer * NE * 2048 * D, (size_t)2048 * D, D / 2};
    EpiSwiglu E{(unsigned char*)(p.ws + OFF_H), p.b1 + (size_t)layer * NE * 2048, base + 704};
    pg8::gemm_phase<EpiSwiglu, MoeOrder, true>((LAS unsigned char*)smem, (const char*)(p.ws + OFF_XNB), D / 2, S, E, tid_of(p.wave_id));
}
DEV void ph_moe2(const Params& p, int layer, char* smem) {
    moe_prepare(p, layer, smem, 4, 2);
    LAS int* base = (LAS int*)(smem + MOE_LDS);
    MoeOrder S{base, base + 704, base + 768, base[640], 4, (int)gridDim.x, (int)blockIdx.x, 0, (const char*)(p.ws + OFF_W2T) + (size_t)layer * NE * D * DFF, (size_t)D * DFF, DFF / 2};
    EpiY E{(unsigned char*)(p.ws + OFF_Y), base + 768, p.b2 + (size_t)layer * NE * D};
    pg8::gemm_phase<EpiY, MoeOrder, true>((LAS unsigned char*)smem, (const char*)(p.ws + OFF_H), DFF / 2, S, E, tid_of(p.wave_id));
}
DEV void ph_combine(const Params& p, int layer, char* smem) {
    const int wid = p.wave_id, lane = lane_asm();
    const float* nr = p.norms + (size_t)layer * 4 * D;
    const int total = layer == 0 ? NT : NB * SEQ, G = (int)gridDim.x, chunk = (total + G - 1) / G, qbeg = (int)blockIdx.x * chunk, qend = min(total, qbeg + chunk);
    float4 cA[4], cB[4], cC[4]; int ckey = -1;
    for (int q0 = qbeg + wid; q0 < qend; q0 += 16) {
        int rr[2]; bool ok[2]; float4 tw[2];
#pragma unroll
        for (int u = 0; u < 2; ++u) { const int q = q0 + u * 8; ok[u] = q < qend; const int qq = ok[u] ? q : q0;
            rr[u] = layer == 0 ? qq : (qq / SEQ) * SL + CTX + qq % SEQ;
            tw[u] = *(const float4*)(((float*)(p.ws + OFF_TOPW)) + (size_t)rr[u] * 4); }
        float4 f[2][4], xv[2][4];
#pragma unroll
        for (int u = 0; u < 2; ++u) {
            const int r = rr[u];
            const float w[4] = {tw[u].x * (1.f / F8_SY), tw[u].y * (1.f / F8_SY), tw[u].z * (1.f / F8_SY), tw[u].w * (1.f / F8_SY)};
#pragma unroll
            for (int i = 0; i < 4; ++i) f[u][i] = make_float4(0.f, 0.f, 0.f, 0.f);
#pragma unroll
            for (int k = 0; k < 4; ++k) {
                const unsigned char* y = (const unsigned char*)(p.ws + OFF_Y) + ((size_t)r * 4 + k) * D;
#pragma unroll
                for (int i = 0; i < 4; ++i) { const int idx = i * 256 + lane * 4; const int yb = *(const int*)(y + idx);
                    const auto lo = __builtin_amdgcn_cvt_pk_f32_fp8(yb, false), hi2 = __builtin_amdgcn_cvt_pk_f32_fp8(yb, true);
                    f[u][i].x += w[k] * lo[0]; f[u][i].y += w[k] * lo[1]; f[u][i].z += w[k] * hi2[0]; f[u][i].w += w[k] * hi2[1]; }
            }
            row_load_bf((const bf16_t*)(p.ws + OFF_XN) + (size_t)r * D, xv[u], lane);
        }
#pragma unroll
        for (int u = 0; u < 2; ++u) {
            const int r = rr[u], b = r / SL, s = r % SL;
            { const int key = s < CTX ? 8 : b;
              if (key != ckey) { ckey = key; const float* m = modrow(p, layer, b, s); const float* m1 = modrow(p, 1, b, s);
#pragma unroll
                  for (int i = 0; i < 4; ++i) { const int idx = i * 256 + lane * 4; const float4 g = *(const float4*)(nr + 3 * D + idx), gt = *(const float4*)(m + 5120 + idx);
                      cA[i] = make_float4(g.x * gt.x, g.y * gt.y, g.z * gt.z, g.w * gt.w);
                      if (layer == 0) { const float4 gn = *(const float4*)(p.norms + (size_t)4 * D + idx), sh = *(const float4*)(m1 + idx), sc = *(const float4*)(m1 + 1024 + idx);
                          cB[i] = make_float4(gn.x * (1.f + sc.x), gn.y * (1.f + sc.y), gn.z * (1.f + sc.z), gn.w * (1.f + sc.w)); cC[i] = sh; } } } }
            const float ri = row_rinv(f[u]);
#pragma unroll
            for (int i = 0; i < 4; ++i) { xv[u][i].x += cA[i].x * (f[u][i].x * ri); xv[u][i].y += cA[i].y * (f[u][i].y * ri); xv[u][i].z += cA[i].z * (f[u][i].z * ri); xv[u][i].w += cA[i].w * (f[u][i].w * ri); }
            if (ok[u]) {
                if (layer == 0) {
                    row_store_bf16((bf16_t*)(p.ws + OFF_X) + (size_t)r * D, xv[u], lane);
                    float4 o[4]; const float rn = row_rinv(xv[u]);
#pragma unroll
                    for (int i = 0; i < 4; ++i) o[i] = make_float4(xv[u][i].x * rn * cB[i].x + cC[i].x, xv[u][i].y * rn * cB[i].y + cC[i].y, xv[u][i].z * rn * cB[i].z + cC[i].z, xv[u][i].w * rn * cB[i].w + cC[i].w);
                    row_store_bf16((bf16_t*)(p.ws + OFF_XNB) + (size_t)r * D, o, lane);
                } else {
                    row_store(p.out + ((size_t)b * SEQ + (s - CTX)) * D, xv[u], lane);
                }
            }
        }
    }
}

template <int layer> DEV void run_layer(const Params& p, char* smem, const XcdBarrier& bar) {
#define GB() xcd_barrier(bar)

        ph_inproj(p, layer, smem, 0); GB();
        ph_inproj(p, layer, smem, 1); ph_scan_local(p, layer, smem); GB();
        ph_scan_carry(p, smem); ph_attn(p, layer, smem); GB();
        ph_scan_out(p, layer, smem); GB();
        ph_outproj(p, layer, smem); GB();
        ph_norm2(p, layer, smem); GB();
        ph_moe1(p, layer, smem); GB();
        ph_moe2(p, layer, smem); GB();
        ph_combine(p, layer, smem); GB();
    #undef GB
}
constexpr int LDS_BYTES = 147456;
__global__ __launch_bounds__(512, 2) void k_mega(Params p_in) {
    Params p = p_in; p.wave_id = __builtin_amdgcn_readfirstlane((int)(threadIdx.x >> 6));
    extern __shared__ __attribute__((aligned(16))) char smem[];
    volatile LAS unsigned* st = (volatile LAS unsigned*)(smem + LDS_BYTES - 16);
    if (threadIdx.x == 0) { st[0] = 0u; st[1] = 0u; st[2] = 0u; st[3] = 0u; }
    __syncthreads();
    const XcdBarrier bar = xcd_barrier_post(((unsigned*)(p.ws + OFF_bar)), st, p.wave_id);
#define GB() xcd_barrier(bar)
    ph_mods(p, smem); ph_convert(p, smem); GB();
    ph_init(p, smem); GB();
    run_layer<0>(p, smem, bar);
    run_layer<1>(p, smem, bar);
#undef GB
}
}

extern "C" void kernel_launch(void* const* d_in, const int* in_sizes, int n_in, void* d_out, int out_size, void* d_ws, size_t ws_size, hipStream_t stream) {
    static int grid = 0;
    if (grid == 0) {
        int dev = 0, cus = 0, per_cu = 0;
        if (hipGetDevice(&dev) != hipSuccess || hipDeviceGetAttribute(&cus, hipDeviceAttributeMultiprocessorCount, dev) != hipSuccess) { grid = -1; return; }
        if (hipFuncSetAttribute((const void*)k_mega, hipFuncAttributeMaxDynamicSharedMemorySize, LDS_BYTES) != hipSuccess) { grid = -1; return; }
        (void)hipOccupancyMaxActiveBlocksPerMultiprocessor(&per_cu, (const void*)k_mega, 512, LDS_BYTES);
        (void)hipGetLastError();
        grid = cus;
    }
    if (grid < 0) return;
    Params p{};
    const float** in = (const float**)&p;
    for (int i = 0; i < 21; ++i) in[i] = (const float*)d_in[i];
    p.out = (float*)d_out;
    p.ws = (char*)d_ws;
    if (WS_END > ws_size) return;
    if (hipMemsetAsync(p.ws + OFF_bar, 0, (size_t)CTL_BYTES, stream) != hipSuccess) return;
    hipLaunchKernelGGL(k_mega, dim3(grid), dim3(512), LDS_BYTES, stream, p);
}
```

```cpp
#include <hip/hip_runtime.h>
#include <stdint.h>

namespace {
constexpr int D = 1024, NB = 8, SEQ = 2048, CTX = 256, SL = 2304, NT = NB * SL;
constexpr int DP = 3840, DPW = 3600, NE = 32, DFF = 1024, NPAIR = NT * 4;
constexpr int O_AQ = 0, O_AI = 256, O_AFF = 512, O_AFB = 768, O_AG = 1024, O_BQ = 1280, O_BK = 1408, O_BV = 1536, O_BO = 1792, O_BG = 3584;
constexpr int LISTCAP = NT;

struct Params {
    const float *x, *c, *ctx, *c_ctx, *ada_w, *ada_b, *norms, *w_in, *w_out, *hlb, *hnorm, *mgb, *mnorm, *dlam, *dnorm, *rw, *rb, *w1, *b1, *w2, *b2;
    float* out;
    char* ws;
    int wave_id, pad_;
};
constexpr size_t al256(size_t x) { return (x + 255) & ~(size_t)255; }
constexpr size_t OFF_bar = 0;
constexpr size_t OFF_MOD = OFF_bar + 16384;
constexpr int CW_QHEAD = 3520, CW_CNT = 3584  , CTL_BYTES = 16384;
constexpr size_t OFF_LB = OFF_MOD + al256((size_t)2 * 9 * 6144 * 4);
constexpr size_t OFF_LAM = OFF_LB + al256(1024 * 4);
constexpr size_t OFF_CNT = OFF_LAM + 256;
constexpr size_t OFF_BC = OFF_CNT + 256;
constexpr size_t OFF_TOPW = OFF_BC + al256((size_t)1024 * NE * 4);
constexpr size_t OFF_TOPI = OFF_TOPW + al256((size_t)NPAIR * 4);
constexpr size_t OFF_LIST = OFF_TOPI + al256((size_t)NPAIR * 4);
constexpr size_t OFF_X = OFF_LIST + al256((size_t)NE * LISTCAP * 4);
constexpr size_t OFF_XN = OFF_X + al256((size_t)NT * D * 4);
constexpr size_t OFF_P = OFF_XN + al256((size_t)NT * D * 4);
constexpr size_t OFF_QR = OFF_P + al256((size_t)NT * DP * 4);
constexpr size_t OFF_KT = OFF_QR + al256((size_t)64 * SL * 64 * 4);
constexpr size_t OFF_OC = OFF_KT + al256((size_t)64 * SL * 64 * 4);
constexpr size_t OFF_MIX = OFF_OC + al256((size_t)32 * SL * 128 * 4);
constexpr size_t OFF_MIXO = OFF_MIX + al256((size_t)NT * D * 4);
constexpr size_t OFF_XNB = OFF_MIXO + al256((size_t)NT * D * 4);
constexpr size_t OFF_MIXB = OFF_XNB + al256((size_t)NT * D * 2);
constexpr size_t OFF_WIN = OFF_MIXB + al256((size_t)NT * D * 2);
constexpr size_t OFF_WOUT = OFF_WIN + al256((size_t)2 * DP * D * 2);
constexpr size_t OFF_W1T = OFF_WOUT + al256((size_t)2 * D * D * 2);
constexpr size_t OFF_W2T = OFF_W1T + al256((size_t)2 * NE * 2048 * D * 2);
constexpr size_t OFF_U = OFF_W2T + al256((size_t)2 * NE * D * DFF * 2);
constexpr size_t WS_END = OFF_U + al256((size_t)32 * SL * SL * 4);
constexpr size_t OFF_UA = OFF_U, OFF_DECA = OFF_UA + (size_t)64 * 36 * 4096 * 4, OFF_UB = OFF_DECA + (size_t)64 * 36 * 64 * 4, OFF_NB = OFF_UB + (size_t)64 * 36 * 2048 * 4,
                 OFF_MB = OFF_NB + (size_t)64 * 36 * 32 * 4, OFF_SCB = OFF_MB + (size_t)64 * 36 * 4 * 4,
                 OFF_OA2 = OFF_SCB + (size_t)2 * NT * 16 * 4, OFF_HB2 = OFF_OA2 + (size_t)NT * 256 * 4, OFF_SA = OFF_HB2 + (size_t)NT * 256 * 4, OFF_SB = OFF_SA + (size_t)64 * 36 * 4096 * 4,
                 OFF_N0 = OFF_SB + (size_t)64 * 36 * 2048 * 4;
constexpr size_t OFF_PB = OFF_P;
constexpr size_t OFF_ROPE = OFF_P + al256((size_t)NT * DP * 2);
constexpr size_t OFF_QRB = OFF_QR, OFF_Q0B = OFF_QR + (size_t)32 * SL * 128 * 2, OFF_KB = OFF_KT, OFF_VB = OFF_KT + (size_t)32 * SL * 128 * 2;
constexpr size_t OFF_S = OFF_U, OFF_H = OFF_U, OFF_Y = OFF_U + al256((size_t)(NPAIR + 256) * DFF * 2);
constexpr size_t OFF_OA = OFF_MIXO, OFF_HB = OFF_MIXO + (size_t)2 * NT * 256 * 4;


#define DEV __device__ __forceinline__
DEV int lane_asm() { int l; asm volatile("v_mbcnt_lo_u32_b32 %0, -1, 0\n\tv_mbcnt_hi_u32_b32 %0, -1, %0" : "=v"(l)); return l; }
DEV int tid_of(int wave_id) { return (wave_id << 6) | lane_asm(); }
DEV float wsum(float v) { for (int o = 32; o >= 1; o >>= 1) v += __shfl_xor(v, o); return v; }
DEV float wmaxf(float v) { for (int o = 32; o >= 1; o >>= 1) v = fmaxf(v, __shfl_xor(v, o)); return v; }
DEV float sigm(float x) { return 1.f / (1.f + expf(-x)); }
DEV float rdlane(float v, int l) { return __int_as_float(__builtin_amdgcn_readlane(__float_as_int(v), l)); }
DEV float lam_init_of(int layer) { return 0.8f - 0.6f * expf(-0.3f * (float)layer); }


#define XB_TMO      128
#define XB_XCNT(j)  (256  + 64 * (j))
#define XB_XSUB(j)  (1280 + 64 * (j))
#define XB_XGEN(j)  (2304 + 64 * (j))
#define XB_TOP      3328
#define XB_TOPGEN   3392
#define XCD_BAR_WORDS 3456
#define XB_SPIN_CAP (1u << 22)
#define LAS __attribute__((address_space(3)))
DEV unsigned xb_ld(unsigned* p)              { return __hip_atomic_load(p, __ATOMIC_RELAXED, __HIP_MEMORY_SCOPE_AGENT); }
DEV unsigned xb_add(unsigned* p, unsigned v) { return __hip_atomic_fetch_add(p, v, __ATOMIC_RELAXED, __HIP_MEMORY_SCOPE_AGENT); }
DEV unsigned xb_xcc_id() { return (unsigned)__builtin_amdgcn_s_getreg((3 << 11) | 20) & 0xFu; }
#define XB_SPIN(cond, bar) do { unsigned _sp = 0; while (cond) { __builtin_amdgcn_s_sleep(1); \
    if ((++_sp & 255u) == 0u) { if (xb_ld(&(bar)[XB_TMO])) break; if (_sp > XB_SPIN_CAP) { atomicAdd(&(bar)[XB_TMO], 1u); break; } } } } while (0)
struct XcdBarrier { unsigned* bar; unsigned x; volatile LAS unsigned* st; int wave; };
DEV bool xb_thread0(int wave) { return wave == 0 && lane_asm() == 0; }
DEV XcdBarrier xcd_barrier_post(unsigned* bar, volatile LAS unsigned* st, int wave) {
    XcdBarrier b; b.bar = bar; b.x = xb_xcc_id(); b.st = st; b.wave = wave;
    if (xb_thread0(wave)) (void)xb_add(&bar[XB_XCNT(b.x)], 1u);
    return b;
}
DEV void xcd_barrier_complete(unsigned* bar, unsigned x, unsigned& nloc, unsigned& nx) {
    const unsigned G = gridDim.x * gridDim.y * gridDim.z;
    unsigned sum, cnt, mine, sp = 0u;
    for (;;) {
        sum = 0u; cnt = 0u; mine = 0u;
#pragma unroll
        for (unsigned j = 0; j < 16; ++j) { const unsigned c = xb_ld(&bar[XB_XCNT(j)]); sum += c; cnt += (c > 0u) ? 1u : 0u; mine = (j == x) ? c : mine; }
        if (sum == G) break;
        __builtin_amdgcn_s_sleep(1);
        if ((++sp & 255u) == 0u) { if (xb_ld(&bar[XB_TMO])) break; if (sp > XB_SPIN_CAP) { atomicAdd(&bar[XB_TMO], 1u); break; } }
    }
    nloc = mine > 0u ? mine : 1u; nx = cnt > 0u ? cnt : 1u;
}
DEV void xcd_barrier(const XcdBarrier& b) {
    asm volatile("s_waitcnt vmcnt(0)" ::: "memory");
    __syncthreads();
    if (xb_thread0(b.wave)) {
        unsigned* bar = b.bar;
        __builtin_amdgcn_s_waitcnt(0);
        unsigned nloc = b.st[0], nx = b.st[1];
        if (nloc == 0u) { xcd_barrier_complete(bar, b.x, nloc, nx); b.st[0] = nloc; b.st[1] = nx; }
        const unsigned old = xb_add(&bar[XB_XSUB(b.x)], 1u);
        const unsigned gen = old / nloc;
        if (old + 1u == (gen + 1u) * nloc) {
            __builtin_amdgcn_fence(__ATOMIC_RELEASE, "agent");
            asm volatile("s_waitcnt vmcnt(0)" ::: "memory");
            const unsigned og = xb_add(&bar[XB_TOP], 1u);
            const unsigned tg = og / nx;
            if (og + 1u == (tg + 1u) * nx) xb_add(&bar[XB_TOPGEN], 1u);
            else XB_SPIN(xb_ld(&bar[XB_TOPGEN]) == tg, bar);
            __builtin_amdgcn_fence(__ATOMIC_ACQUIRE, "agent");
            xb_add(&bar[XB_XGEN(b.x)], 1u);
            asm volatile("s_waitcnt vmcnt(0)" ::: "memory");
        } else {
            XB_SPIN(xb_ld(&bar[XB_XGEN(b.x)]) == gen, bar);
            __builtin_amdgcn_fence(__ATOMIC_ACQUIRE, "agent");
            asm volatile("s_waitcnt vmcnt(0)" ::: "memory");
        }
    }
    __syncthreads();
}

typedef unsigned short bf16_t;
DEV unsigned cvt_pk_bf16(float lo, float hi) { unsigned r; asm volatile("v_cvt_pk_bf16_f32 %0, %1, %2" : "=v"(r) : "v"(lo), "v"(hi)); return r; }

namespace pg8 {
typedef short bf16x8 __attribute__((ext_vector_type(8)));
typedef float f32x4 __attribute__((ext_vector_type(4)));
typedef unsigned u32x4 __attribute__((ext_vector_type(4)));
typedef unsigned u32x2 __attribute__((ext_vector_type(2)));
constexpr int BM = 256, BK = 64, HALF = 128, HTB = HALF * BK * 2, STAGE_BYTES = 8 * HTB, NXCD = 8, WGM = 8;
DEV int lds_byte(int r, int c) { const int st = (r >> 4) * 2 + (c >> 5), rr = r & 15, cc = c & 31, ob = rr * 64 + cc * 2; return st * 1024 + (ob ^ (((ob >> 9) & 1) << 5)); }
DEV void stage_rc(int b, int& R, int& C) { const int st = b / 1024, sb = b % 1024, swz = sb ^ (((sb >> 9) & 1) << 5); R = (st >> 1) * 16 + swz / 64; C = (st & 1) * 32 + (swz % 64) / 2; }
DEV int perm32(int rho) { const int n = rho >> 4, i = rho & 15; return 8 * (i >> 2) + 4 * n + (i & 3); }
struct Unit { int pm, pn, e, t; };
struct StaticOrder {
    int nM, nN, nwg, G, c, skipctx; const char* Bt; int K;
    DEV void init(int nM_, int nN_, int G_, int c_, int skipctx_, const void* Bt_, int K_) { nM = nM_; nN = nN_; nwg = nM * nN; G = G_; c = c_; skipctx = skipctx_; Bt = (const char*)Bt_; K = K_; }
    DEV bool next(int i, Unit& u) const {
        const long L = (long)i * G + c; if (L >= nwg) return false;
        int wgid = (int)L; { const int q = nwg / NXCD, r = nwg % NXCD, xcd = wgid % NXCD, off = wgid / NXCD; wgid = (xcd < r ? xcd * (q + 1) : r * (q + 1) + (xcd - r) * q) + off; }
        const int nig = WGM * nN, gid = wgid / nig, fm = gid * WGM, gsz = (nM - fm) < WGM ? (nM - fm) : WGM;
        int pm = fm + ((wgid % nig) % gsz); u.pn = (wgid % nig) / gsz;
        if (skipctx) pm = (pm >> 3) * 9 + 1 + (pm & 7);
        u.pm = pm; u.e = 0; u.t = 0; return true;
    }
    DEV int arow(const Unit& u, int rr) const { return u.pm * BM + rr; }
    DEV const char* bbase(const Unit& u) const { return Bt + (size_t)u.pn * BM * K * 2; }
};
struct EpiF32 {
    static constexpr bool PERM = false;
    float* C; int ldc;
    DEV void operator()(const f32x4 (&acc)[2][2][4][2], const Unit& u, int wr, int wc, int fr, int fq) const {
        const int row0 = u.pm * BM + wr * 64 + fr, col0 = u.pn * BM + wc * 32 + 4 * fq;
#pragma unroll
        for (int ai = 0; ai < 2; ++ai)
#pragma unroll
            for (int m = 0; m < 4; ++m) { float* rowp = C + (size_t)(row0 + ai * HALF + m * 16) * ldc + col0;
#pragma unroll
                for (int bj = 0; bj < 2; ++bj)
#pragma unroll
                    for (int n = 0; n < 2; ++n) *(f32x4*)(rowp + bj * HALF + n * 16) = acc[ai][bj][m][n]; }
    }
};

typedef int i32x4 __attribute__((ext_vector_type(4)));
typedef int i32x8 __attribute__((ext_vector_type(8)));
DEV i32x8 cat8(bf16x8 a, bf16x8 b) { const i32x4 x = __builtin_bit_cast(i32x4, a), y = __builtin_bit_cast(i32x4, b); return __builtin_shufflevector(x, y, 0, 1, 2, 3, 4, 5, 6, 7); }
template <class Epi, class Sched, bool F8 = false>
DEV void gemm_phase(LAS unsigned char* lds, const char* Abase, const int K, const Sched& S, const Epi& E, const int tid) {
    const int wid = __builtin_amdgcn_readfirstlane(tid >> 6), lane = tid & 63, wr = wid >> 2, wc = wid & 3, fr = lane & 15, fq = lane >> 4;
    const int nt = K / BK;
    unsigned voffB[2];
#pragma unroll
    for (int i = 0; i < 2; ++i) { int R, C; stage_rc(tid * 16 + i * 8192, R, C); const int Rb = Epi::PERM ? ((R & ~31) + perm32(R & 31)) : R;
        voffB[i] = (unsigned)(Rb * BK + C) * 2u; }
    const size_t kstep = (size_t)(BK * 2);
    const size_t hstep = (size_t)HALF * K * 2;
    constexpr size_t kstepB = (size_t)BM * BK * 2, hstepB = (size_t)HALF * BK * 2;
    const unsigned ldsw = (unsigned)wid * 1024u;
    const int aoff = lds_byte(wr * 64 + fr, fq * 8), boff = lds_byte(wc * 32 + fr, fq * 8);
#define PG8_SA(b, h) (((b) * 2 + (h)) * HTB)
#define PG8_SB(b, h) ((4 + (b) * 2 + (h)) * HTB)
#define PG8_STAGE_B(bufoff, gbase) do { _Pragma("unroll") for (int _i = 0; _i < 2; ++_i) \
        __builtin_amdgcn_global_load_lds((const unsigned*)((const char*)(gbase) + voffB[_i]), (LAS unsigned*)(lds + (bufoff) + ldsw + _i * 8192), 16, 0, 0); } while (0)
#define PG8_STAGE_A(bufoff, kb, V, h) do { _Pragma("unroll") for (int _i = 0; _i < 2; ++_i) \
        __builtin_amdgcn_global_load_lds((const unsigned*)(Abase + (kb) + (V)[h][_i]), (LAS unsigned*)(lds + (bufoff) + ldsw + _i * 8192), 16, 0, 0); } while (0)
#define PG8_VOFFA(V, u) do { _Pragma("unroll") for (int _i = 0; _i < 2; ++_i) { int _R, _C; stage_rc(tid * 16 + _i * 8192, _R, _C); _Pragma("unroll") for (int _h = 0; _h < 2; ++_h) \
        (V)[_h][_i] = ((unsigned)S.arow(u, _h * HALF + _R) * (unsigned)K + (unsigned)_C) * 2u; } } while (0)
#define PG8_LDA(dst, b, h) do { _Pragma("unroll") for (int m = 0; m < 4; ++m) _Pragma("unroll") for (int k = 0; k < 2; ++k) dst[m][k] = *(const LAS bf16x8*)(lds + PG8_SA(b, h) + aoff + m * 2048 + k * 1024); } while (0)
#define PG8_LDB(dst, b, h) do { _Pragma("unroll") for (int n = 0; n < 2; ++n) _Pragma("unroll") for (int k = 0; k < 2; ++k) dst[n][k] = *(const LAS bf16x8*)(lds + PG8_SB(b, h) + boff + n * 2048 + k * 1024); } while (0)
#define PG8_MMA(ai, bj, At, Bt) do { __builtin_amdgcn_s_setprio(1); _Pragma("unroll") for (int m = 0; m < 4; ++m) _Pragma("unroll") for (int n = 0; n < 2; ++n) { \
        if constexpr (F8) asm volatile("v_mfma_f32_16x16x128_f8f6f4 %0, %1, %2, %0" : "+v"(acc[ai][bj][m][n]) : "v"(cat8(Bt[n][0], Bt[n][1])), "v"(cat8(At[m][0], At[m][1]))); \
        else { _Pragma("unroll") for (int k = 0; k < 2; ++k) acc[ai][bj][m][n] = __builtin_amdgcn_mfma_f32_16x16x32_bf16(Bt[n][k], At[m][k], acc[ai][bj][m][n], 0, 0, 0); } } __builtin_amdgcn_s_setprio(0); } while (0)
#define PG8_WAIT_V(n) asm volatile("s_waitcnt vmcnt(" #n ")" ::: "memory")
#define PG8_WAIT_L(n) asm volatile("s_waitcnt lgkmcnt(" #n ")" ::: "memory")
#define PG8_BAR __builtin_amdgcn_s_barrier()
#define PG8_SCHED __builtin_amdgcn_sched_barrier(0)
    Unit cur, nxt; int ui = 0;
    if (!S.next(0, cur)) return;
    f32x4 acc[2][2][4][2];
#pragma unroll
    for (int a = 0; a < 2; ++a)
#pragma unroll
        for (int b = 0; b < 2; ++b)
#pragma unroll
            for (int m = 0; m < 4; ++m)
#pragma unroll
                for (int n = 0; n < 2; ++n) acc[a][b][m][n] = (f32x4){0.f, 0.f, 0.f, 0.f};
    bf16x8 At[4][2], B0[2][2], B1[2][2];
    unsigned vc[2][2], v2[2][2];
    PG8_VOFFA(vc, cur);
    const char* cB = S.bbase(cur);
    PG8_STAGE_B(PG8_SB(0, 0), cB); PG8_STAGE_A(PG8_SA(0, 0), 0, vc, 0); PG8_STAGE_B(PG8_SB(0, 1), cB + hstepB); PG8_STAGE_A(PG8_SA(0, 1), 0, vc, 1);
    if (wr == 1) PG8_BAR;
    PG8_WAIT_V(4); PG8_BAR;
    PG8_STAGE_B(PG8_SB(1, 0), cB + kstepB); PG8_STAGE_A(PG8_SA(1, 0), kstep, vc, 0); PG8_STAGE_B(PG8_SB(1, 1), cB + hstepB + kstepB);
    PG8_WAIT_V(6); PG8_BAR;
    for (;;) {
        const bool has_next = S.next(ui + 1, nxt);
        const char* nB = has_next ? S.bbase(nxt) : cB;
        for (int t = 0; t < nt; t += 2) {
            const bool last = (t == nt - 2);
            const size_t k1 = (size_t)(t + 1) * kstep, k2 = last ? (size_t)0 : (size_t)(t + 2) * kstep, k3 = k2 + kstep;
            if (last && has_next) { PG8_VOFFA(v2, nxt); } else {
#pragma unroll
                for (int h = 0; h < 2; ++h)
#pragma unroll
                    for (int i = 0; i < 2; ++i) v2[h][i] = vc[h][i]; }
            const char* b2 = last ? nB : cB + (size_t)(t + 2) * kstepB; const char* b3 = b2 + kstepB;
            PG8_LDB(B0, 0, 0); PG8_SCHED; PG8_LDA(At, 0, 0); PG8_STAGE_A(PG8_SA(1, 1), k1, vc, 1);
            PG8_WAIT_L(8); PG8_BAR; PG8_WAIT_L(0); PG8_MMA(0, 0, At, B0); PG8_BAR; PG8_SCHED;
            PG8_LDB(B1, 0, 1); PG8_STAGE_B(PG8_SB(0, 0), b2);
            PG8_BAR; PG8_WAIT_L(0); PG8_MMA(0, 1, At, B1); PG8_BAR;
            PG8_LDA(At, 0, 1); PG8_STAGE_A(PG8_SA(0, 0), k2, v2, 0);
            PG8_BAR; PG8_WAIT_L(0); PG8_MMA(1, 0, At, B0); PG8_BAR; PG8_SCHED;
            PG8_STAGE_B(PG8_SB(0, 1), b2 + hstepB);
            PG8_WAIT_V(6); PG8_BAR; PG8_MMA(1, 1, At, B1); PG8_BAR;
            PG8_LDB(B0, 1, 0); PG8_SCHED; PG8_LDA(At, 1, 0); PG8_STAGE_A(PG8_SA(0, 1), k2, v2, 1);
            PG8_WAIT_L(8); PG8_BAR; PG8_WAIT_L(0); PG8_MMA(0, 0, At, B0); PG8_BAR; PG8_SCHED;
            PG8_LDB(B1, 1, 1); PG8_STAGE_B(PG8_SB(1, 0), b3);
            PG8_BAR; PG8_WAIT_L(0); PG8_MMA(0, 1, At, B1); PG8_BAR;
            PG8_LDA(At, 1, 1); PG8_STAGE_A(PG8_SA(1, 0), k3, v2, 0);
            PG8_BAR; PG8_WAIT_L(0); PG8_MMA(1, 0, At, B0); PG8_BAR; PG8_SCHED;
            PG8_STAGE_B(PG8_SB(1, 1), b3 + hstepB);
            PG8_WAIT_V(6); PG8_BAR; PG8_MMA(1, 1, At, B1); PG8_BAR;
        }
        if constexpr (F8) asm volatile("s_nop 15\n\ts_nop 15" ::: "memory");
        E(acc, cur, wr, wc, fr, fq);
        if (!has_next) break;
#pragma unroll
        for (int a = 0; a < 2; ++a)
#pragma unroll
            for (int b = 0; b < 2; ++b)
#pragma unroll
                for (int m = 0; m < 4; ++m)
#pragma unroll
                    for (int n = 0; n < 2; ++n) acc[a][b][m][n] = (f32x4){0.f, 0.f, 0.f, 0.f};
        cur = nxt; cB = nB; ++ui;
#pragma unroll
        for (int h = 0; h < 2; ++h)
#pragma unroll
            for (int i = 0; i < 2; ++i) vc[h][i] = v2[h][i];
    }
    PG8_WAIT_V(0);
    if (wr == 0) PG8_BAR;
    PG8_BAR;
#undef PG8_SA
#undef PG8_SB
#undef PG8_STAGE_A
#undef PG8_STAGE_B
#undef PG8_VOFFA
#undef PG8_LDA
#undef PG8_LDB
#undef PG8_MMA
#undef PG8_WAIT_V
#undef PG8_WAIT_L
#undef PG8_BAR
#undef PG8_SCHED
}
}


namespace att {
using bf16x8 = __attribute__((ext_vector_type(8))) short;
using s16x4  = __attribute__((ext_vector_type(4))) short;
using f32x16 = __attribute__((ext_vector_type(16))) float;
using u32x4  = __attribute__((ext_vector_type(4))) unsigned;
constexpr int KVBLK = 64, LDK = 128;
constexpr int SHM_V = KVBLK * 128 * 2, SHM_K = KVBLK * 128 * 2, SHM_ATTN = 2 * SHM_V + 2 * SHM_K + 8 * 64 * 4;
constexpr float THR = 8.f;
#define KSWZ(row, colB) ((row) * 256 + ((colB) ^ (((row) & 7) << 4)))
#define SBAR() __builtin_amdgcn_sched_barrier(0)
DEV int crow(int r, int hi) { return (r & 3) + 8 * (r >> 2) + 4 * hi; }
DEV void partialSM(f32x16& p0, f32x16& p1, float& m_reg, float& mn, float& alpha) {
  float pmax = p0[0]; for (int r = 1; r < 16; ++r) pmax = fmaxf(pmax, p0[r]); for (int r = 0; r < 16; ++r) pmax = fmaxf(pmax, p1[r]);
  { auto rr = __builtin_amdgcn_permlane32_swap(__float_as_uint(pmax), __float_as_uint(pmax), false, false);
    pmax = fmaxf(__uint_as_float(rr[0]), __uint_as_float(rr[1])); }
  if (__builtin_expect(__all(pmax - m_reg <= THR), 1)) { mn = m_reg; alpha = 1.f; }
  else { mn = fmaxf(m_reg, pmax); alpha = __builtin_amdgcn_exp2f(m_reg - mn); m_reg = mn; }
  for (int r = 0; r < 16; ++r) p0[r] = p0[r] - mn; for (int r = 0; r < 16; ++r) p1[r] = p1[r] - mn;
  for (int r = 0; r < 16; ++r) p0[r] = __builtin_amdgcn_exp2f(p0[r]);
}
DEV void finishSM(f32x16& p0, f32x16& p1, float alpha, float& l_reg, bf16x8& pa0, bf16x8& pa1, bf16x8& pa2, bf16x8& pa3) {
  for (int r = 0; r < 16; ++r) p1[r] = __builtin_amdgcn_exp2f(p1[r]);
  float ps = 0; for (int r = 0; r < 16; ++r) ps += p0[r]; for (int r = 0; r < 16; ++r) ps += p1[r];
  { auto rr = __builtin_amdgcn_permlane32_swap(__float_as_uint(ps), __float_as_uint(ps), false, false);
    ps = __uint_as_float(rr[0]) + __uint_as_float(rr[1]); }
  l_reg = l_reg * alpha + ps;
#define PK4(P, BASE, OUT) do { unsigned a0 = cvt_pk_bf16(P[BASE + 0], P[BASE + 1]), a1 = cvt_pk_bf16(P[BASE + 2], P[BASE + 3]);   \
    unsigned b0 = cvt_pk_bf16(P[BASE + 4], P[BASE + 5]), b1 = cvt_pk_bf16(P[BASE + 6], P[BASE + 7]);                              \
    auto r0 = __builtin_amdgcn_permlane32_swap(a0, b0, false, false); auto r1 = __builtin_amdgcn_permlane32_swap(a1, b1, false, false); \
    u32x4 w = {r0[0], r1[0], r0[1], r1[1]}; OUT = *reinterpret_cast<bf16x8*>(&w); } while (0)
  PK4(p0, 0, pa0); PK4(p0, 8, pa1); PK4(p1, 0, pa2); PK4(p1, 8, pa3);
#undef PK4
}
DEV void qkt(f32x16& p0, f32x16& p1, const char* Ks, const bf16x8 (&qr)[4], int r32, int hi, int js) {
  p0 = f32x16{}; p1 = f32x16{};
#pragma unroll
  for (int d0 = 0; d0 < 4; ++d0) { const int cb = ((js * 4 + d0) * 16 + hi * 8) * 2;
    bf16x8 b0 = *reinterpret_cast<const bf16x8*>(Ks + KSWZ(r32, cb));
    bf16x8 b1 = *reinterpret_cast<const bf16x8*>(Ks + KSWZ(32 + r32, cb));
    p0 = __builtin_amdgcn_mfma_f32_32x32x16_bf16(b0, qr[d0], p0, 0, 0, 0);
    p1 = __builtin_amdgcn_mfma_f32_32x32x16_bf16(b1, qr[d0], p1, 0, 0, 0); }
}
DEV int v_st(int k, int c) { const int kk = (k & ~0xC) | ((k & 4) << 1) | ((k & 8) >> 1); return ((kk >> 3) * 4 + (c >> 5)) * 512 + ((kk & 7) * 32 + (c & 31)) * 2; }
DEV int v_rd_base(int lane) { return ((lane & 3) << 3) | (((lane >> 2) & 3) << 6) | (((lane >> 4) & 1) << 5) | (((lane >> 5) & 1) << 8); }
constexpr int v_rd_off(int d0, int ks, int half) { return d0 * 512 + ks * 4096 + half * 2048; }
template <int OFF> DEV s16x4 tr_read(int vb) {
  s16x4 r; asm volatile("ds_read_b64_tr_b16 %0, %1 offset:%2" : "=&v"(r) : "v"(vb), "i"(OFF) : "memory"); return r;
}
template <int D0> DEV void pv_one(f32x16& od, int vb, bf16x8 pa0, bf16x8 pa1, bf16x8 pa2, bf16x8 pa3) {
  const s16x4 l0 = tr_read<v_rd_off(D0, 0, 0)>(vb), h0 = tr_read<v_rd_off(D0, 0, 1)>(vb), l1 = tr_read<v_rd_off(D0, 1, 0)>(vb), h1 = tr_read<v_rd_off(D0, 1, 1)>(vb);
  const s16x4 l2 = tr_read<v_rd_off(D0, 2, 0)>(vb), h2 = tr_read<v_rd_off(D0, 2, 1)>(vb), l3 = tr_read<v_rd_off(D0, 3, 0)>(vb), h3 = tr_read<v_rd_off(D0, 3, 1)>(vb);
  asm volatile("s_waitcnt lgkmcnt(0)" ::: "memory"); SBAR();
#define PK(L, H) (bf16x8){L[0], L[1], L[2], L[3], H[0], H[1], H[2], H[3]}
  od = __builtin_amdgcn_mfma_f32_32x32x16_bf16(pa0, PK(l0, h0), od, 0, 0, 0);
  od = __builtin_amdgcn_mfma_f32_32x32x16_bf16(pa1, PK(l1, h1), od, 0, 0, 0);
  od = __builtin_amdgcn_mfma_f32_32x32x16_bf16(pa2, PK(l2, h2), od, 0, 0, 0);
  od = __builtin_amdgcn_mfma_f32_32x32x16_bf16(pa3, PK(l3, h3), od, 0, 0, 0);
#undef PK
}
DEV void pv_d0(f32x16* o, int vb, bf16x8 pa0, bf16x8 pa1, bf16x8 pa2, bf16x8 pa3) {
  pv_one<0>(o[0], vb, pa0, pa1, pa2, pa3); pv_one<1>(o[1], vb, pa0, pa1, pa2, pa3); pv_one<2>(o[2], vb, pa0, pa1, pa2, pa3); pv_one<3>(o[3], vb, pa0, pa1, pa2, pa3);
}
DEV void attn_tiles(const bf16x8 (&qr)[4], const bf16_t* __restrict__ Kh, const bf16_t* __restrict__ Vh, int seq, char* lds,
                    float& m_reg, float& l_reg, f32x16 (&o)[4], int tid, int js) {
  const int wid = tid >> 6, lane = tid & 63, r32 = lane & 31, hi = lane >> 5;
  char* V_lds = lds; char* K_lds = lds + 2 * SHM_V;
  float* ws = (float*)(lds + 2 * SHM_V + 2 * SHM_K) + wid * 64; float* al_l = ws + 32;
  const int sr = tid >> 4, sc = (tid & 15) * 8, vst0 = v_st(sr, sc), vst1 = v_st(32 + sr, sc);
  const int vb0 = (int)(uintptr_t)V_lds + v_rd_base(lane);
  struct { bf16x8 vs0, vs1, ks0, ks1; } sr_[2];
  const unsigned lo0 = (unsigned)((sr * LDK + sc) * 2), lo1 = lo0 + 32u * LDK * 2u;
#define SLOAD(i, k0) do { const char* vb_ = (const char*)Vh + (size_t)(k0) * (LDK * 2); const char* kb_ = (const char*)Kh + (size_t)(k0) * (LDK * 2); \
    sr_[i].vs0 = *(const bf16x8*)(vb_ + lo0); sr_[i].vs1 = *(const bf16x8*)(vb_ + lo1); sr_[i].ks0 = *(const bf16x8*)(kb_ + lo0); sr_[i].ks1 = *(const bf16x8*)(kb_ + lo1); } while (0)
#define SWRITE(b, i) do { *(bf16x8*)(V_lds + (b) * SHM_V + vst0) = sr_[i].vs0;          \
    *(bf16x8*)(V_lds + (b) * SHM_V + vst1) = sr_[i].vs1; int kc = sc * 2;               \
    *(bf16x8*)(K_lds + (b) * SHM_K + KSWZ(sr, kc)) = sr_[i].ks0;                       \
    *(bf16x8*)(K_lds + (b) * SHM_K + KSWZ(32 + sr, kc)) = sr_[i].ks1; } while (0)
#define SWAIT() asm volatile("s_waitcnt vmcnt(4)" ::: "memory")
#define RESC(a) do { if (__any((a) < 1.f)) { if (hi == 0) al_l[r32] = (a); asm volatile("s_waitcnt lgkmcnt(0)" ::: "memory"); \
    for (int d = 0; d < 4; ++d) for (int r = 0; r < 16; ++r) o[d][r] *= al_l[crow(r, hi)]; } } while (0)
  f32x16 pA0, pA1, pB0, pB1; float mnA, mnB, alA, alB; bf16x8 pa0, pa1, pa2, pa3; const int NTL = seq / KVBLK;
  constexpr int SE = 0, SO = 1;
  __syncthreads();
  SLOAD(SE, 0); asm volatile("s_waitcnt vmcnt(0)" ::: "memory"); SWRITE(0, SE); __syncthreads();
  qkt(pA0, pA1, K_lds, qr, r32, hi, js); partialSM(pA0, pA1, m_reg, mnA, alA);
  SLOAD(SO, KVBLK); if (2 < NTL) SLOAD(SE, 2 * KVBLK);
  SWAIT(); SWRITE(1, SO); __syncthreads();
  RESC(alA);
  for (int j = 1; j + 1 < NTL; j += 2) {
    SBAR(); qkt(pB0, pB1, K_lds + SHM_K, qr, r32, hi, js);
    finishSM(pA0, pA1, alA, l_reg, pa0, pa1, pa2, pa3); SBAR();
    SLOAD(SO, (j + 2) * KVBLK); SBAR();
    pv_d0(o, vb0, pa0, pa1, pa2, pa3); partialSM(pB0, pB1, m_reg, mnB, alB);
    __syncthreads(); SWAIT(); SWRITE(0, SE);
    RESC(alB); __syncthreads();
    SBAR(); qkt(pA0, pA1, K_lds, qr, r32, hi, js);
    finishSM(pB0, pB1, alB, l_reg, pa0, pa1, pa2, pa3); SBAR();
    if (j + 3 < NTL) SLOAD(SE, (j + 3) * KVBLK); SBAR();
    pv_d0(o, vb0 + SHM_V, pa0, pa1, pa2, pa3); partialSM(pA0, pA1, m_reg, mnA, alA);
    __syncthreads(); SWAIT(); SWRITE(1, SO);
    RESC(alA); __syncthreads();
  }
  SBAR(); qkt(pB0, pB1, K_lds + SHM_K, qr, r32, hi, js);
  finishSM(pA0, pA1, alA, l_reg, pa0, pa1, pa2, pa3); SBAR();
  pv_d0(o, vb0, pa0, pa1, pa2, pa3); partialSM(pB0, pB1, m_reg, mnB, alB);
  __syncthreads(); RESC(alB);
  finishSM(pB0, pB1, alB, l_reg, pa0, pa1, pa2, pa3); SBAR();
  pv_d0(o, vb0 + SHM_V, pa0, pa1, pa2, pa3);
#undef SLOAD
#undef SWRITE
#undef SWAIT
#undef RESC
}
}

DEV void cvt_tile(const float* src, int ld, int nvalid, bf16_t* dst, int K, int n0, int k0, float* T, const int t, int ns0 = -1) {
    if (ns0 < 0) ns0 = n0;
#pragma unroll
    for (int h = 0; h < 2; ++h) {
        const int kk = (t >> 4) + 32 * h, nq = (t & 15) * 4, n = ns0 + nq;
        const float4 v = n < nvalid ? *(const float4*)(src + (size_t)(k0 + kk) * ld + n) : make_float4(0.f, 0.f, 0.f, 0.f);
        T[(nq + 0) * 65 + kk] = v.x; T[(nq + 1) * 65 + kk] = v.y; T[(nq + 2) * 65 + kk] = v.z; T[(nq + 3) * 65 + kk] = v.w;
    }
    __syncthreads();
    { const int n = t >> 3, kq = (t & 7) * 8; const float* r = T + n * 65 + kq;
      pg8::u32x4 w; w.x = cvt_pk_bf16(r[0], r[1]); w.y = cvt_pk_bf16(r[2], r[3]); w.z = cvt_pk_bf16(r[4], r[5]); w.w = cvt_pk_bf16(r[6], r[7]);
      *(pg8::u32x4*)(dst + (size_t)(n0 + n) * K + k0 + kq) = w; }
    __syncthreads();
}
DEV unsigned pk4_fp8(float a, float b, float c, float d) {
    a = __builtin_amdgcn_fmed3f(a, -448.f, 448.f); b = __builtin_amdgcn_fmed3f(b, -448.f, 448.f); c = __builtin_amdgcn_fmed3f(c, -448.f, 448.f); d = __builtin_amdgcn_fmed3f(d, -448.f, 448.f);
    int w = 0; w = __builtin_amdgcn_cvt_pk_fp8_f32(a, b, w, false); w = __builtin_amdgcn_cvt_pk_fp8_f32(c, d, w, true); return (unsigned)w;
}
constexpr float F8_SW = 1024.f  , F8_SX = 16.f  , F8_SH = 8.f  , F8_SY = 32.f  ;
DEV void cvt_tile4(const float* src, int ld, int nvalid, bf16_t* dst, int K, int n0, int k0, float* T, const int t, int ns0 = -1, bool f8 = false) {
    if (ns0 < 0) ns0 = n0;
    float4 v[4][2];
#pragma unroll
    for (int q = 0; q < 4; ++q)
#pragma unroll
        for (int h = 0; h < 2; ++h) { const int kk = (t >> 4) + 32 * h, n = ns0 + (t & 15) * 4;
            v[q][h] = n < nvalid ? *(const float4*)(src + (size_t)(k0 + q * 64 + kk) * ld + n) : make_float4(0.f, 0.f, 0.f, 0.f); }
#pragma unroll
    for (int q = 0; q < 4; ++q)
#pragma unroll
        for (int h = 0; h < 2; ++h) { const int kk = (t >> 4) + 32 * h, nq = (t & 15) * 4; float* Tq = T + q * (64 * 65);
            Tq[(nq + 0) * 65 + kk] = v[q][h].x; Tq[(nq + 1) * 65 + kk] = v[q][h].y; Tq[(nq + 2) * 65 + kk] = v[q][h].z; Tq[(nq + 3) * 65 + kk] = v[q][h].w; }
    __syncthreads();
#pragma unroll
    for (int q = 0; q < 4; ++q) { const int n = t >> 3, kq = (t & 7) * 8; const float* r = T + q * (64 * 65) + n * 65 + kq;
      if (f8) { pg8::u32x2 w; w.x = pk4_fp8(r[0] * F8_SW, r[1] * F8_SW, r[2] * F8_SW, r[3] * F8_SW); w.y = pk4_fp8(r[4] * F8_SW, r[5] * F8_SW, r[6] * F8_SW, r[7] * F8_SW);
          const int nn = n0 + n, kk = k0 + q * 64 + kq;
          *(pg8::u32x2*)((unsigned char*)dst + (size_t)(nn >> 8) * 256 * K + (size_t)(kk >> 7) * (256 * 128) + (nn & 255) * 128 + (kk & 127)) = w; }
      else { pg8::u32x4 w; w.x = cvt_pk_bf16(r[0], r[1]); w.y = cvt_pk_bf16(r[2], r[3]); w.z = cvt_pk_bf16(r[4], r[5]); w.w = cvt_pk_bf16(r[6], r[7]);
          const int nn = n0 + n, kk = k0 + q * 64 + kq;
          *(pg8::u32x4*)(dst + (size_t)(nn >> 8) * 256 * K + (size_t)(kk >> 6) * (256 * 64) + (nn & 255) * 64 + (kk & 63)) = w; } }
    __syncthreads();
}
DEV void ph_convert(const Params& p, char* smem) {
    const int tidx = tid_of(p.wave_id);
    float* T = (float*)(smem + 256);
    volatile int* msg = (volatile int*)smem;
    unsigned* qh = (unsigned*)(p.ws + OFF_bar) + CW_QHEAD;
    constexpr int T_IN = 2 * 60 * 4, T_OUT = 2 * 16 * 4, T_W1 = 64 * 32 * 4, T_W2 = 64 * 16 * 4;
    unsigned nxt = 0u;
    if (tidx == 0) nxt = xb_add(qh, 1u);
    for (;;) {
        __syncthreads();
        if (tidx == 0) msg[0] = (int)nxt;
        __syncthreads();
        const int u = msg[0];
        if (u >= T_IN + T_OUT + T_W1 + T_W2) break;
        if (tidx == 0) nxt = xb_add(qh, 1u);
        if (u < T_IN) { const int l = u / 240, r = u % 240, nt = r >> 2, kq = r & 3;
            const int n0 = nt * 64; int ns0, nv;
            if (n0 < 2048) { ns0 = n0; nv = DPW; } else if (n0 < 3584) { ns0 = n0 + 16; nv = DPW; } else if (n0 == 3584) { ns0 = 2048; nv = 2064; } else { ns0 = 0; nv = 0; }
            cvt_tile4(p.w_in + (size_t)l * D * DPW, DPW, nv, (bf16_t*)(p.ws + OFF_WIN) + (size_t)l * DP * D, D, n0, kq * 256, T, tidx, ns0); }
        else if (u < T_IN + T_OUT) { const int v = u - T_IN, l = v >> 6, r = v & 63, nt = r >> 2, kq = r & 3;
            cvt_tile4(p.w_out + (size_t)l * D * D, D, D, (bf16_t*)(p.ws + OFF_WOUT) + (size_t)l * D * D, D, nt * 64, kq * 256, T, tidx); }
        else if (u < T_IN + T_OUT + T_W1) { const int v = u - T_IN - T_OUT, le = v >> 7, r = v & 127, nt = r >> 2, kq = r & 3;
            cvt_tile4(p.w1 + (size_t)le * D * 2048, 2048, 2048, (bf16_t*)(p.ws + OFF_W1T + (size_t)le * 2048 * D), D, nt * 64, kq * 256, T, tidx, -1, true); }
        else { const int v = u - T_IN - T_OUT - T_W1, le = v >> 6, r = v & 63, nt = r >> 2, kq = r & 3;
            cvt_tile4(p.w2 + (size_t)le * DFF * D, D, D, (bf16_t*)(p.ws + OFF_W2T + (size_t)le * D * DFF), DFF, nt * 64, kq * 256, T, tidx, -1, true); }
    }
}

DEV void row_load(const float* src, float4 (&v)[4], int lane) {
#pragma unroll
    for (int i = 0; i < 4; ++i) v[i] = *(const float4*)(src + i * 256 + lane * 4);
}
DEV void row_store(float* dst, const float4 (&v)[4], int lane) {
#pragma unroll
    for (int i = 0; i < 4; ++i) *(float4*)(dst + i * 256 + lane * 4) = v[i];
}
DEV void row_store_bf16(bf16_t* dst, const float4 (&v)[4], int lane) {
#pragma unroll
    for (int i = 0; i < 4; ++i) { pg8::u32x2 w; w.x = cvt_pk_bf16(v[i].x, v[i].y); w.y = cvt_pk_bf16(v[i].z, v[i].w); *(pg8::u32x2*)(dst + i * 256 + lane * 4) = w; }
}
DEV void row_store_fp8(unsigned char* dst, const float4 (&v)[4], int lane, float sc) {
#pragma unroll
    for (int i = 0; i < 4; ++i) *(unsigned*)(dst + i * 256 + lane * 4) = pk4_fp8(v[i].x * sc, v[i].y * sc, v[i].z * sc, v[i].w * sc);
}
DEV void row_load_bf(const bf16_t* src, float4 (&v)[4], int lane) {
#pragma unroll
    for (int i = 0; i < 4; ++i) { const pg8::u32x2 w = *(const pg8::u32x2*)(src + i * 256 + lane * 4);
        v[i] = make_float4(__uint_as_float(w.x << 16), __uint_as_float(w.x & 0xffff0000u), __uint_as_float(w.y << 16), __uint_as_float(w.y & 0xffff0000u)); }
}
DEV float row_rinv(const float4 (&v)[4]) {
    float ss = 0.f;
#pragma unroll
    for (int i = 0; i < 4; ++i) ss += v[i].x * v[i].x + v[i].y * v[i].y + v[i].z * v[i].z + v[i].w * v[i].w;
    ss = wsum(ss);
    return rsqrtf(ss * (1.f / 1024.f) + 1e-6f);
}
DEV void row_modnorm(const float4 (&v)[4], const float* gain, const float* shift, const float* scale, float4 (&o)[4], int lane) {
    const float r = row_rinv(v);
#pragma unroll
    for (int i = 0; i < 4; ++i) {
        const int idx = i * 256 + lane * 4;
        const float4 g = *(const float4*)(gain + idx), sh = *(const float4*)(shift + idx), sc = *(const float4*)(scale + idx);
        o[i].x = v[i].x * r * g.x * (1.f + sc.x) + sh.x; o[i].y = v[i].y * r * g.y * (1.f + sc.y) + sh.y;
        o[i].z = v[i].z * r * g.z * (1.f + sc.z) + sh.z; o[i].w = v[i].w * r * g.w * (1.f + sc.w) + sh.w;
    }
}
DEV const float* modrow(const Params& p, int layer, int b, int s) { return ((float*)(p.ws + OFF_MOD)) + ((size_t)layer * 9 + (s < CTX ? 8 : b)) * 6144; }

DEV void ph_mods(const Params& p, char* smem) {
    const int tidx = tid_of(p.wave_id);
    float (*cond)[1024] = (float (*)[1024])smem;
    float (*red)[9][64] = (float (*)[9][64])(smem + 9 * 1024 * 4);
    const int tid = tidx;
    for (int i = tid; i < 9 * 1024; i += 512) { const int r = i >> 10, k = i & 1023; const float c = r < 8 ? p.c[r * 1024 + k] : p.c_ctx[k]; cond[r][k] = c * sigm(c); }
    __syncthreads();
    for (int u = blockIdx.x; u < 192; u += gridDim.x) {
        const int layer = u / 96, cg = u % 96, jj = tid & 63, ks = tid >> 6, j = cg * 64 + jj;
        float acc[9];
#pragma unroll
        for (int r = 0; r < 9; ++r) acc[r] = 0.f;
        const float* w = p.ada_w + (size_t)layer * 1024 * 6144 + j;
        for (int k = ks * 128; k < ks * 128 + 128; ++k) { const float wv = w[(size_t)k * 6144];
#pragma unroll
            for (int r = 0; r < 9; ++r) acc[r] += cond[r][k] * wv; }
#pragma unroll
        for (int r = 0; r < 9; ++r) red[ks][r][jj] = acc[r];
        __syncthreads();
        for (int t = tid; t < 9 * 64; t += 512) { const int r = t >> 6, q = t & 63; float s = 0.f; for (int z = 0; z < 8; ++z) s += red[z][r][q];
            ((float*)(p.ws + OFF_MOD))[((size_t)layer * 9 + r) * 6144 + cg * 64 + q] = s + p.ada_b[layer * 6144 + cg * 64 + q]; }
        __syncthreads();
    }
    if (blockIdx.x == (gridDim.x > 1 ? 1u : 0u)) {
        for (int t = tid; t < 1024; t += 512) { const int pos = t >> 4, i = t & 15; float sn, cs; sincosf((float)pos * expf(-(float)i * (1.f / 16.f) * 9.210340371976184f), &sn, &cs);
            ((float2*)(p.ws + OFF_ROPE))[t] = make_float2(cs, sn); }
    }
    if (blockIdx.x == 0) {
        for (int t = tid; t < 1024; t += 512) { const int layer = t >> 9, dir = (t >> 8) & 1, w = t & 255;
            const float t0 = p.hlb[(dir * 2 + 0) * 256 + w], t1 = p.hlb[(dir * 2 + 1) * 256 + w];
            const float mx = fmaxf(t0, t1), e0 = expf(t0 - mx), e1 = expf(t1 - mx);
            float lb = layer == 0 ? 0.f : e1 / (e0 + e1); lb = fminf(fmaxf(lb, 0.f), 1.f);
            ((float*)(p.ws + OFF_LB))[(layer * 2 + dir) * 256 + w] = lb; }
        if (tid < 128) { const int layer = tid >> 6, lane = tid & 63; const float* L = p.dlam + layer * 256;
            const float s1 = wsum(L[lane] * L[64 + lane]), s2 = wsum(L[128 + lane] * L[192 + lane]);
            if (lane == 0) ((float*)(p.ws + OFF_LAM))[layer] = expf(s1) - expf(s2) + lam_init_of(layer); }
    }
}

DEV void ph_init(const Params& p, char* smem) {
    const int tidx = tid_of(p.wave_id);
    const int wid = tidx >> 6, lane = tidx & 63;
    for (int r = blockIdx.x * 8 + wid; r < NT; r += gridDim.x * 8) {
        const int b = r / SL, s = r % SL;
        const float* src = s < CTX ? p.ctx + ((size_t)b * CTX + s) * D : p.x + ((size_t)b * SEQ + (s - CTX)) * D;
        float4 v[4], o[4]; row_load(src, v, lane); row_store_bf16((bf16_t*)(p.ws + OFF_X) + (size_t)r * D, v, lane);
        const float* m = modrow(p, 0, b, s);
        row_modnorm(v, p.norms + 0, m + 0, m + 1024, o, lane);
        row_store_bf16((bf16_t*)(p.ws + OFF_XNB) + (size_t)r * D, o, lane);
    }
}


struct EpiIn {
    static constexpr bool PERM = false;
    bf16_t *PB, *QRB, *Q0B, *KB, *VB; const float* CS;
    DEV void operator()(const pg8::f32x4 (&acc)[2][2][4][2], const pg8::Unit& u, int wr, int wc, int fr, int fq) const {
        using pg8::f32x4; using pg8::u32x2;
        const int pn = u.pn;
        if (pn < 8 || pn == 14) {
#pragma unroll
            for (int ai = 0; ai < 2; ++ai)
#pragma unroll
                for (int m = 0; m < 4; ++m) { bf16_t* rowp = PB + (size_t)(u.pm * 256 + ai * 128 + wr * 64 + m * 16 + fr) * DP + pn * 256 + wc * 32 + 4 * fq;
#pragma unroll
                    for (int bj = 0; bj < 2; ++bj)
#pragma unroll
                        for (int n = 0; n < 2; ++n) { const f32x4 v = acc[ai][bj][m][n]; u32x2 w; w.x = cvt_pk_bf16(v[0], v[1]); w.y = cvt_pk_bf16(v[2], v[3]); *(u32x2*)(rowp + bj * 128 + n * 16) = w; } }
        } else {
            const int kind = (pn - 8) >> 1, hb = ((pn - 8) & 1) * 2, b = u.pm / 9, tq = u.pm % 9, half = wc & 1, jsub = wc >> 1;
            const bool isctx = tq == 0;
            const float QC = 0.125f * 1.4426950408889634f;
#pragma unroll
            for (int ai = 0; ai < 2; ++ai)
#pragma unroll
                for (int m = 0; m < 4; ++m) {
                    const int s = tq * 256 + ai * 128 + wr * 64 + m * 16 + fr;
                    f32x4 c4 = {1.f, 1.f, 1.f, 1.f}, s4 = {0.f, 0.f, 0.f, 0.f};
                    if (kind != 2 && !isctx) { const int pos = half == 0 ? (tq - 1) * 4 + ai * 2 + wr : m * 16 + fr;
                        const f32x4 t0 = *(const f32x4*)(CS + (pos * 16 + 4 * fq) * 2), t1 = *(const f32x4*)(CS + (pos * 16 + 4 * fq) * 2 + 4);
                        c4 = (f32x4){t0[0], t0[2], t1[0], t1[2]}; s4 = (f32x4){t0[1], t0[3], t1[1], t1[3]}; }
#pragma unroll
                    for (int bj = 0; bj < 2; ++bj) {
                        const size_t dst = ((size_t)(b * 4 + hb + bj) * SL + s) * 128 + jsub * 64 + half * 32 + 4 * fq;
                        const f32x4 x1 = acc[ai][bj][m][0], x2 = acc[ai][bj][m][1];
#define ST4(ptr, v) do { u32x2 w_; w_.x = cvt_pk_bf16((v)[0], (v)[1]); w_.y = cvt_pk_bf16((v)[2], (v)[3]); *(u32x2*)(ptr) = w_; } while (0)
                        if (kind == 2) { ST4(VB + dst, x1); ST4(VB + dst + 16, x2); }
                        else {
                            const f32x4 o1 = x1 * c4 - x2 * s4, o2 = x1 * s4 + x2 * c4;
                            if (kind == 1) { ST4(KB + dst, o1); ST4(KB + dst + 16, o2); }
                            else { const f32x4 a1 = o1 * QC, a2 = o2 * QC, p1 = x1 * QC, p2 = x2 * QC; ST4(QRB + dst, a1); ST4(QRB + dst + 16, a2); ST4(Q0B + dst, p1); ST4(Q0B + dst + 16, p2); }
                        }
#undef ST4
                    }
                }
        }
    }
};

struct InOrder {
    int G, c, Lbeg, Lend; const char* Bt; int K;
    DEV bool next(int i, pg8::Unit& u) const {
        const int L = Lbeg + i * G + c; if (L >= Lend) return false;
        const int nN = L < 648 ? 9 : 6, l = L < 648 ? L : L - 648, nM = NT / 256, nwg = nM * nN;
        int wgid = l; { const int q = nwg / 8, r = nwg % 8, xcd = wgid % 8, off = wgid / 8; wgid = (xcd < r ? xcd * (q + 1) : r * (q + 1) + (xcd - r) * q) + off; }
        const int nig = 8 * nN, gid = wgid / nig, fm = gid * 8, gsz = (nM - fm) < 8 ? (nM - fm) : 8;
        const int pnl = (wgid % nig) / gsz;
        u.pm = fm + ((wgid % nig) % gsz); u.pn = L < 648 ? (pnl < 8 ? pnl : 14) : 8 + pnl; u.e = 0; u.t = 0; return true;
    }
    DEV int arow(const pg8::Unit& u, int rr) const { return u.pm * 256 + rr; }
    DEV const char* bbase(const pg8::Unit& u) const { return Bt + (size_t)u.pn * 256 * K * 2; }
};
DEV void ph_inproj(const Params& p, int layer, char* smem, int part) {
    const int tidx = tid_of(p.wave_id);
    const int G = (int)gridDim.x, nun = (NT / 256) * (DP / 256), cut = 4 * G < nun ? 4 * G : nun;
    const int nleft = nun - cut, cid = part == 0 ? (int)blockIdx.x : (int)blockIdx.x - (G - nleft);
    if (part == 1 && (nleft <= 0 || cid < 0)) return;
    InOrder S{G, cid, part == 0 ? 0 : cut, part == 0 ? cut : nun, (const char*)((const bf16_t*)(p.ws + OFF_WIN) + (size_t)layer * DP * D), D};
    EpiIn E{(bf16_t*)(p.ws + OFF_PB), (bf16_t*)(p.ws + OFF_QRB), (bf16_t*)(p.ws + OFF_Q0B), (bf16_t*)(p.ws + OFF_KB), (bf16_t*)(p.ws + OFF_VB), (const float*)(p.ws + OFF_ROPE)};
    pg8::gemm_phase(( LAS unsigned char*)smem, (const char*)(p.ws + OFF_XNB), D, S, E, tid_of(p.wave_id));
}


namespace scn {
using att::bf16x8; using att::s16x4; using att::f32x16; using att::u32x4; using att::crow;
DEV int v_st64(int k, int c) { const int kk = (k & ~0xC) | ((k & 4) << 1) | ((k & 8) >> 1); return ((kk >> 3) * 2 + (c >> 5)) * 512 + ((kk & 7) * 32 + (c & 31)) * 2; }
constexpr int v_rd_off64(int d0, int ks, int half) { return d0 * 512 + ks * 2048 + half * 1024; }
#define SCN_PK(L, H) (bf16x8){L[0], L[1], L[2], L[3], H[0], H[1], H[2], H[3]}
template <int D0> DEV void frags4(int vb, bf16x8& f0, bf16x8& f1, bf16x8& f2, bf16x8& f3) {
    const s16x4 l0 = att::tr_read<v_rd_off64(D0, 0, 0)>(vb), h0 = att::tr_read<v_rd_off64(D0, 0, 1)>(vb), l1 = att::tr_read<v_rd_off64(D0, 1, 0)>(vb), h1 = att::tr_read<v_rd_off64(D0, 1, 1)>(vb);
    const s16x4 l2 = att::tr_read<v_rd_off64(D0, 2, 0)>(vb), h2 = att::tr_read<v_rd_off64(D0, 2, 1)>(vb), l3 = att::tr_read<v_rd_off64(D0, 3, 0)>(vb), h3 = att::tr_read<v_rd_off64(D0, 3, 1)>(vb);
    asm volatile("s_waitcnt lgkmcnt(0)" ::: "memory"); SBAR();
    f0 = SCN_PK(l0, h0); f1 = SCN_PK(l1, h1); f2 = SCN_PK(l2, h2); f3 = SCN_PK(l3, h3);
}
DEV bf16x8 pack8(const float (&v)[8]) { u32x4 w = {cvt_pk_bf16(v[0], v[1]), cvt_pk_bf16(v[2], v[3]), cvt_pk_bf16(v[4], v[5]), cvt_pk_bf16(v[6], v[7])}; return *reinterpret_cast<bf16x8*>(&w); }
DEV void stage64(char* img, const float* src, size_t ld, int lane, float sc = 1.f) {
    const float* row = src + (size_t)lane * ld;
#pragma unroll
    for (int c8 = 0; c8 < 8; ++c8) { const float4 a = *(const float4*)(row + c8 * 8), b = *(const float4*)(row + c8 * 8 + 4);
        u32x4 w = {cvt_pk_bf16(a.x * sc, a.y * sc), cvt_pk_bf16(a.z * sc, a.w * sc), cvt_pk_bf16(b.x * sc, b.y * sc), cvt_pk_bf16(b.z * sc, b.w * sc)};
        *(u32x4*)(img + v_st64(lane, c8 * 8)) = w; }
}
template <int CTRL, int RM> DEV float dpp_f(float oldv, float v, bool bc) { return bc ? __builtin_bit_cast(float, __builtin_amdgcn_update_dpp(__builtin_bit_cast(int, oldv), __builtin_bit_cast(int, v), CTRL, RM, 0xf, true))
                                                                                   : __builtin_bit_cast(float, __builtin_amdgcn_update_dpp(__builtin_bit_cast(int, oldv), __builtin_bit_cast(int, v), CTRL, RM, 0xf, false)); }
DEV float bperm(float v, int src) { return __builtin_bit_cast(float, __builtin_amdgcn_ds_bpermute(src << 2, __builtin_bit_cast(int, v))); }
DEV float scan_inc32(float v) {
    v += dpp_f<0x111, 0xf>(0.f, v, true); v += dpp_f<0x112, 0xf>(0.f, v, true); v += dpp_f<0x114, 0xf>(0.f, v, true); v += dpp_f<0x118, 0xf>(0.f, v, true);
    v += dpp_f<0x142, 0xa>(0.f, v, false);
    return v;
}
DEV float scanmax_inc32(float v) {
    const float ni = -3.0e38f;
    v = fmaxf(v, dpp_f<0x111, 0xf>(ni, v, false)); v = fmaxf(v, dpp_f<0x112, 0xf>(ni, v, false)); v = fmaxf(v, dpp_f<0x114, 0xf>(ni, v, false)); v = fmaxf(v, dpp_f<0x118, 0xf>(ni, v, false));
    v = fmaxf(v, dpp_f<0x142, 0xa>(ni, v, false));
    return v;
}
DEV float scanmax_suf32(float v, int lane) {
    const float ni = -3.0e38f;
    v = fmaxf(v, dpp_f<0x101, 0xf>(ni, v, false)); v = fmaxf(v, dpp_f<0x102, 0xf>(ni, v, false)); v = fmaxf(v, dpp_f<0x104, 0xf>(ni, v, false)); v = fmaxf(v, dpp_f<0x108, 0xf>(ni, v, false));
    const float t = bperm(v, (lane & 32) | 16);
    return (lane & 16) ? v : fmaxf(v, t);
}
DEV void ld8(const bf16_t* ub, unsigned boff, float (&v)[8]) { const u32x4 w = *(const u32x4*)((const char*)ub + boff);
    v[0] = __uint_as_float(w.x << 16); v[1] = __uint_as_float(w.x & 0xffff0000u); v[2] = __uint_as_float(w.y << 16); v[3] = __uint_as_float(w.y & 0xffff0000u);
    v[4] = __uint_as_float(w.z << 16); v[5] = __uint_as_float(w.z & 0xffff0000u); v[6] = __uint_as_float(w.w << 16); v[7] = __uint_as_float(w.w & 0xffff0000u); }
DEV float ld1(const bf16_t* ub, unsigned boff) { return __uint_as_float((unsigned)(*(const unsigned short*)((const char*)ub + boff)) << 16); }
DEV void stage64b(char* img, const bf16_t* src, size_t ld, int lane) {
    const bf16_t* row = src + (size_t)lane * ld;
#pragma unroll
    for (int c8 = 0; c8 < 8; ++c8) *(u32x4*)(img + v_st64(lane, c8 * 8)) = *(const u32x4*)(row + c8 * 8);
}
DEV float4 ldg4(const float* ub, unsigned boff) { return *(const float4*)((const char*)ub + boff); }
DEV float ldg1(const float* ub, unsigned boff) { return *(const float*)((const char*)ub + boff); }
DEV float fexp(float x) { return __expf(fminf(fmaxf(x, -80.f), 80.f)); }
DEV float fsig(float x) { return __builtin_amdgcn_rcpf(1.f + __expf(-x)); }
DEV void decay_ks(const float (&x)[2][8], const float (&lb)[8], int dir, int lane, float (&cum)[2][8], float (&kk)[2][8], float (&ref)[8]) {
#pragma unroll
    for (int tb = 0; tb < 2; ++tb)
#pragma unroll
        for (int j = 0; j < 8; ++j) { const float sg = fsig(x[tb][j]); kk[tb][j] = (1.f - lb[j]) * (1.f - sg); cum[tb][j] = __logf(fmaxf(lb[j] + (1.f - lb[j]) * sg, 1e-12f)); }
#pragma unroll
    for (int j = 0; j < 8; ++j) {
        const float i0 = scan_inc32(cum[0][j]), i1 = scan_inc32(cum[1][j]), t0 = bperm(i0, lane | 31), t1 = bperm(i1, lane | 31);
        if (dir == 0) { cum[0][j] = i0; cum[1][j] = i1 + t0; ref[j] = t0; }
        else { const float x0 = cum[0][j], x1 = cum[1][j]; cum[1][j] = t1 - i1 + x1; cum[0][j] = t0 - i0 + x0 + t1; ref[j] = t1; }
        if ((j & 3) == 3) SBAR();
    }
}
}

DEV void scanA_local(const Params& p, int layer, char* Lw, int bh, int tc, int lane) {
    using namespace scn;
    asm volatile("" : "+v"(lane));
    const int r32 = lane & 31, hi = lane >> 5, b = bh >> 2, h = bh & 3;
    const bf16_t* base = (const bf16_t*)(p.ws + OFF_PB) + (size_t)(b * SL + 64 * tc) * DP;
    unsigned lo = (unsigned)(r32 * DP + 8 * hi) * 2u;
    asm volatile("" : "+v"(lo));
    char* imgV = Lw; char* imgK = Lw + 8192;
    const int vbV = (int)(uintptr_t)imgV + att::v_rd_base(lane), vbK = vbV + 8192;
    stage64b(imgV, base + O_AI + h * 64, DP, lane);
#pragma unroll 1
    for (int dir = 0; dir < 2; ++dir) {
        const int chain = bh * 2 + dir, c = dir == 0 ? tc : (tc < 4 ? 3 - tc : 39 - tc);
#pragma unroll 1
        for (int ks = 0; ks < 4; ++ks) {
            const int ch = 16 * ks + 8 * hi;
            float x[2][8], cum[2][8], kk[2][8], ref[8], lb[8];
#pragma unroll
            for (int tb = 0; tb < 2; ++tb) ld8(base + (dir ? O_AFB : O_AFF) + h * 64 + 16 * ks, lo + tb * (32u * DP * 2u), x[tb]);
            { const float* l = (const float*)(p.ws + OFF_LB) + (layer * 2 + dir) * 256 + h * 64 + ch;
#pragma unroll
              for (int j = 0; j < 8; ++j) lb[j] = l[j]; }
            decay_ks(x, lb, dir, lane, cum, kk, ref);
            float ke[8];
#pragma unroll
            for (int tb = 0; tb < 2; ++tb) {
#pragma unroll
                for (int j = 0; j < 8; ++j) { const float ce = dir == 0 ? bperm(cum[1][j], lane | 31) : bperm(cum[0][j], lane & 32);
                    ke[j] = kk[tb][j] * fexp(ce - cum[tb][j]);
                    if (tb == 1 && dir == 0 && r32 == 31) ((float*)(p.ws + OFF_DECA))[(chain * 36 + c) * 64 + ch + j] = __expf(ce);
                    if (tb == 0 && dir == 1 && r32 == 0) ((float*)(p.ws + OFF_DECA))[(chain * 36 + c) * 64 + ch + j] = __expf(ce); }
                *(bf16x8*)(imgK + v_st64(32 * tb + r32, ch)) = pack8(ke);
            }
            SBAR();
        }
        f32x16 u[2][2] = {};
        { bf16x8 k0, k1, k2, k3, v0, v1, v2, v3;
          frags4<0>(vbK, k0, k1, k2, k3); frags4<0>(vbV, v0, v1, v2, v3);
          u[0][0] = __builtin_amdgcn_mfma_f32_32x32x16_bf16(k0, v0, u[0][0], 0, 0, 0); u[0][0] = __builtin_amdgcn_mfma_f32_32x32x16_bf16(k1, v1, u[0][0], 0, 0, 0);
          u[0][0] = __builtin_amdgcn_mfma_f32_32x32x16_bf16(k2, v2, u[0][0], 0, 0, 0); u[0][0] = __builtin_amdgcn_mfma_f32_32x32x16_bf16(k3, v3, u[0][0], 0, 0, 0);
          bf16x8 w0, w1, w2, w3; frags4<1>(vbV, w0, w1, w2, w3);
          u[0][1] = __builtin_amdgcn_mfma_f32_32x32x16_bf16(k0, w0, u[0][1], 0, 0, 0); u[0][1] = __builtin_amdgcn_mfma_f32_32x32x16_bf16(k1, w1, u[0][1], 0, 0, 0);
          u[0][1] = __builtin_amdgcn_mfma_f32_32x32x16_bf16(k2, w2, u[0][1], 0, 0, 0); u[0][1] = __builtin_amdgcn_mfma_f32_32x32x16_bf16(k3, w3, u[0][1], 0, 0, 0);
          frags4<1>(vbK, k0, k1, k2, k3);
          u[1][0] = __builtin_amdgcn_mfma_f32_32x32x16_bf16(k0, v0, u[1][0], 0, 0, 0); u[1][0] = __builtin_amdgcn_mfma_f32_32x32x16_bf16(k1, v1, u[1][0], 0, 0, 0);
          u[1][0] = __builtin_amdgcn_mfma_f32_32x32x16_bf16(k2, v2, u[1][0], 0, 0, 0); u[1][0] = __builtin_amdgcn_mfma_f32_32x32x16_bf16(k3, v3, u[1][0], 0, 0, 0);
          u[1][1] = __builtin_amdgcn_mfma_f32_32x32x16_bf16(k0, w0, u[1][1], 0, 0, 0); u[1][1] = __builtin_amdgcn_mfma_f32_32x32x16_bf16(k1, w1, u[1][1], 0, 0, 0);
          u[1][1] = __builtin_amdgcn_mfma_f32_32x32x16_bf16(k2, w2, u[1][1], 0, 0, 0); u[1][1] = __builtin_amdgcn_mfma_f32_32x32x16_bf16(k3, w3, u[1][1], 0, 0, 0); }
        float* U = (float*)(p.ws + OFF_UA) + ((size_t)chain * 36 + c) * 4096;
#pragma unroll
        for (int kb = 0; kb < 2; ++kb)
#pragma unroll
            for (int d0 = 0; d0 < 2; ++d0)
#pragma unroll
                for (int r = 0; r < 16; ++r) U[(32 * kb + crow(r, hi)) * 64 + 32 * d0 + r32] = u[kb][d0][r];
    }
}
DEV void scanA_out(const Params& p, int layer, char* Lw, int bh, int tc, int lane) {
    using namespace scn;
    asm volatile("" : "+v"(lane));
    const int r32 = lane & 31, hi = lane >> 5, b = bh >> 2, h = bh & 3;
    const bf16_t* base = (const bf16_t*)(p.ws + OFF_PB) + (size_t)(b * SL + 64 * tc) * DP;
    unsigned lo = (unsigned)(r32 * DP + 8 * hi) * 2u;
    asm volatile("" : "+v"(lo));
    char* imgV = Lw; char* imgS = Lw + 8192;
    const int vbV = (int)(uintptr_t)imgV + att::v_rd_base(lane), vbS = vbV + 8192;
    stage64b(imgV, base + O_AI + h * 64, DP, lane);
    f32x16 o[2][2] = {};
#pragma unroll 1
    for (int dir = 0; dir < 2; ++dir) {
        const int chain = bh * 2 + dir, c = dir == 0 ? tc : (tc < 4 ? 3 - tc : 39 - tc);
        const float* S0g = (const float*)(p.ws + OFF_SA) + ((size_t)chain * 36 + c) * 4096;
        f32x16 pd0 = {}, pd1 = {}, px = {};
#define MM(acc, A, B) acc = __builtin_amdgcn_mfma_f32_32x32x16_bf16(A, B, acc, 0, 0, 0)
#define LOADX(ks) do { _Pragma("unroll") for (int tb = 0; tb < 2; ++tb) ld8(base + (dir ? O_AFB : O_AFF) + h * 64 + 16 * (ks), lo + tb * (32u * DP * 2u), xr[tb]); } while (0)
#define LOADQ(ks) do { _Pragma("unroll") for (int tb = 0; tb < 2; ++tb) ld8(base + O_AQ + h * 64 + 16 * (ks), lo + tb * (32u * DP * 2u), qr[tb]); } while (0)
        float xr[2][8], qr[2][8];
#define KSTEP(ks) do { \
            const int ch = 16 * (ks) + 8 * hi; \
            float cum[2][8], kk[2][8], ref[8], lb[8]; \
            { const float* l = (const float*)(p.ws + OFF_LB) + (layer * 2 + dir) * 256 + h * 64 + ch; _Pragma("unroll") for (int j = 0; j < 8; ++j) lb[j] = l[j]; } \
            const int ci = lane >> 2; const int row = 16 * (ks) + ci, c16 = (lane & 3) * 16; const float* sp = S0g + row * 64 + c16; \
            LOADX(ks); LOADQ(ks); decay_ks(xr, lb, dir, lane, cum, kk, ref); \
            const float4 sa = *(const float4*)sp, sb4 = *(const float4*)(sp + 4), sc4 = *(const float4*)(sp + 8), sd4 = *(const float4*)(sp + 12); \
              \
            { const int sj = ci & 7, sl = (ci >> 3) * 32; float rv = 0.f; \
              _Pragma("unroll") for (int j = 0; j < 8; ++j) { const float t = bperm(ref[j], sl); rv = (sj == j) ? t : rv; } \
              const float er = __expf(fmaxf(rv, -80.f)); \
              u32x4 w0 = {cvt_pk_bf16(sa.x * er, sa.y * er), cvt_pk_bf16(sa.z * er, sa.w * er), cvt_pk_bf16(sb4.x * er, sb4.y * er), cvt_pk_bf16(sb4.z * er, sb4.w * er)}; \
              u32x4 w1 = {cvt_pk_bf16(sc4.x * er, sc4.y * er), cvt_pk_bf16(sc4.z * er, sc4.w * er), cvt_pk_bf16(sd4.x * er, sd4.y * er), cvt_pk_bf16(sd4.z * er, sd4.w * er)}; \
              *(u32x4*)(imgS + v_st64(row, c16)) = w0; *(u32x4*)(imgS + v_st64(row, c16 + 8)) = w1; } \
            bf16x8 qt0, qt1, kt0, kt1; \
            _Pragma("unroll") for (int tb = 0; tb < 2; ++tb) { \
                float t1[8], t2[8]; \
                _Pragma("unroll") for (int j = 0; j < 8; ++j) { const float q = qr[tb][j] * fsig(qr[tb][j]); t1[j] = q * fexp(cum[tb][j] - ref[j]); t2[j] = kk[tb][j] * fexp(ref[j] - cum[tb][j]); } \
                if (tb == 0) { qt0 = pack8(t1); kt0 = pack8(t2); } else { qt1 = pack8(t1); kt1 = pack8(t2); } } \
            MM(pd0, kt0, qt0); MM(pd1, kt1, qt1); if (dir == 0) MM(px, kt0, qt1); else MM(px, kt1, qt0); \
            { const s16x4 l0 = att::tr_read<v_rd_off64(0, ks, 0)>(vbS), h0 = att::tr_read<v_rd_off64(0, ks, 1)>(vbS), l1 = att::tr_read<v_rd_off64(1, ks, 0)>(vbS), h1 = att::tr_read<v_rd_off64(1, ks, 1)>(vbS); \
              asm volatile("s_waitcnt lgkmcnt(0)" ::: "memory"); SBAR(); \
              const bf16x8 s0 = SCN_PK(l0, h0), s1 = SCN_PK(l1, h1); \
              MM(o[0][0], qt0, s0); MM(o[1][0], qt1, s0); MM(o[0][1], qt0, s1); MM(o[1][1], qt1, s1); } \
            SBAR(); } while (0)
        KSTEP(0); KSTEP(1); KSTEP(2); KSTEP(3);
#undef KSTEP
#undef LOADX
#undef LOADQ
        const int r32m = r32;
#pragma unroll
        for (int r = 0; r < 16; ++r) { const int sl = crow(r, hi); const bool keep = dir == 0 ? (sl <= r32m) : (sl >= r32m); pd0[r] = keep ? pd0[r] : 0.f; pd1[r] = keep ? pd1[r] : 0.f; }
        bf16x8 a0, a1, b0, b1, c0, c1;
#define PK4(P, BASE, OUT) do { unsigned a0_ = cvt_pk_bf16(P[BASE + 0], P[BASE + 1]), a1_ = cvt_pk_bf16(P[BASE + 2], P[BASE + 3]);   \
    unsigned b0_ = cvt_pk_bf16(P[BASE + 4], P[BASE + 5]), b1_ = cvt_pk_bf16(P[BASE + 6], P[BASE + 7]);                              \
    auto r0_ = __builtin_amdgcn_permlane32_swap(a0_, b0_, false, false); auto r1_ = __builtin_amdgcn_permlane32_swap(a1_, b1_, false, false); \
    u32x4 w_ = {r0_[0], r1_[0], r0_[1], r1_[1]}; OUT = *reinterpret_cast<bf16x8*>(&w_); } while (0)
        PK4(pd0, 0, a0); PK4(pd0, 8, a1); PK4(pd1, 0, b0); PK4(pd1, 8, b1); PK4(px, 0, c0); PK4(px, 8, c1);
#undef PK4
        {   bf16x8 v0, v1, v2, v3;
#define BLOCK(D0) do { frags4<D0>(vbV, v0, v1, v2, v3); \
            if (dir == 0) { MM(o[0][D0], a0, v0); MM(o[0][D0], a1, v1); MM(o[1][D0], c0, v0); MM(o[1][D0], c1, v1); MM(o[1][D0], b0, v2); MM(o[1][D0], b1, v3); } \
            else          { MM(o[0][D0], a0, v0); MM(o[0][D0], a1, v1); MM(o[0][D0], c0, v2); MM(o[0][D0], c1, v3); MM(o[1][D0], b0, v2); MM(o[1][D0], b1, v3); } } while (0)
            BLOCK(0); BLOCK(1);
#undef BLOCK
        }
#undef MM
    }
    unsigned rob = (unsigned)(4 * hi * DP + r32) * 2u, mob = (unsigned)(4 * hi * D + r32) * 2u;
    asm volatile("" : "+v"(rob), "+v"(mob));
    float gv[2][16][2];
#pragma unroll
    for (int tb = 0; tb < 2; ++tb)
#pragma unroll
        for (int r = 0; r < 16; ++r) { const unsigned go = rob + (unsigned)(32 * tb + (r & 3) + 8 * (r >> 2)) * (DP * 2u); const bf16_t* gb = base + O_AG + h * 64;
            gv[tb][r][0] = ld1(gb, go); gv[tb][r][1] = ld1(gb, go + 64u); }
#pragma unroll
    for (int tb = 0; tb < 2; ++tb)
#pragma unroll
        for (int r = 0; r < 16; ++r) {
            const float x0 = o[tb][0][r], x1 = o[tb][1][r];
            float t = x0 * x0 + x1 * x1; t += bperm(t, lane ^ 1); t += bperm(t, lane ^ 2); t += bperm(t, lane ^ 4); t += bperm(t, lane ^ 8); t += bperm(t, lane ^ 16);
            const float ri = rsqrtf(t * (1.f / 64.f) + 1e-6f);
            const unsigned tcst = (unsigned)(32 * tb + (r & 3) + 8 * (r >> 2));
            const float g0 = gv[tb][r][0], g1 = gv[tb][r][1];
            char* mb = (char*)((bf16_t*)(p.ws + OFF_MIXB) + (size_t)(b * SL + 64 * tc) * D + h * 64); const unsigned mo = mob + tcst * (D * 2u);
            *(bf16_t*)(mb + mo) = (bf16_t)(cvt_pk_bf16(x0 * ri * p.hnorm[layer * 64 + r32] * (g0 * fsig(g0)), 0.f) & 0xffffu);
            *(bf16_t*)(mb + mo + 64u) = (bf16_t)(cvt_pk_bf16(x1 * ri * p.hnorm[layer * 64 + 32 + r32] * (g1 * fsig(g1)), 0.f) & 0xffffu);
        }
}

namespace scn {
DEV float logsig_f(float g) { return fminf(g, 0.f) - __logf(1.f + __expf(-fabsf(g))); }
DEV void gates_B(const bf16_t* gb  , unsigned rowoff, int dir, float bi, float bf, int lane, float (&cumf)[2], float (&g)[2], float (&G)[2], float& cend, float& gmax) {
    float lf[2], li[2];
#pragma unroll
    for (int tb = 0; tb < 2; ++tb) { const unsigned bo = rowoff + tb * (32u * DP * 2u); li[tb] = ld1(gb + (dir * 2 + 0) * 4, bo) + bi; lf[tb] = logsig_f(ld1(gb + (dir * 2 + 1) * 4, bo) + bf); }
    { const float i0 = scan_inc32(lf[0]), i1 = scan_inc32(lf[1]), t0 = bperm(i0, lane | 31), t1 = bperm(i1, lane | 31);
      if (dir == 0) { cumf[0] = i0; cumf[1] = i1 + t0; } else { cumf[1] = t1 - i1 + lf[1]; cumf[0] = t0 - i0 + lf[0] + t1; }
      cend = t0 + t1; }
    g[0] = li[0] - cumf[0]; g[1] = li[1] - cumf[1];
    if (dir == 0) { const float a0 = scanmax_inc32(g[0]), m0 = bperm(a0, lane | 31), a1 = fmaxf(scanmax_inc32(g[1]), m0); G[0] = a0; G[1] = a1; gmax = bperm(a1, lane | 31); }
    else { const float a1 = scanmax_suf32(g[1], lane), m1 = bperm(a1, lane & 32), a0 = fmaxf(scanmax_suf32(g[0], lane), m1); G[0] = a0; G[1] = a1; gmax = bperm(a0, lane & 32); }
}
}
DEV void scanB_local(const Params& p, int layer, char* Lw, int bh, int tc, int lane) {
    using namespace scn;
    asm volatile("" : "+v"(lane));
    const int r32 = lane & 31, hi = lane >> 5, b = bh >> 2, h = bh & 3;
    const bf16_t* base = (const bf16_t*)(p.ws + OFF_PB) + (size_t)(b * SL + 64 * tc) * DP;
    unsigned ro = (unsigned)(r32 * DP) * 2u; asm volatile("" : "+v"(ro));
    char* imgV = Lw; char* imgK = Lw + 8192;
    const int vbV = (int)(uintptr_t)imgV + att::v_rd_base(lane), vbK = vbV + 8192;
    stage64b(imgV, base + O_BV + h * 64, DP, lane);
#pragma unroll 1
    for (int dir = 0; dir < 2; ++dir) {
        const int chain = bh * 2 + dir, c = dir == 0 ? tc : (tc < 4 ? 3 - tc : 39 - tc);
        const float bi = p.mgb[layer * 16 + (dir * 2 + 0) * 4 + h], bf = p.mgb[layer * 16 + (dir * 2 + 1) * 4 + h];
        float cumf[2], g[2], G[2], cend, gmax;
        gates_B(base + O_BG + h, ro, dir, bi, bf, lane, cumf, g, G, cend, gmax);
        const float w[2] = {__expf(g[0] - gmax), __expf(g[1] - gmax)};
#pragma unroll
        for (int ks = 0; ks < 2; ++ks) {
            float un[8];
#pragma unroll
            for (int j = 0; j < 8; ++j) un[j] = 0.f;
#pragma unroll
            for (int tb = 0; tb < 2; ++tb) { float wk[8]; ld8(base + O_BK + h * 32 + 16 * ks, ro + 16u * hi + tb * (32u * DP * 2u), wk);
#pragma unroll
                for (int j = 0; j < 8; ++j) { wk[j] *= w[tb]; un[j] += wk[j]; }
                *(bf16x8*)(imgK + v_st64(32 * tb + r32, 16 * ks + 8 * hi)) = pack8(wk); }
#pragma unroll
            for (int j = 0; j < 8; ++j) { float t = un[j]; t += bperm(t, lane ^ 1); t += bperm(t, lane ^ 2); t += bperm(t, lane ^ 4); t += bperm(t, lane ^ 8); t += bperm(t, lane ^ 16);
                if (r32 == 0) ((float*)(p.ws + OFF_NB))[(chain * 36 + c) * 32 + 16 * ks + 8 * hi + j] = t; }
        }
        f32x16 u0 = {}, u1 = {};
        { bf16x8 k0, k1, k2, k3, v0, v1, v2, v3;
#define MM(acc, A, B) acc = __builtin_amdgcn_mfma_f32_32x32x16_bf16(A, B, acc, 0, 0, 0)
          frags4<0>(vbK, k0, k1, k2, k3); frags4<0>(vbV, v0, v1, v2, v3);
          MM(u0, k0, v0); MM(u0, k1, v1); MM(u0, k2, v2); MM(u0, k3, v3);
          frags4<1>(vbV, v0, v1, v2, v3);
          MM(u1, k0, v0); MM(u1, k1, v1); MM(u1, k2, v2); MM(u1, k3, v3);
#undef MM
        }
        float* U = (float*)(p.ws + OFF_UB) + ((size_t)chain * 36 + c) * 2048;
#pragma unroll
        for (int r = 0; r < 16; ++r) { U[crow(r, hi) * 64 + r32] = u0[r]; U[crow(r, hi) * 64 + 32 + r32] = u1[r]; }
        if (lane == 0) { float* M = (float*)(p.ws + OFF_MB) + (chain * 36 + c) * 4; M[0] = cend + gmax; M[1] = cend; }
    }
}
DEV void scanB_out(const Params& p, int layer, char* Lw, int bh, int tc, int lane) {
    using namespace scn;
    asm volatile("" : "+v"(lane));
    const int r32 = lane & 31, hi = lane >> 5, b = bh >> 2, h = bh & 3;
    const bf16_t* base = (const bf16_t*)(p.ws + OFF_PB) + (size_t)(b * SL + 64 * tc) * DP;
    unsigned ro = (unsigned)(r32 * DP) * 2u; asm volatile("" : "+v"(ro));
    char* imgV = Lw; char* imgC = Lw + 8192; float* gA = (float*)(Lw + 12288); float* dA = gA + 64;
    const int vbV = (int)(uintptr_t)imgV + att::v_rd_base(lane), vbC = vbV + 8192;
    stage64b(imgV, base + O_BV + h * 64, DP, lane);
#pragma unroll 1
    for (int dir = 0; dir < 2; ++dir) {
        const int chain = bh * 2 + dir, c = dir == 0 ? tc : (tc < 4 ? 3 - tc : 39 - tc);
        const float bi = p.mgb[layer * 16 + (dir * 2 + 0) * 4 + h], bf = p.mgb[layer * 16 + (dir * 2 + 1) * 4 + h];
        { const float* cg = (const float*)(p.ws + OFF_SB) + ((size_t)chain * 36 + c) * 2048 + (lane >> 1) * 64 + (lane & 1) * 32;
#pragma unroll
          for (int i = 0; i < 4; ++i) { const float4 a = *(const float4*)(cg + 8 * i), bq = *(const float4*)(cg + 8 * i + 4);
              u32x4 w = {cvt_pk_bf16(a.x, a.y), cvt_pk_bf16(a.z, a.w), cvt_pk_bf16(bq.x, bq.y), cvt_pk_bf16(bq.z, bq.w)};
              *(u32x4*)(imgC + v_st64(lane >> 1, (lane & 1) * 32 + 8 * i)) = w; } }
        const float m0 = ((const float*)(p.ws + OFF_MB))[(chain * 36 + c) * 4 + 2];
        float rq[2][2][8], rk[2][2][8];
#pragma unroll
        for (int ks = 0; ks < 2; ++ks)
#pragma unroll
            for (int tb = 0; tb < 2; ++tb) { const unsigned bo = ro + 16u * hi + tb * (32u * DP * 2u);
                ld8(base + O_BQ + h * 32 + 16 * ks, bo, rq[ks][tb]); ld8(base + O_BK + h * 32 + 16 * ks, bo, rk[ks][tb]); }
        float cumf[2], g[2], G[2], cend, gmax;
        gates_B(base + O_BG + h, ro, dir, bi, bf, lane, cumf, g, G, cend, gmax);
        float wi[2], wl[2], emt[2];
#pragma unroll
        for (int tb = 0; tb < 2; ++tb) { const float ml = cumf[tb] + G[tb], mt = fmaxf(cumf[tb] + m0, ml); wi[tb] = __expf(cumf[tb] + m0 - mt); wl[tb] = __expf(ml - mt); emt[tb] = __expf(-mt); }
        if (hi == 0) { gA[r32] = g[0]; gA[32 + r32] = g[1]; }
        f32x16 pd0 = {}, pd1 = {}, px = {};
        float qn[2] = {0.f, 0.f};
        bf16x8 qw[2][2];
#define MM(acc, A, B) acc = __builtin_amdgcn_mfma_f32_32x32x16_bf16(A, B, acc, 0, 0, 0)
#define KSTEP(ks) do { \
            bf16x8 qs0, qs1, kt0, kt1; \
            const float* nn = (const float*)(p.ws + OFF_N0) + (chain * 36 + c) * 32 + 16 * (ks) + 8 * hi; \
            _Pragma("unroll") for (int tb = 0; tb < 2; ++tb) { \
                float q8[8], k8[8], qv[8]; \
                _Pragma("unroll") for (int j = 0; j < 8; ++j) { q8[j] = rq[ks][tb][j] * 0.17677669529663687f; k8[j] = rk[ks][tb][j]; qn[tb] += q8[j] * nn[j]; qv[j] = q8[j] * wi[tb]; } \
                qw[tb][ks] = pack8(qv); \
                if (tb == 0) { qs0 = pack8(q8); kt0 = pack8(k8); } else { qs1 = pack8(q8); kt1 = pack8(k8); } } \
            MM(pd0, kt0, qs0); MM(pd1, kt1, qs1); if (dir == 0) MM(px, kt0, qs1); else MM(px, kt1, qs0); \
            SBAR(); } while (0)
        KSTEP(0); KSTEP(1);
#undef KSTEP
        qn[0] += bperm(qn[0], lane ^ 32); qn[1] += bperm(qn[1], lane ^ 32);
        float ds[2] = {0.f, 0.f};
#pragma unroll
        for (int r = 0; r < 16; ++r) {
            const int sl = crow(r, hi); const bool keep = dir == 0 ? (sl <= r32) : (sl >= r32);
            const float g0 = gA[sl], g1 = gA[32 + sl];
            const float e00 = keep ? __expf(g0 - G[0]) * wl[0] : 0.f, e11 = keep ? __expf(g1 - G[1]) * wl[1] : 0.f;
            const float ex = dir == 0 ? __expf(g0 - G[1]) * wl[1] : __expf(g1 - G[0]) * wl[0];
            pd0[r] *= e00; pd1[r] *= e11; px[r] *= ex;
            if (dir == 0) { ds[0] += pd0[r]; ds[1] += pd1[r] + px[r]; } else { ds[0] += pd0[r] + px[r]; ds[1] += pd1[r]; }
        }
        ds[0] += bperm(ds[0], lane ^ 32); ds[1] += bperm(ds[1], lane ^ 32);
#pragma unroll
        for (int tb = 0; tb < 2; ++tb) { const float den = wi[tb] * qn[tb] + ds[tb]; const float di = __builtin_amdgcn_rcpf(fmaxf(fabsf(den), emt[tb])); if (hi == 0) dA[32 * tb + r32] = di; }
        bf16x8 a0, a1, b0, b1, c0, c1;
#define PK4(P, BASE, OUT) do { unsigned a0_ = cvt_pk_bf16(P[BASE + 0], P[BASE + 1]), a1_ = cvt_pk_bf16(P[BASE + 2], P[BASE + 3]);   \
    unsigned b0_ = cvt_pk_bf16(P[BASE + 4], P[BASE + 5]), b1_ = cvt_pk_bf16(P[BASE + 6], P[BASE + 7]);                              \
    auto r0_ = __builtin_amdgcn_permlane32_swap(a0_, b0_, false, false); auto r1_ = __builtin_amdgcn_permlane32_swap(a1_, b1_, false, false); \
    u32x4 w_ = {r0_[0], r1_[0], r0_[1], r1_[1]}; OUT = *reinterpret_cast<bf16x8*>(&w_); } while (0)
        PK4(pd0, 0, a0); PK4(pd0, 8, a1); PK4(pd1, 0, b0); PK4(pd1, 8, b1); PK4(px, 0, c0); PK4(px, 8, c1);
#undef PK4
        SBAR();
        f32x16 o[2][2] = {};
        {   bf16x8 v0, v1, v2, v3;
#define BLOCK(D0) do { frags4<D0>(vbV, v0, v1, v2, v3); \
            if (dir == 0) { MM(o[0][D0], a0, v0); MM(o[0][D0], a1, v1); MM(o[1][D0], c0, v0); MM(o[1][D0], c1, v1); MM(o[1][D0], b0, v2); MM(o[1][D0], b1, v3); } \
            else          { MM(o[0][D0], a0, v0); MM(o[0][D0], a1, v1); MM(o[0][D0], c0, v2); MM(o[0][D0], c1, v3); MM(o[1][D0], b0, v2); MM(o[1][D0], b1, v3); } \
            { const s16x4 l0 = att::tr_read<v_rd_off64(D0, 0, 0)>(vbC), h0 = att::tr_read<v_rd_off64(D0, 0, 1)>(vbC), l1 = att::tr_read<v_rd_off64(D0, 1, 0)>(vbC), h1 = att::tr_read<v_rd_off64(D0, 1, 1)>(vbC); \
              asm volatile("s_waitcnt lgkmcnt(0)" ::: "memory"); SBAR(); \
              const bf16x8 s0 = SCN_PK(l0, h0), s1 = SCN_PK(l1, h1); \
              MM(o[0][D0], qw[0][0], s0); MM(o[0][D0], qw[0][1], s1); MM(o[1][D0], qw[1][0], s0); MM(o[1][D0], qw[1][1], s1); } } while (0)
            BLOCK(0); BLOCK(1);
#undef BLOCK
        }
#undef MM
        asm volatile("s_waitcnt lgkmcnt(0)" ::: "memory");
        unsigned rob = (unsigned)(4 * hi * DP + r32) * 2u, mob = (unsigned)(4 * hi * D + r32) * 2u, hob = (unsigned)(4 * hi * 256 + r32) * 4u;
        asm volatile("" : "+v"(rob), "+v"(mob), "+v"(hob));
        float* hpk = (float*)(p.ws + OFF_HB2) + (size_t)(b * SL + 64 * tc) * 256 + h * 64;
        if (dir == 0) {
#pragma unroll
            for (int tb = 0; tb < 2; ++tb)
#pragma unroll
                for (int r = 0; r < 16; ++r) { const float di = dA[32 * tb + crow(r, hi)]; const unsigned ho = hob + (unsigned)(32 * tb + (r & 3) + 8 * (r >> 2)) * 1024u;
                    *(float*)((char*)hpk + ho) = o[tb][0][r] * di; *(float*)((char*)hpk + ho + 128u) = o[tb][1][r] * di; }
            asm volatile("s_waitcnt vmcnt(0)" ::: "memory");
        } else {
#pragma unroll
            for (int tb = 0; tb < 2; ++tb)
#pragma unroll
                for (int r = 0; r < 16; ++r) {
                    const unsigned tcst = (unsigned)(32 * tb + (r & 3) + 8 * (r >> 2)); const unsigned ho = hob + tcst * 1024u;
                    const float di = dA[32 * tb + crow(r, hi)];
                    const float x0 = o[tb][0][r] * di + ldg1(hpk, ho), x1 = o[tb][1][r] * di + ldg1(hpk, ho + 128u);
                    float t = x0 * x0 + x1 * x1; t += bperm(t, lane ^ 1); t += bperm(t, lane ^ 2); t += bperm(t, lane ^ 4); t += bperm(t, lane ^ 8); t += bperm(t, lane ^ 16);
                    const float ri = rsqrtf(t * (1.f / 64.f) + 1e-6f);
                    const bf16_t* gb = base + O_BO + h * 64; const unsigned go = rob + tcst * (DP * 2u);
                    const float g0 = ld1(gb, go), g1 = ld1(gb, go + 64u);
                    char* mb = (char*)((bf16_t*)(p.ws + OFF_MIXB) + (size_t)(b * SL + 64 * tc) * D + 256 + h * 64); const unsigned mo = mob + tcst * (D * 2u);
                    *(bf16_t*)(mb + mo) = (bf16_t)(cvt_pk_bf16(x0 * ri * p.mnorm[layer * 256 + h * 64 + r32] * fsig(g0), 0.f) & 0xffffu);
                    *(bf16_t*)(mb + mo + 64u) = (bf16_t)(cvt_pk_bf16(x1 * ri * p.mnorm[layer * 256 + h * 64 + 32 + r32] * fsig(g1), 0.f) & 0xffffu);
                    if ((r & 3) == 3) SBAR();
                }
        }
    }
}

DEV int scan_token(int dir, int step) { return dir == 0 ? step : (step < CTX ? CTX - 1 - step : SL + CTX - 1 - step); }
DEV float logsig(float g) { return fminf(g, 0.f) - log1pf(expf(-fabsf(g))); }
DEV void ph_scan_local(const Params& p, int layer, char* smem) {
    const int wid = p.wave_id;
    const int G = (int)gridDim.x, nw = G * 8, nun = (NT / 256) * (DP / 256), nleft = 4 * G < nun ? nun - 4 * G : 0, nfree = G - nleft > 0 ? G - nleft : G;
    for (int it = 0; it < 2; ++it) {
        int task;
        if (it == 0) task = (int)blockIdx.x * 8 + wid;
        else { if ((int)blockIdx.x >= nfree) break; task = nw + wid * nfree + (int)blockIdx.x; }
        if (task >= 2304) break;
        const int lane = lane_asm();
        if (task < 1152) scanA_local(p, layer, smem + wid * 16384, task / 36, task % 36, lane);
        else scanB_local(p, layer, smem + wid * 16384, (task - 1152) / 36, (task - 1152) % 36, lane);
    }
}
DEV void ph_scan_carry(const Params& p, char* smem) {
    const int tid = tid_of(p.wave_id);
    const int gt = (int)blockIdx.x * 512 + tid, nth = (int)gridDim.x * 512;
    for (int e = gt; e < 64 * 4096; e += nth) {
        const int chain = e >> 12, kv = e & 4095, k = kv >> 6;
        const float* U = (const float*)(p.ws + OFF_UA) + (size_t)chain * 36 * 4096 + kv; float* SO = (float*)(p.ws + OFF_SA) + (size_t)chain * 36 * 4096 + kv; const float* Dc = (const float*)(p.ws + OFF_DECA) + chain * 36 * 64 + k;
        float u[36], d[36];
#pragma unroll
        for (int c = 0; c < 36; ++c) { u[c] = U[(size_t)c * 4096]; d[c] = Dc[c * 64]; }
        float S = 0.f;
#pragma unroll
        for (int c = 0; c < 36; ++c) { SO[(size_t)c * 4096] = S; S = d[c] * S + u[c]; }
    }
    for (int e = gt; e < 64 * 2048; e += nth) {
        const int chain = e >> 11, kv = e & 2047;
        const float* U = (const float*)(p.ws + OFF_UB) + (size_t)chain * 36 * 2048 + kv; float* SO = (float*)(p.ws + OFF_SB) + (size_t)chain * 36 * 2048 + kv; const float* M = (const float*)(p.ws + OFF_MB) + chain * 36 * 4;
        float u[36], mle[36], ce[36];
#pragma unroll
        for (int c = 0; c < 36; ++c) { u[c] = U[(size_t)c * 2048]; mle[c] = M[c * 4 + 0]; ce[c] = M[c * 4 + 1]; }
        float Cc = 0.f, m = 0.f;
#pragma unroll
        for (int c = 0; c < 36; ++c) { SO[(size_t)c * 2048] = Cc;
            const float mn = fmaxf(ce[c] + m, mle[c]); Cc = expf(ce[c] + m - mn) * Cc + expf(mle[c] - mn) * u[c]; m = mn; }
    }
    for (int e = gt; e < 64 * 32; e += nth) {
        const int chain = e >> 5, k = e & 31;
        const float* N = (const float*)(p.ws + OFF_NB) + chain * 36 * 32 + k; float* NO = (float*)(p.ws + OFF_N0) + chain * 36 * 32 + k; float* M = (float*)(p.ws + OFF_MB) + chain * 36 * 4;
        float u[36], mle[36], ce[36];
#pragma unroll
        for (int c = 0; c < 36; ++c) { u[c] = N[c * 32]; mle[c] = M[c * 4 + 0]; ce[c] = M[c * 4 + 1]; }
        float nn = 0.f, m = 0.f;
#pragma unroll
        for (int c = 0; c < 36; ++c) { NO[c * 32] = nn; if (k == 0) M[c * 4 + 2] = m;
            const float mn = fmaxf(ce[c] + m, mle[c]); nn = expf(ce[c] + m - mn) * nn + expf(mle[c] - mn) * u[c]; m = mn; }
    }
}
DEV void ph_scan_out(const Params& p, int layer, char* smem) {
    const int wid = p.wave_id;
    const int nw = (int)gridDim.x * 8, ntc = layer == 0 ? 36 : 32, tc0 = layer == 0 ? 0 : 4, half = 32 * ntc, total = 2 * half;
    for (int it = 0; it < 2 + (total - nw > 0 ? (total - nw) / (int)gridDim.x : 0); ++it) {
        int task;
        if (it == 0) task = (int)blockIdx.x * 8 + wid;
        else { if (wid != 0) break; task = nw + (it - 1) * (int)gridDim.x + (int)blockIdx.x; }
        if (task >= total) break;
        const int lane = lane_asm();
        const bool isB = task >= half; const int tt = isB ? task - half : task, bh = tt / ntc, tc = tc0 + tt % ntc;
        if (!isB) scanA_out(p, layer, smem + wid * 16384, bh, tc, lane);
        else scanB_out(p, layer, smem + wid * 16384, bh, tc, lane);
    }
}

DEV void ph_attn(const Params& p, int layer, char* smem) {
    const int wid = p.wave_id, js = wid & 1, qb = wid >> 1;
    const float lam = ((const float*)(p.ws + OFF_LAM))[layer], omli = 1.f - lam_init_of(layer);
    const bf16_t* KB = (const bf16_t*)(p.ws + OFF_KB); const bf16_t* VB = (const bf16_t*)(p.ws + OFF_VB);
    const bf16_t* QRB = (const bf16_t*)(p.ws + OFF_QRB); const bf16_t* Q0B = (const bf16_t*)(p.ws + OFF_Q0B);
    const int G = (int)gridDim.x, c = (int)blockIdx.x;
    const int nlat = 512, ntot = nlat + (layer == 0 ? 64 : 0);
    for (int i = 0;; ++i) {
        int bh, s0; bool isctx;
        if (G == 256) {
            const int xcd = c & 7, j = c >> 3;
            if (i < 2) { bh = xcd + 8 * (i * 2 + (j >> 4)); s0 = CTX + (j & 15) * 128; isctx = false; }
            else if (i == 2 && layer == 0 && j < 8) { bh = xcd + 8 * (j >> 1); s0 = (j & 1) * 128; isctx = true; }
            else break;
        } else {
            const int u = i * G + c; if (u >= ntot) break;
            if (u < nlat) { bh = u >> 4; s0 = CTX + (u & 15) * 128; isctx = false; } else { const int v = u - nlat; bh = v >> 1; s0 = (v & 1) * 128; isctx = true; }
        }
        const int lane = lane_asm(), tid = (wid << 6) | lane, r32 = lane & 31, hi = lane >> 5;
        const bf16_t* Kh = KB + (size_t)bh * SL * 128; const bf16_t* Vh = VB + (size_t)bh * SL * 128;
        const size_t qoff = ((size_t)bh * SL + s0 + qb * 32 + r32) * 128 + js * 64 + hi * 8;
        att::bf16x8 qr[4];
#pragma unroll
        for (int d0 = 0; d0 < 4; ++d0) qr[d0] = *(const att::bf16x8*)(Q0B + qoff + d0 * 16);
        float m_reg = -1e30f, l_reg = 0.f; att::f32x16 o[4] = {};
        att::attn_tiles(qr, Kh, Vh, CTX, smem, m_reg, l_reg, o, tid, js);
        if (!isctx) {
#pragma unroll
            for (int d0 = 0; d0 < 4; ++d0) qr[d0] = *(const att::bf16x8*)(QRB + qoff + d0 * 16);
            att::attn_tiles(qr, Kh + (size_t)CTX * 128, Vh + (size_t)CTX * 128, SEQ, smem, m_reg, l_reg, o, tid, js);
        }
        float* wsw = (float*)(smem + 2 * att::SHM_V + 2 * att::SHM_K) + wid * 64;
        __syncthreads();
        if (hi == 0) wsw[r32] = l_reg;
        asm volatile("s_waitcnt lgkmcnt(0)" ::: "memory");
        float rli[16];
#pragma unroll
        for (int r = 0; r < 16; ++r) rli[r] = __builtin_amdgcn_rcpf(wsw[att::crow(r, hi)]);
        float* X = (float*)smem + qb * 4096;
        if (js == 1) {
#pragma unroll
            for (int d0 = 0; d0 < 4; ++d0)
#pragma unroll
                for (int r = 0; r < 16; ++r) X[(d0 * 16 + r) * 64 + lane] = o[d0][r] * rli[r];
        }
        __syncthreads();
        if (js == 0) {
            const int b = bh >> 2, h = bh & 3;
            float ss[16];
#pragma unroll
            for (int r = 0; r < 16; ++r) ss[r] = 0.f;
#pragma unroll
            for (int d0 = 0; d0 < 4; ++d0)
#pragma unroll
                for (int r = 0; r < 16; ++r) { const float v = o[d0][r] * rli[r] - lam * X[(d0 * 16 + r) * 64 + lane]; o[d0][r] = v; ss[r] += v * v; }
#pragma unroll
            for (int r = 0; r < 16; ++r) { float t = ss[r]; t += __shfl_xor(t, 1); t += __shfl_xor(t, 2); t += __shfl_xor(t, 4); t += __shfl_xor(t, 8); t += __shfl_xor(t, 16);
                ss[r] = rsqrtf(t * (1.f / 128.f) + 1e-6f) * omli; }
            bf16_t* Tq = (bf16_t*)X;
#pragma unroll
            for (int d0 = 0; d0 < 4; ++d0) { const float g = p.dnorm[layer * 128 + d0 * 32 + r32];
#pragma unroll
                for (int r = 0; r < 16; ++r) Tq[att::crow(r, hi) * 128 + d0 * 32 + r32] = (bf16_t)(cvt_pk_bf16(o[d0][r] * ss[r] * g, 0.f) & 0xffffu); }
            char* mixb = (char*)((bf16_t*)(p.ws + OFF_MIXB) + (size_t)(b * SL + s0 + qb * 32) * D + 512 + h * 128);
#pragma unroll
            for (int k = 0; k < 8; ++k) { const int idx = lane + 64 * k, row = idx >> 4, ch = idx & 15;
                *(pg8::u32x4*)(mixb + (size_t)row * (D * 2) + ch * 16) = *(const pg8::u32x4*)((const char*)Tq + row * 256 + ch * 16); }
        }
        __syncthreads();
    }
}

struct EpiRowsBf16 {
    static constexpr bool PERM = true;
    bf16_t* O; int ldc;
    DEV void operator()(const pg8::f32x4 (&acc)[2][2][4][2], const pg8::Unit& u, int wr, int wc, int fr, int fq) const {
        const int row0 = u.pm * 256 + wr * 64 + fr, col0 = u.pn * 256 + wc * 32 + 8 * fq;
#pragma unroll
        for (int ai = 0; ai < 2; ++ai)
#pragma unroll
            for (int m = 0; m < 4; ++m) { bf16_t* rowp = O + (size_t)(row0 + ai * 128 + m * 16) * ldc + col0;
#pragma unroll
                for (int bj = 0; bj < 2; ++bj) { const pg8::f32x4 v0 = acc[ai][bj][m][0], v1 = acc[ai][bj][m][1];
                    pg8::u32x4 w; w.x = cvt_pk_bf16(v0[0], v0[1]); w.y = cvt_pk_bf16(v0[2], v0[3]); w.z = cvt_pk_bf16(v1[0], v1[1]); w.w = cvt_pk_bf16(v1[2], v1[3]);
                    *(pg8::u32x4*)(rowp + bj * 128) = w; } }
    }
};
DEV void ph_outproj(const Params& p, int layer, char* smem) {
    const int tidx = tid_of(p.wave_id);
    pg8::StaticOrder S; S.init(layer == 0 ? NT / 256 : NB * 8, D / 256, (int)gridDim.x, (int)blockIdx.x, layer == 0 ? 0 : 1, (const bf16_t*)(p.ws + OFF_WOUT) + (size_t)layer * D * D, D);
    EpiRowsBf16 E{(bf16_t*)(p.ws + OFF_MIXO), D};
    pg8::gemm_phase((LAS unsigned char*)smem, (const char*)(p.ws + OFF_MIXB), D, S, E, tid_of(p.wave_id));
}
DEV void ph_norm2(const Params& p, int layer, char* smem) {
    typedef float f32x16 __attribute__((ext_vector_type(16)));
    const int wid = p.wave_id, lane = lane_asm(), tidx = (wid << 6) | lane;
    constexpr int XP = 1028, RP = 24;
    float* xs = (float*)smem;
    float* red = (float*)smem;
    int* hist = (int*)(smem + 32 * XP * 4);
    int* offl = hist + 32;
    int* sel = hist + 64;
    const float* nr = p.norms + (size_t)layer * 4 * D;
    if (tidx < NE) hist[tidx] = 0;
    const int chunk = (NT + (int)gridDim.x - 1) / (int)gridDim.x, rbeg = (int)blockIdx.x * chunk, rend = min(NT, rbeg + chunk);
    for (int i = tidx; i < chunk * 4; i += 512) sel[i] = -1;
    float4 cA[4], cB[4], cC[4]; int ckey = -1;
    float wreg[64];
    { const float* wb = p.rw + (size_t)layer * D * NE + (size_t)(wid * 128 + (lane >> 5)) * NE + (lane & 31);
#pragma unroll
      for (int ks = 0; ks < 64; ++ks) wreg[ks] = wb[(size_t)2 * ks * NE]; }
    for (int r0 = rbeg; r0 < rend; r0 += RP) {
        __syncthreads();
#pragma unroll 1
        for (int j = 0; j < 3; ++j) {
            const int lr = wid * 3 + j, r = r0 + lr;
            if (r >= rend) continue;
            const int b = r / SL, s = r % SL;
            if (layer != 0 && s < CTX) continue;
            float4 mo[4], xv[4], o[4]; row_load_bf((const bf16_t*)(p.ws + OFF_MIXO) + (size_t)r * D, mo, lane); row_load_bf((const bf16_t*)(p.ws + OFF_X) + (size_t)r * D, xv, lane);
            { const int key = s < CTX ? 8 : b;
              if (key != ckey) { ckey = key; const float* m = modrow(p, layer, b, s);
#pragma unroll
                  for (int i = 0; i < 4; ++i) { const int idx = i * 256 + lane * 4; const float4 g = *(const float4*)(nr + D + idx), gt = *(const float4*)(m + 2048 + idx), gn = *(const float4*)(nr + 2 * D + idx), sh = *(const float4*)(m + 3072 + idx), sc = *(const float4*)(m + 4096 + idx);
                      cA[i] = make_float4(g.x * gt.x, g.y * gt.y, g.z * gt.z, g.w * gt.w); cB[i] = make_float4(gn.x * (1.f + sc.x), gn.y * (1.f + sc.y), gn.z * (1.f + sc.z), gn.w * (1.f + sc.w)); cC[i] = sh; } } }
            const float ri = row_rinv(mo);
#pragma unroll
            for (int i = 0; i < 4; ++i) { xv[i].x += cA[i].x * (mo[i].x * ri); xv[i].y += cA[i].y * (mo[i].y * ri); xv[i].z += cA[i].z * (mo[i].z * ri); xv[i].w += cA[i].w * (mo[i].w * ri); }
            row_store_bf16((bf16_t*)(p.ws + OFF_XN) + (size_t)r * D, xv, lane);
            { const float rn = row_rinv(xv);
#pragma unroll
              for (int i = 0; i < 4; ++i) o[i] = make_float4(xv[i].x * rn * cB[i].x + cC[i].x, xv[i].y * rn * cB[i].y + cC[i].y, xv[i].z * rn * cB[i].z + cC[i].z, xv[i].w * rn * cB[i].w + cC[i].w); }
            row_store_fp8((unsigned char*)(p.ws + OFF_XNB) + (size_t)r * D, o, lane, F8_SX);
            row_store(xs + lr * XP, o, lane);
        }
        __syncthreads();
        f32x16 acc = {};
        { const float* xa = xs + (lane & 31) * XP + wid * 128 + (lane >> 5);
#pragma unroll
          for (int ks = 0; ks < 64; ++ks) acc = __builtin_amdgcn_mfma_f32_32x32x2f32(xa[2 * ks], wreg[ks], acc, 0, 0, 0); }
        __syncthreads();
#pragma unroll
        for (int rg = 0; rg < 16; ++rg) red[(wid * 32 + (rg & 3) + 8 * (rg >> 2) + 4 * (lane >> 5)) * 32 + (lane & 31)] = acc[rg];
        __syncthreads();
#pragma unroll 1
        for (int j = 0; j < 3; ++j) {
            const int lr = wid * 3 + j, r = r0 + lr;
            if (r >= rend) continue;
            const int s = r % SL;
            if (layer != 0 && s < CTX) continue;
            const int e = lane & 31;
            float logit = p.rb[layer * NE + e];
#pragma unroll
            for (int w = 0; w < 8; ++w) logit += red[(w * 32 + lr) * 32 + e];
            float tv[4]; int ti[4];
#pragma unroll
            for (int k = 0; k < 4; ++k) {
                float bv = logit; int bi = e;
                for (int o2 = 16; o2 >= 1; o2 >>= 1) { const float ov = __shfl_xor(bv, o2); const int oi = __shfl_xor(bi, o2); if (ov > bv || (ov == bv && oi < bi)) { bv = ov; bi = oi; } }
                tv[k] = bv; ti[k] = bi; if (e == bi) logit = -3.0e38f;
            }
            const float e0 = 1.f, e1 = expf(tv[1] - tv[0]), e2 = expf(tv[2] - tv[0]), e3 = expf(tv[3] - tv[0]), inv = 1.f / (e0 + e1 + e2 + e3);
            if (lane == 0) { *(float4*)(((float*)(p.ws + OFF_TOPW)) + (size_t)r * 4) = make_float4(e0 * inv, e1 * inv, e2 * inv, e3 * inv); *(int4*)(((int*)(p.ws + OFF_TOPI)) + (size_t)r * 4) = make_int4(ti[0], ti[1], ti[2], ti[3]); }
            if (lane < 4) { const int es = lane == 0 ? ti[0] : lane == 1 ? ti[1] : lane == 2 ? ti[2] : ti[3]; atomicAdd(&hist[es], 1); sel[(r - rbeg) * 4 + lane] = es; }
        }
    }
    __syncthreads();
    if (tidx < NE) { const int h = hist[tidx]; offl[tidx] = h ? (int)__hip_atomic_fetch_add((unsigned*)(p.ws + OFF_bar) + CW_CNT + layer * NE + tidx, (unsigned)h, __ATOMIC_RELAXED, __HIP_MEMORY_SCOPE_AGENT) : 0; }
    __syncthreads();
    for (int i = tidx; i < (rend - rbeg) * 4; i += 512) { const int e = sel[i];
        if (e >= 0) { const int pos = atomicAdd(&offl[e], 1); ((int*)(p.ws + OFF_LIST))[(size_t)e * LISTCAP + pos] = rbeg * 4 + i; } }
}
DEV int moe_rt(int i, int G, int c, int npn, int& pn) {
    if (G == 256) { const int xcd = c & 7, j = c >> 3, rpx = 32 / npn; pn = j % npn; return (i * 8 + xcd) * rpx + j / npn; }
    const int L = i * G + c; pn = L % npn; return L / npn;
}
constexpr int MOE_LDS = 131072, MOE_MAXU = 12;
DEV void moe_prepare(const Params& p, int layer, char* smem, int npn, int mode) {
    const int tidx = tid_of(p.wave_id);
    LAS int* base = (LAS int*)(smem + MOE_LDS);
    LAS int *TE = base, *TT = base + 320, *NRT = base + 640, *CN = base + 656  , *UI = base + 704, *IDX = base + 768;
    if (tidx < NE) CN[tidx] = ((const int*)(p.ws + OFF_bar))[CW_CNT + layer * NE + tidx];
    __syncthreads();
    if (tidx < 320) { int e = 0, acc = 0; for (; e < NE; ++e) { const int n = (CN[e] + 255) >> 8; if (tidx < acc + n) break; acc += n; } TE[tidx] = e; TT[tidx] = tidx - acc; }
    if (tidx == 0) { int tot = 0; for (int e = 0; e < NE; ++e) tot += (CN[e] + 255) >> 8; NRT[0] = tot; }
    __syncthreads();
    const int nrt = NRT[0];
#pragma unroll
    for (int k = 0; k < (MOE_MAXU * 256) / 512; ++k) {
        const int idx = tidx + 512 * k, i = idx >> 8, row = idx & 255;
        int pn; const int rt = moe_rt(i, (int)gridDim.x, (int)blockIdx.x, npn, pn);
        if (rt < nrt) { const int e = TE[rt], t = TT[rt], c = CN[e], q = t * 256 + row;
            const int pair = ((const int*)(p.ws + OFF_LIST))[(size_t)e * LISTCAP + min(q, c - 1)];
            IDX[idx] = mode == 1 ? (pair >> 2) : (q < c ? pair : -1); }
    }
    if (tidx < MOE_MAXU) { int pn; const int rt = moe_rt(tidx, (int)gridDim.x, (int)blockIdx.x, npn, pn);
        if (rt < nrt) { const int e = TE[rt], t = TT[rt], c = CN[e]; int pre = 0; for (int z = 0; z < e; ++z) pre += CN[z]; UI[tidx * 4 + 0] = min(256, c - t * 256); UI[tidx * 4 + 1] = pre + t * 256; } }
    __syncthreads();
}
struct MoeOrder {
    const LAS int *te, *ui, *idx; int nrt, npn, G, c, gather; const char* Bt; size_t bstride; int K;
    DEV bool next(int i, pg8::Unit& u) const { int pn; const int rt = moe_rt(i, G, c, npn, pn); if (rt >= nrt || i >= MOE_MAXU) return false;
        u.pm = rt; u.pn = pn; u.e = __builtin_amdgcn_readfirstlane(te[rt]); u.t = i; return true; }
    DEV int arow(const pg8::Unit& u, int rr) const { return gather ? idx[u.t * 256 + rr] : ui[u.t * 4 + 1] + rr; }
    DEV const char* bbase(const pg8::Unit& u) const { return Bt + (size_t)u.e * bstride + (size_t)u.pn * pg8::BM * K * 2; }
};
DEV float swiglu(float g, float l) { g = fminf(g, 7.f); l = fminf(fmaxf(l, -7.f), 7.f); return g * __builtin_amdgcn_rcpf(1.f + __builtin_amdgcn_exp2f(-1.702f * 1.4426950408889634f * g)) * (l + 1.f); }
struct EpiSwiglu {
    static constexpr bool PERM = true;
    unsigned char* H; const float* b1; const LAS int* ui;
    DEV void operator()(const pg8::f32x4 (&acc)[2][2][4][2], const pg8::Unit& u, int wr, int wc, int fr, int fq) const {
        const int ucnt = ui[u.t * 4 + 0], hrow0 = ui[u.t * 4 + 1], col0 = u.pn * 256 + wc * 32 + 8 * fq;
        const float* bb = b1 + (size_t)u.e * 2048 + col0;
        pg8::f32x4 bv[2][2];
#pragma unroll
        for (int bj = 0; bj < 2; ++bj)
#pragma unroll
            for (int n = 0; n < 2; ++n) bv[bj][n] = *(const pg8::f32x4*)(bb + bj * 128 + 4 * n);
        __builtin_amdgcn_s_waitcnt(0x0F70);
#pragma unroll
        for (int ai = 0; ai < 2; ++ai)
#pragma unroll
            for (int m = 0; m < 4; ++m) { const int rr = ai * 128 + wr * 64 + m * 16 + fr;
                if (rr < ucnt) { unsigned char* rowp = H + (size_t)(hrow0 + rr) * DFF + (col0 >> 1);
#pragma unroll
                    for (int bj = 0; bj < 2; ++bj) { constexpr float DS = 1.f / (F8_SX * F8_SW); const pg8::f32x4 v0 = acc[ai][bj][m][0] * DS + bv[bj][0], v1 = acc[ai][bj][m][1] * DS + bv[bj][1];
                        *(unsigned*)(rowp + bj * 64) = pk4_fp8(F8_SH * swiglu(v0[0], v0[1]), F8_SH * swiglu(v0[2], v0[3]), F8_SH * swiglu(v1[0], v1[1]), F8_SH * swiglu(v1[2], v1[3])); } } }
    }
};
struct EpiY {
    static constexpr bool PERM = true;
    unsigned char* Y; const LAS int* idx; const float* b2;
    DEV void operator()(const pg8::f32x4 (&acc)[2][2][4][2], const pg8::Unit& u, int wr, int wc, int fr, int fq) const {
        const int col0 = u.pn * 256 + wc * 32 + 8 * fq;
        const float* bb = b2 + (size_t)u.e * D + col0;
        pg8::f32x4 bv[2][2];
#pragma unroll
        for (int bj = 0; bj < 2; ++bj)
#pragma unroll
            for (int n = 0; n < 2; ++n) bv[bj][n] = *(const pg8::f32x4*)(bb + bj * 128 + 4 * n);
        __builtin_amdgcn_s_waitcnt(0x0F70);
#pragma unroll
        for (int ai = 0; ai < 2; ++ai)
#pragma unroll
            for (int m = 0; m < 4; ++m) { const int rr = ai * 128 + wr * 64 + m * 16 + fr; const int pair = idx[u.t * 256 + rr];
                if (pair >= 0) { unsigned char* rowp = Y + (size_t)pair * D + col0;
#pragma unroll
                    for (int bj = 0; bj < 2; ++bj) { constexpr float DS = 1.f / (F8_SH * F8_SW); const pg8::f32x4 v0 = acc[ai][bj][m][0] * DS + bv[bj][0], v1 = acc[ai][bj][m][1] * DS + bv[bj][1];
                        pg8::u32x2 w; w.x = pk4_fp8(v0[0] * F8_SY, v0[1] * F8_SY, v0[2] * F8_SY, v0[3] * F8_SY); w.y = pk4_fp8(v1[0] * F8_SY, v1[1] * F8_SY, v1[2] * F8_SY, v1[3] * F8_SY);
                        *(pg8::u32x2*)(rowp + bj * 128) = w; } } }
    }
};
DEV void ph_moe1(const Params& p, int layer, char* smem) {
    moe_prepare(p, layer, smem, 8, 1);
    LAS int* base = (LAS int*)(smem + MOE_LDS);
    MoeOrder S{base, base + 704, base + 768, base[640], 8, (int)gridDim.x, (int)blockIdx.x, 1, (const char*)(p.ws + OFF_W1T) + (size_t)layer * NE * 2048 * D, (size_t)2048 * D, D / 2};
    EpiSwiglu E{(unsigned char*)(p.ws + OFF_H), p.b1 + (size_t)layer * NE * 2048, base + 704};
    pg8::gemm_phase<EpiSwiglu, MoeOrder, true>((LAS unsigned char*)smem, (const char*)(p.ws + OFF_XNB), D / 2, S, E, tid_of(p.wave_id));
}
DEV void ph_moe2(const Params& p, int layer, char* smem) {
    moe_prepare(p, layer, smem, 4, 2);
    LAS int* base = (LAS int*)(smem + MOE_LDS);
    MoeOrder S{base, base + 704, base + 768, base[640], 4, (int)gridDim.x, (int)blockIdx.x, 0, (const char*)(p.ws + OFF_W2T) + (size_t)layer * NE * D * DFF, (size_t)D * DFF, DFF / 2};
    EpiY E{(unsigned char*)(p.ws + OFF_Y), base + 768, p.b2 + (size_t)layer * NE * D};
    pg8::gemm_phase<EpiY, MoeOrder, true>((LAS unsigned char*)smem, (const char*)(p.ws + OFF_H), DFF / 2, S, E, tid_of(p.wave_id));
}
DEV void ph_combine(const Params& p, int layer, char* smem) {
    const int wid = p.wave_id, lane = lane_asm();
    const float* nr = p.norms + (size_t)layer * 4 * D;
    const int total = layer == 0 ? NT : NB * SEQ, G = (int)gridDim.x, chunk = (total + G - 1) / G, qbeg = (int)blockIdx.x * chunk, qend = min(total, qbeg + chunk);
    float4 cA[4], cB[4], cC[4]; int ckey = -1;
    for (int q0 = qbeg + wid; q0 < qend; q0 += 16) {
        int rr[2]; bool ok[2]; float4 tw[2];
#pragma unroll
        for (int u = 0; u < 2; ++u) { const int q = q0 + u * 8; ok[u] = q < qend; const int qq = ok[u] ? q : q0;
            rr[u] = layer == 0 ? qq : (qq / SEQ) * SL + CTX + qq % SEQ;
            tw[u] = *(const float4*)(((float*)(p.ws + OFF_TOPW)) + (size_t)rr[u] * 4); }
        float4 f[2][4], xv[2][4];
#pragma unroll
        for (int u = 0; u < 2; ++u) {
            const int r = rr[u];
            const float w[4] = {tw[u].x * (1.f / F8_SY), tw[u].y * (1.f / F8_SY), tw[u].z * (1.f / F8_SY), tw[u].w * (1.f / F8_SY)};
#pragma unroll
            for (int i = 0; i < 4; ++i) f[u][i] = make_float4(0.f, 0.f, 0.f, 0.f);
#pragma unroll
            for (int k = 0; k < 4; ++k) {
                const unsigned char* y = (const unsigned char*)(p.ws + OFF_Y) + ((size_t)r * 4 + k) * D;
#pragma unroll
                for (int i = 0; i < 4; ++i) { const int idx = i * 256 + lane * 4; const int yb = *(const int*)(y + idx);
                    const auto lo = __builtin_amdgcn_cvt_pk_f32_fp8(yb, false), hi2 = __builtin_amdgcn_cvt_pk_f32_fp8(yb, true);
                    f[u][i].x += w[k] * lo[0]; f[u][i].y += w[k] * lo[1]; f[u][i].z += w[k] * hi2[0]; f[u][i].w += w[k] * hi2[1]; }
            }
            row_load_bf((const bf16_t*)(p.ws + OFF_XN) + (size_t)r * D, xv[u], lane);
        }
#pragma unroll
        for (int u = 0; u < 2; ++u) {
            const int r = rr[u], b = r / SL, s = r % SL;
            { const int key = s < CTX ? 8 : b;
              if (key != ckey) { ckey = key; const float* m = modrow(p, layer, b, s); const float* m1 = modrow(p, 1, b, s);
#pragma unroll
                  for (int i = 0; i < 4; ++i) { const int idx = i * 256 + lane * 4; const float4 g = *(const float4*)(nr + 3 * D + idx), gt = *(const float4*)(m + 5120 + idx);
                      cA[i] = make_float4(g.x * gt.x, g.y * gt.y, g.z * gt.z, g.w * gt.w);
                      if (layer == 0) { const float4 gn = *(const float4*)(p.norms + (size_t)4 * D + idx), sh = *(const float4*)(m1 + idx), sc = *(const float4*)(m1 + 1024 + idx);
                          cB[i] = make_float4(gn.x * (1.f + sc.x), gn.y * (1.f + sc.y), gn.z * (1.f + sc.z), gn.w * (1.f + sc.w)); cC[i] = sh; } } } }
            const float ri = row_rinv(f[u]);
#pragma unroll
            for (int i = 0; i < 4; ++i) { xv[u][i].x += cA[i].x * (f[u][i].x * ri); xv[u][i].y += cA[i].y * (f[u][i].y * ri); xv[u][i].z += cA[i].z * (f[u][i].z * ri); xv[u][i].w += cA[i].w * (f[u][i].w * ri); }
            if (ok[u]) {
                if (layer == 0) {
                    row_store_bf16((bf16_t*)(p.ws + OFF_X) + (size_t)r * D, xv[u], lane);
                    float4 o[4]; const float rn = row_rinv(xv[u]);
#pragma unroll
                    for (int i = 0; i < 4; ++i) o[i] = make_float4(xv[u][i].x * rn * cB[i].x + cC[i].x, xv[u][i].y * rn * cB[i].y + cC[i].y, xv[u][i].z * rn * cB[i].z + cC[i].z, xv[u][i].w * rn * cB[i].w + cC[i].w);
                    row_store_bf16((bf16_t*)(p.ws + OFF_XNB) + (size_t)r * D, o, lane);
                } else {
                    row_store(p.out + ((size_t)b * SEQ + (s - CTX)) * D, xv[u], lane);
                }
            }
        }
    }
}

template <int layer> DEV void run_layer(const Params& p, char* smem, const XcdBarrier& bar) {
#define GB() xcd_barrier(bar)

        ph_inproj(p, layer, smem, 0); GB();
        ph_inproj(p, layer, smem, 1); ph_scan_local(p, layer, smem); GB();
        ph_scan_carry(p, smem); ph_attn(p, layer, smem); GB();
        ph_scan_out(p, layer, smem); GB();
        ph_outproj(p, layer, smem); GB();
        ph_norm2(p, layer, smem); GB();
        ph_moe1(p, layer, smem); GB();
        ph_moe2(p, layer, smem); GB();
        ph_combine(p, layer, smem); GB();
    #undef GB
}
constexpr int LDS_BYTES = 147456;
__global__ __launch_bounds__(512, 2) void k_mega(Params p_in) {
    Params p = p_in; p.wave_id = __builtin_amdgcn_readfirstlane((int)(threadIdx.x >> 6));
    extern __shared__ __attribute__((aligned(16))) char smem[];
    volatile LAS unsigned* st = (volatile LAS unsigned*)(smem + LDS_BYTES - 16);
    if (threadIdx.x == 0) { st[0] = 0u; st[1] = 0u; st[2] = 0u; st[3] = 0u; }
    __syncthreads();
    const XcdBarrier bar = xcd_barrier_post(((unsigned*)(p.ws + OFF_bar)), st, p.wave_id);
#define GB() xcd_barrier(bar)
    ph_mods(p, smem); ph_convert(p, smem); GB();
    ph_init(p, smem); GB();
    run_layer<0>(p, smem, bar);
    run_layer<1>(p, smem, bar);
#undef GB
}
}

extern "C" void kernel_launch(void* const* d_in, const int* in_sizes, int n_in, void* d_out, int out_size, void* d_ws, size_t ws_size, hipStream_t stream) {
    static int grid = 0;
    if (grid == 0) {
        int dev = 0, cus = 0, per_cu = 0;
        if (hipGetDevice(&dev) != hipSuccess || hipDeviceGetAttribute(&cus, hipDeviceAttributeMultiprocessorCount, dev) != hipSuccess) { grid = -1; return; }
        if (hipFuncSetAttribute((const void*)k_mega, hipFuncAttributeMaxDynamicSharedMemorySize, LDS_BYTES) != hipSuccess) { grid = -1; return; }
        (void)hipOccupancyMaxActiveBlocksPerMultiprocessor(&per_cu, (const void*)k_mega, 512, LDS_BYTES);
        (void)hipGetLastError();
        grid = cus;
    }
    if (grid < 0) return;
    Params p{};
    const float** in = (const float**)&p;
    for (int i = 0; i < 21; ++i) in[i] = (const float*)d_in[i];
    p.out = (float*)d_out;
    p.ws = (char*)d_ws;
    if (WS_END > ws_size) return;
    if (hipMemsetAsync(p.ws + OFF_bar, 0, (size_t)CTL_BYTES, stream) != hipSuccess) return;
    hipLaunchKernelGGL(k_mega, dim3(grid), dim3(512), LDS_BYTES, stream, p);
}
```

```cpp
#include <hip/hip_runtime.h>
#include <stdint.h>

namespace {
constexpr int D = 1024, NB = 8, SEQ = 2048, CTX = 256, SL = 2304, NT = NB * SL;
constexpr int DP = 3840, DPW = 3600, NE = 32, DFF = 1024, NPAIR = NT * 4;
constexpr int O_AQ = 0, O_AI = 256, O_AFF = 512, O_AFB = 768, O_AG = 1024, O_BQ = 1280, O_BK = 1408, O_BV = 1536, O_BO = 1792, O_BG = 3584;
constexpr int LISTCAP = NT;

struct Params {
    const float *x, *c, *ctx, *c_ctx, *ada_w, *ada_b, *norms, *w_in, *w_out, *hlb, *hnorm, *mgb, *mnorm, *dlam, *dnorm, *rw, *rb, *w1, *b1, *w2, *b2;
    float* out;
    char* ws;
    int wave_id, pad_;
};
constexpr size_t al256(size_t x) { return (x + 255) & ~(size_t)255; }
constexpr size_t OFF_bar = 0;
constexpr size_t OFF_MOD = OFF_bar + 16384;
constexpr int CW_QHEAD = 3520, CW_CNT = 3584  , CTL_BYTES = 16384;
constexpr size_t OFF_LB = OFF_MOD + al256((size_t)2 * 9 * 6144 * 4);
constexpr size_t OFF_LAM = OFF_LB + al256(1024 * 4);
constexpr size_t OFF_CNT = OFF_LAM + 256;
constexpr size_t OFF_BC = OFF_CNT + 256;
constexpr size_t OFF_TOPW = OFF_BC + al256((size_t)1024 * NE * 4);
constexpr size_t OFF_TOPI = OFF_TOPW + al256((size_t)NPAIR * 4);
constexpr size_t OFF_LIST = OFF_TOPI + al256((size_t)NPAIR * 4);
constexpr size_t OFF_X = OFF_LIST + al256((size_t)NE * LISTCAP * 4);
constexpr size_t OFF_XN = OFF_X + al256((size_t)NT * D * 4);
constexpr size_t OFF_P = OFF_XN + al256((size_t)NT * D * 4);
constexpr size_t OFF_QR = OFF_P + al256((size_t)NT * DP * 4);
constexpr size_t OFF_KT = OFF_QR + al256((size_t)64 * SL * 64 * 4);
constexpr size_t OFF_OC = OFF_KT + al256((size_t)64 * SL * 64 * 4);
constexpr size_t OFF_MIX = OFF_OC + al256((size_t)32 * SL * 128 * 4);
constexpr size_t OFF_MIXO = OFF_MIX + al256((size_t)NT * D * 4);
constexpr size_t OFF_XNB = OFF_MIXO + al256((size_t)NT * D * 4);
constexpr size_t OFF_MIXB = OFF_XNB + al256((size_t)NT * D * 2);
constexpr size_t OFF_WIN = OFF_MIXB + al256((size_t)NT * D * 2);
constexpr size_t OFF_WOUT = OFF_WIN + al256((size_t)2 * DP * D * 2);
constexpr size_t OFF_W1T = OFF_WOUT + al256((size_t)2 * D * D * 2);
constexpr size_t OFF_W2T = OFF_W1T + al256((size_t)2 * NE * 2048 * D * 2);
constexpr size_t OFF_U = OFF_W2T + al256((size_t)2 * NE * D * DFF * 2);
constexpr size_t WS_END = OFF_U + al256((size_t)32 * SL * SL * 4);
constexpr size_t OFF_UA = OFF_U, OFF_DECA = OFF_UA + (size_t)64 * 36 * 4096 * 4, OFF_UB = OFF_DECA + (size_t)64 * 36 * 64 * 4, OFF_NB = OFF_UB + (size_t)64 * 36 * 2048 * 4,
                 OFF_MB = OFF_NB + (size_t)64 * 36 * 32 * 4, OFF_SCB = OFF_MB + (size_t)64 * 36 * 4 * 4,
                 OFF_OA2 = OFF_SCB + (size_t)2 * NT * 16 * 4, OFF_HB2 = OFF_OA2 + (size_t)NT * 256 * 4, OFF_SA = OFF_HB2 + (size_t)NT * 256 * 4, OFF_SB = OFF_SA + (size_t)64 * 36 * 4096 * 4,
                 OFF_N0 = OFF_SB + (size_t)64 * 36 * 2048 * 4;
constexpr size_t OFF_PB = OFF_P;
constexpr size_t OFF_ROPE = OFF_P + al256((size_t)NT * DP * 2);
constexpr size_t OFF_QRB = OFF_QR, OFF_Q0B = OFF_QR + (size_t)32 * SL * 128 * 2, OFF_KB = OFF_KT, OFF_VB = OFF_KT + (size_t)32 * SL * 128 * 2;
constexpr size_t OFF_S = OFF_U, OFF_H = OFF_U, OFF_Y = OFF_U + al256((size_t)(NPAIR + 256) * DFF * 2);
constexpr size_t OFF_OA = OFF_MIXO, OFF_HB = OFF_MIXO + (size_t)2 * NT * 256 * 4;


#define DEV __device__ __forceinline__
DEV int lane_asm() { int l; asm volatile("v_mbcnt_lo_u32_b32 %0, -1, 0\n\tv_mbcnt_hi_u32_b32 %0, -1, %0" : "=v"(l)); return l; }
DEV int tid_of(int wave_id) { return (wave_id << 6) | lane_asm(); }
template <int CTRL> DEV float dpp_mov(float v) { return __int_as_float(__builtin_amdgcn_update_dpp(0, __float_as_int(v), CTRL, 0xf, 0xf, true)); }
template <int CTRL> DEV int dpp_movi(int v) { return __builtin_amdgcn_update_dpp(0, v, CTRL, 0xf, 0xf, true); }
DEV float sum16(float v) { v += dpp_mov<0xB1>(v); v += dpp_mov<0x4E>(v); v += dpp_mov<0x141>(v); v += dpp_mov<0x140>(v); return v; }
DEV float sum32(float v) { v = sum16(v); const auto r = __builtin_amdgcn_permlane16_swap(__float_as_uint(v), __float_as_uint(v), false, false); return __uint_as_float(r[0]) + __uint_as_float(r[1]); }
DEV float wsum(float v) { v = sum32(v); const auto r = __builtin_amdgcn_permlane32_swap(__float_as_uint(v), __float_as_uint(v), false, false); return __uint_as_float(r[0]) + __uint_as_float(r[1]); }
DEV float wmaxf(float v) { v = fmaxf(v, dpp_mov<0xB1>(v)); v = fmaxf(v, dpp_mov<0x4E>(v)); v = fmaxf(v, dpp_mov<0x141>(v)); v = fmaxf(v, dpp_mov<0x140>(v));
    { const auto r = __builtin_amdgcn_permlane16_swap(__float_as_uint(v), __float_as_uint(v), false, false); v = fmaxf(__uint_as_float(r[0]), __uint_as_float(r[1])); }
    { const auto r = __builtin_amdgcn_permlane32_swap(__float_as_uint(v), __float_as_uint(v), false, false); v = fmaxf(__uint_as_float(r[0]), __uint_as_float(r[1])); } return v; }
DEV void amax_pick(float& bv, int& bi, float ov, int oi) { if (ov > bv || (ov == bv && oi < bi)) { bv = ov; bi = oi; } }
DEV void argmax32(float& bv, int& bi) {
    amax_pick(bv, bi, dpp_mov<0xB1>(bv), dpp_movi<0xB1>(bi)); amax_pick(bv, bi, dpp_mov<0x4E>(bv), dpp_movi<0x4E>(bi));
    amax_pick(bv, bi, dpp_mov<0x141>(bv), dpp_movi<0x141>(bi)); amax_pick(bv, bi, dpp_mov<0x140>(bv), dpp_movi<0x140>(bi));
    const auto rv = __builtin_amdgcn_permlane16_swap(__float_as_uint(bv), __float_as_uint(bv), false, false); const auto ri = __builtin_amdgcn_permlane16_swap((unsigned)bi, (unsigned)bi, false, false);
    bv = __uint_as_float(rv[0]); bi = (int)ri[0]; amax_pick(bv, bi, __uint_as_float(rv[1]), (int)ri[1]);
}
DEV float sigm(float x) { return 1.f / (1.f + expf(-x)); }
DEV float rdlane(float v, int l) { return __int_as_float(__builtin_amdgcn_readlane(__float_as_int(v), l)); }
DEV float lam_init_of(int layer) { return 0.8f - 0.6f * expf(-0.3f * (float)layer); }


#define XB_TMO      128
#define XB_XCNT(j)  (256  + 64 * (j))
#define XB_XSUB(j)  (1280 + 64 * (j))
#define XB_XGEN(j)  (2304 + 64 * (j))
#define XB_TOP      3328
#define XB_TOPGEN   3392
#define XCD_BAR_WORDS 3456
#define XB_SPIN_CAP (1u << 22)
#define LAS __attribute__((address_space(3)))
DEV unsigned xb_ld(unsigned* p)              { return __hip_atomic_load(p, __ATOMIC_RELAXED, __HIP_MEMORY_SCOPE_AGENT); }
DEV unsigned xb_add(unsigned* p, unsigned v) { return __hip_atomic_fetch_add(p, v, __ATOMIC_RELAXED, __HIP_MEMORY_SCOPE_AGENT); }
DEV unsigned xb_xcc_id() { return (unsigned)__builtin_amdgcn_s_getreg((3 << 11) | 20) & 0xFu; }
#define XB_SPIN(cond, bar) do { unsigned _sp = 0; while (cond) { __builtin_amdgcn_s_sleep(1); \
    if ((++_sp & 255u) == 0u) { if (xb_ld(&(bar)[XB_TMO])) break; if (_sp > XB_SPIN_CAP) { atomicAdd(&(bar)[XB_TMO], 1u); break; } } } } while (0)
struct XcdBarrier { unsigned* bar; unsigned x; volatile LAS unsigned* st; int wave; };
DEV bool xb_thread0(int wave) { return wave == 0 && lane_asm() == 0; }
DEV XcdBarrier xcd_barrier_post(unsigned* bar, volatile LAS unsigned* st, int wave) {
    XcdBarrier b; b.bar = bar; b.x = xb_xcc_id(); b.st = st; b.wave = wave;
    if (xb_thread0(wave)) (void)xb_add(&bar[XB_XCNT(b.x)], 1u);
    return b;
}
DEV void xcd_barrier_complete(unsigned* bar, unsigned x, unsigned& nloc, unsigned& nx) {
    const unsigned G = gridDim.x * gridDim.y * gridDim.z;
    unsigned sum, cnt, mine, sp = 0u;
    for (;;) {
        sum = 0u; cnt = 0u; mine = 0u;
#pragma unroll
        for (unsigned j = 0; j < 16; ++j) { const unsigned c = xb_ld(&bar[XB_XCNT(j)]); sum += c; cnt += (c > 0u) ? 1u : 0u; mine = (j == x) ? c : mine; }
        if (sum == G) break;
        __builtin_amdgcn_s_sleep(1);
        if ((++sp & 255u) == 0u) { if (xb_ld(&bar[XB_TMO])) break; if (sp > XB_SPIN_CAP) { atomicAdd(&bar[XB_TMO], 1u); break; } }
    }
    nloc = mine > 0u ? mine : 1u; nx = cnt > 0u ? cnt : 1u;
}
DEV void xcd_barrier(const XcdBarrier& b) {
    asm volatile("s_waitcnt vmcnt(0)" ::: "memory");
    __syncthreads();
    if (xb_thread0(b.wave)) {
        unsigned* bar = b.bar;
        __builtin_amdgcn_s_waitcnt(0);
        unsigned nloc = b.st[0], nx = b.st[1];
        if (nloc == 0u) { xcd_barrier_complete(bar, b.x, nloc, nx); b.st[0] = nloc; b.st[1] = nx; }
        const unsigned old = xb_add(&bar[XB_XSUB(b.x)], 1u);
        const unsigned gen = old / nloc;
        if (old + 1u == (gen + 1u) * nloc) {
            __builtin_amdgcn_fence(__ATOMIC_RELEASE, "agent");
            asm volatile("s_waitcnt vmcnt(0)" ::: "memory");
            const unsigned og = xb_add(&bar[XB_TOP], 1u);
            const unsigned tg = og / nx;
            if (og + 1u == (tg + 1u) * nx) xb_add(&bar[XB_TOPGEN], 1u);
            else XB_SPIN(xb_ld(&bar[XB_TOPGEN]) == tg, bar);
            __builtin_amdgcn_fence(__ATOMIC_ACQUIRE, "agent");
            xb_add(&bar[XB_XGEN(b.x)], 1u);
            asm volatile("s_waitcnt vmcnt(0)" ::: "memory");
        } else {
            XB_SPIN(xb_ld(&bar[XB_XGEN(b.x)]) == gen, bar);
            __builtin_amdgcn_fence(__ATOMIC_ACQUIRE, "agent");
            asm volatile("s_waitcnt vmcnt(0)" ::: "memory");
        }
    }
    __syncthreads();
}

typedef unsigned short bf16_t;
DEV unsigned cvt_pk_bf16(float lo, float hi) { unsigned r; asm volatile("v_cvt_pk_bf16_f32 %0, %1, %2" : "=v"(r) : "v"(lo), "v"(hi)); return r; }

namespace pg8 {
typedef short bf16x8 __attribute__((ext_vector_type(8)));
typedef float f32x4 __attribute__((ext_vector_type(4)));
typedef unsigned u32x4 __attribute__((ext_vector_type(4)));
typedef unsigned u32x2 __attribute__((ext_vector_type(2)));
constexpr int BM = 256, BK = 64, HALF = 128, HTB = HALF * BK * 2, STAGE_BYTES = 8 * HTB, NXCD = 8, WGM = 8;
DEV int lds_byte(int r, int c) { const int st = (r >> 4) * 2 + (c >> 5), rr = r & 15, cc = c & 31, ob = rr * 64 + cc * 2; return st * 1024 + (ob ^ (((ob >> 9) & 1) << 5)); }
DEV void stage_rc(int b, int& R, int& C) { const int st = b / 1024, sb = b % 1024, swz = sb ^ (((sb >> 9) & 1) << 5); R = (st >> 1) * 16 + swz / 64; C = (st & 1) * 32 + (swz % 64) / 2; }
DEV int perm32(int rho) { const int n = rho >> 4, i = rho & 15; return 8 * (i >> 2) + 4 * n + (i & 3); }
struct Unit { int pm, pn, e, t; };
struct StaticOrder {
    int nM, nN, nwg, G, c, skipctx; const char* Bt; int K;
    DEV void init(int nM_, int nN_, int G_, int c_, int skipctx_, const void* Bt_, int K_) { nM = nM_; nN = nN_; nwg = nM * nN; G = G_; c = c_; skipctx = skipctx_; Bt = (const char*)Bt_; K = K_; }
    DEV bool next(int i, Unit& u) const {
        const long L = (long)i * G + c; if (L >= nwg) return false;
        int wgid = (int)L; { const int q = nwg / NXCD, r = nwg % NXCD, xcd = wgid % NXCD, off = wgid / NXCD; wgid = (xcd < r ? xcd * (q + 1) : r * (q + 1) + (xcd - r) * q) + off; }
        const int nig = WGM * nN, gid = wgid / nig, fm = gid * WGM, gsz = (nM - fm) < WGM ? (nM - fm) : WGM;
        int pm = fm + ((wgid % nig) % gsz); u.pn = (wgid % nig) / gsz;
        if (skipctx) pm = (pm >> 3) * 9 + 1 + (pm & 7);
        u.pm = pm; u.e = 0; u.t = 0; return true;
    }
    DEV int arow(const Unit& u, int rr) const { return u.pm * BM + rr; }
    DEV const char* bbase(const Unit& u) const { return Bt + (size_t)u.pn * BM * K * 2; }
};
struct EpiF32 {
    static constexpr bool PERM = false;
    float* C; int ldc;
    DEV void operator()(const f32x4 (&acc)[2][2][4][2], const Unit& u, int wr, int wc, int fr, int fq) const {
        const int row0 = u.pm * BM + wr * 64 + fr, col0 = u.pn * BM + wc * 32 + 4 * fq;
#pragma unroll
        for (int ai = 0; ai < 2; ++ai)
#pragma unroll
            for (int m = 0; m < 4; ++m) { float* rowp = C + (size_t)(row0 + ai * HALF + m * 16) * ldc + col0;
#pragma unroll
                for (int bj = 0; bj < 2; ++bj)
#pragma unroll
                    for (int n = 0; n < 2; ++n) *(f32x4*)(rowp + bj * HALF + n * 16) = acc[ai][bj][m][n]; }
    }
};

typedef int i32x4 __attribute__((ext_vector_type(4)));
typedef int i32x8 __attribute__((ext_vector_type(8)));
DEV i32x8 cat8(bf16x8 a, bf16x8 b) { const i32x4 x = __builtin_bit_cast(i32x4, a), y = __builtin_bit_cast(i32x4, b); return __builtin_shufflevector(x, y, 0, 1, 2, 3, 4, 5, 6, 7); }
template <class Epi, class Sched, bool F8 = false>
DEV void gemm_phase(LAS unsigned char* lds, const char* Abase, const int K, const Sched& S, const Epi& E, const int tid) {
    const int wid = __builtin_amdgcn_readfirstlane(tid >> 6), lane = tid & 63, wr = wid >> 2, wc = wid & 3, fr = lane & 15, fq = lane >> 4;
    const int nt = K / BK;
    unsigned voffB[2];
#pragma unroll
    for (int i = 0; i < 2; ++i) { int R, C; stage_rc(tid * 16 + i * 8192, R, C); const int Rb = Epi::PERM ? ((R & ~31) + perm32(R & 31)) : R;
        voffB[i] = (unsigned)(Rb * BK + C) * 2u; }
    const size_t kstep = (size_t)(BK * 2);
    const size_t hstep = (size_t)HALF * K * 2;
    constexpr size_t kstepB = (size_t)BM * BK * 2, hstepB = (size_t)HALF * BK * 2;
    const unsigned ldsw = (unsigned)wid * 1024u;
    const int aoff = lds_byte(wr * 64 + fr, fq * 8), boff = lds_byte(wc * 32 + fr, fq * 8);
#define PG8_SA(b, h) (((b) * 2 + (h)) * HTB)
#define PG8_SB(b, h) ((4 + (b) * 2 + (h)) * HTB)
#define PG8_STAGE_B(bufoff, gbase) do { _Pragma("unroll") for (int _i = 0; _i < 2; ++_i) \
        __builtin_amdgcn_global_load_lds((const unsigned*)((const char*)(gbase) + voffB[_i]), (LAS unsigned*)(lds + (bufoff) + ldsw + _i * 8192), 16, 0, 0); } while (0)
#define PG8_STAGE_A(bufoff, kb, V, h) do { _Pragma("unroll") for (int _i = 0; _i < 2; ++_i) \
        __builtin_amdgcn_global_load_lds((const unsigned*)(Abase + (kb) + (V)[h][_i]), (LAS unsigned*)(lds + (bufoff) + ldsw + _i * 8192), 16, 0, 0); } while (0)
#define PG8_VOFFA(V, u) do { _Pragma("unroll") for (int _i = 0; _i < 2; ++_i) { int _R, _C; stage_rc(tid * 16 + _i * 8192, _R, _C); _Pragma("unroll") for (int _h = 0; _h < 2; ++_h) \
        (V)[_h][_i] = ((unsigned)S.arow(u, _h * HALF + _R) * (unsigned)K + (unsigned)_C) * 2u; } } while (0)
#define PG8_LDA(dst, b, h) do { _Pragma("unroll") for (int m = 0; m < 4; ++m) _Pragma("unroll") for (int k = 0; k < 2; ++k) dst[m][k] = *(const LAS bf16x8*)(lds + PG8_SA(b, h) + aoff + m * 2048 + k * 1024); } while (0)
#define PG8_LDB(dst, b, h) do { _Pragma("unroll") for (int n = 0; n < 2; ++n) _Pragma("unroll") for (int k = 0; k < 2; ++k) dst[n][k] = *(const LAS bf16x8*)(lds + PG8_SB(b, h) + boff + n * 2048 + k * 1024); } while (0)
#define PG8_MMA(ai, bj, At, Bt) do { __builtin_amdgcn_s_setprio(1); _Pragma("unroll") for (int m = 0; m < 4; ++m) _Pragma("unroll") for (int n = 0; n < 2; ++n) { \
        if constexpr (F8) asm volatile("v_mfma_f32_16x16x128_f8f6f4 %0, %1, %2, %0" : "+v"(acc[ai][bj][m][n]) : "v"(cat8(Bt[n][0], Bt[n][1])), "v"(cat8(At[m][0], At[m][1]))); \
        else { _Pragma("unroll") for (int k = 0; k < 2; ++k) acc[ai][bj][m][n] = __builtin_amdgcn_mfma_f32_16x16x32_bf16(Bt[n][k], At[m][k], acc[ai][bj][m][n], 0, 0, 0); } } __builtin_amdgcn_s_setprio(0); } while (0)
#define PG8_WAIT_V(n) asm volatile("s_waitcnt vmcnt(" #n ")" ::: "memory")
#define PG8_WAIT_L(n) asm volatile("s_waitcnt lgkmcnt(" #n ")" ::: "memory")
#define PG8_BAR __builtin_amdgcn_s_barrier()
#define PG8_SCHED __builtin_amdgcn_sched_barrier(0)
    Unit cur, nxt; int ui = 0;
    if (!S.next(0, cur)) return;
    f32x4 acc[2][2][4][2];
#pragma unroll
    for (int a = 0; a < 2; ++a)
#pragma unroll
        for (int b = 0; b < 2; ++b)
#pragma unroll
            for (int m = 0; m < 4; ++m)
#pragma unroll
                for (int n = 0; n < 2; ++n) acc[a][b][m][n] = (f32x4){0.f, 0.f, 0.f, 0.f};
    bf16x8 At[4][2], B0[2][2], B1[2][2];
    unsigned vc[2][2], v2[2][2];
    PG8_VOFFA(vc, cur);
    const char* cB = S.bbase(cur);
    PG8_STAGE_B(PG8_SB(0, 0), cB); PG8_STAGE_A(PG8_SA(0, 0), 0, vc, 0); PG8_STAGE_B(PG8_SB(0, 1), cB + hstepB); PG8_STAGE_A(PG8_SA(0, 1), 0, vc, 1);
    if (wr == 1) PG8_BAR;
    PG8_WAIT_V(4); PG8_BAR;
    PG8_STAGE_B(PG8_SB(1, 0), cB + kstepB); PG8_STAGE_A(PG8_SA(1, 0), kstep, vc, 0); PG8_STAGE_B(PG8_SB(1, 1), cB + hstepB + kstepB);
    PG8_WAIT_V(6); PG8_BAR;
    for (;;) {
        const bool has_next = S.next(ui + 1, nxt);
        const char* nB = has_next ? S.bbase(nxt) : cB;
        for (int t = 0; t < nt; t += 2) {
            const bool last = (t == nt - 2);
            const size_t k1 = (size_t)(t + 1) * kstep, k2 = last ? (size_t)0 : (size_t)(t + 2) * kstep, k3 = k2 + kstep;
            if (last && has_next) { PG8_VOFFA(v2, nxt); } else {
#pragma unroll
                for (int h = 0; h < 2; ++h)
#pragma unroll
                    for (int i = 0; i < 2; ++i) v2[h][i] = vc[h][i]; }
            const char* b2 = last ? nB : cB + (size_t)(t + 2) * kstepB; const char* b3 = b2 + kstepB;
            PG8_LDB(B0, 0, 0); PG8_SCHED; PG8_LDA(At, 0, 0); PG8_STAGE_A(PG8_SA(1, 1), k1, vc, 1);
            PG8_WAIT_L(8); PG8_BAR; PG8_WAIT_L(0); PG8_MMA(0, 0, At, B0); PG8_BAR; PG8_SCHED;
            PG8_LDB(B1, 0, 1); PG8_STAGE_B(PG8_SB(0, 0), b2);
            PG8_BAR; PG8_WAIT_L(0); PG8_MMA(0, 1, At, B1); PG8_BAR;
            PG8_LDA(At, 0, 1); PG8_STAGE_A(PG8_SA(0, 0), k2, v2, 0);
            PG8_BAR; PG8_WAIT_L(0); PG8_MMA(1, 0, At, B0); PG8_BAR; PG8_SCHED;
            PG8_STAGE_B(PG8_SB(0, 1), b2 + hstepB);
            PG8_WAIT_V(6); PG8_BAR; PG8_MMA(1, 1, At, B1); PG8_BAR;
            PG8_LDB(B0, 1, 0); PG8_SCHED; PG8_LDA(At, 1, 0); PG8_STAGE_A(PG8_SA(0, 1), k2, v2, 1);
            PG8_WAIT_L(8); PG8_BAR; PG8_WAIT_L(0); PG8_MMA(0, 0, At, B0); PG8_BAR; PG8_SCHED;
            PG8_LDB(B1, 1, 1); PG8_STAGE_B(PG8_SB(1, 0), b3);
            PG8_BAR; PG8_WAIT_L(0); PG8_MMA(0, 1, At, B1); PG8_BAR;
            PG8_LDA(At, 1, 1); PG8_STAGE_A(PG8_SA(1, 0), k3, v2, 0);
            PG8_BAR; PG8_WAIT_L(0); PG8_MMA(1, 0, At, B0); PG8_BAR; PG8_SCHED;
            PG8_STAGE_B(PG8_SB(1, 1), b3 + hstepB);
            PG8_WAIT_V(6); PG8_BAR; PG8_MMA(1, 1, At, B1); PG8_BAR;
        }
        if constexpr (F8) asm volatile("s_nop 15\n\ts_nop 15" ::: "memory");
        E(acc, cur, wr, wc, fr, fq);
        if (!has_next) break;
#pragma unroll
        for (int a = 0; a < 2; ++a)
#pragma unroll
            for (int b = 0; b < 2; ++b)
#pragma unroll
                for (int m = 0; m < 4; ++m)
#pragma unroll
                    for (int n = 0; n < 2; ++n) acc[a][b][m][n] = (f32x4){0.f, 0.f, 0.f, 0.f};
        cur = nxt; cB = nB; ++ui;
#pragma unroll
        for (int h = 0; h < 2; ++h)
#pragma unroll
            for (int i = 0; i < 2; ++i) vc[h][i] = v2[h][i];
    }
    PG8_WAIT_V(0);
    if (wr == 0) PG8_BAR;
    PG8_BAR;
#undef PG8_SA
#undef PG8_SB
#undef PG8_STAGE_A
#undef PG8_STAGE_B
#undef PG8_VOFFA
#undef PG8_LDA
#undef PG8_LDB
#undef PG8_MMA
#undef PG8_WAIT_V
#undef PG8_WAIT_L
#undef PG8_BAR
#undef PG8_SCHED
}
}


namespace att {
using bf16x8 = __attribute__((ext_vector_type(8))) short;
using s16x4  = __attribute__((ext_vector_type(4))) short;
using f32x16 = __attribute__((ext_vector_type(16))) float;
using u32x4  = __attribute__((ext_vector_type(4))) unsigned;
constexpr int KVBLK = 64, LDK = 128;
constexpr int SHM_V = KVBLK * 128 * 2, SHM_K = KVBLK * 128 * 2, SHM_ATTN = 2 * SHM_V + 2 * SHM_K + 8 * 64 * 4;
constexpr float THR = 8.f;
#define KSWZ(row, colB) ((row) * 256 + ((colB) ^ (((row) & 7) << 4)))
#define SBAR() __builtin_amdgcn_sched_barrier(0)
DEV int crow(int r, int hi) { return (r & 3) + 8 * (r >> 2) + 4 * hi; }
DEV void partialSM(f32x16& p0, f32x16& p1, float& m_reg, float& mn, float& alpha) {
  float pmax = p0[0]; for (int r = 1; r < 16; ++r) pmax = fmaxf(pmax, p0[r]); for (int r = 0; r < 16; ++r) pmax = fmaxf(pmax, p1[r]);
  { auto rr = __builtin_amdgcn_permlane32_swap(__float_as_uint(pmax), __float_as_uint(pmax), false, false);
    pmax = fmaxf(__uint_as_float(rr[0]), __uint_as_float(rr[1])); }
  if (__builtin_expect(__all(pmax - m_reg <= THR), 1)) { mn = m_reg; alpha = 1.f; }
  else { mn = fmaxf(m_reg, pmax); alpha = __builtin_amdgcn_exp2f(m_reg - mn); m_reg = mn; }
  for (int r = 0; r < 16; ++r) p0[r] = p0[r] - mn; for (int r = 0; r < 16; ++r) p1[r] = p1[r] - mn;
  for (int r = 0; r < 16; ++r) p0[r] = __builtin_amdgcn_exp2f(p0[r]);
}
DEV void finishSM(f32x16& p0, f32x16& p1, float alpha, float& l_reg, bf16x8& pa0, bf16x8& pa1, bf16x8& pa2, bf16x8& pa3) {
  for (int r = 0; r < 16; ++r) p1[r] = __builtin_amdgcn_exp2f(p1[r]);
  float ps = 0; for (int r = 0; r < 16; ++r) ps += p0[r]; for (int r = 0; r < 16; ++r) ps += p1[r];
  { auto rr = __builtin_amdgcn_permlane32_swap(__float_as_uint(ps), __float_as_uint(ps), false, false);
    ps = __uint_as_float(rr[0]) + __uint_as_float(rr[1]); }
  l_reg = l_reg * alpha + ps;
#define PK4(P, BASE, OUT) do { unsigned a0 = cvt_pk_bf16(P[BASE + 0], P[BASE + 1]), a1 = cvt_pk_bf16(P[BASE + 2], P[BASE + 3]);   \
    unsigned b0 = cvt_pk_bf16(P[BASE + 4], P[BASE + 5]), b1 = cvt_pk_bf16(P[BASE + 6], P[BASE + 7]);                              \
    auto r0 = __builtin_amdgcn_permlane32_swap(a0, b0, false, false); auto r1 = __builtin_amdgcn_permlane32_swap(a1, b1, false, false); \
    u32x4 w = {r0[0], r1[0], r0[1], r1[1]}; OUT = *reinterpret_cast<bf16x8*>(&w); } while (0)
  PK4(p0, 0, pa0); PK4(p0, 8, pa1); PK4(p1, 0, pa2); PK4(p1, 8, pa3);
#undef PK4
}
DEV void qkt(f32x16& p0, f32x16& p1, const char* Ks, const bf16x8 (&qr)[4], int r32, int hi, int js) {
  p0 = f32x16{}; p1 = f32x16{};
#pragma unroll
  for (int d0 = 0; d0 < 4; ++d0) { const int cb = ((js * 4 + d0) * 16 + hi * 8) * 2;
    bf16x8 b0 = *reinterpret_cast<const bf16x8*>(Ks + KSWZ(r32, cb));
    bf16x8 b1 = *reinterpret_cast<const bf16x8*>(Ks + KSWZ(32 + r32, cb));
    p0 = __builtin_amdgcn_mfma_f32_32x32x16_bf16(b0, qr[d0], p0, 0, 0, 0);
    p1 = __builtin_amdgcn_mfma_f32_32x32x16_bf16(b1, qr[d0], p1, 0, 0, 0); }
}
DEV int v_st(int k, int c) { const int kk = (k & ~0xC) | ((k & 4) << 1) | ((k & 8) >> 1); return ((kk >> 3) * 4 + (c >> 5)) * 512 + ((kk & 7) * 32 + (c & 31)) * 2; }
DEV int v_rd_base(int lane) { return ((lane & 3) << 3) | (((lane >> 2) & 3) << 6) | (((lane >> 4) & 1) << 5) | (((lane >> 5) & 1) << 8); }
constexpr int v_rd_off(int d0, int ks, int half) { return d0 * 512 + ks * 4096 + half * 2048; }
template <int OFF> DEV s16x4 tr_read(int vb) {
  s16x4 r; asm volatile("ds_read_b64_tr_b16 %0, %1 offset:%2" : "=&v"(r) : "v"(vb), "i"(OFF) : "memory"); return r;
}
template <int D0> DEV void pv_one(f32x16& od, int vb, bf16x8 pa0, bf16x8 pa1, bf16x8 pa2, bf16x8 pa3) {
  const s16x4 l0 = tr_read<v_rd_off(D0, 0, 0)>(vb), h0 = tr_read<v_rd_off(D0, 0, 1)>(vb), l1 = tr_read<v_rd_off(D0, 1, 0)>(vb), h1 = tr_read<v_rd_off(D0, 1, 1)>(vb);
  const s16x4 l2 = tr_read<v_rd_off(D0, 2, 0)>(vb), h2 = tr_read<v_rd_off(D0, 2, 1)>(vb), l3 = tr_read<v_rd_off(D0, 3, 0)>(vb), h3 = tr_read<v_rd_off(D0, 3, 1)>(vb);
  asm volatile("s_waitcnt lgkmcnt(0)" ::: "memory"); SBAR();
#define PK(L, H) (bf16x8){L[0], L[1], L[2], L[3], H[0], H[1], H[2], H[3]}
  od = __builtin_amdgcn_mfma_f32_32x32x16_bf16(pa0, PK(l0, h0), od, 0, 0, 0);
  od = __builtin_amdgcn_mfma_f32_32x32x16_bf16(pa1, PK(l1, h1), od, 0, 0, 0);
  od = __builtin_amdgcn_mfma_f32_32x32x16_bf16(pa2, PK(l2, h2), od, 0, 0, 0);
  od = __builtin_amdgcn_mfma_f32_32x32x16_bf16(pa3, PK(l3, h3), od, 0, 0, 0);
#undef PK
}
DEV void pv_d0(f32x16* o, int vb, bf16x8 pa0, bf16x8 pa1, bf16x8 pa2, bf16x8 pa3) {
  pv_one<0>(o[0], vb, pa0, pa1, pa2, pa3); pv_one<1>(o[1], vb, pa0, pa1, pa2, pa3); pv_one<2>(o[2], vb, pa0, pa1, pa2, pa3); pv_one<3>(o[3], vb, pa0, pa1, pa2, pa3);
}
DEV void attn_tiles(const bf16x8 (&qr)[4], const bf16_t* __restrict__ Kh, const bf16_t* __restrict__ Vh, int seq, char* lds,
                    float& m_reg, float& l_reg, f32x16 (&o)[4], int tid, int js) {
  const int wid = tid >> 6, lane = tid & 63, r32 = lane & 31, hi = lane >> 5;
  char* V_lds = lds; char* K_lds = lds + 2 * SHM_V;
  float* ws = (float*)(lds + 2 * SHM_V + 2 * SHM_K) + wid * 64; float* al_l = ws + 32;
  const int sr = tid >> 4, sc = (tid & 15) * 8, vst0 = v_st(sr, sc), vst1 = v_st(32 + sr, sc);
  const int vb0 = (int)(uintptr_t)V_lds + v_rd_base(lane);
  struct { bf16x8 vs0, vs1, ks0, ks1; } sr_[2];
  const unsigned lo0 = (unsigned)((sr * LDK + sc) * 2), lo1 = lo0 + 32u * LDK * 2u;
#define SLOAD(i, k0) do { const char* vb_ = (const char*)Vh + (size_t)(k0) * (LDK * 2); const char* kb_ = (const char*)Kh + (size_t)(k0) * (LDK * 2); \
    sr_[i].vs0 = *(const bf16x8*)(vb_ + lo0); sr_[i].vs1 = *(const bf16x8*)(vb_ + lo1); sr_[i].ks0 = *(const bf16x8*)(kb_ + lo0); sr_[i].ks1 = *(const bf16x8*)(kb_ + lo1); } while (0)
#define SWRITE(b, i) do { *(bf16x8*)(V_lds + (b) * SHM_V + vst0) = sr_[i].vs0;          \
    *(bf16x8*)(V_lds + (b) * SHM_V + vst1) = sr_[i].vs1; int kc = sc * 2;               \
    *(bf16x8*)(K_lds + (b) * SHM_K + KSWZ(sr, kc)) = sr_[i].ks0;                       \
    *(bf16x8*)(K_lds + (b) * SHM_K + KSWZ(32 + sr, kc)) = sr_[i].ks1; } while (0)
#define SWAIT() asm volatile("s_waitcnt vmcnt(4)" ::: "memory")
#define RESC(a) do { if (__any((a) < 1.f)) { if (hi == 0) al_l[r32] = (a); asm volatile("s_waitcnt lgkmcnt(0)" ::: "memory"); \
    for (int d = 0; d < 4; ++d) for (int r = 0; r < 16; ++r) o[d][r] *= al_l[crow(r, hi)]; } } while (0)
  f32x16 pA0, pA1, pB0, pB1; float mnA, mnB, alA, alB; bf16x8 pa0, pa1, pa2, pa3; const int NTL = seq / KVBLK;
  constexpr int SE = 0, SO = 1;
  __syncthreads();
  SLOAD(SE, 0); asm volatile("s_waitcnt vmcnt(0)" ::: "memory"); SWRITE(0, SE); __syncthreads();
  qkt(pA0, pA1, K_lds, qr, r32, hi, js); partialSM(pA0, pA1, m_reg, mnA, alA);
  SLOAD(SO, KVBLK); if (2 < NTL) SLOAD(SE, 2 * KVBLK);
  SWAIT(); SWRITE(1, SO); __syncthreads();
  RESC(alA);
  for (int j = 1; j + 1 < NTL; j += 2) {
    SBAR(); qkt(pB0, pB1, K_lds + SHM_K, qr, r32, hi, js);
    finishSM(pA0, pA1, alA, l_reg, pa0, pa1, pa2, pa3); SBAR();
    SLOAD(SO, (j + 2) * KVBLK); SBAR();
    pv_d0(o, vb0, pa0, pa1, pa2, pa3); partialSM(pB0, pB1, m_reg, mnB, alB);
    __syncthreads(); SWAIT(); SWRITE(0, SE);
    RESC(alB); __syncthreads();
    SBAR(); qkt(pA0, pA1, K_lds, qr, r32, hi, js);
    finishSM(pB0, pB1, alB, l_reg, pa0, pa1, pa2, pa3); SBAR();
    if (j + 3 < NTL) SLOAD(SE, (j + 3) * KVBLK); SBAR();
    pv_d0(o, vb0 + SHM_V, pa0, pa1, pa2, pa3); partialSM(pA0, pA1, m_reg, mnA, alA);
    __syncthreads(); SWAIT(); SWRITE(1, SO);
    RESC(alA); __syncthreads();
  }
  SBAR(); qkt(pB0, pB1, K_lds + SHM_K, qr, r32, hi, js);
  finishSM(pA0, pA1, alA, l_reg, pa0, pa1, pa2, pa3); SBAR();
  pv_d0(o, vb0, pa0, pa1, pa2, pa3); partialSM(pB0, pB1, m_reg, mnB, alB);
  __syncthreads(); RESC(alB);
  finishSM(pB0, pB1, alB, l_reg, pa0, pa1, pa2, pa3); SBAR();
  pv_d0(o, vb0 + SHM_V, pa0, pa1, pa2, pa3);
#undef SLOAD
#undef SWRITE
#undef SWAIT
#undef RESC
}
}

DEV void cvt_tile(const float* src, int ld, int nvalid, bf16_t* dst, int K, int n0, int k0, float* T, const int t, int ns0 = -1) {
    if (ns0 < 0) ns0 = n0;
#pragma unroll
    for (int h = 0; h < 2; ++h) {
        const int kk = (t >> 4) + 32 * h, nq = (t & 15) * 4, n = ns0 + nq;
        const float4 v = n < nvalid ? *(const float4*)(src + (size_t)(k0 + kk) * ld + n) : make_float4(0.f, 0.f, 0.f, 0.f);
        T[(nq + 0) * 65 + kk] = v.x; T[(nq + 1) * 65 + kk] = v.y; T[(nq + 2) * 65 + kk] = v.z; T[(nq + 3) * 65 + kk] = v.w;
    }
    __syncthreads();
    { const int n = t >> 3, kq = (t & 7) * 8; const float* r = T + n * 65 + kq;
      pg8::u32x4 w; w.x = cvt_pk_bf16(r[0], r[1]); w.y = cvt_pk_bf16(r[2], r[3]); w.z = cvt_pk_bf16(r[4], r[5]); w.w = cvt_pk_bf16(r[6], r[7]);
      *(pg8::u32x4*)(dst + (size_t)(n0 + n) * K + k0 + kq) = w; }
    __syncthreads();
}
DEV unsigned pk4_fp8(float a, float b, float c, float d) {
    a = __builtin_amdgcn_fmed3f(a, -448.f, 448.f); b = __builtin_amdgcn_fmed3f(b, -448.f, 448.f); c = __builtin_amdgcn_fmed3f(c, -448.f, 448.f); d = __builtin_amdgcn_fmed3f(d, -448.f, 448.f);
    int w = 0; w = __builtin_amdgcn_cvt_pk_fp8_f32(a, b, w, false); w = __builtin_amdgcn_cvt_pk_fp8_f32(c, d, w, true); return (unsigned)w;
}
constexpr float F8_SW = 1024.f  , F8_SX = 16.f  , F8_SH = 8.f  , F8_SY = 32.f  ;
DEV void cvt_tile4(const float* src, int ld, int nvalid, bf16_t* dst, int K, int n0, int k0, float* T, const int t, int ns0 = -1, bool f8 = false) {
    if (ns0 < 0) ns0 = n0;
    float4 v[4][2];
#pragma unroll
    for (int q = 0; q < 4; ++q)
#pragma unroll
        for (int h = 0; h < 2; ++h) { const int kk = (t >> 4) + 32 * h, n = ns0 + (t & 15) * 4;
            v[q][h] = n < nvalid ? *(const float4*)(src + (size_t)(k0 + q * 64 + kk) * ld + n) : make_float4(0.f, 0.f, 0.f, 0.f); }
#pragma unroll
    for (int q = 0; q < 4; ++q)
#pragma unroll
        for (int h = 0; h < 2; ++h) { const int kk = (t >> 4) + 32 * h, nq = (t & 15) * 4; float* Tq = T + q * (64 * 65);
            Tq[(nq + 0) * 65 + kk] = v[q][h].x; Tq[(nq + 1) * 65 + kk] = v[q][h].y; Tq[(nq + 2) * 65 + kk] = v[q][h].z; Tq[(nq + 3) * 65 + kk] = v[q][h].w; }
    __syncthreads();
#pragma unroll
    for (int q = 0; q < 4; ++q) { const int n = t >> 3, kq = (t & 7) * 8; const float* r = T + q * (64 * 65) + n * 65 + kq;
      if (f8) { pg8::u32x2 w; w.x = pk4_fp8(r[0] * F8_SW, r[1] * F8_SW, r[2] * F8_SW, r[3] * F8_SW); w.y = pk4_fp8(r[4] * F8_SW, r[5] * F8_SW, r[6] * F8_SW, r[7] * F8_SW);
          const int nn = n0 + n, kk = k0 + q * 64 + kq;
          *(pg8::u32x2*)((unsigned char*)dst + (size_t)(nn >> 8) * 256 * K + (size_t)(kk >> 7) * (256 * 128) + (nn & 255) * 128 + (kk & 127)) = w; }
      else { pg8::u32x4 w; w.x = cvt_pk_bf16(r[0], r[1]); w.y = cvt_pk_bf16(r[2], r[3]); w.z = cvt_pk_bf16(r[4], r[5]); w.w = cvt_pk_bf16(r[6], r[7]);
          const int nn = n0 + n, kk = k0 + q * 64 + kq;
          *(pg8::u32x4*)(dst + (size_t)(nn >> 8) * 256 * K + (size_t)(kk >> 6) * (256 * 64) + (nn & 255) * 64 + (kk & 63)) = w; } }
    __syncthreads();
}
DEV void ph_convert(const Params& p, char* smem) {
    const int tidx = tid_of(p.wave_id);
    float* T = (float*)(smem + 256);
    volatile int* msg = (volatile int*)smem;
    unsigned* qh = (unsigned*)(p.ws + OFF_bar) + CW_QHEAD;
    constexpr int T_IN = 2 * 60 * 4, T_OUT = 2 * 16 * 4, T_W1 = 64 * 32 * 4, T_W2 = 64 * 16 * 4;
    unsigned nxt = 0u;
    if (tidx == 0) nxt = xb_add(qh, 1u);
    for (;;) {
        __syncthreads();
        if (tidx == 0) msg[0] = (int)nxt;
        __syncthreads();
        const int u = msg[0];
        if (u >= T_IN + T_OUT + T_W1 + T_W2) break;
        if (tidx == 0) nxt = xb_add(qh, 1u);
        if (u < T_IN) { const int l = u / 240, r = u % 240, nt = r >> 2, kq = r & 3;
            const int n0 = nt * 64; int ns0, nv;
            if (n0 < 2048) { ns0 = n0; nv = DPW; } else if (n0 < 3584) { ns0 = n0 + 16; nv = DPW; } else if (n0 == 3584) { ns0 = 2048; nv = 2064; } else { ns0 = 0; nv = 0; }
            cvt_tile4(p.w_in + (size_t)l * D * DPW, DPW, nv, (bf16_t*)(p.ws + OFF_WIN) + (size_t)l * DP * D, D, n0, kq * 256, T, tidx, ns0); }
        else if (u < T_IN + T_OUT) { const int v = u - T_IN, l = v >> 6, r = v & 63, nt = r >> 2, kq = r & 3;
            cvt_tile4(p.w_out + (size_t)l * D * D, D, D, (bf16_t*)(p.ws + OFF_WOUT) + (size_t)l * D * D, D, nt * 64, kq * 256, T, tidx); }
        else if (u < T_IN + T_OUT + T_W1) { const int v = u - T_IN - T_OUT, le = v >> 7, r = v & 127, nt = r >> 2, kq = r & 3;
            cvt_tile4(p.w1 + (size_t)le * D * 2048, 2048, 2048, (bf16_t*)(p.ws + OFF_W1T + (size_t)le * 2048 * D), D, nt * 64, kq * 256, T, tidx, -1, true); }
        else { const int v = u - T_IN - T_OUT - T_W1, le = v >> 6, r = v & 63, nt = r >> 2, kq = r & 3;
            cvt_tile4(p.w2 + (size_t)le * DFF * D, D, D, (bf16_t*)(p.ws + OFF_W2T + (size_t)le * D * DFF), DFF, nt * 64, kq * 256, T, tidx, -1, true); }
    }
}

DEV void row_load(const float* src, float4 (&v)[4], int lane) {
#pragma unroll
    for (int i = 0; i < 4; ++i) v[i] = *(const float4*)(src + i * 256 + lane * 4);
}
DEV void row_store(float* dst, const float4 (&v)[4], int lane) {
#pragma unroll
    for (int i = 0; i < 4; ++i) *(float4*)(dst + i * 256 + lane * 4) = v[i];
}
DEV void row_store_bf16(bf16_t* dst, const float4 (&v)[4], int lane) {
#pragma unroll
    for (int i = 0; i < 4; ++i) { pg8::u32x2 w; w.x = cvt_pk_bf16(v[i].x, v[i].y); w.y = cvt_pk_bf16(v[i].z, v[i].w); *(pg8::u32x2*)(dst + i * 256 + lane * 4) = w; }
}
DEV void row_store_fp8(unsigned char* dst, const float4 (&v)[4], int lane, float sc) {
#pragma unroll
    for (int i = 0; i < 4; ++i) *(unsigned*)(dst + i * 256 + lane * 4) = pk4_fp8(v[i].x * sc, v[i].y * sc, v[i].z * sc, v[i].w * sc);
}
DEV void row_load_bf(const bf16_t* src, float4 (&v)[4], int lane) {
#pragma unroll
    for (int i = 0; i < 4; ++i) { const pg8::u32x2 w = *(const pg8::u32x2*)(src + i * 256 + lane * 4);
        v[i] = make_float4(__uint_as_float(w.x << 16), __uint_as_float(w.x & 0xffff0000u), __uint_as_float(w.y << 16), __uint_as_float(w.y & 0xffff0000u)); }
}
DEV float row_rinv(const float4 (&v)[4]) {
    float ss = 0.f;
#pragma unroll
    for (int i = 0; i < 4; ++i) ss += v[i].x * v[i].x + v[i].y * v[i].y + v[i].z * v[i].z + v[i].w * v[i].w;
    ss = wsum(ss);
    return rsqrtf(ss * (1.f / 1024.f) + 1e-6f);
}
DEV void row_modnorm(const float4 (&v)[4], const float* gain, const float* shift, const float* scale, float4 (&o)[4], int lane) {
    const float r = row_rinv(v);
#pragma unroll
    for (int i = 0; i < 4; ++i) {
        const int idx = i * 256 + lane * 4;
        const float4 g = *(const float4*)(gain + idx), sh = *(const float4*)(shift + idx), sc = *(const float4*)(scale + idx);
        o[i].x = v[i].x * r * g.x * (1.f + sc.x) + sh.x; o[i].y = v[i].y * r * g.y * (1.f + sc.y) + sh.y;
        o[i].z = v[i].z * r * g.z * (1.f + sc.z) + sh.z; o[i].w = v[i].w * r * g.w * (1.f + sc.w) + sh.w;
    }
}
DEV const float* modrow(const Params& p, int layer, int b, int s) { return ((float*)(p.ws + OFF_MOD)) + ((size_t)layer * 9 + (s < CTX ? 8 : b)) * 6144; }

DEV void ph_mods(const Params& p, char* smem) {
    const int tidx = tid_of(p.wave_id);
    float (*cond)[1024] = (float (*)[1024])smem;
    float (*red)[9][64] = (float (*)[9][64])(smem + 9 * 1024 * 4);
    const int tid = tidx;
    for (int i = tid; i < 9 * 1024; i += 512) { const int r = i >> 10, k = i & 1023; const float c = r < 8 ? p.c[r * 1024 + k] : p.c_ctx[k]; cond[r][k] = c * sigm(c); }
    __syncthreads();
    for (int u = blockIdx.x; u < 192; u += gridDim.x) {
        const int layer = u / 96, cg = u % 96, jj = tid & 63, ks = tid >> 6, j = cg * 64 + jj;
        float acc[9];
#pragma unroll
        for (int r = 0; r < 9; ++r) acc[r] = 0.f;
        const float* w = p.ada_w + (size_t)layer * 1024 * 6144 + j;
#pragma unroll 1
        for (int kb = ks * 128; kb < ks * 128 + 128; kb += 32) { float wv[32];
#pragma unroll
            for (int i = 0; i < 32; ++i) wv[i] = w[(size_t)(kb + i) * 6144];
#pragma unroll
            for (int i = 0; i < 32; ++i) {
#pragma unroll
                for (int r = 0; r < 9; ++r) acc[r] += cond[r][kb + i] * wv[i]; } }
#pragma unroll
        for (int r = 0; r < 9; ++r) red[ks][r][jj] = acc[r];
        __syncthreads();
        for (int t = tid; t < 9 * 64; t += 512) { const int r = t >> 6, q = t & 63; float s = 0.f; for (int z = 0; z < 8; ++z) s += red[z][r][q];
            ((float*)(p.ws + OFF_MOD))[((size_t)layer * 9 + r) * 6144 + cg * 64 + q] = s + p.ada_b[layer * 6144 + cg * 64 + q]; }
        __syncthreads();
    }
    if (blockIdx.x == (gridDim.x > 1 ? 1u : 0u)) {
        for (int t = tid; t < 1024; t += 512) { const int pos = t >> 4, i = t & 15; float sn, cs; sincosf((float)pos * expf(-(float)i * (1.f / 16.f) * 9.210340371976184f), &sn, &cs);
            ((float2*)(p.ws + OFF_ROPE))[t] = make_float2(cs, sn); }
    }
    if (blockIdx.x == 0) {
        for (int t = tid; t < 1024; t += 512) { const int layer = t >> 9, dir = (t >> 8) & 1, w = t & 255;
            const float t0 = p.hlb[(dir * 2 + 0) * 256 + w], t1 = p.hlb[(dir * 2 + 1) * 256 + w];
            const float mx = fmaxf(t0, t1), e0 = expf(t0 - mx), e1 = expf(t1 - mx);
            float lb = layer == 0 ? 0.f : e1 / (e0 + e1); lb = fminf(fmaxf(lb, 0.f), 1.f);
            ((float*)(p.ws + OFF_LB))[(layer * 2 + dir) * 256 + w] = lb; }
        if (tid < 128) { const int layer = tid >> 6, lane = tid & 63; const float* L = p.dlam + layer * 256;
            const float s1 = wsum(L[lane] * L[64 + lane]), s2 = wsum(L[128 + lane] * L[192 + lane]);
            if (lane == 0) ((float*)(p.ws + OFF_LAM))[layer] = expf(s1) - expf(s2) + lam_init_of(layer); }
    }
}

DEV void ph_init(const Params& p, char* smem) {
    const int tidx = tid_of(p.wave_id);
    const int wid = tidx >> 6, lane = tidx & 63;
    for (int r = blockIdx.x * 8 + wid; r < NT; r += gridDim.x * 8) {
        const int b = r / SL, s = r % SL;
        const float* src = s < CTX ? p.ctx + ((size_t)b * CTX + s) * D : p.x + ((size_t)b * SEQ + (s - CTX)) * D;
        float4 v[4], o[4]; row_load(src, v, lane); row_store_bf16((bf16_t*)(p.ws + OFF_X) + (size_t)r * D, v, lane);
        const float* m = modrow(p, 0, b, s);
        row_modnorm(v, p.norms + 0, m + 0, m + 1024, o, lane);
        row_store_bf16((bf16_t*)(p.ws + OFF_XNB) + (size_t)r * D, o, lane);
    }
}


struct EpiIn {
    static constexpr bool PERM = false;
    bf16_t *PB, *QRB, *Q0B, *KB, *VB; const float* CS;
    DEV void operator()(const pg8::f32x4 (&acc)[2][2][4][2], const pg8::Unit& u, int wr, int wc, int fr, int fq) const {
        using pg8::f32x4; using pg8::u32x2;
        const int pn = u.pn;
        if (pn < 8 || pn == 14) {
#pragma unroll
            for (int ai = 0; ai < 2; ++ai)
#pragma unroll
                for (int m = 0; m < 4; ++m) { bf16_t* rowp = PB + (size_t)(u.pm * 256 + ai * 128 + wr * 64 + m * 16 + fr) * DP + pn * 256 + wc * 32 + 4 * fq;
#pragma unroll
                    for (int bj = 0; bj < 2; ++bj)
#pragma unroll
                        for (int n = 0; n < 2; ++n) { const f32x4 v = acc[ai][bj][m][n]; u32x2 w; w.x = cvt_pk_bf16(v[0], v[1]); w.y = cvt_pk_bf16(v[2], v[3]); *(u32x2*)(rowp + bj * 128 + n * 16) = w; } }
        } else {
            const int kind = (pn - 8) >> 1, hb = ((pn - 8) & 1) * 2, b = u.pm / 9, tq = u.pm % 9, half = wc & 1, jsub = wc >> 1;
            const bool isctx = tq == 0;
            const float QC = 0.125f * 1.4426950408889634f;
#pragma unroll
            for (int ai = 0; ai < 2; ++ai)
#pragma unroll
                for (int m = 0; m < 4; ++m) {
                    const int s = tq * 256 + ai * 128 + wr * 64 + m * 16 + fr;
                    f32x4 c4 = {1.f, 1.f, 1.f, 1.f}, s4 = {0.f, 0.f, 0.f, 0.f};
                    if (kind != 2 && !isctx) { const int pos = half == 0 ? (tq - 1) * 4 + ai * 2 + wr : m * 16 + fr;
                        const f32x4 t0 = *(const f32x4*)(CS + (pos * 16 + 4 * fq) * 2), t1 = *(const f32x4*)(CS + (pos * 16 + 4 * fq) * 2 + 4);
                        c4 = (f32x4){t0[0], t0[2], t1[0], t1[2]}; s4 = (f32x4){t0[1], t0[3], t1[1], t1[3]}; }
#pragma unroll
                    for (int bj = 0; bj < 2; ++bj) {
                        const size_t dst = ((size_t)(b * 4 + hb + bj) * SL + s) * 128 + jsub * 64 + half * 32 + 4 * fq;
                        const f32x4 x1 = acc[ai][bj][m][0], x2 = acc[ai][bj][m][1];
#define ST4(ptr, v) do { u32x2 w_; w_.x = cvt_pk_bf16((v)[0], (v)[1]); w_.y = cvt_pk_bf16((v)[2], (v)[3]); *(u32x2*)(ptr) = w_; } while (0)
                        if (kind == 2) { ST4(VB + dst, x1); ST4(VB + dst + 16, x2); }
                        else {
                            const f32x4 o1 = x1 * c4 - x2 * s4, o2 = x1 * s4 + x2 * c4;
                            if (kind == 1) { ST4(KB + dst, o1); ST4(KB + dst + 16, o2); }
                            else { const f32x4 a1 = o1 * QC, a2 = o2 * QC, p1 = x1 * QC, p2 = x2 * QC; ST4(QRB + dst, a1); ST4(QRB + dst + 16, a2); ST4(Q0B + dst, p1); ST4(Q0B + dst + 16, p2); }
                        }
#undef ST4
                    }
                }
        }
    }
};

struct InOrder {
    int G, c, Lbeg, Lend; const char* Bt; int K;
    DEV bool next(int i, pg8::Unit& u) const {
        const int L = Lbeg + i * G + c; if (L >= Lend) return false;
        const int nN = L < 648 ? 9 : 6, l = L < 648 ? L : L - 648, nM = NT / 256, nwg = nM * nN;
        int wgid = l; { const int q = nwg / 8, r = nwg % 8, xcd = wgid % 8, off = wgid / 8; wgid = (xcd < r ? xcd * (q + 1) : r * (q + 1) + (xcd - r) * q) + off; }
        const int nig = 8 * nN, gid = wgid / nig, fm = gid * 8, gsz = (nM - fm) < 8 ? (nM - fm) : 8;
        const int pnl = (wgid % nig) / gsz;
        u.pm = fm + ((wgid % nig) % gsz); u.pn = L < 648 ? (pnl < 8 ? pnl : 14) : 8 + pnl; u.e = 0; u.t = 0; return true;
    }
    DEV int arow(const pg8::Unit& u, int rr) const { return u.pm * 256 + rr; }
    DEV const char* bbase(const pg8::Unit& u) const { return Bt + (size_t)u.pn * 256 * K * 2; }
};
DEV void ph_inproj(const Params& p, int layer, char* smem, int part) {
    const int tidx = tid_of(p.wave_id);
    const int G = (int)gridDim.x, nun = (NT / 256) * (DP / 256), cut = 4 * G < nun ? 4 * G : nun;
    const int nleft = nun - cut, cid = part == 0 ? (int)blockIdx.x : (int)blockIdx.x - (G - nleft);
    if (part == 1 && (nleft <= 0 || cid < 0)) return;
    InOrder S{G, cid, part == 0 ? 0 : cut, part == 0 ? cut : nun, (const char*)((const bf16_t*)(p.ws + OFF_WIN) + (size_t)layer * DP * D), D};
    EpiIn E{(bf16_t*)(p.ws + OFF_PB), (bf16_t*)(p.ws + OFF_QRB), (bf16_t*)(p.ws + OFF_Q0B), (bf16_t*)(p.ws + OFF_KB), (bf16_t*)(p.ws + OFF_VB), (const float*)(p.ws + OFF_ROPE)};
    pg8::gemm_phase(( LAS unsigned char*)smem, (const char*)(p.ws + OFF_XNB), D, S, E, tid_of(p.wave_id));
}


namespace scn {
using att::bf16x8; using att::s16x4; using att::f32x16; using att::u32x4; using att::crow;
DEV int v_st64(int k, int c) { const int kk = (k & ~0xC) | ((k & 4) << 1) | ((k & 8) >> 1); return ((kk >> 3) * 2 + (c >> 5)) * 512 + ((kk & 7) * 32 + (c & 31)) * 2; }
constexpr int v_rd_off64(int d0, int ks, int half) { return d0 * 512 + ks * 2048 + half * 1024; }
#define SCN_PK(L, H) (bf16x8){L[0], L[1], L[2], L[3], H[0], H[1], H[2], H[3]}
template <int D0> DEV void frags4(int vb, bf16x8& f0, bf16x8& f1, bf16x8& f2, bf16x8& f3) {
    const s16x4 l0 = att::tr_read<v_rd_off64(D0, 0, 0)>(vb), h0 = att::tr_read<v_rd_off64(D0, 0, 1)>(vb), l1 = att::tr_read<v_rd_off64(D0, 1, 0)>(vb), h1 = att::tr_read<v_rd_off64(D0, 1, 1)>(vb);
    const s16x4 l2 = att::tr_read<v_rd_off64(D0, 2, 0)>(vb), h2 = att::tr_read<v_rd_off64(D0, 2, 1)>(vb), l3 = att::tr_read<v_rd_off64(D0, 3, 0)>(vb), h3 = att::tr_read<v_rd_off64(D0, 3, 1)>(vb);
    asm volatile("s_waitcnt lgkmcnt(0)" ::: "memory"); SBAR();
    f0 = SCN_PK(l0, h0); f1 = SCN_PK(l1, h1); f2 = SCN_PK(l2, h2); f3 = SCN_PK(l3, h3);
}
DEV bf16x8 pack8(const float (&v)[8]) { u32x4 w = {cvt_pk_bf16(v[0], v[1]), cvt_pk_bf16(v[2], v[3]), cvt_pk_bf16(v[4], v[5]), cvt_pk_bf16(v[6], v[7])}; return *reinterpret_cast<bf16x8*>(&w); }
DEV void stage64(char* img, const float* src, size_t ld, int lane, float sc = 1.f) {
    const float* row = src + (size_t)lane * ld;
#pragma unroll
    for (int c8 = 0; c8 < 8; ++c8) { const float4 a = *(const float4*)(row + c8 * 8), b = *(const float4*)(row + c8 * 8 + 4);
        u32x4 w = {cvt_pk_bf16(a.x * sc, a.y * sc), cvt_pk_bf16(a.z * sc, a.w * sc), cvt_pk_bf16(b.x * sc, b.y * sc), cvt_pk_bf16(b.z * sc, b.w * sc)};
        *(u32x4*)(img + v_st64(lane, c8 * 8)) = w; }
}
template <int CTRL, int RM> DEV float dpp_f(float oldv, float v, bool bc) { return bc ? __builtin_bit_cast(float, __builtin_amdgcn_update_dpp(__builtin_bit_cast(int, oldv), __builtin_bit_cast(int, v), CTRL, RM, 0xf, true))
                                                                                   : __builtin_bit_cast(float, __builtin_amdgcn_update_dpp(__builtin_bit_cast(int, oldv), __builtin_bit_cast(int, v), CTRL, RM, 0xf, false)); }
DEV float bperm(float v, int src) { return __builtin_bit_cast(float, __builtin_amdgcn_ds_bpermute(src << 2, __builtin_bit_cast(int, v))); }
DEV float scan_inc32(float v) {
    v += dpp_f<0x111, 0xf>(0.f, v, true); v += dpp_f<0x112, 0xf>(0.f, v, true); v += dpp_f<0x114, 0xf>(0.f, v, true); v += dpp_f<0x118, 0xf>(0.f, v, true);
    v += dpp_f<0x142, 0xa>(0.f, v, false);
    return v;
}
DEV float scanmax_inc32(float v) {
    const float ni = -3.0e38f;
    v = fmaxf(v, dpp_f<0x111, 0xf>(ni, v, false)); v = fmaxf(v, dpp_f<0x112, 0xf>(ni, v, false)); v = fmaxf(v, dpp_f<0x114, 0xf>(ni, v, false)); v = fmaxf(v, dpp_f<0x118, 0xf>(ni, v, false));
    v = fmaxf(v, dpp_f<0x142, 0xa>(ni, v, false));
    return v;
}
DEV float scanmax_suf32(float v, int lane) {
    const float ni = -3.0e38f;
    v = fmaxf(v, dpp_f<0x101, 0xf>(ni, v, false)); v = fmaxf(v, dpp_f<0x102, 0xf>(ni, v, false)); v = fmaxf(v, dpp_f<0x104, 0xf>(ni, v, false)); v = fmaxf(v, dpp_f<0x108, 0xf>(ni, v, false));
    const float t = bperm(v, (lane & 32) | 16);
    return (lane & 16) ? v : fmaxf(v, t);
}
DEV void ld8(const bf16_t* ub, unsigned boff, float (&v)[8]) { const u32x4 w = *(const u32x4*)((const char*)ub + boff);
    v[0] = __uint_as_float(w.x << 16); v[1] = __uint_as_float(w.x & 0xffff0000u); v[2] = __uint_as_float(w.y << 16); v[3] = __uint_as_float(w.y & 0xffff0000u);
    v[4] = __uint_as_float(w.z << 16); v[5] = __uint_as_float(w.z & 0xffff0000u); v[6] = __uint_as_float(w.w << 16); v[7] = __uint_as_float(w.w & 0xffff0000u); }
DEV float ld1(const bf16_t* ub, unsigned boff) { return __uint_as_float((unsigned)(*(const unsigned short*)((const char*)ub + boff)) << 16); }
DEV void stage64b(char* img, const bf16_t* src, size_t ld, int lane) {
    const bf16_t* row = src + (size_t)lane * ld;
#pragma unroll
    for (int c8 = 0; c8 < 8; ++c8) *(u32x4*)(img + v_st64(lane, c8 * 8)) = *(const u32x4*)(row + c8 * 8);
}
DEV float4 ldg4(const float* ub, unsigned boff) { return *(const float4*)((const char*)ub + boff); }
DEV float ldg1(const float* ub, unsigned boff) { return *(const float*)((const char*)ub + boff); }
DEV float fexp(float x) { return __expf(fminf(fmaxf(x, -80.f), 80.f)); }
DEV float fsig(float x) { return __builtin_amdgcn_rcpf(1.f + __expf(-x)); }
DEV void decay_ks(const float (&x)[2][8], const float (&lb)[8], int dir, int lane, float (&cum)[2][8], float (&kk)[2][8], float (&ref)[8]) {
#pragma unroll
    for (int tb = 0; tb < 2; ++tb)
#pragma unroll
        for (int j = 0; j < 8; ++j) { const float sg = fsig(x[tb][j]); kk[tb][j] = (1.f - lb[j]) * (1.f - sg); cum[tb][j] = __logf(fmaxf(lb[j] + (1.f - lb[j]) * sg, 1e-12f)); }
#pragma unroll
    for (int j = 0; j < 8; ++j) {
        const float i0 = scan_inc32(cum[0][j]), i1 = scan_inc32(cum[1][j]), t0 = bperm(i0, lane | 31), t1 = bperm(i1, lane | 31);
        if (dir == 0) { cum[0][j] = i0; cum[1][j] = i1 + t0; ref[j] = t0; }
        else { const float x0 = cum[0][j], x1 = cum[1][j]; cum[1][j] = t1 - i1 + x1; cum[0][j] = t0 - i0 + x0 + t1; ref[j] = t1; }
        if ((j & 3) == 3) SBAR();
    }
}
}

DEV void scanA_local(const Params& p, int layer, char* Lw, int bh, int tc, int lane) {
    using namespace scn;
    asm volatile("" : "+v"(lane));
    const int r32 = lane & 31, hi = lane >> 5, b = bh >> 2, h = bh & 3;
    const bf16_t* base = (const bf16_t*)(p.ws + OFF_PB) + (size_t)(b * SL + 64 * tc) * DP;
    unsigned lo = (unsigned)(r32 * DP + 8 * hi) * 2u;
    asm volatile("" : "+v"(lo));
    char* imgV = Lw; char* imgK = Lw + 8192;
    const int vbV = (int)(uintptr_t)imgV + att::v_rd_base(lane), vbK = vbV + 8192;
    stage64b(imgV, base + O_AI + h * 64, DP, lane);
#pragma unroll 1
    for (int dir = 0; dir < 2; ++dir) {
        const int chain = bh * 2 + dir, c = dir == 0 ? tc : (tc < 4 ? 3 - tc : 39 - tc);
#pragma unroll 1
        for (int ks = 0; ks < 4; ++ks) {
            const int ch = 16 * ks + 8 * hi;
            float x[2][8], cum[2][8], kk[2][8], ref[8], lb[8];
#pragma unroll
            for (int tb = 0; tb < 2; ++tb) ld8(base + (dir ? O_AFB : O_AFF) + h * 64 + 16 * ks, lo + tb * (32u * DP * 2u), x[tb]);
            { const float* l = (const float*)(p.ws + OFF_LB) + (layer * 2 + dir) * 256 + h * 64 + ch;
#pragma unroll
              for (int j = 0; j < 8; ++j) lb[j] = l[j]; }
            decay_ks(x, lb, dir, lane, cum, kk, ref);
            float ke[8];
#pragma unroll
            for (int tb = 0; tb < 2; ++tb) {
#pragma unroll
                for (int j = 0; j < 8; ++j) { const float ce = dir == 0 ? bperm(cum[1][j], lane | 31) : bperm(cum[0][j], lane & 32);
                    ke[j] = kk[tb][j] * fexp(ce - cum[tb][j]);
                    if (tb == 1 && dir == 0 && r32 == 31) ((float*)(p.ws + OFF_DECA))[(chain * 36 + c) * 64 + ch + j] = __expf(ce);
                    if (tb == 0 && dir == 1 && r32 == 0) ((float*)(p.ws + OFF_DECA))[(chain * 36 + c) * 64 + ch + j] = __expf(ce); }
                *(bf16x8*)(imgK + v_st64(32 * tb + r32, ch)) = pack8(ke);
            }
            SBAR();
        }
        f32x16 u[2][2] = {};
        { bf16x8 k0, k1, k2, k3, v0, v1, v2, v3;
          frags4<0>(vbK, k0, k1, k2, k3); frags4<0>(vbV, v0, v1, v2, v3);
          u[0][0] = __builtin_amdgcn_mfma_f32_32x32x16_bf16(k0, v0, u[0][0], 0, 0, 0); u[0][0] = __builtin_amdgcn_mfma_f32_32x32x16_bf16(k1, v1, u[0][0], 0, 0, 0);
          u[0][0] = __builtin_amdgcn_mfma_f32_32x32x16_bf16(k2, v2, u[0][0], 0, 0, 0); u[0][0] = __builtin_amdgcn_mfma_f32_32x32x16_bf16(k3, v3, u[0][0], 0, 0, 0);
          bf16x8 w0, w1, w2, w3; frags4<1>(vbV, w0, w1, w2, w3);
          u[0][1] = __builtin_amdgcn_mfma_f32_32x32x16_bf16(k0, w0, u[0][1], 0, 0, 0); u[0][1] = __builtin_amdgcn_mfma_f32_32x32x16_bf16(k1, w1, u[0][1], 0, 0, 0);
          u[0][1] = __builtin_amdgcn_mfma_f32_32x32x16_bf16(k2, w2, u[0][1], 0, 0, 0); u[0][1] = __builtin_amdgcn_mfma_f32_32x32x16_bf16(k3, w3, u[0][1], 0, 0, 0);
          frags4<1>(vbK, k0, k1, k2, k3);
          u[1][0] = __builtin_amdgcn_mfma_f32_32x32x16_bf16(k0, v0, u[1][0], 0, 0, 0); u[1][0] = __builtin_amdgcn_mfma_f32_32x32x16_bf16(k1, v1, u[1][0], 0, 0, 0);
          u[1][0] = __builtin_amdgcn_mfma_f32_32x32x16_bf16(k2, v2, u[1][0], 0, 0, 0); u[1][0] = __builtin_amdgcn_mfma_f32_32x32x16_bf16(k3, v3, u[1][0], 0, 0, 0);
          u[1][1] = __builtin_amdgcn_mfma_f32_32x32x16_bf16(k0, w0, u[1][1], 0, 0, 0); u[1][1] = __builtin_amdgcn_mfma_f32_32x32x16_bf16(k1, w1, u[1][1], 0, 0, 0);
          u[1][1] = __builtin_amdgcn_mfma_f32_32x32x16_bf16(k2, w2, u[1][1], 0, 0, 0); u[1][1] = __builtin_amdgcn_mfma_f32_32x32x16_bf16(k3, w3, u[1][1], 0, 0, 0); }
        float* U = (float*)(p.ws + OFF_UA) + ((size_t)chain * 36 + c) * 4096;
#pragma unroll
        for (int kb = 0; kb < 2; ++kb)
#pragma unroll
            for (int d0 = 0; d0 < 2; ++d0)
#pragma unroll
                for (int r = 0; r < 16; ++r) U[(32 * kb + crow(r, hi)) * 64 + 32 * d0 + r32] = u[kb][d0][r];
    }
}
DEV void scanA_out(const Params& p, int layer, char* Lw, int bh, int tc, int lane) {
    using namespace scn;
    asm volatile("" : "+v"(lane));
    const int r32 = lane & 31, hi = lane >> 5, b = bh >> 2, h = bh & 3;
    const bf16_t* base = (const bf16_t*)(p.ws + OFF_PB) + (size_t)(b * SL + 64 * tc) * DP;
    unsigned lo = (unsigned)(r32 * DP + 8 * hi) * 2u;
    asm volatile("" : "+v"(lo));
    char* imgV = Lw; char* imgS = Lw + 8192;
    const int vbV = (int)(uintptr_t)imgV + att::v_rd_base(lane), vbS = vbV + 8192;
    stage64b(imgV, base + O_AI + h * 64, DP, lane);
    f32x16 o[2][2] = {};
#pragma unroll 1
    for (int dir = 0; dir < 2; ++dir) {
        const int chain = bh * 2 + dir, c = dir == 0 ? tc : (tc < 4 ? 3 - tc : 39 - tc);
        const float* S0g = (const float*)(p.ws + OFF_SA) + ((size_t)chain * 36 + c) * 4096;
        f32x16 pd0 = {}, pd1 = {}, px = {};
#define MM(acc, A, B) acc = __builtin_amdgcn_mfma_f32_32x32x16_bf16(A, B, acc, 0, 0, 0)
#define LOADX(ks) do { _Pragma("unroll") for (int tb = 0; tb < 2; ++tb) ld8(base + (dir ? O_AFB : O_AFF) + h * 64 + 16 * (ks), lo + tb * (32u * DP * 2u), xr[tb]); } while (0)
#define LOADQ(ks) do { _Pragma("unroll") for (int tb = 0; tb < 2; ++tb) ld8(base + O_AQ + h * 64 + 16 * (ks), lo + tb * (32u * DP * 2u), qr[tb]); } while (0)
        float xr[2][8], qr[2][8];
#define KSTEP(ks) do { \
            const int ch = 16 * (ks) + 8 * hi; \
            float cum[2][8], kk[2][8], ref[8], lb[8]; \
            { const float* l = (const float*)(p.ws + OFF_LB) + (layer * 2 + dir) * 256 + h * 64 + ch; _Pragma("unroll") for (int j = 0; j < 8; ++j) lb[j] = l[j]; } \
            const int ci = lane >> 2; const int row = 16 * (ks) + ci, c16 = (lane & 3) * 16; const float* sp = S0g + row * 64 + c16; \
            LOADX(ks); LOADQ(ks); decay_ks(xr, lb, dir, lane, cum, kk, ref); \
            const float4 sa = *(const float4*)sp, sb4 = *(const float4*)(sp + 4), sc4 = *(const float4*)(sp + 8), sd4 = *(const float4*)(sp + 12); \
              \
            { const int sj = ci & 7, sl = (ci >> 3) * 32; float rv = 0.f; \
              _Pragma("unroll") for (int j = 0; j < 8; ++j) { const float t = bperm(ref[j], sl); rv = (sj == j) ? t : rv; } \
              const float er = __expf(fmaxf(rv, -80.f)); \
              u32x4 w0 = {cvt_pk_bf16(sa.x * er, sa.y * er), cvt_pk_bf16(sa.z * er, sa.w * er), cvt_pk_bf16(sb4.x * er, sb4.y * er), cvt_pk_bf16(sb4.z * er, sb4.w * er)}; \
              u32x4 w1 = {cvt_pk_bf16(sc4.x * er, sc4.y * er), cvt_pk_bf16(sc4.z * er, sc4.w * er), cvt_pk_bf16(sd4.x * er, sd4.y * er), cvt_pk_bf16(sd4.z * er, sd4.w * er)}; \
              *(u32x4*)(imgS + v_st64(row, c16)) = w0; *(u32x4*)(imgS + v_st64(row, c16 + 8)) = w1; } \
            bf16x8 qt0, qt1, kt0, kt1; \
            _Pragma("unroll") for (int tb = 0; tb < 2; ++tb) { \
                float t1[8], t2[8]; \
                _Pragma("unroll") for (int j = 0; j < 8; ++j) { const float q = qr[tb][j] * fsig(qr[tb][j]); t1[j] = q * fexp(cum[tb][j] - ref[j]); t2[j] = kk[tb][j] * fexp(ref[j] - cum[tb][j]); } \
                if (tb == 0) { qt0 = pack8(t1); kt0 = pack8(t2); } else { qt1 = pack8(t1); kt1 = pack8(t2); } } \
            MM(pd0, kt0, qt0); MM(pd1, kt1, qt1); if (dir == 0) MM(px, kt0, qt1); else MM(px, kt1, qt0); \
            { const s16x4 l0 = att::tr_read<v_rd_off64(0, ks, 0)>(vbS), h0 = att::tr_read<v_rd_off64(0, ks, 1)>(vbS), l1 = att::tr_read<v_rd_off64(1, ks, 0)>(vbS), h1 = att::tr_read<v_rd_off64(1, ks, 1)>(vbS); \
              asm volatile("s_waitcnt lgkmcnt(0)" ::: "memory"); SBAR(); \
              const bf16x8 s0 = SCN_PK(l0, h0), s1 = SCN_PK(l1, h1); \
              MM(o[0][0], qt0, s0); MM(o[1][0], qt1, s0); MM(o[0][1], qt0, s1); MM(o[1][1], qt1, s1); } \
            SBAR(); } while (0)
        KSTEP(0); KSTEP(1); KSTEP(2); KSTEP(3);
#undef KSTEP
#undef LOADX
#undef LOADQ
        const int r32m = r32;
#pragma unroll
        for (int r = 0; r < 16; ++r) { const int sl = crow(r, hi); const bool keep = dir == 0 ? (sl <= r32m) : (sl >= r32m); pd0[r] = keep ? pd0[r] : 0.f; pd1[r] = keep ? pd1[r] : 0.f; }
        bf16x8 a0, a1, b0, b1, c0, c1;
#define PK4(P, BASE, OUT) do { unsigned a0_ = cvt_pk_bf16(P[BASE + 0], P[BASE + 1]), a1_ = cvt_pk_bf16(P[BASE + 2], P[BASE + 3]);   \
    unsigned b0_ = cvt_pk_bf16(P[BASE + 4], P[BASE + 5]), b1_ = cvt_pk_bf16(P[BASE + 6], P[BASE + 7]);                              \
    auto r0_ = __builtin_amdgcn_permlane32_swap(a0_, b0_, false, false); auto r1_ = __builtin_amdgcn_permlane32_swap(a1_, b1_, false, false); \
    u32x4 w_ = {r0_[0], r1_[0], r0_[1], r1_[1]}; OUT = *reinterpret_cast<bf16x8*>(&w_); } while (0)
        PK4(pd0, 0, a0); PK4(pd0, 8, a1); PK4(pd1, 0, b0); PK4(pd1, 8, b1); PK4(px, 0, c0); PK4(px, 8, c1);
#undef PK4
        {   bf16x8 v0, v1, v2, v3;
#define BLOCK(D0) do { frags4<D0>(vbV, v0, v1, v2, v3); \
            if (dir == 0) { MM(o[0][D0], a0, v0); MM(o[0][D0], a1, v1); MM(o[1][D0], c0, v0); MM(o[1][D0], c1, v1); MM(o[1][D0], b0, v2); MM(o[1][D0], b1, v3); } \
            else          { MM(o[0][D0], a0, v0); MM(o[0][D0], a1, v1); MM(o[0][D0], c0, v2); MM(o[0][D0], c1, v3); MM(o[1][D0], b0, v2); MM(o[1][D0], b1, v3); } } while (0)
            BLOCK(0); BLOCK(1);
#undef BLOCK
        }
#undef MM
    }
    unsigned rob = (unsigned)(4 * hi * DP + r32) * 2u, mob = (unsigned)(4 * hi * D + r32) * 2u;
    asm volatile("" : "+v"(rob), "+v"(mob));
    float gv[2][16][2];
#pragma unroll
    for (int tb = 0; tb < 2; ++tb)
#pragma unroll
        for (int r = 0; r < 16; ++r) { const unsigned go = rob + (unsigned)(32 * tb + (r & 3) + 8 * (r >> 2)) * (DP * 2u); const bf16_t* gb = base + O_AG + h * 64;
            gv[tb][r][0] = ld1(gb, go); gv[tb][r][1] = ld1(gb, go + 64u); }
#pragma unroll
    for (int tb = 0; tb < 2; ++tb)
#pragma unroll
        for (int r = 0; r < 16; ++r) {
            const float x0 = o[tb][0][r], x1 = o[tb][1][r];
            float t = x0 * x0 + x1 * x1; t = sum32(t);
            const float ri = rsqrtf(t * (1.f / 64.f) + 1e-6f);
            const unsigned tcst = (unsigned)(32 * tb + (r & 3) + 8 * (r >> 2));
            const float g0 = gv[tb][r][0], g1 = gv[tb][r][1];
            char* mb = (char*)((bf16_t*)(p.ws + OFF_MIXB) + (size_t)(b * SL + 64 * tc) * D + h * 64); const unsigned mo = mob + tcst * (D * 2u);
            *(bf16_t*)(mb + mo) = (bf16_t)(cvt_pk_bf16(x0 * ri * p.hnorm[layer * 64 + r32] * (g0 * fsig(g0)), 0.f) & 0xffffu);
            *(bf16_t*)(mb + mo + 64u) = (bf16_t)(cvt_pk_bf16(x1 * ri * p.hnorm[layer * 64 + 32 + r32] * (g1 * fsig(g1)), 0.f) & 0xffffu);
        }
}

namespace scn {
DEV float logsig_f(float g) { return fminf(g, 0.f) - __logf(1.f + __expf(-fabsf(g))); }
DEV void gates_B(const bf16_t* gb  , unsigned rowoff, int dir, float bi, float bf, int lane, float (&cumf)[2], float (&g)[2], float (&G)[2], float& cend, float& gmax) {
    float lf[2], li[2];
#pragma unroll
    for (int tb = 0; tb < 2; ++tb) { const unsigned bo = rowoff + tb * (32u * DP * 2u); li[tb] = ld1(gb + (dir * 2 + 0) * 4, bo) + bi; lf[tb] = logsig_f(ld1(gb + (dir * 2 + 1) * 4, bo) + bf); }
    { const float i0 = scan_inc32(lf[0]), i1 = scan_inc32(lf[1]), t0 = bperm(i0, lane | 31), t1 = bperm(i1, lane | 31);
      if (dir == 0) { cumf[0] = i0; cumf[1] = i1 + t0; } else { cumf[1] = t1 - i1 + lf[1]; cumf[0] = t0 - i0 + lf[0] + t1; }
      cend = t0 + t1; }
    g[0] = li[0] - cumf[0]; g[1] = li[1] - cumf[1];
    if (dir == 0) { const float a0 = scanmax_inc32(g[0]), m0 = bperm(a0, lane | 31), a1 = fmaxf(scanmax_inc32(g[1]), m0); G[0] = a0; G[1] = a1; gmax = bperm(a1, lane | 31); }
    else { const float a1 = scanmax_suf32(g[1], lane), m1 = bperm(a1, lane & 32), a0 = fmaxf(scanmax_suf32(g[0], lane), m1); G[0] = a0; G[1] = a1; gmax = bperm(a0, lane & 32); }
}
}
DEV void scanB_local(const Params& p, int layer, char* Lw, int bh, int tc, int lane) {
    using namespace scn;
    asm volatile("" : "+v"(lane));
    const int r32 = lane & 31, hi = lane >> 5, b = bh >> 2, h = bh & 3;
    const bf16_t* base = (const bf16_t*)(p.ws + OFF_PB) + (size_t)(b * SL + 64 * tc) * DP;
    unsigned ro = (unsigned)(r32 * DP) * 2u; asm volatile("" : "+v"(ro));
    char* imgV = Lw; char* imgK = Lw + 8192;
    const int vbV = (int)(uintptr_t)imgV + att::v_rd_base(lane), vbK = vbV + 8192;
    stage64b(imgV, base + O_BV + h * 64, DP, lane);
#pragma unroll 1
    for (int dir = 0; dir < 2; ++dir) {
        const int chain = bh * 2 + dir, c = dir == 0 ? tc : (tc < 4 ? 3 - tc : 39 - tc);
        const float bi = p.mgb[layer * 16 + (dir * 2 + 0) * 4 + h], bf = p.mgb[layer * 16 + (dir * 2 + 1) * 4 + h];
        float cumf[2], g[2], G[2], cend, gmax;
        gates_B(base + O_BG + h, ro, dir, bi, bf, lane, cumf, g, G, cend, gmax);
        const float w[2] = {__expf(g[0] - gmax), __expf(g[1] - gmax)};
#pragma unroll
        for (int ks = 0; ks < 2; ++ks) {
            float un[8];
#pragma unroll
            for (int j = 0; j < 8; ++j) un[j] = 0.f;
#pragma unroll
            for (int tb = 0; tb < 2; ++tb) { float wk[8]; ld8(base + O_BK + h * 32 + 16 * ks, ro + 16u * hi + tb * (32u * DP * 2u), wk);
#pragma unroll
                for (int j = 0; j < 8; ++j) { wk[j] *= w[tb]; un[j] += wk[j]; }
                *(bf16x8*)(imgK + v_st64(32 * tb + r32, 16 * ks + 8 * hi)) = pack8(wk); }
#pragma unroll
            for (int j = 0; j < 8; ++j) { float t = un[j]; t = sum32(t);
                if (r32 == 0) ((float*)(p.ws + OFF_NB))[(chain * 36 + c) * 32 + 16 * ks + 8 * hi + j] = t; }
        }
        f32x16 u0 = {}, u1 = {};
        { bf16x8 k0, k1, k2, k3, v0, v1, v2, v3;
#define MM(acc, A, B) acc = __builtin_amdgcn_mfma_f32_32x32x16_bf16(A, B, acc, 0, 0, 0)
          frags4<0>(vbK, k0, k1, k2, k3); frags4<0>(vbV, v0, v1, v2, v3);
          MM(u0, k0, v0); MM(u0, k1, v1); MM(u0, k2, v2); MM(u0, k3, v3);
          frags4<1>(vbV, v0, v1, v2, v3);
          MM(u1, k0, v0); MM(u1, k1, v1); MM(u1, k2, v2); MM(u1, k3, v3);
#undef MM
        }
        float* U = (float*)(p.ws + OFF_UB) + ((size_t)chain * 36 + c) * 2048;
#pragma unroll
        for (int r = 0; r < 16; ++r) { U[crow(r, hi) * 64 + r32] = u0[r]; U[crow(r, hi) * 64 + 32 + r32] = u1[r]; }
        if (lane == 0) { float* M = (float*)(p.ws + OFF_MB) + (chain * 36 + c) * 4; M[0] = cend + gmax; M[1] = cend; }
    }
}
DEV void scanB_out(const Params& p, int layer, char* Lw, int bh, int tc, int lane) {
    using namespace scn;
    asm volatile("" : "+v"(lane));
    const int r32 = lane & 31, hi = lane >> 5, b = bh >> 2, h = bh & 3;
    const bf16_t* base = (const bf16_t*)(p.ws + OFF_PB) + (size_t)(b * SL + 64 * tc) * DP;
    unsigned ro = (unsigned)(r32 * DP) * 2u; asm volatile("" : "+v"(ro));
    char* imgV = Lw; char* imgC = Lw + 8192; float* gA = (float*)(Lw + 12288); float* dA = gA + 64;
    const int vbV = (int)(uintptr_t)imgV + att::v_rd_base(lane), vbC = vbV + 8192;
    stage64b(imgV, base + O_BV + h * 64, DP, lane);
#pragma unroll 1
    for (int dir = 0; dir < 2; ++dir) {
        const int chain = bh * 2 + dir, c = dir == 0 ? tc : (tc < 4 ? 3 - tc : 39 - tc);
        const float bi = p.mgb[layer * 16 + (dir * 2 + 0) * 4 + h], bf = p.mgb[layer * 16 + (dir * 2 + 1) * 4 + h];
        { const float* cg = (const float*)(p.ws + OFF_SB) + ((size_t)chain * 36 + c) * 2048 + (lane >> 1) * 64 + (lane & 1) * 32;
#pragma unroll
          for (int i = 0; i < 4; ++i) { const float4 a = *(const float4*)(cg + 8 * i), bq = *(const float4*)(cg + 8 * i + 4);
              u32x4 w = {cvt_pk_bf16(a.x, a.y), cvt_pk_bf16(a.z, a.w), cvt_pk_bf16(bq.x, bq.y), cvt_pk_bf16(bq.z, bq.w)};
              *(u32x4*)(imgC + v_st64(lane >> 1, (lane & 1) * 32 + 8 * i)) = w; } }
        const float m0 = ((const float*)(p.ws + OFF_MB))[(chain * 36 + c) * 4 + 2];
        float rq[2][2][8], rk[2][2][8];
#pragma unroll
        for (int ks = 0; ks < 2; ++ks)
#pragma unroll
            for (int tb = 0; tb < 2; ++tb) { const unsigned bo = ro + 16u * hi + tb * (32u * DP * 2u);
                ld8(base + O_BQ + h * 32 + 16 * ks, bo, rq[ks][tb]); ld8(base + O_BK + h * 32 + 16 * ks, bo, rk[ks][tb]); }
        float cumf[2], g[2], G[2], cend, gmax;
        gates_B(base + O_BG + h, ro, dir, bi, bf, lane, cumf, g, G, cend, gmax);
        float wi[2], wl[2], emt[2];
#pragma unroll
        for (int tb = 0; tb < 2; ++tb) { const float ml = cumf[tb] + G[tb], mt = fmaxf(cumf[tb] + m0, ml); wi[tb] = __expf(cumf[tb] + m0 - mt); wl[tb] = __expf(ml - mt); emt[tb] = __expf(-mt); }
        if (hi == 0) { gA[r32] = g[0]; gA[32 + r32] = g[1]; }
        f32x16 pd0 = {}, pd1 = {}, px = {};
        float qn[2] = {0.f, 0.f};
        bf16x8 qw[2][2];
#define MM(acc, A, B) acc = __builtin_amdgcn_mfma_f32_32x32x16_bf16(A, B, acc, 0, 0, 0)
#define KSTEP(ks) do { \
            bf16x8 qs0, qs1, kt0, kt1; \
            const float* nn = (const float*)(p.ws + OFF_N0) + (chain * 36 + c) * 32 + 16 * (ks) + 8 * hi; \
            _Pragma("unroll") for (int tb = 0; tb < 2; ++tb) { \
                float q8[8], k8[8], qv[8]; \
                _Pragma("unroll") for (int j = 0; j < 8; ++j) { q8[j] = rq[ks][tb][j] * 0.17677669529663687f; k8[j] = rk[ks][tb][j]; qn[tb] += q8[j] * nn[j]; qv[j] = q8[j] * wi[tb]; } \
                qw[tb][ks] = pack8(qv); \
                if (tb == 0) { qs0 = pack8(q8); kt0 = pack8(k8); } else { qs1 = pack8(q8); kt1 = pack8(k8); } } \
            MM(pd0, kt0, qs0); MM(pd1, kt1, qs1); if (dir == 0) MM(px, kt0, qs1); else MM(px, kt1, qs0); \
            SBAR(); } while (0)
        KSTEP(0); KSTEP(1);
#undef KSTEP
        qn[0] += bperm(qn[0], lane ^ 32); qn[1] += bperm(qn[1], lane ^ 32);
        float ds[2] = {0.f, 0.f};
#pragma unroll
        for (int r = 0; r < 16; ++r) {
            const int sl = crow(r, hi); const bool keep = dir == 0 ? (sl <= r32) : (sl >= r32);
            const float g0 = gA[sl], g1 = gA[32 + sl];
            const float e00 = keep ? __expf(g0 - G[0]) * wl[0] : 0.f, e11 = keep ? __expf(g1 - G[1]) * wl[1] : 0.f;
            const float ex = dir == 0 ? __expf(g0 - G[1]) * wl[1] : __expf(g1 - G[0]) * wl[0];
            pd0[r] *= e00; pd1[r] *= e11; px[r] *= ex;
            if (dir == 0) { ds[0] += pd0[r]; ds[1] += pd1[r] + px[r]; } else { ds[0] += pd0[r] + px[r]; ds[1] += pd1[r]; }
        }
        ds[0] += bperm(ds[0], lane ^ 32); ds[1] += bperm(ds[1], lane ^ 32);
#pragma unroll
        for (int tb = 0; tb < 2; ++tb) { const float den = wi[tb] * qn[tb] + ds[tb]; const float di = __builtin_amdgcn_rcpf(fmaxf(fabsf(den), emt[tb])); if (hi == 0) dA[32 * tb + r32] = di; }
        bf16x8 a0, a1, b0, b1, c0, c1;
#define PK4(P, BASE, OUT) do { unsigned a0_ = cvt_pk_bf16(P[BASE + 0], P[BASE + 1]), a1_ = cvt_pk_bf16(P[BASE + 2], P[BASE + 3]);   \
    unsigned b0_ = cvt_pk_bf16(P[BASE + 4], P[BASE + 5]), b1_ = cvt_pk_bf16(P[BASE + 6], P[BASE + 7]);                              \
    auto r0_ = __builtin_amdgcn_permlane32_swap(a0_, b0_, false, false); auto r1_ = __builtin_amdgcn_permlane32_swap(a1_, b1_, false, false); \
    u32x4 w_ = {r0_[0], r1_[0], r0_[1], r1_[1]}; OUT = *reinterpret_cast<bf16x8*>(&w_); } while (0)
        PK4(pd0, 0, a0); PK4(pd0, 8, a1); PK4(pd1, 0, b0); PK4(pd1, 8, b1); PK4(px, 0, c0); PK4(px, 8, c1);
#undef PK4
        SBAR();
        f32x16 o[2][2] = {};
        {   bf16x8 v0, v1, v2, v3;
#define BLOCK(D0) do { frags4<D0>(vbV, v0, v1, v2, v3); \
            if (dir == 0) { MM(o[0][D0], a0, v0); MM(o[0][D0], a1, v1); MM(o[1][D0], c0, v0); MM(o[1][D0], c1, v1); MM(o[1][D0], b0, v2); MM(o[1][D0], b1, v3); } \
            else          { MM(o[0][D0], a0, v0); MM(o[0][D0], a1, v1); MM(o[0][D0], c0, v2); MM(o[0][D0], c1, v3); MM(o[1][D0], b0, v2); MM(o[1][D0], b1, v3); } \
            { const s16x4 l0 = att::tr_read<v_rd_off64(D0, 0, 0)>(vbC), h0 = att::tr_read<v_rd_off64(D0, 0, 1)>(vbC), l1 = att::tr_read<v_rd_off64(D0, 1, 0)>(vbC), h1 = att::tr_read<v_rd_off64(D0, 1, 1)>(vbC); \
              asm volatile("s_waitcnt lgkmcnt(0)" ::: "memory"); SBAR(); \
              const bf16x8 s0 = SCN_PK(l0, h0), s1 = SCN_PK(l1, h1); \
              MM(o[0][D0], qw[0][0], s0); MM(o[0][D0], qw[0][1], s1); MM(o[1][D0], qw[1][0], s0); MM(o[1][D0], qw[1][1], s1); } } while (0)
            BLOCK(0); BLOCK(1);
#undef BLOCK
        }
#undef MM
        asm volatile("s_waitcnt lgkmcnt(0)" ::: "memory");
        unsigned rob = (unsigned)(4 * hi * DP + r32) * 2u, mob = (unsigned)(4 * hi * D + r32) * 2u, hob = (unsigned)(4 * hi * 256 + r32) * 4u;
        asm volatile("" : "+v"(rob), "+v"(mob), "+v"(hob));
        float* hpk = (float*)(p.ws + OFF_HB2) + (size_t)(b * SL + 64 * tc) * 256 + h * 64;
        if (dir == 0) {
#pragma unroll
            for (int tb = 0; tb < 2; ++tb)
#pragma unroll
                for (int r = 0; r < 16; ++r) { const float di = dA[32 * tb + crow(r, hi)]; const unsigned ho = hob + (unsigned)(32 * tb + (r & 3) + 8 * (r >> 2)) * 1024u;
                    *(float*)((char*)hpk + ho) = o[tb][0][r] * di; *(float*)((char*)hpk + ho + 128u) = o[tb][1][r] * di; }
            asm volatile("s_waitcnt vmcnt(0)" ::: "memory");
        } else {
#pragma unroll
            for (int tb = 0; tb < 2; ++tb)
#pragma unroll
                for (int r = 0; r < 16; ++r) {
                    const unsigned tcst = (unsigned)(32 * tb + (r & 3) + 8 * (r >> 2)); const unsigned ho = hob + tcst * 1024u;
                    const float di = dA[32 * tb + crow(r, hi)];
                    const float x0 = o[tb][0][r] * di + ldg1(hpk, ho), x1 = o[tb][1][r] * di + ldg1(hpk, ho + 128u);
                    float t = x0 * x0 + x1 * x1; t = sum32(t);
                    const float ri = rsqrtf(t * (1.f / 64.f) + 1e-6f);
                    const bf16_t* gb = base + O_BO + h * 64; const unsigned go = rob + tcst * (DP * 2u);
                    const float g0 = ld1(gb, go), g1 = ld1(gb, go + 64u);
                    char* mb = (char*)((bf16_t*)(p.ws + OFF_MIXB) + (size_t)(b * SL + 64 * tc) * D + 256 + h * 64); const unsigned mo = mob + tcst * (D * 2u);
                    *(bf16_t*)(mb + mo) = (bf16_t)(cvt_pk_bf16(x0 * ri * p.mnorm[layer * 256 + h * 64 + r32] * fsig(g0), 0.f) & 0xffffu);
                    *(bf16_t*)(mb + mo + 64u) = (bf16_t)(cvt_pk_bf16(x1 * ri * p.mnorm[layer * 256 + h * 64 + 32 + r32] * fsig(g1), 0.f) & 0xffffu);
                    if ((r & 3) == 3) SBAR();
                }
        }
    }
}

DEV int scan_token(int dir, int step) { return dir == 0 ? step : (step < CTX ? CTX - 1 - step : SL + CTX - 1 - step); }
DEV float logsig(float g) { return fminf(g, 0.f) - log1pf(expf(-fabsf(g))); }
DEV void ph_scan_local(const Params& p, int layer, char* smem) {
    const int wid = p.wave_id;
    const int G = (int)gridDim.x, nw = G * 8, nun = (NT / 256) * (DP / 256), nleft = 4 * G < nun ? nun - 4 * G : 0, nfree = G - nleft > 0 ? G - nleft : G;
    for (int it = 0; it < 2; ++it) {
        int task;
        if (it == 0) task = (int)blockIdx.x * 8 + wid;
        else { if ((int)blockIdx.x >= nfree) break; task = nw + wid * nfree + (int)blockIdx.x; }
        if (task >= 2304) break;
        const int lane = lane_asm();
        if (task < 1152) scanA_local(p, layer, smem + wid * 16384, task / 36, task % 36, lane);
        else scanB_local(p, layer, smem + wid * 16384, (task - 1152) / 36, (task - 1152) % 36, lane);
    }
}
DEV void ph_scan_carry(const Params& p, char* smem) {
    const int tid = tid_of(p.wave_id);
    const int gt = (int)blockIdx.x * 512 + tid, nth = (int)gridDim.x * 512;
    for (int e = gt; e < 64 * 4096; e += nth) {
        const int chain = e >> 12, kv = e & 4095, k = kv >> 6;
        const float* U = (const float*)(p.ws + OFF_UA) + (size_t)chain * 36 * 4096 + kv; float* SO = (float*)(p.ws + OFF_SA) + (size_t)chain * 36 * 4096 + kv; const float* Dc = (const float*)(p.ws + OFF_DECA) + chain * 36 * 64 + k;
        float u[36], d[36];
#pragma unroll
        for (int c = 0; c < 36; ++c) { u[c] = U[(size_t)c * 4096]; d[c] = Dc[c * 64]; }
        float S = 0.f;
#pragma unroll
        for (int c = 0; c < 36; ++c) { SO[(size_t)c * 4096] = S; S = d[c] * S + u[c]; }
    }
    for (int e = gt; e < 64 * 2048; e += nth) {
        const int chain = e >> 11, kv = e & 2047;
        const float* U = (const float*)(p.ws + OFF_UB) + (size_t)chain * 36 * 2048 + kv; float* SO = (float*)(p.ws + OFF_SB) + (size_t)chain * 36 * 2048 + kv; const float* M = (const float*)(p.ws + OFF_MB) + chain * 36 * 4;
        float u[36], mle[36], ce[36];
#pragma unroll
        for (int c = 0; c < 36; ++c) { u[c] = U[(size_t)c * 2048]; mle[c] = M[c * 4 + 0]; ce[c] = M[c * 4 + 1]; }
        float Cc = 0.f, m = 0.f;
#pragma unroll
        for (int c = 0; c < 36; ++c) { SO[(size_t)c * 2048] = Cc;
            const float mn = fmaxf(ce[c] + m, mle[c]); Cc = expf(ce[c] + m - mn) * Cc + expf(mle[c] - mn) * u[c]; m = mn; }
    }
    for (int e = gt; e < 64 * 32; e += nth) {
        const int chain = e >> 5, k = e & 31;
        const float* N = (const float*)(p.ws + OFF_NB) + chain * 36 * 32 + k; float* NO = (float*)(p.ws + OFF_N0) + chain * 36 * 32 + k; float* M = (float*)(p.ws + OFF_MB) + chain * 36 * 4;
        float u[36], mle[36], ce[36];
#pragma unroll
        for (int c = 0; c < 36; ++c) { u[c] = N[c * 32]; mle[c] = M[c * 4 + 0]; ce[c] = M[c * 4 + 1]; }
        float nn = 0.f, m = 0.f;
#pragma unroll
        for (int c = 0; c < 36; ++c) { NO[c * 32] = nn; if (k == 0) M[c * 4 + 2] = m;
            const float mn = fmaxf(ce[c] + m, mle[c]); nn = expf(ce[c] + m - mn) * nn + expf(mle[c] - mn) * u[c]; m = mn; }
    }
}
DEV void ph_scan_out(const Params& p, int layer, char* smem) {
    const int wid = p.wave_id;
    const int nw = (int)gridDim.x * 8, ntc = layer == 0 ? 36 : 32, tc0 = layer == 0 ? 0 : 4, half = 32 * ntc, total = 2 * half;
    for (int it = 0; it < 2 + (total - nw > 0 ? (total - nw) / (int)gridDim.x : 0); ++it) {
        int task;
        if (it == 0) task = (int)blockIdx.x * 8 + wid;
        else { if (wid != 0) break; task = nw + (it - 1) * (int)gridDim.x + (int)blockIdx.x; }
        if (task >= total) break;
        const int lane = lane_asm();
        const bool isB = task >= half; const int tt = isB ? task - half : task, bh = tt / ntc, tc = tc0 + tt % ntc;
        if (!isB) scanA_out(p, layer, smem + wid * 16384, bh, tc, lane);
        else scanB_out(p, layer, smem + wid * 16384, bh, tc, lane);
    }
}

DEV void ph_attn(const Params& p, int layer, char* smem) {
    const int wid = p.wave_id, js = wid & 1, qb = wid >> 1;
    const float lam = ((const float*)(p.ws + OFF_LAM))[layer], omli = 1.f - lam_init_of(layer);
    const bf16_t* KB = (const bf16_t*)(p.ws + OFF_KB); const bf16_t* VB = (const bf16_t*)(p.ws + OFF_VB);
    const bf16_t* QRB = (const bf16_t*)(p.ws + OFF_QRB); const bf16_t* Q0B = (const bf16_t*)(p.ws + OFF_Q0B);
    const int G = (int)gridDim.x, c = (int)blockIdx.x;
    const int nlat = 512, ntot = nlat + (layer == 0 ? 64 : 0);
    for (int i = 0;; ++i) {
        int bh, s0; bool isctx;
        if (G == 256) {
            const int xcd = c & 7, j = c >> 3;
            if (i < 2) { bh = xcd + 8 * (i * 2 + (j >> 4)); s0 = CTX + (j & 15) * 128; isctx = false; }
            else if (i == 2 && layer == 0 && j < 8) { bh = xcd + 8 * (j >> 1); s0 = (j & 1) * 128; isctx = true; }
            else break;
        } else {
            const int u = i * G + c; if (u >= ntot) break;
            if (u < nlat) { bh = u >> 4; s0 = CTX + (u & 15) * 128; isctx = false; } else { const int v = u - nlat; bh = v >> 1; s0 = (v & 1) * 128; isctx = true; }
        }
        const int lane = lane_asm(), tid = (wid << 6) | lane, r32 = lane & 31, hi = lane >> 5;
        const bf16_t* Kh = KB + (size_t)bh * SL * 128; const bf16_t* Vh = VB + (size_t)bh * SL * 128;
        const size_t qoff = ((size_t)bh * SL + s0 + qb * 32 + r32) * 128 + js * 64 + hi * 8;
        att::bf16x8 qr[4];
#pragma unroll
        for (int d0 = 0; d0 < 4; ++d0) qr[d0] = *(const att::bf16x8*)(Q0B + qoff + d0 * 16);
        float m_reg = -1e30f, l_reg = 0.f; att::f32x16 o[4] = {};
        att::attn_tiles(qr, Kh, Vh, CTX, smem, m_reg, l_reg, o, tid, js);
        if (!isctx) {
#pragma unroll
            for (int d0 = 0; d0 < 4; ++d0) qr[d0] = *(const att::bf16x8*)(QRB + qoff + d0 * 16);
            att::attn_tiles(qr, Kh + (size_t)CTX * 128, Vh + (size_t)CTX * 128, SEQ, smem, m_reg, l_reg, o, tid, js);
        }
        float* wsw = (float*)(smem + 2 * att::SHM_V + 2 * att::SHM_K) + wid * 64;
        __syncthreads();
        if (hi == 0) wsw[r32] = l_reg;
        asm volatile("s_waitcnt lgkmcnt(0)" ::: "memory");
        float rli[16];
#pragma unroll
        for (int r = 0; r < 16; ++r) rli[r] = __builtin_amdgcn_rcpf(wsw[att::crow(r, hi)]);
        float* X = (float*)smem + qb * 4096;
        if (js == 1) {
#pragma unroll
            for (int d0 = 0; d0 < 4; ++d0)
#pragma unroll
                for (int r = 0; r < 16; ++r) X[(d0 * 16 + r) * 64 + lane] = o[d0][r] * rli[r];
        }
        __syncthreads();
        if (js == 0) {
            const int b = bh >> 2, h = bh & 3;
            float ss[16];
#pragma unroll
            for (int r = 0; r < 16; ++r) ss[r] = 0.f;
#pragma unroll
            for (int d0 = 0; d0 < 4; ++d0)
#pragma unroll
                for (int r = 0; r < 16; ++r) { const float v = o[d0][r] * rli[r] - lam * X[(d0 * 16 + r) * 64 + lane]; o[d0][r] = v; ss[r] += v * v; }
#pragma unroll
            for (int r = 0; r < 16; ++r) { const float t = sum32(ss[r]);
                ss[r] = rsqrtf(t * (1.f / 128.f) + 1e-6f) * omli; }
            bf16_t* Tq = (bf16_t*)X;
#pragma unroll
            for (int d0 = 0; d0 < 4; ++d0) { const float g = p.dnorm[layer * 128 + d0 * 32 + r32];
#pragma unroll
                for (int r = 0; r < 16; ++r) Tq[att::crow(r, hi) * 128 + d0 * 32 + r32] = (bf16_t)(cvt_pk_bf16(o[d0][r] * ss[r] * g, 0.f) & 0xffffu); }
            char* mixb = (char*)((bf16_t*)(p.ws + OFF_MIXB) + (size_t)(b * SL + s0 + qb * 32) * D + 512 + h * 128);
#pragma unroll
            for (int k = 0; k < 8; ++k) { const int idx = lane + 64 * k, row = idx >> 4, ch = idx & 15;
                *(pg8::u32x4*)(mixb + (size_t)row * (D * 2) + ch * 16) = *(const pg8::u32x4*)((const char*)Tq + row * 256 + ch * 16); }
        }
        __syncthreads();
    }
}

struct EpiRowsBf16 {
    static constexpr bool PERM = true;
    bf16_t* O; int ldc;
    DEV void operator()(const pg8::f32x4 (&acc)[2][2][4][2], const pg8::Unit& u, int wr, int wc, int fr, int fq) const {
        const int row0 = u.pm * 256 + wr * 64 + fr, col0 = u.pn * 256 + wc * 32 + 8 * fq;
#pragma unroll
        for (int ai = 0; ai < 2; ++ai)
#pragma unroll
            for (int m = 0; m < 4; ++m) { bf16_t* rowp = O + (size_t)(row0 + ai * 128 + m * 16) * ldc + col0;
#pragma unroll
                for (int bj = 0; bj < 2; ++bj) { const pg8::f32x4 v0 = acc[ai][bj][m][0], v1 = acc[ai][bj][m][1];
                    pg8::u32x4 w; w.x = cvt_pk_bf16(v0[0], v0[1]); w.y = cvt_pk_bf16(v0[2], v0[3]); w.z = cvt_pk_bf16(v1[0], v1[1]); w.w = cvt_pk_bf16(v1[2], v1[3]);
                    *(pg8::u32x4*)(rowp + bj * 128) = w; } }
    }
};
DEV void ph_outproj(const Params& p, int layer, char* smem) {
    const int tidx = tid_of(p.wave_id);
    pg8::StaticOrder S; S.init(layer == 0 ? NT / 256 : NB * 8, D / 256, (int)gridDim.x, (int)blockIdx.x, layer == 0 ? 0 : 1, (const bf16_t*)(p.ws + OFF_WOUT) + (size_t)layer * D * D, D);
    EpiRowsBf16 E{(bf16_t*)(p.ws + OFF_MIXO), D};
    pg8::gemm_phase((LAS unsigned char*)smem, (const char*)(p.ws + OFF_MIXB), D, S, E, tid_of(p.wave_id));
}
DEV void ph_norm2(const Params& p, int layer, char* smem) {
    typedef float f32x16 __attribute__((ext_vector_type(16)));
    const int wid = p.wave_id, lane = lane_asm(), tidx = (wid << 6) | lane;
    constexpr int XP = 1028, RP = 24;
    float* xs = (float*)smem;
    float* red = (float*)smem;
    int* hist = (int*)(smem + 32 * XP * 4);
    int* offl = hist + 32;
    int* sel = hist + 64;
    const float* nr = p.norms + (size_t)layer * 4 * D;
    if (tidx < NE) hist[tidx] = 0;
    const int chunk = (NT + (int)gridDim.x - 1) / (int)gridDim.x, rbeg = (int)blockIdx.x * chunk, rend = min(NT, rbeg + chunk);
    for (int i = tidx; i < chunk * 4; i += 512) sel[i] = -1;
    float4 cA[4], cB[4], cC[4]; int ckey = -1;
    float wreg[64];
    { const float* wb = p.rw + (size_t)layer * D * NE + (size_t)(wid * 128 + (lane >> 5)) * NE + (lane & 31);
#pragma unroll
      for (int ks = 0; ks < 64; ++ks) wreg[ks] = wb[(size_t)2 * ks * NE]; }
    for (int r0 = rbeg; r0 < rend; r0 += RP) {
        __syncthreads();
#pragma unroll 1
        for (int j = 0; j < 3; ++j) {
            const int lr = wid * 3 + j, r = r0 + lr;
            if (r >= rend) continue;
            const int b = r / SL, s = r % SL;
            if (layer != 0 && s < CTX) continue;
            float4 mo[4], xv[4], o[4]; row_load_bf((const bf16_t*)(p.ws + OFF_MIXO) + (size_t)r * D, mo, lane); row_load_bf((const bf16_t*)(p.ws + OFF_X) + (size_t)r * D, xv, lane);
            { const int key = s < CTX ? 8 : b;
              if (key != ckey) { ckey = key; const float* m = modrow(p, layer, b, s);
#pragma unroll
                  for (int i = 0; i < 4; ++i) { const int idx = i * 256 + lane * 4; const float4 g = *(const float4*)(nr + D + idx), gt = *(const float4*)(m + 2048 + idx), gn = *(const float4*)(nr + 2 * D + idx), sh = *(const float4*)(m + 3072 + idx), sc = *(const float4*)(m + 4096 + idx);
                      cA[i] = make_float4(g.x * gt.x, g.y * gt.y, g.z * gt.z, g.w * gt.w); cB[i] = make_float4(gn.x * (1.f + sc.x), gn.y * (1.f + sc.y), gn.z * (1.f + sc.z), gn.w * (1.f + sc.w)); cC[i] = sh; } } }
            const float ri = row_rinv(mo);
#pragma unroll
            for (int i = 0; i < 4; ++i) { xv[i].x += cA[i].x * (mo[i].x * ri); xv[i].y += cA[i].y * (mo[i].y * ri); xv[i].z += cA[i].z * (mo[i].z * ri); xv[i].w += cA[i].w * (mo[i].w * ri); }
            row_store_bf16((bf16_t*)(p.ws + OFF_XN) + (size_t)r * D, xv, lane);
            { const float rn = row_rinv(xv);
#pragma unroll
              for (int i = 0; i < 4; ++i) o[i] = make_float4(xv[i].x * rn * cB[i].x + cC[i].x, xv[i].y * rn * cB[i].y + cC[i].y, xv[i].z * rn * cB[i].z + cC[i].z, xv[i].w * rn * cB[i].w + cC[i].w); }
            row_store_fp8((unsigned char*)(p.ws + OFF_XNB) + (size_t)r * D, o, lane, F8_SX);
            row_store(xs + lr * XP, o, lane);
        }
        __syncthreads();
        f32x16 acc = {};
        { const float* xa = xs + (lane & 31) * XP + wid * 128 + (lane >> 5);
#pragma unroll
          for (int ks = 0; ks < 64; ++ks) acc = __builtin_amdgcn_mfma_f32_32x32x2f32(xa[2 * ks], wreg[ks], acc, 0, 0, 0); }
        __syncthreads();
#pragma unroll
        for (int rg = 0; rg < 16; ++rg) red[(wid * 32 + (rg & 3) + 8 * (rg >> 2) + 4 * (lane >> 5)) * 32 + (lane & 31)] = acc[rg];
        __syncthreads();
#pragma unroll 1
        for (int j = 0; j < 3; ++j) {
            const int lr = wid * 3 + j, r = r0 + lr;
            if (r >= rend) continue;
            const int s = r % SL;
            if (layer != 0 && s < CTX) continue;
            const int e = lane & 31;
            float logit = p.rb[layer * NE + e];
#pragma unroll
            for (int w = 0; w < 8; ++w) logit += red[(w * 32 + lr) * 32 + e];
            float tv[4]; int ti[4];
#pragma unroll
            for (int k = 0; k < 4; ++k) {
                float bv = logit; int bi = e;
                argmax32(bv, bi);
                tv[k] = bv; ti[k] = bi; if (e == bi) logit = -3.0e38f;
            }
            const float e0 = 1.f, e1 = expf(tv[1] - tv[0]), e2 = expf(tv[2] - tv[0]), e3 = expf(tv[3] - tv[0]), inv = 1.f / (e0 + e1 + e2 + e3);
            if (lane == 0) { *(float4*)(((float*)(p.ws + OFF_TOPW)) + (size_t)r * 4) = make_float4(e0 * inv, e1 * inv, e2 * inv, e3 * inv); *(int4*)(((int*)(p.ws + OFF_TOPI)) + (size_t)r * 4) = make_int4(ti[0], ti[1], ti[2], ti[3]); }
            if (lane < 4) { const int es = lane == 0 ? ti[0] : lane == 1 ? ti[1] : lane == 2 ? ti[2] : ti[3]; atomicAdd(&hist[es], 1); sel[(r - rbeg) * 4 + lane] = es; }
        }
    }
    __syncthreads();
    if (tidx < NE) { const int h = hist[tidx]; offl[tidx] = h ? (int)__hip_atomic_fetch_add((unsigned*)(p.ws + OFF_bar) + CW_CNT + layer * NE + tidx, (unsigned)h, __ATOMIC_RELAXED, __HIP_MEMORY_SCOPE_AGENT) : 0; }
    __syncthreads();
    for (int i = tidx; i < (rend - rbeg) * 4; i += 512) { const int e = sel[i];
        if (e >= 0) { const int pos = atomicAdd(&offl[e], 1); ((int*)(p.ws + OFF_LIST))[(size_t)e * LISTCAP + pos] = rbeg * 4 + i; } }
}
DEV int moe_rt(int i, int G, int c, int npn, int& pn) {
    if (G == 256) { const int xcd = c & 7, j = c >> 3, rpx = 32 / npn; pn = j % npn; return (i * 8 + xcd) * rpx + j / npn; }
    const int L = i * G + c; pn = L % npn; return L / npn;
}
constexpr int MOE_LDS = 131072, MOE_MAXU = 12;
DEV void moe_prepare(const Params& p, int layer, char* smem, int npn, int mode) {
    const int tidx = tid_of(p.wave_id);
    LAS int* base = (LAS int*)(smem + MOE_LDS);
    LAS int *TE = base, *TT = base + 320, *NRT = base + 640, *CN = base + 656  , *UI = base + 704, *IDX = base + 768;
    if (tidx < NE) CN[tidx] = ((const int*)(p.ws + OFF_bar))[CW_CNT + layer * NE + tidx];
    __syncthreads();
    if (tidx < 320) { int e = 0, acc = 0; for (; e < NE; ++e) { const int n = (CN[e] + 255) >> 8; if (tidx < acc + n) break; acc += n; } TE[tidx] = e; TT[tidx] = tidx - acc; }
    if (tidx == 0) { int tot = 0; for (int e = 0; e < NE; ++e) tot += (CN[e] + 255) >> 8; NRT[0] = tot; }
    __syncthreads();
    const int nrt = NRT[0];
#pragma unroll
    for (int k = 0; k < (MOE_MAXU * 256) / 512; ++k) {
        const int idx = tidx + 512 * k, i = idx >> 8, row = idx & 255;
        int pn; const int rt = moe_rt(i, (int)gridDim.x, (int)blockIdx.x, npn, pn);
        if (rt < nrt) { const int e = TE[rt], t = TT[rt], c = CN[e], q = t * 256 + row;
            const int pair = ((const int*)(p.ws + OFF_LIST))[(size_t)e * LISTCAP + min(q, c - 1)];
            IDX[idx] = mode == 1 ? (pair >> 2) : (q < c ? pair : -1); }
    }
    if (tidx < MOE_MAXU) { int pn; const int rt = moe_rt(tidx, (int)gridDim.x, (int)blockIdx.x, npn, pn);
        if (rt < nrt) { const int e = TE[rt], t = TT[rt], c = CN[e]; int pre = 0; for (int z = 0; z < e; ++z) pre += CN[z]; UI[tidx * 4 + 0] = min(256, c - t * 256); UI[tidx * 4 + 1] = pre + t * 256; } }
    __syncthreads();
}
struct MoeOrder {
    const LAS int *te, *ui, *idx; int nrt, npn, G, c, gather; const char* Bt; size_t bstride; int K;
    DEV bool next(int i, pg8::Unit& u) const { int pn; const int rt = moe_rt(i, G, c, npn, pn); if (rt >= nrt || i >= MOE_MAXU) return false;
        u.pm = rt; u.pn = pn; u.e = __builtin_amdgcn_readfirstlane(te[rt]); u.t = i; return true; }
    DEV int arow(const pg8::Unit& u, int rr) const { return gather ? idx[u.t * 256 + rr] : ui[u.t * 4 + 1] + rr; }
    DEV const char* bbase(const pg8::Unit& u) const { return Bt + (size_t)u.e * bstride + (size_t)u.pn * pg8::BM * K * 2; }
};
DEV float swiglu(float g, float l) { g = fminf(g, 7.f); l = fminf(fmaxf(l, -7.f), 7.f); return g * __builtin_amdgcn_rcpf(1.f + __builtin_amdgcn_exp2f(-1.702f * 1.4426950408889634f * g)) * (l + 1.f); }
struct EpiSwiglu {
    static constexpr bool PERM = true;
    unsigned char* H; const float* b1; const LAS int* ui;
    DEV void operator()(const pg8::f32x4 (&acc)[2][2][4][2], const pg8::Unit& u, int wr, int wc, int fr, int fq) const {
        const int ucnt = ui[u.t * 4 + 0], hrow0 = ui[u.t * 4 + 1], col0 = u.pn * 256 + wc * 32 + 8 * fq;
        const float* bb = b1 + (size_t)u.e * 2048 + col0;
        pg8::f32x4 bv[2][2];
#pragma unroll
        for (int bj = 0; bj < 2; ++bj)
#pragma unroll
            for (int n = 0; n < 2; ++n) bv[bj][n] = *(const pg8::f32x4*)(bb + bj * 128 + 4 * n);
        __builtin_amdgcn_s_waitcnt(0x0F70);
#pragma unroll
        for (int ai = 0; ai < 2; ++ai)
#pragma unroll
            for (int m = 0; m < 4; ++m) { const int rr = ai * 128 + wr * 64 + m * 16 + fr;
                if (rr < ucnt) { unsigned char* rowp = H + (size_t)(hrow0 + rr) * DFF + (col0 >> 1);
#pragma unroll
                    for (int bj = 0; bj < 2; ++bj) { constexpr float DS = 1.f / (F8_SX * F8_SW); const pg8::f32x4 v0 = acc[ai][bj][m][0] * DS + bv[bj][0], v1 = acc[ai][bj][m][1] * DS + bv[bj][1];
                        *(unsigned*)(rowp + bj * 64) = pk4_fp8(F8_SH * swiglu(v0[0], v0[1]), F8_SH * swiglu(v0[2], v0[3]), F8_SH * swiglu(v1[0], v1[1]), F8_SH * swiglu(v1[2], v1[3])); } } }
    }
};
struct EpiY {
    static constexpr bool PERM = true;
    unsigned char* Y; const LAS int* idx; const float* b2;
    DEV void operator()(const pg8::f32x4 (&acc)[2][2][4][2], const pg8::Unit& u, int wr, int wc, int fr, int fq) const {
        const int col0 = u.pn * 256 + wc * 32 + 8 * fq;
        const float* bb = b2 + (size_t)u.e * D + col0;
        pg8::f32x4 bv[2][2];
#pragma unroll
        for (int bj = 0; bj < 2; ++bj)
#pragma unroll
            for (int n = 0; n < 2; ++n) bv[bj][n] = *(const pg8::f32x4*)(bb + bj * 128 + 4 * n);
        __builtin_amdgcn_s_waitcnt(0x0F70);
#pragma unroll
        for (int ai = 0; ai < 2; ++ai)
#pragma unroll
            for (int m = 0; m < 4; ++m) { const int rr = ai * 128 + wr * 64 + m * 16 + fr; const int pair = idx[u.t * 256 + rr];
                if (pair >= 0) { unsigned char* rowp = Y + (size_t)pair * D + col0;
#pragma unroll
                    for (int bj = 0; bj < 2; ++bj) { constexpr float DS = 1.f / (F8_SH * F8_SW); const pg8::f32x4 v0 = acc[ai][bj][m][0] * DS + bv[bj][0], v1 = acc[ai][bj][m][1] * DS + bv[bj][1];
                        pg8::u32x2 w; w.x = pk4_fp8(v0[0] * F8_SY, v0[1] * F8_SY, v0[2] * F8_SY, v0[3] * F8_SY); w.y = pk4_fp8(v1[0] * F8_SY, v1[1] * F8_SY, v1[2] * F8_SY, v1[3] * F8_SY);
                        *(pg8::u32x2*)(rowp + bj * 128) = w; } } }
    }
};
DEV void ph_moe1(const Params& p, int layer, char* smem) {
    moe_prepare(p, layer, smem, 8, 1);
    LAS int* base = (LAS int*)(smem + MOE_LDS);
    MoeOrder S{base, base + 704, base + 768, base[640], 8, (int)gridDim.x, (int)blockIdx.x, 1, (const char*)(p.ws + OFF_W1T) + (size_t)layer * NE * 2048 * D, (size_t)2048 * D, D / 2};
    EpiSwiglu E{(unsigned char*)(p.ws + OFF_H), p.b1 + (size_t)layer * NE * 2048, base + 704};
    pg8::gemm_phase<EpiSwiglu, MoeOrder, true>((LAS unsigned char*)smem, (const char*)(p.ws + OFF_XNB), D / 2, S, E, tid_of(p.wave_id));
}
DEV void ph_moe2(const Params& p, int layer, char* smem) {
    moe_prepare(p, layer, smem, 4, 2);
    LAS int* base = (LAS int*)(smem + MOE_LDS);
    MoeOrder S{base, base + 704, base + 768, base[640], 4, (int)gridDim.x, (int)blockIdx.x, 0, (const char*)(p.ws + OFF_W2T) + (size_t)layer * NE * D * DFF, (size_t)D * DFF, DFF / 2};
    EpiY E{(unsigned char*)(p.ws + OFF_Y), base + 768, p.b2 + (size_t)layer * NE * D};
    pg8::gemm_phase<EpiY, MoeOrder, true>((LAS unsigned char*)smem, (const char*)(p.ws + OFF_H), DFF / 2, S, E, tid_of(p.wave_id));
}
DEV void ph_combine(const Params& p, int layer, char* smem) {
    const int wid = p.wave_id, lane = lane_asm();
    const float* nr = p.norms + (size_t)layer * 4 * D;
    const int total = layer == 0 ? NT : NB * SEQ, G = (int)gridDim.x, chunk = (total + G - 1) / G, qbeg = (int)blockIdx.x * chunk, qend = min(total, qbeg + chunk);
    float4 cA[4], cB[4], cC[4]; int ckey = -1;
    for (int q0 = qbeg + wid; q0 < qend; q0 += 16) {
        int rr[2]; bool ok[2]; float4 tw[2];
#pragma unroll
        for (int u = 0; u < 2; ++u) { const int q = q0 + u * 8; ok[u] = q < qend; const int qq = ok[u] ? q : q0;
            rr[u] = layer == 0 ? qq : (qq / SEQ) * SL + CTX + qq % SEQ;
            tw[u] = *(const float4*)(((float*)(p.ws + OFF_TOPW)) + (size_t)rr[u] * 4); }
        float4 f[2][4], xv[2][4];
#pragma unroll
        for (int u = 0; u < 2; ++u) {
            const int r = rr[u];
            const float w[4] = {tw[u].x * (1.f / F8_SY), tw[u].y * (1.f / F8_SY), tw[u].z * (1.f / F8_SY), tw[u].w * (1.f / F8_SY)};
#pragma unroll
            for (int i = 0; i < 4; ++i) f[u][i] = make_float4(0.f, 0.f, 0.f, 0.f);
#pragma unroll
            for (int k = 0; k < 4; ++k) {
                const unsigned char* y = (const unsigned char*)(p.ws + OFF_Y) + ((size_t)r * 4 + k) * D;
#pragma unroll
                for (int i = 0; i < 4; ++i) { const int idx = i * 256 + lane * 4; const int yb = *(const int*)(y + idx);
                    const auto lo = __builtin_amdgcn_cvt_pk_f32_fp8(yb, false), hi2 = __builtin_amdgcn_cvt_pk_f32_fp8(yb, true);
                    f[u][i].x += w[k] * lo[0]; f[u][i].y += w[k] * lo[1]; f[u][i].z += w[k] * hi2[0]; f[u][i].w += w[k] * hi2[1]; }
            }
            row_load_bf((const bf16_t*)(p.ws + OFF_XN) + (size_t)r * D, xv[u], lane);
        }
#pragma unroll
        for (int u = 0; u < 2; ++u) {
            const int r = rr[u], b = r / SL, s = r % SL;
            { const int key = s < CTX ? 8 : b;
              if (key != ckey) { ckey = key; const float* m = modrow(p, layer, b, s); const float* m1 = modrow(p, 1, b, s);
#pragma unroll
                  for (int i = 0; i < 4; ++i) { const int idx = i * 256 + lane * 4; const float4 g = *(const float4*)(nr + 3 * D + idx), gt = *(const float4*)(m + 5120 + idx);
                      cA[i] = make_float4(g.x * gt.x, g.y * gt.y, g.z * gt.z, g.w * gt.w);
                      if (layer == 0) { const float4 gn = *(const float4*)(p.norms + (size_t)4 * D + idx), sh = *(const float4*)(m1 + idx), sc = *(const float4*)(m1 + 1024 + idx);
                          cB[i] = make_float4(gn.x * (1.f + sc.x), gn.y * (1.f + sc.y), gn.z * (1.f + sc.z), gn.w * (1.f + sc.w)); cC[i] = sh; } } } }
            const float ri = row_rinv(f[u]);
#pragma unroll
            for (int i = 0; i < 4; ++i) { xv[u][i].x += cA[i].x * (f[u][i].x * ri); xv[u][i].y += cA[i].y * (f[u][i].y * ri); xv[u][i].z += cA[i].z * (f[u][i].z * ri); xv[u][i].w += cA[i].w * (f[u][i].w * ri); }
            if (ok[u]) {
                if (layer == 0) {
                    row_store_bf16((bf16_t*)(p.ws + OFF_X) + (size_t)r * D, xv[u], lane);
                    float4 o[4]; const float rn = row_rinv(xv[u]);
#pragma unroll
                    for (int i = 0; i < 4; ++i) o[i] = make_float4(xv[u][i].x * rn * cB[i].x + cC[i].x, xv[u][i].y * rn * cB[i].y + cC[i].y, xv[u][i].z * rn * cB[i].z + cC[i].z, xv[u][i].w * rn * cB[i].w + cC[i].w);
                    row_store_bf16((bf16_t*)(p.ws + OFF_XNB) + (size_t)r * D, o, lane);
                } else {
                    row_store(p.out + ((size_t)b * SEQ + (s - CTX)) * D, xv[u], lane);
                }
            }
        }
    }
}

template <int layer> DEV void run_layer(const Params& p, char* smem, const XcdBarrier& bar) {
#define GB() xcd_barrier(bar)

        ph_inproj(p, layer, smem, 0); GB();
        ph_inproj(p, layer, smem, 1); ph_scan_local(p, layer, smem); GB();
        ph_scan_carry(p, smem); ph_attn(p, layer, smem); GB();
        ph_scan_out(p, layer, smem); GB();
        ph_outproj(p, layer, smem); GB();
        ph_norm2(p, layer, smem); GB();
        ph_moe1(p, layer, smem); GB();
        ph_moe2(p, layer, smem); GB();
        ph_combine(p, layer, smem); GB();
    #undef GB
}
constexpr int LDS_BYTES = 147456;
__global__ __launch_bounds__(512, 2) void k_mega(Params p_in) {
    Params p = p_in; p.wave_id = __builtin_amdgcn_readfirstlane((int)(threadIdx.x >> 6));
    extern __shared__ __attribute__((aligned(16))) char smem[];
    volatile LAS unsigned* st = (volatile LAS unsigned*)(smem + LDS_BYTES - 16);
    if (threadIdx.x == 0) { st[0] = 0u; st[1] = 0u; st[2] = 0u; st[3] = 0u; }
    __syncthreads();
    const XcdBarrier bar = xcd_barrier_post(((unsigned*)(p.ws + OFF_bar)), st, p.wave_id);
#define GB() xcd_barrier(bar)
    ph_mods(p, smem); ph_convert(p, smem); GB();
    ph_init(p, smem); GB();
    run_layer<0>(p, smem, bar);
    run_layer<1>(p, smem, bar);
#undef GB
}
}

extern "C" void kernel_launch(void* const* d_in, const int* in_sizes, int n_in, void* d_out, int out_size, void* d_ws, size_t ws_size, hipStream_t stream) {
    static int grid = 0;
    if (grid == 0) {
        int dev = 0, cus = 0, per_cu = 0;
        if (hipGetDevice(&dev) != hipSuccess || hipDeviceGetAttribute(&cus, hipDeviceAttributeMultiprocessorCount, dev) != hipSuccess) { grid = -1; return; }
        if (hipFuncSetAttribute((const void*)k_mega, hipFuncAttributeMaxDynamicSharedMemorySize, LDS_BYTES) != hipSuccess) { grid = -1; return; }
        (void)hipOccupancyMaxActiveBlocksPerMultiprocessor(&per_cu, (const void*)k_mega, 512, LDS_BYTES);
        (void)hipGetLastError();
        grid = cus;
    }
    if (grid < 0) return;
    Params p{};
    const float** in = (const float**)&p;
    for (int i = 0; i < 21; ++i) in[i] = (const float*)d_in[i];
    p.out = (float*)d_out;
    p.ws = (char*)d_ws;
    if (WS_END > ws_size) return;
    if (hipMemsetAsync(p.ws + OFF_bar, 0, (size_t)CTL_BYTES, stream) != hipSuccess) return;
    hipLaunchKernelGGL(k_mega, dim3(grid), dim3(512), LDS_BYTES, stream, p);
}
```
